# Optimizing an MI355X kernel written in HIP

```python
import math
import jax, jax.numpy as jnp
from jax import lax
import numpy as np

D_MODEL = 1024
BATCH = 8
SEQ = 8192
DEPTH = 1

MEM_LEN = 256
LN_EPS = 1e-5
DN_ALPHA = (2.0 * DEPTH) ** 0.25
DN_BETA = (8.0 * DEPTH) ** -0.25

DIL_GROUPS = ((128, 1), (512, 4), (2048, 16))
N_DIL_GROUPS = 3
DIL_HEADS = 4
DIL_HEAD_DIM = 128
DIL_WIDTH = DIL_HEADS * DIL_HEAD_DIM
DIL_GROUP_COLS = N_DIL_GROUPS * DIL_HEADS * DIL_HEAD_DIM
DIL_QKV_COLS = 3 * DIL_GROUP_COLS
DIL_BLOCK = 128

REL_BUCKETS = 32
REL_MAX_DIST = 2048

HG_HEADS = 4
HG_DK = 128
HG_DV = 128
HG_WIDTH = HG_HEADS * HG_DV
HG_COLS = 4 * HG_WIDTH
HG_I_OFF = DIL_QKV_COLS + HG_WIDTH
HG_CHUNK = 64

MEM_HEADS = 4
MEM_HEAD_DIM = 128
MEM_WIDTH = MEM_HEADS * MEM_HEAD_DIM

N_BRANCHES = 3
GATE_COLS = N_BRANCHES * D_MODEL
IN_COLS = DIL_QKV_COLS + HG_COLS + MEM_WIDTH + GATE_COLS
IN_SPLITS = (DIL_QKV_COLS, DIL_QKV_COLS + HG_COLS, DIL_QKV_COLS + HG_COLS + MEM_WIDTH)

PEER_HEADS = 8
PEER_N_KEYS = 128
PEER_N_EXPERTS = PEER_N_KEYS * PEER_N_KEYS
PEER_DHALF = 128
PEER_DKEY = 2 * PEER_DHALF
PEER_TOPK = 16
PEER_TOK_BLOCK = 128

kernel_name = 'hybrid_dilated_hgrn2_mem_peer_deepnorm'


def _layer_norm(t, g, b):
    t32 = t.astype(jnp.float32)
    mu = jnp.mean(t32, axis=-1, keepdims=True)
    var = jnp.mean(jnp.square(t32 - mu), axis=-1, keepdims=True)
    return ((t32 - mu) * lax.rsqrt(var + LN_EPS) * g.astype(jnp.float32) + b.astype(jnp.float32)).astype(t.dtype)


def _t5_bucket(dist):
    max_exact = REL_BUCKETS // 2
    n = np.maximum(dist, 0)
    large = max_exact + (np.log(np.maximum(n, 1) / max_exact) / math.log(REL_MAX_DIST / max_exact)
                         * (REL_BUCKETS - max_exact)).astype(np.int32)
    large = np.minimum(large, REL_BUCKETS - 1)
    return np.where(n < max_exact, n, large).astype(np.int32)


def _dilated_group(q, k, v, bias_table, window, dilation):
    b, s, h, hd = q.shape
    span = dilation * DIL_BLOCK
    sp = -(-s // span) * span
    sub = sp // dilation
    nb = sub // DIL_BLOCK

    def to_blocks(t):
        t = jnp.pad(t, ((0, 0), (0, sp - s), (0, 0), (0, 0)))
        t = t.reshape(b, sub, dilation, h, hd).transpose(0, 2, 1, 3, 4)
        return t.reshape(b, dilation, nb, DIL_BLOCK, h, hd)

    def with_prev(t):
        prev = jnp.pad(t[:, :, :-1], ((0, 0), (0, 0), (1, 0), (0, 0), (0, 0), (0, 0)))
        return jnp.concatenate([prev, t], axis=3)

    qb = to_blocks(q)
    kb = with_prev(to_blocks(k))
    vb = with_prev(to_blocks(v))
    qi = np.arange(DIL_BLOCK)[:, None]
    kj = np.arange(2 * DIL_BLOCK)[None, :]
    delta = qi + DIL_BLOCK - kj
    in_window = (delta >= 0) & (delta <= window // dilation)
    rel = jnp.transpose(bias_table[_t5_bucket(delta * dilation)], (2, 0, 1)).astype(jnp.float32)
    not_first = np.arange(nb)[:, None, None] > 0
    valid = in_window[None] & (not_first | (kj >= DIL_BLOCK)[None])
    logits = jnp.einsum('brnqhd,brnkhd->brnhqk', qb, kb).astype(jnp.float32) * (hd ** -0.5) + rel[None, None, None]
    logits = jnp.where(valid[None, None, :, None], logits, -jnp.inf)
    lse = jax.nn.logsumexp(logits, axis=-1)
    p = jnp.exp(logits - lse[..., None])
    o = jnp.einsum('brnhqk,brnkhd->brnqhd', p.astype(v.dtype), vb)
    o = o.reshape(b, dilation, sub, h, hd).transpose(0, 2, 1, 3, 4).reshape(b, sp, h, hd)[:, :s]
    lse = lse.transpose(0, 1, 2, 4, 3).reshape(b, dilation, sub, h).transpose(0, 2, 1, 3).reshape(b, sp, h)[:, :s]
    return o, lse


def _dilated_attention(dil, rel_bias):
    b, s, _ = dil.shape
    dil = dil.reshape(b, s, 3, N_DIL_GROUPS, DIL_HEADS, DIL_HEAD_DIM)
    outs, lses = [], []
    for g_idx, (window, dilation) in enumerate(DIL_GROUPS):
        o_g, lse_g = _dilated_group(dil[:, :, 0, g_idx], dil[:, :, 1, g_idx], dil[:, :, 2, g_idx],
                                    rel_bias[:, g_idx * DIL_HEADS:(g_idx + 1) * DIL_HEADS], window, dilation)
        outs.append(o_g)
        lses.append(lse_g)
    w_groups = jax.nn.softmax(jnp.stack(lses, axis=0), axis=0)
    o = jnp.einsum('gbsh,gbshd->bshd', w_groups, jnp.stack(outs, axis=0).astype(jnp.float32))
    return o.reshape(b, s, DIL_WIDTH).astype(dil.dtype)


def _hgrn2(f_raw, i_in, q_in, g_in, lb, norm_w):
    b, s, _ = f_raw.shape
    n = s // HG_CHUNK

    def heads(t):
        return t.astype(jnp.float32).reshape(b, n, HG_CHUNK, HG_HEADS, -1).transpose(0, 3, 1, 2, 4)

    lbh = lb.astype(jnp.float32).reshape(HG_HEADS, 1, 1, HG_DK)
    f = lbh + (1.0 - lbh) * jax.nn.sigmoid(heads(f_raw))
    log_f = jnp.log(f)
    key = 1.0 - f
    qh = heads(q_in)
    ih = heads(i_in)
    a = jnp.cumsum(log_f, axis=3)
    a_mid = a[:, :, :, HG_CHUNK // 2 - 1:HG_CHUNK // 2]
    a_last = a[:, :, :, -1:]
    causal = np.tril(np.ones((HG_CHUNK, HG_CHUNK), dtype=bool))
    sc = jnp.einsum('bhncd,bhnsd->bhncs', qh * jnp.exp(a - a_mid), key * jnp.exp(a_mid - a))
    o_intra = jnp.einsum('bhncs,bhnsv->bhncv', jnp.where(causal, sc, 0.0), ih)
    upd = jnp.einsum('bhncd,bhncv->bhndv', key * jnp.exp(a_last - a), ih)
    decay = jnp.exp(a_last[:, :, :, 0])

    def step(state, inp):
        dec, u = inp
        return dec[..., None] * state + u, state

    init = jnp.zeros((b, HG_HEADS, HG_DK, HG_DV), jnp.float32)
    _, before = lax.scan(step, init, (jnp.moveaxis(decay, 2, 0), jnp.moveaxis(upd, 2, 0)))
    before = jnp.moveaxis(before, 0, 2)
    o_inter = jnp.einsum('bhncd,bhndv->bhncv', qh * jnp.exp(a), before)
    o = o_intra + o_inter
    o = o * lax.rsqrt(jnp.mean(o * o, axis=-1, keepdims=True) + LN_EPS)
    o = o.transpose(0, 2, 3, 1, 4).reshape(b, s, HG_WIDTH)
    o = o * norm_w.astype(jnp.float32) * jax.nn.silu(g_in.astype(jnp.float32))
    return o.astype(f_raw.dtype)


def _memory_attention(q_in, mem, w_mem_kv):
    b, s, _ = q_in.shape
    m = mem.shape[1]
    k, v = jnp.split(jnp.einsum('bmd,de->bme', mem, w_mem_kv), 2, axis=-1)
    q = q_in.reshape(b, s, MEM_HEADS, MEM_HEAD_DIM)
    k = k.reshape(b, m, MEM_HEADS, MEM_HEAD_DIM)
    v = v.reshape(b, m, MEM_HEADS, MEM_HEAD_DIM)
    logits = jnp.einsum('bshd,bmhd->bhsm', q, k).astype(jnp.float32) * (MEM_HEAD_DIM ** -0.5)
    p = jax.nn.softmax(logits, axis=-1)
    return jnp.einsum('bhsm,bmhd->bshd', p.astype(v.dtype), v).reshape(b, s, MEM_WIDTH)


def _peer(h, w_q, sub_keys, u_tab, v_tab):
    b, s, d = h.shape
    q = jnp.einsum('bsd,dk->bsk', h, w_q).reshape(b, s, PEER_HEADS, 2, PEER_DHALF)
    sc = jnp.einsum('bshpk,hpnk->bshpn', q, sub_keys).astype(jnp.float32)
    s1, i1 = lax.top_k(sc[..., 0, :], PEER_TOPK)
    s2, i2 = lax.top_k(sc[..., 1, :], PEER_TOPK)
    cand = (s1[..., :, None] + s2[..., None, :]).reshape(b, s, PEER_HEADS, PEER_TOPK * PEER_TOPK)
    cidx = (i1[..., :, None] * PEER_N_KEYS + i2[..., None, :]).reshape(b, s, PEER_HEADS, PEER_TOPK * PEER_TOPK)
    top, pos = lax.top_k(cand, PEER_TOPK)
    idx = jnp.take_along_axis(cidx, pos, axis=-1)
    gate = jax.nn.softmax(top, axis=-1)
    n_blk = (b * s) // PEER_TOK_BLOCK
    xb = h.reshape(n_blk, PEER_TOK_BLOCK, d)
    ib = idx.reshape(n_blk, PEER_TOK_BLOCK, PEER_HEADS * PEER_TOPK)
    gb = gate.reshape(n_blk, PEER_TOK_BLOCK, PEER_HEADS * PEER_TOPK).astype(h.dtype)

    def block(args):
        xt, it, gt = args
        act = jax.nn.gelu(jnp.einsum('td,ted->te', xt, u_tab[it]), approximate=False)
        return jnp.einsum('te,ted->td', gt * act, v_tab[it])

    return lax.map(block, (xb, ib, gb)).reshape(b, s, d)


def setup_inputs(seed: int = 0) -> dict:
    key = jax.random.key(seed)
    ks = jax.random.split(key, 18)
    f32 = jnp.float32

    def nrm(k, shape, scale):
        return jax.random.normal(k, shape, f32) * scale

    col_scale = np.ones((IN_COLS,), np.float32)
    col_scale[2 * DIL_GROUP_COLS:3 * DIL_GROUP_COLS] = DN_BETA
    col_scale[HG_I_OFF:HG_I_OFF + HG_WIDTH] = DN_BETA
    mem_scale = np.concatenate([np.ones((MEM_WIDTH,)), np.full((MEM_WIDTH,), DN_BETA)]).astype(np.float32)
    d_inv = D_MODEL ** -0.5
    return {
        'x': nrm(ks[0], (BATCH, SEQ, D_MODEL), 1.0),
        'mem': nrm(ks[1], (BATCH, MEM_LEN, D_MODEL), 1.0),
        'w_in': nrm(ks[2], (DEPTH, D_MODEL, IN_COLS), d_inv) * jnp.asarray(col_scale),
        'b_gate': nrm(ks[3], (DEPTH, GATE_COLS), 0.1),
        'w_mem_kv': nrm(ks[4], (DEPTH, D_MODEL, 2 * MEM_WIDTH), d_inv) * jnp.asarray(mem_scale),
        'rel_bias': nrm(ks[5], (REL_BUCKETS, N_DIL_GROUPS * DIL_HEADS), 0.3),
        'hgrn_lb': nrm(ks[6], (DEPTH + 1, HG_HEADS * HG_DK), 0.1),
        'hgrn_norm_w': 1.0 + nrm(ks[7], (DEPTH, HG_WIDTH), 0.05),
        'w_branch': nrm(ks[8], (DEPTH, N_BRANCHES, DIL_WIDTH, D_MODEL), DIL_WIDTH ** -0.5 * DN_BETA),
        'w_out': nrm(ks[9], (DEPTH, D_MODEL, D_MODEL), d_inv * DN_BETA),
        'ln1_g': 1.0 + nrm(ks[10], (DEPTH, D_MODEL), 0.05),
        'ln1_b': nrm(ks[11], (DEPTH, D_MODEL), 0.02),
        'w_peer_q': nrm(ks[12], (DEPTH, D_MODEL, PEER_HEADS * PEER_DKEY), d_inv),
        'peer_sub_keys': nrm(ks[13], (DEPTH, PEER_HEADS, 2, PEER_N_KEYS, PEER_DHALF), PEER_DHALF ** -0.5),
        'peer_u': nrm(ks[14], (DEPTH, PEER_N_EXPERTS, D_MODEL), d_inv),
        'peer_v': nrm(ks[15], (DEPTH, PEER_N_EXPERTS, D_MODEL), DN_BETA),
        'ln2_g': 1.0 + nrm(ks[16], (DEPTH, D_MODEL), 0.05),
        'ln2_b': nrm(ks[17], (DEPTH, D_MODEL), 0.02),
    }


def reference(x, mem, w_in, b_gate, w_mem_kv, rel_bias, hgrn_lb, hgrn_norm_w, w_branch, w_out,
              ln1_g, ln1_b, w_peer_q, peer_sub_keys, peer_u, peer_v, ln2_g, ln2_b):
    lb_layers = jnp.cumsum(jax.nn.softmax(hgrn_lb.astype(jnp.float32), axis=0), axis=0)
    h = x
    for layer in range(DEPTH):
        b, s, _ = h.shape
        proj = jnp.einsum('bsd,de->bse', h, w_in[layer])
        dil, hg, mem_q, gate_logits = jnp.split(proj, IN_SPLITS, axis=-1)
        a_out = _dilated_attention(dil, rel_bias)
        f_raw, i_in, q_in, g_in = jnp.split(hg, 4, axis=-1)
        b_out = _hgrn2(f_raw, i_in, q_in, g_in, lb_layers[layer], hgrn_norm_w[layer])
        c_out = _memory_attention(mem_q, mem, w_mem_kv[layer])
        branches = jnp.stack([a_out, b_out, c_out], axis=2)
        gates = jax.nn.sigmoid((gate_logits + b_gate[layer]).reshape(b, s, N_BRANCHES, D_MODEL))
        widened = jnp.einsum('bsgw,gwd->bsgd', branches, w_branch[layer])
        merged = jnp.sum(gates * widened, axis=2)
        mix = jnp.einsum('bsd,de->bse', merged, w_out[layer])
        h = _layer_norm(DN_ALPHA * h + mix, ln1_g[layer], ln1_b[layer])
        ffn = _peer(h, w_peer_q[layer], peer_sub_keys[layer], peer_u[layer], peer_v[layer])
        h = _layer_norm(DN_ALPHA * h + ffn, ln2_g[layer], ln2_b[layer])
    return h
```

```cpp
#include <hip/hip_runtime.h>
#include <stdint.h>
#include <math.h>

typedef unsigned short bf16_t;
typedef short bf16x8 __attribute__((ext_vector_type(8)));
typedef float f32x4 __attribute__((ext_vector_type(4)));
#define DI __device__ __forceinline__

DI float bf2f(bf16_t v) { return __uint_as_float(((unsigned)v) << 16); }
DI bf16_t f2bf(float f) { unsigned u = __float_as_uint(f); u += 0x7fffu + ((u >> 16) & 1u); return (bf16_t)(u >> 16); }

constexpr int NB = 8, S = 8192, D = 1024, M = NB * S;
constexpr int NPASS = 4, BPP = NB / NPASS, MP = BPP * S;
constexpr int INC = 10240;
constexpr int NEXP = 16384;
constexpr float ALPHA = 1.189207115002721f;
constexpr float LN_EPS = 1e-5f;
constexpr float QSCALE = 0.08838834764831845f;

constexpr size_t al(size_t x) { return (x + 255) & ~(size_t)255; }
constexpr size_t O_WIN = 0;
constexpr size_t O_WMKV = O_WIN + al((size_t)INC * D * 2);
constexpr size_t O_WBR = O_WMKV + al((size_t)1024 * 1024 * 2);
constexpr size_t O_WOUT = O_WBR + al((size_t)1024 * 1536 * 2);
constexpr size_t O_WPQ = O_WOUT + al((size_t)1024 * 1024 * 2);
constexpr size_t O_SUBK = O_WPQ + al((size_t)2048 * 1024 * 2);
constexpr size_t O_UB = O_SUBK + al((size_t)16 * 128 * 128 * 2);
constexpr size_t O_VB = O_UB + al((size_t)NEXP * D * 2);
constexpr size_t O_XB = O_VB + al((size_t)NEXP * D * 2);
constexpr size_t O_MEMB = O_XB + al((size_t)M * D * 2);
constexpr size_t O_MK = O_MEMB + al((size_t)2048 * 1024 * 2);
constexpr size_t O_MVT = O_MK + al((size_t)2048 * 512 * 2);
constexpr size_t O_H1B = O_MVT + al((size_t)8 * 512 * 256 * 2);
constexpr size_t O_MISC = O_H1B + al((size_t)M * D * 2);
constexpr size_t O_PASS = O_MISC + al(65536);
constexpr size_t P_QK = 0;
constexpr size_t P_VT = P_QK + al((size_t)MP * 3072 * 2);
constexpr size_t P_HFQG = P_VT + al((size_t)1536 * MP * 2);
constexpr size_t P_IT = P_HFQG + al((size_t)MP * 1536 * 2);
constexpr size_t P_MQ = P_IT + al((size_t)512 * MP * 2);
constexpr size_t P_GATE = P_MQ + al((size_t)MP * 512 * 2);
constexpr size_t P_OG = P_GATE + al((size_t)MP * 3072 * 2);
constexpr size_t P_LSE = P_OG + al((size_t)MP * 1536 * 2);
constexpr size_t P_BR = P_LSE + al((size_t)MP * 12 * 4);
constexpr size_t P_MERGED = P_BR + al((size_t)MP * 1536 * 2);
constexpr size_t P_MIX = P_MERGED + al((size_t)MP * 1024 * 2);
constexpr size_t P_END = P_MIX + al((size_t)MP * 1024 * 4);
constexpr size_t P_PQ = 0;
constexpr size_t P_IDX = P_PQ + al((size_t)M * 2048 * 2);
constexpr size_t P_PG = P_IDX + al((size_t)M * 128 * 4);
constexpr size_t P_END2 = P_PG + al((size_t)M * 128 * 4);
constexpr size_t WS_NEED = O_PASS + (P_END > P_END2 ? P_END : P_END2);
static_assert(WS_NEED <= (size_t)1073741824, "workspace budget");

__global__ __launch_bounds__(256) void k_convert(const float* __restrict__ in, bf16_t* __restrict__ out, size_t n4) {
    size_t i = (size_t)blockIdx.x * 256 + threadIdx.x; const size_t st = (size_t)gridDim.x * 256;
    for (; i < n4; i += st) { const f32x4 v = ((const f32x4*)in)[i]; ushort4 o; o.x = f2bf(v[0]); o.y = f2bf(v[1]); o.z = f2bf(v[2]); o.w = f2bf(v[3]); ((ushort4*)out)[i] = o; }
}
__global__ __launch_bounds__(256) void k_transpose(const float* __restrict__ W, int K, int N, bf16_t* __restrict__ out, int ldo, int koff) {
    __shared__ float t[32][33];
    const int k0 = blockIdx.y * 32, n0 = blockIdx.x * 32, tx = threadIdx.x & 31, ty = threadIdx.x >> 5;
    for (int i = ty; i < 32; i += 8) t[i][tx] = W[(size_t)(k0 + i) * N + n0 + tx];
    __syncthreads();
    for (int i = ty; i < 32; i += 8) out[(size_t)(n0 + i) * ldo + koff + k0 + tx] = f2bf(t[tx][i]);
}
__global__ void k_misc(const float* __restrict__ hgrn_lb, const float* __restrict__ rel_bias, float* __restrict__ misc) {
    const int i = blockIdx.x * blockDim.x + threadIdx.x;
    if (i < 512) { const float a = hgrn_lb[i], b = hgrn_lb[512 + i]; const float mx = fmaxf(a, b); const float ea = expf(a - mx), eb = expf(b - mx); misc[i] = ea / (ea + eb); }
    if (i < 3 * 129) {
        const int g = i / 129, j = i % 129; const int dl = g == 0 ? 1 : (g == 1 ? 4 : 16); const int n = j * dl;
        int bucket;
        if (n < 16) bucket = n;
        else { const double v = log((double)n / 16.0) / log(128.0) * 16.0; int l = 16 + (int)v; bucket = l < 31 ? l : 31; }
        for (int h = 0; h < 4; ++h) misc[512 + i * 4 + h] = rel_bias[bucket * 12 + g * 4 + h];
    }
}

template <class Epi>
__global__ __launch_bounds__(256) void gemm_simple(const bf16_t* __restrict__ A, int lda, const bf16_t* __restrict__ Bt, int ldb, int K, Epi epi) {
    const int lane = threadIdx.x & 63, w = threadIdx.x >> 6;
    const int row0 = blockIdx.y * 64 + (w >> 1) * 32, col0 = blockIdx.x * 64 + (w & 1) * 32;
    const int fr = lane & 15, fq = lane >> 4;
    f32x4 acc[2][2];
#pragma unroll
    for (int a = 0; a < 2; ++a)
#pragma unroll
        for (int b = 0; b < 2; ++b) acc[a][b] = (f32x4){0.f, 0.f, 0.f, 0.f};
    const bf16_t* ap = A + (size_t)(row0 + fr) * lda + fq * 8;
    const bf16_t* bp = Bt + (size_t)(col0 + fr) * ldb + fq * 8;
    for (int k0 = 0; k0 < K; k0 += 32) {
        const bf16x8 a0 = *(const bf16x8*)(ap + k0), a1 = *(const bf16x8*)(ap + (size_t)16 * lda + k0);
        const bf16x8 b0 = *(const bf16x8*)(bp + k0), b1 = *(const bf16x8*)(bp + (size_t)16 * ldb + k0);
        acc[0][0] = __builtin_amdgcn_mfma_f32_16x16x32_bf16(a0, b0, acc[0][0], 0, 0, 0);
        acc[0][1] = __builtin_amdgcn_mfma_f32_16x16x32_bf16(a0, b1, acc[0][1], 0, 0, 0);
        acc[1][0] = __builtin_amdgcn_mfma_f32_16x16x32_bf16(a1, b0, acc[1][0], 0, 0, 0);
        acc[1][1] = __builtin_amdgcn_mfma_f32_16x16x32_bf16(a1, b1, acc[1][1], 0, 0, 0);
    }
#pragma unroll
    for (int mi = 0; mi < 2; ++mi)
#pragma unroll
        for (int ni = 0; ni < 2; ++ni)
#pragma unroll
            for (int j = 0; j < 4; ++j) epi(row0 + mi * 16 + fq * 4 + j, col0 + ni * 16 + fr, acc[mi][ni][j]);
}

DI int dil_of(int g) { return g == 0 ? 1 : (g == 1 ? 4 : 16); }
DI int perm_tok(int lb, int s, int dl) { return lb * S + (s % dl) * (S / dl) + s / dl; }

struct EpiProj {
    bf16_t *QK, *VT, *HFQG, *IT, *MQ, *GATE; const float* b_gate;
    DI void operator()(int row, int col, float v) const {
        if (col < 3072) QK[(size_t)row * 3072 + col] = f2bf(v);
        else if (col < 4608) { const int c = col - 3072, g = c >> 9; VT[(size_t)c * MP + perm_tok(row / S, row % S, dil_of(g))] = f2bf(v); }
        else if (col < 5120) HFQG[(size_t)row * 1536 + (col - 4608)] = f2bf(v);
        else if (col < 5632) IT[(size_t)(col - 5120) * MP + row] = f2bf(v);
        else if (col < 6656) HFQG[(size_t)row * 1536 + (col - 5632) + 512] = f2bf(v);
        else if (col < 7168) MQ[(size_t)row * 512 + (col - 6656)] = f2bf(v);
        else { const int c = col - 7168; const float z = v + b_gate[c]; GATE[(size_t)row * 3072 + c] = f2bf(1.f / (1.f + expf(-z))); }
    }
};
struct EpiMemKV {
    bf16_t *MK, *MVT;
    DI void operator()(int row, int col, float v) const {
        if (col < 512) MK[(size_t)row * 512 + col] = f2bf(v);
        else MVT[((size_t)(row >> 8) * 512 + (col - 512)) * 256 + (row & 255)] = f2bf(v);
    }
};
struct EpiWiden {
    const bf16_t* GATE; float* TMP; bf16_t* MERGED; int g;
    DI void operator()(int row, int col, float v) const {
        const float gv = bf2f(GATE[(size_t)row * 3072 + g * 1024 + col]) * v; const size_t o = (size_t)row * 1024 + col;
        if (g == 0) TMP[o] = gv; else if (g == 1) TMP[o] += gv; else MERGED[o] = f2bf(TMP[o] + gv);
    }
};
struct EpiF32 { float* C; int ldc; DI void operator()(int row, int col, float v) const { C[(size_t)row * ldc + col] = v; } };
struct EpiB16 { bf16_t* C; int ldc; DI void operator()(int row, int col, float v) const { C[(size_t)row * ldc + col] = f2bf(v); } };

DI float wave_max(float v) {
#pragma unroll
    for (int o = 1; o < 64; o <<= 1) v = fmaxf(v, __shfl_xor(v, o));
    return v;
}
DI float wave_sum(float v) {
#pragma unroll
    for (int o = 1; o < 64; o <<= 1) v += __shfl_xor(v, o);
    return v;
}

__global__ __launch_bounds__(256) void k_dil_attn(const bf16_t* __restrict__ QK, const bf16_t* __restrict__ VT, const float* __restrict__ BIAS, bf16_t* __restrict__ OG, float* __restrict__ LSE) {
    __shared__ float ps[4][192];
    const int lane = threadIdx.x & 63, w = threadIdx.x >> 6;
    const long task = (long)blockIdx.x * 4 + w;
    const int gh = (int)(task % 12); const int row = (int)(task / 12);
    const int g = gh >> 2, h = gh & 3, dl = dil_of(g);
    const int lb = row / S, s = row % S, m = s / dl, r = s % dl;
    const bf16_t* qp = QK + (size_t)row * 3072 + gh * 128;
    float lg[3]; float mx = -INFINITY;
#pragma unroll
    for (int i = 0; i < 3; ++i) {
        const int j = lane + 64 * i; float l = -INFINITY;
        if (j <= 128 && m - j >= 0) {
            const int krow = lb * S + (m - j) * dl + r; const bf16_t* kp = QK + (size_t)krow * 3072 + 1536 + gh * 128;
            float dot = 0.f;
            for (int d = 0; d < 128; ++d) dot += bf2f(qp[d]) * bf2f(kp[d]);
            l = dot * QSCALE + BIAS[(g * 129 + j) * 4 + h];
        }
        lg[i] = l; mx = fmaxf(mx, l);
    }
    mx = wave_max(mx);
    float sum = 0.f;
#pragma unroll
    for (int i = 0; i < 3; ++i) { const float p = (lg[i] == -INFINITY) ? 0.f : expf(lg[i] - mx); ps[w][lane + 64 * i] = p; sum += p; }
    sum = wave_sum(sum);
    __syncthreads();
    const int nk = m < 128 ? m : 128;
    const float inv = 1.f / sum;
#pragma unroll
    for (int i = 0; i < 2; ++i) {
        const int d = lane + 64 * i; const bf16_t* vp = VT + (size_t)(g * 512 + h * 128 + d) * MP + lb * S + r * (S / dl);
        float o = 0.f;
        for (int j = 0; j <= nk; ++j) o += ps[w][j] * bf2f(vp[m - j]);
        OG[(size_t)row * 1536 + g * 512 + h * 128 + d] = f2bf(o * inv);
    }
    if (lane == 0) LSE[(size_t)row * 12 + gh] = mx + logf(sum);
}
__global__ __launch_bounds__(256) void k_merge(const bf16_t* __restrict__ OG, const float* __restrict__ LSE, bf16_t* __restrict__ BR) {
    const long i = (long)blockIdx.x * 256 + threadIdx.x;
    const int row = (int)(i >> 9), c = (int)(i & 511), h = c >> 7;
    const float l0 = LSE[(size_t)row * 12 + h], l1 = LSE[(size_t)row * 12 + 4 + h], l2 = LSE[(size_t)row * 12 + 8 + h];
    const float mx = fmaxf(l0, fmaxf(l1, l2)); const float e0 = expf(l0 - mx), e1 = expf(l1 - mx), e2 = expf(l2 - mx); const float inv = 1.f / (e0 + e1 + e2);
    const bf16_t* og = OG + (size_t)row * 1536 + c;
    BR[(size_t)row * 1536 + c] = f2bf((e0 * bf2f(og[0]) + e1 * bf2f(og[512]) + e2 * bf2f(og[1024])) * inv);
}
__global__ __launch_bounds__(256) void k_mem_attn(const bf16_t* __restrict__ MQ, const bf16_t* __restrict__ MK, const bf16_t* __restrict__ MVT, bf16_t* __restrict__ BR, int batch0) {
    __shared__ float ps[4][256];
    const int lane = threadIdx.x & 63, w = threadIdx.x >> 6;
    const long task = (long)blockIdx.x * 4 + w;
    const int h = (int)(task & 3); const int row = (int)(task >> 2);
    const int b = batch0 + row / S;
    const bf16_t* qp = MQ + (size_t)row * 512 + h * 128;
    float lg[4]; float mx = -INFINITY;
#pragma unroll
    for (int i = 0; i < 4; ++i) {
        const int j = lane + 64 * i; const bf16_t* kp = MK + (size_t)(b * 256 + j) * 512 + h * 128;
        float dot = 0.f;
        for (int d = 0; d < 128; ++d) dot += bf2f(qp[d]) * bf2f(kp[d]);
        lg[i] = dot * QSCALE; mx = fmaxf(mx, lg[i]);
    }
    mx = wave_max(mx);
    float sum = 0.f;
#pragma unroll
    for (int i = 0; i < 4; ++i) { const float p = expf(lg[i] - mx); ps[w][lane + 64 * i] = p; sum += p; }
    sum = wave_sum(sum);
    __syncthreads();
    const float inv = 1.f / sum;
#pragma unroll
    for (int i = 0; i < 2; ++i) {
        const int d = lane + 64 * i; const bf16_t* vp = MVT + ((size_t)b * 512 + h * 128 + d) * 256;
        float o = 0.f;
        for (int j = 0; j < 256; ++j) o += ps[w][j] * bf2f(vp[j]);
        BR[(size_t)row * 1536 + 1024 + h * 128 + d] = f2bf(o * inv);
    }
}
__global__ __launch_bounds__(128) void k_hgrn(const bf16_t* __restrict__ HFQG, const bf16_t* __restrict__ IT, const float* __restrict__ lbv, const float* __restrict__ norm_w, bf16_t* __restrict__ BR) {
    __shared__ float sf[128], sk[128], sq[128], red[2];
    const int tid = threadIdx.x, h = blockIdx.x & 3, lb = blockIdx.x >> 2;
    const float lbd = lbv[h * 128 + tid], nw = norm_w[h * 128 + tid];
    float St[128];
#pragma unroll
    for (int i = 0; i < 128; ++i) St[i] = 0.f;
    for (int s = 0; s < S; ++s) {
        const size_t row = (size_t)lb * S + s;
        const float fr = bf2f(HFQG[row * 1536 + h * 128 + tid]);
        const float f = lbd + (1.f - lbd) / (1.f + expf(-fr));
        sf[tid] = f; sk[tid] = 1.f - f; sq[tid] = bf2f(HFQG[row * 1536 + 512 + h * 128 + tid]);
        __syncthreads();
        const float iv = bf2f(IT[(size_t)(h * 128 + tid) * MP + row]);
        float o = 0.f;
#pragma unroll
        for (int d = 0; d < 128; ++d) { St[d] = sf[d] * St[d] + sk[d] * iv; o += sq[d] * St[d]; }
        const float ss = wave_sum(o * o);
        if ((tid & 63) == 0) red[tid >> 6] = ss;
        __syncthreads();
        const float ms = (red[0] + red[1]) * (1.f / 128.f);
        const float gv = bf2f(HFQG[row * 1536 + 1024 + h * 128 + tid]);
        BR[row * 1536 + 512 + h * 128 + tid] = f2bf(o * rsqrtf(ms + LN_EPS) * nw * (gv / (1.f + expf(-gv))));
    }
}
__global__ __launch_bounds__(256) void k_ln1(const float* __restrict__ x, const float* __restrict__ mix, const float* __restrict__ g, const float* __restrict__ b, float* __restrict__ h1f, bf16_t* __restrict__ h1b) {
    __shared__ float red[8];
    const size_t row = blockIdx.x; const int tid = threadIdx.x;
    float v[4]; float s = 0.f;
#pragma unroll
    for (int i = 0; i < 4; ++i) { const int c = tid + 256 * i; v[i] = ALPHA * x[row * D + c] + mix[row * D + c]; s += v[i]; }
    s = wave_sum(s); if ((tid & 63) == 0) red[tid >> 6] = s; __syncthreads();
    const float mean = (red[0] + red[1] + red[2] + red[3]) * (1.f / D);
    float q = 0.f;
#pragma unroll
    for (int i = 0; i < 4; ++i) { v[i] -= mean; q += v[i] * v[i]; }
    q = wave_sum(q); if ((tid & 63) == 0) red[4 + (tid >> 6)] = q; __syncthreads();
    const float rstd = rsqrtf((red[4] + red[5] + red[6] + red[7]) * (1.f / D) + LN_EPS);
#pragma unroll
    for (int i = 0; i < 4; ++i) { const int c = tid + 256 * i; const float o = v[i] * rstd * g[c] + b[c]; h1f[row * D + c] = o; h1b[row * D + c] = f2bf(o); }
}

DI void ins16(float (&tv)[16], int (&ti)[16], float v, int i) {
#pragma unroll
    for (int j = 0; j < 16; ++j) { const bool gt = v > tv[j]; const float ov = tv[j]; const int oi = ti[j]; tv[j] = gt ? v : ov; ti[j] = gt ? i : oi; v = gt ? ov : v; i = gt ? oi : i; }
}
__global__ __launch_bounds__(256) void k_route(const bf16_t* __restrict__ PQ, const bf16_t* __restrict__ SUBK, int* __restrict__ IDX, float* __restrict__ PG) {
    const long gi = (long)blockIdx.x * 256 + threadIdx.x;
    const int h = (int)(gi & 7); const size_t t = (size_t)(gi >> 3);
    float s1[16], s2[16]; int i1[16], i2[16];
#pragma unroll
    for (int j = 0; j < 16; ++j) { s1[j] = -INFINITY; s2[j] = -INFINITY; i1[j] = 0; i2[j] = 0; }
    const bf16_t* q0 = PQ + t * 2048 + h * 256;
    for (int n = 0; n < 128; ++n) {
        const bf16_t* k0 = SUBK + (size_t)((h * 2 + 0) * 128 + n) * 128; const bf16_t* k1 = SUBK + (size_t)((h * 2 + 1) * 128 + n) * 128;
        float a = 0.f, b = 0.f;
        for (int k = 0; k < 128; ++k) { a += bf2f(q0[k]) * bf2f(k0[k]); b += bf2f(q0[128 + k]) * bf2f(k1[k]); }
        ins16(s1, i1, a, n); ins16(s2, i2, b, n);
    }
    float cv[16]; int ci[16];
#pragma unroll
    for (int j = 0; j < 16; ++j) { cv[j] = -INFINITY; ci[j] = 0; }
#pragma unroll
    for (int a = 0; a < 16; ++a)
#pragma unroll
        for (int b = 0; b < 16; ++b) ins16(cv, ci, s1[a] + s2[b], i1[a] * 128 + i2[b]);
    float sum = 0.f; float e[16];
#pragma unroll
    for (int j = 0; j < 16; ++j) { e[j] = expf(cv[j] - cv[0]); sum += e[j]; }
    const float inv = 1.f / sum;
#pragma unroll
    for (int j = 0; j < 16; ++j) { IDX[t * 128 + h * 16 + j] = ci[j]; PG[t * 128 + h * 16 + j] = e[j] * inv; }
}
__global__ __launch_bounds__(256) void k_experts(const float* h1f_in, const bf16_t* __restrict__ h1b, const bf16_t* __restrict__ UB, const bf16_t* __restrict__ VB, const int* __restrict__ IDX, const float* __restrict__ PG,
                                                 const float* __restrict__ g2, const float* __restrict__ b2, float* out) {
    __shared__ float hrow[1024]; __shared__ float cw[128]; __shared__ int eid[128]; __shared__ float red[8];
    const size_t t = blockIdx.x; const int tid = threadIdx.x, lane = tid & 63, w = tid >> 6;
    float hv[4];
#pragma unroll
    for (int i = 0; i < 4; ++i) { const int c = tid + 256 * i; hv[i] = h1f_in[t * D + c]; hrow[c] = bf2f(h1b[t * D + c]); }
    if (tid < 128) eid[tid] = IDX[t * 128 + tid];
    __syncthreads();
    for (int e = w; e < 128; e += 4) {
        const bf16_t* up = UB + (size_t)eid[e] * D; float dot = 0.f;
#pragma unroll
        for (int i = 0; i < 16; ++i) dot += hrow[lane + 64 * i] * bf2f(up[lane + 64 * i]);
        dot = wave_sum(dot);
        if (lane == 0) cw[e] = PG[t * 128 + e] * 0.5f * dot * (1.f + erff(dot * 0.7071067811865476f));
    }
    __syncthreads();
    float f[4] = {0.f, 0.f, 0.f, 0.f};
    for (int e = 0; e < 128; ++e) { const bf16_t* vp = VB + (size_t)eid[e] * D; const float c = cw[e];
#pragma unroll
        for (int i = 0; i < 4; ++i) f[i] += c * bf2f(vp[tid + 256 * i]); }
    float v[4]; float s = 0.f;
#pragma unroll
    for (int i = 0; i < 4; ++i) { v[i] = ALPHA * hv[i] + f[i]; s += v[i]; }
    s = wave_sum(s); if (lane == 0) red[w] = s; __syncthreads();
    const float mean = (red[0] + red[1] + red[2] + red[3]) * (1.f / D);
    float q = 0.f;
#pragma unroll
    for (int i = 0; i < 4; ++i) { v[i] -= mean; q += v[i] * v[i]; }
    q = wave_sum(q); if (lane == 0) red[4 + w] = q; __syncthreads();
    const float rstd = rsqrtf((red[4] + red[5] + red[6] + red[7]) * (1.f / D) + LN_EPS);
#pragma unroll
    for (int i = 0; i < 4; ++i) { const int c = tid + 256 * i; out[t * D + c] = v[i] * rstd * g2[c] + b2[c]; }
}

extern "C" void kernel_launch(void* const* d_in, const int* in_sizes, int n_in, void* d_out, int out_size, void* d_ws, size_t ws_size, hipStream_t stream) {
    if (ws_size < WS_NEED) return;
    const float* x = (const float*)d_in[0]; const float* mem = (const float*)d_in[1]; const float* w_in = (const float*)d_in[2]; const float* b_gate = (const float*)d_in[3];
    const float* w_mkv = (const float*)d_in[4]; const float* rel_bias = (const float*)d_in[5]; const float* hgrn_lb = (const float*)d_in[6]; const float* hgrn_nw = (const float*)d_in[7];
    const float* w_branch = (const float*)d_in[8]; const float* w_out = (const float*)d_in[9]; const float* ln1_g = (const float*)d_in[10]; const float* ln1_b = (const float*)d_in[11];
    const float* w_pq = (const float*)d_in[12]; const float* subk = (const float*)d_in[13]; const float* pu = (const float*)d_in[14]; const float* pv = (const float*)d_in[15];
    const float* ln2_g = (const float*)d_in[16]; const float* ln2_b = (const float*)d_in[17];
    char* ws = (char*)d_ws; float* out = (float*)d_out;
    bf16_t* WIN = (bf16_t*)(ws + O_WIN); bf16_t* WMKV = (bf16_t*)(ws + O_WMKV); bf16_t* WBR = (bf16_t*)(ws + O_WBR); bf16_t* WOUT = (bf16_t*)(ws + O_WOUT); bf16_t* WPQ = (bf16_t*)(ws + O_WPQ);
    bf16_t* SUBK = (bf16_t*)(ws + O_SUBK); bf16_t* UB = (bf16_t*)(ws + O_UB); bf16_t* VB = (bf16_t*)(ws + O_VB); bf16_t* XB = (bf16_t*)(ws + O_XB); bf16_t* MEMB = (bf16_t*)(ws + O_MEMB);
    bf16_t* MK = (bf16_t*)(ws + O_MK); bf16_t* MVT = (bf16_t*)(ws + O_MVT); bf16_t* H1B = (bf16_t*)(ws + O_H1B); float* MISC = (float*)(ws + O_MISC);
    char* pr = ws + O_PASS;
    bf16_t* QK = (bf16_t*)(pr + P_QK); bf16_t* VT = (bf16_t*)(pr + P_VT); bf16_t* HFQG = (bf16_t*)(pr + P_HFQG); bf16_t* IT = (bf16_t*)(pr + P_IT); bf16_t* MQ = (bf16_t*)(pr + P_MQ);
    bf16_t* GATE = (bf16_t*)(pr + P_GATE); bf16_t* OG = (bf16_t*)(pr + P_OG); float* LSE = (float*)(pr + P_LSE); bf16_t* BR = (bf16_t*)(pr + P_BR); bf16_t* MERGED = (bf16_t*)(pr + P_MERGED);
    float* MIX = (float*)(pr + P_MIX); bf16_t* PQ = (bf16_t*)(pr + P_PQ); int* IDX = (int*)(pr + P_IDX); float* PG = (float*)(pr + P_PG);

    k_convert<<<2048, 256, 0, stream>>>(x, XB, (size_t)M * D / 4);
    k_convert<<<512, 256, 0, stream>>>(mem, MEMB, (size_t)2048 * 1024 / 4);
    k_convert<<<256, 256, 0, stream>>>(subk, SUBK, (size_t)16 * 128 * 128 / 4);
    k_convert<<<2048, 256, 0, stream>>>(pu, UB, (size_t)NEXP * D / 4);
    k_convert<<<2048, 256, 0, stream>>>(pv, VB, (size_t)NEXP * D / 4);
    k_transpose<<<dim3(INC / 32, 1024 / 32), 256, 0, stream>>>(w_in, 1024, INC, WIN, 1024, 0);
    k_transpose<<<dim3(1024 / 32, 1024 / 32), 256, 0, stream>>>(w_mkv, 1024, 1024, WMKV, 1024, 0);
    for (int g = 0; g < 3; ++g) k_transpose<<<dim3(1024 / 32, 512 / 32), 256, 0, stream>>>(w_branch + (size_t)g * 512 * 1024, 512, 1024, WBR, 1536, g * 512);
    k_transpose<<<dim3(1024 / 32, 1024 / 32), 256, 0, stream>>>(w_out, 1024, 1024, WOUT, 1024, 0);
    k_transpose<<<dim3(2048 / 32, 1024 / 32), 256, 0, stream>>>(w_pq, 1024, 2048, WPQ, 1024, 0);
    k_misc<<<2, 256, 0, stream>>>(hgrn_lb, rel_bias, MISC);
    gemm_simple<EpiMemKV><<<dim3(1024 / 64, 2048 / 64), 256, 0, stream>>>(MEMB, 1024, WMKV, 1024, 1024, EpiMemKV{MK, MVT});

    for (int p = 0; p < NPASS; ++p) {
        const size_t t0 = (size_t)p * MP;
        gemm_simple<EpiProj><<<dim3(INC / 64, MP / 64), 256, 0, stream>>>(XB + t0 * D, D, WIN, D, D, EpiProj{QK, VT, HFQG, IT, MQ, GATE, b_gate});
        k_dil_attn<<<MP * 12 / 4, 256, 0, stream>>>(QK, VT, MISC + 512, OG, LSE);
        k_merge<<<MP * 512 / 256, 256, 0, stream>>>(OG, LSE, BR);
        k_mem_attn<<<MP * 4 / 4, 256, 0, stream>>>(MQ, MK, MVT, BR, p * BPP);
        k_hgrn<<<BPP * 4, 128, 0, stream>>>(HFQG, IT, MISC, hgrn_nw, BR);
        for (int g = 0; g < 3; ++g)
            gemm_simple<EpiWiden><<<dim3(1024 / 64, MP / 64), 256, 0, stream>>>(BR + g * 512, 1536, WBR + g * 512, 1536, 512, EpiWiden{GATE, MIX, MERGED, g});
        gemm_simple<EpiF32><<<dim3(1024 / 64, MP / 64), 256, 0, stream>>>(MERGED, 1024, WOUT, 1024, 1024, EpiF32{MIX, 1024});
        k_ln1<<<MP, 256, 0, stream>>>(x + t0 * D, MIX, ln1_g, ln1_b, out + t0 * D, H1B + t0 * D);
    }
    gemm_simple<EpiB16><<<dim3(2048 / 64, M / 64), 256, 0, stream>>>(H1B, 1024, WPQ, 1024, 1024, EpiB16{PQ, 2048});
    k_route<<<M * 8 / 256, 256, 0, stream>>>(PQ, SUBK, IDX, PG);
    k_experts<<<M, 256, 0, stream>>>(out, H1B, UB, VB, IDX, PG, ln2_g, ln2_b, out);
}
```

```cpp
#include <hip/hip_runtime.h>
#include <stdint.h>
#include <math.h>

typedef unsigned short bf16_t;
typedef short bf16x8 __attribute__((ext_vector_type(8)));
typedef float f32x4 __attribute__((ext_vector_type(4)));
#define DI __device__ __forceinline__

DI float bf2f(bf16_t v) { return __uint_as_float(((unsigned)v) << 16); }
DI bf16_t f2bf(float f) { unsigned u = __float_as_uint(f); u += 0x7fffu + ((u >> 16) & 1u); return (bf16_t)(u >> 16); }

constexpr int NB = 8, S = 8192, D = 1024, M = NB * S;
constexpr int NPASS = 4, BPP = NB / NPASS, MP = BPP * S;
constexpr int INC = 10240;
constexpr int NEXP = 16384;
constexpr float ALPHA = 1.189207115002721f;
constexpr float LN_EPS = 1e-5f;
constexpr float QSCALE = 0.08838834764831845f;

constexpr size_t al(size_t x) { return (x + 255) & ~(size_t)255; }
constexpr size_t O_WIN = 0;
constexpr size_t O_WMKV = O_WIN + al((size_t)INC * D * 2);
constexpr size_t O_WBR = O_WMKV + al((size_t)1024 * 1024 * 2);
constexpr size_t O_WOUT = O_WBR + al((size_t)1024 * 1536 * 2);
constexpr size_t O_WPQ = O_WOUT + al((size_t)1024 * 1024 * 2);
constexpr size_t O_SUBK = O_WPQ + al((size_t)2048 * 1024 * 2);
constexpr size_t O_UB = O_SUBK + al((size_t)16 * 128 * 128 * 2);
constexpr size_t O_VB = O_UB + al((size_t)NEXP * D * 2);
constexpr size_t O_XB = O_VB + al((size_t)NEXP * D * 2);
constexpr size_t O_MEMB = O_XB + al((size_t)M * D * 2);
constexpr size_t O_MK = O_MEMB + al((size_t)2048 * 1024 * 2);
constexpr size_t O_MVT = O_MK + al((size_t)2048 * 512 * 2);
constexpr size_t O_H1B = O_MVT + al((size_t)8 * 512 * 256 * 2);
constexpr size_t O_MISC = O_H1B + al((size_t)M * D * 2);
constexpr size_t O_PASS = O_MISC + al(65536);
constexpr size_t P_QK = 0;
constexpr size_t P_VT = P_QK + al((size_t)MP * 3072 * 2);
constexpr size_t P_IT = P_VT + (size_t)1536 * MP * 2;
constexpr size_t P_HFQG = P_IT + al((size_t)512 * MP * 2);
constexpr size_t P_MQ = P_HFQG + al((size_t)MP * 1536 * 2);
constexpr size_t P_GATE = P_MQ + al((size_t)MP * 512 * 2);
constexpr size_t P_OG = P_GATE + al((size_t)MP * 3072 * 2);
constexpr size_t P_LSE = P_OG + al((size_t)MP * 1536 * 2);
constexpr size_t P_BR = P_LSE + al((size_t)MP * 12 * 4);
constexpr size_t P_MERGED = P_BR + al((size_t)MP * 1536 * 2);
constexpr size_t P_MIX = P_MERGED + al((size_t)MP * 1024 * 2);
constexpr size_t P_HSTL = P_MIX + al((size_t)MP * 1024 * 4);
constexpr size_t P_HSTD = P_HSTL + al((size_t)128 * 16384 * 4);
constexpr size_t P_END = P_HSTD + al((size_t)128 * 128 * 4);
constexpr size_t P_PQ = 0;
constexpr size_t P_IDX = P_PQ + al((size_t)M * 2048 * 2);
constexpr size_t P_PG = P_IDX + al((size_t)M * 128 * 4);
constexpr size_t P_END2 = P_PG + al((size_t)M * 128 * 4);
constexpr size_t WS_NEED = O_PASS + (P_END > P_END2 ? P_END : P_END2);
static_assert(WS_NEED <= (size_t)1073741824, "workspace budget");

__global__ __launch_bounds__(256) void k_convert(const float* __restrict__ in, bf16_t* __restrict__ out, size_t n4) {
    size_t i = (size_t)blockIdx.x * 256 + threadIdx.x; const size_t st = (size_t)gridDim.x * 256;
    for (; i < n4; i += st) { const f32x4 v = ((const f32x4*)in)[i]; ushort4 o; o.x = f2bf(v[0]); o.y = f2bf(v[1]); o.z = f2bf(v[2]); o.w = f2bf(v[3]); ((ushort4*)out)[i] = o; }
}
__global__ __launch_bounds__(256) void k_transpose(const float* __restrict__ W, int K, int ldw, bf16_t* __restrict__ out, int ldo, int koff) {
    __shared__ float t[32][33];
    const int k0 = blockIdx.y * 32, n0 = blockIdx.x * 32, tx = threadIdx.x & 31, ty = threadIdx.x >> 5;
    for (int i = ty; i < 32; i += 8) t[i][tx] = W[(size_t)(k0 + i) * ldw + n0 + tx];
    __syncthreads();
    for (int i = ty; i < 32; i += 8) out[(size_t)(n0 + i) * ldo + koff + k0 + tx] = f2bf(t[tx][i]);
}
__global__ void k_misc(const float* __restrict__ hgrn_lb, const float* __restrict__ rel_bias, float* __restrict__ misc) {
    const int i = blockIdx.x * blockDim.x + threadIdx.x;
    if (i < 512) { const float a = hgrn_lb[i], b = hgrn_lb[512 + i]; const float mx = fmaxf(a, b); const float ea = expf(a - mx), eb = expf(b - mx); misc[i] = ea / (ea + eb); }
    if (i < 3 * 129) {
        const int g = i / 129, j = i % 129; const int dl = g == 0 ? 1 : (g == 1 ? 4 : 16); const int n = j * dl;
        int bucket;
        if (n < 16) bucket = n;
        else { const double v = log((double)n / 16.0) / log(128.0) * 16.0; int l = 16 + (int)v; bucket = l < 31 ? l : 31; }
        for (int h = 0; h < 4; ++h) misc[512 + i * 4 + h] = rel_bias[bucket * 12 + g * 4 + h];
    }
}

template <class Epi>
__global__ __launch_bounds__(256) void gemm_simple(const bf16_t* __restrict__ A, int lda, const bf16_t* __restrict__ Bt, int ldb, int K, Epi epi) {
    const int lane = threadIdx.x & 63, w = threadIdx.x >> 6;
    const int row0 = blockIdx.y * 64 + (w >> 1) * 32, col0 = blockIdx.x * 64 + (w & 1) * 32;
    const int fr = lane & 15, fq = lane >> 4;
    f32x4 acc[2][2];
#pragma unroll
    for (int a = 0; a < 2; ++a)
#pragma unroll
        for (int b = 0; b < 2; ++b) acc[a][b] = (f32x4){0.f, 0.f, 0.f, 0.f};
    const bf16_t* ap = A + (size_t)(row0 + fr) * lda + fq * 8;
    const bf16_t* bp = Bt + (size_t)(col0 + fr) * ldb + fq * 8;
    for (int k0 = 0; k0 < K; k0 += 32) {
        const bf16x8 a0 = *(const bf16x8*)(ap + k0), a1 = *(const bf16x8*)(ap + (size_t)16 * lda + k0);
        const bf16x8 b0 = *(const bf16x8*)(bp + k0), b1 = *(const bf16x8*)(bp + (size_t)16 * ldb + k0);
        acc[0][0] = __builtin_amdgcn_mfma_f32_16x16x32_bf16(a0, b0, acc[0][0], 0, 0, 0);
        acc[0][1] = __builtin_amdgcn_mfma_f32_16x16x32_bf16(a0, b1, acc[0][1], 0, 0, 0);
        acc[1][0] = __builtin_amdgcn_mfma_f32_16x16x32_bf16(a1, b0, acc[1][0], 0, 0, 0);
        acc[1][1] = __builtin_amdgcn_mfma_f32_16x16x32_bf16(a1, b1, acc[1][1], 0, 0, 0);
    }
#pragma unroll
    for (int mi = 0; mi < 2; ++mi)
#pragma unroll
        for (int ni = 0; ni < 2; ++ni)
#pragma unroll
            for (int j = 0; j < 4; ++j) epi(row0 + mi * 16 + fq * 4 + j, col0 + ni * 16 + fr, acc[mi][ni][j]);
}

DI int dil_of(int g) { return g == 0 ? 1 : (g == 1 ? 4 : 16); }
DI int perm_tok(int lb, int s, int dl) { return lb * S + (s % dl) * (S / dl) + s / dl; }

struct EpiProj {
    bf16_t *QK, *VT, *HFQG, *IT, *MQ, *GATE; const float* b_gate;
    DI void operator()(int row, int col, float v) const {
        if (col < 3072) QK[(size_t)row * 3072 + col] = f2bf(v);
        else if (col < 4608) { const int c = col - 3072, g = c >> 9; VT[(size_t)c * MP + perm_tok(row / S, row % S, dil_of(g))] = f2bf(v); }
        else if (col < 5120) HFQG[(size_t)row * 1536 + (col - 4608)] = f2bf(v);
        else if (col < 5632) IT[(size_t)(col - 5120) * MP + row] = f2bf(v);
        else if (col < 6656) HFQG[(size_t)row * 1536 + (col - 5632) + 512] = f2bf(v);
        else if (col < 7168) MQ[(size_t)row * 512 + (col - 6656)] = f2bf(v);
        else { const int c = col - 7168; const float z = v + b_gate[c]; GATE[(size_t)row * 3072 + c] = f2bf(1.f / (1.f + expf(-z))); }
    }
};
struct EpiMemKV {
    bf16_t *MK, *MVT;
    DI void operator()(int row, int col, float v) const {
        if (col < 512) MK[(size_t)row * 512 + col] = f2bf(v);
        else MVT[((size_t)(row >> 8) * 512 + (col - 512)) * 256 + (row & 255)] = f2bf(v);
    }
};
struct EpiWiden {
    const bf16_t* GATE; float* TMP; bf16_t* MERGED; int g, pad;
    DI void operator()(int row, int col, float v) const {
        const float gv = bf2f(GATE[(size_t)row * 3072 + g * 1024 + col]) * v; const size_t o = (size_t)row * 1024 + col;
        if (g == 0) TMP[o] = gv; else if (g == 1) TMP[o] += gv; else MERGED[o] = f2bf(TMP[o] + gv);
    }
};
struct EpiF32 { float* C; int ldc, pad; DI void operator()(int row, int col, float v) const { C[(size_t)row * ldc + col] = v; } };
struct EpiB16 { bf16_t* C; int ldc, pad; DI void operator()(int row, int col, float v) const { C[(size_t)row * ldc + col] = f2bf(v); } };

DI float wave_max(float v) {
#pragma unroll
    for (int o = 1; o < 64; o <<= 1) v = fmaxf(v, __shfl_xor(v, o));
    return v;
}
DI float wave_sum(float v) {
#pragma unroll
    for (int o = 1; o < 64; o <<= 1) v += __shfl_xor(v, o);
    return v;
}

__global__ __launch_bounds__(256) void k_dil_attn(const bf16_t* __restrict__ QK, const bf16_t* __restrict__ VT, const float* __restrict__ BIAS, bf16_t* __restrict__ OG, float* __restrict__ LSE) {
    __shared__ float ps[4][192];
    const int lane = threadIdx.x & 63, w = threadIdx.x >> 6;
    const long task = (long)blockIdx.x * 4 + w;
    const int gh = (int)(task % 12); const int row = (int)(task / 12);
    const int g = gh >> 2, h = gh & 3, dl = dil_of(g);
    const int lb = row / S, s = row % S, m = s / dl, r = s % dl;
    const bf16_t* qp = QK + (size_t)row * 3072 + gh * 128;
    float lg[3]; float mx = -INFINITY;
#pragma unroll
    for (int i = 0; i < 3; ++i) {
        const int j = lane + 64 * i; float l = -INFINITY;
        if (j <= 128 && m - j >= 0) {
            const int krow = lb * S + (m - j) * dl + r; const bf16_t* kp = QK + (size_t)krow * 3072 + 1536 + gh * 128;
            float dot = 0.f;
            for (int d = 0; d < 128; ++d) dot += bf2f(qp[d]) * bf2f(kp[d]);
            l = dot * QSCALE + BIAS[(g * 129 + j) * 4 + h];
        }
        lg[i] = l; mx = fmaxf(mx, l);
    }
    mx = wave_max(mx);
    float sum = 0.f;
#pragma unroll
    for (int i = 0; i < 3; ++i) { const float p = (lg[i] == -INFINITY) ? 0.f : expf(lg[i] - mx); ps[w][lane + 64 * i] = p; sum += p; }
    sum = wave_sum(sum);
    __syncthreads();
    const int nk = m < 128 ? m : 128;
    const float inv = 1.f / sum;
#pragma unroll
    for (int i = 0; i < 2; ++i) {
        const int d = lane + 64 * i; const bf16_t* vp = VT + (size_t)(g * 512 + h * 128 + d) * MP + lb * S + r * (S / dl);
        float o = 0.f;
        for (int j = 0; j <= nk; ++j) o += ps[w][j] * bf2f(vp[m - j]);
        OG[(size_t)row * 1536 + g * 512 + h * 128 + d] = f2bf(o * inv);
    }
    if (lane == 0) LSE[(size_t)row * 12 + gh] = mx + logf(sum);
}
__global__ __launch_bounds__(256) void k_merge(const bf16_t* __restrict__ OG, const float* __restrict__ LSE, bf16_t* __restrict__ BR) {
    const long i = (long)blockIdx.x * 256 + threadIdx.x;
    const int row = (int)(i >> 9), c = (int)(i & 511), h = c >> 7;
    const float l0 = LSE[(size_t)row * 12 + h], l1 = LSE[(size_t)row * 12 + 4 + h], l2 = LSE[(size_t)row * 12 + 8 + h];
    const float mx = fmaxf(l0, fmaxf(l1, l2)); const float e0 = expf(l0 - mx), e1 = expf(l1 - mx), e2 = expf(l2 - mx); const float inv = 1.f / (e0 + e1 + e2);
    const bf16_t* og = OG + (size_t)row * 1536 + c;
    BR[(size_t)row * 1536 + c] = f2bf((e0 * bf2f(og[0]) + e1 * bf2f(og[512]) + e2 * bf2f(og[1024])) * inv);
}
__global__ __launch_bounds__(256) void k_mem_attn(const bf16_t* __restrict__ MQ, const bf16_t* __restrict__ MK, const bf16_t* __restrict__ MVT, bf16_t* __restrict__ BR, int batch0) {
    __shared__ float ps[4][256];
    const int lane = threadIdx.x & 63, w = threadIdx.x >> 6;
    const long task = (long)blockIdx.x * 4 + w;
    const int h = (int)(task & 3); const int row = (int)(task >> 2);
    const int b = batch0 + row / S;
    const bf16_t* qp = MQ + (size_t)row * 512 + h * 128;
    float lg[4]; float mx = -INFINITY;
#pragma unroll
    for (int i = 0; i < 4; ++i) {
        const int j = lane + 64 * i; const bf16_t* kp = MK + (size_t)(b * 256 + j) * 512 + h * 128;
        float dot = 0.f;
        for (int d = 0; d < 128; ++d) dot += bf2f(qp[d]) * bf2f(kp[d]);
        lg[i] = dot * QSCALE; mx = fmaxf(mx, lg[i]);
    }
    mx = wave_max(mx);
    float sum = 0.f;
#pragma unroll
    for (int i = 0; i < 4; ++i) { const float p = expf(lg[i] - mx); ps[w][lane + 64 * i] = p; sum += p; }
    sum = wave_sum(sum);
    __syncthreads();
    const float inv = 1.f / sum;
#pragma unroll
    for (int i = 0; i < 2; ++i) {
        const int d = lane + 64 * i; const bf16_t* vp = MVT + ((size_t)b * 512 + h * 128 + d) * 256;
        float o = 0.f;
        for (int j = 0; j < 256; ++j) o += ps[w][j] * bf2f(vp[j]);
        BR[(size_t)row * 1536 + 1024 + h * 128 + d] = f2bf(o * inv);
    }
}
__global__ __launch_bounds__(128) void k_hgrn(const bf16_t* __restrict__ HFQG, const bf16_t* __restrict__ IT, const float* __restrict__ lbv, const float* __restrict__ norm_w, bf16_t* __restrict__ BR) {
    __shared__ float sf[128], sk[128], sq[128], red[2];
    const int tid = threadIdx.x, h = blockIdx.x & 3, lb = blockIdx.x >> 2;
    const float lbd = lbv[h * 128 + tid], nw = norm_w[h * 128 + tid];
    float St[128];
#pragma unroll
    for (int i = 0; i < 128; ++i) St[i] = 0.f;
    for (int s = 0; s < S; ++s) {
        const size_t row = (size_t)lb * S + s;
        const float fr = bf2f(HFQG[row * 1536 + h * 128 + tid]);
        const float f = lbd + (1.f - lbd) / (1.f + expf(-fr));
        sf[tid] = f; sk[tid] = 1.f - f; sq[tid] = bf2f(HFQG[row * 1536 + 512 + h * 128 + tid]);
        __syncthreads();
        const float iv = bf2f(IT[(size_t)(h * 128 + tid) * MP + row]);
        float o = 0.f;
#pragma unroll
        for (int d = 0; d < 128; ++d) { St[d] = sf[d] * St[d] + sk[d] * iv; o += sq[d] * St[d]; }
        const float ss = wave_sum(o * o);
        if ((tid & 63) == 0) red[tid >> 6] = ss;
        __syncthreads();
        const float ms = (red[0] + red[1]) * (1.f / 128.f);
        const float gv = bf2f(HFQG[row * 1536 + 1024 + h * 128 + tid]);
        BR[row * 1536 + 512 + h * 128 + tid] = f2bf(o * rsqrtf(ms + LN_EPS) * nw * (gv / (1.f + expf(-gv))));
    }
}
__global__ __launch_bounds__(256) void k_ln1(const float* __restrict__ x, const float* __restrict__ mix, const float* __restrict__ g, const float* __restrict__ b, float* __restrict__ h1f, bf16_t* __restrict__ h1b) {
    __shared__ float red[8];
    const size_t row = blockIdx.x; const int tid = threadIdx.x;
    float v[4]; float s = 0.f;
#pragma unroll
    for (int i = 0; i < 4; ++i) { const int c = tid + 256 * i; v[i] = ALPHA * x[row * D + c] + mix[row * D + c]; s += v[i]; }
    s = wave_sum(s); if ((tid & 63) == 0) red[tid >> 6] = s; __syncthreads();
    const float mean = (red[0] + red[1] + red[2] + red[3]) * (1.f / D);
    float q = 0.f;
#pragma unroll
    for (int i = 0; i < 4; ++i) { v[i] -= mean; q += v[i] * v[i]; }
    q = wave_sum(q); if ((tid & 63) == 0) red[4 + (tid >> 6)] = q; __syncthreads();
    const float rstd = rsqrtf((red[4] + red[5] + red[6] + red[7]) * (1.f / D) + LN_EPS);
#pragma unroll
    for (int i = 0; i < 4; ++i) { const int c = tid + 256 * i; const float o = v[i] * rstd * g[c] + b[c]; h1f[row * D + c] = o; h1b[row * D + c] = f2bf(o); }
}

DI void ins16(float (&tv)[16], int (&ti)[16], float v, int i) {
#pragma unroll
    for (int j = 0; j < 16; ++j) { const bool gt = v > tv[j]; const float ov = tv[j]; const int oi = ti[j]; tv[j] = gt ? v : ov; ti[j] = gt ? i : oi; v = gt ? ov : v; i = gt ? oi : i; }
}
__global__ __launch_bounds__(256) void k_route(const bf16_t* __restrict__ PQ, const bf16_t* __restrict__ SUBK, int* __restrict__ IDX, float* __restrict__ PG) {
    const long gi = (long)blockIdx.x * 256 + threadIdx.x;
    const int h = (int)(gi & 7); const size_t t = (size_t)(gi >> 3);
    float s1[16], s2[16]; int i1[16], i2[16];
#pragma unroll
    for (int j = 0; j < 16; ++j) { s1[j] = -INFINITY; s2[j] = -INFINITY; i1[j] = 0; i2[j] = 0; }
    const bf16_t* q0 = PQ + t * 2048 + h * 256;
    for (int n = 0; n < 128; ++n) {
        const bf16_t* k0 = SUBK + (size_t)((h * 2 + 0) * 128 + n) * 128; const bf16_t* k1 = SUBK + (size_t)((h * 2 + 1) * 128 + n) * 128;
        float a = 0.f, b = 0.f;
        for (int k = 0; k < 128; ++k) { a += bf2f(q0[k]) * bf2f(k0[k]); b += bf2f(q0[128 + k]) * bf2f(k1[k]); }
        ins16(s1, i1, a, n); ins16(s2, i2, b, n);
    }
    float cv[16]; int ci[16];
#pragma unroll
    for (int j = 0; j < 16; ++j) { cv[j] = -INFINITY; ci[j] = 0; }
#pragma unroll
    for (int a = 0; a < 16; ++a)
#pragma unroll
        for (int b = 0; b < 16; ++b) ins16(cv, ci, s1[a] + s2[b], i1[a] * 128 + i2[b]);
    float sum = 0.f; float e[16];
#pragma unroll
    for (int j = 0; j < 16; ++j) { e[j] = expf(cv[j] - cv[0]); sum += e[j]; }
    const float inv = 1.f / sum;
#pragma unroll
    for (int j = 0; j < 16; ++j) { IDX[t * 128 + h * 16 + j] = ci[j]; PG[t * 128 + h * 16 + j] = e[j] * inv; }
}
__global__ __launch_bounds__(256) void k_experts(const float* h1f_in, const bf16_t* __restrict__ h1b, const bf16_t* __restrict__ UB, const bf16_t* __restrict__ VB, const int* __restrict__ IDX, const float* __restrict__ PG,
                                                 const float* __restrict__ g2, const float* __restrict__ b2, float* out) {
    __shared__ float hrow[1024]; __shared__ float cw[128]; __shared__ int eid[128]; __shared__ float red[8];
    const size_t t = blockIdx.x; const int tid = threadIdx.x, lane = tid & 63, w = tid >> 6;
    float hv[4];
#pragma unroll
    for (int i = 0; i < 4; ++i) { const int c = tid + 256 * i; hv[i] = h1f_in[t * D + c]; hrow[c] = bf2f(h1b[t * D + c]); }
    if (tid < 128) eid[tid] = IDX[t * 128 + tid];
    __syncthreads();
    for (int e = w; e < 128; e += 4) {
        const bf16_t* up = UB + (size_t)eid[e] * D; float dot = 0.f;
#pragma unroll
        for (int i = 0; i < 16; ++i) dot += hrow[lane + 64 * i] * bf2f(up[lane + 64 * i]);
        dot = wave_sum(dot);
        if (lane == 0) cw[e] = PG[t * 128 + e] * 0.5f * dot * (1.f + erff(dot * 0.7071067811865476f));
    }
    __syncthreads();
    float f[4] = {0.f, 0.f, 0.f, 0.f};
    for (int e = 0; e < 128; ++e) { const bf16_t* vp = VB + (size_t)eid[e] * D; const float c = cw[e];
#pragma unroll
        for (int i = 0; i < 4; ++i) f[i] += c * bf2f(vp[tid + 256 * i]); }
    float v[4]; float s = 0.f;
#pragma unroll
    for (int i = 0; i < 4; ++i) { v[i] = ALPHA * hv[i] + f[i]; s += v[i]; }
    s = wave_sum(s); if (lane == 0) red[w] = s; __syncthreads();
    const float mean = (red[0] + red[1] + red[2] + red[3]) * (1.f / D);
    float q = 0.f;
#pragma unroll
    for (int i = 0; i < 4; ++i) { v[i] -= mean; q += v[i] * v[i]; }
    q = wave_sum(q); if (lane == 0) red[4 + w] = q; __syncthreads();
    const float rstd = rsqrtf((red[4] + red[5] + red[6] + red[7]) * (1.f / D) + LN_EPS);
#pragma unroll
    for (int i = 0; i < 4; ++i) { const int c = tid + 256 * i; out[t * D + c] = v[i] * rstd * g2[c] + b2[c]; }
}

#define LAS __attribute__((address_space(3)))
#define GAS __attribute__((address_space(1)))
typedef unsigned u32x4 __attribute__((ext_vector_type(4)));
typedef unsigned u32x2 __attribute__((ext_vector_type(2)));
typedef float f32x2 __attribute__((ext_vector_type(2)));
typedef __bf16 bf16x2_t __attribute__((ext_vector_type(2)));
DI unsigned cvtpk(float lo, float hi) { f32x2 v = {lo, hi}; bf16x2_t b = __builtin_convertvector(v, bf16x2_t); return __builtin_bit_cast(unsigned, b); }
constexpr float LOG2E = 1.4426950408889634f;
DI float fast_sigmoid(float z) { return __builtin_amdgcn_rcpf(1.f + __builtin_amdgcn_exp2f(-z * LOG2E)); }

namespace g8 {
constexpr int BM = 256, BK = 64, HALF = 128, HTB = HALF * BK * 2, STAGE_BYTES = 8 * HTB;
DI int lds_byte(int r, int c) { const int st = (r >> 4) * 2 + (c >> 5), rr = r & 15, cc = c & 31, ob = rr * 64 + cc * 2; return st * 1024 + (ob ^ (((ob >> 9) & 1) << 5)); }
DI void stage_rc(int b, int& R, int& C) { const int st = b / 1024, sb = b % 1024, swz = sb ^ (((sb >> 9) & 1) << 5); R = (st >> 1) * 16 + swz / 64; C = (st & 1) * 32 + (swz % 64) / 2; }
DI int perm32(int rho) { const int n = rho >> 4, i = rho & 15; return 8 * (i >> 2) + 4 * n + (i & 3); }

struct Unit { const char* a; const char* b; int dlb; int pm, pn, kind; };

template <class Epi, class Sched>
DI void gemm_phase(LAS unsigned char* lds, const int K, const Sched& S, const Epi& E, const int tid) {
    const int wid = __builtin_amdgcn_readfirstlane(tid >> 6), lane = tid & 63, wr = wid >> 2, wc = wid & 3, fr = lane & 15, fq = lane >> 4;
    const int nt = K / BK;
    unsigned voffA[2], rbk[2], ccb[2];
#pragma unroll
    for (int i = 0; i < 2; ++i) { int R, C; stage_rc(tid * 16 + i * 8192, R, C); const int Rb = Epi::PERM ? ((R & ~31) + perm32(R & 31)) : R;
        voffA[i] = (unsigned)(R * K + C) * 2u; rbk[i] = (unsigned)(Rb * K) * 2u; ccb[i] = (unsigned)C * 2u; }
    const size_t kstep = (size_t)(BK * 2);
    const size_t hstepA = (size_t)HALF * K * 2;
    const unsigned ldsw = (unsigned)wid * 1024u;
    const int aoff = lds_byte(wr * 64 + fr, fq * 8), boff = lds_byte(wc * 32 + fr, fq * 8);
#define G8_SA(b, h) (((b) * 2 + (h)) * HTB)
#define G8_SB(b, h) ((4 + (b) * 2 + (h)) * HTB)
#define G8_STAGE(bufoff, gbase, v0, v1) do { \
        __builtin_amdgcn_global_load_lds((const unsigned*)((const char*)(gbase) + (v0)), (LAS unsigned*)(lds + (bufoff) + ldsw), 16, 0, 0); \
        __builtin_amdgcn_global_load_lds((const unsigned*)((const char*)(gbase) + (v1)), (LAS unsigned*)(lds + (bufoff) + ldsw + 8192), 16, 0, 0); } while (0)
#define G8_LDA(dst, b, h) do { _Pragma("unroll") for (int m = 0; m < 4; ++m) _Pragma("unroll") for (int k = 0; k < 2; ++k) dst[m][k] = *(const LAS bf16x8*)(lds + G8_SA(b, h) + aoff + m * 2048 + k * 1024); } while (0)
#define G8_LDB(dst, b, h) do { _Pragma("unroll") for (int n = 0; n < 2; ++n) _Pragma("unroll") for (int k = 0; k < 2; ++k) dst[n][k] = *(const LAS bf16x8*)(lds + G8_SB(b, h) + boff + n * 2048 + k * 1024); } while (0)
#define G8_MMA(ai, bj, At, Bt) do { __builtin_amdgcn_s_setprio(1); _Pragma("unroll") for (int m = 0; m < 4; ++m) _Pragma("unroll") for (int n = 0; n < 2; ++n) _Pragma("unroll") for (int k = 0; k < 2; ++k) \
        acc[ai][bj][m][n] = __builtin_amdgcn_mfma_f32_16x16x32_bf16(Bt[n][k], At[m][k], acc[ai][bj][m][n], 0, 0, 0); __builtin_amdgcn_s_setprio(0); } while (0)
#define G8_WAIT_V(n) asm volatile("s_waitcnt vmcnt(" #n ")" ::: "memory")
#define G8_WAIT_L(n) asm volatile("s_waitcnt lgkmcnt(" #n ")" ::: "memory")
#define G8_BAR __builtin_amdgcn_s_barrier()
#define G8_SCHED __builtin_amdgcn_sched_barrier(0)
    Unit cur, nxt; int ui = 0;
    if (!S.next(0, cur)) return;
    f32x4 acc[2][2][4][2];
#pragma unroll
    for (int a = 0; a < 2; ++a)
#pragma unroll
        for (int b = 0; b < 2; ++b)
#pragma unroll
            for (int m = 0; m < 4; ++m)
#pragma unroll
                for (int n = 0; n < 2; ++n) acc[a][b][m][n] = (f32x4){0.f, 0.f, 0.f, 0.f};
    bf16x8 At[4][2], B0[2][2], B1[2][2];
    const char* cA = cur.a; const char* cB = cur.b;
    unsigned vBc0 = rbk[0] * (unsigned)cur.dlb + ccb[0], vBc1 = rbk[1] * (unsigned)cur.dlb + ccb[1]; size_t hBc = hstepA * (size_t)cur.dlb;
    G8_STAGE(G8_SB(0, 0), cB, vBc0, vBc1); G8_STAGE(G8_SB(0, 1), cB + hBc, vBc0, vBc1); G8_STAGE(G8_SA(0, 0), cA, voffA[0], voffA[1]); G8_STAGE(G8_SA(0, 1), cA + hstepA, voffA[0], voffA[1]);
    if (wr == 1) G8_BAR;
    G8_WAIT_V(2); G8_BAR;
    G8_STAGE(G8_SB(1, 0), cB + kstep, vBc0, vBc1); G8_STAGE(G8_SA(1, 0), cA + kstep, voffA[0], voffA[1]); G8_STAGE(G8_SB(1, 1), cB + hBc + kstep, vBc0, vBc1);
    G8_WAIT_V(6); G8_BAR;
    for (;;) {
        const bool has_next = S.next(ui + 1, nxt);
        const char* nA = has_next ? nxt.a : cA; const char* nB = has_next ? nxt.b : cB; const int dln = has_next ? nxt.dlb : cur.dlb;
        const unsigned vBn0 = rbk[0] * (unsigned)dln + ccb[0], vBn1 = rbk[1] * (unsigned)dln + ccb[1]; const size_t hBn = hstepA * (size_t)dln;
        for (int t = 0; t < nt; t += 2) {
            if constexpr (Epi::HOOK) E.hook(acc, cur, t, wr, wc, fr, fq);
            const bool last = (t == nt - 2);
            const char* a1 = cA + (size_t)(t + 1) * kstep;
            const char* a2 = last ? nA : cA + (size_t)(t + 2) * kstep; const char* b2 = last ? nB : cB + (size_t)(t + 2) * kstep;
            const char* a3 = a2 + kstep; const char* b3 = b2 + kstep;
            const unsigned vB0 = last ? vBn0 : vBc0, vB1 = last ? vBn1 : vBc1; const size_t hB = last ? hBn : hBc;
            G8_LDB(B0, 0, 0); G8_LDB(B1, 0, 1); G8_SCHED; G8_LDA(At, 0, 0); G8_STAGE(G8_SA(1, 1), a1 + hstepA, voffA[0], voffA[1]);
            G8_WAIT_V(8); G8_WAIT_L(0); G8_BAR; G8_MMA(0, 0, At, B0); G8_MMA(0, 1, At, B1); G8_BAR; G8_SCHED;
            G8_LDA(At, 0, 1); G8_STAGE(G8_SB(0, 0), b2, vB0, vB1); G8_STAGE(G8_SB(0, 1), b2 + hB, vB0, vB1); G8_STAGE(G8_SA(0, 0), a2, voffA[0], voffA[1]);
            G8_WAIT_V(8); G8_WAIT_L(0); G8_BAR; G8_MMA(1, 0, At, B0); G8_MMA(1, 1, At, B1); G8_BAR; G8_SCHED;
            G8_LDB(B0, 1, 0); G8_LDB(B1, 1, 1); G8_SCHED; G8_LDA(At, 1, 0); G8_STAGE(G8_SA(0, 1), a2 + hstepA, voffA[0], voffA[1]);
            G8_WAIT_V(8); G8_WAIT_L(0); G8_BAR; G8_MMA(0, 0, At, B0); G8_MMA(0, 1, At, B1); G8_BAR; G8_SCHED;
            G8_LDA(At, 1, 1); G8_STAGE(G8_SB(1, 0), b3, vB0, vB1); G8_STAGE(G8_SB(1, 1), b3 + hB, vB0, vB1); G8_STAGE(G8_SA(1, 0), a3, voffA[0], voffA[1]);
            G8_WAIT_V(8); G8_WAIT_L(0); G8_BAR; G8_MMA(1, 0, At, B0); G8_MMA(1, 1, At, B1); G8_BAR; G8_SCHED;
        }
        if (wr == 0) G8_BAR;
        E(acc, cur, wr, wc, fr, fq);
        if (!has_next) break;
#pragma unroll
        for (int a = 0; a < 2; ++a)
#pragma unroll
            for (int b = 0; b < 2; ++b)
#pragma unroll
                for (int m = 0; m < 4; ++m)
#pragma unroll
                    for (int n = 0; n < 2; ++n) acc[a][b][m][n] = (f32x4){0.f, 0.f, 0.f, 0.f};
        cur = nxt; cA = nA; cB = nB; vBc0 = vBn0; vBc1 = vBn1; hBc = hBn; ++ui;
        if (wr == 1) G8_BAR;
    }
    G8_WAIT_V(0);
    G8_BAR;
#undef G8_SA
#undef G8_SB
#undef G8_STAGE
#undef G8_LDA
#undef G8_LDB
#undef G8_MMA
#undef G8_WAIT_V
#undef G8_WAIT_L
#undef G8_BAR
#undef G8_SCHED
}
}

typedef GAS unsigned gu32;
#define XB_TMO      128
#define XB_XCNT(j)  (256  + 64 * (j))
#define XB_XSUB(j)  (1280 + 64 * (j))
#define XB_XGEN(j)  (2304 + 64 * (j))
#define XB_TOP      3328
#define XB_TOPGEN   3392
#define XCD_BAR_WORDS 3456
#define XB_SPIN_CAP (1u << 22)
DI unsigned xb_ld(unsigned* p)              { return __hip_atomic_load(p, __ATOMIC_RELAXED, __HIP_MEMORY_SCOPE_AGENT); }
DI unsigned xb_add(unsigned* p, unsigned v) { return __hip_atomic_fetch_add(p, v, __ATOMIC_RELAXED, __HIP_MEMORY_SCOPE_AGENT); }
DI unsigned xb_xcc_id() { return (unsigned)__builtin_amdgcn_s_getreg((3 << 11) | 20) & 0xFu; }
#define XB_SPIN(cond, bar) do { unsigned _sp = 0; while (cond) { __builtin_amdgcn_s_sleep(1); \
    if ((++_sp & 255u) == 0u) { if (xb_ld(&(bar)[XB_TMO])) break; if (_sp > XB_SPIN_CAP) { atomicAdd(&(bar)[XB_TMO], 1u); break; } } } } while (0)
struct XcdBarrier { unsigned* bar; unsigned x; volatile LAS unsigned* st; };
DI XcdBarrier xcd_barrier_post(unsigned* bar, volatile LAS unsigned* st) {
    XcdBarrier b; b.bar = bar; b.x = xb_xcc_id(); b.st = st;
    if (threadIdx.x == 0) (void)xb_add(&bar[XB_XCNT(b.x)], 1u);
    return b;
}
DI void xcd_barrier_complete(unsigned* bar, unsigned x, unsigned& nloc, unsigned& nx) {
    const unsigned G = gridDim.x * gridDim.y * gridDim.z;
    unsigned sum, cnt, mine, sp = 0u;
    for (;;) {
        sum = 0u; cnt = 0u; mine = 0u;
#pragma unroll
        for (unsigned j = 0; j < 16; ++j) { const unsigned c = xb_ld(&bar[XB_XCNT(j)]); sum += c; cnt += (c > 0u) ? 1u : 0u; mine = (j == x) ? c : mine; }
        if (sum == G) break;
        __builtin_amdgcn_s_sleep(1);
        if ((++sp & 255u) == 0u) { if (xb_ld(&bar[XB_TMO])) break; if (sp > XB_SPIN_CAP) { atomicAdd(&bar[XB_TMO], 1u); break; } }
    }
    nloc = mine > 0u ? mine : 1u; nx = cnt > 0u ? cnt : 1u;
}
DI void xcd_barrier(const XcdBarrier& b) {
    asm volatile("s_waitcnt vmcnt(0)" ::: "memory");
    __syncthreads();
    if (threadIdx.x == 0) {
        unsigned* bar = b.bar;
        __builtin_amdgcn_s_waitcnt(0);
        unsigned nloc = b.st[0], nx = b.st[1];
        if (nloc == 0u) { xcd_barrier_complete(bar, b.x, nloc, nx); b.st[0] = nloc; b.st[1] = nx; }
        const unsigned old = xb_add(&bar[XB_XSUB(b.x)], 1u);
        const unsigned gen = old / nloc;
        if (old + 1u == (gen + 1u) * nloc) {
            __builtin_amdgcn_fence(__ATOMIC_RELEASE, "agent");
            asm volatile("s_waitcnt vmcnt(0)" ::: "memory");
            const unsigned og = xb_add(&bar[XB_TOP], 1u);
            const unsigned tg = og / nx;
            if (og + 1u == (tg + 1u) * nx) xb_add(&bar[XB_TOPGEN], 1u);
            else XB_SPIN(xb_ld(&bar[XB_TOPGEN]) == tg, bar);
            __builtin_amdgcn_fence(__ATOMIC_ACQUIRE, "agent");
            xb_add(&bar[XB_XGEN(b.x)], 1u);
            asm volatile("s_waitcnt vmcnt(0)" ::: "memory");
        } else {
            XB_SPIN(xb_ld(&bar[XB_XGEN(b.x)]) == gen, bar);
            __builtin_amdgcn_fence(__ATOMIC_ACQUIRE, "agent");
            asm volatile("s_waitcnt vmcnt(0)" ::: "memory");
        }
    }
    __syncthreads();
}

constexpr int NWAVES = 8, NTHR = NWAVES * 64;
constexpr int RING_BYTES = 131072, LDS_BYTES = 147456, LDSCTL_OFF = LDS_BYTES - 1024, MISC_OFF = LDSCTL_OFF + 320;
constexpr size_t CTL_BYTES = 65536;
enum { PH_ALL = 0, PH_PRO = 11, PH_PROJ = 1, PH_ATTN = 2, PH_HGPRE = 3, PH_HGMAIN = 4, PH_WIDEN = 5, PH_WOUT = 6, PH_LN1 = 7, PH_PQ = 8, PH_ROUTE = 9, PH_EXPERTS = 10 };
struct Args { const float* in[18]; float* out; unsigned char* ws; int ph, pass; };

struct Bufs {
    const bf16_t *WIN, *XBp; bf16_t *QK, *VIT, *HFQG, *MQ, *GATE;
};

struct SchedP1 {
    const char* XBp; const char* W; int G, c;
    DI bool next(int i, g8::Unit& u) const {
        const int L = i * G + c; if (L >= 2560) return false;
        if (L < 2048) { const int x = L & 7, off = L >> 3; u.pm = 8 * x + (off & 7); u.pn = off >> 3; u.kind = 0; u.dlb = 1;
            u.a = XBp + (size_t)u.pm * 256 * D * 2; u.b = W + (size_t)u.pn * 256 * D * 2; }
        else { const int idx = L - 2048; u.pm = idx & 7; u.pn = idx >> 3; u.kind = 1;
            const int dl = u.pm < 2 ? 1 : (u.pm < 4 ? 4 : (u.pm < 6 ? 16 : 1));
            const int v0 = u.pn * 256, lb = v0 / S, vv = v0 % S, per = S / dl, r = vv / per, m0 = vv % per;
            u.dlb = dl; u.a = W + (size_t)(8192 + u.pm * 256) * D * 2; u.b = XBp + (size_t)(lb * S + m0 * dl + r) * D * 2; }
        return true;
    }
};
struct EpiP1 {
    static constexpr bool PERM = true, HOOK = false;
    bf16_t *QK, *HFQG, *MQ, *GATE, *VIT; const float* b_gate;
    DI void hook(f32x4 (&)[2][2][4][2], const g8::Unit&, int, int, int, int, int) const {}
    DI void operator()(const f32x4 (&acc)[2][2][4][2], const g8::Unit& u, int wr, int wc, int fr, int fq) const {
        bf16_t* base; int ldc, colt; bool gate = false;
        if (u.kind == 1) { base = VIT; ldc = MP; colt = u.pn * 256; }
        else if (u.pn < 12) { base = QK; ldc = 3072; colt = u.pn * 256; }
        else if (u.pn < 18) { base = HFQG; ldc = 1536; colt = (u.pn - 12) * 256; }
        else if (u.pn < 20) { base = MQ; ldc = 512; colt = (u.pn - 18) * 256; }
        else { base = GATE; ldc = 3072; colt = (u.pn - 20) * 256; gate = true; }
        const int row0 = u.pm * 256 + wr * 64 + fr, col0 = colt + wc * 32 + 8 * fq;
        f32x4 bv[2][2];
#pragma unroll
        for (int bj = 0; bj < 2; ++bj)
#pragma unroll
            for (int n = 0; n < 2; ++n) bv[bj][n] = gate ? *(const f32x4*)(b_gate + col0 + bj * 128 + 4 * n) : (f32x4){0.f, 0.f, 0.f, 0.f};
#pragma unroll
        for (int ai = 0; ai < 2; ++ai)
#pragma unroll
            for (int m = 0; m < 4; ++m) { bf16_t* rowp = base + (size_t)(row0 + ai * 128 + m * 16) * ldc + col0;
#pragma unroll
                for (int bj = 0; bj < 2; ++bj) { f32x4 v0 = acc[ai][bj][m][0], v1 = acc[ai][bj][m][1];
                    if (gate) { v0 = v0 + bv[bj][0]; v1 = v1 + bv[bj][1];
#pragma unroll
                        for (int e = 0; e < 4; ++e) { v0[e] = fast_sigmoid(v0[e]); v1[e] = fast_sigmoid(v1[e]); } }
                    u32x4 w; w.x = cvtpk(v0[0], v0[1]); w.y = cvtpk(v0[2], v0[3]); w.z = cvtpk(v1[0], v1[1]); w.w = cvtpk(v1[2], v1[3]);
                    *(u32x4*)(rowp + bj * 128) = w; } }
    }
};

typedef float f32x16 __attribute__((ext_vector_type(16)));
typedef short s16x4 __attribute__((ext_vector_type(4)));
DI int crow(int r, int hi) { return (r & 3) + 8 * (r >> 2) + 4 * hi; }
DI float xor32f(float v) { return __shfl_xor(v, 32); }
#define MFMA32(a, b, c) __builtin_amdgcn_mfma_f32_32x32x16_bf16((a), (b), (c), 0, 0, 0)
DI bf16x8 pack8(const f32x16& p, int s) {
    u32x4 w; w.x = cvtpk(p[8 * s + 0], p[8 * s + 1]); w.y = cvtpk(p[8 * s + 2], p[8 * s + 3]); w.z = cvtpk(p[8 * s + 4], p[8 * s + 5]); w.w = cvtpk(p[8 * s + 6], p[8 * s + 7]);
    return __builtin_bit_cast(bf16x8, w);
}
DI bf16x8 ldvt(const bf16_t* vp) {
    const s16x4 lo = *(const s16x4*)vp, hi4 = *(const s16x4*)(vp + 8);
    return __builtin_shufflevector(lo, hi4, 0, 1, 2, 3, 4, 5, 6, 7);
}
constexpr int DIL_TASKS = BPP * 12 * (S / 32);
constexpr int MEM_TASKS = (MP / 32) * 4;
DI void attn_dil_wave(const bf16_t* __restrict__ QK, const bf16_t* __restrict__ VT, const LAS float* btab, bf16_t* __restrict__ OG, float* __restrict__ LSE, int task, int lane) {
    const int r32 = lane & 31, hi = lane >> 5;
    const int q32 = task & 255, gh = (task >> 8) % 12, lb = task / (256 * 12);
    const int g = gh >> 2, h = gh & 3, dl = dil_of(g), per = S / dl;
    const int tok0 = q32 * 32, r = tok0 / per, m0 = tok0 % per;
    const size_t rowq = (size_t)lb * S + (size_t)(m0 + r32) * dl + r;
    bf16x8 qf[8];
    { const bf16_t* qp = QK + rowq * 3072 + gh * 128 + 8 * hi;
#pragma unroll
      for (int ks = 0; ks < 8; ++ks) qf[ks] = *(const bf16x8*)(qp + 16 * ks); }
    const LAS float* bt = btab + g * 129 * 4 + h;
    f32x16 o[4];
#pragma unroll
    for (int dt = 0; dt < 4; ++dt)
#pragma unroll
        for (int i = 0; i < 16; ++i) o[dt][i] = 0.f;
    float mrun = -INFINITY, sum = 0.f;
    const bf16_t* vbase = VT + (size_t)(g * 512 + h * 128 + r32) * MP + (size_t)lb * S + (size_t)r * per + 4 * hi;
    const bf16_t* kbase = QK + ((size_t)lb * S + r) * 3072 + 1536 + gh * 128 + 8 * hi;
#pragma unroll 1
    for (int kt = (m0 >= 128 ? 0 : (128 - m0) >> 5); kt < 5; ++kt) {
        const int mt0 = m0 - 128 + 32 * kt;
        const bf16_t* kp = kbase + (size_t)(mt0 + r32) * dl * 3072;
        f32x16 sc;
#pragma unroll
        for (int i = 0; i < 16; ++i) sc[i] = 0.f;
#pragma unroll
        for (int ks = 0; ks < 8; ++ks) { const bf16x8 kf = *(const bf16x8*)(kp + 16 * ks); sc = MFMA32(kf, qf[ks], sc); }
        float mx = -INFINITY;
#pragma unroll
        for (int i = 0; i < 16; ++i) {
            const int delta = 128 - 32 * kt + r32 - crow(i, hi);
            const bool valid = (delta >= 0) && (delta <= 128);
            const int di = delta < 0 ? 0 : (delta > 128 ? 128 : delta);
            const float x = sc[i] * (QSCALE * LOG2E) + bt[di * 4];
            sc[i] = valid ? x : -INFINITY; mx = fmaxf(mx, sc[i]);
        }
        mx = fmaxf(mx, xor32f(mx));
        const float mnew = fmaxf(mrun, mx); const float f = __builtin_amdgcn_exp2f(mrun - mnew);
        sum *= f;
#pragma unroll
        for (int dt = 0; dt < 4; ++dt)
#pragma unroll
            for (int i = 0; i < 16; ++i) o[dt][i] *= f;
        mrun = mnew;
        float ps = 0.f;
#pragma unroll
        for (int i = 0; i < 16; ++i) { sc[i] = __builtin_amdgcn_exp2f(sc[i] - mnew); ps += sc[i]; }
        ps += xor32f(ps); sum += ps;
#pragma unroll
        for (int s = 0; s < 2; ++s) {
            const bf16x8 pb = pack8(sc, s);
#pragma unroll
            for (int dt = 0; dt < 4; ++dt) { const bf16x8 va = ldvt(vbase + (size_t)(32 * dt) * MP + mt0 + 16 * s); o[dt] = MFMA32(va, pb, o[dt]); }
        }
    }
    const float inv = 1.f / sum;
    bf16_t* op = OG + rowq * 1536 + g * 512 + h * 128 + 4 * hi;
#pragma unroll
    for (int dt = 0; dt < 4; ++dt)
#pragma unroll
        for (int a = 0; a < 4; ++a) { u32x2 w; w.x = cvtpk(o[dt][4 * a] * inv, o[dt][4 * a + 1] * inv); w.y = cvtpk(o[dt][4 * a + 2] * inv, o[dt][4 * a + 3] * inv); *(u32x2*)(op + 32 * dt + 8 * a) = w; }
    if (hi == 0) LSE[rowq * 12 + gh] = (mrun + __builtin_amdgcn_logf(sum)) * 0.6931471805599453f;
}
DI void attn_mem_wave(const bf16_t* __restrict__ MQ, const bf16_t* __restrict__ MK, const bf16_t* __restrict__ MVT, bf16_t* __restrict__ BR, int task, int batch0, int lane) {
    const int r32 = lane & 31, hi = lane >> 5;
    const int h = task & 3, blk = task >> 2;
    const size_t rowq = (size_t)blk * 32 + r32; const int b = batch0 + blk * 32 / S;
    bf16x8 qf[8];
    { const bf16_t* qp = MQ + rowq * 512 + h * 128 + 8 * hi;
#pragma unroll
      for (int ks = 0; ks < 8; ++ks) qf[ks] = *(const bf16x8*)(qp + 16 * ks); }
    f32x16 o[4];
#pragma unroll
    for (int dt = 0; dt < 4; ++dt)
#pragma unroll
        for (int i = 0; i < 16; ++i) o[dt][i] = 0.f;
    float mrun = -INFINITY, sum = 0.f;
    const bf16_t* vbase = MVT + (size_t)(h * 128 + r32) * 2048 + (size_t)b * 256 + 4 * hi;
    const bf16_t* kbase = MK + ((size_t)b * 256 + r32) * 512 + h * 128 + 8 * hi;
#pragma unroll 1
    for (int c = 0; c < 4; ++c) {
        f32x16 sc[2]; float mx = -INFINITY;
#pragma unroll
        for (int kt = 0; kt < 2; ++kt) {
            const bf16_t* kp = kbase + (size_t)(c * 64 + kt * 32) * 512;
            f32x16 acc;
#pragma unroll
            for (int i = 0; i < 16; ++i) acc[i] = 0.f;
#pragma unroll
            for (int ks = 0; ks < 8; ++ks) { const bf16x8 kf = *(const bf16x8*)(kp + 16 * ks); acc = MFMA32(kf, qf[ks], acc); }
#pragma unroll
            for (int i = 0; i < 16; ++i) { sc[kt][i] = acc[i] * (QSCALE * LOG2E); mx = fmaxf(mx, sc[kt][i]); }
            asm volatile("" ::: "memory");
        }
        mx = fmaxf(mx, xor32f(mx));
        const float mnew = fmaxf(mrun, mx); const float f = __builtin_amdgcn_exp2f(mrun - mnew);
        sum *= f;
#pragma unroll
        for (int dt = 0; dt < 4; ++dt)
#pragma unroll
            for (int i = 0; i < 16; ++i) o[dt][i] *= f;
        mrun = mnew;
        float ps = 0.f;
#pragma unroll
        for (int kt = 0; kt < 2; ++kt)
#pragma unroll
            for (int i = 0; i < 16; ++i) { sc[kt][i] = __builtin_amdgcn_exp2f(sc[kt][i] - mnew); ps += sc[kt][i]; }
        ps += xor32f(ps); sum += ps;
#pragma unroll
        for (int kt = 0; kt < 2; ++kt)
#pragma unroll
            for (int s = 0; s < 2; ++s) {
                const bf16x8 pb = pack8(sc[kt], s);
#pragma unroll
                for (int dt = 0; dt < 4; ++dt) { const bf16x8 va = ldvt(vbase + (size_t)(32 * dt) * 2048 + c * 64 + kt * 32 + 16 * s); o[dt] = MFMA32(va, pb, o[dt]); }
                asm volatile("" ::: "memory");
            }
    }
    const float inv = 1.f / sum;
    bf16_t* op = BR + rowq * 1536 + 1024 + h * 128 + 4 * hi;
#pragma unroll
    for (int dt = 0; dt < 4; ++dt)
#pragma unroll
        for (int a = 0; a < 4; ++a) { u32x2 w; w.x = cvtpk(o[dt][4 * a] * inv, o[dt][4 * a + 1] * inv); w.y = cvtpk(o[dt][4 * a + 2] * inv, o[dt][4 * a + 3] * inv); *(u32x2*)(op + 32 * dt + 8 * a) = w; }
}

constexpr int HG_SCH = 8, HG_UPS = S / 64 / HG_SCH  , HG_UNITS = BPP * 4 * HG_UPS  ;
constexpr int HG_ROW = 136, HG_KT_ROW = 72;
constexpr int HG_KP = 0, HG_QP = 64 * HG_ROW * 2, HG_QPP = 2 * HG_QP, HG_KPPT = 3 * HG_QP, HG_DEC = HG_KPPT + 128 * HG_KT_ROW * 2, HG_SSQ = HG_DEC + 512, HG_UNIT_BYTES = HG_SSQ + 1024;
DI bf16x8 lds_ld2x8(const LAS unsigned char* p) {
    const s16x4 lo = *(const LAS s16x4*)p, hi4 = *(const LAS s16x4*)(p + 16);
    return __builtin_shufflevector(lo, hi4, 0, 1, 2, 3, 4, 5, 6, 7);
}
template <bool MAIN>
DI void hgrn_unit(LAS unsigned char* ul, int unit, int u, const bf16_t* __restrict__ HFQG, const bf16_t* __restrict__ IT, const float* __restrict__ lbv, const float* __restrict__ nwv,
                  float* HSTL, float* HSTD, bf16_t* __restrict__ BR) {
    const int lane = u & 63, w = u >> 6, r32 = lane & 31, hi = lane >> 5;
    const int seq = unit / HG_UPS, j = unit % HG_UPS, lb = seq >> 2, h = seq & 3;
    const int dk = u & 127, th = u >> 7;
    const float lbd = lbv[h * 128 + dk];
    const size_t row0 = (size_t)lb * S + (size_t)j * (64 * HG_SCH);
    LAS unsigned char* Kp = ul + HG_KP; LAS unsigned char* Qp = ul + HG_QP; LAS unsigned char* Qpp = ul + HG_QPP; LAS unsigned char* KppT = ul + HG_KPPT;
    LAS float* dec = (LAS float*)(ul + HG_DEC); LAS float* ssq = (LAS float*)(ul + HG_SSQ);
    f32x16 X[4];
#pragma unroll
    for (int t = 0; t < 4; ++t)
#pragma unroll
        for (int i = 0; i < 16; ++i) X[t][i] = 0.f;
    if (MAIN) {
        for (int jp = 0; jp < j; ++jp) {
            const float* L = HSTL + (size_t)(seq * HG_UPS + jp) * 16384 + 32 * w + r32; const float* Dp = HSTD + (size_t)(seq * HG_UPS + jp) * 128;
#pragma unroll
            for (int t = 0; t < 4; ++t)
#pragma unroll
                for (int i = 0; i < 16; ++i) { const int d = 32 * t + crow(i, hi); X[t][i] = X[t][i] * Dp[d] + L[(size_t)d * 128]; }
        }
    }
    float atot = 0.f;
    const bf16_t* itrow = IT + (size_t)(h * 128 + 32 * w + r32) * MP;
#pragma unroll 1
    for (int ch = 0; ch < HG_SCH; ++ch) {
        const size_t rc = row0 + (size_t)ch * 64;
        {
            const bf16_t* fp = HFQG + rc * 1536 + h * 128 + dk;
            float amid = 0.f, alast = 0.f;
#pragma unroll 1
            for (int c8 = 0; c8 < 8; ++c8) {
                float fr[8];
#pragma unroll
                for (int e = 0; e < 8; ++e) fr[e] = bf2f(fp[(size_t)(8 * c8 + e) * 1536]);
#pragma unroll
                for (int e = 0; e < 8; ++e) alast += __builtin_amdgcn_logf(lbd + (1.f - lbd) * fast_sigmoid(fr[e]));
                if (c8 == 3) amid = alast;
            }
            atot += alast;
            float run = 0.f;
            if (th == 0) {
#pragma unroll 1
                for (int c8 = 0; c8 < 8; ++c8) {
                    float fr[8], kt[8];
#pragma unroll
                    for (int e = 0; e < 8; ++e) fr[e] = bf2f(fp[(size_t)(8 * c8 + e) * 1536]);
#pragma unroll
                    for (int e = 0; e < 8; ++e) { const int c = 8 * c8 + e; const float f = lbd + (1.f - lbd) * fast_sigmoid(fr[e]); run += __builtin_amdgcn_logf(f); const float key = 1.f - f;
                        kt[e] = key * __builtin_amdgcn_exp2f(alast - run);
                        if (MAIN) *(LAS bf16_t*)(Kp + (c * HG_ROW + dk) * 2) = f2bf(key * __builtin_amdgcn_exp2f(amid - run)); }
                    u32x4 wv; wv.x = cvtpk(kt[0], kt[1]); wv.y = cvtpk(kt[2], kt[3]); wv.z = cvtpk(kt[4], kt[5]); wv.w = cvtpk(kt[6], kt[7]);
                    *(LAS u32x4*)(KppT + (dk * HG_KT_ROW + 8 * c8) * 2) = wv;
                }
                dec[dk] = __builtin_amdgcn_exp2f(alast);
            } else if (MAIN) {
                const bf16_t* qp = HFQG + rc * 1536 + 512 + h * 128 + dk;
#pragma unroll 1
                for (int c8 = 0; c8 < 8; ++c8) {
                    float fr[8], qv[8];
#pragma unroll
                    for (int e = 0; e < 8; ++e) { fr[e] = bf2f(fp[(size_t)(8 * c8 + e) * 1536]); qv[e] = bf2f(qp[(size_t)(8 * c8 + e) * 1536]); }
#pragma unroll
                    for (int e = 0; e < 8; ++e) { const int c = 8 * c8 + e; run += __builtin_amdgcn_logf(lbd + (1.f - lbd) * fast_sigmoid(fr[e]));
                        *(LAS bf16_t*)(Qp + (c * HG_ROW + dk) * 2) = f2bf(qv[e] * __builtin_amdgcn_exp2f(run - amid));
                        *(LAS bf16_t*)(Qpp + (c * HG_ROW + dk) * 2) = f2bf(qv[e] * __builtin_amdgcn_exp2f(run)); }
                }
            }
        }
        __syncthreads();
        f32x16 o[2];
        if (MAIN) {
            f32x16 sc00, sc01, sc11;
#pragma unroll
            for (int i = 0; i < 16; ++i) { sc00[i] = 0.f; sc01[i] = 0.f; sc11[i] = 0.f; o[0][i] = 0.f; o[1][i] = 0.f; }
#pragma unroll
            for (int ks = 0; ks < 8; ++ks) {
                const int co = (16 * ks + 8 * hi) * 2;
                const bf16x8 k0 = *(const LAS bf16x8*)(Kp + (r32 * HG_ROW) * 2 + co), k1 = *(const LAS bf16x8*)(Kp + ((32 + r32) * HG_ROW) * 2 + co);
                const bf16x8 q0 = *(const LAS bf16x8*)(Qp + (r32 * HG_ROW) * 2 + co), q1 = *(const LAS bf16x8*)(Qp + ((32 + r32) * HG_ROW) * 2 + co);
                sc00 = MFMA32(k0, q0, sc00); sc01 = MFMA32(k0, q1, sc01); sc11 = MFMA32(k1, q1, sc11);
                if (ks & 1) __builtin_amdgcn_sched_barrier(0);
            }
#pragma unroll
            for (int i = 0; i < 16; ++i) { const bool keep = crow(i, hi) <= r32; sc00[i] = keep ? sc00[i] : 0.f; sc11[i] = keep ? sc11[i] : 0.f; }
#pragma unroll
            for (int step = 0; step < 2; ++step) {
                const bf16x8 i0 = ldvt(itrow + rc + 16 * step + 4 * hi), i1 = ldvt(itrow + rc + 32 + 16 * step + 4 * hi);
                o[0] = MFMA32(i0, pack8(sc00, step), o[0]);
                o[1] = MFMA32(i0, pack8(sc01, step), o[1]);
                o[1] = MFMA32(i1, pack8(sc11, step), o[1]);
                __builtin_amdgcn_sched_barrier(0);
            }
#pragma unroll
            for (int t = 0; t < 4; ++t)
#pragma unroll
                for (int step = 0; step < 2; ++step) {
                    const bf16x8 xa = pack8(X[t], step); const int co = (32 * t + 16 * step + 4 * hi) * 2;
                    const bf16x8 b0 = lds_ld2x8(Qpp + (r32 * HG_ROW) * 2 + co), b1 = lds_ld2x8(Qpp + ((32 + r32) * HG_ROW) * 2 + co);
                    o[0] = MFMA32(xa, b0, o[0]); o[1] = MFMA32(xa, b1, o[1]);
                    __builtin_amdgcn_sched_barrier(0);
                }
        }
        {
            bf16x8 ib[4];
#pragma unroll
            for (int ks = 0; ks < 4; ++ks) ib[ks] = *(const bf16x8*)(itrow + rc + 16 * ks + 8 * hi);
#pragma unroll
            for (int t = 0; t < 4; ++t) {
#pragma unroll
                for (int i = 0; i < 16; ++i) X[t][i] *= dec[32 * t + crow(i, hi)];
#pragma unroll
                for (int ks = 0; ks < 4; ++ks) { const bf16x8 ka = *(const LAS bf16x8*)(KppT + ((32 * t + r32) * HG_KT_ROW + 16 * ks + 8 * hi) * 2); X[t] = MFMA32(ka, ib[ks], X[t]); }
                __builtin_amdgcn_sched_barrier(0);
            }
        }
        if (MAIN) {
#pragma unroll
            for (int ct = 0; ct < 2; ++ct) { float q2 = 0.f;
#pragma unroll
                for (int i = 0; i < 16; ++i) q2 += o[ct][i] * o[ct][i];
                q2 += xor32f(q2); if (hi == 0) ssq[w * 64 + 32 * ct + r32] = q2; }
        }
        __syncthreads();
        if (MAIN) {
#pragma unroll
            for (int ct = 0; ct < 2; ++ct) {
                const int c = 32 * ct + r32; const float tot = ssq[c] + ssq[64 + c] + ssq[128 + c] + ssq[192 + c];
                const float rs = rsqrtf(tot * (1.f / 128.f) + LN_EPS);
                const size_t row = rc + c; const int col = h * 128 + 32 * w + 4 * hi;
#pragma unroll
                for (int a4 = 0; a4 < 4; ++a4) {
                    const u32x2 gw = *(const u32x2*)(HFQG + row * 1536 + 1024 + col + 8 * a4); const f32x4 nw4 = *(const f32x4*)(nwv + col + 8 * a4);
                    const float g0 = __uint_as_float(gw.x << 16), g1 = __uint_as_float(gw.x & 0xffff0000u), g2 = __uint_as_float(gw.y << 16), g3 = __uint_as_float(gw.y & 0xffff0000u);
                    const float v0 = o[ct][4 * a4] * rs * nw4[0] * g0 * fast_sigmoid(g0), v1 = o[ct][4 * a4 + 1] * rs * nw4[1] * g1 * fast_sigmoid(g1);
                    const float v2 = o[ct][4 * a4 + 2] * rs * nw4[2] * g2 * fast_sigmoid(g2), v3 = o[ct][4 * a4 + 3] * rs * nw4[3] * g3 * fast_sigmoid(g3);
                    u32x2 wv; wv.x = cvtpk(v0, v1); wv.y = cvtpk(v2, v3);
                    *(u32x2*)(BR + row * 1536 + 512 + col + 8 * a4) = wv;
                }
            }
        }
    }
    if (!MAIN) {
        float* L = HSTL + (size_t)unit * 16384 + 32 * w + r32;
#pragma unroll
        for (int t = 0; t < 4; ++t)
#pragma unroll
            for (int i = 0; i < 16; ++i) L[(size_t)(32 * t + crow(i, hi)) * 128] = X[t][i];
        if (th == 0) HSTD[(size_t)unit * 128 + dk] = __builtin_amdgcn_exp2f(atot);
    }
}

struct SchedRows {
    const char* A; const char* B; int K, nN, nU, G, c;
    DI bool next(int i, g8::Unit& u) const {
        const int L = i * G + c; if (L >= nU) return false;
        const int x = L & 7, off = L >> 3, grp = off / (8 * nN), o2 = off % (8 * nN);
        const int ppx = nU / nN / 8;
        u.pm = x * ppx + 8 * grp + (o2 & 7); u.pn = o2 >> 3; u.kind = 0; u.dlb = 1;
        u.a = A + (size_t)u.pm * 256 * K * 2; u.b = B + (size_t)u.pn * 256 * K * 2; return true;
    }
};
DI void unpack8(const u32x4 w, float (&f)[8]) {
    f[0] = __uint_as_float(w.x << 16); f[1] = __uint_as_float(w.x & 0xffff0000u); f[2] = __uint_as_float(w.y << 16); f[3] = __uint_as_float(w.y & 0xffff0000u);
    f[4] = __uint_as_float(w.z << 16); f[5] = __uint_as_float(w.z & 0xffff0000u); f[6] = __uint_as_float(w.w << 16); f[7] = __uint_as_float(w.w & 0xffff0000u);
}
struct EpiWidenF {
    static constexpr bool PERM = true, HOOK = true;
    const bf16_t* GATE; bf16_t* MERGED;
    DI void hook(f32x4 (&acc)[2][2][4][2], const g8::Unit& u, int t, int wr, int wc, int fr, int fq) const {
        if (t != 8 && t != 16) return;
        const int g = (t >> 3) - 1;
        const int row0 = u.pm * 256 + wr * 64 + fr, col0 = u.pn * 256 + wc * 32 + 8 * fq;
#pragma unroll
        for (int ai = 0; ai < 2; ++ai)
#pragma unroll
            for (int m = 0; m < 4; ++m) { const bf16_t* gp = GATE + (size_t)(row0 + ai * 128 + m * 16) * 3072 + g * 1024 + col0;
#pragma unroll
                for (int bj = 0; bj < 2; ++bj) { float ga[8], gb[8]; unpack8(*(const u32x4*)(gp + bj * 128), ga); unpack8(*(const u32x4*)(gp + 1024 + bj * 128), gb);
#pragma unroll
                    for (int e = 0; e < 4; ++e) { acc[ai][bj][m][0][e] *= ga[e] * __builtin_amdgcn_rcpf(gb[e]); acc[ai][bj][m][1][e] *= ga[4 + e] * __builtin_amdgcn_rcpf(gb[4 + e]); } } }
    }
    DI void operator()(const f32x4 (&acc)[2][2][4][2], const g8::Unit& u, int wr, int wc, int fr, int fq) const {
        const int row0 = u.pm * 256 + wr * 64 + fr, col0 = u.pn * 256 + wc * 32 + 8 * fq;
#pragma unroll
        for (int ai = 0; ai < 2; ++ai)
#pragma unroll
            for (int m = 0; m < 4; ++m) { const size_t row = (size_t)(row0 + ai * 128 + m * 16);
#pragma unroll
                for (int bj = 0; bj < 2; ++bj) { float gc[8]; unpack8(*(const u32x4*)(GATE + row * 3072 + 2048 + col0 + bj * 128), gc);
                    const f32x4 v0 = acc[ai][bj][m][0], v1 = acc[ai][bj][m][1];
                    u32x4 w; w.x = cvtpk(v0[0] * gc[0], v0[1] * gc[1]); w.y = cvtpk(v0[2] * gc[2], v0[3] * gc[3]); w.z = cvtpk(v1[0] * gc[4], v1[1] * gc[5]); w.w = cvtpk(v1[2] * gc[6], v1[3] * gc[7]);
                    *(u32x4*)(MERGED + row * 1024 + col0 + bj * 128) = w; } }
    }
};
struct EpiMixF32 {
    static constexpr bool PERM = false, HOOK = false;
    float* C;
    DI void hook(f32x4 (&)[2][2][4][2], const g8::Unit&, int, int, int, int, int) const {}
    DI void operator()(const f32x4 (&acc)[2][2][4][2], const g8::Unit& u, int wr, int wc, int fr, int fq) const {
        const int col0 = u.pn * 256 + wc * 32 + 4 * fq;
#pragma unroll
        for (int ai = 0; ai < 2; ++ai)
#pragma unroll
            for (int m = 0; m < 4; ++m) { float* rp = C + (size_t)(u.pm * 256 + ai * 128 + wr * 64 + m * 16 + fr) * 1024 + col0;
#pragma unroll
                for (int bj = 0; bj < 2; ++bj)
#pragma unroll
                    for (int n = 0; n < 2; ++n) *(f32x4*)(rp + bj * 128 + n * 16) = acc[ai][bj][m][n]; }
    }
};
struct EpiPlainB16 {
    static constexpr bool PERM = true, HOOK = false;
    bf16_t* C; int ldc, pad;
    DI void hook(f32x4 (&)[2][2][4][2], const g8::Unit&, int, int, int, int, int) const {}
    DI void operator()(const f32x4 (&acc)[2][2][4][2], const g8::Unit& u, int wr, int wc, int fr, int fq) const {
        const int row0 = u.pm * 256 + wr * 64 + fr, col0 = u.pn * 256 + wc * 32 + 8 * fq;
#pragma unroll
        for (int ai = 0; ai < 2; ++ai)
#pragma unroll
            for (int m = 0; m < 4; ++m) { bf16_t* rowp = C + (size_t)(row0 + ai * 128 + m * 16) * ldc + col0;
#pragma unroll
                for (int bj = 0; bj < 2; ++bj) { const f32x4 v0 = acc[ai][bj][m][0], v1 = acc[ai][bj][m][1];
                    u32x4 w; w.x = cvtpk(v0[0], v0[1]); w.y = cvtpk(v0[2], v0[3]); w.z = cvtpk(v1[0], v1[1]); w.w = cvtpk(v1[2], v1[3]);
                    *(u32x4*)(rowp + bj * 128) = w; } }
    }
};
DI void lse_merge_items(const bf16_t* __restrict__ OG, const float* __restrict__ LSE, bf16_t* __restrict__ BR, int first, int stride) {
    for (int it = first; it < MP * 64; it += stride) {
        const int row = it >> 6, c8 = it & 63, h = c8 >> 4;
        const float l0 = LSE[(size_t)row * 12 + h], l1 = LSE[(size_t)row * 12 + 4 + h], l2 = LSE[(size_t)row * 12 + 8 + h];
        const float mx = fmaxf(l0, fmaxf(l1, l2)); const float e0 = __expf(l0 - mx), e1 = __expf(l1 - mx), e2 = __expf(l2 - mx); const float inv = 1.f / (e0 + e1 + e2);
        const bf16_t* og = OG + (size_t)row * 1536 + c8 * 8;
        float a[8], b[8], c[8]; unpack8(*(const u32x4*)og, a); unpack8(*(const u32x4*)(og + 512), b); unpack8(*(const u32x4*)(og + 1024), c);
        float r[8];
#pragma unroll
        for (int e = 0; e < 8; ++e) r[e] = (e0 * a[e] + e1 * b[e] + e2 * c[e]) * inv;
        u32x4 w; w.x = cvtpk(r[0], r[1]); w.y = cvtpk(r[2], r[3]); w.z = cvtpk(r[4], r[5]); w.w = cvtpk(r[6], r[7]);
        *(u32x4*)(BR + (size_t)row * 1536 + c8 * 8) = w;
    }
}
DI void ln1_rows(const float* __restrict__ x, const float* __restrict__ mix, const float* __restrict__ g, const float* __restrict__ b, float* __restrict__ h1f, bf16_t* __restrict__ h1b, int wave0, int nwaves, int lane) {
    for (int row = wave0; row < MP; row += nwaves) {
        const f32x4* xr = (const f32x4*)(x + (size_t)row * D) + lane; const f32x4* mr = (const f32x4*)(mix + (size_t)row * D) + lane;
        f32x4 v[4]; float s = 0.f;
#pragma unroll
        for (int j = 0; j < 4; ++j) { v[j] = xr[64 * j] * ALPHA + mr[64 * j]; s += (v[j][0] + v[j][1]) + (v[j][2] + v[j][3]); }
        const float mean = wave_sum(s) * (1.f / D); float q = 0.f;
#pragma unroll
        for (int j = 0; j < 4; ++j) { v[j] = v[j] - mean; q += (v[j][0] * v[j][0] + v[j][1] * v[j][1]) + (v[j][2] * v[j][2] + v[j][3] * v[j][3]); }
        const float rstd = rsqrtf(wave_sum(q) * (1.f / D) + LN_EPS);
#pragma unroll
        for (int j = 0; j < 4; ++j) { const f32x4 gg = ((const f32x4*)g)[lane + 64 * j], bb = ((const f32x4*)b)[lane + 64 * j]; const f32x4 o = v[j] * rstd * gg + bb;
            ((f32x4*)(h1f + (size_t)row * D))[lane + 64 * j] = o; u32x2 w; w.x = cvtpk(o[0], o[1]); w.y = cvtpk(o[2], o[3]); ((u32x2*)(h1b + (size_t)row * D))[lane + 64 * j] = w; }
    }
}

DI unsigned mono(float f) { const unsigned u = __float_as_uint(f); return (u & 0x80000000u) ? ~u : (u | 0x80000000u); }
DI float demono(unsigned m) { return __uint_as_float((m & 0x80000000u) ? (m & 0x7fffffffu) : ~m); }
#define CE_DESC(a, b) do { const unsigned _hi = (a) > (b) ? (a) : (b), _lo = (a) > (b) ? (b) : (a); (a) = _hi; (b) = _lo; } while (0)
DI void sort16_desc(unsigned (&k)[16]) {
#pragma unroll
    for (int size = 2; size <= 16; size <<= 1)
#pragma unroll
        for (int stride = size >> 1; stride > 0; stride >>= 1)
#pragma unroll
            for (int i = 0; i < 16; ++i) { const int j = i ^ stride;
                if (j > i) { if ((i & size) == 0 || size == 16) CE_DESC(k[i], k[j]); else CE_DESC(k[j], k[i]); } }
}
DI void merge_top16(unsigned (&t)[16], const unsigned (&l)[16]) {
#pragma unroll
    for (int i = 0; i < 16; ++i) t[i] = t[i] > l[15 - i] ? t[i] : l[15 - i];
#pragma unroll
    for (int stride = 8; stride > 0; stride >>= 1)
#pragma unroll
        for (int i = 0; i < 16; ++i) { const int j = i ^ stride; if (j > i) CE_DESC(t[i], t[j]); }
}
constexpr int RT_ROW = 136;
constexpr int RT_LDS_BYTES = 2 * 128 * RT_ROW * 2;
DI void route_wave(const bf16_t* __restrict__ PQ, const LAS unsigned char* keys, int* __restrict__ IDX, float* __restrict__ PG, int tb, int h, int lane) {
    const int r32 = lane & 31, hi = lane >> 5;
    const size_t tok = (size_t)tb * 32 + r32;
    unsigned Tp[2][16];
#pragma unroll
    for (int p = 0; p < 2; ++p) {
        bf16x8 qf[8];
        const bf16_t* qp = PQ + tok * 2048 + h * 256 + p * 128 + 8 * hi;
#pragma unroll
        for (int ks = 0; ks < 8; ++ks) qf[ks] = *(const bf16x8*)(qp + 16 * ks);
#pragma unroll
        for (int nt = 0; nt < 4; ++nt) {
            f32x16 acc;
#pragma unroll
            for (int i = 0; i < 16; ++i) acc[i] = 0.f;
#pragma unroll
            for (int ks = 0; ks < 8; ++ks) { const bf16x8 kf = *(const LAS bf16x8*)(keys + ((p * 128 + 32 * nt + r32) * RT_ROW + 16 * ks + 8 * hi) * 2); acc = MFMA32(kf, qf[ks], acc); }
            unsigned L[16];
#pragma unroll
            for (int i = 0; i < 16; ++i) L[i] = (mono(acc[i]) & ~0x7fu) | (unsigned)(127 - (32 * nt + crow(i, hi)));
            sort16_desc(L);
            if (nt == 0) {
#pragma unroll
                for (int i = 0; i < 16; ++i) Tp[p][i] = L[i];
            } else merge_top16(Tp[p], L);
            __builtin_amdgcn_sched_barrier(0);
        }
    }
    unsigned T[16];
    { unsigned O[16];
#pragma unroll
      for (int i = 0; i < 16; ++i) { const auto rr = __builtin_amdgcn_permlane32_swap(Tp[0][i], Tp[1][i], false, false); T[i] = rr[0]; O[i] = rr[1]; }
      merge_top16(T, O); }
    __builtin_amdgcn_sched_barrier(0);
    float s1[16], s2[16]; unsigned i1[16], i2[16];
#pragma unroll
    for (int i = 0; i < 16; ++i) { const auto rr = __builtin_amdgcn_permlane32_swap(T[i], T[i], false, false);
        s1[i] = demono(rr[0] & ~0x7fu); i1[i] = 127u - (rr[0] & 0x7fu); s2[i] = demono(rr[1] & ~0x7fu); i2[i] = 127u - (rr[1] & 0x7fu); }
    unsigned C[64];
    { int n = 0;
#pragma unroll
      for (int a = 0; a < 16; ++a)
#pragma unroll
          for (int b = 0; b < 16; ++b) if ((a + 1) * (b + 1) <= 16) { C[n] = (mono(s1[a] + s2[b]) & ~0x3fffu) | (i1[a] << 7) | i2[b]; ++n; }
#pragma unroll
      for (int i = 50; i < 64; ++i) C[i] = 0u; }
    unsigned F[16];
#pragma unroll
    for (int i = 0; i < 16; ++i) F[i] = C[i];
    sort16_desc(F);
#pragma unroll
    for (int g = 1; g < 4; ++g) { unsigned L[16];
#pragma unroll
        for (int i = 0; i < 16; ++i) L[i] = C[16 * g + i];
        sort16_desc(L); merge_top16(F, L); __builtin_amdgcn_sched_barrier(0); }
    if (hi == 0) {
        float e[16]; float sum = 0.f; const float v0 = demono(F[0] & ~0x3fffu);
#pragma unroll
        for (int i = 0; i < 16; ++i) { e[i] = __expf(demono(F[i] & ~0x3fffu) - v0); sum += e[i]; }
        const float inv = 1.f / sum;
        int* ip = IDX + tok * 128 + h * 16; float* gp = PG + tok * 128 + h * 16;
#pragma unroll
        for (int q = 0; q < 4; ++q) { u32x4 iv; iv.x = F[4 * q] & 0x3fffu; iv.y = F[4 * q + 1] & 0x3fffu; iv.z = F[4 * q + 2] & 0x3fffu; iv.w = F[4 * q + 3] & 0x3fffu; *(u32x4*)(ip + 4 * q) = iv;
            f32x4 gv; gv[0] = e[4 * q] * inv; gv[1] = e[4 * q + 1] * inv; gv[2] = e[4 * q + 2] * inv; gv[3] = e[4 * q + 3] * inv; *(f32x4*)(gp + 4 * q) = gv; }
    }
}
typedef __bf16 bf16x2v __attribute__((ext_vector_type(2)));
DI float dot2bf(unsigned w, unsigned x, float acc) { return __builtin_amdgcn_fdot2_f32_bf16(__builtin_bit_cast(bf16x2v, w), __builtin_bit_cast(bf16x2v, x), acc, false); }
DI float gelu_erf(float v) {
    const float av = fabsf(v), t = __builtin_amdgcn_rcpf(av * 0.2316418882f + 1.0f);
    float q = t * 0.5307027145f + (-0.7265760135f); q = q * t + 0.7107068705f; q = q * t + (-0.142248368f); q = q * t + 0.127414796f; q = q * t;
    const float e = __builtin_amdgcn_exp2f((v * v) * (-0.72134752044f)); const float m = v * (q * e);
    return v < 0.f ? m : v - m;
}
DI void experts_token(const bf16_t* __restrict__ H1B, const bf16_t* __restrict__ UB, const bf16_t* __restrict__ VB, const int* __restrict__ IDX, const float* __restrict__ PG,
                      const float* __restrict__ g2, const float* __restrict__ b2, float* outp, size_t tok, int lane) {
    const u32x4 hb0 = *(const u32x4*)(H1B + tok * D + 8 * lane), hb1 = *(const u32x4*)(H1B + tok * D + 512 + 8 * lane);
    const int ilo = IDX[tok * 128 + lane], ihi = IDX[tok * 128 + 64 + lane];
    float clo, chi;
#pragma unroll
    for (int half = 0; half < 2; ++half) {
        float p[64];
#pragma unroll
        for (int e = 0; e < 64; ++e) {
            const int row = __builtin_amdgcn_readlane(half ? ihi : ilo, e);
            const u32x4* up = (const u32x4*)(UB + (size_t)row * D);
            const u32x4 w0 = up[lane], w1 = up[64 + lane];
            float d = dot2bf(w0.x, hb0.x, 0.f); d = dot2bf(w0.y, hb0.y, d); d = dot2bf(w0.z, hb0.z, d); d = dot2bf(w0.w, hb0.w, d);
            d = dot2bf(w1.x, hb1.x, d); d = dot2bf(w1.y, hb1.y, d); d = dot2bf(w1.z, hb1.z, d); d = dot2bf(w1.w, hb1.w, d);
            p[e] = d;
        }
#pragma unroll
        for (int i = 0; i < 32; ++i) { const auto rr = __builtin_amdgcn_permlane32_swap(__float_as_uint(p[i]), __float_as_uint(p[i + 32]), false, false); p[i] = __uint_as_float(rr[0]) + __uint_as_float(rr[1]); }
#pragma unroll
        for (int m = 16; m >= 1; m >>= 1) {
            const bool up = (lane & m) != 0;
#pragma unroll
            for (int i = 0; i < m; ++i) { const float send = up ? p[i] : p[i + m], keep = up ? p[i + m] : p[i]; p[i] = keep + __shfl_xor(send, m); }
        }
        const float c = PG[tok * 128 + 64 * half + lane] * gelu_erf(p[0]);
        if (half) chi = c; else clo = c;
    }
    float f[16];
#pragma unroll
    for (int i = 0; i < 16; ++i) f[i] = 0.f;
#pragma unroll 4
    for (int e = 0; e < 128; ++e) {
        const int row = __builtin_amdgcn_readlane(e < 64 ? ilo : ihi, e & 63);
        const float c = __builtin_bit_cast(float, __builtin_amdgcn_readlane(__builtin_bit_cast(int, e < 64 ? clo : chi), e & 63));
        const u32x4* vp = (const u32x4*)(VB + (size_t)row * D);
        const u32x4 w0 = vp[lane], w1 = vp[64 + lane];
#pragma unroll
        for (int q = 0; q < 4; ++q) { f[2 * q] += c * __uint_as_float(w0[q] << 16); f[2 * q + 1] += c * __uint_as_float(w0[q] & 0xffff0000u);
            f[8 + 2 * q] += c * __uint_as_float(w1[q] << 16); f[8 + 2 * q + 1] += c * __uint_as_float(w1[q] & 0xffff0000u); }
    }
    float* hr = outp + tok * D;
    f32x4 v[4]; v[0] = *(const f32x4*)(hr + 8 * lane); v[1] = *(const f32x4*)(hr + 8 * lane + 4); v[2] = *(const f32x4*)(hr + 512 + 8 * lane); v[3] = *(const f32x4*)(hr + 512 + 8 * lane + 4);
    float s = 0.f;
#pragma unroll
    for (int j = 0; j < 4; ++j)
#pragma unroll
        for (int e = 0; e < 4; ++e) { v[j][e] = v[j][e] * ALPHA + f[4 * j + e]; s += v[j][e]; }
    const float mean = wave_sum(s) * (1.f / D); float q2 = 0.f;
#pragma unroll
    for (int j = 0; j < 4; ++j)
#pragma unroll
        for (int e = 0; e < 4; ++e) { v[j][e] -= mean; q2 += v[j][e] * v[j][e]; }
    const float rstd = rsqrtf(wave_sum(q2) * (1.f / D) + LN_EPS);
#pragma unroll
    for (int j = 0; j < 4; ++j) { const int c0 = (j >> 1) * 512 + 8 * lane + 4 * (j & 1); const f32x4 gg = *(const f32x4*)(g2 + c0), bb = *(const f32x4*)(b2 + c0); *(f32x4*)(hr + c0) = v[j] * rstd * gg + bb; }
}

DI void p0_convert(const float* __restrict__ in, bf16_t* __restrict__ out, size_t n8, size_t first, size_t stride) {
    for (size_t i = first; i < n8; i += stride) { const f32x4 a = ((const f32x4*)in)[2 * i], b = ((const f32x4*)in)[2 * i + 1];
        u32x4 w; w.x = cvtpk(a[0], a[1]); w.y = cvtpk(a[2], a[3]); w.z = cvtpk(b[0], b[1]); w.w = cvtpk(b[2], b[3]); ((u32x4*)out)[i] = w; }
}
DI void p0_transpose_item(const float* __restrict__ W, int ldw, int ncols, bf16_t* __restrict__ out, int ldo, int koff, LAS float* scr, int item, int lane) {
    const int nblk = ncols / 32, kb = item / nblk, nb = item % nblk, k0 = 64 * kb, n0 = 32 * nb;
#pragma unroll 8
    for (int i = 0; i < 32; ++i) { const int kk = 2 * i + (lane >> 5); scr[kk * 33 + (lane & 31)] = W[(size_t)(k0 + kk) * ldw + n0 + (lane & 31)]; }
    asm volatile("s_waitcnt lgkmcnt(0)" ::: "memory");
    const int c = lane & 7;
#pragma unroll
    for (int j = 0; j < 4; ++j) { const int n = (lane >> 3) + 8 * j; const LAS float* s = scr + (8 * c) * 33 + n;
        u32x4 o; o.x = cvtpk(s[0 * 33], s[1 * 33]); o.y = cvtpk(s[2 * 33], s[3 * 33]); o.z = cvtpk(s[4 * 33], s[5 * 33]); o.w = cvtpk(s[6 * 33], s[7 * 33]);
        *(u32x4*)(out + (size_t)(n0 + n) * ldo + koff + k0 + 8 * c) = o; }
    asm volatile("s_waitcnt lgkmcnt(0)" ::: "memory");
}
DI void p0_misc(const float* __restrict__ hgrn_lb, const float* __restrict__ rel_bias, float* __restrict__ misc, int i) {
    if (i < 512) { const float a = hgrn_lb[i], b = hgrn_lb[512 + i]; const float mx = fmaxf(a, b); const float ea = expf(a - mx), eb = expf(b - mx); misc[i] = ea / (ea + eb); }
    if (i < 3 * 129) {
        const int g = i / 129, j = i % 129; const int dl = g == 0 ? 1 : (g == 1 ? 4 : 16); const int n = j * dl;
        int bucket;
        if (n < 16) bucket = n;
        else { const double v = log((double)n / 16.0) / log(128.0) * 16.0; int l = 16 + (int)v; bucket = l < 31 ? l : 31; }
        for (int h = 0; h < 4; ++h) misc[512 + i * 4 + h] = rel_bias[bucket * 12 + g * 4 + h];
    }
}
struct SchedMemKV {
    const char* MEMB; const char* W; int G, c;
    DI bool next(int i, g8::Unit& u) const {
        const int L = i * G + c; if (L >= 32) return false;
        u.dlb = 1;
        if (L < 16) { u.kind = 0; u.pm = L >> 1; u.pn = L & 1; u.a = MEMB + (size_t)u.pm * 256 * D * 2; u.b = W + (size_t)u.pn * 256 * D * 2; }
        else { const int q = L - 16; u.kind = 1; u.pm = q >> 3; u.pn = q & 7; u.a = W + (size_t)(512 + u.pm * 256) * D * 2; u.b = MEMB + (size_t)u.pn * 256 * D * 2; }
        return true;
    }
};
struct EpiMemKVF {
    static constexpr bool PERM = true, HOOK = false;
    bf16_t *MK, *MVT;
    DI void hook(f32x4 (&)[2][2][4][2], const g8::Unit&, int, int, int, int, int) const {}
    DI void operator()(const f32x4 (&acc)[2][2][4][2], const g8::Unit& u, int wr, int wc, int fr, int fq) const {
        bf16_t* base = u.kind ? MVT : MK; const int ldc = u.kind ? 2048 : 512;
        const int row0 = u.pm * 256 + wr * 64 + fr, col0 = u.pn * 256 + wc * 32 + 8 * fq;
#pragma unroll
        for (int ai = 0; ai < 2; ++ai)
#pragma unroll
            for (int m = 0; m < 4; ++m) { bf16_t* rowp = base + (size_t)(row0 + ai * 128 + m * 16) * ldc + col0;
#pragma unroll
                for (int bj = 0; bj < 2; ++bj) { const f32x4 v0 = acc[ai][bj][m][0], v1 = acc[ai][bj][m][1];
                    u32x4 w; w.x = cvtpk(v0[0], v0[1]); w.y = cvtpk(v0[2], v0[3]); w.z = cvtpk(v1[0], v1[1]); w.w = cvtpk(v1[2], v1[3]);
                    *(u32x4*)(rowp + bj * 128) = w; } }
    }
};

static_assert(2 * HG_UNIT_BYTES <= LDSCTL_OFF, "hgrn LDS");
__global__ void __launch_bounds__(NTHR, 2) mega(Args args) {
    extern __shared__ __attribute__((aligned(16))) unsigned char lds_raw[];
    LAS unsigned char* lds = (LAS unsigned char*)lds_raw;
    volatile LAS unsigned* MISC = (volatile LAS unsigned*)(lds + MISC_OFF);
    for (int u = threadIdx.x; u < (LDS_BYTES - LDSCTL_OFF) / 4; u += NTHR) ((LAS unsigned*)(lds + LDSCTL_OFF))[u] = 0u;
    __syncthreads();
    unsigned char* ws = args.ws;
    const int G = gridDim.x;
    const bool ALL = args.ph == PH_ALL;
    XcdBarrier bar; bar.bar = (unsigned*)(ws + O_MISC + 16384); bar.x = 0; bar.st = nullptr;
    if (ALL) bar = xcd_barrier_post((unsigned*)(ws + O_MISC + 16384), MISC + 8);
#define RUN(k) (ALL || args.ph == (k))
#define SEAM() do { if (ALL) xcd_barrier(bar); } while (0)
    if (RUN(PH_PRO)) {
        int tid = threadIdx.x; asm volatile("" : "+v"(tid)); asm volatile("" : "+s"(ws));
        const size_t gt = (size_t)blockIdx.x * NTHR + tid, nth = (size_t)G * NTHR;
        p0_convert(args.in[0], (bf16_t*)(ws + O_XB), (size_t)M * D / 8, gt, nth);
        p0_convert(args.in[1], (bf16_t*)(ws + O_MEMB), (size_t)2048 * 1024 / 8, gt, nth);
        p0_convert(args.in[13], (bf16_t*)(ws + O_SUBK), (size_t)16 * 128 * 128 / 8, gt, nth);
        p0_convert(args.in[14], (bf16_t*)(ws + O_UB), (size_t)NEXP * D / 8, gt, nth);
        p0_convert(args.in[15], (bf16_t*)(ws + O_VB), (size_t)NEXP * D / 8, gt, nth);
        if (blockIdx.x == 0) p0_misc(args.in[6], args.in[5], (float*)(ws + O_MISC), tid);
        const int wid = __builtin_amdgcn_readfirstlane(tid >> 6), lane = tid & 63;
        LAS float* scr = (LAS float*)(lds + wid * 16384);
        const int gw = blockIdx.x * NWAVES + wid, ngw = G * NWAVES;
        constexpr int NJ = 13;
        for (int it = gw; ; it += ngw) {
            int r = it; bool done = true;
#pragma unroll
            for (int j = 0; j < NJ; ++j) {
                const int srcc[NJ] = {0, 4608, 5632, 6656, 7168, 3072, 5120, 0, 0, 0, 0, 0, 0};
                const int cnt[NJ] = {3072, 512, 1024, 512, 3072, 1536, 512, 1024, 1024, 1024, 1024, 1024, 2048};
                const int drow[NJ] = {0, 3072, 3584, 4608, 5120, 8192, 9728, 0, 0, 0, 0, 0, 0};
                const int Kj = (j >= 8 && j <= 10) ? 512 : 1024;
                const int items = (Kj / 64) * (cnt[j] / 32);
                if (done && r < items) {
                    const float* W; int ldw; bf16_t* o; int ldo, koff = 0;
                    if (j < 7) { W = args.in[2] + srcc[j]; ldw = INC; o = (bf16_t*)(ws + O_WIN) + (size_t)drow[j] * 1024; ldo = 1024; }
                    else if (j == 7) { W = args.in[4]; ldw = 1024; o = (bf16_t*)(ws + O_WMKV); ldo = 1024; }
                    else if (j <= 10) { W = args.in[8] + (size_t)(j - 8) * 512 * 1024; ldw = 1024; o = (bf16_t*)(ws + O_WBR); ldo = 1536; koff = (j - 8) * 512; }
                    else if (j == 11) { W = args.in[9]; ldw = 1024; o = (bf16_t*)(ws + O_WOUT); ldo = 1024; }
                    else { W = args.in[12]; ldw = 2048; o = (bf16_t*)(ws + O_WPQ); ldo = 1024; }
                    p0_transpose_item(W, ldw, cnt[j], o, ldo, koff, scr, r, lane); done = false;
                }
                r -= items;
            }
            if (done) break;
        }
        SEAM();
    }
#pragma unroll 1
    for (int p = (ALL ? 0 : args.pass); p < (ALL ? NPASS : args.pass + 1); ++p) {
        int tid = threadIdx.x; asm volatile("" : "+v"(tid));
        asm volatile("" : "+s"(ws));
        char* pr = (char*)ws + O_PASS;
        const size_t t0 = (size_t)p * MP;
        if (RUN(PH_PROJ)) {
            SchedP1 Sc{(const char*)(ws + O_XB) + t0 * D * 2, (const char*)(ws + O_WIN), G, (int)blockIdx.x};
            EpiP1 E{(bf16_t*)(pr + P_QK), (bf16_t*)(pr + P_HFQG), (bf16_t*)(pr + P_MQ), (bf16_t*)(pr + P_GATE), (bf16_t*)(pr + P_VT), args.in[3]};
            g8::gemm_phase<EpiP1, SchedP1>(lds, D, Sc, E, tid);
            if (p == 0) {
                SchedMemKV S2{(const char*)(ws + O_MEMB), (const char*)(ws + O_WMKV), G, (int)blockIdx.x};
                EpiMemKVF E2{(bf16_t*)(ws + O_MK), (bf16_t*)(ws + O_MVT)};
                g8::gemm_phase<EpiMemKVF, SchedMemKV>(lds, D, S2, E2, tid);
            }
            SEAM();
        }
        if (RUN(PH_ATTN)) {
            const float* bsrc = (const float*)(ws + O_MISC) + 512; LAS float* btab = (LAS float*)lds;
            for (int i = tid; i < 3 * 129 * 4; i += NTHR) btab[i] = bsrc[i] * LOG2E;
            __syncthreads();
            const int wid = __builtin_amdgcn_readfirstlane(tid >> 6), lane = tid & 63;
            for (int task = blockIdx.x * NWAVES + wid; task < DIL_TASKS; task += G * NWAVES)
                attn_dil_wave((const bf16_t*)(pr + P_QK), (const bf16_t*)(pr + P_VT), btab, (bf16_t*)(pr + P_OG), (float*)(pr + P_LSE), task, lane);
            for (int task = blockIdx.x * NWAVES + wid; task < MEM_TASKS; task += G * NWAVES)
                attn_mem_wave((const bf16_t*)(pr + P_MQ), (const bf16_t*)(ws + O_MK), (const bf16_t*)(ws + O_MVT), (bf16_t*)(pr + P_BR), task, p * BPP, lane);
            __syncthreads();
        }
        if (RUN(PH_HGPRE)) {
            const int unit = blockIdx.x * 2 + (tid >> 8);
            if ((int)blockIdx.x * 2 < HG_UNITS)
                hgrn_unit<false>(lds + (tid >> 8) * HG_UNIT_BYTES, unit, tid & 255, (const bf16_t*)(pr + P_HFQG), (const bf16_t*)(pr + P_IT), (const float*)(ws + O_MISC), args.in[7],
                                 (float*)(pr + P_HSTL), (float*)(pr + P_HSTD), (bf16_t*)(pr + P_BR));
            SEAM();
        }
        if (RUN(PH_HGMAIN)) {
            lse_merge_items((const bf16_t*)(pr + P_OG), (const float*)(pr + P_LSE), (bf16_t*)(pr + P_BR), blockIdx.x * NTHR + tid, G * NTHR);
            const int unit = blockIdx.x * 2 + (tid >> 8);
            if ((int)blockIdx.x * 2 < HG_UNITS)
                hgrn_unit<true>(lds + (tid >> 8) * HG_UNIT_BYTES, unit, tid & 255, (const bf16_t*)(pr + P_HFQG), (const bf16_t*)(pr + P_IT), (const float*)(ws + O_MISC), args.in[7],
                                (float*)(pr + P_HSTL), (float*)(pr + P_HSTD), (bf16_t*)(pr + P_BR));
            SEAM();
        }
        if (RUN(PH_WIDEN)) {
            SchedRows Sc{(const char*)(pr + P_BR), (const char*)(ws + O_WBR), 1536, 4, 256, G, (int)blockIdx.x};
            EpiWidenF E{(const bf16_t*)(pr + P_GATE), (bf16_t*)(pr + P_MERGED)};
            g8::gemm_phase<EpiWidenF, SchedRows>(lds, 1536, Sc, E, tid);
            SEAM();
        }
        if (RUN(PH_WOUT)) {
            SchedRows Sc{(const char*)(pr + P_MERGED), (const char*)(ws + O_WOUT), 1024, 4, 256, G, (int)blockIdx.x};
            EpiMixF32 E{(float*)(pr + P_MIX)};
            g8::gemm_phase<EpiMixF32, SchedRows>(lds, 1024, Sc, E, tid);
            SEAM();
        }
        if (RUN(PH_LN1)) {
            ln1_rows(args.in[0] + t0 * D, (const float*)(pr + P_MIX), args.in[10], args.in[11], args.out + t0 * D, (bf16_t*)(ws + O_H1B) + t0 * D, blockIdx.x * NWAVES + (tid >> 6), G * NWAVES, tid & 63);
        }
    }
    if (RUN(PH_PQ)) {
        SEAM();
        int tid = threadIdx.x; asm volatile("" : "+v"(tid)); asm volatile("" : "+s"(ws));
        char* pr = (char*)ws + O_PASS;
        SchedRows Sc{(const char*)(ws + O_H1B), (const char*)(ws + O_WPQ), 1024, 8, 2048, G, (int)blockIdx.x};
        EpiPlainB16 E{(bf16_t*)(pr + P_PQ), 2048, 0};
        g8::gemm_phase<EpiPlainB16, SchedRows>(lds, 1024, Sc, E, tid);
        SEAM();
    }
    if (RUN(PH_ROUTE)) {
        int tid = threadIdx.x; asm volatile("" : "+v"(tid)); asm volatile("" : "+s"(ws));
        char* pr = (char*)ws + O_PASS;
        const int h = blockIdx.x & 7, wgi = blockIdx.x >> 3, nwg = G >> 3;
        const bf16_t* ksrc = (const bf16_t*)(ws + O_SUBK) + (size_t)h * 2 * 128 * 128;
        for (int i = tid; i < 2 * 128 * 16; i += NTHR) { const int rowk = i >> 4, ch = i & 15; *(LAS u32x4*)(lds + (rowk * RT_ROW + ch * 8) * 2) = *(const u32x4*)(ksrc + rowk * 128 + ch * 8); }
        __syncthreads();
        const int wid = __builtin_amdgcn_readfirstlane(tid >> 6), lane = tid & 63;
        for (int tb = wgi * NWAVES + wid; tb < M / 32; tb += nwg * NWAVES)
            route_wave((const bf16_t*)(pr + P_PQ), lds, (int*)(pr + P_IDX), (float*)(pr + P_PG), tb, h, lane);
        __syncthreads();
        SEAM();
    }
    if (RUN(PH_EXPERTS)) {
        int tid = threadIdx.x; asm volatile("" : "+v"(tid)); asm volatile("" : "+s"(ws));
        char* pr = (char*)ws + O_PASS;
        const int wid = __builtin_amdgcn_readfirstlane(tid >> 6), lane = tid & 63;
        for (int tok = blockIdx.x * NWAVES + wid; tok < M; tok += G * NWAVES)
            experts_token((const bf16_t*)(ws + O_H1B), (const bf16_t*)(ws + O_UB), (const bf16_t*)(ws + O_VB), (const int*)(pr + P_IDX), (const float*)(pr + P_PG), args.in[16], args.in[17], args.out, (size_t)tok, lane);
    }
#undef RUN
#undef SEAM
}

extern "C" void kernel_launch(void* const* d_in, const int* in_sizes, int n_in, void* d_out, int out_size, void* d_ws, size_t ws_size, hipStream_t stream) {
    if (ws_size < WS_NEED || n_in != 18) return;
    static bool attr_set = false;
    if (!attr_set) { (void)hipFuncSetAttribute((const void*)mega, hipFuncAttributeMaxDynamicSharedMemorySize, LDS_BYTES); attr_set = true; }
    (void)hipMemsetAsync((char*)d_ws + O_MISC + 16384, 0, 16384, stream);
    Args a{}; for (int i = 0; i < 18; ++i) a.in[i] = (const float*)d_in[i]; a.out = (float*)d_out; a.ws = (unsigned char*)d_ws; a.ph = PH_ALL; a.pass = 0;
    mega<<<256, NTHR, LDS_BYTES, stream>>>(a);
}
```

```cpp
#include <hip/hip_runtime.h>
#include <stdint.h>
#include <math.h>

typedef unsigned short bf16_t;
typedef short bf16x8 __attribute__((ext_vector_type(8)));
typedef float f32x4 __attribute__((ext_vector_type(4)));
#define DI __device__ __forceinline__

DI float bf2f(bf16_t v) { return __uint_as_float(((unsigned)v) << 16); }
DI bf16_t f2bf(float f) { unsigned u = __float_as_uint(f); u += 0x7fffu + ((u >> 16) & 1u); return (bf16_t)(u >> 16); }

constexpr int NB = 8, S = 8192, D = 1024, M = NB * S;
constexpr int NPASS = 4, BPP = NB / NPASS, MP = BPP * S;
constexpr int INC = 10240;
constexpr int NEXP = 16384;
constexpr float ALPHA = 1.189207115002721f;
constexpr float LN_EPS = 1e-5f;
constexpr float QSCALE = 0.08838834764831845f;

constexpr size_t al(size_t x) { return (x + 255) & ~(size_t)255; }
constexpr size_t O_WIN = 0;
constexpr size_t O_WMKV = O_WIN + al((size_t)INC * D * 2);
constexpr size_t O_WBR = O_WMKV + al((size_t)1024 * 1024 * 2);
constexpr size_t O_WOUT = O_WBR + al((size_t)1024 * 1536 * 2);
constexpr size_t O_WPQ = O_WOUT + al((size_t)1024 * 1024 * 2);
constexpr size_t O_SUBK = O_WPQ + al((size_t)2048 * 1024 * 2);
constexpr size_t O_UB = O_SUBK + al((size_t)16 * 128 * 128 * 2);
constexpr size_t O_VB = O_UB + al((size_t)NEXP * D * 2);
constexpr size_t O_XB = O_VB + al((size_t)NEXP * D * 2);
constexpr size_t O_MEMB = O_XB + al((size_t)M * D * 2);
constexpr size_t O_MK = O_MEMB + al((size_t)2048 * 1024 * 2);
constexpr size_t O_MVT = O_MK + al((size_t)2048 * 512 * 2);
constexpr size_t O_H1B = O_MVT + al((size_t)8 * 512 * 256 * 2);
constexpr size_t O_MISC = O_H1B + al((size_t)M * D * 2);
constexpr size_t O_PASS = O_MISC + al(65536);
constexpr size_t P_QK = 0;
constexpr size_t P_VT = P_QK + al((size_t)MP * 3072 * 2);
constexpr size_t P_IT = P_VT + (size_t)1536 * MP * 2;
constexpr size_t P_HFQG = P_IT + al((size_t)512 * MP * 2);
constexpr size_t P_MQ = P_HFQG + al((size_t)MP * 1536 * 2);
constexpr size_t P_GATE = P_MQ + al((size_t)MP * 512 * 2);
constexpr size_t P_OG = P_GATE + al((size_t)MP * 3072 * 2);
constexpr size_t P_LSE = P_OG + al((size_t)MP * 1536 * 2);
constexpr size_t P_BR = P_LSE + al((size_t)MP * 12 * 4);
constexpr size_t P_MERGED = P_BR + al((size_t)MP * 1536 * 2);
constexpr size_t P_MIX = P_MERGED + al((size_t)MP * 1024 * 2);
constexpr size_t P_HSTL = P_MIX + al((size_t)MP * 1024 * 4);
constexpr size_t P_HSTD = P_HSTL + al((size_t)256 * 16384 * 4);
constexpr size_t P_SIN = P_HSTD + al((size_t)256 * 128 * 4);
constexpr size_t P_END = P_SIN + al((size_t)256 * 16384 * 4);
constexpr size_t P_PQ = 0;
constexpr size_t P_IDX = P_PQ + al((size_t)M * 2048 * 2);
constexpr size_t P_PG = P_IDX + al((size_t)M * 128 * 4);
constexpr size_t P_END2 = P_PG + al((size_t)M * 128 * 4);
constexpr size_t WS_NEED = O_PASS + (P_END > P_END2 ? P_END : P_END2);
static_assert(WS_NEED <= (size_t)1073741824, "workspace budget");

__global__ __launch_bounds__(256) void k_convert(const float* __restrict__ in, bf16_t* __restrict__ out, size_t n4) {
    size_t i = (size_t)blockIdx.x * 256 + threadIdx.x; const size_t st = (size_t)gridDim.x * 256;
    for (; i < n4; i += st) { const f32x4 v = ((const f32x4*)in)[i]; ushort4 o; o.x = f2bf(v[0]); o.y = f2bf(v[1]); o.z = f2bf(v[2]); o.w = f2bf(v[3]); ((ushort4*)out)[i] = o; }
}
__global__ __launch_bounds__(256) void k_transpose(const float* __restrict__ W, int K, int ldw, bf16_t* __restrict__ out, int ldo, int koff) {
    __shared__ float t[32][33];
    const int k0 = blockIdx.y * 32, n0 = blockIdx.x * 32, tx = threadIdx.x & 31, ty = threadIdx.x >> 5;
    for (int i = ty; i < 32; i += 8) t[i][tx] = W[(size_t)(k0 + i) * ldw + n0 + tx];
    __syncthreads();
    for (int i = ty; i < 32; i += 8) out[(size_t)(n0 + i) * ldo + koff + k0 + tx] = f2bf(t[tx][i]);
}
__global__ void k_misc(const float* __restrict__ hgrn_lb, const float* __restrict__ rel_bias, float* __restrict__ misc) {
    const int i = blockIdx.x * blockDim.x + threadIdx.x;
    if (i < 512) { const float a = hgrn_lb[i], b = hgrn_lb[512 + i]; const float mx = fmaxf(a, b); const float ea = expf(a - mx), eb = expf(b - mx); misc[i] = ea / (ea + eb); }
    if (i < 3 * 129) {
        const int g = i / 129, j = i % 129; const int dl = g == 0 ? 1 : (g == 1 ? 4 : 16); const int n = j * dl;
        int bucket;
        if (n < 16) bucket = n;
        else { const double v = log((double)n / 16.0) / log(128.0) * 16.0; int l = 16 + (int)v; bucket = l < 31 ? l : 31; }
        for (int h = 0; h < 4; ++h) misc[512 + i * 4 + h] = rel_bias[bucket * 12 + g * 4 + h];
    }
}

template <class Epi>
__global__ __launch_bounds__(256) void gemm_simple(const bf16_t* __restrict__ A, int lda, const bf16_t* __restrict__ Bt, int ldb, int K, Epi epi) {
    const int lane = threadIdx.x & 63, w = threadIdx.x >> 6;
    const int row0 = blockIdx.y * 64 + (w >> 1) * 32, col0 = blockIdx.x * 64 + (w & 1) * 32;
    const int fr = lane & 15, fq = lane >> 4;
    f32x4 acc[2][2];
#pragma unroll
    for (int a = 0; a < 2; ++a)
#pragma unroll
        for (int b = 0; b < 2; ++b) acc[a][b] = (f32x4){0.f, 0.f, 0.f, 0.f};
    const bf16_t* ap = A + (size_t)(row0 + fr) * lda + fq * 8;
    const bf16_t* bp = Bt + (size_t)(col0 + fr) * ldb + fq * 8;
    for (int k0 = 0; k0 < K; k0 += 32) {
        const bf16x8 a0 = *(const bf16x8*)(ap + k0), a1 = *(const bf16x8*)(ap + (size_t)16 * lda + k0);
        const bf16x8 b0 = *(const bf16x8*)(bp + k0), b1 = *(const bf16x8*)(bp + (size_t)16 * ldb + k0);
        acc[0][0] = __builtin_amdgcn_mfma_f32_16x16x32_bf16(a0, b0, acc[0][0], 0, 0, 0);
        acc[0][1] = __builtin_amdgcn_mfma_f32_16x16x32_bf16(a0, b1, acc[0][1], 0, 0, 0);
        acc[1][0] = __builtin_amdgcn_mfma_f32_16x16x32_bf16(a1, b0, acc[1][0], 0, 0, 0);
        acc[1][1] = __builtin_amdgcn_mfma_f32_16x16x32_bf16(a1, b1, acc[1][1], 0, 0, 0);
    }
#pragma unroll
    for (int mi = 0; mi < 2; ++mi)
#pragma unroll
        for (int ni = 0; ni < 2; ++ni)
#pragma unroll
            for (int j = 0; j < 4; ++j) epi(row0 + mi * 16 + fq * 4 + j, col0 + ni * 16 + fr, acc[mi][ni][j]);
}

DI int dil_of(int g) { return g == 0 ? 1 : (g == 1 ? 4 : 16); }
DI int perm_tok(int lb, int s, int dl) { return lb * S + (s % dl) * (S / dl) + s / dl; }

struct EpiProj {
    bf16_t *QK, *VT, *HFQG, *IT, *MQ, *GATE; const float* b_gate;
    DI void operator()(int row, int col, float v) const {
        if (col < 3072) QK[(size_t)row * 3072 + col] = f2bf(v);
        else if (col < 4608) { const int c = col - 3072, g = c >> 9; VT[(size_t)c * MP + perm_tok(row / S, row % S, dil_of(g))] = f2bf(v); }
        else if (col < 5120) HFQG[(size_t)row * 1536 + (col - 4608)] = f2bf(v);
        else if (col < 5632) IT[(size_t)(col - 5120) * MP + row] = f2bf(v);
        else if (col < 6656) HFQG[(size_t)row * 1536 + (col - 5632) + 512] = f2bf(v);
        else if (col < 7168) MQ[(size_t)row * 512 + (col - 6656)] = f2bf(v);
        else { const int c = col - 7168; const float z = v + b_gate[c]; GATE[(size_t)row * 3072 + c] = f2bf(1.f / (1.f + expf(-z))); }
    }
};
struct EpiMemKV {
    bf16_t *MK, *MVT;
    DI void operator()(int row, int col, float v) const {
        if (col < 512) MK[(size_t)row * 512 + col] = f2bf(v);
        else MVT[((size_t)(row >> 8) * 512 + (col - 512)) * 256 + (row & 255)] = f2bf(v);
    }
};
struct EpiWiden {
    const bf16_t* GATE; float* TMP; bf16_t* MERGED; int g, pad;
    DI void operator()(int row, int col, float v) const {
        const float gv = bf2f(GATE[(size_t)row * 3072 + g * 1024 + col]) * v; const size_t o = (size_t)row * 1024 + col;
        if (g == 0) TMP[o] = gv; else if (g == 1) TMP[o] += gv; else MERGED[o] = f2bf(TMP[o] + gv);
    }
};
struct EpiF32 { float* C; int ldc, pad; DI void operator()(int row, int col, float v) const { C[(size_t)row * ldc + col] = v; } };
struct EpiB16 { bf16_t* C; int ldc, pad; DI void operator()(int row, int col, float v) const { C[(size_t)row * ldc + col] = f2bf(v); } };

DI float wave_max(float v) {
#pragma unroll
    for (int o = 1; o < 64; o <<= 1) v = fmaxf(v, __shfl_xor(v, o));
    return v;
}
DI float wave_sum(float v) {
#pragma unroll
    for (int o = 1; o < 64; o <<= 1) v += __shfl_xor(v, o);
    return v;
}

__global__ __launch_bounds__(256) void k_dil_attn(const bf16_t* __restrict__ QK, const bf16_t* __restrict__ VT, const float* __restrict__ BIAS, bf16_t* __restrict__ OG, float* __restrict__ LSE) {
    __shared__ float ps[4][192];
    const int lane = threadIdx.x & 63, w = threadIdx.x >> 6;
    const long task = (long)blockIdx.x * 4 + w;
    const int gh = (int)(task % 12); const int row = (int)(task / 12);
    const int g = gh >> 2, h = gh & 3, dl = dil_of(g);
    const int lb = row / S, s = row % S, m = s / dl, r = s % dl;
    const bf16_t* qp = QK + (size_t)row * 3072 + gh * 128;
    float lg[3]; float mx = -INFINITY;
#pragma unroll
    for (int i = 0; i < 3; ++i) {
        const int j = lane + 64 * i; float l = -INFINITY;
        if (j <= 128 && m - j >= 0) {
            const int krow = lb * S + (m - j) * dl + r; const bf16_t* kp = QK + (size_t)krow * 3072 + 1536 + gh * 128;
            float dot = 0.f;
            for (int d = 0; d < 128; ++d) dot += bf2f(qp[d]) * bf2f(kp[d]);
            l = dot * QSCALE + BIAS[(g * 129 + j) * 4 + h];
        }
        lg[i] = l; mx = fmaxf(mx, l);
    }
    mx = wave_max(mx);
    float sum = 0.f;
#pragma unroll
    for (int i = 0; i < 3; ++i) { const float p = (lg[i] == -INFINITY) ? 0.f : expf(lg[i] - mx); ps[w][lane + 64 * i] = p; sum += p; }
    sum = wave_sum(sum);
    __syncthreads();
    const int nk = m < 128 ? m : 128;
    const float inv = 1.f / sum;
#pragma unroll
    for (int i = 0; i < 2; ++i) {
        const int d = lane + 64 * i; const bf16_t* vp = VT + (size_t)(g * 512 + h * 128 + d) * MP + lb * S + r * (S / dl);
        float o = 0.f;
        for (int j = 0; j <= nk; ++j) o += ps[w][j] * bf2f(vp[m - j]);
        OG[(size_t)row * 1536 + g * 512 + h * 128 + d] = f2bf(o * inv);
    }
    if (lane == 0) LSE[(size_t)row * 12 + gh] = mx + logf(sum);
}
__global__ __launch_bounds__(256) void k_merge(const bf16_t* __restrict__ OG, const float* __restrict__ LSE, bf16_t* __restrict__ BR) {
    const long i = (long)blockIdx.x * 256 + threadIdx.x;
    const int row = (int)(i >> 9), c = (int)(i & 511), h = c >> 7;
    const float l0 = LSE[(size_t)row * 12 + h], l1 = LSE[(size_t)row * 12 + 4 + h], l2 = LSE[(size_t)row * 12 + 8 + h];
    const float mx = fmaxf(l0, fmaxf(l1, l2)); const float e0 = expf(l0 - mx), e1 = expf(l1 - mx), e2 = expf(l2 - mx); const float inv = 1.f / (e0 + e1 + e2);
    const bf16_t* og = OG + (size_t)row * 1536 + c;
    BR[(size_t)row * 1536 + c] = f2bf((e0 * bf2f(og[0]) + e1 * bf2f(og[512]) + e2 * bf2f(og[1024])) * inv);
}
__global__ __launch_bounds__(256) void k_mem_attn(const bf16_t* __restrict__ MQ, const bf16_t* __restrict__ MK, const bf16_t* __restrict__ MVT, bf16_t* __restrict__ BR, int batch0) {
    __shared__ float ps[4][256];
    const int lane = threadIdx.x & 63, w = threadIdx.x >> 6;
    const long task = (long)blockIdx.x * 4 + w;
    const int h = (int)(task & 3); const int row = (int)(task >> 2);
    const int b = batch0 + row / S;
    const bf16_t* qp = MQ + (size_t)row * 512 + h * 128;
    float lg[4]; float mx = -INFINITY;
#pragma unroll
    for (int i = 0; i < 4; ++i) {
        const int j = lane + 64 * i; const bf16_t* kp = MK + (size_t)(b * 256 + j) * 512 + h * 128;
        float dot = 0.f;
        for (int d = 0; d < 128; ++d) dot += bf2f(qp[d]) * bf2f(kp[d]);
        lg[i] = dot * QSCALE; mx = fmaxf(mx, lg[i]);
    }
    mx = wave_max(mx);
    float sum = 0.f;
#pragma unroll
    for (int i = 0; i < 4; ++i) { const float p = expf(lg[i] - mx); ps[w][lane + 64 * i] = p; sum += p; }
    sum = wave_sum(sum);
    __syncthreads();
    const float inv = 1.f / sum;
#pragma unroll
    for (int i = 0; i < 2; ++i) {
        const int d = lane + 64 * i; const bf16_t* vp = MVT + ((size_t)b * 512 + h * 128 + d) * 256;
        float o = 0.f;
        for (int j = 0; j < 256; ++j) o += ps[w][j] * bf2f(vp[j]);
        BR[(size_t)row * 1536 + 1024 + h * 128 + d] = f2bf(o * inv);
    }
}
__global__ __launch_bounds__(128) void k_hgrn(const bf16_t* __restrict__ HFQG, const bf16_t* __restrict__ IT, const float* __restrict__ lbv, const float* __restrict__ norm_w, bf16_t* __restrict__ BR) {
    __shared__ float sf[128], sk[128], sq[128], red[2];
    const int tid = threadIdx.x, h = blockIdx.x & 3, lb = blockIdx.x >> 2;
    const float lbd = lbv[h * 128 + tid], nw = norm_w[h * 128 + tid];
    float St[128];
#pragma unroll
    for (int i = 0; i < 128; ++i) St[i] = 0.f;
    for (int s = 0; s < S; ++s) {
        const size_t row = (size_t)lb * S + s;
        const float fr = bf2f(HFQG[row * 1536 + h * 128 + tid]);
        const float f = lbd + (1.f - lbd) / (1.f + expf(-fr));
        sf[tid] = f; sk[tid] = 1.f - f; sq[tid] = bf2f(HFQG[row * 1536 + 512 + h * 128 + tid]);
        __syncthreads();
        const float iv = bf2f(IT[(size_t)(h * 128 + tid) * MP + row]);
        float o = 0.f;
#pragma unroll
        for (int d = 0; d < 128; ++d) { St[d] = sf[d] * St[d] + sk[d] * iv; o += sq[d] * St[d]; }
        const float ss = wave_sum(o * o);
        if ((tid & 63) == 0) red[tid >> 6] = ss;
        __syncthreads();
        const float ms = (red[0] + red[1]) * (1.f / 128.f);
        const float gv = bf2f(HFQG[row * 1536 + 1024 + h * 128 + tid]);
        BR[row * 1536 + 512 + h * 128 + tid] = f2bf(o * rsqrtf(ms + LN_EPS) * nw * (gv / (1.f + expf(-gv))));
    }
}
__global__ __launch_bounds__(256) void k_ln1(const float* __restrict__ x, const float* __restrict__ mix, const float* __restrict__ g, const float* __restrict__ b, float* __restrict__ h1f, bf16_t* __restrict__ h1b) {
    __shared__ float red[8];
    const size_t row = blockIdx.x; const int tid = threadIdx.x;
    float v[4]; float s = 0.f;
#pragma unroll
    for (int i = 0; i < 4; ++i) { const int c = tid + 256 * i; v[i] = ALPHA * x[row * D + c] + mix[row * D + c]; s += v[i]; }
    s = wave_sum(s); if ((tid & 63) == 0) red[tid >> 6] = s; __syncthreads();
    const float mean = (red[0] + red[1] + red[2] + red[3]) * (1.f / D);
    float q = 0.f;
#pragma unroll
    for (int i = 0; i < 4; ++i) { v[i] -= mean; q += v[i] * v[i]; }
    q = wave_sum(q); if ((tid & 63) == 0) red[4 + (tid >> 6)] = q; __syncthreads();
    const float rstd = rsqrtf((red[4] + red[5] + red[6] + red[7]) * (1.f / D) + LN_EPS);
#pragma unroll
    for (int i = 0; i < 4; ++i) { const int c = tid + 256 * i; const float o = v[i] * rstd * g[c] + b[c]; h1f[row * D + c] = o; h1b[row * D + c] = f2bf(o); }
}

DI void ins16(float (&tv)[16], int (&ti)[16], float v, int i) {
#pragma unroll
    for (int j = 0; j < 16; ++j) { const bool gt = v > tv[j]; const float ov = tv[j]; const int oi = ti[j]; tv[j] = gt ? v : ov; ti[j] = gt ? i : oi; v = gt ? ov : v; i = gt ? oi : i; }
}
__global__ __launch_bounds__(256) void k_route(const bf16_t* __restrict__ PQ, const bf16_t* __restrict__ SUBK, int* __restrict__ IDX, float* __restrict__ PG) {
    const long gi = (long)blockIdx.x * 256 + threadIdx.x;
    const int h = (int)(gi & 7); const size_t t = (size_t)(gi >> 3);
    float s1[16], s2[16]; int i1[16], i2[16];
#pragma unroll
    for (int j = 0; j < 16; ++j) { s1[j] = -INFINITY; s2[j] = -INFINITY; i1[j] = 0; i2[j] = 0; }
    const bf16_t* q0 = PQ + t * 2048 + h * 256;
    for (int n = 0; n < 128; ++n) {
        const bf16_t* k0 = SUBK + (size_t)((h * 2 + 0) * 128 + n) * 128; const bf16_t* k1 = SUBK + (size_t)((h * 2 + 1) * 128 + n) * 128;
        float a = 0.f, b = 0.f;
        for (int k = 0; k < 128; ++k) { a += bf2f(q0[k]) * bf2f(k0[k]); b += bf2f(q0[128 + k]) * bf2f(k1[k]); }
        ins16(s1, i1, a, n); ins16(s2, i2, b, n);
    }
    float cv[16]; int ci[16];
#pragma unroll
    for (int j = 0; j < 16; ++j) { cv[j] = -INFINITY; ci[j] = 0; }
#pragma unroll
    for (int a = 0; a < 16; ++a)
#pragma unroll
        for (int b = 0; b < 16; ++b) ins16(cv, ci, s1[a] + s2[b], i1[a] * 128 + i2[b]);
    float sum = 0.f; float e[16];
#pragma unroll
    for (int j = 0; j < 16; ++j) { e[j] = expf(cv[j] - cv[0]); sum += e[j]; }
    const float inv = 1.f / sum;
#pragma unroll
    for (int j = 0; j < 16; ++j) { IDX[t * 128 + h * 16 + j] = ci[j]; PG[t * 128 + h * 16 + j] = e[j] * inv; }
}
__global__ __launch_bounds__(256) void k_experts(const float* h1f_in, const bf16_t* __restrict__ h1b, const bf16_t* __restrict__ UB, const bf16_t* __restrict__ VB, const int* __restrict__ IDX, const float* __restrict__ PG,
                                                 const float* __restrict__ g2, const float* __restrict__ b2, float* out) {
    __shared__ float hrow[1024]; __shared__ float cw[128]; __shared__ int eid[128]; __shared__ float red[8];
    const size_t t = blockIdx.x; const int tid = threadIdx.x, lane = tid & 63, w = tid >> 6;
    float hv[4];
#pragma unroll
    for (int i = 0; i < 4; ++i) { const int c = tid + 256 * i; hv[i] = h1f_in[t * D + c]; hrow[c] = bf2f(h1b[t * D + c]); }
    if (tid < 128) eid[tid] = IDX[t * 128 + tid];
    __syncthreads();
    for (int e = w; e < 128; e += 4) {
        const bf16_t* up = UB + (size_t)eid[e] * D; float dot = 0.f;
#pragma unroll
        for (int i = 0; i < 16; ++i) dot += hrow[lane + 64 * i] * bf2f(up[lane + 64 * i]);
        dot = wave_sum(dot);
        if (lane == 0) cw[e] = PG[t * 128 + e] * 0.5f * dot * (1.f + erff(dot * 0.7071067811865476f));
    }
    __syncthreads();
    float f[4] = {0.f, 0.f, 0.f, 0.f};
    for (int e = 0; e < 128; ++e) { const bf16_t* vp = VB + (size_t)eid[e] * D; const float c = cw[e];
#pragma unroll
        for (int i = 0; i < 4; ++i) f[i] += c * bf2f(vp[tid + 256 * i]); }
    float v[4]; float s = 0.f;
#pragma unroll
    for (int i = 0; i < 4; ++i) { v[i] = ALPHA * hv[i] + f[i]; s += v[i]; }
    s = wave_sum(s); if (lane == 0) red[w] = s; __syncthreads();
    const float mean = (red[0] + red[1] + red[2] + red[3]) * (1.f / D);
    float q = 0.f;
#pragma unroll
    for (int i = 0; i < 4; ++i) { v[i] -= mean; q += v[i] * v[i]; }
    q = wave_sum(q); if (lane == 0) red[4 + w] = q; __syncthreads();
    const float rstd = rsqrtf((red[4] + red[5] + red[6] + red[7]) * (1.f / D) + LN_EPS);
#pragma unroll
    for (int i = 0; i < 4; ++i) { const int c = tid + 256 * i; out[t * D + c] = v[i] * rstd * g2[c] + b2[c]; }
}

#define LAS __attribute__((address_space(3)))
#define GAS __attribute__((address_space(1)))
typedef unsigned u32x4 __attribute__((ext_vector_type(4)));
typedef unsigned u32x2 __attribute__((ext_vector_type(2)));
typedef float f32x2 __attribute__((ext_vector_type(2)));
typedef __bf16 bf16x2_t __attribute__((ext_vector_type(2)));
DI unsigned cvtpk(float lo, float hi) { f32x2 v = {lo, hi}; bf16x2_t b = __builtin_convertvector(v, bf16x2_t); return __builtin_bit_cast(unsigned, b); }
constexpr float LOG2E = 1.4426950408889634f;
DI float fast_sigmoid(float z) { return __builtin_amdgcn_rcpf(1.f + __builtin_amdgcn_exp2f(-z * LOG2E)); }

namespace g8 {
constexpr int BM = 256, BK = 64, HALF = 128, HTB = HALF * BK * 2, STAGE_BYTES = 8 * HTB;
DI int lds_byte(int r, int c) { const int st = (r >> 4) * 2 + (c >> 5), rr = r & 15, cc = c & 31, ob = rr * 64 + cc * 2; return st * 1024 + (ob ^ (((ob >> 9) & 1) << 5)); }
DI void stage_rc(int b, int& R, int& C) { const int st = b / 1024, sb = b % 1024, swz = sb ^ (((sb >> 9) & 1) << 5); R = (st >> 1) * 16 + swz / 64; C = (st & 1) * 32 + (swz % 64) / 2; }
DI int perm32(int rho) { const int n = rho >> 4, i = rho & 15; return 8 * (i >> 2) + 4 * n + (i & 3); }

struct Unit { unsigned a, b; int dlb; int pm, pn, kind; };

template <class Epi, class Sched>
DI void gemm_phase(LAS unsigned char* lds, const char* const wsb, const int K, const Sched& S, const Epi& E, const int tid) {
    const int wid = __builtin_amdgcn_readfirstlane(tid >> 6), lane = tid & 63, wr = wid >> 2, wc = wid & 3, fr = lane & 15, fq = lane >> 4;
    const int nt = K / BK;
    unsigned voffA[2], rbk[2], ccb[2];
#pragma unroll
    for (int i = 0; i < 2; ++i) { int R, C; stage_rc(tid * 16 + i * 8192, R, C); const int Rb = Epi::PERM ? ((R & ~31) + perm32(R & 31)) : R;
        voffA[i] = (unsigned)(R * K + C) * 2u; rbk[i] = (unsigned)(Rb * K) * 2u; ccb[i] = (unsigned)C * 2u; }
    const unsigned kstep = (unsigned)(BK * 2);
    const unsigned hstepA = (unsigned)(HALF * K * 2);
    const unsigned ldsw = (unsigned)wid * 1024u;
    const int aoff = lds_byte(wr * 64 + fr, fq * 8), boff = lds_byte(wc * 32 + fr, fq * 8);
#define G8_SA(b, h) (((b) * 2 + (h)) * HTB)
#define G8_SB(b, h) ((4 + (b) * 2 + (h)) * HTB)
#define G8_STAGE(bufoff, gbase, v0, v1) do { \
        __builtin_amdgcn_global_load_lds((const unsigned*)(wsb + (unsigned)((gbase) + (v0))), (LAS unsigned*)(lds + (bufoff) + ldsw), 16, 0, 0); \
        __builtin_amdgcn_global_load_lds((const unsigned*)(wsb + (unsigned)((gbase) + (v1))), (LAS unsigned*)(lds + (bufoff) + ldsw + 8192), 16, 0, 0); } while (0)
#define G8_LDA(dst, b, h) do { _Pragma("unroll") for (int m = 0; m < 4; ++m) _Pragma("unroll") for (int k = 0; k < 2; ++k) dst[m][k] = *(const LAS bf16x8*)(lds + G8_SA(b, h) + aoff + m * 2048 + k * 1024); } while (0)
#define G8_LDB(dst, b, h) do { _Pragma("unroll") for (int n = 0; n < 2; ++n) _Pragma("unroll") for (int k = 0; k < 2; ++k) dst[n][k] = *(const LAS bf16x8*)(lds + G8_SB(b, h) + boff + n * 2048 + k * 1024); } while (0)
#define G8_MMA(ai, bj, At, Bt) do { __builtin_amdgcn_s_setprio(1); _Pragma("unroll") for (int m = 0; m < 4; ++m) _Pragma("unroll") for (int n = 0; n < 2; ++n) _Pragma("unroll") for (int k = 0; k < 2; ++k) \
        acc[ai][bj][m][n] = __builtin_amdgcn_mfma_f32_16x16x32_bf16(Bt[n][k], At[m][k], acc[ai][bj][m][n], 0, 0, 0); __builtin_amdgcn_s_setprio(0); } while (0)
#define G8_WAIT_V(n) asm volatile("s_waitcnt vmcnt(" #n ")" ::: "memory")
#define G8_WAIT_L(n) asm volatile("s_waitcnt lgkmcnt(" #n ")" ::: "memory")
#define G8_BAR __builtin_amdgcn_s_barrier()
#define G8_SCHED __builtin_amdgcn_sched_barrier(0)
    Unit cur, nxt; int ui = 0;
    if (!S.next(0, cur)) return;
    f32x4 acc[2][2][4][2];
#pragma unroll
    for (int a = 0; a < 2; ++a)
#pragma unroll
        for (int b = 0; b < 2; ++b)
#pragma unroll
            for (int m = 0; m < 4; ++m)
#pragma unroll
                for (int n = 0; n < 2; ++n) acc[a][b][m][n] = (f32x4){0.f, 0.f, 0.f, 0.f};
    bf16x8 At[4][2], B0[2][2], B1[2][2];
    unsigned cA = cur.a, cB = cur.b;
    unsigned vBc0 = rbk[0] * (unsigned)cur.dlb + ccb[0], vBc1 = rbk[1] * (unsigned)cur.dlb + ccb[1]; unsigned hBc = hstepA * (unsigned)cur.dlb;
    G8_STAGE(G8_SB(0, 0), cB, vBc0, vBc1); G8_STAGE(G8_SB(0, 1), cB + hBc, vBc0, vBc1); G8_STAGE(G8_SA(0, 0), cA, voffA[0], voffA[1]); G8_STAGE(G8_SA(0, 1), cA + hstepA, voffA[0], voffA[1]);
    if (wr == 1) G8_BAR;
    G8_WAIT_V(2); G8_BAR;
    G8_STAGE(G8_SB(1, 0), cB + kstep, vBc0, vBc1); G8_STAGE(G8_SA(1, 0), cA + kstep, voffA[0], voffA[1]); G8_STAGE(G8_SB(1, 1), cB + hBc + kstep, vBc0, vBc1);
    G8_WAIT_V(6); G8_BAR;
    for (;;) {
        const bool has_next = S.next(ui + 1, nxt);
        const unsigned nA = has_next ? nxt.a : cA, nB = has_next ? nxt.b : cB; const int dln = has_next ? nxt.dlb : cur.dlb;
        const unsigned vBn0 = rbk[0] * (unsigned)dln + ccb[0], vBn1 = rbk[1] * (unsigned)dln + ccb[1]; const unsigned hBn = hstepA * (unsigned)dln;
        for (int t = 0; t < nt; t += 2) {
            if constexpr (Epi::HOOK) E.hook(acc, cur, t, wr, wc, fr, fq);
            const bool last = (t == nt - 2);
            const unsigned a1 = cA + (unsigned)(t + 1) * kstep;
            const unsigned a2 = last ? nA : cA + (unsigned)(t + 2) * kstep, b2 = last ? nB : cB + (unsigned)(t + 2) * kstep;
            const unsigned a3 = a2 + kstep, b3 = b2 + kstep;
            const unsigned vB0 = last ? vBn0 : vBc0, vB1 = last ? vBn1 : vBc1; const unsigned hB = last ? hBn : hBc;
            G8_LDB(B0, 0, 0); G8_LDB(B1, 0, 1); G8_SCHED; G8_LDA(At, 0, 0); G8_STAGE(G8_SA(1, 1), a1 + hstepA, voffA[0], voffA[1]);
            G8_WAIT_V(8); G8_WAIT_L(0); G8_BAR; G8_MMA(0, 0, At, B0); G8_MMA(0, 1, At, B1); G8_BAR; G8_SCHED;
            G8_LDA(At, 0, 1); G8_STAGE(G8_SB(0, 0), b2, vB0, vB1); G8_STAGE(G8_SB(0, 1), b2 + hB, vB0, vB1); G8_STAGE(G8_SA(0, 0), a2, voffA[0], voffA[1]);
            G8_WAIT_V(8); G8_WAIT_L(0); G8_BAR; G8_MMA(1, 0, At, B0); G8_MMA(1, 1, At, B1); G8_BAR; G8_SCHED;
            G8_LDB(B0, 1, 0); G8_LDB(B1, 1, 1); G8_SCHED; G8_LDA(At, 1, 0); G8_STAGE(G8_SA(0, 1), a2 + hstepA, voffA[0], voffA[1]);
            G8_WAIT_V(8); G8_WAIT_L(0); G8_BAR; G8_MMA(0, 0, At, B0); G8_MMA(0, 1, At, B1); G8_BAR; G8_SCHED;
            G8_LDA(At, 1, 1); G8_STAGE(G8_SB(1, 0), b3, vB0, vB1); G8_STAGE(G8_SB(1, 1), b3 + hB, vB0, vB1); G8_STAGE(G8_SA(1, 0), a3, voffA[0], voffA[1]);
            G8_WAIT_V(8); G8_WAIT_L(0); G8_BAR; G8_MMA(1, 0, At, B0); G8_MMA(1, 1, At, B1); G8_BAR; G8_SCHED;
        }
        if (wr == 0) G8_BAR;
        E(acc, cur, wr, wc, fr, fq);
        if (!has_next) break;
#pragma unroll
        for (int a = 0; a < 2; ++a)
#pragma unroll
            for (int b = 0; b < 2; ++b)
#pragma unroll
                for (int m = 0; m < 4; ++m)
#pragma unroll
                    for (int n = 0; n < 2; ++n) acc[a][b][m][n] = (f32x4){0.f, 0.f, 0.f, 0.f};
        cur = nxt; cA = nA; cB = nB; vBc0 = vBn0; vBc1 = vBn1; hBc = hBn; ++ui;
        if (wr == 1) G8_BAR;
    }
    G8_WAIT_V(0);
    G8_BAR;
#undef G8_SA
#undef G8_SB
#undef G8_STAGE
#undef G8_LDA
#undef G8_LDB
#undef G8_MMA
#undef G8_WAIT_V
#undef G8_WAIT_L
#undef G8_BAR
#undef G8_SCHED
}
}

typedef GAS unsigned gu32;
#define XB_TMO      128
#define XB_XCNT(j)  (256  + 64 * (j))
#define XB_XSUB(j)  (1280 + 64 * (j))
#define XB_XGEN(j)  (2304 + 64 * (j))
#define XB_TOP      3328
#define XB_TOPGEN   3392
#define XCD_BAR_WORDS 3456
#define XB_SPIN_CAP (1u << 22)
DI unsigned xb_ld(unsigned* p)              { return __hip_atomic_load(p, __ATOMIC_RELAXED, __HIP_MEMORY_SCOPE_AGENT); }
DI unsigned xb_add(unsigned* p, unsigned v) { return __hip_atomic_fetch_add(p, v, __ATOMIC_RELAXED, __HIP_MEMORY_SCOPE_AGENT); }
DI unsigned xb_xcc_id() { return (unsigned)__builtin_amdgcn_s_getreg((3 << 11) | 20) & 0xFu; }
#define XB_SPIN(cond, bar) do { unsigned _sp = 0; while (cond) { __builtin_amdgcn_s_sleep(1); \
    if ((++_sp & 255u) == 0u) { if (xb_ld(&(bar)[XB_TMO])) break; if (_sp > XB_SPIN_CAP) { atomicAdd(&(bar)[XB_TMO], 1u); break; } } } } while (0)
struct XcdBarrier { unsigned* bar; unsigned x; volatile LAS unsigned* st; };
DI XcdBarrier xcd_barrier_post(unsigned* bar, volatile LAS unsigned* st) {
    XcdBarrier b; b.bar = bar; b.x = xb_xcc_id(); b.st = st;
    if (threadIdx.x == 0) (void)xb_add(&bar[XB_XCNT(b.x)], 1u);
    return b;
}
DI void xcd_barrier_complete(unsigned* bar, unsigned x, unsigned& nloc, unsigned& nx) {
    const unsigned G = gridDim.x * gridDim.y * gridDim.z;
    unsigned sum, cnt, mine, sp = 0u;
    for (;;) {
        sum = 0u; cnt = 0u; mine = 0u;
#pragma unroll
        for (unsigned j = 0; j < 16; ++j) { const unsigned c = xb_ld(&bar[XB_XCNT(j)]); sum += c; cnt += (c > 0u) ? 1u : 0u; mine = (j == x) ? c : mine; }
        if (sum == G) break;
        __builtin_amdgcn_s_sleep(1);
        if ((++sp & 255u) == 0u) { if (xb_ld(&bar[XB_TMO])) break; if (sp > XB_SPIN_CAP) { atomicAdd(&bar[XB_TMO], 1u); break; } }
    }
    nloc = mine > 0u ? mine : 1u; nx = cnt > 0u ? cnt : 1u;
}
DI void xcd_barrier(const XcdBarrier& b) {
    asm volatile("s_waitcnt vmcnt(0)" ::: "memory");
    __syncthreads();
    if (threadIdx.x == 0) {
        unsigned* bar = b.bar;
        __builtin_amdgcn_s_waitcnt(0);
        unsigned nloc = b.st[0], nx = b.st[1];
        if (nloc == 0u) { xcd_barrier_complete(bar, b.x, nloc, nx); b.st[0] = nloc; b.st[1] = nx; }
        const unsigned old = xb_add(&bar[XB_XSUB(b.x)], 1u);
        const unsigned gen = old / nloc;
        if (old + 1u == (gen + 1u) * nloc) {
            __builtin_amdgcn_fence(__ATOMIC_RELEASE, "agent");
            asm volatile("s_waitcnt vmcnt(0)" ::: "memory");
            const unsigned og = xb_add(&bar[XB_TOP], 1u);
            const unsigned tg = og / nx;
            if (og + 1u == (tg + 1u) * nx) xb_add(&bar[XB_TOPGEN], 1u);
            else XB_SPIN(xb_ld(&bar[XB_TOPGEN]) == tg, bar);
            __builtin_amdgcn_fence(__ATOMIC_ACQUIRE, "agent");
            xb_add(&bar[XB_XGEN(b.x)], 1u);
            asm volatile("s_waitcnt vmcnt(0)" ::: "memory");
        } else {
            XB_SPIN(xb_ld(&bar[XB_XGEN(b.x)]) == gen, bar);
            __builtin_amdgcn_fence(__ATOMIC_ACQUIRE, "agent");
            asm volatile("s_waitcnt vmcnt(0)" ::: "memory");
        }
    }
    __syncthreads();
}

constexpr int NWAVES = 8, NTHR = NWAVES * 64;
constexpr int RING_BYTES = 131072, LDS_BYTES = 147456, LDSCTL_OFF = LDS_BYTES - 1024, MISC_OFF = LDSCTL_OFF + 320;
constexpr size_t CTL_BYTES = 65536;
enum { PH_ALL = 0, PH_PRO = 11, PH_PROJ = 1, PH_ATTN = 2, PH_HGPRE = 3, PH_HGMAIN = 4, PH_WIDEN = 5, PH_WOUT = 6, PH_LN1 = 7, PH_PQ = 8, PH_ROUTE = 9, PH_EXPERTS = 10, PH_HGSCAN = 12 };
struct Args { const float* in[18]; float* out; unsigned char* ws; int ph, pass; };

struct Bufs {
    const bf16_t *WIN, *XBp; bf16_t *QK, *VIT, *HFQG, *MQ, *GATE;
};

struct SchedP1 {
    unsigned XBp, W; int G, c;
    DI bool next(int i, g8::Unit& u) const {
        const int L = i * G + c; if (L >= 2560) return false;
        if (L < 2048) { const int x = L & 7, off = L >> 3; u.pm = 8 * x + (off & 7); u.pn = off >> 3; u.kind = 0; u.dlb = 1;
            u.a = XBp + (unsigned)u.pm * 256u * D * 2u; u.b = W + (unsigned)u.pn * 256u * D * 2u; }
        else { const int idx = L - 2048; u.pm = idx & 7; u.pn = idx >> 3; u.kind = 1;
            const int dl = u.pm < 2 ? 1 : (u.pm < 4 ? 4 : (u.pm < 6 ? 16 : 1));
            const int v0 = u.pn * 256, lb = v0 / S, vv = v0 % S, per = S / dl, r = vv / per, m0 = vv % per;
            u.dlb = dl; u.a = W + (unsigned)(8192 + u.pm * 256) * D * 2u; u.b = XBp + (unsigned)(lb * S + m0 * dl + r) * D * 2u; }
        return true;
    }
};
struct EpiP1 {
    static constexpr bool PERM = true, HOOK = false;
    char* pr; const float* b_gate;
    DI void hook(f32x4 (&)[2][2][4][2], const g8::Unit&, int, int, int, int, int) const {}
    DI void operator()(const f32x4 (&acc)[2][2][4][2], const g8::Unit& u, int wr, int wc, int fr, int fq) const {
        bf16_t* base; int ldc, colt; bool gate = false;
        if (u.kind == 1) { base = (bf16_t*)(pr + P_VT); ldc = MP; colt = u.pn * 256; }
        else if (u.pn < 12) { base = (bf16_t*)(pr + P_QK); ldc = 3072; colt = u.pn * 256; }
        else if (u.pn < 18) { base = (bf16_t*)(pr + P_HFQG); ldc = 1536; colt = (u.pn - 12) * 256; }
        else if (u.pn < 20) { base = (bf16_t*)(pr + P_MQ); ldc = 512; colt = (u.pn - 18) * 256; }
        else { base = (bf16_t*)(pr + P_GATE); ldc = 3072; colt = (u.pn - 20) * 256; gate = true; }
        const int row0 = u.pm * 256 + wr * 64 + fr, col0 = colt + wc * 32 + 8 * fq;
        f32x4 bv[2][2];
#pragma unroll
        for (int bj = 0; bj < 2; ++bj)
#pragma unroll
            for (int n = 0; n < 2; ++n) bv[bj][n] = gate ? *(const f32x4*)(b_gate + col0 + bj * 128 + 4 * n) : (f32x4){0.f, 0.f, 0.f, 0.f};
#pragma unroll
        for (int ai = 0; ai < 2; ++ai)
#pragma unroll
            for (int m = 0; m < 4; ++m) { bf16_t* rowp = base + (size_t)(row0 + ai * 128 + m * 16) * ldc + col0;
#pragma unroll
                for (int bj = 0; bj < 2; ++bj) { f32x4 v0 = acc[ai][bj][m][0], v1 = acc[ai][bj][m][1];
                    if (gate) { v0 = v0 + bv[bj][0]; v1 = v1 + bv[bj][1];
#pragma unroll
                        for (int e = 0; e < 4; ++e) { v0[e] = fast_sigmoid(v0[e]); v1[e] = fast_sigmoid(v1[e]); } }
                    u32x4 w; w.x = cvtpk(v0[0], v0[1]); w.y = cvtpk(v0[2], v0[3]); w.z = cvtpk(v1[0], v1[1]); w.w = cvtpk(v1[2], v1[3]);
                    *(u32x4*)(rowp + bj * 128) = w; } }
    }
};

typedef float f32x16 __attribute__((ext_vector_type(16)));
typedef short s16x4 __attribute__((ext_vector_type(4)));
DI int crow(int r, int hi) { return (r & 3) + 8 * (r >> 2) + 4 * hi; }
DI float xor32f(float v) { return __shfl_xor(v, 32); }
#define MFMA32(a, b, c) __builtin_amdgcn_mfma_f32_32x32x16_bf16((a), (b), (c), 0, 0, 0)
DI bf16x8 pack8(const f32x16& p, int s) {
    u32x4 w; w.x = cvtpk(p[8 * s + 0], p[8 * s + 1]); w.y = cvtpk(p[8 * s + 2], p[8 * s + 3]); w.z = cvtpk(p[8 * s + 4], p[8 * s + 5]); w.w = cvtpk(p[8 * s + 6], p[8 * s + 7]);
    return __builtin_bit_cast(bf16x8, w);
}
DI bf16x8 ldvt(const bf16_t* vp) {
    const s16x4 lo = *(const s16x4*)vp, hi4 = *(const s16x4*)(vp + 8);
    return __builtin_shufflevector(lo, hi4, 0, 1, 2, 3, 4, 5, 6, 7);
}
constexpr int DIL_TASKS = BPP * 12 * (S / 32);
constexpr int MEM_TASKS = (MP / 32) * 4;
DI void attn_dil_wave(const bf16_t* __restrict__ QK, const bf16_t* __restrict__ VT, const LAS float* btab, bf16_t* __restrict__ OG, float* __restrict__ LSE, int task, int lane) {
    const int r32 = lane & 31, hi = lane >> 5;
    const int q32 = task & 255, gh = (task >> 8) % 12, lb = task / (256 * 12);
    const int g = gh >> 2, h = gh & 3, dl = dil_of(g), per = S / dl;
    const int tok0 = q32 * 32, r = tok0 / per, m0 = tok0 % per;
    const size_t rowq = (size_t)lb * S + (size_t)(m0 + r32) * dl + r;
    bf16x8 qf[8];
    { const bf16_t* qp = QK + rowq * 3072 + gh * 128 + 8 * hi;
#pragma unroll
      for (int ks = 0; ks < 8; ++ks) qf[ks] = *(const bf16x8*)(qp + 16 * ks); }
    const LAS float* bt = btab + g * 129 * 4 + h;
    f32x16 o[4];
#pragma unroll
    for (int dt = 0; dt < 4; ++dt)
#pragma unroll
        for (int i = 0; i < 16; ++i) o[dt][i] = 0.f;
    float mrun = -INFINITY, sum = 0.f;
    const bf16_t* vbase = VT + (size_t)(g * 512 + h * 128 + r32) * MP + (size_t)lb * S + (size_t)r * per + 4 * hi;
    const bf16_t* kbase = QK + ((size_t)lb * S + r) * 3072 + 1536 + gh * 128 + 8 * hi;
#pragma unroll 1
    for (int kt = (m0 >= 128 ? 0 : (128 - m0) >> 5); kt < 5; ++kt) {
        const int mt0 = m0 - 128 + 32 * kt;
        const bf16_t* kp = kbase + (size_t)(mt0 + r32) * dl * 3072;
        f32x16 sc;
#pragma unroll
        for (int i = 0; i < 16; ++i) sc[i] = 0.f;
#pragma unroll
        for (int ks = 0; ks < 8; ++ks) { const bf16x8 kf = *(const bf16x8*)(kp + 16 * ks); sc = MFMA32(kf, qf[ks], sc); }
        float mx = -INFINITY;
#pragma unroll
        for (int i = 0; i < 16; ++i) {
            const int delta = 128 - 32 * kt + r32 - crow(i, hi);
            const bool valid = (delta >= 0) && (delta <= 128);
            const int di = delta < 0 ? 0 : (delta > 128 ? 128 : delta);
            const float x = sc[i] * (QSCALE * LOG2E) + bt[di * 4];
            sc[i] = valid ? x : -INFINITY; mx = fmaxf(mx, sc[i]);
        }
        mx = fmaxf(mx, xor32f(mx));
        const float mnew = fmaxf(mrun, mx); const float f = __builtin_amdgcn_exp2f(mrun - mnew);
        sum *= f;
#pragma unroll
        for (int dt = 0; dt < 4; ++dt)
#pragma unroll
            for (int i = 0; i < 16; ++i) o[dt][i] *= f;
        mrun = mnew;
        float ps = 0.f;
#pragma unroll
        for (int i = 0; i < 16; ++i) { sc[i] = __builtin_amdgcn_exp2f(sc[i] - mnew); ps += sc[i]; }
        ps += xor32f(ps); sum += ps;
#pragma unroll
        for (int s = 0; s < 2; ++s) {
            const bf16x8 pb = pack8(sc, s);
#pragma unroll
            for (int dt = 0; dt < 4; ++dt) { const bf16x8 va = ldvt(vbase + (size_t)(32 * dt) * MP + mt0 + 16 * s); o[dt] = MFMA32(va, pb, o[dt]); }
        }
    }
    const float inv = 1.f / sum;
    bf16_t* op = OG + rowq * 1536 + g * 512 + h * 128 + 4 * hi;
#pragma unroll
    for (int dt = 0; dt < 4; ++dt)
#pragma unroll
        for (int a = 0; a < 4; ++a) { u32x2 w; w.x = cvtpk(o[dt][4 * a] * inv, o[dt][4 * a + 1] * inv); w.y = cvtpk(o[dt][4 * a + 2] * inv, o[dt][4 * a + 3] * inv); *(u32x2*)(op + 32 * dt + 8 * a) = w; }
    if (hi == 0) LSE[rowq * 12 + gh] = (mrun + __builtin_amdgcn_logf(sum)) * 0.6931471805599453f;
}
DI void attn_mem_wave(const bf16_t* __restrict__ MQ, const bf16_t* __restrict__ MK, const bf16_t* __restrict__ MVT, bf16_t* __restrict__ BR, int task, int batch0, int lane) {
    const int r32 = lane & 31, hi = lane >> 5;
    const int h = task & 3, blk = task >> 2;
    const size_t rowq = (size_t)blk * 32 + r32; const int b = batch0 + blk * 32 / S;
    bf16x8 qf[8];
    { const bf16_t* qp = MQ + rowq * 512 + h * 128 + 8 * hi;
#pragma unroll
      for (int ks = 0; ks < 8; ++ks) qf[ks] = *(const bf16x8*)(qp + 16 * ks); }
    f32x16 o[4];
#pragma unroll
    for (int dt = 0; dt < 4; ++dt)
#pragma unroll
        for (int i = 0; i < 16; ++i) o[dt][i] = 0.f;
    float mrun = -INFINITY, sum = 0.f;
    const bf16_t* vbase = MVT + (size_t)(h * 128 + r32) * 2048 + (size_t)b * 256 + 4 * hi;
    const bf16_t* kbase = MK + ((size_t)b * 256 + r32) * 512 + h * 128 + 8 * hi;
#pragma unroll 1
    for (int c = 0; c < 4; ++c) {
        f32x16 sc[2]; float mx = -INFINITY;
#pragma unroll
        for (int kt = 0; kt < 2; ++kt) {
            const bf16_t* kp = kbase + (size_t)(c * 64 + kt * 32) * 512;
            f32x16 acc;
#pragma unroll
            for (int i = 0; i < 16; ++i) acc[i] = 0.f;
#pragma unroll
            for (int ks = 0; ks < 8; ++ks) { const bf16x8 kf = *(const bf16x8*)(kp + 16 * ks); acc = MFMA32(kf, qf[ks], acc); }
#pragma unroll
            for (int i = 0; i < 16; ++i) { sc[kt][i] = acc[i] * (QSCALE * LOG2E); mx = fmaxf(mx, sc[kt][i]); }
            asm volatile("" ::: "memory");
        }
        mx = fmaxf(mx, xor32f(mx));
        const float mnew = fmaxf(mrun, mx); const float f = __builtin_amdgcn_exp2f(mrun - mnew);
        sum *= f;
#pragma unroll
        for (int dt = 0; dt < 4; ++dt)
#pragma unroll
            for (int i = 0; i < 16; ++i) o[dt][i] *= f;
        mrun = mnew;
        float ps = 0.f;
#pragma unroll
        for (int kt = 0; kt < 2; ++kt)
#pragma unroll
            for (int i = 0; i < 16; ++i) { sc[kt][i] = __builtin_amdgcn_exp2f(sc[kt][i] - mnew); ps += sc[kt][i]; }
        ps += xor32f(ps); sum += ps;
#pragma unroll
        for (int kt = 0; kt < 2; ++kt)
#pragma unroll
            for (int s = 0; s < 2; ++s) {
                const bf16x8 pb = pack8(sc[kt], s);
#pragma unroll
                for (int dt = 0; dt < 4; ++dt) { const bf16x8 va = ldvt(vbase + (size_t)(32 * dt) * 2048 + c * 64 + kt * 32 + 16 * s); o[dt] = MFMA32(va, pb, o[dt]); }
                asm volatile("" ::: "memory");
            }
    }
    const float inv = 1.f / sum;
    bf16_t* op = BR + rowq * 1536 + 1024 + h * 128 + 4 * hi;
#pragma unroll
    for (int dt = 0; dt < 4; ++dt)
#pragma unroll
        for (int a = 0; a < 4; ++a) { u32x2 w; w.x = cvtpk(o[dt][4 * a] * inv, o[dt][4 * a + 1] * inv); w.y = cvtpk(o[dt][4 * a + 2] * inv, o[dt][4 * a + 3] * inv); *(u32x2*)(op + 32 * dt + 8 * a) = w; }
}

constexpr int HG_SCH = 4, HG_UPS = S / 64 / HG_SCH  , HG_UNITS = BPP * 4 * HG_UPS  ;
constexpr int HG_ROW = 136, HG_KT_ROW = 72;
constexpr int HG_KP = 0, HG_QP = 64 * HG_ROW * 2, HG_QPP = 2 * HG_QP, HG_KPPT = 3 * HG_QP, HG_DEC = HG_KPPT + 128 * HG_KT_ROW * 2, HG_SSQ = HG_DEC + 512, HG_PSUM = HG_SSQ + 1024, HG_UNIT_BYTES = HG_PSUM + 2048;
DI bf16x8 lds_ld2x8(const LAS unsigned char* p) {
    const s16x4 lo = *(const LAS s16x4*)p, hi4 = *(const LAS s16x4*)(p + 16);
    return __builtin_shufflevector(lo, hi4, 0, 1, 2, 3, 4, 5, 6, 7);
}
DI int opq(int x) { asm volatile("" : "+v"(x)); return x; }
DI float lds_bf(const LAS unsigned char* p) { return __uint_as_float((unsigned)(*(const LAS unsigned short*)p) << 16); }
template <bool MAIN>
DI void hgrn_unit(LAS unsigned char* ul, int unit, int u, const bf16_t* __restrict__ HFQG, const bf16_t* __restrict__ IT, const float* __restrict__ lbv, const float* __restrict__ nwv,
                  float* HSTL, float* HSTD, const float* __restrict__ SIN, bf16_t* __restrict__ BR) {
    constexpr int NX = MAIN ? 4 : 2;
    const int lane = u & 63, w = u >> 6, r32 = lane & 31, hi = lane >> 5, dvt = w & 3, wh = w >> 2;
    const int seq = unit / HG_UPS, j = unit % HG_UPS, lb = seq >> 2, h = seq & 3;
    const int dk = u & 127, qt = u >> 7, cb = 16 * qt;
    const float lbd = lbv[h * 128 + dk];
    const size_t row0 = (size_t)lb * S + (size_t)j * (64 * HG_SCH);
    LAS unsigned char* Kp = ul + HG_KP; LAS unsigned char* Qp = ul + HG_QP; LAS unsigned char* Qpp = ul + HG_QPP; LAS unsigned char* KppT = ul + HG_KPPT;
    LAS float* dec = (LAS float*)(ul + HG_DEC); LAS float* ssq = (LAS float*)(ul + HG_SSQ); LAS float* psum = (LAS float*)(ul + HG_PSUM);
    const int dk0 = MAIN ? 0 : 64 * wh;
    f32x16 X[NX];
    if (MAIN) {
        const float* Sp = SIN + (size_t)unit * 16384 + 32 * dvt + r32;
#pragma unroll
        for (int t = 0; t < NX; ++t)
#pragma unroll
            for (int i = 0; i < 16; ++i) X[t][i] = Sp[(size_t)(32 * t + crow(i, hi)) * 128];
    } else {
#pragma unroll
        for (int t = 0; t < NX; ++t)
#pragma unroll
            for (int i = 0; i < 16; ++i) X[t][i] = 0.f;
    }
    float atot = 0.f;
#pragma unroll 1
    for (int ch = 0; ch < HG_SCH; ++ch) {
        const size_t rc = row0 + (size_t)ch * 64;
        {
            const int sc0 = opq(u) >> 4, sch = (opq(u) & 15) * 8;
            const bf16_t* fp = HFQG + (rc + sc0) * 1536 + h * 128 + sch;
            u32x4 sf[2], sq[2];
#pragma unroll
            for (int i = 0; i < 2; ++i) { sf[i] = *(const u32x4*)(fp + (size_t)(32 * i) * 1536); if (MAIN) sq[i] = *(const u32x4*)(fp + (size_t)(32 * i) * 1536 + 512); }
#pragma unroll
            for (int i = 0; i < 2; ++i) { *(LAS u32x4*)(Kp + ((sc0 + 32 * i) * HG_ROW + sch) * 2) = sf[i]; if (MAIN) *(LAS u32x4*)(Qp + ((sc0 + 32 * i) * HG_ROW + sch) * 2) = sq[i]; }
        }
        __syncthreads();
        {
            float s = 0.f;
#pragma unroll
            for (int i = 0; i < 16; ++i) s += __builtin_amdgcn_logf(lbd + (1.f - lbd) * fast_sigmoid(lds_bf(Kp + ((cb + i) * HG_ROW + dk) * 2)));
            psum[qt * 128 + dk] = s;
        }
        __syncthreads();
        {
            const float p0 = psum[dk], p1 = psum[128 + dk], p2 = psum[256 + dk], p3 = psum[384 + dk];
            const float amid = p0 + p1, alast = (p0 + p1) + (p2 + p3);
            float run = qt == 0 ? 0.f : (qt == 1 ? p0 : (qt == 2 ? amid : amid + p2));
            atot += alast;
#pragma unroll 1
            for (int c8 = 0; c8 < 2; ++c8) {
                float kt[8];
#pragma unroll
                for (int e = 0; e < 8; ++e) { const int c = cb + 8 * c8 + e; const float f = lbd + (1.f - lbd) * fast_sigmoid(lds_bf(Kp + (c * HG_ROW + dk) * 2)); run += __builtin_amdgcn_logf(f); const float key = 1.f - f;
                    kt[e] = key * __builtin_amdgcn_exp2f(alast - run);
                    if (MAIN) { *(LAS bf16_t*)(Kp + (c * HG_ROW + dk) * 2) = f2bf(key * __builtin_amdgcn_exp2f(amid - run));
                        const float q = lds_bf(Qp + (c * HG_ROW + dk) * 2);
                        *(LAS bf16_t*)(Qp + (c * HG_ROW + dk) * 2) = f2bf(q * __builtin_amdgcn_exp2f(run - amid));
                        *(LAS bf16_t*)(Qpp + (c * HG_ROW + dk) * 2) = f2bf(q * __builtin_amdgcn_exp2f(run)); } }
                u32x4 wv; wv.x = cvtpk(kt[0], kt[1]); wv.y = cvtpk(kt[2], kt[3]); wv.z = cvtpk(kt[4], kt[5]); wv.w = cvtpk(kt[6], kt[7]);
                *(LAS u32x4*)(KppT + (dk * HG_KT_ROW + cb + 8 * c8) * 2) = wv;
            }
            if (qt == 0) dec[dk] = __builtin_amdgcn_exp2f(alast);
        }
        __syncthreads();
        f32x16 o;
        const bf16_t* itrow = IT + (size_t)(h * 128 + 32 * dvt + opq(r32)) * MP;
        if (MAIN) {
#pragma unroll
            for (int i = 0; i < 16; ++i) o[i] = 0.f;
            const LAS unsigned char* qrow = Qpp + ((32 * wh + r32) * HG_ROW) * 2;
#pragma unroll
            for (int t = 0; t < 4; ++t)
#pragma unroll
                for (int step = 0; step < 2; ++step) { o = MFMA32(pack8(X[t], step), lds_ld2x8(qrow + (32 * t + 16 * step + 4 * hi) * 2), o); }
            __builtin_amdgcn_sched_barrier(0);
            const int r32m = opq(r32);
            const LAS unsigned char* qprow = Qp + ((32 * wh + r32) * HG_ROW) * 2;
            {
                f32x16 sc;
#pragma unroll
                for (int i = 0; i < 16; ++i) sc[i] = 0.f;
#pragma unroll
                for (int ks = 0; ks < 8; ++ks) { const int cof = (16 * ks + 8 * hi) * 2; sc = MFMA32(*(const LAS bf16x8*)(Kp + (r32 * HG_ROW) * 2 + cof), *(const LAS bf16x8*)(qprow + cof), sc); }
                if (wh == 0) {
#pragma unroll
                    for (int i = 0; i < 16; ++i) sc[i] = (crow(i, hi) <= r32m) ? sc[i] : 0.f;
                }
#pragma unroll
                for (int step = 0; step < 2; ++step) o = MFMA32(ldvt(itrow + rc + 16 * step + 4 * hi), pack8(sc, step), o);
                __builtin_amdgcn_sched_barrier(0);
            }
            if (wh == 1) {
                f32x16 sc;
#pragma unroll
                for (int i = 0; i < 16; ++i) sc[i] = 0.f;
#pragma unroll
                for (int ks = 0; ks < 8; ++ks) { const int cof = (16 * ks + 8 * hi) * 2; sc = MFMA32(*(const LAS bf16x8*)(Kp + ((32 + r32) * HG_ROW) * 2 + cof), *(const LAS bf16x8*)(qprow + cof), sc); }
#pragma unroll
                for (int i = 0; i < 16; ++i) sc[i] = (crow(i, hi) <= r32m) ? sc[i] : 0.f;
#pragma unroll
                for (int step = 0; step < 2; ++step) o = MFMA32(ldvt(itrow + rc + 32 + 16 * step + 4 * hi), pack8(sc, step), o);
                __builtin_amdgcn_sched_barrier(0);
            }
        }
        {
            bf16x8 ib[4];
#pragma unroll
            for (int ks = 0; ks < 4; ++ks) ib[ks] = *(const bf16x8*)(itrow + rc + 16 * ks + 8 * hi);
#pragma unroll
            for (int t = 0; t < NX; ++t) {
#pragma unroll
                for (int i = 0; i < 16; ++i) X[t][i] *= dec[dk0 + 32 * t + crow(i, hi)];
#pragma unroll
                for (int ks = 0; ks < 4; ++ks) { const bf16x8 ka = *(const LAS bf16x8*)(KppT + ((dk0 + 32 * t + r32) * HG_KT_ROW + 16 * ks + 8 * hi) * 2); X[t] = MFMA32(ka, ib[ks], X[t]); }
                __builtin_amdgcn_sched_barrier(0);
            }
        }
        if (MAIN) {
            float q2 = 0.f;
#pragma unroll
            for (int i = 0; i < 16; ++i) q2 += o[i] * o[i];
            q2 += xor32f(q2); if (hi == 0) ssq[dvt * 64 + 32 * wh + r32] = q2;
        }
        __syncthreads();
        if (MAIN) {
            const int r32o = opq(r32), hio = opq(hi);
            const int c = 32 * wh + r32o; const float tot = ssq[c] + ssq[64 + c] + ssq[128 + c] + ssq[192 + c];
            const float rs = rsqrtf(tot * (1.f / 128.f) + LN_EPS);
            const size_t row = rc + c; const int col = h * 128 + 32 * dvt + 4 * hio;
#pragma unroll
            for (int a4 = 0; a4 < 4; ++a4) {
                const u32x2 gw = *(const u32x2*)(HFQG + row * 1536 + 1024 + col + 8 * a4); const f32x4 nw4 = *(const f32x4*)(nwv + col + 8 * a4);
                const float g0 = __uint_as_float(gw.x << 16), g1 = __uint_as_float(gw.x & 0xffff0000u), g2 = __uint_as_float(gw.y << 16), g3 = __uint_as_float(gw.y & 0xffff0000u);
                const float v0 = o[4 * a4] * rs * nw4[0] * g0 * fast_sigmoid(g0), v1 = o[4 * a4 + 1] * rs * nw4[1] * g1 * fast_sigmoid(g1);
                const float v2 = o[4 * a4 + 2] * rs * nw4[2] * g2 * fast_sigmoid(g2), v3 = o[4 * a4 + 3] * rs * nw4[3] * g3 * fast_sigmoid(g3);
                u32x2 wv; wv.x = cvtpk(v0, v1); wv.y = cvtpk(v2, v3);
                *(u32x2*)(BR + row * 1536 + 512 + col + 8 * a4) = wv;
            }
        }
    }
    if (!MAIN) {
        float* L = HSTL + (size_t)unit * 16384 + 32 * dvt + r32;
#pragma unroll
        for (int t = 0; t < NX; ++t)
#pragma unroll
            for (int i = 0; i < 16; ++i) L[(size_t)(dk0 + 32 * t + crow(i, hi)) * 128] = X[t][i];
        if (qt == 0) HSTD[(size_t)unit * 128 + dk] = __builtin_amdgcn_exp2f(atot);
    }
}
DI void hgrn_scan(const float* __restrict__ HSTL, const float* __restrict__ HSTD, float* __restrict__ SIN, int gt) {
    if (gt >= BPP * 4 * 16384) return;
    const int seq = gt >> 14, el = gt & 16383, dkk = el >> 7;
    float st = 0.f;
    for (int j = 0; j < HG_UPS; ++j) { const size_t uo = (size_t)(seq * HG_UPS + j); SIN[uo * 16384 + el] = st; st = HSTD[uo * 128 + dkk] * st + HSTL[uo * 16384 + el]; }
}

struct SchedRows {
    unsigned A, B; int K, nN, nU, G, c;
    DI bool next(int i, g8::Unit& u) const {
        const int L = i * G + c; if (L >= nU) return false;
        const int x = L & 7, off = L >> 3, grp = off / (8 * nN), o2 = off % (8 * nN);
        const int ppx = nU / nN / 8;
        u.pm = x * ppx + 8 * grp + (o2 & 7); u.pn = o2 >> 3; u.kind = 0; u.dlb = 1;
        u.a = A + (unsigned)u.pm * 256u * K * 2u; u.b = B + (unsigned)u.pn * 256u * K * 2u; return true;
    }
};
DI void unpack8(const u32x4 w, float (&f)[8]) {
    f[0] = __uint_as_float(w.x << 16); f[1] = __uint_as_float(w.x & 0xffff0000u); f[2] = __uint_as_float(w.y << 16); f[3] = __uint_as_float(w.y & 0xffff0000u);
    f[4] = __uint_as_float(w.z << 16); f[5] = __uint_as_float(w.z & 0xffff0000u); f[6] = __uint_as_float(w.w << 16); f[7] = __uint_as_float(w.w & 0xffff0000u);
}
struct EpiWidenF {
    static constexpr bool PERM = true, HOOK = true;
    const bf16_t* GATE; bf16_t* MERGED;
    DI void hook(f32x4 (&acc)[2][2][4][2], const g8::Unit& u, int t, int wr, int wc, int fr, int fq) const {
        if (t != 8 && t != 16) return;
        const int g = (t >> 3) - 1;
        const int row0 = u.pm * 256 + wr * 64 + fr, col0 = u.pn * 256 + wc * 32 + 8 * fq;
#pragma unroll
        for (int ai = 0; ai < 2; ++ai)
#pragma unroll
            for (int m = 0; m < 4; ++m) { const bf16_t* gp = GATE + (size_t)(row0 + ai * 128 + m * 16) * 3072 + g * 1024 + col0;
#pragma unroll
                for (int bj = 0; bj < 2; ++bj) { float ga[8], gb[8]; unpack8(*(const u32x4*)(gp + bj * 128), ga); unpack8(*(const u32x4*)(gp + 1024 + bj * 128), gb);
#pragma unroll
                    for (int e = 0; e < 4; ++e) { acc[ai][bj][m][0][e] *= ga[e] * __builtin_amdgcn_rcpf(gb[e]); acc[ai][bj][m][1][e] *= ga[4 + e] * __builtin_amdgcn_rcpf(gb[4 + e]); } } }
    }
    DI void operator()(const f32x4 (&acc)[2][2][4][2], const g8::Unit& u, int wr, int wc, int fr, int fq) const {
        const int row0 = u.pm * 256 + wr * 64 + fr, col0 = u.pn * 256 + wc * 32 + 8 * fq;
#pragma unroll
        for (int ai = 0; ai < 2; ++ai)
#pragma unroll
            for (int m = 0; m < 4; ++m) { const size_t row = (size_t)(row0 + ai * 128 + m * 16);
#pragma unroll
                for (int bj = 0; bj < 2; ++bj) { float gc[8]; unpack8(*(const u32x4*)(GATE + row * 3072 + 2048 + col0 + bj * 128), gc);
                    const f32x4 v0 = acc[ai][bj][m][0], v1 = acc[ai][bj][m][1];
                    u32x4 w; w.x = cvtpk(v0[0] * gc[0], v0[1] * gc[1]); w.y = cvtpk(v0[2] * gc[2], v0[3] * gc[3]); w.z = cvtpk(v1[0] * gc[4], v1[1] * gc[5]); w.w = cvtpk(v1[2] * gc[6], v1[3] * gc[7]);
                    *(u32x4*)(MERGED + row * 1024 + col0 + bj * 128) = w; } }
    }
};
struct EpiMixF32 {
    static constexpr bool PERM = false, HOOK = false;
    float* C;
    DI void hook(f32x4 (&)[2][2][4][2], const g8::Unit&, int, int, int, int, int) const {}
    DI void operator()(const f32x4 (&acc)[2][2][4][2], const g8::Unit& u, int wr, int wc, int fr, int fq) const {
        const int col0 = u.pn * 256 + wc * 32 + 4 * fq;
#pragma unroll
        for (int ai = 0; ai < 2; ++ai)
#pragma unroll
            for (int m = 0; m < 4; ++m) { float* rp = C + (size_t)(u.pm * 256 + ai * 128 + wr * 64 + m * 16 + fr) * 1024 + col0;
#pragma unroll
                for (int bj = 0; bj < 2; ++bj)
#pragma unroll
                    for (int n = 0; n < 2; ++n) *(f32x4*)(rp + bj * 128 + n * 16) = acc[ai][bj][m][n]; }
    }
};
struct EpiPlainB16 {
    static constexpr bool PERM = true, HOOK = false;
    bf16_t* C; int ldc, pad;
    DI void hook(f32x4 (&)[2][2][4][2], const g8::Unit&, int, int, int, int, int) const {}
    DI void operator()(const f32x4 (&acc)[2][2][4][2], const g8::Unit& u, int wr, int wc, int fr, int fq) const {
        const int row0 = u.pm * 256 + wr * 64 + fr, col0 = u.pn * 256 + wc * 32 + 8 * fq;
#pragma unroll
        for (int ai = 0; ai < 2; ++ai)
#pragma unroll
            for (int m = 0; m < 4; ++m) { bf16_t* rowp = C + (size_t)(row0 + ai * 128 + m * 16) * ldc + col0;
#pragma unroll
                for (int bj = 0; bj < 2; ++bj) { const f32x4 v0 = acc[ai][bj][m][0], v1 = acc[ai][bj][m][1];
                    u32x4 w; w.x = cvtpk(v0[0], v0[1]); w.y = cvtpk(v0[2], v0[3]); w.z = cvtpk(v1[0], v1[1]); w.w = cvtpk(v1[2], v1[3]);
                    *(u32x4*)(rowp + bj * 128) = w; } }
    }
};
DI void lse_merge_items(const bf16_t* __restrict__ OG, const float* __restrict__ LSE, bf16_t* __restrict__ BR, int first, int stride) {
    for (int it = first; it < MP * 64; it += stride) {
        const int row = it >> 6, c8 = it & 63, h = c8 >> 4;
        const float l0 = LSE[(size_t)row * 12 + h], l1 = LSE[(size_t)row * 12 + 4 + h], l2 = LSE[(size_t)row * 12 + 8 + h];
        const float mx = fmaxf(l0, fmaxf(l1, l2)); const float e0 = __expf(l0 - mx), e1 = __expf(l1 - mx), e2 = __expf(l2 - mx); const float inv = 1.f / (e0 + e1 + e2);
        const bf16_t* og = OG + (size_t)row * 1536 + c8 * 8;
        float a[8], b[8], c[8]; unpack8(*(const u32x4*)og, a); unpack8(*(const u32x4*)(og + 512), b); unpack8(*(const u32x4*)(og + 1024), c);
        float r[8];
#pragma unroll
        for (int e = 0; e < 8; ++e) r[e] = (e0 * a[e] + e1 * b[e] + e2 * c[e]) * inv;
        u32x4 w; w.x = cvtpk(r[0], r[1]); w.y = cvtpk(r[2], r[3]); w.z = cvtpk(r[4], r[5]); w.w = cvtpk(r[6], r[7]);
        *(u32x4*)(BR + (size_t)row * 1536 + c8 * 8) = w;
    }
}
DI void ln1_rows(const float* __restrict__ x, const float* __restrict__ mix, const float* __restrict__ g, const float* __restrict__ b, float* __restrict__ h1f, bf16_t* __restrict__ h1b, int wave0, int nwaves, int lane) {
    for (int row = wave0; row < MP; row += nwaves) {
        const f32x4* xr = (const f32x4*)(x + (size_t)row * D) + lane; const f32x4* mr = (const f32x4*)(mix + (size_t)row * D) + lane;
        f32x4 v[4]; float s = 0.f;
#pragma unroll
        for (int j = 0; j < 4; ++j) { v[j] = xr[64 * j] * ALPHA + mr[64 * j]; s += (v[j][0] + v[j][1]) + (v[j][2] + v[j][3]); }
        const float mean = wave_sum(s) * (1.f / D); float q = 0.f;
#pragma unroll
        for (int j = 0; j < 4; ++j) { v[j] = v[j] - mean; q += (v[j][0] * v[j][0] + v[j][1] * v[j][1]) + (v[j][2] * v[j][2] + v[j][3] * v[j][3]); }
        const float rstd = rsqrtf(wave_sum(q) * (1.f / D) + LN_EPS);
#pragma unroll
        for (int j = 0; j < 4; ++j) { const f32x4 gg = ((const f32x4*)g)[lane + 64 * j], bb = ((const f32x4*)b)[lane + 64 * j]; const f32x4 o = v[j] * rstd * gg + bb;
            ((f32x4*)(h1f + (size_t)row * D))[lane + 64 * j] = o; u32x2 w; w.x = cvtpk(o[0], o[1]); w.y = cvtpk(o[2], o[3]); ((u32x2*)(h1b + (size_t)row * D))[lane + 64 * j] = w; }
    }
}

DI unsigned mono(float f) { const unsigned u = __float_as_uint(f); return (u & 0x80000000u) ? ~u : (u | 0x80000000u); }
DI float demono(unsigned m) { return __uint_as_float((m & 0x80000000u) ? (m & 0x7fffffffu) : ~m); }
#define CE_DESC(a, b) do { const unsigned _hi = (a) > (b) ? (a) : (b), _lo = (a) > (b) ? (b) : (a); (a) = _hi; (b) = _lo; } while (0)
DI void sort16_desc(unsigned (&k)[16]) {
#pragma unroll
    for (int size = 2; size <= 16; size <<= 1)
#pragma unroll
        for (int stride = size >> 1; stride > 0; stride >>= 1)
#pragma unroll
            for (int i = 0; i < 16; ++i) { const int j = i ^ stride;
                if (j > i) { if ((i & size) == 0 || size == 16) CE_DESC(k[i], k[j]); else CE_DESC(k[j], k[i]); } }
}
DI void merge_top16(unsigned (&t)[16], const unsigned (&l)[16]) {
#pragma unroll
    for (int i = 0; i < 16; ++i) t[i] = t[i] > l[15 - i] ? t[i] : l[15 - i];
#pragma unroll
    for (int stride = 8; stride > 0; stride >>= 1)
#pragma unroll
        for (int i = 0; i < 16; ++i) { const int j = i ^ stride; if (j > i) CE_DESC(t[i], t[j]); }
}
constexpr int RT_ROW = 136;
constexpr int RT_LDS_BYTES = 2 * 128 * RT_ROW * 2;
DI void route_wave(const bf16_t* __restrict__ PQ, const LAS unsigned char* keys, int* __restrict__ IDX, float* __restrict__ PG, int tb, int h, int lane) {
    const int r32 = lane & 31, hi = lane >> 5;
    const size_t tok = (size_t)tb * 32 + r32;
    unsigned Tp[2][16];
#pragma unroll
    for (int p = 0; p < 2; ++p) {
        bf16x8 qf[8];
        const bf16_t* qp = PQ + tok * 2048 + h * 256 + p * 128 + 8 * hi;
#pragma unroll
        for (int ks = 0; ks < 8; ++ks) qf[ks] = *(const bf16x8*)(qp + 16 * ks);
#pragma unroll
        for (int nt = 0; nt < 4; ++nt) {
            f32x16 acc;
#pragma unroll
            for (int i = 0; i < 16; ++i) acc[i] = 0.f;
#pragma unroll
            for (int ks = 0; ks < 8; ++ks) { const bf16x8 kf = *(const LAS bf16x8*)(keys + ((p * 128 + 32 * nt + r32) * RT_ROW + 16 * ks + 8 * hi) * 2); acc = MFMA32(kf, qf[ks], acc); }
            unsigned L[16];
#pragma unroll
            for (int i = 0; i < 16; ++i) L[i] = (mono(acc[i]) & ~0x7fu) | (unsigned)(127 - (32 * nt + crow(i, hi)));
            sort16_desc(L);
            if (nt == 0) {
#pragma unroll
                for (int i = 0; i < 16; ++i) Tp[p][i] = L[i];
            } else merge_top16(Tp[p], L);
            __builtin_amdgcn_sched_barrier(0);
        }
    }
    unsigned T[16];
    { unsigned O[16];
#pragma unroll
      for (int i = 0; i < 16; ++i) { const auto rr = __builtin_amdgcn_permlane32_swap(Tp[0][i], Tp[1][i], false, false); T[i] = rr[0]; O[i] = rr[1]; }
      merge_top16(T, O); }
    __builtin_amdgcn_sched_barrier(0);
    float s1[16], s2[16]; unsigned i1[16], i2[16];
#pragma unroll
    for (int i = 0; i < 16; ++i) { const auto rr = __builtin_amdgcn_permlane32_swap(T[i], T[i], false, false);
        s1[i] = demono(rr[0] & ~0x7fu); i1[i] = 127u - (rr[0] & 0x7fu); s2[i] = demono(rr[1] & ~0x7fu); i2[i] = 127u - (rr[1] & 0x7fu); }
    unsigned C[64];
    { int n = 0;
#pragma unroll
      for (int a = 0; a < 16; ++a)
#pragma unroll
          for (int b = 0; b < 16; ++b) if ((a + 1) * (b + 1) <= 16) { C[n] = (mono(s1[a] + s2[b]) & ~0x3fffu) | (i1[a] << 7) | i2[b]; ++n; }
#pragma unroll
      for (int i = 50; i < 64; ++i) C[i] = 0u; }
    unsigned F[16];
#pragma unroll
    for (int i = 0; i < 16; ++i) F[i] = C[i];
    sort16_desc(F);
#pragma unroll
    for (int g = 1; g < 4; ++g) { unsigned L[16];
#pragma unroll
        for (int i = 0; i < 16; ++i) L[i] = C[16 * g + i];
        sort16_desc(L); merge_top16(F, L); __builtin_amdgcn_sched_barrier(0); }
    if (hi == 0) {
        float e[16]; float sum = 0.f; const float v0 = demono(F[0] & ~0x3fffu);
#pragma unroll
        for (int i = 0; i < 16; ++i) { e[i] = __expf(demono(F[i] & ~0x3fffu) - v0); sum += e[i]; }
        const float inv = 1.f / sum;
        int* ip = IDX + tok * 128 + h * 16; float* gp = PG + tok * 128 + h * 16;
#pragma unroll
        for (int q = 0; q < 4; ++q) { u32x4 iv; iv.x = F[4 * q] & 0x3fffu; iv.y = F[4 * q + 1] & 0x3fffu; iv.z = F[4 * q + 2] & 0x3fffu; iv.w = F[4 * q + 3] & 0x3fffu; *(u32x4*)(ip + 4 * q) = iv;
            f32x4 gv; gv[0] = e[4 * q] * inv; gv[1] = e[4 * q + 1] * inv; gv[2] = e[4 * q + 2] * inv; gv[3] = e[4 * q + 3] * inv; *(f32x4*)(gp + 4 * q) = gv; }
    }
}
typedef __bf16 bf16x2v __attribute__((ext_vector_type(2)));
DI float dot2bf(unsigned w, unsigned x, float acc) { return __builtin_amdgcn_fdot2_f32_bf16(__builtin_bit_cast(bf16x2v, w), __builtin_bit_cast(bf16x2v, x), acc, false); }
DI float gelu_erf(float v) {
    const float av = fabsf(v), t = __builtin_amdgcn_rcpf(av * 0.2316418882f + 1.0f);
    float q = t * 0.5307027145f + (-0.7265760135f); q = q * t + 0.7107068705f; q = q * t + (-0.142248368f); q = q * t + 0.127414796f; q = q * t;
    const float e = __builtin_amdgcn_exp2f((v * v) * (-0.72134752044f)); const float m = v * (q * e);
    return v < 0.f ? m : v - m;
}
DI void experts_token(const bf16_t* __restrict__ H1B, const bf16_t* __restrict__ UB, const bf16_t* __restrict__ VB, const int* __restrict__ IDX, const float* __restrict__ PG,
                      const float* __restrict__ g2, const float* __restrict__ b2, float* outp, size_t tok, int lane) {
    const u32x4 hb0 = *(const u32x4*)(H1B + tok * D + 8 * lane), hb1 = *(const u32x4*)(H1B + tok * D + 512 + 8 * lane);
    const int ilo = IDX[tok * 128 + lane], ihi = IDX[tok * 128 + 64 + lane];
    float clo, chi;
#pragma unroll
    for (int half = 0; half < 2; ++half) {
        float p[64];
#pragma unroll
        for (int e = 0; e < 64; ++e) {
            const int row = __builtin_amdgcn_readlane(half ? ihi : ilo, e);
            const u32x4* up = (const u32x4*)(UB + (size_t)row * D);
            const u32x4 w0 = up[lane], w1 = up[64 + lane];
            float d = dot2bf(w0.x, hb0.x, 0.f); d = dot2bf(w0.y, hb0.y, d); d = dot2bf(w0.z, hb0.z, d); d = dot2bf(w0.w, hb0.w, d);
            d = dot2bf(w1.x, hb1.x, d); d = dot2bf(w1.y, hb1.y, d); d = dot2bf(w1.z, hb1.z, d); d = dot2bf(w1.w, hb1.w, d);
            p[e] = d;
        }
#pragma unroll
        for (int i = 0; i < 32; ++i) { const auto rr = __builtin_amdgcn_permlane32_swap(__float_as_uint(p[i]), __float_as_uint(p[i + 32]), false, false); p[i] = __uint_as_float(rr[0]) + __uint_as_float(rr[1]); }
#pragma unroll
        for (int m = 16; m >= 1; m >>= 1) {
            const bool up = (lane & m) != 0;
#pragma unroll
            for (int i = 0; i < m; ++i) { const float send = up ? p[i] : p[i + m], keep = up ? p[i + m] : p[i]; p[i] = keep + __shfl_xor(send, m); }
        }
        const float c = PG[tok * 128 + 64 * half + lane] * gelu_erf(p[0]);
        if (half) chi = c; else clo = c;
    }
    float f[16];
#pragma unroll
    for (int i = 0; i < 16; ++i) f[i] = 0.f;
#pragma unroll 4
    for (int e = 0; e < 128; ++e) {
        const int row = __builtin_amdgcn_readlane(e < 64 ? ilo : ihi, e & 63);
        const float c = __builtin_bit_cast(float, __builtin_amdgcn_readlane(__builtin_bit_cast(int, e < 64 ? clo : chi), e & 63));
        const u32x4* vp = (const u32x4*)(VB + (size_t)row * D);
        const u32x4 w0 = vp[lane], w1 = vp[64 + lane];
#pragma unroll
        for (int q = 0; q < 4; ++q) { f[2 * q] += c * __uint_as_float(w0[q] << 16); f[2 * q + 1] += c * __uint_as_float(w0[q] & 0xffff0000u);
            f[8 + 2 * q] += c * __uint_as_float(w1[q] << 16); f[8 + 2 * q + 1] += c * __uint_as_float(w1[q] & 0xffff0000u); }
    }
    float* hr = outp + tok * D;
    f32x4 v[4]; v[0] = *(const f32x4*)(hr + 8 * lane); v[1] = *(const f32x4*)(hr + 8 * lane + 4); v[2] = *(const f32x4*)(hr + 512 + 8 * lane); v[3] = *(const f32x4*)(hr + 512 + 8 * lane + 4);
    float s = 0.f;
#pragma unroll
    for (int j = 0; j < 4; ++j)
#pragma unroll
        for (int e = 0; e < 4; ++e) { v[j][e] = v[j][e] * ALPHA + f[4 * j + e]; s += v[j][e]; }
    const float mean = wave_sum(s) * (1.f / D); float q2 = 0.f;
#pragma unroll
    for (int j = 0; j < 4; ++j)
#pragma unroll
        for (int e = 0; e < 4; ++e) { v[j][e] -= mean; q2 += v[j][e] * v[j][e]; }
    const float rstd = rsqrtf(wave_sum(q2) * (1.f / D) + LN_EPS);
#pragma unroll
    for (int j = 0; j < 4; ++j) { const int c0 = (j >> 1) * 512 + 8 * lane + 4 * (j & 1); const f32x4 gg = *(const f32x4*)(g2 + c0), bb = *(const f32x4*)(b2 + c0); *(f32x4*)(hr + c0) = v[j] * rstd * gg + bb; }
}

DI void p0_convert(const float* __restrict__ in, bf16_t* __restrict__ out, size_t n8, size_t first, size_t stride) {
    for (size_t i = first; i < n8; i += stride) { const f32x4 a = ((const f32x4*)in)[2 * i], b = ((const f32x4*)in)[2 * i + 1];
        u32x4 w; w.x = cvtpk(a[0], a[1]); w.y = cvtpk(a[2], a[3]); w.z = cvtpk(b[0], b[1]); w.w = cvtpk(b[2], b[3]); ((u32x4*)out)[i] = w; }
}
DI void p0_transpose_item(const float* __restrict__ W, int ldw, int ncols, bf16_t* __restrict__ out, int ldo, int koff, LAS float* scr, int item, int lane) {
    const int nblk = ncols / 32, kb = item / nblk, nb = item % nblk, k0 = 64 * kb, n0 = 32 * nb;
#pragma unroll 8
    for (int i = 0; i < 32; ++i) { const int kk = 2 * i + (lane >> 5); scr[kk * 33 + (lane & 31)] = W[(size_t)(k0 + kk) * ldw + n0 + (lane & 31)]; }
    asm volatile("s_waitcnt lgkmcnt(0)" ::: "memory");
    const int c = lane & 7;
#pragma unroll
    for (int j = 0; j < 4; ++j) { const int n = (lane >> 3) + 8 * j; const LAS float* s = scr + (8 * c) * 33 + n;
        u32x4 o; o.x = cvtpk(s[0 * 33], s[1 * 33]); o.y = cvtpk(s[2 * 33], s[3 * 33]); o.z = cvtpk(s[4 * 33], s[5 * 33]); o.w = cvtpk(s[6 * 33], s[7 * 33]);
        *(u32x4*)(out + (size_t)(n0 + n) * ldo + koff + k0 + 8 * c) = o; }
    asm volatile("s_waitcnt lgkmcnt(0)" ::: "memory");
}
DI void p0_misc(const float* __restrict__ hgrn_lb, const float* __restrict__ rel_bias, float* __restrict__ misc, int i) {
    if (i < 512) { const float a = hgrn_lb[i], b = hgrn_lb[512 + i]; const float mx = fmaxf(a, b); const float ea = expf(a - mx), eb = expf(b - mx); misc[i] = ea / (ea + eb); }
    if (i < 3 * 129) {
        const int g = i / 129, j = i % 129; const int dl = g == 0 ? 1 : (g == 1 ? 4 : 16); const int n = j * dl;
        int bucket;
        if (n < 16) bucket = n;
        else { const double v = log((double)n / 16.0) / log(128.0) * 16.0; int l = 16 + (int)v; bucket = l < 31 ? l : 31; }
        for (int h = 0; h < 4; ++h) misc[512 + i * 4 + h] = rel_bias[bucket * 12 + g * 4 + h];
    }
}
struct SchedMemKV {
    unsigned MEMB, W; int G, c;
    DI bool next(int i, g8::Unit& u) const {
        const int L = i * G + c; if (L >= 32) return false;
        u.dlb = 1;
        if (L < 16) { u.kind = 0; u.pm = L >> 1; u.pn = L & 1; u.a = MEMB + (unsigned)u.pm * 256u * D * 2u; u.b = W + (unsigned)u.pn * 256u * D * 2u; }
        else { const int q = L - 16; u.kind = 1; u.pm = q >> 3; u.pn = q & 7; u.a = W + (unsigned)(512 + u.pm * 256) * D * 2u; u.b = MEMB + (unsigned)u.pn * 256u * D * 2u; }
        return true;
    }
};
struct EpiMemKVF {
    static constexpr bool PERM = true, HOOK = false;
    bf16_t *MK, *MVT;
    DI void hook(f32x4 (&)[2][2][4][2], const g8::Unit&, int, int, int, int, int) const {}
    DI void operator()(const f32x4 (&acc)[2][2][4][2], const g8::Unit& u, int wr, int wc, int fr, int fq) const {
        bf16_t* base = u.kind ? MVT : MK; const int ldc = u.kind ? 2048 : 512;
        const int row0 = u.pm * 256 + wr * 64 + fr, col0 = u.pn * 256 + wc * 32 + 8 * fq;
#pragma unroll
        for (int ai = 0; ai < 2; ++ai)
#pragma unroll
            for (int m = 0; m < 4; ++m) { bf16_t* rowp = base + (size_t)(row0 + ai * 128 + m * 16) * ldc + col0;
#pragma unroll
                for (int bj = 0; bj < 2; ++bj) { const f32x4 v0 = acc[ai][bj][m][0], v1 = acc[ai][bj][m][1];
                    u32x4 w; w.x = cvtpk(v0[0], v0[1]); w.y = cvtpk(v0[2], v0[3]); w.z = cvtpk(v1[0], v1[1]); w.w = cvtpk(v1[2], v1[3]);
                    *(u32x4*)(rowp + bj * 128) = w; } }
    }
};

static_assert(HG_UNIT_BYTES <= LDSCTL_OFF, "hgrn LDS");
DI const float* karg_in(int i) { const float* const* kp = (const float* const*)__builtin_amdgcn_kernarg_segment_ptr(); asm volatile("" : "+s"(kp)); return kp[i]; }
DI float* karg_out() { float* const* kp = (float* const*)__builtin_amdgcn_kernarg_segment_ptr(); asm volatile("" : "+s"(kp)); return kp[18]; }
__global__ void __launch_bounds__(NTHR, 2) mega(Args args) {
    extern __shared__ __attribute__((aligned(16))) unsigned char lds_raw[];
    LAS unsigned char* lds = (LAS unsigned char*)lds_raw;
    volatile LAS unsigned* MISC = (volatile LAS unsigned*)(lds + MISC_OFF);
    for (int u = threadIdx.x; u < (LDS_BYTES - LDSCTL_OFF) / 4; u += NTHR) ((LAS unsigned*)(lds + LDSCTL_OFF))[u] = 0u;
    __syncthreads();
    unsigned char* ws = args.ws;
    const int G = gridDim.x;
    const bool ALL = args.ph == PH_ALL;
    XcdBarrier bar; bar.bar = (unsigned*)(ws + O_MISC + 16384); bar.x = 0; bar.st = nullptr;
    if (ALL) bar = xcd_barrier_post((unsigned*)(ws + O_MISC + 16384), MISC + 8);
#ifndef REP_MASK
#define REP_MASK 0
#endif
#define RUN(k) (ALL || args.ph == (k))
#define NREP(k) (((REP_MASK >> (k)) & 1) ? 2 : 1)
#define SEAM() do { if (ALL) xcd_barrier(bar); } while (0)
    for (int rep_ = 0; rep_ < NREP(PH_PRO); ++rep_) if (RUN(PH_PRO)) {
        int tid = threadIdx.x; asm volatile("" : "+v"(tid)); asm volatile("" : "+s"(ws)); int bid = blockIdx.x; asm volatile("" : "+s"(bid));
        const size_t gt = (size_t)bid * NTHR + tid, nth = (size_t)G * NTHR;
        p0_convert(karg_in(0), (bf16_t*)(ws + O_XB), (size_t)M * D / 8, gt, nth);
        p0_convert(karg_in(1), (bf16_t*)(ws + O_MEMB), (size_t)2048 * 1024 / 8, gt, nth);
        p0_convert(karg_in(13), (bf16_t*)(ws + O_SUBK), (size_t)16 * 128 * 128 / 8, gt, nth);
        p0_convert(karg_in(14), (bf16_t*)(ws + O_UB), (size_t)NEXP * D / 8, gt, nth);
        p0_convert(karg_in(15), (bf16_t*)(ws + O_VB), (size_t)NEXP * D / 8, gt, nth);
        if (bid == 0) p0_misc(karg_in(6), karg_in(5), (float*)(ws + O_MISC), tid);
        const int wid = __builtin_amdgcn_readfirstlane(tid >> 6), lane = tid & 63;
        LAS float* scr = (LAS float*)(lds + wid * 16384);
        const int gw = bid * NWAVES + wid, ngw = G * NWAVES;
        constexpr int NJ = 13;
        for (int it = gw; ; it += ngw) {
            int r = it; bool done = true;
#pragma unroll
            for (int j = 0; j < NJ; ++j) {
                const int srcc[NJ] = {0, 4608, 5632, 6656, 7168, 3072, 5120, 0, 0, 0, 0, 0, 0};
                const int cnt[NJ] = {3072, 512, 1024, 512, 3072, 1536, 512, 1024, 1024, 1024, 1024, 1024, 2048};
                const int drow[NJ] = {0, 3072, 3584, 4608, 5120, 8192, 9728, 0, 0, 0, 0, 0, 0};
                const int Kj = (j >= 8 && j <= 10) ? 512 : 1024;
                const int items = (Kj / 64) * (cnt[j] / 32);
                if (done && r < items) {
                    const float* W; int ldw; bf16_t* o; int ldo, koff = 0;
                    if (j < 7) { W = karg_in(2) + srcc[j]; ldw = INC; o = (bf16_t*)(ws + O_WIN) + (size_t)drow[j] * 1024; ldo = 1024; }
                    else if (j == 7) { W = karg_in(4); ldw = 1024; o = (bf16_t*)(ws + O_WMKV); ldo = 1024; }
                    else if (j <= 10) { W = karg_in(8) + (size_t)(j - 8) * 512 * 1024; ldw = 1024; o = (bf16_t*)(ws + O_WBR); ldo = 1536; koff = (j - 8) * 512; }
                    else if (j == 11) { W = karg_in(9); ldw = 1024; o = (bf16_t*)(ws + O_WOUT); ldo = 1024; }
                    else { W = karg_in(12); ldw = 2048; o = (bf16_t*)(ws + O_WPQ); ldo = 1024; }
                    p0_transpose_item(W, ldw, cnt[j], o, ldo, koff, scr, r, lane); done = false;
                }
                r -= items;
            }
            if (done) break;
        }
        SEAM();
    }
#pragma unroll 1
    for (int p = (ALL ? 0 : args.pass); p < (ALL ? NPASS : args.pass + 1); ++p) {
        int bid = blockIdx.x; asm volatile("" : "+s"(bid));
        int tid = threadIdx.x; asm volatile("" : "+v"(tid));
        asm volatile("" : "+s"(ws));
        char* pr = (char*)ws + O_PASS;
        const size_t t0 = (size_t)p * MP;
        for (int rep_ = 0; rep_ < NREP(PH_PROJ); ++rep_) if (RUN(PH_PROJ)) {
            asm volatile("" : "+s"(bid)); asm volatile("" : "+v"(tid)); asm volatile("" : "+s"(ws)); pr = (char*)ws + O_PASS;
            SchedP1 Sc{(unsigned)(O_XB + t0 * D * 2), (unsigned)O_WIN, G, bid};
            EpiP1 E{pr, karg_in(3)};
            g8::gemm_phase<EpiP1, SchedP1>(lds, (const char*)ws, D, Sc, E, tid);
            if (p == 0) {
                SchedMemKV S2{(unsigned)O_MEMB, (unsigned)O_WMKV, G, bid};
                EpiMemKVF E2{(bf16_t*)(ws + O_MK), (bf16_t*)(ws + O_MVT)};
                g8::gemm_phase<EpiMemKVF, SchedMemKV>(lds, (const char*)ws, D, S2, E2, tid);
            }
            SEAM();
        }
        for (int rep_ = 0; rep_ < NREP(PH_ATTN); ++rep_) if (RUN(PH_ATTN)) {
            asm volatile("" : "+s"(bid)); asm volatile("" : "+v"(tid)); asm volatile("" : "+s"(ws)); pr = (char*)ws + O_PASS;
            const float* bsrc = (const float*)(ws + O_MISC) + 512; LAS float* btab = (LAS float*)lds;
            for (int i = tid; i < 3 * 129 * 4; i += NTHR) btab[i] = bsrc[i] * LOG2E;
            __syncthreads();
            const int wid = __builtin_amdgcn_readfirstlane(tid >> 6), lane = tid & 63;
            for (int task = bid * NWAVES + wid; task < DIL_TASKS; task += G * NWAVES)
                attn_dil_wave((const bf16_t*)(pr + P_QK), (const bf16_t*)(pr + P_VT), btab, (bf16_t*)(pr + P_OG), (float*)(pr + P_LSE), task, lane);
            for (int task = bid * NWAVES + wid; task < MEM_TASKS; task += G * NWAVES)
                attn_mem_wave((const bf16_t*)(pr + P_MQ), (const bf16_t*)(ws + O_MK), (const bf16_t*)(ws + O_MVT), (bf16_t*)(pr + P_BR), task, p * BPP, lane);
            __syncthreads();
        }
        for (int rep_ = 0; rep_ < NREP(PH_HGPRE); ++rep_) if (RUN(PH_HGPRE)) {
            asm volatile("" : "+s"(bid)); asm volatile("" : "+v"(tid)); asm volatile("" : "+s"(ws)); pr = (char*)ws + O_PASS;
            { const int unit = bid; static_assert(HG_UNITS == 256, "one HGRN unit per workgroup"); if (unit < HG_UNITS) {
                hgrn_unit<false>(lds, unit, tid, (const bf16_t*)(pr + P_HFQG), (const bf16_t*)(pr + P_IT), (const float*)(ws + O_MISC), karg_in(7),
                                 (float*)(pr + P_HSTL), (float*)(pr + P_HSTD), (const float*)(pr + P_SIN), (bf16_t*)(pr + P_BR));
            } }
            SEAM();
        }
        for (int rep_ = 0; rep_ < NREP(PH_HGSCAN); ++rep_) if (RUN(PH_HGSCAN)) {
            asm volatile("" : "+s"(bid)); asm volatile("" : "+v"(tid)); asm volatile("" : "+s"(ws)); pr = (char*)ws + O_PASS;
            hgrn_scan((const float*)(pr + P_HSTL), (const float*)(pr + P_HSTD), (float*)(pr + P_SIN), bid * NTHR + tid);
            lse_merge_items((const bf16_t*)(pr + P_OG), (const float*)(pr + P_LSE), (bf16_t*)(pr + P_BR), bid * NTHR + tid, G * NTHR);
            SEAM();
        }
        for (int rep_ = 0; rep_ < NREP(PH_HGMAIN); ++rep_) if (RUN(PH_HGMAIN)) {
            asm volatile("" : "+s"(bid)); asm volatile("" : "+v"(tid)); asm volatile("" : "+s"(ws)); pr = (char*)ws + O_PASS;
            { const int unit = bid; static_assert(HG_UNITS == 256, "one HGRN unit per workgroup"); if (unit < HG_UNITS) {
                hgrn_unit<true>(lds, unit, tid, (const bf16_t*)(pr + P_HFQG), (const bf16_t*)(pr + P_IT), (const float*)(ws + O_MISC), karg_in(7),
                                (float*)(pr + P_HSTL), (float*)(pr + P_HSTD), (const float*)(pr + P_SIN), (bf16_t*)(pr + P_BR));
            } }
            SEAM();
        }
        for (int rep_ = 0; rep_ < NREP(PH_WIDEN); ++rep_) if (RUN(PH_WIDEN)) {
            asm volatile("" : "+s"(bid)); asm volatile("" : "+v"(tid)); asm volatile("" : "+s"(ws)); pr = (char*)ws + O_PASS;
            SchedRows Sc{(unsigned)(O_PASS + P_BR), (unsigned)O_WBR, 1536, 4, 256, G, bid};
            EpiWidenF E{(const bf16_t*)(pr + P_GATE), (bf16_t*)(pr + P_MERGED)};
            g8::gemm_phase<EpiWidenF, SchedRows>(lds, (const char*)ws, 1536, Sc, E, tid);
            SEAM();
        }
        for (int rep_ = 0; rep_ < NREP(PH_WOUT); ++rep_) if (RUN(PH_WOUT)) {
            asm volatile("" : "+s"(bid)); asm volatile("" : "+v"(tid)); asm volatile("" : "+s"(ws)); pr = (char*)ws + O_PASS;
            SchedRows Sc{(unsigned)(O_PASS + P_MERGED), (unsigned)O_WOUT, 1024, 4, 256, G, bid};
            EpiMixF32 E{(float*)(pr + P_MIX)};
            g8::gemm_phase<EpiMixF32, SchedRows>(lds, (const char*)ws, 1024, Sc, E, tid);
            SEAM();
        }
        for (int rep_ = 0; rep_ < NREP(PH_LN1); ++rep_) if (RUN(PH_LN1)) {
            asm volatile("" : "+s"(bid)); asm volatile("" : "+v"(tid)); asm volatile("" : "+s"(ws)); pr = (char*)ws + O_PASS;
            ln1_rows(karg_in(0) + t0 * D, (const float*)(pr + P_MIX), karg_in(10), karg_in(11), karg_out() + t0 * D, (bf16_t*)(ws + O_H1B) + t0 * D, bid * NWAVES + (tid >> 6), G * NWAVES, tid & 63);
        }
    }
    for (int rep_ = 0; rep_ < NREP(PH_PQ); ++rep_) if (RUN(PH_PQ)) {
        SEAM();
        int tid = threadIdx.x; asm volatile("" : "+v"(tid)); asm volatile("" : "+s"(ws)); int bid = blockIdx.x; asm volatile("" : "+s"(bid));
        char* pr = (char*)ws + O_PASS;
        SchedRows Sc{(unsigned)O_H1B, (unsigned)O_WPQ, 1024, 8, 2048, G, bid};
        EpiPlainB16 E{(bf16_t*)(pr + P_PQ), 2048, 0};
        g8::gemm_phase<EpiPlainB16, SchedRows>(lds, (const char*)ws, 1024, Sc, E, tid);
        SEAM();
    }
    for (int rep_ = 0; rep_ < NREP(PH_ROUTE); ++rep_) if (RUN(PH_ROUTE)) {
        int tid = threadIdx.x; asm volatile("" : "+v"(tid)); asm volatile("" : "+s"(ws)); int bid = blockIdx.x; asm volatile("" : "+s"(bid));
        char* pr = (char*)ws + O_PASS;
        const int h = bid & 7, wgi = bid >> 3, nwg = G >> 3;
        const bf16_t* ksrc = (const bf16_t*)(ws + O_SUBK) + (size_t)h * 2 * 128 * 128;
        for (int i = tid; i < 2 * 128 * 16; i += NTHR) { const int rowk = i >> 4, ch = i & 15; *(LAS u32x4*)(lds + (rowk * RT_ROW + ch * 8) * 2) = *(const u32x4*)(ksrc + rowk * 128 + ch * 8); }
        __syncthreads();
        const int wid = __builtin_amdgcn_readfirstlane(tid >> 6), lane = tid & 63;
        for (int tb = wgi * NWAVES + wid; tb < M / 32; tb += nwg * NWAVES)
            route_wave((const bf16_t*)(pr + P_PQ), lds, (int*)(pr + P_IDX), (float*)(pr + P_PG), tb, h, lane);
        __syncthreads();
        SEAM();
    }
    if (RUN(PH_EXPERTS)) {
        int tid = threadIdx.x; asm volatile("" : "+v"(tid)); asm volatile("" : "+s"(ws)); int bid = blockIdx.x; asm volatile("" : "+s"(bid));
        char* pr = (char*)ws + O_PASS;
        const int wid = __builtin_amdgcn_readfirstlane(tid >> 6), lane = tid & 63;
        for (int tok = bid * NWAVES + wid; tok < M; tok += G * NWAVES)
            experts_token((const bf16_t*)(ws + O_H1B), (const bf16_t*)(ws + O_UB), (const bf16_t*)(ws + O_VB), (const int*)(pr + P_IDX), (const float*)(pr + P_PG), karg_in(16), karg_in(17), karg_out(), (size_t)tok, lane);
    }
#undef RUN
#undef SEAM
}

extern "C" void kernel_launch(void* const* d_in, const int* in_sizes, int n_in, void* d_out, int out_size, void* d_ws, size_t ws_size, hipStream_t stream) {
    if (ws_size < WS_NEED || n_in != 18) return;
    static bool attr_set = false;
    if (!attr_set) { (void)hipFuncSetAttribute((const void*)mega, hipFuncAttributeMaxDynamicSharedMemorySize, LDS_BYTES); attr_set = true; }
    (void)hipMemsetAsync((char*)d_ws + O_MISC + 16384, 0, 16384, stream);
    Args a{}; for (int i = 0; i < 18; ++i) a.in[i] = (const float*)d_in[i]; a.out = (float*)d_out; a.ws = (unsigned char*)d_ws; a.ph = PH_ALL; a.pass = 0;
    mega<<<256, NTHR, LDS_BYTES, stream>>>(a);
}
```

```cpp
#include <hip/hip_runtime.h>
#include <stdint.h>
#include <math.h>

typedef unsigned short bf16_t;
typedef short bf16x8 __attribute__((ext_vector_type(8)));
typedef float f32x4 __attribute__((ext_vector_type(4)));
#define DI __device__ __forceinline__

DI float bf2f(bf16_t v) { return __uint_as_float(((unsigned)v) << 16); }
DI bf16_t f2bf(float f) { unsigned u = __float_as_uint(f); u += 0x7fffu + ((u >> 16) & 1u); return (bf16_t)(u >> 16); }

constexpr int NB = 8, S = 8192, D = 1024, M = NB * S;
constexpr int NPASS = 4, BPP = NB / NPASS, MP = BPP * S;
constexpr int INC = 10240;
constexpr int NEXP = 16384;
constexpr float ALPHA = 1.189207115002721f;
constexpr float LN_EPS = 1e-5f;
constexpr float QSCALE = 0.08838834764831845f;

constexpr size_t al(size_t x) { return (x + 255) & ~(size_t)255; }
constexpr size_t O_WIN = 0;
constexpr size_t O_WMKV = O_WIN + al((size_t)INC * D * 2);
constexpr size_t O_WBR = O_WMKV + al((size_t)1024 * 1024 * 2);
constexpr size_t O_WOUT = O_WBR + al((size_t)1024 * 1536 * 2);
constexpr size_t O_WPQ = O_WOUT + al((size_t)1024 * 1024 * 2);
constexpr size_t O_SUBK = O_WPQ + al((size_t)2048 * 1024 * 2);
constexpr size_t O_UB = O_SUBK + al((size_t)16 * 128 * 128 * 2);
constexpr size_t O_VB = O_UB + al((size_t)NEXP * D);
constexpr size_t O_USC = O_VB + al((size_t)NEXP * D);
constexpr size_t O_VSC = O_USC + al((size_t)NEXP * 4);
constexpr size_t O_XB = O_VSC + al((size_t)NEXP * 4);
constexpr size_t O_MEMB = O_XB + al((size_t)M * D * 2);
constexpr size_t O_MK = O_MEMB + al((size_t)2048 * 1024 * 2);
constexpr size_t O_MVT = O_MK + al((size_t)2048 * 512 * 2);
constexpr size_t O_H1B = O_MVT + al((size_t)8 * 512 * 256 * 2);
constexpr size_t O_MISC = O_H1B + al((size_t)M * D * 2);
constexpr size_t O_PASS = O_MISC + al(65536);
constexpr size_t P_QK = 0;
constexpr size_t P_VT = P_QK + al((size_t)MP * 3072 * 2);
constexpr size_t P_IT = P_VT + (size_t)1536 * MP * 2;
constexpr size_t P_HFQG = P_IT + al((size_t)512 * MP * 2);
constexpr size_t P_MQ = P_HFQG + al((size_t)MP * 1536 * 2);
constexpr size_t P_GATE = P_MQ + al((size_t)MP * 512 * 2);
constexpr size_t P_OG = P_GATE + al((size_t)MP * 3072 * 2);
constexpr size_t P_LSE = P_OG + al((size_t)MP * 1536 * 2);
constexpr size_t P_BR = P_LSE + al((size_t)MP * 12 * 4);
constexpr size_t P_MERGED = P_BR + al((size_t)MP * 1536 * 2);
constexpr size_t P_MIX = P_MERGED + al((size_t)MP * 1024 * 2);
constexpr size_t P_HSTL = P_MIX + al((size_t)MP * 1024 * 4);
constexpr size_t P_HSTD = P_HSTL + al((size_t)256 * 16384 * 4);
constexpr size_t P_SIN = P_HSTD + al((size_t)256 * 128 * 4);
constexpr size_t P_END = P_SIN + al((size_t)256 * 16384 * 4);
constexpr size_t P_PQ = 0;
constexpr size_t P_IDX = P_PQ + al((size_t)M * 2048 * 2);
constexpr size_t P_PG = P_IDX + al((size_t)M * 128 * 4);
constexpr size_t P_END2 = P_PG + al((size_t)M * 128 * 4);
constexpr size_t WS_NEED = O_PASS + (P_END > P_END2 ? P_END : P_END2);
static_assert(WS_NEED <= (size_t)1073741824, "workspace budget");

__global__ __launch_bounds__(256) void k_convert(const float* __restrict__ in, bf16_t* __restrict__ out, size_t n4) {
    size_t i = (size_t)blockIdx.x * 256 + threadIdx.x; const size_t st = (size_t)gridDim.x * 256;
    for (; i < n4; i += st) { const f32x4 v = ((const f32x4*)in)[i]; ushort4 o; o.x = f2bf(v[0]); o.y = f2bf(v[1]); o.z = f2bf(v[2]); o.w = f2bf(v[3]); ((ushort4*)out)[i] = o; }
}
__global__ __launch_bounds__(256) void k_transpose(const float* __restrict__ W, int K, int ldw, bf16_t* __restrict__ out, int ldo, int koff) {
    __shared__ float t[32][33];
    const int k0 = blockIdx.y * 32, n0 = blockIdx.x * 32, tx = threadIdx.x & 31, ty = threadIdx.x >> 5;
    for (int i = ty; i < 32; i += 8) t[i][tx] = W[(size_t)(k0 + i) * ldw + n0 + tx];
    __syncthreads();
    for (int i = ty; i < 32; i += 8) out[(size_t)(n0 + i) * ldo + koff + k0 + tx] = f2bf(t[tx][i]);
}
__global__ void k_misc(const float* __restrict__ hgrn_lb, const float* __restrict__ rel_bias, float* __restrict__ misc) {
    const int i = blockIdx.x * blockDim.x + threadIdx.x;
    if (i < 512) { const float a = hgrn_lb[i], b = hgrn_lb[512 + i]; const float mx = fmaxf(a, b); const float ea = expf(a - mx), eb = expf(b - mx); misc[i] = ea / (ea + eb); }
    if (i < 3 * 129) {
        const int g = i / 129, j = i % 129; const int dl = g == 0 ? 1 : (g == 1 ? 4 : 16); const int n = j * dl;
        int bucket;
        if (n < 16) bucket = n;
        else { const double v = log((double)n / 16.0) / log(128.0) * 16.0; int l = 16 + (int)v; bucket = l < 31 ? l : 31; }
        for (int h = 0; h < 4; ++h) misc[512 + i * 4 + h] = rel_bias[bucket * 12 + g * 4 + h];
    }
}

template <class Epi>
__global__ __launch_bounds__(256) void gemm_simple(const bf16_t* __restrict__ A, int lda, const bf16_t* __restrict__ Bt, int ldb, int K, Epi epi) {
    const int lane = threadIdx.x & 63, w = threadIdx.x >> 6;
    const int row0 = blockIdx.y * 64 + (w >> 1) * 32, col0 = blockIdx.x * 64 + (w & 1) * 32;
    const int fr = lane & 15, fq = lane >> 4;
    f32x4 acc[2][2];
#pragma unroll
    for (int a = 0; a < 2; ++a)
#pragma unroll
        for (int b = 0; b < 2; ++b) acc[a][b] = (f32x4){0.f, 0.f, 0.f, 0.f};
    const bf16_t* ap = A + (size_t)(row0 + fr) * lda + fq * 8;
    const bf16_t* bp = Bt + (size_t)(col0 + fr) * ldb + fq * 8;
    for (int k0 = 0; k0 < K; k0 += 32) {
        const bf16x8 a0 = *(const bf16x8*)(ap + k0), a1 = *(const bf16x8*)(ap + (size_t)16 * lda + k0);
        const bf16x8 b0 = *(const bf16x8*)(bp + k0), b1 = *(const bf16x8*)(bp + (size_t)16 * ldb + k0);
        acc[0][0] = __builtin_amdgcn_mfma_f32_16x16x32_bf16(a0, b0, acc[0][0], 0, 0, 0);
        acc[0][1] = __builtin_amdgcn_mfma_f32_16x16x32_bf16(a0, b1, acc[0][1], 0, 0, 0);
        acc[1][0] = __builtin_amdgcn_mfma_f32_16x16x32_bf16(a1, b0, acc[1][0], 0, 0, 0);
        acc[1][1] = __builtin_amdgcn_mfma_f32_16x16x32_bf16(a1, b1, acc[1][1], 0, 0, 0);
    }
#pragma unroll
    for (int mi = 0; mi < 2; ++mi)
#pragma unroll
        for (int ni = 0; ni < 2; ++ni)
#pragma unroll
            for (int j = 0; j < 4; ++j) epi(row0 + mi * 16 + fq * 4 + j, col0 + ni * 16 + fr, acc[mi][ni][j]);
}

DI int dil_of(int g) { return g == 0 ? 1 : (g == 1 ? 4 : 16); }
DI int perm_tok(int lb, int s, int dl) { return lb * S + (s % dl) * (S / dl) + s / dl; }

struct EpiProj {
    bf16_t *QK, *VT, *HFQG, *IT, *MQ, *GATE; const float* b_gate;
    DI void operator()(int row, int col, float v) const {
        if (col < 3072) QK[(size_t)row * 3072 + col] = f2bf(v);
        else if (col < 4608) { const int c = col - 3072, g = c >> 9; VT[(size_t)c * MP + perm_tok(row / S, row % S, dil_of(g))] = f2bf(v); }
        else if (col < 5120) HFQG[(size_t)row * 1536 + (col - 4608)] = f2bf(v);
        else if (col < 5632) IT[(size_t)(col - 5120) * MP + row] = f2bf(v);
        else if (col < 6656) HFQG[(size_t)row * 1536 + (col - 5632) + 512] = f2bf(v);
        else if (col < 7168) MQ[(size_t)row * 512 + (col - 6656)] = f2bf(v);
        else { const int c = col - 7168; const float z = v + b_gate[c]; GATE[(size_t)row * 3072 + c] = f2bf(1.f / (1.f + expf(-z))); }
    }
};
struct EpiMemKV {
    bf16_t *MK, *MVT;
    DI void operator()(int row, int col, float v) const {
        if (col < 512) MK[(size_t)row * 512 + col] = f2bf(v);
        else MVT[((size_t)(row >> 8) * 512 + (col - 512)) * 256 + (row & 255)] = f2bf(v);
    }
};
struct EpiWiden {
    const bf16_t* GATE; float* TMP; bf16_t* MERGED; int g, pad;
    DI void operator()(int row, int col, float v) const {
        const float gv = bf2f(GATE[(size_t)row * 3072 + g * 1024 + col]) * v; const size_t o = (size_t)row * 1024 + col;
        if (g == 0) TMP[o] = gv; else if (g == 1) TMP[o] += gv; else MERGED[o] = f2bf(TMP[o] + gv);
    }
};
struct EpiF32 { float* C; int ldc, pad; DI void operator()(int row, int col, float v) const { C[(size_t)row * ldc + col] = v; } };
struct EpiB16 { bf16_t* C; int ldc, pad; DI void operator()(int row, int col, float v) const { C[(size_t)row * ldc + col] = f2bf(v); } };

DI float wave_max(float v) {
#pragma unroll
    for (int o = 1; o < 64; o <<= 1) v = fmaxf(v, __shfl_xor(v, o));
    return v;
}
DI float wave_sum(float v) {
#pragma unroll
    for (int o = 1; o < 64; o <<= 1) v += __shfl_xor(v, o);
    return v;
}

__global__ __launch_bounds__(256) void k_dil_attn(const bf16_t* __restrict__ QK, const bf16_t* __restrict__ VT, const float* __restrict__ BIAS, bf16_t* __restrict__ OG, float* __restrict__ LSE) {
    __shared__ float ps[4][192];
    const int lane = threadIdx.x & 63, w = threadIdx.x >> 6;
    const long task = (long)blockIdx.x * 4 + w;
    const int gh = (int)(task % 12); const int row = (int)(task / 12);
    const int g = gh >> 2, h = gh & 3, dl = dil_of(g);
    const int lb = row / S, s = row % S, m = s / dl, r = s % dl;
    const bf16_t* qp = QK + (size_t)row * 3072 + gh * 128;
    float lg[3]; float mx = -INFINITY;
#pragma unroll
    for (int i = 0; i < 3; ++i) {
        const int j = lane + 64 * i; float l = -INFINITY;
        if (j <= 128 && m - j >= 0) {
            const int krow = lb * S + (m - j) * dl + r; const bf16_t* kp = QK + (size_t)krow * 3072 + 1536 + gh * 128;
            float dot = 0.f;
            for (int d = 0; d < 128; ++d) dot += bf2f(qp[d]) * bf2f(kp[d]);
            l = dot * QSCALE + BIAS[(g * 129 + j) * 4 + h];
        }
        lg[i] = l; mx = fmaxf(mx, l);
    }
    mx = wave_max(mx);
    float sum = 0.f;
#pragma unroll
    for (int i = 0; i < 3; ++i) { const float p = (lg[i] == -INFINITY) ? 0.f : expf(lg[i] - mx); ps[w][lane + 64 * i] = p; sum += p; }
    sum = wave_sum(sum);
    __syncthreads();
    const int nk = m < 128 ? m : 128;
    const float inv = 1.f / sum;
#pragma unroll
    for (int i = 0; i < 2; ++i) {
        const int d = lane + 64 * i; const bf16_t* vp = VT + (size_t)(g * 512 + h * 128 + d) * MP + lb * S + r * (S / dl);
        float o = 0.f;
        for (int j = 0; j <= nk; ++j) o += ps[w][j] * bf2f(vp[m - j]);
        OG[(size_t)row * 1536 + g * 512 + h * 128 + d] = f2bf(o * inv);
    }
    if (lane == 0) LSE[(size_t)row * 12 + gh] = mx + logf(sum);
}
__global__ __launch_bounds__(256) void k_merge(const bf16_t* __restrict__ OG, const float* __restrict__ LSE, bf16_t* __restrict__ BR) {
    const long i = (long)blockIdx.x * 256 + threadIdx.x;
    const int row = (int)(i >> 9), c = (int)(i & 511), h = c >> 7;
    const float l0 = LSE[(size_t)row * 12 + h], l1 = LSE[(size_t)row * 12 + 4 + h], l2 = LSE[(size_t)row * 12 + 8 + h];
    const float mx = fmaxf(l0, fmaxf(l1, l2)); const float e0 = expf(l0 - mx), e1 = expf(l1 - mx), e2 = expf(l2 - mx); const float inv = 1.f / (e0 + e1 + e2);
    const bf16_t* og = OG + (size_t)row * 1536 + c;
    BR[(size_t)row * 1536 + c] = f2bf((e0 * bf2f(og[0]) + e1 * bf2f(og[512]) + e2 * bf2f(og[1024])) * inv);
}
__global__ __launch_bounds__(256) void k_mem_attn(const bf16_t* __restrict__ MQ, const bf16_t* __restrict__ MK, const bf16_t* __restrict__ MVT, bf16_t* __restrict__ BR, int batch0) {
    __shared__ float ps[4][256];
    const int lane = threadIdx.x & 63, w = threadIdx.x >> 6;
    const long task = (long)blockIdx.x * 4 + w;
    const int h = (int)(task & 3); const int row = (int)(task >> 2);
    const int b = batch0 + row / S;
    const bf16_t* qp = MQ + (size_t)row * 512 + h * 128;
    float lg[4]; float mx = -INFINITY;
#pragma unroll
    for (int i = 0; i < 4; ++i) {
        const int j = lane + 64 * i; const bf16_t* kp = MK + (size_t)(b * 256 + j) * 512 + h * 128;
        float dot = 0.f;
        for (int d = 0; d < 128; ++d) dot += bf2f(qp[d]) * bf2f(kp[d]);
        lg[i] = dot * QSCALE; mx = fmaxf(mx, lg[i]);
    }
    mx = wave_max(mx);
    float sum = 0.f;
#pragma unroll
    for (int i = 0; i < 4; ++i) { const float p = expf(lg[i] - mx); ps[w][lane + 64 * i] = p; sum += p; }
    sum = wave_sum(sum);
    __syncthreads();
    const float inv = 1.f / sum;
#pragma unroll
    for (int i = 0; i < 2; ++i) {
        const int d = lane + 64 * i; const bf16_t* vp = MVT + ((size_t)b * 512 + h * 128 + d) * 256;
        float o = 0.f;
        for (int j = 0; j < 256; ++j) o += ps[w][j] * bf2f(vp[j]);
        BR[(size_t)row * 1536 + 1024 + h * 128 + d] = f2bf(o * inv);
    }
}
__global__ __launch_bounds__(128) void k_hgrn(const bf16_t* __restrict__ HFQG, const bf16_t* __restrict__ IT, const float* __restrict__ lbv, const float* __restrict__ norm_w, bf16_t* __restrict__ BR) {
    __shared__ float sf[128], sk[128], sq[128], red[2];
    const int tid = threadIdx.x, h = blockIdx.x & 3, lb = blockIdx.x >> 2;
    const float lbd = lbv[h * 128 + tid], nw = norm_w[h * 128 + tid];
    float St[128];
#pragma unroll
    for (int i = 0; i < 128; ++i) St[i] = 0.f;
    for (int s = 0; s < S; ++s) {
        const size_t row = (size_t)lb * S + s;
        const float fr = bf2f(HFQG[row * 1536 + h * 128 + tid]);
        const float f = lbd + (1.f - lbd) / (1.f + expf(-fr));
        sf[tid] = f; sk[tid] = 1.f - f; sq[tid] = bf2f(HFQG[row * 1536 + 512 + h * 128 + tid]);
        __syncthreads();
        const float iv = bf2f(IT[(size_t)(h * 128 + tid) * MP + row]);
        float o = 0.f;
#pragma unroll
        for (int d = 0; d < 128; ++d) { St[d] = sf[d] * St[d] + sk[d] * iv; o += sq[d] * St[d]; }
        const float ss = wave_sum(o * o);
        if ((tid & 63) == 0) red[tid >> 6] = ss;
        __syncthreads();
        const float ms = (red[0] + red[1]) * (1.f / 128.f);
        const float gv = bf2f(HFQG[row * 1536 + 1024 + h * 128 + tid]);
        BR[row * 1536 + 512 + h * 128 + tid] = f2bf(o * rsqrtf(ms + LN_EPS) * nw * (gv / (1.f + expf(-gv))));
    }
}
__global__ __launch_bounds__(256) void k_ln1(const float* __restrict__ x, const float* __restrict__ mix, const float* __restrict__ g, const float* __restrict__ b, float* __restrict__ h1f, bf16_t* __restrict__ h1b) {
    __shared__ float red[8];
    const size_t row = blockIdx.x; const int tid = threadIdx.x;
    float v[4]; float s = 0.f;
#pragma unroll
    for (int i = 0; i < 4; ++i) { const int c = tid + 256 * i; v[i] = ALPHA * x[row * D + c] + mix[row * D + c]; s += v[i]; }
    s = wave_sum(s); if ((tid & 63) == 0) red[tid >> 6] = s; __syncthreads();
    const float mean = (red[0] + red[1] + red[2] + red[3]) * (1.f / D);
    float q = 0.f;
#pragma unroll
    for (int i = 0; i < 4; ++i) { v[i] -= mean; q += v[i] * v[i]; }
    q = wave_sum(q); if ((tid & 63) == 0) red[4 + (tid >> 6)] = q; __syncthreads();
    const float rstd = rsqrtf((red[4] + red[5] + red[6] + red[7]) * (1.f / D) + LN_EPS);
#pragma unroll
    for (int i = 0; i < 4; ++i) { const int c = tid + 256 * i; const float o = v[i] * rstd * g[c] + b[c]; h1f[row * D + c] = o; h1b[row * D + c] = f2bf(o); }
}

DI void ins16(float (&tv)[16], int (&ti)[16], float v, int i) {
#pragma unroll
    for (int j = 0; j < 16; ++j) { const bool gt = v > tv[j]; const float ov = tv[j]; const int oi = ti[j]; tv[j] = gt ? v : ov; ti[j] = gt ? i : oi; v = gt ? ov : v; i = gt ? oi : i; }
}
__global__ __launch_bounds__(256) void k_route(const bf16_t* __restrict__ PQ, const bf16_t* __restrict__ SUBK, int* __restrict__ IDX, float* __restrict__ PG) {
    const long gi = (long)blockIdx.x * 256 + threadIdx.x;
    const int h = (int)(gi & 7); const size_t t = (size_t)(gi >> 3);
    float s1[16], s2[16]; int i1[16], i2[16];
#pragma unroll
    for (int j = 0; j < 16; ++j) { s1[j] = -INFINITY; s2[j] = -INFINITY; i1[j] = 0; i2[j] = 0; }
    const bf16_t* q0 = PQ + t * 2048 + h * 256;
    for (int n = 0; n < 128; ++n) {
        const bf16_t* k0 = SUBK + (size_t)((h * 2 + 0) * 128 + n) * 128; const bf16_t* k1 = SUBK + (size_t)((h * 2 + 1) * 128 + n) * 128;
        float a = 0.f, b = 0.f;
        for (int k = 0; k < 128; ++k) { a += bf2f(q0[k]) * bf2f(k0[k]); b += bf2f(q0[128 + k]) * bf2f(k1[k]); }
        ins16(s1, i1, a, n); ins16(s2, i2, b, n);
    }
    float cv[16]; int ci[16];
#pragma unroll
    for (int j = 0; j < 16; ++j) { cv[j] = -INFINITY; ci[j] = 0; }
#pragma unroll
    for (int a = 0; a < 16; ++a)
#pragma unroll
        for (int b = 0; b < 16; ++b) ins16(cv, ci, s1[a] + s2[b], i1[a] * 128 + i2[b]);
    float sum = 0.f; float e[16];
#pragma unroll
    for (int j = 0; j < 16; ++j) { e[j] = expf(cv[j] - cv[0]); sum += e[j]; }
    const float inv = 1.f / sum;
#pragma unroll
    for (int j = 0; j < 16; ++j) { IDX[t * 128 + h * 16 + j] = ci[j]; PG[t * 128 + h * 16 + j] = e[j] * inv; }
}
__global__ __launch_bounds__(256) void k_experts(const float* h1f_in, const bf16_t* __restrict__ h1b, const bf16_t* __restrict__ UB, const bf16_t* __restrict__ VB, const int* __restrict__ IDX, const float* __restrict__ PG,
                                                 const float* __restrict__ g2, const float* __restrict__ b2, float* out) {
    __shared__ float hrow[1024]; __shared__ float cw[128]; __shared__ int eid[128]; __shared__ float red[8];
    const size_t t = blockIdx.x; const int tid = threadIdx.x, lane = tid & 63, w = tid >> 6;
    float hv[4];
#pragma unroll
    for (int i = 0; i < 4; ++i) { const int c = tid + 256 * i; hv[i] = h1f_in[t * D + c]; hrow[c] = bf2f(h1b[t * D + c]); }
    if (tid < 128) eid[tid] = IDX[t * 128 + tid];
    __syncthreads();
    for (int e = w; e < 128; e += 4) {
        const bf16_t* up = UB + (size_t)eid[e] * D; float dot = 0.f;
#pragma unroll
        for (int i = 0; i < 16; ++i) dot += hrow[lane + 64 * i] * bf2f(up[lane + 64 * i]);
        dot = wave_sum(dot);
        if (lane == 0) cw[e] = PG[t * 128 + e] * 0.5f * dot * (1.f + erff(dot * 0.7071067811865476f));
    }
    __syncthreads();
    float f[4] = {0.f, 0.f, 0.f, 0.f};
    for (int e = 0; e < 128; ++e) { const bf16_t* vp = VB + (size_t)eid[e] * D; const float c = cw[e];
#pragma unroll
        for (int i = 0; i < 4; ++i) f[i] += c * bf2f(vp[tid + 256 * i]); }
    float v[4]; float s = 0.f;
#pragma unroll
    for (int i = 0; i < 4; ++i) { v[i] = ALPHA * hv[i] + f[i]; s += v[i]; }
    s = wave_sum(s); if (lane == 0) red[w] = s; __syncthreads();
    const float mean = (red[0] + red[1] + red[2] + red[3]) * (1.f / D);
    float q = 0.f;
#pragma unroll
    for (int i = 0; i < 4; ++i) { v[i] -= mean; q += v[i] * v[i]; }
    q = wave_sum(q); if (lane == 0) red[4 + w] = q; __syncthreads();
    const float rstd = rsqrtf((red[4] + red[5] + red[6] + red[7]) * (1.f / D) + LN_EPS);
#pragma unroll
    for (int i = 0; i < 4; ++i) { const int c = tid + 256 * i; out[t * D + c] = v[i] * rstd * g2[c] + b2[c]; }
}

#define LAS __attribute__((address_space(3)))
#define GAS __attribute__((address_space(1)))
typedef unsigned u32x4 __attribute__((ext_vector_type(4)));
typedef unsigned u32x2 __attribute__((ext_vector_type(2)));
typedef float f32x2 __attribute__((ext_vector_type(2)));
typedef __bf16 bf16x2_t __attribute__((ext_vector_type(2)));
DI unsigned cvtpk(float lo, float hi) { f32x2 v = {lo, hi}; bf16x2_t b = __builtin_convertvector(v, bf16x2_t); return __builtin_bit_cast(unsigned, b); }
constexpr float LOG2E = 1.4426950408889634f;
DI float fast_sigmoid(float z) { return __builtin_amdgcn_rcpf(1.f + __builtin_amdgcn_exp2f(-z * LOG2E)); }

namespace g8 {
constexpr int BM = 256, BK = 64, HALF = 128, HTB = HALF * BK * 2, STAGE_BYTES = 8 * HTB;
DI int lds_byte(int r, int c) { const int st = (r >> 4) * 2 + (c >> 5), rr = r & 15, cc = c & 31, ob = rr * 64 + cc * 2; return st * 1024 + (ob ^ (((ob >> 9) & 1) << 5)); }
DI void stage_rc(int b, int& R, int& C) { const int st = b / 1024, sb = b % 1024, swz = sb ^ (((sb >> 9) & 1) << 5); R = (st >> 1) * 16 + swz / 64; C = (st & 1) * 32 + (swz % 64) / 2; }
DI int perm32(int rho) { const int n = rho >> 4, i = rho & 15; return 8 * (i >> 2) + 4 * n + (i & 3); }

struct Unit { unsigned a, b; int dlb; int pm, pn, kind; };

template <class Epi, class Sched>
DI void gemm_phase(LAS unsigned char* lds, const char* const wsb, const int K, const Sched& S, const Epi& E, const int tid) {
    const int wid = __builtin_amdgcn_readfirstlane(tid >> 6), lane = tid & 63, wr = wid >> 2, wc = wid & 3, fr = lane & 15, fq = lane >> 4;
    const int nt = K / BK;
    unsigned voffA[2], rbk[2], ccb[2];
#pragma unroll
    for (int i = 0; i < 2; ++i) { int R, C; stage_rc(tid * 16 + i * 8192, R, C); const int Rb = Epi::PERM ? ((R & ~31) + perm32(R & 31)) : R;
        voffA[i] = (unsigned)(R * K + C) * 2u; rbk[i] = (unsigned)(Rb * K) * 2u; ccb[i] = (unsigned)C * 2u; }
    const unsigned kstep = (unsigned)(BK * 2);
    const unsigned hstepA = (unsigned)(HALF * K * 2);
    const unsigned ldsw = (unsigned)wid * 1024u;
    const int aoff = lds_byte(wr * 64 + fr, fq * 8), boff = lds_byte(wc * 32 + fr, fq * 8);
#define G8_SA(b, h) (((b) * 2 + (h)) * HTB)
#define G8_SB(b, h) ((4 + (b) * 2 + (h)) * HTB)
#define G8_STAGE(bufoff, gbase, v0, v1) do { \
        __builtin_amdgcn_global_load_lds((const unsigned*)(wsb + (unsigned)((gbase) + (v0))), (LAS unsigned*)(lds + (bufoff) + ldsw), 16, 0, 0); \
        __builtin_amdgcn_global_load_lds((const unsigned*)(wsb + (unsigned)((gbase) + (v1))), (LAS unsigned*)(lds + (bufoff) + ldsw + 8192), 16, 0, 0); } while (0)
#define G8_LDA(dst, b, h) do { _Pragma("unroll") for (int m = 0; m < 4; ++m) _Pragma("unroll") for (int k = 0; k < 2; ++k) dst[m][k] = *(const LAS bf16x8*)(lds + G8_SA(b, h) + aoff + m * 2048 + k * 1024); } while (0)
#define G8_LDB(dst, b, h) do { _Pragma("unroll") for (int n = 0; n < 2; ++n) _Pragma("unroll") for (int k = 0; k < 2; ++k) dst[n][k] = *(const LAS bf16x8*)(lds + G8_SB(b, h) + boff + n * 2048 + k * 1024); } while (0)
#define G8_MMA(ai, bj, At, Bt) do { __builtin_amdgcn_s_setprio(1); _Pragma("unroll") for (int m = 0; m < 4; ++m) _Pragma("unroll") for (int n = 0; n < 2; ++n) _Pragma("unroll") for (int k = 0; k < 2; ++k) \
        acc[ai][bj][m][n] = __builtin_amdgcn_mfma_f32_16x16x32_bf16(Bt[n][k], At[m][k], acc[ai][bj][m][n], 0, 0, 0); __builtin_amdgcn_s_setprio(0); } while (0)
#define G8_WAIT_V(n) asm volatile("s_waitcnt vmcnt(" #n ")" ::: "memory")
#define G8_WAIT_L(n) asm volatile("s_waitcnt lgkmcnt(" #n ")" ::: "memory")
#define G8_BAR __builtin_amdgcn_s_barrier()
#define G8_SCHED __builtin_amdgcn_sched_barrier(0)
    Unit cur, nxt; int ui = 0;
    if (!S.next(0, cur)) return;
    f32x4 acc[2][2][4][2];
#pragma unroll
    for (int a = 0; a < 2; ++a)
#pragma unroll
        for (int b = 0; b < 2; ++b)
#pragma unroll
            for (int m = 0; m < 4; ++m)
#pragma unroll
                for (int n = 0; n < 2; ++n) acc[a][b][m][n] = (f32x4){0.f, 0.f, 0.f, 0.f};
    bf16x8 At[4][2], B0[2][2], B1[2][2];
    unsigned cA = cur.a, cB = cur.b;
    unsigned vBc0 = rbk[0] * (unsigned)cur.dlb + ccb[0], vBc1 = rbk[1] * (unsigned)cur.dlb + ccb[1]; unsigned hBc = hstepA * (unsigned)cur.dlb;
    G8_STAGE(G8_SB(0, 0), cB, vBc0, vBc1); G8_STAGE(G8_SB(0, 1), cB + hBc, vBc0, vBc1); G8_STAGE(G8_SA(0, 0), cA, voffA[0], voffA[1]); G8_STAGE(G8_SA(0, 1), cA + hstepA, voffA[0], voffA[1]);
    if (wr == 1) G8_BAR;
    G8_WAIT_V(2); G8_BAR;
    G8_STAGE(G8_SB(1, 0), cB + kstep, vBc0, vBc1); G8_STAGE(G8_SA(1, 0), cA + kstep, voffA[0], voffA[1]); G8_STAGE(G8_SB(1, 1), cB + hBc + kstep, vBc0, vBc1);
    G8_WAIT_V(6); G8_BAR;
    for (;;) {
        const bool has_next = S.next(ui + 1, nxt);
        const unsigned nA = has_next ? nxt.a : cA, nB = has_next ? nxt.b : cB; const int dln = has_next ? nxt.dlb : cur.dlb;
        const unsigned vBn0 = rbk[0] * (unsigned)dln + ccb[0], vBn1 = rbk[1] * (unsigned)dln + ccb[1]; const unsigned hBn = hstepA * (unsigned)dln;
        for (int t = 0; t < nt; t += 2) {
            if constexpr (Epi::HOOK) E.hook(acc, cur, t, wr, wc, fr, fq);
            const bool last = (t == nt - 2);
            const unsigned a1 = cA + (unsigned)(t + 1) * kstep;
            const unsigned a2 = last ? nA : cA + (unsigned)(t + 2) * kstep, b2 = last ? nB : cB + (unsigned)(t + 2) * kstep;
            const unsigned a3 = a2 + kstep, b3 = b2 + kstep;
            const unsigned vB0 = last ? vBn0 : vBc0, vB1 = last ? vBn1 : vBc1; const unsigned hB = last ? hBn : hBc;
            G8_LDB(B0, 0, 0); G8_LDB(B1, 0, 1); G8_SCHED; G8_LDA(At, 0, 0); G8_STAGE(G8_SA(1, 1), a1 + hstepA, voffA[0], voffA[1]);
            G8_WAIT_V(8); G8_WAIT_L(0); G8_BAR; G8_MMA(0, 0, At, B0); G8_MMA(0, 1, At, B1); G8_BAR; G8_SCHED;
            G8_LDA(At, 0, 1); G8_STAGE(G8_SB(0, 0), b2, vB0, vB1); G8_STAGE(G8_SB(0, 1), b2 + hB, vB0, vB1); G8_STAGE(G8_SA(0, 0), a2, voffA[0], voffA[1]);
            G8_WAIT_V(8); G8_WAIT_L(0); G8_BAR; G8_MMA(1, 0, At, B0); G8_MMA(1, 1, At, B1); G8_BAR; G8_SCHED;
            G8_LDB(B0, 1, 0); G8_LDB(B1, 1, 1); G8_SCHED; G8_LDA(At, 1, 0); G8_STAGE(G8_SA(0, 1), a2 + hstepA, voffA[0], voffA[1]);
            G8_WAIT_V(8); G8_WAIT_L(0); G8_BAR; G8_MMA(0, 0, At, B0); G8_MMA(0, 1, At, B1); G8_BAR; G8_SCHED;
            G8_LDA(At, 1, 1); G8_STAGE(G8_SB(1, 0), b3, vB0, vB1); G8_STAGE(G8_SB(1, 1), b3 + hB, vB0, vB1); G8_STAGE(G8_SA(1, 0), a3, voffA[0], voffA[1]);
            G8_WAIT_V(8); G8_WAIT_L(0); G8_BAR; G8_MMA(1, 0, At, B0); G8_MMA(1, 1, At, B1); G8_BAR; G8_SCHED;
        }
        if (wr == 0) G8_BAR;
        E(acc, cur, wr, wc, fr, fq);
        if (!has_next) break;
#pragma unroll
        for (int a = 0; a < 2; ++a)
#pragma unroll
            for (int b = 0; b < 2; ++b)
#pragma unroll
                for (int m = 0; m < 4; ++m)
#pragma unroll
                    for (int n = 0; n < 2; ++n) acc[a][b][m][n] = (f32x4){0.f, 0.f, 0.f, 0.f};
        cur = nxt; cA = nA; cB = nB; vBc0 = vBn0; vBc1 = vBn1; hBc = hBn; ++ui;
        if (wr == 1) G8_BAR;
    }
    G8_WAIT_V(0);
    G8_BAR;
#undef G8_SA
#undef G8_SB
#undef G8_STAGE
#undef G8_LDA
#undef G8_LDB
#undef G8_MMA
#undef G8_WAIT_V
#undef G8_WAIT_L
#undef G8_BAR
#undef G8_SCHED
}
}

typedef GAS unsigned gu32;
#define XB_TMO      128
#define XB_XCNT(j)  (256  + 64 * (j))
#define XB_XSUB(j)  (1280 + 64 * (j))
#define XB_XGEN(j)  (2304 + 64 * (j))
#define XB_TOP      3328
#define XB_TOPGEN   3392
#define XCD_BAR_WORDS 3456
#define XB_SPIN_CAP (1u << 22)
DI unsigned xb_ld(unsigned* p)              { return __hip_atomic_load(p, __ATOMIC_RELAXED, __HIP_MEMORY_SCOPE_AGENT); }
DI unsigned xb_add(unsigned* p, unsigned v) { return __hip_atomic_fetch_add(p, v, __ATOMIC_RELAXED, __HIP_MEMORY_SCOPE_AGENT); }
DI unsigned xb_xcc_id() { return (unsigned)__builtin_amdgcn_s_getreg((3 << 11) | 20) & 0xFu; }
#define XB_SPIN(cond, bar) do { unsigned _sp = 0; while (cond) { __builtin_amdgcn_s_sleep(1); \
    if ((++_sp & 255u) == 0u) { if (xb_ld(&(bar)[XB_TMO])) break; if (_sp > XB_SPIN_CAP) { atomicAdd(&(bar)[XB_TMO], 1u); break; } } } } while (0)
struct XcdBarrier { unsigned* bar; unsigned x; volatile LAS unsigned* st; };
DI XcdBarrier xcd_barrier_post(unsigned* bar, volatile LAS unsigned* st) {
    XcdBarrier b; b.bar = bar; b.x = xb_xcc_id(); b.st = st;
    if (threadIdx.x == 0) (void)xb_add(&bar[XB_XCNT(b.x)], 1u);
    return b;
}
DI void xcd_barrier_complete(unsigned* bar, unsigned x, unsigned& nloc, unsigned& nx) {
    const unsigned G = gridDim.x * gridDim.y * gridDim.z;
    unsigned sum, cnt, mine, sp = 0u;
    for (;;) {
        sum = 0u; cnt = 0u; mine = 0u;
#pragma unroll
        for (unsigned j = 0; j < 16; ++j) { const unsigned c = xb_ld(&bar[XB_XCNT(j)]); sum += c; cnt += (c > 0u) ? 1u : 0u; mine = (j == x) ? c : mine; }
        if (sum == G) break;
        __builtin_amdgcn_s_sleep(1);
        if ((++sp & 255u) == 0u) { if (xb_ld(&bar[XB_TMO])) break; if (sp > XB_SPIN_CAP) { atomicAdd(&bar[XB_TMO], 1u); break; } }
    }
    nloc = mine > 0u ? mine : 1u; nx = cnt > 0u ? cnt : 1u;
}
DI void xcd_barrier(const XcdBarrier& b) {
    asm volatile("s_waitcnt vmcnt(0)" ::: "memory");
    __syncthreads();
    if (threadIdx.x == 0) {
        unsigned* bar = b.bar;
        __builtin_amdgcn_s_waitcnt(0);
        unsigned nloc = b.st[0], nx = b.st[1];
        if (nloc == 0u) { xcd_barrier_complete(bar, b.x, nloc, nx); b.st[0] = nloc; b.st[1] = nx; }
        const unsigned old = xb_add(&bar[XB_XSUB(b.x)], 1u);
        const unsigned gen = old / nloc;
        if (old + 1u == (gen + 1u) * nloc) {
            __builtin_amdgcn_fence(__ATOMIC_RELEASE, "agent");
            asm volatile("s_waitcnt vmcnt(0)" ::: "memory");
            const unsigned og = xb_add(&bar[XB_TOP], 1u);
            const unsigned tg = og / nx;
            if (og + 1u == (tg + 1u) * nx) xb_add(&bar[XB_TOPGEN], 1u);
            else XB_SPIN(xb_ld(&bar[XB_TOPGEN]) == tg, bar);
            __builtin_amdgcn_fence(__ATOMIC_ACQUIRE, "agent");
            xb_add(&bar[XB_XGEN(b.x)], 1u);
            asm volatile("s_waitcnt vmcnt(0)" ::: "memory");
        } else {
            XB_SPIN(xb_ld(&bar[XB_XGEN(b.x)]) == gen, bar);
            __builtin_amdgcn_fence(__ATOMIC_ACQUIRE, "agent");
            asm volatile("s_waitcnt vmcnt(0)" ::: "memory");
        }
    }
    __syncthreads();
}

constexpr int NWAVES = 8, NTHR = NWAVES * 64;
constexpr int RING_BYTES = 131072, LDS_BYTES = 147456, LDSCTL_OFF = LDS_BYTES - 1024, MISC_OFF = LDSCTL_OFF + 320;
constexpr size_t CTL_BYTES = 65536;
enum { PH_ALL = 0, PH_PRO = 11, PH_PROJ = 1, PH_ATTN = 2, PH_HGPRE = 3, PH_HGMAIN = 4, PH_WIDEN = 5, PH_WOUT = 6, PH_LN1 = 7, PH_PQ = 8, PH_ROUTE = 9, PH_EXPERTS = 10, PH_HGSCAN = 12 };
struct Args { const float* in[18]; float* out; unsigned char* ws; int ph, pass; };

struct Bufs {
    const bf16_t *WIN, *XBp; bf16_t *QK, *VIT, *HFQG, *MQ, *GATE;
};

struct SchedP1 {
    unsigned XBp, W; int G, c;
    DI bool next(int i, g8::Unit& u) const {
        const int L = i * G + c; if (L >= 2560) return false;
        if (L < 2048) { const int x = L & 7, off = L >> 3; u.pm = 8 * x + (off & 7); u.pn = off >> 3; u.kind = 0; u.dlb = 1;
            u.a = XBp + (unsigned)u.pm * 256u * D * 2u; u.b = W + (unsigned)u.pn * 256u * D * 2u; }
        else { const int idx = L - 2048; u.pm = idx & 7; u.pn = idx >> 3; u.kind = 1;
            const int dl = u.pm < 2 ? 1 : (u.pm < 4 ? 4 : (u.pm < 6 ? 16 : 1));
            const int v0 = u.pn * 256, lb = v0 / S, vv = v0 % S, per = S / dl, r = vv / per, m0 = vv % per;
            u.dlb = dl; u.a = W + (unsigned)(8192 + u.pm * 256) * D * 2u; u.b = XBp + (unsigned)(lb * S + m0 * dl + r) * D * 2u; }
        return true;
    }
};
struct EpiP1 {
    static constexpr bool PERM = true, HOOK = false;
    char* pr; const float* b_gate;
    DI void hook(f32x4 (&)[2][2][4][2], const g8::Unit&, int, int, int, int, int) const {}
    DI void operator()(const f32x4 (&acc)[2][2][4][2], const g8::Unit& u, int wr, int wc, int fr, int fq) const {
        bf16_t* base; int ldc, colt; bool gate = false;
        if (u.kind == 1) { base = (bf16_t*)(pr + P_VT); ldc = MP; colt = u.pn * 256; }
        else if (u.pn < 12) { base = (bf16_t*)(pr + P_QK); ldc = 3072; colt = u.pn * 256; }
        else if (u.pn < 18) { base = (bf16_t*)(pr + P_HFQG); ldc = 1536; colt = (u.pn - 12) * 256; }
        else if (u.pn < 20) { base = (bf16_t*)(pr + P_MQ); ldc = 512; colt = (u.pn - 18) * 256; }
        else { base = (bf16_t*)(pr + P_GATE); ldc = 3072; colt = (u.pn - 20) * 256; gate = true; }
        const int row0 = u.pm * 256 + wr * 64 + fr, col0 = colt + wc * 32 + 8 * fq;
        f32x4 bv[2][2];
#pragma unroll
        for (int bj = 0; bj < 2; ++bj)
#pragma unroll
            for (int n = 0; n < 2; ++n) bv[bj][n] = gate ? *(const f32x4*)(b_gate + col0 + bj * 128 + 4 * n) : (f32x4){0.f, 0.f, 0.f, 0.f};
#pragma unroll
        for (int ai = 0; ai < 2; ++ai)
#pragma unroll
            for (int m = 0; m < 4; ++m) { bf16_t* rowp = base + (size_t)(row0 + ai * 128 + m * 16) * ldc + col0;
#pragma unroll
                for (int bj = 0; bj < 2; ++bj) { f32x4 v0 = acc[ai][bj][m][0], v1 = acc[ai][bj][m][1];
                    if (gate) { v0 = v0 + bv[bj][0]; v1 = v1 + bv[bj][1];
#pragma unroll
                        for (int e = 0; e < 4; ++e) { v0[e] = fast_sigmoid(v0[e]); v1[e] = fast_sigmoid(v1[e]); } }
                    u32x4 w; w.x = cvtpk(v0[0], v0[1]); w.y = cvtpk(v0[2], v0[3]); w.z = cvtpk(v1[0], v1[1]); w.w = cvtpk(v1[2], v1[3]);
                    *(u32x4*)(rowp + bj * 128) = w; } }
    }
};

typedef float f32x16 __attribute__((ext_vector_type(16)));
typedef short s16x4 __attribute__((ext_vector_type(4)));
DI int crow(int r, int hi) { return (r & 3) + 8 * (r >> 2) + 4 * hi; }
DI float xor32f(float v) { return __shfl_xor(v, 32); }
#define MFMA32(a, b, c) __builtin_amdgcn_mfma_f32_32x32x16_bf16((a), (b), (c), 0, 0, 0)
DI bf16x8 pack8(const f32x16& p, int s) {
    u32x4 w; w.x = cvtpk(p[8 * s + 0], p[8 * s + 1]); w.y = cvtpk(p[8 * s + 2], p[8 * s + 3]); w.z = cvtpk(p[8 * s + 4], p[8 * s + 5]); w.w = cvtpk(p[8 * s + 6], p[8 * s + 7]);
    return __builtin_bit_cast(bf16x8, w);
}
DI bf16x8 ldvt(const bf16_t* vp) {
    const s16x4 lo = *(const s16x4*)vp, hi4 = *(const s16x4*)(vp + 8);
    return __builtin_shufflevector(lo, hi4, 0, 1, 2, 3, 4, 5, 6, 7);
}
constexpr int DIL_TASKS = BPP * 12 * (S / 32);
constexpr int MEM_TASKS = (MP / 32) * 4;
DI void attn_dil_wave(const bf16_t* __restrict__ QK, const bf16_t* __restrict__ VT, const LAS float* btab, bf16_t* __restrict__ OG, float* __restrict__ LSE, int task, int lane) {
    const int r32 = lane & 31, hi = lane >> 5;
    const int q32 = task & 255, gh = (task >> 8) % 12, lb = task / (256 * 12);
    const int g = gh >> 2, h = gh & 3, dl = dil_of(g), per = S / dl;
    const int tok0 = q32 * 32, r = tok0 / per, m0 = tok0 % per;
    const size_t rowq = (size_t)lb * S + (size_t)(m0 + r32) * dl + r;
    bf16x8 qf[8];
    { const bf16_t* qp = QK + rowq * 3072 + gh * 128 + 8 * hi;
#pragma unroll
      for (int ks = 0; ks < 8; ++ks) qf[ks] = *(const bf16x8*)(qp + 16 * ks); }
    const LAS float* bt = btab + g * 129 * 4 + h;
    f32x16 o[4];
#pragma unroll
    for (int dt = 0; dt < 4; ++dt)
#pragma unroll
        for (int i = 0; i < 16; ++i) o[dt][i] = 0.f;
    float mrun = -INFINITY, sum = 0.f;
    const bf16_t* vbase = VT + (size_t)(g * 512 + h * 128 + r32) * MP + (size_t)lb * S + (size_t)r * per + 4 * hi;
    const bf16_t* kbase = QK + ((size_t)lb * S + r) * 3072 + 1536 + gh * 128 + 8 * hi;
#pragma unroll 1
    for (int kt = (m0 >= 128 ? 0 : (128 - m0) >> 5); kt < 5; ++kt) {
        const int mt0 = m0 - 128 + 32 * kt;
        const bf16_t* kp = kbase + (size_t)(mt0 + r32) * dl * 3072;
        f32x16 sc;
#pragma unroll
        for (int i = 0; i < 16; ++i) sc[i] = 0.f;
#pragma unroll
        for (int ks = 0; ks < 8; ++ks) { const bf16x8 kf = *(const bf16x8*)(kp + 16 * ks); sc = MFMA32(kf, qf[ks], sc); }
        float mx = -INFINITY;
#pragma unroll
        for (int i = 0; i < 16; ++i) {
            const int delta = 128 - 32 * kt + r32 - crow(i, hi);
            const bool valid = (delta >= 0) && (delta <= 128);
            const int di = delta < 0 ? 0 : (delta > 128 ? 128 : delta);
            const float x = sc[i] * (QSCALE * LOG2E) + bt[di * 4];
            sc[i] = valid ? x : -INFINITY; mx = fmaxf(mx, sc[i]);
        }
        mx = fmaxf(mx, xor32f(mx));
        const float mnew = fmaxf(mrun, mx); const float f = __builtin_amdgcn_exp2f(mrun - mnew);
        sum *= f;
#pragma unroll
        for (int dt = 0; dt < 4; ++dt)
#pragma unroll
            for (int i = 0; i < 16; ++i) o[dt][i] *= f;
        mrun = mnew;
        float ps = 0.f;
#pragma unroll
        for (int i = 0; i < 16; ++i) { sc[i] = __builtin_amdgcn_exp2f(sc[i] - mnew); ps += sc[i]; }
        ps += xor32f(ps); sum += ps;
#pragma unroll
        for (int s = 0; s < 2; ++s) {
            const bf16x8 pb = pack8(sc, s);
#pragma unroll
            for (int dt = 0; dt < 4; ++dt) { const bf16x8 va = ldvt(vbase + (size_t)(32 * dt) * MP + mt0 + 16 * s); o[dt] = MFMA32(va, pb, o[dt]); }
        }
    }
    const float inv = 1.f / sum;
    bf16_t* op = OG + rowq * 1536 + g * 512 + h * 128 + 4 * hi;
#pragma unroll
    for (int dt = 0; dt < 4; ++dt)
#pragma unroll
        for (int a = 0; a < 4; ++a) { u32x2 w; w.x = cvtpk(o[dt][4 * a] * inv, o[dt][4 * a + 1] * inv); w.y = cvtpk(o[dt][4 * a + 2] * inv, o[dt][4 * a + 3] * inv); *(u32x2*)(op + 32 * dt + 8 * a) = w; }
    if (hi == 0) LSE[rowq * 12 + gh] = (mrun + __builtin_amdgcn_logf(sum)) * 0.6931471805599453f;
}
DI void attn_mem_wave(const bf16_t* __restrict__ MQ, const bf16_t* __restrict__ MK, const bf16_t* __restrict__ MVT, bf16_t* __restrict__ BR, int task, int batch0, int lane) {
    const int r32 = lane & 31, hi = lane >> 5;
    const int h = task & 3, blk = task >> 2;
    const size_t rowq = (size_t)blk * 32 + r32; const int b = batch0 + blk * 32 / S;
    bf16x8 qf[8];
    { const bf16_t* qp = MQ + rowq * 512 + h * 128 + 8 * hi;
#pragma unroll
      for (int ks = 0; ks < 8; ++ks) qf[ks] = *(const bf16x8*)(qp + 16 * ks); }
    f32x16 o[4];
#pragma unroll
    for (int dt = 0; dt < 4; ++dt)
#pragma unroll
        for (int i = 0; i < 16; ++i) o[dt][i] = 0.f;
    float mrun = -INFINITY, sum = 0.f;
    const bf16_t* vbase = MVT + (size_t)(h * 128 + r32) * 2048 + (size_t)b * 256 + 4 * hi;
    const bf16_t* kbase = MK + ((size_t)b * 256 + r32) * 512 + h * 128 + 8 * hi;
#pragma unroll 1
    for (int c = 0; c < 4; ++c) {
        f32x16 sc[2]; float mx = -INFINITY;
#pragma unroll
        for (int kt = 0; kt < 2; ++kt) {
            const bf16_t* kp = kbase + (size_t)(c * 64 + kt * 32) * 512;
            f32x16 acc;
#pragma unroll
            for (int i = 0; i < 16; ++i) acc[i] = 0.f;
#pragma unroll
            for (int ks = 0; ks < 8; ++ks) { const bf16x8 kf = *(const bf16x8*)(kp + 16 * ks); acc = MFMA32(kf, qf[ks], acc); }
#pragma unroll
            for (int i = 0; i < 16; ++i) { sc[kt][i] = acc[i] * (QSCALE * LOG2E); mx = fmaxf(mx, sc[kt][i]); }
            asm volatile("" ::: "memory");
        }
        mx = fmaxf(mx, xor32f(mx));
        const float mnew = fmaxf(mrun, mx); const float f = __builtin_amdgcn_exp2f(mrun - mnew);
        sum *= f;
#pragma unroll
        for (int dt = 0; dt < 4; ++dt)
#pragma unroll
            for (int i = 0; i < 16; ++i) o[dt][i] *= f;
        mrun = mnew;
        float ps = 0.f;
#pragma unroll
        for (int kt = 0; kt < 2; ++kt)
#pragma unroll
            for (int i = 0; i < 16; ++i) { sc[kt][i] = __builtin_amdgcn_exp2f(sc[kt][i] - mnew); ps += sc[kt][i]; }
        ps += xor32f(ps); sum += ps;
#pragma unroll
        for (int kt = 0; kt < 2; ++kt)
#pragma unroll
            for (int s = 0; s < 2; ++s) {
                const bf16x8 pb = pack8(sc[kt], s);
#pragma unroll
                for (int dt = 0; dt < 4; ++dt) { const bf16x8 va = ldvt(vbase + (size_t)(32 * dt) * 2048 + c * 64 + kt * 32 + 16 * s); o[dt] = MFMA32(va, pb, o[dt]); }
                asm volatile("" ::: "memory");
            }
    }
    const float inv = 1.f / sum;
    bf16_t* op = BR + rowq * 1536 + 1024 + h * 128 + 4 * hi;
#pragma unroll
    for (int dt = 0; dt < 4; ++dt)
#pragma unroll
        for (int a = 0; a < 4; ++a) { u32x2 w; w.x = cvtpk(o[dt][4 * a] * inv, o[dt][4 * a + 1] * inv); w.y = cvtpk(o[dt][4 * a + 2] * inv, o[dt][4 * a + 3] * inv); *(u32x2*)(op + 32 * dt + 8 * a) = w; }
}

constexpr int HG_SCH = 4, HG_UPS = S / 64 / HG_SCH  , HG_UNITS = BPP * 4 * HG_UPS  ;
constexpr int HG_ROW = 136, HG_KT_ROW = 72;
constexpr int HG_KP = 0, HG_QP = 64 * HG_ROW * 2, HG_QPP = 2 * HG_QP, HG_KPPT = 3 * HG_QP, HG_DEC = HG_KPPT + 128 * HG_KT_ROW * 2, HG_SSQ = HG_DEC + 512, HG_PSUM = HG_SSQ + 1024, HG_UNIT_BYTES = HG_PSUM + 2048;
DI bf16x8 lds_ld2x8(const LAS unsigned char* p) {
    const s16x4 lo = *(const LAS s16x4*)p, hi4 = *(const LAS s16x4*)(p + 16);
    return __builtin_shufflevector(lo, hi4, 0, 1, 2, 3, 4, 5, 6, 7);
}
DI int opq(int x) { asm volatile("" : "+v"(x)); return x; }
DI float lds_bf(const LAS unsigned char* p) { return __uint_as_float((unsigned)(*(const LAS unsigned short*)p) << 16); }
template <bool MAIN>
DI void hgrn_unit(LAS unsigned char* ul, int unit, int u, const bf16_t* __restrict__ HFQG, const bf16_t* __restrict__ IT, const float* __restrict__ lbv, const float* __restrict__ nwv,
                  float* HSTL, float* HSTD, const float* __restrict__ SIN, bf16_t* __restrict__ BR) {
    constexpr int NX = MAIN ? 4 : 2;
    const int lane = u & 63, w = u >> 6, r32 = lane & 31, hi = lane >> 5, dvt = w & 3, wh = w >> 2;
    const int seq = unit / HG_UPS, j = unit % HG_UPS, lb = seq >> 2, h = seq & 3;
    const int dk = u & 127, qt = u >> 7, cb = 16 * qt;
    const float lbd = lbv[h * 128 + dk];
    const size_t row0 = (size_t)lb * S + (size_t)j * (64 * HG_SCH);
    LAS unsigned char* Kp = ul + HG_KP; LAS unsigned char* Qp = ul + HG_QP; LAS unsigned char* Qpp = ul + HG_QPP; LAS unsigned char* KppT = ul + HG_KPPT;
    LAS float* dec = (LAS float*)(ul + HG_DEC); LAS float* ssq = (LAS float*)(ul + HG_SSQ); LAS float* psum = (LAS float*)(ul + HG_PSUM);
    const int dk0 = MAIN ? 0 : 64 * wh;
    f32x16 X[NX];
    if (MAIN) {
        const float* Sp = SIN + (size_t)unit * 16384 + 32 * dvt + r32;
#pragma unroll
        for (int t = 0; t < NX; ++t)
#pragma unroll
            for (int i = 0; i < 16; ++i) X[t][i] = Sp[(size_t)(32 * t + crow(i, hi)) * 128];
    } else {
#pragma unroll
        for (int t = 0; t < NX; ++t)
#pragma unroll
            for (int i = 0; i < 16; ++i) X[t][i] = 0.f;
    }
    float atot = 0.f;
#pragma unroll 1
    for (int ch = 0; ch < HG_SCH; ++ch) {
        const size_t rc = row0 + (size_t)ch * 64;
        {
            const int sc0 = opq(u) >> 4, sch = (opq(u) & 15) * 8;
            const bf16_t* fp = HFQG + (rc + sc0) * 1536 + h * 128 + sch;
            u32x4 sf[2], sq[2];
#pragma unroll
            for (int i = 0; i < 2; ++i) { sf[i] = *(const u32x4*)(fp + (size_t)(32 * i) * 1536); if (MAIN) sq[i] = *(const u32x4*)(fp + (size_t)(32 * i) * 1536 + 512); }
#pragma unroll
            for (int i = 0; i < 2; ++i) { *(LAS u32x4*)(Kp + ((sc0 + 32 * i) * HG_ROW + sch) * 2) = sf[i]; if (MAIN) *(LAS u32x4*)(Qp + ((sc0 + 32 * i) * HG_ROW + sch) * 2) = sq[i]; }
        }
        __syncthreads();
        {
            float s = 0.f;
#pragma unroll
            for (int i = 0; i < 16; ++i) s += __builtin_amdgcn_logf(lbd + (1.f - lbd) * fast_sigmoid(lds_bf(Kp + ((cb + i) * HG_ROW + dk) * 2)));
            psum[qt * 128 + dk] = s;
        }
        __syncthreads();
        {
            const float p0 = psum[dk], p1 = psum[128 + dk], p2 = psum[256 + dk], p3 = psum[384 + dk];
            const float amid = p0 + p1, alast = (p0 + p1) + (p2 + p3);
            float run = qt == 0 ? 0.f : (qt == 1 ? p0 : (qt == 2 ? amid : amid + p2));
            atot += alast;
#pragma unroll 1
            for (int c8 = 0; c8 < 2; ++c8) {
                float kt[8];
#pragma unroll
                for (int e = 0; e < 8; ++e) { const int c = cb + 8 * c8 + e; const float f = lbd + (1.f - lbd) * fast_sigmoid(lds_bf(Kp + (c * HG_ROW + dk) * 2)); run += __builtin_amdgcn_logf(f); const float key = 1.f - f;
                    kt[e] = key * __builtin_amdgcn_exp2f(alast - run);
                    if (MAIN) { *(LAS bf16_t*)(Kp + (c * HG_ROW + dk) * 2) = f2bf(key * __builtin_amdgcn_exp2f(amid - run));
                        const float q = lds_bf(Qp + (c * HG_ROW + dk) * 2);
                        *(LAS bf16_t*)(Qp + (c * HG_ROW + dk) * 2) = f2bf(q * __builtin_amdgcn_exp2f(run - amid));
                        *(LAS bf16_t*)(Qpp + (c * HG_ROW + dk) * 2) = f2bf(q * __builtin_amdgcn_exp2f(run)); } }
                u32x4 wv; wv.x = cvtpk(kt[0], kt[1]); wv.y = cvtpk(kt[2], kt[3]); wv.z = cvtpk(kt[4], kt[5]); wv.w = cvtpk(kt[6], kt[7]);
                *(LAS u32x4*)(KppT + (dk * HG_KT_ROW + cb + 8 * c8) * 2) = wv;
            }
            if (qt == 0) dec[dk] = __builtin_amdgcn_exp2f(alast);
        }
        __syncthreads();
        f32x16 o;
        const bf16_t* itrow = IT + (size_t)(h * 128 + 32 * dvt + opq(r32)) * MP;
        if (MAIN) {
#pragma unroll
            for (int i = 0; i < 16; ++i) o[i] = 0.f;
            const LAS unsigned char* qrow = Qpp + ((32 * wh + r32) * HG_ROW) * 2;
#pragma unroll
            for (int t = 0; t < 4; ++t)
#pragma unroll
                for (int step = 0; step < 2; ++step) { o = MFMA32(pack8(X[t], step), lds_ld2x8(qrow + (32 * t + 16 * step + 4 * hi) * 2), o); }
            __builtin_amdgcn_sched_barrier(0);
            const int r32m = opq(r32);
            const LAS unsigned char* qprow = Qp + ((32 * wh + r32) * HG_ROW) * 2;
            {
                f32x16 sc;
#pragma unroll
                for (int i = 0; i < 16; ++i) sc[i] = 0.f;
#pragma unroll
                for (int ks = 0; ks < 8; ++ks) { const int cof = (16 * ks + 8 * hi) * 2; sc = MFMA32(*(const LAS bf16x8*)(Kp + (r32 * HG_ROW) * 2 + cof), *(const LAS bf16x8*)(qprow + cof), sc); }
                if (wh == 0) {
#pragma unroll
                    for (int i = 0; i < 16; ++i) sc[i] = (crow(i, hi) <= r32m) ? sc[i] : 0.f;
                }
#pragma unroll
                for (int step = 0; step < 2; ++step) o = MFMA32(ldvt(itrow + rc + 16 * step + 4 * hi), pack8(sc, step), o);
                __builtin_amdgcn_sched_barrier(0);
            }
            if (wh == 1) {
                f32x16 sc;
#pragma unroll
                for (int i = 0; i < 16; ++i) sc[i] = 0.f;
#pragma unroll
                for (int ks = 0; ks < 8; ++ks) { const int cof = (16 * ks + 8 * hi) * 2; sc = MFMA32(*(const LAS bf16x8*)(Kp + ((32 + r32) * HG_ROW) * 2 + cof), *(const LAS bf16x8*)(qprow + cof), sc); }
#pragma unroll
                for (int i = 0; i < 16; ++i) sc[i] = (crow(i, hi) <= r32m) ? sc[i] : 0.f;
#pragma unroll
                for (int step = 0; step < 2; ++step) o = MFMA32(ldvt(itrow + rc + 32 + 16 * step + 4 * hi), pack8(sc, step), o);
                __builtin_amdgcn_sched_barrier(0);
            }
        }
        {
            bf16x8 ib[4];
#pragma unroll
            for (int ks = 0; ks < 4; ++ks) ib[ks] = *(const bf16x8*)(itrow + rc + 16 * ks + 8 * hi);
#pragma unroll
            for (int t = 0; t < NX; ++t) {
#pragma unroll
                for (int i = 0; i < 16; ++i) X[t][i] *= dec[dk0 + 32 * t + crow(i, hi)];
#pragma unroll
                for (int ks = 0; ks < 4; ++ks) { const bf16x8 ka = *(const LAS bf16x8*)(KppT + ((dk0 + 32 * t + r32) * HG_KT_ROW + 16 * ks + 8 * hi) * 2); X[t] = MFMA32(ka, ib[ks], X[t]); }
                __builtin_amdgcn_sched_barrier(0);
            }
        }
        if (MAIN) {
            float q2 = 0.f;
#pragma unroll
            for (int i = 0; i < 16; ++i) q2 += o[i] * o[i];
            q2 += xor32f(q2); if (hi == 0) ssq[dvt * 64 + 32 * wh + r32] = q2;
        }
        __syncthreads();
        if (MAIN) {
            const int r32o = opq(r32), hio = opq(hi);
            const int c = 32 * wh + r32o; const float tot = ssq[c] + ssq[64 + c] + ssq[128 + c] + ssq[192 + c];
            const float rs = rsqrtf(tot * (1.f / 128.f) + LN_EPS);
            const size_t row = rc + c; const int col = h * 128 + 32 * dvt + 4 * hio;
#pragma unroll
            for (int a4 = 0; a4 < 4; ++a4) {
                const u32x2 gw = *(const u32x2*)(HFQG + row * 1536 + 1024 + col + 8 * a4); const f32x4 nw4 = *(const f32x4*)(nwv + col + 8 * a4);
                const float g0 = __uint_as_float(gw.x << 16), g1 = __uint_as_float(gw.x & 0xffff0000u), g2 = __uint_as_float(gw.y << 16), g3 = __uint_as_float(gw.y & 0xffff0000u);
                const float v0 = o[4 * a4] * rs * nw4[0] * g0 * fast_sigmoid(g0), v1 = o[4 * a4 + 1] * rs * nw4[1] * g1 * fast_sigmoid(g1);
                const float v2 = o[4 * a4 + 2] * rs * nw4[2] * g2 * fast_sigmoid(g2), v3 = o[4 * a4 + 3] * rs * nw4[3] * g3 * fast_sigmoid(g3);
                u32x2 wv; wv.x = cvtpk(v0, v1); wv.y = cvtpk(v2, v3);
                *(u32x2*)(BR + row * 1536 + 512 + col + 8 * a4) = wv;
            }
        }
    }
    if (!MAIN) {
        float* L = HSTL + (size_t)unit * 16384 + 32 * dvt + r32;
#pragma unroll
        for (int t = 0; t < NX; ++t)
#pragma unroll
            for (int i = 0; i < 16; ++i) L[(size_t)(dk0 + 32 * t + crow(i, hi)) * 128] = X[t][i];
        if (qt == 0) HSTD[(size_t)unit * 128 + dk] = __builtin_amdgcn_exp2f(atot);
    }
}
DI void hgrn_scan(const float* __restrict__ HSTL, const float* __restrict__ HSTD, float* __restrict__ SIN, int gt) {
    if (gt >= BPP * 4 * 16384) return;
    const int seq = gt >> 14, el = gt & 16383, dkk = el >> 7;
    float st = 0.f;
    for (int j = 0; j < HG_UPS; ++j) { const size_t uo = (size_t)(seq * HG_UPS + j); SIN[uo * 16384 + el] = st; st = HSTD[uo * 128 + dkk] * st + HSTL[uo * 16384 + el]; }
}

struct SchedRows {
    unsigned A, B; int K, nN, nU, G, c;
    DI bool next(int i, g8::Unit& u) const {
        const int L = i * G + c; if (L >= nU) return false;
        const int x = L & 7, off = L >> 3, grp = off / (8 * nN), o2 = off % (8 * nN);
        const int ppx = nU / nN / 8;
        u.pm = x * ppx + 8 * grp + (o2 & 7); u.pn = o2 >> 3; u.kind = 0; u.dlb = 1;
        u.a = A + (unsigned)u.pm * 256u * K * 2u; u.b = B + (unsigned)u.pn * 256u * K * 2u; return true;
    }
};
DI void unpack8(const u32x4 w, float (&f)[8]) {
    f[0] = __uint_as_float(w.x << 16); f[1] = __uint_as_float(w.x & 0xffff0000u); f[2] = __uint_as_float(w.y << 16); f[3] = __uint_as_float(w.y & 0xffff0000u);
    f[4] = __uint_as_float(w.z << 16); f[5] = __uint_as_float(w.z & 0xffff0000u); f[6] = __uint_as_float(w.w << 16); f[7] = __uint_as_float(w.w & 0xffff0000u);
}
struct EpiWidenF {
    static constexpr bool PERM = true, HOOK = true;
    const bf16_t* GATE; bf16_t* MERGED;
    DI void hook(f32x4 (&acc)[2][2][4][2], const g8::Unit& u, int t, int wr, int wc, int fr, int fq) const {
        if (t != 8 && t != 16) return;
        const int g = (t >> 3) - 1;
        const int row0 = u.pm * 256 + wr * 64 + fr, col0 = u.pn * 256 + wc * 32 + 8 * fq;
#pragma unroll
        for (int ai = 0; ai < 2; ++ai)
#pragma unroll
            for (int m = 0; m < 4; ++m) { const bf16_t* gp = GATE + (size_t)(row0 + ai * 128 + m * 16) * 3072 + g * 1024 + col0;
#pragma unroll
                for (int bj = 0; bj < 2; ++bj) { float ga[8], gb[8]; unpack8(*(const u32x4*)(gp + bj * 128), ga); unpack8(*(const u32x4*)(gp + 1024 + bj * 128), gb);
#pragma unroll
                    for (int e = 0; e < 4; ++e) { acc[ai][bj][m][0][e] *= ga[e] * __builtin_amdgcn_rcpf(gb[e]); acc[ai][bj][m][1][e] *= ga[4 + e] * __builtin_amdgcn_rcpf(gb[4 + e]); } } }
    }
    DI void operator()(const f32x4 (&acc)[2][2][4][2], const g8::Unit& u, int wr, int wc, int fr, int fq) const {
        const int row0 = u.pm * 256 + wr * 64 + fr, col0 = u.pn * 256 + wc * 32 + 8 * fq;
#pragma unroll
        for (int ai = 0; ai < 2; ++ai)
#pragma unroll
            for (int m = 0; m < 4; ++m) { const size_t row = (size_t)(row0 + ai * 128 + m * 16);
#pragma unroll
                for (int bj = 0; bj < 2; ++bj) { float gc[8]; unpack8(*(const u32x4*)(GATE + row * 3072 + 2048 + col0 + bj * 128), gc);
                    const f32x4 v0 = acc[ai][bj][m][0], v1 = acc[ai][bj][m][1];
                    u32x4 w; w.x = cvtpk(v0[0] * gc[0], v0[1] * gc[1]); w.y = cvtpk(v0[2] * gc[2], v0[3] * gc[3]); w.z = cvtpk(v1[0] * gc[4], v1[1] * gc[5]); w.w = cvtpk(v1[2] * gc[6], v1[3] * gc[7]);
                    *(u32x4*)(MERGED + row * 1024 + col0 + bj * 128) = w; } }
    }
};
struct EpiMixF32 {
    static constexpr bool PERM = false, HOOK = false;
    float* C;
    DI void hook(f32x4 (&)[2][2][4][2], const g8::Unit&, int, int, int, int, int) const {}
    DI void operator()(const f32x4 (&acc)[2][2][4][2], const g8::Unit& u, int wr, int wc, int fr, int fq) const {
        const int col0 = u.pn * 256 + wc * 32 + 4 * fq;
#pragma unroll
        for (int ai = 0; ai < 2; ++ai)
#pragma unroll
            for (int m = 0; m < 4; ++m) { float* rp = C + (size_t)(u.pm * 256 + ai * 128 + wr * 64 + m * 16 + fr) * 1024 + col0;
#pragma unroll
                for (int bj = 0; bj < 2; ++bj)
#pragma unroll
                    for (int n = 0; n < 2; ++n) *(f32x4*)(rp + bj * 128 + n * 16) = acc[ai][bj][m][n]; }
    }
};
struct EpiPlainB16 {
    static constexpr bool PERM = true, HOOK = false;
    bf16_t* C; int ldc, pad;
    DI void hook(f32x4 (&)[2][2][4][2], const g8::Unit&, int, int, int, int, int) const {}
    DI void operator()(const f32x4 (&acc)[2][2][4][2], const g8::Unit& u, int wr, int wc, int fr, int fq) const {
        const int row0 = u.pm * 256 + wr * 64 + fr, col0 = u.pn * 256 + wc * 32 + 8 * fq;
#pragma unroll
        for (int ai = 0; ai < 2; ++ai)
#pragma unroll
            for (int m = 0; m < 4; ++m) { bf16_t* rowp = C + (size_t)(row0 + ai * 128 + m * 16) * ldc + col0;
#pragma unroll
                for (int bj = 0; bj < 2; ++bj) { const f32x4 v0 = acc[ai][bj][m][0], v1 = acc[ai][bj][m][1];
                    u32x4 w; w.x = cvtpk(v0[0], v0[1]); w.y = cvtpk(v0[2], v0[3]); w.z = cvtpk(v1[0], v1[1]); w.w = cvtpk(v1[2], v1[3]);
                    *(u32x4*)(rowp + bj * 128) = w; } }
    }
};
DI void lse_merge_items(const bf16_t* __restrict__ OG, const float* __restrict__ LSE, bf16_t* __restrict__ BR, int first, int stride) {
    for (int it = first; it < MP * 64; it += stride) {
        const int row = it >> 6, c8 = it & 63, h = c8 >> 4;
        const float l0 = LSE[(size_t)row * 12 + h], l1 = LSE[(size_t)row * 12 + 4 + h], l2 = LSE[(size_t)row * 12 + 8 + h];
        const float mx = fmaxf(l0, fmaxf(l1, l2)); const float e0 = __expf(l0 - mx), e1 = __expf(l1 - mx), e2 = __expf(l2 - mx); const float inv = 1.f / (e0 + e1 + e2);
        const bf16_t* og = OG + (size_t)row * 1536 + c8 * 8;
        float a[8], b[8], c[8]; unpack8(*(const u32x4*)og, a); unpack8(*(const u32x4*)(og + 512), b); unpack8(*(const u32x4*)(og + 1024), c);
        float r[8];
#pragma unroll
        for (int e = 0; e < 8; ++e) r[e] = (e0 * a[e] + e1 * b[e] + e2 * c[e]) * inv;
        u32x4 w; w.x = cvtpk(r[0], r[1]); w.y = cvtpk(r[2], r[3]); w.z = cvtpk(r[4], r[5]); w.w = cvtpk(r[6], r[7]);
        *(u32x4*)(BR + (size_t)row * 1536 + c8 * 8) = w;
    }
}
DI void ln1_rows(const float* __restrict__ x, const float* __restrict__ mix, const float* __restrict__ g, const float* __restrict__ b, float* __restrict__ h1f, bf16_t* __restrict__ h1b, int wave0, int nwaves, int lane) {
    for (int row = wave0; row < MP; row += nwaves) {
        const f32x4* xr = (const f32x4*)(x + (size_t)row * D) + lane; const f32x4* mr = (const f32x4*)(mix + (size_t)row * D) + lane;
        f32x4 v[4]; float s = 0.f;
#pragma unroll
        for (int j = 0; j < 4; ++j) { v[j] = xr[64 * j] * ALPHA + mr[64 * j]; s += (v[j][0] + v[j][1]) + (v[j][2] + v[j][3]); }
        const float mean = wave_sum(s) * (1.f / D); float q = 0.f;
#pragma unroll
        for (int j = 0; j < 4; ++j) { v[j] = v[j] - mean; q += (v[j][0] * v[j][0] + v[j][1] * v[j][1]) + (v[j][2] * v[j][2] + v[j][3] * v[j][3]); }
        const float rstd = rsqrtf(wave_sum(q) * (1.f / D) + LN_EPS);
#pragma unroll
        for (int j = 0; j < 4; ++j) { const f32x4 gg = ((const f32x4*)g)[lane + 64 * j], bb = ((const f32x4*)b)[lane + 64 * j]; const f32x4 o = v[j] * rstd * gg + bb;
            ((f32x4*)(h1f + (size_t)row * D))[lane + 64 * j] = o; u32x2 w; w.x = cvtpk(o[0], o[1]); w.y = cvtpk(o[2], o[3]); ((u32x2*)(h1b + (size_t)row * D))[lane + 64 * j] = w; }
    }
}

DI unsigned mono(float f) { const unsigned u = __float_as_uint(f); return (u & 0x80000000u) ? ~u : (u | 0x80000000u); }
DI float demono(unsigned m) { return __uint_as_float((m & 0x80000000u) ? (m & 0x7fffffffu) : ~m); }
#define CE_DESC(a, b) do { const unsigned _hi = (a) > (b) ? (a) : (b), _lo = (a) > (b) ? (b) : (a); (a) = _hi; (b) = _lo; } while (0)
DI void sort16_desc(unsigned (&k)[16]) {
#pragma unroll
    for (int size = 2; size <= 16; size <<= 1)
#pragma unroll
        for (int stride = size >> 1; stride > 0; stride >>= 1)
#pragma unroll
            for (int i = 0; i < 16; ++i) { const int j = i ^ stride;
                if (j > i) { if ((i & size) == 0 || size == 16) CE_DESC(k[i], k[j]); else CE_DESC(k[j], k[i]); } }
}
DI void merge_top16(unsigned (&t)[16], const unsigned (&l)[16]) {
#pragma unroll
    for (int i = 0; i < 16; ++i) t[i] = t[i] > l[15 - i] ? t[i] : l[15 - i];
#pragma unroll
    for (int stride = 8; stride > 0; stride >>= 1)
#pragma unroll
        for (int i = 0; i < 16; ++i) { const int j = i ^ stride; if (j > i) CE_DESC(t[i], t[j]); }
}
constexpr int RT_ROW = 136;
constexpr int RT_LDS_BYTES = 2 * 128 * RT_ROW * 2;
DI void route_wave(const bf16_t* __restrict__ PQ, const LAS unsigned char* keys, int* __restrict__ IDX, float* __restrict__ PG, int tb, int h, int lane) {
    const int r32 = lane & 31, hi = lane >> 5;
    const size_t tok = (size_t)tb * 32 + r32;
    unsigned Tp[2][16];
#pragma unroll
    for (int p = 0; p < 2; ++p) {
        bf16x8 qf[8];
        const bf16_t* qp = PQ + tok * 2048 + h * 256 + p * 128 + 8 * hi;
#pragma unroll
        for (int ks = 0; ks < 8; ++ks) qf[ks] = *(const bf16x8*)(qp + 16 * ks);
#pragma unroll
        for (int nt = 0; nt < 4; ++nt) {
            f32x16 acc;
#pragma unroll
            for (int i = 0; i < 16; ++i) acc[i] = 0.f;
#pragma unroll
            for (int ks = 0; ks < 8; ++ks) { const bf16x8 kf = *(const LAS bf16x8*)(keys + ((p * 128 + 32 * nt + r32) * RT_ROW + 16 * ks + 8 * hi) * 2); acc = MFMA32(kf, qf[ks], acc); }
            unsigned L[16];
#pragma unroll
            for (int i = 0; i < 16; ++i) L[i] = (mono(acc[i]) & ~0x7fu) | (unsigned)(127 - (32 * nt + crow(i, hi)));
            sort16_desc(L);
            if (nt == 0) {
#pragma unroll
                for (int i = 0; i < 16; ++i) Tp[p][i] = L[i];
            } else merge_top16(Tp[p], L);
            __builtin_amdgcn_sched_barrier(0);
        }
    }
    unsigned T[16];
    { unsigned O[16];
#pragma unroll
      for (int i = 0; i < 16; ++i) { const auto rr = __builtin_amdgcn_permlane32_swap(Tp[0][i], Tp[1][i], false, false); T[i] = rr[0]; O[i] = rr[1]; }
      merge_top16(T, O); }
    __builtin_amdgcn_sched_barrier(0);
    float s1[16], s2[16]; unsigned i1[16], i2[16];
#pragma unroll
    for (int i = 0; i < 16; ++i) { const auto rr = __builtin_amdgcn_permlane32_swap(T[i], T[i], false, false);
        s1[i] = demono(rr[0] & ~0x7fu); i1[i] = 127u - (rr[0] & 0x7fu); s2[i] = demono(rr[1] & ~0x7fu); i2[i] = 127u - (rr[1] & 0x7fu); }
    unsigned C[64];
    { int n = 0;
#pragma unroll
      for (int a = 0; a < 16; ++a)
#pragma unroll
          for (int b = 0; b < 16; ++b) if ((a + 1) * (b + 1) <= 16) { C[n] = (mono(s1[a] + s2[b]) & ~0x3fffu) | (i1[a] << 7) | i2[b]; ++n; }
#pragma unroll
      for (int i = 50; i < 64; ++i) C[i] = 0u; }
    unsigned F[16];
#pragma unroll
    for (int i = 0; i < 16; ++i) F[i] = C[i];
    sort16_desc(F);
#pragma unroll
    for (int g = 1; g < 4; ++g) { unsigned L[16];
#pragma unroll
        for (int i = 0; i < 16; ++i) L[i] = C[16 * g + i];
        sort16_desc(L); merge_top16(F, L); __builtin_amdgcn_sched_barrier(0); }
    if (hi == 0) {
        float e[16]; float sum = 0.f; const float v0 = demono(F[0] & ~0x3fffu);
#pragma unroll
        for (int i = 0; i < 16; ++i) { e[i] = __expf(demono(F[i] & ~0x3fffu) - v0); sum += e[i]; }
        const float inv = 1.f / sum;
        int* ip = IDX + tok * 128 + h * 16; float* gp = PG + tok * 128 + h * 16;
#pragma unroll
        for (int q = 0; q < 4; ++q) { u32x4 iv; iv.x = F[4 * q] & 0x3fffu; iv.y = F[4 * q + 1] & 0x3fffu; iv.z = F[4 * q + 2] & 0x3fffu; iv.w = F[4 * q + 3] & 0x3fffu; *(u32x4*)(ip + 4 * q) = iv;
            f32x4 gv; gv[0] = e[4 * q] * inv; gv[1] = e[4 * q + 1] * inv; gv[2] = e[4 * q + 2] * inv; gv[3] = e[4 * q + 3] * inv; *(f32x4*)(gp + 4 * q) = gv; }
    }
}
typedef __bf16 bf16x2v __attribute__((ext_vector_type(2)));
DI float dot2bf(unsigned w, unsigned x, float acc) { return __builtin_amdgcn_fdot2_f32_bf16(__builtin_bit_cast(bf16x2v, w), __builtin_bit_cast(bf16x2v, x), acc, false); }
DI float gelu_erf(float v) {
    const float av = fabsf(v), t = __builtin_amdgcn_rcpf(av * 0.2316418882f + 1.0f);
    float q = t * 0.5307027145f + (-0.7265760135f); q = q * t + 0.7107068705f; q = q * t + (-0.142248368f); q = q * t + 0.127414796f; q = q * t;
    const float e = __builtin_amdgcn_exp2f((v * v) * (-0.72134752044f)); const float m = v * (q * e);
    return v < 0.f ? m : v - m;
}
DI void experts_token(const bf16_t* __restrict__ H1B, const unsigned char* __restrict__ U8, const unsigned char* __restrict__ V8, const float* __restrict__ USC, const float* __restrict__ VSC,
                      const int* __restrict__ IDX, const float* __restrict__ PG, const float* __restrict__ g2, const float* __restrict__ b2, float* outp, size_t tok, int lane) {
    f32x2 hv[8];
    { const u32x4 a = *(const u32x4*)(H1B + tok * D + 16 * lane), b = *(const u32x4*)(H1B + tok * D + 16 * lane + 8);
#pragma unroll
      for (int q = 0; q < 4; ++q) { hv[q] = (f32x2){__uint_as_float(a[q] << 16), __uint_as_float(a[q] & 0xffff0000u)}; hv[4 + q] = (f32x2){__uint_as_float(b[q] << 16), __uint_as_float(b[q] & 0xffff0000u)}; } }
    const int ilo = IDX[tok * 128 + lane], ihi = IDX[tok * 128 + 64 + lane];
    float c0 = 0.f, c1 = 0.f;
#pragma unroll 1
    for (int b = 0; b < 8; ++b) {
        const int isel = b < 4 ? ilo : ihi;
        float p[16];
#pragma unroll
        for (int i = 0; i < 16; ++i) {
            const int row = __builtin_amdgcn_readlane(isel, (16 * b + i) & 63);
            const u32x4 w = *((const u32x4*)(U8 + (size_t)row * D) + lane);
            f32x2 d2 = {0.f, 0.f};
#pragma unroll
            for (int q = 0; q < 4; ++q) { d2 += __builtin_amdgcn_cvt_pk_f32_fp8((int)w[q], false) * hv[2 * q]; d2 += __builtin_amdgcn_cvt_pk_f32_fp8((int)w[q], true) * hv[2 * q + 1]; }
            p[i] = d2[0] + d2[1];
        }
#pragma unroll
        for (int i = 0; i < 8; ++i) { const auto rr = __builtin_amdgcn_permlane32_swap(__float_as_uint(p[i]), __float_as_uint(p[i + 8]), false, false); p[i] = __uint_as_float(rr[0]) + __uint_as_float(rr[1]); }
#pragma unroll
        for (int m = 16; m >= 4; m >>= 1) {
            const bool up = (lane & m) != 0; const int n = m >> 2;
#pragma unroll
            for (int i = 0; i < n; ++i) { const float send = up ? p[i] : p[i + n], keep = up ? p[i + n] : p[i]; p[i] = keep + __shfl_xor(send, m); }
        }
        p[0] += __shfl_xor(p[0], 2); p[0] += __shfl_xor(p[0], 1);
        const bool mine = (lane & 3) == (b & 3);
        c0 = (mine && b < 4) ? p[0] : c0; c1 = (mine && b >= 4) ? p[0] : c1;
    }
    {
        const int e0 = 16 * (lane & 3) + (lane >> 2), e1 = e0 + 64;
        const int my0 = IDX[tok * 128 + e0], my1 = IDX[tok * 128 + e1];
        c0 = PG[tok * 128 + e0] * gelu_erf(c0 * USC[my0]) * VSC[my0];
        c1 = PG[tok * 128 + e1] * gelu_erf(c1 * USC[my1]) * VSC[my1];
    }
    f32x2 f2[8];
#pragma unroll
    for (int i = 0; i < 8; ++i) f2[i] = (f32x2){0.f, 0.f};
#pragma unroll 8
    for (int e = 0; e < 128; ++e) {
        const int row = __builtin_amdgcn_readlane(e < 64 ? ilo : ihi, e & 63);
        const float c = __builtin_bit_cast(float, __builtin_amdgcn_readlane(__builtin_bit_cast(int, e < 64 ? c0 : c1), 4 * (e & 15) + ((e >> 4) & 3)));
        const u32x4 w = *((const u32x4*)(V8 + (size_t)row * D) + lane);
        const f32x2 c2 = {c, c};
#pragma unroll
        for (int q = 0; q < 4; ++q) { f2[2 * q] += c2 * __builtin_amdgcn_cvt_pk_f32_fp8((int)w[q], false); f2[2 * q + 1] += c2 * __builtin_amdgcn_cvt_pk_f32_fp8((int)w[q], true); }
    }
    float* hr = outp + tok * D + 16 * lane;
    f32x4 v[4];
#pragma unroll
    for (int j = 0; j < 4; ++j) v[j] = *(const f32x4*)(hr + 4 * j);
    float s = 0.f;
#pragma unroll
    for (int j = 0; j < 4; ++j) { v[j][0] = v[j][0] * ALPHA + f2[2 * j][0]; v[j][1] = v[j][1] * ALPHA + f2[2 * j][1]; v[j][2] = v[j][2] * ALPHA + f2[2 * j + 1][0]; v[j][3] = v[j][3] * ALPHA + f2[2 * j + 1][1];
        s += (v[j][0] + v[j][1]) + (v[j][2] + v[j][3]); }
    const float mean = wave_sum(s) * (1.f / D); float q2 = 0.f;
#pragma unroll
    for (int j = 0; j < 4; ++j)
#pragma unroll
        for (int e = 0; e < 4; ++e) { v[j][e] -= mean; q2 += v[j][e] * v[j][e]; }
    const float rstd = rsqrtf(wave_sum(q2) * (1.f / D) + LN_EPS);
#pragma unroll
    for (int j = 0; j < 4; ++j) { const f32x4 gg = *(const f32x4*)(g2 + 16 * lane + 4 * j), bb = *(const f32x4*)(b2 + 16 * lane + 4 * j); *(f32x4*)(hr + 4 * j) = v[j] * rstd * gg + bb; }
}

DI void p0_convert(const float* __restrict__ in, bf16_t* __restrict__ out, size_t n8, size_t first, size_t stride) {
    for (size_t i = first; i < n8; i += stride) { const f32x4 a = ((const f32x4*)in)[2 * i], b = ((const f32x4*)in)[2 * i + 1];
        u32x4 w; w.x = cvtpk(a[0], a[1]); w.y = cvtpk(a[2], a[3]); w.z = cvtpk(b[0], b[1]); w.w = cvtpk(b[2], b[3]); ((u32x4*)out)[i] = w; }
}
DI void p0_transpose_item(const float* __restrict__ W, int ldw, int ncols, bf16_t* __restrict__ out, int ldo, int koff, LAS float* scr, int item, int lane) {
    const int nblk = ncols / 32, kb = item / nblk, nb = item % nblk, k0 = 64 * kb, n0 = 32 * nb;
#pragma unroll 8
    for (int i = 0; i < 32; ++i) { const int kk = 2 * i + (lane >> 5); scr[kk * 33 + (lane & 31)] = W[(size_t)(k0 + kk) * ldw + n0 + (lane & 31)]; }
    asm volatile("s_waitcnt lgkmcnt(0)" ::: "memory");
    const int c = lane & 7;
#pragma unroll
    for (int j = 0; j < 4; ++j) { const int n = (lane >> 3) + 8 * j; const LAS float* s = scr + (8 * c) * 33 + n;
        u32x4 o; o.x = cvtpk(s[0 * 33], s[1 * 33]); o.y = cvtpk(s[2 * 33], s[3 * 33]); o.z = cvtpk(s[4 * 33], s[5 * 33]); o.w = cvtpk(s[6 * 33], s[7 * 33]);
        *(u32x4*)(out + (size_t)(n0 + n) * ldo + koff + k0 + 8 * c) = o; }
    asm volatile("s_waitcnt lgkmcnt(0)" ::: "memory");
}
DI void p0_fp8_row(const float* __restrict__ src, unsigned char* __restrict__ dst, float* __restrict__ scale, int row, int lane) {
    const f32x4* sp = (const f32x4*)(src + (size_t)row * D) + 4 * lane;
    f32x4 v[4]; float mx = 0.f;
#pragma unroll
    for (int j = 0; j < 4; ++j) { v[j] = sp[j]; mx = fmaxf(mx, fmaxf(fmaxf(fabsf(v[j][0]), fabsf(v[j][1])), fmaxf(fabsf(v[j][2]), fabsf(v[j][3])))); }
    mx = wave_max(mx);
    const float sc = mx > 0.f ? 224.f / mx : 1.f;
    u32x4 w;
#pragma unroll
    for (int j = 0; j < 4; ++j) { int p = 0; p = __builtin_amdgcn_cvt_pk_fp8_f32(v[j][0] * sc, v[j][1] * sc, p, false); p = __builtin_amdgcn_cvt_pk_fp8_f32(v[j][2] * sc, v[j][3] * sc, p, true); w[j] = (unsigned)p; }
    *(u32x4*)(dst + (size_t)row * D + 16 * lane) = w;
    if (lane == 0) scale[row] = mx > 0.f ? mx * (1.f / 224.f) : 1.f;
}
DI void p0_misc(const float* __restrict__ hgrn_lb, const float* __restrict__ rel_bias, float* __restrict__ misc, int i) {
    if (i < 512) { const float a = hgrn_lb[i], b = hgrn_lb[512 + i]; const float mx = fmaxf(a, b); const float ea = expf(a - mx), eb = expf(b - mx); misc[i] = ea / (ea + eb); }
    if (i < 3 * 129) {
        const int g = i / 129, j = i % 129; const int dl = g == 0 ? 1 : (g == 1 ? 4 : 16); const int n = j * dl;
        int bucket;
        if (n < 16) bucket = n;
        else { const double v = log((double)n / 16.0) / log(128.0) * 16.0; int l = 16 + (int)v; bucket = l < 31 ? l : 31; }
        for (int h = 0; h < 4; ++h) misc[512 + i * 4 + h] = rel_bias[bucket * 12 + g * 4 + h];
    }
}
struct SchedMemKV {
    unsigned MEMB, W; int G, c;
    DI bool next(int i, g8::Unit& u) const {
        const int L = i * G + c; if (L >= 32) return false;
        u.dlb = 1;
        if (L < 16) { u.kind = 0; u.pm = L >> 1; u.pn = L & 1; u.a = MEMB + (unsigned)u.pm * 256u * D * 2u; u.b = W + (unsigned)u.pn * 256u * D * 2u; }
        else { const int q = L - 16; u.kind = 1; u.pm = q >> 3; u.pn = q & 7; u.a = W + (unsigned)(512 + u.pm * 256) * D * 2u; u.b = MEMB + (unsigned)u.pn * 256u * D * 2u; }
        return true;
    }
};
struct EpiMemKVF {
    static constexpr bool PERM = true, HOOK = false;
    bf16_t *MK, *MVT;
    DI void hook(f32x4 (&)[2][2][4][2], const g8::Unit&, int, int, int, int, int) const {}
    DI void operator()(const f32x4 (&acc)[2][2][4][2], const g8::Unit& u, int wr, int wc, int fr, int fq) const {
        bf16_t* base = u.kind ? MVT : MK; const int ldc = u.kind ? 2048 : 512;
        const int row0 = u.pm * 256 + wr * 64 + fr, col0 = u.pn * 256 + wc * 32 + 8 * fq;
#pragma unroll
        for (int ai = 0; ai < 2; ++ai)
#pragma unroll
            for (int m = 0; m < 4; ++m) { bf16_t* rowp = base + (size_t)(row0 + ai * 128 + m * 16) * ldc + col0;
#pragma unroll
                for (int bj = 0; bj < 2; ++bj) { const f32x4 v0 = acc[ai][bj][m][0], v1 = acc[ai][bj][m][1];
                    u32x4 w; w.x = cvtpk(v0[0], v0[1]); w.y = cvtpk(v0[2], v0[3]); w.z = cvtpk(v1[0], v1[1]); w.w = cvtpk(v1[2], v1[3]);
                    *(u32x4*)(rowp + bj * 128) = w; } }
    }
};

static_assert(HG_UNIT_BYTES <= LDSCTL_OFF, "hgrn LDS");
DI const float* karg_in(int i) { const float* const* kp = (const float* const*)__builtin_amdgcn_kernarg_segment_ptr(); asm volatile("" : "+s"(kp)); return kp[i]; }
DI float* karg_out() { float* const* kp = (float* const*)__builtin_amdgcn_kernarg_segment_ptr(); asm volatile("" : "+s"(kp)); return kp[18]; }
__global__ void __launch_bounds__(NTHR, 2) mega(Args args) {
    extern __shared__ __attribute__((aligned(16))) unsigned char lds_raw[];
    LAS unsigned char* lds = (LAS unsigned char*)lds_raw;
    volatile LAS unsigned* MISC = (volatile LAS unsigned*)(lds + MISC_OFF);
    for (int u = threadIdx.x; u < (LDS_BYTES - LDSCTL_OFF) / 4; u += NTHR) ((LAS unsigned*)(lds + LDSCTL_OFF))[u] = 0u;
    __syncthreads();
    unsigned char* ws = args.ws;
    const int G = gridDim.x;
    const bool ALL = args.ph == PH_ALL;
    XcdBarrier bar; bar.bar = (unsigned*)(ws + O_MISC + 16384); bar.x = 0; bar.st = nullptr;
    if (ALL) bar = xcd_barrier_post((unsigned*)(ws + O_MISC + 16384), MISC + 8);
#ifndef REP_MASK
#define REP_MASK 0
#endif
#define RUN(k) (ALL || args.ph == (k))
#define NREP(k) (((REP_MASK >> (k)) & 1) ? 2 : 1)
#define SEAM() do { if (ALL) xcd_barrier(bar); } while (0)
    for (int rep_ = 0; rep_ < NREP(PH_PRO); ++rep_) if (RUN(PH_PRO)) {
        int tid = threadIdx.x; asm volatile("" : "+v"(tid)); asm volatile("" : "+s"(ws)); int bid = blockIdx.x; asm volatile("" : "+s"(bid));
        const size_t gt = (size_t)bid * NTHR + tid, nth = (size_t)G * NTHR;
        p0_convert(karg_in(0), (bf16_t*)(ws + O_XB), (size_t)M * D / 8, gt, nth);
        p0_convert(karg_in(1), (bf16_t*)(ws + O_MEMB), (size_t)2048 * 1024 / 8, gt, nth);
        p0_convert(karg_in(13), (bf16_t*)(ws + O_SUBK), (size_t)16 * 128 * 128 / 8, gt, nth);
        if (bid == 0) p0_misc(karg_in(6), karg_in(5), (float*)(ws + O_MISC), tid);
        const int wid = __builtin_amdgcn_readfirstlane(tid >> 6), lane = tid & 63;
        LAS float* scr = (LAS float*)(lds + wid * 16384);
        const int gw = bid * NWAVES + wid, ngw = G * NWAVES;
        for (int r = gw; r < 2 * NEXP; r += ngw) {
            if (r < NEXP) p0_fp8_row(karg_in(14), (unsigned char*)(ws + O_UB), (float*)(ws + O_USC), r, lane);
            else p0_fp8_row(karg_in(15), (unsigned char*)(ws + O_VB), (float*)(ws + O_VSC), r - NEXP, lane);
        }
        constexpr int NJ = 13;
        for (int it = gw; ; it += ngw) {
            int r = it; bool done = true;
#pragma unroll
            for (int j = 0; j < NJ; ++j) {
                const int srcc[NJ] = {0, 4608, 5632, 6656, 7168, 3072, 5120, 0, 0, 0, 0, 0, 0};
                const int cnt[NJ] = {3072, 512, 1024, 512, 3072, 1536, 512, 1024, 1024, 1024, 1024, 1024, 2048};
                const int drow[NJ] = {0, 3072, 3584, 4608, 5120, 8192, 9728, 0, 0, 0, 0, 0, 0};
                const int Kj = (j >= 8 && j <= 10) ? 512 : 1024;
                const int items = (Kj / 64) * (cnt[j] / 32);
                if (done && r < items) {
                    const float* W; int ldw; bf16_t* o; int ldo, koff = 0;
                    if (j < 7) { W = karg_in(2) + srcc[j]; ldw = INC; o = (bf16_t*)(ws + O_WIN) + (size_t)drow[j] * 1024; ldo = 1024; }
                    else if (j == 7) { W = karg_in(4); ldw = 1024; o = (bf16_t*)(ws + O_WMKV); ldo = 1024; }
                    else if (j <= 10) { W = karg_in(8) + (size_t)(j - 8) * 512 * 1024; ldw = 1024; o = (bf16_t*)(ws + O_WBR); ldo = 1536; koff = (j - 8) * 512; }
                    else if (j == 11) { W = karg_in(9); ldw = 1024; o = (bf16_t*)(ws + O_WOUT); ldo = 1024; }
                    else { W = karg_in(12); ldw = 2048; o = (bf16_t*)(ws + O_WPQ); ldo = 1024; }
                    p0_transpose_item(W, ldw, cnt[j], o, ldo, koff, scr, r, lane); done = false;
                }
                r -= items;
            }
            if (done) break;
        }
        SEAM();
    }
#pragma unroll 1
    for (int p = (ALL ? 0 : args.pass); p < (ALL ? NPASS : args.pass + 1); ++p) {
        int bid = blockIdx.x; asm volatile("" : "+s"(bid));
        int tid = threadIdx.x; asm volatile("" : "+v"(tid));
        asm volatile("" : "+s"(ws));
        char* pr = (char*)ws + O_PASS;
        const size_t t0 = (size_t)p * MP;
        for (int rep_ = 0; rep_ < NREP(PH_PROJ); ++rep_) if (RUN(PH_PROJ)) {
            asm volatile("" : "+s"(bid)); asm volatile("" : "+v"(tid)); asm volatile("" : "+s"(ws)); pr = (char*)ws + O_PASS;
            SchedP1 Sc{(unsigned)(O_XB + t0 * D * 2), (unsigned)O_WIN, G, bid};
            EpiP1 E{pr, karg_in(3)};
            g8::gemm_phase<EpiP1, SchedP1>(lds, (const char*)ws, D, Sc, E, tid);
            if (p == 0) {
                SchedMemKV S2{(unsigned)O_MEMB, (unsigned)O_WMKV, G, bid};
                EpiMemKVF E2{(bf16_t*)(ws + O_MK), (bf16_t*)(ws + O_MVT)};
                g8::gemm_phase<EpiMemKVF, SchedMemKV>(lds, (const char*)ws, D, S2, E2, tid);
            }
            SEAM();
        }
        for (int rep_ = 0; rep_ < NREP(PH_ATTN); ++rep_) if (RUN(PH_ATTN)) {
            asm volatile("" : "+s"(bid)); asm volatile("" : "+v"(tid)); asm volatile("" : "+s"(ws)); pr = (char*)ws + O_PASS;
            const float* bsrc = (const float*)(ws + O_MISC) + 512; LAS float* btab = (LAS float*)lds;
            for (int i = tid; i < 3 * 129 * 4; i += NTHR) btab[i] = bsrc[i] * LOG2E;
            __syncthreads();
            const int wid = __builtin_amdgcn_readfirstlane(tid >> 6), lane = tid & 63;
            for (int task = bid * NWAVES + wid; task < DIL_TASKS; task += G * NWAVES)
                attn_dil_wave((const bf16_t*)(pr + P_QK), (const bf16_t*)(pr + P_VT), btab, (bf16_t*)(pr + P_OG), (float*)(pr + P_LSE), task, lane);
            for (int task = bid * NWAVES + wid; task < MEM_TASKS; task += G * NWAVES)
                attn_mem_wave((const bf16_t*)(pr + P_MQ), (const bf16_t*)(ws + O_MK), (const bf16_t*)(ws + O_MVT), (bf16_t*)(pr + P_BR), task, p * BPP, lane);
            __syncthreads();
        }
        for (int rep_ = 0; rep_ < NREP(PH_HGPRE); ++rep_) if (RUN(PH_HGPRE)) {
            asm volatile("" : "+s"(bid)); asm volatile("" : "+v"(tid)); asm volatile("" : "+s"(ws)); pr = (char*)ws + O_PASS;
            { const int unit = bid; static_assert(HG_UNITS == 256, "one HGRN unit per workgroup"); if (unit < HG_UNITS) {
                hgrn_unit<false>(lds, unit, tid, (const bf16_t*)(pr + P_HFQG), (const bf16_t*)(pr + P_IT), (const float*)(ws + O_MISC), karg_in(7),
                                 (float*)(pr + P_HSTL), (float*)(pr + P_HSTD), (const float*)(pr + P_SIN), (bf16_t*)(pr + P_BR));
            } }
            SEAM();
        }
        for (int rep_ = 0; rep_ < NREP(PH_HGSCAN); ++rep_) if (RUN(PH_HGSCAN)) {
            asm volatile("" : "+s"(bid)); asm volatile("" : "+v"(tid)); asm volatile("" : "+s"(ws)); pr = (char*)ws + O_PASS;
            hgrn_scan((const float*)(pr + P_HSTL), (const float*)(pr + P_HSTD), (float*)(pr + P_SIN), bid * NTHR + tid);
            lse_merge_items((const bf16_t*)(pr + P_OG), (const float*)(pr + P_LSE), (bf16_t*)(pr + P_BR), bid * NTHR + tid, G * NTHR);
            SEAM();
        }
        for (int rep_ = 0; rep_ < NREP(PH_HGMAIN); ++rep_) if (RUN(PH_HGMAIN)) {
            asm volatile("" : "+s"(bid)); asm volatile("" : "+v"(tid)); asm volatile("" : "+s"(ws)); pr = (char*)ws + O_PASS;
            { const int unit = bid; static_assert(HG_UNITS == 256, "one HGRN unit per workgroup"); if (unit < HG_UNITS) {
                hgrn_unit<true>(lds, unit, tid, (const bf16_t*)(pr + P_HFQG), (const bf16_t*)(pr + P_IT), (const float*)(ws + O_MISC), karg_in(7),
                                (float*)(pr + P_HSTL), (float*)(pr + P_HSTD), (const float*)(pr + P_SIN), (bf16_t*)(pr + P_BR));
            } }
            SEAM();
        }
        for (int rep_ = 0; rep_ < NREP(PH_WIDEN); ++rep_) if (RUN(PH_WIDEN)) {
            asm volatile("" : "+s"(bid)); asm volatile("" : "+v"(tid)); asm volatile("" : "+s"(ws)); pr = (char*)ws + O_PASS;
            SchedRows Sc{(unsigned)(O_PASS + P_BR), (unsigned)O_WBR, 1536, 4, 256, G, bid};
            EpiWidenF E{(const bf16_t*)(pr + P_GATE), (bf16_t*)(pr + P_MERGED)};
            g8::gemm_phase<EpiWidenF, SchedRows>(lds, (const char*)ws, 1536, Sc, E, tid);
            SEAM();
        }
        for (int rep_ = 0; rep_ < NREP(PH_WOUT); ++rep_) if (RUN(PH_WOUT)) {
            asm volatile("" : "+s"(bid)); asm volatile("" : "+v"(tid)); asm volatile("" : "+s"(ws)); pr = (char*)ws + O_PASS;
            SchedRows Sc{(unsigned)(O_PASS + P_MERGED), (unsigned)O_WOUT, 1024, 4, 256, G, bid};
            EpiMixF32 E{(float*)(pr + P_MIX)};
            g8::gemm_phase<EpiMixF32, SchedRows>(lds, (const char*)ws, 1024, Sc, E, tid);
            SEAM();
        }
        for (int rep_ = 0; rep_ < NREP(PH_LN1); ++rep_) if (RUN(PH_LN1)) {
            asm volatile("" : "+s"(bid)); asm volatile("" : "+v"(tid)); asm volatile("" : "+s"(ws)); pr = (char*)ws + O_PASS;
            ln1_rows(karg_in(0) + t0 * D, (const float*)(pr + P_MIX), karg_in(10), karg_in(11), karg_out() + t0 * D, (bf16_t*)(ws + O_H1B) + t0 * D, bid * NWAVES + (tid >> 6), G * NWAVES, tid & 63);
        }
    }
    for (int rep_ = 0; rep_ < NREP(PH_PQ); ++rep_) if (RUN(PH_PQ)) {
        SEAM();
        int tid = threadIdx.x; asm volatile("" : "+v"(tid)); asm volatile("" : "+s"(ws)); int bid = blockIdx.x; asm volatile("" : "+s"(bid));
        char* pr = (char*)ws + O_PASS;
        SchedRows Sc{(unsigned)O_H1B, (unsigned)O_WPQ, 1024, 8, 2048, G, bid};
        EpiPlainB16 E{(bf16_t*)(pr + P_PQ), 2048, 0};
        g8::gemm_phase<EpiPlainB16, SchedRows>(lds, (const char*)ws, 1024, Sc, E, tid);
        SEAM();
    }
    for (int rep_ = 0; rep_ < NREP(PH_ROUTE); ++rep_) if (RUN(PH_ROUTE)) {
        int tid = threadIdx.x; asm volatile("" : "+v"(tid)); asm volatile("" : "+s"(ws)); int bid = blockIdx.x; asm volatile("" : "+s"(bid));
        char* pr = (char*)ws + O_PASS;
        const int h = bid & 7, wgi = bid >> 3, nwg = G >> 3;
        const bf16_t* ksrc = (const bf16_t*)(ws + O_SUBK) + (size_t)h * 2 * 128 * 128;
        for (int i = tid; i < 2 * 128 * 16; i += NTHR) { const int rowk = i >> 4, ch = i & 15; *(LAS u32x4*)(lds + (rowk * RT_ROW + ch * 8) * 2) = *(const u32x4*)(ksrc + rowk * 128 + ch * 8); }
        __syncthreads();
        const int wid = __builtin_amdgcn_readfirstlane(tid >> 6), lane = tid & 63;
        for (int tb = wgi * NWAVES + wid; tb < M / 32; tb += nwg * NWAVES)
            route_wave((const bf16_t*)(pr + P_PQ), lds, (int*)(pr + P_IDX), (float*)(pr + P_PG), tb, h, lane);
        __syncthreads();
        SEAM();
    }
    if (RUN(PH_EXPERTS)) {
        int tid = threadIdx.x; asm volatile("" : "+v"(tid)); asm volatile("" : "+s"(ws)); int bid = blockIdx.x; asm volatile("" : "+s"(bid));
        char* pr = (char*)ws + O_PASS;
        const int wid = __builtin_amdgcn_readfirstlane(tid >> 6), lane = tid & 63;
        for (int tok = bid * NWAVES + wid; tok < M; tok += G * NWAVES)
            experts_token((const bf16_t*)(ws + O_H1B), (const unsigned char*)(ws + O_UB), (const unsigned char*)(ws + O_VB), (const float*)(ws + O_USC), (const float*)(ws + O_VSC), (const int*)(pr + P_IDX), (const float*)(pr + P_PG), karg_in(16), karg_in(17), karg_out(), (size_t)tok, lane);
    }
#undef RUN
#undef SEAM
}

extern "C" void kernel_launch(void* const* d_in, const int* in_sizes, int n_in, void* d_out, int out_size, void* d_ws, size_t ws_size, hipStream_t stream) {
    if (ws_size < WS_NEED || n_in != 18) return;
    static bool attr_set = false;
    if (!attr_set) { (void)hipFuncSetAttribute((const void*)mega, hipFuncAttributeMaxDynamicSharedMemorySize, LDS_BYTES); attr_set = true; }
    (void)hipMemsetAsync((char*)d_ws + O_MISC + 16384, 0, 16384, stream);
    Args a{}; for (int i = 0; i < 18; ++i) a.in[i] = (const float*)d_in[i]; a.out = (float*)d_out; a.ws = (unsigned char*)d_ws; a.ph = PH_ALL; a.pass = 0;
    mega<<<256, NTHR, LDS_BYTES, stream>>>(a);
}
```

```cpp
#include <hip/hip_runtime.h>
#include <stdint.h>
#include <math.h>

typedef unsigned short bf16_t;
typedef short bf16x8 __attribute__((ext_vector_type(8)));
typedef float f32x4 __attribute__((ext_vector_type(4)));
#define DI __device__ __forceinline__

DI float bf2f(bf16_t v) { return __uint_as_float(((unsigned)v) << 16); }
DI bf16_t f2bf(float f) { unsigned u = __float_as_uint(f); u += 0x7fffu + ((u >> 16) & 1u); return (bf16_t)(u >> 16); }

constexpr int NB = 8, S = 8192, D = 1024, M = NB * S;
constexpr int NPASS = 4, BPP = NB / NPASS, MP = BPP * S;
constexpr int INC = 10240;
constexpr int NEXP = 16384;
constexpr float ALPHA = 1.189207115002721f;
constexpr float LN_EPS = 1e-5f;
constexpr float QSCALE = 0.08838834764831845f;

constexpr size_t al(size_t x) { return (x + 255) & ~(size_t)255; }
constexpr size_t O_WIN = 0;
constexpr size_t O_WMKV = O_WIN + al((size_t)INC * D * 2);
constexpr size_t O_WBR = O_WMKV + al((size_t)1024 * 1024 * 2);
constexpr size_t O_WOUT = O_WBR + al((size_t)1024 * 1536 * 2);
constexpr size_t O_WPQ = O_WOUT + al((size_t)1024 * 1024 * 2);
constexpr size_t O_SUBK = O_WPQ + al((size_t)2048 * 1024 * 2);
constexpr size_t O_UB = O_SUBK + al((size_t)16 * 128 * 128 * 2);
constexpr size_t O_VB = O_UB + al((size_t)NEXP * D);
constexpr size_t O_USC = O_VB + al((size_t)NEXP * D);
constexpr size_t O_VSC = O_USC + al((size_t)NEXP * 4);
constexpr size_t O_XB = O_VSC + al((size_t)NEXP * 4);
constexpr size_t O_MEMB = O_XB + al((size_t)M * D * 2);
constexpr size_t O_MK = O_MEMB + al((size_t)2048 * 1024 * 2);
constexpr size_t O_MVT = O_MK + al((size_t)2048 * 512 * 2);
constexpr size_t O_H1B = O_MVT + al((size_t)8 * 512 * 256 * 2);
constexpr size_t O_MISC = O_H1B + al((size_t)M * D * 2);
constexpr size_t O_PASS = O_MISC + al(65536);
constexpr size_t P_QK = 0;
constexpr size_t P_VT = P_QK + al((size_t)MP * 3072 * 2);
constexpr size_t P_IT = P_VT + (size_t)1536 * MP * 2;
constexpr size_t P_HFQG = P_IT + al((size_t)512 * MP * 2);
constexpr size_t P_MQ = P_HFQG + al((size_t)MP * 1536 * 2);
constexpr size_t P_GATE = P_MQ + al((size_t)MP * 512 * 2);
constexpr size_t P_OG = P_GATE + al((size_t)MP * 3072 * 2);
constexpr size_t P_LSE = P_OG + al((size_t)MP * 1536 * 2);
constexpr size_t P_BR = P_LSE + al((size_t)MP * 12 * 4);
constexpr size_t P_MERGED = P_BR + al((size_t)MP * 1536 * 2);
constexpr size_t P_MIX = P_MERGED + al((size_t)MP * 1024 * 2);
constexpr size_t P_HSTL = P_MIX + al((size_t)MP * 1024 * 4);
constexpr size_t P_HSTD = P_HSTL + al((size_t)256 * 16384 * 4);
constexpr size_t P_SIN = P_HSTD + al((size_t)256 * 128 * 4);
constexpr size_t P_END = P_SIN + al((size_t)256 * 16384 * 4);
constexpr size_t P_PQ = 0;
constexpr size_t P_IDX = P_PQ + al((size_t)M * 2048 * 2);
constexpr size_t P_PG = P_IDX + al((size_t)M * 128 * 4);
constexpr size_t P_C = P_PG + al((size_t)M * 128 * 4);
constexpr size_t P_END2 = P_C + al((size_t)M * 128 * 4);
constexpr size_t P_PD = 0;
constexpr size_t P_FFN = P_PD + al((size_t)M * 1024 * 2);
static_assert(P_FFN + (size_t)M * 1024 * 2 <= P_IDX, "PEER overlay");
constexpr size_t WS_NEED = O_PASS + (P_END > P_END2 ? P_END : P_END2);
static_assert(WS_NEED <= (size_t)1073741824, "workspace budget");

__global__ __launch_bounds__(256) void k_convert(const float* __restrict__ in, bf16_t* __restrict__ out, size_t n4) {
    size_t i = (size_t)blockIdx.x * 256 + threadIdx.x; const size_t st = (size_t)gridDim.x * 256;
    for (; i < n4; i += st) { const f32x4 v = ((const f32x4*)in)[i]; ushort4 o; o.x = f2bf(v[0]); o.y = f2bf(v[1]); o.z = f2bf(v[2]); o.w = f2bf(v[3]); ((ushort4*)out)[i] = o; }
}
__global__ __launch_bounds__(256) void k_transpose(const float* __restrict__ W, int K, int ldw, bf16_t* __restrict__ out, int ldo, int koff) {
    __shared__ float t[32][33];
    const int k0 = blockIdx.y * 32, n0 = blockIdx.x * 32, tx = threadIdx.x & 31, ty = threadIdx.x >> 5;
    for (int i = ty; i < 32; i += 8) t[i][tx] = W[(size_t)(k0 + i) * ldw + n0 + tx];
    __syncthreads();
    for (int i = ty; i < 32; i += 8) out[(size_t)(n0 + i) * ldo + koff + k0 + tx] = f2bf(t[tx][i]);
}
__global__ void k_misc(const float* __restrict__ hgrn_lb, const float* __restrict__ rel_bias, float* __restrict__ misc) {
    const int i = blockIdx.x * blockDim.x + threadIdx.x;
    if (i < 512) { const float a = hgrn_lb[i], b = hgrn_lb[512 + i]; const float mx = fmaxf(a, b); const float ea = expf(a - mx), eb = expf(b - mx); misc[i] = ea / (ea + eb); }
    if (i < 3 * 129) {
        const int g = i / 129, j = i % 129; const int dl = g == 0 ? 1 : (g == 1 ? 4 : 16); const int n = j * dl;
        int bucket;
        if (n < 16) bucket = n;
        else { const double v = log((double)n / 16.0) / log(128.0) * 16.0; int l = 16 + (int)v; bucket = l < 31 ? l : 31; }
        for (int h = 0; h < 4; ++h) misc[512 + i * 4 + h] = rel_bias[bucket * 12 + g * 4 + h];
    }
}

template <class Epi>
__global__ __launch_bounds__(256) void gemm_simple(const bf16_t* __restrict__ A, int lda, const bf16_t* __restrict__ Bt, int ldb, int K, Epi epi) {
    const int lane = threadIdx.x & 63, w = threadIdx.x >> 6;
    const int row0 = blockIdx.y * 64 + (w >> 1) * 32, col0 = blockIdx.x * 64 + (w & 1) * 32;
    const int fr = lane & 15, fq = lane >> 4;
    f32x4 acc[2][2];
#pragma unroll
    for (int a = 0; a < 2; ++a)
#pragma unroll
        for (int b = 0; b < 2; ++b) acc[a][b] = (f32x4){0.f, 0.f, 0.f, 0.f};
    const bf16_t* ap = A + (size_t)(row0 + fr) * lda + fq * 8;
    const bf16_t* bp = Bt + (size_t)(col0 + fr) * ldb + fq * 8;
    for (int k0 = 0; k0 < K; k0 += 32) {
        const bf16x8 a0 = *(const bf16x8*)(ap + k0), a1 = *(const bf16x8*)(ap + (size_t)16 * lda + k0);
        const bf16x8 b0 = *(const bf16x8*)(bp + k0), b1 = *(const bf16x8*)(bp + (size_t)16 * ldb + k0);
        acc[0][0] = __builtin_amdgcn_mfma_f32_16x16x32_bf16(a0, b0, acc[0][0], 0, 0, 0);
        acc[0][1] = __builtin_amdgcn_mfma_f32_16x16x32_bf16(a0, b1, acc[0][1], 0, 0, 0);
        acc[1][0] = __builtin_amdgcn_mfma_f32_16x16x32_bf16(a1, b0, acc[1][0], 0, 0, 0);
        acc[1][1] = __builtin_amdgcn_mfma_f32_16x16x32_bf16(a1, b1, acc[1][1], 0, 0, 0);
    }
#pragma unroll
    for (int mi = 0; mi < 2; ++mi)
#pragma unroll
        for (int ni = 0; ni < 2; ++ni)
#pragma unroll
            for (int j = 0; j < 4; ++j) epi(row0 + mi * 16 + fq * 4 + j, col0 + ni * 16 + fr, acc[mi][ni][j]);
}

DI int dil_of(int g) { return g == 0 ? 1 : (g == 1 ? 4 : 16); }
DI int perm_tok(int lb, int s, int dl) { return lb * S + (s % dl) * (S / dl) + s / dl; }

struct EpiProj {
    bf16_t *QK, *VT, *HFQG, *IT, *MQ, *GATE; const float* b_gate;
    DI void operator()(int row, int col, float v) const {
        if (col < 3072) QK[(size_t)row * 3072 + col] = f2bf(v);
        else if (col < 4608) { const int c = col - 3072, g = c >> 9; VT[(size_t)c * MP + perm_tok(row / S, row % S, dil_of(g))] = f2bf(v); }
        else if (col < 5120) HFQG[(size_t)row * 1536 + (col - 4608)] = f2bf(v);
        else if (col < 5632) IT[(size_t)(col - 5120) * MP + row] = f2bf(v);
        else if (col < 6656) HFQG[(size_t)row * 1536 + (col - 5632) + 512] = f2bf(v);
        else if (col < 7168) MQ[(size_t)row * 512 + (col - 6656)] = f2bf(v);
        else { const int c = col - 7168; const float z = v + b_gate[c]; GATE[(size_t)row * 3072 + c] = f2bf(1.f / (1.f + expf(-z))); }
    }
};
struct EpiMemKV {
    bf16_t *MK, *MVT;
    DI void operator()(int row, int col, float v) const {
        if (col < 512) MK[(size_t)row * 512 + col] = f2bf(v);
        else MVT[((size_t)(row >> 8) * 512 + (col - 512)) * 256 + (row & 255)] = f2bf(v);
    }
};
struct EpiWiden {
    const bf16_t* GATE; float* TMP; bf16_t* MERGED; int g, pad;
    DI void operator()(int row, int col, float v) const {
        const float gv = bf2f(GATE[(size_t)row * 3072 + g * 1024 + col]) * v; const size_t o = (size_t)row * 1024 + col;
        if (g == 0) TMP[o] = gv; else if (g == 1) TMP[o] += gv; else MERGED[o] = f2bf(TMP[o] + gv);
    }
};
struct EpiF32 { float* C; int ldc, pad; DI void operator()(int row, int col, float v) const { C[(size_t)row * ldc + col] = v; } };
struct EpiB16 { bf16_t* C; int ldc, pad; DI void operator()(int row, int col, float v) const { C[(size_t)row * ldc + col] = f2bf(v); } };

DI float wave_max(float v) {
#pragma unroll
    for (int o = 1; o < 64; o <<= 1) v = fmaxf(v, __shfl_xor(v, o));
    return v;
}
DI float wave_sum(float v) {
#pragma unroll
    for (int o = 1; o < 64; o <<= 1) v += __shfl_xor(v, o);
    return v;
}

__global__ __launch_bounds__(256) void k_dil_attn(const bf16_t* __restrict__ QK, const bf16_t* __restrict__ VT, const float* __restrict__ BIAS, bf16_t* __restrict__ OG, float* __restrict__ LSE) {
    __shared__ float ps[4][192];
    const int lane = threadIdx.x & 63, w = threadIdx.x >> 6;
    const long task = (long)blockIdx.x * 4 + w;
    const int gh = (int)(task % 12); const int row = (int)(task / 12);
    const int g = gh >> 2, h = gh & 3, dl = dil_of(g);
    const int lb = row / S, s = row % S, m = s / dl, r = s % dl;
    const bf16_t* qp = QK + (size_t)row * 3072 + gh * 128;
    float lg[3]; float mx = -INFINITY;
#pragma unroll
    for (int i = 0; i < 3; ++i) {
        const int j = lane + 64 * i; float l = -INFINITY;
        if (j <= 128 && m - j >= 0) {
            const int krow = lb * S + (m - j) * dl + r; const bf16_t* kp = QK + (size_t)krow * 3072 + 1536 + gh * 128;
            float dot = 0.f;
            for (int d = 0; d < 128; ++d) dot += bf2f(qp[d]) * bf2f(kp[d]);
            l = dot * QSCALE + BIAS[(g * 129 + j) * 4 + h];
        }
        lg[i] = l; mx = fmaxf(mx, l);
    }
    mx = wave_max(mx);
    float sum = 0.f;
#pragma unroll
    for (int i = 0; i < 3; ++i) { const float p = (lg[i] == -INFINITY) ? 0.f : expf(lg[i] - mx); ps[w][lane + 64 * i] = p; sum += p; }
    sum = wave_sum(sum);
    __syncthreads();
    const int nk = m < 128 ? m : 128;
    const float inv = 1.f / sum;
#pragma unroll
    for (int i = 0; i < 2; ++i) {
        const int d = lane + 64 * i; const bf16_t* vp = VT + (size_t)(g * 512 + h * 128 + d) * MP + lb * S + r * (S / dl);
        float o = 0.f;
        for (int j = 0; j <= nk; ++j) o += ps[w][j] * bf2f(vp[m - j]);
        OG[(size_t)row * 1536 + g * 512 + h * 128 + d] = f2bf(o * inv);
    }
    if (lane == 0) LSE[(size_t)row * 12 + gh] = mx + logf(sum);
}
__global__ __launch_bounds__(256) void k_merge(const bf16_t* __restrict__ OG, const float* __restrict__ LSE, bf16_t* __restrict__ BR) {
    const long i = (long)blockIdx.x * 256 + threadIdx.x;
    const int row = (int)(i >> 9), c = (int)(i & 511), h = c >> 7;
    const float l0 = LSE[(size_t)row * 12 + h], l1 = LSE[(size_t)row * 12 + 4 + h], l2 = LSE[(size_t)row * 12 + 8 + h];
    const float mx = fmaxf(l0, fmaxf(l1, l2)); const float e0 = expf(l0 - mx), e1 = expf(l1 - mx), e2 = expf(l2 - mx); const float inv = 1.f / (e0 + e1 + e2);
    const bf16_t* og = OG + (size_t)row * 1536 + c;
    BR[(size_t)row * 1536 + c] = f2bf((e0 * bf2f(og[0]) + e1 * bf2f(og[512]) + e2 * bf2f(og[1024])) * inv);
}
__global__ __launch_bounds__(256) void k_mem_attn(const bf16_t* __restrict__ MQ, const bf16_t* __restrict__ MK, const bf16_t* __restrict__ MVT, bf16_t* __restrict__ BR, int batch0) {
    __shared__ float ps[4][256];
    const int lane = threadIdx.x & 63, w = threadIdx.x >> 6;
    const long task = (long)blockIdx.x * 4 + w;
    const int h = (int)(task & 3); const int row = (int)(task >> 2);
    const int b = batch0 + row / S;
    const bf16_t* qp = MQ + (size_t)row * 512 + h * 128;
    float lg[4]; float mx = -INFINITY;
#pragma unroll
    for (int i = 0; i < 4; ++i) {
        const int j = lane + 64 * i; const bf16_t* kp = MK + (size_t)(b * 256 + j) * 512 + h * 128;
        float dot = 0.f;
        for (int d = 0; d < 128; ++d) dot += bf2f(qp[d]) * bf2f(kp[d]);
        lg[i] = dot * QSCALE; mx = fmaxf(mx, lg[i]);
    }
    mx = wave_max(mx);
    float sum = 0.f;
#pragma unroll
    for (int i = 0; i < 4; ++i) { const float p = expf(lg[i] - mx); ps[w][lane + 64 * i] = p; sum += p; }
    sum = wave_sum(sum);
    __syncthreads();
    const float inv = 1.f / sum;
#pragma unroll
    for (int i = 0; i < 2; ++i) {
        const int d = lane + 64 * i; const bf16_t* vp = MVT + ((size_t)b * 512 + h * 128 + d) * 256;
        float o = 0.f;
        for (int j = 0; j < 256; ++j) o += ps[w][j] * bf2f(vp[j]);
        BR[(size_t)row * 1536 + 1024 + h * 128 + d] = f2bf(o * inv);
    }
}
__global__ __launch_bounds__(128) void k_hgrn(const bf16_t* __restrict__ HFQG, const bf16_t* __restrict__ IT, const float* __restrict__ lbv, const float* __restrict__ norm_w, bf16_t* __restrict__ BR) {
    __shared__ float sf[128], sk[128], sq[128], red[2];
    const int tid = threadIdx.x, h = blockIdx.x & 3, lb = blockIdx.x >> 2;
    const float lbd = lbv[h * 128 + tid], nw = norm_w[h * 128 + tid];
    float St[128];
#pragma unroll
    for (int i = 0; i < 128; ++i) St[i] = 0.f;
    for (int s = 0; s < S; ++s) {
        const size_t row = (size_t)lb * S + s;
        const float fr = bf2f(HFQG[row * 1536 + h * 128 + tid]);
        const float f = lbd + (1.f - lbd) / (1.f + expf(-fr));
        sf[tid] = f; sk[tid] = 1.f - f; sq[tid] = bf2f(HFQG[row * 1536 + 512 + h * 128 + tid]);
        __syncthreads();
        const float iv = bf2f(IT[(size_t)(h * 128 + tid) * MP + row]);
        float o = 0.f;
#pragma unroll
        for (int d = 0; d < 128; ++d) { St[d] = sf[d] * St[d] + sk[d] * iv; o += sq[d] * St[d]; }
        const float ss = wave_sum(o * o);
        if ((tid & 63) == 0) red[tid >> 6] = ss;
        __syncthreads();
        const float ms = (red[0] + red[1]) * (1.f / 128.f);
        const float gv = bf2f(HFQG[row * 1536 + 1024 + h * 128 + tid]);
        BR[row * 1536 + 512 + h * 128 + tid] = f2bf(o * rsqrtf(ms + LN_EPS) * nw * (gv / (1.f + expf(-gv))));
    }
}
__global__ __launch_bounds__(256) void k_ln1(const float* __restrict__ x, const float* __restrict__ mix, const float* __restrict__ g, const float* __restrict__ b, float* __restrict__ h1f, bf16_t* __restrict__ h1b) {
    __shared__ float red[8];
    const size_t row = blockIdx.x; const int tid = threadIdx.x;
    float v[4]; float s = 0.f;
#pragma unroll
    for (int i = 0; i < 4; ++i) { const int c = tid + 256 * i; v[i] = ALPHA * x[row * D + c] + mix[row * D + c]; s += v[i]; }
    s = wave_sum(s); if ((tid & 63) == 0) red[tid >> 6] = s; __syncthreads();
    const float mean = (red[0] + red[1] + red[2] + red[3]) * (1.f / D);
    float q = 0.f;
#pragma unroll
    for (int i = 0; i < 4; ++i) { v[i] -= mean; q += v[i] * v[i]; }
    q = wave_sum(q); if ((tid & 63) == 0) red[4 + (tid >> 6)] = q; __syncthreads();
    const float rstd = rsqrtf((red[4] + red[5] + red[6] + red[7]) * (1.f / D) + LN_EPS);
#pragma unroll
    for (int i = 0; i < 4; ++i) { const int c = tid + 256 * i; const float o = v[i] * rstd * g[c] + b[c]; h1f[row * D + c] = o; h1b[row * D + c] = f2bf(o); }
}

DI void ins16(float (&tv)[16], int (&ti)[16], float v, int i) {
#pragma unroll
    for (int j = 0; j < 16; ++j) { const bool gt = v > tv[j]; const float ov = tv[j]; const int oi = ti[j]; tv[j] = gt ? v : ov; ti[j] = gt ? i : oi; v = gt ? ov : v; i = gt ? oi : i; }
}
__global__ __launch_bounds__(256) void k_route(const bf16_t* __restrict__ PQ, const bf16_t* __restrict__ SUBK, int* __restrict__ IDX, float* __restrict__ PG) {
    const long gi = (long)blockIdx.x * 256 + threadIdx.x;
    const int h = (int)(gi & 7); const size_t t = (size_t)(gi >> 3);
    float s1[16], s2[16]; int i1[16], i2[16];
#pragma unroll
    for (int j = 0; j < 16; ++j) { s1[j] = -INFINITY; s2[j] = -INFINITY; i1[j] = 0; i2[j] = 0; }
    const bf16_t* q0 = PQ + t * 2048 + h * 256;
    for (int n = 0; n < 128; ++n) {
        const bf16_t* k0 = SUBK + (size_t)((h * 2 + 0) * 128 + n) * 128; const bf16_t* k1 = SUBK + (size_t)((h * 2 + 1) * 128 + n) * 128;
        float a = 0.f, b = 0.f;
        for (int k = 0; k < 128; ++k) { a += bf2f(q0[k]) * bf2f(k0[k]); b += bf2f(q0[128 + k]) * bf2f(k1[k]); }
        ins16(s1, i1, a, n); ins16(s2, i2, b, n);
    }
    float cv[16]; int ci[16];
#pragma unroll
    for (int j = 0; j < 16; ++j) { cv[j] = -INFINITY; ci[j] = 0; }
#pragma unroll
    for (int a = 0; a < 16; ++a)
#pragma unroll
        for (int b = 0; b < 16; ++b) ins16(cv, ci, s1[a] + s2[b], i1[a] * 128 + i2[b]);
    float sum = 0.f; float e[16];
#pragma unroll
    for (int j = 0; j < 16; ++j) { e[j] = expf(cv[j] - cv[0]); sum += e[j]; }
    const float inv = 1.f / sum;
#pragma unroll
    for (int j = 0; j < 16; ++j) { IDX[t * 128 + h * 16 + j] = ci[j]; PG[t * 128 + h * 16 + j] = e[j] * inv; }
}
__global__ __launch_bounds__(256) void k_experts(const float* h1f_in, const bf16_t* __restrict__ h1b, const bf16_t* __restrict__ UB, const bf16_t* __restrict__ VB, const int* __restrict__ IDX, const float* __restrict__ PG,
                                                 const float* __restrict__ g2, const float* __restrict__ b2, float* out) {
    __shared__ float hrow[1024]; __shared__ float cw[128]; __shared__ int eid[128]; __shared__ float red[8];
    const size_t t = blockIdx.x; const int tid = threadIdx.x, lane = tid & 63, w = tid >> 6;
    float hv[4];
#pragma unroll
    for (int i = 0; i < 4; ++i) { const int c = tid + 256 * i; hv[i] = h1f_in[t * D + c]; hrow[c] = bf2f(h1b[t * D + c]); }
    if (tid < 128) eid[tid] = IDX[t * 128 + tid];
    __syncthreads();
    for (int e = w; e < 128; e += 4) {
        const bf16_t* up = UB + (size_t)eid[e] * D; float dot = 0.f;
#pragma unroll
        for (int i = 0; i < 16; ++i) dot += hrow[lane + 64 * i] * bf2f(up[lane + 64 * i]);
        dot = wave_sum(dot);
        if (lane == 0) cw[e] = PG[t * 128 + e] * 0.5f * dot * (1.f + erff(dot * 0.7071067811865476f));
    }
    __syncthreads();
    float f[4] = {0.f, 0.f, 0.f, 0.f};
    for (int e = 0; e < 128; ++e) { const bf16_t* vp = VB + (size_t)eid[e] * D; const float c = cw[e];
#pragma unroll
        for (int i = 0; i < 4; ++i) f[i] += c * bf2f(vp[tid + 256 * i]); }
    float v[4]; float s = 0.f;
#pragma unroll
    for (int i = 0; i < 4; ++i) { v[i] = ALPHA * hv[i] + f[i]; s += v[i]; }
    s = wave_sum(s); if (lane == 0) red[w] = s; __syncthreads();
    const float mean = (red[0] + red[1] + red[2] + red[3]) * (1.f / D);
    float q = 0.f;
#pragma unroll
    for (int i = 0; i < 4; ++i) { v[i] -= mean; q += v[i] * v[i]; }
    q = wave_sum(q); if (lane == 0) red[4 + w] = q; __syncthreads();
    const float rstd = rsqrtf((red[4] + red[5] + red[6] + red[7]) * (1.f / D) + LN_EPS);
#pragma unroll
    for (int i = 0; i < 4; ++i) { const int c = tid + 256 * i; out[t * D + c] = v[i] * rstd * g2[c] + b2[c]; }
}

#define LAS __attribute__((address_space(3)))
#define GAS __attribute__((address_space(1)))
typedef unsigned u32x4 __attribute__((ext_vector_type(4)));
typedef unsigned u32x2 __attribute__((ext_vector_type(2)));
typedef float f32x2 __attribute__((ext_vector_type(2)));
typedef __bf16 bf16x2_t __attribute__((ext_vector_type(2)));
DI unsigned cvtpk(float lo, float hi) { f32x2 v = {lo, hi}; bf16x2_t b = __builtin_convertvector(v, bf16x2_t); return __builtin_bit_cast(unsigned, b); }
constexpr float LOG2E = 1.4426950408889634f;
DI float fast_sigmoid(float z) { return __builtin_amdgcn_rcpf(1.f + __builtin_amdgcn_exp2f(-z * LOG2E)); }

namespace g8 {
constexpr int BM = 256, BK = 64, HALF = 128, HTB = HALF * BK * 2, STAGE_BYTES = 8 * HTB;
DI int lds_byte(int r, int c) { const int st = (r >> 4) * 2 + (c >> 5), rr = r & 15, cc = c & 31, ob = rr * 64 + cc * 2; return st * 1024 + (ob ^ (((ob >> 9) & 1) << 5)); }
DI void stage_rc(int b, int& R, int& C) { const int st = b / 1024, sb = b % 1024, swz = sb ^ (((sb >> 9) & 1) << 5); R = (st >> 1) * 16 + swz / 64; C = (st & 1) * 32 + (swz % 64) / 2; }
DI int perm32(int rho) { const int n = rho >> 4, i = rho & 15; return 8 * (i >> 2) + 4 * n + (i & 3); }

struct Unit { unsigned a, b; int dlb; int pm, pn, kind; };

template <class Epi, class Sched>
DI void gemm_phase(LAS unsigned char* lds, const char* const wsb, const int K, const Sched& S, const Epi& E, const int tid) {
    const int wid = __builtin_amdgcn_readfirstlane(tid >> 6), lane = tid & 63, wr = wid >> 2, wc = wid & 3, fr = lane & 15, fq = lane >> 4;
    const int nt = K / BK;
    unsigned voffA[2], rbk[2], ccb[2];
#pragma unroll
    for (int i = 0; i < 2; ++i) { int R, C; stage_rc(tid * 16 + i * 8192, R, C); const int Rb = Epi::PERM ? ((R & ~31) + perm32(R & 31)) : R;
        voffA[i] = (unsigned)(R * K + C) * 2u; rbk[i] = (unsigned)(Rb * K) * 2u; ccb[i] = (unsigned)C * 2u; }
    const unsigned kstep = (unsigned)(BK * 2);
    const unsigned hstepA = (unsigned)(HALF * K * 2);
    const unsigned ldsw = (unsigned)wid * 1024u;
    const int aoff = lds_byte(wr * 64 + fr, fq * 8), boff = lds_byte(wc * 32 + fr, fq * 8);
#define G8_SA(b, h) (((b) * 2 + (h)) * HTB)
#define G8_SB(b, h) ((4 + (b) * 2 + (h)) * HTB)
#define G8_STAGE(bufoff, gbase, v0, v1) do { \
        __builtin_amdgcn_global_load_lds((const unsigned*)(wsb + (unsigned)((gbase) + (v0))), (LAS unsigned*)(lds + (bufoff) + ldsw), 16, 0, 0); \
        __builtin_amdgcn_global_load_lds((const unsigned*)(wsb + (unsigned)((gbase) + (v1))), (LAS unsigned*)(lds + (bufoff) + ldsw + 8192), 16, 0, 0); } while (0)
#define G8_LDA(dst, b, h) do { _Pragma("unroll") for (int m = 0; m < 4; ++m) _Pragma("unroll") for (int k = 0; k < 2; ++k) dst[m][k] = *(const LAS bf16x8*)(lds + G8_SA(b, h) + aoff + m * 2048 + k * 1024); } while (0)
#define G8_LDB(dst, b, h) do { _Pragma("unroll") for (int n = 0; n < 2; ++n) _Pragma("unroll") for (int k = 0; k < 2; ++k) dst[n][k] = *(const LAS bf16x8*)(lds + G8_SB(b, h) + boff + n * 2048 + k * 1024); } while (0)
#define G8_MMA(ai, bj, At, Bt) do { __builtin_amdgcn_s_setprio(1); _Pragma("unroll") for (int m = 0; m < 4; ++m) _Pragma("unroll") for (int n = 0; n < 2; ++n) _Pragma("unroll") for (int k = 0; k < 2; ++k) \
        acc[ai][bj][m][n] = __builtin_amdgcn_mfma_f32_16x16x32_bf16(Bt[n][k], At[m][k], acc[ai][bj][m][n], 0, 0, 0); __builtin_amdgcn_s_setprio(0); } while (0)
#define G8_WAIT_V(n) asm volatile("s_waitcnt vmcnt(" #n ")" ::: "memory")
#define G8_WAIT_L(n) asm volatile("s_waitcnt lgkmcnt(" #n ")" ::: "memory")
#define G8_BAR __builtin_amdgcn_s_barrier()
#define G8_SCHED __builtin_amdgcn_sched_barrier(0)
    Unit cur, nxt; int ui = 0;
    if (!S.next(0, cur)) return;
    f32x4 acc[2][2][4][2];
#pragma unroll
    for (int a = 0; a < 2; ++a)
#pragma unroll
        for (int b = 0; b < 2; ++b)
#pragma unroll
            for (int m = 0; m < 4; ++m)
#pragma unroll
                for (int n = 0; n < 2; ++n) acc[a][b][m][n] = (f32x4){0.f, 0.f, 0.f, 0.f};
    bf16x8 At[4][2], B0[2][2], B1[2][2];
    unsigned cA = cur.a, cB = cur.b;
    unsigned vBc0 = rbk[0] * (unsigned)cur.dlb + ccb[0], vBc1 = rbk[1] * (unsigned)cur.dlb + ccb[1]; unsigned hBc = hstepA * (unsigned)cur.dlb;
    G8_STAGE(G8_SB(0, 0), cB, vBc0, vBc1); G8_STAGE(G8_SB(0, 1), cB + hBc, vBc0, vBc1); G8_STAGE(G8_SA(0, 0), cA, voffA[0], voffA[1]); G8_STAGE(G8_SA(0, 1), cA + hstepA, voffA[0], voffA[1]);
    if (wr == 1) G8_BAR;
    G8_WAIT_V(2); G8_BAR;
    G8_STAGE(G8_SB(1, 0), cB + kstep, vBc0, vBc1); G8_STAGE(G8_SA(1, 0), cA + kstep, voffA[0], voffA[1]); G8_STAGE(G8_SB(1, 1), cB + hBc + kstep, vBc0, vBc1);
    G8_WAIT_V(6); G8_BAR;
    for (;;) {
        const bool has_next = S.next(ui + 1, nxt);
        const unsigned nA = has_next ? nxt.a : cA, nB = has_next ? nxt.b : cB; const int dln = has_next ? nxt.dlb : cur.dlb;
        const unsigned vBn0 = rbk[0] * (unsigned)dln + ccb[0], vBn1 = rbk[1] * (unsigned)dln + ccb[1]; const unsigned hBn = hstepA * (unsigned)dln;
        for (int t = 0; t < nt; t += 2) {
            if constexpr (Epi::HOOK) E.hook(acc, cur, t, wr, wc, fr, fq);
            const bool last = (t == nt - 2);
            const unsigned a1 = cA + (unsigned)(t + 1) * kstep;
            const unsigned a2 = last ? nA : cA + (unsigned)(t + 2) * kstep, b2 = last ? nB : cB + (unsigned)(t + 2) * kstep;
            const unsigned a3 = a2 + kstep, b3 = b2 + kstep;
            const unsigned vB0 = last ? vBn0 : vBc0, vB1 = last ? vBn1 : vBc1; const unsigned hB = last ? hBn : hBc;
            G8_LDB(B0, 0, 0); G8_LDB(B1, 0, 1); G8_SCHED; G8_LDA(At, 0, 0); G8_STAGE(G8_SA(1, 1), a1 + hstepA, voffA[0], voffA[1]);
            G8_WAIT_V(8); G8_WAIT_L(0); G8_BAR; G8_MMA(0, 0, At, B0); G8_MMA(0, 1, At, B1); G8_BAR; G8_SCHED;
            G8_LDA(At, 0, 1); G8_STAGE(G8_SB(0, 0), b2, vB0, vB1); G8_STAGE(G8_SB(0, 1), b2 + hB, vB0, vB1); G8_STAGE(G8_SA(0, 0), a2, voffA[0], voffA[1]);
            G8_WAIT_V(8); G8_WAIT_L(0); G8_BAR; G8_MMA(1, 0, At, B0); G8_MMA(1, 1, At, B1); G8_BAR; G8_SCHED;
            G8_LDB(B0, 1, 0); G8_LDB(B1, 1, 1); G8_SCHED; G8_LDA(At, 1, 0); G8_STAGE(G8_SA(0, 1), a2 + hstepA, voffA[0], voffA[1]);
            G8_WAIT_V(8); G8_WAIT_L(0); G8_BAR; G8_MMA(0, 0, At, B0); G8_MMA(0, 1, At, B1); G8_BAR; G8_SCHED;
            G8_LDA(At, 1, 1); G8_STAGE(G8_SB(1, 0), b3, vB0, vB1); G8_STAGE(G8_SB(1, 1), b3 + hB, vB0, vB1); G8_STAGE(G8_SA(1, 0), a3, voffA[0], voffA[1]);
            G8_WAIT_V(8); G8_WAIT_L(0); G8_BAR; G8_MMA(1, 0, At, B0); G8_MMA(1, 1, At, B1); G8_BAR; G8_SCHED;
        }
        if (wr == 0) G8_BAR;
        E(acc, cur, wr, wc, fr, fq);
        if (!has_next) break;
#pragma unroll
        for (int a = 0; a < 2; ++a)
#pragma unroll
            for (int b = 0; b < 2; ++b)
#pragma unroll
                for (int m = 0; m < 4; ++m)
#pragma unroll
                    for (int n = 0; n < 2; ++n) acc[a][b][m][n] = (f32x4){0.f, 0.f, 0.f, 0.f};
        cur = nxt; cA = nA; cB = nB; vBc0 = vBn0; vBc1 = vBn1; hBc = hBn; ++ui;
        if (wr == 1) G8_BAR;
    }
    G8_WAIT_V(0);
    G8_BAR;
#undef G8_SA
#undef G8_SB
#undef G8_STAGE
#undef G8_LDA
#undef G8_LDB
#undef G8_MMA
#undef G8_WAIT_V
#undef G8_WAIT_L
#undef G8_BAR
#undef G8_SCHED
}
}

typedef GAS unsigned gu32;
#define XB_TMO      128
#define XB_XCNT(j)  (256  + 64 * (j))
#define XB_XSUB(j)  (1280 + 64 * (j))
#define XB_XGEN(j)  (2304 + 64 * (j))
#define XB_TOP      3328
#define XB_TOPGEN   3392
#define XCD_BAR_WORDS 3456
#define XB_SPIN_CAP (1u << 22)
DI unsigned xb_ld(unsigned* p)              { return __hip_atomic_load(p, __ATOMIC_RELAXED, __HIP_MEMORY_SCOPE_AGENT); }
DI unsigned xb_add(unsigned* p, unsigned v) { return __hip_atomic_fetch_add(p, v, __ATOMIC_RELAXED, __HIP_MEMORY_SCOPE_AGENT); }
DI unsigned xb_xcc_id() { return (unsigned)__builtin_amdgcn_s_getreg((3 << 11) | 20) & 0xFu; }
#define XB_SPIN(cond, bar) do { unsigned _sp = 0; while (cond) { __builtin_amdgcn_s_sleep(1); \
    if ((++_sp & 255u) == 0u) { if (xb_ld(&(bar)[XB_TMO])) break; if (_sp > XB_SPIN_CAP) { atomicAdd(&(bar)[XB_TMO], 1u); break; } } } } while (0)
struct XcdBarrier { unsigned* bar; unsigned x; volatile LAS unsigned* st; };
DI XcdBarrier xcd_barrier_post(unsigned* bar, volatile LAS unsigned* st) {
    XcdBarrier b; b.bar = bar; b.x = xb_xcc_id(); b.st = st;
    if (threadIdx.x == 0) st[2] = xb_add(&bar[XB_XCNT(b.x)], 1u);
    return b;
}
DI void xcd_barrier_complete(unsigned* bar, unsigned x, unsigned& nloc, unsigned& nx) {
    const unsigned G = gridDim.x * gridDim.y * gridDim.z;
    unsigned sum, cnt, mine, sp = 0u;
    for (;;) {
        sum = 0u; cnt = 0u; mine = 0u;
#pragma unroll
        for (unsigned j = 0; j < 16; ++j) { const unsigned c = xb_ld(&bar[XB_XCNT(j)]); sum += c; cnt += (c > 0u) ? 1u : 0u; mine = (j == x) ? c : mine; }
        if (sum == G) break;
        __builtin_amdgcn_s_sleep(1);
        if ((++sp & 255u) == 0u) { if (xb_ld(&bar[XB_TMO])) break; if (sp > XB_SPIN_CAP) { atomicAdd(&bar[XB_TMO], 1u); break; } }
    }
    nloc = mine > 0u ? mine : 1u; nx = cnt > 0u ? cnt : 1u;
}
DI void xcd_barrier(const XcdBarrier& b) {
    asm volatile("s_waitcnt vmcnt(0)" ::: "memory");
    __syncthreads();
    if (threadIdx.x == 0) {
        unsigned* bar = b.bar;
        __builtin_amdgcn_s_waitcnt(0);
        unsigned nloc = b.st[0], nx = b.st[1];
        if (nloc == 0u) { xcd_barrier_complete(bar, b.x, nloc, nx); b.st[0] = nloc; b.st[1] = nx; }
        const unsigned old = xb_add(&bar[XB_XSUB(b.x)], 1u);
        const unsigned gen = old / nloc;
        if (old + 1u == (gen + 1u) * nloc) {
            __builtin_amdgcn_fence(__ATOMIC_RELEASE, "agent");
            asm volatile("s_waitcnt vmcnt(0)" ::: "memory");
            const unsigned og = xb_add(&bar[XB_TOP], 1u);
            const unsigned tg = og / nx;
            if (og + 1u == (tg + 1u) * nx) xb_add(&bar[XB_TOPGEN], 1u);
            else XB_SPIN(xb_ld(&bar[XB_TOPGEN]) == tg, bar);
            __builtin_amdgcn_fence(__ATOMIC_ACQUIRE, "agent");
            xb_add(&bar[XB_XGEN(b.x)], 1u);
            asm volatile("s_waitcnt vmcnt(0)" ::: "memory");
        } else {
            XB_SPIN(xb_ld(&bar[XB_XGEN(b.x)]) == gen, bar);
            __builtin_amdgcn_fence(__ATOMIC_ACQUIRE, "agent");
            asm volatile("s_waitcnt vmcnt(0)" ::: "memory");
        }
    }
    __syncthreads();
}

constexpr int NWAVES = 8, NTHR = NWAVES * 64;
constexpr int RING_BYTES = 131072, LDS_BYTES = 147456, LDSCTL_OFF = LDS_BYTES - 1024, MISC_OFF = LDSCTL_OFF + 320;
constexpr size_t CTL_BYTES = 65536;
enum { PH_ALL = 0, PH_PRO = 11, PH_PROJ = 1, PH_ATTN = 2, PH_HGPRE = 3, PH_HGMAIN = 4, PH_WIDEN = 5, PH_WOUT = 6, PH_LN1 = 7, PH_PQ = 8, PH_ROUTE = 9, PH_EXPERTS = 10, PH_HGSCAN = 12 };
struct Args { const float* in[18]; float* out; unsigned char* ws; int ph, pass; };

struct Bufs {
    const bf16_t *WIN, *XBp; bf16_t *QK, *VIT, *HFQG, *MQ, *GATE;
};

struct SchedP1 {
    unsigned XBp, W; int G, c;
    DI bool next(int i, g8::Unit& u) const {
        const int L = i * G + c; if (L >= 2560) return false;
        if (L < 2048) { const int x = L & 7, off = L >> 3; u.pm = 8 * x + (off & 7); u.pn = off >> 3; u.kind = 0; u.dlb = 1;
            u.a = XBp + (unsigned)u.pm * 256u * D * 2u; u.b = W + (unsigned)u.pn * 256u * D * 2u; }
        else { const int idx = L - 2048; u.pm = idx & 7; u.pn = idx >> 3; u.kind = 1;
            const int dl = u.pm < 2 ? 1 : (u.pm < 4 ? 4 : (u.pm < 6 ? 16 : 1));
            const int v0 = u.pn * 256, lb = v0 / S, vv = v0 % S, per = S / dl, r = vv / per, m0 = vv % per;
            u.dlb = dl; u.a = W + (unsigned)(8192 + u.pm * 256) * D * 2u; u.b = XBp + (unsigned)(lb * S + m0 * dl + r) * D * 2u; }
        return true;
    }
};
struct EpiP1 {
    static constexpr bool PERM = true, HOOK = false;
    char* pr; const float* b_gate;
    DI void hook(f32x4 (&)[2][2][4][2], const g8::Unit&, int, int, int, int, int) const {}
    DI void operator()(const f32x4 (&acc)[2][2][4][2], const g8::Unit& u, int wr, int wc, int fr, int fq) const {
        bf16_t* base; int ldc, colt; bool gate = false;
        if (u.kind == 1) { base = (bf16_t*)(pr + P_VT); ldc = MP; colt = u.pn * 256; }
        else if (u.pn < 12) { base = (bf16_t*)(pr + P_QK); ldc = 3072; colt = u.pn * 256; }
        else if (u.pn < 18) { base = (bf16_t*)(pr + P_HFQG); ldc = 1536; colt = (u.pn - 12) * 256; }
        else if (u.pn < 20) { base = (bf16_t*)(pr + P_MQ); ldc = 512; colt = (u.pn - 18) * 256; }
        else { base = (bf16_t*)(pr + P_GATE); ldc = 3072; colt = (u.pn - 20) * 256; gate = true; }
        const int row0 = u.pm * 256 + wr * 64 + fr, col0 = colt + wc * 32 + 8 * fq;
        f32x4 bv[2][2];
#pragma unroll
        for (int bj = 0; bj < 2; ++bj)
#pragma unroll
            for (int n = 0; n < 2; ++n) bv[bj][n] = gate ? *(const f32x4*)(b_gate + col0 + bj * 128 + 4 * n) : (f32x4){0.f, 0.f, 0.f, 0.f};
#pragma unroll
        for (int ai = 0; ai < 2; ++ai)
#pragma unroll
            for (int m = 0; m < 4; ++m) { bf16_t* rowp = base + (size_t)(row0 + ai * 128 + m * 16) * ldc + col0;
#pragma unroll
                for (int bj = 0; bj < 2; ++bj) { f32x4 v0 = acc[ai][bj][m][0], v1 = acc[ai][bj][m][1];
                    if (gate) { v0 = v0 + bv[bj][0]; v1 = v1 + bv[bj][1];
#pragma unroll
                        for (int e = 0; e < 4; ++e) { v0[e] = fast_sigmoid(v0[e]); v1[e] = fast_sigmoid(v1[e]); } }
                    u32x4 w; w.x = cvtpk(v0[0], v0[1]); w.y = cvtpk(v0[2], v0[3]); w.z = cvtpk(v1[0], v1[1]); w.w = cvtpk(v1[2], v1[3]);
                    *(u32x4*)(rowp + bj * 128) = w; } }
    }
};

typedef float f32x16 __attribute__((ext_vector_type(16)));
typedef short s16x4 __attribute__((ext_vector_type(4)));
DI int crow(int r, int hi) { return (r & 3) + 8 * (r >> 2) + 4 * hi; }
DI float xor32f(float v) { return __shfl_xor(v, 32); }
#define MFMA32(a, b, c) __builtin_amdgcn_mfma_f32_32x32x16_bf16((a), (b), (c), 0, 0, 0)
DI bf16x8 pack8(const f32x16& p, int s) {
    u32x4 w; w.x = cvtpk(p[8 * s + 0], p[8 * s + 1]); w.y = cvtpk(p[8 * s + 2], p[8 * s + 3]); w.z = cvtpk(p[8 * s + 4], p[8 * s + 5]); w.w = cvtpk(p[8 * s + 6], p[8 * s + 7]);
    return __builtin_bit_cast(bf16x8, w);
}
DI bf16x8 ldvt(const bf16_t* vp) {
    const s16x4 lo = *(const s16x4*)vp, hi4 = *(const s16x4*)(vp + 8);
    return __builtin_shufflevector(lo, hi4, 0, 1, 2, 3, 4, 5, 6, 7);
}
constexpr int DIL_TASKS = BPP * 12 * (S / 32);
constexpr int MEM_TASKS = (MP / 32) * 4;
DI void attn_dil_wave(const bf16_t* __restrict__ QK, const bf16_t* __restrict__ VT, const LAS float* btab, bf16_t* __restrict__ OG, float* __restrict__ LSE, int task, int lane) {
    const int r32 = lane & 31, hi = lane >> 5;
    const int q32 = task & 255, gh = (task >> 8) % 12, lb = task / (256 * 12);
    const int g = gh >> 2, h = gh & 3, dl = dil_of(g), per = S / dl;
    const int tok0 = q32 * 32, r = tok0 / per, m0 = tok0 % per;
    const size_t rowq = (size_t)lb * S + (size_t)(m0 + r32) * dl + r;
    bf16x8 qf[8];
    { const bf16_t* qp = QK + rowq * 3072 + gh * 128 + 8 * hi;
#pragma unroll
      for (int ks = 0; ks < 8; ++ks) qf[ks] = *(const bf16x8*)(qp + 16 * ks); }
    const LAS float* bt = btab + g * 129 * 4 + h;
    f32x16 o[4];
#pragma unroll
    for (int dt = 0; dt < 4; ++dt)
#pragma unroll
        for (int i = 0; i < 16; ++i) o[dt][i] = 0.f;
    float mrun = -INFINITY, sum = 0.f;
    const bf16_t* vbase = VT + (size_t)(g * 512 + h * 128 + r32) * MP + (size_t)lb * S + (size_t)r * per + 4 * hi;
    const bf16_t* kbase = QK + ((size_t)lb * S + r) * 3072 + 1536 + gh * 128 + 8 * hi;
#pragma unroll 1
    for (int kt = (m0 >= 128 ? 0 : (128 - m0) >> 5); kt < 5; ++kt) {
        const int mt0 = m0 - 128 + 32 * kt;
        const bf16_t* kp = kbase + (size_t)(mt0 + r32) * dl * 3072;
        f32x16 sc;
#pragma unroll
        for (int i = 0; i < 16; ++i) sc[i] = 0.f;
#pragma unroll
        for (int ks = 0; ks < 8; ++ks) { const bf16x8 kf = *(const bf16x8*)(kp + 16 * ks); sc = MFMA32(kf, qf[ks], sc); }
        float mx = -INFINITY;
#pragma unroll
        for (int i = 0; i < 16; ++i) {
            const int delta = 128 - 32 * kt + r32 - crow(i, hi);
            const bool valid = (delta >= 0) && (delta <= 128);
            const int di = delta < 0 ? 0 : (delta > 128 ? 128 : delta);
            const float x = sc[i] * (QSCALE * LOG2E) + bt[di * 4];
            sc[i] = valid ? x : -INFINITY; mx = fmaxf(mx, sc[i]);
        }
        mx = fmaxf(mx, xor32f(mx));
        const float mnew = fmaxf(mrun, mx); const float f = __builtin_amdgcn_exp2f(mrun - mnew);
        sum *= f;
#pragma unroll
        for (int dt = 0; dt < 4; ++dt)
#pragma unroll
            for (int i = 0; i < 16; ++i) o[dt][i] *= f;
        mrun = mnew;
        float ps = 0.f;
#pragma unroll
        for (int i = 0; i < 16; ++i) { sc[i] = __builtin_amdgcn_exp2f(sc[i] - mnew); ps += sc[i]; }
        ps += xor32f(ps); sum += ps;
#pragma unroll
        for (int s = 0; s < 2; ++s) {
            const bf16x8 pb = pack8(sc, s);
#pragma unroll
            for (int dt = 0; dt < 4; ++dt) { const bf16x8 va = ldvt(vbase + (size_t)(32 * dt) * MP + mt0 + 16 * s); o[dt] = MFMA32(va, pb, o[dt]); }
        }
    }
    const float inv = 1.f / sum;
    bf16_t* op = OG + rowq * 1536 + g * 512 + h * 128 + 4 * hi;
#pragma unroll
    for (int dt = 0; dt < 4; ++dt)
#pragma unroll
        for (int a = 0; a < 4; ++a) { u32x2 w; w.x = cvtpk(o[dt][4 * a] * inv, o[dt][4 * a + 1] * inv); w.y = cvtpk(o[dt][4 * a + 2] * inv, o[dt][4 * a + 3] * inv); *(u32x2*)(op + 32 * dt + 8 * a) = w; }
    if (hi == 0) LSE[rowq * 12 + gh] = (mrun + __builtin_amdgcn_logf(sum)) * 0.6931471805599453f;
}
DI void attn_mem_wave(const bf16_t* __restrict__ MQ, const bf16_t* __restrict__ MK, const bf16_t* __restrict__ MVT, bf16_t* __restrict__ BR, int task, int batch0, int lane) {
    const int r32 = lane & 31, hi = lane >> 5;
    const int h = task & 3, blk = task >> 2;
    const size_t rowq = (size_t)blk * 32 + r32; const int b = batch0 + blk * 32 / S;
    bf16x8 qf[8];
    { const bf16_t* qp = MQ + rowq * 512 + h * 128 + 8 * hi;
#pragma unroll
      for (int ks = 0; ks < 8; ++ks) qf[ks] = *(const bf16x8*)(qp + 16 * ks); }
    f32x16 o[4];
#pragma unroll
    for (int dt = 0; dt < 4; ++dt)
#pragma unroll
        for (int i = 0; i < 16; ++i) o[dt][i] = 0.f;
    float mrun = -INFINITY, sum = 0.f;
    const bf16_t* vbase = MVT + (size_t)(h * 128 + r32) * 2048 + (size_t)b * 256 + 4 * hi;
    const bf16_t* kbase = MK + ((size_t)b * 256 + r32) * 512 + h * 128 + 8 * hi;
#pragma unroll 1
    for (int c = 0; c < 4; ++c) {
        f32x16 sc[2]; float mx = -INFINITY;
#pragma unroll
        for (int kt = 0; kt < 2; ++kt) {
            const bf16_t* kp = kbase + (size_t)(c * 64 + kt * 32) * 512;
            f32x16 acc;
#pragma unroll
            for (int i = 0; i < 16; ++i) acc[i] = 0.f;
#pragma unroll
            for (int ks = 0; ks < 8; ++ks) { const bf16x8 kf = *(const bf16x8*)(kp + 16 * ks); acc = MFMA32(kf, qf[ks], acc); }
#pragma unroll
            for (int i = 0; i < 16; ++i) { sc[kt][i] = acc[i] * (QSCALE * LOG2E); mx = fmaxf(mx, sc[kt][i]); }
            asm volatile("" ::: "memory");
        }
        mx = fmaxf(mx, xor32f(mx));
        const float mnew = fmaxf(mrun, mx); const float f = __builtin_amdgcn_exp2f(mrun - mnew);
        sum *= f;
#pragma unroll
        for (int dt = 0; dt < 4; ++dt)
#pragma unroll
            for (int i = 0; i < 16; ++i) o[dt][i] *= f;
        mrun = mnew;
        float ps = 0.f;
#pragma unroll
        for (int kt = 0; kt < 2; ++kt)
#pragma unroll
            for (int i = 0; i < 16; ++i) { sc[kt][i] = __builtin_amdgcn_exp2f(sc[kt][i] - mnew); ps += sc[kt][i]; }
        ps += xor32f(ps); sum += ps;
#pragma unroll
        for (int kt = 0; kt < 2; ++kt)
#pragma unroll
            for (int s = 0; s < 2; ++s) {
                const bf16x8 pb = pack8(sc[kt], s);
#pragma unroll
                for (int dt = 0; dt < 4; ++dt) { const bf16x8 va = ldvt(vbase + (size_t)(32 * dt) * 2048 + c * 64 + kt * 32 + 16 * s); o[dt] = MFMA32(va, pb, o[dt]); }
                asm volatile("" ::: "memory");
            }
    }
    const float inv = 1.f / sum;
    bf16_t* op = BR + rowq * 1536 + 1024 + h * 128 + 4 * hi;
#pragma unroll
    for (int dt = 0; dt < 4; ++dt)
#pragma unroll
        for (int a = 0; a < 4; ++a) { u32x2 w; w.x = cvtpk(o[dt][4 * a] * inv, o[dt][4 * a + 1] * inv); w.y = cvtpk(o[dt][4 * a + 2] * inv, o[dt][4 * a + 3] * inv); *(u32x2*)(op + 32 * dt + 8 * a) = w; }
}

constexpr int HG_SCH = 4, HG_UPS = S / 64 / HG_SCH  , HG_UNITS = BPP * 4 * HG_UPS  ;
constexpr int HG_ROW = 136, HG_KT_ROW = 72;
constexpr int HG_KP = 0, HG_QP = 64 * HG_ROW * 2, HG_QPP = 2 * HG_QP, HG_KPPT = 3 * HG_QP, HG_DEC = HG_KPPT + 128 * HG_KT_ROW * 2, HG_SSQ = HG_DEC + 512, HG_PSUM = HG_SSQ + 1024, HG_UNIT_BYTES = HG_PSUM + 2048;
DI bf16x8 lds_ld2x8(const LAS unsigned char* p) {
    const s16x4 lo = *(const LAS s16x4*)p, hi4 = *(const LAS s16x4*)(p + 16);
    return __builtin_shufflevector(lo, hi4, 0, 1, 2, 3, 4, 5, 6, 7);
}
DI int opq(int x) { asm volatile("" : "+v"(x)); return x; }
DI float lds_bf(const LAS unsigned char* p) { return __uint_as_float((unsigned)(*(const LAS unsigned short*)p) << 16); }
template <bool MAIN>
DI void hgrn_unit(LAS unsigned char* ul, int unit, int u, const bf16_t* __restrict__ HFQG, const bf16_t* __restrict__ IT, const float* __restrict__ lbv, const float* __restrict__ nwv,
                  float* HSTL, float* HSTD, const float* __restrict__ SIN, bf16_t* __restrict__ BR) {
    constexpr int NX = MAIN ? 4 : 2;
    const int lane = u & 63, w = u >> 6, r32 = lane & 31, hi = lane >> 5, dvt = w & 3, wh = w >> 2;
    const int seq = unit / HG_UPS, j = unit % HG_UPS, lb = seq >> 2, h = seq & 3;
    const int dk = u & 127, qt = u >> 7, cb = 16 * qt;
    const float lbd = lbv[h * 128 + dk];
    const size_t row0 = (size_t)lb * S + (size_t)j * (64 * HG_SCH);
    LAS unsigned char* Kp = ul + HG_KP; LAS unsigned char* Qp = ul + HG_QP; LAS unsigned char* Qpp = ul + HG_QPP; LAS unsigned char* KppT = ul + HG_KPPT;
    LAS float* dec = (LAS float*)(ul + HG_DEC); LAS float* ssq = (LAS float*)(ul + HG_SSQ); LAS float* psum = (LAS float*)(ul + HG_PSUM);
    const int dk0 = MAIN ? 0 : 64 * wh;
    f32x16 X[NX];
    if (MAIN) {
        const float* Sp = SIN + (size_t)unit * 16384 + 32 * dvt + r32;
#pragma unroll
        for (int t = 0; t < NX; ++t)
#pragma unroll
            for (int i = 0; i < 16; ++i) X[t][i] = Sp[(size_t)(32 * t + crow(i, hi)) * 128];
    } else {
#pragma unroll
        for (int t = 0; t < NX; ++t)
#pragma unroll
            for (int i = 0; i < 16; ++i) X[t][i] = 0.f;
    }
    float atot = 0.f;
#pragma unroll 1
    for (int ch = 0; ch < HG_SCH; ++ch) {
        const size_t rc = row0 + (size_t)ch * 64;
        {
            const int sc0 = opq(u) >> 4, sch = (opq(u) & 15) * 8;
            const bf16_t* fp = HFQG + (rc + sc0) * 1536 + h * 128 + sch;
            u32x4 sf[2], sq[2];
#pragma unroll
            for (int i = 0; i < 2; ++i) { sf[i] = *(const u32x4*)(fp + (size_t)(32 * i) * 1536); if (MAIN) sq[i] = *(const u32x4*)(fp + (size_t)(32 * i) * 1536 + 512); }
#pragma unroll
            for (int i = 0; i < 2; ++i) { *(LAS u32x4*)(Kp + ((sc0 + 32 * i) * HG_ROW + sch) * 2) = sf[i]; if (MAIN) *(LAS u32x4*)(Qp + ((sc0 + 32 * i) * HG_ROW + sch) * 2) = sq[i]; }
        }
        __syncthreads();
        {
            float s = 0.f;
#pragma unroll
            for (int i = 0; i < 16; ++i) s += __builtin_amdgcn_logf(lbd + (1.f - lbd) * fast_sigmoid(lds_bf(Kp + ((cb + i) * HG_ROW + dk) * 2)));
            psum[qt * 128 + dk] = s;
        }
        __syncthreads();
        {
            const float p0 = psum[dk], p1 = psum[128 + dk], p2 = psum[256 + dk], p3 = psum[384 + dk];
            const float amid = p0 + p1, alast = (p0 + p1) + (p2 + p3);
            float run = qt == 0 ? 0.f : (qt == 1 ? p0 : (qt == 2 ? amid : amid + p2));
            atot += alast;
#pragma unroll 1
            for (int c8 = 0; c8 < 2; ++c8) {
                float kt[8];
#pragma unroll
                for (int e = 0; e < 8; ++e) { const int c = cb + 8 * c8 + e; const float f = lbd + (1.f - lbd) * fast_sigmoid(lds_bf(Kp + (c * HG_ROW + dk) * 2)); run += __builtin_amdgcn_logf(f); const float key = 1.f - f;
                    kt[e] = key * __builtin_amdgcn_exp2f(alast - run);
                    if (MAIN) { *(LAS bf16_t*)(Kp + (c * HG_ROW + dk) * 2) = f2bf(key * __builtin_amdgcn_exp2f(amid - run));
                        const float q = lds_bf(Qp + (c * HG_ROW + dk) * 2);
                        *(LAS bf16_t*)(Qp + (c * HG_ROW + dk) * 2) = f2bf(q * __builtin_amdgcn_exp2f(run - amid));
                        *(LAS bf16_t*)(Qpp + (c * HG_ROW + dk) * 2) = f2bf(q * __builtin_amdgcn_exp2f(run)); } }
                u32x4 wv; wv.x = cvtpk(kt[0], kt[1]); wv.y = cvtpk(kt[2], kt[3]); wv.z = cvtpk(kt[4], kt[5]); wv.w = cvtpk(kt[6], kt[7]);
                *(LAS u32x4*)(KppT + (dk * HG_KT_ROW + cb + 8 * c8) * 2) = wv;
            }
            if (qt == 0) dec[dk] = __builtin_amdgcn_exp2f(alast);
        }
        __syncthreads();
        f32x16 o;
        const bf16_t* itrow = IT + (size_t)(h * 128 + 32 * dvt + opq(r32)) * MP;
        if (MAIN) {
#pragma unroll
            for (int i = 0; i < 16; ++i) o[i] = 0.f;
            const LAS unsigned char* qrow = Qpp + ((32 * wh + r32) * HG_ROW) * 2;
#pragma unroll
            for (int t = 0; t < 4; ++t)
#pragma unroll
                for (int step = 0; step < 2; ++step) { o = MFMA32(pack8(X[t], step), lds_ld2x8(qrow + (32 * t + 16 * step + 4 * hi) * 2), o); }
            __builtin_amdgcn_sched_barrier(0);
            const int r32m = opq(r32);
            const LAS unsigned char* qprow = Qp + ((32 * wh + r32) * HG_ROW) * 2;
            {
                f32x16 sc;
#pragma unroll
                for (int i = 0; i < 16; ++i) sc[i] = 0.f;
#pragma unroll
                for (int ks = 0; ks < 8; ++ks) { const int cof = (16 * ks + 8 * hi) * 2; sc = MFMA32(*(const LAS bf16x8*)(Kp + (r32 * HG_ROW) * 2 + cof), *(const LAS bf16x8*)(qprow + cof), sc); }
                if (wh == 0) {
#pragma unroll
                    for (int i = 0; i < 16; ++i) sc[i] = (crow(i, hi) <= r32m) ? sc[i] : 0.f;
                }
#pragma unroll
                for (int step = 0; step < 2; ++step) o = MFMA32(ldvt(itrow + rc + 16 * step + 4 * hi), pack8(sc, step), o);
                __builtin_amdgcn_sched_barrier(0);
            }
            if (wh == 1) {
                f32x16 sc;
#pragma unroll
                for (int i = 0; i < 16; ++i) sc[i] = 0.f;
#pragma unroll
                for (int ks = 0; ks < 8; ++ks) { const int cof = (16 * ks + 8 * hi) * 2; sc = MFMA32(*(const LAS bf16x8*)(Kp + ((32 + r32) * HG_ROW) * 2 + cof), *(const LAS bf16x8*)(qprow + cof), sc); }
#pragma unroll
                for (int i = 0; i < 16; ++i) sc[i] = (crow(i, hi) <= r32m) ? sc[i] : 0.f;
#pragma unroll
                for (int step = 0; step < 2; ++step) o = MFMA32(ldvt(itrow + rc + 32 + 16 * step + 4 * hi), pack8(sc, step), o);
                __builtin_amdgcn_sched_barrier(0);
            }
        }
        {
            bf16x8 ib[4];
#pragma unroll
            for (int ks = 0; ks < 4; ++ks) ib[ks] = *(const bf16x8*)(itrow + rc + 16 * ks + 8 * hi);
#pragma unroll
            for (int t = 0; t < NX; ++t) {
#pragma unroll
                for (int i = 0; i < 16; ++i) X[t][i] *= dec[dk0 + 32 * t + crow(i, hi)];
#pragma unroll
                for (int ks = 0; ks < 4; ++ks) { const bf16x8 ka = *(const LAS bf16x8*)(KppT + ((dk0 + 32 * t + r32) * HG_KT_ROW + 16 * ks + 8 * hi) * 2); X[t] = MFMA32(ka, ib[ks], X[t]); }
                __builtin_amdgcn_sched_barrier(0);
            }
        }
        if (MAIN) {
            float q2 = 0.f;
#pragma unroll
            for (int i = 0; i < 16; ++i) q2 += o[i] * o[i];
            q2 += xor32f(q2); if (hi == 0) ssq[dvt * 64 + 32 * wh + r32] = q2;
        }
        __syncthreads();
        if (MAIN) {
            const int r32o = opq(r32), hio = opq(hi);
            const int c = 32 * wh + r32o; const float tot = ssq[c] + ssq[64 + c] + ssq[128 + c] + ssq[192 + c];
            const float rs = rsqrtf(tot * (1.f / 128.f) + LN_EPS);
            const size_t row = rc + c; const int col = h * 128 + 32 * dvt + 4 * hio;
#pragma unroll
            for (int a4 = 0; a4 < 4; ++a4) {
                const u32x2 gw = *(const u32x2*)(HFQG + row * 1536 + 1024 + col + 8 * a4); const f32x4 nw4 = *(const f32x4*)(nwv + col + 8 * a4);
                const float g0 = __uint_as_float(gw.x << 16), g1 = __uint_as_float(gw.x & 0xffff0000u), g2 = __uint_as_float(gw.y << 16), g3 = __uint_as_float(gw.y & 0xffff0000u);
                const float v0 = o[4 * a4] * rs * nw4[0] * g0 * fast_sigmoid(g0), v1 = o[4 * a4 + 1] * rs * nw4[1] * g1 * fast_sigmoid(g1);
                const float v2 = o[4 * a4 + 2] * rs * nw4[2] * g2 * fast_sigmoid(g2), v3 = o[4 * a4 + 3] * rs * nw4[3] * g3 * fast_sigmoid(g3);
                u32x2 wv; wv.x = cvtpk(v0, v1); wv.y = cvtpk(v2, v3);
                *(u32x2*)(BR + row * 1536 + 512 + col + 8 * a4) = wv;
            }
        }
    }
    if (!MAIN) {
        float* L = HSTL + (size_t)unit * 16384 + 32 * dvt + r32;
#pragma unroll
        for (int t = 0; t < NX; ++t)
#pragma unroll
            for (int i = 0; i < 16; ++i) L[(size_t)(dk0 + 32 * t + crow(i, hi)) * 128] = X[t][i];
        if (qt == 0) HSTD[(size_t)unit * 128 + dk] = __builtin_amdgcn_exp2f(atot);
    }
}
DI void hgrn_scan(const float* __restrict__ HSTL, const float* __restrict__ HSTD, float* __restrict__ SIN, int gt) {
    if (gt >= BPP * 4 * 16384) return;
    const int seq = gt >> 14, el = gt & 16383, dkk = el >> 7;
    float st = 0.f;
    for (int j = 0; j < HG_UPS; ++j) { const size_t uo = (size_t)(seq * HG_UPS + j); SIN[uo * 16384 + el] = st; st = HSTD[uo * 128 + dkk] * st + HSTL[uo * 16384 + el]; }
}

struct SchedRows {
    unsigned A, B; int K, nN, nU, G, c;
    DI bool next(int i, g8::Unit& u) const {
        const int L = i * G + c; if (L >= nU) return false;
        const int x = L & 7, off = L >> 3, grp = off / (8 * nN), o2 = off % (8 * nN);
        const int ppx = nU / nN / 8;
        u.pm = x * ppx + 8 * grp + (o2 & 7); u.pn = o2 >> 3; u.kind = 0; u.dlb = 1;
        u.a = A + (unsigned)u.pm * 256u * K * 2u; u.b = B + (unsigned)u.pn * 256u * K * 2u; return true;
    }
};
DI void unpack8(const u32x4 w, float (&f)[8]) {
    f[0] = __uint_as_float(w.x << 16); f[1] = __uint_as_float(w.x & 0xffff0000u); f[2] = __uint_as_float(w.y << 16); f[3] = __uint_as_float(w.y & 0xffff0000u);
    f[4] = __uint_as_float(w.z << 16); f[5] = __uint_as_float(w.z & 0xffff0000u); f[6] = __uint_as_float(w.w << 16); f[7] = __uint_as_float(w.w & 0xffff0000u);
}
struct EpiWidenF {
    static constexpr bool PERM = true, HOOK = true;
    const bf16_t* GATE; bf16_t* MERGED;
    DI void hook(f32x4 (&acc)[2][2][4][2], const g8::Unit& u, int t, int wr, int wc, int fr, int fq) const {
        if (t != 8 && t != 16) return;
        const int g = (t >> 3) - 1;
        const int row0 = u.pm * 256 + wr * 64 + fr, col0 = u.pn * 256 + wc * 32 + 8 * fq;
#pragma unroll
        for (int ai = 0; ai < 2; ++ai)
#pragma unroll
            for (int m = 0; m < 4; ++m) { const bf16_t* gp = GATE + (size_t)(row0 + ai * 128 + m * 16) * 3072 + g * 1024 + col0;
#pragma unroll
                for (int bj = 0; bj < 2; ++bj) { float ga[8], gb[8]; unpack8(*(const u32x4*)(gp + bj * 128), ga); unpack8(*(const u32x4*)(gp + 1024 + bj * 128), gb);
#pragma unroll
                    for (int e = 0; e < 4; ++e) { acc[ai][bj][m][0][e] *= ga[e] * __builtin_amdgcn_rcpf(gb[e]); acc[ai][bj][m][1][e] *= ga[4 + e] * __builtin_amdgcn_rcpf(gb[4 + e]); } } }
    }
    DI void operator()(const f32x4 (&acc)[2][2][4][2], const g8::Unit& u, int wr, int wc, int fr, int fq) const {
        const int row0 = u.pm * 256 + wr * 64 + fr, col0 = u.pn * 256 + wc * 32 + 8 * fq;
#pragma unroll
        for (int ai = 0; ai < 2; ++ai)
#pragma unroll
            for (int m = 0; m < 4; ++m) { const size_t row = (size_t)(row0 + ai * 128 + m * 16);
#pragma unroll
                for (int bj = 0; bj < 2; ++bj) { float gc[8]; unpack8(*(const u32x4*)(GATE + row * 3072 + 2048 + col0 + bj * 128), gc);
                    const f32x4 v0 = acc[ai][bj][m][0], v1 = acc[ai][bj][m][1];
                    u32x4 w; w.x = cvtpk(v0[0] * gc[0], v0[1] * gc[1]); w.y = cvtpk(v0[2] * gc[2], v0[3] * gc[3]); w.z = cvtpk(v1[0] * gc[4], v1[1] * gc[5]); w.w = cvtpk(v1[2] * gc[6], v1[3] * gc[7]);
                    *(u32x4*)(MERGED + row * 1024 + col0 + bj * 128) = w; } }
    }
};
struct EpiMixF32 {
    static constexpr bool PERM = false, HOOK = false;
    float* C;
    DI void hook(f32x4 (&)[2][2][4][2], const g8::Unit&, int, int, int, int, int) const {}
    DI void operator()(const f32x4 (&acc)[2][2][4][2], const g8::Unit& u, int wr, int wc, int fr, int fq) const {
        const int col0 = u.pn * 256 + wc * 32 + 4 * fq;
#pragma unroll
        for (int ai = 0; ai < 2; ++ai)
#pragma unroll
            for (int m = 0; m < 4; ++m) { float* rp = C + (size_t)(u.pm * 256 + ai * 128 + wr * 64 + m * 16 + fr) * 1024 + col0;
#pragma unroll
                for (int bj = 0; bj < 2; ++bj)
#pragma unroll
                    for (int n = 0; n < 2; ++n) *(f32x4*)(rp + bj * 128 + n * 16) = acc[ai][bj][m][n]; }
    }
};
struct EpiPlainB16 {
    static constexpr bool PERM = true, HOOK = false;
    bf16_t* C; int ldc, pad;
    DI void hook(f32x4 (&)[2][2][4][2], const g8::Unit&, int, int, int, int, int) const {}
    DI void operator()(const f32x4 (&acc)[2][2][4][2], const g8::Unit& u, int wr, int wc, int fr, int fq) const {
        const int row0 = u.pm * 256 + wr * 64 + fr, col0 = u.pn * 256 + wc * 32 + 8 * fq;
#pragma unroll
        for (int ai = 0; ai < 2; ++ai)
#pragma unroll
            for (int m = 0; m < 4; ++m) { bf16_t* rowp = C + (size_t)(row0 + ai * 128 + m * 16) * ldc + col0;
#pragma unroll
                for (int bj = 0; bj < 2; ++bj) { const f32x4 v0 = acc[ai][bj][m][0], v1 = acc[ai][bj][m][1];
                    u32x4 w; w.x = cvtpk(v0[0], v0[1]); w.y = cvtpk(v0[2], v0[3]); w.z = cvtpk(v1[0], v1[1]); w.w = cvtpk(v1[2], v1[3]);
                    *(u32x4*)(rowp + bj * 128) = w; } }
    }
};
DI void lse_merge_items(const bf16_t* __restrict__ OG, const float* __restrict__ LSE, bf16_t* __restrict__ BR, int first, int stride) {
    for (int it = first; it < MP * 64; it += stride) {
        const int row = it >> 6, c8 = it & 63, h = c8 >> 4;
        const float l0 = LSE[(size_t)row * 12 + h], l1 = LSE[(size_t)row * 12 + 4 + h], l2 = LSE[(size_t)row * 12 + 8 + h];
        const float mx = fmaxf(l0, fmaxf(l1, l2)); const float e0 = __expf(l0 - mx), e1 = __expf(l1 - mx), e2 = __expf(l2 - mx); const float inv = 1.f / (e0 + e1 + e2);
        const bf16_t* og = OG + (size_t)row * 1536 + c8 * 8;
        float a[8], b[8], c[8]; unpack8(*(const u32x4*)og, a); unpack8(*(const u32x4*)(og + 512), b); unpack8(*(const u32x4*)(og + 1024), c);
        float r[8];
#pragma unroll
        for (int e = 0; e < 8; ++e) r[e] = (e0 * a[e] + e1 * b[e] + e2 * c[e]) * inv;
        u32x4 w; w.x = cvtpk(r[0], r[1]); w.y = cvtpk(r[2], r[3]); w.z = cvtpk(r[4], r[5]); w.w = cvtpk(r[6], r[7]);
        *(u32x4*)(BR + (size_t)row * 1536 + c8 * 8) = w;
    }
}
DI void ln1_rows(const float* __restrict__ x, const float* __restrict__ mix, const float* __restrict__ g, const float* __restrict__ b, float* __restrict__ h1f, bf16_t* __restrict__ h1b, int wave0, int nwaves, int lane) {
    for (int row = wave0; row < MP; row += nwaves) {
        const f32x4* xr = (const f32x4*)(x + (size_t)row * D) + lane; const f32x4* mr = (const f32x4*)(mix + (size_t)row * D) + lane;
        f32x4 v[4]; float s = 0.f;
#pragma unroll
        for (int j = 0; j < 4; ++j) { v[j] = xr[64 * j] * ALPHA + mr[64 * j]; s += (v[j][0] + v[j][1]) + (v[j][2] + v[j][3]); }
        const float mean = wave_sum(s) * (1.f / D); float q = 0.f;
#pragma unroll
        for (int j = 0; j < 4; ++j) { v[j] = v[j] - mean; q += (v[j][0] * v[j][0] + v[j][1] * v[j][1]) + (v[j][2] * v[j][2] + v[j][3] * v[j][3]); }
        const float rstd = rsqrtf(wave_sum(q) * (1.f / D) + LN_EPS);
#pragma unroll
        for (int j = 0; j < 4; ++j) { const f32x4 gg = ((const f32x4*)g)[lane + 64 * j], bb = ((const f32x4*)b)[lane + 64 * j]; const f32x4 o = v[j] * rstd * gg + bb;
            ((f32x4*)(h1f + (size_t)row * D))[lane + 64 * j] = o; u32x2 w; w.x = cvtpk(o[0], o[1]); w.y = cvtpk(o[2], o[3]); ((u32x2*)(h1b + (size_t)row * D))[lane + 64 * j] = w; }
    }
}

DI unsigned mono(float f) { const unsigned u = __float_as_uint(f); return (u & 0x80000000u) ? ~u : (u | 0x80000000u); }
DI float demono(unsigned m) { return __uint_as_float((m & 0x80000000u) ? (m & 0x7fffffffu) : ~m); }
#define CE_DESC(a, b) do { const unsigned _hi = (a) > (b) ? (a) : (b), _lo = (a) > (b) ? (b) : (a); (a) = _hi; (b) = _lo; } while (0)
DI void sort16_desc(unsigned (&k)[16]) {
#pragma unroll
    for (int size = 2; size <= 16; size <<= 1)
#pragma unroll
        for (int stride = size >> 1; stride > 0; stride >>= 1)
#pragma unroll
            for (int i = 0; i < 16; ++i) { const int j = i ^ stride;
                if (j > i) { if ((i & size) == 0 || size == 16) CE_DESC(k[i], k[j]); else CE_DESC(k[j], k[i]); } }
}
DI void merge_top16(unsigned (&t)[16], const unsigned (&l)[16]) {
#pragma unroll
    for (int i = 0; i < 16; ++i) t[i] = t[i] > l[15 - i] ? t[i] : l[15 - i];
#pragma unroll
    for (int stride = 8; stride > 0; stride >>= 1)
#pragma unroll
        for (int i = 0; i < 16; ++i) { const int j = i ^ stride; if (j > i) CE_DESC(t[i], t[j]); }
}
constexpr int RT_ROW = 136;
constexpr int RT_LDS_BYTES = 2 * 128 * RT_ROW * 2;
DI void route_wave(const bf16_t* __restrict__ PQ, const LAS unsigned char* keys, int* __restrict__ IDX, float* __restrict__ PG, int tb, int h, int lane) {
    const int r32 = lane & 31, hi = lane >> 5;
    const size_t tok = (size_t)tb * 32 + r32;
    unsigned Tp[2][16];
#pragma unroll
    for (int p = 0; p < 2; ++p) {
        bf16x8 qf[8];
        const bf16_t* qp = PQ + tok * 2048 + h * 256 + p * 128 + 8 * hi;
#pragma unroll
        for (int ks = 0; ks < 8; ++ks) qf[ks] = *(const bf16x8*)(qp + 16 * ks);
#pragma unroll
        for (int nt = 0; nt < 4; ++nt) {
            f32x16 acc;
#pragma unroll
            for (int i = 0; i < 16; ++i) acc[i] = 0.f;
#pragma unroll
            for (int ks = 0; ks < 8; ++ks) { const bf16x8 kf = *(const LAS bf16x8*)(keys + ((p * 128 + 32 * nt + r32) * RT_ROW + 16 * ks + 8 * hi) * 2); acc = MFMA32(kf, qf[ks], acc); }
            unsigned L[16];
#pragma unroll
            for (int i = 0; i < 16; ++i) L[i] = (mono(acc[i]) & ~0x7fu) | (unsigned)(127 - (32 * nt + crow(i, hi)));
            sort16_desc(L);
            if (nt == 0) {
#pragma unroll
                for (int i = 0; i < 16; ++i) Tp[p][i] = L[i];
            } else merge_top16(Tp[p], L);
            __builtin_amdgcn_sched_barrier(0);
        }
    }
    unsigned T[16];
    { unsigned O[16];
#pragma unroll
      for (int i = 0; i < 16; ++i) { const auto rr = __builtin_amdgcn_permlane32_swap(Tp[0][i], Tp[1][i], false, false); T[i] = rr[0]; O[i] = rr[1]; }
      merge_top16(T, O); }
    __builtin_amdgcn_sched_barrier(0);
    float s1[16], s2[16]; unsigned i1[16], i2[16];
#pragma unroll
    for (int i = 0; i < 16; ++i) { const auto rr = __builtin_amdgcn_permlane32_swap(T[i], T[i], false, false);
        s1[i] = demono(rr[0] & ~0x7fu); i1[i] = 127u - (rr[0] & 0x7fu); s2[i] = demono(rr[1] & ~0x7fu); i2[i] = 127u - (rr[1] & 0x7fu); }
    unsigned C[64];
    { int n = 0;
#pragma unroll
      for (int a = 0; a < 16; ++a)
#pragma unroll
          for (int b = 0; b < 16; ++b) if ((a + 1) * (b + 1) <= 16) { C[n] = (mono(s1[a] + s2[b]) & ~0x3fffu) | (i1[a] << 7) | i2[b]; ++n; }
#pragma unroll
      for (int i = 50; i < 64; ++i) C[i] = 0u; }
    unsigned F[16];
#pragma unroll
    for (int i = 0; i < 16; ++i) F[i] = C[i];
    sort16_desc(F);
#pragma unroll
    for (int g = 1; g < 4; ++g) { unsigned L[16];
#pragma unroll
        for (int i = 0; i < 16; ++i) L[i] = C[16 * g + i];
        sort16_desc(L); merge_top16(F, L); __builtin_amdgcn_sched_barrier(0); }
    if (hi == 0) {
        float e[16]; float sum = 0.f; const float v0 = demono(F[0] & ~0x3fffu);
#pragma unroll
        for (int i = 0; i < 16; ++i) { e[i] = __expf(demono(F[i] & ~0x3fffu) - v0); sum += e[i]; }
        const float inv = 1.f / sum;
        int* ip = IDX + tok * 128 + h * 16; float* gp = PG + tok * 128 + h * 16;
#pragma unroll
        for (int q = 0; q < 4; ++q) { u32x4 iv; iv.x = F[4 * q] & 0x3fffu; iv.y = F[4 * q + 1] & 0x3fffu; iv.z = F[4 * q + 2] & 0x3fffu; iv.w = F[4 * q + 3] & 0x3fffu; *(u32x4*)(ip + 4 * q) = iv;
            f32x4 gv; gv[0] = e[4 * q] * inv; gv[1] = e[4 * q + 1] * inv; gv[2] = e[4 * q + 2] * inv; gv[3] = e[4 * q + 3] * inv; *(f32x4*)(gp + 4 * q) = gv; }
    }
}
typedef __bf16 bf16x2v __attribute__((ext_vector_type(2)));
DI float dot2bf(unsigned w, unsigned x, float acc) { return __builtin_amdgcn_fdot2_f32_bf16(__builtin_bit_cast(bf16x2v, w), __builtin_bit_cast(bf16x2v, x), acc, false); }
DI float gelu_erf(float v) {
    const float av = fabsf(v), t = __builtin_amdgcn_rcpf(av * 0.2316418882f + 1.0f);
    float q = t * 0.5307027145f + (-0.7265760135f); q = q * t + 0.7107068705f; q = q * t + (-0.142248368f); q = q * t + 0.127414796f; q = q * t;
    const float e = __builtin_amdgcn_exp2f((v * v) * (-0.72134752044f)); const float m = v * (q * e);
    return v < 0.f ? m : v - m;
}
DI float dppf(float v, const int ctrl_sel) {
    const int s = __float_as_int(v);
    int r;
    if (ctrl_sel == 0) r = __builtin_amdgcn_update_dpp(0, s, 0xB1, 0xF, 0xF, true);
    else if (ctrl_sel == 1) r = __builtin_amdgcn_update_dpp(0, s, 0x4E, 0xF, 0xF, true);
    else if (ctrl_sel == 2) r = __builtin_amdgcn_update_dpp(0, s, 0x141, 0xF, 0xF, true);
    else r = __builtin_amdgcn_update_dpp(0, s, 0x128, 0xF, 0xF, true);
    return __int_as_float(r);
}
DI void experts_u_slice(const bf16_t* __restrict__ H1B, const unsigned char* __restrict__ U8x, const int* __restrict__ IDX, bf16_t* __restrict__ PD, size_t tok, int x, int lane) {
    const int g = lane >> 3, l8 = lane & 7;
    f32x2 hv[8];
    { const u32x4 a = *(const u32x4*)(H1B + tok * D + 128 * x + 16 * l8), b = *(const u32x4*)(H1B + tok * D + 128 * x + 16 * l8 + 8);
#pragma unroll
      for (int q = 0; q < 4; ++q) { hv[q] = (f32x2){__uint_as_float(a[q] << 16), __uint_as_float(a[q] & 0xffff0000u)}; hv[4 + q] = (f32x2){__uint_as_float(b[q] << 16), __uint_as_float(b[q] & 0xffff0000u)}; } }
    u32x4 iv[4];
#pragma unroll
    for (int q = 0; q < 4; ++q) iv[q] = *(const u32x4*)(IDX + tok * 128 + 16 * g + 4 * q);
    u32x4 w[16];
#pragma unroll
    for (int j = 0; j < 16; ++j) w[j] = *(const u32x4*)(U8x + (size_t)(iv[j >> 2][j & 3] * 128u + 16u * l8));
    float p[16];
#pragma unroll
    for (int j = 0; j < 16; ++j) { f32x2 d2 = {0.f, 0.f};
#pragma unroll
        for (int q = 0; q < 4; ++q) { d2 += __builtin_amdgcn_cvt_pk_f32_fp8((int)w[j][q], false) * hv[2 * q]; d2 += __builtin_amdgcn_cvt_pk_f32_fp8((int)w[j][q], true) * hv[2 * q + 1]; }
        float s = d2[0] + d2[1]; s += dppf(s, 0); s += dppf(s, 1); s += dppf(s, 2); p[j] = s; }
    if (l8 == 0) {
        u32x4 o0, o1;
        o0.x = cvtpk(p[0], p[1]); o0.y = cvtpk(p[2], p[3]); o0.z = cvtpk(p[4], p[5]); o0.w = cvtpk(p[6], p[7]);
        o1.x = cvtpk(p[8], p[9]); o1.y = cvtpk(p[10], p[11]); o1.z = cvtpk(p[12], p[13]); o1.w = cvtpk(p[14], p[15]);
        bf16_t* dp = PD + (tok * 8 + x) * 128 + 16 * g; *(u32x4*)dp = o0; *(u32x4*)(dp + 8) = o1;
    }
}
DI void experts_combine(const bf16_t* __restrict__ PD, const int* __restrict__ IDX, const float* __restrict__ PG, const float* __restrict__ USC, const float* __restrict__ VSC, float* __restrict__ C, size_t first, size_t stride) {
    for (size_t i = first; i < (size_t)M * 128; i += stride) {
        const size_t tok = i >> 7; const int e = (int)(i & 127);
        float s = 0.f;
#pragma unroll
        for (int x = 0; x < 8; ++x) s += bf2f(PD[(tok * 8 + x) * 128 + e]);
        const int row = IDX[i];
        C[i] = PG[i] * gelu_erf(s * USC[row]) * VSC[row];
    }
}
DI void experts_v_slice(const unsigned char* __restrict__ V8x, const int* __restrict__ IDX, const float* __restrict__ C, bf16_t* __restrict__ FFN, size_t tok, int x, int lane) {
    const int g = lane >> 3, l8 = lane & 7;
    u32x4 iv[4]; f32x4 cv[4];
#pragma unroll
    for (int q = 0; q < 4; ++q) { iv[q] = *(const u32x4*)(IDX + tok * 128 + 16 * g + 4 * q); cv[q] = *(const f32x4*)(C + tok * 128 + 16 * g + 4 * q); }
    u32x4 w[16];
#pragma unroll
    for (int j = 0; j < 16; ++j) w[j] = *(const u32x4*)(V8x + (size_t)(iv[j >> 2][j & 3] * 128u + 16u * l8));
    f32x2 f2[8];
#pragma unroll
    for (int i = 0; i < 8; ++i) f2[i] = (f32x2){0.f, 0.f};
#pragma unroll
    for (int j = 0; j < 16; ++j) { const float c = cv[j >> 2][j & 3]; const f32x2 c2 = {c, c};
#pragma unroll
        for (int q = 0; q < 4; ++q) { f2[2 * q] += c2 * __builtin_amdgcn_cvt_pk_f32_fp8((int)w[j][q], false); f2[2 * q + 1] += c2 * __builtin_amdgcn_cvt_pk_f32_fp8((int)w[j][q], true); } }
#pragma unroll
    for (int i = 0; i < 8; ++i)
#pragma unroll
        for (int k = 0; k < 2; ++k) { float s = f2[i][k]; s += dppf(s, 3); s += __shfl_xor(s, 16); s += __shfl_xor(s, 32); f2[i][k] = s; }
    if (g == 0) {
        u32x4 o0, o1;
        o0.x = cvtpk(f2[0][0], f2[0][1]); o0.y = cvtpk(f2[1][0], f2[1][1]); o0.z = cvtpk(f2[2][0], f2[2][1]); o0.w = cvtpk(f2[3][0], f2[3][1]);
        o1.x = cvtpk(f2[4][0], f2[4][1]); o1.y = cvtpk(f2[5][0], f2[5][1]); o1.z = cvtpk(f2[6][0], f2[6][1]); o1.w = cvtpk(f2[7][0], f2[7][1]);
        bf16_t* dp = FFN + tok * D + 128 * x + 16 * l8; *(u32x4*)dp = o0; *(u32x4*)(dp + 8) = o1;
    }
}
DI void ln2_token(const bf16_t* __restrict__ FFN, const float* __restrict__ g2, const float* __restrict__ b2, float* outp, size_t tok, int lane) {
    float* hr = outp + tok * D + 16 * lane;
    const u32x4 fa = *(const u32x4*)(FFN + tok * D + 16 * lane), fb = *(const u32x4*)(FFN + tok * D + 16 * lane + 8);
    f32x4 v[4];
#pragma unroll
    for (int j = 0; j < 4; ++j) v[j] = *(const f32x4*)(hr + 4 * j);
    float ff[16]; unpack8(fa, *(float(*)[8])&ff[0]); unpack8(fb, *(float(*)[8])&ff[8]);
    float s = 0.f;
#pragma unroll
    for (int j = 0; j < 4; ++j)
#pragma unroll
        for (int e = 0; e < 4; ++e) { v[j][e] = v[j][e] * ALPHA + ff[4 * j + e]; s += v[j][e]; }
    const float mean = wave_sum(s) * (1.f / D); float q2 = 0.f;
#pragma unroll
    for (int j = 0; j < 4; ++j)
#pragma unroll
        for (int e = 0; e < 4; ++e) { v[j][e] -= mean; q2 += v[j][e] * v[j][e]; }
    const float rstd = rsqrtf(wave_sum(q2) * (1.f / D) + LN_EPS);
#pragma unroll
    for (int j = 0; j < 4; ++j) { const f32x4 gg = *(const f32x4*)(g2 + 16 * lane + 4 * j), bb = *(const f32x4*)(b2 + 16 * lane + 4 * j); *(f32x4*)(hr + 4 * j) = v[j] * rstd * gg + bb; }
}

DI void p0_convert(const float* __restrict__ in, bf16_t* __restrict__ out, size_t n8, size_t first, size_t stride) {
    for (size_t i = first; i < n8; i += stride) { const f32x4 a = ((const f32x4*)in)[2 * i], b = ((const f32x4*)in)[2 * i + 1];
        u32x4 w; w.x = cvtpk(a[0], a[1]); w.y = cvtpk(a[2], a[3]); w.z = cvtpk(b[0], b[1]); w.w = cvtpk(b[2], b[3]); ((u32x4*)out)[i] = w; }
}
DI void p0_transpose_item(const float* __restrict__ W, int ldw, int ncols, bf16_t* __restrict__ out, int ldo, int koff, LAS float* scr, int item, int lane) {
    const int nblk = ncols / 32, kb = item / nblk, nb = item % nblk, k0 = 64 * kb, n0 = 32 * nb;
#pragma unroll 8
    for (int i = 0; i < 32; ++i) { const int kk = 2 * i + (lane >> 5); scr[kk * 33 + (lane & 31)] = W[(size_t)(k0 + kk) * ldw + n0 + (lane & 31)]; }
    asm volatile("s_waitcnt lgkmcnt(0)" ::: "memory");
    const int c = lane & 7;
#pragma unroll
    for (int j = 0; j < 4; ++j) { const int n = (lane >> 3) + 8 * j; const LAS float* s = scr + (8 * c) * 33 + n;
        u32x4 o; o.x = cvtpk(s[0 * 33], s[1 * 33]); o.y = cvtpk(s[2 * 33], s[3 * 33]); o.z = cvtpk(s[4 * 33], s[5 * 33]); o.w = cvtpk(s[6 * 33], s[7 * 33]);
        *(u32x4*)(out + (size_t)(n0 + n) * ldo + koff + k0 + 8 * c) = o; }
    asm volatile("s_waitcnt lgkmcnt(0)" ::: "memory");
}
DI void p0_fp8_row(const float* __restrict__ src, unsigned char* __restrict__ dst, float* __restrict__ scale, int row, int lane) {
    const f32x4* sp = (const f32x4*)(src + (size_t)row * D) + 4 * lane;
    f32x4 v[4]; float mx = 0.f;
#pragma unroll
    for (int j = 0; j < 4; ++j) { v[j] = sp[j]; mx = fmaxf(mx, fmaxf(fmaxf(fabsf(v[j][0]), fabsf(v[j][1])), fmaxf(fabsf(v[j][2]), fabsf(v[j][3])))); }
    mx = wave_max(mx);
    const float sc = mx > 0.f ? 224.f / mx : 1.f;
    u32x4 w;
#pragma unroll
    for (int j = 0; j < 4; ++j) { int p = 0; p = __builtin_amdgcn_cvt_pk_fp8_f32(v[j][0] * sc, v[j][1] * sc, p, false); p = __builtin_amdgcn_cvt_pk_fp8_f32(v[j][2] * sc, v[j][3] * sc, p, true); w[j] = (unsigned)p; }
    *(u32x4*)(dst + (size_t)(lane >> 3) * ((size_t)NEXP * 128) + (size_t)row * 128 + 16 * (lane & 7)) = w;
    if (lane == 0) scale[row] = mx > 0.f ? mx * (1.f / 224.f) : 1.f;
}
DI void p0_misc(const float* __restrict__ hgrn_lb, const float* __restrict__ rel_bias, float* __restrict__ misc, int i) {
    if (i < 512) { const float a = hgrn_lb[i], b = hgrn_lb[512 + i]; const float mx = fmaxf(a, b); const float ea = expf(a - mx), eb = expf(b - mx); misc[i] = ea / (ea + eb); }
    if (i < 3 * 129) {
        const int g = i / 129, j = i % 129; const int dl = g == 0 ? 1 : (g == 1 ? 4 : 16); const int n = j * dl;
        int bucket;
        if (n < 16) bucket = n;
        else { const double v = log((double)n / 16.0) / log(128.0) * 16.0; int l = 16 + (int)v; bucket = l < 31 ? l : 31; }
        for (int h = 0; h < 4; ++h) misc[512 + i * 4 + h] = rel_bias[bucket * 12 + g * 4 + h];
    }
}
struct SchedMemKV {
    unsigned MEMB, W; int G, c;
    DI bool next(int i, g8::Unit& u) const {
        const int L = i * G + c; if (L >= 32) return false;
        u.dlb = 1;
        if (L < 16) { u.kind = 0; u.pm = L >> 1; u.pn = L & 1; u.a = MEMB + (unsigned)u.pm * 256u * D * 2u; u.b = W + (unsigned)u.pn * 256u * D * 2u; }
        else { const int q = L - 16; u.kind = 1; u.pm = q >> 3; u.pn = q & 7; u.a = W + (unsigned)(512 + u.pm * 256) * D * 2u; u.b = MEMB + (unsigned)u.pn * 256u * D * 2u; }
        return true;
    }
};
struct EpiMemKVF {
    static constexpr bool PERM = true, HOOK = false;
    bf16_t *MK, *MVT;
    DI void hook(f32x4 (&)[2][2][4][2], const g8::Unit&, int, int, int, int, int) const {}
    DI void operator()(const f32x4 (&acc)[2][2][4][2], const g8::Unit& u, int wr, int wc, int fr, int fq) const {
        bf16_t* base = u.kind ? MVT : MK; const int ldc = u.kind ? 2048 : 512;
        const int row0 = u.pm * 256 + wr * 64 + fr, col0 = u.pn * 256 + wc * 32 + 8 * fq;
#pragma unroll
        for (int ai = 0; ai < 2; ++ai)
#pragma unroll
            for (int m = 0; m < 4; ++m) { bf16_t* rowp = base + (size_t)(row0 + ai * 128 + m * 16) * ldc + col0;
#pragma unroll
                for (int bj = 0; bj < 2; ++bj) { const f32x4 v0 = acc[ai][bj][m][0], v1 = acc[ai][bj][m][1];
                    u32x4 w; w.x = cvtpk(v0[0], v0[1]); w.y = cvtpk(v0[2], v0[3]); w.z = cvtpk(v1[0], v1[1]); w.w = cvtpk(v1[2], v1[3]);
                    *(u32x4*)(rowp + bj * 128) = w; } }
    }
};

static_assert(HG_UNIT_BYTES <= LDSCTL_OFF, "hgrn LDS");
DI const float* karg_in(int i) { const float* const* kp = (const float* const*)__builtin_amdgcn_kernarg_segment_ptr(); asm volatile("" : "+s"(kp)); return kp[i]; }
DI float* karg_out() { float* const* kp = (float* const*)__builtin_amdgcn_kernarg_segment_ptr(); asm volatile("" : "+s"(kp)); return kp[18]; }
__global__ void __launch_bounds__(NTHR, 2) mega(Args args) {
    extern __shared__ __attribute__((aligned(16))) unsigned char lds_raw[];
    LAS unsigned char* lds = (LAS unsigned char*)lds_raw;
    volatile LAS unsigned* MISC = (volatile LAS unsigned*)(lds + MISC_OFF);
    for (int u = threadIdx.x; u < (LDS_BYTES - LDSCTL_OFF) / 4; u += NTHR) ((LAS unsigned*)(lds + LDSCTL_OFF))[u] = 0u;
    __syncthreads();
    unsigned char* ws = args.ws;
    const int G = gridDim.x;
    const bool ALL = args.ph == PH_ALL;
    XcdBarrier bar; bar.bar = (unsigned*)(ws + O_MISC + 16384); bar.x = 0; bar.st = nullptr;
    if (ALL) bar = xcd_barrier_post((unsigned*)(ws + O_MISC + 16384), MISC + 8);
#ifndef REP_MASK
#define REP_MASK 0
#endif
#define RUN(k) (ALL || args.ph == (k))
#define NREP(k) (((REP_MASK >> (k)) & 1) ? 2 : 1)
#define SEAM() do { if (ALL) xcd_barrier(bar); } while (0)
    for (int rep_ = 0; rep_ < NREP(PH_PRO); ++rep_) if (RUN(PH_PRO)) {
        int tid = threadIdx.x; asm volatile("" : "+v"(tid)); asm volatile("" : "+s"(ws)); int bid = blockIdx.x; asm volatile("" : "+s"(bid));
        const size_t gt = (size_t)bid * NTHR + tid, nth = (size_t)G * NTHR;
        p0_convert(karg_in(0), (bf16_t*)(ws + O_XB), (size_t)M * D / 8, gt, nth);
        p0_convert(karg_in(1), (bf16_t*)(ws + O_MEMB), (size_t)2048 * 1024 / 8, gt, nth);
        p0_convert(karg_in(13), (bf16_t*)(ws + O_SUBK), (size_t)16 * 128 * 128 / 8, gt, nth);
        if (bid == 0) p0_misc(karg_in(6), karg_in(5), (float*)(ws + O_MISC), tid);
        const int wid = __builtin_amdgcn_readfirstlane(tid >> 6), lane = tid & 63;
        LAS float* scr = (LAS float*)(lds + wid * 16384);
        const int gw = bid * NWAVES + wid, ngw = G * NWAVES;
        for (int r = gw; r < 2 * NEXP; r += ngw) {
            if (r < NEXP) p0_fp8_row(karg_in(14), (unsigned char*)(ws + O_UB), (float*)(ws + O_USC), r, lane);
            else p0_fp8_row(karg_in(15), (unsigned char*)(ws + O_VB), (float*)(ws + O_VSC), r - NEXP, lane);
        }
        constexpr int NJ = 13;
        for (int it = gw; ; it += ngw) {
            int r = it; bool done = true;
#pragma unroll
            for (int j = 0; j < NJ; ++j) {
                const int srcc[NJ] = {0, 4608, 5632, 6656, 7168, 3072, 5120, 0, 0, 0, 0, 0, 0};
                const int cnt[NJ] = {3072, 512, 1024, 512, 3072, 1536, 512, 1024, 1024, 1024, 1024, 1024, 2048};
                const int drow[NJ] = {0, 3072, 3584, 4608, 5120, 8192, 9728, 0, 0, 0, 0, 0, 0};
                const int Kj = (j >= 8 && j <= 10) ? 512 : 1024;
                const int items = (Kj / 64) * (cnt[j] / 32);
                if (done && r < items) {
                    const float* W; int ldw; bf16_t* o; int ldo, koff = 0;
                    if (j < 7) { W = karg_in(2) + srcc[j]; ldw = INC; o = (bf16_t*)(ws + O_WIN) + (size_t)drow[j] * 1024; ldo = 1024; }
                    else if (j == 7) { W = karg_in(4); ldw = 1024; o = (bf16_t*)(ws + O_WMKV); ldo = 1024; }
                    else if (j <= 10) { W = karg_in(8) + (size_t)(j - 8) * 512 * 1024; ldw = 1024; o = (bf16_t*)(ws + O_WBR); ldo = 1536; koff = (j - 8) * 512; }
                    else if (j == 11) { W = karg_in(9); ldw = 1024; o = (bf16_t*)(ws + O_WOUT); ldo = 1024; }
                    else { W = karg_in(12); ldw = 2048; o = (bf16_t*)(ws + O_WPQ); ldo = 1024; }
                    p0_transpose_item(W, ldw, cnt[j], o, ldo, koff, scr, r, lane); done = false;
                }
                r -= items;
            }
            if (done) break;
        }
        SEAM();
    }
#pragma unroll 1
    for (int p = (ALL ? 0 : args.pass); p < (ALL ? NPASS : args.pass + 1); ++p) {
        int bid = blockIdx.x; asm volatile("" : "+s"(bid));
        int tid = threadIdx.x; asm volatile("" : "+v"(tid));
        asm volatile("" : "+s"(ws));
        char* pr = (char*)ws + O_PASS;
        const size_t t0 = (size_t)p * MP;
        for (int rep_ = 0; rep_ < NREP(PH_PROJ); ++rep_) if (RUN(PH_PROJ)) {
            asm volatile("" : "+s"(bid)); asm volatile("" : "+v"(tid)); asm volatile("" : "+s"(ws)); pr = (char*)ws + O_PASS;
            SchedP1 Sc{(unsigned)(O_XB + t0 * D * 2), (unsigned)O_WIN, G, bid};
            EpiP1 E{pr, karg_in(3)};
            g8::gemm_phase<EpiP1, SchedP1>(lds, (const char*)ws, D, Sc, E, tid);
            if (p == 0) {
                SchedMemKV S2{(unsigned)O_MEMB, (unsigned)O_WMKV, G, bid};
                EpiMemKVF E2{(bf16_t*)(ws + O_MK), (bf16_t*)(ws + O_MVT)};
                g8::gemm_phase<EpiMemKVF, SchedMemKV>(lds, (const char*)ws, D, S2, E2, tid);
            }
            SEAM();
        }
        for (int rep_ = 0; rep_ < NREP(PH_ATTN); ++rep_) if (RUN(PH_ATTN)) {
            asm volatile("" : "+s"(bid)); asm volatile("" : "+v"(tid)); asm volatile("" : "+s"(ws)); pr = (char*)ws + O_PASS;
            const float* bsrc = (const float*)(ws + O_MISC) + 512; LAS float* btab = (LAS float*)lds;
            for (int i = tid; i < 3 * 129 * 4; i += NTHR) btab[i] = bsrc[i] * LOG2E;
            __syncthreads();
            const int wid = __builtin_amdgcn_readfirstlane(tid >> 6), lane = tid & 63;
            for (int task = bid * NWAVES + wid; task < DIL_TASKS; task += G * NWAVES)
                attn_dil_wave((const bf16_t*)(pr + P_QK), (const bf16_t*)(pr + P_VT), btab, (bf16_t*)(pr + P_OG), (float*)(pr + P_LSE), task, lane);
            for (int task = bid * NWAVES + wid; task < MEM_TASKS; task += G * NWAVES)
                attn_mem_wave((const bf16_t*)(pr + P_MQ), (const bf16_t*)(ws + O_MK), (const bf16_t*)(ws + O_MVT), (bf16_t*)(pr + P_BR), task, p * BPP, lane);
            __syncthreads();
        }
        for (int rep_ = 0; rep_ < NREP(PH_HGPRE); ++rep_) if (RUN(PH_HGPRE)) {
            asm volatile("" : "+s"(bid)); asm volatile("" : "+v"(tid)); asm volatile("" : "+s"(ws)); pr = (char*)ws + O_PASS;
            { const int unit = bid; static_assert(HG_UNITS == 256, "one HGRN unit per workgroup"); if (unit < HG_UNITS) {
                hgrn_unit<false>(lds, unit, tid, (const bf16_t*)(pr + P_HFQG), (const bf16_t*)(pr + P_IT), (const float*)(ws + O_MISC), karg_in(7),
                                 (float*)(pr + P_HSTL), (float*)(pr + P_HSTD), (const float*)(pr + P_SIN), (bf16_t*)(pr + P_BR));
            } }
            SEAM();
        }
        for (int rep_ = 0; rep_ < NREP(PH_HGSCAN); ++rep_) if (RUN(PH_HGSCAN)) {
            asm volatile("" : "+s"(bid)); asm volatile("" : "+v"(tid)); asm volatile("" : "+s"(ws)); pr = (char*)ws + O_PASS;
            hgrn_scan((const float*)(pr + P_HSTL), (const float*)(pr + P_HSTD), (float*)(pr + P_SIN), bid * NTHR + tid);
            lse_merge_items((const bf16_t*)(pr + P_OG), (const float*)(pr + P_LSE), (bf16_t*)(pr + P_BR), bid * NTHR + tid, G * NTHR);
            SEAM();
        }
        for (int rep_ = 0; rep_ < NREP(PH_HGMAIN); ++rep_) if (RUN(PH_HGMAIN)) {
            asm volatile("" : "+s"(bid)); asm volatile("" : "+v"(tid)); asm volatile("" : "+s"(ws)); pr = (char*)ws + O_PASS;
            { const int unit = bid; static_assert(HG_UNITS == 256, "one HGRN unit per workgroup"); if (unit < HG_UNITS) {
                hgrn_unit<true>(lds, unit, tid, (const bf16_t*)(pr + P_HFQG), (const bf16_t*)(pr + P_IT), (const float*)(ws + O_MISC), karg_in(7),
                                (float*)(pr + P_HSTL), (float*)(pr + P_HSTD), (const float*)(pr + P_SIN), (bf16_t*)(pr + P_BR));
            } }
            SEAM();
        }
        for (int rep_ = 0; rep_ < NREP(PH_WIDEN); ++rep_) if (RUN(PH_WIDEN)) {
            asm volatile("" : "+s"(bid)); asm volatile("" : "+v"(tid)); asm volatile("" : "+s"(ws)); pr = (char*)ws + O_PASS;
            SchedRows Sc{(unsigned)(O_PASS + P_BR), (unsigned)O_WBR, 1536, 4, 256, G, bid};
            EpiWidenF E{(const bf16_t*)(pr + P_GATE), (bf16_t*)(pr + P_MERGED)};
            g8::gemm_phase<EpiWidenF, SchedRows>(lds, (const char*)ws, 1536, Sc, E, tid);
            SEAM();
        }
        for (int rep_ = 0; rep_ < NREP(PH_WOUT); ++rep_) if (RUN(PH_WOUT)) {
            asm volatile("" : "+s"(bid)); asm volatile("" : "+v"(tid)); asm volatile("" : "+s"(ws)); pr = (char*)ws + O_PASS;
            SchedRows Sc{(unsigned)(O_PASS + P_MERGED), (unsigned)O_WOUT, 1024, 4, 256, G, bid};
            EpiMixF32 E{(float*)(pr + P_MIX)};
            g8::gemm_phase<EpiMixF32, SchedRows>(lds, (const char*)ws, 1024, Sc, E, tid);
            SEAM();
        }
        for (int rep_ = 0; rep_ < NREP(PH_LN1); ++rep_) if (RUN(PH_LN1)) {
            asm volatile("" : "+s"(bid)); asm volatile("" : "+v"(tid)); asm volatile("" : "+s"(ws)); pr = (char*)ws + O_PASS;
            ln1_rows(karg_in(0) + t0 * D, (const float*)(pr + P_MIX), karg_in(10), karg_in(11), karg_out() + t0 * D, (bf16_t*)(ws + O_H1B) + t0 * D, bid * NWAVES + (tid >> 6), G * NWAVES, tid & 63);
        }
    }
    for (int rep_ = 0; rep_ < NREP(PH_PQ); ++rep_) if (RUN(PH_PQ)) {
        SEAM();
        int tid = threadIdx.x; asm volatile("" : "+v"(tid)); asm volatile("" : "+s"(ws)); int bid = blockIdx.x; asm volatile("" : "+s"(bid));
        char* pr = (char*)ws + O_PASS;
        SchedRows Sc{(unsigned)O_H1B, (unsigned)O_WPQ, 1024, 8, 2048, G, bid};
        EpiPlainB16 E{(bf16_t*)(pr + P_PQ), 2048, 0};
        g8::gemm_phase<EpiPlainB16, SchedRows>(lds, (const char*)ws, 1024, Sc, E, tid);
        SEAM();
    }
    for (int rep_ = 0; rep_ < NREP(PH_ROUTE); ++rep_) if (RUN(PH_ROUTE)) {
        int tid = threadIdx.x; asm volatile("" : "+v"(tid)); asm volatile("" : "+s"(ws)); int bid = blockIdx.x; asm volatile("" : "+s"(bid));
        char* pr = (char*)ws + O_PASS;
        const int h = bid & 7, wgi = bid >> 3, nwg = G >> 3;
        const bf16_t* ksrc = (const bf16_t*)(ws + O_SUBK) + (size_t)h * 2 * 128 * 128;
        for (int i = tid; i < 2 * 128 * 16; i += NTHR) { const int rowk = i >> 4, ch = i & 15; *(LAS u32x4*)(lds + (rowk * RT_ROW + ch * 8) * 2) = *(const u32x4*)(ksrc + rowk * 128 + ch * 8); }
        __syncthreads();
        const int wid = __builtin_amdgcn_readfirstlane(tid >> 6), lane = tid & 63;
        for (int tb = wgi * NWAVES + wid; tb < M / 32; tb += nwg * NWAVES)
            route_wave((const bf16_t*)(pr + P_PQ), lds, (int*)(pr + P_IDX), (float*)(pr + P_PG), tb, h, lane);
        __syncthreads();
        SEAM();
    }
    if (RUN(PH_EXPERTS)) {
        int tid = threadIdx.x; asm volatile("" : "+v"(tid)); asm volatile("" : "+s"(ws)); int bid = blockIdx.x; asm volatile("" : "+s"(bid));
        char* pr = (char*)ws + O_PASS;
        const int wid = __builtin_amdgcn_readfirstlane(tid >> 6), lane = tid & 63;
        if (tid == 0) {
            unsigned base = 0; const unsigned myx = ALL ? bar.x : 0u;
            if (ALL) { for (unsigned jx = 0; jx < 16; ++jx) { const unsigned c = xb_ld(&bar.bar[XB_XCNT(jx)]); if (jx < myx) base += c; } MISC[12] = base + MISC[10]; }
            else MISC[12] = (unsigned)bid;
        }
        __syncthreads();
        const int vwg = (int)MISC[12];
        const int nper = G >> 3, x = vwg / nper, r = vwg % nper;
        const int tpw = M / (nper * NWAVES);
        const size_t tokw0 = (size_t)(r * NWAVES + wid) * tpw;
        {
            const unsigned char* U8x = (const unsigned char*)(ws + O_UB) + (size_t)x * ((size_t)NEXP * 128);
            for (int i = 0; i < tpw; ++i) experts_u_slice((const bf16_t*)(ws + O_H1B), U8x, (const int*)(pr + P_IDX), (bf16_t*)(pr + P_PD), tokw0 + i, x, lane);
        }
        SEAM();
        experts_combine((const bf16_t*)(pr + P_PD), (const int*)(pr + P_IDX), (const float*)(pr + P_PG), (const float*)(ws + O_USC), (const float*)(ws + O_VSC), (float*)(pr + P_C), (size_t)bid * NTHR + tid, (size_t)G * NTHR);
        SEAM();
        {
            const unsigned char* V8x = (const unsigned char*)(ws + O_VB) + (size_t)x * ((size_t)NEXP * 128);
            for (int i = 0; i < tpw; ++i) experts_v_slice(V8x, (const int*)(pr + P_IDX), (const float*)(pr + P_C), (bf16_t*)(pr + P_FFN), tokw0 + i, x, lane);
        }
        SEAM();
        for (int tok = bid * NWAVES + wid; tok < M; tok += G * NWAVES) ln2_token((const bf16_t*)(pr + P_FFN), karg_in(16), karg_in(17), karg_out(), (size_t)tok, lane);
    }
#undef RUN
#undef SEAM
}

extern "C" void kernel_launch(void* const* d_in, const int* in_sizes, int n_in, void* d_out, int out_size, void* d_ws, size_t ws_size, hipStream_t stream) {
    if (ws_size < WS_NEED || n_in != 18) return;
    static bool attr_set = false;
    if (!attr_set) { (void)hipFuncSetAttribute((const void*)mega, hipFuncAttributeMaxDynamicSharedMemorySize, LDS_BYTES); attr_set = true; }
    (void)hipMemsetAsync((char*)d_ws + O_MISC + 16384, 0, 16384, stream);
    Args a{}; for (int i = 0; i < 18; ++i) a.in[i] = (const float*)d_in[i]; a.out = (float*)d_out; a.ws = (unsigned char*)d_ws; a.ph = PH_ALL; a.pass = 0;
    mega<<<256, NTHR, LDS_BYTES, stream>>>(a);
}
```

```cpp
#include <hip/hip_runtime.h>
#include <stdint.h>
#include <math.h>

typedef unsigned short bf16_t;
typedef short bf16x8 __attribute__((ext_vector_type(8)));
typedef float f32x4 __attribute__((ext_vector_type(4)));
#define DI __device__ __forceinline__

DI float bf2f(bf16_t v) { return __uint_as_float(((unsigned)v) << 16); }
DI bf16_t f2bf(float f) { unsigned u = __float_as_uint(f); u += 0x7fffu + ((u >> 16) & 1u); return (bf16_t)(u >> 16); }

constexpr int NB = 8, S = 8192, D = 1024, M = NB * S;
constexpr int NPASS = 4, BPP = NB / NPASS, MP = BPP * S;
constexpr int INC = 10240;
constexpr int NEXP = 16384;
constexpr float ALPHA = 1.189207115002721f;
constexpr float LN_EPS = 1e-5f;
constexpr float QSCALE = 0.08838834764831845f;

constexpr size_t al(size_t x) { return (x + 255) & ~(size_t)255; }
constexpr size_t O_WIN = 0;
constexpr size_t O_WMKV = O_WIN + al((size_t)INC * D * 2);
constexpr size_t O_WBR = O_WMKV + al((size_t)1024 * 1024 * 2);
constexpr size_t O_WOUT = O_WBR + al((size_t)1024 * 1536 * 2);
constexpr size_t O_WPQ = O_WOUT + al((size_t)1024 * 1024 * 2);
constexpr size_t O_SUBK = O_WPQ + al((size_t)2048 * 1024 * 2);
constexpr size_t O_UB = O_SUBK + al((size_t)16 * 128 * 128 * 2);
constexpr size_t O_VB = O_UB + al((size_t)NEXP * D);
constexpr size_t O_USC = O_VB + al((size_t)NEXP * D);
constexpr size_t O_VSC = O_USC + al((size_t)NEXP * 4);
constexpr size_t O_XB = O_VSC + al((size_t)NEXP * 4);
constexpr size_t O_MEMB = O_XB + al((size_t)M * D * 2);
constexpr size_t O_MK = O_MEMB + al((size_t)2048 * 1024 * 2);
constexpr size_t O_MVT = O_MK + al((size_t)2048 * 512 * 2);
constexpr size_t O_H1B = O_MVT + al((size_t)8 * 512 * 256 * 2);
constexpr size_t O_MISC = O_H1B + al((size_t)M * D * 2);
constexpr size_t O_PASS = O_MISC + al(65536);
constexpr size_t P_QK = 0;
constexpr size_t P_VT = P_QK + al((size_t)MP * 3072 * 2);
constexpr size_t P_IT = P_VT + (size_t)1536 * MP * 2;
constexpr size_t P_HFQG = P_IT + al((size_t)512 * MP * 2);
constexpr size_t P_MQ = P_HFQG + al((size_t)MP * 1536 * 2);
constexpr size_t P_GATE = P_MQ + al((size_t)MP * 512 * 2);
constexpr size_t P_OG = P_GATE + al((size_t)MP * 3072 * 2);
constexpr size_t P_LSE = P_OG + al((size_t)MP * 1536 * 2);
constexpr size_t P_BR = P_LSE + al((size_t)MP * 12 * 4);
constexpr size_t P_MERGED = P_BR + al((size_t)MP * 1536 * 2);
constexpr size_t P_MIX = P_MERGED + al((size_t)MP * 1024 * 2);
constexpr size_t P_HSTL = P_MIX + al((size_t)MP * 1024 * 4);
constexpr size_t P_HSTD = P_HSTL + al((size_t)256 * 16384 * 4);
constexpr size_t P_SIN = P_HSTD + al((size_t)256 * 128 * 4);
constexpr size_t P_END = P_SIN + al((size_t)256 * 16384 * 4);
constexpr size_t P_PQ = 0;
constexpr size_t P_IDX = P_PQ + al((size_t)M * 2048 * 2);
constexpr size_t P_PG = P_IDX + al((size_t)M * 128 * 4);
constexpr size_t P_C = P_PG + al((size_t)M * 128 * 4);
constexpr size_t P_END2 = P_C + al((size_t)M * 128 * 4);
constexpr size_t P_PD = 0;
constexpr size_t P_FFN = P_PD + al((size_t)M * 1024 * 2);
static_assert(P_FFN + (size_t)M * 1024 * 2 <= P_IDX, "PEER overlay");
constexpr size_t WS_NEED = O_PASS + (P_END > P_END2 ? P_END : P_END2);
static_assert(WS_NEED <= (size_t)1073741824, "workspace budget");

__global__ __launch_bounds__(256) void k_convert(const float* __restrict__ in, bf16_t* __restrict__ out, size_t n4) {
    size_t i = (size_t)blockIdx.x * 256 + threadIdx.x; const size_t st = (size_t)gridDim.x * 256;
    for (; i < n4; i += st) { const f32x4 v = ((const f32x4*)in)[i]; ushort4 o; o.x = f2bf(v[0]); o.y = f2bf(v[1]); o.z = f2bf(v[2]); o.w = f2bf(v[3]); ((ushort4*)out)[i] = o; }
}
__global__ __launch_bounds__(256) void k_transpose(const float* __restrict__ W, int K, int ldw, bf16_t* __restrict__ out, int ldo, int koff) {
    __shared__ float t[32][33];
    const int k0 = blockIdx.y * 32, n0 = blockIdx.x * 32, tx = threadIdx.x & 31, ty = threadIdx.x >> 5;
    for (int i = ty; i < 32; i += 8) t[i][tx] = W[(size_t)(k0 + i) * ldw + n0 + tx];
    __syncthreads();
    for (int i = ty; i < 32; i += 8) out[(size_t)(n0 + i) * ldo + koff + k0 + tx] = f2bf(t[tx][i]);
}
__global__ void k_misc(const float* __restrict__ hgrn_lb, const float* __restrict__ rel_bias, float* __restrict__ misc) {
    const int i = blockIdx.x * blockDim.x + threadIdx.x;
    if (i < 512) { const float a = hgrn_lb[i], b = hgrn_lb[512 + i]; const float mx = fmaxf(a, b); const float ea = expf(a - mx), eb = expf(b - mx); misc[i] = ea / (ea + eb); }
    if (i < 3 * 129) {
        const int g = i / 129, j = i % 129; const int dl = g == 0 ? 1 : (g == 1 ? 4 : 16); const int n = j * dl;
        int bucket;
        if (n < 16) bucket = n;
        else { const double v = log((double)n / 16.0) / log(128.0) * 16.0; int l = 16 + (int)v; bucket = l < 31 ? l : 31; }
        for (int h = 0; h < 4; ++h) misc[512 + i * 4 + h] = rel_bias[bucket * 12 + g * 4 + h];
    }
}

template <class Epi>
__global__ __launch_bounds__(256) void gemm_simple(const bf16_t* __restrict__ A, int lda, const bf16_t* __restrict__ Bt, int ldb, int K, Epi epi) {
    const int lane = threadIdx.x & 63, w = threadIdx.x >> 6;
    const int row0 = blockIdx.y * 64 + (w >> 1) * 32, col0 = blockIdx.x * 64 + (w & 1) * 32;
    const int fr = lane & 15, fq = lane >> 4;
    f32x4 acc[2][2];
#pragma unroll
    for (int a = 0; a < 2; ++a)
#pragma unroll
        for (int b = 0; b < 2; ++b) acc[a][b] = (f32x4){0.f, 0.f, 0.f, 0.f};
    const bf16_t* ap = A + (size_t)(row0 + fr) * lda + fq * 8;
    const bf16_t* bp = Bt + (size_t)(col0 + fr) * ldb + fq * 8;
    for (int k0 = 0; k0 < K; k0 += 32) {
        const bf16x8 a0 = *(const bf16x8*)(ap + k0), a1 = *(const bf16x8*)(ap + (size_t)16 * lda + k0);
        const bf16x8 b0 = *(const bf16x8*)(bp + k0), b1 = *(const bf16x8*)(bp + (size_t)16 * ldb + k0);
        acc[0][0] = __builtin_amdgcn_mfma_f32_16x16x32_bf16(a0, b0, acc[0][0], 0, 0, 0);
        acc[0][1] = __builtin_amdgcn_mfma_f32_16x16x32_bf16(a0, b1, acc[0][1], 0, 0, 0);
        acc[1][0] = __builtin_amdgcn_mfma_f32_16x16x32_bf16(a1, b0, acc[1][0], 0, 0, 0);
        acc[1][1] = __builtin_amdgcn_mfma_f32_16x16x32_bf16(a1, b1, acc[1][1], 0, 0, 0);
    }
#pragma unroll
    for (int mi = 0; mi < 2; ++mi)
#pragma unroll
        for (int ni = 0; ni < 2; ++ni)
#pragma unroll
            for (int j = 0; j < 4; ++j) epi(row0 + mi * 16 + fq * 4 + j, col0 + ni * 16 + fr, acc[mi][ni][j]);
}

DI int dil_of(int g) { return g == 0 ? 1 : (g == 1 ? 4 : 16); }
DI int perm_tok(int lb, int s, int dl) { return lb * S + (s % dl) * (S / dl) + s / dl; }

struct EpiProj {
    bf16_t *QK, *VT, *HFQG, *IT, *MQ, *GATE; const float* b_gate;
    DI void operator()(int row, int col, float v) const {
        if (col < 3072) QK[(size_t)row * 3072 + col] = f2bf(v);
        else if (col < 4608) { const int c = col - 3072, g = c >> 9; VT[(size_t)c * MP + perm_tok(row / S, row % S, dil_of(g))] = f2bf(v); }
        else if (col < 5120) HFQG[(size_t)row * 1536 + (col - 4608)] = f2bf(v);
        else if (col < 5632) IT[(size_t)(col - 5120) * MP + row] = f2bf(v);
        else if (col < 6656) HFQG[(size_t)row * 1536 + (col - 5632) + 512] = f2bf(v);
        else if (col < 7168) MQ[(size_t)row * 512 + (col - 6656)] = f2bf(v);
        else { const int c = col - 7168; const float z = v + b_gate[c]; GATE[(size_t)row * 3072 + c] = f2bf(1.f / (1.f + expf(-z))); }
    }
};
struct EpiMemKV {
    bf16_t *MK, *MVT;
    DI void operator()(int row, int col, float v) const {
        if (col < 512) MK[(size_t)row * 512 + col] = f2bf(v);
        else MVT[((size_t)(row >> 8) * 512 + (col - 512)) * 256 + (row & 255)] = f2bf(v);
    }
};
struct EpiWiden {
    const bf16_t* GATE; float* TMP; bf16_t* MERGED; int g, pad;
    DI void operator()(int row, int col, float v) const {
        const float gv = bf2f(GATE[(size_t)row * 3072 + g * 1024 + col]) * v; const size_t o = (size_t)row * 1024 + col;
        if (g == 0) TMP[o] = gv; else if (g == 1) TMP[o] += gv; else MERGED[o] = f2bf(TMP[o] + gv);
    }
};
struct EpiF32 { float* C; int ldc, pad; DI void operator()(int row, int col, float v) const { C[(size_t)row * ldc + col] = v; } };
struct EpiB16 { bf16_t* C; int ldc, pad; DI void operator()(int row, int col, float v) const { C[(size_t)row * ldc + col] = f2bf(v); } };

DI float wave_max(float v) {
#pragma unroll
    for (int o = 1; o < 64; o <<= 1) v = fmaxf(v, __shfl_xor(v, o));
    return v;
}
DI float wave_sum(float v) {
#pragma unroll
    for (int o = 1; o < 64; o <<= 1) v += __shfl_xor(v, o);
    return v;
}

__global__ __launch_bounds__(256) void k_dil_attn(const bf16_t* __restrict__ QK, const bf16_t* __restrict__ VT, const float* __restrict__ BIAS, bf16_t* __restrict__ OG, float* __restrict__ LSE) {
    __shared__ float ps[4][192];
    const int lane = threadIdx.x & 63, w = threadIdx.x >> 6;
    const long task = (long)blockIdx.x * 4 + w;
    const int gh = (int)(task % 12); const int row = (int)(task / 12);
    const int g = gh >> 2, h = gh & 3, dl = dil_of(g);
    const int lb = row / S, s = row % S, m = s / dl, r = s % dl;
    const bf16_t* qp = QK + (size_t)row * 3072 + gh * 128;
    float lg[3]; float mx = -INFINITY;
#pragma unroll
    for (int i = 0; i < 3; ++i) {
        const int j = lane + 64 * i; float l = -INFINITY;
        if (j <= 128 && m - j >= 0) {
            const int krow = lb * S + (m - j) * dl + r; const bf16_t* kp = QK + (size_t)krow * 3072 + 1536 + gh * 128;
            float dot = 0.f;
            for (int d = 0; d < 128; ++d) dot += bf2f(qp[d]) * bf2f(kp[d]);
            l = dot * QSCALE + BIAS[(g * 129 + j) * 4 + h];
        }
        lg[i] = l; mx = fmaxf(mx, l);
    }
    mx = wave_max(mx);
    float sum = 0.f;
#pragma unroll
    for (int i = 0; i < 3; ++i) { const float p = (lg[i] == -INFINITY) ? 0.f : expf(lg[i] - mx); ps[w][lane + 64 * i] = p; sum += p; }
    sum = wave_sum(sum);
    __syncthreads();
    const int nk = m < 128 ? m : 128;
    const float inv = 1.f / sum;
#pragma unroll
    for (int i = 0; i < 2; ++i) {
        const int d = lane + 64 * i; const bf16_t* vp = VT + (size_t)(g * 512 + h * 128 + d) * MP + lb * S + r * (S / dl);
        float o = 0.f;
        for (int j = 0; j <= nk; ++j) o += ps[w][j] * bf2f(vp[m - j]);
        OG[(size_t)row * 1536 + g * 512 + h * 128 + d] = f2bf(o * inv);
    }
    if (lane == 0) LSE[(size_t)row * 12 + gh] = mx + logf(sum);
}
__global__ __launch_bounds__(256) void k_merge(const bf16_t* __restrict__ OG, const float* __restrict__ LSE, bf16_t* __restrict__ BR) {
    const long i = (long)blockIdx.x * 256 + threadIdx.x;
    const int row = (int)(i >> 9), c = (int)(i & 511), h = c >> 7;
    const float l0 = LSE[(size_t)row * 12 + h], l1 = LSE[(size_t)row * 12 + 4 + h], l2 = LSE[(size_t)row * 12 + 8 + h];
    const float mx = fmaxf(l0, fmaxf(l1, l2)); const float e0 = expf(l0 - mx), e1 = expf(l1 - mx), e2 = expf(l2 - mx); const float inv = 1.f / (e0 + e1 + e2);
    const bf16_t* og = OG + (size_t)row * 1536 + c;
    BR[(size_t)row * 1536 + c] = f2bf((e0 * bf2f(og[0]) + e1 * bf2f(og[512]) + e2 * bf2f(og[1024])) * inv);
}
__global__ __launch_bounds__(256) void k_mem_attn(const bf16_t* __restrict__ MQ, const bf16_t* __restrict__ MK, const bf16_t* __restrict__ MVT, bf16_t* __restrict__ BR, int batch0) {
    __shared__ float ps[4][256];
    const int lane = threadIdx.x & 63, w = threadIdx.x >> 6;
    const long task = (long)blockIdx.x * 4 + w;
    const int h = (int)(task & 3); const int row = (int)(task >> 2);
    const int b = batch0 + row / S;
    const bf16_t* qp = MQ + (size_t)row * 512 + h * 128;
    float lg[4]; float mx = -INFINITY;
#pragma unroll
    for (int i = 0; i < 4; ++i) {
        const int j = lane + 64 * i; const bf16_t* kp = MK + (size_t)(b * 256 + j) * 512 + h * 128;
        float dot = 0.f;
        for (int d = 0; d < 128; ++d) dot += bf2f(qp[d]) * bf2f(kp[d]);
        lg[i] = dot * QSCALE; mx = fmaxf(mx, lg[i]);
    }
    mx = wave_max(mx);
    float sum = 0.f;
#pragma unroll
    for (int i = 0; i < 4; ++i) { const float p = expf(lg[i] - mx); ps[w][lane + 64 * i] = p; sum += p; }
    sum = wave_sum(sum);
    __syncthreads();
    const float inv = 1.f / sum;
#pragma unroll
    for (int i = 0; i < 2; ++i) {
        const int d = lane + 64 * i; const bf16_t* vp = MVT + ((size_t)b * 512 + h * 128 + d) * 256;
        float o = 0.f;
        for (int j = 0; j < 256; ++j) o += ps[w][j] * bf2f(vp[j]);
        BR[(size_t)row * 1536 + 1024 + h * 128 + d] = f2bf(o * inv);
    }
}
__global__ __launch_bounds__(128) void k_hgrn(const bf16_t* __restrict__ HFQG, const bf16_t* __restrict__ IT, const float* __restrict__ lbv, const float* __restrict__ norm_w, bf16_t* __restrict__ BR) {
    __shared__ float sf[128], sk[128], sq[128], red[2];
    const int tid = threadIdx.x, h = blockIdx.x & 3, lb = blockIdx.x >> 2;
    const float lbd = lbv[h * 128 + tid], nw = norm_w[h * 128 + tid];
    float St[128];
#pragma unroll
    for (int i = 0; i < 128; ++i) St[i] = 0.f;
    for (int s = 0; s < S; ++s) {
        const size_t row = (size_t)lb * S + s;
        const float fr = bf2f(HFQG[row * 1536 + h * 128 + tid]);
        const float f = lbd + (1.f - lbd) / (1.f + expf(-fr));
        sf[tid] = f; sk[tid] = 1.f - f; sq[tid] = bf2f(HFQG[row * 1536 + 512 + h * 128 + tid]);
        __syncthreads();
        const float iv = bf2f(IT[(size_t)(h * 128 + tid) * MP + row]);
        float o = 0.f;
#pragma unroll
        for (int d = 0; d < 128; ++d) { St[d] = sf[d] * St[d] + sk[d] * iv; o += sq[d] * St[d]; }
        const float ss = wave_sum(o * o);
        if ((tid & 63) == 0) red[tid >> 6] = ss;
        __syncthreads();
        const float ms = (red[0] + red[1]) * (1.f / 128.f);
        const float gv = bf2f(HFQG[row * 1536 + 1024 + h * 128 + tid]);
        BR[row * 1536 + 512 + h * 128 + tid] = f2bf(o * rsqrtf(ms + LN_EPS) * nw * (gv / (1.f + expf(-gv))));
    }
}
__global__ __launch_bounds__(256) void k_ln1(const float* __restrict__ x, const float* __restrict__ mix, const float* __restrict__ g, const float* __restrict__ b, float* __restrict__ h1f, bf16_t* __restrict__ h1b) {
    __shared__ float red[8];
    const size_t row = blockIdx.x; const int tid = threadIdx.x;
    float v[4]; float s = 0.f;
#pragma unroll
    for (int i = 0; i < 4; ++i) { const int c = tid + 256 * i; v[i] = ALPHA * x[row * D + c] + mix[row * D + c]; s += v[i]; }
    s = wave_sum(s); if ((tid & 63) == 0) red[tid >> 6] = s; __syncthreads();
    const float mean = (red[0] + red[1] + red[2] + red[3]) * (1.f / D);
    float q = 0.f;
#pragma unroll
    for (int i = 0; i < 4; ++i) { v[i] -= mean; q += v[i] * v[i]; }
    q = wave_sum(q); if ((tid & 63) == 0) red[4 + (tid >> 6)] = q; __syncthreads();
    const float rstd = rsqrtf((red[4] + red[5] + red[6] + red[7]) * (1.f / D) + LN_EPS);
#pragma unroll
    for (int i = 0; i < 4; ++i) { const int c = tid + 256 * i; const float o = v[i] * rstd * g[c] + b[c]; h1f[row * D + c] = o; h1b[row * D + c] = f2bf(o); }
}

DI void ins16(float (&tv)[16], int (&ti)[16], float v, int i) {
#pragma unroll
    for (int j = 0; j < 16; ++j) { const bool gt = v > tv[j]; const float ov = tv[j]; const int oi = ti[j]; tv[j] = gt ? v : ov; ti[j] = gt ? i : oi; v = gt ? ov : v; i = gt ? oi : i; }
}
__global__ __launch_bounds__(256) void k_route(const bf16_t* __restrict__ PQ, const bf16_t* __restrict__ SUBK, int* __restrict__ IDX, float* __restrict__ PG) {
    const long gi = (long)blockIdx.x * 256 + threadIdx.x;
    const int h = (int)(gi & 7); const size_t t = (size_t)(gi >> 3);
    float s1[16], s2[16]; int i1[16], i2[16];
#pragma unroll
    for (int j = 0; j < 16; ++j) { s1[j] = -INFINITY; s2[j] = -INFINITY; i1[j] = 0; i2[j] = 0; }
    const bf16_t* q0 = PQ + t * 2048 + h * 256;
    for (int n = 0; n < 128; ++n) {
        const bf16_t* k0 = SUBK + (size_t)((h * 2 + 0) * 128 + n) * 128; const bf16_t* k1 = SUBK + (size_t)((h * 2 + 1) * 128 + n) * 128;
        float a = 0.f, b = 0.f;
        for (int k = 0; k < 128; ++k) { a += bf2f(q0[k]) * bf2f(k0[k]); b += bf2f(q0[128 + k]) * bf2f(k1[k]); }
        ins16(s1, i1, a, n); ins16(s2, i2, b, n);
    }
    float cv[16]; int ci[16];
#pragma unroll
    for (int j = 0; j < 16; ++j) { cv[j] = -INFINITY; ci[j] = 0; }
#pragma unroll
    for (int a = 0; a < 16; ++a)
#pragma unroll
        for (int b = 0; b < 16; ++b) ins16(cv, ci, s1[a] + s2[b], i1[a] * 128 + i2[b]);
    float sum = 0.f; float e[16];
#pragma unroll
    for (int j = 0; j < 16; ++j) { e[j] = expf(cv[j] - cv[0]); sum += e[j]; }
    const float inv = 1.f / sum;
#pragma unroll
    for (int j = 0; j < 16; ++j) { IDX[t * 128 + h * 16 + j] = ci[j]; PG[t * 128 + h * 16 + j] = e[j] * inv; }
}
__global__ __launch_bounds__(256) void k_experts(const float* h1f_in, const bf16_t* __restrict__ h1b, const bf16_t* __restrict__ UB, const bf16_t* __restrict__ VB, const int* __restrict__ IDX, const float* __restrict__ PG,
                                                 const float* __restrict__ g2, const float* __restrict__ b2, float* out) {
    __shared__ float hrow[1024]; __shared__ float cw[128]; __shared__ int eid[128]; __shared__ float red[8];
    const size_t t = blockIdx.x; const int tid = threadIdx.x, lane = tid & 63, w = tid >> 6;
    float hv[4];
#pragma unroll
    for (int i = 0; i < 4; ++i) { const int c = tid + 256 * i; hv[i] = h1f_in[t * D + c]; hrow[c] = bf2f(h1b[t * D + c]); }
    if (tid < 128) eid[tid] = IDX[t * 128 + tid];
    __syncthreads();
    for (int e = w; e < 128; e += 4) {
        const bf16_t* up = UB + (size_t)eid[e] * D; float dot = 0.f;
#pragma unroll
        for (int i = 0; i < 16; ++i) dot += hrow[lane + 64 * i] * bf2f(up[lane + 64 * i]);
        dot = wave_sum(dot);
        if (lane == 0) cw[e] = PG[t * 128 + e] * 0.5f * dot * (1.f + erff(dot * 0.7071067811865476f));
    }
    __syncthreads();
    float f[4] = {0.f, 0.f, 0.f, 0.f};
    for (int e = 0; e < 128; ++e) { const bf16_t* vp = VB + (size_t)eid[e] * D; const float c = cw[e];
#pragma unroll
        for (int i = 0; i < 4; ++i) f[i] += c * bf2f(vp[tid + 256 * i]); }
    float v[4]; float s = 0.f;
#pragma unroll
    for (int i = 0; i < 4; ++i) { v[i] = ALPHA * hv[i] + f[i]; s += v[i]; }
    s = wave_sum(s); if (lane == 0) red[w] = s; __syncthreads();
    const float mean = (red[0] + red[1] + red[2] + red[3]) * (1.f / D);
    float q = 0.f;
#pragma unroll
    for (int i = 0; i < 4; ++i) { v[i] -= mean; q += v[i] * v[i]; }
    q = wave_sum(q); if (lane == 0) red[4 + w] = q; __syncthreads();
    const float rstd = rsqrtf((red[4] + red[5] + red[6] + red[7]) * (1.f / D) + LN_EPS);
#pragma unroll
    for (int i = 0; i < 4; ++i) { const int c = tid + 256 * i; out[t * D + c] = v[i] * rstd * g2[c] + b2[c]; }
}

#define LAS __attribute__((address_space(3)))
#define GAS __attribute__((address_space(1)))
typedef unsigned u32x4 __attribute__((ext_vector_type(4)));
typedef unsigned u32x2 __attribute__((ext_vector_type(2)));
typedef float f32x2 __attribute__((ext_vector_type(2)));
typedef __bf16 bf16x2_t __attribute__((ext_vector_type(2)));
DI unsigned cvtpk(float lo, float hi) { f32x2 v = {lo, hi}; bf16x2_t b = __builtin_convertvector(v, bf16x2_t); return __builtin_bit_cast(unsigned, b); }
constexpr float LOG2E = 1.4426950408889634f;
DI float fast_sigmoid(float z) { return __builtin_amdgcn_rcpf(1.f + __builtin_amdgcn_exp2f(-z * LOG2E)); }

namespace g8 {
constexpr int BM = 256, BK = 64, HALF = 128, HTB = HALF * BK * 2, STAGE_BYTES = 8 * HTB;
DI int lds_byte(int r, int c) { const int st = (r >> 4) * 2 + (c >> 5), rr = r & 15, cc = c & 31, ob = rr * 64 + cc * 2; return st * 1024 + (ob ^ (((ob >> 9) & 1) << 5)); }
DI void stage_rc(int b, int& R, int& C) { const int st = b / 1024, sb = b % 1024, swz = sb ^ (((sb >> 9) & 1) << 5); R = (st >> 1) * 16 + swz / 64; C = (st & 1) * 32 + (swz % 64) / 2; }
DI int perm32(int rho) { const int n = rho >> 4, i = rho & 15; return 8 * (i >> 2) + 4 * n + (i & 3); }

struct Unit { unsigned a, b; int dlb; int pm, pn, kind; };

template <class Epi, class Sched>
DI void gemm_phase(LAS unsigned char* lds, const char* const wsb, const int K, const Sched& S, const Epi& E, const int tid) {
    const int wid = __builtin_amdgcn_readfirstlane(tid >> 6), lane = tid & 63, wr = wid >> 2, wc = wid & 3, fr = lane & 15, fq = lane >> 4;
    const int nt = K / BK;
    unsigned voffA[2], rbk[2], ccb[2];
#pragma unroll
    for (int i = 0; i < 2; ++i) { int R, C; stage_rc(tid * 16 + i * 8192, R, C); const int Rb = Epi::PERM ? ((R & ~31) + perm32(R & 31)) : R;
        voffA[i] = (unsigned)(R * K + C) * 2u; rbk[i] = (unsigned)(Rb * K) * 2u; ccb[i] = (unsigned)C * 2u; }
    const unsigned kstep = (unsigned)(BK * 2);
    const unsigned hstepA = (unsigned)(HALF * K * 2);
    const unsigned ldsw = (unsigned)wid * 1024u;
    const int aoff = lds_byte(wr * 64 + fr, fq * 8), boff = lds_byte(wc * 32 + fr, fq * 8);
#define G8_SA(b, h) (((b) * 2 + (h)) * HTB)
#define G8_SB(b, h) ((4 + (b) * 2 + (h)) * HTB)
#define G8_STAGE(bufoff, gbase, v0, v1) do { \
        __builtin_amdgcn_global_load_lds((const unsigned*)(wsb + (unsigned)((gbase) + (v0))), (LAS unsigned*)(lds + (bufoff) + ldsw), 16, 0, 0); \
        __builtin_amdgcn_global_load_lds((const unsigned*)(wsb + (unsigned)((gbase) + (v1))), (LAS unsigned*)(lds + (bufoff) + ldsw + 8192), 16, 0, 0); } while (0)
#define G8_LDA(dst, b, h) do { _Pragma("unroll") for (int m = 0; m < 4; ++m) _Pragma("unroll") for (int k = 0; k < 2; ++k) dst[m][k] = *(const LAS bf16x8*)(lds + G8_SA(b, h) + aoff + m * 2048 + k * 1024); } while (0)
#define G8_LDB(dst, b, h) do { _Pragma("unroll") for (int n = 0; n < 2; ++n) _Pragma("unroll") for (int k = 0; k < 2; ++k) dst[n][k] = *(const LAS bf16x8*)(lds + G8_SB(b, h) + boff + n * 2048 + k * 1024); } while (0)
#define G8_MMA(ai, bj, At, Bt) do { __builtin_amdgcn_s_setprio(1); _Pragma("unroll") for (int m = 0; m < 4; ++m) _Pragma("unroll") for (int n = 0; n < 2; ++n) _Pragma("unroll") for (int k = 0; k < 2; ++k) \
        acc[ai][bj][m][n] = __builtin_amdgcn_mfma_f32_16x16x32_bf16(Bt[n][k], At[m][k], acc[ai][bj][m][n], 0, 0, 0); __builtin_amdgcn_s_setprio(0); } while (0)
#define G8_WAIT_V(n) asm volatile("s_waitcnt vmcnt(" #n ")" ::: "memory")
#define G8_WAIT_L(n) asm volatile("s_waitcnt lgkmcnt(" #n ")" ::: "memory")
#define G8_BAR __builtin_amdgcn_s_barrier()
#define G8_SCHED __builtin_amdgcn_sched_barrier(0)
    Unit cur, nxt; int ui = 0;
    if (!S.next(0, cur)) return;
    f32x4 acc[2][2][4][2];
#pragma unroll
    for (int a = 0; a < 2; ++a)
#pragma unroll
        for (int b = 0; b < 2; ++b)
#pragma unroll
            for (int m = 0; m < 4; ++m)
#pragma unroll
                for (int n = 0; n < 2; ++n) acc[a][b][m][n] = (f32x4){0.f, 0.f, 0.f, 0.f};
    bf16x8 At[4][2], B0[2][2], B1[2][2];
    unsigned cA = cur.a, cB = cur.b;
    unsigned vBc0 = rbk[0] * (unsigned)cur.dlb + ccb[0], vBc1 = rbk[1] * (unsigned)cur.dlb + ccb[1]; unsigned hBc = hstepA * (unsigned)cur.dlb;
    G8_STAGE(G8_SB(0, 0), cB, vBc0, vBc1); G8_STAGE(G8_SB(0, 1), cB + hBc, vBc0, vBc1); G8_STAGE(G8_SA(0, 0), cA, voffA[0], voffA[1]); G8_STAGE(G8_SA(0, 1), cA + hstepA, voffA[0], voffA[1]);
    if (wr == 1) G8_BAR;
    G8_WAIT_V(2); G8_BAR;
    G8_STAGE(G8_SB(1, 0), cB + kstep, vBc0, vBc1); G8_STAGE(G8_SA(1, 0), cA + kstep, voffA[0], voffA[1]); G8_STAGE(G8_SB(1, 1), cB + hBc + kstep, vBc0, vBc1);
    G8_WAIT_V(6); G8_BAR;
    for (;;) {
        const bool has_next = S.next(ui + 1, nxt);
        const unsigned nA = has_next ? nxt.a : cA, nB = has_next ? nxt.b : cB; const int dln = has_next ? nxt.dlb : cur.dlb;
        const unsigned vBn0 = rbk[0] * (unsigned)dln + ccb[0], vBn1 = rbk[1] * (unsigned)dln + ccb[1]; const unsigned hBn = hstepA * (unsigned)dln;
        for (int t = 0; t < nt; t += 2) {
            if constexpr (Epi::HOOK) E.hook(acc, cur, t, wr, wc, fr, fq);
            const bool last = (t == nt - 2);
            const unsigned a1 = cA + (unsigned)(t + 1) * kstep;
            const unsigned a2 = last ? nA : cA + (unsigned)(t + 2) * kstep, b2 = last ? nB : cB + (unsigned)(t + 2) * kstep;
            const unsigned a3 = a2 + kstep, b3 = b2 + kstep;
            const unsigned vB0 = last ? vBn0 : vBc0, vB1 = last ? vBn1 : vBc1; const unsigned hB = last ? hBn : hBc;
            G8_LDB(B0, 0, 0); G8_LDB(B1, 0, 1); G8_SCHED; G8_LDA(At, 0, 0); G8_STAGE(G8_SA(1, 1), a1 + hstepA, voffA[0], voffA[1]);
            G8_WAIT_V(8); G8_WAIT_L(0); G8_BAR; G8_MMA(0, 0, At, B0); G8_MMA(0, 1, At, B1); G8_BAR; G8_SCHED;
            G8_LDA(At, 0, 1); G8_STAGE(G8_SB(0, 0), b2, vB0, vB1); G8_STAGE(G8_SB(0, 1), b2 + hB, vB0, vB1); G8_STAGE(G8_SA(0, 0), a2, voffA[0], voffA[1]);
            G8_WAIT_V(8); G8_WAIT_L(0); G8_BAR; G8_MMA(1, 0, At, B0); G8_MMA(1, 1, At, B1); G8_BAR; G8_SCHED;
            G8_LDB(B0, 1, 0); G8_LDB(B1, 1, 1); G8_SCHED; G8_LDA(At, 1, 0); G8_STAGE(G8_SA(0, 1), a2 + hstepA, voffA[0], voffA[1]);
            G8_WAIT_V(8); G8_WAIT_L(0); G8_BAR; G8_MMA(0, 0, At, B0); G8_MMA(0, 1, At, B1); G8_BAR; G8_SCHED;
            G8_LDA(At, 1, 1); G8_STAGE(G8_SB(1, 0), b3, vB0, vB1); G8_STAGE(G8_SB(1, 1), b3 + hB, vB0, vB1); G8_STAGE(G8_SA(1, 0), a3, voffA[0], voffA[1]);
            G8_WAIT_V(8); G8_WAIT_L(0); G8_BAR; G8_MMA(1, 0, At, B0); G8_MMA(1, 1, At, B1); G8_BAR; G8_SCHED;
        }
        if (wr == 0) G8_BAR;
        E(acc, cur, wr, wc, fr, fq);
        if (!has_next) break;
#pragma unroll
        for (int a = 0; a < 2; ++a)
#pragma unroll
            for (int b = 0; b < 2; ++b)
#pragma unroll
                for (int m = 0; m < 4; ++m)
#pragma unroll
                    for (int n = 0; n < 2; ++n) acc[a][b][m][n] = (f32x4){0.f, 0.f, 0.f, 0.f};
        cur = nxt; cA = nA; cB = nB; vBc0 = vBn0; vBc1 = vBn1; hBc = hBn; ++ui;
        if (wr == 1) G8_BAR;
    }
    G8_WAIT_V(0);
    G8_BAR;
#undef G8_SA
#undef G8_SB
#undef G8_STAGE
#undef G8_LDA
#undef G8_LDB
#undef G8_MMA
#undef G8_WAIT_V
#undef G8_WAIT_L
#undef G8_BAR
#undef G8_SCHED
}
}

typedef GAS unsigned gu32;
#define XB_TMO      128
#define XB_XCNT(j)  (256  + 64 * (j))
#define XB_XSUB(j)  (1280 + 64 * (j))
#define XB_XGEN(j)  (2304 + 64 * (j))
#define XB_TOP      3328
#define XB_TOPGEN   3392
#define XCD_BAR_WORDS 3456
#define XB_SPIN_CAP (1u << 22)
DI unsigned xb_ld(unsigned* p)              { return __hip_atomic_load(p, __ATOMIC_RELAXED, __HIP_MEMORY_SCOPE_AGENT); }
DI unsigned xb_add(unsigned* p, unsigned v) { return __hip_atomic_fetch_add(p, v, __ATOMIC_RELAXED, __HIP_MEMORY_SCOPE_AGENT); }
DI unsigned xb_xcc_id() { return (unsigned)__builtin_amdgcn_s_getreg((3 << 11) | 20) & 0xFu; }
#define XB_SPIN(cond, bar) do { unsigned _sp = 0; while (cond) { __builtin_amdgcn_s_sleep(1); \
    if ((++_sp & 255u) == 0u) { if (xb_ld(&(bar)[XB_TMO])) break; if (_sp > XB_SPIN_CAP) { atomicAdd(&(bar)[XB_TMO], 1u); break; } } } } while (0)
struct XcdBarrier { unsigned* bar; unsigned x; volatile LAS unsigned* st; };
DI XcdBarrier xcd_barrier_post(unsigned* bar, volatile LAS unsigned* st) {
    XcdBarrier b; b.bar = bar; b.x = xb_xcc_id(); b.st = st;
    if (threadIdx.x == 0) st[2] = xb_add(&bar[XB_XCNT(b.x)], 1u);
    return b;
}
DI void xcd_barrier_complete(unsigned* bar, unsigned x, unsigned& nloc, unsigned& nx) {
    const unsigned G = gridDim.x * gridDim.y * gridDim.z;
    unsigned sum, cnt, mine, sp = 0u;
    for (;;) {
        sum = 0u; cnt = 0u; mine = 0u;
#pragma unroll
        for (unsigned j = 0; j < 16; ++j) { const unsigned c = xb_ld(&bar[XB_XCNT(j)]); sum += c; cnt += (c > 0u) ? 1u : 0u; mine = (j == x) ? c : mine; }
        if (sum == G) break;
        __builtin_amdgcn_s_sleep(1);
        if ((++sp & 255u) == 0u) { if (xb_ld(&bar[XB_TMO])) break; if (sp > XB_SPIN_CAP) { atomicAdd(&bar[XB_TMO], 1u); break; } }
    }
    nloc = mine > 0u ? mine : 1u; nx = cnt > 0u ? cnt : 1u;
}
DI void xcd_barrier(const XcdBarrier& b) {
    asm volatile("s_waitcnt vmcnt(0)" ::: "memory");
    __syncthreads();
    if (threadIdx.x == 0) {
        unsigned* bar = b.bar;
        __builtin_amdgcn_s_waitcnt(0);
        unsigned nloc = b.st[0], nx = b.st[1];
        if (nloc == 0u) { xcd_barrier_complete(bar, b.x, nloc, nx); b.st[0] = nloc; b.st[1] = nx; }
        const unsigned old = xb_add(&bar[XB_XSUB(b.x)], 1u);
        const unsigned gen = old / nloc;
        if (old + 1u == (gen + 1u) * nloc) {
            __builtin_amdgcn_fence(__ATOMIC_RELEASE, "agent");
            asm volatile("s_waitcnt vmcnt(0)" ::: "memory");
            const unsigned og = xb_add(&bar[XB_TOP], 1u);
            const unsigned tg = og / nx;
            if (og + 1u == (tg + 1u) * nx) xb_add(&bar[XB_TOPGEN], 1u);
            else XB_SPIN(xb_ld(&bar[XB_TOPGEN]) == tg, bar);
            __builtin_amdgcn_fence(__ATOMIC_ACQUIRE, "agent");
            xb_add(&bar[XB_XGEN(b.x)], 1u);
            asm volatile("s_waitcnt vmcnt(0)" ::: "memory");
        } else {
            XB_SPIN(xb_ld(&bar[XB_XGEN(b.x)]) == gen, bar);
            __builtin_amdgcn_fence(__ATOMIC_ACQUIRE, "agent");
            asm volatile("s_waitcnt vmcnt(0)" ::: "memory");
        }
    }
    __syncthreads();
}

constexpr int NWAVES = 8, NTHR = NWAVES * 64;
constexpr int RING_BYTES = 131072, LDS_BYTES = 147456, LDSCTL_OFF = LDS_BYTES - 1024, MISC_OFF = LDSCTL_OFF + 320;
constexpr size_t CTL_BYTES = 65536;
enum { PH_ALL = 0, PH_PRO = 11, PH_PROJ = 1, PH_ATTN = 2, PH_HGPRE = 3, PH_HGMAIN = 4, PH_WIDEN = 5, PH_WOUT = 6, PH_LN1 = 7, PH_PQ = 8, PH_ROUTE = 9, PH_EXPERTS = 10, PH_HGSCAN = 12 };
struct Args { const float* in[18]; float* out; unsigned char* ws; int ph, pass; };

struct Bufs {
    const bf16_t *WIN, *XBp; bf16_t *QK, *VIT, *HFQG, *MQ, *GATE;
};

struct SchedP1 {
    unsigned XBp, W; int G, c;
    DI bool next(int i, g8::Unit& u) const {
        const int L = i * G + c; if (L >= 2560) return false;
        if (L < 2048) { const int x = L & 7, off = L >> 3; u.pm = 8 * x + (off & 7); u.pn = off >> 3; u.kind = 0; u.dlb = 1;
            u.a = XBp + (unsigned)u.pm * 256u * D * 2u; u.b = W + (unsigned)u.pn * 256u * D * 2u; }
        else { const int idx = L - 2048; u.pm = idx & 7; u.pn = idx >> 3; u.kind = 1;
            const int dl = u.pm < 2 ? 1 : (u.pm < 4 ? 4 : (u.pm < 6 ? 16 : 1));
            const int v0 = u.pn * 256, lb = v0 / S, vv = v0 % S, per = S / dl, r = vv / per, m0 = vv % per;
            u.dlb = dl; u.a = W + (unsigned)(8192 + u.pm * 256) * D * 2u; u.b = XBp + (unsigned)(lb * S + m0 * dl + r) * D * 2u; }
        return true;
    }
};
DI int frag_row_off(int d0, int r32) { return (((d0 >> 4) * 64 + ((d0 >> 3) & 1) * 32 + r32) * 8); }
struct EpiP1 {
    static constexpr bool PERM = true, HOOK = false;
    char* pr; const float* b_gate;
    DI void hook(f32x4 (&)[2][2][4][2], const g8::Unit&, int, int, int, int, int) const {}
    DI void operator()(const f32x4 (&acc)[2][2][4][2], const g8::Unit& u, int wr, int wc, int fr, int fq) const {
        const int rowl = wr * 64 + fr, d0 = wc * 32 + 8 * fq;
        if (u.kind == 1) {
#pragma unroll
            for (int ai = 0; ai < 2; ++ai)
#pragma unroll
                for (int m = 0; m < 4; ++m) { const int R = u.pm * 256 + rowl + ai * 128 + m * 16;
#pragma unroll
                    for (int bj = 0; bj < 2; ++bj) { const f32x4 v0 = acc[ai][bj][m][0], v1 = acc[ai][bj][m][1];
                        const int c = u.pn * 256 + bj * 128 + d0;
                        if (R < 1536) {
                            const int gh = R >> 7, d = R & 127, lb = c >> 13, pos = c & (S - 1), kk = pos & 31;
                            bf16_t* blk = (bf16_t*)(pr + P_VT) + ((size_t)((lb * 12 + gh) * 256 + (pos >> 5))) * 4096 + (((d >> 5) * 2 + (kk >> 4)) * 64 + (d & 31)) * 8 + 4 * ((kk >> 3) & 1);
                            u32x2 wa, wb; wa.x = cvtpk(v0[0], v0[1]); wa.y = cvtpk(v0[2], v0[3]); wb.x = cvtpk(v1[0], v1[1]); wb.y = cvtpk(v1[2], v1[3]);
                            *(u32x2*)blk = wa; *(u32x2*)(blk + 32 * 8) = wb;
                        } else {
                            u32x4 w; w.x = cvtpk(v0[0], v0[1]); w.y = cvtpk(v0[2], v0[3]); w.z = cvtpk(v1[0], v1[1]); w.w = cvtpk(v1[2], v1[3]);
                            *(u32x4*)((bf16_t*)(pr + P_IT) + (size_t)(R - 1536) * MP + c) = w;
                        } } }
            return;
        }
        if (u.pn < 12 || u.pn == 18 || u.pn == 19) {
#pragma unroll
            for (int ai = 0; ai < 2; ++ai)
#pragma unroll
                for (int m = 0; m < 4; ++m) { const int row = u.pm * 256 + rowl + ai * 128 + m * 16;
#pragma unroll
                    for (int bj = 0; bj < 2; ++bj) { const f32x4 v0 = acc[ai][bj][m][0], v1 = acc[ai][bj][m][1];
                        u32x4 w; w.x = cvtpk(v0[0], v0[1]); w.y = cvtpk(v0[2], v0[3]); w.z = cvtpk(v1[0], v1[1]); w.w = cvtpk(v1[2], v1[3]);
                        bf16_t* dst;
                        if (u.pn < 12) { const int hh = u.pn * 2 + bj, qk = hh >= 12 ? 1 : 0, gh = hh - 12 * qk, lg = (gh >> 2) * 2;
                            const int lb = row >> 13, s = row & (S - 1), pos = ((s & ((1 << lg) - 1)) << (13 - lg)) + (s >> lg);
                            dst = (bf16_t*)(pr + P_QK) + ((size_t)(((qk * BPP + lb) * 12 + gh) * 256 + (pos >> 5))) * 4096 + frag_row_off(d0, pos & 31); }
                        else { const int h = (u.pn - 18) * 2 + bj; dst = (bf16_t*)(pr + P_MQ) + ((size_t)((row >> 5) * 4 + h)) * 4096 + frag_row_off(d0, row & 31); }
                        *(u32x4*)dst = w; } }
            return;
        }
        bf16_t* base; int ldc, colt; bool gate = false;
        if (u.pn < 18) { base = (bf16_t*)(pr + P_HFQG); ldc = 1536; colt = (u.pn - 12) * 256; }
        else { base = (bf16_t*)(pr + P_GATE); ldc = 3072; colt = (u.pn - 20) * 256; gate = true; }
        const int row0 = u.pm * 256 + rowl, col0 = colt + d0;
        f32x4 bv[2][2];
#pragma unroll
        for (int bj = 0; bj < 2; ++bj)
#pragma unroll
            for (int n = 0; n < 2; ++n) bv[bj][n] = gate ? *(const f32x4*)(b_gate + col0 + bj * 128 + 4 * n) : (f32x4){0.f, 0.f, 0.f, 0.f};
#pragma unroll
        for (int ai = 0; ai < 2; ++ai)
#pragma unroll
            for (int m = 0; m < 4; ++m) { bf16_t* rowp = base + (size_t)(row0 + ai * 128 + m * 16) * ldc + col0;
#pragma unroll
                for (int bj = 0; bj < 2; ++bj) { f32x4 v0 = acc[ai][bj][m][0], v1 = acc[ai][bj][m][1];
                    if (gate) { v0 = v0 + bv[bj][0]; v1 = v1 + bv[bj][1];
#pragma unroll
                        for (int e = 0; e < 4; ++e) { v0[e] = fast_sigmoid(v0[e]); v1[e] = fast_sigmoid(v1[e]); } }
                    u32x4 w; w.x = cvtpk(v0[0], v0[1]); w.y = cvtpk(v0[2], v0[3]); w.z = cvtpk(v1[0], v1[1]); w.w = cvtpk(v1[2], v1[3]);
                    *(u32x4*)(rowp + bj * 128) = w; } }
    }
};

typedef float f32x16 __attribute__((ext_vector_type(16)));
typedef short s16x4 __attribute__((ext_vector_type(4)));
DI int crow(int r, int hi) { return (r & 3) + 8 * (r >> 2) + 4 * hi; }
DI float xor32f(float v) { return __shfl_xor(v, 32); }
#define MFMA32(a, b, c) __builtin_amdgcn_mfma_f32_32x32x16_bf16((a), (b), (c), 0, 0, 0)
DI bf16x8 pack8(const f32x16& p, int s) {
    u32x4 w; w.x = cvtpk(p[8 * s + 0], p[8 * s + 1]); w.y = cvtpk(p[8 * s + 2], p[8 * s + 3]); w.z = cvtpk(p[8 * s + 4], p[8 * s + 5]); w.w = cvtpk(p[8 * s + 6], p[8 * s + 7]);
    return __builtin_bit_cast(bf16x8, w);
}
DI bf16x8 ldvt(const bf16_t* vp) {
    const s16x4 lo = *(const s16x4*)vp, hi4 = *(const s16x4*)(vp + 8);
    return __builtin_shufflevector(lo, hi4, 0, 1, 2, 3, 4, 5, 6, 7);
}
constexpr int DIL_TASKS = BPP * 12 * (S / 32);
constexpr int MEM_TASKS = (MP / 32) * 4;
DI void attn_dil_wave(const bf16_t* __restrict__ QK, const bf16_t* __restrict__ VT, const LAS float* btab, bf16_t* __restrict__ OG, float* __restrict__ LSE, int task, int lane) {
    const int r32 = lane & 31, hi = lane >> 5;
    const int q32 = task & 255, gh = (task >> 8) % 12, lb = task / (256 * 12);
    const int g = gh >> 2, h = gh & 3, dl = dil_of(g), per = S / dl;
    const int tok0 = q32 * 32, r = tok0 / per, m0 = tok0 % per;
    const size_t rowq = (size_t)lb * S + (size_t)(m0 + r32) * dl + r;
    bf16x8 qf[8];
    const int tile0 = (r * per + m0) >> 5;
    { const bf16_t* qp = QK + ((size_t)((lb * 12 + gh) * 256 + tile0)) * 4096 + lane * 8;
#pragma unroll
      for (int ks = 0; ks < 8; ++ks) qf[ks] = *(const bf16x8*)(qp + ks * 512); }
    const LAS float* bt = btab + g * 129 * 4 + h;
    f32x16 o[4];
#pragma unroll
    for (int dt = 0; dt < 4; ++dt)
#pragma unroll
        for (int i = 0; i < 16; ++i) o[dt][i] = 0.f;
    float mrun = -INFINITY, sum = 0.f;
    const bf16_t* vbase = VT + ((size_t)((lb * 12 + gh) * 256 + tile0 - 4)) * 4096 + lane * 8;
    const bf16_t* kbase = QK + ((size_t)(((BPP + lb) * 12 + gh) * 256 + tile0 - 4)) * 4096 + lane * 8;
    const int kt0 = (m0 >= 128 ? 0 : (128 - m0) >> 5);
    bf16x8 kf[8], vf[8];
#pragma unroll
    for (int ks = 0; ks < 8; ++ks) kf[ks] = *(const bf16x8*)(kbase + (size_t)kt0 * 4096 + ks * 512);
#pragma unroll 1
    for (int kt = kt0; kt < 5; ++kt) {
#pragma unroll
        for (int i = 0; i < 8; ++i) vf[i] = *(const bf16x8*)(vbase + (size_t)kt * 4096 + i * 512);
        f32x16 sc;
#pragma unroll
        for (int i = 0; i < 16; ++i) sc[i] = 0.f;
#pragma unroll
        for (int ks = 0; ks < 8; ++ks) sc = MFMA32(kf[ks], qf[ks], sc);
        if (kt < 4) {
#pragma unroll
            for (int ks = 0; ks < 8; ++ks) kf[ks] = *(const bf16x8*)(kbase + (size_t)(kt + 1) * 4096 + ks * 512);
        }
        float mx = -INFINITY;
#pragma unroll
        for (int i = 0; i < 16; ++i) {
            const int delta = 128 - 32 * kt + r32 - crow(i, hi);
            const bool valid = (delta >= 0) && (delta <= 128);
            const int di = delta < 0 ? 0 : (delta > 128 ? 128 : delta);
            const float x = sc[i] * (QSCALE * LOG2E) + bt[di * 4];
            sc[i] = valid ? x : -INFINITY; mx = fmaxf(mx, sc[i]);
        }
        mx = fmaxf(mx, xor32f(mx));
        const float mnew = fmaxf(mrun, mx); const float f = __builtin_amdgcn_exp2f(mrun - mnew);
        sum *= f;
#pragma unroll
        for (int dt = 0; dt < 4; ++dt)
#pragma unroll
            for (int i = 0; i < 16; ++i) o[dt][i] *= f;
        mrun = mnew;
        float ps = 0.f;
#pragma unroll
        for (int i = 0; i < 16; ++i) { sc[i] = __builtin_amdgcn_exp2f(sc[i] - mnew); ps += sc[i]; }
        ps += xor32f(ps); sum += ps;
#pragma unroll
        for (int s = 0; s < 2; ++s) {
            const bf16x8 pb = pack8(sc, s);
#pragma unroll
            for (int dt = 0; dt < 4; ++dt) o[dt] = MFMA32(vf[dt * 2 + s], pb, o[dt]);
        }
    }
    const float inv = 1.f / sum;
    bf16_t* op = OG + rowq * 1536 + g * 512 + h * 128 + 4 * hi;
#pragma unroll
    for (int dt = 0; dt < 4; ++dt)
#pragma unroll
        for (int a = 0; a < 4; ++a) { u32x2 w; w.x = cvtpk(o[dt][4 * a] * inv, o[dt][4 * a + 1] * inv); w.y = cvtpk(o[dt][4 * a + 2] * inv, o[dt][4 * a + 3] * inv); *(u32x2*)(op + 32 * dt + 8 * a) = w; }
    if (hi == 0) LSE[rowq * 12 + gh] = (mrun + __builtin_amdgcn_logf(sum)) * 0.6931471805599453f;
}
DI void attn_mem_wave(const bf16_t* __restrict__ MQ, const bf16_t* __restrict__ MK, const bf16_t* __restrict__ MVT, bf16_t* __restrict__ BR, int task, int batch0, int lane) {
    const int r32 = lane & 31, hi = lane >> 5;
    const int h = task & 3, blk = task >> 2;
    const size_t rowq = (size_t)blk * 32 + r32; const int b = batch0 + blk * 32 / S;
    bf16x8 qf[8];
    { const bf16_t* qp = MQ + ((size_t)(blk * 4 + h)) * 4096 + lane * 8;
#pragma unroll
      for (int ks = 0; ks < 8; ++ks) qf[ks] = *(const bf16x8*)(qp + ks * 512); }
    f32x16 o[4];
#pragma unroll
    for (int dt = 0; dt < 4; ++dt)
#pragma unroll
        for (int i = 0; i < 16; ++i) o[dt][i] = 0.f;
    float mrun = -INFINITY, sum = 0.f;
    const bf16_t* vbase = MVT + ((size_t)((b * 4 + h) * 8)) * 4096 + lane * 8;
    const bf16_t* kbase = MK + ((size_t)((b * 4 + h) * 8)) * 4096 + lane * 8;
#pragma unroll 1
    for (int c = 0; c < 4; ++c) {
        f32x16 sc[2]; float mx = -INFINITY;
#pragma unroll
        for (int kt = 0; kt < 2; ++kt) {
            const bf16_t* kp = kbase + (size_t)(c * 2 + kt) * 4096;
            f32x16 acc;
#pragma unroll
            for (int i = 0; i < 16; ++i) acc[i] = 0.f;
#pragma unroll
            for (int ks = 0; ks < 8; ++ks) { const bf16x8 kf = *(const bf16x8*)(kp + ks * 512); acc = MFMA32(kf, qf[ks], acc); }
#pragma unroll
            for (int i = 0; i < 16; ++i) { sc[kt][i] = acc[i] * (QSCALE * LOG2E); mx = fmaxf(mx, sc[kt][i]); }
            asm volatile("" ::: "memory");
        }
        mx = fmaxf(mx, xor32f(mx));
        const float mnew = fmaxf(mrun, mx); const float f = __builtin_amdgcn_exp2f(mrun - mnew);
        sum *= f;
#pragma unroll
        for (int dt = 0; dt < 4; ++dt)
#pragma unroll
            for (int i = 0; i < 16; ++i) o[dt][i] *= f;
        mrun = mnew;
        float ps = 0.f;
#pragma unroll
        for (int kt = 0; kt < 2; ++kt)
#pragma unroll
            for (int i = 0; i < 16; ++i) { sc[kt][i] = __builtin_amdgcn_exp2f(sc[kt][i] - mnew); ps += sc[kt][i]; }
        ps += xor32f(ps); sum += ps;
#pragma unroll
        for (int kt = 0; kt < 2; ++kt)
#pragma unroll
            for (int s = 0; s < 2; ++s) {
                const bf16x8 pb = pack8(sc[kt], s);
#pragma unroll
                for (int dt = 0; dt < 4; ++dt) { const bf16x8 va = *(const bf16x8*)(vbase + (size_t)(c * 2 + kt) * 4096 + (dt * 2 + s) * 512); o[dt] = MFMA32(va, pb, o[dt]); }
                asm volatile("" ::: "memory");
            }
    }
    const float inv = 1.f / sum;
    bf16_t* op = BR + rowq * 1536 + 1024 + h * 128 + 4 * hi;
#pragma unroll
    for (int dt = 0; dt < 4; ++dt)
#pragma unroll
        for (int a = 0; a < 4; ++a) { u32x2 w; w.x = cvtpk(o[dt][4 * a] * inv, o[dt][4 * a + 1] * inv); w.y = cvtpk(o[dt][4 * a + 2] * inv, o[dt][4 * a + 3] * inv); *(u32x2*)(op + 32 * dt + 8 * a) = w; }
}

constexpr int HG_SCH = 4, HG_UPS = S / 64 / HG_SCH  , HG_UNITS = BPP * 4 * HG_UPS  ;
constexpr int HG_ROW = 136, HG_KT_ROW = 72;
constexpr int HG_KP = 0, HG_QP = 64 * HG_ROW * 2, HG_QPP = 2 * HG_QP, HG_KPPT = 3 * HG_QP, HG_DEC = HG_KPPT + 128 * HG_KT_ROW * 2, HG_SSQ = HG_DEC + 512, HG_PSUM = HG_SSQ + 1024, HG_UNIT_BYTES = HG_PSUM + 2048;
DI bf16x8 lds_ld2x8(const LAS unsigned char* p) {
    const s16x4 lo = *(const LAS s16x4*)p, hi4 = *(const LAS s16x4*)(p + 16);
    return __builtin_shufflevector(lo, hi4, 0, 1, 2, 3, 4, 5, 6, 7);
}
DI int opq(int x) { asm volatile("" : "+v"(x)); return x; }
DI float lds_bf(const LAS unsigned char* p) { return __uint_as_float((unsigned)(*(const LAS unsigned short*)p) << 16); }
template <bool MAIN>
DI void hgrn_unit(LAS unsigned char* ul, int unit, int u, const bf16_t* __restrict__ HFQG, const bf16_t* __restrict__ IT, const float* __restrict__ lbv, const float* __restrict__ nwv,
                  float* HSTL, float* HSTD, const float* __restrict__ SIN, bf16_t* __restrict__ BR) {
    constexpr int NX = MAIN ? 4 : 2;
    const int lane = u & 63, w = u >> 6, r32 = lane & 31, hi = lane >> 5, dvt = w & 3, wh = w >> 2;
    const int seq = unit / HG_UPS, j = unit % HG_UPS, lb = seq >> 2, h = seq & 3;
    const int dk = u & 127, qt = u >> 7, cb = 16 * qt;
    const float lbd = lbv[h * 128 + dk];
    const size_t row0 = (size_t)lb * S + (size_t)j * (64 * HG_SCH);
    LAS unsigned char* Kp = ul + HG_KP; LAS unsigned char* Qp = ul + HG_QP; LAS unsigned char* Qpp = ul + HG_QPP; LAS unsigned char* KppT = ul + HG_KPPT;
    LAS float* dec = (LAS float*)(ul + HG_DEC); LAS float* ssq = (LAS float*)(ul + HG_SSQ); LAS float* psum = (LAS float*)(ul + HG_PSUM);
    const int dk0 = MAIN ? 0 : 64 * wh;
    f32x16 X[NX];
    if (MAIN) {
        const float* Sp = SIN + (size_t)unit * 16384 + 32 * dvt + r32;
#pragma unroll
        for (int t = 0; t < NX; ++t)
#pragma unroll
            for (int i = 0; i < 16; ++i) X[t][i] = Sp[(size_t)(32 * t + crow(i, hi)) * 128];
    } else {
#pragma unroll
        for (int t = 0; t < NX; ++t)
#pragma unroll
            for (int i = 0; i < 16; ++i) X[t][i] = 0.f;
    }
    float atot = 0.f;
#pragma unroll 1
    for (int ch = 0; ch < HG_SCH; ++ch) {
        const size_t rc = row0 + (size_t)ch * 64;
        {
            const int sc0 = opq(u) >> 4, sch = (opq(u) & 15) * 8;
            const bf16_t* fp = HFQG + (rc + sc0) * 1536 + h * 128 + sch;
            u32x4 sf[2], sq[2];
#pragma unroll
            for (int i = 0; i < 2; ++i) { sf[i] = *(const u32x4*)(fp + (size_t)(32 * i) * 1536); if (MAIN) sq[i] = *(const u32x4*)(fp + (size_t)(32 * i) * 1536 + 512); }
#pragma unroll
            for (int i = 0; i < 2; ++i) { *(LAS u32x4*)(Kp + ((sc0 + 32 * i) * HG_ROW + sch) * 2) = sf[i]; if (MAIN) *(LAS u32x4*)(Qp + ((sc0 + 32 * i) * HG_ROW + sch) * 2) = sq[i]; }
        }
        __syncthreads();
        {
            float s = 0.f;
#pragma unroll
            for (int i = 0; i < 16; ++i) s += __builtin_amdgcn_logf(lbd + (1.f - lbd) * fast_sigmoid(lds_bf(Kp + ((cb + i) * HG_ROW + dk) * 2)));
            psum[qt * 128 + dk] = s;
        }
        __syncthreads();
        {
            const float p0 = psum[dk], p1 = psum[128 + dk], p2 = psum[256 + dk], p3 = psum[384 + dk];
            const float amid = p0 + p1, alast = (p0 + p1) + (p2 + p3);
            float run = qt == 0 ? 0.f : (qt == 1 ? p0 : (qt == 2 ? amid : amid + p2));
            atot += alast;
#pragma unroll 1
            for (int c8 = 0; c8 < 2; ++c8) {
                float kt[8];
#pragma unroll
                for (int e = 0; e < 8; ++e) { const int c = cb + 8 * c8 + e; const float f = lbd + (1.f - lbd) * fast_sigmoid(lds_bf(Kp + (c * HG_ROW + dk) * 2)); run += __builtin_amdgcn_logf(f); const float key = 1.f - f;
                    kt[e] = key * __builtin_amdgcn_exp2f(alast - run);
                    if (MAIN) { *(LAS bf16_t*)(Kp + (c * HG_ROW + dk) * 2) = f2bf(key * __builtin_amdgcn_exp2f(amid - run));
                        const float q = lds_bf(Qp + (c * HG_ROW + dk) * 2);
                        *(LAS bf16_t*)(Qp + (c * HG_ROW + dk) * 2) = f2bf(q * __builtin_amdgcn_exp2f(run - amid));
                        *(LAS bf16_t*)(Qpp + (c * HG_ROW + dk) * 2) = f2bf(q * __builtin_amdgcn_exp2f(run)); } }
                u32x4 wv; wv.x = cvtpk(kt[0], kt[1]); wv.y = cvtpk(kt[2], kt[3]); wv.z = cvtpk(kt[4], kt[5]); wv.w = cvtpk(kt[6], kt[7]);
                *(LAS u32x4*)(KppT + (dk * HG_KT_ROW + cb + 8 * c8) * 2) = wv;
            }
            if (qt == 0) dec[dk] = __builtin_amdgcn_exp2f(alast);
        }
        __syncthreads();
        f32x16 o;
        const bf16_t* itrow = IT + (size_t)(h * 128 + 32 * dvt + opq(r32)) * MP;
        if (MAIN) {
#pragma unroll
            for (int i = 0; i < 16; ++i) o[i] = 0.f;
            const LAS unsigned char* qrow = Qpp + ((32 * wh + r32) * HG_ROW) * 2;
#pragma unroll
            for (int t = 0; t < 4; ++t)
#pragma unroll
                for (int step = 0; step < 2; ++step) { o = MFMA32(pack8(X[t], step), lds_ld2x8(qrow + (32 * t + 16 * step + 4 * hi) * 2), o); }
            __builtin_amdgcn_sched_barrier(0);
            const int r32m = opq(r32);
            const LAS unsigned char* qprow = Qp + ((32 * wh + r32) * HG_ROW) * 2;
            {
                f32x16 sc;
#pragma unroll
                for (int i = 0; i < 16; ++i) sc[i] = 0.f;
#pragma unroll
                for (int ks = 0; ks < 8; ++ks) { const int cof = (16 * ks + 8 * hi) * 2; sc = MFMA32(*(const LAS bf16x8*)(Kp + (r32 * HG_ROW) * 2 + cof), *(const LAS bf16x8*)(qprow + cof), sc); }
                if (wh == 0) {
#pragma unroll
                    for (int i = 0; i < 16; ++i) sc[i] = (crow(i, hi) <= r32m) ? sc[i] : 0.f;
                }
#pragma unroll
                for (int step = 0; step < 2; ++step) o = MFMA32(ldvt(itrow + rc + 16 * step + 4 * hi), pack8(sc, step), o);
                __builtin_amdgcn_sched_barrier(0);
            }
            if (wh == 1) {
                f32x16 sc;
#pragma unroll
                for (int i = 0; i < 16; ++i) sc[i] = 0.f;
#pragma unroll
                for (int ks = 0; ks < 8; ++ks) { const int cof = (16 * ks + 8 * hi) * 2; sc = MFMA32(*(const LAS bf16x8*)(Kp + ((32 + r32) * HG_ROW) * 2 + cof), *(const LAS bf16x8*)(qprow + cof), sc); }
#pragma unroll
                for (int i = 0; i < 16; ++i) sc[i] = (crow(i, hi) <= r32m) ? sc[i] : 0.f;
#pragma unroll
                for (int step = 0; step < 2; ++step) o = MFMA32(ldvt(itrow + rc + 32 + 16 * step + 4 * hi), pack8(sc, step), o);
                __builtin_amdgcn_sched_barrier(0);
            }
        }
        {
            bf16x8 ib[4];
#pragma unroll
            for (int ks = 0; ks < 4; ++ks) ib[ks] = *(const bf16x8*)(itrow + rc + 16 * ks + 8 * hi);
#pragma unroll
            for (int t = 0; t < NX; ++t) {
#pragma unroll
                for (int i = 0; i < 16; ++i) X[t][i] *= dec[dk0 + 32 * t + crow(i, hi)];
#pragma unroll
                for (int ks = 0; ks < 4; ++ks) { const bf16x8 ka = *(const LAS bf16x8*)(KppT + ((dk0 + 32 * t + r32) * HG_KT_ROW + 16 * ks + 8 * hi) * 2); X[t] = MFMA32(ka, ib[ks], X[t]); }
                __builtin_amdgcn_sched_barrier(0);
            }
        }
        if (MAIN) {
            float q2 = 0.f;
#pragma unroll
            for (int i = 0; i < 16; ++i) q2 += o[i] * o[i];
            q2 += xor32f(q2); if (hi == 0) ssq[dvt * 64 + 32 * wh + r32] = q2;
        }
        __syncthreads();
        if (MAIN) {
            const int r32o = opq(r32), hio = opq(hi);
            const int c = 32 * wh + r32o; const float tot = ssq[c] + ssq[64 + c] + ssq[128 + c] + ssq[192 + c];
            const float rs = rsqrtf(tot * (1.f / 128.f) + LN_EPS);
            const size_t row = rc + c; const int col = h * 128 + 32 * dvt + 4 * hio;
#pragma unroll
            for (int a4 = 0; a4 < 4; ++a4) {
                const u32x2 gw = *(const u32x2*)(HFQG + row * 1536 + 1024 + col + 8 * a4); const f32x4 nw4 = *(const f32x4*)(nwv + col + 8 * a4);
                const float g0 = __uint_as_float(gw.x << 16), g1 = __uint_as_float(gw.x & 0xffff0000u), g2 = __uint_as_float(gw.y << 16), g3 = __uint_as_float(gw.y & 0xffff0000u);
                const float v0 = o[4 * a4] * rs * nw4[0] * g0 * fast_sigmoid(g0), v1 = o[4 * a4 + 1] * rs * nw4[1] * g1 * fast_sigmoid(g1);
                const float v2 = o[4 * a4 + 2] * rs * nw4[2] * g2 * fast_sigmoid(g2), v3 = o[4 * a4 + 3] * rs * nw4[3] * g3 * fast_sigmoid(g3);
                u32x2 wv; wv.x = cvtpk(v0, v1); wv.y = cvtpk(v2, v3);
                *(u32x2*)(BR + row * 1536 + 512 + col + 8 * a4) = wv;
            }
        }
    }
    if (!MAIN) {
        float* L = HSTL + (size_t)unit * 16384 + 32 * dvt + r32;
#pragma unroll
        for (int t = 0; t < NX; ++t)
#pragma unroll
            for (int i = 0; i < 16; ++i) L[(size_t)(dk0 + 32 * t + crow(i, hi)) * 128] = X[t][i];
        if (qt == 0) HSTD[(size_t)unit * 128 + dk] = __builtin_amdgcn_exp2f(atot);
    }
}
DI void hgrn_scan(const float* __restrict__ HSTL, const float* __restrict__ HSTD, float* __restrict__ SIN, int gt) {
    if (gt >= BPP * 4 * 16384) return;
    const int seq = gt >> 14, el = gt & 16383, dkk = el >> 7;
    float st = 0.f;
    for (int j = 0; j < HG_UPS; ++j) { const size_t uo = (size_t)(seq * HG_UPS + j); SIN[uo * 16384 + el] = st; st = HSTD[uo * 128 + dkk] * st + HSTL[uo * 16384 + el]; }
}

struct SchedRows {
    unsigned A, B; int K, nN, nU, G, c;
    DI bool next(int i, g8::Unit& u) const {
        const int L = i * G + c; if (L >= nU) return false;
        const int x = L & 7, off = L >> 3, grp = off / (8 * nN), o2 = off % (8 * nN);
        const int ppx = nU / nN / 8;
        u.pm = x * ppx + 8 * grp + (o2 & 7); u.pn = o2 >> 3; u.kind = 0; u.dlb = 1;
        u.a = A + (unsigned)u.pm * 256u * K * 2u; u.b = B + (unsigned)u.pn * 256u * K * 2u; return true;
    }
};
DI void unpack8(const u32x4 w, float (&f)[8]) {
    f[0] = __uint_as_float(w.x << 16); f[1] = __uint_as_float(w.x & 0xffff0000u); f[2] = __uint_as_float(w.y << 16); f[3] = __uint_as_float(w.y & 0xffff0000u);
    f[4] = __uint_as_float(w.z << 16); f[5] = __uint_as_float(w.z & 0xffff0000u); f[6] = __uint_as_float(w.w << 16); f[7] = __uint_as_float(w.w & 0xffff0000u);
}
struct EpiWidenF {
    static constexpr bool PERM = true, HOOK = true;
    const bf16_t* GATE; bf16_t* MERGED;
    DI void hook(f32x4 (&acc)[2][2][4][2], const g8::Unit& u, int t, int wr, int wc, int fr, int fq) const {
        if (t != 8 && t != 16) return;
        const int g = (t >> 3) - 1;
        const int row0 = u.pm * 256 + wr * 64 + fr, col0 = u.pn * 256 + wc * 32 + 8 * fq;
#pragma unroll
        for (int ai = 0; ai < 2; ++ai)
#pragma unroll
            for (int m = 0; m < 4; ++m) { const bf16_t* gp = GATE + (size_t)(row0 + ai * 128 + m * 16) * 3072 + g * 1024 + col0;
#pragma unroll
                for (int bj = 0; bj < 2; ++bj) { float ga[8], gb[8]; unpack8(*(const u32x4*)(gp + bj * 128), ga); unpack8(*(const u32x4*)(gp + 1024 + bj * 128), gb);
#pragma unroll
                    for (int e = 0; e < 4; ++e) { acc[ai][bj][m][0][e] *= ga[e] * __builtin_amdgcn_rcpf(gb[e]); acc[ai][bj][m][1][e] *= ga[4 + e] * __builtin_amdgcn_rcpf(gb[4 + e]); } } }
    }
    DI void operator()(const f32x4 (&acc)[2][2][4][2], const g8::Unit& u, int wr, int wc, int fr, int fq) const {
        const int row0 = u.pm * 256 + wr * 64 + fr, col0 = u.pn * 256 + wc * 32 + 8 * fq;
#pragma unroll
        for (int ai = 0; ai < 2; ++ai)
#pragma unroll
            for (int m = 0; m < 4; ++m) { const size_t row = (size_t)(row0 + ai * 128 + m * 16);
#pragma unroll
                for (int bj = 0; bj < 2; ++bj) { float gc[8]; unpack8(*(const u32x4*)(GATE + row * 3072 + 2048 + col0 + bj * 128), gc);
                    const f32x4 v0 = acc[ai][bj][m][0], v1 = acc[ai][bj][m][1];
                    u32x4 w; w.x = cvtpk(v0[0] * gc[0], v0[1] * gc[1]); w.y = cvtpk(v0[2] * gc[2], v0[3] * gc[3]); w.z = cvtpk(v1[0] * gc[4], v1[1] * gc[5]); w.w = cvtpk(v1[2] * gc[6], v1[3] * gc[7]);
                    *(u32x4*)(MERGED + row * 1024 + col0 + bj * 128) = w; } }
    }
};
struct EpiMixF32 {
    static constexpr bool PERM = false, HOOK = false;
    float* C;
    DI void hook(f32x4 (&)[2][2][4][2], const g8::Unit&, int, int, int, int, int) const {}
    DI void operator()(const f32x4 (&acc)[2][2][4][2], const g8::Unit& u, int wr, int wc, int fr, int fq) const {
        const int col0 = u.pn * 256 + wc * 32 + 4 * fq;
#pragma unroll
        for (int ai = 0; ai < 2; ++ai)
#pragma unroll
            for (int m = 0; m < 4; ++m) { float* rp = C + (size_t)(u.pm * 256 + ai * 128 + wr * 64 + m * 16 + fr) * 1024 + col0;
#pragma unroll
                for (int bj = 0; bj < 2; ++bj)
#pragma unroll
                    for (int n = 0; n < 2; ++n) *(f32x4*)(rp + bj * 128 + n * 16) = acc[ai][bj][m][n]; }
    }
};
struct EpiPlainB16 {
    static constexpr bool PERM = true, HOOK = false;
    bf16_t* C; int ldc, pad;
    DI void hook(f32x4 (&)[2][2][4][2], const g8::Unit&, int, int, int, int, int) const {}
    DI void operator()(const f32x4 (&acc)[2][2][4][2], const g8::Unit& u, int wr, int wc, int fr, int fq) const {
        const int row0 = u.pm * 256 + wr * 64 + fr, col0 = u.pn * 256 + wc * 32 + 8 * fq;
#pragma unroll
        for (int ai = 0; ai < 2; ++ai)
#pragma unroll
            for (int m = 0; m < 4; ++m) { bf16_t* rowp = C + (size_t)(row0 + ai * 128 + m * 16) * ldc + col0;
#pragma unroll
                for (int bj = 0; bj < 2; ++bj) { const f32x4 v0 = acc[ai][bj][m][0], v1 = acc[ai][bj][m][1];
                    u32x4 w; w.x = cvtpk(v0[0], v0[1]); w.y = cvtpk(v0[2], v0[3]); w.z = cvtpk(v1[0], v1[1]); w.w = cvtpk(v1[2], v1[3]);
                    *(u32x4*)(rowp + bj * 128) = w; } }
    }
};
DI void lse_merge_items(const bf16_t* __restrict__ OG, const float* __restrict__ LSE, bf16_t* __restrict__ BR, int first, int stride) {
    for (int it = first; it < MP * 64; it += stride) {
        const int row = it >> 6, c8 = it & 63, h = c8 >> 4;
        const float l0 = LSE[(size_t)row * 12 + h], l1 = LSE[(size_t)row * 12 + 4 + h], l2 = LSE[(size_t)row * 12 + 8 + h];
        const float mx = fmaxf(l0, fmaxf(l1, l2)); const float e0 = __expf(l0 - mx), e1 = __expf(l1 - mx), e2 = __expf(l2 - mx); const float inv = 1.f / (e0 + e1 + e2);
        const bf16_t* og = OG + (size_t)row * 1536 + c8 * 8;
        float a[8], b[8], c[8]; unpack8(*(const u32x4*)og, a); unpack8(*(const u32x4*)(og + 512), b); unpack8(*(const u32x4*)(og + 1024), c);
        float r[8];
#pragma unroll
        for (int e = 0; e < 8; ++e) r[e] = (e0 * a[e] + e1 * b[e] + e2 * c[e]) * inv;
        u32x4 w; w.x = cvtpk(r[0], r[1]); w.y = cvtpk(r[2], r[3]); w.z = cvtpk(r[4], r[5]); w.w = cvtpk(r[6], r[7]);
        *(u32x4*)(BR + (size_t)row * 1536 + c8 * 8) = w;
    }
}
DI void ln1_rows(const float* __restrict__ x, const bf16_t* __restrict__ mix, const float* __restrict__ g, const float* __restrict__ b, bf16_t* __restrict__ h1b, int wave0, int nwaves, int lane) {
    for (int row = wave0; row < MP; row += nwaves) {
        const f32x4* xr = (const f32x4*)(x + (size_t)row * D + 16 * lane);
        const u32x4 ma = *(const u32x4*)(mix + (size_t)row * D + 16 * lane), mb = *(const u32x4*)(mix + (size_t)row * D + 16 * lane + 8);
        float mf[16]; unpack8(ma, *(float(*)[8])&mf[0]); unpack8(mb, *(float(*)[8])&mf[8]);
        f32x4 v[4]; float s = 0.f;
#pragma unroll
        for (int j = 0; j < 4; ++j) { v[j] = xr[j] * ALPHA;
#pragma unroll
            for (int e = 0; e < 4; ++e) { v[j][e] += mf[4 * j + e]; s += v[j][e]; } }
        const float mean = wave_sum(s) * (1.f / D); float q = 0.f;
#pragma unroll
        for (int j = 0; j < 4; ++j) { v[j] = v[j] - mean; q += (v[j][0] * v[j][0] + v[j][1] * v[j][1]) + (v[j][2] * v[j][2] + v[j][3] * v[j][3]); }
        const float rstd = rsqrtf(wave_sum(q) * (1.f / D) + LN_EPS);
        u32x4 o0, o1;
#pragma unroll
        for (int j = 0; j < 4; ++j) { const f32x4 gg = *(const f32x4*)(g + 16 * lane + 4 * j), bb = *(const f32x4*)(b + 16 * lane + 4 * j); const f32x4 o = v[j] * rstd * gg + bb;
            if (j < 2) { o0[2 * j] = cvtpk(o[0], o[1]); o0[2 * j + 1] = cvtpk(o[2], o[3]); } else { o1[2 * (j - 2)] = cvtpk(o[0], o[1]); o1[2 * (j - 2) + 1] = cvtpk(o[2], o[3]); } }
        *(u32x4*)(h1b + (size_t)row * D + 16 * lane) = o0; *(u32x4*)(h1b + (size_t)row * D + 16 * lane + 8) = o1;
    }
}

DI unsigned mono(float f) { const unsigned u = __float_as_uint(f); return (u & 0x80000000u) ? ~u : (u | 0x80000000u); }
DI float demono(unsigned m) { return __uint_as_float((m & 0x80000000u) ? (m & 0x7fffffffu) : ~m); }
#define CE_DESC(a, b) do { const unsigned _hi = (a) > (b) ? (a) : (b), _lo = (a) > (b) ? (b) : (a); (a) = _hi; (b) = _lo; } while (0)
DI void sort16_desc(unsigned (&k)[16]) {
#pragma unroll
    for (int size = 2; size <= 16; size <<= 1)
#pragma unroll
        for (int stride = size >> 1; stride > 0; stride >>= 1)
#pragma unroll
            for (int i = 0; i < 16; ++i) { const int j = i ^ stride;
                if (j > i) { if ((i & size) == 0 || size == 16) CE_DESC(k[i], k[j]); else CE_DESC(k[j], k[i]); } }
}
DI void merge_top16(unsigned (&t)[16], const unsigned (&l)[16]) {
#pragma unroll
    for (int i = 0; i < 16; ++i) t[i] = t[i] > l[15 - i] ? t[i] : l[15 - i];
#pragma unroll
    for (int stride = 8; stride > 0; stride >>= 1)
#pragma unroll
        for (int i = 0; i < 16; ++i) { const int j = i ^ stride; if (j > i) CE_DESC(t[i], t[j]); }
}
constexpr int RT_ROW = 136;
constexpr int RT_LDS_BYTES = 2 * 128 * RT_ROW * 2;
DI void route_wave(const bf16_t* __restrict__ PQ, const LAS unsigned char* keys, int* __restrict__ IDX, float* __restrict__ PG, int tb, int h, int lane) {
    const int r32 = lane & 31, hi = lane >> 5;
    const size_t tok = (size_t)tb * 32 + r32;
    unsigned Tp[2][16];
#pragma unroll
    for (int p = 0; p < 2; ++p) {
        bf16x8 qf[8];
        const bf16_t* qp = PQ + tok * 2048 + h * 256 + p * 128 + 8 * hi;
#pragma unroll
        for (int ks = 0; ks < 8; ++ks) qf[ks] = *(const bf16x8*)(qp + 16 * ks);
#pragma unroll
        for (int nt = 0; nt < 4; ++nt) {
            f32x16 acc;
#pragma unroll
            for (int i = 0; i < 16; ++i) acc[i] = 0.f;
#pragma unroll
            for (int ks = 0; ks < 8; ++ks) { const bf16x8 kf = *(const LAS bf16x8*)(keys + ((p * 128 + 32 * nt + r32) * RT_ROW + 16 * ks + 8 * hi) * 2); acc = MFMA32(kf, qf[ks], acc); }
            unsigned L[16];
#pragma unroll
            for (int i = 0; i < 16; ++i) L[i] = (mono(acc[i]) & ~0x7fu) | (unsigned)(127 - (32 * nt + crow(i, hi)));
            sort16_desc(L);
            if (nt == 0) {
#pragma unroll
                for (int i = 0; i < 16; ++i) Tp[p][i] = L[i];
            } else merge_top16(Tp[p], L);
            __builtin_amdgcn_sched_barrier(0);
        }
    }
    unsigned T[16];
    { unsigned O[16];
#pragma unroll
      for (int i = 0; i < 16; ++i) { const auto rr = __builtin_amdgcn_permlane32_swap(Tp[0][i], Tp[1][i], false, false); T[i] = rr[0]; O[i] = rr[1]; }
      merge_top16(T, O); }
    __builtin_amdgcn_sched_barrier(0);
    float s1[16], s2[16]; unsigned i1[16], i2[16];
#pragma unroll
    for (int i = 0; i < 16; ++i) { const auto rr = __builtin_amdgcn_permlane32_swap(T[i], T[i], false, false);
        s1[i] = demono(rr[0] & ~0x7fu); i1[i] = 127u - (rr[0] & 0x7fu); s2[i] = demono(rr[1] & ~0x7fu); i2[i] = 127u - (rr[1] & 0x7fu); }
    unsigned C[64];
    { int n = 0;
#pragma unroll
      for (int a = 0; a < 16; ++a)
#pragma unroll
          for (int b = 0; b < 16; ++b) if ((a + 1) * (b + 1) <= 16) { C[n] = (mono(s1[a] + s2[b]) & ~0x3fffu) | (i1[a] << 7) | i2[b]; ++n; }
#pragma unroll
      for (int i = 50; i < 64; ++i) C[i] = 0u; }
    unsigned F[16];
#pragma unroll
    for (int i = 0; i < 16; ++i) F[i] = C[i];
    sort16_desc(F);
#pragma unroll
    for (int g = 1; g < 4; ++g) { unsigned L[16];
#pragma unroll
        for (int i = 0; i < 16; ++i) L[i] = C[16 * g + i];
        sort16_desc(L); merge_top16(F, L); __builtin_amdgcn_sched_barrier(0); }
    if (hi == 0) {
        float e[16]; float sum = 0.f; const float v0 = demono(F[0] & ~0x3fffu);
#pragma unroll
        for (int i = 0; i < 16; ++i) { e[i] = __expf(demono(F[i] & ~0x3fffu) - v0); sum += e[i]; }
        const float inv = 1.f / sum;
        int* ip = IDX + tok * 128 + h * 16; float* gp = PG + tok * 128 + h * 16;
#pragma unroll
        for (int q = 0; q < 4; ++q) { u32x4 iv; iv.x = F[4 * q] & 0x3fffu; iv.y = F[4 * q + 1] & 0x3fffu; iv.z = F[4 * q + 2] & 0x3fffu; iv.w = F[4 * q + 3] & 0x3fffu; *(u32x4*)(ip + 4 * q) = iv;
            f32x4 gv; gv[0] = e[4 * q] * inv; gv[1] = e[4 * q + 1] * inv; gv[2] = e[4 * q + 2] * inv; gv[3] = e[4 * q + 3] * inv; *(f32x4*)(gp + 4 * q) = gv; }
    }
}
typedef __bf16 bf16x2v __attribute__((ext_vector_type(2)));
DI float dot2bf(unsigned w, unsigned x, float acc) { return __builtin_amdgcn_fdot2_f32_bf16(__builtin_bit_cast(bf16x2v, w), __builtin_bit_cast(bf16x2v, x), acc, false); }
DI float gelu_erf(float v) {
    const float av = fabsf(v), t = __builtin_amdgcn_rcpf(av * 0.2316418882f + 1.0f);
    float q = t * 0.5307027145f + (-0.7265760135f); q = q * t + 0.7107068705f; q = q * t + (-0.142248368f); q = q * t + 0.127414796f; q = q * t;
    const float e = __builtin_amdgcn_exp2f((v * v) * (-0.72134752044f)); const float m = v * (q * e);
    return v < 0.f ? m : v - m;
}
DI float dppf(float v, const int ctrl_sel) {
    const int s = __float_as_int(v);
    int r;
    if (ctrl_sel == 0) r = __builtin_amdgcn_update_dpp(0, s, 0xB1, 0xF, 0xF, true);
    else if (ctrl_sel == 1) r = __builtin_amdgcn_update_dpp(0, s, 0x4E, 0xF, 0xF, true);
    else if (ctrl_sel == 2) r = __builtin_amdgcn_update_dpp(0, s, 0x141, 0xF, 0xF, true);
    else r = __builtin_amdgcn_update_dpp(0, s, 0x128, 0xF, 0xF, true);
    return __int_as_float(r);
}
template <int NT>
DI void experts_u_slice(const bf16_t* __restrict__ H1B, const unsigned char* __restrict__ U8x, const int* __restrict__ IDX, bf16_t* __restrict__ PD, size_t tok, int x, int lane) {
    const int g = lane >> 3, l8 = lane & 7;
    u32x4 ha[NT], hb[NT], iv[NT][4], w[NT][16];
#pragma unroll
    for (int t = 0; t < NT; ++t) { ha[t] = *(const u32x4*)(H1B + (tok + t) * D + 128 * x + 16 * l8); hb[t] = *(const u32x4*)(H1B + (tok + t) * D + 128 * x + 16 * l8 + 8);
#pragma unroll
        for (int q = 0; q < 4; ++q) iv[t][q] = *(const u32x4*)(IDX + (tok + t) * 128 + 16 * g + 4 * q); }
#pragma unroll
    for (int t = 0; t < NT; ++t)
#pragma unroll
        for (int j = 0; j < 16; ++j) w[t][j] = *(const u32x4*)(U8x + (size_t)(iv[t][j >> 2][j & 3] * 128u + 16u * l8));
#pragma unroll
    for (int t = 0; t < NT; ++t) {
        f32x2 hv[8];
#pragma unroll
        for (int q = 0; q < 4; ++q) { hv[q] = (f32x2){__uint_as_float(ha[t][q] << 16), __uint_as_float(ha[t][q] & 0xffff0000u)}; hv[4 + q] = (f32x2){__uint_as_float(hb[t][q] << 16), __uint_as_float(hb[t][q] & 0xffff0000u)}; }
        float p[16];
#pragma unroll
        for (int j = 0; j < 16; ++j) { f32x2 d2 = {0.f, 0.f};
#pragma unroll
            for (int q = 0; q < 4; ++q) { d2 += __builtin_amdgcn_cvt_pk_f32_fp8((int)w[t][j][q], false) * hv[2 * q]; d2 += __builtin_amdgcn_cvt_pk_f32_fp8((int)w[t][j][q], true) * hv[2 * q + 1]; }
            float s = d2[0] + d2[1]; s += dppf(s, 0); s += dppf(s, 1); s += dppf(s, 2); p[j] = s; }
        if (l8 == 0) {
            u32x4 o0, o1;
            o0.x = cvtpk(p[0], p[1]); o0.y = cvtpk(p[2], p[3]); o0.z = cvtpk(p[4], p[5]); o0.w = cvtpk(p[6], p[7]);
            o1.x = cvtpk(p[8], p[9]); o1.y = cvtpk(p[10], p[11]); o1.z = cvtpk(p[12], p[13]); o1.w = cvtpk(p[14], p[15]);
            bf16_t* dp = PD + ((tok + t) * 8 + x) * 128 + 16 * g; *(u32x4*)dp = o0; *(u32x4*)(dp + 8) = o1;
        }
    }
}
DI void experts_combine(const bf16_t* __restrict__ PD, const int* __restrict__ IDX, const float* __restrict__ PG, const float* __restrict__ USC, const float* __restrict__ VSC, float* __restrict__ C, size_t first, size_t stride) {
    for (size_t i = first; i < (size_t)M * 128; i += stride) {
        const size_t tok = i >> 7; const int e = (int)(i & 127);
        float s = 0.f;
#pragma unroll
        for (int x = 0; x < 8; ++x) s += bf2f(PD[(tok * 8 + x) * 128 + e]);
        const int row = IDX[i];
        C[i] = PG[i] * gelu_erf(s * USC[row]) * VSC[row];
    }
}
template <int NT>
DI void experts_v_slice(const unsigned char* __restrict__ V8x, const int* __restrict__ IDX, const float* __restrict__ C, bf16_t* __restrict__ FFN, size_t tok, int x, int lane) {
    const int g = lane >> 3, l8 = lane & 7;
    u32x4 iv[NT][4], w[NT][16]; f32x4 cv[NT][4];
#pragma unroll
    for (int t = 0; t < NT; ++t)
#pragma unroll
        for (int q = 0; q < 4; ++q) { iv[t][q] = *(const u32x4*)(IDX + (tok + t) * 128 + 16 * g + 4 * q); cv[t][q] = *(const f32x4*)(C + (tok + t) * 128 + 16 * g + 4 * q); }
#pragma unroll
    for (int t = 0; t < NT; ++t)
#pragma unroll
        for (int j = 0; j < 16; ++j) w[t][j] = *(const u32x4*)(V8x + (size_t)(iv[t][j >> 2][j & 3] * 128u + 16u * l8));
#pragma unroll
    for (int t = 0; t < NT; ++t) {
        f32x2 f2[8];
#pragma unroll
        for (int i = 0; i < 8; ++i) f2[i] = (f32x2){0.f, 0.f};
#pragma unroll
        for (int j = 0; j < 16; ++j) { const float c = cv[t][j >> 2][j & 3]; const f32x2 c2 = {c, c};
#pragma unroll
            for (int q = 0; q < 4; ++q) { f2[2 * q] += c2 * __builtin_amdgcn_cvt_pk_f32_fp8((int)w[t][j][q], false); f2[2 * q + 1] += c2 * __builtin_amdgcn_cvt_pk_f32_fp8((int)w[t][j][q], true); } }
#pragma unroll
        for (int i = 0; i < 8; ++i)
#pragma unroll
            for (int k = 0; k < 2; ++k) { float s = f2[i][k]; s += dppf(s, 3); s += __shfl_xor(s, 16); s += __shfl_xor(s, 32); f2[i][k] = s; }
        if (g == 0) {
            u32x4 o0, o1;
            o0.x = cvtpk(f2[0][0], f2[0][1]); o0.y = cvtpk(f2[1][0], f2[1][1]); o0.z = cvtpk(f2[2][0], f2[2][1]); o0.w = cvtpk(f2[3][0], f2[3][1]);
            o1.x = cvtpk(f2[4][0], f2[4][1]); o1.y = cvtpk(f2[5][0], f2[5][1]); o1.z = cvtpk(f2[6][0], f2[6][1]); o1.w = cvtpk(f2[7][0], f2[7][1]);
            bf16_t* dp = FFN + (tok + t) * D + 128 * x + 16 * l8; *(u32x4*)dp = o0; *(u32x4*)(dp + 8) = o1;
        }
    }
}
DI void ln2_token(const bf16_t* __restrict__ FFN, const bf16_t* __restrict__ H1B, const float* __restrict__ g2, const float* __restrict__ b2, float* __restrict__ outp, size_t tok, int lane) {
    float* hr = outp + tok * D + 16 * lane;
    const u32x4 fa = *(const u32x4*)(FFN + tok * D + 16 * lane), fb = *(const u32x4*)(FFN + tok * D + 16 * lane + 8);
    const u32x4 ha = *(const u32x4*)(H1B + tok * D + 16 * lane), hb = *(const u32x4*)(H1B + tok * D + 16 * lane + 8);
    float ff[16], hh[16]; unpack8(fa, *(float(*)[8])&ff[0]); unpack8(fb, *(float(*)[8])&ff[8]); unpack8(ha, *(float(*)[8])&hh[0]); unpack8(hb, *(float(*)[8])&hh[8]);
    f32x4 v[4];
#pragma unroll
    for (int j = 0; j < 4; ++j)
#pragma unroll
        for (int e = 0; e < 4; ++e) v[j][e] = hh[4 * j + e];
    float s = 0.f;
#pragma unroll
    for (int j = 0; j < 4; ++j)
#pragma unroll
        for (int e = 0; e < 4; ++e) { v[j][e] = v[j][e] * ALPHA + ff[4 * j + e]; s += v[j][e]; }
    const float mean = wave_sum(s) * (1.f / D); float q2 = 0.f;
#pragma unroll
    for (int j = 0; j < 4; ++j)
#pragma unroll
        for (int e = 0; e < 4; ++e) { v[j][e] -= mean; q2 += v[j][e] * v[j][e]; }
    const float rstd = rsqrtf(wave_sum(q2) * (1.f / D) + LN_EPS);
#pragma unroll
    for (int j = 0; j < 4; ++j) { const f32x4 gg = *(const f32x4*)(g2 + 16 * lane + 4 * j), bb = *(const f32x4*)(b2 + 16 * lane + 4 * j); *(f32x4*)(hr + 4 * j) = v[j] * rstd * gg + bb; }
}

DI void p0_convert(const float* __restrict__ in, bf16_t* __restrict__ out, size_t n8, size_t first, size_t stride) {
    for (size_t i = first; i < n8; i += stride) { const f32x4 a = ((const f32x4*)in)[2 * i], b = ((const f32x4*)in)[2 * i + 1];
        u32x4 w; w.x = cvtpk(a[0], a[1]); w.y = cvtpk(a[2], a[3]); w.z = cvtpk(b[0], b[1]); w.w = cvtpk(b[2], b[3]); ((u32x4*)out)[i] = w; }
}
DI void p0_transpose_item(const float* __restrict__ W, int ldw, int ncols, bf16_t* __restrict__ out, int ldo, int koff, LAS float* scr, int item, int lane) {
    const int nblk = ncols / 32, kb = item / nblk, nb = item % nblk, k0 = 64 * kb, n0 = 32 * nb;
#pragma unroll 8
    for (int i = 0; i < 32; ++i) { const int kk = 2 * i + (lane >> 5); scr[kk * 33 + (lane & 31)] = W[(size_t)(k0 + kk) * ldw + n0 + (lane & 31)]; }
    asm volatile("s_waitcnt lgkmcnt(0)" ::: "memory");
    const int c = lane & 7;
#pragma unroll
    for (int j = 0; j < 4; ++j) { const int n = (lane >> 3) + 8 * j; const LAS float* s = scr + (8 * c) * 33 + n;
        u32x4 o; o.x = cvtpk(s[0 * 33], s[1 * 33]); o.y = cvtpk(s[2 * 33], s[3 * 33]); o.z = cvtpk(s[4 * 33], s[5 * 33]); o.w = cvtpk(s[6 * 33], s[7 * 33]);
        *(u32x4*)(out + (size_t)(n0 + n) * ldo + koff + k0 + 8 * c) = o; }
    asm volatile("s_waitcnt lgkmcnt(0)" ::: "memory");
}
DI void p0_fp8_row(const float* __restrict__ src, unsigned char* __restrict__ dst, float* __restrict__ scale, int row, int lane) {
    const f32x4* sp = (const f32x4*)(src + (size_t)row * D) + 4 * lane;
    f32x4 v[4]; float mx = 0.f;
#pragma unroll
    for (int j = 0; j < 4; ++j) { v[j] = sp[j]; mx = fmaxf(mx, fmaxf(fmaxf(fabsf(v[j][0]), fabsf(v[j][1])), fmaxf(fabsf(v[j][2]), fabsf(v[j][3])))); }
    mx = wave_max(mx);
    const float sc = mx > 0.f ? 224.f / mx : 1.f;
    u32x4 w;
#pragma unroll
    for (int j = 0; j < 4; ++j) { int p = 0; p = __builtin_amdgcn_cvt_pk_fp8_f32(v[j][0] * sc, v[j][1] * sc, p, false); p = __builtin_amdgcn_cvt_pk_fp8_f32(v[j][2] * sc, v[j][3] * sc, p, true); w[j] = (unsigned)p; }
    *(u32x4*)(dst + (size_t)(lane >> 3) * ((size_t)NEXP * 128) + (size_t)row * 128 + 16 * (lane & 7)) = w;
    if (lane == 0) scale[row] = mx > 0.f ? mx * (1.f / 224.f) : 1.f;
}
DI void p0_misc(const float* __restrict__ hgrn_lb, const float* __restrict__ rel_bias, float* __restrict__ misc, int i) {
    if (i < 512) { const float a = hgrn_lb[i], b = hgrn_lb[512 + i]; const float mx = fmaxf(a, b); const float ea = expf(a - mx), eb = expf(b - mx); misc[i] = ea / (ea + eb); }
    if (i < 3 * 129) {
        const int g = i / 129, j = i % 129; const int dl = g == 0 ? 1 : (g == 1 ? 4 : 16); const int n = j * dl;
        int bucket;
        if (n < 16) bucket = n;
        else { const double v = log((double)n / 16.0) / log(128.0) * 16.0; int l = 16 + (int)v; bucket = l < 31 ? l : 31; }
        for (int h = 0; h < 4; ++h) misc[512 + i * 4 + h] = rel_bias[bucket * 12 + g * 4 + h];
    }
}
struct SchedMemKV {
    unsigned MEMB, W; int G, c;
    DI bool next(int i, g8::Unit& u) const {
        const int L = i * G + c; if (L >= 32) return false;
        u.dlb = 1;
        if (L < 16) { u.kind = 0; u.pm = L >> 1; u.pn = L & 1; u.a = MEMB + (unsigned)u.pm * 256u * D * 2u; u.b = W + (unsigned)u.pn * 256u * D * 2u; }
        else { const int q = L - 16; u.kind = 1; u.pm = q >> 3; u.pn = q & 7; u.a = W + (unsigned)(512 + u.pm * 256) * D * 2u; u.b = MEMB + (unsigned)u.pn * 256u * D * 2u; }
        return true;
    }
};
struct EpiMemKVF {
    static constexpr bool PERM = true, HOOK = false;
    bf16_t *MK, *MVT;
    DI void hook(f32x4 (&)[2][2][4][2], const g8::Unit&, int, int, int, int, int) const {}
    DI void operator()(const f32x4 (&acc)[2][2][4][2], const g8::Unit& u, int wr, int wc, int fr, int fq) const {
        const int rowl = wr * 64 + fr, d0 = wc * 32 + 8 * fq;
#pragma unroll
        for (int ai = 0; ai < 2; ++ai)
#pragma unroll
            for (int m = 0; m < 4; ++m) { const int R = u.pm * 256 + rowl + ai * 128 + m * 16;
#pragma unroll
                for (int bj = 0; bj < 2; ++bj) { const f32x4 v0 = acc[ai][bj][m][0], v1 = acc[ai][bj][m][1];
                    if (u.kind == 0) { const int b = R >> 8, mm = R & 255, h = u.pn * 2 + bj;
                        u32x4 w; w.x = cvtpk(v0[0], v0[1]); w.y = cvtpk(v0[2], v0[3]); w.z = cvtpk(v1[0], v1[1]); w.w = cvtpk(v1[2], v1[3]);
                        *(u32x4*)(MK + ((size_t)((b * 4 + h) * 8 + (mm >> 5))) * 4096 + frag_row_off(d0, mm & 31)) = w; }
                    else { const int h = R >> 7, d = R & 127, c = u.pn * 256 + bj * 128 + d0, b = c >> 8, mm = c & 255, kk = mm & 31;
                        bf16_t* blk = MVT + ((size_t)((b * 4 + h) * 8 + (mm >> 5))) * 4096 + (((d >> 5) * 2 + (kk >> 4)) * 64 + (d & 31)) * 8 + 4 * ((kk >> 3) & 1);
                        u32x2 wa, wb; wa.x = cvtpk(v0[0], v0[1]); wa.y = cvtpk(v0[2], v0[3]); wb.x = cvtpk(v1[0], v1[1]); wb.y = cvtpk(v1[2], v1[3]);
                        *(u32x2*)blk = wa; *(u32x2*)(blk + 32 * 8) = wb; } } }
    }
};

static_assert(HG_UNIT_BYTES <= LDSCTL_OFF, "hgrn LDS");
DI const float* karg_in(int i) { const float* const* kp = (const float* const*)__builtin_amdgcn_kernarg_segment_ptr(); asm volatile("" : "+s"(kp)); return kp[i]; }
DI float* karg_out() { float* const* kp = (float* const*)__builtin_amdgcn_kernarg_segment_ptr(); asm volatile("" : "+s"(kp)); return kp[18]; }
__global__ void __launch_bounds__(NTHR, 2) mega(Args args) {
    extern __shared__ __attribute__((aligned(16))) unsigned char lds_raw[];
    LAS unsigned char* lds = (LAS unsigned char*)lds_raw;
    volatile LAS unsigned* MISC = (volatile LAS unsigned*)(lds + MISC_OFF);
    for (int u = threadIdx.x; u < (LDS_BYTES - LDSCTL_OFF) / 4; u += NTHR) ((LAS unsigned*)(lds + LDSCTL_OFF))[u] = 0u;
    __syncthreads();
    unsigned char* ws = args.ws;
    const int G = gridDim.x;
    const bool ALL = args.ph == PH_ALL;
    XcdBarrier bar; bar.bar = (unsigned*)(ws + O_MISC + 16384); bar.x = 0; bar.st = nullptr;
    if (ALL) bar = xcd_barrier_post((unsigned*)(ws + O_MISC + 16384), MISC + 8);
#ifndef REP_MASK
#define REP_MASK 0
#endif
#define RUN(k) (ALL || args.ph == (k))
#define NREP(k) (((REP_MASK >> (k)) & 1) ? 2 : 1)
#define SEAM() do { if (ALL) xcd_barrier(bar); } while (0)
    for (int rep_ = 0; rep_ < NREP(PH_PRO); ++rep_) if (RUN(PH_PRO)) {
        int tid = threadIdx.x; asm volatile("" : "+v"(tid)); asm volatile("" : "+s"(ws)); int bid = blockIdx.x; asm volatile("" : "+s"(bid));
        const size_t gt = (size_t)bid * NTHR + tid, nth = (size_t)G * NTHR;
        p0_convert(karg_in(0), (bf16_t*)(ws + O_XB), (size_t)M * D / 8, gt, nth);
        p0_convert(karg_in(1), (bf16_t*)(ws + O_MEMB), (size_t)2048 * 1024 / 8, gt, nth);
        p0_convert(karg_in(13), (bf16_t*)(ws + O_SUBK), (size_t)16 * 128 * 128 / 8, gt, nth);
        if (bid == 0) p0_misc(karg_in(6), karg_in(5), (float*)(ws + O_MISC), tid);
        const int wid = __builtin_amdgcn_readfirstlane(tid >> 6), lane = tid & 63;
        LAS float* scr = (LAS float*)(lds + wid * 16384);
        const int gw = bid * NWAVES + wid, ngw = G * NWAVES;
        for (int r = gw; r < 2 * NEXP; r += ngw) {
            if (r < NEXP) p0_fp8_row(karg_in(14), (unsigned char*)(ws + O_UB), (float*)(ws + O_USC), r, lane);
            else p0_fp8_row(karg_in(15), (unsigned char*)(ws + O_VB), (float*)(ws + O_VSC), r - NEXP, lane);
        }
        constexpr int NJ = 13;
        for (int it = gw; ; it += ngw) {
            int r = it; bool done = true;
#pragma unroll
            for (int j = 0; j < NJ; ++j) {
                const int srcc[NJ] = {0, 4608, 5632, 6656, 7168, 3072, 5120, 0, 0, 0, 0, 0, 0};
                const int cnt[NJ] = {3072, 512, 1024, 512, 3072, 1536, 512, 1024, 1024, 1024, 1024, 1024, 2048};
                const int drow[NJ] = {0, 3072, 3584, 4608, 5120, 8192, 9728, 0, 0, 0, 0, 0, 0};
                const int Kj = (j >= 8 && j <= 10) ? 512 : 1024;
                const int items = (Kj / 64) * (cnt[j] / 32);
                if (done && r < items) {
                    const float* W; int ldw; bf16_t* o; int ldo, koff = 0;
                    if (j < 7) { W = karg_in(2) + srcc[j]; ldw = INC; o = (bf16_t*)(ws + O_WIN) + (size_t)drow[j] * 1024; ldo = 1024; }
                    else if (j == 7) { W = karg_in(4); ldw = 1024; o = (bf16_t*)(ws + O_WMKV); ldo = 1024; }
                    else if (j <= 10) { W = karg_in(8) + (size_t)(j - 8) * 512 * 1024; ldw = 1024; o = (bf16_t*)(ws + O_WBR); ldo = 1536; koff = (j - 8) * 512; }
                    else if (j == 11) { W = karg_in(9); ldw = 1024; o = (bf16_t*)(ws + O_WOUT); ldo = 1024; }
                    else { W = karg_in(12); ldw = 2048; o = (bf16_t*)(ws + O_WPQ); ldo = 1024; }
                    p0_transpose_item(W, ldw, cnt[j], o, ldo, koff, scr, r, lane); done = false;
                }
                r -= items;
            }
            if (done) break;
        }
        SEAM();
    }
#pragma unroll 1
    for (int p = (ALL ? 0 : args.pass); p < (ALL ? NPASS : args.pass + 1); ++p) {
        int bid = blockIdx.x; asm volatile("" : "+s"(bid));
        int tid = threadIdx.x; asm volatile("" : "+v"(tid));
        asm volatile("" : "+s"(ws));
        char* pr = (char*)ws + O_PASS;
        const size_t t0 = (size_t)p * MP;
        for (int rep_ = 0; rep_ < NREP(PH_PROJ); ++rep_) if (RUN(PH_PROJ)) {
            asm volatile("" : "+s"(bid)); asm volatile("" : "+v"(tid)); asm volatile("" : "+s"(ws)); pr = (char*)ws + O_PASS;
            SchedP1 Sc{(unsigned)(O_XB + t0 * D * 2), (unsigned)O_WIN, G, bid};
            EpiP1 E{pr, karg_in(3)};
            g8::gemm_phase<EpiP1, SchedP1>(lds, (const char*)ws, D, Sc, E, tid);
            if (p == 0) {
                SchedMemKV S2{(unsigned)O_MEMB, (unsigned)O_WMKV, G, bid};
                EpiMemKVF E2{(bf16_t*)(ws + O_MK), (bf16_t*)(ws + O_MVT)};
                g8::gemm_phase<EpiMemKVF, SchedMemKV>(lds, (const char*)ws, D, S2, E2, tid);
            }
            SEAM();
        }
        for (int rep_ = 0; rep_ < NREP(PH_ATTN); ++rep_) if (RUN(PH_ATTN)) {
            asm volatile("" : "+s"(bid)); asm volatile("" : "+v"(tid)); asm volatile("" : "+s"(ws)); pr = (char*)ws + O_PASS;
            const float* bsrc = (const float*)(ws + O_MISC) + 512; LAS float* btab = (LAS float*)lds;
            for (int i = tid; i < 3 * 129 * 4; i += NTHR) btab[i] = bsrc[i] * LOG2E;
            __syncthreads();
            const int wid = __builtin_amdgcn_readfirstlane(tid >> 6), lane = tid & 63;
            for (int task = bid * NWAVES + wid; task < DIL_TASKS; task += G * NWAVES)
                attn_dil_wave((const bf16_t*)(pr + P_QK), (const bf16_t*)(pr + P_VT), btab, (bf16_t*)(pr + P_OG), (float*)(pr + P_LSE), task, lane);
            for (int task = bid * NWAVES + wid; task < MEM_TASKS; task += G * NWAVES)
                attn_mem_wave((const bf16_t*)(pr + P_MQ), (const bf16_t*)(ws + O_MK), (const bf16_t*)(ws + O_MVT), (bf16_t*)(pr + P_BR), task, p * BPP, lane);
            __syncthreads();
        }
        for (int rep_ = 0; rep_ < NREP(PH_HGPRE); ++rep_) if (RUN(PH_HGPRE)) {
            asm volatile("" : "+s"(bid)); asm volatile("" : "+v"(tid)); asm volatile("" : "+s"(ws)); pr = (char*)ws + O_PASS;
            { const int unit = bid; static_assert(HG_UNITS == 256, "one HGRN unit per workgroup"); if (unit < HG_UNITS) {
                hgrn_unit<false>(lds, unit, tid, (const bf16_t*)(pr + P_HFQG), (const bf16_t*)(pr + P_IT), (const float*)(ws + O_MISC), karg_in(7),
                                 (float*)(pr + P_HSTL), (float*)(pr + P_HSTD), (const float*)(pr + P_SIN), (bf16_t*)(pr + P_BR));
            } }
            SEAM();
        }
        for (int rep_ = 0; rep_ < NREP(PH_HGSCAN); ++rep_) if (RUN(PH_HGSCAN)) {
            asm volatile("" : "+s"(bid)); asm volatile("" : "+v"(tid)); asm volatile("" : "+s"(ws)); pr = (char*)ws + O_PASS;
            hgrn_scan((const float*)(pr + P_HSTL), (const float*)(pr + P_HSTD), (float*)(pr + P_SIN), bid * NTHR + tid);
            lse_merge_items((const bf16_t*)(pr + P_OG), (const float*)(pr + P_LSE), (bf16_t*)(pr + P_BR), bid * NTHR + tid, G * NTHR);
            SEAM();
        }
        for (int rep_ = 0; rep_ < NREP(PH_HGMAIN); ++rep_) if (RUN(PH_HGMAIN)) {
            asm volatile("" : "+s"(bid)); asm volatile("" : "+v"(tid)); asm volatile("" : "+s"(ws)); pr = (char*)ws + O_PASS;
            { const int unit = bid; static_assert(HG_UNITS == 256, "one HGRN unit per workgroup"); if (unit < HG_UNITS) {
                hgrn_unit<true>(lds, unit, tid, (const bf16_t*)(pr + P_HFQG), (const bf16_t*)(pr + P_IT), (const float*)(ws + O_MISC), karg_in(7),
                                (float*)(pr + P_HSTL), (float*)(pr + P_HSTD), (const float*)(pr + P_SIN), (bf16_t*)(pr + P_BR));
            } }
            SEAM();
        }
        for (int rep_ = 0; rep_ < NREP(PH_WIDEN); ++rep_) if (RUN(PH_WIDEN)) {
            asm volatile("" : "+s"(bid)); asm volatile("" : "+v"(tid)); asm volatile("" : "+s"(ws)); pr = (char*)ws + O_PASS;
            SchedRows Sc{(unsigned)(O_PASS + P_BR), (unsigned)O_WBR, 1536, 4, 256, G, bid};
            EpiWidenF E{(const bf16_t*)(pr + P_GATE), (bf16_t*)(pr + P_MERGED)};
            g8::gemm_phase<EpiWidenF, SchedRows>(lds, (const char*)ws, 1536, Sc, E, tid);
            SEAM();
        }
        for (int rep_ = 0; rep_ < NREP(PH_WOUT); ++rep_) if (RUN(PH_WOUT)) {
            asm volatile("" : "+s"(bid)); asm volatile("" : "+v"(tid)); asm volatile("" : "+s"(ws)); pr = (char*)ws + O_PASS;
            SchedRows Sc{(unsigned)(O_PASS + P_MERGED), (unsigned)O_WOUT, 1024, 4, 256, G, bid};
            EpiPlainB16 E{(bf16_t*)(pr + P_MIX), 1024, 0};
            g8::gemm_phase<EpiPlainB16, SchedRows>(lds, (const char*)ws, 1024, Sc, E, tid);
            SEAM();
        }
        for (int rep_ = 0; rep_ < NREP(PH_LN1); ++rep_) if (RUN(PH_LN1)) {
            asm volatile("" : "+s"(bid)); asm volatile("" : "+v"(tid)); asm volatile("" : "+s"(ws)); pr = (char*)ws + O_PASS;
            ln1_rows(karg_in(0) + t0 * D, (const bf16_t*)(pr + P_MIX), karg_in(10), karg_in(11), (bf16_t*)(ws + O_H1B) + t0 * D, bid * NWAVES + (tid >> 6), G * NWAVES, tid & 63);
        }
    }
    for (int rep_ = 0; rep_ < NREP(PH_PQ); ++rep_) if (RUN(PH_PQ)) {
        SEAM();
        int tid = threadIdx.x; asm volatile("" : "+v"(tid)); asm volatile("" : "+s"(ws)); int bid = blockIdx.x; asm volatile("" : "+s"(bid));
        char* pr = (char*)ws + O_PASS;
        SchedRows Sc{(unsigned)O_H1B, (unsigned)O_WPQ, 1024, 8, 2048, G, bid};
        EpiPlainB16 E{(bf16_t*)(pr + P_PQ), 2048, 0};
        g8::gemm_phase<EpiPlainB16, SchedRows>(lds, (const char*)ws, 1024, Sc, E, tid);
        SEAM();
    }
    for (int rep_ = 0; rep_ < NREP(PH_ROUTE); ++rep_) if (RUN(PH_ROUTE)) {
        int tid = threadIdx.x; asm volatile("" : "+v"(tid)); asm volatile("" : "+s"(ws)); int bid = blockIdx.x; asm volatile("" : "+s"(bid));
        char* pr = (char*)ws + O_PASS;
        const int h = bid & 7, wgi = bid >> 3, nwg = G >> 3;
        const bf16_t* ksrc = (const bf16_t*)(ws + O_SUBK) + (size_t)h * 2 * 128 * 128;
        for (int i = tid; i < 2 * 128 * 16; i += NTHR) { const int rowk = i >> 4, ch = i & 15; *(LAS u32x4*)(lds + (rowk * RT_ROW + ch * 8) * 2) = *(const u32x4*)(ksrc + rowk * 128 + ch * 8); }
        __syncthreads();
        const int wid = __builtin_amdgcn_readfirstlane(tid >> 6), lane = tid & 63;
        for (int tb = wgi * NWAVES + wid; tb < M / 32; tb += nwg * NWAVES)
            route_wave((const bf16_t*)(pr + P_PQ), lds, (int*)(pr + P_IDX), (float*)(pr + P_PG), tb, h, lane);
        __syncthreads();
        SEAM();
    }
    if (RUN(PH_EXPERTS)) {
        int tid = threadIdx.x; asm volatile("" : "+v"(tid)); asm volatile("" : "+s"(ws)); int bid = blockIdx.x; asm volatile("" : "+s"(bid));
        char* pr = (char*)ws + O_PASS;
        const int wid = __builtin_amdgcn_readfirstlane(tid >> 6), lane = tid & 63;
        if (tid == 0) {
            unsigned base = 0; const unsigned myx = ALL ? bar.x : 0u;
            if (ALL) { for (unsigned jx = 0; jx < 16; ++jx) { const unsigned c = xb_ld(&bar.bar[XB_XCNT(jx)]); if (jx < myx) base += c; } MISC[12] = base + MISC[10]; }
            else MISC[12] = (unsigned)bid;
        }
        __syncthreads();
        const int vwg = (int)MISC[12];
        const int nper = G >> 3, x = vwg / nper, r = vwg % nper;
        const int tpw = M / (nper * NWAVES);
        const size_t tokw0 = (size_t)(r * NWAVES + wid) * tpw;
        {
            const unsigned char* U8x = (const unsigned char*)(ws + O_UB) + (size_t)x * ((size_t)NEXP * 128);
            for (int i = 0; i < tpw; i += 2) experts_u_slice<2>((const bf16_t*)(ws + O_H1B), U8x, (const int*)(pr + P_IDX), (bf16_t*)(pr + P_PD), tokw0 + i, x, lane);
        }
        SEAM();
        experts_combine((const bf16_t*)(pr + P_PD), (const int*)(pr + P_IDX), (const float*)(pr + P_PG), (const float*)(ws + O_USC), (const float*)(ws + O_VSC), (float*)(pr + P_C), (size_t)bid * NTHR + tid, (size_t)G * NTHR);
        SEAM();
        {
            const unsigned char* V8x = (const unsigned char*)(ws + O_VB) + (size_t)x * ((size_t)NEXP * 128);
            for (int i = 0; i < tpw; i += 2) experts_v_slice<2>(V8x, (const int*)(pr + P_IDX), (const float*)(pr + P_C), (bf16_t*)(pr + P_FFN), tokw0 + i, x, lane);
        }
        SEAM();
        for (int tok = bid * NWAVES + wid; tok < M; tok += G * NWAVES) ln2_token((const bf16_t*)(pr + P_FFN), (const bf16_t*)(ws + O_H1B), karg_in(16), karg_in(17), karg_out(), (size_t)tok, lane);
    }
#undef RUN
#undef SEAM
}

extern "C" void kernel_launch(void* const* d_in, const int* in_sizes, int n_in, void* d_out, int out_size, void* d_ws, size_t ws_size, hipStream_t stream) {
    if (ws_size < WS_NEED || n_in != 18) return;
    static bool attr_set = false;
    if (!attr_set) { (void)hipFuncSetAttribute((const void*)mega, hipFuncAttributeMaxDynamicSharedMemorySize, LDS_BYTES); attr_set = true; }
    (void)hipMemsetAsync((char*)d_ws + O_MISC + 16384, 0, 16384, stream);
    Args a{}; for (int i = 0; i < 18; ++i) a.in[i] = (const float*)d_in[i]; a.out = (float*)d_out; a.ws = (unsigned char*)d_ws; a.ph = PH_ALL; a.pass = 0;
    mega<<<256, NTHR, LDS_BYTES, stream>>>(a);
}
```

```cpp
#include <hip/hip_runtime.h>
#include <stdint.h>
#include <math.h>

typedef unsigned short bf16_t;
typedef short bf16x8 __attribute__((ext_vector_type(8)));
typedef float f32x4 __attribute__((ext_vector_type(4)));
#define DI __device__ __forceinline__

DI float bf2f(bf16_t v) { return __uint_as_float(((unsigned)v) << 16); }
DI bf16_t f2bf(float f) { unsigned u = __float_as_uint(f); u += 0x7fffu + ((u >> 16) & 1u); return (bf16_t)(u >> 16); }

constexpr int NB = 8, S = 8192, D = 1024, M = NB * S;
constexpr int NPASS = 4, BPP = NB / NPASS, MP = BPP * S;
constexpr int INC = 10240;
constexpr int NEXP = 16384;
constexpr float ALPHA = 1.189207115002721f;
constexpr float LN_EPS = 1e-5f;
constexpr float QSCALE = 0.08838834764831845f;

constexpr size_t al(size_t x) { return (x + 255) & ~(size_t)255; }
constexpr size_t O_WIN = 0;
constexpr size_t O_WMKV = O_WIN + al((size_t)INC * D * 2);
constexpr size_t O_WBR = O_WMKV + al((size_t)1024 * 1024 * 2);
constexpr size_t O_WOUT = O_WBR + al((size_t)1024 * 1536 * 2);
constexpr size_t O_WPQ = O_WOUT + al((size_t)1024 * 1024 * 2);
constexpr size_t O_SUBK = O_WPQ + al((size_t)2048 * 1024 * 2);
constexpr size_t O_UB = O_SUBK + al((size_t)16 * 128 * 128 * 2);
constexpr size_t O_VB = O_UB + al((size_t)NEXP * D);
constexpr size_t O_USC = O_VB + al((size_t)NEXP * D);
constexpr size_t O_VSC = O_USC + al((size_t)NEXP * 4);
constexpr size_t O_XB = O_VSC + al((size_t)NEXP * 4);
constexpr size_t O_MEMB = O_XB + al((size_t)M * D * 2);
constexpr size_t O_MK = O_MEMB + al((size_t)2048 * 1024 * 2);
constexpr size_t O_MVT = O_MK + al((size_t)2048 * 512 * 2);
constexpr size_t O_H1B = O_MVT + al((size_t)8 * 512 * 256 * 2);
constexpr size_t O_H1Q = O_H1B + al((size_t)M * D * 2);
constexpr size_t O_HSC = O_H1Q + al((size_t)M * D);
constexpr size_t O_MISC = O_HSC + al((size_t)M * 4);
constexpr size_t O_PASS = O_MISC + al(65536);
constexpr size_t P_QK = 0;
constexpr size_t P_VT = P_QK + al((size_t)MP * 3072 * 2);
constexpr size_t P_IT = P_VT + (size_t)1536 * MP * 2;
constexpr size_t P_HFQG = P_IT + al((size_t)512 * MP * 2);
constexpr size_t P_MQ = P_HFQG + al((size_t)MP * 1536 * 2);
constexpr size_t P_GATE = P_MQ + al((size_t)MP * 512 * 2);
constexpr size_t P_OG = P_GATE + al((size_t)MP * 3072 * 2);
constexpr size_t P_LSE = P_OG + al((size_t)MP * 1536 * 2);
constexpr size_t P_BR = P_LSE + al((size_t)MP * 12 * 4);
constexpr size_t P_MERGED = P_BR + al((size_t)MP * 1536 * 2);
constexpr size_t P_MIX = P_MERGED + al((size_t)MP * 1024 * 2);
constexpr size_t P_HSTL = P_MIX + al((size_t)MP * 1024 * 4);
constexpr size_t P_HSTD = P_HSTL + al((size_t)256 * 16384 * 4);
constexpr size_t P_SIN = P_HSTD + al((size_t)256 * 128 * 4);
constexpr size_t P_END = P_SIN + al((size_t)256 * 16384 * 4);
constexpr size_t P_PQ = 0;
constexpr size_t P_IDX = P_PQ + al((size_t)M * 2048 * 2);
constexpr size_t P_PG = P_IDX + al((size_t)M * 128 * 4);
constexpr size_t P_C = P_PG + al((size_t)M * 128 * 4);
constexpr size_t P_END2 = P_C + al((size_t)M * 128 * 4);
constexpr size_t P_PD = 0;
constexpr size_t P_FFN = P_PD + al((size_t)M * 1024 * 2);
static_assert(P_FFN + (size_t)M * 1024 * 2 <= P_IDX, "PEER overlay");
constexpr size_t WS_NEED = O_PASS + (P_END > P_END2 ? P_END : P_END2);
static_assert(WS_NEED <= (size_t)1073741824, "workspace budget");

__global__ __launch_bounds__(256) void k_convert(const float* __restrict__ in, bf16_t* __restrict__ out, size_t n4) {
    size_t i = (size_t)blockIdx.x * 256 + threadIdx.x; const size_t st = (size_t)gridDim.x * 256;
    for (; i < n4; i += st) { const f32x4 v = ((const f32x4*)in)[i]; ushort4 o; o.x = f2bf(v[0]); o.y = f2bf(v[1]); o.z = f2bf(v[2]); o.w = f2bf(v[3]); ((ushort4*)out)[i] = o; }
}
__global__ __launch_bounds__(256) void k_transpose(const float* __restrict__ W, int K, int ldw, bf16_t* __restrict__ out, int ldo, int koff) {
    __shared__ float t[32][33];
    const int k0 = blockIdx.y * 32, n0 = blockIdx.x * 32, tx = threadIdx.x & 31, ty = threadIdx.x >> 5;
    for (int i = ty; i < 32; i += 8) t[i][tx] = W[(size_t)(k0 + i) * ldw + n0 + tx];
    __syncthreads();
    for (int i = ty; i < 32; i += 8) out[(size_t)(n0 + i) * ldo + koff + k0 + tx] = f2bf(t[tx][i]);
}
__global__ void k_misc(const float* __restrict__ hgrn_lb, const float* __restrict__ rel_bias, float* __restrict__ misc) {
    const int i = blockIdx.x * blockDim.x + threadIdx.x;
    if (i < 512) { const float a = hgrn_lb[i], b = hgrn_lb[512 + i]; const float mx = fmaxf(a, b); const float ea = expf(a - mx), eb = expf(b - mx); misc[i] = ea / (ea + eb); }
    if (i < 3 * 129) {
        const int g = i / 129, j = i % 129; const int dl = g == 0 ? 1 : (g == 1 ? 4 : 16); const int n = j * dl;
        int bucket;
        if (n < 16) bucket = n;
        else { const double v = log((double)n / 16.0) / log(128.0) * 16.0; int l = 16 + (int)v; bucket = l < 31 ? l : 31; }
        for (int h = 0; h < 4; ++h) misc[512 + i * 4 + h] = rel_bias[bucket * 12 + g * 4 + h];
    }
}

template <class Epi>
__global__ __launch_bounds__(256) void gemm_simple(const bf16_t* __restrict__ A, int lda, const bf16_t* __restrict__ Bt, int ldb, int K, Epi epi) {
    const int lane = threadIdx.x & 63, w = threadIdx.x >> 6;
    const int row0 = blockIdx.y * 64 + (w >> 1) * 32, col0 = blockIdx.x * 64 + (w & 1) * 32;
    const int fr = lane & 15, fq = lane >> 4;
    f32x4 acc[2][2];
#pragma unroll
    for (int a = 0; a < 2; ++a)
#pragma unroll
        for (int b = 0; b < 2; ++b) acc[a][b] = (f32x4){0.f, 0.f, 0.f, 0.f};
    const bf16_t* ap = A + (size_t)(row0 + fr) * lda + fq * 8;
    const bf16_t* bp = Bt + (size_t)(col0 + fr) * ldb + fq * 8;
    for (int k0 = 0; k0 < K; k0 += 32) {
        const bf16x8 a0 = *(const bf16x8*)(ap + k0), a1 = *(const bf16x8*)(ap + (size_t)16 * lda + k0);
        const bf16x8 b0 = *(const bf16x8*)(bp + k0), b1 = *(const bf16x8*)(bp + (size_t)16 * ldb + k0);
        acc[0][0] = __builtin_amdgcn_mfma_f32_16x16x32_bf16(a0, b0, acc[0][0], 0, 0, 0);
        acc[0][1] = __builtin_amdgcn_mfma_f32_16x16x32_bf16(a0, b1, acc[0][1], 0, 0, 0);
        acc[1][0] = __builtin_amdgcn_mfma_f32_16x16x32_bf16(a1, b0, acc[1][0], 0, 0, 0);
        acc[1][1] = __builtin_amdgcn_mfma_f32_16x16x32_bf16(a1, b1, acc[1][1], 0, 0, 0);
    }
#pragma unroll
    for (int mi = 0; mi < 2; ++mi)
#pragma unroll
        for (int ni = 0; ni < 2; ++ni)
#pragma unroll
            for (int j = 0; j < 4; ++j) epi(row0 + mi * 16 + fq * 4 + j, col0 + ni * 16 + fr, acc[mi][ni][j]);
}

DI int dil_of(int g) { return g == 0 ? 1 : (g == 1 ? 4 : 16); }
DI int perm_tok(int lb, int s, int dl) { return lb * S + (s % dl) * (S / dl) + s / dl; }

struct EpiProj {
    bf16_t *QK, *VT, *HFQG, *IT, *MQ, *GATE; const float* b_gate;
    DI void operator()(int row, int col, float v) const {
        if (col < 3072) QK[(size_t)row * 3072 + col] = f2bf(v);
        else if (col < 4608) { const int c = col - 3072, g = c >> 9; VT[(size_t)c * MP + perm_tok(row / S, row % S, dil_of(g))] = f2bf(v); }
        else if (col < 5120) HFQG[(size_t)row * 1536 + (col - 4608)] = f2bf(v);
        else if (col < 5632) IT[(size_t)(col - 5120) * MP + row] = f2bf(v);
        else if (col < 6656) HFQG[(size_t)row * 1536 + (col - 5632) + 512] = f2bf(v);
        else if (col < 7168) MQ[(size_t)row * 512 + (col - 6656)] = f2bf(v);
        else { const int c = col - 7168; const float z = v + b_gate[c]; GATE[(size_t)row * 3072 + c] = f2bf(1.f / (1.f + expf(-z))); }
    }
};
struct EpiMemKV {
    bf16_t *MK, *MVT;
    DI void operator()(int row, int col, float v) const {
        if (col < 512) MK[(size_t)row * 512 + col] = f2bf(v);
        else MVT[((size_t)(row >> 8) * 512 + (col - 512)) * 256 + (row & 255)] = f2bf(v);
    }
};
struct EpiWiden {
    const bf16_t* GATE; float* TMP; bf16_t* MERGED; int g, pad;
    DI void operator()(int row, int col, float v) const {
        const float gv = bf2f(GATE[(size_t)row * 3072 + g * 1024 + col]) * v; const size_t o = (size_t)row * 1024 + col;
        if (g == 0) TMP[o] = gv; else if (g == 1) TMP[o] += gv; else MERGED[o] = f2bf(TMP[o] + gv);
    }
};
struct EpiF32 { float* C; int ldc, pad; DI void operator()(int row, int col, float v) const { C[(size_t)row * ldc + col] = v; } };
struct EpiB16 { bf16_t* C; int ldc, pad; DI void operator()(int row, int col, float v) const { C[(size_t)row * ldc + col] = f2bf(v); } };

DI float wave_max(float v) {
#pragma unroll
    for (int o = 1; o < 64; o <<= 1) v = fmaxf(v, __shfl_xor(v, o));
    return v;
}
DI float wave_sum(float v) {
#pragma unroll
    for (int o = 1; o < 64; o <<= 1) v += __shfl_xor(v, o);
    return v;
}

__global__ __launch_bounds__(256) void k_dil_attn(const bf16_t* __restrict__ QK, const bf16_t* __restrict__ VT, const float* __restrict__ BIAS, bf16_t* __restrict__ OG, float* __restrict__ LSE) {
    __shared__ float ps[4][192];
    const int lane = threadIdx.x & 63, w = threadIdx.x >> 6;
    const long task = (long)blockIdx.x * 4 + w;
    const int gh = (int)(task % 12); const int row = (int)(task / 12);
    const int g = gh >> 2, h = gh & 3, dl = dil_of(g);
    const int lb = row / S, s = row % S, m = s / dl, r = s % dl;
    const bf16_t* qp = QK + (size_t)row * 3072 + gh * 128;
    float lg[3]; float mx = -INFINITY;
#pragma unroll
    for (int i = 0; i < 3; ++i) {
        const int j = lane + 64 * i; float l = -INFINITY;
        if (j <= 128 && m - j >= 0) {
            const int krow = lb * S + (m - j) * dl + r; const bf16_t* kp = QK + (size_t)krow * 3072 + 1536 + gh * 128;
            float dot = 0.f;
            for (int d = 0; d < 128; ++d) dot += bf2f(qp[d]) * bf2f(kp[d]);
            l = dot * QSCALE + BIAS[(g * 129 + j) * 4 + h];
        }
        lg[i] = l; mx = fmaxf(mx, l);
    }
    mx = wave_max(mx);
    float sum = 0.f;
#pragma unroll
    for (int i = 0; i < 3; ++i) { const float p = (lg[i] == -INFINITY) ? 0.f : expf(lg[i] - mx); ps[w][lane + 64 * i] = p; sum += p; }
    sum = wave_sum(sum);
    __syncthreads();
    const int nk = m < 128 ? m : 128;
    const float inv = 1.f / sum;
#pragma unroll
    for (int i = 0; i < 2; ++i) {
        const int d = lane + 64 * i; const bf16_t* vp = VT + (size_t)(g * 512 + h * 128 + d) * MP + lb * S + r * (S / dl);
        float o = 0.f;
        for (int j = 0; j <= nk; ++j) o += ps[w][j] * bf2f(vp[m - j]);
        OG[(size_t)row * 1536 + g * 512 + h * 128 + d] = f2bf(o * inv);
    }
    if (lane == 0) LSE[(size_t)row * 12 + gh] = mx + logf(sum);
}
__global__ __launch_bounds__(256) void k_merge(const bf16_t* __restrict__ OG, const float* __restrict__ LSE, bf16_t* __restrict__ BR) {
    const long i = (long)blockIdx.x * 256 + threadIdx.x;
    const int row = (int)(i >> 9), c = (int)(i & 511), h = c >> 7;
    const float l0 = LSE[(size_t)row * 12 + h], l1 = LSE[(size_t)row * 12 + 4 + h], l2 = LSE[(size_t)row * 12 + 8 + h];
    const float mx = fmaxf(l0, fmaxf(l1, l2)); const float e0 = expf(l0 - mx), e1 = expf(l1 - mx), e2 = expf(l2 - mx); const float inv = 1.f / (e0 + e1 + e2);
    const bf16_t* og = OG + (size_t)row * 1536 + c;
    BR[(size_t)row * 1536 + c] = f2bf((e0 * bf2f(og[0]) + e1 * bf2f(og[512]) + e2 * bf2f(og[1024])) * inv);
}
__global__ __launch_bounds__(256) void k_mem_attn(const bf16_t* __restrict__ MQ, const bf16_t* __restrict__ MK, const bf16_t* __restrict__ MVT, bf16_t* __restrict__ BR, int batch0) {
    __shared__ float ps[4][256];
    const int lane = threadIdx.x & 63, w = threadIdx.x >> 6;
    const long task = (long)blockIdx.x * 4 + w;
    const int h = (int)(task & 3); const int row = (int)(task >> 2);
    const int b = batch0 + row / S;
    const bf16_t* qp = MQ + (size_t)row * 512 + h * 128;
    float lg[4]; float mx = -INFINITY;
#pragma unroll
    for (int i = 0; i < 4; ++i) {
        const int j = lane + 64 * i; const bf16_t* kp = MK + (size_t)(b * 256 + j) * 512 + h * 128;
        float dot = 0.f;
        for (int d = 0; d < 128; ++d) dot += bf2f(qp[d]) * bf2f(kp[d]);
        lg[i] = dot * QSCALE; mx = fmaxf(mx, lg[i]);
    }
    mx = wave_max(mx);
    float sum = 0.f;
#pragma unroll
    for (int i = 0; i < 4; ++i) { const float p = expf(lg[i] - mx); ps[w][lane + 64 * i] = p; sum += p; }
    sum = wave_sum(sum);
    __syncthreads();
    const float inv = 1.f / sum;
#pragma unroll
    for (int i = 0; i < 2; ++i) {
        const int d = lane + 64 * i; const bf16_t* vp = MVT + ((size_t)b * 512 + h * 128 + d) * 256;
        float o = 0.f;
        for (int j = 0; j < 256; ++j) o += ps[w][j] * bf2f(vp[j]);
        BR[(size_t)row * 1536 + 1024 + h * 128 + d] = f2bf(o * inv);
    }
}
__global__ __launch_bounds__(128) void k_hgrn(const bf16_t* __restrict__ HFQG, const bf16_t* __restrict__ IT, const float* __restrict__ lbv, const float* __restrict__ norm_w, bf16_t* __restrict__ BR) {
    __shared__ float sf[128], sk[128], sq[128], red[2];
    const int tid = threadIdx.x, h = blockIdx.x & 3, lb = blockIdx.x >> 2;
    const float lbd = lbv[h * 128 + tid], nw = norm_w[h * 128 + tid];
    float St[128];
#pragma unroll
    for (int i = 0; i < 128; ++i) St[i] = 0.f;
    for (int s = 0; s < S; ++s) {
        const size_t row = (size_t)lb * S + s;
        const float fr = bf2f(HFQG[row * 1536 + h * 128 + tid]);
        const float f = lbd + (1.f - lbd) / (1.f + expf(-fr));
        sf[tid] = f; sk[tid] = 1.f - f; sq[tid] = bf2f(HFQG[row * 1536 + 512 + h * 128 + tid]);
        __syncthreads();
        const float iv = bf2f(IT[(size_t)(h * 128 + tid) * MP + row]);
        float o = 0.f;
#pragma unroll
        for (int d = 0; d < 128; ++d) { St[d] = sf[d] * St[d] + sk[d] * iv; o += sq[d] * St[d]; }
        const float ss = wave_sum(o * o);
        if ((tid & 63) == 0) red[tid >> 6] = ss;
        __syncthreads();
        const float ms = (red[0] + red[1]) * (1.f / 128.f);
        const float gv = bf2f(HFQG[row * 1536 + 1024 + h * 128 + tid]);
        BR[row * 1536 + 512 + h * 128 + tid] = f2bf(o * rsqrtf(ms + LN_EPS) * nw * (gv / (1.f + expf(-gv))));
    }
}
__global__ __launch_bounds__(256) void k_ln1(const float* __restrict__ x, const float* __restrict__ mix, const float* __restrict__ g, const float* __restrict__ b, float* __restrict__ h1f, bf16_t* __restrict__ h1b) {
    __shared__ float red[8];
    const size_t row = blockIdx.x; const int tid = threadIdx.x;
    float v[4]; float s = 0.f;
#pragma unroll
    for (int i = 0; i < 4; ++i) { const int c = tid + 256 * i; v[i] = ALPHA * x[row * D + c] + mix[row * D + c]; s += v[i]; }
    s = wave_sum(s); if ((tid & 63) == 0) red[tid >> 6] = s; __syncthreads();
    const float mean = (red[0] + red[1] + red[2] + red[3]) * (1.f / D);
    float q = 0.f;
#pragma unroll
    for (int i = 0; i < 4; ++i) { v[i] -= mean; q += v[i] * v[i]; }
    q = wave_sum(q); if ((tid & 63) == 0) red[4 + (tid >> 6)] = q; __syncthreads();
    const float rstd = rsqrtf((red[4] + red[5] + red[6] + red[7]) * (1.f / D) + LN_EPS);
#pragma unroll
    for (int i = 0; i < 4; ++i) { const int c = tid + 256 * i; const float o = v[i] * rstd * g[c] + b[c]; h1f[row * D + c] = o; h1b[row * D + c] = f2bf(o); }
}

DI void ins16(float (&tv)[16], int (&ti)[16], float v, int i) {
#pragma unroll
    for (int j = 0; j < 16; ++j) { const bool gt = v > tv[j]; const float ov = tv[j]; const int oi = ti[j]; tv[j] = gt ? v : ov; ti[j] = gt ? i : oi; v = gt ? ov : v; i = gt ? oi : i; }
}
__global__ __launch_bounds__(256) void k_route(const bf16_t* __restrict__ PQ, const bf16_t* __restrict__ SUBK, int* __restrict__ IDX, float* __restrict__ PG) {
    const long gi = (long)blockIdx.x * 256 + threadIdx.x;
    const int h = (int)(gi & 7); const size_t t = (size_t)(gi >> 3);
    float s1[16], s2[16]; int i1[16], i2[16];
#pragma unroll
    for (int j = 0; j < 16; ++j) { s1[j] = -INFINITY; s2[j] = -INFINITY; i1[j] = 0; i2[j] = 0; }
    const bf16_t* q0 = PQ + t * 2048 + h * 256;
    for (int n = 0; n < 128; ++n) {
        const bf16_t* k0 = SUBK + (size_t)((h * 2 + 0) * 128 + n) * 128; const bf16_t* k1 = SUBK + (size_t)((h * 2 + 1) * 128 + n) * 128;
        float a = 0.f, b = 0.f;
        for (int k = 0; k < 128; ++k) { a += bf2f(q0[k]) * bf2f(k0[k]); b += bf2f(q0[128 + k]) * bf2f(k1[k]); }
        ins16(s1, i1, a, n); ins16(s2, i2, b, n);
    }
    float cv[16]; int ci[16];
#pragma unroll
    for (int j = 0; j < 16; ++j) { cv[j] = -INFINITY; ci[j] = 0; }
#pragma unroll
    for (int a = 0; a < 16; ++a)
#pragma unroll
        for (int b = 0; b < 16; ++b) ins16(cv, ci, s1[a] + s2[b], i1[a] * 128 + i2[b]);
    float sum = 0.f; float e[16];
#pragma unroll
    for (int j = 0; j < 16; ++j) { e[j] = expf(cv[j] - cv[0]); sum += e[j]; }
    const float inv = 1.f / sum;
#pragma unroll
    for (int j = 0; j < 16; ++j) { IDX[t * 128 + h * 16 + j] = ci[j]; PG[t * 128 + h * 16 + j] = e[j] * inv; }
}
__global__ __launch_bounds__(256) void k_experts(const float* h1f_in, const bf16_t* __restrict__ h1b, const bf16_t* __restrict__ UB, const bf16_t* __restrict__ VB, const int* __restrict__ IDX, const float* __restrict__ PG,
                                                 const float* __restrict__ g2, const float* __restrict__ b2, float* out) {
    __shared__ float hrow[1024]; __shared__ float cw[128]; __shared__ int eid[128]; __shared__ float red[8];
    const size_t t = blockIdx.x; const int tid = threadIdx.x, lane = tid & 63, w = tid >> 6;
    float hv[4];
#pragma unroll
    for (int i = 0; i < 4; ++i) { const int c = tid + 256 * i; hv[i] = h1f_in[t * D + c]; hrow[c] = bf2f(h1b[t * D + c]); }
    if (tid < 128) eid[tid] = IDX[t * 128 + tid];
    __syncthreads();
    for (int e = w; e < 128; e += 4) {
        const bf16_t* up = UB + (size_t)eid[e] * D; float dot = 0.f;
#pragma unroll
        for (int i = 0; i < 16; ++i) dot += hrow[lane + 64 * i] * bf2f(up[lane + 64 * i]);
        dot = wave_sum(dot);
        if (lane == 0) cw[e] = PG[t * 128 + e] * 0.5f * dot * (1.f + erff(dot * 0.7071067811865476f));
    }
    __syncthreads();
    float f[4] = {0.f, 0.f, 0.f, 0.f};
    for (int e = 0; e < 128; ++e) { const bf16_t* vp = VB + (size_t)eid[e] * D; const float c = cw[e];
#pragma unroll
        for (int i = 0; i < 4; ++i) f[i] += c * bf2f(vp[tid + 256 * i]); }
    float v[4]; float s = 0.f;
#pragma unroll
    for (int i = 0; i < 4; ++i) { v[i] = ALPHA * hv[i] + f[i]; s += v[i]; }
    s = wave_sum(s); if (lane == 0) red[w] = s; __syncthreads();
    const float mean = (red[0] + red[1] + red[2] + red[3]) * (1.f / D);
    float q = 0.f;
#pragma unroll
    for (int i = 0; i < 4; ++i) { v[i] -= mean; q += v[i] * v[i]; }
    q = wave_sum(q); if (lane == 0) red[4 + w] = q; __syncthreads();
    const float rstd = rsqrtf((red[4] + red[5] + red[6] + red[7]) * (1.f / D) + LN_EPS);
#pragma unroll
    for (int i = 0; i < 4; ++i) { const int c = tid + 256 * i; out[t * D + c] = v[i] * rstd * g2[c] + b2[c]; }
}

#define LAS __attribute__((address_space(3)))
#define GAS __attribute__((address_space(1)))
typedef unsigned u32x4 __attribute__((ext_vector_type(4)));
typedef unsigned u32x2 __attribute__((ext_vector_type(2)));
typedef float f32x2 __attribute__((ext_vector_type(2)));
typedef __bf16 bf16x2_t __attribute__((ext_vector_type(2)));
DI unsigned cvtpk(float lo, float hi) { f32x2 v = {lo, hi}; bf16x2_t b = __builtin_convertvector(v, bf16x2_t); return __builtin_bit_cast(unsigned, b); }
constexpr float LOG2E = 1.4426950408889634f;
DI float fast_sigmoid(float z) { return __builtin_amdgcn_rcpf(1.f + __builtin_amdgcn_exp2f(-z * LOG2E)); }

namespace g8 {
constexpr int BM = 256, BK = 64, HALF = 128, HTB = HALF * BK * 2, STAGE_BYTES = 8 * HTB;
DI int lds_byte(int r, int c) { const int st = (r >> 4) * 2 + (c >> 5), rr = r & 15, cc = c & 31, ob = rr * 64 + cc * 2; return st * 1024 + (ob ^ (((ob >> 9) & 1) << 5)); }
DI void stage_rc(int b, int& R, int& C) { const int st = b / 1024, sb = b % 1024, swz = sb ^ (((sb >> 9) & 1) << 5); R = (st >> 1) * 16 + swz / 64; C = (st & 1) * 32 + (swz % 64) / 2; }
DI int perm32(int rho) { const int n = rho >> 4, i = rho & 15; return 8 * (i >> 2) + 4 * n + (i & 3); }

struct Unit { unsigned a, b; int dlb; int pm, pn, kind; };

template <class Epi, class Sched>
DI void gemm_phase(LAS unsigned char* lds, const char* const wsb, const int K, const Sched& S, const Epi& E, const int tid) {
    const int wid = __builtin_amdgcn_readfirstlane(tid >> 6), lane = tid & 63, wr = wid >> 2, wc = wid & 3, fr = lane & 15, fq = lane >> 4;
    const int nt = K / BK;
    unsigned voffA[2], rbk[2], ccb[2];
#pragma unroll
    for (int i = 0; i < 2; ++i) { int R, C; stage_rc(tid * 16 + i * 8192, R, C); const int Rb = Epi::PERM ? ((R & ~31) + perm32(R & 31)) : R;
        voffA[i] = (unsigned)(R * K + C) * 2u; rbk[i] = (unsigned)(Rb * K) * 2u; ccb[i] = (unsigned)C * 2u; }
    const unsigned kstep = (unsigned)(BK * 2);
    const unsigned hstepA = (unsigned)(HALF * K * 2);
    const unsigned ldsw = (unsigned)wid * 1024u;
    const int aoff = lds_byte(wr * 64 + fr, fq * 8), boff = lds_byte(wc * 32 + fr, fq * 8);
#define G8_SA(b, h) (((b) * 2 + (h)) * HTB)
#define G8_SB(b, h) ((4 + (b) * 2 + (h)) * HTB)
#define G8_STAGE(bufoff, gbase, v0, v1) do { \
        __builtin_amdgcn_global_load_lds((const unsigned*)(wsb + (unsigned)((gbase) + (v0))), (LAS unsigned*)(lds + (bufoff) + ldsw), 16, 0, 0); \
        __builtin_amdgcn_global_load_lds((const unsigned*)(wsb + (unsigned)((gbase) + (v1))), (LAS unsigned*)(lds + (bufoff) + ldsw + 8192), 16, 0, 0); } while (0)
#define G8_LDA(dst, b, h) do { _Pragma("unroll") for (int m = 0; m < 4; ++m) _Pragma("unroll") for (int k = 0; k < 2; ++k) dst[m][k] = *(const LAS bf16x8*)(lds + G8_SA(b, h) + aoff + m * 2048 + k * 1024); } while (0)
#define G8_LDB(dst, b, h) do { _Pragma("unroll") for (int n = 0; n < 2; ++n) _Pragma("unroll") for (int k = 0; k < 2; ++k) dst[n][k] = *(const LAS bf16x8*)(lds + G8_SB(b, h) + boff + n * 2048 + k * 1024); } while (0)
#define G8_MMA(ai, bj, At, Bt) do { __builtin_amdgcn_s_setprio(1); _Pragma("unroll") for (int m = 0; m < 4; ++m) _Pragma("unroll") for (int n = 0; n < 2; ++n) _Pragma("unroll") for (int k = 0; k < 2; ++k) \
        acc[ai][bj][m][n] = __builtin_amdgcn_mfma_f32_16x16x32_bf16(Bt[n][k], At[m][k], acc[ai][bj][m][n], 0, 0, 0); __builtin_amdgcn_s_setprio(0); } while (0)
#define G8_WAIT_V(n) asm volatile("s_waitcnt vmcnt(" #n ")" ::: "memory")
#define G8_WAIT_L(n) asm volatile("s_waitcnt lgkmcnt(" #n ")" ::: "memory")
#define G8_BAR __builtin_amdgcn_s_barrier()
#define G8_SCHED __builtin_amdgcn_sched_barrier(0)
    Unit cur, nxt; int ui = 0;
    if (!S.next(0, cur)) return;
    f32x4 acc[2][2][4][2];
#pragma unroll
    for (int a = 0; a < 2; ++a)
#pragma unroll
        for (int b = 0; b < 2; ++b)
#pragma unroll
            for (int m = 0; m < 4; ++m)
#pragma unroll
                for (int n = 0; n < 2; ++n) acc[a][b][m][n] = (f32x4){0.f, 0.f, 0.f, 0.f};
    bf16x8 At[4][2], B0[2][2], B1[2][2];
    unsigned cA = cur.a, cB = cur.b;
    unsigned vBc0 = rbk[0] * (unsigned)cur.dlb + ccb[0], vBc1 = rbk[1] * (unsigned)cur.dlb + ccb[1]; unsigned hBc = hstepA * (unsigned)cur.dlb;
    G8_STAGE(G8_SB(0, 0), cB, vBc0, vBc1); G8_STAGE(G8_SB(0, 1), cB + hBc, vBc0, vBc1); G8_STAGE(G8_SA(0, 0), cA, voffA[0], voffA[1]); G8_STAGE(G8_SA(0, 1), cA + hstepA, voffA[0], voffA[1]);
    if (wr == 1) G8_BAR;
    G8_WAIT_V(2); G8_BAR;
    G8_STAGE(G8_SB(1, 0), cB + kstep, vBc0, vBc1); G8_STAGE(G8_SA(1, 0), cA + kstep, voffA[0], voffA[1]); G8_STAGE(G8_SB(1, 1), cB + hBc + kstep, vBc0, vBc1);
    G8_WAIT_V(6); G8_BAR;
    for (;;) {
        const bool has_next = S.next(ui + 1, nxt);
        const unsigned nA = has_next ? nxt.a : cA, nB = has_next ? nxt.b : cB; const int dln = has_next ? nxt.dlb : cur.dlb;
        const unsigned vBn0 = rbk[0] * (unsigned)dln + ccb[0], vBn1 = rbk[1] * (unsigned)dln + ccb[1]; const unsigned hBn = hstepA * (unsigned)dln;
        for (int t = 0; t < nt; t += 2) {
            if constexpr (Epi::HOOK) E.hook(acc, cur, t, wr, wc, fr, fq);
            const bool last = (t == nt - 2);
            const unsigned a1 = cA + (unsigned)(t + 1) * kstep;
            const unsigned a2 = last ? nA : cA + (unsigned)(t + 2) * kstep, b2 = last ? nB : cB + (unsigned)(t + 2) * kstep;
            const unsigned a3 = a2 + kstep, b3 = b2 + kstep;
            const unsigned vB0 = last ? vBn0 : vBc0, vB1 = last ? vBn1 : vBc1; const unsigned hB = last ? hBn : hBc;
            G8_LDB(B0, 0, 0); G8_LDB(B1, 0, 1); G8_SCHED; G8_LDA(At, 0, 0); G8_STAGE(G8_SA(1, 1), a1 + hstepA, voffA[0], voffA[1]);
            G8_WAIT_V(8); G8_WAIT_L(0); G8_BAR; G8_MMA(0, 0, At, B0); G8_MMA(0, 1, At, B1); G8_BAR; G8_SCHED;
            G8_LDA(At, 0, 1); G8_STAGE(G8_SB(0, 0), b2, vB0, vB1); G8_STAGE(G8_SB(0, 1), b2 + hB, vB0, vB1); G8_STAGE(G8_SA(0, 0), a2, voffA[0], voffA[1]);
            G8_WAIT_V(8); G8_WAIT_L(0); G8_BAR; G8_MMA(1, 0, At, B0); G8_MMA(1, 1, At, B1); G8_BAR; G8_SCHED;
            G8_LDB(B0, 1, 0); G8_LDB(B1, 1, 1); G8_SCHED; G8_LDA(At, 1, 0); G8_STAGE(G8_SA(0, 1), a2 + hstepA, voffA[0], voffA[1]);
            G8_WAIT_V(8); G8_WAIT_L(0); G8_BAR; G8_MMA(0, 0, At, B0); G8_MMA(0, 1, At, B1); G8_BAR; G8_SCHED;
            G8_LDA(At, 1, 1); G8_STAGE(G8_SB(1, 0), b3, vB0, vB1); G8_STAGE(G8_SB(1, 1), b3 + hB, vB0, vB1); G8_STAGE(G8_SA(1, 0), a3, voffA[0], voffA[1]);
            G8_WAIT_V(8); G8_WAIT_L(0); G8_BAR; G8_MMA(1, 0, At, B0); G8_MMA(1, 1, At, B1); G8_BAR; G8_SCHED;
        }
        if (wr == 0) G8_BAR;
        E(acc, cur, wr, wc, fr, fq);
        if (!has_next) break;
#pragma unroll
        for (int a = 0; a < 2; ++a)
#pragma unroll
            for (int b = 0; b < 2; ++b)
#pragma unroll
                for (int m = 0; m < 4; ++m)
#pragma unroll
                    for (int n = 0; n < 2; ++n) acc[a][b][m][n] = (f32x4){0.f, 0.f, 0.f, 0.f};
        cur = nxt; cA = nA; cB = nB; vBc0 = vBn0; vBc1 = vBn1; hBc = hBn; ++ui;
        if (wr == 1) G8_BAR;
    }
    G8_WAIT_V(0);
    G8_BAR;
#undef G8_SA
#undef G8_SB
#undef G8_STAGE
#undef G8_LDA
#undef G8_LDB
#undef G8_MMA
#undef G8_WAIT_V
#undef G8_WAIT_L
#undef G8_BAR
#undef G8_SCHED
}
}

typedef GAS unsigned gu32;
#define XB_TMO      128
#define XB_XCNT(j)  (256  + 64 * (j))
#define XB_XSUB(j)  (1280 + 64 * (j))
#define XB_XGEN(j)  (2304 + 64 * (j))
#define XB_TOP      3328
#define XB_TOPGEN   3392
#define XCD_BAR_WORDS 3456
#define XB_SPIN_CAP (1u << 22)
DI unsigned xb_ld(unsigned* p)              { return __hip_atomic_load(p, __ATOMIC_RELAXED, __HIP_MEMORY_SCOPE_AGENT); }
DI unsigned xb_add(unsigned* p, unsigned v) { return __hip_atomic_fetch_add(p, v, __ATOMIC_RELAXED, __HIP_MEMORY_SCOPE_AGENT); }
DI unsigned xb_xcc_id() { return (unsigned)__builtin_amdgcn_s_getreg((3 << 11) | 20) & 0xFu; }
#define XB_SPIN(cond, bar) do { unsigned _sp = 0; while (cond) { __builtin_amdgcn_s_sleep(1); \
    if ((++_sp & 255u) == 0u) { if (xb_ld(&(bar)[XB_TMO])) break; if (_sp > XB_SPIN_CAP) { atomicAdd(&(bar)[XB_TMO], 1u); break; } } } } while (0)
struct XcdBarrier { unsigned* bar; unsigned x; volatile LAS unsigned* st; };
DI XcdBarrier xcd_barrier_post(unsigned* bar, volatile LAS unsigned* st) {
    XcdBarrier b; b.bar = bar; b.x = xb_xcc_id(); b.st = st;
    if (threadIdx.x == 0) st[2] = xb_add(&bar[XB_XCNT(b.x)], 1u);
    return b;
}
DI void xcd_barrier_complete(unsigned* bar, unsigned x, unsigned& nloc, unsigned& nx) {
    const unsigned G = gridDim.x * gridDim.y * gridDim.z;
    unsigned sum, cnt, mine, sp = 0u;
    for (;;) {
        sum = 0u; cnt = 0u; mine = 0u;
#pragma unroll
        for (unsigned j = 0; j < 16; ++j) { const unsigned c = xb_ld(&bar[XB_XCNT(j)]); sum += c; cnt += (c > 0u) ? 1u : 0u; mine = (j == x) ? c : mine; }
        if (sum == G) break;
        __builtin_amdgcn_s_sleep(1);
        if ((++sp & 255u) == 0u) { if (xb_ld(&bar[XB_TMO])) break; if (sp > XB_SPIN_CAP) { atomicAdd(&bar[XB_TMO], 1u); break; } }
    }
    nloc = mine > 0u ? mine : 1u; nx = cnt > 0u ? cnt : 1u;
}
DI void xcd_barrier(const XcdBarrier& b) {
    asm volatile("s_waitcnt vmcnt(0)" ::: "memory");
    __syncthreads();
    if (threadIdx.x == 0) {
        unsigned* bar = b.bar;
        __builtin_amdgcn_s_waitcnt(0);
        unsigned nloc = b.st[0], nx = b.st[1];
        if (nloc == 0u) { xcd_barrier_complete(bar, b.x, nloc, nx); b.st[0] = nloc; b.st[1] = nx; }
        const unsigned old = xb_add(&bar[XB_XSUB(b.x)], 1u);
        const unsigned gen = old / nloc;
        if (old + 1u == (gen + 1u) * nloc) {
            __builtin_amdgcn_fence(__ATOMIC_RELEASE, "agent");
            asm volatile("s_waitcnt vmcnt(0)" ::: "memory");
            const unsigned og = xb_add(&bar[XB_TOP], 1u);
            const unsigned tg = og / nx;
            if (og + 1u == (tg + 1u) * nx) xb_add(&bar[XB_TOPGEN], 1u);
            else XB_SPIN(xb_ld(&bar[XB_TOPGEN]) == tg, bar);
            __builtin_amdgcn_fence(__ATOMIC_ACQUIRE, "agent");
            xb_add(&bar[XB_XGEN(b.x)], 1u);
            asm volatile("s_waitcnt vmcnt(0)" ::: "memory");
        } else {
            XB_SPIN(xb_ld(&bar[XB_XGEN(b.x)]) == gen, bar);
            __builtin_amdgcn_fence(__ATOMIC_ACQUIRE, "agent");
            asm volatile("s_waitcnt vmcnt(0)" ::: "memory");
        }
    }
    __syncthreads();
}

constexpr int NWAVES = 8, NTHR = NWAVES * 64;
constexpr int RING_BYTES = 131072, LDS_BYTES = 147456, LDSCTL_OFF = LDS_BYTES - 1024, MISC_OFF = LDSCTL_OFF + 320;
constexpr size_t CTL_BYTES = 65536;
enum { PH_ALL = 0, PH_PRO = 11, PH_PROJ = 1, PH_ATTN = 2, PH_HGPRE = 3, PH_HGMAIN = 4, PH_WIDEN = 5, PH_WOUT = 6, PH_LN1 = 7, PH_PQ = 8, PH_ROUTE = 9, PH_EXPERTS = 10, PH_HGSCAN = 12 };
struct Args { const float* in[18]; float* out; unsigned char* ws; int ph, pass; };

struct Bufs {
    const bf16_t *WIN, *XBp; bf16_t *QK, *VIT, *HFQG, *MQ, *GATE;
};

struct SchedP1 {
    unsigned XBp, W; int G, c;
    DI bool next(int i, g8::Unit& u) const {
        const int L = i * G + c; if (L >= 2560) return false;
        if (L < 2048) { const int x = L & 7, off = L >> 3; u.pm = 8 * x + (off & 7); u.pn = off >> 3; u.kind = 0; u.dlb = 1;
            u.a = XBp + (unsigned)u.pm * 256u * D * 2u; u.b = W + (unsigned)u.pn * 256u * D * 2u; }
        else { const int idx = L - 2048; u.pm = idx & 7; u.pn = idx >> 3; u.kind = 1;
            const int dl = u.pm < 2 ? 1 : (u.pm < 4 ? 4 : (u.pm < 6 ? 16 : 1));
            const int v0 = u.pn * 256, lb = v0 / S, vv = v0 % S, per = S / dl, r = vv / per, m0 = vv % per;
            u.dlb = dl; u.a = W + (unsigned)(8192 + u.pm * 256) * D * 2u; u.b = XBp + (unsigned)(lb * S + m0 * dl + r) * D * 2u; }
        return true;
    }
};
DI int frag_row_off(int d0, int r32) { return (((d0 >> 4) * 64 + ((d0 >> 3) & 1) * 32 + r32) * 8); }
struct EpiP1 {
    static constexpr bool PERM = true, HOOK = false;
    char* pr; const float* b_gate;
    DI void hook(f32x4 (&)[2][2][4][2], const g8::Unit&, int, int, int, int, int) const {}
    DI void operator()(const f32x4 (&acc)[2][2][4][2], const g8::Unit& u, int wr, int wc, int fr, int fq) const {
        const int rowl = wr * 64 + fr, d0 = wc * 32 + 8 * fq;
        if (u.kind == 1) {
#pragma unroll
            for (int ai = 0; ai < 2; ++ai)
#pragma unroll
                for (int m = 0; m < 4; ++m) { const int R = u.pm * 256 + rowl + ai * 128 + m * 16;
#pragma unroll
                    for (int bj = 0; bj < 2; ++bj) { const f32x4 v0 = acc[ai][bj][m][0], v1 = acc[ai][bj][m][1];
                        const int c = u.pn * 256 + bj * 128 + d0;
                        if (R < 1536) {
                            const int gh = R >> 7, d = R & 127, lb = c >> 13, pos = c & (S - 1), kk = pos & 31;
                            bf16_t* blk = (bf16_t*)(pr + P_VT) + ((size_t)((lb * 12 + gh) * 256 + (pos >> 5))) * 4096 + (((d >> 5) * 2 + (kk >> 4)) * 64 + (d & 31)) * 8 + 4 * ((kk >> 3) & 1);
                            u32x2 wa, wb; wa.x = cvtpk(v0[0], v0[1]); wa.y = cvtpk(v0[2], v0[3]); wb.x = cvtpk(v1[0], v1[1]); wb.y = cvtpk(v1[2], v1[3]);
                            *(u32x2*)blk = wa; *(u32x2*)(blk + 32 * 8) = wb;
                        } else {
                            u32x4 w; w.x = cvtpk(v0[0], v0[1]); w.y = cvtpk(v0[2], v0[3]); w.z = cvtpk(v1[0], v1[1]); w.w = cvtpk(v1[2], v1[3]);
                            *(u32x4*)((bf16_t*)(pr + P_IT) + (size_t)(R - 1536) * MP + c) = w;
                        } } }
            return;
        }
        if (u.pn < 12 || u.pn == 18 || u.pn == 19) {
#pragma unroll
            for (int ai = 0; ai < 2; ++ai)
#pragma unroll
                for (int m = 0; m < 4; ++m) { const int row = u.pm * 256 + rowl + ai * 128 + m * 16;
#pragma unroll
                    for (int bj = 0; bj < 2; ++bj) { const f32x4 v0 = acc[ai][bj][m][0], v1 = acc[ai][bj][m][1];
                        u32x4 w; w.x = cvtpk(v0[0], v0[1]); w.y = cvtpk(v0[2], v0[3]); w.z = cvtpk(v1[0], v1[1]); w.w = cvtpk(v1[2], v1[3]);
                        bf16_t* dst;
                        if (u.pn < 12) { const int hh = u.pn * 2 + bj, qk = hh >= 12 ? 1 : 0, gh = hh - 12 * qk, lg = (gh >> 2) * 2;
                            const int lb = row >> 13, s = row & (S - 1), pos = ((s & ((1 << lg) - 1)) << (13 - lg)) + (s >> lg);
                            dst = (bf16_t*)(pr + P_QK) + ((size_t)(((qk * BPP + lb) * 12 + gh) * 256 + (pos >> 5))) * 4096 + frag_row_off(d0, pos & 31); }
                        else { const int h = (u.pn - 18) * 2 + bj; dst = (bf16_t*)(pr + P_MQ) + ((size_t)((row >> 5) * 4 + h)) * 4096 + frag_row_off(d0, row & 31); }
                        *(u32x4*)dst = w; } }
            return;
        }
        bf16_t* base; int ldc, colt; bool gate = false;
        if (u.pn < 18) { base = (bf16_t*)(pr + P_HFQG); ldc = 1536; colt = (u.pn - 12) * 256; }
        else { base = (bf16_t*)(pr + P_GATE); ldc = 3072; colt = (u.pn - 20) * 256; gate = true; }
        const int row0 = u.pm * 256 + rowl, col0 = colt + d0;
        f32x4 bv[2][2];
#pragma unroll
        for (int bj = 0; bj < 2; ++bj)
#pragma unroll
            for (int n = 0; n < 2; ++n) bv[bj][n] = gate ? *(const f32x4*)(b_gate + col0 + bj * 128 + 4 * n) : (f32x4){0.f, 0.f, 0.f, 0.f};
#pragma unroll
        for (int ai = 0; ai < 2; ++ai)
#pragma unroll
            for (int m = 0; m < 4; ++m) { bf16_t* rowp = base + (size_t)(row0 + ai * 128 + m * 16) * ldc + col0;
#pragma unroll
                for (int bj = 0; bj < 2; ++bj) { f32x4 v0 = acc[ai][bj][m][0], v1 = acc[ai][bj][m][1];
                    if (gate) { v0 = v0 + bv[bj][0]; v1 = v1 + bv[bj][1];
#pragma unroll
                        for (int e = 0; e < 4; ++e) { v0[e] = fast_sigmoid(v0[e]); v1[e] = fast_sigmoid(v1[e]); } }
                    u32x4 w; w.x = cvtpk(v0[0], v0[1]); w.y = cvtpk(v0[2], v0[3]); w.z = cvtpk(v1[0], v1[1]); w.w = cvtpk(v1[2], v1[3]);
                    *(u32x4*)(rowp + bj * 128) = w; } }
    }
};

typedef float f32x16 __attribute__((ext_vector_type(16)));
typedef short s16x4 __attribute__((ext_vector_type(4)));
DI int crow(int r, int hi) { return (r & 3) + 8 * (r >> 2) + 4 * hi; }
DI float xor32f(float v) { return __shfl_xor(v, 32); }
#define MFMA32(a, b, c) __builtin_amdgcn_mfma_f32_32x32x16_bf16((a), (b), (c), 0, 0, 0)
DI bf16x8 pack8(const f32x16& p, int s) {
    u32x4 w; w.x = cvtpk(p[8 * s + 0], p[8 * s + 1]); w.y = cvtpk(p[8 * s + 2], p[8 * s + 3]); w.z = cvtpk(p[8 * s + 4], p[8 * s + 5]); w.w = cvtpk(p[8 * s + 6], p[8 * s + 7]);
    return __builtin_bit_cast(bf16x8, w);
}
DI bf16x8 ldvt(const bf16_t* vp) {
    const s16x4 lo = *(const s16x4*)vp, hi4 = *(const s16x4*)(vp + 8);
    return __builtin_shufflevector(lo, hi4, 0, 1, 2, 3, 4, 5, 6, 7);
}
constexpr int DIL_TASKS = BPP * 12 * (S / 32);
constexpr int MEM_TASKS = (MP / 32) * 4;
DI void attn_dil_wave(const bf16_t* __restrict__ QK, const bf16_t* __restrict__ VT, const LAS float* btab, bf16_t* __restrict__ OG, float* __restrict__ LSE, int task, int lane) {
    const int r32 = lane & 31, hi = lane >> 5;
    const int q32 = task & 255, gh = (task >> 8) % 12, lb = task / (256 * 12);
    const int g = gh >> 2, h = gh & 3, dl = dil_of(g), per = S / dl;
    const int tok0 = q32 * 32, r = tok0 / per, m0 = tok0 % per;
    const size_t rowq = (size_t)lb * S + (size_t)(m0 + r32) * dl + r;
    bf16x8 qf[8];
    const int tile0 = (r * per + m0) >> 5;
    { const bf16_t* qp = QK + ((size_t)((lb * 12 + gh) * 256 + tile0)) * 4096 + lane * 8;
#pragma unroll
      for (int ks = 0; ks < 8; ++ks) qf[ks] = *(const bf16x8*)(qp + ks * 512); }
    const LAS float* bt = btab + g * 129 * 4 + h;
    f32x16 o[4];
#pragma unroll
    for (int dt = 0; dt < 4; ++dt)
#pragma unroll
        for (int i = 0; i < 16; ++i) o[dt][i] = 0.f;
    float mrun = -INFINITY, sum = 0.f;
    const bf16_t* vbase = VT + ((size_t)((lb * 12 + gh) * 256 + tile0 - 4)) * 4096 + lane * 8;
    const bf16_t* kbase = QK + ((size_t)(((BPP + lb) * 12 + gh) * 256 + tile0 - 4)) * 4096 + lane * 8;
    const int kt0 = (m0 >= 128 ? 0 : (128 - m0) >> 5);
    bf16x8 kf[8], vf[8];
#pragma unroll
    for (int ks = 0; ks < 8; ++ks) kf[ks] = *(const bf16x8*)(kbase + (size_t)kt0 * 4096 + ks * 512);
#pragma unroll 1
    for (int kt = kt0; kt < 5; ++kt) {
#pragma unroll
        for (int i = 0; i < 8; ++i) vf[i] = *(const bf16x8*)(vbase + (size_t)kt * 4096 + i * 512);
        f32x16 sc;
#pragma unroll
        for (int i = 0; i < 16; ++i) sc[i] = 0.f;
#pragma unroll
        for (int ks = 0; ks < 8; ++ks) sc = MFMA32(kf[ks], qf[ks], sc);
        if (kt < 4) {
#pragma unroll
            for (int ks = 0; ks < 8; ++ks) kf[ks] = *(const bf16x8*)(kbase + (size_t)(kt + 1) * 4096 + ks * 512);
        }
        float mx = -INFINITY;
#pragma unroll
        for (int i = 0; i < 16; ++i) {
            const int delta = 128 - 32 * kt + r32 - crow(i, hi);
            const bool valid = (delta >= 0) && (delta <= 128);
            const int di = delta < 0 ? 0 : (delta > 128 ? 128 : delta);
            const float x = sc[i] * (QSCALE * LOG2E) + bt[di * 4];
            sc[i] = valid ? x : -INFINITY; mx = fmaxf(mx, sc[i]);
        }
        mx = fmaxf(mx, xor32f(mx));
        const float mnew = fmaxf(mrun, mx); const float f = __builtin_amdgcn_exp2f(mrun - mnew);
        sum *= f;
#pragma unroll
        for (int dt = 0; dt < 4; ++dt)
#pragma unroll
            for (int i = 0; i < 16; ++i) o[dt][i] *= f;
        mrun = mnew;
        float ps = 0.f;
#pragma unroll
        for (int i = 0; i < 16; ++i) { sc[i] = __builtin_amdgcn_exp2f(sc[i] - mnew); ps += sc[i]; }
        ps += xor32f(ps); sum += ps;
#pragma unroll
        for (int s = 0; s < 2; ++s) {
            const bf16x8 pb = pack8(sc, s);
#pragma unroll
            for (int dt = 0; dt < 4; ++dt) o[dt] = MFMA32(vf[dt * 2 + s], pb, o[dt]);
        }
    }
    const float inv = 1.f / sum;
    bf16_t* op = OG + rowq * 1536 + g * 512 + h * 128 + 4 * hi;
#pragma unroll
    for (int dt = 0; dt < 4; ++dt)
#pragma unroll
        for (int a = 0; a < 4; ++a) { u32x2 w; w.x = cvtpk(o[dt][4 * a] * inv, o[dt][4 * a + 1] * inv); w.y = cvtpk(o[dt][4 * a + 2] * inv, o[dt][4 * a + 3] * inv); *(u32x2*)(op + 32 * dt + 8 * a) = w; }
    if (hi == 0) LSE[rowq * 12 + gh] = (mrun + __builtin_amdgcn_logf(sum)) * 0.6931471805599453f;
}
DI void attn_mem_wave(const bf16_t* __restrict__ MQ, const bf16_t* __restrict__ MK, const bf16_t* __restrict__ MVT, bf16_t* __restrict__ BR, int task, int batch0, int lane) {
    const int r32 = lane & 31, hi = lane >> 5;
    const int h = task & 3, blk = task >> 2;
    const size_t rowq = (size_t)blk * 32 + r32; const int b = batch0 + blk * 32 / S;
    bf16x8 qf[8];
    { const bf16_t* qp = MQ + ((size_t)(blk * 4 + h)) * 4096 + lane * 8;
#pragma unroll
      for (int ks = 0; ks < 8; ++ks) qf[ks] = *(const bf16x8*)(qp + ks * 512); }
    f32x16 o[4];
#pragma unroll
    for (int dt = 0; dt < 4; ++dt)
#pragma unroll
        for (int i = 0; i < 16; ++i) o[dt][i] = 0.f;
    float mrun = -INFINITY, sum = 0.f;
    const bf16_t* vbase = MVT + ((size_t)((b * 4 + h) * 8)) * 4096 + lane * 8;
    const bf16_t* kbase = MK + ((size_t)((b * 4 + h) * 8)) * 4096 + lane * 8;
#pragma unroll 1
    for (int c = 0; c < 4; ++c) {
        f32x16 sc[2]; float mx = -INFINITY;
#pragma unroll
        for (int kt = 0; kt < 2; ++kt) {
            const bf16_t* kp = kbase + (size_t)(c * 2 + kt) * 4096;
            f32x16 acc;
#pragma unroll
            for (int i = 0; i < 16; ++i) acc[i] = 0.f;
#pragma unroll
            for (int ks = 0; ks < 8; ++ks) { const bf16x8 kf = *(const bf16x8*)(kp + ks * 512); acc = MFMA32(kf, qf[ks], acc); }
#pragma unroll
            for (int i = 0; i < 16; ++i) { sc[kt][i] = acc[i] * (QSCALE * LOG2E); mx = fmaxf(mx, sc[kt][i]); }
            asm volatile("" ::: "memory");
        }
        mx = fmaxf(mx, xor32f(mx));
        const float mnew = fmaxf(mrun, mx); const float f = __builtin_amdgcn_exp2f(mrun - mnew);
        sum *= f;
#pragma unroll
        for (int dt = 0; dt < 4; ++dt)
#pragma unroll
            for (int i = 0; i < 16; ++i) o[dt][i] *= f;
        mrun = mnew;
        float ps = 0.f;
#pragma unroll
        for (int kt = 0; kt < 2; ++kt)
#pragma unroll
            for (int i = 0; i < 16; ++i) { sc[kt][i] = __builtin_amdgcn_exp2f(sc[kt][i] - mnew); ps += sc[kt][i]; }
        ps += xor32f(ps); sum += ps;
#pragma unroll
        for (int kt = 0; kt < 2; ++kt)
#pragma unroll
            for (int s = 0; s < 2; ++s) {
                const bf16x8 pb = pack8(sc[kt], s);
#pragma unroll
                for (int dt = 0; dt < 4; ++dt) { const bf16x8 va = *(const bf16x8*)(vbase + (size_t)(c * 2 + kt) * 4096 + (dt * 2 + s) * 512); o[dt] = MFMA32(va, pb, o[dt]); }
                asm volatile("" ::: "memory");
            }
    }
    const float inv = 1.f / sum;
    bf16_t* op = BR + rowq * 1536 + 1024 + h * 128 + 4 * hi;
#pragma unroll
    for (int dt = 0; dt < 4; ++dt)
#pragma unroll
        for (int a = 0; a < 4; ++a) { u32x2 w; w.x = cvtpk(o[dt][4 * a] * inv, o[dt][4 * a + 1] * inv); w.y = cvtpk(o[dt][4 * a + 2] * inv, o[dt][4 * a + 3] * inv); *(u32x2*)(op + 32 * dt + 8 * a) = w; }
}

constexpr int HG_SCH = 4, HG_UPS = S / 64 / HG_SCH  , HG_UNITS = BPP * 4 * HG_UPS  ;
constexpr int HG_ROW = 136, HG_KT_ROW = 72;
constexpr int HG_KP = 0, HG_QP = 64 * HG_ROW * 2, HG_QPP = 2 * HG_QP, HG_KPPT = 3 * HG_QP, HG_DEC = HG_KPPT + 128 * HG_KT_ROW * 2, HG_SSQ = HG_DEC + 512, HG_PSUM = HG_SSQ + 1024, HG_UNIT_BYTES = HG_PSUM + 2048;
DI bf16x8 lds_ld2x8(const LAS unsigned char* p) {
    const s16x4 lo = *(const LAS s16x4*)p, hi4 = *(const LAS s16x4*)(p + 16);
    return __builtin_shufflevector(lo, hi4, 0, 1, 2, 3, 4, 5, 6, 7);
}
DI int opq(int x) { asm volatile("" : "+v"(x)); return x; }
DI float lds_bf(const LAS unsigned char* p) { return __uint_as_float((unsigned)(*(const LAS unsigned short*)p) << 16); }
template <bool MAIN>
DI void hgrn_unit(LAS unsigned char* ul, int unit, int u, const bf16_t* __restrict__ HFQG, const bf16_t* __restrict__ IT, const float* __restrict__ lbv, const float* __restrict__ nwv,
                  float* HSTL, float* HSTD, const float* __restrict__ SIN, bf16_t* __restrict__ BR) {
    constexpr int NX = MAIN ? 4 : 2;
    const int lane = u & 63, w = u >> 6, r32 = lane & 31, hi = lane >> 5, dvt = w & 3, wh = w >> 2;
    const int seq = unit / HG_UPS, j = unit % HG_UPS, lb = seq >> 2, h = seq & 3;
    const int dk = u & 127, qt = u >> 7, cb = 16 * qt;
    const float lbd = lbv[h * 128 + dk];
    const size_t row0 = (size_t)lb * S + (size_t)j * (64 * HG_SCH);
    LAS unsigned char* Kp = ul + HG_KP; LAS unsigned char* Qp = ul + HG_QP; LAS unsigned char* Qpp = ul + HG_QPP; LAS unsigned char* KppT = ul + HG_KPPT;
    LAS float* dec = (LAS float*)(ul + HG_DEC); LAS float* ssq = (LAS float*)(ul + HG_SSQ); LAS float* psum = (LAS float*)(ul + HG_PSUM);
    const int dk0 = MAIN ? 0 : 64 * wh;
    f32x16 X[NX];
    if (MAIN) {
        const float* Sp = SIN + (size_t)unit * 16384 + 32 * dvt + r32;
#pragma unroll
        for (int t = 0; t < NX; ++t)
#pragma unroll
            for (int i = 0; i < 16; ++i) X[t][i] = Sp[(size_t)(32 * t + crow(i, hi)) * 128];
    } else {
#pragma unroll
        for (int t = 0; t < NX; ++t)
#pragma unroll
            for (int i = 0; i < 16; ++i) X[t][i] = 0.f;
    }
    float atot = 0.f;
#pragma unroll 1
    for (int ch = 0; ch < HG_SCH; ++ch) {
        const size_t rc = row0 + (size_t)ch * 64;
        {
            const int sc0 = opq(u) >> 4, sch = (opq(u) & 15) * 8;
            const bf16_t* fp = HFQG + (rc + sc0) * 1536 + h * 128 + sch;
            u32x4 sf[2], sq[2];
#pragma unroll
            for (int i = 0; i < 2; ++i) { sf[i] = *(const u32x4*)(fp + (size_t)(32 * i) * 1536); if (MAIN) sq[i] = *(const u32x4*)(fp + (size_t)(32 * i) * 1536 + 512); }
#pragma unroll
            for (int i = 0; i < 2; ++i) { *(LAS u32x4*)(Kp + ((sc0 + 32 * i) * HG_ROW + sch) * 2) = sf[i]; if (MAIN) *(LAS u32x4*)(Qp + ((sc0 + 32 * i) * HG_ROW + sch) * 2) = sq[i]; }
        }
        __syncthreads();
        {
            float s = 0.f;
#pragma unroll
            for (int i = 0; i < 16; ++i) s += __builtin_amdgcn_logf(lbd + (1.f - lbd) * fast_sigmoid(lds_bf(Kp + ((cb + i) * HG_ROW + dk) * 2)));
            psum[qt * 128 + dk] = s;
        }
        __syncthreads();
        {
            const float p0 = psum[dk], p1 = psum[128 + dk], p2 = psum[256 + dk], p3 = psum[384 + dk];
            const float amid = p0 + p1, alast = (p0 + p1) + (p2 + p3);
            float run = qt == 0 ? 0.f : (qt == 1 ? p0 : (qt == 2 ? amid : amid + p2));
            atot += alast;
#pragma unroll 1
            for (int c8 = 0; c8 < 2; ++c8) {
                float kt[8];
#pragma unroll
                for (int e = 0; e < 8; ++e) { const int c = cb + 8 * c8 + e; const float f = lbd + (1.f - lbd) * fast_sigmoid(lds_bf(Kp + (c * HG_ROW + dk) * 2)); run += __builtin_amdgcn_logf(f); const float key = 1.f - f;
                    kt[e] = key * __builtin_amdgcn_exp2f(alast - run);
                    if (MAIN) { *(LAS bf16_t*)(Kp + (c * HG_ROW + dk) * 2) = f2bf(key * __builtin_amdgcn_exp2f(amid - run));
                        const float q = lds_bf(Qp + (c * HG_ROW + dk) * 2);
                        *(LAS bf16_t*)(Qp + (c * HG_ROW + dk) * 2) = f2bf(q * __builtin_amdgcn_exp2f(run - amid));
                        *(LAS bf16_t*)(Qpp + (c * HG_ROW + dk) * 2) = f2bf(q * __builtin_amdgcn_exp2f(run)); } }
                u32x4 wv; wv.x = cvtpk(kt[0], kt[1]); wv.y = cvtpk(kt[2], kt[3]); wv.z = cvtpk(kt[4], kt[5]); wv.w = cvtpk(kt[6], kt[7]);
                *(LAS u32x4*)(KppT + (dk * HG_KT_ROW + cb + 8 * c8) * 2) = wv;
            }
            if (qt == 0) dec[dk] = __builtin_amdgcn_exp2f(alast);
        }
        __syncthreads();
        f32x16 o;
        const bf16_t* itrow = IT + (size_t)(h * 128 + 32 * dvt + opq(r32)) * MP;
        if (MAIN) {
#pragma unroll
            for (int i = 0; i < 16; ++i) o[i] = 0.f;
            const LAS unsigned char* qrow = Qpp + ((32 * wh + r32) * HG_ROW) * 2;
#pragma unroll
            for (int t = 0; t < 4; ++t)
#pragma unroll
                for (int step = 0; step < 2; ++step) { o = MFMA32(pack8(X[t], step), lds_ld2x8(qrow + (32 * t + 16 * step + 4 * hi) * 2), o); }
            __builtin_amdgcn_sched_barrier(0);
            const int r32m = opq(r32);
            const LAS unsigned char* qprow = Qp + ((32 * wh + r32) * HG_ROW) * 2;
            {
                f32x16 sc;
#pragma unroll
                for (int i = 0; i < 16; ++i) sc[i] = 0.f;
#pragma unroll
                for (int ks = 0; ks < 8; ++ks) { const int cof = (16 * ks + 8 * hi) * 2; sc = MFMA32(*(const LAS bf16x8*)(Kp + (r32 * HG_ROW) * 2 + cof), *(const LAS bf16x8*)(qprow + cof), sc); }
                if (wh == 0) {
#pragma unroll
                    for (int i = 0; i < 16; ++i) sc[i] = (crow(i, hi) <= r32m) ? sc[i] : 0.f;
                }
#pragma unroll
                for (int step = 0; step < 2; ++step) o = MFMA32(ldvt(itrow + rc + 16 * step + 4 * hi), pack8(sc, step), o);
                __builtin_amdgcn_sched_barrier(0);
            }
            if (wh == 1) {
                f32x16 sc;
#pragma unroll
                for (int i = 0; i < 16; ++i) sc[i] = 0.f;
#pragma unroll
                for (int ks = 0; ks < 8; ++ks) { const int cof = (16 * ks + 8 * hi) * 2; sc = MFMA32(*(const LAS bf16x8*)(Kp + ((32 + r32) * HG_ROW) * 2 + cof), *(const LAS bf16x8*)(qprow + cof), sc); }
#pragma unroll
                for (int i = 0; i < 16; ++i) sc[i] = (crow(i, hi) <= r32m) ? sc[i] : 0.f;
#pragma unroll
                for (int step = 0; step < 2; ++step) o = MFMA32(ldvt(itrow + rc + 32 + 16 * step + 4 * hi), pack8(sc, step), o);
                __builtin_amdgcn_sched_barrier(0);
            }
        }
        {
            bf16x8 ib[4];
#pragma unroll
            for (int ks = 0; ks < 4; ++ks) ib[ks] = *(const bf16x8*)(itrow + rc + 16 * ks + 8 * hi);
#pragma unroll
            for (int t = 0; t < NX; ++t) {
#pragma unroll
                for (int i = 0; i < 16; ++i) X[t][i] *= dec[dk0 + 32 * t + crow(i, hi)];
#pragma unroll
                for (int ks = 0; ks < 4; ++ks) { const bf16x8 ka = *(const LAS bf16x8*)(KppT + ((dk0 + 32 * t + r32) * HG_KT_ROW + 16 * ks + 8 * hi) * 2); X[t] = MFMA32(ka, ib[ks], X[t]); }
                __builtin_amdgcn_sched_barrier(0);
            }
        }
        if (MAIN) {
            float q2 = 0.f;
#pragma unroll
            for (int i = 0; i < 16; ++i) q2 += o[i] * o[i];
            q2 += xor32f(q2); if (hi == 0) ssq[dvt * 64 + 32 * wh + r32] = q2;
        }
        __syncthreads();
        if (MAIN) {
            const int r32o = opq(r32), hio = opq(hi);
            const int c = 32 * wh + r32o; const float tot = ssq[c] + ssq[64 + c] + ssq[128 + c] + ssq[192 + c];
            const float rs = rsqrtf(tot * (1.f / 128.f) + LN_EPS);
            const size_t row = rc + c; const int col = h * 128 + 32 * dvt + 4 * hio;
#pragma unroll
            for (int a4 = 0; a4 < 4; ++a4) {
                const u32x2 gw = *(const u32x2*)(HFQG + row * 1536 + 1024 + col + 8 * a4); const f32x4 nw4 = *(const f32x4*)(nwv + col + 8 * a4);
                const float g0 = __uint_as_float(gw.x << 16), g1 = __uint_as_float(gw.x & 0xffff0000u), g2 = __uint_as_float(gw.y << 16), g3 = __uint_as_float(gw.y & 0xffff0000u);
                const float v0 = o[4 * a4] * rs * nw4[0] * g0 * fast_sigmoid(g0), v1 = o[4 * a4 + 1] * rs * nw4[1] * g1 * fast_sigmoid(g1);
                const float v2 = o[4 * a4 + 2] * rs * nw4[2] * g2 * fast_sigmoid(g2), v3 = o[4 * a4 + 3] * rs * nw4[3] * g3 * fast_sigmoid(g3);
                u32x2 wv; wv.x = cvtpk(v0, v1); wv.y = cvtpk(v2, v3);
                *(u32x2*)(BR + row * 1536 + 512 + col + 8 * a4) = wv;
            }
        }
    }
    if (!MAIN) {
        float* L = HSTL + (size_t)unit * 16384 + 32 * dvt + r32;
#pragma unroll
        for (int t = 0; t < NX; ++t)
#pragma unroll
            for (int i = 0; i < 16; ++i) L[(size_t)(dk0 + 32 * t + crow(i, hi)) * 128] = X[t][i];
        if (qt == 0) HSTD[(size_t)unit * 128 + dk] = __builtin_amdgcn_exp2f(atot);
    }
}
DI void hgrn_scan(const float* __restrict__ HSTL, const float* __restrict__ HSTD, float* __restrict__ SIN, int gt) {
    if (gt >= BPP * 4 * 16384) return;
    const int seq = gt >> 14, el = gt & 16383, dkk = el >> 7;
    float st = 0.f;
    for (int j = 0; j < HG_UPS; ++j) { const size_t uo = (size_t)(seq * HG_UPS + j); SIN[uo * 16384 + el] = st; st = HSTD[uo * 128 + dkk] * st + HSTL[uo * 16384 + el]; }
}

struct SchedRows {
    unsigned A, B; int K, nN, nU, G, c;
    DI bool next(int i, g8::Unit& u) const {
        const int L = i * G + c; if (L >= nU) return false;
        const int x = L & 7, off = L >> 3, grp = off / (8 * nN), o2 = off % (8 * nN);
        const int ppx = nU / nN / 8;
        u.pm = x * ppx + 8 * grp + (o2 & 7); u.pn = o2 >> 3; u.kind = 0; u.dlb = 1;
        u.a = A + (unsigned)u.pm * 256u * K * 2u; u.b = B + (unsigned)u.pn * 256u * K * 2u; return true;
    }
};
DI void unpack8(const u32x4 w, float (&f)[8]) {
    f[0] = __uint_as_float(w.x << 16); f[1] = __uint_as_float(w.x & 0xffff0000u); f[2] = __uint_as_float(w.y << 16); f[3] = __uint_as_float(w.y & 0xffff0000u);
    f[4] = __uint_as_float(w.z << 16); f[5] = __uint_as_float(w.z & 0xffff0000u); f[6] = __uint_as_float(w.w << 16); f[7] = __uint_as_float(w.w & 0xffff0000u);
}
struct EpiWidenF {
    static constexpr bool PERM = true, HOOK = true;
    const bf16_t* GATE; bf16_t* MERGED;
    DI void hook(f32x4 (&acc)[2][2][4][2], const g8::Unit& u, int t, int wr, int wc, int fr, int fq) const {
        if (t != 8 && t != 16) return;
        const int g = (t >> 3) - 1;
        const int row0 = u.pm * 256 + wr * 64 + fr, col0 = u.pn * 256 + wc * 32 + 8 * fq;
#pragma unroll
        for (int ai = 0; ai < 2; ++ai)
#pragma unroll
            for (int m = 0; m < 4; ++m) { const bf16_t* gp = GATE + (size_t)(row0 + ai * 128 + m * 16) * 3072 + g * 1024 + col0;
#pragma unroll
                for (int bj = 0; bj < 2; ++bj) { float ga[8], gb[8]; unpack8(*(const u32x4*)(gp + bj * 128), ga); unpack8(*(const u32x4*)(gp + 1024 + bj * 128), gb);
#pragma unroll
                    for (int e = 0; e < 4; ++e) { acc[ai][bj][m][0][e] *= ga[e] * __builtin_amdgcn_rcpf(gb[e]); acc[ai][bj][m][1][e] *= ga[4 + e] * __builtin_amdgcn_rcpf(gb[4 + e]); } } }
    }
    DI void operator()(const f32x4 (&acc)[2][2][4][2], const g8::Unit& u, int wr, int wc, int fr, int fq) const {
        const int row0 = u.pm * 256 + wr * 64 + fr, col0 = u.pn * 256 + wc * 32 + 8 * fq;
#pragma unroll
        for (int ai = 0; ai < 2; ++ai)
#pragma unroll
            for (int m = 0; m < 4; ++m) { const size_t row = (size_t)(row0 + ai * 128 + m * 16);
#pragma unroll
                for (int bj = 0; bj < 2; ++bj) { float gc[8]; unpack8(*(const u32x4*)(GATE + row * 3072 + 2048 + col0 + bj * 128), gc);
                    const f32x4 v0 = acc[ai][bj][m][0], v1 = acc[ai][bj][m][1];
                    u32x4 w; w.x = cvtpk(v0[0] * gc[0], v0[1] * gc[1]); w.y = cvtpk(v0[2] * gc[2], v0[3] * gc[3]); w.z = cvtpk(v1[0] * gc[4], v1[1] * gc[5]); w.w = cvtpk(v1[2] * gc[6], v1[3] * gc[7]);
                    *(u32x4*)(MERGED + row * 1024 + col0 + bj * 128) = w; } }
    }
};
struct EpiMixF32 {
    static constexpr bool PERM = false, HOOK = false;
    float* C;
    DI void hook(f32x4 (&)[2][2][4][2], const g8::Unit&, int, int, int, int, int) const {}
    DI void operator()(const f32x4 (&acc)[2][2][4][2], const g8::Unit& u, int wr, int wc, int fr, int fq) const {
        const int col0 = u.pn * 256 + wc * 32 + 4 * fq;
#pragma unroll
        for (int ai = 0; ai < 2; ++ai)
#pragma unroll
            for (int m = 0; m < 4; ++m) { float* rp = C + (size_t)(u.pm * 256 + ai * 128 + wr * 64 + m * 16 + fr) * 1024 + col0;
#pragma unroll
                for (int bj = 0; bj < 2; ++bj)
#pragma unroll
                    for (int n = 0; n < 2; ++n) *(f32x4*)(rp + bj * 128 + n * 16) = acc[ai][bj][m][n]; }
    }
};
struct EpiPlainB16 {
    static constexpr bool PERM = true, HOOK = false;
    bf16_t* C; int ldc, pad;
    DI void hook(f32x4 (&)[2][2][4][2], const g8::Unit&, int, int, int, int, int) const {}
    DI void operator()(const f32x4 (&acc)[2][2][4][2], const g8::Unit& u, int wr, int wc, int fr, int fq) const {
        const int row0 = u.pm * 256 + wr * 64 + fr, col0 = u.pn * 256 + wc * 32 + 8 * fq;
#pragma unroll
        for (int ai = 0; ai < 2; ++ai)
#pragma unroll
            for (int m = 0; m < 4; ++m) { bf16_t* rowp = C + (size_t)(row0 + ai * 128 + m * 16) * ldc + col0;
#pragma unroll
                for (int bj = 0; bj < 2; ++bj) { const f32x4 v0 = acc[ai][bj][m][0], v1 = acc[ai][bj][m][1];
                    u32x4 w; w.x = cvtpk(v0[0], v0[1]); w.y = cvtpk(v0[2], v0[3]); w.z = cvtpk(v1[0], v1[1]); w.w = cvtpk(v1[2], v1[3]);
                    *(u32x4*)(rowp + bj * 128) = w; } }
    }
};
DI void lse_merge_items(const bf16_t* __restrict__ OG, const float* __restrict__ LSE, bf16_t* __restrict__ BR, int first, int stride) {
    for (int it = first; it < MP * 64; it += stride) {
        const int row = it >> 6, c8 = it & 63, h = c8 >> 4;
        const float l0 = LSE[(size_t)row * 12 + h], l1 = LSE[(size_t)row * 12 + 4 + h], l2 = LSE[(size_t)row * 12 + 8 + h];
        const float mx = fmaxf(l0, fmaxf(l1, l2)); const float e0 = __expf(l0 - mx), e1 = __expf(l1 - mx), e2 = __expf(l2 - mx); const float inv = 1.f / (e0 + e1 + e2);
        const bf16_t* og = OG + (size_t)row * 1536 + c8 * 8;
        float a[8], b[8], c[8]; unpack8(*(const u32x4*)og, a); unpack8(*(const u32x4*)(og + 512), b); unpack8(*(const u32x4*)(og + 1024), c);
        float r[8];
#pragma unroll
        for (int e = 0; e < 8; ++e) r[e] = (e0 * a[e] + e1 * b[e] + e2 * c[e]) * inv;
        u32x4 w; w.x = cvtpk(r[0], r[1]); w.y = cvtpk(r[2], r[3]); w.z = cvtpk(r[4], r[5]); w.w = cvtpk(r[6], r[7]);
        *(u32x4*)(BR + (size_t)row * 1536 + c8 * 8) = w;
    }
}
DI void ln1_rows(const float* __restrict__ x, const bf16_t* __restrict__ mix, const float* __restrict__ g, const float* __restrict__ b, bf16_t* __restrict__ h1b, unsigned char* __restrict__ h1q, float* __restrict__ hsc, int wave0, int nwaves, int lane) {
    for (int row = wave0; row < MP; row += nwaves) {
        const f32x4* xr = (const f32x4*)(x + (size_t)row * D + 16 * lane);
        const u32x4 ma = *(const u32x4*)(mix + (size_t)row * D + 16 * lane), mb = *(const u32x4*)(mix + (size_t)row * D + 16 * lane + 8);
        float mf[16]; unpack8(ma, *(float(*)[8])&mf[0]); unpack8(mb, *(float(*)[8])&mf[8]);
        f32x4 v[4]; float s = 0.f;
#pragma unroll
        for (int j = 0; j < 4; ++j) { v[j] = xr[j] * ALPHA;
#pragma unroll
            for (int e = 0; e < 4; ++e) { v[j][e] += mf[4 * j + e]; s += v[j][e]; } }
        const float mean = wave_sum(s) * (1.f / D); float q = 0.f;
#pragma unroll
        for (int j = 0; j < 4; ++j) { v[j] = v[j] - mean; q += (v[j][0] * v[j][0] + v[j][1] * v[j][1]) + (v[j][2] * v[j][2] + v[j][3] * v[j][3]); }
        const float rstd = rsqrtf(wave_sum(q) * (1.f / D) + LN_EPS);
        u32x4 o0, o1; float amax = 0.f;
#pragma unroll
        for (int j = 0; j < 4; ++j) { const f32x4 gg = *(const f32x4*)(g + 16 * lane + 4 * j), bb = *(const f32x4*)(b + 16 * lane + 4 * j); const f32x4 o = v[j] * rstd * gg + bb; v[j] = o;
            amax = fmaxf(amax, fmaxf(fmaxf(fabsf(o[0]), fabsf(o[1])), fmaxf(fabsf(o[2]), fabsf(o[3]))));
            if (j < 2) { o0[2 * j] = cvtpk(o[0], o[1]); o0[2 * j + 1] = cvtpk(o[2], o[3]); } else { o1[2 * (j - 2)] = cvtpk(o[0], o[1]); o1[2 * (j - 2) + 1] = cvtpk(o[2], o[3]); } }
        *(u32x4*)(h1b + (size_t)row * D + 16 * lane) = o0; *(u32x4*)(h1b + (size_t)row * D + 16 * lane + 8) = o1;
        amax = wave_max(amax); const float qs = amax > 0.f ? 127.f / amax : 1.f;
        u32x4 qv;
#pragma unroll
        for (int j = 0; j < 4; ++j) qv[j] = ((unsigned)__float2int_rn(v[j][0] * qs) & 0xffu) | (((unsigned)__float2int_rn(v[j][1] * qs) & 0xffu) << 8) | (((unsigned)__float2int_rn(v[j][2] * qs) & 0xffu) << 16) | (((unsigned)__float2int_rn(v[j][3] * qs) & 0xffu) << 24);
        *(u32x4*)(h1q + (size_t)row * D + 16 * lane) = qv;
        if (lane == 0) hsc[row] = amax > 0.f ? amax * (1.f / 127.f) : 1.f;
    }
}

DI unsigned mono(float f) { const unsigned u = __float_as_uint(f); return (u & 0x80000000u) ? ~u : (u | 0x80000000u); }
DI float demono(unsigned m) { return __uint_as_float((m & 0x80000000u) ? (m & 0x7fffffffu) : ~m); }
#define CE_DESC(a, b) do { const unsigned _hi = (a) > (b) ? (a) : (b), _lo = (a) > (b) ? (b) : (a); (a) = _hi; (b) = _lo; } while (0)
DI void sort16_desc(unsigned (&k)[16]) {
#pragma unroll
    for (int size = 2; size <= 16; size <<= 1)
#pragma unroll
        for (int stride = size >> 1; stride > 0; stride >>= 1)
#pragma unroll
            for (int i = 0; i < 16; ++i) { const int j = i ^ stride;
                if (j > i) { if ((i & size) == 0 || size == 16) CE_DESC(k[i], k[j]); else CE_DESC(k[j], k[i]); } }
}
DI void merge_top16(unsigned (&t)[16], const unsigned (&l)[16]) {
#pragma unroll
    for (int i = 0; i < 16; ++i) t[i] = t[i] > l[15 - i] ? t[i] : l[15 - i];
#pragma unroll
    for (int stride = 8; stride > 0; stride >>= 1)
#pragma unroll
        for (int i = 0; i < 16; ++i) { const int j = i ^ stride; if (j > i) CE_DESC(t[i], t[j]); }
}
constexpr int RT_ROW = 136;
constexpr int RT_LDS_BYTES = 2 * 128 * RT_ROW * 2;
DI void route_wave(const bf16_t* __restrict__ PQ, const LAS unsigned char* keys, int* __restrict__ IDX, float* __restrict__ PG, int tb, int h, int lane) {
    const int r32 = lane & 31, hi = lane >> 5;
    const size_t tok = (size_t)tb * 32 + r32;
    unsigned Tp[2][16];
#pragma unroll
    for (int p = 0; p < 2; ++p) {
        bf16x8 qf[8];
        const bf16_t* qp = PQ + tok * 2048 + h * 256 + p * 128 + 8 * hi;
#pragma unroll
        for (int ks = 0; ks < 8; ++ks) qf[ks] = *(const bf16x8*)(qp + 16 * ks);
#pragma unroll
        for (int nt = 0; nt < 4; ++nt) {
            f32x16 acc;
#pragma unroll
            for (int i = 0; i < 16; ++i) acc[i] = 0.f;
#pragma unroll
            for (int ks = 0; ks < 8; ++ks) { const bf16x8 kf = *(const LAS bf16x8*)(keys + ((p * 128 + 32 * nt + r32) * RT_ROW + 16 * ks + 8 * hi) * 2); acc = MFMA32(kf, qf[ks], acc); }
            unsigned L[16];
#pragma unroll
            for (int i = 0; i < 16; ++i) L[i] = (mono(acc[i]) & ~0x7fu) | (unsigned)(127 - (32 * nt + crow(i, hi)));
            sort16_desc(L);
            if (nt == 0) {
#pragma unroll
                for (int i = 0; i < 16; ++i) Tp[p][i] = L[i];
            } else merge_top16(Tp[p], L);
            __builtin_amdgcn_sched_barrier(0);
        }
    }
    unsigned T[16];
    { unsigned O[16];
#pragma unroll
      for (int i = 0; i < 16; ++i) { const auto rr = __builtin_amdgcn_permlane32_swap(Tp[0][i], Tp[1][i], false, false); T[i] = rr[0]; O[i] = rr[1]; }
      merge_top16(T, O); }
    __builtin_amdgcn_sched_barrier(0);
    float s1[16], s2[16]; unsigned i1[16], i2[16];
#pragma unroll
    for (int i = 0; i < 16; ++i) { const auto rr = __builtin_amdgcn_permlane32_swap(T[i], T[i], false, false);
        s1[i] = demono(rr[0] & ~0x7fu); i1[i] = 127u - (rr[0] & 0x7fu); s2[i] = demono(rr[1] & ~0x7fu); i2[i] = 127u - (rr[1] & 0x7fu); }
    unsigned C[64];
    { int n = 0;
#pragma unroll
      for (int a = 0; a < 16; ++a)
#pragma unroll
          for (int b = 0; b < 16; ++b) if ((a + 1) * (b + 1) <= 16) { C[n] = (mono(s1[a] + s2[b]) & ~0x3fffu) | (i1[a] << 7) | i2[b]; ++n; }
#pragma unroll
      for (int i = 50; i < 64; ++i) C[i] = 0u; }
    unsigned F[16];
#pragma unroll
    for (int i = 0; i < 16; ++i) F[i] = C[i];
    sort16_desc(F);
#pragma unroll
    for (int g = 1; g < 4; ++g) { unsigned L[16];
#pragma unroll
        for (int i = 0; i < 16; ++i) L[i] = C[16 * g + i];
        sort16_desc(L); merge_top16(F, L); __builtin_amdgcn_sched_barrier(0); }
    if (hi == 0) {
        float e[16]; float sum = 0.f; const float v0 = demono(F[0] & ~0x3fffu);
#pragma unroll
        for (int i = 0; i < 16; ++i) { e[i] = __expf(demono(F[i] & ~0x3fffu) - v0); sum += e[i]; }
        const float inv = 1.f / sum;
        int* ip = IDX + tok * 128 + h * 16; float* gp = PG + tok * 128 + h * 16;
#pragma unroll
        for (int q = 0; q < 4; ++q) { u32x4 iv; iv.x = F[4 * q] & 0x3fffu; iv.y = F[4 * q + 1] & 0x3fffu; iv.z = F[4 * q + 2] & 0x3fffu; iv.w = F[4 * q + 3] & 0x3fffu; *(u32x4*)(ip + 4 * q) = iv;
            f32x4 gv; gv[0] = e[4 * q] * inv; gv[1] = e[4 * q + 1] * inv; gv[2] = e[4 * q + 2] * inv; gv[3] = e[4 * q + 3] * inv; *(f32x4*)(gp + 4 * q) = gv; }
    }
}
typedef __bf16 bf16x2v __attribute__((ext_vector_type(2)));
DI float dot2bf(unsigned w, unsigned x, float acc) { return __builtin_amdgcn_fdot2_f32_bf16(__builtin_bit_cast(bf16x2v, w), __builtin_bit_cast(bf16x2v, x), acc, false); }
DI float gelu_erf(float v) {
    const float av = fabsf(v), t = __builtin_amdgcn_rcpf(av * 0.2316418882f + 1.0f);
    float q = t * 0.5307027145f + (-0.7265760135f); q = q * t + 0.7107068705f; q = q * t + (-0.142248368f); q = q * t + 0.127414796f; q = q * t;
    const float e = __builtin_amdgcn_exp2f((v * v) * (-0.72134752044f)); const float m = v * (q * e);
    return v < 0.f ? m : v - m;
}
DI float dppf(float v, const int ctrl_sel) {
    const int s = __float_as_int(v);
    int r;
    if (ctrl_sel == 0) r = __builtin_amdgcn_update_dpp(0, s, 0xB1, 0xF, 0xF, true);
    else if (ctrl_sel == 1) r = __builtin_amdgcn_update_dpp(0, s, 0x4E, 0xF, 0xF, true);
    else if (ctrl_sel == 2) r = __builtin_amdgcn_update_dpp(0, s, 0x141, 0xF, 0xF, true);
    else r = __builtin_amdgcn_update_dpp(0, s, 0x128, 0xF, 0xF, true);
    return __int_as_float(r);
}
DI int dppi(int s, const int ctrl_sel) {
    if (ctrl_sel == 0) return __builtin_amdgcn_update_dpp(0, s, 0xB1, 0xF, 0xF, true);
    if (ctrl_sel == 1) return __builtin_amdgcn_update_dpp(0, s, 0x4E, 0xF, 0xF, true);
    return __builtin_amdgcn_update_dpp(0, s, 0x141, 0xF, 0xF, true);
}
template <int NT>
DI void experts_u_slice(const unsigned char* __restrict__ H1Q, const unsigned char* __restrict__ U8x, const int* __restrict__ IDX, bf16_t* __restrict__ PD, size_t tok, int x, int lane) {
    const int g = lane >> 3, l8 = lane & 7;
    u32x4 hq[NT], iv[NT][4], w[NT][16];
#pragma unroll
    for (int t = 0; t < NT; ++t) { hq[t] = *(const u32x4*)(H1Q + (tok + t) * D + 128 * x + 16 * l8);
#pragma unroll
        for (int q = 0; q < 4; ++q) iv[t][q] = *(const u32x4*)(IDX + (tok + t) * 128 + 16 * g + 4 * q); }
#pragma unroll
    for (int t = 0; t < NT; ++t)
#pragma unroll
        for (int j = 0; j < 16; ++j) w[t][j] = *(const u32x4*)(U8x + (size_t)(iv[t][j >> 2][j & 3] * 128u + 16u * l8));
#pragma unroll
    for (int t = 0; t < NT; ++t) {
        float p[16];
#pragma unroll
        for (int j = 0; j < 16; ++j) { int d = 0;
#pragma unroll
            for (int q = 0; q < 4; ++q) d = __builtin_amdgcn_sdot4((int)w[t][j][q], (int)hq[t][q], d, false);
            d += dppi(d, 0); d += dppi(d, 1); d += dppi(d, 2); p[j] = (float)d; }
        if (l8 == 0) {
            u32x4 o0, o1;
            o0.x = cvtpk(p[0], p[1]); o0.y = cvtpk(p[2], p[3]); o0.z = cvtpk(p[4], p[5]); o0.w = cvtpk(p[6], p[7]);
            o1.x = cvtpk(p[8], p[9]); o1.y = cvtpk(p[10], p[11]); o1.z = cvtpk(p[12], p[13]); o1.w = cvtpk(p[14], p[15]);
            bf16_t* dp = PD + ((tok + t) * 8 + x) * 128 + 16 * g; *(u32x4*)dp = o0; *(u32x4*)(dp + 8) = o1;
        }
    }
}
DI void experts_combine(const bf16_t* __restrict__ PD, const int* __restrict__ IDX, const float* __restrict__ PG, const float* __restrict__ USC, const float* __restrict__ VSC, const float* __restrict__ HSC, float* __restrict__ C, size_t first, size_t stride) {
    for (size_t i = first; i < (size_t)M * 128; i += stride) {
        const size_t tok = i >> 7; const int e = (int)(i & 127);
        float s = 0.f;
#pragma unroll
        for (int x = 0; x < 8; ++x) s += bf2f(PD[(tok * 8 + x) * 128 + e]);
        const int row = IDX[i];
        C[i] = PG[i] * gelu_erf(s * USC[row] * HSC[tok]) * VSC[row];
    }
}
template <int NT>
DI void experts_v_slice(const unsigned char* __restrict__ V8x, const int* __restrict__ IDX, const float* __restrict__ C, bf16_t* __restrict__ FFN, size_t tok, int x, int lane) {
    const int g = lane >> 3, l8 = lane & 7;
    u32x4 iv[NT][4], w[NT][16]; f32x4 cv[NT][4];
#pragma unroll
    for (int t = 0; t < NT; ++t)
#pragma unroll
        for (int q = 0; q < 4; ++q) { iv[t][q] = *(const u32x4*)(IDX + (tok + t) * 128 + 16 * g + 4 * q); cv[t][q] = *(const f32x4*)(C + (tok + t) * 128 + 16 * g + 4 * q); }
#pragma unroll
    for (int t = 0; t < NT; ++t)
#pragma unroll
        for (int j = 0; j < 16; ++j) w[t][j] = *(const u32x4*)(V8x + (size_t)(iv[t][j >> 2][j & 3] * 128u + 16u * l8));
#pragma unroll
    for (int t = 0; t < NT; ++t) {
        f32x2 f2[8];
#pragma unroll
        for (int i = 0; i < 8; ++i) f2[i] = (f32x2){0.f, 0.f};
#pragma unroll
        for (int j = 0; j < 16; ++j) { const float c = cv[t][j >> 2][j & 3]; const f32x2 c2 = {c, c};
#pragma unroll
            for (int q = 0; q < 4; ++q) { f2[2 * q] += c2 * __builtin_amdgcn_cvt_pk_f32_fp8((int)w[t][j][q], false); f2[2 * q + 1] += c2 * __builtin_amdgcn_cvt_pk_f32_fp8((int)w[t][j][q], true); } }
#pragma unroll
        for (int i = 0; i < 8; ++i)
#pragma unroll
            for (int k = 0; k < 2; ++k) { float s = f2[i][k]; s += dppf(s, 3); s += __shfl_xor(s, 16); s += __shfl_xor(s, 32); f2[i][k] = s; }
        if (g == 0) {
            u32x4 o0, o1;
            o0.x = cvtpk(f2[0][0], f2[0][1]); o0.y = cvtpk(f2[1][0], f2[1][1]); o0.z = cvtpk(f2[2][0], f2[2][1]); o0.w = cvtpk(f2[3][0], f2[3][1]);
            o1.x = cvtpk(f2[4][0], f2[4][1]); o1.y = cvtpk(f2[5][0], f2[5][1]); o1.z = cvtpk(f2[6][0], f2[6][1]); o1.w = cvtpk(f2[7][0], f2[7][1]);
            bf16_t* dp = FFN + (tok + t) * D + 128 * x + 16 * l8; *(u32x4*)dp = o0; *(u32x4*)(dp + 8) = o1;
        }
    }
}
DI void ln2_token(const bf16_t* __restrict__ FFN, const bf16_t* __restrict__ H1B, const float* __restrict__ g2, const float* __restrict__ b2, float* __restrict__ outp, size_t tok, int lane) {
    float* hr = outp + tok * D + 16 * lane;
    const u32x4 fa = *(const u32x4*)(FFN + tok * D + 16 * lane), fb = *(const u32x4*)(FFN + tok * D + 16 * lane + 8);
    const u32x4 ha = *(const u32x4*)(H1B + tok * D + 16 * lane), hb = *(const u32x4*)(H1B + tok * D + 16 * lane + 8);
    float ff[16], hh[16]; unpack8(fa, *(float(*)[8])&ff[0]); unpack8(fb, *(float(*)[8])&ff[8]); unpack8(ha, *(float(*)[8])&hh[0]); unpack8(hb, *(float(*)[8])&hh[8]);
    f32x4 v[4];
#pragma unroll
    for (int j = 0; j < 4; ++j)
#pragma unroll
        for (int e = 0; e < 4; ++e) v[j][e] = hh[4 * j + e];
    float s = 0.f;
#pragma unroll
    for (int j = 0; j < 4; ++j)
#pragma unroll
        for (int e = 0; e < 4; ++e) { v[j][e] = v[j][e] * ALPHA + ff[4 * j + e]; s += v[j][e]; }
    const float mean = wave_sum(s) * (1.f / D); float q2 = 0.f;
#pragma unroll
    for (int j = 0; j < 4; ++j)
#pragma unroll
        for (int e = 0; e < 4; ++e) { v[j][e] -= mean; q2 += v[j][e] * v[j][e]; }
    const float rstd = rsqrtf(wave_sum(q2) * (1.f / D) + LN_EPS);
#pragma unroll
    for (int j = 0; j < 4; ++j) { const f32x4 gg = *(const f32x4*)(g2 + 16 * lane + 4 * j), bb = *(const f32x4*)(b2 + 16 * lane + 4 * j); *(f32x4*)(hr + 4 * j) = v[j] * rstd * gg + bb; }
}

DI void p0_convert(const float* __restrict__ in, bf16_t* __restrict__ out, size_t n8, size_t first, size_t stride) {
    for (size_t i = first; i < n8; i += stride) { const f32x4 a = ((const f32x4*)in)[2 * i], b = ((const f32x4*)in)[2 * i + 1];
        u32x4 w; w.x = cvtpk(a[0], a[1]); w.y = cvtpk(a[2], a[3]); w.z = cvtpk(b[0], b[1]); w.w = cvtpk(b[2], b[3]); ((u32x4*)out)[i] = w; }
}
DI void p0_transpose_item(const float* __restrict__ W, int ldw, int ncols, bf16_t* __restrict__ out, int ldo, int koff, LAS float* scr, int item, int lane) {
    const int nblk = ncols / 32, kb = item / nblk, nb = item % nblk, k0 = 64 * kb, n0 = 32 * nb;
#pragma unroll 8
    for (int i = 0; i < 32; ++i) { const int kk = 2 * i + (lane >> 5); scr[kk * 33 + (lane & 31)] = W[(size_t)(k0 + kk) * ldw + n0 + (lane & 31)]; }
    asm volatile("s_waitcnt lgkmcnt(0)" ::: "memory");
    const int c = lane & 7;
#pragma unroll
    for (int j = 0; j < 4; ++j) { const int n = (lane >> 3) + 8 * j; const LAS float* s = scr + (8 * c) * 33 + n;
        u32x4 o; o.x = cvtpk(s[0 * 33], s[1 * 33]); o.y = cvtpk(s[2 * 33], s[3 * 33]); o.z = cvtpk(s[4 * 33], s[5 * 33]); o.w = cvtpk(s[6 * 33], s[7 * 33]);
        *(u32x4*)(out + (size_t)(n0 + n) * ldo + koff + k0 + 8 * c) = o; }
    asm volatile("s_waitcnt lgkmcnt(0)" ::: "memory");
}
template <bool I8>
DI void p0_fp8_row(const float* __restrict__ src, unsigned char* __restrict__ dst, float* __restrict__ scale, int row, int lane) {
    const f32x4* sp = (const f32x4*)(src + (size_t)row * D) + 4 * lane;
    f32x4 v[4]; float mx = 0.f;
#pragma unroll
    for (int j = 0; j < 4; ++j) { v[j] = sp[j]; mx = fmaxf(mx, fmaxf(fmaxf(fabsf(v[j][0]), fabsf(v[j][1])), fmaxf(fabsf(v[j][2]), fabsf(v[j][3])))); }
    mx = wave_max(mx);
    const float top = I8 ? 127.f : 224.f;
    const float sc = mx > 0.f ? top / mx : 1.f;
    u32x4 w;
#pragma unroll
    for (int j = 0; j < 4; ++j) {
        if (I8) { w[j] = ((unsigned)__float2int_rn(v[j][0] * sc) & 0xffu) | (((unsigned)__float2int_rn(v[j][1] * sc) & 0xffu) << 8) | (((unsigned)__float2int_rn(v[j][2] * sc) & 0xffu) << 16) | (((unsigned)__float2int_rn(v[j][3] * sc) & 0xffu) << 24); }
        else { int p = 0; p = __builtin_amdgcn_cvt_pk_fp8_f32(v[j][0] * sc, v[j][1] * sc, p, false); p = __builtin_amdgcn_cvt_pk_fp8_f32(v[j][2] * sc, v[j][3] * sc, p, true); w[j] = (unsigned)p; } }
    *(u32x4*)(dst + (size_t)(lane >> 3) * ((size_t)NEXP * 128) + (size_t)row * 128 + 16 * (lane & 7)) = w;
    if (lane == 0) scale[row] = mx > 0.f ? mx / top : 1.f;
}
DI void p0_misc(const float* __restrict__ hgrn_lb, const float* __restrict__ rel_bias, float* __restrict__ misc, int i) {
    if (i < 512) { const float a = hgrn_lb[i], b = hgrn_lb[512 + i]; const float mx = fmaxf(a, b); const float ea = expf(a - mx), eb = expf(b - mx); misc[i] = ea / (ea + eb); }
    if (i < 3 * 129) {
        const int g = i / 129, j = i % 129; const int dl = g == 0 ? 1 : (g == 1 ? 4 : 16); const int n = j * dl;
        int bucket;
        if (n < 16) bucket = n;
        else { const double v = log((double)n / 16.0) / log(128.0) * 16.0; int l = 16 + (int)v; bucket = l < 31 ? l : 31; }
        for (int h = 0; h < 4; ++h) misc[512 + i * 4 + h] = rel_bias[bucket * 12 + g * 4 + h];
    }
}
struct SchedMemKV {
    unsigned MEMB, W; int G, c;
    DI bool next(int i, g8::Unit& u) const {
        const int L = i * G + c; if (L >= 32) return false;
        u.dlb = 1;
        if (L < 16) { u.kind = 0; u.pm = L >> 1; u.pn = L & 1; u.a = MEMB + (unsigned)u.pm * 256u * D * 2u; u.b = W + (unsigned)u.pn * 256u * D * 2u; }
        else { const int q = L - 16; u.kind = 1; u.pm = q >> 3; u.pn = q & 7; u.a = W + (unsigned)(512 + u.pm * 256) * D * 2u; u.b = MEMB + (unsigned)u.pn * 256u * D * 2u; }
        return true;
    }
};
struct EpiMemKVF {
    static constexpr bool PERM = true, HOOK = false;
    bf16_t *MK, *MVT;
    DI void hook(f32x4 (&)[2][2][4][2], const g8::Unit&, int, int, int, int, int) const {}
    DI void operator()(const f32x4 (&acc)[2][2][4][2], const g8::Unit& u, int wr, int wc, int fr, int fq) const {
        const int rowl = wr * 64 + fr, d0 = wc * 32 + 8 * fq;
#pragma unroll
        for (int ai = 0; ai < 2; ++ai)
#pragma unroll
            for (int m = 0; m < 4; ++m) { const int R = u.pm * 256 + rowl + ai * 128 + m * 16;
#pragma unroll
                for (int bj = 0; bj < 2; ++bj) { const f32x4 v0 = acc[ai][bj][m][0], v1 = acc[ai][bj][m][1];
                    if (u.kind == 0) { const int b = R >> 8, mm = R & 255, h = u.pn * 2 + bj;
                        u32x4 w; w.x = cvtpk(v0[0], v0[1]); w.y = cvtpk(v0[2], v0[3]); w.z = cvtpk(v1[0], v1[1]); w.w = cvtpk(v1[2], v1[3]);
                        *(u32x4*)(MK + ((size_t)((b * 4 + h) * 8 + (mm >> 5))) * 4096 + frag_row_off(d0, mm & 31)) = w; }
                    else { const int h = R >> 7, d = R & 127, c = u.pn * 256 + bj * 128 + d0, b = c >> 8, mm = c & 255, kk = mm & 31;
                        bf16_t* blk = MVT + ((size_t)((b * 4 + h) * 8 + (mm >> 5))) * 4096 + (((d >> 5) * 2 + (kk >> 4)) * 64 + (d & 31)) * 8 + 4 * ((kk >> 3) & 1);
                        u32x2 wa, wb; wa.x = cvtpk(v0[0], v0[1]); wa.y = cvtpk(v0[2], v0[3]); wb.x = cvtpk(v1[0], v1[1]); wb.y = cvtpk(v1[2], v1[3]);
                        *(u32x2*)blk = wa; *(u32x2*)(blk + 32 * 8) = wb; } } }
    }
};

static_assert(HG_UNIT_BYTES <= LDSCTL_OFF, "hgrn LDS");
DI const float* karg_in(int i) { const float* const* kp = (const float* const*)__builtin_amdgcn_kernarg_segment_ptr(); asm volatile("" : "+s"(kp)); return kp[i]; }
DI float* karg_out() { float* const* kp = (float* const*)__builtin_amdgcn_kernarg_segment_ptr(); asm volatile("" : "+s"(kp)); return kp[18]; }
__global__ void __launch_bounds__(NTHR, 2) mega(Args args) {
    extern __shared__ __attribute__((aligned(16))) unsigned char lds_raw[];
    LAS unsigned char* lds = (LAS unsigned char*)lds_raw;
    volatile LAS unsigned* MISC = (volatile LAS unsigned*)(lds + MISC_OFF);
    for (int u = threadIdx.x; u < (LDS_BYTES - LDSCTL_OFF) / 4; u += NTHR) ((LAS unsigned*)(lds + LDSCTL_OFF))[u] = 0u;
    __syncthreads();
    unsigned char* ws = args.ws;
    const int G = gridDim.x;
    const bool ALL = args.ph == PH_ALL;
    XcdBarrier bar; bar.bar = (unsigned*)(ws + O_MISC + 16384); bar.x = 0; bar.st = nullptr;
    if (ALL) bar = xcd_barrier_post((unsigned*)(ws + O_MISC + 16384), MISC + 8);
#ifndef REP_MASK
#define REP_MASK 0
#endif
#define RUN(k) (ALL || args.ph == (k))
#define NREP(k) (((REP_MASK >> (k)) & 1) ? 2 : 1)
#define SEAM() do { if (ALL) xcd_barrier(bar); } while (0)
    for (int rep_ = 0; rep_ < NREP(PH_PRO); ++rep_) if (RUN(PH_PRO)) {
        int tid = threadIdx.x; asm volatile("" : "+v"(tid)); asm volatile("" : "+s"(ws)); int bid = blockIdx.x; asm volatile("" : "+s"(bid));
        const size_t gt = (size_t)bid * NTHR + tid, nth = (size_t)G * NTHR;
        p0_convert(karg_in(0), (bf16_t*)(ws + O_XB), (size_t)M * D / 8, gt, nth);
        p0_convert(karg_in(1), (bf16_t*)(ws + O_MEMB), (size_t)2048 * 1024 / 8, gt, nth);
        p0_convert(karg_in(13), (bf16_t*)(ws + O_SUBK), (size_t)16 * 128 * 128 / 8, gt, nth);
        if (bid == 0) p0_misc(karg_in(6), karg_in(5), (float*)(ws + O_MISC), tid);
        const int wid = __builtin_amdgcn_readfirstlane(tid >> 6), lane = tid & 63;
        LAS float* scr = (LAS float*)(lds + wid * 16384);
        const int gw = bid * NWAVES + wid, ngw = G * NWAVES;
        for (int r = gw; r < 2 * NEXP; r += ngw) {
            if (r < NEXP) p0_fp8_row<true>(karg_in(14), (unsigned char*)(ws + O_UB), (float*)(ws + O_USC), r, lane);
            else p0_fp8_row<false>(karg_in(15), (unsigned char*)(ws + O_VB), (float*)(ws + O_VSC), r - NEXP, lane);
        }
        constexpr int NJ = 13;
        for (int it = gw; ; it += ngw) {
            int r = it; bool done = true;
#pragma unroll
            for (int j = 0; j < NJ; ++j) {
                const int srcc[NJ] = {0, 4608, 5632, 6656, 7168, 3072, 5120, 0, 0, 0, 0, 0, 0};
                const int cnt[NJ] = {3072, 512, 1024, 512, 3072, 1536, 512, 1024, 1024, 1024, 1024, 1024, 2048};
                const int drow[NJ] = {0, 3072, 3584, 4608, 5120, 8192, 9728, 0, 0, 0, 0, 0, 0};
                const int Kj = (j >= 8 && j <= 10) ? 512 : 1024;
                const int items = (Kj / 64) * (cnt[j] / 32);
                if (done && r < items) {
                    const float* W; int ldw; bf16_t* o; int ldo, koff = 0;
                    if (j < 7) { W = karg_in(2) + srcc[j]; ldw = INC; o = (bf16_t*)(ws + O_WIN) + (size_t)drow[j] * 1024; ldo = 1024; }
                    else if (j == 7) { W = karg_in(4); ldw = 1024; o = (bf16_t*)(ws + O_WMKV); ldo = 1024; }
                    else if (j <= 10) { W = karg_in(8) + (size_t)(j - 8) * 512 * 1024; ldw = 1024; o = (bf16_t*)(ws + O_WBR); ldo = 1536; koff = (j - 8) * 512; }
                    else if (j == 11) { W = karg_in(9); ldw = 1024; o = (bf16_t*)(ws + O_WOUT); ldo = 1024; }
                    else { W = karg_in(12); ldw = 2048; o = (bf16_t*)(ws + O_WPQ); ldo = 1024; }
                    p0_transpose_item(W, ldw, cnt[j], o, ldo, koff, scr, r, lane); done = false;
                }
                r -= items;
            }
            if (done) break;
        }
        SEAM();
    }
#pragma unroll 1
    for (int p = (ALL ? 0 : args.pass); p < (ALL ? NPASS : args.pass + 1); ++p) {
        int bid = blockIdx.x; asm volatile("" : "+s"(bid));
        int tid = threadIdx.x; asm volatile("" : "+v"(tid));
        asm volatile("" : "+s"(ws));
        char* pr = (char*)ws + O_PASS;
        const size_t t0 = (size_t)p * MP;
        for (int rep_ = 0; rep_ < NREP(PH_PROJ); ++rep_) if (RUN(PH_PROJ)) {
            asm volatile("" : "+s"(bid)); asm volatile("" : "+v"(tid)); asm volatile("" : "+s"(ws)); pr = (char*)ws + O_PASS;
            SchedP1 Sc{(unsigned)(O_XB + t0 * D * 2), (unsigned)O_WIN, G, bid};
            EpiP1 E{pr, karg_in(3)};
            g8::gemm_phase<EpiP1, SchedP1>(lds, (const char*)ws, D, Sc, E, tid);
            if (p == 0) {
                SchedMemKV S2{(unsigned)O_MEMB, (unsigned)O_WMKV, G, bid};
                EpiMemKVF E2{(bf16_t*)(ws + O_MK), (bf16_t*)(ws + O_MVT)};
                g8::gemm_phase<EpiMemKVF, SchedMemKV>(lds, (const char*)ws, D, S2, E2, tid);
            }
            SEAM();
        }
        for (int rep_ = 0; rep_ < NREP(PH_ATTN); ++rep_) if (RUN(PH_ATTN)) {
            asm volatile("" : "+s"(bid)); asm volatile("" : "+v"(tid)); asm volatile("" : "+s"(ws)); pr = (char*)ws + O_PASS;
            const float* bsrc = (const float*)(ws + O_MISC) + 512; LAS float* btab = (LAS float*)lds;
            for (int i = tid; i < 3 * 129 * 4; i += NTHR) btab[i] = bsrc[i] * LOG2E;
            __syncthreads();
            const int wid = __builtin_amdgcn_readfirstlane(tid >> 6), lane = tid & 63;
            for (int task = bid * NWAVES + wid; task < DIL_TASKS; task += G * NWAVES)
                attn_dil_wave((const bf16_t*)(pr + P_QK), (const bf16_t*)(pr + P_VT), btab, (bf16_t*)(pr + P_OG), (float*)(pr + P_LSE), task, lane);
            for (int task = bid * NWAVES + wid; task < MEM_TASKS; task += G * NWAVES)
                attn_mem_wave((const bf16_t*)(pr + P_MQ), (const bf16_t*)(ws + O_MK), (const bf16_t*)(ws + O_MVT), (bf16_t*)(pr + P_BR), task, p * BPP, lane);
            __syncthreads();
        }
        for (int rep_ = 0; rep_ < NREP(PH_HGPRE); ++rep_) if (RUN(PH_HGPRE)) {
            asm volatile("" : "+s"(bid)); asm volatile("" : "+v"(tid)); asm volatile("" : "+s"(ws)); pr = (char*)ws + O_PASS;
            { const int unit = bid; static_assert(HG_UNITS == 256, "one HGRN unit per workgroup"); if (unit < HG_UNITS) {
                hgrn_unit<false>(lds, unit, tid, (const bf16_t*)(pr + P_HFQG), (const bf16_t*)(pr + P_IT), (const float*)(ws + O_MISC), karg_in(7),
                                 (float*)(pr + P_HSTL), (float*)(pr + P_HSTD), (const float*)(pr + P_SIN), (bf16_t*)(pr + P_BR));
            } }
            SEAM();
        }
        for (int rep_ = 0; rep_ < NREP(PH_HGSCAN); ++rep_) if (RUN(PH_HGSCAN)) {
            asm volatile("" : "+s"(bid)); asm volatile("" : "+v"(tid)); asm volatile("" : "+s"(ws)); pr = (char*)ws + O_PASS;
            hgrn_scan((const float*)(pr + P_HSTL), (const float*)(pr + P_HSTD), (float*)(pr + P_SIN), bid * NTHR + tid);
            lse_merge_items((const bf16_t*)(pr + P_OG), (const float*)(pr + P_LSE), (bf16_t*)(pr + P_BR), bid * NTHR + tid, G * NTHR);
            SEAM();
        }
        for (int rep_ = 0; rep_ < NREP(PH_HGMAIN); ++rep_) if (RUN(PH_HGMAIN)) {
            asm volatile("" : "+s"(bid)); asm volatile("" : "+v"(tid)); asm volatile("" : "+s"(ws)); pr = (char*)ws + O_PASS;
            { const int unit = bid; static_assert(HG_UNITS == 256, "one HGRN unit per workgroup"); if (unit < HG_UNITS) {
                hgrn_unit<true>(lds, unit, tid, (const bf16_t*)(pr + P_HFQG), (const bf16_t*)(pr + P_IT), (const float*)(ws + O_MISC), karg_in(7),
                                (float*)(pr + P_HSTL), (float*)(pr + P_HSTD), (const float*)(pr + P_SIN), (bf16_t*)(pr + P_BR));
            } }
            SEAM();
        }
        for (int rep_ = 0; rep_ < NREP(PH_WIDEN); ++rep_) if (RUN(PH_WIDEN)) {
            asm volatile("" : "+s"(bid)); asm volatile("" : "+v"(tid)); asm volatile("" : "+s"(ws)); pr = (char*)ws + O_PASS;
            SchedRows Sc{(unsigned)(O_PASS + P_BR), (unsigned)O_WBR, 1536, 4, 256, G, bid};
            EpiWidenF E{(const bf16_t*)(pr + P_GATE), (bf16_t*)(pr + P_MERGED)};
            g8::gemm_phase<EpiWidenF, SchedRows>(lds, (const char*)ws, 1536, Sc, E, tid);
            SEAM();
        }
        for (int rep_ = 0; rep_ < NREP(PH_WOUT); ++rep_) if (RUN(PH_WOUT)) {
            asm volatile("" : "+s"(bid)); asm volatile("" : "+v"(tid)); asm volatile("" : "+s"(ws)); pr = (char*)ws + O_PASS;
            SchedRows Sc{(unsigned)(O_PASS + P_MERGED), (unsigned)O_WOUT, 1024, 4, 256, G, bid};
            EpiPlainB16 E{(bf16_t*)(pr + P_MIX), 1024, 0};
            g8::gemm_phase<EpiPlainB16, SchedRows>(lds, (const char*)ws, 1024, Sc, E, tid);
            SEAM();
        }
        for (int rep_ = 0; rep_ < NREP(PH_LN1); ++rep_) if (RUN(PH_LN1)) {
            asm volatile("" : "+s"(bid)); asm volatile("" : "+v"(tid)); asm volatile("" : "+s"(ws)); pr = (char*)ws + O_PASS;
            ln1_rows(karg_in(0) + t0 * D, (const bf16_t*)(pr + P_MIX), karg_in(10), karg_in(11), (bf16_t*)(ws + O_H1B) + t0 * D, (unsigned char*)(ws + O_H1Q) + t0 * D, (float*)(ws + O_HSC) + t0, bid * NWAVES + (tid >> 6), G * NWAVES, tid & 63);
        }
    }
    for (int rep_ = 0; rep_ < NREP(PH_PQ); ++rep_) if (RUN(PH_PQ)) {
        SEAM();
        int tid = threadIdx.x; asm volatile("" : "+v"(tid)); asm volatile("" : "+s"(ws)); int bid = blockIdx.x; asm volatile("" : "+s"(bid));
        char* pr = (char*)ws + O_PASS;
        SchedRows Sc{(unsigned)O_H1B, (unsigned)O_WPQ, 1024, 8, 2048, G, bid};
        EpiPlainB16 E{(bf16_t*)(pr + P_PQ), 2048, 0};
        g8::gemm_phase<EpiPlainB16, SchedRows>(lds, (const char*)ws, 1024, Sc, E, tid);
        SEAM();
    }
    for (int rep_ = 0; rep_ < NREP(PH_ROUTE); ++rep_) if (RUN(PH_ROUTE)) {
        int tid = threadIdx.x; asm volatile("" : "+v"(tid)); asm volatile("" : "+s"(ws)); int bid = blockIdx.x; asm volatile("" : "+s"(bid));
        char* pr = (char*)ws + O_PASS;
        const int h = bid & 7, wgi = bid >> 3, nwg = G >> 3;
        const bf16_t* ksrc = (const bf16_t*)(ws + O_SUBK) + (size_t)h * 2 * 128 * 128;
        for (int i = tid; i < 2 * 128 * 16; i += NTHR) { const int rowk = i >> 4, ch = i & 15; *(LAS u32x4*)(lds + (rowk * RT_ROW + ch * 8) * 2) = *(const u32x4*)(ksrc + rowk * 128 + ch * 8); }
        __syncthreads();
        const int wid = __builtin_amdgcn_readfirstlane(tid >> 6), lane = tid & 63;
        for (int tb = wgi * NWAVES + wid; tb < M / 32; tb += nwg * NWAVES)
            route_wave((const bf16_t*)(pr + P_PQ), lds, (int*)(pr + P_IDX), (float*)(pr + P_PG), tb, h, lane);
        __syncthreads();
        SEAM();
    }
    if (RUN(PH_EXPERTS)) {
        int tid = threadIdx.x; asm volatile("" : "+v"(tid)); asm volatile("" : "+s"(ws)); int bid = blockIdx.x; asm volatile("" : "+s"(bid));
        char* pr = (char*)ws + O_PASS;
        const int wid = __builtin_amdgcn_readfirstlane(tid >> 6), lane = tid & 63;
        if (tid == 0) {
            unsigned base = 0; const unsigned myx = ALL ? bar.x : 0u;
            if (ALL) { for (unsigned jx = 0; jx < 16; ++jx) { const unsigned c = xb_ld(&bar.bar[XB_XCNT(jx)]); if (jx < myx) base += c; } MISC[12] = base + MISC[10]; }
            else MISC[12] = (unsigned)bid;
        }
        __syncthreads();
        const int vwg = (int)MISC[12];
        const int nper = G >> 3, x = vwg / nper, r = vwg % nper;
        const int tpw = M / (nper * NWAVES);
        const size_t tokw0 = (size_t)(r * NWAVES + wid) * tpw;
        {
            const unsigned char* U8x = (const unsigned char*)(ws + O_UB) + (size_t)x * ((size_t)NEXP * 128);
            for (int i = 0; i < tpw; i += 2) experts_u_slice<2>((const unsigned char*)(ws + O_H1Q), U8x, (const int*)(pr + P_IDX), (bf16_t*)(pr + P_PD), tokw0 + i, x, lane);
        }
        SEAM();
        experts_combine((const bf16_t*)(pr + P_PD), (const int*)(pr + P_IDX), (const float*)(pr + P_PG), (const float*)(ws + O_USC), (const float*)(ws + O_VSC), (const float*)(ws + O_HSC), (float*)(pr + P_C), (size_t)bid * NTHR + tid, (size_t)G * NTHR);
        SEAM();
        {
            const unsigned char* V8x = (const unsigned char*)(ws + O_VB) + (size_t)x * ((size_t)NEXP * 128);
            for (int i = 0; i < tpw; i += 2) experts_v_slice<2>(V8x, (const int*)(pr + P_IDX), (const float*)(pr + P_C), (bf16_t*)(pr + P_FFN), tokw0 + i, x, lane);
        }
        SEAM();
        for (int tok = bid * NWAVES + wid; tok < M; tok += G * NWAVES) ln2_token((const bf16_t*)(pr + P_FFN), (const bf16_t*)(ws + O_H1B), karg_in(16), karg_in(17), karg_out(), (size_t)tok, lane);
    }
#undef RUN
#undef SEAM
}

extern "C" void kernel_launch(void* const* d_in, const int* in_sizes, int n_in, void* d_out, int out_size, void* d_ws, size_t ws_size, hipStream_t stream) {
    if (ws_size < WS_NEED || n_in != 18) return;
    static bool attr_set = false;
    if (!attr_set) { (void)hipFuncSetAttribute((const void*)mega, hipFuncAttributeMaxDynamicSharedMemorySize, LDS_BYTES); attr_set = true; }
    (void)hipMemsetAsync((char*)d_ws + O_MISC + 16384, 0, 16384, stream);
    Args a{}; for (int i = 0; i < 18; ++i) a.in[i] = (const float*)d_in[i]; a.out = (float*)d_out; a.ws = (unsigned char*)d_ws; a.ph = PH_ALL; a.pass = 0;
    mega<<<256, NTHR, LDS_BYTES, stream>>>(a);
}
```

```cpp
#include <hip/hip_runtime.h>
#include <stdint.h>
#include <math.h>

typedef unsigned short bf16_t;
typedef short bf16x8 __attribute__((ext_vector_type(8)));
typedef float f32x4 __attribute__((ext_vector_type(4)));
#define DI __device__ __forceinline__

DI float bf2f(bf16_t v) { return __uint_as_float(((unsigned)v) << 16); }
DI bf16_t f2bf(float f) { unsigned u = __float_as_uint(f); u += 0x7fffu + ((u >> 16) & 1u); return (bf16_t)(u >> 16); }

constexpr int NB = 8, S = 8192, D = 1024, M = NB * S;
constexpr int NPASS = 4, BPP = NB / NPASS, MP = BPP * S;
constexpr int INC = 10240;
constexpr int NEXP = 16384;
constexpr float ALPHA = 1.189207115002721f;
constexpr float LN_EPS = 1e-5f;
constexpr float QSCALE = 0.08838834764831845f;

constexpr size_t al(size_t x) { return (x + 255) & ~(size_t)255; }
constexpr size_t O_WIN = 0;
constexpr size_t O_WMKV = O_WIN + al((size_t)INC * D * 2);
constexpr size_t O_WBR = O_WMKV + al((size_t)1024 * 1024 * 2);
constexpr size_t O_WOUT = O_WBR + al((size_t)1024 * 1536 * 2);
constexpr size_t O_WPQ = O_WOUT + al((size_t)1024 * 1024 * 2);
constexpr size_t O_SUBK = O_WPQ + al((size_t)2048 * 1024 * 2);
constexpr size_t O_UB = O_SUBK + al((size_t)16 * 128 * 128 * 2);
constexpr size_t O_VB = O_UB + al((size_t)NEXP * D);
constexpr size_t O_USC = O_VB + al((size_t)NEXP * D);
constexpr size_t O_VSC = O_USC + al((size_t)NEXP * 4);
constexpr size_t O_XB = O_VSC + al((size_t)NEXP * 4);
constexpr size_t O_MEMB = O_XB + al((size_t)M * D * 2);
constexpr size_t O_MK = O_MEMB + al((size_t)2048 * 1024 * 2);
constexpr size_t O_MVT = O_MK + al((size_t)2048 * 512 * 2);
constexpr size_t O_H1B = O_MVT + al((size_t)8 * 512 * 256 * 2);
constexpr size_t O_H1Q = O_H1B + al((size_t)M * D * 2);
constexpr size_t O_HSC = O_H1Q + al((size_t)M * D);
constexpr size_t O_MISC = O_HSC + al((size_t)M * 4);
constexpr size_t O_PASS = O_MISC + al(65536);
constexpr size_t P_QK = 0;
constexpr size_t P_VT = P_QK + al((size_t)MP * 3072 * 2);
constexpr size_t P_IT = P_VT + (size_t)1536 * MP * 2;
constexpr size_t P_HFQG = P_IT + al((size_t)512 * MP * 2);
constexpr size_t P_MQ = P_HFQG + al((size_t)MP * 1536 * 2);
constexpr size_t P_GATE = P_MQ + al((size_t)MP * 512 * 2);
constexpr size_t P_OG = P_GATE + al((size_t)MP * 3072 * 2);
constexpr size_t P_LSE = P_OG + al((size_t)MP * 1536 * 2);
constexpr size_t P_BR = P_LSE + al((size_t)MP * 12 * 4);
constexpr size_t P_MERGED = P_BR + al((size_t)MP * 1536 * 2);
constexpr size_t P_MIX = P_MERGED + al((size_t)MP * 1024 * 2);
constexpr size_t P_HSTL = P_MIX + al((size_t)MP * 1024 * 4);
constexpr size_t P_HSTD = P_HSTL + al((size_t)256 * 16384 * 4);
constexpr size_t P_SIN = P_HSTD + al((size_t)256 * 128 * 4);
constexpr size_t P_END = P_SIN + al((size_t)256 * 16384 * 4);
constexpr size_t P_PQ = 0;
constexpr size_t P_IDX = P_PQ + al((size_t)M * 2048 * 2);
constexpr size_t P_PG = P_IDX + al((size_t)M * 128 * 4);
constexpr size_t P_C = P_PG + al((size_t)M * 128 * 4);
constexpr size_t P_END2 = P_C + al((size_t)M * 128 * 4);
constexpr size_t P_PD = 0;
constexpr size_t P_FFN = P_PD + al((size_t)M * 1024 * 2);
static_assert(P_FFN + (size_t)M * 1024 * 2 <= P_IDX, "PEER overlay");
constexpr size_t WS_NEED = O_PASS + (P_END > P_END2 ? P_END : P_END2);
static_assert(WS_NEED <= (size_t)1073741824, "workspace budget");

__global__ __launch_bounds__(256) void k_convert(const float* __restrict__ in, bf16_t* __restrict__ out, size_t n4) {
    size_t i = (size_t)blockIdx.x * 256 + threadIdx.x; const size_t st = (size_t)gridDim.x * 256;
    for (; i < n4; i += st) { const f32x4 v = ((const f32x4*)in)[i]; ushort4 o; o.x = f2bf(v[0]); o.y = f2bf(v[1]); o.z = f2bf(v[2]); o.w = f2bf(v[3]); ((ushort4*)out)[i] = o; }
}
__global__ __launch_bounds__(256) void k_transpose(const float* __restrict__ W, int K, int ldw, bf16_t* __restrict__ out, int ldo, int koff) {
    __shared__ float t[32][33];
    const int k0 = blockIdx.y * 32, n0 = blockIdx.x * 32, tx = threadIdx.x & 31, ty = threadIdx.x >> 5;
    for (int i = ty; i < 32; i += 8) t[i][tx] = W[(size_t)(k0 + i) * ldw + n0 + tx];
    __syncthreads();
    for (int i = ty; i < 32; i += 8) out[(size_t)(n0 + i) * ldo + koff + k0 + tx] = f2bf(t[tx][i]);
}
__global__ void k_misc(const float* __restrict__ hgrn_lb, const float* __restrict__ rel_bias, float* __restrict__ misc) {
    const int i = blockIdx.x * blockDim.x + threadIdx.x;
    if (i < 512) { const float a = hgrn_lb[i], b = hgrn_lb[512 + i]; const float mx = fmaxf(a, b); const float ea = expf(a - mx), eb = expf(b - mx); misc[i] = ea / (ea + eb); }
    if (i < 3 * 129) {
        const int g = i / 129, j = i % 129; const int dl = g == 0 ? 1 : (g == 1 ? 4 : 16); const int n = j * dl;
        int bucket;
        if (n < 16) bucket = n;
        else { const double v = log((double)n / 16.0) / log(128.0) * 16.0; int l = 16 + (int)v; bucket = l < 31 ? l : 31; }
        for (int h = 0; h < 4; ++h) misc[512 + i * 4 + h] = rel_bias[bucket * 12 + g * 4 + h];
    }
}

template <class Epi>
__global__ __launch_bounds__(256) void gemm_simple(const bf16_t* __restrict__ A, int lda, const bf16_t* __restrict__ Bt, int ldb, int K, Epi epi) {
    const int lane = threadIdx.x & 63, w = threadIdx.x >> 6;
    const int row0 = blockIdx.y * 64 + (w >> 1) * 32, col0 = blockIdx.x * 64 + (w & 1) * 32;
    const int fr = lane & 15, fq = lane >> 4;
    f32x4 acc[2][2];
#pragma unroll
    for (int a = 0; a < 2; ++a)
#pragma unroll
        for (int b = 0; b < 2; ++b) acc[a][b] = (f32x4){0.f, 0.f, 0.f, 0.f};
    const bf16_t* ap = A + (size_t)(row0 + fr) * lda + fq * 8;
    const bf16_t* bp = Bt + (size_t)(col0 + fr) * ldb + fq * 8;
    for (int k0 = 0; k0 < K; k0 += 32) {
        const bf16x8 a0 = *(const bf16x8*)(ap + k0), a1 = *(const bf16x8*)(ap + (size_t)16 * lda + k0);
        const bf16x8 b0 = *(const bf16x8*)(bp + k0), b1 = *(const bf16x8*)(bp + (size_t)16 * ldb + k0);
        acc[0][0] = __builtin_amdgcn_mfma_f32_16x16x32_bf16(a0, b0, acc[0][0], 0, 0, 0);
        acc[0][1] = __builtin_amdgcn_mfma_f32_16x16x32_bf16(a0, b1, acc[0][1], 0, 0, 0);
        acc[1][0] = __builtin_amdgcn_mfma_f32_16x16x32_bf16(a1, b0, acc[1][0], 0, 0, 0);
        acc[1][1] = __builtin_amdgcn_mfma_f32_16x16x32_bf16(a1, b1, acc[1][1], 0, 0, 0);
    }
#pragma unroll
    for (int mi = 0; mi < 2; ++mi)
#pragma unroll
        for (int ni = 0; ni < 2; ++ni)
#pragma unroll
            for (int j = 0; j < 4; ++j) epi(row0 + mi * 16 + fq * 4 + j, col0 + ni * 16 + fr, acc[mi][ni][j]);
}

DI int dil_of(int g) { return g == 0 ? 1 : (g == 1 ? 4 : 16); }
DI int perm_tok(int lb, int s, int dl) { return lb * S + (s % dl) * (S / dl) + s / dl; }

struct EpiProj {
    bf16_t *QK, *VT, *HFQG, *IT, *MQ, *GATE; const float* b_gate;
    DI void operator()(int row, int col, float v) const {
        if (col < 3072) QK[(size_t)row * 3072 + col] = f2bf(v);
        else if (col < 4608) { const int c = col - 3072, g = c >> 9; VT[(size_t)c * MP + perm_tok(row / S, row % S, dil_of(g))] = f2bf(v); }
        else if (col < 5120) HFQG[(size_t)row * 1536 + (col - 4608)] = f2bf(v);
        else if (col < 5632) IT[(size_t)(col - 5120) * MP + row] = f2bf(v);
        else if (col < 6656) HFQG[(size_t)row * 1536 + (col - 5632) + 512] = f2bf(v);
        else if (col < 7168) MQ[(size_t)row * 512 + (col - 6656)] = f2bf(v);
        else { const int c = col - 7168; const float z = v + b_gate[c]; GATE[(size_t)row * 3072 + c] = f2bf(1.f / (1.f + expf(-z))); }
    }
};
struct EpiMemKV {
    bf16_t *MK, *MVT;
    DI void operator()(int row, int col, float v) const {
        if (col < 512) MK[(size_t)row * 512 + col] = f2bf(v);
        else MVT[((size_t)(row >> 8) * 512 + (col - 512)) * 256 + (row & 255)] = f2bf(v);
    }
};
struct EpiWiden {
    const bf16_t* GATE; float* TMP; bf16_t* MERGED; int g, pad;
    DI void operator()(int row, int col, float v) const {
        const float gv = bf2f(GATE[(size_t)row * 3072 + g * 1024 + col]) * v; const size_t o = (size_t)row * 1024 + col;
        if (g == 0) TMP[o] = gv; else if (g == 1) TMP[o] += gv; else MERGED[o] = f2bf(TMP[o] + gv);
    }
};
struct EpiF32 { float* C; int ldc, pad; DI void operator()(int row, int col, float v) const { C[(size_t)row * ldc + col] = v; } };
struct EpiB16 { bf16_t* C; int ldc, pad; DI void operator()(int row, int col, float v) const { C[(size_t)row * ldc + col] = f2bf(v); } };

DI float wave_max(float v) {
#pragma unroll
    for (int o = 1; o < 64; o <<= 1) v = fmaxf(v, __shfl_xor(v, o));
    return v;
}
DI float wave_sum(float v) {
#pragma unroll
    for (int o = 1; o < 64; o <<= 1) v += __shfl_xor(v, o);
    return v;
}

__global__ __launch_bounds__(256) void k_dil_attn(const bf16_t* __restrict__ QK, const bf16_t* __restrict__ VT, const float* __restrict__ BIAS, bf16_t* __restrict__ OG, float* __restrict__ LSE) {
    __shared__ float ps[4][192];
    const int lane = threadIdx.x & 63, w = threadIdx.x >> 6;
    const long task = (long)blockIdx.x * 4 + w;
    const int gh = (int)(task % 12); const int row = (int)(task / 12);
    const int g = gh >> 2, h = gh & 3, dl = dil_of(g);
    const int lb = row / S, s = row % S, m = s / dl, r = s % dl;
    const bf16_t* qp = QK + (size_t)row * 3072 + gh * 128;
    float lg[3]; float mx = -INFINITY;
#pragma unroll
    for (int i = 0; i < 3; ++i) {
        const int j = lane + 64 * i; float l = -INFINITY;
        if (j <= 128 && m - j >= 0) {
            const int krow = lb * S + (m - j) * dl + r; const bf16_t* kp = QK + (size_t)krow * 3072 + 1536 + gh * 128;
            float dot = 0.f;
            for (int d = 0; d < 128; ++d) dot += bf2f(qp[d]) * bf2f(kp[d]);
            l = dot * QSCALE + BIAS[(g * 129 + j) * 4 + h];
        }
        lg[i] = l; mx = fmaxf(mx, l);
    }
    mx = wave_max(mx);
    float sum = 0.f;
#pragma unroll
    for (int i = 0; i < 3; ++i) { const float p = (lg[i] == -INFINITY) ? 0.f : expf(lg[i] - mx); ps[w][lane + 64 * i] = p; sum += p; }
    sum = wave_sum(sum);
    __syncthreads();
    const int nk = m < 128 ? m : 128;
    const float inv = 1.f / sum;
#pragma unroll
    for (int i = 0; i < 2; ++i) {
        const int d = lane + 64 * i; const bf16_t* vp = VT + (size_t)(g * 512 + h * 128 + d) * MP + lb * S + r * (S / dl);
        float o = 0.f;
        for (int j = 0; j <= nk; ++j) o += ps[w][j] * bf2f(vp[m - j]);
        OG[(size_t)row * 1536 + g * 512 + h * 128 + d] = f2bf(o * inv);
    }
    if (lane == 0) LSE[(size_t)row * 12 + gh] = mx + logf(sum);
}
__global__ __launch_bounds__(256) void k_merge(const bf16_t* __restrict__ OG, const float* __restrict__ LSE, bf16_t* __restrict__ BR) {
    const long i = (long)blockIdx.x * 256 + threadIdx.x;
    const int row = (int)(i >> 9), c = (int)(i & 511), h = c >> 7;
    const float l0 = LSE[(size_t)row * 12 + h], l1 = LSE[(size_t)row * 12 + 4 + h], l2 = LSE[(size_t)row * 12 + 8 + h];
    const float mx = fmaxf(l0, fmaxf(l1, l2)); const float e0 = expf(l0 - mx), e1 = expf(l1 - mx), e2 = expf(l2 - mx); const float inv = 1.f / (e0 + e1 + e2);
    const bf16_t* og = OG + (size_t)row * 1536 + c;
    BR[(size_t)row * 1536 + c] = f2bf((e0 * bf2f(og[0]) + e1 * bf2f(og[512]) + e2 * bf2f(og[1024])) * inv);
}
__global__ __launch_bounds__(256) void k_mem_attn(const bf16_t* __restrict__ MQ, const bf16_t* __restrict__ MK, const bf16_t* __restrict__ MVT, bf16_t* __restrict__ BR, int batch0) {
    __shared__ float ps[4][256];
    const int lane = threadIdx.x & 63, w = threadIdx.x >> 6;
    const long task = (long)blockIdx.x * 4 + w;
    const int h = (int)(task & 3); const int row = (int)(task >> 2);
    const int b = batch0 + row / S;
    const bf16_t* qp = MQ + (size_t)row * 512 + h * 128;
    float lg[4]; float mx = -INFINITY;
#pragma unroll
    for (int i = 0; i < 4; ++i) {
        const int j = lane + 64 * i; const bf16_t* kp = MK + (size_t)(b * 256 + j) * 512 + h * 128;
        float dot = 0.f;
        for (int d = 0; d < 128; ++d) dot += bf2f(qp[d]) * bf2f(kp[d]);
        lg[i] = dot * QSCALE; mx = fmaxf(mx, lg[i]);
    }
    mx = wave_max(mx);
    float sum = 0.f;
#pragma unroll
    for (int i = 0; i < 4; ++i) { const float p = expf(lg[i] - mx); ps[w][lane + 64 * i] = p; sum += p; }
    sum = wave_sum(sum);
    __syncthreads();
    const float inv = 1.f / sum;
#pragma unroll
    for (int i = 0; i < 2; ++i) {
        const int d = lane + 64 * i; const bf16_t* vp = MVT + ((size_t)b * 512 + h * 128 + d) * 256;
        float o = 0.f;
        for (int j = 0; j < 256; ++j) o += ps[w][j] * bf2f(vp[j]);
        BR[(size_t)row * 1536 + 1024 + h * 128 + d] = f2bf(o * inv);
    }
}
__global__ __launch_bounds__(128) void k_hgrn(const bf16_t* __restrict__ HFQG, const bf16_t* __restrict__ IT, const float* __restrict__ lbv, const float* __restrict__ norm_w, bf16_t* __restrict__ BR) {
    __shared__ float sf[128], sk[128], sq[128], red[2];
    const int tid = threadIdx.x, h = blockIdx.x & 3, lb = blockIdx.x >> 2;
    const float lbd = lbv[h * 128 + tid], nw = norm_w[h * 128 + tid];
    float St[128];
#pragma unroll
    for (int i = 0; i < 128; ++i) St[i] = 0.f;
    for (int s = 0; s < S; ++s) {
        const size_t row = (size_t)lb * S + s;
        const float fr = bf2f(HFQG[row * 1536 + h * 128 + tid]);
        const float f = lbd + (1.f - lbd) / (1.f + expf(-fr));
        sf[tid] = f; sk[tid] = 1.f - f; sq[tid] = bf2f(HFQG[row * 1536 + 512 + h * 128 + tid]);
        __syncthreads();
        const float iv = bf2f(IT[(size_t)(h * 128 + tid) * MP + row]);
        float o = 0.f;
#pragma unroll
        for (int d = 0; d < 128; ++d) { St[d] = sf[d] * St[d] + sk[d] * iv; o += sq[d] * St[d]; }
        const float ss = wave_sum(o * o);
        if ((tid & 63) == 0) red[tid >> 6] = ss;
        __syncthreads();
        const float ms = (red[0] + red[1]) * (1.f / 128.f);
        const float gv = bf2f(HFQG[row * 1536 + 1024 + h * 128 + tid]);
        BR[row * 1536 + 512 + h * 128 + tid] = f2bf(o * rsqrtf(ms + LN_EPS) * nw * (gv / (1.f + expf(-gv))));
    }
}
__global__ __launch_bounds__(256) void k_ln1(const float* __restrict__ x, const float* __restrict__ mix, const float* __restrict__ g, const float* __restrict__ b, float* __restrict__ h1f, bf16_t* __restrict__ h1b) {
    __shared__ float red[8];
    const size_t row = blockIdx.x; const int tid = threadIdx.x;
    float v[4]; float s = 0.f;
#pragma unroll
    for (int i = 0; i < 4; ++i) { const int c = tid + 256 * i; v[i] = ALPHA * x[row * D + c] + mix[row * D + c]; s += v[i]; }
    s = wave_sum(s); if ((tid & 63) == 0) red[tid >> 6] = s; __syncthreads();
    const float mean = (red[0] + red[1] + red[2] + red[3]) * (1.f / D);
    float q = 0.f;
#pragma unroll
    for (int i = 0; i < 4; ++i) { v[i] -= mean; q += v[i] * v[i]; }
    q = wave_sum(q); if ((tid & 63) == 0) red[4 + (tid >> 6)] = q; __syncthreads();
    const float rstd = rsqrtf((red[4] + red[5] + red[6] + red[7]) * (1.f / D) + LN_EPS);
#pragma unroll
    for (int i = 0; i < 4; ++i) { const int c = tid + 256 * i; const float o = v[i] * rstd * g[c] + b[c]; h1f[row * D + c] = o; h1b[row * D + c] = f2bf(o); }
}

DI void ins16(float (&tv)[16], int (&ti)[16], float v, int i) {
#pragma unroll
    for (int j = 0; j < 16; ++j) { const bool gt = v > tv[j]; const float ov = tv[j]; const int oi = ti[j]; tv[j] = gt ? v : ov; ti[j] = gt ? i : oi; v = gt ? ov : v; i = gt ? oi : i; }
}
__global__ __launch_bounds__(256) void k_route(const bf16_t* __restrict__ PQ, const bf16_t* __restrict__ SUBK, int* __restrict__ IDX, float* __restrict__ PG) {
    const long gi = (long)blockIdx.x * 256 + threadIdx.x;
    const int h = (int)(gi & 7); const size_t t = (size_t)(gi >> 3);
    float s1[16], s2[16]; int i1[16], i2[16];
#pragma unroll
    for (int j = 0; j < 16; ++j) { s1[j] = -INFINITY; s2[j] = -INFINITY; i1[j] = 0; i2[j] = 0; }
    const bf16_t* q0 = PQ + t * 2048 + h * 256;
    for (int n = 0; n < 128; ++n) {
        const bf16_t* k0 = SUBK + (size_t)((h * 2 + 0) * 128 + n) * 128; const bf16_t* k1 = SUBK + (size_t)((h * 2 + 1) * 128 + n) * 128;
        float a = 0.f, b = 0.f;
        for (int k = 0; k < 128; ++k) { a += bf2f(q0[k]) * bf2f(k0[k]); b += bf2f(q0[128 + k]) * bf2f(k1[k]); }
        ins16(s1, i1, a, n); ins16(s2, i2, b, n);
    }
    float cv[16]; int ci[16];
#pragma unroll
    for (int j = 0; j < 16; ++j) { cv[j] = -INFINITY; ci[j] = 0; }
#pragma unroll
    for (int a = 0; a < 16; ++a)
#pragma unroll
        for (int b = 0; b < 16; ++b) ins16(cv, ci, s1[a] + s2[b], i1[a] * 128 + i2[b]);
    float sum = 0.f; float e[16];
#pragma unroll
    for (int j = 0; j < 16; ++j) { e[j] = expf(cv[j] - cv[0]); sum += e[j]; }
    const float inv = 1.f / sum;
#pragma unroll
    for (int j = 0; j < 16; ++j) { IDX[t * 128 + h * 16 + j] = ci[j]; PG[t * 128 + h * 16 + j] = e[j] * inv; }
}
__global__ __launch_bounds__(256) void k_experts(const float* h1f_in, const bf16_t* __restrict__ h1b, const bf16_t* __restrict__ UB, const bf16_t* __restrict__ VB, const int* __restrict__ IDX, const float* __restrict__ PG,
                                                 const float* __restrict__ g2, const float* __restrict__ b2, float* out) {
    __shared__ float hrow[1024]; __shared__ float cw[128]; __shared__ int eid[128]; __shared__ float red[8];
    const size_t t = blockIdx.x; const int tid = threadIdx.x, lane = tid & 63, w = tid >> 6;
    float hv[4];
#pragma unroll
    for (int i = 0; i < 4; ++i) { const int c = tid + 256 * i; hv[i] = h1f_in[t * D + c]; hrow[c] = bf2f(h1b[t * D + c]); }
    if (tid < 128) eid[tid] = IDX[t * 128 + tid];
    __syncthreads();
    for (int e = w; e < 128; e += 4) {
        const bf16_t* up = UB + (size_t)eid[e] * D; float dot = 0.f;
#pragma unroll
        for (int i = 0; i < 16; ++i) dot += hrow[lane + 64 * i] * bf2f(up[lane + 64 * i]);
        dot = wave_sum(dot);
        if (lane == 0) cw[e] = PG[t * 128 + e] * 0.5f * dot * (1.f + erff(dot * 0.7071067811865476f));
    }
    __syncthreads();
    float f[4] = {0.f, 0.f, 0.f, 0.f};
    for (int e = 0; e < 128; ++e) { const bf16_t* vp = VB + (size_t)eid[e] * D; const float c = cw[e];
#pragma unroll
        for (int i = 0; i < 4; ++i) f[i] += c * bf2f(vp[tid + 256 * i]); }
    float v[4]; float s = 0.f;
#pragma unroll
    for (int i = 0; i < 4; ++i) { v[i] = ALPHA * hv[i] + f[i]; s += v[i]; }
    s = wave_sum(s); if (lane == 0) red[w] = s; __syncthreads();
    const float mean = (red[0] + red[1] + red[2] + red[3]) * (1.f / D);
    float q = 0.f;
#pragma unroll
    for (int i = 0; i < 4; ++i) { v[i] -= mean; q += v[i] * v[i]; }
    q = wave_sum(q); if (lane == 0) red[4 + w] = q; __syncthreads();
    const float rstd = rsqrtf((red[4] + red[5] + red[6] + red[7]) * (1.f / D) + LN_EPS);
#pragma unroll
    for (int i = 0; i < 4; ++i) { const int c = tid + 256 * i; out[t * D + c] = v[i] * rstd * g2[c] + b2[c]; }
}

#define LAS __attribute__((address_space(3)))
#define GAS __attribute__((address_space(1)))
typedef unsigned u32x4 __attribute__((ext_vector_type(4)));
typedef unsigned u32x2 __attribute__((ext_vector_type(2)));
typedef float f32x2 __attribute__((ext_vector_type(2)));
typedef __bf16 bf16x2_t __attribute__((ext_vector_type(2)));
DI unsigned cvtpk(float lo, float hi) { f32x2 v = {lo, hi}; bf16x2_t b = __builtin_convertvector(v, bf16x2_t); return __builtin_bit_cast(unsigned, b); }
constexpr float LOG2E = 1.4426950408889634f;
DI float fast_sigmoid(float z) { return __builtin_amdgcn_rcpf(1.f + __builtin_amdgcn_exp2f(-z * LOG2E)); }

namespace g8 {
constexpr int BM = 256, BK = 64, HALF = 128, HTB = HALF * BK * 2, STAGE_BYTES = 8 * HTB;
DI int lds_byte(int r, int c) { const int st = (r >> 4) * 2 + (c >> 5), rr = r & 15, cc = c & 31, ob = rr * 64 + cc * 2; return st * 1024 + (ob ^ (((ob >> 9) & 1) << 5)); }
DI void stage_rc(int b, int& R, int& C) { const int st = b / 1024, sb = b % 1024, swz = sb ^ (((sb >> 9) & 1) << 5); R = (st >> 1) * 16 + swz / 64; C = (st & 1) * 32 + (swz % 64) / 2; }
DI int perm32(int rho) { const int n = rho >> 4, i = rho & 15; return 8 * (i >> 2) + 4 * n + (i & 3); }

struct Unit { unsigned a, b; int dlb; int pm, pn, kind; };

template <class Epi, class Sched>
DI void gemm_phase(LAS unsigned char* lds, const char* const wsb, const int K, const Sched& S, const Epi& E, const int tid) {
    const int wid = __builtin_amdgcn_readfirstlane(tid >> 6), lane = tid & 63, wr = wid >> 2, wc = wid & 3, fr = lane & 15, fq = lane >> 4;
    const int nt = K / BK;
    unsigned voffA[2], rbk[2], ccb[2];
#pragma unroll
    for (int i = 0; i < 2; ++i) { int R, C; stage_rc(tid * 16 + i * 8192, R, C); const int Rb = Epi::PERM ? ((R & ~31) + perm32(R & 31)) : R;
        voffA[i] = (unsigned)(R * K + C) * 2u; rbk[i] = (unsigned)(Rb * K) * 2u; ccb[i] = (unsigned)C * 2u; }
    const unsigned kstep = (unsigned)(BK * 2);
    const unsigned hstepA = (unsigned)(HALF * K * 2);
    const unsigned ldsw = (unsigned)wid * 1024u;
    const int aoff = lds_byte(wr * 64 + fr, fq * 8), boff = lds_byte(wc * 32 + fr, fq * 8);
#define G8_SA(b, h) (((b) * 2 + (h)) * HTB)
#define G8_SB(b, h) ((4 + (b) * 2 + (h)) * HTB)
#define G8_STAGE(bufoff, gbase, v0, v1) do { \
        __builtin_amdgcn_global_load_lds((const unsigned*)(wsb + (unsigned)((gbase) + (v0))), (LAS unsigned*)(lds + (bufoff) + ldsw), 16, 0, 0); \
        __builtin_amdgcn_global_load_lds((const unsigned*)(wsb + (unsigned)((gbase) + (v1))), (LAS unsigned*)(lds + (bufoff) + ldsw + 8192), 16, 0, 0); } while (0)
#define G8_LDA(dst, b, h) do { _Pragma("unroll") for (int m = 0; m < 4; ++m) _Pragma("unroll") for (int k = 0; k < 2; ++k) dst[m][k] = *(const LAS bf16x8*)(lds + G8_SA(b, h) + aoff + m * 2048 + k * 1024); } while (0)
#define G8_LDB(dst, b, h) do { _Pragma("unroll") for (int n = 0; n < 2; ++n) _Pragma("unroll") for (int k = 0; k < 2; ++k) dst[n][k] = *(const LAS bf16x8*)(lds + G8_SB(b, h) + boff + n * 2048 + k * 1024); } while (0)
#define G8_MMA(ai, bj, At, Bt) do { __builtin_amdgcn_s_setprio(1); _Pragma("unroll") for (int m = 0; m < 4; ++m) _Pragma("unroll") for (int n = 0; n < 2; ++n) _Pragma("unroll") for (int k = 0; k < 2; ++k) \
        acc[ai][bj][m][n] = __builtin_amdgcn_mfma_f32_16x16x32_bf16(Bt[n][k], At[m][k], acc[ai][bj][m][n], 0, 0, 0); __builtin_amdgcn_s_setprio(0); } while (0)
#define G8_WAIT_V(n) asm volatile("s_waitcnt vmcnt(" #n ")" ::: "memory")
#define G8_WAIT_L(n) asm volatile("s_waitcnt lgkmcnt(" #n ")" ::: "memory")
#define G8_BAR __builtin_amdgcn_s_barrier()
#define G8_SCHED __builtin_amdgcn_sched_barrier(0)
    Unit cur, nxt; int ui = 0;
    if (!S.next(0, cur)) return;
    f32x4 acc[2][2][4][2];
#pragma unroll
    for (int a = 0; a < 2; ++a)
#pragma unroll
        for (int b = 0; b < 2; ++b)
#pragma unroll
            for (int m = 0; m < 4; ++m)
#pragma unroll
                for (int n = 0; n < 2; ++n) acc[a][b][m][n] = (f32x4){0.f, 0.f, 0.f, 0.f};
    bf16x8 At[4][2], B0[2][2], B1[2][2];
    unsigned cA = cur.a, cB = cur.b;
    unsigned vBc0 = rbk[0] * (unsigned)cur.dlb + ccb[0], vBc1 = rbk[1] * (unsigned)cur.dlb + ccb[1]; unsigned hBc = hstepA * (unsigned)cur.dlb;
    G8_STAGE(G8_SB(0, 0), cB, vBc0, vBc1); G8_STAGE(G8_SB(0, 1), cB + hBc, vBc0, vBc1); G8_STAGE(G8_SA(0, 0), cA, voffA[0], voffA[1]); G8_STAGE(G8_SA(0, 1), cA + hstepA, voffA[0], voffA[1]);
    if (wr == 1) G8_BAR;
    G8_WAIT_V(2); G8_BAR;
    G8_STAGE(G8_SB(1, 0), cB + kstep, vBc0, vBc1); G8_STAGE(G8_SA(1, 0), cA + kstep, voffA[0], voffA[1]); G8_STAGE(G8_SB(1, 1), cB + hBc + kstep, vBc0, vBc1);
    G8_WAIT_V(6); G8_BAR;
    for (;;) {
        const bool has_next = S.next(ui + 1, nxt);
        const unsigned nA = has_next ? nxt.a : cA, nB = has_next ? nxt.b : cB; const int dln = has_next ? nxt.dlb : cur.dlb;
        const unsigned vBn0 = rbk[0] * (unsigned)dln + ccb[0], vBn1 = rbk[1] * (unsigned)dln + ccb[1]; const unsigned hBn = hstepA * (unsigned)dln;
        for (int t = 0; t < nt; t += 2) {
            if constexpr (Epi::HOOK) E.hook(acc, cur, t, wr, wc, fr, fq);
            const bool last = (t == nt - 2);
            const unsigned a1 = cA + (unsigned)(t + 1) * kstep;
            const unsigned a2 = last ? nA : cA + (unsigned)(t + 2) * kstep, b2 = last ? nB : cB + (unsigned)(t + 2) * kstep;
            const unsigned a3 = a2 + kstep, b3 = b2 + kstep;
            const unsigned vB0 = last ? vBn0 : vBc0, vB1 = last ? vBn1 : vBc1; const unsigned hB = last ? hBn : hBc;
            G8_LDB(B0, 0, 0); G8_LDB(B1, 0, 1); G8_SCHED; G8_LDA(At, 0, 0); G8_STAGE(G8_SA(1, 1), a1 + hstepA, voffA[0], voffA[1]);
            G8_WAIT_V(8); G8_WAIT_L(0); G8_BAR; G8_MMA(0, 0, At, B0); G8_MMA(0, 1, At, B1); G8_BAR; G8_SCHED;
            G8_LDA(At, 0, 1); G8_STAGE(G8_SB(0, 0), b2, vB0, vB1); G8_STAGE(G8_SB(0, 1), b2 + hB, vB0, vB1); G8_STAGE(G8_SA(0, 0), a2, voffA[0], voffA[1]);
            G8_WAIT_V(8); G8_WAIT_L(0); G8_BAR; G8_MMA(1, 0, At, B0); G8_MMA(1, 1, At, B1); G8_BAR; G8_SCHED;
            G8_LDB(B0, 1, 0); G8_LDB(B1, 1, 1); G8_SCHED; G8_LDA(At, 1, 0); G8_STAGE(G8_SA(0, 1), a2 + hstepA, voffA[0], voffA[1]);
            G8_WAIT_V(8); G8_WAIT_L(0); G8_BAR; G8_MMA(0, 0, At, B0); G8_MMA(0, 1, At, B1); G8_BAR; G8_SCHED;
            G8_LDA(At, 1, 1); G8_STAGE(G8_SB(1, 0), b3, vB0, vB1); G8_STAGE(G8_SB(1, 1), b3 + hB, vB0, vB1); G8_STAGE(G8_SA(1, 0), a3, voffA[0], voffA[1]);
            G8_WAIT_V(8); G8_WAIT_L(0); G8_BAR; G8_MMA(1, 0, At, B0); G8_MMA(1, 1, At, B1); G8_BAR; G8_SCHED;
        }
        if (wr == 0) G8_BAR;
        E(acc, cur, wr, wc, fr, fq);
        if (!has_next) break;
#pragma unroll
        for (int a = 0; a < 2; ++a)
#pragma unroll
            for (int b = 0; b < 2; ++b)
#pragma unroll
                for (int m = 0; m < 4; ++m)
#pragma unroll
                    for (int n = 0; n < 2; ++n) acc[a][b][m][n] = (f32x4){0.f, 0.f, 0.f, 0.f};
        cur = nxt; cA = nA; cB = nB; vBc0 = vBn0; vBc1 = vBn1; hBc = hBn; ++ui;
        if (wr == 1) G8_BAR;
    }
    G8_WAIT_V(0);
    G8_BAR;
#undef G8_SA
#undef G8_SB
#undef G8_STAGE
#undef G8_LDA
#undef G8_LDB
#undef G8_MMA
#undef G8_WAIT_V
#undef G8_WAIT_L
#undef G8_BAR
#undef G8_SCHED
}
}

typedef GAS unsigned gu32;
#define XB_TMO      128
#define XB_XCNT(j)  (256  + 64 * (j))
#define XB_XSUB(j)  (1280 + 64 * (j))
#define XB_XGEN(j)  (2304 + 64 * (j))
#define XB_TOP      3328
#define XB_TOPGEN   3392
#define XCD_BAR_WORDS 3456
#define XB_SPIN_CAP (1u << 22)
DI unsigned xb_ld(unsigned* p)              { return __hip_atomic_load(p, __ATOMIC_RELAXED, __HIP_MEMORY_SCOPE_AGENT); }
DI unsigned xb_add(unsigned* p, unsigned v) { return __hip_atomic_fetch_add(p, v, __ATOMIC_RELAXED, __HIP_MEMORY_SCOPE_AGENT); }
DI unsigned xb_xcc_id() { return (unsigned)__builtin_amdgcn_s_getreg((3 << 11) | 20) & 0xFu; }
#define XB_SPIN(cond, bar) do { unsigned _sp = 0; while (cond) { __builtin_amdgcn_s_sleep(1); \
    if ((++_sp & 255u) == 0u) { if (xb_ld(&(bar)[XB_TMO])) break; if (_sp > XB_SPIN_CAP) { atomicAdd(&(bar)[XB_TMO], 1u); break; } } } } while (0)
struct XcdBarrier { unsigned* bar; unsigned x; volatile LAS unsigned* st; };
DI XcdBarrier xcd_barrier_post(unsigned* bar, volatile LAS unsigned* st) {
    XcdBarrier b; b.bar = bar; b.x = xb_xcc_id(); b.st = st;
    if (threadIdx.x == 0) st[2] = xb_add(&bar[XB_XCNT(b.x)], 1u);
    return b;
}
DI void xcd_barrier_complete(unsigned* bar, unsigned x, unsigned& nloc, unsigned& nx) {
    const unsigned G = gridDim.x * gridDim.y * gridDim.z;
    unsigned sum, cnt, mine, sp = 0u;
    for (;;) {
        sum = 0u; cnt = 0u; mine = 0u;
#pragma unroll
        for (unsigned j = 0; j < 16; ++j) { const unsigned c = xb_ld(&bar[XB_XCNT(j)]); sum += c; cnt += (c > 0u) ? 1u : 0u; mine = (j == x) ? c : mine; }
        if (sum == G) break;
        __builtin_amdgcn_s_sleep(1);
        if ((++sp & 255u) == 0u) { if (xb_ld(&bar[XB_TMO])) break; if (sp > XB_SPIN_CAP) { atomicAdd(&bar[XB_TMO], 1u); break; } }
    }
    nloc = mine > 0u ? mine : 1u; nx = cnt > 0u ? cnt : 1u;
}
DI void xcd_barrier(const XcdBarrier& b) {
    asm volatile("s_waitcnt vmcnt(0)" ::: "memory");
    __syncthreads();
    if (threadIdx.x == 0) {
        unsigned* bar = b.bar;
        __builtin_amdgcn_s_waitcnt(0);
        unsigned nloc = b.st[0], nx = b.st[1];
        if (nloc == 0u) { xcd_barrier_complete(bar, b.x, nloc, nx); b.st[0] = nloc; b.st[1] = nx; }
        const unsigned old = xb_add(&bar[XB_XSUB(b.x)], 1u);
        const unsigned gen = old / nloc;
        if (old + 1u == (gen + 1u) * nloc) {
            __builtin_amdgcn_fence(__ATOMIC_RELEASE, "agent");
            asm volatile("s_waitcnt vmcnt(0)" ::: "memory");
            const unsigned og = xb_add(&bar[XB_TOP], 1u);
            const unsigned tg = og / nx;
            if (og + 1u == (tg + 1u) * nx) xb_add(&bar[XB_TOPGEN], 1u);
            else XB_SPIN(xb_ld(&bar[XB_TOPGEN]) == tg, bar);
            __builtin_amdgcn_fence(__ATOMIC_ACQUIRE, "agent");
            xb_add(&bar[XB_XGEN(b.x)], 1u);
            asm volatile("s_waitcnt vmcnt(0)" ::: "memory");
        } else {
            XB_SPIN(xb_ld(&bar[XB_XGEN(b.x)]) == gen, bar);
            __builtin_amdgcn_fence(__ATOMIC_ACQUIRE, "agent");
            asm volatile("s_waitcnt vmcnt(0)" ::: "memory");
        }
    }
    __syncthreads();
}

constexpr int NWAVES = 8, NTHR = NWAVES * 64;
constexpr int RING_BYTES = 131072, LDS_BYTES = 147456, LDSCTL_OFF = LDS_BYTES - 1024, MISC_OFF = LDSCTL_OFF + 320;
constexpr size_t CTL_BYTES = 65536;
enum { PH_ALL = 0, PH_PRO = 11, PH_PROJ = 1, PH_ATTN = 2, PH_HGPRE = 3, PH_HGMAIN = 4, PH_WIDEN = 5, PH_WOUT = 6, PH_LN1 = 7, PH_PQ = 8, PH_ROUTE = 9, PH_EXPERTS = 10, PH_HGSCAN = 12 };
struct Args { const float* in[18]; float* out; unsigned char* ws; int ph, pass; };

struct Bufs {
    const bf16_t *WIN, *XBp; bf16_t *QK, *VIT, *HFQG, *MQ, *GATE;
};

struct SchedP1 {
    unsigned XBp, W; int G, c;
    DI bool next(int i, g8::Unit& u) const {
        const int L = i * G + c; if (L >= 2560) return false;
        if (L < 2048) { const int x = L & 7, off = L >> 3; u.pm = 8 * x + (off & 7); u.pn = off >> 3; u.kind = 0; u.dlb = 1;
            u.a = XBp + (unsigned)u.pm * 256u * D * 2u; u.b = W + (unsigned)u.pn * 256u * D * 2u; }
        else { const int idx = L - 2048; u.pm = idx & 7; u.pn = idx >> 3; u.kind = 1;
            const int dl = u.pm < 2 ? 1 : (u.pm < 4 ? 4 : (u.pm < 6 ? 16 : 1));
            const int v0 = u.pn * 256, lb = v0 / S, vv = v0 % S, per = S / dl, r = vv / per, m0 = vv % per;
            u.dlb = dl; u.a = W + (unsigned)(8192 + u.pm * 256) * D * 2u; u.b = XBp + (unsigned)(lb * S + m0 * dl + r) * D * 2u; }
        return true;
    }
};
DI int frag_row_off(int d0, int r32) { return (((d0 >> 4) * 64 + ((d0 >> 3) & 1) * 32 + r32) * 8); }
struct EpiP1 {
    static constexpr bool PERM = true, HOOK = false;
    char* pr; const float* b_gate;
    DI void hook(f32x4 (&)[2][2][4][2], const g8::Unit&, int, int, int, int, int) const {}
    DI void operator()(const f32x4 (&acc)[2][2][4][2], const g8::Unit& u, int wr, int wc, int fr, int fq) const {
        const int rowl = wr * 64 + fr, d0 = wc * 32 + 8 * fq;
        if (u.kind == 1) {
#pragma unroll
            for (int ai = 0; ai < 2; ++ai)
#pragma unroll
                for (int m = 0; m < 4; ++m) { const int R = u.pm * 256 + rowl + ai * 128 + m * 16;
#pragma unroll
                    for (int bj = 0; bj < 2; ++bj) { const f32x4 v0 = acc[ai][bj][m][0], v1 = acc[ai][bj][m][1];
                        const int c = u.pn * 256 + bj * 128 + d0;
                        if (R < 1536) {
                            const int gh = R >> 7, d = R & 127, lb = c >> 13, pos = c & (S - 1), kk = pos & 31;
                            bf16_t* blk = (bf16_t*)(pr + P_VT) + ((size_t)((lb * 12 + gh) * 256 + (pos >> 5))) * 4096 + (((d >> 5) * 2 + (kk >> 4)) * 64 + (d & 31)) * 8 + 4 * ((kk >> 3) & 1);
                            u32x2 wa, wb; wa.x = cvtpk(v0[0], v0[1]); wa.y = cvtpk(v0[2], v0[3]); wb.x = cvtpk(v1[0], v1[1]); wb.y = cvtpk(v1[2], v1[3]);
                            *(u32x2*)blk = wa; *(u32x2*)(blk + 32 * 8) = wb;
                        } else {
                            u32x4 w; w.x = cvtpk(v0[0], v0[1]); w.y = cvtpk(v0[2], v0[3]); w.z = cvtpk(v1[0], v1[1]); w.w = cvtpk(v1[2], v1[3]);
                            *(u32x4*)((bf16_t*)(pr + P_IT) + (size_t)(R - 1536) * MP + c) = w;
                        } } }
            return;
        }
        if (u.pn < 12 || u.pn == 18 || u.pn == 19) {
#pragma unroll
            for (int ai = 0; ai < 2; ++ai)
#pragma unroll
                for (int m = 0; m < 4; ++m) { const int row = u.pm * 256 + rowl + ai * 128 + m * 16;
#pragma unroll
                    for (int bj = 0; bj < 2; ++bj) { const f32x4 v0 = acc[ai][bj][m][0], v1 = acc[ai][bj][m][1];
                        u32x4 w; w.x = cvtpk(v0[0], v0[1]); w.y = cvtpk(v0[2], v0[3]); w.z = cvtpk(v1[0], v1[1]); w.w = cvtpk(v1[2], v1[3]);
                        bf16_t* dst;
                        if (u.pn < 12) { const int hh = u.pn * 2 + bj, qk = hh >= 12 ? 1 : 0, gh = hh - 12 * qk, lg = (gh >> 2) * 2;
                            const int lb = row >> 13, s = row & (S - 1), pos = ((s & ((1 << lg) - 1)) << (13 - lg)) + (s >> lg);
                            dst = (bf16_t*)(pr + P_QK) + ((size_t)(((qk * BPP + lb) * 12 + gh) * 256 + (pos >> 5))) * 4096 + frag_row_off(d0, pos & 31); }
                        else { const int h = (u.pn - 18) * 2 + bj; dst = (bf16_t*)(pr + P_MQ) + ((size_t)((row >> 5) * 4 + h)) * 4096 + frag_row_off(d0, row & 31); }
                        *(u32x4*)dst = w; } }
            return;
        }
        bf16_t* base; int ldc, colt; bool gate = false;
        if (u.pn < 18) { base = (bf16_t*)(pr + P_HFQG); ldc = 1536; colt = (u.pn - 12) * 256; }
        else { base = (bf16_t*)(pr + P_GATE); ldc = 3072; colt = (u.pn - 20) * 256; gate = true; }
        const int row0 = u.pm * 256 + rowl, col0 = colt + d0;
        f32x4 bv[2][2];
#pragma unroll
        for (int bj = 0; bj < 2; ++bj)
#pragma unroll
            for (int n = 0; n < 2; ++n) bv[bj][n] = gate ? *(const f32x4*)(b_gate + col0 + bj * 128 + 4 * n) : (f32x4){0.f, 0.f, 0.f, 0.f};
#pragma unroll
        for (int ai = 0; ai < 2; ++ai)
#pragma unroll
            for (int m = 0; m < 4; ++m) { bf16_t* rowp = base + (size_t)(row0 + ai * 128 + m * 16) * ldc + col0;
#pragma unroll
                for (int bj = 0; bj < 2; ++bj) { f32x4 v0 = acc[ai][bj][m][0], v1 = acc[ai][bj][m][1];
                    if (gate) { v0 = v0 + bv[bj][0]; v1 = v1 + bv[bj][1];
#pragma unroll
                        for (int e = 0; e < 4; ++e) { v0[e] = fast_sigmoid(v0[e]); v1[e] = fast_sigmoid(v1[e]); } }
                    u32x4 w; w.x = cvtpk(v0[0], v0[1]); w.y = cvtpk(v0[2], v0[3]); w.z = cvtpk(v1[0], v1[1]); w.w = cvtpk(v1[2], v1[3]);
                    *(u32x4*)(rowp + bj * 128) = w; } }
    }
};

typedef float f32x16 __attribute__((ext_vector_type(16)));
typedef short s16x4 __attribute__((ext_vector_type(4)));
DI int crow(int r, int hi) { return (r & 3) + 8 * (r >> 2) + 4 * hi; }
DI float xor32f(float v) { return __shfl_xor(v, 32); }
#define MFMA32(a, b, c) __builtin_amdgcn_mfma_f32_32x32x16_bf16((a), (b), (c), 0, 0, 0)
DI bf16x8 pack8(const f32x16& p, int s) {
    u32x4 w; w.x = cvtpk(p[8 * s + 0], p[8 * s + 1]); w.y = cvtpk(p[8 * s + 2], p[8 * s + 3]); w.z = cvtpk(p[8 * s + 4], p[8 * s + 5]); w.w = cvtpk(p[8 * s + 6], p[8 * s + 7]);
    return __builtin_bit_cast(bf16x8, w);
}
DI bf16x8 ldvt(const bf16_t* vp) {
    const s16x4 lo = *(const s16x4*)vp, hi4 = *(const s16x4*)(vp + 8);
    return __builtin_shufflevector(lo, hi4, 0, 1, 2, 3, 4, 5, 6, 7);
}
constexpr int DIL_TASKS = BPP * 12 * (S / 32);
constexpr int MEM_TASKS = (MP / 32) * 4;
DI void attn_dil_wave(const bf16_t* __restrict__ QK, const bf16_t* __restrict__ VT, const LAS float* btab, bf16_t* __restrict__ OG, float* __restrict__ LSE, int task, int lane) {
    const int r32 = lane & 31, hi = lane >> 5;
    const int q32 = task & 255, gh = (task >> 8) % 12, lb = task / (256 * 12);
    const int g = gh >> 2, h = gh & 3, dl = dil_of(g), per = S / dl;
    const int tok0 = q32 * 32, r = tok0 / per, m0 = tok0 % per;
    const size_t rowq = (size_t)lb * S + (size_t)(m0 + r32) * dl + r;
    bf16x8 qf[8];
    const int tile0 = (r * per + m0) >> 5;
    { const bf16_t* qp = QK + ((size_t)((lb * 12 + gh) * 256 + tile0)) * 4096 + lane * 8;
#pragma unroll
      for (int ks = 0; ks < 8; ++ks) qf[ks] = *(const bf16x8*)(qp + ks * 512); }
    const LAS float* bt = btab + g * 129 * 4 + h;
    f32x16 o[4];
#pragma unroll
    for (int dt = 0; dt < 4; ++dt)
#pragma unroll
        for (int i = 0; i < 16; ++i) o[dt][i] = 0.f;
    float mrun = -INFINITY, sum = 0.f;
    const bf16_t* vbase = VT + ((size_t)((lb * 12 + gh) * 256 + tile0 - 4)) * 4096 + lane * 8;
    const bf16_t* kbase = QK + ((size_t)(((BPP + lb) * 12 + gh) * 256 + tile0 - 4)) * 4096 + lane * 8;
    const int kt0 = (m0 >= 128 ? 0 : (128 - m0) >> 5);
    bf16x8 kf[8], vf[8];
#pragma unroll
    for (int ks = 0; ks < 8; ++ks) kf[ks] = *(const bf16x8*)(kbase + (size_t)kt0 * 4096 + ks * 512);
#pragma unroll 1
    for (int kt = kt0; kt < 5; ++kt) {
#pragma unroll
        for (int i = 0; i < 8; ++i) vf[i] = *(const bf16x8*)(vbase + (size_t)kt * 4096 + i * 512);
        f32x16 sc;
#pragma unroll
        for (int i = 0; i < 16; ++i) sc[i] = 0.f;
#pragma unroll
        for (int ks = 0; ks < 8; ++ks) sc = MFMA32(kf[ks], qf[ks], sc);
        if (kt < 4) {
#pragma unroll
            for (int ks = 0; ks < 8; ++ks) kf[ks] = *(const bf16x8*)(kbase + (size_t)(kt + 1) * 4096 + ks * 512);
        }
        float mx = -INFINITY;
#pragma unroll
        for (int i = 0; i < 16; ++i) {
            const int delta = 128 - 32 * kt + r32 - crow(i, hi);
            const bool valid = (delta >= 0) && (delta <= 128);
            const int di = delta < 0 ? 0 : (delta > 128 ? 128 : delta);
            const float x = sc[i] * (QSCALE * LOG2E) + bt[di * 4];
            sc[i] = valid ? x : -INFINITY; mx = fmaxf(mx, sc[i]);
        }
        mx = fmaxf(mx, xor32f(mx));
        const float mnew = fmaxf(mrun, mx); const float f = __builtin_amdgcn_exp2f(mrun - mnew);
        sum *= f;
#pragma unroll
        for (int dt = 0; dt < 4; ++dt)
#pragma unroll
            for (int i = 0; i < 16; ++i) o[dt][i] *= f;
        mrun = mnew;
        float ps = 0.f;
#pragma unroll
        for (int i = 0; i < 16; ++i) { sc[i] = __builtin_amdgcn_exp2f(sc[i] - mnew); ps += sc[i]; }
        ps += xor32f(ps); sum += ps;
#pragma unroll
        for (int s = 0; s < 2; ++s) {
            const bf16x8 pb = pack8(sc, s);
#pragma unroll
            for (int dt = 0; dt < 4; ++dt) o[dt] = MFMA32(vf[dt * 2 + s], pb, o[dt]);
        }
    }
    const float inv = 1.f / sum;
    bf16_t* op = OG + rowq * 1536 + g * 512 + h * 128 + 4 * hi;
#pragma unroll
    for (int dt = 0; dt < 4; ++dt)
#pragma unroll
        for (int a = 0; a < 4; ++a) { u32x2 w; w.x = cvtpk(o[dt][4 * a] * inv, o[dt][4 * a + 1] * inv); w.y = cvtpk(o[dt][4 * a + 2] * inv, o[dt][4 * a + 3] * inv); *(u32x2*)(op + 32 * dt + 8 * a) = w; }
    if (hi == 0) LSE[rowq * 12 + gh] = (mrun + __builtin_amdgcn_logf(sum)) * 0.6931471805599453f;
}
DI void attn_mem_wave(const bf16_t* __restrict__ MQ, const bf16_t* __restrict__ MK, const bf16_t* __restrict__ MVT, bf16_t* __restrict__ BR, int task, int batch0, int lane) {
    const int r32 = lane & 31, hi = lane >> 5;
    const int h = task & 3, blk = task >> 2;
    const size_t rowq = (size_t)blk * 32 + r32; const int b = batch0 + blk * 32 / S;
    bf16x8 qf[8];
    { const bf16_t* qp = MQ + ((size_t)(blk * 4 + h)) * 4096 + lane * 8;
#pragma unroll
      for (int ks = 0; ks < 8; ++ks) qf[ks] = *(const bf16x8*)(qp + ks * 512); }
    f32x16 o[4];
#pragma unroll
    for (int dt = 0; dt < 4; ++dt)
#pragma unroll
        for (int i = 0; i < 16; ++i) o[dt][i] = 0.f;
    float mrun = -INFINITY, sum = 0.f;
    const bf16_t* vbase = MVT + ((size_t)((b * 4 + h) * 8)) * 4096 + lane * 8;
    const bf16_t* kbase = MK + ((size_t)((b * 4 + h) * 8)) * 4096 + lane * 8;
#pragma unroll 1
    for (int c = 0; c < 4; ++c) {
        f32x16 sc[2]; float mx = -INFINITY;
#pragma unroll
        for (int kt = 0; kt < 2; ++kt) {
            const bf16_t* kp = kbase + (size_t)(c * 2 + kt) * 4096;
            f32x16 acc;
#pragma unroll
            for (int i = 0; i < 16; ++i) acc[i] = 0.f;
#pragma unroll
            for (int ks = 0; ks < 8; ++ks) { const bf16x8 kf = *(const bf16x8*)(kp + ks * 512); acc = MFMA32(kf, qf[ks], acc); }
#pragma unroll
            for (int i = 0; i < 16; ++i) { sc[kt][i] = acc[i] * (QSCALE * LOG2E); mx = fmaxf(mx, sc[kt][i]); }
            asm volatile("" ::: "memory");
        }
        mx = fmaxf(mx, xor32f(mx));
        const float mnew = fmaxf(mrun, mx); const float f = __builtin_amdgcn_exp2f(mrun - mnew);
        sum *= f;
#pragma unroll
        for (int dt = 0; dt < 4; ++dt)
#pragma unroll
            for (int i = 0; i < 16; ++i) o[dt][i] *= f;
        mrun = mnew;
        float ps = 0.f;
#pragma unroll
        for (int kt = 0; kt < 2; ++kt)
#pragma unroll
            for (int i = 0; i < 16; ++i) { sc[kt][i] = __builtin_amdgcn_exp2f(sc[kt][i] - mnew); ps += sc[kt][i]; }
        ps += xor32f(ps); sum += ps;
#pragma unroll
        for (int kt = 0; kt < 2; ++kt)
#pragma unroll
            for (int s = 0; s < 2; ++s) {
                const bf16x8 pb = pack8(sc[kt], s);
#pragma unroll
                for (int dt = 0; dt < 4; ++dt) { const bf16x8 va = *(const bf16x8*)(vbase + (size_t)(c * 2 + kt) * 4096 + (dt * 2 + s) * 512); o[dt] = MFMA32(va, pb, o[dt]); }
                asm volatile("" ::: "memory");
            }
    }
    const float inv = 1.f / sum;
    bf16_t* op = BR + rowq * 1536 + 1024 + h * 128 + 4 * hi;
#pragma unroll
    for (int dt = 0; dt < 4; ++dt)
#pragma unroll
        for (int a = 0; a < 4; ++a) { u32x2 w; w.x = cvtpk(o[dt][4 * a] * inv, o[dt][4 * a + 1] * inv); w.y = cvtpk(o[dt][4 * a + 2] * inv, o[dt][4 * a + 3] * inv); *(u32x2*)(op + 32 * dt + 8 * a) = w; }
}

constexpr int HG_SCH = 4, HG_UPS = S / 64 / HG_SCH  , HG_UNITS = BPP * 4 * HG_UPS  ;
constexpr int HG_ROW = 136, HG_KT_ROW = 72;
constexpr int HG_KP = 0, HG_QP = 64 * HG_ROW * 2, HG_QPP = 2 * HG_QP, HG_KPPT = 3 * HG_QP, HG_DEC = HG_KPPT + 128 * HG_KT_ROW * 2, HG_SSQ = HG_DEC + 512, HG_PSUM = HG_SSQ + 1024, HG_UNIT_BYTES = HG_PSUM + 2048;
DI bf16x8 lds_ld2x8(const LAS unsigned char* p) {
    const s16x4 lo = *(const LAS s16x4*)p, hi4 = *(const LAS s16x4*)(p + 16);
    return __builtin_shufflevector(lo, hi4, 0, 1, 2, 3, 4, 5, 6, 7);
}
DI int opq(int x) { asm volatile("" : "+v"(x)); return x; }
DI float lds_bf(const LAS unsigned char* p) { return __uint_as_float((unsigned)(*(const LAS unsigned short*)p) << 16); }
template <bool MAIN>
DI void hgrn_unit(LAS unsigned char* ul, int unit, int u, const bf16_t* __restrict__ HFQG, const bf16_t* __restrict__ IT, const float* __restrict__ lbv, const float* __restrict__ nwv,
                  float* HSTL, float* HSTD, const float* __restrict__ SIN, bf16_t* __restrict__ BR) {
    constexpr int NX = MAIN ? 4 : 2;
    const int lane = u & 63, w = u >> 6, r32 = lane & 31, hi = lane >> 5, dvt = w & 3, wh = w >> 2;
    const int seq = unit / HG_UPS, j = unit % HG_UPS, lb = seq >> 2, h = seq & 3;
    const int dk = u & 127, qt = u >> 7, cb = 16 * qt;
    const float lbd = lbv[h * 128 + dk];
    const size_t row0 = (size_t)lb * S + (size_t)j * (64 * HG_SCH);
    LAS unsigned char* Kp = ul + HG_KP; LAS unsigned char* Qp = ul + HG_QP; LAS unsigned char* Qpp = ul + HG_QPP; LAS unsigned char* KppT = ul + HG_KPPT;
    LAS float* dec = (LAS float*)(ul + HG_DEC); LAS float* ssq = (LAS float*)(ul + HG_SSQ); LAS float* psum = (LAS float*)(ul + HG_PSUM);
    const int dk0 = MAIN ? 0 : 64 * wh;
    f32x16 X[NX];
    if (MAIN) {
        const float* Sp = SIN + (size_t)unit * 16384 + 32 * dvt + r32;
#pragma unroll
        for (int t = 0; t < NX; ++t)
#pragma unroll
            for (int i = 0; i < 16; ++i) X[t][i] = Sp[(size_t)(32 * t + crow(i, hi)) * 128];
    } else {
#pragma unroll
        for (int t = 0; t < NX; ++t)
#pragma unroll
            for (int i = 0; i < 16; ++i) X[t][i] = 0.f;
    }
    float atot = 0.f;
    u32x4 sf[2], sq[2];
    {
        const int sc0 = u >> 4, sch = (u & 15) * 8;
        const bf16_t* fp = HFQG + (row0 + sc0) * 1536 + h * 128 + sch;
#pragma unroll
        for (int i = 0; i < 2; ++i) { sf[i] = *(const u32x4*)(fp + (size_t)(32 * i) * 1536); if (MAIN) sq[i] = *(const u32x4*)(fp + (size_t)(32 * i) * 1536 + 512); }
    }
#pragma unroll 1
    for (int ch = 0; ch < HG_SCH; ++ch) {
        const size_t rc = row0 + (size_t)ch * 64;
        {
            const int sc0 = opq(u) >> 4, sch = (opq(u) & 15) * 8;
#pragma unroll
            for (int i = 0; i < 2; ++i) { *(LAS u32x4*)(Kp + ((sc0 + 32 * i) * HG_ROW + sch) * 2) = sf[i]; if (MAIN) *(LAS u32x4*)(Qp + ((sc0 + 32 * i) * HG_ROW + sch) * 2) = sq[i]; }
        }
        __syncthreads();
        float fv[16], lf[16];
        {
            float s = 0.f;
#pragma unroll
            for (int i = 0; i < 16; ++i) { fv[i] = lbd + (1.f - lbd) * fast_sigmoid(lds_bf(Kp + ((cb + i) * HG_ROW + dk) * 2)); lf[i] = __builtin_amdgcn_logf(fv[i]); s += lf[i]; }
            psum[qt * 128 + dk] = s;
        }
        __syncthreads();
        {
            const float p0 = psum[dk], p1 = psum[128 + dk], p2 = psum[256 + dk], p3 = psum[384 + dk];
            const float amid = p0 + p1, alast = (p0 + p1) + (p2 + p3);
            float run = qt == 0 ? 0.f : (qt == 1 ? p0 : (qt == 2 ? amid : amid + p2));
            atot += alast;
            const float Ela = __builtin_amdgcn_exp2f(alast - amid), Ea = __builtin_amdgcn_exp2f(amid);
#pragma unroll
            for (int c8 = 0; c8 < 2; ++c8) {
                float kt[8];
#pragma unroll
                for (int e = 0; e < 8; ++e) { const int i = 8 * c8 + e, c = cb + i; run += lf[i]; const float key = 1.f - fv[i];
                    const float e1 = __builtin_amdgcn_exp2f(amid - run);
                    const float kp = key * e1;
                    kt[e] = kp * Ela;
                    if (MAIN) { *(LAS bf16_t*)(Kp + (c * HG_ROW + dk) * 2) = f2bf(kp);
                        const float qp = lds_bf(Qp + (c * HG_ROW + dk) * 2) * __builtin_amdgcn_rcpf(e1);
                        *(LAS bf16_t*)(Qp + (c * HG_ROW + dk) * 2) = f2bf(qp);
                        *(LAS bf16_t*)(Qpp + (c * HG_ROW + dk) * 2) = f2bf(qp * Ea); } }
                u32x4 wv; wv.x = cvtpk(kt[0], kt[1]); wv.y = cvtpk(kt[2], kt[3]); wv.z = cvtpk(kt[4], kt[5]); wv.w = cvtpk(kt[6], kt[7]);
                *(LAS u32x4*)(KppT + (dk * HG_KT_ROW + cb + 8 * c8) * 2) = wv;
            }
            if (qt == 0) dec[dk] = __builtin_amdgcn_exp2f(alast);
        }
        if (ch + 1 < HG_SCH) {
            const int sc0 = opq(u) >> 4, sch = (opq(u) & 15) * 8;
            const bf16_t* fp = HFQG + (rc + 64 + sc0) * 1536 + h * 128 + sch;
#pragma unroll
            for (int i = 0; i < 2; ++i) { sf[i] = *(const u32x4*)(fp + (size_t)(32 * i) * 1536); if (MAIN) sq[i] = *(const u32x4*)(fp + (size_t)(32 * i) * 1536 + 512); }
        }
        __syncthreads();
        f32x16 o;
        const bf16_t* itrow = IT + (size_t)(h * 128 + 32 * dvt + opq(r32)) * MP;
        if (MAIN) {
#pragma unroll
            for (int i = 0; i < 16; ++i) o[i] = 0.f;
            const LAS unsigned char* qrow = Qpp + ((32 * wh + r32) * HG_ROW) * 2;
#pragma unroll
            for (int t = 0; t < 4; ++t)
#pragma unroll
                for (int step = 0; step < 2; ++step) { o = MFMA32(pack8(X[t], step), lds_ld2x8(qrow + (32 * t + 16 * step + 4 * hi) * 2), o); }
            __builtin_amdgcn_sched_barrier(0);
            const int r32m = opq(r32);
            const LAS unsigned char* qprow = Qp + ((32 * wh + r32) * HG_ROW) * 2;
            {
                f32x16 sc;
#pragma unroll
                for (int i = 0; i < 16; ++i) sc[i] = 0.f;
#pragma unroll
                for (int ks = 0; ks < 8; ++ks) { const int cof = (16 * ks + 8 * hi) * 2; sc = MFMA32(*(const LAS bf16x8*)(Kp + (r32 * HG_ROW) * 2 + cof), *(const LAS bf16x8*)(qprow + cof), sc); }
                if (wh == 0) {
#pragma unroll
                    for (int i = 0; i < 16; ++i) sc[i] = (crow(i, hi) <= r32m) ? sc[i] : 0.f;
                }
#pragma unroll
                for (int step = 0; step < 2; ++step) o = MFMA32(ldvt(itrow + rc + 16 * step + 4 * hi), pack8(sc, step), o);
                __builtin_amdgcn_sched_barrier(0);
            }
            if (wh == 1) {
                f32x16 sc;
#pragma unroll
                for (int i = 0; i < 16; ++i) sc[i] = 0.f;
#pragma unroll
                for (int ks = 0; ks < 8; ++ks) { const int cof = (16 * ks + 8 * hi) * 2; sc = MFMA32(*(const LAS bf16x8*)(Kp + ((32 + r32) * HG_ROW) * 2 + cof), *(const LAS bf16x8*)(qprow + cof), sc); }
#pragma unroll
                for (int i = 0; i < 16; ++i) sc[i] = (crow(i, hi) <= r32m) ? sc[i] : 0.f;
#pragma unroll
                for (int step = 0; step < 2; ++step) o = MFMA32(ldvt(itrow + rc + 32 + 16 * step + 4 * hi), pack8(sc, step), o);
                __builtin_amdgcn_sched_barrier(0);
            }
        }
        {
            bf16x8 ib[4];
#pragma unroll
            for (int ks = 0; ks < 4; ++ks) ib[ks] = *(const bf16x8*)(itrow + rc + 16 * ks + 8 * hi);
#pragma unroll
            for (int t = 0; t < NX; ++t) {
#pragma unroll
                for (int i = 0; i < 16; ++i) X[t][i] *= dec[dk0 + 32 * t + crow(i, hi)];
#pragma unroll
                for (int ks = 0; ks < 4; ++ks) { const bf16x8 ka = *(const LAS bf16x8*)(KppT + ((dk0 + 32 * t + r32) * HG_KT_ROW + 16 * ks + 8 * hi) * 2); X[t] = MFMA32(ka, ib[ks], X[t]); }
                __builtin_amdgcn_sched_barrier(0);
            }
        }
        if (MAIN) {
            float q2 = 0.f;
#pragma unroll
            for (int i = 0; i < 16; ++i) q2 += o[i] * o[i];
            q2 += xor32f(q2); if (hi == 0) ssq[dvt * 64 + 32 * wh + r32] = q2;
        }
        __syncthreads();
        if (MAIN) {
            const int r32o = opq(r32), hio = opq(hi);
            const int c = 32 * wh + r32o; const float tot = ssq[c] + ssq[64 + c] + ssq[128 + c] + ssq[192 + c];
            const float rs = rsqrtf(tot * (1.f / 128.f) + LN_EPS);
            const size_t row = rc + c; const int col = h * 128 + 32 * dvt + 4 * hio;
#pragma unroll
            for (int a4 = 0; a4 < 4; ++a4) {
                const u32x2 gw = *(const u32x2*)(HFQG + row * 1536 + 1024 + col + 8 * a4); const f32x4 nw4 = *(const f32x4*)(nwv + col + 8 * a4);
                const float g0 = __uint_as_float(gw.x << 16), g1 = __uint_as_float(gw.x & 0xffff0000u), g2 = __uint_as_float(gw.y << 16), g3 = __uint_as_float(gw.y & 0xffff0000u);
                const float v0 = o[4 * a4] * rs * nw4[0] * g0 * fast_sigmoid(g0), v1 = o[4 * a4 + 1] * rs * nw4[1] * g1 * fast_sigmoid(g1);
                const float v2 = o[4 * a4 + 2] * rs * nw4[2] * g2 * fast_sigmoid(g2), v3 = o[4 * a4 + 3] * rs * nw4[3] * g3 * fast_sigmoid(g3);
                u32x2 wv; wv.x = cvtpk(v0, v1); wv.y = cvtpk(v2, v3);
                *(u32x2*)(BR + row * 1536 + 512 + col + 8 * a4) = wv;
            }
        }
    }
    if (!MAIN) {
        float* L = HSTL + (size_t)unit * 16384 + 32 * dvt + r32;
#pragma unroll
        for (int t = 0; t < NX; ++t)
#pragma unroll
            for (int i = 0; i < 16; ++i) L[(size_t)(dk0 + 32 * t + crow(i, hi)) * 128] = X[t][i];
        if (qt == 0) HSTD[(size_t)unit * 128 + dk] = __builtin_amdgcn_exp2f(atot);
    }
}
DI void hgrn_scan(const float* __restrict__ HSTL, const float* __restrict__ HSTD, float* __restrict__ SIN, int gt) {
    if (gt >= BPP * 4 * 16384) return;
    const int seq = gt >> 14, el = gt & 16383, dkk = el >> 7;
    float st = 0.f;
    for (int j = 0; j < HG_UPS; ++j) { const size_t uo = (size_t)(seq * HG_UPS + j); SIN[uo * 16384 + el] = st; st = HSTD[uo * 128 + dkk] * st + HSTL[uo * 16384 + el]; }
}

struct SchedRows {
    unsigned A, B; int K, nN, nU, G, c;
    DI bool next(int i, g8::Unit& u) const {
        const int L = i * G + c; if (L >= nU) return false;
        const int x = L & 7, off = L >> 3, grp = off / (8 * nN), o2 = off % (8 * nN);
        const int ppx = nU / nN / 8;
        u.pm = x * ppx + 8 * grp + (o2 & 7); u.pn = o2 >> 3; u.kind = 0; u.dlb = 1;
        u.a = A + (unsigned)u.pm * 256u * K * 2u; u.b = B + (unsigned)u.pn * 256u * K * 2u; return true;
    }
};
DI void unpack8(const u32x4 w, float (&f)[8]) {
    f[0] = __uint_as_float(w.x << 16); f[1] = __uint_as_float(w.x & 0xffff0000u); f[2] = __uint_as_float(w.y << 16); f[3] = __uint_as_float(w.y & 0xffff0000u);
    f[4] = __uint_as_float(w.z << 16); f[5] = __uint_as_float(w.z & 0xffff0000u); f[6] = __uint_as_float(w.w << 16); f[7] = __uint_as_float(w.w & 0xffff0000u);
}
struct EpiWidenF {
    static constexpr bool PERM = true, HOOK = true;
    const bf16_t* GATE; bf16_t* MERGED;
    DI void hook(f32x4 (&acc)[2][2][4][2], const g8::Unit& u, int t, int wr, int wc, int fr, int fq) const {
        if (t != 8 && t != 16) return;
        const int g = (t >> 3) - 1;
        const int row0 = u.pm * 256 + wr * 64 + fr, col0 = u.pn * 256 + wc * 32 + 8 * fq;
#pragma unroll
        for (int ai = 0; ai < 2; ++ai)
#pragma unroll
            for (int m = 0; m < 4; ++m) { const bf16_t* gp = GATE + (size_t)(row0 + ai * 128 + m * 16) * 3072 + g * 1024 + col0;
#pragma unroll
                for (int bj = 0; bj < 2; ++bj) { float ga[8], gb[8]; unpack8(*(const u32x4*)(gp + bj * 128), ga); unpack8(*(const u32x4*)(gp + 1024 + bj * 128), gb);
#pragma unroll
                    for (int e = 0; e < 4; ++e) { acc[ai][bj][m][0][e] *= ga[e] * __builtin_amdgcn_rcpf(gb[e]); acc[ai][bj][m][1][e] *= ga[4 + e] * __builtin_amdgcn_rcpf(gb[4 + e]); } } }
    }
    DI void operator()(const f32x4 (&acc)[2][2][4][2], const g8::Unit& u, int wr, int wc, int fr, int fq) const {
        const int row0 = u.pm * 256 + wr * 64 + fr, col0 = u.pn * 256 + wc * 32 + 8 * fq;
#pragma unroll
        for (int ai = 0; ai < 2; ++ai)
#pragma unroll
            for (int m = 0; m < 4; ++m) { const size_t row = (size_t)(row0 + ai * 128 + m * 16);
#pragma unroll
                for (int bj = 0; bj < 2; ++bj) { float gc[8]; unpack8(*(const u32x4*)(GATE + row * 3072 + 2048 + col0 + bj * 128), gc);
                    const f32x4 v0 = acc[ai][bj][m][0], v1 = acc[ai][bj][m][1];
                    u32x4 w; w.x = cvtpk(v0[0] * gc[0], v0[1] * gc[1]); w.y = cvtpk(v0[2] * gc[2], v0[3] * gc[3]); w.z = cvtpk(v1[0] * gc[4], v1[1] * gc[5]); w.w = cvtpk(v1[2] * gc[6], v1[3] * gc[7]);
                    *(u32x4*)(MERGED + row * 1024 + col0 + bj * 128) = w; } }
    }
};
struct EpiMixF32 {
    static constexpr bool PERM = false, HOOK = false;
    float* C;
    DI void hook(f32x4 (&)[2][2][4][2], const g8::Unit&, int, int, int, int, int) const {}
    DI void operator()(const f32x4 (&acc)[2][2][4][2], const g8::Unit& u, int wr, int wc, int fr, int fq) const {
        const int col0 = u.pn * 256 + wc * 32 + 4 * fq;
#pragma unroll
        for (int ai = 0; ai < 2; ++ai)
#pragma unroll
            for (int m = 0; m < 4; ++m) { float* rp = C + (size_t)(u.pm * 256 + ai * 128 + wr * 64 + m * 16 + fr) * 1024 + col0;
#pragma unroll
                for (int bj = 0; bj < 2; ++bj)
#pragma unroll
                    for (int n = 0; n < 2; ++n) *(f32x4*)(rp + bj * 128 + n * 16) = acc[ai][bj][m][n]; }
    }
};
struct EpiPlainB16 {
    static constexpr bool PERM = true, HOOK = false;
    bf16_t* C; int ldc, pad;
    DI void hook(f32x4 (&)[2][2][4][2], const g8::Unit&, int, int, int, int, int) const {}
    DI void operator()(const f32x4 (&acc)[2][2][4][2], const g8::Unit& u, int wr, int wc, int fr, int fq) const {
        const int row0 = u.pm * 256 + wr * 64 + fr, col0 = u.pn * 256 + wc * 32 + 8 * fq;
#pragma unroll
        for (int ai = 0; ai < 2; ++ai)
#pragma unroll
            for (int m = 0; m < 4; ++m) { bf16_t* rowp = C + (size_t)(row0 + ai * 128 + m * 16) * ldc + col0;
#pragma unroll
                for (int bj = 0; bj < 2; ++bj) { const f32x4 v0 = acc[ai][bj][m][0], v1 = acc[ai][bj][m][1];
                    u32x4 w; w.x = cvtpk(v0[0], v0[1]); w.y = cvtpk(v0[2], v0[3]); w.z = cvtpk(v1[0], v1[1]); w.w = cvtpk(v1[2], v1[3]);
                    *(u32x4*)(rowp + bj * 128) = w; } }
    }
};
DI void lse_merge_items(const bf16_t* __restrict__ OG, const float* __restrict__ LSE, bf16_t* __restrict__ BR, int first, int stride) {
    for (int it = first; it < MP * 64; it += stride) {
        const int row = it >> 6, c8 = it & 63, h = c8 >> 4;
        const float l0 = LSE[(size_t)row * 12 + h], l1 = LSE[(size_t)row * 12 + 4 + h], l2 = LSE[(size_t)row * 12 + 8 + h];
        const float mx = fmaxf(l0, fmaxf(l1, l2)); const float e0 = __expf(l0 - mx), e1 = __expf(l1 - mx), e2 = __expf(l2 - mx); const float inv = 1.f / (e0 + e1 + e2);
        const bf16_t* og = OG + (size_t)row * 1536 + c8 * 8;
        float a[8], b[8], c[8]; unpack8(*(const u32x4*)og, a); unpack8(*(const u32x4*)(og + 512), b); unpack8(*(const u32x4*)(og + 1024), c);
        float r[8];
#pragma unroll
        for (int e = 0; e < 8; ++e) r[e] = (e0 * a[e] + e1 * b[e] + e2 * c[e]) * inv;
        u32x4 w; w.x = cvtpk(r[0], r[1]); w.y = cvtpk(r[2], r[3]); w.z = cvtpk(r[4], r[5]); w.w = cvtpk(r[6], r[7]);
        *(u32x4*)(BR + (size_t)row * 1536 + c8 * 8) = w;
    }
}
DI void ln1_rows(const float* __restrict__ x, const bf16_t* __restrict__ mix, const float* __restrict__ g, const float* __restrict__ b, bf16_t* __restrict__ h1b, unsigned char* __restrict__ h1q, float* __restrict__ hsc, int wave0, int nwaves, int lane) {
    for (int row = wave0; row < MP; row += nwaves) {
        const f32x4* xr = (const f32x4*)(x + (size_t)row * D + 16 * lane);
        const u32x4 ma = *(const u32x4*)(mix + (size_t)row * D + 16 * lane), mb = *(const u32x4*)(mix + (size_t)row * D + 16 * lane + 8);
        float mf[16]; unpack8(ma, *(float(*)[8])&mf[0]); unpack8(mb, *(float(*)[8])&mf[8]);
        f32x4 v[4]; float s = 0.f;
#pragma unroll
        for (int j = 0; j < 4; ++j) { v[j] = xr[j] * ALPHA;
#pragma unroll
            for (int e = 0; e < 4; ++e) { v[j][e] += mf[4 * j + e]; s += v[j][e]; } }
        const float mean = wave_sum(s) * (1.f / D); float q = 0.f;
#pragma unroll
        for (int j = 0; j < 4; ++j) { v[j] = v[j] - mean; q += (v[j][0] * v[j][0] + v[j][1] * v[j][1]) + (v[j][2] * v[j][2] + v[j][3] * v[j][3]); }
        const float rstd = rsqrtf(wave_sum(q) * (1.f / D) + LN_EPS);
        u32x4 o0, o1; float amax = 0.f;
#pragma unroll
        for (int j = 0; j < 4; ++j) { const f32x4 gg = *(const f32x4*)(g + 16 * lane + 4 * j), bb = *(const f32x4*)(b + 16 * lane + 4 * j); const f32x4 o = v[j] * rstd * gg + bb; v[j] = o;
            amax = fmaxf(amax, fmaxf(fmaxf(fabsf(o[0]), fabsf(o[1])), fmaxf(fabsf(o[2]), fabsf(o[3]))));
            if (j < 2) { o0[2 * j] = cvtpk(o[0], o[1]); o0[2 * j + 1] = cvtpk(o[2], o[3]); } else { o1[2 * (j - 2)] = cvtpk(o[0], o[1]); o1[2 * (j - 2) + 1] = cvtpk(o[2], o[3]); } }
        *(u32x4*)(h1b + (size_t)row * D + 16 * lane) = o0; *(u32x4*)(h1b + (size_t)row * D + 16 * lane + 8) = o1;
        amax = wave_max(amax); const float qs = amax > 0.f ? 127.f / amax : 1.f;
        u32x4 qv;
#pragma unroll
        for (int j = 0; j < 4; ++j) qv[j] = ((unsigned)__float2int_rn(v[j][0] * qs) & 0xffu) | (((unsigned)__float2int_rn(v[j][1] * qs) & 0xffu) << 8) | (((unsigned)__float2int_rn(v[j][2] * qs) & 0xffu) << 16) | (((unsigned)__float2int_rn(v[j][3] * qs) & 0xffu) << 24);
        *(u32x4*)(h1q + (size_t)row * D + 16 * lane) = qv;
        if (lane == 0) hsc[row] = amax > 0.f ? amax * (1.f / 127.f) : 1.f;
    }
}

DI unsigned mono(float f) { const unsigned u = __float_as_uint(f); return (u & 0x80000000u) ? ~u : (u | 0x80000000u); }
DI float demono(unsigned m) { return __uint_as_float((m & 0x80000000u) ? (m & 0x7fffffffu) : ~m); }
#define CE_DESC(a, b) do { const unsigned _hi = (a) > (b) ? (a) : (b), _lo = (a) > (b) ? (b) : (a); (a) = _hi; (b) = _lo; } while (0)
DI void sort16_desc(unsigned (&k)[16]) {
#pragma unroll
    for (int size = 2; size <= 16; size <<= 1)
#pragma unroll
        for (int stride = size >> 1; stride > 0; stride >>= 1)
#pragma unroll
            for (int i = 0; i < 16; ++i) { const int j = i ^ stride;
                if (j > i) { if ((i & size) == 0 || size == 16) CE_DESC(k[i], k[j]); else CE_DESC(k[j], k[i]); } }
}
DI void merge_top16(unsigned (&t)[16], const unsigned (&l)[16]) {
#pragma unroll
    for (int i = 0; i < 16; ++i) t[i] = t[i] > l[15 - i] ? t[i] : l[15 - i];
#pragma unroll
    for (int stride = 8; stride > 0; stride >>= 1)
#pragma unroll
        for (int i = 0; i < 16; ++i) { const int j = i ^ stride; if (j > i) CE_DESC(t[i], t[j]); }
}
constexpr int RT_ROW = 136;
constexpr int RT_LDS_BYTES = 2 * 128 * RT_ROW * 2;
DI void route_wave(const bf16_t* __restrict__ PQ, const LAS unsigned char* keys, int* __restrict__ IDX, float* __restrict__ PG, int tb, int h, int lane) {
    const int r32 = lane & 31, hi = lane >> 5;
    const size_t tok = (size_t)tb * 32 + r32;
    unsigned Tp[2][16];
#pragma unroll
    for (int p = 0; p < 2; ++p) {
        bf16x8 qf[8];
        const bf16_t* qp = PQ + tok * 2048 + h * 256 + p * 128 + 8 * hi;
#pragma unroll
        for (int ks = 0; ks < 8; ++ks) qf[ks] = *(const bf16x8*)(qp + 16 * ks);
#pragma unroll
        for (int nt = 0; nt < 4; ++nt) {
            f32x16 acc;
#pragma unroll
            for (int i = 0; i < 16; ++i) acc[i] = 0.f;
#pragma unroll
            for (int ks = 0; ks < 8; ++ks) { const bf16x8 kf = *(const LAS bf16x8*)(keys + ((p * 128 + 32 * nt + r32) * RT_ROW + 16 * ks + 8 * hi) * 2); acc = MFMA32(kf, qf[ks], acc); }
            unsigned L[16];
#pragma unroll
            for (int i = 0; i < 16; ++i) L[i] = (mono(acc[i]) & ~0x7fu) | (unsigned)(127 - (32 * nt + crow(i, hi)));
            sort16_desc(L);
            if (nt == 0) {
#pragma unroll
                for (int i = 0; i < 16; ++i) Tp[p][i] = L[i];
            } else merge_top16(Tp[p], L);
            __builtin_amdgcn_sched_barrier(0);
        }
    }
    unsigned T[16];
    { unsigned O[16];
#pragma unroll
      for (int i = 0; i < 16; ++i) { const auto rr = __builtin_amdgcn_permlane32_swap(Tp[0][i], Tp[1][i], false, false); T[i] = rr[0]; O[i] = rr[1]; }
      merge_top16(T, O); }
    __builtin_amdgcn_sched_barrier(0);
    float s1[16], s2[16]; unsigned i1[16], i2[16];
#pragma unroll
    for (int i = 0; i < 16; ++i) { const auto rr = __builtin_amdgcn_permlane32_swap(T[i], T[i], false, false);
        s1[i] = demono(rr[0] & ~0x7fu); i1[i] = 127u - (rr[0] & 0x7fu); s2[i] = demono(rr[1] & ~0x7fu); i2[i] = 127u - (rr[1] & 0x7fu); }
    unsigned C[64];
    { int n = 0;
#pragma unroll
      for (int a = 0; a < 16; ++a)
#pragma unroll
          for (int b = 0; b < 16; ++b) if ((a + 1) * (b + 1) <= 16) { C[n] = (mono(s1[a] + s2[b]) & ~0x3fffu) | (i1[a] << 7) | i2[b]; ++n; }
#pragma unroll
      for (int i = 50; i < 64; ++i) C[i] = 0u; }
    unsigned F[16];
#pragma unroll
    for (int i = 0; i < 16; ++i) F[i] = C[i];
    sort16_desc(F);
#pragma unroll
    for (int g = 1; g < 4; ++g) { unsigned L[16];
#pragma unroll
        for (int i = 0; i < 16; ++i) L[i] = C[16 * g + i];
        sort16_desc(L); merge_top16(F, L); __builtin_amdgcn_sched_barrier(0); }
    if (hi == 0) {
        float e[16]; float sum = 0.f; const float v0 = demono(F[0] & ~0x3fffu);
#pragma unroll
        for (int i = 0; i < 16; ++i) { e[i] = __expf(demono(F[i] & ~0x3fffu) - v0); sum += e[i]; }
        const float inv = 1.f / sum;
        int* ip = IDX + tok * 128 + h * 16; float* gp = PG + tok * 128 + h * 16;
#pragma unroll
        for (int q = 0; q < 4; ++q) { u32x4 iv; iv.x = F[4 * q] & 0x3fffu; iv.y = F[4 * q + 1] & 0x3fffu; iv.z = F[4 * q + 2] & 0x3fffu; iv.w = F[4 * q + 3] & 0x3fffu; *(u32x4*)(ip + 4 * q) = iv;
            f32x4 gv; gv[0] = e[4 * q] * inv; gv[1] = e[4 * q + 1] * inv; gv[2] = e[4 * q + 2] * inv; gv[3] = e[4 * q + 3] * inv; *(f32x4*)(gp + 4 * q) = gv; }
    }
}
typedef __bf16 bf16x2v __attribute__((ext_vector_type(2)));
DI float dot2bf(unsigned w, unsigned x, float acc) { return __builtin_amdgcn_fdot2_f32_bf16(__builtin_bit_cast(bf16x2v, w), __builtin_bit_cast(bf16x2v, x), acc, false); }
DI float gelu_erf(float v) {
    const float av = fabsf(v), t = __builtin_amdgcn_rcpf(av * 0.2316418882f + 1.0f);
    float q = t * 0.5307027145f + (-0.7265760135f); q = q * t + 0.7107068705f; q = q * t + (-0.142248368f); q = q * t + 0.127414796f; q = q * t;
    const float e = __builtin_amdgcn_exp2f((v * v) * (-0.72134752044f)); const float m = v * (q * e);
    return v < 0.f ? m : v - m;
}
DI float dppf(float v, const int ctrl_sel) {
    const int s = __float_as_int(v);
    int r;
    if (ctrl_sel == 0) r = __builtin_amdgcn_update_dpp(0, s, 0xB1, 0xF, 0xF, true);
    else if (ctrl_sel == 1) r = __builtin_amdgcn_update_dpp(0, s, 0x4E, 0xF, 0xF, true);
    else if (ctrl_sel == 2) r = __builtin_amdgcn_update_dpp(0, s, 0x141, 0xF, 0xF, true);
    else r = __builtin_amdgcn_update_dpp(0, s, 0x128, 0xF, 0xF, true);
    return __int_as_float(r);
}
DI int dppi(int s, const int ctrl_sel) {
    if (ctrl_sel == 0) return __builtin_amdgcn_update_dpp(0, s, 0xB1, 0xF, 0xF, true);
    if (ctrl_sel == 1) return __builtin_amdgcn_update_dpp(0, s, 0x4E, 0xF, 0xF, true);
    return __builtin_amdgcn_update_dpp(0, s, 0x141, 0xF, 0xF, true);
}
template <int NT>
DI void experts_u_slice(const unsigned char* __restrict__ H1Q, const unsigned char* __restrict__ U8x, const int* __restrict__ IDX, bf16_t* __restrict__ PD, size_t tok, int x, int lane) {
    const int g = lane >> 3, l8 = lane & 7;
    u32x4 hq[NT], iv[NT][4], w[NT][16];
#pragma unroll
    for (int t = 0; t < NT; ++t) { hq[t] = *(const u32x4*)(H1Q + (tok + t) * D + 128 * x + 16 * l8);
#pragma unroll
        for (int q = 0; q < 4; ++q) iv[t][q] = *(const u32x4*)(IDX + (tok + t) * 128 + 16 * g + 4 * q); }
#pragma unroll
    for (int t = 0; t < NT; ++t)
#pragma unroll
        for (int j = 0; j < 16; ++j) w[t][j] = *(const u32x4*)(U8x + (size_t)(iv[t][j >> 2][j & 3] * 128u + 16u * l8));
#pragma unroll
    for (int t = 0; t < NT; ++t) {
        float p[16];
#pragma unroll
        for (int j = 0; j < 16; ++j) { int d = 0;
#pragma unroll
            for (int q = 0; q < 4; ++q) d = __builtin_amdgcn_sdot4((int)w[t][j][q], (int)hq[t][q], d, false);
            d += dppi(d, 0); d += dppi(d, 1); d += dppi(d, 2); p[j] = (float)d; }
        if (l8 == 0) {
            u32x4 o0, o1;
            o0.x = cvtpk(p[0], p[1]); o0.y = cvtpk(p[2], p[3]); o0.z = cvtpk(p[4], p[5]); o0.w = cvtpk(p[6], p[7]);
            o1.x = cvtpk(p[8], p[9]); o1.y = cvtpk(p[10], p[11]); o1.z = cvtpk(p[12], p[13]); o1.w = cvtpk(p[14], p[15]);
            bf16_t* dp = PD + ((tok + t) * 8 + x) * 128 + 16 * g; *(u32x4*)dp = o0; *(u32x4*)(dp + 8) = o1;
        }
    }
}
DI void experts_combine(const bf16_t* __restrict__ PD, const int* __restrict__ IDX, const float* __restrict__ PG, const float* __restrict__ USC, const float* __restrict__ VSC, const float* __restrict__ HSC,
                        unsigned char* __restrict__ C8, float* __restrict__ CSC, int wave0, int nwaves, int lane) {
    for (int tok = wave0; tok < M; tok += nwaves) {
        float s0 = 0.f, s1 = 0.f;
#pragma unroll
        for (int x = 0; x < 8; ++x) { const unsigned w = *(const unsigned*)(PD + ((size_t)tok * 8 + x) * 128 + 2 * lane); s0 += __uint_as_float(w << 16); s1 += __uint_as_float(w & 0xffff0000u); }
        const u32x2 rows = *(const u32x2*)(IDX + (size_t)tok * 128 + 2 * lane); const f32x2 gt = *(const f32x2*)(PG + (size_t)tok * 128 + 2 * lane);
        const float hs = HSC[tok];
        const float c0 = gt[0] * gelu_erf(s0 * USC[rows.x] * hs) * VSC[rows.x], c1 = gt[1] * gelu_erf(s1 * USC[rows.y] * hs) * VSC[rows.y];
        const float amax = wave_max(fmaxf(fabsf(c0), fabsf(c1)));
        const float qs = amax > 0.f ? 127.f / amax : 1.f;
        const unsigned short q2 = (unsigned short)(((unsigned)__float2int_rn(c0 * qs) & 0xffu) | (((unsigned)__float2int_rn(c1 * qs) & 0xffu) << 8));
        *(unsigned short*)(C8 + (size_t)tok * 128 + 2 * lane) = q2;
        if (lane == 0) CSC[tok] = amax > 0.f ? amax * (1.f / 127.f) : 1.f;
    }
}
template <int NT>
DI void experts_v_slice(const unsigned char* __restrict__ V8x, const int* __restrict__ IDX, const unsigned char* __restrict__ C8, const float* __restrict__ CSC, bf16_t* __restrict__ FFN, size_t tok, int x, int lane) {
    const int g = lane >> 3, l8 = lane & 7;
    u32x4 iv[NT][4], w[NT][16], cq[NT];
#pragma unroll
    for (int t = 0; t < NT; ++t) { cq[t] = *(const u32x4*)(C8 + (tok + t) * 128 + 16 * g);
#pragma unroll
        for (int q = 0; q < 4; ++q) iv[t][q] = *(const u32x4*)(IDX + (tok + t) * 128 + 16 * g + 4 * q); }
#pragma unroll
    for (int t = 0; t < NT; ++t)
#pragma unroll
        for (int j = 0; j < 16; ++j) w[t][j] = *(const u32x4*)(V8x + (size_t)(iv[t][j >> 2][j & 3] * 128u + 16u * l8));
#pragma unroll
    for (int t = 0; t < NT; ++t) {
        int acc[16];
#pragma unroll
        for (int i = 0; i < 16; ++i) acc[i] = 0;
#pragma unroll
        for (int jj = 0; jj < 4; ++jj) {
            const int cdw = (int)cq[t][jj];
#pragma unroll
            for (int q = 0; q < 4; ++q) {
                const unsigned r0 = w[t][4 * jj][q], r1 = w[t][4 * jj + 1][q], r2 = w[t][4 * jj + 2][q], r3 = w[t][4 * jj + 3][q];
                const unsigned lo01 = __builtin_amdgcn_perm(r1, r0, 0x05010400u), hi01 = __builtin_amdgcn_perm(r1, r0, 0x07030602u);
                const unsigned lo23 = __builtin_amdgcn_perm(r3, r2, 0x05010400u), hi23 = __builtin_amdgcn_perm(r3, r2, 0x07030602u);
                acc[4 * q + 0] = __builtin_amdgcn_sdot4((int)__builtin_amdgcn_perm(lo23, lo01, 0x05040100u), cdw, acc[4 * q + 0], false);
                acc[4 * q + 1] = __builtin_amdgcn_sdot4((int)__builtin_amdgcn_perm(lo23, lo01, 0x07060302u), cdw, acc[4 * q + 1], false);
                acc[4 * q + 2] = __builtin_amdgcn_sdot4((int)__builtin_amdgcn_perm(hi23, hi01, 0x05040100u), cdw, acc[4 * q + 2], false);
                acc[4 * q + 3] = __builtin_amdgcn_sdot4((int)__builtin_amdgcn_perm(hi23, hi01, 0x07060302u), cdw, acc[4 * q + 3], false);
            }
        }
        const float cs = CSC[tok + t];
        float fo[16];
#pragma unroll
        for (int i = 0; i < 16; ++i) { int s = acc[i]; s += __builtin_amdgcn_update_dpp(0, s, 0x128, 0xF, 0xF, true); s += __shfl_xor(s, 16); s += __shfl_xor(s, 32); fo[i] = (float)s * cs; }
        if (g == 0) {
            u32x4 o0, o1;
            o0.x = cvtpk(fo[0], fo[1]); o0.y = cvtpk(fo[2], fo[3]); o0.z = cvtpk(fo[4], fo[5]); o0.w = cvtpk(fo[6], fo[7]);
            o1.x = cvtpk(fo[8], fo[9]); o1.y = cvtpk(fo[10], fo[11]); o1.z = cvtpk(fo[12], fo[13]); o1.w = cvtpk(fo[14], fo[15]);
            bf16_t* dp = FFN + (tok + t) * D + 128 * x + 16 * l8; *(u32x4*)dp = o0; *(u32x4*)(dp + 8) = o1;
        }
    }
}
DI void ln2_token(const bf16_t* __restrict__ FFN, const bf16_t* __restrict__ H1B, const float* __restrict__ g2, const float* __restrict__ b2, float* __restrict__ outp, size_t tok, int lane) {
    float* hr = outp + tok * D + 16 * lane;
    const u32x4 fa = *(const u32x4*)(FFN + tok * D + 16 * lane), fb = *(const u32x4*)(FFN + tok * D + 16 * lane + 8);
    const u32x4 ha = *(const u32x4*)(H1B + tok * D + 16 * lane), hb = *(const u32x4*)(H1B + tok * D + 16 * lane + 8);
    float ff[16], hh[16]; unpack8(fa, *(float(*)[8])&ff[0]); unpack8(fb, *(float(*)[8])&ff[8]); unpack8(ha, *(float(*)[8])&hh[0]); unpack8(hb, *(float(*)[8])&hh[8]);
    f32x4 v[4];
#pragma unroll
    for (int j = 0; j < 4; ++j)
#pragma unroll
        for (int e = 0; e < 4; ++e) v[j][e] = hh[4 * j + e];
    float s = 0.f;
#pragma unroll
    for (int j = 0; j < 4; ++j)
#pragma unroll
        for (int e = 0; e < 4; ++e) { v[j][e] = v[j][e] * ALPHA + ff[4 * j + e]; s += v[j][e]; }
    const float mean = wave_sum(s) * (1.f / D); float q2 = 0.f;
#pragma unroll
    for (int j = 0; j < 4; ++j)
#pragma unroll
        for (int e = 0; e < 4; ++e) { v[j][e] -= mean; q2 += v[j][e] * v[j][e]; }
    const float rstd = rsqrtf(wave_sum(q2) * (1.f / D) + LN_EPS);
#pragma unroll
    for (int j = 0; j < 4; ++j) { const f32x4 gg = *(const f32x4*)(g2 + 16 * lane + 4 * j), bb = *(const f32x4*)(b2 + 16 * lane + 4 * j); *(f32x4*)(hr + 4 * j) = v[j] * rstd * gg + bb; }
}

DI void p0_convert(const float* __restrict__ in, bf16_t* __restrict__ out, size_t n8, size_t first, size_t stride) {
    for (size_t i = first; i < n8; i += stride) { const f32x4 a = ((const f32x4*)in)[2 * i], b = ((const f32x4*)in)[2 * i + 1];
        u32x4 w; w.x = cvtpk(a[0], a[1]); w.y = cvtpk(a[2], a[3]); w.z = cvtpk(b[0], b[1]); w.w = cvtpk(b[2], b[3]); ((u32x4*)out)[i] = w; }
}
DI void p0_transpose_item(const float* __restrict__ W, int ldw, int ncols, bf16_t* __restrict__ out, int ldo, int koff, LAS float* scr, int item, int lane) {
    const int nblk = ncols / 32, kb = item / nblk, nb = item % nblk, k0 = 64 * kb, n0 = 32 * nb;
#pragma unroll 8
    for (int i = 0; i < 32; ++i) { const int kk = 2 * i + (lane >> 5); scr[kk * 33 + (lane & 31)] = W[(size_t)(k0 + kk) * ldw + n0 + (lane & 31)]; }
    asm volatile("s_waitcnt lgkmcnt(0)" ::: "memory");
    const int c = lane & 7;
#pragma unroll
    for (int j = 0; j < 4; ++j) { const int n = (lane >> 3) + 8 * j; const LAS float* s = scr + (8 * c) * 33 + n;
        u32x4 o; o.x = cvtpk(s[0 * 33], s[1 * 33]); o.y = cvtpk(s[2 * 33], s[3 * 33]); o.z = cvtpk(s[4 * 33], s[5 * 33]); o.w = cvtpk(s[6 * 33], s[7 * 33]);
        *(u32x4*)(out + (size_t)(n0 + n) * ldo + koff + k0 + 8 * c) = o; }
    asm volatile("s_waitcnt lgkmcnt(0)" ::: "memory");
}
template <bool I8>
DI void p0_fp8_row(const float* __restrict__ src, unsigned char* __restrict__ dst, float* __restrict__ scale, int row, int lane) {
    const f32x4* sp = (const f32x4*)(src + (size_t)row * D) + 4 * lane;
    f32x4 v[4]; float mx = 0.f;
#pragma unroll
    for (int j = 0; j < 4; ++j) { v[j] = sp[j]; mx = fmaxf(mx, fmaxf(fmaxf(fabsf(v[j][0]), fabsf(v[j][1])), fmaxf(fabsf(v[j][2]), fabsf(v[j][3])))); }
    mx = wave_max(mx);
    const float top = I8 ? 127.f : 224.f;
    const float sc = mx > 0.f ? top / mx : 1.f;
    u32x4 w;
#pragma unroll
    for (int j = 0; j < 4; ++j) {
        if (I8) { w[j] = ((unsigned)__float2int_rn(v[j][0] * sc) & 0xffu) | (((unsigned)__float2int_rn(v[j][1] * sc) & 0xffu) << 8) | (((unsigned)__float2int_rn(v[j][2] * sc) & 0xffu) << 16) | (((unsigned)__float2int_rn(v[j][3] * sc) & 0xffu) << 24); }
        else { int p = 0; p = __builtin_amdgcn_cvt_pk_fp8_f32(v[j][0] * sc, v[j][1] * sc, p, false); p = __builtin_amdgcn_cvt_pk_fp8_f32(v[j][2] * sc, v[j][3] * sc, p, true); w[j] = (unsigned)p; } }
    *(u32x4*)(dst + (size_t)(lane >> 3) * ((size_t)NEXP * 128) + (size_t)row * 128 + 16 * (lane & 7)) = w;
    if (lane == 0) scale[row] = mx > 0.f ? mx / top : 1.f;
}
DI void p0_misc(const float* __restrict__ hgrn_lb, const float* __restrict__ rel_bias, float* __restrict__ misc, int i) {
    if (i < 512) { const float a = hgrn_lb[i], b = hgrn_lb[512 + i]; const float mx = fmaxf(a, b); const float ea = expf(a - mx), eb = expf(b - mx); misc[i] = ea / (ea + eb); }
    if (i < 3 * 129) {
        const int g = i / 129, j = i % 129; const int dl = g == 0 ? 1 : (g == 1 ? 4 : 16); const int n = j * dl;
        int bucket;
        if (n < 16) bucket = n;
        else { const double v = log((double)n / 16.0) / log(128.0) * 16.0; int l = 16 + (int)v; bucket = l < 31 ? l : 31; }
        for (int h = 0; h < 4; ++h) misc[512 + i * 4 + h] = rel_bias[bucket * 12 + g * 4 + h];
    }
}
struct SchedMemKV {
    unsigned MEMB, W; int G, c;
    DI bool next(int i, g8::Unit& u) const {
        const int L = i * G + c; if (L >= 32) return false;
        u.dlb = 1;
        if (L < 16) { u.kind = 0; u.pm = L >> 1; u.pn = L & 1; u.a = MEMB + (unsigned)u.pm * 256u * D * 2u; u.b = W + (unsigned)u.pn * 256u * D * 2u; }
        else { const int q = L - 16; u.kind = 1; u.pm = q >> 3; u.pn = q & 7; u.a = W + (unsigned)(512 + u.pm * 256) * D * 2u; u.b = MEMB + (unsigned)u.pn * 256u * D * 2u; }
        return true;
    }
};
struct EpiMemKVF {
    static constexpr bool PERM = true, HOOK = false;
    bf16_t *MK, *MVT;
    DI void hook(f32x4 (&)[2][2][4][2], const g8::Unit&, int, int, int, int, int) const {}
    DI void operator()(const f32x4 (&acc)[2][2][4][2], const g8::Unit& u, int wr, int wc, int fr, int fq) const {
        const int rowl = wr * 64 + fr, d0 = wc * 32 + 8 * fq;
#pragma unroll
        for (int ai = 0; ai < 2; ++ai)
#pragma unroll
            for (int m = 0; m < 4; ++m) { const int R = u.pm * 256 + rowl + ai * 128 + m * 16;
#pragma unroll
                for (int bj = 0; bj < 2; ++bj) { const f32x4 v0 = acc[ai][bj][m][0], v1 = acc[ai][bj][m][1];
                    if (u.kind == 0) { const int b = R >> 8, mm = R & 255, h = u.pn * 2 + bj;
                        u32x4 w; w.x = cvtpk(v0[0], v0[1]); w.y = cvtpk(v0[2], v0[3]); w.z = cvtpk(v1[0], v1[1]); w.w = cvtpk(v1[2], v1[3]);
                        *(u32x4*)(MK + ((size_t)((b * 4 + h) * 8 + (mm >> 5))) * 4096 + frag_row_off(d0, mm & 31)) = w; }
                    else { const int h = R >> 7, d = R & 127, c = u.pn * 256 + bj * 128 + d0, b = c >> 8, mm = c & 255, kk = mm & 31;
                        bf16_t* blk = MVT + ((size_t)((b * 4 + h) * 8 + (mm >> 5))) * 4096 + (((d >> 5) * 2 + (kk >> 4)) * 64 + (d & 31)) * 8 + 4 * ((kk >> 3) & 1);
                        u32x2 wa, wb; wa.x = cvtpk(v0[0], v0[1]); wa.y = cvtpk(v0[2], v0[3]); wb.x = cvtpk(v1[0], v1[1]); wb.y = cvtpk(v1[2], v1[3]);
                        *(u32x2*)blk = wa; *(u32x2*)(blk + 32 * 8) = wb; } } }
    }
};

static_assert(HG_UNIT_BYTES <= LDSCTL_OFF, "hgrn LDS");
DI const float* karg_in(int i) { const float* const* kp = (const float* const*)__builtin_amdgcn_kernarg_segment_ptr(); asm volatile("" : "+s"(kp)); return kp[i]; }
DI float* karg_out() { float* const* kp = (float* const*)__builtin_amdgcn_kernarg_segment_ptr(); asm volatile("" : "+s"(kp)); return kp[18]; }
__global__ void __launch_bounds__(NTHR, 2) mega(Args args) {
    extern __shared__ __attribute__((aligned(16))) unsigned char lds_raw[];
    LAS unsigned char* lds = (LAS unsigned char*)lds_raw;
    volatile LAS unsigned* MISC = (volatile LAS unsigned*)(lds + MISC_OFF);
    for (int u = threadIdx.x; u < (LDS_BYTES - LDSCTL_OFF) / 4; u += NTHR) ((LAS unsigned*)(lds + LDSCTL_OFF))[u] = 0u;
    __syncthreads();
    unsigned char* ws = args.ws;
    const int G = gridDim.x;
    const bool ALL = args.ph == PH_ALL;
    XcdBarrier bar; bar.bar = (unsigned*)(ws + O_MISC + 16384); bar.x = 0; bar.st = nullptr;
    if (ALL) bar = xcd_barrier_post((unsigned*)(ws + O_MISC + 16384), MISC + 8);
#ifndef REP_MASK
#define REP_MASK 0
#endif
#define RUN(k) (ALL || args.ph == (k))
#define NREP(k) (((REP_MASK >> (k)) & 1) ? 2 : 1)
#define SEAM() do { if (ALL) xcd_barrier(bar); } while (0)
    for (int rep_ = 0; rep_ < NREP(PH_PRO); ++rep_) if (RUN(PH_PRO)) {
        int tid = threadIdx.x; asm volatile("" : "+v"(tid)); asm volatile("" : "+s"(ws)); int bid = blockIdx.x; asm volatile("" : "+s"(bid));
        const size_t gt = (size_t)bid * NTHR + tid, nth = (size_t)G * NTHR;
        p0_convert(karg_in(0), (bf16_t*)(ws + O_XB), (size_t)M * D / 8, gt, nth);
        p0_convert(karg_in(1), (bf16_t*)(ws + O_MEMB), (size_t)2048 * 1024 / 8, gt, nth);
        p0_convert(karg_in(13), (bf16_t*)(ws + O_SUBK), (size_t)16 * 128 * 128 / 8, gt, nth);
        if (bid == 0) p0_misc(karg_in(6), karg_in(5), (float*)(ws + O_MISC), tid);
        const int wid = __builtin_amdgcn_readfirstlane(tid >> 6), lane = tid & 63;
        LAS float* scr = (LAS float*)(lds + wid * 16384);
        const int gw = bid * NWAVES + wid, ngw = G * NWAVES;
        for (int r = gw; r < 2 * NEXP; r += ngw) {
            if (r < NEXP) p0_fp8_row<true>(karg_in(14), (unsigned char*)(ws + O_UB), (float*)(ws + O_USC), r, lane);
            else p0_fp8_row<true>(karg_in(15), (unsigned char*)(ws + O_VB), (float*)(ws + O_VSC), r - NEXP, lane);
        }
        constexpr int NJ = 13;
        for (int it = gw; ; it += ngw) {
            int r = it; bool done = true;
#pragma unroll
            for (int j = 0; j < NJ; ++j) {
                const int srcc[NJ] = {0, 4608, 5632, 6656, 7168, 3072, 5120, 0, 0, 0, 0, 0, 0};
                const int cnt[NJ] = {3072, 512, 1024, 512, 3072, 1536, 512, 1024, 1024, 1024, 1024, 1024, 2048};
                const int drow[NJ] = {0, 3072, 3584, 4608, 5120, 8192, 9728, 0, 0, 0, 0, 0, 0};
                const int Kj = (j >= 8 && j <= 10) ? 512 : 1024;
                const int items = (Kj / 64) * (cnt[j] / 32);
                if (done && r < items) {
                    const float* W; int ldw; bf16_t* o; int ldo, koff = 0;
                    if (j < 7) { W = karg_in(2) + srcc[j]; ldw = INC; o = (bf16_t*)(ws + O_WIN) + (size_t)drow[j] * 1024; ldo = 1024; }
                    else if (j == 7) { W = karg_in(4); ldw = 1024; o = (bf16_t*)(ws + O_WMKV); ldo = 1024; }
                    else if (j <= 10) { W = karg_in(8) + (size_t)(j - 8) * 512 * 1024; ldw = 1024; o = (bf16_t*)(ws + O_WBR); ldo = 1536; koff = (j - 8) * 512; }
                    else if (j == 11) { W = karg_in(9); ldw = 1024; o = (bf16_t*)(ws + O_WOUT); ldo = 1024; }
                    else { W = karg_in(12); ldw = 2048; o = (bf16_t*)(ws + O_WPQ); ldo = 1024; }
                    p0_transpose_item(W, ldw, cnt[j], o, ldo, koff, scr, r, lane); done = false;
                }
                r -= items;
            }
            if (done) break;
        }
        SEAM();
    }
#pragma unroll 1
    for (int p = (ALL ? 0 : args.pass); p < (ALL ? NPASS : args.pass + 1); ++p) {
        int bid = blockIdx.x; asm volatile("" : "+s"(bid));
        int tid = threadIdx.x; asm volatile("" : "+v"(tid));
        asm volatile("" : "+s"(ws));
        char* pr = (char*)ws + O_PASS;
        const size_t t0 = (size_t)p * MP;
        for (int rep_ = 0; rep_ < NREP(PH_PROJ); ++rep_) if (RUN(PH_PROJ)) {
            asm volatile("" : "+s"(bid)); asm volatile("" : "+v"(tid)); asm volatile("" : "+s"(ws)); pr = (char*)ws + O_PASS;
            SchedP1 Sc{(unsigned)(O_XB + t0 * D * 2), (unsigned)O_WIN, G, bid};
            EpiP1 E{pr, karg_in(3)};
            g8::gemm_phase<EpiP1, SchedP1>(lds, (const char*)ws, D, Sc, E, tid);
            if (p == 0) {
                SchedMemKV S2{(unsigned)O_MEMB, (unsigned)O_WMKV, G, bid};
                EpiMemKVF E2{(bf16_t*)(ws + O_MK), (bf16_t*)(ws + O_MVT)};
                g8::gemm_phase<EpiMemKVF, SchedMemKV>(lds, (const char*)ws, D, S2, E2, tid);
            }
            SEAM();
        }
        for (int rep_ = 0; rep_ < NREP(PH_ATTN); ++rep_) if (RUN(PH_ATTN)) {
            asm volatile("" : "+s"(bid)); asm volatile("" : "+v"(tid)); asm volatile("" : "+s"(ws)); pr = (char*)ws + O_PASS;
            const float* bsrc = (const float*)(ws + O_MISC) + 512; LAS float* btab = (LAS float*)lds;
            for (int i = tid; i < 3 * 129 * 4; i += NTHR) btab[i] = bsrc[i] * LOG2E;
            __syncthreads();
            const int wid = __builtin_amdgcn_readfirstlane(tid >> 6), lane = tid & 63;
            for (int task = bid * NWAVES + wid; task < DIL_TASKS; task += G * NWAVES)
                attn_dil_wave((const bf16_t*)(pr + P_QK), (const bf16_t*)(pr + P_VT), btab, (bf16_t*)(pr + P_OG), (float*)(pr + P_LSE), task, lane);
            for (int task = bid * NWAVES + wid; task < MEM_TASKS; task += G * NWAVES)
                attn_mem_wave((const bf16_t*)(pr + P_MQ), (const bf16_t*)(ws + O_MK), (const bf16_t*)(ws + O_MVT), (bf16_t*)(pr + P_BR), task, p * BPP, lane);
            __syncthreads();
        }
        for (int rep_ = 0; rep_ < NREP(PH_HGPRE); ++rep_) if (RUN(PH_HGPRE)) {
            asm volatile("" : "+s"(bid)); asm volatile("" : "+v"(tid)); asm volatile("" : "+s"(ws)); pr = (char*)ws + O_PASS;
            { const int unit = bid; static_assert(HG_UNITS == 256, "one HGRN unit per workgroup"); if (unit < HG_UNITS) {
                hgrn_unit<false>(lds, unit, tid, (const bf16_t*)(pr + P_HFQG), (const bf16_t*)(pr + P_IT), (const float*)(ws + O_MISC), karg_in(7),
                                 (float*)(pr + P_HSTL), (float*)(pr + P_HSTD), (const float*)(pr + P_SIN), (bf16_t*)(pr + P_BR));
            } }
            SEAM();
        }
        for (int rep_ = 0; rep_ < NREP(PH_HGSCAN); ++rep_) if (RUN(PH_HGSCAN)) {
            asm volatile("" : "+s"(bid)); asm volatile("" : "+v"(tid)); asm volatile("" : "+s"(ws)); pr = (char*)ws + O_PASS;
            hgrn_scan((const float*)(pr + P_HSTL), (const float*)(pr + P_HSTD), (float*)(pr + P_SIN), bid * NTHR + tid);
            lse_merge_items((const bf16_t*)(pr + P_OG), (const float*)(pr + P_LSE), (bf16_t*)(pr + P_BR), bid * NTHR + tid, G * NTHR);
            SEAM();
        }
        for (int rep_ = 0; rep_ < NREP(PH_HGMAIN); ++rep_) if (RUN(PH_HGMAIN)) {
            asm volatile("" : "+s"(bid)); asm volatile("" : "+v"(tid)); asm volatile("" : "+s"(ws)); pr = (char*)ws + O_PASS;
            { const int unit = bid; static_assert(HG_UNITS == 256, "one HGRN unit per workgroup"); if (unit < HG_UNITS) {
                hgrn_unit<true>(lds, unit, tid, (const bf16_t*)(pr + P_HFQG), (const bf16_t*)(pr + P_IT), (const float*)(ws + O_MISC), karg_in(7),
                                (float*)(pr + P_HSTL), (float*)(pr + P_HSTD), (const float*)(pr + P_SIN), (bf16_t*)(pr + P_BR));
            } }
            SEAM();
        }
        for (int rep_ = 0; rep_ < NREP(PH_WIDEN); ++rep_) if (RUN(PH_WIDEN)) {
            asm volatile("" : "+s"(bid)); asm volatile("" : "+v"(tid)); asm volatile("" : "+s"(ws)); pr = (char*)ws + O_PASS;
            SchedRows Sc{(unsigned)(O_PASS + P_BR), (unsigned)O_WBR, 1536, 4, 256, G, bid};
            EpiWidenF E{(const bf16_t*)(pr + P_GATE), (bf16_t*)(pr + P_MERGED)};
            g8::gemm_phase<EpiWidenF, SchedRows>(lds, (const char*)ws, 1536, Sc, E, tid);
            SEAM();
        }
        for (int rep_ = 0; rep_ < NREP(PH_WOUT); ++rep_) if (RUN(PH_WOUT)) {
            asm volatile("" : "+s"(bid)); asm volatile("" : "+v"(tid)); asm volatile("" : "+s"(ws)); pr = (char*)ws + O_PASS;
            SchedRows Sc{(unsigned)(O_PASS + P_MERGED), (unsigned)O_WOUT, 1024, 4, 256, G, bid};
            EpiPlainB16 E{(bf16_t*)(pr + P_MIX), 1024, 0};
            g8::gemm_phase<EpiPlainB16, SchedRows>(lds, (const char*)ws, 1024, Sc, E, tid);
            SEAM();
        }
        for (int rep_ = 0; rep_ < NREP(PH_LN1); ++rep_) if (RUN(PH_LN1)) {
            asm volatile("" : "+s"(bid)); asm volatile("" : "+v"(tid)); asm volatile("" : "+s"(ws)); pr = (char*)ws + O_PASS;
            ln1_rows(karg_in(0) + t0 * D, (const bf16_t*)(pr + P_MIX), karg_in(10), karg_in(11), (bf16_t*)(ws + O_H1B) + t0 * D, (unsigned char*)(ws + O_H1Q) + t0 * D, (float*)(ws + O_HSC) + t0, bid * NWAVES + (tid >> 6), G * NWAVES, tid & 63);
        }
    }
    for (int rep_ = 0; rep_ < NREP(PH_PQ); ++rep_) if (RUN(PH_PQ)) {
        SEAM();
        int tid = threadIdx.x; asm volatile("" : "+v"(tid)); asm volatile("" : "+s"(ws)); int bid = blockIdx.x; asm volatile("" : "+s"(bid));
        char* pr = (char*)ws + O_PASS;
        SchedRows Sc{(unsigned)O_H1B, (unsigned)O_WPQ, 1024, 8, 2048, G, bid};
        EpiPlainB16 E{(bf16_t*)(pr + P_PQ), 2048, 0};
        g8::gemm_phase<EpiPlainB16, SchedRows>(lds, (const char*)ws, 1024, Sc, E, tid);
        SEAM();
    }
    for (int rep_ = 0; rep_ < NREP(PH_ROUTE); ++rep_) if (RUN(PH_ROUTE)) {
        int tid = threadIdx.x; asm volatile("" : "+v"(tid)); asm volatile("" : "+s"(ws)); int bid = blockIdx.x; asm volatile("" : "+s"(bid));
        char* pr = (char*)ws + O_PASS;
        const int h = bid & 7, wgi = bid >> 3, nwg = G >> 3;
        const bf16_t* ksrc = (const bf16_t*)(ws + O_SUBK) + (size_t)h * 2 * 128 * 128;
        for (int i = tid; i < 2 * 128 * 16; i += NTHR) { const int rowk = i >> 4, ch = i & 15; *(LAS u32x4*)(lds + (rowk * RT_ROW + ch * 8) * 2) = *(const u32x4*)(ksrc + rowk * 128 + ch * 8); }
        __syncthreads();
        const int wid = __builtin_amdgcn_readfirstlane(tid >> 6), lane = tid & 63;
        for (int tb = wgi * NWAVES + wid; tb < M / 32; tb += nwg * NWAVES)
            route_wave((const bf16_t*)(pr + P_PQ), lds, (int*)(pr + P_IDX), (float*)(pr + P_PG), tb, h, lane);
        __syncthreads();
        SEAM();
    }
    if (RUN(PH_EXPERTS)) {
        int tid = threadIdx.x; asm volatile("" : "+v"(tid)); asm volatile("" : "+s"(ws)); int bid = blockIdx.x; asm volatile("" : "+s"(bid));
        char* pr = (char*)ws + O_PASS;
        const int wid = __builtin_amdgcn_readfirstlane(tid >> 6), lane = tid & 63;
        if (tid == 0) {
            unsigned base = 0; const unsigned myx = ALL ? bar.x : 0u;
            if (ALL) { for (unsigned jx = 0; jx < 16; ++jx) { const unsigned c = xb_ld(&bar.bar[XB_XCNT(jx)]); if (jx < myx) base += c; } MISC[12] = base + MISC[10]; }
            else MISC[12] = (unsigned)bid;
        }
        __syncthreads();
        const int vwg = (int)MISC[12];
        const int nper = G >> 3, x = vwg / nper, r = vwg % nper;
        const int tpw = M / (nper * NWAVES);
        const size_t tokw0 = (size_t)(r * NWAVES + wid) * tpw;
        {
            const unsigned char* U8x = (const unsigned char*)(ws + O_UB) + (size_t)x * ((size_t)NEXP * 128);
            for (int i = 0; i < tpw; i += 2) experts_u_slice<2>((const unsigned char*)(ws + O_H1Q), U8x, (const int*)(pr + P_IDX), (bf16_t*)(pr + P_PD), tokw0 + i, x, lane);
        }
        SEAM();
        experts_combine((const bf16_t*)(pr + P_PD), (const int*)(pr + P_IDX), (const float*)(pr + P_PG), (const float*)(ws + O_USC), (const float*)(ws + O_VSC), (const float*)(ws + O_HSC), (unsigned char*)(pr + P_C), (float*)(pr + P_C + (size_t)M * 128), bid * NWAVES + wid, G * NWAVES, lane);
        SEAM();
        {
            const unsigned char* V8x = (const unsigned char*)(ws + O_VB) + (size_t)x * ((size_t)NEXP * 128);
            for (int i = 0; i < tpw; i += 2) experts_v_slice<2>(V8x, (const int*)(pr + P_IDX), (const unsigned char*)(pr + P_C), (const float*)(pr + P_C + (size_t)M * 128), (bf16_t*)(pr + P_FFN), tokw0 + i, x, lane);
        }
        SEAM();
        for (int tok = bid * NWAVES + wid; tok < M; tok += G * NWAVES) ln2_token((const bf16_t*)(pr + P_FFN), (const bf16_t*)(ws + O_H1B), karg_in(16), karg_in(17), karg_out(), (size_t)tok, lane);
    }
#undef RUN
#undef SEAM
}

extern "C" void kernel_launch(void* const* d_in, const int* in_sizes, int n_in, void* d_out, int out_size, void* d_ws, size_t ws_size, hipStream_t stream) {
    if (ws_size < WS_NEED || n_in != 18) return;
    static bool attr_set = false;
    if (!attr_set) { (void)hipFuncSetAttribute((const void*)mega, hipFuncAttributeMaxDynamicSharedMemorySize, LDS_BYTES); attr_set = true; }
    (void)hipMemsetAsync((char*)d_ws + O_MISC + 16384, 0, 16384, stream);
    Args a{}; for (int i = 0; i < 18; ++i) a.in[i] = (const float*)d_in[i]; a.out = (float*)d_out; a.ws = (unsigned char*)d_ws; a.ph = PH_ALL; a.pass = 0;
    mega<<<256, NTHR, LDS_BYTES, stream>>>(a);
}
```

```cpp
#include <hip/hip_runtime.h>
#include <stdint.h>
#include <math.h>

typedef unsigned short bf16_t;
typedef short bf16x8 __attribute__((ext_vector_type(8)));
typedef float f32x4 __attribute__((ext_vector_type(4)));
#define DI __device__ __forceinline__

DI float bf2f(bf16_t v) { return __uint_as_float(((unsigned)v) << 16); }
DI bf16_t f2bf(float f) { unsigned u = __float_as_uint(f); u += 0x7fffu + ((u >> 16) & 1u); return (bf16_t)(u >> 16); }

constexpr int NB = 8, S = 8192, D = 1024, M = NB * S;
constexpr int NPASS = 4, BPP = NB / NPASS, MP = BPP * S;
constexpr int INC = 10240;
constexpr int NEXP = 16384;
constexpr float ALPHA = 1.189207115002721f;
constexpr float LN_EPS = 1e-5f;
constexpr float QSCALE = 0.08838834764831845f;

constexpr size_t al(size_t x) { return (x + 255) & ~(size_t)255; }
constexpr size_t O_WIN = 0;
constexpr size_t O_WMKV = O_WIN + al((size_t)INC * D * 2);
constexpr size_t O_WBR = O_WMKV + al((size_t)1024 * 1024 * 2);
constexpr size_t O_WOUT = O_WBR + al((size_t)1024 * 1536 * 2);
constexpr size_t O_WPQ = O_WOUT + al((size_t)1024 * 1024 * 2);
constexpr size_t O_SUBK = O_WPQ + al((size_t)2048 * 1024 * 2);
constexpr size_t O_UB = O_SUBK + al((size_t)16 * 128 * 128 * 2);
constexpr size_t O_VB = O_UB + al((size_t)NEXP * D);
constexpr size_t O_USC = O_VB + al((size_t)NEXP * D);
constexpr size_t O_VSC = O_USC + al((size_t)NEXP * 4);
constexpr size_t O_XB = O_VSC + al((size_t)NEXP * 4);
constexpr size_t O_MEMB = O_XB + al((size_t)M * D * 2);
constexpr size_t O_MK = O_MEMB + al((size_t)2048 * 1024 * 2);
constexpr size_t O_MVT = O_MK + al((size_t)2048 * 512 * 2);
constexpr size_t O_H1B = O_MVT + al((size_t)8 * 512 * 256 * 2);
constexpr size_t O_H1Q = O_H1B + al((size_t)M * D * 2);
constexpr size_t O_HSC = O_H1Q + al((size_t)M * D);
constexpr size_t O_MISC = O_HSC + al((size_t)M * 4);
constexpr size_t O_PASS = O_MISC + al(65536);
constexpr size_t P_QK = 0;
constexpr size_t P_VT = P_QK + al((size_t)MP * 3072 * 2);
constexpr size_t P_IT = P_VT + (size_t)1536 * MP * 2;
constexpr size_t P_HFQG = P_IT + al((size_t)512 * MP * 2);
constexpr size_t P_MQ = P_HFQG + al((size_t)MP * 1536 * 2);
constexpr size_t P_GATE = P_MQ + al((size_t)MP * 512 * 2);
constexpr size_t P_OG = P_GATE + al((size_t)MP * 3072 * 2);
constexpr size_t P_LSE = P_OG + al((size_t)MP * 1536 * 2);
constexpr size_t P_BR = P_LSE + al((size_t)MP * 12 * 4);
constexpr size_t P_MERGED = P_BR + al((size_t)MP * 1536 * 2);
constexpr size_t P_MIX = P_MERGED + al((size_t)MP * 1024 * 2);
constexpr size_t P_HSTL = P_MIX + al((size_t)MP * 1024 * 4);
constexpr size_t P_HSTD = P_HSTL + al((size_t)256 * 16384 * 4);
constexpr size_t P_SIN = P_HSTD + al((size_t)256 * 128 * 4);
constexpr size_t P_END = P_SIN + al((size_t)256 * 16384 * 4);
constexpr size_t P_PQ = 0;
constexpr size_t P_IDX = P_PQ + al((size_t)M * 2048 * 2);
constexpr size_t P_PG = P_IDX + al((size_t)M * 128 * 4);
constexpr size_t P_C = P_PG + al((size_t)M * 128 * 4);
constexpr size_t P_END2 = P_C + al((size_t)M * 128 * 4);
constexpr size_t P_PD = 0;
constexpr size_t P_FFN = P_PD + al((size_t)M * 1024 * 2);
static_assert(P_FFN + (size_t)M * 1024 * 2 <= P_IDX, "PEER overlay");
constexpr size_t WS_NEED = O_PASS + (P_END > P_END2 ? P_END : P_END2);
static_assert(WS_NEED <= (size_t)1073741824, "workspace budget");

DI int dil_of(int g) { return g == 0 ? 1 : (g == 1 ? 4 : 16); }
DI float wave_max(float v) {
#pragma unroll
    for (int o = 1; o < 64; o <<= 1) v = fmaxf(v, __shfl_xor(v, o));
    return v;
}
DI float wave_sum(float v) {
#pragma unroll
    for (int o = 1; o < 64; o <<= 1) v += __shfl_xor(v, o);
    return v;
}

#define LAS __attribute__((address_space(3)))
#define GAS __attribute__((address_space(1)))
typedef unsigned u32x4 __attribute__((ext_vector_type(4)));
typedef unsigned u32x2 __attribute__((ext_vector_type(2)));
typedef float f32x2 __attribute__((ext_vector_type(2)));
typedef __bf16 bf16x2_t __attribute__((ext_vector_type(2)));
DI unsigned cvtpk(float lo, float hi) { f32x2 v = {lo, hi}; bf16x2_t b = __builtin_convertvector(v, bf16x2_t); return __builtin_bit_cast(unsigned, b); }
constexpr float LOG2E = 1.4426950408889634f;
DI float fast_sigmoid(float z) { return __builtin_amdgcn_rcpf(1.f + __builtin_amdgcn_exp2f(-z * LOG2E)); }

namespace g8 {
constexpr int BM = 256, BK = 64, HALF = 128, HTB = HALF * BK * 2, STAGE_BYTES = 8 * HTB;
DI int lds_byte(int r, int c) { const int st = (r >> 4) * 2 + (c >> 5), rr = r & 15, cc = c & 31, ob = rr * 64 + cc * 2; return st * 1024 + (ob ^ (((ob >> 9) & 1) << 5)); }
DI void stage_rc(int b, int& R, int& C) { const int st = b / 1024, sb = b % 1024, swz = sb ^ (((sb >> 9) & 1) << 5); R = (st >> 1) * 16 + swz / 64; C = (st & 1) * 32 + (swz % 64) / 2; }
DI int perm32(int rho) { const int n = rho >> 4, i = rho & 15; return 8 * (i >> 2) + 4 * n + (i & 3); }

struct Unit { unsigned a, b; int dla, dlb; int pm, pn, kind; };

template <class Epi, class Sched>
DI void gemm_phase(LAS unsigned char* lds, const char* const wsb, const int K, const Sched& S, const Epi& E, const int tid) {
    const int wid = __builtin_amdgcn_readfirstlane(tid >> 6), lane = tid & 63, wr = wid >> 2, wc = wid & 3, fr = lane & 15, fq = lane >> 4;
    const int nt = K / BK;
    unsigned rak[2], rbk[2], ccb[2];
#pragma unroll
    for (int i = 0; i < 2; ++i) { int R, C; stage_rc(tid * 16 + i * 8192, R, C); const int Rb = Epi::PERM ? ((R & ~31) + perm32(R & 31)) : R;
        rak[i] = (unsigned)(R * K) * 2u; rbk[i] = (unsigned)(Rb * K) * 2u; ccb[i] = (unsigned)C * 2u; }
    const unsigned kstep = (unsigned)(BK * 2);
    const unsigned hstepA = (unsigned)(HALF * K * 2);
    const unsigned ldsw = (unsigned)wid * 1024u;
    const int aoff = lds_byte(wr * 64 + fr, fq * 8), boff = lds_byte(wc * 32 + fr, fq * 8);
#define G8_SA(b, h) (((b) * 2 + (h)) * HTB)
#define G8_SB(b, h) ((4 + (b) * 2 + (h)) * HTB)
#define G8_STAGE(bufoff, gbase, v0, v1) do { \
        __builtin_amdgcn_global_load_lds((const unsigned*)(wsb + (unsigned)((gbase) + (v0))), (LAS unsigned*)(lds + (bufoff) + ldsw), 16, 0, 0); \
        __builtin_amdgcn_global_load_lds((const unsigned*)(wsb + (unsigned)((gbase) + (v1))), (LAS unsigned*)(lds + (bufoff) + ldsw + 8192), 16, 0, 0); } while (0)
#define G8_LDA(dst, b, h) do { _Pragma("unroll") for (int m = 0; m < 4; ++m) _Pragma("unroll") for (int k = 0; k < 2; ++k) dst[m][k] = *(const LAS bf16x8*)(lds + G8_SA(b, h) + aoff + m * 2048 + k * 1024); } while (0)
#define G8_LDB(dst, b, h) do { _Pragma("unroll") for (int n = 0; n < 2; ++n) _Pragma("unroll") for (int k = 0; k < 2; ++k) dst[n][k] = *(const LAS bf16x8*)(lds + G8_SB(b, h) + boff + n * 2048 + k * 1024); } while (0)
#define G8_MMA(ai, bj, At, Bt) do { __builtin_amdgcn_s_setprio(1); _Pragma("unroll") for (int m = 0; m < 4; ++m) _Pragma("unroll") for (int n = 0; n < 2; ++n) _Pragma("unroll") for (int k = 0; k < 2; ++k) \
        acc[ai][bj][m][n] = __builtin_amdgcn_mfma_f32_16x16x32_bf16(Bt[n][k], At[m][k], acc[ai][bj][m][n], 0, 0, 0); __builtin_amdgcn_s_setprio(0); } while (0)
#define G8_WAIT_V(n) asm volatile("s_waitcnt vmcnt(" #n ")" ::: "memory")
#define G8_WAIT_L(n) asm volatile("s_waitcnt lgkmcnt(" #n ")" ::: "memory")
#define G8_BAR __builtin_amdgcn_s_barrier()
#define G8_SCHED __builtin_amdgcn_sched_barrier(0)
    Unit cur, nxt; int ui = 0;
    if (!S.next(0, cur)) return;
    f32x4 acc[2][2][4][2];
#pragma unroll
    for (int a = 0; a < 2; ++a)
#pragma unroll
        for (int b = 0; b < 2; ++b)
#pragma unroll
            for (int m = 0; m < 4; ++m)
#pragma unroll
                for (int n = 0; n < 2; ++n) acc[a][b][m][n] = (f32x4){0.f, 0.f, 0.f, 0.f};
    bf16x8 At[4][2], B0[2][2], B1[2][2];
    unsigned cA = cur.a, cB = cur.b;
    unsigned vBc0 = rbk[0] * (unsigned)cur.dlb + ccb[0], vBc1 = rbk[1] * (unsigned)cur.dlb + ccb[1]; unsigned hBc = hstepA * (unsigned)cur.dlb;
    unsigned vAc0 = rak[0] * (unsigned)cur.dla + ccb[0], vAc1 = rak[1] * (unsigned)cur.dla + ccb[1]; unsigned hAc = hstepA * (unsigned)cur.dla;
    G8_STAGE(G8_SB(0, 0), cB, vBc0, vBc1); G8_STAGE(G8_SB(0, 1), cB + hBc, vBc0, vBc1); G8_STAGE(G8_SA(0, 0), cA, vAc0, vAc1); G8_STAGE(G8_SA(0, 1), cA + hAc, vAc0, vAc1);
    if (wr == 1) G8_BAR;
    G8_WAIT_V(2); G8_BAR;
    G8_STAGE(G8_SB(1, 0), cB + kstep, vBc0, vBc1); G8_STAGE(G8_SA(1, 0), cA + kstep, vAc0, vAc1); G8_STAGE(G8_SB(1, 1), cB + hBc + kstep, vBc0, vBc1);
    G8_WAIT_V(6); G8_BAR;
    for (;;) {
        const bool has_next = S.next(ui + 1, nxt);
        const unsigned nA = has_next ? nxt.a : cA, nB = has_next ? nxt.b : cB; const int dln = has_next ? nxt.dlb : cur.dlb;
        const unsigned vBn0 = rbk[0] * (unsigned)dln + ccb[0], vBn1 = rbk[1] * (unsigned)dln + ccb[1]; const unsigned hBn = hstepA * (unsigned)dln;
        const int dlan = has_next ? nxt.dla : cur.dla;
        const unsigned vAn0 = rak[0] * (unsigned)dlan + ccb[0], vAn1 = rak[1] * (unsigned)dlan + ccb[1]; const unsigned hAn = hstepA * (unsigned)dlan;
        for (int t = 0; t < nt; t += 2) {
            if constexpr (Epi::HOOK) E.hook(acc, cur, t, wr, wc, fr, fq);
            const bool last = (t == nt - 2);
            const unsigned a1 = cA + (unsigned)(t + 1) * kstep;
            const unsigned a2 = last ? nA : cA + (unsigned)(t + 2) * kstep, b2 = last ? nB : cB + (unsigned)(t + 2) * kstep;
            const unsigned a3 = a2 + kstep, b3 = b2 + kstep;
            const unsigned vB0 = last ? vBn0 : vBc0, vB1 = last ? vBn1 : vBc1; const unsigned hB = last ? hBn : hBc;
            const unsigned vA0 = last ? vAn0 : vAc0, vA1 = last ? vAn1 : vAc1; const unsigned hA = last ? hAn : hAc;
            G8_LDB(B0, 0, 0); G8_LDB(B1, 0, 1); G8_SCHED; G8_LDA(At, 0, 0); G8_STAGE(G8_SA(1, 1), a1 + hAc, vAc0, vAc1);
            G8_WAIT_V(8); G8_WAIT_L(0); G8_BAR; G8_MMA(0, 0, At, B0); G8_MMA(0, 1, At, B1); G8_BAR; G8_SCHED;
            G8_LDA(At, 0, 1); G8_STAGE(G8_SB(0, 0), b2, vB0, vB1); G8_STAGE(G8_SB(0, 1), b2 + hB, vB0, vB1); G8_STAGE(G8_SA(0, 0), a2, vA0, vA1);
            G8_WAIT_V(8); G8_WAIT_L(0); G8_BAR; G8_MMA(1, 0, At, B0); G8_MMA(1, 1, At, B1); G8_BAR; G8_SCHED;
            G8_LDB(B0, 1, 0); G8_LDB(B1, 1, 1); G8_SCHED; G8_LDA(At, 1, 0); G8_STAGE(G8_SA(0, 1), a2 + hA, vA0, vA1);
            G8_WAIT_V(8); G8_WAIT_L(0); G8_BAR; G8_MMA(0, 0, At, B0); G8_MMA(0, 1, At, B1); G8_BAR; G8_SCHED;
            G8_LDA(At, 1, 1); G8_STAGE(G8_SB(1, 0), b3, vB0, vB1); G8_STAGE(G8_SB(1, 1), b3 + hB, vB0, vB1); G8_STAGE(G8_SA(1, 0), a3, vA0, vA1);
            G8_WAIT_V(8); G8_WAIT_L(0); G8_BAR; G8_MMA(1, 0, At, B0); G8_MMA(1, 1, At, B1); G8_BAR; G8_SCHED;
        }
        if (wr == 0) G8_BAR;
        E(acc, cur, wr, wc, fr, fq);
        if (!has_next) break;
#pragma unroll
        for (int a = 0; a < 2; ++a)
#pragma unroll
            for (int b = 0; b < 2; ++b)
#pragma unroll
                for (int m = 0; m < 4; ++m)
#pragma unroll
                    for (int n = 0; n < 2; ++n) acc[a][b][m][n] = (f32x4){0.f, 0.f, 0.f, 0.f};
        cur = nxt; cA = nA; cB = nB; vBc0 = vBn0; vBc1 = vBn1; hBc = hBn; vAc0 = vAn0; vAc1 = vAn1; hAc = hAn; ++ui;
        if (wr == 1) G8_BAR;
    }
    G8_WAIT_V(0);
    G8_BAR;
#undef G8_SA
#undef G8_SB
#undef G8_STAGE
#undef G8_LDA
#undef G8_LDB
#undef G8_MMA
#undef G8_WAIT_V
#undef G8_WAIT_L
#undef G8_BAR
#undef G8_SCHED
}
}

typedef GAS unsigned gu32;
#define XB_TMO      128
#define XB_XCNT(j)  (256  + 64 * (j))
#define XB_XSUB(j)  (1280 + 64 * (j))
#define XB_XGEN(j)  (2304 + 64 * (j))
#define XB_TOP      3328
#define XB_TOPGEN   3392
#define XCD_BAR_WORDS 3456
#define XB_SPIN_CAP (1u << 22)
DI unsigned xb_ld(unsigned* p)              { return __hip_atomic_load(p, __ATOMIC_RELAXED, __HIP_MEMORY_SCOPE_AGENT); }
DI unsigned xb_add(unsigned* p, unsigned v) { return __hip_atomic_fetch_add(p, v, __ATOMIC_RELAXED, __HIP_MEMORY_SCOPE_AGENT); }
DI unsigned xb_xcc_id() { return (unsigned)__builtin_amdgcn_s_getreg((3 << 11) | 20) & 0xFu; }
#define XB_SPIN(cond, bar) do { unsigned _sp = 0; while (cond) { __builtin_amdgcn_s_sleep(1); \
    if ((++_sp & 255u) == 0u) { if (xb_ld(&(bar)[XB_TMO])) break; if (_sp > XB_SPIN_CAP) { atomicAdd(&(bar)[XB_TMO], 1u); break; } } } } while (0)
struct XcdBarrier { unsigned* bar; unsigned x; volatile LAS unsigned* st; };
DI XcdBarrier xcd_barrier_post(unsigned* bar, volatile LAS unsigned* st) {
    XcdBarrier b; b.bar = bar; b.x = xb_xcc_id(); b.st = st;
    if (threadIdx.x == 0) st[2] = xb_add(&bar[XB_XCNT(b.x)], 1u);
    return b;
}
DI void xcd_barrier_complete(unsigned* bar, unsigned x, unsigned& nloc, unsigned& nx) {
    const unsigned G = gridDim.x * gridDim.y * gridDim.z;
    unsigned sum, cnt, mine, sp = 0u;
    for (;;) {
        sum = 0u; cnt = 0u; mine = 0u;
#pragma unroll
        for (unsigned j = 0; j < 16; ++j) { const unsigned c = xb_ld(&bar[XB_XCNT(j)]); sum += c; cnt += (c > 0u) ? 1u : 0u; mine = (j == x) ? c : mine; }
        if (sum == G) break;
        __builtin_amdgcn_s_sleep(1);
        if ((++sp & 255u) == 0u) { if (xb_ld(&bar[XB_TMO])) break; if (sp > XB_SPIN_CAP) { atomicAdd(&bar[XB_TMO], 1u); break; } }
    }
    nloc = mine > 0u ? mine : 1u; nx = cnt > 0u ? cnt : 1u;
}
DI void xcd_barrier(const XcdBarrier& b) {
    asm volatile("s_waitcnt vmcnt(0)" ::: "memory");
    __syncthreads();
    if (threadIdx.x == 0) {
        unsigned* bar = b.bar;
        __builtin_amdgcn_s_waitcnt(0);
        unsigned nloc = b.st[0], nx = b.st[1];
        if (nloc == 0u) { xcd_barrier_complete(bar, b.x, nloc, nx); b.st[0] = nloc; b.st[1] = nx; }
        const unsigned old = xb_add(&bar[XB_XSUB(b.x)], 1u);
        const unsigned gen = old / nloc;
        if (old + 1u == (gen + 1u) * nloc) {
            __builtin_amdgcn_fence(__ATOMIC_RELEASE, "agent");
            asm volatile("s_waitcnt vmcnt(0)" ::: "memory");
            const unsigned og = xb_add(&bar[XB_TOP], 1u);
            const unsigned tg = og / nx;
            if (og + 1u == (tg + 1u) * nx) xb_add(&bar[XB_TOPGEN], 1u);
            else XB_SPIN(xb_ld(&bar[XB_TOPGEN]) == tg, bar);
            __builtin_amdgcn_fence(__ATOMIC_ACQUIRE, "agent");
            xb_add(&bar[XB_XGEN(b.x)], 1u);
            asm volatile("s_waitcnt vmcnt(0)" ::: "memory");
        } else {
            XB_SPIN(xb_ld(&bar[XB_XGEN(b.x)]) == gen, bar);
            __builtin_amdgcn_fence(__ATOMIC_ACQUIRE, "agent");
            asm volatile("s_waitcnt vmcnt(0)" ::: "memory");
        }
    }
    __syncthreads();
}

constexpr int NWAVES = 8, NTHR = NWAVES * 64;
constexpr int RING_BYTES = 131072, LDS_BYTES = 147456, LDSCTL_OFF = LDS_BYTES - 1024, MISC_OFF = LDSCTL_OFF + 320;
constexpr size_t CTL_BYTES = 65536;
enum { PH_ALL = 0, PH_PRO = 11, PH_PROJ = 1, PH_ATTN = 2, PH_HGPRE = 3, PH_HGMAIN = 4, PH_WIDEN = 5, PH_WOUT = 6, PH_LN1 = 7, PH_PQ = 8, PH_ROUTE = 9, PH_EXPERTS = 10, PH_HGSCAN = 12 };
struct Args { const float* in[18]; float* out; unsigned char* ws; int ph, pass; };

struct Bufs {
    const bf16_t *WIN, *XBp; bf16_t *QK, *VIT, *HFQG, *MQ, *GATE;
};

struct SchedP1 {
    unsigned XBp, W; int G, c;
    DI bool next(int i, g8::Unit& u) const {
        const int L = i * G + c; if (L >= 2560) return false;
        if (L < 2048) { const int x = L & 7, off = L >> 3; u.pm = 8 * x + (off & 7); u.pn = off >> 3; u.kind = 0; u.dlb = 1;
            const int hp = u.pn < 12 ? (u.pn < 6 ? u.pn : u.pn - 6) : 0, dl = hp < 2 ? 1 : (hp < 4 ? 4 : 16);
            const int v0 = u.pm * 256, lb = v0 / S, vv = v0 % S, per = S / dl, r = vv / per, m0 = vv % per;
            u.dla = dl; u.a = XBp + (unsigned)(lb * S + m0 * dl + r) * D * 2u; u.b = W + (unsigned)u.pn * 256u * D * 2u; }
        else { const int idx = L - 2048; u.pm = idx & 7; u.pn = idx >> 3; u.kind = 1;
            const int dl = u.pm < 2 ? 1 : (u.pm < 4 ? 4 : (u.pm < 6 ? 16 : 1));
            const int v0 = u.pn * 256, lb = v0 / S, vv = v0 % S, per = S / dl, r = vv / per, m0 = vv % per;
            u.dla = 1; u.dlb = dl; u.a = W + (unsigned)(8192 + u.pm * 256) * D * 2u; u.b = XBp + (unsigned)(lb * S + m0 * dl + r) * D * 2u; }
        return true;
    }
};
DI int frag_row_off(int d0, int r32) { return (((d0 >> 4) * 64 + ((d0 >> 3) & 1) * 32 + r32) * 8); }
struct EpiP1 {
    static constexpr bool PERM = true, HOOK = false;
    char* pr; const float* b_gate;
    DI void hook(f32x4 (&)[2][2][4][2], const g8::Unit&, int, int, int, int, int) const {}
    DI void operator()(const f32x4 (&acc)[2][2][4][2], const g8::Unit& u, int wr, int wc, int fr, int fq) const {
        const int rowl = wr * 64 + fr, d0 = wc * 32 + 8 * fq;
        if (u.kind == 1) {
#pragma unroll
            for (int ai = 0; ai < 2; ++ai)
#pragma unroll
                for (int m = 0; m < 4; ++m) { const int R = u.pm * 256 + rowl + ai * 128 + m * 16;
#pragma unroll
                    for (int bj = 0; bj < 2; ++bj) { const f32x4 v0 = acc[ai][bj][m][0], v1 = acc[ai][bj][m][1];
                        const int c = u.pn * 256 + bj * 128 + d0;
                        if (R < 1536) {
                            const int gh = R >> 7, d = R & 127, lb = c >> 13, pos = c & (S - 1), kk = pos & 31;
                            bf16_t* blk = (bf16_t*)(pr + P_VT) + ((size_t)((lb * 12 + gh) * 256 + (pos >> 5))) * 4096 + (((d >> 5) * 2 + (kk >> 4)) * 64 + (d & 31)) * 8 + 4 * ((kk >> 3) & 1);
                            u32x2 wa, wb; wa.x = cvtpk(v0[0], v0[1]); wa.y = cvtpk(v0[2], v0[3]); wb.x = cvtpk(v1[0], v1[1]); wb.y = cvtpk(v1[2], v1[3]);
                            *(u32x2*)blk = wa; *(u32x2*)(blk + 32 * 8) = wb;
                        } else {
                            u32x4 w; w.x = cvtpk(v0[0], v0[1]); w.y = cvtpk(v0[2], v0[3]); w.z = cvtpk(v1[0], v1[1]); w.w = cvtpk(v1[2], v1[3]);
                            *(u32x4*)((bf16_t*)(pr + P_IT) + (size_t)(R - 1536) * MP + c) = w;
                        } } }
            return;
        }
        if (u.pn < 12 || u.pn == 18 || u.pn == 19) {
#pragma unroll
            for (int ai = 0; ai < 2; ++ai)
#pragma unroll
                for (int m = 0; m < 4; ++m) { const int row = u.pm * 256 + rowl + ai * 128 + m * 16;
#pragma unroll
                    for (int bj = 0; bj < 2; ++bj) { const f32x4 v0 = acc[ai][bj][m][0], v1 = acc[ai][bj][m][1];
                        u32x4 w; w.x = cvtpk(v0[0], v0[1]); w.y = cvtpk(v0[2], v0[3]); w.z = cvtpk(v1[0], v1[1]); w.w = cvtpk(v1[2], v1[3]);
                        bf16_t* dst;
                        if (u.pn < 12) { const int hh = u.pn * 2 + bj, qk = hh >= 12 ? 1 : 0, gh = hh - 12 * qk;
                            const int lb = row >> 13, pos = row & (S - 1);
                            dst = (bf16_t*)(pr + P_QK) + ((size_t)(((qk * BPP + lb) * 12 + gh) * 256 + (pos >> 5))) * 4096 + frag_row_off(d0, pos & 31); }
                        else { const int h = (u.pn - 18) * 2 + bj; dst = (bf16_t*)(pr + P_MQ) + ((size_t)((row >> 5) * 4 + h)) * 4096 + frag_row_off(d0, row & 31); }
                        *(u32x4*)dst = w; } }
            return;
        }
        bf16_t* base; int ldc, colt; bool gate = false;
        if (u.pn < 18) { base = (bf16_t*)(pr + P_HFQG); ldc = 1536; colt = (u.pn - 12) * 256; }
        else { base = (bf16_t*)(pr + P_GATE); ldc = 3072; colt = (u.pn - 20) * 256; gate = true; }
        const int row0 = u.pm * 256 + rowl, col0 = colt + d0;
        f32x4 bv[2][2];
#pragma unroll
        for (int bj = 0; bj < 2; ++bj)
#pragma unroll
            for (int n = 0; n < 2; ++n) bv[bj][n] = gate ? *(const f32x4*)(b_gate + col0 + bj * 128 + 4 * n) : (f32x4){0.f, 0.f, 0.f, 0.f};
#pragma unroll
        for (int ai = 0; ai < 2; ++ai)
#pragma unroll
            for (int m = 0; m < 4; ++m) { bf16_t* rowp = base + (size_t)(row0 + ai * 128 + m * 16) * ldc + col0;
#pragma unroll
                for (int bj = 0; bj < 2; ++bj) { f32x4 v0 = acc[ai][bj][m][0], v1 = acc[ai][bj][m][1];
                    if (gate) { v0 = v0 + bv[bj][0]; v1 = v1 + bv[bj][1];
#pragma unroll
                        for (int e = 0; e < 4; ++e) { v0[e] = fast_sigmoid(v0[e]); v1[e] = fast_sigmoid(v1[e]); } }
                    u32x4 w; w.x = cvtpk(v0[0], v0[1]); w.y = cvtpk(v0[2], v0[3]); w.z = cvtpk(v1[0], v1[1]); w.w = cvtpk(v1[2], v1[3]);
                    *(u32x4*)(rowp + bj * 128) = w; } }
    }
};

typedef float f32x16 __attribute__((ext_vector_type(16)));
typedef short s16x4 __attribute__((ext_vector_type(4)));
DI int crow(int r, int hi) { return (r & 3) + 8 * (r >> 2) + 4 * hi; }
DI float xor32f(float v) { return __shfl_xor(v, 32); }
#define MFMA32(a, b, c) __builtin_amdgcn_mfma_f32_32x32x16_bf16((a), (b), (c), 0, 0, 0)
DI bf16x8 pack8(const f32x16& p, int s) {
    u32x4 w; w.x = cvtpk(p[8 * s + 0], p[8 * s + 1]); w.y = cvtpk(p[8 * s + 2], p[8 * s + 3]); w.z = cvtpk(p[8 * s + 4], p[8 * s + 5]); w.w = cvtpk(p[8 * s + 6], p[8 * s + 7]);
    return __builtin_bit_cast(bf16x8, w);
}
DI bf16x8 ldvt(const bf16_t* vp) {
    const s16x4 lo = *(const s16x4*)vp, hi4 = *(const s16x4*)(vp + 8);
    return __builtin_shufflevector(lo, hi4, 0, 1, 2, 3, 4, 5, 6, 7);
}
constexpr int DIL_TASKS = BPP * 12 * (S / 32);
constexpr int MEM_TASKS = (MP / 32) * 4;
DI void attn_dil_wave(const bf16_t* __restrict__ QK, const bf16_t* __restrict__ VT, const LAS float* btab, bf16_t* __restrict__ OG, float* __restrict__ LSE, int task, int lane) {
    const int r32 = lane & 31, hi = lane >> 5;
    const int q32 = task & 255, gh = (task >> 8) % 12, lb = task / (256 * 12);
    const int g = gh >> 2, h = gh & 3, dl = dil_of(g), per = S / dl;
    const int tok0 = q32 * 32, r = tok0 / per, m0 = tok0 % per;
    const size_t rowq = (size_t)lb * S + (size_t)(m0 + r32) * dl + r;
    bf16x8 qf[8];
    const int tile0 = (r * per + m0) >> 5;
    { const bf16_t* qp = QK + ((size_t)((lb * 12 + gh) * 256 + tile0)) * 4096 + lane * 8;
#pragma unroll
      for (int ks = 0; ks < 8; ++ks) qf[ks] = *(const bf16x8*)(qp + ks * 512); }
    const LAS float* bt = btab + g * 129 * 4 + h;
    f32x16 o[4];
#pragma unroll
    for (int dt = 0; dt < 4; ++dt)
#pragma unroll
        for (int i = 0; i < 16; ++i) o[dt][i] = 0.f;
    float mrun = -INFINITY, sum = 0.f;
    const bf16_t* vbase = VT + ((size_t)((lb * 12 + gh) * 256 + tile0 - 4)) * 4096 + lane * 8;
    const bf16_t* kbase = QK + ((size_t)(((BPP + lb) * 12 + gh) * 256 + tile0 - 4)) * 4096 + lane * 8;
    const int kt0 = (m0 >= 128 ? 0 : (128 - m0) >> 5);
    bf16x8 kf[8], vf[8];
#pragma unroll
    for (int ks = 0; ks < 8; ++ks) kf[ks] = *(const bf16x8*)(kbase + (size_t)kt0 * 4096 + ks * 512);
#pragma unroll 1
    for (int kt = kt0; kt < 5; ++kt) {
#pragma unroll
        for (int i = 0; i < 8; ++i) vf[i] = *(const bf16x8*)(vbase + (size_t)kt * 4096 + i * 512);
        f32x16 sc;
#pragma unroll
        for (int i = 0; i < 16; ++i) sc[i] = 0.f;
#pragma unroll
        for (int ks = 0; ks < 8; ++ks) sc = MFMA32(kf[ks], qf[ks], sc);
        if (kt < 4) {
#pragma unroll
            for (int ks = 0; ks < 8; ++ks) kf[ks] = *(const bf16x8*)(kbase + (size_t)(kt + 1) * 4096 + ks * 512);
        }
        float mx = -INFINITY;
#pragma unroll
        for (int i = 0; i < 16; ++i) {
            const int delta = 128 - 32 * kt + r32 - crow(i, hi);
            const bool valid = (delta >= 0) && (delta <= 128);
            const int di = delta < 0 ? 0 : (delta > 128 ? 128 : delta);
            const float x = sc[i] * (QSCALE * LOG2E) + bt[di * 4];
            sc[i] = valid ? x : -INFINITY; mx = fmaxf(mx, sc[i]);
        }
        mx = fmaxf(mx, xor32f(mx));
        const float mnew = fmaxf(mrun, mx); const float f = __builtin_amdgcn_exp2f(mrun - mnew);
        sum *= f;
#pragma unroll
        for (int dt = 0; dt < 4; ++dt)
#pragma unroll
            for (int i = 0; i < 16; ++i) o[dt][i] *= f;
        mrun = mnew;
        float ps = 0.f;
#pragma unroll
        for (int i = 0; i < 16; ++i) { sc[i] = __builtin_amdgcn_exp2f(sc[i] - mnew); ps += sc[i]; }
        ps += xor32f(ps); sum += ps;
#pragma unroll
        for (int s = 0; s < 2; ++s) {
            const bf16x8 pb = pack8(sc, s);
#pragma unroll
            for (int dt = 0; dt < 4; ++dt) o[dt] = MFMA32(vf[dt * 2 + s], pb, o[dt]);
        }
    }
    const float inv = 1.f / sum;
    bf16_t* op = OG + rowq * 1536 + g * 512 + h * 128 + 4 * hi;
#pragma unroll
    for (int dt = 0; dt < 4; ++dt)
#pragma unroll
        for (int a = 0; a < 4; ++a) { u32x2 w; w.x = cvtpk(o[dt][4 * a] * inv, o[dt][4 * a + 1] * inv); w.y = cvtpk(o[dt][4 * a + 2] * inv, o[dt][4 * a + 3] * inv); *(u32x2*)(op + 32 * dt + 8 * a) = w; }
    if (hi == 0) LSE[rowq * 12 + gh] = (mrun + __builtin_amdgcn_logf(sum)) * 0.6931471805599453f;
}
DI void attn_mem_wave(const bf16_t* __restrict__ MQ, const bf16_t* __restrict__ MK, const bf16_t* __restrict__ MVT, bf16_t* __restrict__ BR, int task, int batch0, int lane) {
    const int r32 = lane & 31, hi = lane >> 5;
    const int h = task & 3, blk = task >> 2;
    const size_t rowq = (size_t)blk * 32 + r32; const int b = batch0 + blk * 32 / S;
    bf16x8 qf[8];
    { const bf16_t* qp = MQ + ((size_t)(blk * 4 + h)) * 4096 + lane * 8;
#pragma unroll
      for (int ks = 0; ks < 8; ++ks) qf[ks] = *(const bf16x8*)(qp + ks * 512); }
    f32x16 o[4];
#pragma unroll
    for (int dt = 0; dt < 4; ++dt)
#pragma unroll
        for (int i = 0; i < 16; ++i) o[dt][i] = 0.f;
    float mrun = -INFINITY, sum = 0.f;
    const bf16_t* vbase = MVT + ((size_t)((b * 4 + h) * 8)) * 4096 + lane * 8;
    const bf16_t* kbase = MK + ((size_t)((b * 4 + h) * 8)) * 4096 + lane * 8;
#pragma unroll 1
    for (int c = 0; c < 4; ++c) {
        f32x16 sc[2]; float mx = -INFINITY;
#pragma unroll
        for (int kt = 0; kt < 2; ++kt) {
            const bf16_t* kp = kbase + (size_t)(c * 2 + kt) * 4096;
            f32x16 acc;
#pragma unroll
            for (int i = 0; i < 16; ++i) acc[i] = 0.f;
#pragma unroll
            for (int ks = 0; ks < 8; ++ks) { const bf16x8 kf = *(const bf16x8*)(kp + ks * 512); acc = MFMA32(kf, qf[ks], acc); }
#pragma unroll
            for (int i = 0; i < 16; ++i) { sc[kt][i] = acc[i] * (QSCALE * LOG2E); mx = fmaxf(mx, sc[kt][i]); }
            asm volatile("" ::: "memory");
        }
        mx = fmaxf(mx, xor32f(mx));
        const float mnew = fmaxf(mrun, mx); const float f = __builtin_amdgcn_exp2f(mrun - mnew);
        sum *= f;
#pragma unroll
        for (int dt = 0; dt < 4; ++dt)
#pragma unroll
            for (int i = 0; i < 16; ++i) o[dt][i] *= f;
        mrun = mnew;
        float ps = 0.f;
#pragma unroll
        for (int kt = 0; kt < 2; ++kt)
#pragma unroll
            for (int i = 0; i < 16; ++i) { sc[kt][i] = __builtin_amdgcn_exp2f(sc[kt][i] - mnew); ps += sc[kt][i]; }
        ps += xor32f(ps); sum += ps;
#pragma unroll
        for (int kt = 0; kt < 2; ++kt)
#pragma unroll
            for (int s = 0; s < 2; ++s) {
                const bf16x8 pb = pack8(sc[kt], s);
#pragma unroll
                for (int dt = 0; dt < 4; ++dt) { const bf16x8 va = *(const bf16x8*)(vbase + (size_t)(c * 2 + kt) * 4096 + (dt * 2 + s) * 512); o[dt] = MFMA32(va, pb, o[dt]); }
                asm volatile("" ::: "memory");
            }
    }
    const float inv = 1.f / sum;
    bf16_t* op = BR + rowq * 1536 + 1024 + h * 128 + 4 * hi;
#pragma unroll
    for (int dt = 0; dt < 4; ++dt)
#pragma unroll
        for (int a = 0; a < 4; ++a) { u32x2 w; w.x = cvtpk(o[dt][4 * a] * inv, o[dt][4 * a + 1] * inv); w.y = cvtpk(o[dt][4 * a + 2] * inv, o[dt][4 * a + 3] * inv); *(u32x2*)(op + 32 * dt + 8 * a) = w; }
}

constexpr int HG_SCH = 4, HG_UPS = S / 64 / HG_SCH  , HG_UNITS = BPP * 4 * HG_UPS  ;
constexpr int HG_ROW = 136, HG_KT_ROW = 72;
constexpr int HG_KP = 0, HG_QP = 64 * HG_ROW * 2, HG_QPP = 2 * HG_QP, HG_KPPT = 3 * HG_QP, HG_DEC = HG_KPPT + 128 * HG_KT_ROW * 2, HG_SSQ = HG_DEC + 512, HG_PSUM = HG_SSQ + 1024, HG_UNIT_BYTES = HG_PSUM + 2048;
DI bf16x8 lds_ld2x8(const LAS unsigned char* p) {
    const s16x4 lo = *(const LAS s16x4*)p, hi4 = *(const LAS s16x4*)(p + 16);
    return __builtin_shufflevector(lo, hi4, 0, 1, 2, 3, 4, 5, 6, 7);
}
DI int opq(int x) { asm volatile("" : "+v"(x)); return x; }
DI float lds_bf(const LAS unsigned char* p) { return __uint_as_float((unsigned)(*(const LAS unsigned short*)p) << 16); }
template <bool MAIN>
DI void hgrn_unit(LAS unsigned char* ul, int unit, int u, const bf16_t* __restrict__ HFQG, const bf16_t* __restrict__ IT, const float* __restrict__ lbv, const float* __restrict__ nwv,
                  float* HSTL, float* HSTD, const float* __restrict__ SIN, bf16_t* __restrict__ BR) {
    constexpr int NX = MAIN ? 4 : 2;
    const int lane = u & 63, w = u >> 6, r32 = lane & 31, hi = lane >> 5, dvt = w & 3, wh = w >> 2;
    const int seq = unit / HG_UPS, j = unit % HG_UPS, lb = seq >> 2, h = seq & 3;
    const int dk = u & 127, qt = u >> 7, cb = 16 * qt;
    const float lbd = lbv[h * 128 + dk];
    const size_t row0 = (size_t)lb * S + (size_t)j * (64 * HG_SCH);
    LAS unsigned char* Kp = ul + HG_KP; LAS unsigned char* Qp = ul + HG_QP; LAS unsigned char* Qpp = ul + HG_QPP; LAS unsigned char* KppT = ul + HG_KPPT;
    LAS float* dec = (LAS float*)(ul + HG_DEC); LAS float* ssq = (LAS float*)(ul + HG_SSQ); LAS float* psum = (LAS float*)(ul + HG_PSUM);
    const int dk0 = MAIN ? 0 : 64 * wh;
    f32x16 X[NX];
    if (MAIN) {
        const float* Sp = SIN + (size_t)unit * 16384 + 32 * dvt + r32;
#pragma unroll
        for (int t = 0; t < NX; ++t)
#pragma unroll
            for (int i = 0; i < 16; ++i) X[t][i] = Sp[(size_t)(32 * t + crow(i, hi)) * 128];
    } else {
#pragma unroll
        for (int t = 0; t < NX; ++t)
#pragma unroll
            for (int i = 0; i < 16; ++i) X[t][i] = 0.f;
    }
    float atot = 0.f;
    u32x4 sf[2], sq[2];
    {
        const int sc0 = u >> 4, sch = (u & 15) * 8;
        const bf16_t* fp = HFQG + (row0 + sc0) * 1536 + h * 128 + sch;
#pragma unroll
        for (int i = 0; i < 2; ++i) { sf[i] = *(const u32x4*)(fp + (size_t)(32 * i) * 1536); if (MAIN) sq[i] = *(const u32x4*)(fp + (size_t)(32 * i) * 1536 + 512); }
    }
#pragma unroll 1
    for (int ch = 0; ch < HG_SCH; ++ch) {
        const size_t rc = row0 + (size_t)ch * 64;
        {
            const int sc0 = opq(u) >> 4, sch = (opq(u) & 15) * 8;
#pragma unroll
            for (int i = 0; i < 2; ++i) { *(LAS u32x4*)(Kp + ((sc0 + 32 * i) * HG_ROW + sch) * 2) = sf[i]; if (MAIN) *(LAS u32x4*)(Qp + ((sc0 + 32 * i) * HG_ROW + sch) * 2) = sq[i]; }
        }
        __syncthreads();
        float fv[16], lf[16];
        {
            float s = 0.f;
#pragma unroll
            for (int i = 0; i < 16; ++i) { fv[i] = lbd + (1.f - lbd) * fast_sigmoid(lds_bf(Kp + ((cb + i) * HG_ROW + dk) * 2)); lf[i] = __builtin_amdgcn_logf(fv[i]); s += lf[i]; }
            psum[qt * 128 + dk] = s;
        }
        __syncthreads();
        {
            const float p0 = psum[dk], p1 = psum[128 + dk], p2 = psum[256 + dk], p3 = psum[384 + dk];
            const float amid = p0 + p1, alast = (p0 + p1) + (p2 + p3);
            float run = qt == 0 ? 0.f : (qt == 1 ? p0 : (qt == 2 ? amid : amid + p2));
            atot += alast;
            const float Ela = __builtin_amdgcn_exp2f(alast - amid), Ea = __builtin_amdgcn_exp2f(amid);
#pragma unroll
            for (int c8 = 0; c8 < 2; ++c8) {
                float kt[8];
#pragma unroll
                for (int e = 0; e < 8; ++e) { const int i = 8 * c8 + e, c = cb + i; run += lf[i]; const float key = 1.f - fv[i];
                    const float e1 = __builtin_amdgcn_exp2f(amid - run);
                    const float kp = key * e1;
                    kt[e] = kp * Ela;
                    if (MAIN) { *(LAS bf16_t*)(Kp + (c * HG_ROW + dk) * 2) = f2bf(kp);
                        const float qp = lds_bf(Qp + (c * HG_ROW + dk) * 2) * __builtin_amdgcn_rcpf(e1);
                        *(LAS bf16_t*)(Qp + (c * HG_ROW + dk) * 2) = f2bf(qp);
                        *(LAS bf16_t*)(Qpp + (c * HG_ROW + dk) * 2) = f2bf(qp * Ea); } }
                u32x4 wv; wv.x = cvtpk(kt[0], kt[1]); wv.y = cvtpk(kt[2], kt[3]); wv.z = cvtpk(kt[4], kt[5]); wv.w = cvtpk(kt[6], kt[7]);
                *(LAS u32x4*)(KppT + (dk * HG_KT_ROW + cb + 8 * c8) * 2) = wv;
            }
            if (qt == 0) dec[dk] = __builtin_amdgcn_exp2f(alast);
        }
        if (ch + 1 < HG_SCH) {
            const int sc0 = opq(u) >> 4, sch = (opq(u) & 15) * 8;
            const bf16_t* fp = HFQG + (rc + 64 + sc0) * 1536 + h * 128 + sch;
#pragma unroll
            for (int i = 0; i < 2; ++i) { sf[i] = *(const u32x4*)(fp + (size_t)(32 * i) * 1536); if (MAIN) sq[i] = *(const u32x4*)(fp + (size_t)(32 * i) * 1536 + 512); }
        }
        __syncthreads();
        f32x16 o;
        const bf16_t* itrow = IT + (size_t)(h * 128 + 32 * dvt + opq(r32)) * MP;
        if (MAIN) {
#pragma unroll
            for (int i = 0; i < 16; ++i) o[i] = 0.f;
            const LAS unsigned char* qrow = Qpp + ((32 * wh + r32) * HG_ROW) * 2;
#pragma unroll
            for (int t = 0; t < 4; ++t)
#pragma unroll
                for (int step = 0; step < 2; ++step) { o = MFMA32(pack8(X[t], step), lds_ld2x8(qrow + (32 * t + 16 * step + 4 * hi) * 2), o); }
            __builtin_amdgcn_sched_barrier(0);
            const int r32m = opq(r32);
            const LAS unsigned char* qprow = Qp + ((32 * wh + r32) * HG_ROW) * 2;
            {
                f32x16 sc;
#pragma unroll
                for (int i = 0; i < 16; ++i) sc[i] = 0.f;
#pragma unroll
                for (int ks = 0; ks < 8; ++ks) { const int cof = (16 * ks + 8 * hi) * 2; sc = MFMA32(*(const LAS bf16x8*)(Kp + (r32 * HG_ROW) * 2 + cof), *(const LAS bf16x8*)(qprow + cof), sc); }
                if (wh == 0) {
#pragma unroll
                    for (int i = 0; i < 16; ++i) sc[i] = (crow(i, hi) <= r32m) ? sc[i] : 0.f;
                }
#pragma unroll
                for (int step = 0; step < 2; ++step) o = MFMA32(ldvt(itrow + rc + 16 * step + 4 * hi), pack8(sc, step), o);
                __builtin_amdgcn_sched_barrier(0);
            }
            if (wh == 1) {
                f32x16 sc;
#pragma unroll
                for (int i = 0; i < 16; ++i) sc[i] = 0.f;
#pragma unroll
                for (int ks = 0; ks < 8; ++ks) { const int cof = (16 * ks + 8 * hi) * 2; sc = MFMA32(*(const LAS bf16x8*)(Kp + ((32 + r32) * HG_ROW) * 2 + cof), *(const LAS bf16x8*)(qprow + cof), sc); }
#pragma unroll
                for (int i = 0; i < 16; ++i) sc[i] = (crow(i, hi) <= r32m) ? sc[i] : 0.f;
#pragma unroll
                for (int step = 0; step < 2; ++step) o = MFMA32(ldvt(itrow + rc + 32 + 16 * step + 4 * hi), pack8(sc, step), o);
                __builtin_amdgcn_sched_barrier(0);
            }
        }
        {
            bf16x8 ib[4];
#pragma unroll
            for (int ks = 0; ks < 4; ++ks) ib[ks] = *(const bf16x8*)(itrow + rc + 16 * ks + 8 * hi);
#pragma unroll
            for (int t = 0; t < NX; ++t) {
#pragma unroll
                for (int i = 0; i < 16; ++i) X[t][i] *= dec[dk0 + 32 * t + crow(i, hi)];
#pragma unroll
                for (int ks = 0; ks < 4; ++ks) { const bf16x8 ka = *(const LAS bf16x8*)(KppT + ((dk0 + 32 * t + r32) * HG_KT_ROW + 16 * ks + 8 * hi) * 2); X[t] = MFMA32(ka, ib[ks], X[t]); }
                __builtin_amdgcn_sched_barrier(0);
            }
        }
        if (MAIN) {
            float q2 = 0.f;
#pragma unroll
            for (int i = 0; i < 16; ++i) q2 += o[i] * o[i];
            q2 += xor32f(q2); if (hi == 0) ssq[dvt * 64 + 32 * wh + r32] = q2;
        }
        __syncthreads();
        if (MAIN) {
            const int r32o = opq(r32), hio = opq(hi);
            const int c = 32 * wh + r32o; const float tot = ssq[c] + ssq[64 + c] + ssq[128 + c] + ssq[192 + c];
            const float rs = rsqrtf(tot * (1.f / 128.f) + LN_EPS);
            const size_t row = rc + c; const int col = h * 128 + 32 * dvt + 4 * hio;
#pragma unroll
            for (int a4 = 0; a4 < 4; ++a4) {
                const u32x2 gw = *(const u32x2*)(HFQG + row * 1536 + 1024 + col + 8 * a4); const f32x4 nw4 = *(const f32x4*)(nwv + col + 8 * a4);
                const float g0 = __uint_as_float(gw.x << 16), g1 = __uint_as_float(gw.x & 0xffff0000u), g2 = __uint_as_float(gw.y << 16), g3 = __uint_as_float(gw.y & 0xffff0000u);
                const float v0 = o[4 * a4] * rs * nw4[0] * g0 * fast_sigmoid(g0), v1 = o[4 * a4 + 1] * rs * nw4[1] * g1 * fast_sigmoid(g1);
                const float v2 = o[4 * a4 + 2] * rs * nw4[2] * g2 * fast_sigmoid(g2), v3 = o[4 * a4 + 3] * rs * nw4[3] * g3 * fast_sigmoid(g3);
                u32x2 wv; wv.x = cvtpk(v0, v1); wv.y = cvtpk(v2, v3);
                *(u32x2*)(BR + row * 1536 + 512 + col + 8 * a4) = wv;
            }
        }
    }
    if (!MAIN) {
        float* L = HSTL + (size_t)unit * 16384 + 32 * dvt + r32;
#pragma unroll
        for (int t = 0; t < NX; ++t)
#pragma unroll
            for (int i = 0; i < 16; ++i) L[(size_t)(dk0 + 32 * t + crow(i, hi)) * 128] = X[t][i];
        if (qt == 0) HSTD[(size_t)unit * 128 + dk] = __builtin_amdgcn_exp2f(atot);
    }
}
DI void hgrn_scan(const float* __restrict__ HSTL, const float* __restrict__ HSTD, float* __restrict__ SIN, int gt) {
    if (gt >= BPP * 4 * 16384) return;
    const int seq = gt >> 14, el = gt & 16383, dkk = el >> 7;
    float st = 0.f;
    for (int j = 0; j < HG_UPS; ++j) { const size_t uo = (size_t)(seq * HG_UPS + j); SIN[uo * 16384 + el] = st; st = HSTD[uo * 128 + dkk] * st + HSTL[uo * 16384 + el]; }
}

struct SchedRows {
    unsigned A, B; int K, nN, nU, G, c;
    DI bool next(int i, g8::Unit& u) const {
        const int L = i * G + c; if (L >= nU) return false;
        const int x = L & 7, off = L >> 3, grp = off / (8 * nN), o2 = off % (8 * nN);
        const int ppx = nU / nN / 8;
        u.pm = x * ppx + 8 * grp + (o2 & 7); u.pn = o2 >> 3; u.kind = 0; u.dla = 1; u.dlb = 1;
        u.a = A + (unsigned)u.pm * 256u * K * 2u; u.b = B + (unsigned)u.pn * 256u * K * 2u; return true;
    }
};
DI void unpack8(const u32x4 w, float (&f)[8]) {
    f[0] = __uint_as_float(w.x << 16); f[1] = __uint_as_float(w.x & 0xffff0000u); f[2] = __uint_as_float(w.y << 16); f[3] = __uint_as_float(w.y & 0xffff0000u);
    f[4] = __uint_as_float(w.z << 16); f[5] = __uint_as_float(w.z & 0xffff0000u); f[6] = __uint_as_float(w.w << 16); f[7] = __uint_as_float(w.w & 0xffff0000u);
}
struct EpiWidenF {
    static constexpr bool PERM = true, HOOK = true;
    const bf16_t* GATE; bf16_t* MERGED;
    DI void hook(f32x4 (&acc)[2][2][4][2], const g8::Unit& u, int t, int wr, int wc, int fr, int fq) const {
        if (t != 8 && t != 16) return;
        const int g = (t >> 3) - 1;
        const int row0 = u.pm * 256 + wr * 64 + fr, col0 = u.pn * 256 + wc * 32 + 8 * fq;
#pragma unroll
        for (int ai = 0; ai < 2; ++ai)
#pragma unroll
            for (int m = 0; m < 4; ++m) { const bf16_t* gp = GATE + (size_t)(row0 + ai * 128 + m * 16) * 3072 + g * 1024 + col0;
#pragma unroll
                for (int bj = 0; bj < 2; ++bj) { float ga[8], gb[8]; unpack8(*(const u32x4*)(gp + bj * 128), ga); unpack8(*(const u32x4*)(gp + 1024 + bj * 128), gb);
#pragma unroll
                    for (int e = 0; e < 4; ++e) { acc[ai][bj][m][0][e] *= ga[e] * __builtin_amdgcn_rcpf(gb[e]); acc[ai][bj][m][1][e] *= ga[4 + e] * __builtin_amdgcn_rcpf(gb[4 + e]); } } }
    }
    DI void operator()(const f32x4 (&acc)[2][2][4][2], const g8::Unit& u, int wr, int wc, int fr, int fq) const {
        const int row0 = u.pm * 256 + wr * 64 + fr, col0 = u.pn * 256 + wc * 32 + 8 * fq;
#pragma unroll
        for (int ai = 0; ai < 2; ++ai)
#pragma unroll
            for (int m = 0; m < 4; ++m) { const size_t row = (size_t)(row0 + ai * 128 + m * 16);
#pragma unroll
                for (int bj = 0; bj < 2; ++bj) { float gc[8]; unpack8(*(const u32x4*)(GATE + row * 3072 + 2048 + col0 + bj * 128), gc);
                    const f32x4 v0 = acc[ai][bj][m][0], v1 = acc[ai][bj][m][1];
                    u32x4 w; w.x = cvtpk(v0[0] * gc[0], v0[1] * gc[1]); w.y = cvtpk(v0[2] * gc[2], v0[3] * gc[3]); w.z = cvtpk(v1[0] * gc[4], v1[1] * gc[5]); w.w = cvtpk(v1[2] * gc[6], v1[3] * gc[7]);
                    *(u32x4*)(MERGED + row * 1024 + col0 + bj * 128) = w; } }
    }
};
struct EpiPlainB16 {
    static constexpr bool PERM = true, HOOK = false;
    bf16_t* C; int ldc, pad;
    DI void hook(f32x4 (&)[2][2][4][2], const g8::Unit&, int, int, int, int, int) const {}
    DI void operator()(const f32x4 (&acc)[2][2][4][2], const g8::Unit& u, int wr, int wc, int fr, int fq) const {
        const int row0 = u.pm * 256 + wr * 64 + fr, col0 = u.pn * 256 + wc * 32 + 8 * fq;
#pragma unroll
        for (int ai = 0; ai < 2; ++ai)
#pragma unroll
            for (int m = 0; m < 4; ++m) { bf16_t* rowp = C + (size_t)(row0 + ai * 128 + m * 16) * ldc + col0;
#pragma unroll
                for (int bj = 0; bj < 2; ++bj) { const f32x4 v0 = acc[ai][bj][m][0], v1 = acc[ai][bj][m][1];
                    u32x4 w; w.x = cvtpk(v0[0], v0[1]); w.y = cvtpk(v0[2], v0[3]); w.z = cvtpk(v1[0], v1[1]); w.w = cvtpk(v1[2], v1[3]);
                    *(u32x4*)(rowp + bj * 128) = w; } }
    }
};
DI void lse_merge_items(const bf16_t* __restrict__ OG, const float* __restrict__ LSE, bf16_t* __restrict__ BR, int first, int stride) {
    for (int it = first; it < MP * 64; it += stride) {
        const int row = it >> 6, c8 = it & 63, h = c8 >> 4;
        const float l0 = LSE[(size_t)row * 12 + h], l1 = LSE[(size_t)row * 12 + 4 + h], l2 = LSE[(size_t)row * 12 + 8 + h];
        const float mx = fmaxf(l0, fmaxf(l1, l2)); const float e0 = __expf(l0 - mx), e1 = __expf(l1 - mx), e2 = __expf(l2 - mx); const float inv = 1.f / (e0 + e1 + e2);
        const bf16_t* og = OG + (size_t)row * 1536 + c8 * 8;
        float a[8], b[8], c[8]; unpack8(*(const u32x4*)og, a); unpack8(*(const u32x4*)(og + 512), b); unpack8(*(const u32x4*)(og + 1024), c);
        float r[8];
#pragma unroll
        for (int e = 0; e < 8; ++e) r[e] = (e0 * a[e] + e1 * b[e] + e2 * c[e]) * inv;
        u32x4 w; w.x = cvtpk(r[0], r[1]); w.y = cvtpk(r[2], r[3]); w.z = cvtpk(r[4], r[5]); w.w = cvtpk(r[6], r[7]);
        *(u32x4*)(BR + (size_t)row * 1536 + c8 * 8) = w;
    }
}
DI void ln1_rows(const float* __restrict__ x, const bf16_t* __restrict__ mix, const float* __restrict__ g, const float* __restrict__ b, bf16_t* __restrict__ h1b, unsigned char* __restrict__ h1q, float* __restrict__ hsc, int wave0, int nwaves, int lane) {
    for (int row = wave0; row < MP; row += nwaves) {
        const f32x4* xr = (const f32x4*)(x + (size_t)row * D + 16 * lane);
        const u32x4 ma = *(const u32x4*)(mix + (size_t)row * D + 16 * lane), mb = *(const u32x4*)(mix + (size_t)row * D + 16 * lane + 8);
        float mf[16]; unpack8(ma, *(float(*)[8])&mf[0]); unpack8(mb, *(float(*)[8])&mf[8]);
        f32x4 v[4]; float s = 0.f;
#pragma unroll
        for (int j = 0; j < 4; ++j) { v[j] = xr[j] * ALPHA;
#pragma unroll
            for (int e = 0; e < 4; ++e) { v[j][e] += mf[4 * j + e]; s += v[j][e]; } }
        const float mean = wave_sum(s) * (1.f / D); float q = 0.f;
#pragma unroll
        for (int j = 0; j < 4; ++j) { v[j] = v[j] - mean; q += (v[j][0] * v[j][0] + v[j][1] * v[j][1]) + (v[j][2] * v[j][2] + v[j][3] * v[j][3]); }
        const float rstd = rsqrtf(wave_sum(q) * (1.f / D) + LN_EPS);
        u32x4 o0, o1; float amax = 0.f;
#pragma unroll
        for (int j = 0; j < 4; ++j) { const f32x4 gg = *(const f32x4*)(g + 16 * lane + 4 * j), bb = *(const f32x4*)(b + 16 * lane + 4 * j); const f32x4 o = v[j] * rstd * gg + bb; v[j] = o;
            amax = fmaxf(amax, fmaxf(fmaxf(fabsf(o[0]), fabsf(o[1])), fmaxf(fabsf(o[2]), fabsf(o[3]))));
            if (j < 2) { o0[2 * j] = cvtpk(o[0], o[1]); o0[2 * j + 1] = cvtpk(o[2], o[3]); } else { o1[2 * (j - 2)] = cvtpk(o[0], o[1]); o1[2 * (j - 2) + 1] = cvtpk(o[2], o[3]); } }
        *(u32x4*)(h1b + (size_t)row * D + 16 * lane) = o0; *(u32x4*)(h1b + (size_t)row * D + 16 * lane + 8) = o1;
        amax = wave_max(amax); const float qs = amax > 0.f ? 127.f / amax : 1.f;
        u32x4 qv;
#pragma unroll
        for (int j = 0; j < 4; ++j) qv[j] = ((unsigned)__float2int_rn(v[j][0] * qs) & 0xffu) | (((unsigned)__float2int_rn(v[j][1] * qs) & 0xffu) << 8) | (((unsigned)__float2int_rn(v[j][2] * qs) & 0xffu) << 16) | (((unsigned)__float2int_rn(v[j][3] * qs) & 0xffu) << 24);
        *(u32x4*)(h1q + (size_t)row * D + 16 * lane) = qv;
        if (lane == 0) hsc[row] = amax > 0.f ? amax * (1.f / 127.f) : 1.f;
    }
}

DI unsigned mono(float f) { const unsigned u = __float_as_uint(f); return (u & 0x80000000u) ? ~u : (u | 0x80000000u); }
DI float demono(unsigned m) { return __uint_as_float((m & 0x80000000u) ? (m & 0x7fffffffu) : ~m); }
#define CE_DESC(a, b) do { const unsigned _hi = (a) > (b) ? (a) : (b), _lo = (a) > (b) ? (b) : (a); (a) = _hi; (b) = _lo; } while (0)
DI void sort16_desc(unsigned (&k)[16]) {
#pragma unroll
    for (int size = 2; size <= 16; size <<= 1)
#pragma unroll
        for (int stride = size >> 1; stride > 0; stride >>= 1)
#pragma unroll
            for (int i = 0; i < 16; ++i) { const int j = i ^ stride;
                if (j > i) { if ((i & size) == 0 || size == 16) CE_DESC(k[i], k[j]); else CE_DESC(k[j], k[i]); } }
}
DI void merge_top16(unsigned (&t)[16], const unsigned (&l)[16]) {
#pragma unroll
    for (int i = 0; i < 16; ++i) t[i] = t[i] > l[15 - i] ? t[i] : l[15 - i];
#pragma unroll
    for (int stride = 8; stride > 0; stride >>= 1)
#pragma unroll
        for (int i = 0; i < 16; ++i) { const int j = i ^ stride; if (j > i) CE_DESC(t[i], t[j]); }
}
constexpr int RT_ROW = 136;
constexpr int RT_LDS_BYTES = 2 * 128 * RT_ROW * 2;
DI void route_wave(const bf16_t* __restrict__ PQ, const LAS unsigned char* keys, int* __restrict__ IDX, float* __restrict__ PG, int tb, int h, int lane) {
    const int r32 = lane & 31, hi = lane >> 5;
    const size_t tok = (size_t)tb * 32 + r32;
    unsigned Tp[2][16];
#pragma unroll
    for (int p = 0; p < 2; ++p) {
        bf16x8 qf[8];
        const bf16_t* qp = PQ + tok * 2048 + h * 256 + p * 128 + 8 * hi;
#pragma unroll
        for (int ks = 0; ks < 8; ++ks) qf[ks] = *(const bf16x8*)(qp + 16 * ks);
#pragma unroll
        for (int nt = 0; nt < 4; ++nt) {
            f32x16 acc;
#pragma unroll
            for (int i = 0; i < 16; ++i) acc[i] = 0.f;
#pragma unroll
            for (int ks = 0; ks < 8; ++ks) { const bf16x8 kf = *(const LAS bf16x8*)(keys + ((p * 128 + 32 * nt + r32) * RT_ROW + 16 * ks + 8 * hi) * 2); acc = MFMA32(kf, qf[ks], acc); }
            unsigned L[16];
#pragma unroll
            for (int i = 0; i < 16; ++i) L[i] = (mono(acc[i]) & ~0x7fu) | (unsigned)(127 - (32 * nt + crow(i, hi)));
            sort16_desc(L);
            if (nt == 0) {
#pragma unroll
                for (int i = 0; i < 16; ++i) Tp[p][i] = L[i];
            } else merge_top16(Tp[p], L);
            __builtin_amdgcn_sched_barrier(0);
        }
    }
    unsigned T[16];
    { unsigned O[16];
#pragma unroll
      for (int i = 0; i < 16; ++i) { const auto rr = __builtin_amdgcn_permlane32_swap(Tp[0][i], Tp[1][i], false, false); T[i] = rr[0]; O[i] = rr[1]; }
      merge_top16(T, O); }
    __builtin_amdgcn_sched_barrier(0);
    float s1[16], s2[16]; unsigned i1[16], i2[16];
#pragma unroll
    for (int i = 0; i < 16; ++i) { const auto rr = __builtin_amdgcn_permlane32_swap(T[i], T[i], false, false);
        s1[i] = demono(rr[0] & ~0x7fu); i1[i] = 127u - (rr[0] & 0x7fu); s2[i] = demono(rr[1] & ~0x7fu); i2[i] = 127u - (rr[1] & 0x7fu); }
    unsigned C[64];
    { int n = 0;
#pragma unroll
      for (int a = 0; a < 16; ++a)
#pragma unroll
          for (int b = 0; b < 16; ++b) if ((a + 1) * (b + 1) <= 16) { C[n] = (mono(s1[a] + s2[b]) & ~0x3fffu) | (i1[a] << 7) | i2[b]; ++n; }
#pragma unroll
      for (int i = 50; i < 64; ++i) C[i] = 0u; }
    unsigned F[16];
#pragma unroll
    for (int i = 0; i < 16; ++i) F[i] = C[i];
    sort16_desc(F);
#pragma unroll
    for (int g = 1; g < 4; ++g) { unsigned L[16];
#pragma unroll
        for (int i = 0; i < 16; ++i) L[i] = C[16 * g + i];
        sort16_desc(L); merge_top16(F, L); __builtin_amdgcn_sched_barrier(0); }
    if (hi == 0) {
        float e[16]; float sum = 0.f; const float v0 = demono(F[0] & ~0x3fffu);
#pragma unroll
        for (int i = 0; i < 16; ++i) { e[i] = __expf(demono(F[i] & ~0x3fffu) - v0); sum += e[i]; }
        const float inv = 1.f / sum;
        int* ip = IDX + tok * 128 + h * 16; float* gp = PG + tok * 128 + h * 16;
#pragma unroll
        for (int q = 0; q < 4; ++q) { u32x4 iv; iv.x = F[4 * q] & 0x3fffu; iv.y = F[4 * q + 1] & 0x3fffu; iv.z = F[4 * q + 2] & 0x3fffu; iv.w = F[4 * q + 3] & 0x3fffu; *(u32x4*)(ip + 4 * q) = iv;
            f32x4 gv; gv[0] = e[4 * q] * inv; gv[1] = e[4 * q + 1] * inv; gv[2] = e[4 * q + 2] * inv; gv[3] = e[4 * q + 3] * inv; *(f32x4*)(gp + 4 * q) = gv; }
    }
}
typedef __bf16 bf16x2v __attribute__((ext_vector_type(2)));
DI float dot2bf(unsigned w, unsigned x, float acc) { return __builtin_amdgcn_fdot2_f32_bf16(__builtin_bit_cast(bf16x2v, w), __builtin_bit_cast(bf16x2v, x), acc, false); }
DI float gelu_erf(float v) {
    const float av = fabsf(v), t = __builtin_amdgcn_rcpf(av * 0.2316418882f + 1.0f);
    float q = t * 0.5307027145f + (-0.7265760135f); q = q * t + 0.7107068705f; q = q * t + (-0.142248368f); q = q * t + 0.127414796f; q = q * t;
    const float e = __builtin_amdgcn_exp2f((v * v) * (-0.72134752044f)); const float m = v * (q * e);
    return v < 0.f ? m : v - m;
}
DI float dppf(float v, const int ctrl_sel) {
    const int s = __float_as_int(v);
    int r;
    if (ctrl_sel == 0) r = __builtin_amdgcn_update_dpp(0, s, 0xB1, 0xF, 0xF, true);
    else if (ctrl_sel == 1) r = __builtin_amdgcn_update_dpp(0, s, 0x4E, 0xF, 0xF, true);
    else if (ctrl_sel == 2) r = __builtin_amdgcn_update_dpp(0, s, 0x141, 0xF, 0xF, true);
    else r = __builtin_amdgcn_update_dpp(0, s, 0x128, 0xF, 0xF, true);
    return __int_as_float(r);
}
DI int dppi(int s, const int ctrl_sel) {
    if (ctrl_sel == 0) return __builtin_amdgcn_update_dpp(0, s, 0xB1, 0xF, 0xF, true);
    if (ctrl_sel == 1) return __builtin_amdgcn_update_dpp(0, s, 0x4E, 0xF, 0xF, true);
    return __builtin_amdgcn_update_dpp(0, s, 0x141, 0xF, 0xF, true);
}
template <int NT>
DI void experts_u_slice(const unsigned char* __restrict__ H1Q, const unsigned char* __restrict__ U8x, const int* __restrict__ IDX, bf16_t* __restrict__ PD, size_t tok, int x, int lane) {
    const int g = lane >> 3, l8 = lane & 7;
    u32x4 hq[NT], iv[NT][4], w[NT][16];
#pragma unroll
    for (int t = 0; t < NT; ++t) { hq[t] = *(const u32x4*)(H1Q + (tok + t) * D + 128 * x + 16 * l8);
#pragma unroll
        for (int q = 0; q < 4; ++q) iv[t][q] = *(const u32x4*)(IDX + (tok + t) * 128 + 16 * g + 4 * q); }
#pragma unroll
    for (int t = 0; t < NT; ++t)
#pragma unroll
        for (int j = 0; j < 16; ++j) w[t][j] = *(const u32x4*)(U8x + (size_t)(iv[t][j >> 2][j & 3] * 128u + 16u * l8));
#pragma unroll
    for (int t = 0; t < NT; ++t) {
        float p[16];
#pragma unroll
        for (int j = 0; j < 16; ++j) { int d = 0;
#pragma unroll
            for (int q = 0; q < 4; ++q) d = __builtin_amdgcn_sdot4((int)w[t][j][q], (int)hq[t][q], d, false);
            d += dppi(d, 0); d += dppi(d, 1); d += dppi(d, 2); p[j] = (float)d; }
        if (l8 == 0) {
            u32x4 o0, o1;
            o0.x = cvtpk(p[0], p[1]); o0.y = cvtpk(p[2], p[3]); o0.z = cvtpk(p[4], p[5]); o0.w = cvtpk(p[6], p[7]);
            o1.x = cvtpk(p[8], p[9]); o1.y = cvtpk(p[10], p[11]); o1.z = cvtpk(p[12], p[13]); o1.w = cvtpk(p[14], p[15]);
            bf16_t* dp = PD + ((tok + t) * 8 + x) * 128 + 16 * g; *(u32x4*)dp = o0; *(u32x4*)(dp + 8) = o1;
        }
    }
}
DI void experts_combine(const bf16_t* __restrict__ PD, const int* __restrict__ IDX, const float* __restrict__ PG, const float* __restrict__ USC, const float* __restrict__ VSC, const float* __restrict__ HSC,
                        unsigned char* __restrict__ C8, float* __restrict__ CSC, int wave0, int nwaves, int lane) {
    for (int tok = wave0; tok < M; tok += nwaves) {
        float s0 = 0.f, s1 = 0.f;
#pragma unroll
        for (int x = 0; x < 8; ++x) { const unsigned w = *(const unsigned*)(PD + ((size_t)tok * 8 + x) * 128 + 2 * lane); s0 += __uint_as_float(w << 16); s1 += __uint_as_float(w & 0xffff0000u); }
        const u32x2 rows = *(const u32x2*)(IDX + (size_t)tok * 128 + 2 * lane); const f32x2 gt = *(const f32x2*)(PG + (size_t)tok * 128 + 2 * lane);
        const float hs = HSC[tok];
        const float c0 = gt[0] * gelu_erf(s0 * USC[rows.x] * hs) * VSC[rows.x], c1 = gt[1] * gelu_erf(s1 * USC[rows.y] * hs) * VSC[rows.y];
        const float amax = wave_max(fmaxf(fabsf(c0), fabsf(c1)));
        const float qs = amax > 0.f ? 127.f / amax : 1.f;
        const unsigned short q2 = (unsigned short)(((unsigned)__float2int_rn(c0 * qs) & 0xffu) | (((unsigned)__float2int_rn(c1 * qs) & 0xffu) << 8));
        *(unsigned short*)(C8 + (size_t)tok * 128 + 2 * lane) = q2;
        if (lane == 0) CSC[tok] = amax > 0.f ? amax * (1.f / 127.f) : 1.f;
    }
}
template <int NT>
DI void experts_v_slice(const unsigned char* __restrict__ V8x, const int* __restrict__ IDX, const unsigned char* __restrict__ C8, const float* __restrict__ CSC, bf16_t* __restrict__ FFN, size_t tok, int x, int lane) {
    const int g = lane >> 3, l8 = lane & 7;
    u32x4 iv[NT][4], w[NT][16], cq[NT];
#pragma unroll
    for (int t = 0; t < NT; ++t) { cq[t] = *(const u32x4*)(C8 + (tok + t) * 128 + 16 * g);
#pragma unroll
        for (int q = 0; q < 4; ++q) iv[t][q] = *(const u32x4*)(IDX + (tok + t) * 128 + 16 * g + 4 * q); }
#pragma unroll
    for (int t = 0; t < NT; ++t)
#pragma unroll
        for (int j = 0; j < 16; ++j) w[t][j] = *(const u32x4*)(V8x + (size_t)(iv[t][j >> 2][j & 3] * 128u + 16u * l8));
#pragma unroll
    for (int t = 0; t < NT; ++t) {
        int acc[16];
#pragma unroll
        for (int i = 0; i < 16; ++i) acc[i] = 0;
#pragma unroll
        for (int jj = 0; jj < 4; ++jj) {
            const int cdw = (int)cq[t][jj];
#pragma unroll
            for (int q = 0; q < 4; ++q) {
                const unsigned r0 = w[t][4 * jj][q], r1 = w[t][4 * jj + 1][q], r2 = w[t][4 * jj + 2][q], r3 = w[t][4 * jj + 3][q];
                const unsigned lo01 = __builtin_amdgcn_perm(r1, r0, 0x05010400u), hi01 = __builtin_amdgcn_perm(r1, r0, 0x07030602u);
                const unsigned lo23 = __builtin_amdgcn_perm(r3, r2, 0x05010400u), hi23 = __builtin_amdgcn_perm(r3, r2, 0x07030602u);
                acc[4 * q + 0] = __builtin_amdgcn_sdot4((int)__builtin_amdgcn_perm(lo23, lo01, 0x05040100u), cdw, acc[4 * q + 0], false);
                acc[4 * q + 1] = __builtin_amdgcn_sdot4((int)__builtin_amdgcn_perm(lo23, lo01, 0x07060302u), cdw, acc[4 * q + 1], false);
                acc[4 * q + 2] = __builtin_amdgcn_sdot4((int)__builtin_amdgcn_perm(hi23, hi01, 0x05040100u), cdw, acc[4 * q + 2], false);
                acc[4 * q + 3] = __builtin_amdgcn_sdot4((int)__builtin_amdgcn_perm(hi23, hi01, 0x07060302u), cdw, acc[4 * q + 3], false);
            }
        }
        const float cs = CSC[tok + t];
        float fo[16];
#pragma unroll
        for (int i = 0; i < 16; ++i) { int s = acc[i]; s += __builtin_amdgcn_update_dpp(0, s, 0x128, 0xF, 0xF, true); s += __shfl_xor(s, 16); s += __shfl_xor(s, 32); fo[i] = (float)s * cs; }
        if (g == 0) {
            u32x4 o0, o1;
            o0.x = cvtpk(fo[0], fo[1]); o0.y = cvtpk(fo[2], fo[3]); o0.z = cvtpk(fo[4], fo[5]); o0.w = cvtpk(fo[6], fo[7]);
            o1.x = cvtpk(fo[8], fo[9]); o1.y = cvtpk(fo[10], fo[11]); o1.z = cvtpk(fo[12], fo[13]); o1.w = cvtpk(fo[14], fo[15]);
            bf16_t* dp = FFN + (tok + t) * D + 128 * x + 16 * l8; *(u32x4*)dp = o0; *(u32x4*)(dp + 8) = o1;
        }
    }
}
DI void ln2_token(const bf16_t* __restrict__ FFN, const bf16_t* __restrict__ H1B, const float* __restrict__ g2, const float* __restrict__ b2, float* __restrict__ outp, size_t tok, int lane) {
    float* hr = outp + tok * D + 16 * lane;
    const u32x4 fa = *(const u32x4*)(FFN + tok * D + 16 * lane), fb = *(const u32x4*)(FFN + tok * D + 16 * lane + 8);
    const u32x4 ha = *(const u32x4*)(H1B + tok * D + 16 * lane), hb = *(const u32x4*)(H1B + tok * D + 16 * lane + 8);
    float ff[16], hh[16]; unpack8(fa, *(float(*)[8])&ff[0]); unpack8(fb, *(float(*)[8])&ff[8]); unpack8(ha, *(float(*)[8])&hh[0]); unpack8(hb, *(float(*)[8])&hh[8]);
    f32x4 v[4];
#pragma unroll
    for (int j = 0; j < 4; ++j)
#pragma unroll
        for (int e = 0; e < 4; ++e) v[j][e] = hh[4 * j + e];
    float s = 0.f;
#pragma unroll
    for (int j = 0; j < 4; ++j)
#pragma unroll
        for (int e = 0; e < 4; ++e) { v[j][e] = v[j][e] * ALPHA + ff[4 * j + e]; s += v[j][e]; }
    const float mean = wave_sum(s) * (1.f / D); float q2 = 0.f;
#pragma unroll
    for (int j = 0; j < 4; ++j)
#pragma unroll
        for (int e = 0; e < 4; ++e) { v[j][e] -= mean; q2 += v[j][e] * v[j][e]; }
    const float rstd = rsqrtf(wave_sum(q2) * (1.f / D) + LN_EPS);
#pragma unroll
    for (int j = 0; j < 4; ++j) { const f32x4 gg = *(const f32x4*)(g2 + 16 * lane + 4 * j), bb = *(const f32x4*)(b2 + 16 * lane + 4 * j); *(f32x4*)(hr + 4 * j) = v[j] * rstd * gg + bb; }
}

DI void p0_convert(const float* __restrict__ in, bf16_t* __restrict__ out, size_t n8, size_t first, size_t stride) {
    for (size_t i = first; i < n8; i += stride) { const f32x4 a = ((const f32x4*)in)[2 * i], b = ((const f32x4*)in)[2 * i + 1];
        u32x4 w; w.x = cvtpk(a[0], a[1]); w.y = cvtpk(a[2], a[3]); w.z = cvtpk(b[0], b[1]); w.w = cvtpk(b[2], b[3]); ((u32x4*)out)[i] = w; }
}
DI void p0_transpose_item(const float* __restrict__ W, int ldw, int ncols, bf16_t* __restrict__ out, int ldo, int koff, LAS float* scr, int item, int lane) {
    const int nblk = ncols / 32, kb = item / nblk, nb = item % nblk, k0 = 64 * kb, n0 = 32 * nb;
#pragma unroll 8
    for (int i = 0; i < 32; ++i) { const int kk = 2 * i + (lane >> 5); scr[kk * 33 + (lane & 31)] = W[(size_t)(k0 + kk) * ldw + n0 + (lane & 31)]; }
    asm volatile("s_waitcnt lgkmcnt(0)" ::: "memory");
    const int c = lane & 7;
#pragma unroll
    for (int j = 0; j < 4; ++j) { const int n = (lane >> 3) + 8 * j; const LAS float* s = scr + (8 * c) * 33 + n;
        u32x4 o; o.x = cvtpk(s[0 * 33], s[1 * 33]); o.y = cvtpk(s[2 * 33], s[3 * 33]); o.z = cvtpk(s[4 * 33], s[5 * 33]); o.w = cvtpk(s[6 * 33], s[7 * 33]);
        *(u32x4*)(out + (size_t)(n0 + n) * ldo + koff + k0 + 8 * c) = o; }
    asm volatile("s_waitcnt lgkmcnt(0)" ::: "memory");
}
template <bool I8>
DI void p0_fp8_row(const float* __restrict__ src, unsigned char* __restrict__ dst, float* __restrict__ scale, int row, int lane) {
    const f32x4* sp = (const f32x4*)(src + (size_t)row * D) + 4 * lane;
    f32x4 v[4]; float mx = 0.f;
#pragma unroll
    for (int j = 0; j < 4; ++j) { v[j] = sp[j]; mx = fmaxf(mx, fmaxf(fmaxf(fabsf(v[j][0]), fabsf(v[j][1])), fmaxf(fabsf(v[j][2]), fabsf(v[j][3])))); }
    mx = wave_max(mx);
    const float top = I8 ? 127.f : 224.f;
    const float sc = mx > 0.f ? top / mx : 1.f;
    u32x4 w;
#pragma unroll
    for (int j = 0; j < 4; ++j) {
        if (I8) { w[j] = ((unsigned)__float2int_rn(v[j][0] * sc) & 0xffu) | (((unsigned)__float2int_rn(v[j][1] * sc) & 0xffu) << 8) | (((unsigned)__float2int_rn(v[j][2] * sc) & 0xffu) << 16) | (((unsigned)__float2int_rn(v[j][3] * sc) & 0xffu) << 24); }
        else { int p = 0; p = __builtin_amdgcn_cvt_pk_fp8_f32(v[j][0] * sc, v[j][1] * sc, p, false); p = __builtin_amdgcn_cvt_pk_fp8_f32(v[j][2] * sc, v[j][3] * sc, p, true); w[j] = (unsigned)p; } }
    *(u32x4*)(dst + (size_t)(lane >> 3) * ((size_t)NEXP * 128) + (size_t)row * 128 + 16 * (lane & 7)) = w;
    if (lane == 0) scale[row] = mx > 0.f ? mx / top : 1.f;
}
DI void p0_misc(const float* __restrict__ hgrn_lb, const float* __restrict__ rel_bias, float* __restrict__ misc, int i) {
    if (i < 512) { const float a = hgrn_lb[i], b = hgrn_lb[512 + i]; const float mx = fmaxf(a, b); const float ea = expf(a - mx), eb = expf(b - mx); misc[i] = ea / (ea + eb); }
    if (i < 3 * 129) {
        const int g = i / 129, j = i % 129; const int dl = g == 0 ? 1 : (g == 1 ? 4 : 16); const int n = j * dl;
        int bucket;
        if (n < 16) bucket = n;
        else { const double v = log((double)n / 16.0) / log(128.0) * 16.0; int l = 16 + (int)v; bucket = l < 31 ? l : 31; }
        for (int h = 0; h < 4; ++h) misc[512 + i * 4 + h] = rel_bias[bucket * 12 + g * 4 + h];
    }
}
struct SchedMemKV {
    unsigned MEMB, W; int G, c;
    DI bool next(int i, g8::Unit& u) const {
        const int L = i * G + c; if (L >= 32) return false;
        u.dla = 1; u.dlb = 1;
        if (L < 16) { u.kind = 0; u.pm = L >> 1; u.pn = L & 1; u.a = MEMB + (unsigned)u.pm * 256u * D * 2u; u.b = W + (unsigned)u.pn * 256u * D * 2u; }
        else { const int q = L - 16; u.kind = 1; u.pm = q >> 3; u.pn = q & 7; u.a = W + (unsigned)(512 + u.pm * 256) * D * 2u; u.b = MEMB + (unsigned)u.pn * 256u * D * 2u; }
        return true;
    }
};
struct EpiMemKVF {
    static constexpr bool PERM = true, HOOK = false;
    bf16_t *MK, *MVT;
    DI void hook(f32x4 (&)[2][2][4][2], const g8::Unit&, int, int, int, int, int) const {}
    DI void operator()(const f32x4 (&acc)[2][2][4][2], const g8::Unit& u, int wr, int wc, int fr, int fq) const {
        const int rowl = wr * 64 + fr, d0 = wc * 32 + 8 * fq;
#pragma unroll
        for (int ai = 0; ai < 2; ++ai)
#pragma unroll
            for (int m = 0; m < 4; ++m) { const int R = u.pm * 256 + rowl + ai * 128 + m * 16;
#pragma unroll
                for (int bj = 0; bj < 2; ++bj) { const f32x4 v0 = acc[ai][bj][m][0], v1 = acc[ai][bj][m][1];
                    if (u.kind == 0) { const int b = R >> 8, mm = R & 255, h = u.pn * 2 + bj;
                        u32x4 w; w.x = cvtpk(v0[0], v0[1]); w.y = cvtpk(v0[2], v0[3]); w.z = cvtpk(v1[0], v1[1]); w.w = cvtpk(v1[2], v1[3]);
                        *(u32x4*)(MK + ((size_t)((b * 4 + h) * 8 + (mm >> 5))) * 4096 + frag_row_off(d0, mm & 31)) = w; }
                    else { const int h = R >> 7, d = R & 127, c = u.pn * 256 + bj * 128 + d0, b = c >> 8, mm = c & 255, kk = mm & 31;
                        bf16_t* blk = MVT + ((size_t)((b * 4 + h) * 8 + (mm >> 5))) * 4096 + (((d >> 5) * 2 + (kk >> 4)) * 64 + (d & 31)) * 8 + 4 * ((kk >> 3) & 1);
                        u32x2 wa, wb; wa.x = cvtpk(v0[0], v0[1]); wa.y = cvtpk(v0[2], v0[3]); wb.x = cvtpk(v1[0], v1[1]); wb.y = cvtpk(v1[2], v1[3]);
                        *(u32x2*)blk = wa; *(u32x2*)(blk + 32 * 8) = wb; } } }
    }
};

static_assert(HG_UNIT_BYTES <= LDSCTL_OFF, "hgrn LDS");
DI const float* karg_in(int i) { const float* const* kp = (const float* const*)__builtin_amdgcn_kernarg_segment_ptr(); asm volatile("" : "+s"(kp)); return kp[i]; }
DI float* karg_out() { float* const* kp = (float* const*)__builtin_amdgcn_kernarg_segment_ptr(); asm volatile("" : "+s"(kp)); return kp[18]; }
__global__ void __launch_bounds__(NTHR, 2) mega(Args args) {
    extern __shared__ __attribute__((aligned(16))) unsigned char lds_raw[];
    LAS unsigned char* lds = (LAS unsigned char*)lds_raw;
    volatile LAS unsigned* MISC = (volatile LAS unsigned*)(lds + MISC_OFF);
    for (int u = threadIdx.x; u < (LDS_BYTES - LDSCTL_OFF) / 4; u += NTHR) ((LAS unsigned*)(lds + LDSCTL_OFF))[u] = 0u;
    __syncthreads();
    unsigned char* ws = args.ws;
    const int G = gridDim.x;
    const bool ALL = args.ph == PH_ALL;
    XcdBarrier bar; bar.bar = (unsigned*)(ws + O_MISC + 16384); bar.x = 0; bar.st = nullptr;
    if (ALL) bar = xcd_barrier_post((unsigned*)(ws + O_MISC + 16384), MISC + 8);
#ifndef REP_MASK
#define REP_MASK 0
#endif
#define RUN(k) (ALL || args.ph == (k))
#define NREP(k) (((REP_MASK >> (k)) & 1) ? 2 : 1)
#define SEAM() do { if (ALL) xcd_barrier(bar); } while (0)
    for (int rep_ = 0; rep_ < NREP(PH_PRO); ++rep_) if (RUN(PH_PRO)) {
        int tid = threadIdx.x; asm volatile("" : "+v"(tid)); asm volatile("" : "+s"(ws)); int bid = blockIdx.x; asm volatile("" : "+s"(bid));
        const size_t gt = (size_t)bid * NTHR + tid, nth = (size_t)G * NTHR;
        p0_convert(karg_in(0), (bf16_t*)(ws + O_XB), (size_t)M * D / 8, gt, nth);
        p0_convert(karg_in(1), (bf16_t*)(ws + O_MEMB), (size_t)2048 * 1024 / 8, gt, nth);
        p0_convert(karg_in(13), (bf16_t*)(ws + O_SUBK), (size_t)16 * 128 * 128 / 8, gt, nth);
        if (bid == 0) p0_misc(karg_in(6), karg_in(5), (float*)(ws + O_MISC), tid);
        const int wid = __builtin_amdgcn_readfirstlane(tid >> 6), lane = tid & 63;
        LAS float* scr = (LAS float*)(lds + wid * 16384);
        const int gw = bid * NWAVES + wid, ngw = G * NWAVES;
        for (int r = gw; r < 2 * NEXP; r += ngw) {
            if (r < NEXP) p0_fp8_row<true>(karg_in(14), (unsigned char*)(ws + O_UB), (float*)(ws + O_USC), r, lane);
            else p0_fp8_row<true>(karg_in(15), (unsigned char*)(ws + O_VB), (float*)(ws + O_VSC), r - NEXP, lane);
        }
        constexpr int NJ = 13;
        for (int it = gw; ; it += ngw) {
            int r = it; bool done = true;
#pragma unroll
            for (int j = 0; j < NJ; ++j) {
                const int srcc[NJ] = {0, 4608, 5632, 6656, 7168, 3072, 5120, 0, 0, 0, 0, 0, 0};
                const int cnt[NJ] = {3072, 512, 1024, 512, 3072, 1536, 512, 1024, 1024, 1024, 1024, 1024, 2048};
                const int drow[NJ] = {0, 3072, 3584, 4608, 5120, 8192, 9728, 0, 0, 0, 0, 0, 0};
                const int Kj = (j >= 8 && j <= 10) ? 512 : 1024;
                const int items = (Kj / 64) * (cnt[j] / 32);
                if (done && r < items) {
                    const float* W; int ldw; bf16_t* o; int ldo, koff = 0;
                    if (j < 7) { W = karg_in(2) + srcc[j]; ldw = INC; o = (bf16_t*)(ws + O_WIN) + (size_t)drow[j] * 1024; ldo = 1024; }
                    else if (j == 7) { W = karg_in(4); ldw = 1024; o = (bf16_t*)(ws + O_WMKV); ldo = 1024; }
                    else if (j <= 10) { W = karg_in(8) + (size_t)(j - 8) * 512 * 1024; ldw = 1024; o = (bf16_t*)(ws + O_WBR); ldo = 1536; koff = (j - 8) * 512; }
                    else if (j == 11) { W = karg_in(9); ldw = 1024; o = (bf16_t*)(ws + O_WOUT); ldo = 1024; }
                    else { W = karg_in(12); ldw = 2048; o = (bf16_t*)(ws + O_WPQ); ldo = 1024; }
                    p0_transpose_item(W, ldw, cnt[j], o, ldo, koff, scr, r, lane); done = false;
                }
                r -= items;
            }
            if (done) break;
        }
        SEAM();
    }
#pragma unroll 1
    for (int p = (ALL ? 0 : args.pass); p < (ALL ? NPASS : args.pass + 1); ++p) {
        int bid = blockIdx.x; asm volatile("" : "+s"(bid));
        int tid = threadIdx.x; asm volatile("" : "+v"(tid));
        asm volatile("" : "+s"(ws));
        char* pr = (char*)ws + O_PASS;
        const size_t t0 = (size_t)p * MP;
        for (int rep_ = 0; rep_ < NREP(PH_PROJ); ++rep_) if (RUN(PH_PROJ)) {
            asm volatile("" : "+s"(bid)); asm volatile("" : "+v"(tid)); asm volatile("" : "+s"(ws)); pr = (char*)ws + O_PASS;
            SchedP1 Sc{(unsigned)(O_XB + t0 * D * 2), (unsigned)O_WIN, G, bid};
            EpiP1 E{pr, karg_in(3)};
            g8::gemm_phase<EpiP1, SchedP1>(lds, (const char*)ws, D, Sc, E, tid);
            if (p == 0) {
                SchedMemKV S2{(unsigned)O_MEMB, (unsigned)O_WMKV, G, bid};
                EpiMemKVF E2{(bf16_t*)(ws + O_MK), (bf16_t*)(ws + O_MVT)};
                g8::gemm_phase<EpiMemKVF, SchedMemKV>(lds, (const char*)ws, D, S2, E2, tid);
            }
            SEAM();
        }
        for (int rep_ = 0; rep_ < NREP(PH_ATTN); ++rep_) if (RUN(PH_ATTN)) {
            asm volatile("" : "+s"(bid)); asm volatile("" : "+v"(tid)); asm volatile("" : "+s"(ws)); pr = (char*)ws + O_PASS;
            const float* bsrc = (const float*)(ws + O_MISC) + 512; LAS float* btab = (LAS float*)lds;
            for (int i = tid; i < 3 * 129 * 4; i += NTHR) btab[i] = bsrc[i] * LOG2E;
            __syncthreads();
            const int wid = __builtin_amdgcn_readfirstlane(tid >> 6), lane = tid & 63;
            for (int task = bid * NWAVES + wid; task < DIL_TASKS; task += G * NWAVES)
                attn_dil_wave((const bf16_t*)(pr + P_QK), (const bf16_t*)(pr + P_VT), btab, (bf16_t*)(pr + P_OG), (float*)(pr + P_LSE), task, lane);
            for (int task = bid * NWAVES + wid; task < MEM_TASKS; task += G * NWAVES)
                attn_mem_wave((const bf16_t*)(pr + P_MQ), (const bf16_t*)(ws + O_MK), (const bf16_t*)(ws + O_MVT), (bf16_t*)(pr + P_BR), task, p * BPP, lane);
            __syncthreads();
        }
        for (int rep_ = 0; rep_ < NREP(PH_HGPRE); ++rep_) if (RUN(PH_HGPRE)) {
            asm volatile("" : "+s"(bid)); asm volatile("" : "+v"(tid)); asm volatile("" : "+s"(ws)); pr = (char*)ws + O_PASS;
            { const int unit = bid; static_assert(HG_UNITS == 256, "one HGRN unit per workgroup"); if (unit < HG_UNITS) {
                hgrn_unit<false>(lds, unit, tid, (const bf16_t*)(pr + P_HFQG), (const bf16_t*)(pr + P_IT), (const float*)(ws + O_MISC), karg_in(7),
                                 (float*)(pr + P_HSTL), (float*)(pr + P_HSTD), (const float*)(pr + P_SIN), (bf16_t*)(pr + P_BR));
            } }
            SEAM();
        }
        for (int rep_ = 0; rep_ < NREP(PH_HGSCAN); ++rep_) if (RUN(PH_HGSCAN)) {
            asm volatile("" : "+s"(bid)); asm volatile("" : "+v"(tid)); asm volatile("" : "+s"(ws)); pr = (char*)ws + O_PASS;
            hgrn_scan((const float*)(pr + P_HSTL), (const float*)(pr + P_HSTD), (float*)(pr + P_SIN), bid * NTHR + tid);
            lse_merge_items((const bf16_t*)(pr + P_OG), (const float*)(pr + P_LSE), (bf16_t*)(pr + P_BR), bid * NTHR + tid, G * NTHR);
            SEAM();
        }
        for (int rep_ = 0; rep_ < NREP(PH_HGMAIN); ++rep_) if (RUN(PH_HGMAIN)) {
            asm volatile("" : "+s"(bid)); asm volatile("" : "+v"(tid)); asm volatile("" : "+s"(ws)); pr = (char*)ws + O_PASS;
            { const int unit = bid; static_assert(HG_UNITS == 256, "one HGRN unit per workgroup"); if (unit < HG_UNITS) {
                hgrn_unit<true>(lds, unit, tid, (const bf16_t*)(pr + P_HFQG), (const bf16_t*)(pr + P_IT), (const float*)(ws + O_MISC), karg_in(7),
                                (float*)(pr + P_HSTL), (float*)(pr + P_HSTD), (const float*)(pr + P_SIN), (bf16_t*)(pr + P_BR));
            } }
            SEAM();
        }
        for (int rep_ = 0; rep_ < NREP(PH_WIDEN); ++rep_) if (RUN(PH_WIDEN)) {
            asm volatile("" : "+s"(bid)); asm volatile("" : "+v"(tid)); asm volatile("" : "+s"(ws)); pr = (char*)ws + O_PASS;
            SchedRows Sc{(unsigned)(O_PASS + P_BR), (unsigned)O_WBR, 1536, 4, 256, G, bid};
            EpiWidenF E{(const bf16_t*)(pr + P_GATE), (bf16_t*)(pr + P_MERGED)};
            g8::gemm_phase<EpiWidenF, SchedRows>(lds, (const char*)ws, 1536, Sc, E, tid);
            SEAM();
        }
        for (int rep_ = 0; rep_ < NREP(PH_WOUT); ++rep_) if (RUN(PH_WOUT)) {
            asm volatile("" : "+s"(bid)); asm volatile("" : "+v"(tid)); asm volatile("" : "+s"(ws)); pr = (char*)ws + O_PASS;
            SchedRows Sc{(unsigned)(O_PASS + P_MERGED), (unsigned)O_WOUT, 1024, 4, 256, G, bid};
            EpiPlainB16 E{(bf16_t*)(pr + P_MIX), 1024, 0};
            g8::gemm_phase<EpiPlainB16, SchedRows>(lds, (const char*)ws, 1024, Sc, E, tid);
            SEAM();
        }
        for (int rep_ = 0; rep_ < NREP(PH_LN1); ++rep_) if (RUN(PH_LN1)) {
            asm volatile("" : "+s"(bid)); asm volatile("" : "+v"(tid)); asm volatile("" : "+s"(ws)); pr = (char*)ws + O_PASS;
            ln1_rows(karg_in(0) + t0 * D, (const bf16_t*)(pr + P_MIX), karg_in(10), karg_in(11), (bf16_t*)(ws + O_H1B) + t0 * D, (unsigned char*)(ws + O_H1Q) + t0 * D, (float*)(ws + O_HSC) + t0, bid * NWAVES + (tid >> 6), G * NWAVES, tid & 63);
        }
    }
    for (int rep_ = 0; rep_ < NREP(PH_PQ); ++rep_) if (RUN(PH_PQ)) {
        SEAM();
        int tid = threadIdx.x; asm volatile("" : "+v"(tid)); asm volatile("" : "+s"(ws)); int bid = blockIdx.x; asm volatile("" : "+s"(bid));
        char* pr = (char*)ws + O_PASS;
        SchedRows Sc{(unsigned)O_H1B, (unsigned)O_WPQ, 1024, 8, 2048, G, bid};
        EpiPlainB16 E{(bf16_t*)(pr + P_PQ), 2048, 0};
        g8::gemm_phase<EpiPlainB16, SchedRows>(lds, (const char*)ws, 1024, Sc, E, tid);
        SEAM();
    }
    for (int rep_ = 0; rep_ < NREP(PH_ROUTE); ++rep_) if (RUN(PH_ROUTE)) {
        int tid = threadIdx.x; asm volatile("" : "+v"(tid)); asm volatile("" : "+s"(ws)); int bid = blockIdx.x; asm volatile("" : "+s"(bid));
        char* pr = (char*)ws + O_PASS;
        const int h = bid & 7, wgi = bid >> 3, nwg = G >> 3;
        const bf16_t* ksrc = (const bf16_t*)(ws + O_SUBK) + (size_t)h * 2 * 128 * 128;
        for (int i = tid; i < 2 * 128 * 16; i += NTHR) { const int rowk = i >> 4, ch = i & 15; *(LAS u32x4*)(lds + (rowk * RT_ROW + ch * 8) * 2) = *(const u32x4*)(ksrc + rowk * 128 + ch * 8); }
        __syncthreads();
        const int wid = __builtin_amdgcn_readfirstlane(tid >> 6), lane = tid & 63;
        for (int tb = wgi * NWAVES + wid; tb < M / 32; tb += nwg * NWAVES)
            route_wave((const bf16_t*)(pr + P_PQ), lds, (int*)(pr + P_IDX), (float*)(pr + P_PG), tb, h, lane);
        __syncthreads();
        SEAM();
    }
    if (RUN(PH_EXPERTS)) {
        int tid = threadIdx.x; asm volatile("" : "+v"(tid)); asm volatile("" : "+s"(ws)); int bid = blockIdx.x; asm volatile("" : "+s"(bid));
        char* pr = (char*)ws + O_PASS;
        const int wid = __builtin_amdgcn_readfirstlane(tid >> 6), lane = tid & 63;
        if (tid == 0) {
            unsigned base = 0; const unsigned myx = ALL ? bar.x : 0u;
            if (ALL) { for (unsigned jx = 0; jx < 16; ++jx) { const unsigned c = xb_ld(&bar.bar[XB_XCNT(jx)]); if (jx < myx) base += c; } MISC[12] = base + MISC[10]; }
            else MISC[12] = (unsigned)bid;
        }
        __syncthreads();
        const int vwg = (int)MISC[12];
        const int nper = G >> 3, x = vwg / nper, r = vwg % nper;
        const int tpw = M / (nper * NWAVES);
        const size_t tokw0 = (size_t)(r * NWAVES + wid) * tpw;
        {
            const unsigned char* U8x = (const unsigned char*)(ws + O_UB) + (size_t)x * ((size_t)NEXP * 128);
            for (int i = 0; i < tpw; i += 2) experts_u_slice<2>((const unsigned char*)(ws + O_H1Q), U8x, (const int*)(pr + P_IDX), (bf16_t*)(pr + P_PD), tokw0 + i, x, lane);
        }
        SEAM();
        experts_combine((const bf16_t*)(pr + P_PD), (const int*)(pr + P_IDX), (const float*)(pr + P_PG), (const float*)(ws + O_USC), (const float*)(ws + O_VSC), (const float*)(ws + O_HSC), (unsigned char*)(pr + P_C), (float*)(pr + P_C + (size_t)M * 128), bid * NWAVES + wid, G * NWAVES, lane);
        SEAM();
        {
            const unsigned char* V8x = (const unsigned char*)(ws + O_VB) + (size_t)x * ((size_t)NEXP * 128);
            for (int i = 0; i < tpw; i += 2) experts_v_slice<2>(V8x, (const int*)(pr + P_IDX), (const unsigned char*)(pr + P_C), (const float*)(pr + P_C + (size_t)M * 128), (bf16_t*)(pr + P_FFN), tokw0 + i, x, lane);
        }
        SEAM();
        for (int tok = bid * NWAVES + wid; tok < M; tok += G * NWAVES) ln2_token((const bf16_t*)(pr + P_FFN), (const bf16_t*)(ws + O_H1B), karg_in(16), karg_in(17), karg_out(), (size_t)tok, lane);
    }
#undef RUN
#undef SEAM
}

extern "C" void kernel_launch(void* const* d_in, const int* in_sizes, int n_in, void* d_out, int out_size, void* d_ws, size_t ws_size, hipStream_t stream) {
    if (ws_size < WS_NEED || n_in != 18) return;
    static bool attr_set = false;
    if (!attr_set) { (void)hipFuncSetAttribute((const void*)mega, hipFuncAttributeMaxDynamicSharedMemorySize, LDS_BYTES); attr_set = true; }
    (void)hipMemsetAsync((char*)d_ws + O_MISC + 16384, 0, 16384, stream);
    Args a{}; for (int i = 0; i < 18; ++i) a.in[i] = (const float*)d_in[i]; a.out = (float*)d_out; a.ws = (unsigned char*)d_ws; a.ph = PH_ALL; a.pass = 0;
    mega<<<256, NTHR, LDS_BYTES, stream>>>(a);
}
```

```cpp
#include <hip/hip_runtime.h>
#include <stdint.h>
#include <math.h>

typedef unsigned short bf16_t;
typedef short bf16x8 __attribute__((ext_vector_type(8)));
typedef float f32x4 __attribute__((ext_vector_type(4)));
#define DI __device__ __forceinline__

DI float bf2f(bf16_t v) { return __uint_as_float(((unsigned)v) << 16); }
DI bf16_t f2bf(float f) { unsigned u = __float_as_uint(f); u += 0x7fffu + ((u >> 16) & 1u); return (bf16_t)(u >> 16); }

constexpr int NB = 8, S = 8192, D = 1024, M = NB * S;
constexpr int NPASS = 4, BPP = NB / NPASS, MP = BPP * S;
constexpr int INC = 10240;
constexpr int NEXP = 16384;
constexpr float ALPHA = 1.189207115002721f;
constexpr float LN_EPS = 1e-5f;
constexpr float QSCALE = 0.08838834764831845f;

constexpr size_t al(size_t x) { return (x + 255) & ~(size_t)255; }
constexpr size_t O_WIN = 0;
constexpr size_t O_WMKV = O_WIN + al((size_t)INC * D * 2);
constexpr size_t O_WBR = O_WMKV + al((size_t)1024 * 1024 * 2);
constexpr size_t O_WOUT = O_WBR + al((size_t)1024 * 1536 * 2);
constexpr size_t O_WPQ = O_WOUT + al((size_t)1024 * 1024 * 2);
constexpr size_t O_SUBK = O_WPQ + al((size_t)2048 * 1024 * 2);
constexpr size_t O_UB = O_SUBK + al((size_t)16 * 128 * 128 * 2);
constexpr size_t O_VB = O_UB + al((size_t)NEXP * D);
constexpr size_t O_USC = O_VB + al((size_t)NEXP * D);
constexpr size_t O_VSC = O_USC + al((size_t)NEXP * 4);
constexpr size_t O_XB = O_VSC + al((size_t)NEXP * 4);
constexpr size_t O_MEMB = O_XB + al((size_t)M * D * 2);
constexpr size_t O_MK = O_MEMB + al((size_t)2048 * 1024 * 2);
constexpr size_t O_MVT = O_MK + al((size_t)2048 * 512 * 2);
constexpr size_t O_H1B = O_MVT + al((size_t)8 * 512 * 256 * 2);
constexpr size_t O_H1Q = O_H1B + al((size_t)M * D * 2);
constexpr size_t O_HSC = O_H1Q + al((size_t)M * D);
constexpr size_t O_MISC = O_HSC + al((size_t)M * 4);
constexpr size_t O_PASS = O_MISC + al(65536);
constexpr size_t P_QK = 0;
constexpr size_t P_VT = P_QK + al((size_t)MP * 3072 * 2);
constexpr size_t P_IT = P_VT + (size_t)1536 * MP * 2;
constexpr size_t P_HFQG = P_IT + al((size_t)512 * MP * 2);
constexpr size_t P_MQ = P_HFQG + al((size_t)MP * 1536 * 2);
constexpr size_t P_GATE = P_MQ + al((size_t)MP * 512 * 2);
constexpr size_t P_OG = P_GATE + al((size_t)MP * 3072 * 2);
constexpr size_t P_LSE = P_OG + al((size_t)MP * 1536 * 2);
constexpr size_t P_BR = P_LSE + al((size_t)MP * 12 * 4);
constexpr size_t P_MERGED = P_BR + al((size_t)MP * 1536 * 2);
constexpr size_t P_MIX = P_MERGED + al((size_t)MP * 1024 * 2);
constexpr size_t P_HSTL = P_MIX + al((size_t)MP * 1024 * 4);
constexpr size_t P_HSTD = P_HSTL + al((size_t)256 * 16384 * 4);
constexpr size_t P_SIN = P_HSTD + al((size_t)256 * 128 * 4);
constexpr size_t P_END = P_SIN + al((size_t)256 * 16384 * 4);
constexpr size_t P_PQ = 0;
constexpr size_t P_IDX = P_PQ + al((size_t)M * 2048 * 2);
constexpr size_t P_PG = P_IDX + al((size_t)M * 128 * 4);
constexpr size_t P_C = P_PG + al((size_t)M * 128 * 4);
constexpr size_t P_END2 = P_C + al((size_t)M * 128 * 4);
constexpr size_t P_PD = 0;
constexpr size_t P_FFN = P_PD + al((size_t)M * 1024 * 2);
static_assert(P_FFN + (size_t)M * 1024 * 2 <= P_IDX, "PEER overlay");
constexpr size_t WS_NEED = O_PASS + (P_END > P_END2 ? P_END : P_END2);
static_assert(WS_NEED <= (size_t)1073741824, "workspace budget");

DI int dil_of(int g) { return g == 0 ? 1 : (g == 1 ? 4 : 16); }
DI float dpp_x(float v, const int which) {
    const int s = __float_as_int(v);
    const int r = which == 0 ? __builtin_amdgcn_update_dpp(0, s, 0xB1, 0xF, 0xF, true) : which == 1 ? __builtin_amdgcn_update_dpp(0, s, 0x4E, 0xF, 0xF, true)
                : which == 2 ? __builtin_amdgcn_update_dpp(0, s, 0x141, 0xF, 0xF, true) : __builtin_amdgcn_update_dpp(0, s, 0x128, 0xF, 0xF, true);
    return __int_as_float(r);
}
DI float pair_sum(float v) { const auto rr = __builtin_amdgcn_permlane32_swap(__float_as_uint(v), __float_as_uint(v), false, false); return __uint_as_float(rr[0]) + __uint_as_float(rr[1]); }
DI float pair_max(float v) { const auto rr = __builtin_amdgcn_permlane32_swap(__float_as_uint(v), __float_as_uint(v), false, false); return fmaxf(__uint_as_float(rr[0]), __uint_as_float(rr[1])); }
DI float wave_max(float v) {
    v = fmaxf(v, dpp_x(v, 0)); v = fmaxf(v, dpp_x(v, 1)); v = fmaxf(v, dpp_x(v, 2)); v = fmaxf(v, dpp_x(v, 3));
    { const auto rr = __builtin_amdgcn_permlane16_swap(__float_as_uint(v), __float_as_uint(v), false, false); v = fmaxf(__uint_as_float(rr[0]), __uint_as_float(rr[1])); }
    return pair_max(v);
}
DI float wave_sum(float v) {
    v += dpp_x(v, 0); v += dpp_x(v, 1); v += dpp_x(v, 2); v += dpp_x(v, 3);
    { const auto rr = __builtin_amdgcn_permlane16_swap(__float_as_uint(v), __float_as_uint(v), false, false); v = __uint_as_float(rr[0]) + __uint_as_float(rr[1]); }
    return pair_sum(v);
}

#define LAS __attribute__((address_space(3)))
#define GAS __attribute__((address_space(1)))
typedef unsigned u32x4 __attribute__((ext_vector_type(4)));
typedef unsigned u32x2 __attribute__((ext_vector_type(2)));
typedef float f32x2 __attribute__((ext_vector_type(2)));
typedef __bf16 bf16x2_t __attribute__((ext_vector_type(2)));
DI unsigned cvtpk(float lo, float hi) { f32x2 v = {lo, hi}; bf16x2_t b = __builtin_convertvector(v, bf16x2_t); return __builtin_bit_cast(unsigned, b); }
constexpr float LOG2E = 1.4426950408889634f;
DI float fast_sigmoid(float z) { return __builtin_amdgcn_rcpf(1.f + __builtin_amdgcn_exp2f(-z * LOG2E)); }

namespace g8 {
constexpr int BM = 256, BK = 64, HALF = 128, HTB = HALF * BK * 2, STAGE_BYTES = 8 * HTB;
DI int lds_byte(int r, int c) { const int st = (r >> 4) * 2 + (c >> 5), rr = r & 15, cc = c & 31, ob = rr * 64 + cc * 2; return st * 1024 + (ob ^ (((ob >> 9) & 1) << 5)); }
DI void stage_rc(int b, int& R, int& C) { const int st = b / 1024, sb = b % 1024, swz = sb ^ (((sb >> 9) & 1) << 5); R = (st >> 1) * 16 + swz / 64; C = (st & 1) * 32 + (swz % 64) / 2; }
DI int perm32(int rho) { const int n = rho >> 4, i = rho & 15; return 8 * (i >> 2) + 4 * n + (i & 3); }

struct Unit { unsigned a, b; int dla, dlb; int pm, pn, kind; };

template <class Epi, class Sched>
DI void gemm_phase(LAS unsigned char* lds, const char* const wsb, const int K, const Sched& S, const Epi& E, const int tid) {
    const int wid = __builtin_amdgcn_readfirstlane(tid >> 6), lane = tid & 63, wr = wid >> 2, wc = wid & 3, fr = lane & 15, fq = lane >> 4;
    const int nt = K / BK;
    unsigned rak[2], rbk[2], ccb[2];
#pragma unroll
    for (int i = 0; i < 2; ++i) { int R, C; stage_rc(tid * 16 + i * 8192, R, C); const int Rb = Epi::PERM ? ((R & ~31) + perm32(R & 31)) : R;
        rak[i] = (unsigned)(R * K) * 2u; rbk[i] = (unsigned)(Rb * K) * 2u; ccb[i] = (unsigned)C * 2u; }
    const unsigned kstep = (unsigned)(BK * 2);
    const unsigned hstepA = (unsigned)(HALF * K * 2);
    const unsigned ldsw = (unsigned)wid * 1024u;
    const int aoff = lds_byte(wr * 64 + fr, fq * 8), boff = lds_byte(wc * 32 + fr, fq * 8);
#define G8_SA(b, h) (((b) * 2 + (h)) * HTB)
#define G8_SB(b, h) ((4 + (b) * 2 + (h)) * HTB)
#define G8_STAGE(bufoff, gbase, v0, v1) do { \
        __builtin_amdgcn_global_load_lds((const unsigned*)(wsb + (unsigned)((gbase) + (v0))), (LAS unsigned*)(lds + (bufoff) + ldsw), 16, 0, 0); \
        __builtin_amdgcn_global_load_lds((const unsigned*)(wsb + (unsigned)((gbase) + (v1))), (LAS unsigned*)(lds + (bufoff) + ldsw + 8192), 16, 0, 0); } while (0)
#define G8_LDA(dst, b, h) do { _Pragma("unroll") for (int m = 0; m < 4; ++m) _Pragma("unroll") for (int k = 0; k < 2; ++k) dst[m][k] = *(const LAS bf16x8*)(lds + G8_SA(b, h) + aoff + m * 2048 + k * 1024); } while (0)
#define G8_LDB(dst, b, h) do { _Pragma("unroll") for (int n = 0; n < 2; ++n) _Pragma("unroll") for (int k = 0; k < 2; ++k) dst[n][k] = *(const LAS bf16x8*)(lds + G8_SB(b, h) + boff + n * 2048 + k * 1024); } while (0)
#define G8_MMA(ai, bj, At, Bt) do { __builtin_amdgcn_s_setprio(1); _Pragma("unroll") for (int m = 0; m < 4; ++m) _Pragma("unroll") for (int n = 0; n < 2; ++n) _Pragma("unroll") for (int k = 0; k < 2; ++k) \
        acc[ai][bj][m][n] = __builtin_amdgcn_mfma_f32_16x16x32_bf16(Bt[n][k], At[m][k], acc[ai][bj][m][n], 0, 0, 0); __builtin_amdgcn_s_setprio(0); } while (0)
#define G8_WAIT_V(n) asm volatile("s_waitcnt vmcnt(" #n ")" ::: "memory")
#define G8_WAIT_L(n) asm volatile("s_waitcnt lgkmcnt(" #n ")" ::: "memory")
#define G8_BAR __builtin_amdgcn_s_barrier()
#define G8_SCHED __builtin_amdgcn_sched_barrier(0)
    Unit cur, nxt; int ui = 0;
    if (!S.next(0, cur)) return;
    f32x4 acc[2][2][4][2];
#pragma unroll
    for (int a = 0; a < 2; ++a)
#pragma unroll
        for (int b = 0; b < 2; ++b)
#pragma unroll
            for (int m = 0; m < 4; ++m)
#pragma unroll
                for (int n = 0; n < 2; ++n) acc[a][b][m][n] = (f32x4){0.f, 0.f, 0.f, 0.f};
    bf16x8 At[4][2], B0[2][2], B1[2][2];
    unsigned cA = cur.a, cB = cur.b;
    unsigned vBc0 = rbk[0] * (unsigned)cur.dlb + ccb[0], vBc1 = rbk[1] * (unsigned)cur.dlb + ccb[1]; unsigned hBc = hstepA * (unsigned)cur.dlb;
    unsigned vAc0 = rak[0] * (unsigned)cur.dla + ccb[0], vAc1 = rak[1] * (unsigned)cur.dla + ccb[1]; unsigned hAc = hstepA * (unsigned)cur.dla;
    G8_STAGE(G8_SB(0, 0), cB, vBc0, vBc1); G8_STAGE(G8_SB(0, 1), cB + hBc, vBc0, vBc1); G8_STAGE(G8_SA(0, 0), cA, vAc0, vAc1); G8_STAGE(G8_SA(0, 1), cA + hAc, vAc0, vAc1);
    if (wr == 1) G8_BAR;
    G8_WAIT_V(2); G8_BAR;
    G8_STAGE(G8_SB(1, 0), cB + kstep, vBc0, vBc1); G8_STAGE(G8_SA(1, 0), cA + kstep, vAc0, vAc1); G8_STAGE(G8_SB(1, 1), cB + hBc + kstep, vBc0, vBc1);
    G8_WAIT_V(6); G8_BAR;
    for (;;) {
        const bool has_next = S.next(ui + 1, nxt);
        const unsigned nA = has_next ? nxt.a : cA, nB = has_next ? nxt.b : cB; const int dln = has_next ? nxt.dlb : cur.dlb;
        const unsigned vBn0 = rbk[0] * (unsigned)dln + ccb[0], vBn1 = rbk[1] * (unsigned)dln + ccb[1]; const unsigned hBn = hstepA * (unsigned)dln;
        const int dlan = has_next ? nxt.dla : cur.dla;
        const unsigned vAn0 = rak[0] * (unsigned)dlan + ccb[0], vAn1 = rak[1] * (unsigned)dlan + ccb[1]; const unsigned hAn = hstepA * (unsigned)dlan;
        for (int t = 0; t < nt; t += 2) {
            if constexpr (Epi::HOOK) E.hook(acc, cur, t, wr, wc, fr, fq);
            const bool last = (t == nt - 2);
            const unsigned a1 = cA + (unsigned)(t + 1) * kstep;
            const unsigned a2 = last ? nA : cA + (unsigned)(t + 2) * kstep, b2 = last ? nB : cB + (unsigned)(t + 2) * kstep;
            const unsigned a3 = a2 + kstep, b3 = b2 + kstep;
            const unsigned vB0 = last ? vBn0 : vBc0, vB1 = last ? vBn1 : vBc1; const unsigned hB = last ? hBn : hBc;
            const unsigned vA0 = last ? vAn0 : vAc0, vA1 = last ? vAn1 : vAc1; const unsigned hA = last ? hAn : hAc;
            G8_LDB(B0, 0, 0); G8_LDB(B1, 0, 1); G8_SCHED; G8_LDA(At, 0, 0); G8_STAGE(G8_SA(1, 1), a1 + hAc, vAc0, vAc1);
            G8_WAIT_V(8); G8_WAIT_L(0); G8_BAR; G8_MMA(0, 0, At, B0); G8_MMA(0, 1, At, B1); G8_BAR; G8_SCHED;
            G8_LDA(At, 0, 1); G8_STAGE(G8_SB(0, 0), b2, vB0, vB1); G8_STAGE(G8_SB(0, 1), b2 + hB, vB0, vB1); G8_STAGE(G8_SA(0, 0), a2, vA0, vA1);
            G8_WAIT_V(8); G8_WAIT_L(0); G8_BAR; G8_MMA(1, 0, At, B0); G8_MMA(1, 1, At, B1); G8_BAR; G8_SCHED;
            G8_LDB(B0, 1, 0); G8_LDB(B1, 1, 1); G8_SCHED; G8_LDA(At, 1, 0); G8_STAGE(G8_SA(0, 1), a2 + hA, vA0, vA1);
            G8_WAIT_V(8); G8_WAIT_L(0); G8_BAR; G8_MMA(0, 0, At, B0); G8_MMA(0, 1, At, B1); G8_BAR; G8_SCHED;
            G8_LDA(At, 1, 1); G8_STAGE(G8_SB(1, 0), b3, vB0, vB1); G8_STAGE(G8_SB(1, 1), b3 + hB, vB0, vB1); G8_STAGE(G8_SA(1, 0), a3, vA0, vA1);
            G8_WAIT_V(8); G8_WAIT_L(0); G8_BAR; G8_MMA(1, 0, At, B0); G8_MMA(1, 1, At, B1); G8_BAR; G8_SCHED;
        }
        if (wr == 0) G8_BAR;
        E(acc, cur, wr, wc, fr, fq);
        if (!has_next) break;
#pragma unroll
        for (int a = 0; a < 2; ++a)
#pragma unroll
            for (int b = 0; b < 2; ++b)
#pragma unroll
                for (int m = 0; m < 4; ++m)
#pragma unroll
                    for (int n = 0; n < 2; ++n) acc[a][b][m][n] = (f32x4){0.f, 0.f, 0.f, 0.f};
        cur = nxt; cA = nA; cB = nB; vBc0 = vBn0; vBc1 = vBn1; hBc = hBn; vAc0 = vAn0; vAc1 = vAn1; hAc = hAn; ++ui;
        if (wr == 1) G8_BAR;
    }
    G8_WAIT_V(0);
    G8_BAR;
#undef G8_SA
#undef G8_SB
#undef G8_STAGE
#undef G8_LDA
#undef G8_LDB
#undef G8_MMA
#undef G8_WAIT_V
#undef G8_WAIT_L
#undef G8_BAR
#undef G8_SCHED
}
}

typedef GAS unsigned gu32;
#define XB_TMO      128
#define XB_XCNT(j)  (256  + 64 * (j))
#define XB_XSUB(j)  (1280 + 64 * (j))
#define XB_XGEN(j)  (2304 + 64 * (j))
#define XB_TOP      3328
#define XB_TOPGEN   3392
#define XCD_BAR_WORDS 3456
#define XB_SPIN_CAP (1u << 22)
DI unsigned xb_ld(unsigned* p)              { return __hip_atomic_load(p, __ATOMIC_RELAXED, __HIP_MEMORY_SCOPE_AGENT); }
DI unsigned xb_add(unsigned* p, unsigned v) { return __hip_atomic_fetch_add(p, v, __ATOMIC_RELAXED, __HIP_MEMORY_SCOPE_AGENT); }
DI unsigned xb_xcc_id() { return (unsigned)__builtin_amdgcn_s_getreg((3 << 11) | 20) & 0xFu; }
#define XB_SPIN(cond, bar) do { unsigned _sp = 0; while (cond) { __builtin_amdgcn_s_sleep(1); \
    if ((++_sp & 255u) == 0u) { if (xb_ld(&(bar)[XB_TMO])) break; if (_sp > XB_SPIN_CAP) { atomicAdd(&(bar)[XB_TMO], 1u); break; } } } } while (0)
struct XcdBarrier { unsigned* bar; unsigned x; volatile LAS unsigned* st; };
DI XcdBarrier xcd_barrier_post(unsigned* bar, volatile LAS unsigned* st) {
    XcdBarrier b; b.bar = bar; b.x = xb_xcc_id(); b.st = st;
    if (threadIdx.x == 0) st[2] = xb_add(&bar[XB_XCNT(b.x)], 1u);
    return b;
}
DI void xcd_barrier_complete(unsigned* bar, unsigned x, unsigned& nloc, unsigned& nx) {
    const unsigned G = gridDim.x * gridDim.y * gridDim.z;
    unsigned sum, cnt, mine, sp = 0u;
    for (;;) {
        sum = 0u; cnt = 0u; mine = 0u;
#pragma unroll
        for (unsigned j = 0; j < 16; ++j) { const unsigned c = xb_ld(&bar[XB_XCNT(j)]); sum += c; cnt += (c > 0u) ? 1u : 0u; mine = (j == x) ? c : mine; }
        if (sum == G) break;
        __builtin_amdgcn_s_sleep(1);
        if ((++sp & 255u) == 0u) { if (xb_ld(&bar[XB_TMO])) break; if (sp > XB_SPIN_CAP) { atomicAdd(&bar[XB_TMO], 1u); break; } }
    }
    nloc = mine > 0u ? mine : 1u; nx = cnt > 0u ? cnt : 1u;
}
DI void xcd_barrier(const XcdBarrier& b) {
    asm volatile("s_waitcnt vmcnt(0)" ::: "memory");
    __syncthreads();
    if (threadIdx.x == 0) {
        unsigned* bar = b.bar;
        __builtin_amdgcn_s_waitcnt(0);
        unsigned nloc = b.st[0], nx = b.st[1];
        if (nloc == 0u) { xcd_barrier_complete(bar, b.x, nloc, nx); b.st[0] = nloc; b.st[1] = nx; }
        const unsigned old = xb_add(&bar[XB_XSUB(b.x)], 1u);
        const unsigned gen = old / nloc;
        if (old + 1u == (gen + 1u) * nloc) {
            __builtin_amdgcn_fence(__ATOMIC_RELEASE, "agent");
            asm volatile("s_waitcnt vmcnt(0)" ::: "memory");
            const unsigned og = xb_add(&bar[XB_TOP], 1u);
            const unsigned tg = og / nx;
            if (og + 1u == (tg + 1u) * nx) xb_add(&bar[XB_TOPGEN], 1u);
            else XB_SPIN(xb_ld(&bar[XB_TOPGEN]) == tg, bar);
            __builtin_amdgcn_fence(__ATOMIC_ACQUIRE, "agent");
            xb_add(&bar[XB_XGEN(b.x)], 1u);
            asm volatile("s_waitcnt vmcnt(0)" ::: "memory");
        } else {
            XB_SPIN(xb_ld(&bar[XB_XGEN(b.x)]) == gen, bar);
            __builtin_amdgcn_fence(__ATOMIC_ACQUIRE, "agent");
            asm volatile("s_waitcnt vmcnt(0)" ::: "memory");
        }
    }
    __syncthreads();
}

constexpr int NWAVES = 8, NTHR = NWAVES * 64;
constexpr int RING_BYTES = 131072, LDS_BYTES = 147456, LDSCTL_OFF = LDS_BYTES - 1024, MISC_OFF = LDSCTL_OFF + 320;
constexpr size_t CTL_BYTES = 65536;
enum { PH_ALL = 0, PH_PRO = 11, PH_PROJ = 1, PH_ATTN = 2, PH_HGPRE = 3, PH_HGMAIN = 4, PH_WIDEN = 5, PH_WOUT = 6, PH_LN1 = 7, PH_PQ = 8, PH_ROUTE = 9, PH_EXPERTS = 10, PH_HGSCAN = 12 };
struct Args { const float* in[18]; float* out; unsigned char* ws; int ph, pass; };

struct Bufs {
    const bf16_t *WIN, *XBp; bf16_t *QK, *VIT, *HFQG, *MQ, *GATE;
};

struct SchedP1 {
    unsigned XBp, W; int G, c;
    DI bool next(int i, g8::Unit& u) const {
        const int L = i * G + c; if (L >= 2560) return false;
        if (L < 2048) { const int x = L & 7, off = L >> 3; u.pm = 8 * x + (off & 7); u.pn = off >> 3; u.kind = 0; u.dlb = 1;
            const int hp = u.pn < 12 ? (u.pn < 6 ? u.pn : u.pn - 6) : 0, dl = hp < 2 ? 1 : (hp < 4 ? 4 : 16);
            const int v0 = u.pm * 256, lb = v0 / S, vv = v0 % S, per = S / dl, r = vv / per, m0 = vv % per;
            u.dla = dl; u.a = XBp + (unsigned)(lb * S + m0 * dl + r) * D * 2u; u.b = W + (unsigned)u.pn * 256u * D * 2u; }
        else { const int idx = L - 2048; u.pm = idx & 7; u.pn = idx >> 3; u.kind = 1;
            const int dl = u.pm < 2 ? 1 : (u.pm < 4 ? 4 : (u.pm < 6 ? 16 : 1));
            const int v0 = u.pn * 256, lb = v0 / S, vv = v0 % S, per = S / dl, r = vv / per, m0 = vv % per;
            u.dla = 1; u.dlb = dl; u.a = W + (unsigned)(8192 + u.pm * 256) * D * 2u; u.b = XBp + (unsigned)(lb * S + m0 * dl + r) * D * 2u; }
        return true;
    }
};
DI int frag_row_off(int d0, int r32) { return (((d0 >> 4) * 64 + ((d0 >> 3) & 1) * 32 + r32) * 8); }
struct EpiP1 {
    static constexpr bool PERM = true, HOOK = false;
    char* pr; const float* b_gate;
    DI void hook(f32x4 (&)[2][2][4][2], const g8::Unit&, int, int, int, int, int) const {}
    DI void operator()(const f32x4 (&acc)[2][2][4][2], const g8::Unit& u, int wr, int wc, int fr, int fq) const {
        const int rowl = wr * 64 + fr, d0 = wc * 32 + 8 * fq;
        if (u.kind == 1) {
#pragma unroll
            for (int ai = 0; ai < 2; ++ai)
#pragma unroll
                for (int m = 0; m < 4; ++m) { const int R = u.pm * 256 + rowl + ai * 128 + m * 16;
#pragma unroll
                    for (int bj = 0; bj < 2; ++bj) { const f32x4 v0 = acc[ai][bj][m][0], v1 = acc[ai][bj][m][1];
                        const int c = u.pn * 256 + bj * 128 + d0;
                        if (R < 1536) {
                            const int gh = R >> 7, d = R & 127, lb = c >> 13, pos = c & (S - 1), kk = pos & 31;
                            bf16_t* blk = (bf16_t*)(pr + P_VT) + ((size_t)((lb * 12 + gh) * 256 + (pos >> 5))) * 4096 + (((d >> 5) * 2 + (kk >> 4)) * 64 + (d & 31)) * 8 + 4 * ((kk >> 3) & 1);
                            u32x2 wa, wb; wa.x = cvtpk(v0[0], v0[1]); wa.y = cvtpk(v0[2], v0[3]); wb.x = cvtpk(v1[0], v1[1]); wb.y = cvtpk(v1[2], v1[3]);
                            *(u32x2*)blk = wa; *(u32x2*)(blk + 32 * 8) = wb;
                        } else {
                            u32x4 w; w.x = cvtpk(v0[0], v0[1]); w.y = cvtpk(v0[2], v0[3]); w.z = cvtpk(v1[0], v1[1]); w.w = cvtpk(v1[2], v1[3]);
                            *(u32x4*)((bf16_t*)(pr + P_IT) + (size_t)(R - 1536) * MP + c) = w;
                        } } }
            return;
        }
        if (u.pn < 12 || u.pn == 18 || u.pn == 19) {
#pragma unroll
            for (int ai = 0; ai < 2; ++ai)
#pragma unroll
                for (int m = 0; m < 4; ++m) { const int row = u.pm * 256 + rowl + ai * 128 + m * 16;
#pragma unroll
                    for (int bj = 0; bj < 2; ++bj) { const f32x4 v0 = acc[ai][bj][m][0], v1 = acc[ai][bj][m][1];
                        u32x4 w; w.x = cvtpk(v0[0], v0[1]); w.y = cvtpk(v0[2], v0[3]); w.z = cvtpk(v1[0], v1[1]); w.w = cvtpk(v1[2], v1[3]);
                        bf16_t* dst;
                        if (u.pn < 12) { const int hh = u.pn * 2 + bj, qk = hh >= 12 ? 1 : 0, gh = hh - 12 * qk;
                            const int lb = row >> 13, pos = row & (S - 1);
                            dst = (bf16_t*)(pr + P_QK) + ((size_t)(((qk * BPP + lb) * 12 + gh) * 256 + (pos >> 5))) * 4096 + frag_row_off(d0, pos & 31); }
                        else { const int h = (u.pn - 18) * 2 + bj; dst = (bf16_t*)(pr + P_MQ) + ((size_t)((row >> 5) * 4 + h)) * 4096 + frag_row_off(d0, row & 31); }
                        *(u32x4*)dst = w; } }
            return;
        }
        bf16_t* base; int ldc, colt; bool gate = false;
        if (u.pn < 18) { base = (bf16_t*)(pr + P_HFQG); ldc = 1536; colt = (u.pn - 12) * 256; }
        else { base = (bf16_t*)(pr + P_GATE); ldc = 3072; colt = (u.pn - 20) * 256; gate = true; }
        const int row0 = u.pm * 256 + rowl, col0 = colt + d0;
        f32x4 bv[2][2];
#pragma unroll
        for (int bj = 0; bj < 2; ++bj)
#pragma unroll
            for (int n = 0; n < 2; ++n) bv[bj][n] = gate ? *(const f32x4*)(b_gate + col0 + bj * 128 + 4 * n) : (f32x4){0.f, 0.f, 0.f, 0.f};
#pragma unroll
        for (int ai = 0; ai < 2; ++ai)
#pragma unroll
            for (int m = 0; m < 4; ++m) { bf16_t* rowp = base + (size_t)(row0 + ai * 128 + m * 16) * ldc + col0;
#pragma unroll
                for (int bj = 0; bj < 2; ++bj) { f32x4 v0 = acc[ai][bj][m][0], v1 = acc[ai][bj][m][1];
                    if (gate) { v0 = v0 + bv[bj][0]; v1 = v1 + bv[bj][1];
#pragma unroll
                        for (int e = 0; e < 4; ++e) { v0[e] = fast_sigmoid(v0[e]); v1[e] = fast_sigmoid(v1[e]); } }
                    u32x4 w; w.x = cvtpk(v0[0], v0[1]); w.y = cvtpk(v0[2], v0[3]); w.z = cvtpk(v1[0], v1[1]); w.w = cvtpk(v1[2], v1[3]);
                    *(u32x4*)(rowp + bj * 128) = w; } }
    }
};

typedef float f32x16 __attribute__((ext_vector_type(16)));
typedef short s16x4 __attribute__((ext_vector_type(4)));
DI int crow(int r, int hi) { return (r & 3) + 8 * (r >> 2) + 4 * hi; }
DI float xor32f(float v) { return __shfl_xor(v, 32); }
#define MFMA32(a, b, c) __builtin_amdgcn_mfma_f32_32x32x16_bf16((a), (b), (c), 0, 0, 0)
DI bf16x8 pack8(const f32x16& p, int s) {
    u32x4 w; w.x = cvtpk(p[8 * s + 0], p[8 * s + 1]); w.y = cvtpk(p[8 * s + 2], p[8 * s + 3]); w.z = cvtpk(p[8 * s + 4], p[8 * s + 5]); w.w = cvtpk(p[8 * s + 6], p[8 * s + 7]);
    return __builtin_bit_cast(bf16x8, w);
}
DI bf16x8 ldvt(const bf16_t* vp) {
    const s16x4 lo = *(const s16x4*)vp, hi4 = *(const s16x4*)(vp + 8);
    return __builtin_shufflevector(lo, hi4, 0, 1, 2, 3, 4, 5, 6, 7);
}
constexpr int DIL_TASKS = BPP * 12 * (S / 32);
constexpr int MEM_TASKS = (MP / 32) * 4;
DI void attn_dil_wave(const bf16_t* __restrict__ QK, const bf16_t* __restrict__ VT, const LAS float* btab, bf16_t* __restrict__ OG, float* __restrict__ LSE, int task, int lane) {
    const int r32 = lane & 31, hi = lane >> 5;
    const int q32 = task & 255, gh = (task >> 8) % 12, lb = task / (256 * 12);
    const int g = gh >> 2, h = gh & 3, dl = dil_of(g), per = S / dl;
    const int tok0 = q32 * 32, r = tok0 / per, m0 = tok0 % per;
    const size_t rowq = (size_t)lb * S + (size_t)(m0 + r32) * dl + r;
    bf16x8 qf[8];
    const int tile0 = (r * per + m0) >> 5;
    { const bf16_t* qp = QK + ((size_t)((lb * 12 + gh) * 256 + tile0)) * 4096 + lane * 8;
#pragma unroll
      for (int ks = 0; ks < 8; ++ks) qf[ks] = *(const bf16x8*)(qp + ks * 512); }
    const LAS float* bt = btab + g * 129 * 4 + h;
    f32x16 o[4];
#pragma unroll
    for (int dt = 0; dt < 4; ++dt)
#pragma unroll
        for (int i = 0; i < 16; ++i) o[dt][i] = 0.f;
    float mrun = -INFINITY, sum = 0.f;
    const bf16_t* vbase = VT + ((size_t)((lb * 12 + gh) * 256 + tile0 - 4)) * 4096 + lane * 8;
    const bf16_t* kbase = QK + ((size_t)(((BPP + lb) * 12 + gh) * 256 + tile0 - 4)) * 4096 + lane * 8;
    const int kt0 = (m0 >= 128 ? 0 : (128 - m0) >> 5);
    bf16x8 kf[8], vf[8];
#pragma unroll
    for (int ks = 0; ks < 8; ++ks) kf[ks] = *(const bf16x8*)(kbase + (size_t)kt0 * 4096 + ks * 512);
#pragma unroll 1
    for (int kt = kt0; kt < 5; ++kt) {
#pragma unroll
        for (int i = 0; i < 8; ++i) vf[i] = *(const bf16x8*)(vbase + (size_t)kt * 4096 + i * 512);
        f32x16 sc;
#pragma unroll
        for (int i = 0; i < 16; ++i) sc[i] = 0.f;
#pragma unroll
        for (int ks = 0; ks < 8; ++ks) sc = MFMA32(kf[ks], qf[ks], sc);
        if (kt < 4) {
#pragma unroll
            for (int ks = 0; ks < 8; ++ks) kf[ks] = *(const bf16x8*)(kbase + (size_t)(kt + 1) * 4096 + ks * 512);
        }
        float mx = -INFINITY;
        if (kt == 0 || kt == 4) {
#pragma unroll
            for (int i = 0; i < 16; ++i) {
                const int delta = 128 - 32 * kt + r32 - crow(i, hi);
                const bool valid = (delta >= 0) && (delta <= 128);
                const int di = delta < 0 ? 0 : (delta > 128 ? 128 : delta);
                const float x = sc[i] * (QSCALE * LOG2E) + bt[di * 4];
                sc[i] = valid ? x : -INFINITY; mx = fmaxf(mx, sc[i]);
            }
        } else {
            const LAS float* btk = bt + (128 - 32 * kt + r32 - 4 * hi) * 4;
#pragma unroll
            for (int i = 0; i < 16; ++i) { sc[i] = sc[i] * (QSCALE * LOG2E) + btk[-4 * ((i & 3) + 8 * (i >> 2))]; mx = fmaxf(mx, sc[i]); }
        }
        mx = pair_max(mx);
        const float mnew = fmaxf(mrun, mx); const float f = __builtin_amdgcn_exp2f(mrun - mnew);
        sum *= f;
#pragma unroll
        for (int dt = 0; dt < 4; ++dt)
#pragma unroll
            for (int i = 0; i < 16; ++i) o[dt][i] *= f;
        mrun = mnew;
        float ps = 0.f;
#pragma unroll
        for (int i = 0; i < 16; ++i) { sc[i] = __builtin_amdgcn_exp2f(sc[i] - mnew); ps += sc[i]; }
        ps = pair_sum(ps); sum += ps;
#pragma unroll
        for (int s = 0; s < 2; ++s) {
            const bf16x8 pb = pack8(sc, s);
#pragma unroll
            for (int dt = 0; dt < 4; ++dt) o[dt] = MFMA32(vf[dt * 2 + s], pb, o[dt]);
        }
    }
    const float inv = 1.f / sum;
    bf16_t* op = OG + rowq * 1536 + g * 512 + h * 128 + 4 * hi;
#pragma unroll
    for (int dt = 0; dt < 4; ++dt)
#pragma unroll
        for (int a = 0; a < 4; ++a) { u32x2 w; w.x = cvtpk(o[dt][4 * a] * inv, o[dt][4 * a + 1] * inv); w.y = cvtpk(o[dt][4 * a + 2] * inv, o[dt][4 * a + 3] * inv); *(u32x2*)(op + 32 * dt + 8 * a) = w; }
    if (hi == 0) LSE[rowq * 12 + gh] = (mrun + __builtin_amdgcn_logf(sum)) * 0.6931471805599453f;
}
DI void attn_mem_wave(const bf16_t* __restrict__ MQ, const bf16_t* __restrict__ MK, const bf16_t* __restrict__ MVT, bf16_t* __restrict__ BR, int task, int batch0, int lane) {
    const int r32 = lane & 31, hi = lane >> 5;
    const int h = task & 3, blk = task >> 2;
    const size_t rowq = (size_t)blk * 32 + r32; const int b = batch0 + blk * 32 / S;
    bf16x8 qf[8];
    { const bf16_t* qp = MQ + ((size_t)(blk * 4 + h)) * 4096 + lane * 8;
#pragma unroll
      for (int ks = 0; ks < 8; ++ks) qf[ks] = *(const bf16x8*)(qp + ks * 512); }
    f32x16 o[4];
#pragma unroll
    for (int dt = 0; dt < 4; ++dt)
#pragma unroll
        for (int i = 0; i < 16; ++i) o[dt][i] = 0.f;
    float mrun = -INFINITY, sum = 0.f;
    const bf16_t* vbase = MVT + ((size_t)((b * 4 + h) * 8)) * 4096 + lane * 8;
    const bf16_t* kbase = MK + ((size_t)((b * 4 + h) * 8)) * 4096 + lane * 8;
#pragma unroll 1
    for (int c = 0; c < 4; ++c) {
        bf16x8 vf[16];
#pragma unroll
        for (int i = 0; i < 16; ++i) vf[i] = *(const bf16x8*)(vbase + (size_t)(c * 2 + (i >> 3)) * 4096 + (i & 7) * 512);
        f32x16 sc[2]; float mx = -INFINITY;
#pragma unroll
        for (int kt = 0; kt < 2; ++kt) {
            const bf16_t* kp = kbase + (size_t)(c * 2 + kt) * 4096;
            f32x16 acc;
#pragma unroll
            for (int i = 0; i < 16; ++i) acc[i] = 0.f;
#pragma unroll
            for (int ks = 0; ks < 8; ++ks) { const bf16x8 kf = *(const bf16x8*)(kp + ks * 512); acc = MFMA32(kf, qf[ks], acc); }
#pragma unroll
            for (int i = 0; i < 16; ++i) { sc[kt][i] = acc[i] * (QSCALE * LOG2E); mx = fmaxf(mx, sc[kt][i]); }
            asm volatile("" ::: "memory");
        }
        mx = pair_max(mx);
        const float mnew = fmaxf(mrun, mx); const float f = __builtin_amdgcn_exp2f(mrun - mnew);
        sum *= f;
#pragma unroll
        for (int dt = 0; dt < 4; ++dt)
#pragma unroll
            for (int i = 0; i < 16; ++i) o[dt][i] *= f;
        mrun = mnew;
        float ps = 0.f;
#pragma unroll
        for (int kt = 0; kt < 2; ++kt)
#pragma unroll
            for (int i = 0; i < 16; ++i) { sc[kt][i] = __builtin_amdgcn_exp2f(sc[kt][i] - mnew); ps += sc[kt][i]; }
        ps = pair_sum(ps); sum += ps;
#pragma unroll
        for (int kt = 0; kt < 2; ++kt)
#pragma unroll
            for (int s = 0; s < 2; ++s) {
                const bf16x8 pb = pack8(sc[kt], s);
#pragma unroll
                for (int dt = 0; dt < 4; ++dt) o[dt] = MFMA32(vf[kt * 8 + dt * 2 + s], pb, o[dt]);
                asm volatile("" ::: "memory");
            }
    }
    const float inv = 1.f / sum;
    bf16_t* op = BR + rowq * 1536 + 1024 + h * 128 + 4 * hi;
#pragma unroll
    for (int dt = 0; dt < 4; ++dt)
#pragma unroll
        for (int a = 0; a < 4; ++a) { u32x2 w; w.x = cvtpk(o[dt][4 * a] * inv, o[dt][4 * a + 1] * inv); w.y = cvtpk(o[dt][4 * a + 2] * inv, o[dt][4 * a + 3] * inv); *(u32x2*)(op + 32 * dt + 8 * a) = w; }
}

constexpr int HG_SCH = 4, HG_UPS = S / 64 / HG_SCH  , HG_UNITS = BPP * 4 * HG_UPS  ;
constexpr int HG_ROW = 136, HG_KT_ROW = 72;
constexpr int HG_KP = 0, HG_QP = 64 * HG_ROW * 2, HG_QPP = 2 * HG_QP, HG_KPPT = 3 * HG_QP, HG_DEC = HG_KPPT + 128 * HG_KT_ROW * 2, HG_SSQ = HG_DEC + 512, HG_PSUM = HG_SSQ + 1024, HG_UNIT_BYTES = HG_PSUM + 2048;
DI bf16x8 lds_ld2x8(const LAS unsigned char* p) {
    const s16x4 lo = *(const LAS s16x4*)p, hi4 = *(const LAS s16x4*)(p + 16);
    return __builtin_shufflevector(lo, hi4, 0, 1, 2, 3, 4, 5, 6, 7);
}
DI int opq(int x) { asm volatile("" : "+v"(x)); return x; }
DI float lds_bf(const LAS unsigned char* p) { return __uint_as_float((unsigned)(*(const LAS unsigned short*)p) << 16); }
template <bool MAIN>
DI void hgrn_unit(LAS unsigned char* ul, int unit, int u, const bf16_t* __restrict__ HFQG, const bf16_t* __restrict__ IT, const float* __restrict__ lbv, const float* __restrict__ nwv,
                  float* HSTL, float* HSTD, const float* __restrict__ SIN, bf16_t* __restrict__ BR) {
    constexpr int NX = MAIN ? 4 : 2;
    const int lane = u & 63, w = u >> 6, r32 = lane & 31, hi = lane >> 5, dvt = w & 3, wh = w >> 2;
    const int seq = unit / HG_UPS, j = unit % HG_UPS, lb = seq >> 2, h = seq & 3;
    const int dk = u & 127, qt = u >> 7, cb = 16 * qt;
    const float lbd = lbv[h * 128 + dk];
    const size_t row0 = (size_t)lb * S + (size_t)j * (64 * HG_SCH);
    LAS unsigned char* Kp = ul + HG_KP; LAS unsigned char* Qp = ul + HG_QP; LAS unsigned char* Qpp = ul + HG_QPP; LAS unsigned char* KppT = ul + HG_KPPT;
    LAS float* dec = (LAS float*)(ul + HG_DEC); LAS float* ssq = (LAS float*)(ul + HG_SSQ); LAS float* psum = (LAS float*)(ul + HG_PSUM);
    const int dk0 = MAIN ? 0 : 64 * wh;
    f32x16 X[NX];
    if (MAIN) {
        const float* Sp = SIN + (size_t)unit * 16384 + 32 * dvt + r32;
#pragma unroll
        for (int t = 0; t < NX; ++t)
#pragma unroll
            for (int i = 0; i < 16; ++i) X[t][i] = Sp[(size_t)(32 * t + crow(i, hi)) * 128];
    } else {
#pragma unroll
        for (int t = 0; t < NX; ++t)
#pragma unroll
            for (int i = 0; i < 16; ++i) X[t][i] = 0.f;
    }
    float atot = 0.f;
    u32x4 sf[2], sq[2];
    {
        const int sc0 = u >> 4, sch = (u & 15) * 8;
        const bf16_t* fp = HFQG + (row0 + sc0) * 1536 + h * 128 + sch;
#pragma unroll
        for (int i = 0; i < 2; ++i) { sf[i] = *(const u32x4*)(fp + (size_t)(32 * i) * 1536); if (MAIN) sq[i] = *(const u32x4*)(fp + (size_t)(32 * i) * 1536 + 512); }
    }
#pragma unroll 1
    for (int ch = 0; ch < HG_SCH; ++ch) {
        const size_t rc = row0 + (size_t)ch * 64;
        {
            const int sc0 = opq(u) >> 4, sch = (opq(u) & 15) * 8;
#pragma unroll
            for (int i = 0; i < 2; ++i) { *(LAS u32x4*)(Kp + ((sc0 + 32 * i) * HG_ROW + sch) * 2) = sf[i]; if (MAIN) *(LAS u32x4*)(Qp + ((sc0 + 32 * i) * HG_ROW + sch) * 2) = sq[i]; }
        }
        __syncthreads();
        float fv[16], lf[16];
        {
            float s = 0.f;
#pragma unroll
            for (int i = 0; i < 16; ++i) { fv[i] = lbd + (1.f - lbd) * fast_sigmoid(lds_bf(Kp + ((cb + i) * HG_ROW + dk) * 2)); lf[i] = __builtin_amdgcn_logf(fv[i]); s += lf[i]; }
            psum[qt * 128 + dk] = s;
        }
        __syncthreads();
        {
            const float p0 = psum[dk], p1 = psum[128 + dk], p2 = psum[256 + dk], p3 = psum[384 + dk];
            const float amid = p0 + p1, alast = (p0 + p1) + (p2 + p3);
            float run = qt == 0 ? 0.f : (qt == 1 ? p0 : (qt == 2 ? amid : amid + p2));
            atot += alast;
            const float Ela = __builtin_amdgcn_exp2f(alast - amid), Ea = __builtin_amdgcn_exp2f(amid);
#pragma unroll
            for (int c8 = 0; c8 < 2; ++c8) {
                float kt[8];
#pragma unroll
                for (int e = 0; e < 8; ++e) { const int i = 8 * c8 + e, c = cb + i; run += lf[i]; const float key = 1.f - fv[i];
                    const float e1 = __builtin_amdgcn_exp2f(amid - run);
                    const float kp = key * e1;
                    kt[e] = kp * Ela;
                    if (MAIN) { *(LAS bf16_t*)(Kp + (c * HG_ROW + dk) * 2) = f2bf(kp);
                        const float qp = lds_bf(Qp + (c * HG_ROW + dk) * 2) * __builtin_amdgcn_rcpf(e1);
                        *(LAS bf16_t*)(Qp + (c * HG_ROW + dk) * 2) = f2bf(qp);
                        *(LAS bf16_t*)(Qpp + (c * HG_ROW + dk) * 2) = f2bf(qp * Ea); } }
                u32x4 wv; wv.x = cvtpk(kt[0], kt[1]); wv.y = cvtpk(kt[2], kt[3]); wv.z = cvtpk(kt[4], kt[5]); wv.w = cvtpk(kt[6], kt[7]);
                *(LAS u32x4*)(KppT + (dk * HG_KT_ROW + cb + 8 * c8) * 2) = wv;
            }
            if (qt == 0) dec[dk] = __builtin_amdgcn_exp2f(alast);
        }
        if (ch + 1 < HG_SCH) {
            const int sc0 = opq(u) >> 4, sch = (opq(u) & 15) * 8;
            const bf16_t* fp = HFQG + (rc + 64 + sc0) * 1536 + h * 128 + sch;
#pragma unroll
            for (int i = 0; i < 2; ++i) { sf[i] = *(const u32x4*)(fp + (size_t)(32 * i) * 1536); if (MAIN) sq[i] = *(const u32x4*)(fp + (size_t)(32 * i) * 1536 + 512); }
        }
        __syncthreads();
        f32x16 o;
        const bf16_t* itrow = IT + (size_t)(h * 128 + 32 * dvt + opq(r32)) * MP;
        if (MAIN) {
#pragma unroll
            for (int i = 0; i < 16; ++i) o[i] = 0.f;
            const LAS unsigned char* qrow = Qpp + ((32 * wh + r32) * HG_ROW) * 2;
#pragma unroll
            for (int t = 0; t < 4; ++t)
#pragma unroll
                for (int step = 0; step < 2; ++step) { o = MFMA32(pack8(X[t], step), lds_ld2x8(qrow + (32 * t + 16 * step + 4 * hi) * 2), o); }
            __builtin_amdgcn_sched_barrier(0);
            const int r32m = opq(r32);
            const LAS unsigned char* qprow = Qp + ((32 * wh + r32) * HG_ROW) * 2;
            {
                f32x16 sc;
#pragma unroll
                for (int i = 0; i < 16; ++i) sc[i] = 0.f;
#pragma unroll
                for (int ks = 0; ks < 8; ++ks) { const int cof = (16 * ks + 8 * hi) * 2; sc = MFMA32(*(const LAS bf16x8*)(Kp + (r32 * HG_ROW) * 2 + cof), *(const LAS bf16x8*)(qprow + cof), sc); }
                if (wh == 0) {
#pragma unroll
                    for (int i = 0; i < 16; ++i) sc[i] = (crow(i, hi) <= r32m) ? sc[i] : 0.f;
                }
#pragma unroll
                for (int step = 0; step < 2; ++step) o = MFMA32(ldvt(itrow + rc + 16 * step + 4 * hi), pack8(sc, step), o);
                __builtin_amdgcn_sched_barrier(0);
            }
            if (wh == 1) {
                f32x16 sc;
#pragma unroll
                for (int i = 0; i < 16; ++i) sc[i] = 0.f;
#pragma unroll
                for (int ks = 0; ks < 8; ++ks) { const int cof = (16 * ks + 8 * hi) * 2; sc = MFMA32(*(const LAS bf16x8*)(Kp + ((32 + r32) * HG_ROW) * 2 + cof), *(const LAS bf16x8*)(qprow + cof), sc); }
#pragma unroll
                for (int i = 0; i < 16; ++i) sc[i] = (crow(i, hi) <= r32m) ? sc[i] : 0.f;
#pragma unroll
                for (int step = 0; step < 2; ++step) o = MFMA32(ldvt(itrow + rc + 32 + 16 * step + 4 * hi), pack8(sc, step), o);
                __builtin_amdgcn_sched_barrier(0);
            }
        }
        {
            bf16x8 ib[4];
#pragma unroll
            for (int ks = 0; ks < 4; ++ks) ib[ks] = *(const bf16x8*)(itrow + rc + 16 * ks + 8 * hi);
#pragma unroll
            for (int t = 0; t < NX; ++t) {
#pragma unroll
                for (int i = 0; i < 16; ++i) X[t][i] *= dec[dk0 + 32 * t + crow(i, hi)];
#pragma unroll
                for (int ks = 0; ks < 4; ++ks) { const bf16x8 ka = *(const LAS bf16x8*)(KppT + ((dk0 + 32 * t + r32) * HG_KT_ROW + 16 * ks + 8 * hi) * 2); X[t] = MFMA32(ka, ib[ks], X[t]); }
                __builtin_amdgcn_sched_barrier(0);
            }
        }
        if (MAIN) {
            float q2 = 0.f;
#pragma unroll
            for (int i = 0; i < 16; ++i) q2 += o[i] * o[i];
            q2 = pair_sum(q2); if (hi == 0) ssq[dvt * 64 + 32 * wh + r32] = q2;
        }
        __syncthreads();
        if (MAIN) {
            const int r32o = opq(r32), hio = opq(hi);
            const int c = 32 * wh + r32o; const float tot = ssq[c] + ssq[64 + c] + ssq[128 + c] + ssq[192 + c];
            const float rs = rsqrtf(tot * (1.f / 128.f) + LN_EPS);
            const size_t row = rc + c; const int col = h * 128 + 32 * dvt + 4 * hio;
#pragma unroll
            for (int a4 = 0; a4 < 4; ++a4) {
                const u32x2 gw = *(const u32x2*)(HFQG + row * 1536 + 1024 + col + 8 * a4); const f32x4 nw4 = *(const f32x4*)(nwv + col + 8 * a4);
                const float g0 = __uint_as_float(gw.x << 16), g1 = __uint_as_float(gw.x & 0xffff0000u), g2 = __uint_as_float(gw.y << 16), g3 = __uint_as_float(gw.y & 0xffff0000u);
                const float v0 = o[4 * a4] * rs * nw4[0] * g0 * fast_sigmoid(g0), v1 = o[4 * a4 + 1] * rs * nw4[1] * g1 * fast_sigmoid(g1);
                const float v2 = o[4 * a4 + 2] * rs * nw4[2] * g2 * fast_sigmoid(g2), v3 = o[4 * a4 + 3] * rs * nw4[3] * g3 * fast_sigmoid(g3);
                u32x2 wv; wv.x = cvtpk(v0, v1); wv.y = cvtpk(v2, v3);
                *(u32x2*)(BR + row * 1536 + 512 + col + 8 * a4) = wv;
            }
        }
    }
    if (!MAIN) {
        float* L = HSTL + (size_t)unit * 16384 + 32 * dvt + r32;
#pragma unroll
        for (int t = 0; t < NX; ++t)
#pragma unroll
            for (int i = 0; i < 16; ++i) L[(size_t)(dk0 + 32 * t + crow(i, hi)) * 128] = X[t][i];
        if (qt == 0) HSTD[(size_t)unit * 128 + dk] = __builtin_amdgcn_exp2f(atot);
    }
}
DI void hgrn_scan(const float* __restrict__ HSTL, const float* __restrict__ HSTD, float* __restrict__ SIN, int gt) {
    if (gt >= BPP * 4 * 16384) return;
    const int seq = gt >> 14, el = gt & 16383, dkk = el >> 7;
    float st = 0.f;
    for (int j = 0; j < HG_UPS; ++j) { const size_t uo = (size_t)(seq * HG_UPS + j); SIN[uo * 16384 + el] = st; st = HSTD[uo * 128 + dkk] * st + HSTL[uo * 16384 + el]; }
}

struct SchedRows {
    unsigned A, B; int K, nN, nU, G, c;
    DI bool next(int i, g8::Unit& u) const {
        const int L = i * G + c; if (L >= nU) return false;
        const int x = L & 7, off = L >> 3, grp = off / (8 * nN), o2 = off % (8 * nN);
        const int ppx = nU / nN / 8;
        u.pm = x * ppx + 8 * grp + (o2 & 7); u.pn = o2 >> 3; u.kind = 0; u.dla = 1; u.dlb = 1;
        u.a = A + (unsigned)u.pm * 256u * K * 2u; u.b = B + (unsigned)u.pn * 256u * K * 2u; return true;
    }
};
DI void unpack8(const u32x4 w, float (&f)[8]) {
    f[0] = __uint_as_float(w.x << 16); f[1] = __uint_as_float(w.x & 0xffff0000u); f[2] = __uint_as_float(w.y << 16); f[3] = __uint_as_float(w.y & 0xffff0000u);
    f[4] = __uint_as_float(w.z << 16); f[5] = __uint_as_float(w.z & 0xffff0000u); f[6] = __uint_as_float(w.w << 16); f[7] = __uint_as_float(w.w & 0xffff0000u);
}
struct EpiWidenF {
    static constexpr bool PERM = true, HOOK = true;
    const bf16_t* GATE; bf16_t* MERGED;
    DI void hook(f32x4 (&acc)[2][2][4][2], const g8::Unit& u, int t, int wr, int wc, int fr, int fq) const {
        if (t != 8 && t != 16) return;
        const int g = (t >> 3) - 1;
        const int row0 = u.pm * 256 + wr * 64 + fr, col0 = u.pn * 256 + wc * 32 + 8 * fq;
#pragma unroll
        for (int ai = 0; ai < 2; ++ai)
#pragma unroll
            for (int m = 0; m < 4; ++m) { const bf16_t* gp = GATE + (size_t)(row0 + ai * 128 + m * 16) * 3072 + g * 1024 + col0;
#pragma unroll
                for (int bj = 0; bj < 2; ++bj) { float ga[8], gb[8]; unpack8(*(const u32x4*)(gp + bj * 128), ga); unpack8(*(const u32x4*)(gp + 1024 + bj * 128), gb);
#pragma unroll
                    for (int e = 0; e < 4; ++e) { acc[ai][bj][m][0][e] *= ga[e] * __builtin_amdgcn_rcpf(gb[e]); acc[ai][bj][m][1][e] *= ga[4 + e] * __builtin_amdgcn_rcpf(gb[4 + e]); } } }
    }
    DI void operator()(const f32x4 (&acc)[2][2][4][2], const g8::Unit& u, int wr, int wc, int fr, int fq) const {
        const int row0 = u.pm * 256 + wr * 64 + fr, col0 = u.pn * 256 + wc * 32 + 8 * fq;
#pragma unroll
        for (int ai = 0; ai < 2; ++ai)
#pragma unroll
            for (int m = 0; m < 4; ++m) { const size_t row = (size_t)(row0 + ai * 128 + m * 16);
#pragma unroll
                for (int bj = 0; bj < 2; ++bj) { float gc[8]; unpack8(*(const u32x4*)(GATE + row * 3072 + 2048 + col0 + bj * 128), gc);
                    const f32x4 v0 = acc[ai][bj][m][0], v1 = acc[ai][bj][m][1];
                    u32x4 w; w.x = cvtpk(v0[0] * gc[0], v0[1] * gc[1]); w.y = cvtpk(v0[2] * gc[2], v0[3] * gc[3]); w.z = cvtpk(v1[0] * gc[4], v1[1] * gc[5]); w.w = cvtpk(v1[2] * gc[6], v1[3] * gc[7]);
                    *(u32x4*)(MERGED + row * 1024 + col0 + bj * 128) = w; } }
    }
};
struct EpiPlainB16 {
    static constexpr bool PERM = true, HOOK = false;
    bf16_t* C; int ldc, pad;
    DI void hook(f32x4 (&)[2][2][4][2], const g8::Unit&, int, int, int, int, int) const {}
    DI void operator()(const f32x4 (&acc)[2][2][4][2], const g8::Unit& u, int wr, int wc, int fr, int fq) const {
        const int row0 = u.pm * 256 + wr * 64 + fr, col0 = u.pn * 256 + wc * 32 + 8 * fq;
#pragma unroll
        for (int ai = 0; ai < 2; ++ai)
#pragma unroll
            for (int m = 0; m < 4; ++m) { bf16_t* rowp = C + (size_t)(row0 + ai * 128 + m * 16) * ldc + col0;
#pragma unroll
                for (int bj = 0; bj < 2; ++bj) { const f32x4 v0 = acc[ai][bj][m][0], v1 = acc[ai][bj][m][1];
                    u32x4 w; w.x = cvtpk(v0[0], v0[1]); w.y = cvtpk(v0[2], v0[3]); w.z = cvtpk(v1[0], v1[1]); w.w = cvtpk(v1[2], v1[3]);
                    *(u32x4*)(rowp + bj * 128) = w; } }
    }
};
DI void lse_merge_items(const bf16_t* __restrict__ OG, const float* __restrict__ LSE, bf16_t* __restrict__ BR, int first, int stride) {
    for (int it = first; it < MP * 64; it += stride) {
        const int row = it >> 6, c8 = it & 63, h = c8 >> 4;
        const float l0 = LSE[(size_t)row * 12 + h], l1 = LSE[(size_t)row * 12 + 4 + h], l2 = LSE[(size_t)row * 12 + 8 + h];
        const float mx = fmaxf(l0, fmaxf(l1, l2)); const float e0 = __expf(l0 - mx), e1 = __expf(l1 - mx), e2 = __expf(l2 - mx); const float inv = 1.f / (e0 + e1 + e2);
        const bf16_t* og = OG + (size_t)row * 1536 + c8 * 8;
        float a[8], b[8], c[8]; unpack8(*(const u32x4*)og, a); unpack8(*(const u32x4*)(og + 512), b); unpack8(*(const u32x4*)(og + 1024), c);
        float r[8];
#pragma unroll
        for (int e = 0; e < 8; ++e) r[e] = (e0 * a[e] + e1 * b[e] + e2 * c[e]) * inv;
        u32x4 w; w.x = cvtpk(r[0], r[1]); w.y = cvtpk(r[2], r[3]); w.z = cvtpk(r[4], r[5]); w.w = cvtpk(r[6], r[7]);
        *(u32x4*)(BR + (size_t)row * 1536 + c8 * 8) = w;
    }
}
DI void ln1_rows(const float* __restrict__ x, const bf16_t* __restrict__ mix, const float* __restrict__ g, const float* __restrict__ b, bf16_t* __restrict__ h1b, unsigned char* __restrict__ h1q, float* __restrict__ hsc, int wave0, int nwaves, int lane) {
    for (int row = wave0; row < MP; row += nwaves) {
        const f32x4* xr = (const f32x4*)(x + (size_t)row * D + 16 * lane);
        const u32x4 ma = *(const u32x4*)(mix + (size_t)row * D + 16 * lane), mb = *(const u32x4*)(mix + (size_t)row * D + 16 * lane + 8);
        float mf[16]; unpack8(ma, *(float(*)[8])&mf[0]); unpack8(mb, *(float(*)[8])&mf[8]);
        f32x4 v[4]; float s = 0.f;
#pragma unroll
        for (int j = 0; j < 4; ++j) { v[j] = xr[j] * ALPHA;
#pragma unroll
            for (int e = 0; e < 4; ++e) { v[j][e] += mf[4 * j + e]; s += v[j][e]; } }
        const float mean = wave_sum(s) * (1.f / D); float q = 0.f;
#pragma unroll
        for (int j = 0; j < 4; ++j) { v[j] = v[j] - mean; q += (v[j][0] * v[j][0] + v[j][1] * v[j][1]) + (v[j][2] * v[j][2] + v[j][3] * v[j][3]); }
        const float rstd = rsqrtf(wave_sum(q) * (1.f / D) + LN_EPS);
        u32x4 o0, o1; float amax = 0.f;
#pragma unroll
        for (int j = 0; j < 4; ++j) { const f32x4 gg = *(const f32x4*)(g + 16 * lane + 4 * j), bb = *(const f32x4*)(b + 16 * lane + 4 * j); const f32x4 o = v[j] * rstd * gg + bb; v[j] = o;
            amax = fmaxf(amax, fmaxf(fmaxf(fabsf(o[0]), fabsf(o[1])), fmaxf(fabsf(o[2]), fabsf(o[3]))));
            if (j < 2) { o0[2 * j] = cvtpk(o[0], o[1]); o0[2 * j + 1] = cvtpk(o[2], o[3]); } else { o1[2 * (j - 2)] = cvtpk(o[0], o[1]); o1[2 * (j - 2) + 1] = cvtpk(o[2], o[3]); } }
        *(u32x4*)(h1b + (size_t)row * D + 16 * lane) = o0; *(u32x4*)(h1b + (size_t)row * D + 16 * lane + 8) = o1;
        amax = wave_max(amax); const float qs = amax > 0.f ? 127.f / amax : 1.f;
        u32x4 qv;
#pragma unroll
        for (int j = 0; j < 4; ++j) qv[j] = ((unsigned)__float2int_rn(v[j][0] * qs) & 0xffu) | (((unsigned)__float2int_rn(v[j][1] * qs) & 0xffu) << 8) | (((unsigned)__float2int_rn(v[j][2] * qs) & 0xffu) << 16) | (((unsigned)__float2int_rn(v[j][3] * qs) & 0xffu) << 24);
        *(u32x4*)(h1q + (size_t)row * D + 16 * lane) = qv;
        if (lane == 0) hsc[row] = amax > 0.f ? amax * (1.f / 127.f) : 1.f;
    }
}

DI unsigned mono(float f) { const unsigned u = __float_as_uint(f); return (u & 0x80000000u) ? ~u : (u | 0x80000000u); }
DI float demono(unsigned m) { return __uint_as_float((m & 0x80000000u) ? (m & 0x7fffffffu) : ~m); }
#define CE_DESC(a, b) do { const unsigned _hi = (a) > (b) ? (a) : (b), _lo = (a) > (b) ? (b) : (a); (a) = _hi; (b) = _lo; } while (0)
DI void sort16_desc(unsigned (&k)[16]) {
#pragma unroll
    for (int size = 2; size <= 16; size <<= 1)
#pragma unroll
        for (int stride = size >> 1; stride > 0; stride >>= 1)
#pragma unroll
            for (int i = 0; i < 16; ++i) { const int j = i ^ stride;
                if (j > i) { if ((i & size) == 0 || size == 16) CE_DESC(k[i], k[j]); else CE_DESC(k[j], k[i]); } }
}
DI void merge_top16(unsigned (&t)[16], const unsigned (&l)[16]) {
#pragma unroll
    for (int i = 0; i < 16; ++i) t[i] = t[i] > l[15 - i] ? t[i] : l[15 - i];
#pragma unroll
    for (int stride = 8; stride > 0; stride >>= 1)
#pragma unroll
        for (int i = 0; i < 16; ++i) { const int j = i ^ stride; if (j > i) CE_DESC(t[i], t[j]); }
}
constexpr int RT_ROW = 136;
constexpr int RT_LDS_BYTES = 2 * 128 * RT_ROW * 2;
DI void route_wave(const bf16_t* __restrict__ PQ, const LAS unsigned char* keys, int* __restrict__ IDX, float* __restrict__ PG, int tb, int h, int lane) {
    const int r32 = lane & 31, hi = lane >> 5;
    const size_t tok = (size_t)tb * 32 + r32;
    unsigned Tp[2][16];
#pragma unroll
    for (int p = 0; p < 2; ++p) {
        bf16x8 qf[8];
        const bf16_t* qp = PQ + tok * 2048 + h * 256 + p * 128 + 8 * hi;
#pragma unroll
        for (int ks = 0; ks < 8; ++ks) qf[ks] = *(const bf16x8*)(qp + 16 * ks);
#pragma unroll
        for (int nt = 0; nt < 4; ++nt) {
            f32x16 acc;
#pragma unroll
            for (int i = 0; i < 16; ++i) acc[i] = 0.f;
#pragma unroll
            for (int ks = 0; ks < 8; ++ks) { const bf16x8 kf = *(const LAS bf16x8*)(keys + ((p * 128 + 32 * nt + r32) * RT_ROW + 16 * ks + 8 * hi) * 2); acc = MFMA32(kf, qf[ks], acc); }
            unsigned L[16];
#pragma unroll
            for (int i = 0; i < 16; ++i) L[i] = (mono(acc[i]) & ~0x7fu) | (unsigned)(127 - (32 * nt + crow(i, hi)));
            sort16_desc(L);
            if (nt == 0) {
#pragma unroll
                for (int i = 0; i < 16; ++i) Tp[p][i] = L[i];
            } else merge_top16(Tp[p], L);
            __builtin_amdgcn_sched_barrier(0);
        }
    }
    unsigned T[16];
    { unsigned O[16];
#pragma unroll
      for (int i = 0; i < 16; ++i) { const auto rr = __builtin_amdgcn_permlane32_swap(Tp[0][i], Tp[1][i], false, false); T[i] = rr[0]; O[i] = rr[1]; }
      merge_top16(T, O); }
    __builtin_amdgcn_sched_barrier(0);
    float s1[16], s2[16]; unsigned i1[16], i2[16];
#pragma unroll
    for (int i = 0; i < 16; ++i) { const auto rr = __builtin_amdgcn_permlane32_swap(T[i], T[i], false, false);
        s1[i] = demono(rr[0] & ~0x7fu); i1[i] = 127u - (rr[0] & 0x7fu); s2[i] = demono(rr[1] & ~0x7fu); i2[i] = 127u - (rr[1] & 0x7fu); }
    unsigned C[64];
    { int n = 0;
#pragma unroll
      for (int a = 0; a < 16; ++a)
#pragma unroll
          for (int b = 0; b < 16; ++b) if ((a + 1) * (b + 1) <= 16) { C[n] = (mono(s1[a] + s2[b]) & ~0x3fffu) | (i1[a] << 7) | i2[b]; ++n; }
#pragma unroll
      for (int i = 50; i < 64; ++i) C[i] = 0u; }
    unsigned F[16];
#pragma unroll
    for (int i = 0; i < 16; ++i) F[i] = C[i];
    sort16_desc(F);
#pragma unroll
    for (int g = 1; g < 4; ++g) { unsigned L[16];
#pragma unroll
        for (int i = 0; i < 16; ++i) L[i] = C[16 * g + i];
        sort16_desc(L); merge_top16(F, L); __builtin_amdgcn_sched_barrier(0); }
    if (hi == 0) {
        float e[16]; float sum = 0.f; const float v0 = demono(F[0] & ~0x3fffu);
#pragma unroll
        for (int i = 0; i < 16; ++i) { e[i] = __expf(demono(F[i] & ~0x3fffu) - v0); sum += e[i]; }
        const float inv = 1.f / sum;
        int* ip = IDX + tok * 128 + h * 16; float* gp = PG + tok * 128 + h * 16;
#pragma unroll
        for (int q = 0; q < 4; ++q) { u32x4 iv; iv.x = F[4 * q] & 0x3fffu; iv.y = F[4 * q + 1] & 0x3fffu; iv.z = F[4 * q + 2] & 0x3fffu; iv.w = F[4 * q + 3] & 0x3fffu; *(u32x4*)(ip + 4 * q) = iv;
            f32x4 gv; gv[0] = e[4 * q] * inv; gv[1] = e[4 * q + 1] * inv; gv[2] = e[4 * q + 2] * inv; gv[3] = e[4 * q + 3] * inv; *(f32x4*)(gp + 4 * q) = gv; }
    }
}
typedef __bf16 bf16x2v __attribute__((ext_vector_type(2)));
DI float dot2bf(unsigned w, unsigned x, float acc) { return __builtin_amdgcn_fdot2_f32_bf16(__builtin_bit_cast(bf16x2v, w), __builtin_bit_cast(bf16x2v, x), acc, false); }
DI float gelu_erf(float v) {
    const float av = fabsf(v), t = __builtin_amdgcn_rcpf(av * 0.2316418882f + 1.0f);
    float q = t * 0.5307027145f + (-0.7265760135f); q = q * t + 0.7107068705f; q = q * t + (-0.142248368f); q = q * t + 0.127414796f; q = q * t;
    const float e = __builtin_amdgcn_exp2f((v * v) * (-0.72134752044f)); const float m = v * (q * e);
    return v < 0.f ? m : v - m;
}
DI float dppf(float v, const int ctrl_sel) {
    const int s = __float_as_int(v);
    int r;
    if (ctrl_sel == 0) r = __builtin_amdgcn_update_dpp(0, s, 0xB1, 0xF, 0xF, true);
    else if (ctrl_sel == 1) r = __builtin_amdgcn_update_dpp(0, s, 0x4E, 0xF, 0xF, true);
    else if (ctrl_sel == 2) r = __builtin_amdgcn_update_dpp(0, s, 0x141, 0xF, 0xF, true);
    else r = __builtin_amdgcn_update_dpp(0, s, 0x128, 0xF, 0xF, true);
    return __int_as_float(r);
}
DI int dppi(int s, const int ctrl_sel) {
    if (ctrl_sel == 0) return __builtin_amdgcn_update_dpp(0, s, 0xB1, 0xF, 0xF, true);
    if (ctrl_sel == 1) return __builtin_amdgcn_update_dpp(0, s, 0x4E, 0xF, 0xF, true);
    return __builtin_amdgcn_update_dpp(0, s, 0x141, 0xF, 0xF, true);
}
template <int NT>
DI void experts_u_slice(const unsigned char* __restrict__ H1Q, const unsigned char* __restrict__ U8x, const int* __restrict__ IDX, bf16_t* __restrict__ PD, size_t tok, int x, int lane) {
    const int g = lane >> 3, l8 = lane & 7;
    u32x4 hq[NT], iv[NT][4], w[NT][16];
#pragma unroll
    for (int t = 0; t < NT; ++t) { hq[t] = *(const u32x4*)(H1Q + (tok + t) * D + 128 * x + 16 * l8);
#pragma unroll
        for (int q = 0; q < 4; ++q) iv[t][q] = *(const u32x4*)(IDX + (tok + t) * 128 + 16 * g + 4 * q); }
#pragma unroll
    for (int t = 0; t < NT; ++t)
#pragma unroll
        for (int j = 0; j < 16; ++j) w[t][j] = *(const u32x4*)(U8x + (size_t)(iv[t][j >> 2][j & 3] * 128u + 16u * l8));
#pragma unroll
    for (int t = 0; t < NT; ++t) {
        float p[16];
#pragma unroll
        for (int j = 0; j < 16; ++j) { int d = 0;
#pragma unroll
            for (int q = 0; q < 4; ++q) d = __builtin_amdgcn_sdot4((int)w[t][j][q], (int)hq[t][q], d, false);
            d += dppi(d, 0); d += dppi(d, 1); d += dppi(d, 2); p[j] = (float)d; }
        if (l8 == 0) {
            u32x4 o0, o1;
            o0.x = cvtpk(p[0], p[1]); o0.y = cvtpk(p[2], p[3]); o0.z = cvtpk(p[4], p[5]); o0.w = cvtpk(p[6], p[7]);
            o1.x = cvtpk(p[8], p[9]); o1.y = cvtpk(p[10], p[11]); o1.z = cvtpk(p[12], p[13]); o1.w = cvtpk(p[14], p[15]);
            bf16_t* dp = PD + ((tok + t) * 8 + x) * 128 + 16 * g; *(u32x4*)dp = o0; *(u32x4*)(dp + 8) = o1;
        }
    }
}
DI void experts_combine(const bf16_t* __restrict__ PD, const int* __restrict__ IDX, const float* __restrict__ PG, const float* __restrict__ USC, const float* __restrict__ VSC, const float* __restrict__ HSC,
                        unsigned char* __restrict__ C8, float* __restrict__ CSC, int wave0, int nwaves, int lane) {
    for (int tok = wave0; tok < M; tok += nwaves) {
        float s0 = 0.f, s1 = 0.f;
#pragma unroll
        for (int x = 0; x < 8; ++x) { const unsigned w = *(const unsigned*)(PD + ((size_t)tok * 8 + x) * 128 + 2 * lane); s0 += __uint_as_float(w << 16); s1 += __uint_as_float(w & 0xffff0000u); }
        const u32x2 rows = *(const u32x2*)(IDX + (size_t)tok * 128 + 2 * lane); const f32x2 gt = *(const f32x2*)(PG + (size_t)tok * 128 + 2 * lane);
        const float hs = HSC[tok];
        const float c0 = gt[0] * gelu_erf(s0 * USC[rows.x] * hs) * VSC[rows.x], c1 = gt[1] * gelu_erf(s1 * USC[rows.y] * hs) * VSC[rows.y];
        const float amax = wave_max(fmaxf(fabsf(c0), fabsf(c1)));
        const float qs = amax > 0.f ? 127.f / amax : 1.f;
        const unsigned short q2 = (unsigned short)(((unsigned)__float2int_rn(c0 * qs) & 0xffu) | (((unsigned)__float2int_rn(c1 * qs) & 0xffu) << 8));
        *(unsigned short*)(C8 + (size_t)tok * 128 + 2 * lane) = q2;
        if (lane == 0) CSC[tok] = amax > 0.f ? amax * (1.f / 127.f) : 1.f;
    }
}
template <int NT>
DI void experts_v_slice(const unsigned char* __restrict__ V8x, const int* __restrict__ IDX, const unsigned char* __restrict__ C8, const float* __restrict__ CSC, bf16_t* __restrict__ FFN, size_t tok, int x, int lane) {
    const int g = lane >> 3, l8 = lane & 7;
    u32x4 iv[NT][4], w[NT][16], cq[NT];
#pragma unroll
    for (int t = 0; t < NT; ++t) { cq[t] = *(const u32x4*)(C8 + (tok + t) * 128 + 16 * g);
#pragma unroll
        for (int q = 0; q < 4; ++q) iv[t][q] = *(const u32x4*)(IDX + (tok + t) * 128 + 16 * g + 4 * q); }
#pragma unroll
    for (int t = 0; t < NT; ++t)
#pragma unroll
        for (int j = 0; j < 16; ++j) w[t][j] = *(const u32x4*)(V8x + (size_t)(iv[t][j >> 2][j & 3] * 128u + 16u * l8));
#pragma unroll
    for (int t = 0; t < NT; ++t) {
        int acc[16];
#pragma unroll
        for (int i = 0; i < 16; ++i) acc[i] = 0;
#pragma unroll
        for (int jj = 0; jj < 4; ++jj) {
            const int cdw = (int)cq[t][jj];
#pragma unroll
            for (int q = 0; q < 4; ++q) {
                const unsigned r0 = w[t][4 * jj][q], r1 = w[t][4 * jj + 1][q], r2 = w[t][4 * jj + 2][q], r3 = w[t][4 * jj + 3][q];
                const unsigned lo01 = __builtin_amdgcn_perm(r1, r0, 0x05010400u), hi01 = __builtin_amdgcn_perm(r1, r0, 0x07030602u);
                const unsigned lo23 = __builtin_amdgcn_perm(r3, r2, 0x05010400u), hi23 = __builtin_amdgcn_perm(r3, r2, 0x07030602u);
                acc[4 * q + 0] = __builtin_amdgcn_sdot4((int)__builtin_amdgcn_perm(lo23, lo01, 0x05040100u), cdw, acc[4 * q + 0], false);
                acc[4 * q + 1] = __builtin_amdgcn_sdot4((int)__builtin_amdgcn_perm(lo23, lo01, 0x07060302u), cdw, acc[4 * q + 1], false);
                acc[4 * q + 2] = __builtin_amdgcn_sdot4((int)__builtin_amdgcn_perm(hi23, hi01, 0x05040100u), cdw, acc[4 * q + 2], false);
                acc[4 * q + 3] = __builtin_amdgcn_sdot4((int)__builtin_amdgcn_perm(hi23, hi01, 0x07060302u), cdw, acc[4 * q + 3], false);
            }
        }
        const float cs = CSC[tok + t];
#pragma unroll
        for (int i = 0; i < 8; ++i) { const auto rr = __builtin_amdgcn_permlane32_swap((unsigned)acc[i], (unsigned)acc[i + 8], false, false); acc[i] = (int)rr[0] + (int)rr[1]; }
#pragma unroll
        for (int i = 0; i < 4; ++i) { const auto rr = __builtin_amdgcn_permlane16_swap((unsigned)acc[i], (unsigned)acc[i + 4], false, false); acc[i] = (int)rr[0] + (int)rr[1]; }
        { const bool up = (lane & 8) != 0;
#pragma unroll
          for (int i = 0; i < 2; ++i) { const int send = up ? acc[i] : acc[i + 2], keep = up ? acc[i + 2] : acc[i]; acc[i] = keep + __builtin_amdgcn_update_dpp(0, send, 0x128, 0xF, 0xF, true); } }
        *(unsigned*)(FFN + (tok + t) * D + 128 * x + 16 * l8 + 2 * g) = cvtpk((float)acc[0] * cs, (float)acc[1] * cs);
    }
}
DI void ln2_token(const bf16_t* __restrict__ FFN, const bf16_t* __restrict__ H1B, const float* __restrict__ g2, const float* __restrict__ b2, float* __restrict__ outp, size_t tok, int lane) {
    float* hr = outp + tok * D + 16 * lane;
    const u32x4 fa = *(const u32x4*)(FFN + tok * D + 16 * lane), fb = *(const u32x4*)(FFN + tok * D + 16 * lane + 8);
    const u32x4 ha = *(const u32x4*)(H1B + tok * D + 16 * lane), hb = *(const u32x4*)(H1B + tok * D + 16 * lane + 8);
    float ff[16], hh[16]; unpack8(fa, *(float(*)[8])&ff[0]); unpack8(fb, *(float(*)[8])&ff[8]); unpack8(ha, *(float(*)[8])&hh[0]); unpack8(hb, *(float(*)[8])&hh[8]);
    f32x4 v[4];
#pragma unroll
    for (int j = 0; j < 4; ++j)
#pragma unroll
        for (int e = 0; e < 4; ++e) v[j][e] = hh[4 * j + e];
    float s = 0.f;
#pragma unroll
    for (int j = 0; j < 4; ++j)
#pragma unroll
        for (int e = 0; e < 4; ++e) { v[j][e] = v[j][e] * ALPHA + ff[4 * j + e]; s += v[j][e]; }
    const float mean = wave_sum(s) * (1.f / D); float q2 = 0.f;
#pragma unroll
    for (int j = 0; j < 4; ++j)
#pragma unroll
        for (int e = 0; e < 4; ++e) { v[j][e] -= mean; q2 += v[j][e] * v[j][e]; }
    const float rstd = rsqrtf(wave_sum(q2) * (1.f / D) + LN_EPS);
#pragma unroll
    for (int j = 0; j < 4; ++j) { const f32x4 gg = *(const f32x4*)(g2 + 16 * lane + 4 * j), bb = *(const f32x4*)(b2 + 16 * lane + 4 * j); *(f32x4*)(hr + 4 * j) = v[j] * rstd * gg + bb; }
}

DI void p0_convert(const float* __restrict__ in, bf16_t* __restrict__ out, size_t n8, size_t first, size_t stride) {
    for (size_t i = first; i < n8; i += stride) { const f32x4 a = ((const f32x4*)in)[2 * i], b = ((const f32x4*)in)[2 * i + 1];
        u32x4 w; w.x = cvtpk(a[0], a[1]); w.y = cvtpk(a[2], a[3]); w.z = cvtpk(b[0], b[1]); w.w = cvtpk(b[2], b[3]); ((u32x4*)out)[i] = w; }
}
DI void p0_transpose_item(const float* __restrict__ W, int ldw, int ncols, bf16_t* __restrict__ out, int ldo, int koff, LAS float* scr, int item, int lane) {
    const int nblk = ncols / 32, kb = item / nblk, nb = item % nblk, k0 = 64 * kb, n0 = 32 * nb;
#pragma unroll 8
    for (int i = 0; i < 32; ++i) { const int kk = 2 * i + (lane >> 5); scr[kk * 33 + (lane & 31)] = W[(size_t)(k0 + kk) * ldw + n0 + (lane & 31)]; }
    asm volatile("s_waitcnt lgkmcnt(0)" ::: "memory");
    const int c = lane & 7;
#pragma unroll
    for (int j = 0; j < 4; ++j) { const int n = (lane >> 3) + 8 * j; const LAS float* s = scr + (8 * c) * 33 + n;
        u32x4 o; o.x = cvtpk(s[0 * 33], s[1 * 33]); o.y = cvtpk(s[2 * 33], s[3 * 33]); o.z = cvtpk(s[4 * 33], s[5 * 33]); o.w = cvtpk(s[6 * 33], s[7 * 33]);
        *(u32x4*)(out + (size_t)(n0 + n) * ldo + koff + k0 + 8 * c) = o; }
    asm volatile("s_waitcnt lgkmcnt(0)" ::: "memory");
}
template <bool I8>
DI void p0_fp8_row(const float* __restrict__ src, unsigned char* __restrict__ dst, float* __restrict__ scale, int row, int lane) {
    const f32x4* sp = (const f32x4*)(src + (size_t)row * D) + 4 * lane;
    f32x4 v[4]; float mx = 0.f;
#pragma unroll
    for (int j = 0; j < 4; ++j) { v[j] = sp[j]; mx = fmaxf(mx, fmaxf(fmaxf(fabsf(v[j][0]), fabsf(v[j][1])), fmaxf(fabsf(v[j][2]), fabsf(v[j][3])))); }
    mx = wave_max(mx);
    const float top = I8 ? 127.f : 224.f;
    const float sc = mx > 0.f ? top / mx : 1.f;
    u32x4 w;
#pragma unroll
    for (int j = 0; j < 4; ++j) {
        if (I8) { w[j] = ((unsigned)__float2int_rn(v[j][0] * sc) & 0xffu) | (((unsigned)__float2int_rn(v[j][1] * sc) & 0xffu) << 8) | (((unsigned)__float2int_rn(v[j][2] * sc) & 0xffu) << 16) | (((unsigned)__float2int_rn(v[j][3] * sc) & 0xffu) << 24); }
        else { int p = 0; p = __builtin_amdgcn_cvt_pk_fp8_f32(v[j][0] * sc, v[j][1] * sc, p, false); p = __builtin_amdgcn_cvt_pk_fp8_f32(v[j][2] * sc, v[j][3] * sc, p, true); w[j] = (unsigned)p; } }
    *(u32x4*)(dst + (size_t)(lane >> 3) * ((size_t)NEXP * 128) + (size_t)row * 128 + 16 * (lane & 7)) = w;
    if (lane == 0) scale[row] = mx > 0.f ? mx / top : 1.f;
}
DI void p0_misc(const float* __restrict__ hgrn_lb, const float* __restrict__ rel_bias, float* __restrict__ misc, int i) {
    if (i < 512) { const float a = hgrn_lb[i], b = hgrn_lb[512 + i]; const float mx = fmaxf(a, b); const float ea = expf(a - mx), eb = expf(b - mx); misc[i] = ea / (ea + eb); }
    if (i < 3 * 129) {
        const int g = i / 129, j = i % 129; const int dl = g == 0 ? 1 : (g == 1 ? 4 : 16); const int n = j * dl;
        int bucket;
        if (n < 16) bucket = n;
        else { const double v = log((double)n / 16.0) / log(128.0) * 16.0; int l = 16 + (int)v; bucket = l < 31 ? l : 31; }
        for (int h = 0; h < 4; ++h) misc[512 + i * 4 + h] = rel_bias[bucket * 12 + g * 4 + h];
    }
}
struct SchedMemKV {
    unsigned MEMB, W; int G, c;
    DI bool next(int i, g8::Unit& u) const {
        const int L = i * G + c; if (L >= 32) return false;
        u.dla = 1; u.dlb = 1;
        if (L < 16) { u.kind = 0; u.pm = L >> 1; u.pn = L & 1; u.a = MEMB + (unsigned)u.pm * 256u * D * 2u; u.b = W + (unsigned)u.pn * 256u * D * 2u; }
        else { const int q = L - 16; u.kind = 1; u.pm = q >> 3; u.pn = q & 7; u.a = W + (unsigned)(512 + u.pm * 256) * D * 2u; u.b = MEMB + (unsigned)u.pn * 256u * D * 2u; }
        return true;
    }
};
struct EpiMemKVF {
    static constexpr bool PERM = true, HOOK = false;
    bf16_t *MK, *MVT;
    DI void hook(f32x4 (&)[2][2][4][2], const g8::Unit&, int, int, int, int, int) const {}
    DI void operator()(const f32x4 (&acc)[2][2][4][2], const g8::Unit& u, int wr, int wc, int fr, int fq) const {
        const int rowl = wr * 64 + fr, d0 = wc * 32 + 8 * fq;
#pragma unroll
        for (int ai = 0; ai < 2; ++ai)
#pragma unroll
            for (int m = 0; m < 4; ++m) { const int R = u.pm * 256 + rowl + ai * 128 + m * 16;
#pragma unroll
                for (int bj = 0; bj < 2; ++bj) { const f32x4 v0 = acc[ai][bj][m][0], v1 = acc[ai][bj][m][1];
                    if (u.kind == 0) { const int b = R >> 8, mm = R & 255, h = u.pn * 2 + bj;
                        u32x4 w; w.x = cvtpk(v0[0], v0[1]); w.y = cvtpk(v0[2], v0[3]); w.z = cvtpk(v1[0], v1[1]); w.w = cvtpk(v1[2], v1[3]);
                        *(u32x4*)(MK + ((size_t)((b * 4 + h) * 8 + (mm >> 5))) * 4096 + frag_row_off(d0, mm & 31)) = w; }
                    else { const int h = R >> 7, d = R & 127, c = u.pn * 256 + bj * 128 + d0, b = c >> 8, mm = c & 255, kk = mm & 31;
                        bf16_t* blk = MVT + ((size_t)((b * 4 + h) * 8 + (mm >> 5))) * 4096 + (((d >> 5) * 2 + (kk >> 4)) * 64 + (d & 31)) * 8 + 4 * ((kk >> 3) & 1);
                        u32x2 wa, wb; wa.x = cvtpk(v0[0], v0[1]); wa.y = cvtpk(v0[2], v0[3]); wb.x = cvtpk(v1[0], v1[1]); wb.y = cvtpk(v1[2], v1[3]);
                        *(u32x2*)blk = wa; *(u32x2*)(blk + 32 * 8) = wb; } } }
    }
};

static_assert(HG_UNIT_BYTES <= LDSCTL_OFF, "hgrn LDS");
DI const float* karg_in(int i) { const float* const* kp = (const float* const*)__builtin_amdgcn_kernarg_segment_ptr(); asm volatile("" : "+s"(kp)); return kp[i]; }
DI float* karg_out() { float* const* kp = (float* const*)__builtin_amdgcn_kernarg_segment_ptr(); asm volatile("" : "+s"(kp)); return kp[18]; }
__global__ void __launch_bounds__(NTHR, 2) mega(Args args) {
    extern __shared__ __attribute__((aligned(16))) unsigned char lds_raw[];
    LAS unsigned char* lds = (LAS unsigned char*)lds_raw;
    volatile LAS unsigned* MISC = (volatile LAS unsigned*)(lds + MISC_OFF);
    for (int u = threadIdx.x; u < (LDS_BYTES - LDSCTL_OFF) / 4; u += NTHR) ((LAS unsigned*)(lds + LDSCTL_OFF))[u] = 0u;
    __syncthreads();
    unsigned char* ws = args.ws;
    const int G = gridDim.x;
    const bool ALL = args.ph == PH_ALL;
    XcdBarrier bar; bar.bar = (unsigned*)(ws + O_MISC + 16384); bar.x = 0; bar.st = nullptr;
    if (ALL) bar = xcd_barrier_post((unsigned*)(ws + O_MISC + 16384), MISC + 8);
#ifndef REP_MASK
#define REP_MASK 0
#endif
#define RUN(k) (ALL || args.ph == (k))
#define NREP(k) (((REP_MASK >> (k)) & 1) ? 2 : 1)
#define SEAM() do { if (ALL) xcd_barrier(bar); } while (0)
    for (int rep_ = 0; rep_ < NREP(PH_PRO); ++rep_) if (RUN(PH_PRO)) {
        int tid = threadIdx.x; asm volatile("" : "+v"(tid)); asm volatile("" : "+s"(ws)); int bid = blockIdx.x; asm volatile("" : "+s"(bid));
        const size_t gt = (size_t)bid * NTHR + tid, nth = (size_t)G * NTHR;
        p0_convert(karg_in(0), (bf16_t*)(ws + O_XB), (size_t)M * D / 8, gt, nth);
        p0_convert(karg_in(1), (bf16_t*)(ws + O_MEMB), (size_t)2048 * 1024 / 8, gt, nth);
        p0_convert(karg_in(13), (bf16_t*)(ws + O_SUBK), (size_t)16 * 128 * 128 / 8, gt, nth);
        if (bid == 0) p0_misc(karg_in(6), karg_in(5), (float*)(ws + O_MISC), tid);
        const int wid = __builtin_amdgcn_readfirstlane(tid >> 6), lane = tid & 63;
        LAS float* scr = (LAS float*)(lds + wid * 16384);
        const int gw = bid * NWAVES + wid, ngw = G * NWAVES;
        for (int r = gw; r < 2 * NEXP; r += ngw) {
            if (r < NEXP) p0_fp8_row<true>(karg_in(14), (unsigned char*)(ws + O_UB), (float*)(ws + O_USC), r, lane);
            else p0_fp8_row<true>(karg_in(15), (unsigned char*)(ws + O_VB), (float*)(ws + O_VSC), r - NEXP, lane);
        }
        constexpr int NJ = 13;
        for (int it = gw; ; it += ngw) {
            int r = it; bool done = true;
#pragma unroll
            for (int j = 0; j < NJ; ++j) {
                const int srcc[NJ] = {0, 4608, 5632, 6656, 7168, 3072, 5120, 0, 0, 0, 0, 0, 0};
                const int cnt[NJ] = {3072, 512, 1024, 512, 3072, 1536, 512, 1024, 1024, 1024, 1024, 1024, 2048};
                const int drow[NJ] = {0, 3072, 3584, 4608, 5120, 8192, 9728, 0, 0, 0, 0, 0, 0};
                const int Kj = (j >= 8 && j <= 10) ? 512 : 1024;
                const int items = (Kj / 64) * (cnt[j] / 32);
                if (done && r < items) {
                    const float* W; int ldw; bf16_t* o; int ldo, koff = 0;
                    if (j < 7) { W = karg_in(2) + srcc[j]; ldw = INC; o = (bf16_t*)(ws + O_WIN) + (size_t)drow[j] * 1024; ldo = 1024; }
                    else if (j == 7) { W = karg_in(4); ldw = 1024; o = (bf16_t*)(ws + O_WMKV); ldo = 1024; }
                    else if (j <= 10) { W = karg_in(8) + (size_t)(j - 8) * 512 * 1024; ldw = 1024; o = (bf16_t*)(ws + O_WBR); ldo = 1536; koff = (j - 8) * 512; }
                    else if (j == 11) { W = karg_in(9); ldw = 1024; o = (bf16_t*)(ws + O_WOUT); ldo = 1024; }
                    else { W = karg_in(12); ldw = 2048; o = (bf16_t*)(ws + O_WPQ); ldo = 1024; }
                    p0_transpose_item(W, ldw, cnt[j], o, ldo, koff, scr, r, lane); done = false;
                }
                r -= items;
            }
            if (done) break;
        }
        SEAM();
    }
#pragma unroll 1
    for (int p = (ALL ? 0 : args.pass); p < (ALL ? NPASS : args.pass + 1); ++p) {
        int bid = blockIdx.x; asm volatile("" : "+s"(bid));
        int tid = threadIdx.x; asm volatile("" : "+v"(tid));
        asm volatile("" : "+s"(ws));
        char* pr = (char*)ws + O_PASS;
        const size_t t0 = (size_t)p * MP;
        for (int rep_ = 0; rep_ < NREP(PH_PROJ); ++rep_) if (RUN(PH_PROJ)) {
            asm volatile("" : "+s"(bid)); asm volatile("" : "+v"(tid)); asm volatile("" : "+s"(ws)); pr = (char*)ws + O_PASS;
            SchedP1 Sc{(unsigned)(O_XB + t0 * D * 2), (unsigned)O_WIN, G, bid};
            EpiP1 E{pr, karg_in(3)};
            g8::gemm_phase<EpiP1, SchedP1>(lds, (const char*)ws, D, Sc, E, tid);
            if (p == 0) {
                SchedMemKV S2{(unsigned)O_MEMB, (unsigned)O_WMKV, G, bid};
                EpiMemKVF E2{(bf16_t*)(ws + O_MK), (bf16_t*)(ws + O_MVT)};
                g8::gemm_phase<EpiMemKVF, SchedMemKV>(lds, (const char*)ws, D, S2, E2, tid);
            }
            SEAM();
        }
        for (int rep_ = 0; rep_ < NREP(PH_ATTN); ++rep_) if (RUN(PH_ATTN)) {
            asm volatile("" : "+s"(bid)); asm volatile("" : "+v"(tid)); asm volatile("" : "+s"(ws)); pr = (char*)ws + O_PASS;
            const float* bsrc = (const float*)(ws + O_MISC) + 512; LAS float* btab = (LAS float*)lds;
            for (int i = tid; i < 3 * 129 * 4; i += NTHR) btab[i] = bsrc[i] * LOG2E;
            __syncthreads();
            const int wid = __builtin_amdgcn_readfirstlane(tid >> 6), lane = tid & 63;
            for (int task = bid * NWAVES + wid; task < DIL_TASKS; task += G * NWAVES)
                attn_dil_wave((const bf16_t*)(pr + P_QK), (const bf16_t*)(pr + P_VT), btab, (bf16_t*)(pr + P_OG), (float*)(pr + P_LSE), task, lane);
            for (int task = bid * NWAVES + wid; task < MEM_TASKS; task += G * NWAVES)
                attn_mem_wave((const bf16_t*)(pr + P_MQ), (const bf16_t*)(ws + O_MK), (const bf16_t*)(ws + O_MVT), (bf16_t*)(pr + P_BR), task, p * BPP, lane);
            __syncthreads();
        }
        for (int rep_ = 0; rep_ < NREP(PH_HGPRE); ++rep_) if (RUN(PH_HGPRE)) {
            asm volatile("" : "+s"(bid)); asm volatile("" : "+v"(tid)); asm volatile("" : "+s"(ws)); pr = (char*)ws + O_PASS;
            { const int unit = bid; static_assert(HG_UNITS == 256, "one HGRN unit per workgroup"); if (unit < HG_UNITS) {
                hgrn_unit<false>(lds, unit, tid, (const bf16_t*)(pr + P_HFQG), (const bf16_t*)(pr + P_IT), (const float*)(ws + O_MISC), karg_in(7),
                                 (float*)(pr + P_HSTL), (float*)(pr + P_HSTD), (const float*)(pr + P_SIN), (bf16_t*)(pr + P_BR));
            } }
            SEAM();
        }
        for (int rep_ = 0; rep_ < NREP(PH_HGSCAN); ++rep_) if (RUN(PH_HGSCAN)) {
            asm volatile("" : "+s"(bid)); asm volatile("" : "+v"(tid)); asm volatile("" : "+s"(ws)); pr = (char*)ws + O_PASS;
            hgrn_scan((const float*)(pr + P_HSTL), (const float*)(pr + P_HSTD), (float*)(pr + P_SIN), bid * NTHR + tid);
            lse_merge_items((const bf16_t*)(pr + P_OG), (const float*)(pr + P_LSE), (bf16_t*)(pr + P_BR), bid * NTHR + tid, G * NTHR);
            SEAM();
        }
        for (int rep_ = 0; rep_ < NREP(PH_HGMAIN); ++rep_) if (RUN(PH_HGMAIN)) {
            asm volatile("" : "+s"(bid)); asm volatile("" : "+v"(tid)); asm volatile("" : "+s"(ws)); pr = (char*)ws + O_PASS;
            { const int unit = bid; static_assert(HG_UNITS == 256, "one HGRN unit per workgroup"); if (unit < HG_UNITS) {
                hgrn_unit<true>(lds, unit, tid, (const bf16_t*)(pr + P_HFQG), (const bf16_t*)(pr + P_IT), (const float*)(ws + O_MISC), karg_in(7),
                                (float*)(pr + P_HSTL), (float*)(pr + P_HSTD), (const float*)(pr + P_SIN), (bf16_t*)(pr + P_BR));
            } }
            SEAM();
        }
        for (int rep_ = 0; rep_ < NREP(PH_WIDEN); ++rep_) if (RUN(PH_WIDEN)) {
            asm volatile("" : "+s"(bid)); asm volatile("" : "+v"(tid)); asm volatile("" : "+s"(ws)); pr = (char*)ws + O_PASS;
            SchedRows Sc{(unsigned)(O_PASS + P_BR), (unsigned)O_WBR, 1536, 4, 256, G, bid};
            EpiWidenF E{(const bf16_t*)(pr + P_GATE), (bf16_t*)(pr + P_MERGED)};
            g8::gemm_phase<EpiWidenF, SchedRows>(lds, (const char*)ws, 1536, Sc, E, tid);
            SEAM();
        }
        for (int rep_ = 0; rep_ < NREP(PH_WOUT); ++rep_) if (RUN(PH_WOUT)) {
            asm volatile("" : "+s"(bid)); asm volatile("" : "+v"(tid)); asm volatile("" : "+s"(ws)); pr = (char*)ws + O_PASS;
            SchedRows Sc{(unsigned)(O_PASS + P_MERGED), (unsigned)O_WOUT, 1024, 4, 256, G, bid};
            EpiPlainB16 E{(bf16_t*)(pr + P_MIX), 1024, 0};
            g8::gemm_phase<EpiPlainB16, SchedRows>(lds, (const char*)ws, 1024, Sc, E, tid);
            SEAM();
        }
        for (int rep_ = 0; rep_ < NREP(PH_LN1); ++rep_) if (RUN(PH_LN1)) {
            asm volatile("" : "+s"(bid)); asm volatile("" : "+v"(tid)); asm volatile("" : "+s"(ws)); pr = (char*)ws + O_PASS;
            ln1_rows(karg_in(0) + t0 * D, (const bf16_t*)(pr + P_MIX), karg_in(10), karg_in(11), (bf16_t*)(ws + O_H1B) + t0 * D, (unsigned char*)(ws + O_H1Q) + t0 * D, (float*)(ws + O_HSC) + t0, bid * NWAVES + (tid >> 6), G * NWAVES, tid & 63);
        }
    }
    for (int rep_ = 0; rep_ < NREP(PH_PQ); ++rep_) if (RUN(PH_PQ)) {
        SEAM();
        int tid = threadIdx.x; asm volatile("" : "+v"(tid)); asm volatile("" : "+s"(ws)); int bid = blockIdx.x; asm volatile("" : "+s"(bid));
        char* pr = (char*)ws + O_PASS;
        SchedRows Sc{(unsigned)O_H1B, (unsigned)O_WPQ, 1024, 8, 2048, G, bid};
        EpiPlainB16 E{(bf16_t*)(pr + P_PQ), 2048, 0};
        g8::gemm_phase<EpiPlainB16, SchedRows>(lds, (const char*)ws, 1024, Sc, E, tid);
        SEAM();
    }
    for (int rep_ = 0; rep_ < NREP(PH_ROUTE); ++rep_) if (RUN(PH_ROUTE)) {
        int tid = threadIdx.x; asm volatile("" : "+v"(tid)); asm volatile("" : "+s"(ws)); int bid = blockIdx.x; asm volatile("" : "+s"(bid));
        char* pr = (char*)ws + O_PASS;
        const int h = bid & 7, wgi = bid >> 3, nwg = G >> 3;
        const bf16_t* ksrc = (const bf16_t*)(ws + O_SUBK) + (size_t)h * 2 * 128 * 128;
        for (int i = tid; i < 2 * 128 * 16; i += NTHR) { const int rowk = i >> 4, ch = i & 15; *(LAS u32x4*)(lds + (rowk * RT_ROW + ch * 8) * 2) = *(const u32x4*)(ksrc + rowk * 128 + ch * 8); }
        __syncthreads();
        const int wid = __builtin_amdgcn_readfirstlane(tid >> 6), lane = tid & 63;
        for (int tb = wgi * NWAVES + wid; tb < M / 32; tb += nwg * NWAVES)
            route_wave((const bf16_t*)(pr + P_PQ), lds, (int*)(pr + P_IDX), (float*)(pr + P_PG), tb, h, lane);
        __syncthreads();
        SEAM();
    }
    if (RUN(PH_EXPERTS)) {
        int tid = threadIdx.x; asm volatile("" : "+v"(tid)); asm volatile("" : "+s"(ws)); int bid = blockIdx.x; asm volatile("" : "+s"(bid));
        char* pr = (char*)ws + O_PASS;
        const int wid = __builtin_amdgcn_readfirstlane(tid >> 6), lane = tid & 63;
        if (tid == 0) {
            unsigned base = 0; const unsigned myx = ALL ? bar.x : 0u;
            if (ALL) { for (unsigned jx = 0; jx < 16; ++jx) { const unsigned c = xb_ld(&bar.bar[XB_XCNT(jx)]); if (jx < myx) base += c; } MISC[12] = base + MISC[10]; }
            else MISC[12] = (unsigned)bid;
        }
        __syncthreads();
        const int vwg = (int)MISC[12];
        const int nper = G >> 3, x = vwg / nper, r = vwg % nper;
        const int tpw = M / (nper * NWAVES);
        const size_t tokw0 = (size_t)(r * NWAVES + wid) * tpw;
        {
            const unsigned char* U8x = (const unsigned char*)(ws + O_UB) + (size_t)x * ((size_t)NEXP * 128);
            for (int i = 0; i < tpw; i += 2) experts_u_slice<2>((const unsigned char*)(ws + O_H1Q), U8x, (const int*)(pr + P_IDX), (bf16_t*)(pr + P_PD), tokw0 + i, x, lane);
        }
        SEAM();
        experts_combine((const bf16_t*)(pr + P_PD), (const int*)(pr + P_IDX), (const float*)(pr + P_PG), (const float*)(ws + O_USC), (const float*)(ws + O_VSC), (const float*)(ws + O_HSC), (unsigned char*)(pr + P_C), (float*)(pr + P_C + (size_t)M * 128), bid * NWAVES + wid, G * NWAVES, lane);
        SEAM();
        {
            const unsigned char* V8x = (const unsigned char*)(ws + O_VB) + (size_t)x * ((size_t)NEXP * 128);
            for (int i = 0; i < tpw; i += 2) experts_v_slice<2>(V8x, (const int*)(pr + P_IDX), (const unsigned char*)(pr + P_C), (const float*)(pr + P_C + (size_t)M * 128), (bf16_t*)(pr + P_FFN), tokw0 + i, x, lane);
        }
        SEAM();
        for (int tok = bid * NWAVES + wid; tok < M; tok += G * NWAVES) ln2_token((const bf16_t*)(pr + P_FFN), (const bf16_t*)(ws + O_H1B), karg_in(16), karg_in(17), karg_out(), (size_t)tok, lane);
    }
#undef RUN
#undef SEAM
}

extern "C" void kernel_launch(void* const* d_in, const int* in_sizes, int n_in, void* d_out, int out_size, void* d_ws, size_t ws_size, hipStream_t stream) {
    if (ws_size < WS_NEED || n_in != 18) return;
    static bool attr_set = false;
    if (!attr_set) { (void)hipFuncSetAttribute((const void*)mega, hipFuncAttributeMaxDynamicSharedMemorySize, LDS_BYTES); attr_set = true; }
    (void)hipMemsetAsync((char*)d_ws + O_MISC + 16384, 0, 16384, stream);
    Args a{}; for (int i = 0; i < 18; ++i) a.in[i] = (const float*)d_in[i]; a.out = (float*)d_out; a.ws = (unsigned char*)d_ws; a.ph = PH_ALL; a.pass = 0;
    mega<<<256, NTHR, LDS_BYTES, stream>>>(a);
}
```

```cpp
#include <hip/hip_runtime.h>
#include <stdint.h>
#include <math.h>

typedef unsigned short bf16_t;
typedef short bf16x8 __attribute__((ext_vector_type(8)));
typedef float f32x4 __attribute__((ext_vector_type(4)));
#define DI __device__ __forceinline__

DI float bf2f(bf16_t v) { return __uint_as_float(((unsigned)v) << 16); }
DI bf16_t f2bf(float f) { unsigned u = __float_as_uint(f); u += 0x7fffu + ((u >> 16) & 1u); return (bf16_t)(u >> 16); }

constexpr int NB = 8, S = 8192, D = 1024, M = NB * S;
constexpr int NPASS = 4, BPP = NB / NPASS, MP = BPP * S;
constexpr int INC = 10240;
constexpr int NEXP = 16384;
constexpr float ALPHA = 1.189207115002721f;
constexpr float LN_EPS = 1e-5f;
constexpr float QSCALE = 0.08838834764831845f;

constexpr size_t al(size_t x) { return (x + 255) & ~(size_t)255; }
constexpr size_t O_WIN = 0;
constexpr size_t O_WMKV = O_WIN + al((size_t)INC * D * 2);
constexpr size_t O_WBR = O_WMKV + al((size_t)1024 * 1024 * 2);
constexpr size_t O_WOUT = O_WBR + al((size_t)1024 * 1536 * 2);
constexpr size_t O_WPQ = O_WOUT + al((size_t)1024 * 1024 * 2);
constexpr size_t O_SUBK = O_WPQ + al((size_t)2048 * 1024 * 2);
constexpr size_t O_UB = O_SUBK + al((size_t)16 * 128 * 128 * 2);
constexpr size_t O_VB = O_UB + al((size_t)NEXP * D);
constexpr size_t O_USC = O_VB + al((size_t)NEXP * D);
constexpr size_t O_VSC = O_USC + al((size_t)NEXP * 4);
constexpr size_t O_XB = O_VSC + al((size_t)NEXP * 4);
constexpr size_t O_MEMB = O_XB + al((size_t)M * D * 2);
constexpr size_t O_MK = O_MEMB + al((size_t)2048 * 1024 * 2);
constexpr size_t O_MVT = O_MK + al((size_t)2048 * 512 * 2);
constexpr size_t O_H1B = O_MVT + al((size_t)8 * 512 * 256 * 2);
constexpr size_t O_H1Q = O_H1B + al((size_t)M * D * 2);
constexpr size_t O_HSC = O_H1Q + al((size_t)M * D);
constexpr size_t O_MISC = O_HSC + al((size_t)M * 4);
constexpr size_t O_PASS = O_MISC + al(65536);
constexpr size_t P_QK = 0;
constexpr size_t P_VT = P_QK + al((size_t)MP * 3072 * 2);
constexpr size_t P_IT = P_VT + (size_t)1536 * MP * 2;
constexpr size_t P_HFQG = P_IT + al((size_t)512 * MP * 2);
constexpr size_t P_MQ = P_HFQG + al((size_t)MP * 1536 * 2);
constexpr size_t P_GATE = P_MQ + al((size_t)MP * 512 * 2);
constexpr size_t P_OG = P_GATE + al((size_t)MP * 3072 * 2);
constexpr size_t P_LSE = P_OG + al((size_t)MP * 1536 * 2);
constexpr size_t P_BR = P_LSE + al((size_t)MP * 12 * 4);
constexpr size_t P_MERGED = P_BR + al((size_t)MP * 1536 * 2);
constexpr size_t P_MIX = P_MERGED + al((size_t)MP * 1024 * 2);
constexpr size_t P_HSTL = P_MIX + al((size_t)MP * 1024 * 4);
constexpr size_t P_HSTD = P_HSTL + al((size_t)256 * 16384 * 4);
constexpr size_t P_SIN = P_HSTD + al((size_t)256 * 128 * 4);
constexpr size_t P_END = P_SIN + al((size_t)256 * 16384 * 4);
constexpr size_t P_PQ = 0;
constexpr size_t P_IDX = P_PQ + al((size_t)M * 2048 * 2);
constexpr size_t P_PG = P_IDX + al((size_t)M * 128 * 4);
constexpr size_t P_C = P_PG + al((size_t)M * 128 * 4);
constexpr size_t P_END2 = P_C + al((size_t)M * 128 * 4);
constexpr size_t P_PD = 0;
constexpr size_t P_FFN = P_PD + al((size_t)M * 1024 * 2);
static_assert(P_FFN + (size_t)M * 1024 * 2 <= P_IDX, "PEER overlay");
constexpr size_t WS_NEED = O_PASS + (P_END > P_END2 ? P_END : P_END2);
static_assert(WS_NEED <= (size_t)1073741824, "workspace budget");

DI int dil_of(int g) { return g == 0 ? 1 : (g == 1 ? 4 : 16); }
DI float dpp_x(float v, const int which) {
    const int s = __float_as_int(v);
    const int r = which == 0 ? __builtin_amdgcn_update_dpp(0, s, 0xB1, 0xF, 0xF, true) : which == 1 ? __builtin_amdgcn_update_dpp(0, s, 0x4E, 0xF, 0xF, true)
                : which == 2 ? __builtin_amdgcn_update_dpp(0, s, 0x141, 0xF, 0xF, true) : __builtin_amdgcn_update_dpp(0, s, 0x128, 0xF, 0xF, true);
    return __int_as_float(r);
}
DI float pair_sum(float v) { const auto rr = __builtin_amdgcn_permlane32_swap(__float_as_uint(v), __float_as_uint(v), false, false); return __uint_as_float(rr[0]) + __uint_as_float(rr[1]); }
DI float pair_max(float v) { const auto rr = __builtin_amdgcn_permlane32_swap(__float_as_uint(v), __float_as_uint(v), false, false); return fmaxf(__uint_as_float(rr[0]), __uint_as_float(rr[1])); }
DI float wave_max(float v) {
    v = fmaxf(v, dpp_x(v, 0)); v = fmaxf(v, dpp_x(v, 1)); v = fmaxf(v, dpp_x(v, 2)); v = fmaxf(v, dpp_x(v, 3));
    { const auto rr = __builtin_amdgcn_permlane16_swap(__float_as_uint(v), __float_as_uint(v), false, false); v = fmaxf(__uint_as_float(rr[0]), __uint_as_float(rr[1])); }
    return pair_max(v);
}
DI float wave_sum(float v) {
    v += dpp_x(v, 0); v += dpp_x(v, 1); v += dpp_x(v, 2); v += dpp_x(v, 3);
    { const auto rr = __builtin_amdgcn_permlane16_swap(__float_as_uint(v), __float_as_uint(v), false, false); v = __uint_as_float(rr[0]) + __uint_as_float(rr[1]); }
    return pair_sum(v);
}

#define LAS __attribute__((address_space(3)))
#define GAS __attribute__((address_space(1)))
typedef unsigned u32x4 __attribute__((ext_vector_type(4)));
typedef unsigned u32x2 __attribute__((ext_vector_type(2)));
typedef float f32x2 __attribute__((ext_vector_type(2)));
typedef __bf16 bf16x2_t __attribute__((ext_vector_type(2)));
DI unsigned cvtpk(float lo, float hi) { f32x2 v = {lo, hi}; bf16x2_t b = __builtin_convertvector(v, bf16x2_t); return __builtin_bit_cast(unsigned, b); }
constexpr float LOG2E = 1.4426950408889634f;
constexpr int NTHR_C = 512;
DI float fast_sigmoid(float z) { return __builtin_amdgcn_rcpf(1.f + __builtin_amdgcn_exp2f(-z * LOG2E)); }

namespace g8 {
constexpr int BM = 256, BK = 64, HALF = 128, HTB = HALF * BK * 2, STAGE_BYTES = 8 * HTB;
DI int lds_byte(int r, int c) { const int st = (r >> 4) * 2 + (c >> 5), rr = r & 15, cc = c & 31, ob = rr * 64 + cc * 2; return st * 1024 + (ob ^ (((ob >> 9) & 1) << 5)); }
DI void stage_rc(int b, int& R, int& C) { const int st = b / 1024, sb = b % 1024, swz = sb ^ (((sb >> 9) & 1) << 5); R = (st >> 1) * 16 + swz / 64; C = (st & 1) * 32 + (swz % 64) / 2; }
DI int perm32(int rho) { const int n = rho >> 4, i = rho & 15; return 8 * (i >> 2) + 4 * n + (i & 3); }

struct Unit { unsigned a, b; int dla, dlb; int pm, pn, kind; };

template <class Epi, class Sched>
DI void gemm_phase(LAS unsigned char* lds, const char* const wsb, const int K, const Sched& S, const Epi& E, const int tid) {
    const int wid = __builtin_amdgcn_readfirstlane(tid >> 6), lane = tid & 63, wr = wid >> 2, wc = wid & 3, fr = lane & 15, fq = lane >> 4;
    const int nt = K / BK;
    unsigned rak[2], rbk[2], ccb[2];
#pragma unroll
    for (int i = 0; i < 2; ++i) { int R, C; stage_rc(tid * 16 + i * 8192, R, C); const int Rb = Epi::PERM ? ((R & ~31) + perm32(R & 31)) : R;
        rak[i] = (unsigned)(R * K) * 2u; rbk[i] = (unsigned)(Rb * K) * 2u; ccb[i] = (unsigned)C * 2u; }
    const unsigned kstep = (unsigned)(BK * 2);
    const unsigned hstepA = (unsigned)(HALF * K * 2);
    const unsigned ldsw = (unsigned)wid * 1024u;
    const int aoff = lds_byte(wr * 64 + fr, fq * 8), boff = lds_byte(wc * 32 + fr, fq * 8);
#define G8_SA(b, h) (((b) * 2 + (h)) * HTB)
#define G8_SB(b, h) ((4 + (b) * 2 + (h)) * HTB)
#define G8_STAGE(bufoff, gbase, v0, v1) do { \
        __builtin_amdgcn_global_load_lds((const unsigned*)(wsb + (unsigned)((gbase) + (v0))), (LAS unsigned*)(lds + (bufoff) + ldsw), 16, 0, 0); \
        __builtin_amdgcn_global_load_lds((const unsigned*)(wsb + (unsigned)((gbase) + (v1))), (LAS unsigned*)(lds + (bufoff) + ldsw + 8192), 16, 0, 0); } while (0)
#define G8_LDA(dst, b, h) do { _Pragma("unroll") for (int m = 0; m < 4; ++m) _Pragma("unroll") for (int k = 0; k < 2; ++k) dst[m][k] = *(const LAS bf16x8*)(lds + G8_SA(b, h) + aoff + m * 2048 + k * 1024); } while (0)
#define G8_LDB(dst, b, h) do { _Pragma("unroll") for (int n = 0; n < 2; ++n) _Pragma("unroll") for (int k = 0; k < 2; ++k) dst[n][k] = *(const LAS bf16x8*)(lds + G8_SB(b, h) + boff + n * 2048 + k * 1024); } while (0)
#define G8_MMA(ai, bj, At, Bt) do { __builtin_amdgcn_s_setprio(1); _Pragma("unroll") for (int m = 0; m < 4; ++m) _Pragma("unroll") for (int n = 0; n < 2; ++n) _Pragma("unroll") for (int k = 0; k < 2; ++k) \
        acc[ai][bj][m][n] = __builtin_amdgcn_mfma_f32_16x16x32_bf16(Bt[n][k], At[m][k], acc[ai][bj][m][n], 0, 0, 0); __builtin_amdgcn_s_setprio(0); } while (0)
#define G8_WAIT_V(n) asm volatile("s_waitcnt vmcnt(" #n ")" ::: "memory")
#define G8_WAIT_L(n) asm volatile("s_waitcnt lgkmcnt(" #n ")" ::: "memory")
#define G8_BAR __builtin_amdgcn_s_barrier()
#define G8_SCHED __builtin_amdgcn_sched_barrier(0)
    Unit cur, nxt; int ui = 0;
    if (!S.next(0, cur)) return;
    f32x4 acc[2][2][4][2];
#pragma unroll
    for (int a = 0; a < 2; ++a)
#pragma unroll
        for (int b = 0; b < 2; ++b)
#pragma unroll
            for (int m = 0; m < 4; ++m)
#pragma unroll
                for (int n = 0; n < 2; ++n) acc[a][b][m][n] = (f32x4){0.f, 0.f, 0.f, 0.f};
    bf16x8 At[4][2], B0[2][2], B1[2][2];
    unsigned cA = cur.a, cB = cur.b;
    unsigned vBc0 = rbk[0] * (unsigned)cur.dlb + ccb[0], vBc1 = rbk[1] * (unsigned)cur.dlb + ccb[1]; unsigned hBc = hstepA * (unsigned)cur.dlb;
    unsigned vAc0 = rak[0] * (unsigned)cur.dla + ccb[0], vAc1 = rak[1] * (unsigned)cur.dla + ccb[1]; unsigned hAc = hstepA * (unsigned)cur.dla;
    G8_STAGE(G8_SB(0, 0), cB, vBc0, vBc1); G8_STAGE(G8_SB(0, 1), cB + hBc, vBc0, vBc1); G8_STAGE(G8_SA(0, 0), cA, vAc0, vAc1); G8_STAGE(G8_SA(0, 1), cA + hAc, vAc0, vAc1);
    if (wr == 1) G8_BAR;
    G8_WAIT_V(2); G8_BAR;
    G8_STAGE(G8_SB(1, 0), cB + kstep, vBc0, vBc1); G8_STAGE(G8_SA(1, 0), cA + kstep, vAc0, vAc1); G8_STAGE(G8_SB(1, 1), cB + hBc + kstep, vBc0, vBc1);
    G8_WAIT_V(6); G8_BAR;
    for (;;) {
        const bool has_next = S.next(ui + 1, nxt);
        const unsigned nA = has_next ? nxt.a : cA, nB = has_next ? nxt.b : cB; const int dln = has_next ? nxt.dlb : cur.dlb;
        const unsigned vBn0 = rbk[0] * (unsigned)dln + ccb[0], vBn1 = rbk[1] * (unsigned)dln + ccb[1]; const unsigned hBn = hstepA * (unsigned)dln;
        const int dlan = has_next ? nxt.dla : cur.dla;
        const unsigned vAn0 = rak[0] * (unsigned)dlan + ccb[0], vAn1 = rak[1] * (unsigned)dlan + ccb[1]; const unsigned hAn = hstepA * (unsigned)dlan;
        for (int t = 0; t < nt; t += 2) {
            if constexpr (Epi::HOOK) E.hook(acc, cur, t, wr, wc, fr, fq);
            const bool last = (t == nt - 2);
            const unsigned a1 = cA + (unsigned)(t + 1) * kstep;
            const unsigned a2 = last ? nA : cA + (unsigned)(t + 2) * kstep, b2 = last ? nB : cB + (unsigned)(t + 2) * kstep;
            const unsigned a3 = a2 + kstep, b3 = b2 + kstep;
            const unsigned vB0 = last ? vBn0 : vBc0, vB1 = last ? vBn1 : vBc1; const unsigned hB = last ? hBn : hBc;
            const unsigned vA0 = last ? vAn0 : vAc0, vA1 = last ? vAn1 : vAc1; const unsigned hA = last ? hAn : hAc;
            G8_LDB(B0, 0, 0); G8_LDB(B1, 0, 1); G8_SCHED; G8_LDA(At, 0, 0); G8_STAGE(G8_SA(1, 1), a1 + hAc, vAc0, vAc1);
            G8_WAIT_V(8); G8_WAIT_L(0); G8_BAR; G8_MMA(0, 0, At, B0); G8_MMA(0, 1, At, B1); G8_BAR; G8_SCHED;
            G8_LDA(At, 0, 1); G8_STAGE(G8_SB(0, 0), b2, vB0, vB1); G8_STAGE(G8_SB(0, 1), b2 + hB, vB0, vB1); G8_STAGE(G8_SA(0, 0), a2, vA0, vA1);
            G8_WAIT_V(8); G8_WAIT_L(0); G8_BAR; G8_MMA(1, 0, At, B0); G8_MMA(1, 1, At, B1); G8_BAR; G8_SCHED;
            G8_LDB(B0, 1, 0); G8_LDB(B1, 1, 1); G8_SCHED; G8_LDA(At, 1, 0); G8_STAGE(G8_SA(0, 1), a2 + hA, vA0, vA1);
            G8_WAIT_V(8); G8_WAIT_L(0); G8_BAR; G8_MMA(0, 0, At, B0); G8_MMA(0, 1, At, B1); G8_BAR; G8_SCHED;
            G8_LDA(At, 1, 1); G8_STAGE(G8_SB(1, 0), b3, vB0, vB1); G8_STAGE(G8_SB(1, 1), b3 + hB, vB0, vB1); G8_STAGE(G8_SA(1, 0), a3, vA0, vA1);
            G8_WAIT_V(8); G8_WAIT_L(0); G8_BAR; G8_MMA(1, 0, At, B0); G8_MMA(1, 1, At, B1); G8_BAR; G8_SCHED;
        }
        if (wr == 0) G8_BAR;
        E(acc, cur, wr, wc, fr, fq);
        if (!has_next) break;
#pragma unroll
        for (int a = 0; a < 2; ++a)
#pragma unroll
            for (int b = 0; b < 2; ++b)
#pragma unroll
                for (int m = 0; m < 4; ++m)
#pragma unroll
                    for (int n = 0; n < 2; ++n) acc[a][b][m][n] = (f32x4){0.f, 0.f, 0.f, 0.f};
        cur = nxt; cA = nA; cB = nB; vBc0 = vBn0; vBc1 = vBn1; hBc = hBn; vAc0 = vAn0; vAc1 = vAn1; hAc = hAn; ++ui;
        if (wr == 1) G8_BAR;
    }
    G8_WAIT_V(0);
    G8_BAR;
#undef G8_SA
#undef G8_SB
#undef G8_STAGE
#undef G8_LDA
#undef G8_LDB
#undef G8_MMA
#undef G8_WAIT_V
#undef G8_WAIT_L
#undef G8_BAR
#undef G8_SCHED
}
}

typedef GAS unsigned gu32;
#define XB_TMO      128
#define XB_XCNT(j)  (256  + 64 * (j))
#define XB_XSUB(j)  (1280 + 64 * (j))
#define XB_XGEN(j)  (2304 + 64 * (j))
#define XB_TOP      3328
#define XB_TOPGEN   3392
#define XCD_BAR_WORDS 3456
#define XB_SPIN_CAP (1u << 22)
DI unsigned xb_ld(unsigned* p)              { return __hip_atomic_load(p, __ATOMIC_RELAXED, __HIP_MEMORY_SCOPE_AGENT); }
DI unsigned xb_add(unsigned* p, unsigned v) { return __hip_atomic_fetch_add(p, v, __ATOMIC_RELAXED, __HIP_MEMORY_SCOPE_AGENT); }
DI unsigned xb_xcc_id() { return (unsigned)__builtin_amdgcn_s_getreg((3 << 11) | 20) & 0xFu; }
#define XB_SPIN(cond, bar) do { unsigned _sp = 0; while (cond) { __builtin_amdgcn_s_sleep(1); \
    if ((++_sp & 255u) == 0u) { if (xb_ld(&(bar)[XB_TMO])) break; if (_sp > XB_SPIN_CAP) { atomicAdd(&(bar)[XB_TMO], 1u); break; } } } } while (0)
struct XcdBarrier { unsigned* bar; unsigned x; volatile LAS unsigned* st; };
DI XcdBarrier xcd_barrier_post(unsigned* bar, volatile LAS unsigned* st) {
    XcdBarrier b; b.bar = bar; b.x = xb_xcc_id(); b.st = st;
    if (threadIdx.x == 0) st[2] = xb_add(&bar[XB_XCNT(b.x)], 1u);
    return b;
}
DI void xcd_barrier_complete(unsigned* bar, unsigned x, unsigned& nloc, unsigned& nx) {
    const unsigned G = gridDim.x * gridDim.y * gridDim.z;
    unsigned sum, cnt, mine, sp = 0u;
    for (;;) {
        sum = 0u; cnt = 0u; mine = 0u;
#pragma unroll
        for (unsigned j = 0; j < 16; ++j) { const unsigned c = xb_ld(&bar[XB_XCNT(j)]); sum += c; cnt += (c > 0u) ? 1u : 0u; mine = (j == x) ? c : mine; }
        if (sum == G) break;
        __builtin_amdgcn_s_sleep(1);
        if ((++sp & 255u) == 0u) { if (xb_ld(&bar[XB_TMO])) break; if (sp > XB_SPIN_CAP) { atomicAdd(&bar[XB_TMO], 1u); break; } }
    }
    nloc = mine > 0u ? mine : 1u; nx = cnt > 0u ? cnt : 1u;
}
DI void xcd_barrier(const XcdBarrier& b) {
    asm volatile("s_waitcnt vmcnt(0)" ::: "memory");
    __syncthreads();
    if (threadIdx.x == 0) {
        unsigned* bar = b.bar;
        __builtin_amdgcn_s_waitcnt(0);
        unsigned nloc = b.st[0], nx = b.st[1];
        if (nloc == 0u) { xcd_barrier_complete(bar, b.x, nloc, nx); b.st[0] = nloc; b.st[1] = nx; }
        const unsigned old = xb_add(&bar[XB_XSUB(b.x)], 1u);
        const unsigned gen = old / nloc;
        if (old + 1u == (gen + 1u) * nloc) {
            __builtin_amdgcn_fence(__ATOMIC_RELEASE, "agent");
            asm volatile("s_waitcnt vmcnt(0)" ::: "memory");
            const unsigned og = xb_add(&bar[XB_TOP], 1u);
            const unsigned tg = og / nx;
            if (og + 1u == (tg + 1u) * nx) xb_add(&bar[XB_TOPGEN], 1u);
            else XB_SPIN(xb_ld(&bar[XB_TOPGEN]) == tg, bar);
            __builtin_amdgcn_fence(__ATOMIC_ACQUIRE, "agent");
            xb_add(&bar[XB_XGEN(b.x)], 1u);
            asm volatile("s_waitcnt vmcnt(0)" ::: "memory");
        } else {
            XB_SPIN(xb_ld(&bar[XB_XGEN(b.x)]) == gen, bar);
            __builtin_amdgcn_fence(__ATOMIC_ACQUIRE, "agent");
            asm volatile("s_waitcnt vmcnt(0)" ::: "memory");
        }
    }
    __syncthreads();
}

constexpr int NWAVES = 8, NTHR = NWAVES * 64;
constexpr int RING_BYTES = 131072, LDS_BYTES = 147456, LDSCTL_OFF = LDS_BYTES - 1024, MISC_OFF = LDSCTL_OFF + 320;
constexpr size_t CTL_BYTES = 65536;
enum { PH_ALL = 0, PH_PRO = 11, PH_PROJ = 1, PH_ATTN = 2, PH_HGPRE = 3, PH_HGMAIN = 4, PH_WIDEN = 5, PH_WOUT = 6, PH_LN1 = 7, PH_PQ = 8, PH_ROUTE = 9, PH_EXPERTS = 10, PH_HGSCAN = 12 };
struct Args { const float* in[18]; float* out; unsigned char* ws; int ph, pass; };

struct Bufs {
    const bf16_t *WIN, *XBp; bf16_t *QK, *VIT, *HFQG, *MQ, *GATE;
};

struct SchedP1 {
    unsigned XBp, W; int G, c;
    DI bool next(int i, g8::Unit& u) const {
        const int L = i * G + c; if (L >= 2560) return false;
        if (L < 2048) { const int x = L & 7, off = L >> 3; u.pm = 8 * x + (off & 7); u.pn = off >> 3; u.kind = 0; u.dlb = 1;
            const int hp = u.pn < 12 ? (u.pn < 6 ? u.pn : u.pn - 6) : 0, dl = hp < 2 ? 1 : (hp < 4 ? 4 : 16);
            const int v0 = u.pm * 256, lb = v0 / S, vv = v0 % S, per = S / dl, r = vv / per, m0 = vv % per;
            u.dla = dl; u.a = XBp + (unsigned)(lb * S + m0 * dl + r) * D * 2u; u.b = W + (unsigned)u.pn * 256u * D * 2u; }
        else { const int idx = L - 2048; u.pm = idx & 7; u.pn = idx >> 3; u.kind = 1;
            const int dl = u.pm < 2 ? 1 : (u.pm < 4 ? 4 : (u.pm < 6 ? 16 : 1));
            const int v0 = u.pn * 256, lb = v0 / S, vv = v0 % S, per = S / dl, r = vv / per, m0 = vv % per;
            u.dla = 1; u.dlb = dl; u.a = W + (unsigned)(8192 + u.pm * 256) * D * 2u; u.b = XBp + (unsigned)(lb * S + m0 * dl + r) * D * 2u; }
        return true;
    }
};
DI int frag_row_off(int d0, int r32) { return (((d0 >> 4) * 64 + ((d0 >> 3) & 1) * 32 + r32) * 8); }
struct EpiP1 {
    static constexpr bool PERM = true, HOOK = false;
    char* pr; const float* b_gate;
    DI void hook(f32x4 (&)[2][2][4][2], const g8::Unit&, int, int, int, int, int) const {}
    DI void operator()(const f32x4 (&acc)[2][2][4][2], const g8::Unit& u, int wr, int wc, int fr, int fq) const {
        const int rowl = wr * 64 + fr, d0 = wc * 32 + 8 * fq;
        if (u.kind == 1) {
#pragma unroll
            for (int ai = 0; ai < 2; ++ai)
#pragma unroll
                for (int m = 0; m < 4; ++m) { const int R = u.pm * 256 + rowl + ai * 128 + m * 16;
#pragma unroll
                    for (int bj = 0; bj < 2; ++bj) { const f32x4 v0 = acc[ai][bj][m][0], v1 = acc[ai][bj][m][1];
                        const int c = u.pn * 256 + bj * 128 + d0;
                        if (R < 1536) {
                            const int gh = R >> 7, d = R & 127, lb = c >> 13, pos = c & (S - 1), kk = pos & 31;
                            bf16_t* blk = (bf16_t*)(pr + P_VT) + ((size_t)((lb * 12 + gh) * 256 + (pos >> 5))) * 4096 + (((d >> 5) * 2 + (kk >> 4)) * 64 + (d & 31)) * 8 + 4 * ((kk >> 3) & 1);
                            u32x2 wa, wb; wa.x = cvtpk(v0[0], v0[1]); wa.y = cvtpk(v0[2], v0[3]); wb.x = cvtpk(v1[0], v1[1]); wb.y = cvtpk(v1[2], v1[3]);
                            *(u32x2*)blk = wa; *(u32x2*)(blk + 32 * 8) = wb;
                        } else {
                            u32x4 w; w.x = cvtpk(v0[0], v0[1]); w.y = cvtpk(v0[2], v0[3]); w.z = cvtpk(v1[0], v1[1]); w.w = cvtpk(v1[2], v1[3]);
                            *(u32x4*)((bf16_t*)(pr + P_IT) + (size_t)(R - 1536) * MP + c) = w;
                        } } }
            return;
        }
        if (u.pn < 12 || u.pn == 18 || u.pn == 19) {
#pragma unroll
            for (int ai = 0; ai < 2; ++ai)
#pragma unroll
                for (int m = 0; m < 4; ++m) { const int row = u.pm * 256 + rowl + ai * 128 + m * 16;
#pragma unroll
                    for (int bj = 0; bj < 2; ++bj) { const f32x4 v0 = acc[ai][bj][m][0], v1 = acc[ai][bj][m][1];
                        u32x4 w; w.x = cvtpk(v0[0], v0[1]); w.y = cvtpk(v0[2], v0[3]); w.z = cvtpk(v1[0], v1[1]); w.w = cvtpk(v1[2], v1[3]);
                        bf16_t* dst;
                        if (u.pn < 12) { const int hh = u.pn * 2 + bj, qk = hh >= 12 ? 1 : 0, gh = hh - 12 * qk;
                            const int lb = row >> 13, pos = row & (S - 1);
                            dst = (bf16_t*)(pr + P_QK) + ((size_t)(((qk * BPP + lb) * 12 + gh) * 256 + (pos >> 5))) * 4096 + frag_row_off(d0, pos & 31); }
                        else { const int h = (u.pn - 18) * 2 + bj; dst = (bf16_t*)(pr + P_MQ) + ((size_t)((row >> 5) * 4 + h)) * 4096 + frag_row_off(d0, row & 31); }
                        *(u32x4*)dst = w; } }
            return;
        }
        bf16_t* base; int ldc, colt; bool gate = false;
        if (u.pn < 18) { base = (bf16_t*)(pr + P_HFQG); ldc = 1536; colt = (u.pn - 12) * 256; }
        else { base = (bf16_t*)(pr + P_GATE); ldc = 3072; colt = (u.pn - 20) * 256; gate = true; }
        const int row0 = u.pm * 256 + rowl, col0 = colt + d0;
        f32x4 bv[2][2];
#pragma unroll
        for (int bj = 0; bj < 2; ++bj)
#pragma unroll
            for (int n = 0; n < 2; ++n) bv[bj][n] = gate ? *(const f32x4*)(b_gate + col0 + bj * 128 + 4 * n) : (f32x4){0.f, 0.f, 0.f, 0.f};
#pragma unroll
        for (int ai = 0; ai < 2; ++ai)
#pragma unroll
            for (int m = 0; m < 4; ++m) { bf16_t* rowp = base + (size_t)(row0 + ai * 128 + m * 16) * ldc + col0;
#pragma unroll
                for (int bj = 0; bj < 2; ++bj) { f32x4 v0 = acc[ai][bj][m][0], v1 = acc[ai][bj][m][1];
                    if (gate) { v0 = v0 + bv[bj][0]; v1 = v1 + bv[bj][1];
#pragma unroll
                        for (int e = 0; e < 4; ++e) { v0[e] = fast_sigmoid(v0[e]); v1[e] = fast_sigmoid(v1[e]); } }
                    u32x4 w; w.x = cvtpk(v0[0], v0[1]); w.y = cvtpk(v0[2], v0[3]); w.z = cvtpk(v1[0], v1[1]); w.w = cvtpk(v1[2], v1[3]);
                    *(u32x4*)(rowp + bj * 128) = w; } }
    }
};

typedef float f32x16 __attribute__((ext_vector_type(16)));
typedef short s16x4 __attribute__((ext_vector_type(4)));
DI int crow(int r, int hi) { return (r & 3) + 8 * (r >> 2) + 4 * hi; }
DI float xor32f(float v) { return __shfl_xor(v, 32); }
#define MFMA32(a, b, c) __builtin_amdgcn_mfma_f32_32x32x16_bf16((a), (b), (c), 0, 0, 0)
DI bf16x8 pack8(const f32x16& p, int s) {
    u32x4 w; w.x = cvtpk(p[8 * s + 0], p[8 * s + 1]); w.y = cvtpk(p[8 * s + 2], p[8 * s + 3]); w.z = cvtpk(p[8 * s + 4], p[8 * s + 5]); w.w = cvtpk(p[8 * s + 6], p[8 * s + 7]);
    return __builtin_bit_cast(bf16x8, w);
}
DI bf16x8 ldvt(const bf16_t* vp) {
    const s16x4 lo = *(const s16x4*)vp, hi4 = *(const s16x4*)(vp + 8);
    return __builtin_shufflevector(lo, hi4, 0, 1, 2, 3, 4, 5, 6, 7);
}
constexpr int DIL_TASKS = BPP * 12 * (S / 32);
constexpr int MEM_TASKS = (MP / 32) * 4;
DI void attn_dil_wave(const bf16_t* __restrict__ QK, const bf16_t* __restrict__ VT, const LAS float* btab, bf16_t* __restrict__ OG, float* __restrict__ LSE, int task, int lane) {
    const int r32 = lane & 31, hi = lane >> 5;
    const int q32 = task & 255, gh = (task >> 8) % 12, lb = task / (256 * 12);
    const int g = gh >> 2, h = gh & 3, dl = dil_of(g), per = S / dl;
    const int tok0 = q32 * 32, r = tok0 / per, m0 = tok0 % per;
    const size_t rowq = (size_t)lb * S + (size_t)(m0 + r32) * dl + r;
    bf16x8 qf[8];
    const int tile0 = (r * per + m0) >> 5;
    { const bf16_t* qp = QK + ((size_t)((lb * 12 + gh) * 256 + tile0)) * 4096 + lane * 8;
#pragma unroll
      for (int ks = 0; ks < 8; ++ks) qf[ks] = *(const bf16x8*)(qp + ks * 512); }
    const LAS float* bt = btab + g * 129 * 4 + h;
    f32x16 o[4];
#pragma unroll
    for (int dt = 0; dt < 4; ++dt)
#pragma unroll
        for (int i = 0; i < 16; ++i) o[dt][i] = 0.f;
    float mrun = -INFINITY, sum = 0.f;
    const bf16_t* vbase = VT + ((size_t)((lb * 12 + gh) * 256 + tile0 - 4)) * 4096 + lane * 8;
    const bf16_t* kbase = QK + ((size_t)(((BPP + lb) * 12 + gh) * 256 + tile0 - 4)) * 4096 + lane * 8;
    const int kt0 = (m0 >= 128 ? 0 : (128 - m0) >> 5);
    bf16x8 kf[8], vf[8];
#pragma unroll
    for (int ks = 0; ks < 8; ++ks) kf[ks] = *(const bf16x8*)(kbase + (size_t)kt0 * 4096 + ks * 512);
#pragma unroll 1
    for (int kt = kt0; kt < 5; ++kt) {
#pragma unroll
        for (int i = 0; i < 8; ++i) vf[i] = *(const bf16x8*)(vbase + (size_t)kt * 4096 + i * 512);
        f32x16 sc;
#pragma unroll
        for (int i = 0; i < 16; ++i) sc[i] = 0.f;
#pragma unroll
        for (int ks = 0; ks < 8; ++ks) sc = MFMA32(kf[ks], qf[ks], sc);
        if (kt < 4) {
#pragma unroll
            for (int ks = 0; ks < 8; ++ks) kf[ks] = *(const bf16x8*)(kbase + (size_t)(kt + 1) * 4096 + ks * 512);
        }
        float mx = -INFINITY;
        if (kt == 0 || kt == 4) {
#pragma unroll
            for (int i = 0; i < 16; ++i) {
                const int delta = 128 - 32 * kt + r32 - crow(i, hi);
                const bool valid = (delta >= 0) && (delta <= 128);
                const int di = delta < 0 ? 0 : (delta > 128 ? 128 : delta);
                const float x = sc[i] * (QSCALE * LOG2E) + bt[di * 4];
                sc[i] = valid ? x : -INFINITY; mx = fmaxf(mx, sc[i]);
            }
        } else {
            const LAS float* btk = bt + (128 - 32 * kt + r32 - 4 * hi) * 4;
#pragma unroll
            for (int i = 0; i < 16; ++i) { sc[i] = sc[i] * (QSCALE * LOG2E) + btk[-4 * ((i & 3) + 8 * (i >> 2))]; mx = fmaxf(mx, sc[i]); }
        }
        mx = pair_max(mx);
        const float mnew = fmaxf(mrun, mx); const float f = __builtin_amdgcn_exp2f(mrun - mnew);
        sum *= f;
#pragma unroll
        for (int dt = 0; dt < 4; ++dt)
#pragma unroll
            for (int i = 0; i < 16; ++i) o[dt][i] *= f;
        mrun = mnew;
        float ps = 0.f;
#pragma unroll
        for (int i = 0; i < 16; ++i) { sc[i] = __builtin_amdgcn_exp2f(sc[i] - mnew); ps += sc[i]; }
        ps = pair_sum(ps); sum += ps;
#pragma unroll
        for (int s = 0; s < 2; ++s) {
            const bf16x8 pb = pack8(sc, s);
#pragma unroll
            for (int dt = 0; dt < 4; ++dt) o[dt] = MFMA32(vf[dt * 2 + s], pb, o[dt]);
        }
    }
    const float inv = 1.f / sum;
    bf16_t* op = OG + rowq * 1536 + g * 512 + h * 128 + 4 * hi;
#pragma unroll
    for (int dt = 0; dt < 4; ++dt)
#pragma unroll
        for (int a = 0; a < 4; ++a) { u32x2 w; w.x = cvtpk(o[dt][4 * a] * inv, o[dt][4 * a + 1] * inv); w.y = cvtpk(o[dt][4 * a + 2] * inv, o[dt][4 * a + 3] * inv); *(u32x2*)(op + 32 * dt + 8 * a) = w; }
    if (hi == 0) LSE[rowq * 12 + gh] = (mrun + __builtin_amdgcn_logf(sum)) * 0.6931471805599453f;
}
DI void attn_mem_wave(const bf16_t* __restrict__ MQ, const bf16_t* __restrict__ MK, const bf16_t* __restrict__ MVT, bf16_t* __restrict__ BR, int task, int batch0, int lane) {
    const int r32 = lane & 31, hi = lane >> 5;
    const int h = task & 3, blk = task >> 2;
    const size_t rowq = (size_t)blk * 32 + r32; const int b = batch0 + blk * 32 / S;
    bf16x8 qf[8];
    { const bf16_t* qp = MQ + ((size_t)(blk * 4 + h)) * 4096 + lane * 8;
#pragma unroll
      for (int ks = 0; ks < 8; ++ks) qf[ks] = *(const bf16x8*)(qp + ks * 512); }
    f32x16 o[4];
#pragma unroll
    for (int dt = 0; dt < 4; ++dt)
#pragma unroll
        for (int i = 0; i < 16; ++i) o[dt][i] = 0.f;
    float mrun = -INFINITY, sum = 0.f;
    const bf16_t* vbase = MVT + ((size_t)((b * 4 + h) * 8)) * 4096 + lane * 8;
    const bf16_t* kbase = MK + ((size_t)((b * 4 + h) * 8)) * 4096 + lane * 8;
#pragma unroll 1
    for (int c = 0; c < 4; ++c) {
        bf16x8 vf[16];
#pragma unroll
        for (int i = 0; i < 16; ++i) vf[i] = *(const bf16x8*)(vbase + (size_t)(c * 2 + (i >> 3)) * 4096 + (i & 7) * 512);
        f32x16 sc[2]; float mx = -INFINITY;
#pragma unroll
        for (int kt = 0; kt < 2; ++kt) {
            const bf16_t* kp = kbase + (size_t)(c * 2 + kt) * 4096;
            f32x16 acc;
#pragma unroll
            for (int i = 0; i < 16; ++i) acc[i] = 0.f;
#pragma unroll
            for (int ks = 0; ks < 8; ++ks) { const bf16x8 kf = *(const bf16x8*)(kp + ks * 512); acc = MFMA32(kf, qf[ks], acc); }
#pragma unroll
            for (int i = 0; i < 16; ++i) { sc[kt][i] = acc[i] * (QSCALE * LOG2E); mx = fmaxf(mx, sc[kt][i]); }
            asm volatile("" ::: "memory");
        }
        mx = pair_max(mx);
        const float mnew = fmaxf(mrun, mx); const float f = __builtin_amdgcn_exp2f(mrun - mnew);
        sum *= f;
#pragma unroll
        for (int dt = 0; dt < 4; ++dt)
#pragma unroll
            for (int i = 0; i < 16; ++i) o[dt][i] *= f;
        mrun = mnew;
        float ps = 0.f;
#pragma unroll
        for (int kt = 0; kt < 2; ++kt)
#pragma unroll
            for (int i = 0; i < 16; ++i) { sc[kt][i] = __builtin_amdgcn_exp2f(sc[kt][i] - mnew); ps += sc[kt][i]; }
        ps = pair_sum(ps); sum += ps;
#pragma unroll
        for (int kt = 0; kt < 2; ++kt)
#pragma unroll
            for (int s = 0; s < 2; ++s) {
                const bf16x8 pb = pack8(sc[kt], s);
#pragma unroll
                for (int dt = 0; dt < 4; ++dt) o[dt] = MFMA32(vf[kt * 8 + dt * 2 + s], pb, o[dt]);
                asm volatile("" ::: "memory");
            }
    }
    const float inv = 1.f / sum;
    bf16_t* op = BR + rowq * 1536 + 1024 + h * 128 + 4 * hi;
#pragma unroll
    for (int dt = 0; dt < 4; ++dt)
#pragma unroll
        for (int a = 0; a < 4; ++a) { u32x2 w; w.x = cvtpk(o[dt][4 * a] * inv, o[dt][4 * a + 1] * inv); w.y = cvtpk(o[dt][4 * a + 2] * inv, o[dt][4 * a + 3] * inv); *(u32x2*)(op + 32 * dt + 8 * a) = w; }
}

constexpr int HG_SCH = 4, HG_UPS = S / 64 / HG_SCH  , HG_UNITS = BPP * 4 * HG_UPS  ;
constexpr int HG_ROW = 136, HG_KT_ROW = 72;
constexpr int HG_KP = 0, HG_QP = 64 * HG_ROW * 2, HG_QPP = 2 * HG_QP, HG_KPPT = 3 * HG_QP, HG_DEC = HG_KPPT + 128 * HG_KT_ROW * 2, HG_SSQ = HG_DEC + 512, HG_PSUM = HG_SSQ + 1024, HG_UNIT_BYTES = HG_PSUM + 2048;
DI bf16x8 lds_ld2x8(const LAS unsigned char* p) {
    const s16x4 lo = *(const LAS s16x4*)p, hi4 = *(const LAS s16x4*)(p + 16);
    return __builtin_shufflevector(lo, hi4, 0, 1, 2, 3, 4, 5, 6, 7);
}
DI int opq(int x) { asm volatile("" : "+v"(x)); return x; }
DI float lds_bf(const LAS unsigned char* p) { return __uint_as_float((unsigned)(*(const LAS unsigned short*)p) << 16); }
template <bool MAIN>
DI void hgrn_unit(LAS unsigned char* ul, int unit, int u, const bf16_t* __restrict__ HFQG, const bf16_t* __restrict__ IT, const float* __restrict__ lbv, const float* __restrict__ nwv,
                  float* HSTL, float* HSTD, const float* __restrict__ SIN, bf16_t* __restrict__ BR) {
    constexpr int NX = MAIN ? 4 : 2;
    const int lane = u & 63, w = u >> 6, r32 = lane & 31, hi = lane >> 5, dvt = w & 3, wh = w >> 2;
    const int seq = unit / HG_UPS, j = unit % HG_UPS, lb = seq >> 2, h = seq & 3;
    const int dk = u & 127, qt = u >> 7, cb = 16 * qt;
    const float lbd = lbv[h * 128 + dk];
    const size_t row0 = (size_t)lb * S + (size_t)j * (64 * HG_SCH);
    LAS unsigned char* Kp = ul + HG_KP; LAS unsigned char* Qp = ul + HG_QP; LAS unsigned char* Qpp = ul + HG_QPP; LAS unsigned char* KppT = ul + HG_KPPT;
    LAS float* dec = (LAS float*)(ul + HG_DEC); LAS float* ssq = (LAS float*)(ul + HG_SSQ); LAS float* psum = (LAS float*)(ul + HG_PSUM);
    const int dk0 = MAIN ? 0 : 64 * wh;
    f32x16 X[NX];
    if (MAIN) {
        const float* Sp = SIN + (size_t)unit * 16384 + 32 * dvt + r32;
#pragma unroll
        for (int t = 0; t < NX; ++t)
#pragma unroll
            for (int i = 0; i < 16; ++i) X[t][i] = Sp[(size_t)(32 * t + crow(i, hi)) * 128];
    } else {
#pragma unroll
        for (int t = 0; t < NX; ++t)
#pragma unroll
            for (int i = 0; i < 16; ++i) X[t][i] = 0.f;
    }
    float atot = 0.f;
    u32x4 sf[2], sq[2];
    {
        const int sc0 = u >> 4, sch = (u & 15) * 8;
        const bf16_t* fp = HFQG + (row0 + sc0) * 1536 + h * 128 + sch;
#pragma unroll
        for (int i = 0; i < 2; ++i) { sf[i] = *(const u32x4*)(fp + (size_t)(32 * i) * 1536); if (MAIN) sq[i] = *(const u32x4*)(fp + (size_t)(32 * i) * 1536 + 512); }
    }
#pragma unroll 1
    for (int ch = 0; ch < HG_SCH; ++ch) {
        const size_t rc = row0 + (size_t)ch * 64;
        {
            const int sc0 = opq(u) >> 4, sch = (opq(u) & 15) * 8;
#pragma unroll
            for (int i = 0; i < 2; ++i) { *(LAS u32x4*)(Kp + ((sc0 + 32 * i) * HG_ROW + sch) * 2) = sf[i]; if (MAIN) *(LAS u32x4*)(Qp + ((sc0 + 32 * i) * HG_ROW + sch) * 2) = sq[i]; }
        }
        __syncthreads();
        float fv[16], lf[16];
        {
            float s = 0.f;
#pragma unroll
            for (int i = 0; i < 16; ++i) { fv[i] = lbd + (1.f - lbd) * fast_sigmoid(lds_bf(Kp + ((cb + i) * HG_ROW + dk) * 2)); lf[i] = __builtin_amdgcn_logf(fv[i]); s += lf[i]; }
            psum[qt * 128 + dk] = s;
        }
        __syncthreads();
        {
            const float p0 = psum[dk], p1 = psum[128 + dk], p2 = psum[256 + dk], p3 = psum[384 + dk];
            const float amid = p0 + p1, alast = (p0 + p1) + (p2 + p3);
            float run = qt == 0 ? 0.f : (qt == 1 ? p0 : (qt == 2 ? amid : amid + p2));
            atot += alast;
            const float Ela = __builtin_amdgcn_exp2f(alast - amid), Ea = __builtin_amdgcn_exp2f(amid);
#pragma unroll
            for (int c8 = 0; c8 < 2; ++c8) {
                float kt[8];
#pragma unroll
                for (int e = 0; e < 8; ++e) { const int i = 8 * c8 + e, c = cb + i; run += lf[i]; const float key = 1.f - fv[i];
                    const float e1 = __builtin_amdgcn_exp2f(amid - run);
                    const float kp = key * e1;
                    kt[e] = kp * Ela;
                    if (MAIN) { *(LAS bf16_t*)(Kp + (c * HG_ROW + dk) * 2) = f2bf(kp);
                        const float qp = lds_bf(Qp + (c * HG_ROW + dk) * 2) * __builtin_amdgcn_rcpf(e1);
                        *(LAS bf16_t*)(Qp + (c * HG_ROW + dk) * 2) = f2bf(qp);
                        *(LAS bf16_t*)(Qpp + (c * HG_ROW + dk) * 2) = f2bf(qp * Ea); } }
                u32x4 wv; wv.x = cvtpk(kt[0], kt[1]); wv.y = cvtpk(kt[2], kt[3]); wv.z = cvtpk(kt[4], kt[5]); wv.w = cvtpk(kt[6], kt[7]);
                *(LAS u32x4*)(KppT + (dk * HG_KT_ROW + cb + 8 * c8) * 2) = wv;
            }
            if (qt == 0) dec[dk] = __builtin_amdgcn_exp2f(alast);
        }
        if (ch + 1 < HG_SCH) {
            const int sc0 = opq(u) >> 4, sch = (opq(u) & 15) * 8;
            const bf16_t* fp = HFQG + (rc + 64 + sc0) * 1536 + h * 128 + sch;
#pragma unroll
            for (int i = 0; i < 2; ++i) { sf[i] = *(const u32x4*)(fp + (size_t)(32 * i) * 1536); if (MAIN) sq[i] = *(const u32x4*)(fp + (size_t)(32 * i) * 1536 + 512); }
        }
        __syncthreads();
        f32x16 o;
        const bf16_t* itrow = IT + (size_t)(h * 128 + 32 * dvt + opq(r32)) * MP;
        if (MAIN) {
#pragma unroll
            for (int i = 0; i < 16; ++i) o[i] = 0.f;
            const LAS unsigned char* qrow = Qpp + ((32 * wh + r32) * HG_ROW) * 2;
#pragma unroll
            for (int t = 0; t < 4; ++t)
#pragma unroll
                for (int step = 0; step < 2; ++step) { o = MFMA32(pack8(X[t], step), lds_ld2x8(qrow + (32 * t + 16 * step + 4 * hi) * 2), o); }
            __builtin_amdgcn_sched_barrier(0);
            const int r32m = opq(r32);
            const LAS unsigned char* qprow = Qp + ((32 * wh + r32) * HG_ROW) * 2;
            {
                f32x16 sc;
#pragma unroll
                for (int i = 0; i < 16; ++i) sc[i] = 0.f;
#pragma unroll
                for (int ks = 0; ks < 8; ++ks) { const int cof = (16 * ks + 8 * hi) * 2; sc = MFMA32(*(const LAS bf16x8*)(Kp + (r32 * HG_ROW) * 2 + cof), *(const LAS bf16x8*)(qprow + cof), sc); }
                if (wh == 0) {
#pragma unroll
                    for (int i = 0; i < 16; ++i) sc[i] = (crow(i, hi) <= r32m) ? sc[i] : 0.f;
                }
#pragma unroll
                for (int step = 0; step < 2; ++step) o = MFMA32(ldvt(itrow + rc + 16 * step + 4 * hi), pack8(sc, step), o);
                __builtin_amdgcn_sched_barrier(0);
            }
            if (wh == 1) {
                f32x16 sc;
#pragma unroll
                for (int i = 0; i < 16; ++i) sc[i] = 0.f;
#pragma unroll
                for (int ks = 0; ks < 8; ++ks) { const int cof = (16 * ks + 8 * hi) * 2; sc = MFMA32(*(const LAS bf16x8*)(Kp + ((32 + r32) * HG_ROW) * 2 + cof), *(const LAS bf16x8*)(qprow + cof), sc); }
#pragma unroll
                for (int i = 0; i < 16; ++i) sc[i] = (crow(i, hi) <= r32m) ? sc[i] : 0.f;
#pragma unroll
                for (int step = 0; step < 2; ++step) o = MFMA32(ldvt(itrow + rc + 32 + 16 * step + 4 * hi), pack8(sc, step), o);
                __builtin_amdgcn_sched_barrier(0);
            }
        }
        {
            bf16x8 ib[4];
#pragma unroll
            for (int ks = 0; ks < 4; ++ks) ib[ks] = *(const bf16x8*)(itrow + rc + 16 * ks + 8 * hi);
#pragma unroll
            for (int t = 0; t < NX; ++t) {
#pragma unroll
                for (int i = 0; i < 16; ++i) X[t][i] *= dec[dk0 + 32 * t + crow(i, hi)];
#pragma unroll
                for (int ks = 0; ks < 4; ++ks) { const bf16x8 ka = *(const LAS bf16x8*)(KppT + ((dk0 + 32 * t + r32) * HG_KT_ROW + 16 * ks + 8 * hi) * 2); X[t] = MFMA32(ka, ib[ks], X[t]); }
                __builtin_amdgcn_sched_barrier(0);
            }
        }
        if (MAIN) {
            float q2 = 0.f;
#pragma unroll
            for (int i = 0; i < 16; ++i) q2 += o[i] * o[i];
            q2 = pair_sum(q2); if (hi == 0) ssq[dvt * 64 + 32 * wh + r32] = q2;
        }
        __syncthreads();
        if (MAIN) {
            const int r32o = opq(r32), hio = opq(hi);
            const int c = 32 * wh + r32o; const float tot = ssq[c] + ssq[64 + c] + ssq[128 + c] + ssq[192 + c];
            const float rs = rsqrtf(tot * (1.f / 128.f) + LN_EPS);
            const size_t row = rc + c; const int col = h * 128 + 32 * dvt + 4 * hio;
#pragma unroll
            for (int a4 = 0; a4 < 4; ++a4) {
                const u32x2 gw = *(const u32x2*)(HFQG + row * 1536 + 1024 + col + 8 * a4); const f32x4 nw4 = *(const f32x4*)(nwv + col + 8 * a4);
                const float g0 = __uint_as_float(gw.x << 16), g1 = __uint_as_float(gw.x & 0xffff0000u), g2 = __uint_as_float(gw.y << 16), g3 = __uint_as_float(gw.y & 0xffff0000u);
                const float v0 = o[4 * a4] * rs * nw4[0] * g0 * fast_sigmoid(g0), v1 = o[4 * a4 + 1] * rs * nw4[1] * g1 * fast_sigmoid(g1);
                const float v2 = o[4 * a4 + 2] * rs * nw4[2] * g2 * fast_sigmoid(g2), v3 = o[4 * a4 + 3] * rs * nw4[3] * g3 * fast_sigmoid(g3);
                u32x2 wv; wv.x = cvtpk(v0, v1); wv.y = cvtpk(v2, v3);
                *(u32x2*)(BR + row * 1536 + 512 + col + 8 * a4) = wv;
            }
        }
    }
    if (!MAIN) {
        float* L = HSTL + (size_t)unit * 16384 + 32 * dvt + r32;
#pragma unroll
        for (int t = 0; t < NX; ++t)
#pragma unroll
            for (int i = 0; i < 16; ++i) L[(size_t)(dk0 + 32 * t + crow(i, hi)) * 128] = X[t][i];
        if (qt == 0) HSTD[(size_t)unit * 128 + dk] = __builtin_amdgcn_exp2f(atot);
    }
}
DI void hgrn_scan(const float* __restrict__ HSTL, const float* __restrict__ HSTD, float* __restrict__ SIN, int gt) {
    if (gt >= BPP * 4 * 16384) return;
    const int seq = gt >> 14, el = gt & 16383, dkk = el >> 7;
    float st = 0.f;
    for (int j = 0; j < HG_UPS; ++j) { const size_t uo = (size_t)(seq * HG_UPS + j); SIN[uo * 16384 + el] = st; st = HSTD[uo * 128 + dkk] * st + HSTL[uo * 16384 + el]; }
}

struct SchedRows {
    unsigned A, B; int K, nN, nU, G, c;
    DI bool next(int i, g8::Unit& u) const {
        const int L = i * G + c; if (L >= nU) return false;
        const int x = L & 7, off = L >> 3, grp = off / (8 * nN), o2 = off % (8 * nN);
        const int ppx = nU / nN / 8;
        u.pm = x * ppx + 8 * grp + (o2 & 7); u.pn = o2 >> 3; u.kind = 0; u.dla = 1; u.dlb = 1;
        u.a = A + (unsigned)u.pm * 256u * K * 2u; u.b = B + (unsigned)u.pn * 256u * K * 2u; return true;
    }
};
DI void unpack8(const u32x4 w, float (&f)[8]) {
    f[0] = __uint_as_float(w.x << 16); f[1] = __uint_as_float(w.x & 0xffff0000u); f[2] = __uint_as_float(w.y << 16); f[3] = __uint_as_float(w.y & 0xffff0000u);
    f[4] = __uint_as_float(w.z << 16); f[5] = __uint_as_float(w.z & 0xffff0000u); f[6] = __uint_as_float(w.w << 16); f[7] = __uint_as_float(w.w & 0xffff0000u);
}
struct EpiWidenF {
    static constexpr bool PERM = true, HOOK = true;
    const bf16_t* GATE; bf16_t* MERGED;
    DI void hook(f32x4 (&acc)[2][2][4][2], const g8::Unit& u, int t, int wr, int wc, int fr, int fq) const {
        if (t != 8 && t != 16) return;
        const int g = (t >> 3) - 1;
        const int row0 = u.pm * 256 + wr * 64 + fr, col0 = u.pn * 256 + wc * 32 + 8 * fq;
#pragma unroll
        for (int ai = 0; ai < 2; ++ai)
#pragma unroll
            for (int m = 0; m < 4; ++m) { const bf16_t* gp = GATE + (size_t)(row0 + ai * 128 + m * 16) * 3072 + g * 1024 + col0;
#pragma unroll
                for (int bj = 0; bj < 2; ++bj) { float ga[8], gb[8]; unpack8(*(const u32x4*)(gp + bj * 128), ga); unpack8(*(const u32x4*)(gp + 1024 + bj * 128), gb);
#pragma unroll
                    for (int e = 0; e < 4; ++e) { acc[ai][bj][m][0][e] *= ga[e] * __builtin_amdgcn_rcpf(gb[e]); acc[ai][bj][m][1][e] *= ga[4 + e] * __builtin_amdgcn_rcpf(gb[4 + e]); } } }
    }
    DI void operator()(const f32x4 (&acc)[2][2][4][2], const g8::Unit& u, int wr, int wc, int fr, int fq) const {
        const int row0 = u.pm * 256 + wr * 64 + fr, col0 = u.pn * 256 + wc * 32 + 8 * fq;
#pragma unroll
        for (int ai = 0; ai < 2; ++ai)
#pragma unroll
            for (int m = 0; m < 4; ++m) { const size_t row = (size_t)(row0 + ai * 128 + m * 16);
#pragma unroll
                for (int bj = 0; bj < 2; ++bj) { float gc[8]; unpack8(*(const u32x4*)(GATE + row * 3072 + 2048 + col0 + bj * 128), gc);
                    const f32x4 v0 = acc[ai][bj][m][0], v1 = acc[ai][bj][m][1];
                    u32x4 w; w.x = cvtpk(v0[0] * gc[0], v0[1] * gc[1]); w.y = cvtpk(v0[2] * gc[2], v0[3] * gc[3]); w.z = cvtpk(v1[0] * gc[4], v1[1] * gc[5]); w.w = cvtpk(v1[2] * gc[6], v1[3] * gc[7]);
                    *(u32x4*)(MERGED + row * 1024 + col0 + bj * 128) = w; } }
    }
};
struct EpiScores {
    static constexpr bool PERM = true, HOOK = false;
    bf16_t* SC;
    DI void hook(f32x4 (&)[2][2][4][2], const g8::Unit&, int, int, int, int, int) const {}
    DI void operator()(const f32x4 (&acc)[2][2][4][2], const g8::Unit& u, int wr, int wc, int fr, int fq) const {
        const int rowl = wr * 64 + fr, d0 = wc * 32 + 8 * fq;
#pragma unroll
        for (int ai = 0; ai < 2; ++ai)
#pragma unroll
            for (int m = 0; m < 4; ++m) { const int row = u.pm * 256 + rowl + ai * 128 + m * 16;
#pragma unroll
                for (int bj = 0; bj < 2; ++bj) { const f32x4 v0 = acc[ai][bj][m][0], v1 = acc[ai][bj][m][1];
                    u32x4 w; w.x = cvtpk(v0[0], v0[1]); w.y = cvtpk(v0[2], v0[3]); w.z = cvtpk(v1[0], v1[1]); w.w = cvtpk(v1[2], v1[3]);
                    *(u32x4*)(SC + ((size_t)((row >> 5) * 16 + u.pn * 2 + bj)) * 4096 + frag_row_off(d0, row & 31)) = w; } }
    }
};
struct EpiPlainB16 {
    static constexpr bool PERM = true, HOOK = false;
    bf16_t* C; int ldc, pad;
    DI void hook(f32x4 (&)[2][2][4][2], const g8::Unit&, int, int, int, int, int) const {}
    DI void operator()(const f32x4 (&acc)[2][2][4][2], const g8::Unit& u, int wr, int wc, int fr, int fq) const {
        const int row0 = u.pm * 256 + wr * 64 + fr, col0 = u.pn * 256 + wc * 32 + 8 * fq;
#pragma unroll
        for (int ai = 0; ai < 2; ++ai)
#pragma unroll
            for (int m = 0; m < 4; ++m) { bf16_t* rowp = C + (size_t)(row0 + ai * 128 + m * 16) * ldc + col0;
#pragma unroll
                for (int bj = 0; bj < 2; ++bj) { const f32x4 v0 = acc[ai][bj][m][0], v1 = acc[ai][bj][m][1];
                    u32x4 w; w.x = cvtpk(v0[0], v0[1]); w.y = cvtpk(v0[2], v0[3]); w.z = cvtpk(v1[0], v1[1]); w.w = cvtpk(v1[2], v1[3]);
                    *(u32x4*)(rowp + bj * 128) = w; } }
    }
};
DI void lse_merge_items(const bf16_t* __restrict__ OG, const float* __restrict__ LSE, bf16_t* __restrict__ BR, int first, int stride) {
    for (int it = first; it < MP * 64; it += stride) {
        const int row = it >> 6, c8 = it & 63, h = c8 >> 4;
        const float l0 = LSE[(size_t)row * 12 + h], l1 = LSE[(size_t)row * 12 + 4 + h], l2 = LSE[(size_t)row * 12 + 8 + h];
        const float mx = fmaxf(l0, fmaxf(l1, l2)); const float e0 = __expf(l0 - mx), e1 = __expf(l1 - mx), e2 = __expf(l2 - mx); const float inv = 1.f / (e0 + e1 + e2);
        const bf16_t* og = OG + (size_t)row * 1536 + c8 * 8;
        float a[8], b[8], c[8]; unpack8(*(const u32x4*)og, a); unpack8(*(const u32x4*)(og + 512), b); unpack8(*(const u32x4*)(og + 1024), c);
        float r[8];
#pragma unroll
        for (int e = 0; e < 8; ++e) r[e] = (e0 * a[e] + e1 * b[e] + e2 * c[e]) * inv;
        u32x4 w; w.x = cvtpk(r[0], r[1]); w.y = cvtpk(r[2], r[3]); w.z = cvtpk(r[4], r[5]); w.w = cvtpk(r[6], r[7]);
        *(u32x4*)(BR + (size_t)row * 1536 + c8 * 8) = w;
    }
}
DI void ln1_rows(const bf16_t* __restrict__ x, const bf16_t* __restrict__ mix, const float* __restrict__ g, const float* __restrict__ b, bf16_t* __restrict__ h1b, unsigned char* __restrict__ h1q, float* __restrict__ hsc, int wave0, int nwaves, int lane) {
    for (int row = wave0; row < MP; row += nwaves) {
        const u32x4 xa = *(const u32x4*)(x + (size_t)row * D + 16 * lane), xb = *(const u32x4*)(x + (size_t)row * D + 16 * lane + 8);
        float xf[16]; unpack8(xa, *(float(*)[8])&xf[0]); unpack8(xb, *(float(*)[8])&xf[8]);
        const u32x4 ma = *(const u32x4*)(mix + (size_t)row * D + 16 * lane), mb = *(const u32x4*)(mix + (size_t)row * D + 16 * lane + 8);
        float mf[16]; unpack8(ma, *(float(*)[8])&mf[0]); unpack8(mb, *(float(*)[8])&mf[8]);
        f32x4 v[4]; float s = 0.f;
#pragma unroll
        for (int j = 0; j < 4; ++j) {
#pragma unroll
            for (int e = 0; e < 4; ++e) { v[j][e] = xf[4 * j + e] * ALPHA + mf[4 * j + e]; s += v[j][e]; } }
        const float mean = wave_sum(s) * (1.f / D); float q = 0.f;
#pragma unroll
        for (int j = 0; j < 4; ++j) { v[j] = v[j] - mean; q += (v[j][0] * v[j][0] + v[j][1] * v[j][1]) + (v[j][2] * v[j][2] + v[j][3] * v[j][3]); }
        const float rstd = rsqrtf(wave_sum(q) * (1.f / D) + LN_EPS);
        u32x4 o0, o1; float amax = 0.f;
#pragma unroll
        for (int j = 0; j < 4; ++j) { const f32x4 gg = *(const f32x4*)(g + 16 * lane + 4 * j), bb = *(const f32x4*)(b + 16 * lane + 4 * j); const f32x4 o = v[j] * rstd * gg + bb; v[j] = o;
            amax = fmaxf(amax, fmaxf(fmaxf(fabsf(o[0]), fabsf(o[1])), fmaxf(fabsf(o[2]), fabsf(o[3]))));
            if (j < 2) { o0[2 * j] = cvtpk(o[0], o[1]); o0[2 * j + 1] = cvtpk(o[2], o[3]); } else { o1[2 * (j - 2)] = cvtpk(o[0], o[1]); o1[2 * (j - 2) + 1] = cvtpk(o[2], o[3]); } }
        *(u32x4*)(h1b + (size_t)row * D + 16 * lane) = o0; *(u32x4*)(h1b + (size_t)row * D + 16 * lane + 8) = o1;
        amax = wave_max(amax); const float qs = amax > 0.f ? 127.f / amax : 1.f;
        u32x4 qv;
#pragma unroll
        for (int j = 0; j < 4; ++j) qv[j] = ((unsigned)__float2int_rn(v[j][0] * qs) & 0xffu) | (((unsigned)__float2int_rn(v[j][1] * qs) & 0xffu) << 8) | (((unsigned)__float2int_rn(v[j][2] * qs) & 0xffu) << 16) | (((unsigned)__float2int_rn(v[j][3] * qs) & 0xffu) << 24);
        *(u32x4*)(h1q + (size_t)row * D + 16 * lane) = qv;
        if (lane == 0) hsc[row] = amax > 0.f ? amax * (1.f / 127.f) : 1.f;
    }
}

DI unsigned mono(float f) { const unsigned u = __float_as_uint(f); return (u & 0x80000000u) ? ~u : (u | 0x80000000u); }
DI float demono(unsigned m) { return __uint_as_float((m & 0x80000000u) ? (m & 0x7fffffffu) : ~m); }
#define CE_DESC(a, b) do { const unsigned _hi = (a) > (b) ? (a) : (b), _lo = (a) > (b) ? (b) : (a); (a) = _hi; (b) = _lo; } while (0)
DI void sort16_desc(unsigned (&k)[16]) {
#pragma unroll
    for (int size = 2; size <= 16; size <<= 1)
#pragma unroll
        for (int stride = size >> 1; stride > 0; stride >>= 1)
#pragma unroll
            for (int i = 0; i < 16; ++i) { const int j = i ^ stride;
                if (j > i) { if ((i & size) == 0 || size == 16) CE_DESC(k[i], k[j]); else CE_DESC(k[j], k[i]); } }
}
DI void merge_top16(unsigned (&t)[16], const unsigned (&l)[16]) {
#pragma unroll
    for (int i = 0; i < 16; ++i) t[i] = t[i] > l[15 - i] ? t[i] : l[15 - i];
#pragma unroll
    for (int stride = 8; stride > 0; stride >>= 1)
#pragma unroll
        for (int i = 0; i < 16; ++i) { const int j = i ^ stride; if (j > i) CE_DESC(t[i], t[j]); }
}
DI void route_wave(const bf16_t* __restrict__ SC, int* __restrict__ IDX, float* __restrict__ PG, int tb, int h, int lane) {
    const int r32 = lane & 31, hi = lane >> 5;
    const size_t tok = (size_t)tb * 32 + r32;
    unsigned Tp[2][16];
#pragma unroll
    for (int p = 0; p < 2; ++p) {
        const bf16_t* sp = SC + ((size_t)(tb * 16 + h * 2 + p)) * 4096 + lane * 8;
        u32x4 sv[8];
#pragma unroll
        for (int ks = 0; ks < 8; ++ks) sv[ks] = *(const u32x4*)(sp + ks * 512);
#pragma unroll
        for (int nt = 0; nt < 4; ++nt) {
            unsigned L[16];
#pragma unroll
            for (int e = 0; e < 16; ++e) { const int ks = 2 * nt + (e >> 3), j = e & 7; const unsigned w = sv[ks][j >> 1];
                const float sc = __uint_as_float((j & 1) ? (w & 0xffff0000u) : (w << 16));
                L[e] = (mono(sc) & ~0x7fu) | (unsigned)(127 - (16 * ks + 8 * hi + j)); }
            sort16_desc(L);
            if (nt == 0) {
#pragma unroll
                for (int i = 0; i < 16; ++i) Tp[p][i] = L[i];
            } else merge_top16(Tp[p], L);
            __builtin_amdgcn_sched_barrier(0);
        }
    }
    unsigned T[16];
    { unsigned O[16];
#pragma unroll
      for (int i = 0; i < 16; ++i) { const auto rr = __builtin_amdgcn_permlane32_swap(Tp[0][i], Tp[1][i], false, false); T[i] = rr[0]; O[i] = rr[1]; }
      merge_top16(T, O); }
    __builtin_amdgcn_sched_barrier(0);
    float s1[16], s2[16]; unsigned i1[16], i2[16];
#pragma unroll
    for (int i = 0; i < 16; ++i) { const auto rr = __builtin_amdgcn_permlane32_swap(T[i], T[i], false, false);
        s1[i] = demono(rr[0] & ~0x7fu); i1[i] = 127u - (rr[0] & 0x7fu); s2[i] = demono(rr[1] & ~0x7fu); i2[i] = 127u - (rr[1] & 0x7fu); }
    unsigned C[64];
    { int n = 0;
#pragma unroll
      for (int a = 0; a < 16; ++a)
#pragma unroll
          for (int b = 0; b < 16; ++b) if ((a + 1) * (b + 1) <= 16) { C[n] = (mono(s1[a] + s2[b]) & ~0x3fffu) | (i1[a] << 7) | i2[b]; ++n; }
#pragma unroll
      for (int i = 50; i < 64; ++i) C[i] = 0u; }
    unsigned F[16];
#pragma unroll
    for (int i = 0; i < 16; ++i) F[i] = C[i];
    sort16_desc(F);
#pragma unroll
    for (int g = 1; g < 4; ++g) { unsigned L[16];
#pragma unroll
        for (int i = 0; i < 16; ++i) L[i] = C[16 * g + i];
        sort16_desc(L); merge_top16(F, L); __builtin_amdgcn_sched_barrier(0); }
    if (hi == 0) {
        float e[16]; float sum = 0.f; const float v0 = demono(F[0] & ~0x3fffu);
#pragma unroll
        for (int i = 0; i < 16; ++i) { e[i] = __expf(demono(F[i] & ~0x3fffu) - v0); sum += e[i]; }
        const float inv = 1.f / sum;
        int* ip = IDX + tok * 128 + h * 16; float* gp = PG + tok * 128 + h * 16;
#pragma unroll
        for (int q = 0; q < 4; ++q) { u32x4 iv; iv.x = F[4 * q] & 0x3fffu; iv.y = F[4 * q + 1] & 0x3fffu; iv.z = F[4 * q + 2] & 0x3fffu; iv.w = F[4 * q + 3] & 0x3fffu; *(u32x4*)(ip + 4 * q) = iv;
            f32x4 gv; gv[0] = e[4 * q] * inv; gv[1] = e[4 * q + 1] * inv; gv[2] = e[4 * q + 2] * inv; gv[3] = e[4 * q + 3] * inv; *(f32x4*)(gp + 4 * q) = gv; }
    }
}
typedef __bf16 bf16x2v __attribute__((ext_vector_type(2)));
DI float dot2bf(unsigned w, unsigned x, float acc) { return __builtin_amdgcn_fdot2_f32_bf16(__builtin_bit_cast(bf16x2v, w), __builtin_bit_cast(bf16x2v, x), acc, false); }
DI float gelu_erf(float v) {
    const float av = fabsf(v), t = __builtin_amdgcn_rcpf(av * 0.2316418882f + 1.0f);
    float q = t * 0.5307027145f + (-0.7265760135f); q = q * t + 0.7107068705f; q = q * t + (-0.142248368f); q = q * t + 0.127414796f; q = q * t;
    const float e = __builtin_amdgcn_exp2f((v * v) * (-0.72134752044f)); const float m = v * (q * e);
    return v < 0.f ? m : v - m;
}
DI float dppf(float v, const int ctrl_sel) {
    const int s = __float_as_int(v);
    int r;
    if (ctrl_sel == 0) r = __builtin_amdgcn_update_dpp(0, s, 0xB1, 0xF, 0xF, true);
    else if (ctrl_sel == 1) r = __builtin_amdgcn_update_dpp(0, s, 0x4E, 0xF, 0xF, true);
    else if (ctrl_sel == 2) r = __builtin_amdgcn_update_dpp(0, s, 0x141, 0xF, 0xF, true);
    else r = __builtin_amdgcn_update_dpp(0, s, 0x128, 0xF, 0xF, true);
    return __int_as_float(r);
}
DI int dppi(int s, const int ctrl_sel) {
    if (ctrl_sel == 0) return __builtin_amdgcn_update_dpp(0, s, 0xB1, 0xF, 0xF, true);
    if (ctrl_sel == 1) return __builtin_amdgcn_update_dpp(0, s, 0x4E, 0xF, 0xF, true);
    return __builtin_amdgcn_update_dpp(0, s, 0x141, 0xF, 0xF, true);
}
template <int NT>
DI void experts_u_slice(const unsigned char* __restrict__ H1Q, const unsigned char* __restrict__ U8x, const int* __restrict__ IDX, bf16_t* __restrict__ PD, size_t tok, int x, int lane) {
    const int g = lane >> 3, l8 = lane & 7;
    u32x4 hq[NT], iv[NT][4], w[NT][16];
#pragma unroll
    for (int t = 0; t < NT; ++t) { hq[t] = *(const u32x4*)(H1Q + (tok + t) * D + 128 * x + 16 * l8);
#pragma unroll
        for (int q = 0; q < 4; ++q) iv[t][q] = *(const u32x4*)(IDX + (tok + t) * 128 + 16 * g + 4 * q); }
#pragma unroll
    for (int t = 0; t < NT; ++t)
#pragma unroll
        for (int j = 0; j < 16; ++j) w[t][j] = *(const u32x4*)(U8x + (size_t)(iv[t][j >> 2][j & 3] * 128u + 16u * l8));
#pragma unroll
    for (int t = 0; t < NT; ++t) {
        float p[16];
#pragma unroll
        for (int j = 0; j < 16; ++j) { int d = 0;
#pragma unroll
            for (int q = 0; q < 4; ++q) d = __builtin_amdgcn_sdot4((int)w[t][j][q], (int)hq[t][q], d, false);
            d += dppi(d, 0); d += dppi(d, 1); d += dppi(d, 2); p[j] = (float)d; }
        if (l8 == 0) {
            u32x4 o0, o1;
            o0.x = cvtpk(p[0], p[1]); o0.y = cvtpk(p[2], p[3]); o0.z = cvtpk(p[4], p[5]); o0.w = cvtpk(p[6], p[7]);
            o1.x = cvtpk(p[8], p[9]); o1.y = cvtpk(p[10], p[11]); o1.z = cvtpk(p[12], p[13]); o1.w = cvtpk(p[14], p[15]);
            bf16_t* dp = PD + ((tok + t) * 8 + x) * 128 + 16 * g; *(u32x4*)dp = o0; *(u32x4*)(dp + 8) = o1;
        }
    }
}
DI void experts_combine(const bf16_t* __restrict__ PD, const int* __restrict__ IDX, const float* __restrict__ PG, const float* __restrict__ USC, const float* __restrict__ VSC, const float* __restrict__ HSC,
                        unsigned char* __restrict__ C8, float* __restrict__ CSC, int wave0, int nwaves, int lane) {
    for (int tok = wave0; tok < M; tok += nwaves) {
        float s0 = 0.f, s1 = 0.f;
#pragma unroll
        for (int x = 0; x < 8; ++x) { const unsigned w = *(const unsigned*)(PD + ((size_t)tok * 8 + x) * 128 + 2 * lane); s0 += __uint_as_float(w << 16); s1 += __uint_as_float(w & 0xffff0000u); }
        const u32x2 rows = *(const u32x2*)(IDX + (size_t)tok * 128 + 2 * lane); const f32x2 gt = *(const f32x2*)(PG + (size_t)tok * 128 + 2 * lane);
        const float hs = HSC[tok];
        const float c0 = gt[0] * gelu_erf(s0 * USC[rows.x] * hs) * VSC[rows.x], c1 = gt[1] * gelu_erf(s1 * USC[rows.y] * hs) * VSC[rows.y];
        const float amax = wave_max(fmaxf(fabsf(c0), fabsf(c1)));
        const float qs = amax > 0.f ? 127.f / amax : 1.f;
        const unsigned short q2 = (unsigned short)(((unsigned)__float2int_rn(c0 * qs) & 0xffu) | (((unsigned)__float2int_rn(c1 * qs) & 0xffu) << 8));
        *(unsigned short*)(C8 + (size_t)tok * 128 + 2 * lane) = q2;
        if (lane == 0) CSC[tok] = amax > 0.f ? amax * (1.f / 127.f) : 1.f;
    }
}
template <int NT>
DI void experts_v_slice(const unsigned char* __restrict__ V8x, const int* __restrict__ IDX, const unsigned char* __restrict__ C8, const float* __restrict__ CSC, bf16_t* __restrict__ FFN, size_t tok, int x, int lane) {
    const int g = lane >> 3, l8 = lane & 7;
    u32x4 iv[NT][4], w[NT][16], cq[NT];
#pragma unroll
    for (int t = 0; t < NT; ++t) { cq[t] = *(const u32x4*)(C8 + (tok + t) * 128 + 16 * g);
#pragma unroll
        for (int q = 0; q < 4; ++q) iv[t][q] = *(const u32x4*)(IDX + (tok + t) * 128 + 16 * g + 4 * q); }
#pragma unroll
    for (int t = 0; t < NT; ++t)
#pragma unroll
        for (int j = 0; j < 16; ++j) w[t][j] = *(const u32x4*)(V8x + (size_t)(iv[t][j >> 2][j & 3] * 128u + 16u * l8));
#pragma unroll
    for (int t = 0; t < NT; ++t) {
        int acc[16];
#pragma unroll
        for (int i = 0; i < 16; ++i) acc[i] = 0;
#pragma unroll
        for (int jj = 0; jj < 4; ++jj) {
            const int cdw = (int)cq[t][jj];
#pragma unroll
            for (int q = 0; q < 4; ++q) {
                const unsigned r0 = w[t][4 * jj][q], r1 = w[t][4 * jj + 1][q], r2 = w[t][4 * jj + 2][q], r3 = w[t][4 * jj + 3][q];
                const unsigned lo01 = __builtin_amdgcn_perm(r1, r0, 0x05010400u), hi01 = __builtin_amdgcn_perm(r1, r0, 0x07030602u);
                const unsigned lo23 = __builtin_amdgcn_perm(r3, r2, 0x05010400u), hi23 = __builtin_amdgcn_perm(r3, r2, 0x07030602u);
                acc[4 * q + 0] = __builtin_amdgcn_sdot4((int)__builtin_amdgcn_perm(lo23, lo01, 0x05040100u), cdw, acc[4 * q + 0], false);
                acc[4 * q + 1] = __builtin_amdgcn_sdot4((int)__builtin_amdgcn_perm(lo23, lo01, 0x07060302u), cdw, acc[4 * q + 1], false);
                acc[4 * q + 2] = __builtin_amdgcn_sdot4((int)__builtin_amdgcn_perm(hi23, hi01, 0x05040100u), cdw, acc[4 * q + 2], false);
                acc[4 * q + 3] = __builtin_amdgcn_sdot4((int)__builtin_amdgcn_perm(hi23, hi01, 0x07060302u), cdw, acc[4 * q + 3], false);
            }
        }
        const float cs = CSC[tok + t];
#pragma unroll
        for (int i = 0; i < 8; ++i) { const auto rr = __builtin_amdgcn_permlane32_swap((unsigned)acc[i], (unsigned)acc[i + 8], false, false); acc[i] = (int)rr[0] + (int)rr[1]; }
#pragma unroll
        for (int i = 0; i < 4; ++i) { const auto rr = __builtin_amdgcn_permlane16_swap((unsigned)acc[i], (unsigned)acc[i + 4], false, false); acc[i] = (int)rr[0] + (int)rr[1]; }
        { const bool up = (lane & 8) != 0;
#pragma unroll
          for (int i = 0; i < 2; ++i) { const int send = up ? acc[i] : acc[i + 2], keep = up ? acc[i + 2] : acc[i]; acc[i] = keep + __builtin_amdgcn_update_dpp(0, send, 0x128, 0xF, 0xF, true); } }
        *(unsigned*)(FFN + (tok + t) * D + 128 * x + 16 * l8 + 2 * g) = cvtpk((float)acc[0] * cs, (float)acc[1] * cs);
    }
}
DI void ln2_token(const bf16_t* __restrict__ FFN, const bf16_t* __restrict__ H1B, const float* __restrict__ g2, const float* __restrict__ b2, float* __restrict__ outp, size_t tok, int lane) {
    float* hr = outp + tok * D + 16 * lane;
    const u32x4 fa = *(const u32x4*)(FFN + tok * D + 16 * lane), fb = *(const u32x4*)(FFN + tok * D + 16 * lane + 8);
    const u32x4 ha = *(const u32x4*)(H1B + tok * D + 16 * lane), hb = *(const u32x4*)(H1B + tok * D + 16 * lane + 8);
    float ff[16], hh[16]; unpack8(fa, *(float(*)[8])&ff[0]); unpack8(fb, *(float(*)[8])&ff[8]); unpack8(ha, *(float(*)[8])&hh[0]); unpack8(hb, *(float(*)[8])&hh[8]);
    f32x4 v[4];
#pragma unroll
    for (int j = 0; j < 4; ++j)
#pragma unroll
        for (int e = 0; e < 4; ++e) v[j][e] = hh[4 * j + e];
    float s = 0.f;
#pragma unroll
    for (int j = 0; j < 4; ++j)
#pragma unroll
        for (int e = 0; e < 4; ++e) { v[j][e] = v[j][e] * ALPHA + ff[4 * j + e]; s += v[j][e]; }
    const float mean = wave_sum(s) * (1.f / D); float q2 = 0.f;
#pragma unroll
    for (int j = 0; j < 4; ++j)
#pragma unroll
        for (int e = 0; e < 4; ++e) { v[j][e] -= mean; q2 += v[j][e] * v[j][e]; }
    const float rstd = rsqrtf(wave_sum(q2) * (1.f / D) + LN_EPS);
#pragma unroll
    for (int j = 0; j < 4; ++j) { const f32x4 gg = *(const f32x4*)(g2 + 16 * lane + 4 * j), bb = *(const f32x4*)(b2 + 16 * lane + 4 * j); *(f32x4*)(hr + 4 * j) = v[j] * rstd * gg + bb; }
}

DI void p0_convert(const float* __restrict__ in, bf16_t* __restrict__ out, size_t n8, size_t first, size_t stride) {
    for (size_t i = first; i < n8; i += stride) { const f32x4 a = ((const f32x4*)in)[2 * i], b = ((const f32x4*)in)[2 * i + 1];
        u32x4 w; w.x = cvtpk(a[0], a[1]); w.y = cvtpk(a[2], a[3]); w.z = cvtpk(b[0], b[1]); w.w = cvtpk(b[2], b[3]); ((u32x4*)out)[i] = w; }
}
DI void p0_transpose_item(const float* __restrict__ W, int ldw, int ncols, bf16_t* __restrict__ out, int ldo, int koff, LAS float* scr, int item, int lane) {
    const int nblk = ncols / 32, kb = item / nblk, nb = item % nblk, k0 = 64 * kb, n0 = 32 * nb;
#pragma unroll 8
    for (int i = 0; i < 32; ++i) { const int kk = 2 * i + (lane >> 5); scr[kk * 33 + (lane & 31)] = W[(size_t)(k0 + kk) * ldw + n0 + (lane & 31)]; }
    asm volatile("s_waitcnt lgkmcnt(0)" ::: "memory");
    const int c = lane & 7;
#pragma unroll
    for (int j = 0; j < 4; ++j) { const int n = (lane >> 3) + 8 * j; const LAS float* s = scr + (8 * c) * 33 + n;
        u32x4 o; o.x = cvtpk(s[0 * 33], s[1 * 33]); o.y = cvtpk(s[2 * 33], s[3 * 33]); o.z = cvtpk(s[4 * 33], s[5 * 33]); o.w = cvtpk(s[6 * 33], s[7 * 33]);
        *(u32x4*)(out + (size_t)(n0 + n) * ldo + koff + k0 + 8 * c) = o; }
    asm volatile("s_waitcnt lgkmcnt(0)" ::: "memory");
}
template <bool I8>
DI void p0_fp8_row(const float* __restrict__ src, unsigned char* __restrict__ dst, float* __restrict__ scale, int row, int lane) {
    const f32x4* sp = (const f32x4*)(src + (size_t)row * D) + 4 * lane;
    f32x4 v[4]; float mx = 0.f;
#pragma unroll
    for (int j = 0; j < 4; ++j) { v[j] = sp[j]; mx = fmaxf(mx, fmaxf(fmaxf(fabsf(v[j][0]), fabsf(v[j][1])), fmaxf(fabsf(v[j][2]), fabsf(v[j][3])))); }
    mx = wave_max(mx);
    const float top = I8 ? 127.f : 224.f;
    const float sc = mx > 0.f ? top / mx : 1.f;
    u32x4 w;
#pragma unroll
    for (int j = 0; j < 4; ++j) {
        if (I8) { w[j] = ((unsigned)__float2int_rn(v[j][0] * sc) & 0xffu) | (((unsigned)__float2int_rn(v[j][1] * sc) & 0xffu) << 8) | (((unsigned)__float2int_rn(v[j][2] * sc) & 0xffu) << 16) | (((unsigned)__float2int_rn(v[j][3] * sc) & 0xffu) << 24); }
        else { int p = 0; p = __builtin_amdgcn_cvt_pk_fp8_f32(v[j][0] * sc, v[j][1] * sc, p, false); p = __builtin_amdgcn_cvt_pk_fp8_f32(v[j][2] * sc, v[j][3] * sc, p, true); w[j] = (unsigned)p; } }
    *(u32x4*)(dst + (size_t)(lane >> 3) * ((size_t)NEXP * 128) + (size_t)row * 128 + 16 * (lane & 7)) = w;
    if (lane == 0) scale[row] = mx > 0.f ? mx / top : 1.f;
}
DI void p0_fold_tile(const float* __restrict__ wq, const float* __restrict__ keys, bf16_t* __restrict__ out, LAS float* sm, int tile, int tid) {
    const int hp = tile >> 4, d0 = (tile & 15) * 64;
    LAS float* sw = sm; LAS float* sk = sm + 64 * 129;
    for (int i = tid; i < 64 * 32; i += NTHR_C) { const int r = i >> 5, c4 = (i & 31) * 4; const f32x4 v = *(const f32x4*)(wq + (size_t)(d0 + r) * 2048 + hp * 128 + c4);
        sw[r * 129 + c4] = v[0]; sw[r * 129 + c4 + 1] = v[1]; sw[r * 129 + c4 + 2] = v[2]; sw[r * 129 + c4 + 3] = v[3]; }
    for (int i = tid; i < 128 * 32; i += NTHR_C) { const int r = i >> 5, c4 = (i & 31) * 4; const f32x4 v = *(const f32x4*)(keys + (size_t)(hp * 128 + r) * 128 + c4);
        sk[r * 129 + c4] = v[0]; sk[r * 129 + c4 + 1] = v[1]; sk[r * 129 + c4 + 2] = v[2]; sk[r * 129 + c4 + 3] = v[3]; }
    __syncthreads();
    const int n = tid & 127, dq = (tid >> 7) * 16;
    float acc[16];
#pragma unroll
    for (int j = 0; j < 16; ++j) acc[j] = 0.f;
    for (int k = 0; k < 128; ++k) { const float kv = sk[n * 129 + k];
#pragma unroll
        for (int j = 0; j < 16; ++j) acc[j] += kv * sw[(dq + j) * 129 + k]; }
    bf16_t* op = out + (size_t)(hp * 128 + n) * D + d0 + dq;
    u32x4 o0, o1;
    o0.x = cvtpk(acc[0], acc[1]); o0.y = cvtpk(acc[2], acc[3]); o0.z = cvtpk(acc[4], acc[5]); o0.w = cvtpk(acc[6], acc[7]);
    o1.x = cvtpk(acc[8], acc[9]); o1.y = cvtpk(acc[10], acc[11]); o1.z = cvtpk(acc[12], acc[13]); o1.w = cvtpk(acc[14], acc[15]);
    *(u32x4*)op = o0; *(u32x4*)(op + 8) = o1;
    __syncthreads();
}
DI void p0_misc(const float* __restrict__ hgrn_lb, const float* __restrict__ rel_bias, float* __restrict__ misc, int i) {
    if (i < 512) { const float a = hgrn_lb[i], b = hgrn_lb[512 + i]; const float mx = fmaxf(a, b); const float ea = expf(a - mx), eb = expf(b - mx); misc[i] = ea / (ea + eb); }
    if (i < 3 * 129) {
        const int g = i / 129, j = i % 129; const int dl = g == 0 ? 1 : (g == 1 ? 4 : 16); const int n = j * dl;
        int bucket;
        if (n < 16) bucket = n;
        else { const double v = log((double)n / 16.0) / log(128.0) * 16.0; int l = 16 + (int)v; bucket = l < 31 ? l : 31; }
        for (int h = 0; h < 4; ++h) misc[512 + i * 4 + h] = rel_bias[bucket * 12 + g * 4 + h];
    }
}
struct SchedMemKV {
    unsigned MEMB, W; int G, c;
    DI bool next(int i, g8::Unit& u) const {
        const int L = i * G + c; if (L >= 32) return false;
        u.dla = 1; u.dlb = 1;
        if (L < 16) { u.kind = 0; u.pm = L >> 1; u.pn = L & 1; u.a = MEMB + (unsigned)u.pm * 256u * D * 2u; u.b = W + (unsigned)u.pn * 256u * D * 2u; }
        else { const int q = L - 16; u.kind = 1; u.pm = q >> 3; u.pn = q & 7; u.a = W + (unsigned)(512 + u.pm * 256) * D * 2u; u.b = MEMB + (unsigned)u.pn * 256u * D * 2u; }
        return true;
    }
};
struct EpiMemKVF {
    static constexpr bool PERM = true, HOOK = false;
    bf16_t *MK, *MVT;
    DI void hook(f32x4 (&)[2][2][4][2], const g8::Unit&, int, int, int, int, int) const {}
    DI void operator()(const f32x4 (&acc)[2][2][4][2], const g8::Unit& u, int wr, int wc, int fr, int fq) const {
        const int rowl = wr * 64 + fr, d0 = wc * 32 + 8 * fq;
#pragma unroll
        for (int ai = 0; ai < 2; ++ai)
#pragma unroll
            for (int m = 0; m < 4; ++m) { const int R = u.pm * 256 + rowl + ai * 128 + m * 16;
#pragma unroll
                for (int bj = 0; bj < 2; ++bj) { const f32x4 v0 = acc[ai][bj][m][0], v1 = acc[ai][bj][m][1];
                    if (u.kind == 0) { const int b = R >> 8, mm = R & 255, h = u.pn * 2 + bj;
                        u32x4 w; w.x = cvtpk(v0[0], v0[1]); w.y = cvtpk(v0[2], v0[3]); w.z = cvtpk(v1[0], v1[1]); w.w = cvtpk(v1[2], v1[3]);
                        *(u32x4*)(MK + ((size_t)((b * 4 + h) * 8 + (mm >> 5))) * 4096 + frag_row_off(d0, mm & 31)) = w; }
                    else { const int h = R >> 7, d = R & 127, c = u.pn * 256 + bj * 128 + d0, b = c >> 8, mm = c & 255, kk = mm & 31;
                        bf16_t* blk = MVT + ((size_t)((b * 4 + h) * 8 + (mm >> 5))) * 4096 + (((d >> 5) * 2 + (kk >> 4)) * 64 + (d & 31)) * 8 + 4 * ((kk >> 3) & 1);
                        u32x2 wa, wb; wa.x = cvtpk(v0[0], v0[1]); wa.y = cvtpk(v0[2], v0[3]); wb.x = cvtpk(v1[0], v1[1]); wb.y = cvtpk(v1[2], v1[3]);
                        *(u32x2*)blk = wa; *(u32x2*)(blk + 32 * 8) = wb; } } }
    }
};

static_assert(HG_UNIT_BYTES <= LDSCTL_OFF, "hgrn LDS");
DI const float* karg_in(int i) { const float* const* kp = (const float* const*)__builtin_amdgcn_kernarg_segment_ptr(); asm volatile("" : "+s"(kp)); return kp[i]; }
DI float* karg_out() { float* const* kp = (float* const*)__builtin_amdgcn_kernarg_segment_ptr(); asm volatile("" : "+s"(kp)); return kp[18]; }
__global__ void __launch_bounds__(NTHR, 2) mega(Args args) {
    extern __shared__ __attribute__((aligned(16))) unsigned char lds_raw[];
    LAS unsigned char* lds = (LAS unsigned char*)lds_raw;
    volatile LAS unsigned* MISC = (volatile LAS unsigned*)(lds + MISC_OFF);
    for (int u = threadIdx.x; u < (LDS_BYTES - LDSCTL_OFF) / 4; u += NTHR) ((LAS unsigned*)(lds + LDSCTL_OFF))[u] = 0u;
    __syncthreads();
    unsigned char* ws = args.ws;
    const int G = gridDim.x;
    const bool ALL = args.ph == PH_ALL;
    XcdBarrier bar; bar.bar = (unsigned*)(ws + O_MISC + 16384); bar.x = 0; bar.st = nullptr;
    if (ALL) bar = xcd_barrier_post((unsigned*)(ws + O_MISC + 16384), MISC + 8);
#ifndef REP_MASK
#define REP_MASK 0
#endif
#define RUN(k) (ALL || args.ph == (k))
#define NREP(k) (((REP_MASK >> (k)) & 1) ? 2 : 1)
#define SEAM() do { if (ALL) xcd_barrier(bar); } while (0)
    for (int rep_ = 0; rep_ < NREP(PH_PRO); ++rep_) if (RUN(PH_PRO)) {
        int tid = threadIdx.x; asm volatile("" : "+v"(tid)); asm volatile("" : "+s"(ws)); int bid = blockIdx.x; asm volatile("" : "+s"(bid));
        const size_t gt = (size_t)bid * NTHR + tid, nth = (size_t)G * NTHR;
        p0_convert(karg_in(0), (bf16_t*)(ws + O_XB), (size_t)M * D / 8, gt, nth);
        p0_convert(karg_in(1), (bf16_t*)(ws + O_MEMB), (size_t)2048 * 1024 / 8, gt, nth);
        if (bid == 0) p0_misc(karg_in(6), karg_in(5), (float*)(ws + O_MISC), tid);
        const int wid = __builtin_amdgcn_readfirstlane(tid >> 6), lane = tid & 63;
        LAS float* scr = (LAS float*)(lds + wid * 16384);
        const int gw = bid * NWAVES + wid, ngw = G * NWAVES;
        for (int r = gw; r < 2 * NEXP; r += ngw) {
            if (r < NEXP) p0_fp8_row<true>(karg_in(14), (unsigned char*)(ws + O_UB), (float*)(ws + O_USC), r, lane);
            else p0_fp8_row<true>(karg_in(15), (unsigned char*)(ws + O_VB), (float*)(ws + O_VSC), r - NEXP, lane);
        }
        constexpr int NJ = 12;
        for (int it = gw; ; it += ngw) {
            int r = it; bool done = true;
#pragma unroll
            for (int j = 0; j < NJ; ++j) {
                const int srcc[NJ] = {0, 4608, 5632, 6656, 7168, 3072, 5120, 0, 0, 0, 0, 0};
                const int cnt[NJ] = {3072, 512, 1024, 512, 3072, 1536, 512, 1024, 1024, 1024, 1024, 1024};
                const int drow[NJ] = {0, 3072, 3584, 4608, 5120, 8192, 9728, 0, 0, 0, 0, 0};
                const int Kj = (j >= 8 && j <= 10) ? 512 : 1024;
                const int items = (Kj / 64) * (cnt[j] / 32);
                if (done && r < items) {
                    const float* W; int ldw; bf16_t* o; int ldo, koff = 0;
                    if (j < 7) { W = karg_in(2) + srcc[j]; ldw = INC; o = (bf16_t*)(ws + O_WIN) + (size_t)drow[j] * 1024; ldo = 1024; }
                    else if (j == 7) { W = karg_in(4); ldw = 1024; o = (bf16_t*)(ws + O_WMKV); ldo = 1024; }
                    else if (j <= 10) { W = karg_in(8) + (size_t)(j - 8) * 512 * 1024; ldw = 1024; o = (bf16_t*)(ws + O_WBR); ldo = 1536; koff = (j - 8) * 512; }
                    else { W = karg_in(9); ldw = 1024; o = (bf16_t*)(ws + O_WOUT); ldo = 1024; }
                    p0_transpose_item(W, ldw, cnt[j], o, ldo, koff, scr, r, lane); done = false;
                }
                r -= items;
            }
            if (done) break;
        }
        __syncthreads();
        for (int tile = bid; tile < 256; tile += G) p0_fold_tile(karg_in(12), karg_in(13), (bf16_t*)(ws + O_WPQ), (LAS float*)lds, tile, tid);
        SEAM();
    }
#pragma unroll 1
    for (int p = (ALL ? 0 : args.pass); p < (ALL ? NPASS : args.pass + 1); ++p) {
        int bid = blockIdx.x; asm volatile("" : "+s"(bid));
        int tid = threadIdx.x; asm volatile("" : "+v"(tid));
        asm volatile("" : "+s"(ws));
        char* pr = (char*)ws + O_PASS;
        const size_t t0 = (size_t)p * MP;
        for (int rep_ = 0; rep_ < NREP(PH_PROJ); ++rep_) if (RUN(PH_PROJ)) {
            asm volatile("" : "+s"(bid)); asm volatile("" : "+v"(tid)); asm volatile("" : "+s"(ws)); pr = (char*)ws + O_PASS;
            SchedP1 Sc{(unsigned)(O_XB + t0 * D * 2), (unsigned)O_WIN, G, bid};
            EpiP1 E{pr, karg_in(3)};
            g8::gemm_phase<EpiP1, SchedP1>(lds, (const char*)ws, D, Sc, E, tid);
            if (p == 0) {
                SchedMemKV S2{(unsigned)O_MEMB, (unsigned)O_WMKV, G, bid};
                EpiMemKVF E2{(bf16_t*)(ws + O_MK), (bf16_t*)(ws + O_MVT)};
                g8::gemm_phase<EpiMemKVF, SchedMemKV>(lds, (const char*)ws, D, S2, E2, tid);
            }
            SEAM();
        }
        for (int rep_ = 0; rep_ < NREP(PH_ATTN); ++rep_) if (RUN(PH_ATTN)) {
            asm volatile("" : "+s"(bid)); asm volatile("" : "+v"(tid)); asm volatile("" : "+s"(ws)); pr = (char*)ws + O_PASS;
            const float* bsrc = (const float*)(ws + O_MISC) + 512; LAS float* btab = (LAS float*)lds;
            for (int i = tid; i < 3 * 129 * 4; i += NTHR) btab[i] = bsrc[i] * LOG2E;
            __syncthreads();
            const int wid = __builtin_amdgcn_readfirstlane(tid >> 6), lane = tid & 63;
            for (int task = bid * NWAVES + wid; task < DIL_TASKS; task += G * NWAVES)
                attn_dil_wave((const bf16_t*)(pr + P_QK), (const bf16_t*)(pr + P_VT), btab, (bf16_t*)(pr + P_OG), (float*)(pr + P_LSE), task, lane);
            for (int task = bid * NWAVES + wid; task < MEM_TASKS; task += G * NWAVES)
                attn_mem_wave((const bf16_t*)(pr + P_MQ), (const bf16_t*)(ws + O_MK), (const bf16_t*)(ws + O_MVT), (bf16_t*)(pr + P_BR), task, p * BPP, lane);
            __syncthreads();
        }
        for (int rep_ = 0; rep_ < NREP(PH_HGPRE); ++rep_) if (RUN(PH_HGPRE)) {
            asm volatile("" : "+s"(bid)); asm volatile("" : "+v"(tid)); asm volatile("" : "+s"(ws)); pr = (char*)ws + O_PASS;
            { const int unit = bid; static_assert(HG_UNITS == 256, "one HGRN unit per workgroup"); if (unit < HG_UNITS) {
                hgrn_unit<false>(lds, unit, tid, (const bf16_t*)(pr + P_HFQG), (const bf16_t*)(pr + P_IT), (const float*)(ws + O_MISC), karg_in(7),
                                 (float*)(pr + P_HSTL), (float*)(pr + P_HSTD), (const float*)(pr + P_SIN), (bf16_t*)(pr + P_BR));
            } }
            SEAM();
        }
        for (int rep_ = 0; rep_ < NREP(PH_HGSCAN); ++rep_) if (RUN(PH_HGSCAN)) {
            asm volatile("" : "+s"(bid)); asm volatile("" : "+v"(tid)); asm volatile("" : "+s"(ws)); pr = (char*)ws + O_PASS;
            hgrn_scan((const float*)(pr + P_HSTL), (const float*)(pr + P_HSTD), (float*)(pr + P_SIN), bid * NTHR + tid);
            lse_merge_items((const bf16_t*)(pr + P_OG), (const float*)(pr + P_LSE), (bf16_t*)(pr + P_BR), bid * NTHR + tid, G * NTHR);
            SEAM();
        }
        for (int rep_ = 0; rep_ < NREP(PH_HGMAIN); ++rep_) if (RUN(PH_HGMAIN)) {
            asm volatile("" : "+s"(bid)); asm volatile("" : "+v"(tid)); asm volatile("" : "+s"(ws)); pr = (char*)ws + O_PASS;
            { const int unit = bid; static_assert(HG_UNITS == 256, "one HGRN unit per workgroup"); if (unit < HG_UNITS) {
                hgrn_unit<true>(lds, unit, tid, (const bf16_t*)(pr + P_HFQG), (const bf16_t*)(pr + P_IT), (const float*)(ws + O_MISC), karg_in(7),
                                (float*)(pr + P_HSTL), (float*)(pr + P_HSTD), (const float*)(pr + P_SIN), (bf16_t*)(pr + P_BR));
            } }
            SEAM();
        }
        for (int rep_ = 0; rep_ < NREP(PH_WIDEN); ++rep_) if (RUN(PH_WIDEN)) {
            asm volatile("" : "+s"(bid)); asm volatile("" : "+v"(tid)); asm volatile("" : "+s"(ws)); pr = (char*)ws + O_PASS;
            SchedRows Sc{(unsigned)(O_PASS + P_BR), (unsigned)O_WBR, 1536, 4, 256, G, bid};
            EpiWidenF E{(const bf16_t*)(pr + P_GATE), (bf16_t*)(pr + P_MERGED)};
            g8::gemm_phase<EpiWidenF, SchedRows>(lds, (const char*)ws, 1536, Sc, E, tid);
            SEAM();
        }
        for (int rep_ = 0; rep_ < NREP(PH_WOUT); ++rep_) if (RUN(PH_WOUT)) {
            asm volatile("" : "+s"(bid)); asm volatile("" : "+v"(tid)); asm volatile("" : "+s"(ws)); pr = (char*)ws + O_PASS;
            SchedRows Sc{(unsigned)(O_PASS + P_MERGED), (unsigned)O_WOUT, 1024, 4, 256, G, bid};
            EpiPlainB16 E{(bf16_t*)(pr + P_MIX), 1024, 0};
            g8::gemm_phase<EpiPlainB16, SchedRows>(lds, (const char*)ws, 1024, Sc, E, tid);
            SEAM();
        }
        for (int rep_ = 0; rep_ < NREP(PH_LN1); ++rep_) if (RUN(PH_LN1)) {
            asm volatile("" : "+s"(bid)); asm volatile("" : "+v"(tid)); asm volatile("" : "+s"(ws)); pr = (char*)ws + O_PASS;
            ln1_rows((const bf16_t*)(ws + O_XB) + t0 * D, (const bf16_t*)(pr + P_MIX), karg_in(10), karg_in(11), (bf16_t*)(ws + O_H1B) + t0 * D, (unsigned char*)(ws + O_H1Q) + t0 * D, (float*)(ws + O_HSC) + t0, bid * NWAVES + (tid >> 6), G * NWAVES, tid & 63);
        }
    }
    for (int rep_ = 0; rep_ < NREP(PH_PQ); ++rep_) if (RUN(PH_PQ)) {
        SEAM();
        int tid = threadIdx.x; asm volatile("" : "+v"(tid)); asm volatile("" : "+s"(ws)); int bid = blockIdx.x; asm volatile("" : "+s"(bid));
        char* pr = (char*)ws + O_PASS;
        SchedRows Sc{(unsigned)O_H1B, (unsigned)O_WPQ, 1024, 8, 2048, G, bid};
        EpiScores E{(bf16_t*)(pr + P_PQ)};
        g8::gemm_phase<EpiScores, SchedRows>(lds, (const char*)ws, 1024, Sc, E, tid);
        SEAM();
    }
    for (int rep_ = 0; rep_ < NREP(PH_ROUTE); ++rep_) if (RUN(PH_ROUTE)) {
        int tid = threadIdx.x; asm volatile("" : "+v"(tid)); asm volatile("" : "+s"(ws)); int bid = blockIdx.x; asm volatile("" : "+s"(bid));
        char* pr = (char*)ws + O_PASS;
        const int wid = __builtin_amdgcn_readfirstlane(tid >> 6), lane = tid & 63;
        for (int task = bid * NWAVES + wid; task < (M / 32) * 8; task += G * NWAVES)
            route_wave((const bf16_t*)(pr + P_PQ), (int*)(pr + P_IDX), (float*)(pr + P_PG), task >> 3, task & 7, lane);
        SEAM();
    }
    if (RUN(PH_EXPERTS)) {
        int tid = threadIdx.x; asm volatile("" : "+v"(tid)); asm volatile("" : "+s"(ws)); int bid = blockIdx.x; asm volatile("" : "+s"(bid));
        char* pr = (char*)ws + O_PASS;
        const int wid = __builtin_amdgcn_readfirstlane(tid >> 6), lane = tid & 63;
        if (tid == 0) {
            unsigned base = 0; const unsigned myx = ALL ? bar.x : 0u;
            if (ALL) { for (unsigned jx = 0; jx < 16; ++jx) { const unsigned c = xb_ld(&bar.bar[XB_XCNT(jx)]); if (jx < myx) base += c; } MISC[12] = base + MISC[10]; }
            else MISC[12] = (unsigned)bid;
        }
        __syncthreads();
        const int vwg = (int)MISC[12];
        const int nper = G >> 3, x = vwg / nper, r = vwg % nper;
        const int tpw = M / (nper * NWAVES);
        const size_t tokw0 = (size_t)(r * NWAVES + wid) * tpw;
        {
            const unsigned char* U8x = (const unsigned char*)(ws + O_UB) + (size_t)x * ((size_t)NEXP * 128);
            for (int i = 0; i < tpw; i += 2) experts_u_slice<2>((const unsigned char*)(ws + O_H1Q), U8x, (const int*)(pr + P_IDX), (bf16_t*)(pr + P_PD), tokw0 + i, x, lane);
        }
        SEAM();
        experts_combine((const bf16_t*)(pr + P_PD), (const int*)(pr + P_IDX), (const float*)(pr + P_PG), (const float*)(ws + O_USC), (const float*)(ws + O_VSC), (const float*)(ws + O_HSC), (unsigned char*)(pr + P_C), (float*)(pr + P_C + (size_t)M * 128), bid * NWAVES + wid, G * NWAVES, lane);
        SEAM();
        {
            const unsigned char* V8x = (const unsigned char*)(ws + O_VB) + (size_t)x * ((size_t)NEXP * 128);
            for (int i = 0; i < tpw; i += 2) experts_v_slice<2>(V8x, (const int*)(pr + P_IDX), (const unsigned char*)(pr + P_C), (const float*)(pr + P_C + (size_t)M * 128), (bf16_t*)(pr + P_FFN), tokw0 + i, x, lane);
        }
        SEAM();
        for (int tok = bid * NWAVES + wid; tok < M; tok += G * NWAVES) ln2_token((const bf16_t*)(pr + P_FFN), (const bf16_t*)(ws + O_H1B), karg_in(16), karg_in(17), karg_out(), (size_t)tok, lane);
    }
#undef RUN
#undef SEAM
}

extern "C" void kernel_launch(void* const* d_in, const int* in_sizes, int n_in, void* d_out, int out_size, void* d_ws, size_t ws_size, hipStream_t stream) {
    if (ws_size < WS_NEED || n_in != 18) return;
    static bool attr_set = false;
    if (!attr_set) { (void)hipFuncSetAttribute((const void*)mega, hipFuncAttributeMaxDynamicSharedMemorySize, LDS_BYTES); attr_set = true; }
    (void)hipMemsetAsync((char*)d_ws + O_MISC + 16384, 0, 16384, stream);
    Args a{}; for (int i = 0; i < 18; ++i) a.in[i] = (const float*)d_in[i]; a.out = (float*)d_out; a.ws = (unsigned char*)d_ws; a.ph = PH_ALL; a.pass = 0;
    mega<<<256, NTHR, LDS_BYTES, stream>>>(a);
}
```

```cpp
#include <hip/hip_runtime.h>
#include <stdint.h>
#include <math.h>

typedef unsigned short bf16_t;
typedef short bf16x8 __attribute__((ext_vector_type(8)));
typedef float f32x4 __attribute__((ext_vector_type(4)));
#define DI __device__ __forceinline__

DI float bf2f(bf16_t v) { return __uint_as_float(((unsigned)v) << 16); }
DI bf16_t f2bf(float f) { unsigned u = __float_as_uint(f); u += 0x7fffu + ((u >> 16) & 1u); return (bf16_t)(u >> 16); }

constexpr int NB = 8, S = 8192, D = 1024, M = NB * S;
constexpr int NPASS = 4, BPP = NB / NPASS, MP = BPP * S;
constexpr int INC = 10240;
constexpr int NEXP = 16384;
constexpr float ALPHA = 1.189207115002721f;
constexpr float LN_EPS = 1e-5f;
constexpr float QSCALE = 0.08838834764831845f;

constexpr size_t al(size_t x) { return (x + 255) & ~(size_t)255; }
constexpr size_t O_WIN = 0;
constexpr size_t O_WMKV = O_WIN + al((size_t)INC * D * 2);
constexpr size_t O_WBR = O_WMKV + al((size_t)1024 * 1024 * 2);
constexpr size_t O_WOUT = O_WBR + al((size_t)1024 * 1536 * 2);
constexpr size_t O_WPQ = O_WOUT + al((size_t)1024 * 1024 * 2);
constexpr size_t O_SUBK = O_WPQ + al((size_t)2048 * 1024 * 2);
constexpr size_t O_UB = O_SUBK + al((size_t)16 * 128 * 128 * 2);
constexpr size_t O_VB = O_UB + al((size_t)NEXP * D);
constexpr size_t O_USC = O_VB + al((size_t)NEXP * D);
constexpr size_t O_VSC = O_USC + al((size_t)NEXP * 4);
constexpr size_t O_XB = O_VSC + al((size_t)NEXP * 4);
constexpr size_t O_MEMB = O_XB + al((size_t)M * D * 2);
constexpr size_t O_MK = O_MEMB + al((size_t)2048 * 1024 * 2);
constexpr size_t O_MVT = O_MK + al((size_t)2048 * 512 * 2);
constexpr size_t O_H1B = O_MVT + al((size_t)8 * 512 * 256 * 2);
constexpr size_t O_H1Q = O_H1B + al((size_t)M * D * 2);
constexpr size_t O_HSC = O_H1Q + al((size_t)M * D);
constexpr size_t O_MISC = O_HSC + al((size_t)M * 4);
constexpr size_t O_PASS = O_MISC + al(65536);
constexpr size_t P_QK = 0;
constexpr size_t P_VT = P_QK + al((size_t)MP * 3072 * 2);
constexpr size_t P_IT = P_VT + (size_t)1536 * MP * 2;
constexpr size_t P_HFQG = P_IT + al((size_t)512 * MP * 2);
constexpr size_t P_MQ = P_HFQG + al((size_t)MP * 1536 * 2);
constexpr size_t P_GATE = P_MQ + al((size_t)MP * 512 * 2);
constexpr size_t P_OG = P_GATE + al((size_t)MP * 3072 * 2);
constexpr size_t P_LSE = P_OG + al((size_t)MP * 1536 * 2);
constexpr size_t P_BR = P_LSE + al((size_t)MP * 12 * 4);
constexpr size_t P_MERGED = P_BR + al((size_t)MP * 1536 * 2);
constexpr size_t P_MIX = P_MERGED + al((size_t)MP * 1024 * 2);
constexpr size_t P_HSTL = P_MIX + al((size_t)MP * 1024 * 4);
constexpr size_t P_HSTD = P_HSTL + al((size_t)256 * 16384 * 4);
constexpr size_t P_SIN = P_HSTD + al((size_t)256 * 128 * 4);
constexpr size_t P_END = P_SIN + al((size_t)256 * 16384 * 4);
constexpr size_t P_PQ = 0;
constexpr size_t P_IDX = P_PQ + al((size_t)M * 2048 * 2);
constexpr size_t P_PG = P_IDX + al((size_t)M * 128 * 4);
constexpr size_t P_C = P_PG + al((size_t)M * 128 * 4);
constexpr size_t P_END2 = P_C + al((size_t)M * 128 * 4);
constexpr size_t P_PD = 0;
constexpr size_t P_FFN = P_PD + al((size_t)M * 1024 * 2);
static_assert(P_FFN + (size_t)M * 1024 * 2 <= P_IDX, "PEER overlay");
constexpr size_t WS_NEED = O_PASS + (P_END > P_END2 ? P_END : P_END2);
static_assert(WS_NEED <= (size_t)1073741824, "workspace budget");

DI int dil_of(int g) { return g == 0 ? 1 : (g == 1 ? 4 : 16); }
DI float dpp_x(float v, const int which) {
    const int s = __float_as_int(v);
    const int r = which == 0 ? __builtin_amdgcn_update_dpp(0, s, 0xB1, 0xF, 0xF, true) : which == 1 ? __builtin_amdgcn_update_dpp(0, s, 0x4E, 0xF, 0xF, true)
                : which == 2 ? __builtin_amdgcn_update_dpp(0, s, 0x141, 0xF, 0xF, true) : __builtin_amdgcn_update_dpp(0, s, 0x128, 0xF, 0xF, true);
    return __int_as_float(r);
}
DI float pair_sum(float v) { const auto rr = __builtin_amdgcn_permlane32_swap(__float_as_uint(v), __float_as_uint(v), false, false); return __uint_as_float(rr[0]) + __uint_as_float(rr[1]); }
DI float pair_max(float v) { const auto rr = __builtin_amdgcn_permlane32_swap(__float_as_uint(v), __float_as_uint(v), false, false); return fmaxf(__uint_as_float(rr[0]), __uint_as_float(rr[1])); }
DI float wave_max(float v) {
    v = fmaxf(v, dpp_x(v, 0)); v = fmaxf(v, dpp_x(v, 1)); v = fmaxf(v, dpp_x(v, 2)); v = fmaxf(v, dpp_x(v, 3));
    { const auto rr = __builtin_amdgcn_permlane16_swap(__float_as_uint(v), __float_as_uint(v), false, false); v = fmaxf(__uint_as_float(rr[0]), __uint_as_float(rr[1])); }
    return pair_max(v);
}
DI float wave_sum(float v) {
    v += dpp_x(v, 0); v += dpp_x(v, 1); v += dpp_x(v, 2); v += dpp_x(v, 3);
    { const auto rr = __builtin_amdgcn_permlane16_swap(__float_as_uint(v), __float_as_uint(v), false, false); v = __uint_as_float(rr[0]) + __uint_as_float(rr[1]); }
    return pair_sum(v);
}

#define LAS __attribute__((address_space(3)))
#define GAS __attribute__((address_space(1)))
typedef unsigned u32x4 __attribute__((ext_vector_type(4)));
typedef unsigned u32x2 __attribute__((ext_vector_type(2)));
typedef float f32x2 __attribute__((ext_vector_type(2)));
typedef __bf16 bf16x2_t __attribute__((ext_vector_type(2)));
DI unsigned cvtpk(float lo, float hi) { f32x2 v = {lo, hi}; bf16x2_t b = __builtin_convertvector(v, bf16x2_t); return __builtin_bit_cast(unsigned, b); }
constexpr float LOG2E = 1.4426950408889634f;
constexpr int NTHR_C = 512;
DI float fast_sigmoid(float z) { return __builtin_amdgcn_rcpf(1.f + __builtin_amdgcn_exp2f(-z * LOG2E)); }

namespace g8 {
constexpr int BM = 256, BK = 64, HALF = 128, HTB = HALF * BK * 2, STAGE_BYTES = 8 * HTB;
DI int lds_byte(int r, int c) { const int st = (r >> 4) * 2 + (c >> 5), rr = r & 15, cc = c & 31, ob = rr * 64 + cc * 2; return st * 1024 + (ob ^ (((ob >> 9) & 1) << 5)); }
DI void stage_rc(int b, int& R, int& C) { const int st = b / 1024, sb = b % 1024, swz = sb ^ (((sb >> 9) & 1) << 5); R = (st >> 1) * 16 + swz / 64; C = (st & 1) * 32 + (swz % 64) / 2; }
DI int perm32(int rho) { const int n = rho >> 4, i = rho & 15; return 8 * (i >> 2) + 4 * n + (i & 3); }

struct Unit { unsigned a, b; int dla, dlb; int pm, pn, kind; };

template <class Epi, class Sched>
DI void gemm_phase(LAS unsigned char* lds, const char* const wsb, const int K, const Sched& S, const Epi& E, const int tid) {
    const int wid = __builtin_amdgcn_readfirstlane(tid >> 6), lane = tid & 63, wr = wid >> 2, wc = wid & 3, fr = lane & 15, fq = lane >> 4;
    const int nt = K / BK;
    unsigned rak[2], rbk[2], ccb[2];
#pragma unroll
    for (int i = 0; i < 2; ++i) { int R, C; stage_rc(tid * 16 + i * 8192, R, C); const int Rb = Epi::PERM ? ((R & ~31) + perm32(R & 31)) : R;
        rak[i] = (unsigned)(R * K) * 2u; rbk[i] = (unsigned)(Rb * K) * 2u; ccb[i] = (unsigned)C * 2u; }
    const unsigned kstep = (unsigned)(BK * 2);
    const unsigned hstepA = (unsigned)(HALF * K * 2);
    const unsigned ldsw = (unsigned)wid * 1024u;
    const int aoff = lds_byte(wr * 64 + fr, fq * 8), boff = lds_byte(wc * 32 + fr, fq * 8);
#define G8_SA(b, h) (((b) * 2 + (h)) * HTB)
#define G8_SB(b, h) ((4 + (b) * 2 + (h)) * HTB)
#define G8_STAGE(bufoff, gbase, v0, v1) do { \
        __builtin_amdgcn_global_load_lds((const unsigned*)(wsb + (unsigned)((gbase) + (v0))), (LAS unsigned*)(lds + (bufoff) + ldsw), 16, 0, 0); \
        __builtin_amdgcn_global_load_lds((const unsigned*)(wsb + (unsigned)((gbase) + (v1))), (LAS unsigned*)(lds + (bufoff) + ldsw + 8192), 16, 0, 0); } while (0)
#define G8_LDA(dst, b, h) do { _Pragma("unroll") for (int m = 0; m < 4; ++m) _Pragma("unroll") for (int k = 0; k < 2; ++k) dst[m][k] = *(const LAS bf16x8*)(lds + G8_SA(b, h) + aoff + m * 2048 + k * 1024); } while (0)
#define G8_LDB(dst, b, h) do { _Pragma("unroll") for (int n = 0; n < 2; ++n) _Pragma("unroll") for (int k = 0; k < 2; ++k) dst[n][k] = *(const LAS bf16x8*)(lds + G8_SB(b, h) + boff + n * 2048 + k * 1024); } while (0)
#define G8_MMA(ai, bj, At, Bt) do { __builtin_amdgcn_s_setprio(1); _Pragma("unroll") for (int m = 0; m < 4; ++m) _Pragma("unroll") for (int n = 0; n < 2; ++n) _Pragma("unroll") for (int k = 0; k < 2; ++k) \
        acc[ai][bj][m][n] = __builtin_amdgcn_mfma_f32_16x16x32_bf16(Bt[n][k], At[m][k], acc[ai][bj][m][n], 0, 0, 0); __builtin_amdgcn_s_setprio(0); } while (0)
#define G8_WAIT_V(n) asm volatile("s_waitcnt vmcnt(" #n ")" ::: "memory")
#define G8_WAIT_L(n) asm volatile("s_waitcnt lgkmcnt(" #n ")" ::: "memory")
#define G8_BAR __builtin_amdgcn_s_barrier()
#define G8_SCHED __builtin_amdgcn_sched_barrier(0)
    Unit cur, nxt; int ui = 0;
    if (!S.next(0, cur)) return;
    f32x4 acc[2][2][4][2];
#pragma unroll
    for (int a = 0; a < 2; ++a)
#pragma unroll
        for (int b = 0; b < 2; ++b)
#pragma unroll
            for (int m = 0; m < 4; ++m)
#pragma unroll
                for (int n = 0; n < 2; ++n) acc[a][b][m][n] = (f32x4){0.f, 0.f, 0.f, 0.f};
    bf16x8 At[4][2], B0[2][2], B1[2][2];
    unsigned cA = cur.a, cB = cur.b;
    unsigned vBc0 = rbk[0] * (unsigned)cur.dlb + ccb[0], vBc1 = rbk[1] * (unsigned)cur.dlb + ccb[1]; unsigned hBc = hstepA * (unsigned)cur.dlb;
    unsigned vAc0 = rak[0] * (unsigned)cur.dla + ccb[0], vAc1 = rak[1] * (unsigned)cur.dla + ccb[1]; unsigned hAc = hstepA * (unsigned)cur.dla;
    G8_STAGE(G8_SB(0, 0), cB, vBc0, vBc1); G8_STAGE(G8_SB(0, 1), cB + hBc, vBc0, vBc1); G8_STAGE(G8_SA(0, 0), cA, vAc0, vAc1); G8_STAGE(G8_SA(0, 1), cA + hAc, vAc0, vAc1);
    if (wr == 1) G8_BAR;
    G8_WAIT_V(2); G8_BAR;
    G8_STAGE(G8_SB(1, 0), cB + kstep, vBc0, vBc1); G8_STAGE(G8_SA(1, 0), cA + kstep, vAc0, vAc1); G8_STAGE(G8_SB(1, 1), cB + hBc + kstep, vBc0, vBc1);
    G8_WAIT_V(6); G8_BAR;
    for (;;) {
        const bool has_next = S.next(ui + 1, nxt);
        const unsigned nA = has_next ? nxt.a : cA, nB = has_next ? nxt.b : cB; const int dln = has_next ? nxt.dlb : cur.dlb;
        const unsigned vBn0 = rbk[0] * (unsigned)dln + ccb[0], vBn1 = rbk[1] * (unsigned)dln + ccb[1]; const unsigned hBn = hstepA * (unsigned)dln;
        const int dlan = has_next ? nxt.dla : cur.dla;
        const unsigned vAn0 = rak[0] * (unsigned)dlan + ccb[0], vAn1 = rak[1] * (unsigned)dlan + ccb[1]; const unsigned hAn = hstepA * (unsigned)dlan;
        for (int t = 0; t < nt; t += 2) {
            if constexpr (Epi::HOOK) E.hook(acc, cur, t, wr, wc, fr, fq);
            const bool last = (t == nt - 2);
            const unsigned a1 = cA + (unsigned)(t + 1) * kstep;
            const unsigned a2 = last ? nA : cA + (unsigned)(t + 2) * kstep, b2 = last ? nB : cB + (unsigned)(t + 2) * kstep;
            const unsigned a3 = a2 + kstep, b3 = b2 + kstep;
            const unsigned vB0 = last ? vBn0 : vBc0, vB1 = last ? vBn1 : vBc1; const unsigned hB = last ? hBn : hBc;
            const unsigned vA0 = last ? vAn0 : vAc0, vA1 = last ? vAn1 : vAc1; const unsigned hA = last ? hAn : hAc;
            G8_LDB(B0, 0, 0); G8_LDB(B1, 0, 1); G8_SCHED; G8_LDA(At, 0, 0); G8_STAGE(G8_SA(1, 1), a1 + hAc, vAc0, vAc1);
            G8_WAIT_V(8); G8_WAIT_L(0); G8_BAR; G8_MMA(0, 0, At, B0); G8_MMA(0, 1, At, B1); G8_BAR; G8_SCHED;
            G8_LDA(At, 0, 1); G8_STAGE(G8_SB(0, 0), b2, vB0, vB1); G8_STAGE(G8_SB(0, 1), b2 + hB, vB0, vB1); G8_STAGE(G8_SA(0, 0), a2, vA0, vA1);
            G8_WAIT_V(8); G8_WAIT_L(0); G8_BAR; G8_MMA(1, 0, At, B0); G8_MMA(1, 1, At, B1); G8_BAR; G8_SCHED;
            G8_LDB(B0, 1, 0); G8_LDB(B1, 1, 1); G8_SCHED; G8_LDA(At, 1, 0); G8_STAGE(G8_SA(0, 1), a2 + hA, vA0, vA1);
            G8_WAIT_V(8); G8_WAIT_L(0); G8_BAR; G8_MMA(0, 0, At, B0); G8_MMA(0, 1, At, B1); G8_BAR; G8_SCHED;
            G8_LDA(At, 1, 1); G8_STAGE(G8_SB(1, 0), b3, vB0, vB1); G8_STAGE(G8_SB(1, 1), b3 + hB, vB0, vB1); G8_STAGE(G8_SA(1, 0), a3, vA0, vA1);
            G8_WAIT_V(8); G8_WAIT_L(0); G8_BAR; G8_MMA(1, 0, At, B0); G8_MMA(1, 1, At, B1); G8_BAR; G8_SCHED;
        }
        if (wr == 0) G8_BAR;
        E(acc, cur, wr, wc, fr, fq);
        if (!has_next) break;
#pragma unroll
        for (int a = 0; a < 2; ++a)
#pragma unroll
            for (int b = 0; b < 2; ++b)
#pragma unroll
                for (int m = 0; m < 4; ++m)
#pragma unroll
                    for (int n = 0; n < 2; ++n) acc[a][b][m][n] = (f32x4){0.f, 0.f, 0.f, 0.f};
        cur = nxt; cA = nA; cB = nB; vBc0 = vBn0; vBc1 = vBn1; hBc = hBn; vAc0 = vAn0; vAc1 = vAn1; hAc = hAn; ++ui;
        if (wr == 1) G8_BAR;
    }
    G8_WAIT_V(0);
    G8_BAR;
#undef G8_SA
#undef G8_SB
#undef G8_STAGE
#undef G8_LDA
#undef G8_LDB
#undef G8_MMA
#undef G8_WAIT_V
#undef G8_WAIT_L
#undef G8_BAR
#undef G8_SCHED
}
}

typedef GAS unsigned gu32;
#define XB_TMO      128
#define XB_XCNT(j)  (256  + 64 * (j))
#define XB_XSUB(j)  (1280 + 64 * (j))
#define XB_XGEN(j)  (2304 + 64 * (j))
#define XB_TOP      3328
#define XB_TOPGEN   3392
#define XCD_BAR_WORDS 3456
#define XB_SPIN_CAP (1u << 22)
DI unsigned xb_ld(unsigned* p)              { return __hip_atomic_load(p, __ATOMIC_RELAXED, __HIP_MEMORY_SCOPE_AGENT); }
DI unsigned xb_add(unsigned* p, unsigned v) { return __hip_atomic_fetch_add(p, v, __ATOMIC_RELAXED, __HIP_MEMORY_SCOPE_AGENT); }
DI unsigned xb_xcc_id() { return (unsigned)__builtin_amdgcn_s_getreg((3 << 11) | 20) & 0xFu; }
#define XB_SPIN(cond, bar) do { unsigned _sp = 0; while (cond) { __builtin_amdgcn_s_sleep(1); \
    if ((++_sp & 255u) == 0u) { if (xb_ld(&(bar)[XB_TMO])) break; if (_sp > XB_SPIN_CAP) { atomicAdd(&(bar)[XB_TMO], 1u); break; } } } } while (0)
struct XcdBarrier { unsigned* bar; unsigned x; volatile LAS unsigned* st; };
DI XcdBarrier xcd_barrier_post(unsigned* bar, volatile LAS unsigned* st) {
    XcdBarrier b; b.bar = bar; b.x = xb_xcc_id(); b.st = st;
    if (threadIdx.x == 0) st[2] = xb_add(&bar[XB_XCNT(b.x)], 1u);
    return b;
}
DI void xcd_barrier_complete(unsigned* bar, unsigned x, unsigned& nloc, unsigned& nx) {
    const unsigned G = gridDim.x * gridDim.y * gridDim.z;
    unsigned sum, cnt, mine, sp = 0u;
    for (;;) {
        sum = 0u; cnt = 0u; mine = 0u;
#pragma unroll
        for (unsigned j = 0; j < 16; ++j) { const unsigned c = xb_ld(&bar[XB_XCNT(j)]); sum += c; cnt += (c > 0u) ? 1u : 0u; mine = (j == x) ? c : mine; }
        if (sum == G) break;
        __builtin_amdgcn_s_sleep(1);
        if ((++sp & 255u) == 0u) { if (xb_ld(&bar[XB_TMO])) break; if (sp > XB_SPIN_CAP) { atomicAdd(&bar[XB_TMO], 1u); break; } }
    }
    nloc = mine > 0u ? mine : 1u; nx = cnt > 0u ? cnt : 1u;
}
DI void xcd_barrier(const XcdBarrier& b) {
    asm volatile("s_waitcnt vmcnt(0)" ::: "memory");
    __syncthreads();
    if (threadIdx.x == 0) {
        unsigned* bar = b.bar;
        __builtin_amdgcn_s_waitcnt(0);
        unsigned nloc = b.st[0], nx = b.st[1];
        if (nloc == 0u) { xcd_barrier_complete(bar, b.x, nloc, nx); b.st[0] = nloc; b.st[1] = nx; }
        const unsigned old = xb_add(&bar[XB_XSUB(b.x)], 1u);
        const unsigned gen = old / nloc;
        if (old + 1u == (gen + 1u) * nloc) {
            __builtin_amdgcn_fence(__ATOMIC_RELEASE, "agent");
            asm volatile("s_waitcnt vmcnt(0)" ::: "memory");
            const unsigned og = xb_add(&bar[XB_TOP], 1u);
            const unsigned tg = og / nx;
            if (og + 1u == (tg + 1u) * nx) xb_add(&bar[XB_TOPGEN], 1u);
            else XB_SPIN(xb_ld(&bar[XB_TOPGEN]) == tg, bar);
            __builtin_amdgcn_fence(__ATOMIC_ACQUIRE, "agent");
            xb_add(&bar[XB_XGEN(b.x)], 1u);
            asm volatile("s_waitcnt vmcnt(0)" ::: "memory");
        } else {
            XB_SPIN(xb_ld(&bar[XB_XGEN(b.x)]) == gen, bar);
            __builtin_amdgcn_fence(__ATOMIC_ACQUIRE, "agent");
            asm volatile("s_waitcnt vmcnt(0)" ::: "memory");
        }
    }
    __syncthreads();
}

constexpr int NWAVES = 8, NTHR = NWAVES * 64;
constexpr int RING_BYTES = 131072, LDS_BYTES = 147456, LDSCTL_OFF = LDS_BYTES - 1024, MISC_OFF = LDSCTL_OFF + 320;
constexpr size_t CTL_BYTES = 65536;
enum { PH_ALL = 0, PH_PRO = 11, PH_PROJ = 1, PH_ATTN = 2, PH_HGPRE = 3, PH_HGMAIN = 4, PH_WIDEN = 5, PH_WOUT = 6, PH_LN1 = 7, PH_PQ = 8, PH_ROUTE = 9, PH_EXPERTS = 10, PH_HGSCAN = 12 };
struct Args { const float* in[18]; float* out; unsigned char* ws; int ph, pass; };

struct Bufs {
    const bf16_t *WIN, *XBp; bf16_t *QK, *VIT, *HFQG, *MQ, *GATE;
};

struct SchedP1 {
    unsigned XBp, W; int G, c;
    DI bool next(int i, g8::Unit& u) const {
        const int L = i * G + c; if (L >= 2560) return false;
        if (L < 2048) { const int x = L & 7, off = L >> 3; u.pm = 8 * x + (off & 7); u.pn = off >> 3; u.kind = 0; u.dlb = 1;
            const int hp = u.pn < 12 ? (u.pn < 6 ? u.pn : u.pn - 6) : 0, dl = hp < 2 ? 1 : (hp < 4 ? 4 : 16);
            const int v0 = u.pm * 256, lb = v0 / S, vv = v0 % S, per = S / dl, r = vv / per, m0 = vv % per;
            u.dla = dl; u.a = XBp + (unsigned)(lb * S + m0 * dl + r) * D * 2u; u.b = W + (unsigned)u.pn * 256u * D * 2u; }
        else { const int idx = L - 2048; u.pm = idx & 7; u.pn = idx >> 3; u.kind = 1;
            const int dl = u.pm < 2 ? 1 : (u.pm < 4 ? 4 : (u.pm < 6 ? 16 : 1));
            const int v0 = u.pn * 256, lb = v0 / S, vv = v0 % S, per = S / dl, r = vv / per, m0 = vv % per;
            u.dla = 1; u.dlb = dl; u.a = W + (unsigned)(8192 + u.pm * 256) * D * 2u; u.b = XBp + (unsigned)(lb * S + m0 * dl + r) * D * 2u; }
        return true;
    }
};
DI int frag_row_off(int d0, int r32) { return (((d0 >> 4) * 64 + ((d0 >> 3) & 1) * 32 + r32) * 8); }
struct EpiP1 {
    static constexpr bool PERM = true, HOOK = false;
    char* pr; const float* b_gate;
    DI void hook(f32x4 (&)[2][2][4][2], const g8::Unit&, int, int, int, int, int) const {}
    DI void operator()(const f32x4 (&acc)[2][2][4][2], const g8::Unit& u, int wr, int wc, int fr, int fq) const {
        const int rowl = wr * 64 + fr, d0 = wc * 32 + 8 * fq;
        if (u.kind == 1) {
#pragma unroll
            for (int ai = 0; ai < 2; ++ai)
#pragma unroll
                for (int m = 0; m < 4; ++m) { const int R = u.pm * 256 + rowl + ai * 128 + m * 16;
#pragma unroll
                    for (int bj = 0; bj < 2; ++bj) { const f32x4 v0 = acc[ai][bj][m][0], v1 = acc[ai][bj][m][1];
                        const int c = u.pn * 256 + bj * 128 + d0;
                        if (R < 1536) {
                            const int gh = R >> 7, d = R & 127, lb = c >> 13, pos = c & (S - 1), kk = pos & 31;
                            bf16_t* blk = (bf16_t*)(pr + P_VT) + ((size_t)((lb * 12 + gh) * 256 + (pos >> 5))) * 4096 + (((d >> 5) * 2 + (kk >> 4)) * 64 + (d & 31)) * 8 + 4 * ((kk >> 3) & 1);
                            u32x2 wa, wb; wa.x = cvtpk(v0[0], v0[1]); wa.y = cvtpk(v0[2], v0[3]); wb.x = cvtpk(v1[0], v1[1]); wb.y = cvtpk(v1[2], v1[3]);
                            *(u32x2*)blk = wa; *(u32x2*)(blk + 32 * 8) = wb;
                        } else {
                            u32x4 w; w.x = cvtpk(v0[0], v0[1]); w.y = cvtpk(v0[2], v0[3]); w.z = cvtpk(v1[0], v1[1]); w.w = cvtpk(v1[2], v1[3]);
                            *(u32x4*)((bf16_t*)(pr + P_IT) + (size_t)(R - 1536) * MP + c) = w;
                        } } }
            return;
        }
        if (u.pn < 12 || u.pn == 18 || u.pn == 19) {
#pragma unroll
            for (int ai = 0; ai < 2; ++ai)
#pragma unroll
                for (int m = 0; m < 4; ++m) { const int row = u.pm * 256 + rowl + ai * 128 + m * 16;
#pragma unroll
                    for (int bj = 0; bj < 2; ++bj) { const f32x4 v0 = acc[ai][bj][m][0], v1 = acc[ai][bj][m][1];
                        u32x4 w; w.x = cvtpk(v0[0], v0[1]); w.y = cvtpk(v0[2], v0[3]); w.z = cvtpk(v1[0], v1[1]); w.w = cvtpk(v1[2], v1[3]);
                        bf16_t* dst;
                        if (u.pn < 12) { const int hh = u.pn * 2 + bj, qk = hh >= 12 ? 1 : 0, gh = hh - 12 * qk;
                            const int lb = row >> 13, pos = row & (S - 1);
                            dst = (bf16_t*)(pr + P_QK) + ((size_t)(((qk * BPP + lb) * 12 + gh) * 256 + (pos >> 5))) * 4096 + frag_row_off(d0, pos & 31); }
                        else { const int h = (u.pn - 18) * 2 + bj; dst = (bf16_t*)(pr + P_MQ) + ((size_t)((row >> 5) * 4 + h)) * 4096 + frag_row_off(d0, row & 31); }
                        *(u32x4*)dst = w; } }
            return;
        }
        bf16_t* base; int ldc, colt; bool gate = false;
        if (u.pn < 18) { base = (bf16_t*)(pr + P_HFQG); ldc = 1536; colt = (u.pn - 12) * 256; }
        else { base = (bf16_t*)(pr + P_GATE); ldc = 3072; colt = (u.pn - 20) * 256; gate = true; }
        const int row0 = u.pm * 256 + rowl, col0 = colt + d0;
        f32x4 bv[2][2];
#pragma unroll
        for (int bj = 0; bj < 2; ++bj)
#pragma unroll
            for (int n = 0; n < 2; ++n) bv[bj][n] = gate ? *(const f32x4*)(b_gate + col0 + bj * 128 + 4 * n) : (f32x4){0.f, 0.f, 0.f, 0.f};
#pragma unroll
        for (int ai = 0; ai < 2; ++ai)
#pragma unroll
            for (int m = 0; m < 4; ++m) { bf16_t* rowp = base + (size_t)(row0 + ai * 128 + m * 16) * ldc + col0;
#pragma unroll
                for (int bj = 0; bj < 2; ++bj) { f32x4 v0 = acc[ai][bj][m][0], v1 = acc[ai][bj][m][1];
                    if (gate) { v0 = v0 + bv[bj][0]; v1 = v1 + bv[bj][1];
#pragma unroll
                        for (int e = 0; e < 4; ++e) { v0[e] = fast_sigmoid(v0[e]); v1[e] = fast_sigmoid(v1[e]); } }
                    u32x4 w; w.x = cvtpk(v0[0], v0[1]); w.y = cvtpk(v0[2], v0[3]); w.z = cvtpk(v1[0], v1[1]); w.w = cvtpk(v1[2], v1[3]);
                    *(u32x4*)(rowp + bj * 128) = w; } }
    }
};

typedef float f32x16 __attribute__((ext_vector_type(16)));
typedef short s16x4 __attribute__((ext_vector_type(4)));
DI int crow(int r, int hi) { return (r & 3) + 8 * (r >> 2) + 4 * hi; }
DI float xor32f(float v) { return __shfl_xor(v, 32); }
#define MFMA32(a, b, c) __builtin_amdgcn_mfma_f32_32x32x16_bf16((a), (b), (c), 0, 0, 0)
DI bf16x8 pack8(const f32x16& p, int s) {
    u32x4 w; w.x = cvtpk(p[8 * s + 0], p[8 * s + 1]); w.y = cvtpk(p[8 * s + 2], p[8 * s + 3]); w.z = cvtpk(p[8 * s + 4], p[8 * s + 5]); w.w = cvtpk(p[8 * s + 6], p[8 * s + 7]);
    return __builtin_bit_cast(bf16x8, w);
}
DI bf16x8 ldvt(const bf16_t* vp) {
    const s16x4 lo = *(const s16x4*)vp, hi4 = *(const s16x4*)(vp + 8);
    return __builtin_shufflevector(lo, hi4, 0, 1, 2, 3, 4, 5, 6, 7);
}
constexpr int DIL_TASKS = BPP * 12 * (S / 32);
constexpr int MEM_TASKS = (MP / 32) * 4;
DI void attn_dil_wave(const bf16_t* __restrict__ QK, const bf16_t* __restrict__ VT, const LAS float* btab, bf16_t* __restrict__ OG, float* __restrict__ LSE, int task, int lane) {
    const int r32 = lane & 31, hi = lane >> 5;
    const int q32 = task & 255, gh = (task >> 8) % 12, lb = task / (256 * 12);
    const int g = gh >> 2, h = gh & 3, dl = dil_of(g), per = S / dl;
    const int tok0 = q32 * 32, r = tok0 / per, m0 = tok0 % per;
    const size_t rowq = (size_t)lb * S + (size_t)(m0 + r32) * dl + r;
    bf16x8 qf[8];
    const int tile0 = (r * per + m0) >> 5;
    { const bf16_t* qp = QK + ((size_t)((lb * 12 + gh) * 256 + tile0)) * 4096 + lane * 8;
#pragma unroll
      for (int ks = 0; ks < 8; ++ks) qf[ks] = *(const bf16x8*)(qp + ks * 512); }
    const LAS float* bt = btab + g * 129 * 4 + h;
    f32x16 o[4];
#pragma unroll
    for (int dt = 0; dt < 4; ++dt)
#pragma unroll
        for (int i = 0; i < 16; ++i) o[dt][i] = 0.f;
    float mrun = -INFINITY, sum = 0.f;
    const bf16_t* vbase = VT + ((size_t)((lb * 12 + gh) * 256 + tile0 - 4)) * 4096 + lane * 8;
    const bf16_t* kbase = QK + ((size_t)(((BPP + lb) * 12 + gh) * 256 + tile0 - 4)) * 4096 + lane * 8;
    const int kt0 = (m0 >= 128 ? 0 : (128 - m0) >> 5);
    bf16x8 kf[8], vf[8];
#pragma unroll
    for (int ks = 0; ks < 8; ++ks) kf[ks] = *(const bf16x8*)(kbase + (size_t)kt0 * 4096 + ks * 512);
#pragma unroll 1
    for (int kt = kt0; kt < 5; ++kt) {
#pragma unroll
        for (int i = 0; i < 8; ++i) vf[i] = *(const bf16x8*)(vbase + (size_t)kt * 4096 + i * 512);
        f32x16 sc;
#pragma unroll
        for (int i = 0; i < 16; ++i) sc[i] = 0.f;
#pragma unroll
        for (int ks = 0; ks < 8; ++ks) sc = MFMA32(kf[ks], qf[ks], sc);
        if (kt < 4) {
#pragma unroll
            for (int ks = 0; ks < 8; ++ks) kf[ks] = *(const bf16x8*)(kbase + (size_t)(kt + 1) * 4096 + ks * 512);
        }
        float mx = -INFINITY;
        if (kt == 0 || kt == 4) {
#pragma unroll
            for (int i = 0; i < 16; ++i) {
                const int delta = 128 - 32 * kt + r32 - crow(i, hi);
                const bool valid = (delta >= 0) && (delta <= 128);
                const int di = delta < 0 ? 0 : (delta > 128 ? 128 : delta);
                const float x = sc[i] * (QSCALE * LOG2E) + bt[di * 4];
                sc[i] = valid ? x : -INFINITY; mx = fmaxf(mx, sc[i]);
            }
        } else {
            const LAS float* btk = bt + (128 - 32 * kt + r32 - 4 * hi) * 4;
#pragma unroll
            for (int i = 0; i < 16; ++i) { sc[i] = sc[i] * (QSCALE * LOG2E) + btk[-4 * ((i & 3) + 8 * (i >> 2))]; mx = fmaxf(mx, sc[i]); }
        }
        mx = pair_max(mx);
        const float mnew = fmaxf(mrun, mx); const float f = __builtin_amdgcn_exp2f(mrun - mnew);
        sum *= f;
#pragma unroll
        for (int dt = 0; dt < 4; ++dt)
#pragma unroll
            for (int i = 0; i < 16; ++i) o[dt][i] *= f;
        mrun = mnew;
        float ps = 0.f;
#pragma unroll
        for (int i = 0; i < 16; ++i) { sc[i] = __builtin_amdgcn_exp2f(sc[i] - mnew); ps += sc[i]; }
        ps = pair_sum(ps); sum += ps;
#pragma unroll
        for (int s = 0; s < 2; ++s) {
            const bf16x8 pb = pack8(sc, s);
#pragma unroll
            for (int dt = 0; dt < 4; ++dt) o[dt] = MFMA32(vf[dt * 2 + s], pb, o[dt]);
        }
    }
    const float inv = 1.f / sum;
    bf16_t* op = OG + rowq * 1536 + g * 512 + h * 128 + 4 * hi;
#pragma unroll
    for (int dt = 0; dt < 4; ++dt)
#pragma unroll
        for (int a = 0; a < 4; ++a) { u32x2 w; w.x = cvtpk(o[dt][4 * a] * inv, o[dt][4 * a + 1] * inv); w.y = cvtpk(o[dt][4 * a + 2] * inv, o[dt][4 * a + 3] * inv); *(u32x2*)(op + 32 * dt + 8 * a) = w; }
    if (hi == 0) LSE[rowq * 12 + gh] = (mrun + __builtin_amdgcn_logf(sum)) * 0.6931471805599453f;
}
DI void attn_mem_wave(const bf16_t* __restrict__ MQ, const bf16_t* __restrict__ MK, const bf16_t* __restrict__ MVT, bf16_t* __restrict__ BR, int task, int batch0, int lane) {
    const int r32 = lane & 31, hi = lane >> 5;
    const int h = task & 3, blk = task >> 2;
    const size_t rowq = (size_t)blk * 32 + r32; const int b = batch0 + blk * 32 / S;
    bf16x8 qf[8];
    { const bf16_t* qp = MQ + ((size_t)(blk * 4 + h)) * 4096 + lane * 8;
#pragma unroll
      for (int ks = 0; ks < 8; ++ks) qf[ks] = *(const bf16x8*)(qp + ks * 512); }
    f32x16 o[4];
#pragma unroll
    for (int dt = 0; dt < 4; ++dt)
#pragma unroll
        for (int i = 0; i < 16; ++i) o[dt][i] = 0.f;
    float mrun = -INFINITY, sum = 0.f;
    const bf16_t* vbase = MVT + ((size_t)((b * 4 + h) * 8)) * 4096 + lane * 8;
    const bf16_t* kbase = MK + ((size_t)((b * 4 + h) * 8)) * 4096 + lane * 8;
#pragma unroll 1
    for (int c = 0; c < 4; ++c) {
        bf16x8 vf[16];
#pragma unroll
        for (int i = 0; i < 16; ++i) vf[i] = *(const bf16x8*)(vbase + (size_t)(c * 2 + (i >> 3)) * 4096 + (i & 7) * 512);
        f32x16 sc[2]; float mx = -INFINITY;
#pragma unroll
        for (int kt = 0; kt < 2; ++kt) {
            const bf16_t* kp = kbase + (size_t)(c * 2 + kt) * 4096;
            f32x16 acc;
#pragma unroll
            for (int i = 0; i < 16; ++i) acc[i] = 0.f;
#pragma unroll
            for (int ks = 0; ks < 8; ++ks) { const bf16x8 kf = *(const bf16x8*)(kp + ks * 512); acc = MFMA32(kf, qf[ks], acc); }
#pragma unroll
            for (int i = 0; i < 16; ++i) { sc[kt][i] = acc[i] * (QSCALE * LOG2E); mx = fmaxf(mx, sc[kt][i]); }
            asm volatile("" ::: "memory");
        }
        mx = pair_max(mx);
        const float mnew = fmaxf(mrun, mx); const float f = __builtin_amdgcn_exp2f(mrun - mnew);
        sum *= f;
#pragma unroll
        for (int dt = 0; dt < 4; ++dt)
#pragma unroll
            for (int i = 0; i < 16; ++i) o[dt][i] *= f;
        mrun = mnew;
        float ps = 0.f;
#pragma unroll
        for (int kt = 0; kt < 2; ++kt)
#pragma unroll
            for (int i = 0; i < 16; ++i) { sc[kt][i] = __builtin_amdgcn_exp2f(sc[kt][i] - mnew); ps += sc[kt][i]; }
        ps = pair_sum(ps); sum += ps;
#pragma unroll
        for (int kt = 0; kt < 2; ++kt)
#pragma unroll
            for (int s = 0; s < 2; ++s) {
                const bf16x8 pb = pack8(sc[kt], s);
#pragma unroll
                for (int dt = 0; dt < 4; ++dt) o[dt] = MFMA32(vf[kt * 8 + dt * 2 + s], pb, o[dt]);
                asm volatile("" ::: "memory");
            }
    }
    const float inv = 1.f / sum;
    bf16_t* op = BR + rowq * 1536 + 1024 + h * 128 + 4 * hi;
#pragma unroll
    for (int dt = 0; dt < 4; ++dt)
#pragma unroll
        for (int a = 0; a < 4; ++a) { u32x2 w; w.x = cvtpk(o[dt][4 * a] * inv, o[dt][4 * a + 1] * inv); w.y = cvtpk(o[dt][4 * a + 2] * inv, o[dt][4 * a + 3] * inv); *(u32x2*)(op + 32 * dt + 8 * a) = w; }
}

constexpr int HG_SCH = 4, HG_UPS = S / 64 / HG_SCH  , HG_UNITS = BPP * 4 * HG_UPS  ;
constexpr int HG_ROW = 136, HG_KT_ROW = 72;
constexpr int HG_KP = 0, HG_QP = 64 * HG_ROW * 2, HG_QPP = 2 * HG_QP, HG_KPPT = 3 * HG_QP, HG_DEC = HG_KPPT + 128 * HG_KT_ROW * 2, HG_SSQ = HG_DEC + 512, HG_PSUM = HG_SSQ + 1024, HG_UNIT_BYTES = HG_PSUM + 2048;
DI bf16x8 lds_ld2x8(const LAS unsigned char* p) {
    const s16x4 lo = *(const LAS s16x4*)p, hi4 = *(const LAS s16x4*)(p + 16);
    return __builtin_shufflevector(lo, hi4, 0, 1, 2, 3, 4, 5, 6, 7);
}
DI int opq(int x) { asm volatile("" : "+v"(x)); return x; }
DI float lds_bf(const LAS unsigned char* p) { return __uint_as_float((unsigned)(*(const LAS unsigned short*)p) << 16); }
template <bool MAIN>
DI void hgrn_unit(LAS unsigned char* ul, int unit, int u, const bf16_t* __restrict__ HFQG, const bf16_t* __restrict__ IT, const float* __restrict__ lbv, const float* __restrict__ nwv,
                  float* HSTL, float* HSTD, const float* __restrict__ SIN, bf16_t* __restrict__ BR) {
    constexpr int NX = MAIN ? 4 : 2;
    const int lane = u & 63, w = u >> 6, r32 = lane & 31, hi = lane >> 5, dvt = w & 3, wh = w >> 2;
    const int seq = unit / HG_UPS, j = unit % HG_UPS, lb = seq >> 2, h = seq & 3;
    const int dk = u & 127, qt = u >> 7, cb = 16 * qt;
    const float lbd = lbv[h * 128 + dk];
    const size_t row0 = (size_t)lb * S + (size_t)j * (64 * HG_SCH);
    LAS unsigned char* Kp = ul + HG_KP; LAS unsigned char* Qp = ul + HG_QP; LAS unsigned char* Qpp = ul + HG_QPP; LAS unsigned char* KppT = ul + HG_KPPT;
    LAS float* dec = (LAS float*)(ul + HG_DEC); LAS float* ssq = (LAS float*)(ul + HG_SSQ); LAS float* psum = (LAS float*)(ul + HG_PSUM);
    const int dk0 = MAIN ? 0 : 64 * wh;
    f32x16 X[NX];
    if (MAIN) {
        const float* Sp = SIN + (size_t)unit * 16384 + 32 * dvt + r32;
#pragma unroll
        for (int t = 0; t < NX; ++t)
#pragma unroll
            for (int i = 0; i < 16; ++i) X[t][i] = Sp[(size_t)(32 * t + crow(i, hi)) * 128];
    } else {
#pragma unroll
        for (int t = 0; t < NX; ++t)
#pragma unroll
            for (int i = 0; i < 16; ++i) X[t][i] = 0.f;
    }
    float atot = 0.f;
    u32x4 sf[2], sq[2];
    {
        const int sc0 = u >> 4, sch = (u & 15) * 8;
        const bf16_t* fp = HFQG + (row0 + sc0) * 1536 + h * 128 + sch;
#pragma unroll
        for (int i = 0; i < 2; ++i) { sf[i] = *(const u32x4*)(fp + (size_t)(32 * i) * 1536); if (MAIN) sq[i] = *(const u32x4*)(fp + (size_t)(32 * i) * 1536 + 512); }
    }
#pragma unroll 1
    for (int ch = 0; ch < HG_SCH; ++ch) {
        const size_t rc = row0 + (size_t)ch * 64;
        {
            const int sc0 = opq(u) >> 4, sch = (opq(u) & 15) * 8;
#pragma unroll
            for (int i = 0; i < 2; ++i) { *(LAS u32x4*)(Kp + ((sc0 + 32 * i) * HG_ROW + sch) * 2) = sf[i]; if (MAIN) *(LAS u32x4*)(Qp + ((sc0 + 32 * i) * HG_ROW + sch) * 2) = sq[i]; }
        }
        __syncthreads();
        const bf16_t* itrow = IT + (size_t)(h * 128 + 32 * dvt + opq(r32)) * MP;
        bf16x8 ib[4], it0[2], it1[2]; u32x2 gwv[4];
#pragma unroll
        for (int ks = 0; ks < 4; ++ks) ib[ks] = *(const bf16x8*)(itrow + rc + 16 * ks + 8 * hi);
        if (MAIN) {
#pragma unroll
            for (int step = 0; step < 2; ++step) { it0[step] = ldvt(itrow + rc + 16 * step + 4 * hi); it1[step] = ldvt(itrow + rc + 32 + 16 * step + 4 * hi); }
            const size_t grow = rc + 32 * wh + opq(r32);
#pragma unroll
            for (int a4 = 0; a4 < 4; ++a4) gwv[a4] = *(const u32x2*)(HFQG + grow * 1536 + 1024 + h * 128 + 32 * dvt + 4 * opq(hi) + 8 * a4);
        }
        float fv[16], lf[16];
        {
            float s = 0.f;
#pragma unroll
            for (int i = 0; i < 16; ++i) { fv[i] = lbd + (1.f - lbd) * fast_sigmoid(lds_bf(Kp + ((cb + i) * HG_ROW + dk) * 2)); lf[i] = __builtin_amdgcn_logf(fv[i]); s += lf[i]; }
            psum[qt * 128 + dk] = s;
        }
        __syncthreads();
        {
            const float p0 = psum[dk], p1 = psum[128 + dk], p2 = psum[256 + dk], p3 = psum[384 + dk];
            const float amid = p0 + p1, alast = (p0 + p1) + (p2 + p3);
            float run = qt == 0 ? 0.f : (qt == 1 ? p0 : (qt == 2 ? amid : amid + p2));
            atot += alast;
            const float Ela = __builtin_amdgcn_exp2f(alast - amid), Ea = __builtin_amdgcn_exp2f(amid);
#pragma unroll
            for (int c8 = 0; c8 < 2; ++c8) {
                float kt[8];
#pragma unroll
                for (int e = 0; e < 8; ++e) { const int i = 8 * c8 + e, c = cb + i; run += lf[i]; const float key = 1.f - fv[i];
                    const float e1 = __builtin_amdgcn_exp2f(amid - run);
                    const float kp = key * e1;
                    kt[e] = kp * Ela;
                    if (MAIN) { *(LAS bf16_t*)(Kp + (c * HG_ROW + dk) * 2) = f2bf(kp);
                        const float qp = lds_bf(Qp + (c * HG_ROW + dk) * 2) * __builtin_amdgcn_rcpf(e1);
                        *(LAS bf16_t*)(Qp + (c * HG_ROW + dk) * 2) = f2bf(qp);
                        *(LAS bf16_t*)(Qpp + (c * HG_ROW + dk) * 2) = f2bf(qp * Ea); } }
                u32x4 wv; wv.x = cvtpk(kt[0], kt[1]); wv.y = cvtpk(kt[2], kt[3]); wv.z = cvtpk(kt[4], kt[5]); wv.w = cvtpk(kt[6], kt[7]);
                *(LAS u32x4*)(KppT + (dk * HG_KT_ROW + cb + 8 * c8) * 2) = wv;
            }
            if (qt == 0) dec[dk] = __builtin_amdgcn_exp2f(alast);
        }
        if (ch + 1 < HG_SCH) {
            const int sc0 = opq(u) >> 4, sch = (opq(u) & 15) * 8;
            const bf16_t* fp = HFQG + (rc + 64 + sc0) * 1536 + h * 128 + sch;
#pragma unroll
            for (int i = 0; i < 2; ++i) { sf[i] = *(const u32x4*)(fp + (size_t)(32 * i) * 1536); if (MAIN) sq[i] = *(const u32x4*)(fp + (size_t)(32 * i) * 1536 + 512); }
        }
        __syncthreads();
        f32x16 o;
        if (MAIN) {
#pragma unroll
            for (int i = 0; i < 16; ++i) o[i] = 0.f;
            const LAS unsigned char* qrow = Qpp + ((32 * wh + r32) * HG_ROW) * 2;
#pragma unroll
            for (int t = 0; t < 4; ++t)
#pragma unroll
                for (int step = 0; step < 2; ++step) { o = MFMA32(pack8(X[t], step), lds_ld2x8(qrow + (32 * t + 16 * step + 4 * hi) * 2), o); }
            __builtin_amdgcn_sched_barrier(0);
            const int r32m = opq(r32);
            const LAS unsigned char* qprow = Qp + ((32 * wh + r32) * HG_ROW) * 2;
            {
                f32x16 sc;
#pragma unroll
                for (int i = 0; i < 16; ++i) sc[i] = 0.f;
#pragma unroll
                for (int ks = 0; ks < 8; ++ks) { const int cof = (16 * ks + 8 * hi) * 2; sc = MFMA32(*(const LAS bf16x8*)(Kp + (r32 * HG_ROW) * 2 + cof), *(const LAS bf16x8*)(qprow + cof), sc); }
                if (wh == 0) {
#pragma unroll
                    for (int i = 0; i < 16; ++i) sc[i] = (crow(i, hi) <= r32m) ? sc[i] : 0.f;
                }
#pragma unroll
                for (int step = 0; step < 2; ++step) o = MFMA32(it0[step], pack8(sc, step), o);
                __builtin_amdgcn_sched_barrier(0);
            }
            if (wh == 1) {
                f32x16 sc;
#pragma unroll
                for (int i = 0; i < 16; ++i) sc[i] = 0.f;
#pragma unroll
                for (int ks = 0; ks < 8; ++ks) { const int cof = (16 * ks + 8 * hi) * 2; sc = MFMA32(*(const LAS bf16x8*)(Kp + ((32 + r32) * HG_ROW) * 2 + cof), *(const LAS bf16x8*)(qprow + cof), sc); }
#pragma unroll
                for (int i = 0; i < 16; ++i) sc[i] = (crow(i, hi) <= r32m) ? sc[i] : 0.f;
#pragma unroll
                for (int step = 0; step < 2; ++step) o = MFMA32(it1[step], pack8(sc, step), o);
                __builtin_amdgcn_sched_barrier(0);
            }
        }
        {
#pragma unroll
            for (int t = 0; t < NX; ++t) {
#pragma unroll
                for (int i = 0; i < 16; ++i) X[t][i] *= dec[dk0 + 32 * t + crow(i, hi)];
#pragma unroll
                for (int ks = 0; ks < 4; ++ks) { const bf16x8 ka = *(const LAS bf16x8*)(KppT + ((dk0 + 32 * t + r32) * HG_KT_ROW + 16 * ks + 8 * hi) * 2); X[t] = MFMA32(ka, ib[ks], X[t]); }
                __builtin_amdgcn_sched_barrier(0);
            }
        }
        if (MAIN) {
            float q2 = 0.f;
#pragma unroll
            for (int i = 0; i < 16; ++i) q2 += o[i] * o[i];
            q2 = pair_sum(q2); if (hi == 0) ssq[dvt * 64 + 32 * wh + r32] = q2;
        }
        __syncthreads();
        if (MAIN) {
            const int r32o = opq(r32), hio = opq(hi);
            const int c = 32 * wh + r32o; const float tot = ssq[c] + ssq[64 + c] + ssq[128 + c] + ssq[192 + c];
            const float rs = rsqrtf(tot * (1.f / 128.f) + LN_EPS);
            const size_t row = rc + c; const int col = h * 128 + 32 * dvt + 4 * hio;
#pragma unroll
            for (int a4 = 0; a4 < 4; ++a4) {
                const u32x2 gw = gwv[a4]; const f32x4 nw4 = *(const f32x4*)(nwv + col + 8 * a4);
                const float g0 = __uint_as_float(gw.x << 16), g1 = __uint_as_float(gw.x & 0xffff0000u), g2 = __uint_as_float(gw.y << 16), g3 = __uint_as_float(gw.y & 0xffff0000u);
                const float v0 = o[4 * a4] * rs * nw4[0] * g0 * fast_sigmoid(g0), v1 = o[4 * a4 + 1] * rs * nw4[1] * g1 * fast_sigmoid(g1);
                const float v2 = o[4 * a4 + 2] * rs * nw4[2] * g2 * fast_sigmoid(g2), v3 = o[4 * a4 + 3] * rs * nw4[3] * g3 * fast_sigmoid(g3);
                u32x2 wv; wv.x = cvtpk(v0, v1); wv.y = cvtpk(v2, v3);
                *(u32x2*)(BR + row * 1536 + 512 + col + 8 * a4) = wv;
            }
        }
    }
    if (!MAIN) {
        float* L = HSTL + (size_t)unit * 16384 + 32 * dvt + r32;
#pragma unroll
        for (int t = 0; t < NX; ++t)
#pragma unroll
            for (int i = 0; i < 16; ++i) L[(size_t)(dk0 + 32 * t + crow(i, hi)) * 128] = X[t][i];
        if (qt == 0) HSTD[(size_t)unit * 128 + dk] = __builtin_amdgcn_exp2f(atot);
    }
}
DI void hgrn_scan(const float* __restrict__ HSTL, const float* __restrict__ HSTD, float* __restrict__ SIN, int gt) {
    if (gt >= BPP * 4 * 16384) return;
    const int seq = gt >> 14, el = gt & 16383, dkk = el >> 7;
    float st = 0.f;
    for (int j = 0; j < HG_UPS; ++j) { const size_t uo = (size_t)(seq * HG_UPS + j); SIN[uo * 16384 + el] = st; st = HSTD[uo * 128 + dkk] * st + HSTL[uo * 16384 + el]; }
}

struct SchedRows {
    unsigned A, B; int K, nN, nU, G, c;
    DI bool next(int i, g8::Unit& u) const {
        const int L = i * G + c; if (L >= nU) return false;
        const int x = L & 7, off = L >> 3, grp = off / (8 * nN), o2 = off % (8 * nN);
        const int ppx = nU / nN / 8;
        u.pm = x * ppx + 8 * grp + (o2 & 7); u.pn = o2 >> 3; u.kind = 0; u.dla = 1; u.dlb = 1;
        u.a = A + (unsigned)u.pm * 256u * K * 2u; u.b = B + (unsigned)u.pn * 256u * K * 2u; return true;
    }
};
DI void unpack8(const u32x4 w, float (&f)[8]) {
    f[0] = __uint_as_float(w.x << 16); f[1] = __uint_as_float(w.x & 0xffff0000u); f[2] = __uint_as_float(w.y << 16); f[3] = __uint_as_float(w.y & 0xffff0000u);
    f[4] = __uint_as_float(w.z << 16); f[5] = __uint_as_float(w.z & 0xffff0000u); f[6] = __uint_as_float(w.w << 16); f[7] = __uint_as_float(w.w & 0xffff0000u);
}
struct EpiWidenF {
    static constexpr bool PERM = true, HOOK = true;
    const bf16_t* GATE; bf16_t* MERGED;
    DI void hook(f32x4 (&acc)[2][2][4][2], const g8::Unit& u, int t, int wr, int wc, int fr, int fq) const {
        if (t != 8 && t != 16) return;
        const int g = (t >> 3) - 1;
        const int row0 = u.pm * 256 + wr * 64 + fr, col0 = u.pn * 256 + wc * 32 + 8 * fq;
#pragma unroll
        for (int ai = 0; ai < 2; ++ai)
#pragma unroll
            for (int m = 0; m < 4; ++m) { const bf16_t* gp = GATE + (size_t)(row0 + ai * 128 + m * 16) * 3072 + g * 1024 + col0;
#pragma unroll
                for (int bj = 0; bj < 2; ++bj) { float ga[8], gb[8]; unpack8(*(const u32x4*)(gp + bj * 128), ga); unpack8(*(const u32x4*)(gp + 1024 + bj * 128), gb);
#pragma unroll
                    for (int e = 0; e < 4; ++e) { acc[ai][bj][m][0][e] *= ga[e] * __builtin_amdgcn_rcpf(gb[e]); acc[ai][bj][m][1][e] *= ga[4 + e] * __builtin_amdgcn_rcpf(gb[4 + e]); } } }
    }
    DI void operator()(const f32x4 (&acc)[2][2][4][2], const g8::Unit& u, int wr, int wc, int fr, int fq) const {
        const int row0 = u.pm * 256 + wr * 64 + fr, col0 = u.pn * 256 + wc * 32 + 8 * fq;
#pragma unroll
        for (int ai = 0; ai < 2; ++ai)
#pragma unroll
            for (int m = 0; m < 4; ++m) { const size_t row = (size_t)(row0 + ai * 128 + m * 16);
#pragma unroll
                for (int bj = 0; bj < 2; ++bj) { float gc[8]; unpack8(*(const u32x4*)(GATE + row * 3072 + 2048 + col0 + bj * 128), gc);
                    const f32x4 v0 = acc[ai][bj][m][0], v1 = acc[ai][bj][m][1];
                    u32x4 w; w.x = cvtpk(v0[0] * gc[0], v0[1] * gc[1]); w.y = cvtpk(v0[2] * gc[2], v0[3] * gc[3]); w.z = cvtpk(v1[0] * gc[4], v1[1] * gc[5]); w.w = cvtpk(v1[2] * gc[6], v1[3] * gc[7]);
                    *(u32x4*)(MERGED + row * 1024 + col0 + bj * 128) = w; } }
    }
};
struct EpiScores {
    static constexpr bool PERM = true, HOOK = false;
    bf16_t* SC;
    DI void hook(f32x4 (&)[2][2][4][2], const g8::Unit&, int, int, int, int, int) const {}
    DI void operator()(const f32x4 (&acc)[2][2][4][2], const g8::Unit& u, int wr, int wc, int fr, int fq) const {
        const int rowl = wr * 64 + fr, d0 = wc * 32 + 8 * fq;
#pragma unroll
        for (int ai = 0; ai < 2; ++ai)
#pragma unroll
            for (int m = 0; m < 4; ++m) { const int row = u.pm * 256 + rowl + ai * 128 + m * 16;
#pragma unroll
                for (int bj = 0; bj < 2; ++bj) { const f32x4 v0 = acc[ai][bj][m][0], v1 = acc[ai][bj][m][1];
                    u32x4 w; w.x = cvtpk(v0[0], v0[1]); w.y = cvtpk(v0[2], v0[3]); w.z = cvtpk(v1[0], v1[1]); w.w = cvtpk(v1[2], v1[3]);
                    *(u32x4*)(SC + ((size_t)((row >> 5) * 16 + u.pn * 2 + bj)) * 4096 + frag_row_off(d0, row & 31)) = w; } }
    }
};
struct EpiPlainB16 {
    static constexpr bool PERM = true, HOOK = false;
    bf16_t* C; int ldc, pad;
    DI void hook(f32x4 (&)[2][2][4][2], const g8::Unit&, int, int, int, int, int) const {}
    DI void operator()(const f32x4 (&acc)[2][2][4][2], const g8::Unit& u, int wr, int wc, int fr, int fq) const {
        const int row0 = u.pm * 256 + wr * 64 + fr, col0 = u.pn * 256 + wc * 32 + 8 * fq;
#pragma unroll
        for (int ai = 0; ai < 2; ++ai)
#pragma unroll
            for (int m = 0; m < 4; ++m) { bf16_t* rowp = C + (size_t)(row0 + ai * 128 + m * 16) * ldc + col0;
#pragma unroll
                for (int bj = 0; bj < 2; ++bj) { const f32x4 v0 = acc[ai][bj][m][0], v1 = acc[ai][bj][m][1];
                    u32x4 w; w.x = cvtpk(v0[0], v0[1]); w.y = cvtpk(v0[2], v0[3]); w.z = cvtpk(v1[0], v1[1]); w.w = cvtpk(v1[2], v1[3]);
                    *(u32x4*)(rowp + bj * 128) = w; } }
    }
};
DI void lse_merge_items(const bf16_t* __restrict__ OG, const float* __restrict__ LSE, bf16_t* __restrict__ BR, int first, int stride) {
    for (int it = first; it < MP * 64; it += stride) {
        const int row = it >> 6, c8 = it & 63, h = c8 >> 4;
        const float l0 = LSE[(size_t)row * 12 + h], l1 = LSE[(size_t)row * 12 + 4 + h], l2 = LSE[(size_t)row * 12 + 8 + h];
        const float mx = fmaxf(l0, fmaxf(l1, l2)); const float e0 = __expf(l0 - mx), e1 = __expf(l1 - mx), e2 = __expf(l2 - mx); const float inv = 1.f / (e0 + e1 + e2);
        const bf16_t* og = OG + (size_t)row * 1536 + c8 * 8;
        float a[8], b[8], c[8]; unpack8(*(const u32x4*)og, a); unpack8(*(const u32x4*)(og + 512), b); unpack8(*(const u32x4*)(og + 1024), c);
        float r[8];
#pragma unroll
        for (int e = 0; e < 8; ++e) r[e] = (e0 * a[e] + e1 * b[e] + e2 * c[e]) * inv;
        u32x4 w; w.x = cvtpk(r[0], r[1]); w.y = cvtpk(r[2], r[3]); w.z = cvtpk(r[4], r[5]); w.w = cvtpk(r[6], r[7]);
        *(u32x4*)(BR + (size_t)row * 1536 + c8 * 8) = w;
    }
}
template <int NR>
DI void ln1_rows(const bf16_t* __restrict__ x, const bf16_t* __restrict__ mix, const float* __restrict__ g, const float* __restrict__ b, bf16_t* __restrict__ h1b, unsigned char* __restrict__ h1q, float* __restrict__ hsc, int wave0, int nwaves, int lane) {
    for (int row0 = wave0 * NR; row0 < MP; row0 += nwaves * NR) {
        u32x4 xa[NR], xb[NR], ma[NR], mb[NR];
#pragma unroll
        for (int r = 0; r < NR; ++r) { const size_t o = (size_t)(row0 + r) * D + 16 * lane;
            xa[r] = *(const u32x4*)(x + o); xb[r] = *(const u32x4*)(x + o + 8); ma[r] = *(const u32x4*)(mix + o); mb[r] = *(const u32x4*)(mix + o + 8); }
#pragma unroll
        for (int r = 0; r < NR; ++r) {
            const int row = row0 + r;
            float xf[16], mf[16]; unpack8(xa[r], *(float(*)[8])&xf[0]); unpack8(xb[r], *(float(*)[8])&xf[8]); unpack8(ma[r], *(float(*)[8])&mf[0]); unpack8(mb[r], *(float(*)[8])&mf[8]);
            f32x4 v[4]; float s = 0.f;
#pragma unroll
            for (int j = 0; j < 4; ++j) {
#pragma unroll
                for (int e = 0; e < 4; ++e) { v[j][e] = xf[4 * j + e] * ALPHA + mf[4 * j + e]; s += v[j][e]; } }
            const float mean = wave_sum(s) * (1.f / D); float q = 0.f;
#pragma unroll
            for (int j = 0; j < 4; ++j) { v[j] = v[j] - mean; q += (v[j][0] * v[j][0] + v[j][1] * v[j][1]) + (v[j][2] * v[j][2] + v[j][3] * v[j][3]); }
            const float rstd = rsqrtf(wave_sum(q) * (1.f / D) + LN_EPS);
            u32x4 o0, o1; float amax = 0.f;
#pragma unroll
            for (int j = 0; j < 4; ++j) { const f32x4 gg = *(const f32x4*)(g + 16 * lane + 4 * j), bb = *(const f32x4*)(b + 16 * lane + 4 * j); const f32x4 o = v[j] * rstd * gg + bb; v[j] = o;
                amax = fmaxf(amax, fmaxf(fmaxf(fabsf(o[0]), fabsf(o[1])), fmaxf(fabsf(o[2]), fabsf(o[3]))));
                if (j < 2) { o0[2 * j] = cvtpk(o[0], o[1]); o0[2 * j + 1] = cvtpk(o[2], o[3]); } else { o1[2 * (j - 2)] = cvtpk(o[0], o[1]); o1[2 * (j - 2) + 1] = cvtpk(o[2], o[3]); } }
            *(u32x4*)(h1b + (size_t)row * D + 16 * lane) = o0; *(u32x4*)(h1b + (size_t)row * D + 16 * lane + 8) = o1;
            amax = wave_max(amax); const float qs = amax > 0.f ? 127.f / amax : 1.f;
            u32x4 qv;
#pragma unroll
            for (int j = 0; j < 4; ++j) qv[j] = ((unsigned)__float2int_rn(v[j][0] * qs) & 0xffu) | (((unsigned)__float2int_rn(v[j][1] * qs) & 0xffu) << 8) | (((unsigned)__float2int_rn(v[j][2] * qs) & 0xffu) << 16) | (((unsigned)__float2int_rn(v[j][3] * qs) & 0xffu) << 24);
            *(u32x4*)(h1q + (size_t)row * D + 16 * lane) = qv;
            if (lane == 0) hsc[row] = amax > 0.f ? amax * (1.f / 127.f) : 1.f;
        }
    }
}

DI unsigned mono(float f) { const unsigned u = __float_as_uint(f); return (u & 0x80000000u) ? ~u : (u | 0x80000000u); }
DI float demono(unsigned m) { return __uint_as_float((m & 0x80000000u) ? (m & 0x7fffffffu) : ~m); }
#define CE_DESC(a, b) do { const unsigned _hi = (a) > (b) ? (a) : (b), _lo = (a) > (b) ? (b) : (a); (a) = _hi; (b) = _lo; } while (0)
DI void sort16_desc(unsigned (&k)[16]) {
#pragma unroll
    for (int size = 2; size <= 16; size <<= 1)
#pragma unroll
        for (int stride = size >> 1; stride > 0; stride >>= 1)
#pragma unroll
            for (int i = 0; i < 16; ++i) { const int j = i ^ stride;
                if (j > i) { if ((i & size) == 0 || size == 16) CE_DESC(k[i], k[j]); else CE_DESC(k[j], k[i]); } }
}
DI void merge_top16(unsigned (&t)[16], const unsigned (&l)[16]) {
#pragma unroll
    for (int i = 0; i < 16; ++i) t[i] = t[i] > l[15 - i] ? t[i] : l[15 - i];
#pragma unroll
    for (int stride = 8; stride > 0; stride >>= 1)
#pragma unroll
        for (int i = 0; i < 16; ++i) { const int j = i ^ stride; if (j > i) CE_DESC(t[i], t[j]); }
}
DI void route_wave(const bf16_t* __restrict__ SC, int* __restrict__ IDX, float* __restrict__ PG, int tb, int h, int lane) {
    const int r32 = lane & 31, hi = lane >> 5;
    const size_t tok = (size_t)tb * 32 + r32;
    unsigned Tp[2][16];
#pragma unroll
    for (int p = 0; p < 2; ++p) {
        const bf16_t* sp = SC + ((size_t)(tb * 16 + h * 2 + p)) * 4096 + lane * 8;
        u32x4 sv[8];
#pragma unroll
        for (int ks = 0; ks < 8; ++ks) sv[ks] = *(const u32x4*)(sp + ks * 512);
#pragma unroll
        for (int nt = 0; nt < 4; ++nt) {
            unsigned L[16];
#pragma unroll
            for (int e = 0; e < 16; ++e) { const int ks = 2 * nt + (e >> 3), j = e & 7; const unsigned w = sv[ks][j >> 1];
                const float sc = __uint_as_float((j & 1) ? (w & 0xffff0000u) : (w << 16));
                L[e] = (mono(sc) & ~0x7fu) | (unsigned)(127 - (16 * ks + 8 * hi + j)); }
            sort16_desc(L);
            if (nt == 0) {
#pragma unroll
                for (int i = 0; i < 16; ++i) Tp[p][i] = L[i];
            } else merge_top16(Tp[p], L);
            __builtin_amdgcn_sched_barrier(0);
        }
    }
    unsigned T[16];
    { unsigned O[16];
#pragma unroll
      for (int i = 0; i < 16; ++i) { const auto rr = __builtin_amdgcn_permlane32_swap(Tp[0][i], Tp[1][i], false, false); T[i] = rr[0]; O[i] = rr[1]; }
      merge_top16(T, O); }
    __builtin_amdgcn_sched_barrier(0);
    float s1[16], s2[16]; unsigned i1[16], i2[16];
#pragma unroll
    for (int i = 0; i < 16; ++i) { const auto rr = __builtin_amdgcn_permlane32_swap(T[i], T[i], false, false);
        s1[i] = demono(rr[0] & ~0x7fu); i1[i] = 127u - (rr[0] & 0x7fu); s2[i] = demono(rr[1] & ~0x7fu); i2[i] = 127u - (rr[1] & 0x7fu); }
    unsigned C[64];
    { int n = 0;
#pragma unroll
      for (int a = 0; a < 16; ++a)
#pragma unroll
          for (int b = 0; b < 16; ++b) if ((a + 1) * (b + 1) <= 16) { C[n] = (mono(s1[a] + s2[b]) & ~0x3fffu) | (i1[a] << 7) | i2[b]; ++n; }
#pragma unroll
      for (int i = 50; i < 64; ++i) C[i] = 0u; }
    unsigned F[16];
#pragma unroll
    for (int i = 0; i < 16; ++i) F[i] = C[i];
    sort16_desc(F);
#pragma unroll
    for (int g = 1; g < 4; ++g) { unsigned L[16];
#pragma unroll
        for (int i = 0; i < 16; ++i) L[i] = C[16 * g + i];
        sort16_desc(L); merge_top16(F, L); __builtin_amdgcn_sched_barrier(0); }
    if (hi == 0) {
        float e[16]; float sum = 0.f; const float v0 = demono(F[0] & ~0x3fffu);
#pragma unroll
        for (int i = 0; i < 16; ++i) { e[i] = __expf(demono(F[i] & ~0x3fffu) - v0); sum += e[i]; }
        const float inv = 1.f / sum;
        int* ip = IDX + tok * 128 + h * 16; float* gp = PG + tok * 128 + h * 16;
#pragma unroll
        for (int q = 0; q < 4; ++q) { u32x4 iv; iv.x = F[4 * q] & 0x3fffu; iv.y = F[4 * q + 1] & 0x3fffu; iv.z = F[4 * q + 2] & 0x3fffu; iv.w = F[4 * q + 3] & 0x3fffu; *(u32x4*)(ip + 4 * q) = iv;
            f32x4 gv; gv[0] = e[4 * q] * inv; gv[1] = e[4 * q + 1] * inv; gv[2] = e[4 * q + 2] * inv; gv[3] = e[4 * q + 3] * inv; *(f32x4*)(gp + 4 * q) = gv; }
    }
}
typedef __bf16 bf16x2v __attribute__((ext_vector_type(2)));
DI float dot2bf(unsigned w, unsigned x, float acc) { return __builtin_amdgcn_fdot2_f32_bf16(__builtin_bit_cast(bf16x2v, w), __builtin_bit_cast(bf16x2v, x), acc, false); }
DI float gelu_erf(float v) {
    const float av = fabsf(v), t = __builtin_amdgcn_rcpf(av * 0.2316418882f + 1.0f);
    float q = t * 0.5307027145f + (-0.7265760135f); q = q * t + 0.7107068705f; q = q * t + (-0.142248368f); q = q * t + 0.127414796f; q = q * t;
    const float e = __builtin_amdgcn_exp2f((v * v) * (-0.72134752044f)); const float m = v * (q * e);
    return v < 0.f ? m : v - m;
}
DI float dppf(float v, const int ctrl_sel) {
    const int s = __float_as_int(v);
    int r;
    if (ctrl_sel == 0) r = __builtin_amdgcn_update_dpp(0, s, 0xB1, 0xF, 0xF, true);
    else if (ctrl_sel == 1) r = __builtin_amdgcn_update_dpp(0, s, 0x4E, 0xF, 0xF, true);
    else if (ctrl_sel == 2) r = __builtin_amdgcn_update_dpp(0, s, 0x141, 0xF, 0xF, true);
    else r = __builtin_amdgcn_update_dpp(0, s, 0x128, 0xF, 0xF, true);
    return __int_as_float(r);
}
DI int dppi(int s, const int ctrl_sel) {
    if (ctrl_sel == 0) return __builtin_amdgcn_update_dpp(0, s, 0xB1, 0xF, 0xF, true);
    if (ctrl_sel == 1) return __builtin_amdgcn_update_dpp(0, s, 0x4E, 0xF, 0xF, true);
    return __builtin_amdgcn_update_dpp(0, s, 0x141, 0xF, 0xF, true);
}
template <int NT>
DI void experts_u_slice(const unsigned char* __restrict__ H1Q, const unsigned char* __restrict__ U8x, const int* __restrict__ IDX, bf16_t* __restrict__ PD, size_t tok0, int ntok, int x, int lane) {
    const int g = lane >> 3, l8 = lane & 7;
    u32x4 hq[NT], iv[NT][4];
#pragma unroll
    for (int t = 0; t < NT; ++t) { hq[t] = *(const u32x4*)(H1Q + (tok0 + t) * D + 128 * x + 16 * l8);
#pragma unroll
        for (int q = 0; q < 4; ++q) iv[t][q] = *(const u32x4*)(IDX + (tok0 + t) * 128 + 16 * g + 4 * q); }
#pragma unroll 1
    for (int i = 0; i < ntok; i += NT) {
        const size_t tok = tok0 + i;
        u32x4 w[NT][16], hc[NT];
#pragma unroll
        for (int t = 0; t < NT; ++t) { hc[t] = hq[t];
#pragma unroll
            for (int j = 0; j < 16; ++j) w[t][j] = *(const u32x4*)(U8x + (size_t)(iv[t][j >> 2][j & 3] * 128u + 16u * l8)); }
        if (i + NT < ntok) {
#pragma unroll
            for (int t = 0; t < NT; ++t) { hq[t] = *(const u32x4*)(H1Q + (tok + NT + t) * D + 128 * x + 16 * l8);
#pragma unroll
                for (int q = 0; q < 4; ++q) iv[t][q] = *(const u32x4*)(IDX + (tok + NT + t) * 128 + 16 * g + 4 * q); }
        }
#pragma unroll
        for (int t = 0; t < NT; ++t) {
            float p[16];
#pragma unroll
            for (int j = 0; j < 16; ++j) { int d = 0;
#pragma unroll
                for (int q = 0; q < 4; ++q) d = __builtin_amdgcn_sdot4((int)w[t][j][q], (int)hc[t][q], d, false);
                d += dppi(d, 0); d += dppi(d, 1); d += dppi(d, 2); p[j] = (float)d; }
            if (l8 == 0) {
                u32x4 o0, o1;
                o0.x = cvtpk(p[0], p[1]); o0.y = cvtpk(p[2], p[3]); o0.z = cvtpk(p[4], p[5]); o0.w = cvtpk(p[6], p[7]);
                o1.x = cvtpk(p[8], p[9]); o1.y = cvtpk(p[10], p[11]); o1.z = cvtpk(p[12], p[13]); o1.w = cvtpk(p[14], p[15]);
                bf16_t* dp = PD + ((tok + t) * 8 + x) * 128 + 16 * g; *(u32x4*)dp = o0; *(u32x4*)(dp + 8) = o1;
            }
        }
    }
}
DI void experts_combine(const bf16_t* __restrict__ PD, const int* __restrict__ IDX, const float* __restrict__ PG, const float* __restrict__ USC, const float* __restrict__ VSC, const float* __restrict__ HSC,
                        unsigned char* __restrict__ C8, float* __restrict__ CSC, int wave0, int nwaves, int lane) {
    for (int tokb = wave0 * 2; tokb < M; tokb += nwaves * 2) {
        unsigned pw[2][8]; u32x2 rows[2]; f32x2 gt[2]; float hs[2];
#pragma unroll
        for (int r = 0; r < 2; ++r) { const size_t tok = (size_t)tokb + r;
#pragma unroll
            for (int x = 0; x < 8; ++x) pw[r][x] = *(const unsigned*)(PD + (tok * 8 + x) * 128 + 2 * lane);
            rows[r] = *(const u32x2*)(IDX + tok * 128 + 2 * lane); gt[r] = *(const f32x2*)(PG + tok * 128 + 2 * lane); hs[r] = HSC[tok]; }
#pragma unroll
        for (int r = 0; r < 2; ++r) { const size_t tok = (size_t)tokb + r;
            float s0 = 0.f, s1 = 0.f;
#pragma unroll
            for (int x = 0; x < 8; ++x) { s0 += __uint_as_float(pw[r][x] << 16); s1 += __uint_as_float(pw[r][x] & 0xffff0000u); }
            const float c0 = gt[r][0] * gelu_erf(s0 * USC[rows[r].x] * hs[r]) * VSC[rows[r].x], c1 = gt[r][1] * gelu_erf(s1 * USC[rows[r].y] * hs[r]) * VSC[rows[r].y];
            const float amax = wave_max(fmaxf(fabsf(c0), fabsf(c1)));
            const float qs = amax > 0.f ? 127.f / amax : 1.f;
            const unsigned short q2 = (unsigned short)(((unsigned)__float2int_rn(c0 * qs) & 0xffu) | (((unsigned)__float2int_rn(c1 * qs) & 0xffu) << 8));
            *(unsigned short*)(C8 + tok * 128 + 2 * lane) = q2;
            if (lane == 0) CSC[tok] = amax > 0.f ? amax * (1.f / 127.f) : 1.f;
        }
    }
}
template <int NT>
DI void experts_v_slice(const unsigned char* __restrict__ V8x, const int* __restrict__ IDX, const unsigned char* __restrict__ C8, const float* __restrict__ CSC, bf16_t* __restrict__ FFN, size_t tok0, int ntok, int x, int lane) {
    const int g = lane >> 3, l8 = lane & 7;
    u32x4 iv[NT][4], cqn[NT]; float csn[NT];
#pragma unroll
    for (int t = 0; t < NT; ++t) { cqn[t] = *(const u32x4*)(C8 + (tok0 + t) * 128 + 16 * g); csn[t] = CSC[tok0 + t];
#pragma unroll
        for (int q = 0; q < 4; ++q) iv[t][q] = *(const u32x4*)(IDX + (tok0 + t) * 128 + 16 * g + 4 * q); }
#pragma unroll 1
    for (int i = 0; i < ntok; i += NT) {
        const size_t tok = tok0 + i;
        u32x4 w[NT][16], cq[NT]; float csc[NT];
#pragma unroll
        for (int t = 0; t < NT; ++t) { cq[t] = cqn[t]; csc[t] = csn[t];
#pragma unroll
            for (int j = 0; j < 16; ++j) w[t][j] = *(const u32x4*)(V8x + (size_t)(iv[t][j >> 2][j & 3] * 128u + 16u * l8)); }
        if (i + NT < ntok) {
#pragma unroll
            for (int t = 0; t < NT; ++t) { cqn[t] = *(const u32x4*)(C8 + (tok + NT + t) * 128 + 16 * g); csn[t] = CSC[tok + NT + t];
#pragma unroll
                for (int q = 0; q < 4; ++q) iv[t][q] = *(const u32x4*)(IDX + (tok + NT + t) * 128 + 16 * g + 4 * q); }
        }
#pragma unroll
        for (int t = 0; t < NT; ++t) {
            int acc[16];
#pragma unroll
            for (int k = 0; k < 16; ++k) acc[k] = 0;
#pragma unroll
            for (int jj = 0; jj < 4; ++jj) {
                const int cdw = (int)cq[t][jj];
#pragma unroll
                for (int q = 0; q < 4; ++q) {
                    const unsigned r0 = w[t][4 * jj][q], r1 = w[t][4 * jj + 1][q], r2 = w[t][4 * jj + 2][q], r3 = w[t][4 * jj + 3][q];
                    const unsigned lo01 = __builtin_amdgcn_perm(r1, r0, 0x05010400u), hi01 = __builtin_amdgcn_perm(r1, r0, 0x07030602u);
                    const unsigned lo23 = __builtin_amdgcn_perm(r3, r2, 0x05010400u), hi23 = __builtin_amdgcn_perm(r3, r2, 0x07030602u);
                    acc[4 * q + 0] = __builtin_amdgcn_sdot4((int)__builtin_amdgcn_perm(lo23, lo01, 0x05040100u), cdw, acc[4 * q + 0], false);
                    acc[4 * q + 1] = __builtin_amdgcn_sdot4((int)__builtin_amdgcn_perm(lo23, lo01, 0x07060302u), cdw, acc[4 * q + 1], false);
                    acc[4 * q + 2] = __builtin_amdgcn_sdot4((int)__builtin_amdgcn_perm(hi23, hi01, 0x05040100u), cdw, acc[4 * q + 2], false);
                    acc[4 * q + 3] = __builtin_amdgcn_sdot4((int)__builtin_amdgcn_perm(hi23, hi01, 0x07060302u), cdw, acc[4 * q + 3], false);
                }
            }
            const float cs = csc[t];
#pragma unroll
            for (int k = 0; k < 8; ++k) { const auto rr = __builtin_amdgcn_permlane32_swap((unsigned)acc[k], (unsigned)acc[k + 8], false, false); acc[k] = (int)rr[0] + (int)rr[1]; }
#pragma unroll
            for (int k = 0; k < 4; ++k) { const auto rr = __builtin_amdgcn_permlane16_swap((unsigned)acc[k], (unsigned)acc[k + 4], false, false); acc[k] = (int)rr[0] + (int)rr[1]; }
            { const bool up = (lane & 8) != 0;
#pragma unroll
              for (int k = 0; k < 2; ++k) { const int send = up ? acc[k] : acc[k + 2], keep = up ? acc[k + 2] : acc[k]; acc[k] = keep + __builtin_amdgcn_update_dpp(0, send, 0x128, 0xF, 0xF, true); } }
            *(unsigned*)(FFN + (tok + t) * D + 128 * x + 16 * l8 + 2 * g) = cvtpk((float)acc[0] * cs, (float)acc[1] * cs);
        }
    }
}
template <int NR>
DI void ln2_tokens(const bf16_t* __restrict__ FFN, const bf16_t* __restrict__ H1B, const float* __restrict__ g2, const float* __restrict__ b2, float* __restrict__ outp, size_t tok0, int lane) {
    u32x4 fa[NR], fb[NR], ha[NR], hb[NR];
#pragma unroll
    for (int r = 0; r < NR; ++r) { const size_t o = (tok0 + r) * D + 16 * lane;
        fa[r] = *(const u32x4*)(FFN + o); fb[r] = *(const u32x4*)(FFN + o + 8); ha[r] = *(const u32x4*)(H1B + o); hb[r] = *(const u32x4*)(H1B + o + 8); }
#pragma unroll
    for (int r = 0; r < NR; ++r) {
        float* hr = outp + (tok0 + r) * D + 16 * lane;
        float ff[16], hh[16]; unpack8(fa[r], *(float(*)[8])&ff[0]); unpack8(fb[r], *(float(*)[8])&ff[8]); unpack8(ha[r], *(float(*)[8])&hh[0]); unpack8(hb[r], *(float(*)[8])&hh[8]);
        f32x4 v[4]; float s = 0.f;
#pragma unroll
        for (int j = 0; j < 4; ++j)
#pragma unroll
            for (int e = 0; e < 4; ++e) { v[j][e] = hh[4 * j + e] * ALPHA + ff[4 * j + e]; s += v[j][e]; }
        const float mean = wave_sum(s) * (1.f / D); float q2 = 0.f;
#pragma unroll
        for (int j = 0; j < 4; ++j)
#pragma unroll
            for (int e = 0; e < 4; ++e) { v[j][e] -= mean; q2 += v[j][e] * v[j][e]; }
        const float rstd = rsqrtf(wave_sum(q2) * (1.f / D) + LN_EPS);
#pragma unroll
        for (int j = 0; j < 4; ++j) { const f32x4 gg = *(const f32x4*)(g2 + 16 * lane + 4 * j), bb = *(const f32x4*)(b2 + 16 * lane + 4 * j); *(f32x4*)(hr + 4 * j) = v[j] * rstd * gg + bb; }
    }
}

DI void p0_convert(const float* __restrict__ in, bf16_t* __restrict__ out, size_t n8, size_t first, size_t stride) {
    for (size_t i = first; i < n8; i += stride) { const f32x4 a = ((const f32x4*)in)[2 * i], b = ((const f32x4*)in)[2 * i + 1];
        u32x4 w; w.x = cvtpk(a[0], a[1]); w.y = cvtpk(a[2], a[3]); w.z = cvtpk(b[0], b[1]); w.w = cvtpk(b[2], b[3]); ((u32x4*)out)[i] = w; }
}
DI void p0_transpose_item(const float* __restrict__ W, int ldw, int ncols, bf16_t* __restrict__ out, int ldo, int koff, LAS float* scr, int item, int lane) {
    const int nblk = ncols / 32, kb = item / nblk, nb = item % nblk, k0 = 64 * kb, n0 = 32 * nb;
#pragma unroll 8
    for (int i = 0; i < 32; ++i) { const int kk = 2 * i + (lane >> 5); scr[kk * 33 + (lane & 31)] = W[(size_t)(k0 + kk) * ldw + n0 + (lane & 31)]; }
    asm volatile("s_waitcnt lgkmcnt(0)" ::: "memory");
    const int c = lane & 7;
#pragma unroll
    for (int j = 0; j < 4; ++j) { const int n = (lane >> 3) + 8 * j; const LAS float* s = scr + (8 * c) * 33 + n;
        u32x4 o; o.x = cvtpk(s[0 * 33], s[1 * 33]); o.y = cvtpk(s[2 * 33], s[3 * 33]); o.z = cvtpk(s[4 * 33], s[5 * 33]); o.w = cvtpk(s[6 * 33], s[7 * 33]);
        *(u32x4*)(out + (size_t)(n0 + n) * ldo + koff + k0 + 8 * c) = o; }
    asm volatile("s_waitcnt lgkmcnt(0)" ::: "memory");
}
template <bool I8>
DI void p0_fp8_row(const float* __restrict__ src, unsigned char* __restrict__ dst, float* __restrict__ scale, int row, int lane) {
    const f32x4* sp = (const f32x4*)(src + (size_t)row * D) + 4 * lane;
    f32x4 v[4]; float mx = 0.f;
#pragma unroll
    for (int j = 0; j < 4; ++j) { v[j] = sp[j]; mx = fmaxf(mx, fmaxf(fmaxf(fabsf(v[j][0]), fabsf(v[j][1])), fmaxf(fabsf(v[j][2]), fabsf(v[j][3])))); }
    mx = wave_max(mx);
    const float top = I8 ? 127.f : 224.f;
    const float sc = mx > 0.f ? top / mx : 1.f;
    u32x4 w;
#pragma unroll
    for (int j = 0; j < 4; ++j) {
        if (I8) { w[j] = ((unsigned)__float2int_rn(v[j][0] * sc) & 0xffu) | (((unsigned)__float2int_rn(v[j][1] * sc) & 0xffu) << 8) | (((unsigned)__float2int_rn(v[j][2] * sc) & 0xffu) << 16) | (((unsigned)__float2int_rn(v[j][3] * sc) & 0xffu) << 24); }
        else { int p = 0; p = __builtin_amdgcn_cvt_pk_fp8_f32(v[j][0] * sc, v[j][1] * sc, p, false); p = __builtin_amdgcn_cvt_pk_fp8_f32(v[j][2] * sc, v[j][3] * sc, p, true); w[j] = (unsigned)p; } }
    *(u32x4*)(dst + (size_t)(lane >> 3) * ((size_t)NEXP * 128) + (size_t)row * 128 + 16 * (lane & 7)) = w;
    if (lane == 0) scale[row] = mx > 0.f ? mx / top : 1.f;
}
DI void p0_fold_tile(const float* __restrict__ wq, const float* __restrict__ keys, bf16_t* __restrict__ out, LAS float* sm, int tile, int tid) {
    const int hp = tile >> 4, d0 = (tile & 15) * 64;
    LAS float* skT = sm; LAS float* swT = sm + 128 * 132;
    { const int r = tid & 127;
      for (int c4 = (tid >> 7) * 4; c4 < 128; c4 += 16) { const f32x4 v = *(const f32x4*)(keys + (size_t)(hp * 128 + r) * 128 + c4);
          skT[(c4 + 0) * 132 + r] = v[0]; skT[(c4 + 1) * 132 + r] = v[1]; skT[(c4 + 2) * 132 + r] = v[2]; skT[(c4 + 3) * 132 + r] = v[3]; } }
    { const int r = tid & 63;
      for (int c4 = (tid >> 6) * 4; c4 < 128; c4 += 32) { const f32x4 v = *(const f32x4*)(wq + (size_t)(d0 + r) * 2048 + hp * 128 + c4);
          swT[(c4 + 0) * 68 + r] = v[0]; swT[(c4 + 1) * 68 + r] = v[1]; swT[(c4 + 2) * 68 + r] = v[2]; swT[(c4 + 3) * 68 + r] = v[3]; } }
    __syncthreads();
    const int nb = tid & 31, db = tid >> 5;
    f32x4 acc[4];
#pragma unroll
    for (int i = 0; i < 4; ++i) acc[i] = (f32x4){0.f, 0.f, 0.f, 0.f};
#pragma unroll 4
    for (int k = 0; k < 128; ++k) { const f32x4 a = *(const LAS f32x4*)(skT + k * 132 + 4 * nb), b = *(const LAS f32x4*)(swT + k * 68 + 4 * db);
#pragma unroll
        for (int i = 0; i < 4; ++i) acc[i] += b * a[i]; }
#pragma unroll
    for (int i = 0; i < 4; ++i) { u32x2 o; o.x = cvtpk(acc[i][0], acc[i][1]); o.y = cvtpk(acc[i][2], acc[i][3]); *(u32x2*)(out + (size_t)(hp * 128 + 4 * nb + i) * D + d0 + 4 * db) = o; }
    __syncthreads();
}
DI void p0_misc(const float* __restrict__ hgrn_lb, const float* __restrict__ rel_bias, float* __restrict__ misc, int i) {
    if (i < 512) { const float a = hgrn_lb[i], b = hgrn_lb[512 + i]; const float mx = fmaxf(a, b); const float ea = expf(a - mx), eb = expf(b - mx); misc[i] = ea / (ea + eb); }
    if (i < 3 * 129) {
        const int g = i / 129, j = i % 129; const int dl = g == 0 ? 1 : (g == 1 ? 4 : 16); const int n = j * dl;
        int bucket;
        if (n < 16) bucket = n;
        else { const double v = log((double)n / 16.0) / log(128.0) * 16.0; int l = 16 + (int)v; bucket = l < 31 ? l : 31; }
        for (int h = 0; h < 4; ++h) misc[512 + i * 4 + h] = rel_bias[bucket * 12 + g * 4 + h];
    }
}
struct SchedMemKV {
    unsigned MEMB, W; int G, c;
    DI bool next(int i, g8::Unit& u) const {
        const int L = i * G + c; if (L >= 32) return false;
        u.dla = 1; u.dlb = 1;
        if (L < 16) { u.kind = 0; u.pm = L >> 1; u.pn = L & 1; u.a = MEMB + (unsigned)u.pm * 256u * D * 2u; u.b = W + (unsigned)u.pn * 256u * D * 2u; }
        else { const int q = L - 16; u.kind = 1; u.pm = q >> 3; u.pn = q & 7; u.a = W + (unsigned)(512 + u.pm * 256) * D * 2u; u.b = MEMB + (unsigned)u.pn * 256u * D * 2u; }
        return true;
    }
};
struct EpiMemKVF {
    static constexpr bool PERM = true, HOOK = false;
    bf16_t *MK, *MVT;
    DI void hook(f32x4 (&)[2][2][4][2], const g8::Unit&, int, int, int, int, int) const {}
    DI void operator()(const f32x4 (&acc)[2][2][4][2], const g8::Unit& u, int wr, int wc, int fr, int fq) const {
        const int rowl = wr * 64 + fr, d0 = wc * 32 + 8 * fq;
#pragma unroll
        for (int ai = 0; ai < 2; ++ai)
#pragma unroll
            for (int m = 0; m < 4; ++m) { const int R = u.pm * 256 + rowl + ai * 128 + m * 16;
#pragma unroll
                for (int bj = 0; bj < 2; ++bj) { const f32x4 v0 = acc[ai][bj][m][0], v1 = acc[ai][bj][m][1];
                    if (u.kind == 0) { const int b = R >> 8, mm = R & 255, h = u.pn * 2 + bj;
                        u32x4 w; w.x = cvtpk(v0[0], v0[1]); w.y = cvtpk(v0[2], v0[3]); w.z = cvtpk(v1[0], v1[1]); w.w = cvtpk(v1[2], v1[3]);
                        *(u32x4*)(MK + ((size_t)((b * 4 + h) * 8 + (mm >> 5))) * 4096 + frag_row_off(d0, mm & 31)) = w; }
                    else { const int h = R >> 7, d = R & 127, c = u.pn * 256 + bj * 128 + d0, b = c >> 8, mm = c & 255, kk = mm & 31;
                        bf16_t* blk = MVT + ((size_t)((b * 4 + h) * 8 + (mm >> 5))) * 4096 + (((d >> 5) * 2 + (kk >> 4)) * 64 + (d & 31)) * 8 + 4 * ((kk >> 3) & 1);
                        u32x2 wa, wb; wa.x = cvtpk(v0[0], v0[1]); wa.y = cvtpk(v0[2], v0[3]); wb.x = cvtpk(v1[0], v1[1]); wb.y = cvtpk(v1[2], v1[3]);
                        *(u32x2*)blk = wa; *(u32x2*)(blk + 32 * 8) = wb; } } }
    }
};

static_assert(HG_UNIT_BYTES <= LDSCTL_OFF, "hgrn LDS");
DI const float* karg_in(int i) { const float* const* kp = (const float* const*)__builtin_amdgcn_kernarg_segment_ptr(); asm volatile("" : "+s"(kp)); return kp[i]; }
DI float* karg_out() { float* const* kp = (float* const*)__builtin_amdgcn_kernarg_segment_ptr(); asm volatile("" : "+s"(kp)); return kp[18]; }
__global__ void __launch_bounds__(NTHR, 2) mega(Args args) {
    extern __shared__ __attribute__((aligned(16))) unsigned char lds_raw[];
    LAS unsigned char* lds = (LAS unsigned char*)lds_raw;
    volatile LAS unsigned* MISC = (volatile LAS unsigned*)(lds + MISC_OFF);
    for (int u = threadIdx.x; u < (LDS_BYTES - LDSCTL_OFF) / 4; u += NTHR) ((LAS unsigned*)(lds + LDSCTL_OFF))[u] = 0u;
    __syncthreads();
    unsigned char* ws = args.ws;
    const int G = gridDim.x;
    const bool ALL = args.ph == PH_ALL;
    XcdBarrier bar; bar.bar = (unsigned*)(ws + O_MISC + 16384); bar.x = 0; bar.st = nullptr;
    if (ALL) bar = xcd_barrier_post((unsigned*)(ws + O_MISC + 16384), MISC + 8);
#ifndef REP_MASK
#define REP_MASK 0
#endif
#define RUN(k) (ALL || args.ph == (k))
#define NREP(k) (((REP_MASK >> (k)) & 1) ? 2 : 1)
#define SEAM() do { if (ALL) xcd_barrier(bar); } while (0)
    for (int rep_ = 0; rep_ < NREP(PH_PRO); ++rep_) if (RUN(PH_PRO)) {
        int tid = threadIdx.x; asm volatile("" : "+v"(tid)); asm volatile("" : "+s"(ws)); int bid = blockIdx.x; asm volatile("" : "+s"(bid));
        const size_t gt = (size_t)bid * NTHR + tid, nth = (size_t)G * NTHR;
        p0_convert(karg_in(0), (bf16_t*)(ws + O_XB), (size_t)M * D / 8, gt, nth);
        p0_convert(karg_in(1), (bf16_t*)(ws + O_MEMB), (size_t)2048 * 1024 / 8, gt, nth);
        if (bid == 0) p0_misc(karg_in(6), karg_in(5), (float*)(ws + O_MISC), tid);
        const int wid = __builtin_amdgcn_readfirstlane(tid >> 6), lane = tid & 63;
        LAS float* scr = (LAS float*)(lds + wid * 16384);
        const int gw = bid * NWAVES + wid, ngw = G * NWAVES;
        for (int r = gw; r < 2 * NEXP; r += ngw) {
            if (r < NEXP) p0_fp8_row<true>(karg_in(14), (unsigned char*)(ws + O_UB), (float*)(ws + O_USC), r, lane);
            else p0_fp8_row<true>(karg_in(15), (unsigned char*)(ws + O_VB), (float*)(ws + O_VSC), r - NEXP, lane);
        }
        constexpr int NJ = 12;
        for (int it = gw; ; it += ngw) {
            int r = it; bool done = true;
#pragma unroll
            for (int j = 0; j < NJ; ++j) {
                const int srcc[NJ] = {0, 4608, 5632, 6656, 7168, 3072, 5120, 0, 0, 0, 0, 0};
                const int cnt[NJ] = {3072, 512, 1024, 512, 3072, 1536, 512, 1024, 1024, 1024, 1024, 1024};
                const int drow[NJ] = {0, 3072, 3584, 4608, 5120, 8192, 9728, 0, 0, 0, 0, 0};
                const int Kj = (j >= 8 && j <= 10) ? 512 : 1024;
                const int items = (Kj / 64) * (cnt[j] / 32);
                if (done && r < items) {
                    const float* W; int ldw; bf16_t* o; int ldo, koff = 0;
                    if (j < 7) { W = karg_in(2) + srcc[j]; ldw = INC; o = (bf16_t*)(ws + O_WIN) + (size_t)drow[j] * 1024; ldo = 1024; }
                    else if (j == 7) { W = karg_in(4); ldw = 1024; o = (bf16_t*)(ws + O_WMKV); ldo = 1024; }
                    else if (j <= 10) { W = karg_in(8) + (size_t)(j - 8) * 512 * 1024; ldw = 1024; o = (bf16_t*)(ws + O_WBR); ldo = 1536; koff = (j - 8) * 512; }
                    else { W = karg_in(9); ldw = 1024; o = (bf16_t*)(ws + O_WOUT); ldo = 1024; }
                    p0_transpose_item(W, ldw, cnt[j], o, ldo, koff, scr, r, lane); done = false;
                }
                r -= items;
            }
            if (done) break;
        }
        __syncthreads();
        for (int tile = bid; tile < 256; tile += G) p0_fold_tile(karg_in(12), karg_in(13), (bf16_t*)(ws + O_WPQ), (LAS float*)lds, tile, tid);
        SEAM();
    }
#pragma unroll 1
    for (int p = (ALL ? 0 : args.pass); p < (ALL ? NPASS : args.pass + 1); ++p) {
        int bid = blockIdx.x; asm volatile("" : "+s"(bid));
        int tid = threadIdx.x; asm volatile("" : "+v"(tid));
        asm volatile("" : "+s"(ws));
        char* pr = (char*)ws + O_PASS;
        const size_t t0 = (size_t)p * MP;
        for (int rep_ = 0; rep_ < NREP(PH_PROJ); ++rep_) if (RUN(PH_PROJ)) {
            asm volatile("" : "+s"(bid)); asm volatile("" : "+v"(tid)); asm volatile("" : "+s"(ws)); pr = (char*)ws + O_PASS;
            SchedP1 Sc{(unsigned)(O_XB + t0 * D * 2), (unsigned)O_WIN, G, bid};
            EpiP1 E{pr, karg_in(3)};
            g8::gemm_phase<EpiP1, SchedP1>(lds, (const char*)ws, D, Sc, E, tid);
            if (p == 0) {
                SchedMemKV S2{(unsigned)O_MEMB, (unsigned)O_WMKV, G, bid};
                EpiMemKVF E2{(bf16_t*)(ws + O_MK), (bf16_t*)(ws + O_MVT)};
                g8::gemm_phase<EpiMemKVF, SchedMemKV>(lds, (const char*)ws, D, S2, E2, tid);
            }
            SEAM();
        }
        for (int rep_ = 0; rep_ < NREP(PH_ATTN); ++rep_) if (RUN(PH_ATTN)) {
            asm volatile("" : "+s"(bid)); asm volatile("" : "+v"(tid)); asm volatile("" : "+s"(ws)); pr = (char*)ws + O_PASS;
            const float* bsrc = (const float*)(ws + O_MISC) + 512; LAS float* btab = (LAS float*)lds;
            for (int i = tid; i < 3 * 129 * 4; i += NTHR) btab[i] = bsrc[i] * LOG2E;
            __syncthreads();
            const int wid = __builtin_amdgcn_readfirstlane(tid >> 6), lane = tid & 63;
            for (int task = bid * NWAVES + wid; task < DIL_TASKS; task += G * NWAVES)
                attn_dil_wave((const bf16_t*)(pr + P_QK), (const bf16_t*)(pr + P_VT), btab, (bf16_t*)(pr + P_OG), (float*)(pr + P_LSE), task, lane);
            for (int task = bid * NWAVES + wid; task < MEM_TASKS; task += G * NWAVES)
                attn_mem_wave((const bf16_t*)(pr + P_MQ), (const bf16_t*)(ws + O_MK), (const bf16_t*)(ws + O_MVT), (bf16_t*)(pr + P_BR), task, p * BPP, lane);
            __syncthreads();
        }
        for (int rep_ = 0; rep_ < NREP(PH_HGPRE); ++rep_) if (RUN(PH_HGPRE)) {
            asm volatile("" : "+s"(bid)); asm volatile("" : "+v"(tid)); asm volatile("" : "+s"(ws)); pr = (char*)ws + O_PASS;
            { const int unit = bid; static_assert(HG_UNITS == 256, "one HGRN unit per workgroup"); if (unit < HG_UNITS) {
                hgrn_unit<false>(lds, unit, tid, (const bf16_t*)(pr + P_HFQG), (const bf16_t*)(pr + P_IT), (const float*)(ws + O_MISC), karg_in(7),
                                 (float*)(pr + P_HSTL), (float*)(pr + P_HSTD), (const float*)(pr + P_SIN), (bf16_t*)(pr + P_BR));
            } }
            SEAM();
        }
        for (int rep_ = 0; rep_ < NREP(PH_HGSCAN); ++rep_) if (RUN(PH_HGSCAN)) {
            asm volatile("" : "+s"(bid)); asm volatile("" : "+v"(tid)); asm volatile("" : "+s"(ws)); pr = (char*)ws + O_PASS;
            hgrn_scan((const float*)(pr + P_HSTL), (const float*)(pr + P_HSTD), (float*)(pr + P_SIN), bid * NTHR + tid);
            lse_merge_items((const bf16_t*)(pr + P_OG), (const float*)(pr + P_LSE), (bf16_t*)(pr + P_BR), bid * NTHR + tid, G * NTHR);
            SEAM();
        }
        for (int rep_ = 0; rep_ < NREP(PH_HGMAIN); ++rep_) if (RUN(PH_HGMAIN)) {
            asm volatile("" : "+s"(bid)); asm volatile("" : "+v"(tid)); asm volatile("" : "+s"(ws)); pr = (char*)ws + O_PASS;
            { const int unit = bid; static_assert(HG_UNITS == 256, "one HGRN unit per workgroup"); if (unit < HG_UNITS) {
                hgrn_unit<true>(lds, unit, tid, (const bf16_t*)(pr + P_HFQG), (const bf16_t*)(pr + P_IT), (const float*)(ws + O_MISC), karg_in(7),
                                (float*)(pr + P_HSTL), (float*)(pr + P_HSTD), (const float*)(pr + P_SIN), (bf16_t*)(pr + P_BR));
            } }
            SEAM();
        }
        for (int rep_ = 0; rep_ < NREP(PH_WIDEN); ++rep_) if (RUN(PH_WIDEN)) {
            asm volatile("" : "+s"(bid)); asm volatile("" : "+v"(tid)); asm volatile("" : "+s"(ws)); pr = (char*)ws + O_PASS;
            SchedRows Sc{(unsigned)(O_PASS + P_BR), (unsigned)O_WBR, 1536, 4, 256, G, bid};
            EpiWidenF E{(const bf16_t*)(pr + P_GATE), (bf16_t*)(pr + P_MERGED)};
            g8::gemm_phase<EpiWidenF, SchedRows>(lds, (const char*)ws, 1536, Sc, E, tid);
            SEAM();
        }
        for (int rep_ = 0; rep_ < NREP(PH_WOUT); ++rep_) if (RUN(PH_WOUT)) {
            asm volatile("" : "+s"(bid)); asm volatile("" : "+v"(tid)); asm volatile("" : "+s"(ws)); pr = (char*)ws + O_PASS;
            SchedRows Sc{(unsigned)(O_PASS + P_MERGED), (unsigned)O_WOUT, 1024, 4, 256, G, bid};
            EpiPlainB16 E{(bf16_t*)(pr + P_MIX), 1024, 0};
            g8::gemm_phase<EpiPlainB16, SchedRows>(lds, (const char*)ws, 1024, Sc, E, tid);
            SEAM();
        }
        for (int rep_ = 0; rep_ < NREP(PH_LN1); ++rep_) if (RUN(PH_LN1)) {
            asm volatile("" : "+s"(bid)); asm volatile("" : "+v"(tid)); asm volatile("" : "+s"(ws)); pr = (char*)ws + O_PASS;
            ln1_rows<4>((const bf16_t*)(ws + O_XB) + t0 * D, (const bf16_t*)(pr + P_MIX), karg_in(10), karg_in(11), (bf16_t*)(ws + O_H1B) + t0 * D, (unsigned char*)(ws + O_H1Q) + t0 * D, (float*)(ws + O_HSC) + t0, bid * NWAVES + (tid >> 6), G * NWAVES, tid & 63);
        }
    }
    for (int rep_ = 0; rep_ < NREP(PH_PQ); ++rep_) if (RUN(PH_PQ)) {
        SEAM();
        int tid = threadIdx.x; asm volatile("" : "+v"(tid)); asm volatile("" : "+s"(ws)); int bid = blockIdx.x; asm volatile("" : "+s"(bid));
        char* pr = (char*)ws + O_PASS;
        SchedRows Sc{(unsigned)O_H1B, (unsigned)O_WPQ, 1024, 8, 2048, G, bid};
        EpiScores E{(bf16_t*)(pr + P_PQ)};
        g8::gemm_phase<EpiScores, SchedRows>(lds, (const char*)ws, 1024, Sc, E, tid);
        SEAM();
    }
    for (int rep_ = 0; rep_ < NREP(PH_ROUTE); ++rep_) if (RUN(PH_ROUTE)) {
        int tid = threadIdx.x; asm volatile("" : "+v"(tid)); asm volatile("" : "+s"(ws)); int bid = blockIdx.x; asm volatile("" : "+s"(bid));
        char* pr = (char*)ws + O_PASS;
        const int wid = __builtin_amdgcn_readfirstlane(tid >> 6), lane = tid & 63;
        for (int task = bid * NWAVES + wid; task < (M / 32) * 8; task += G * NWAVES)
            route_wave((const bf16_t*)(pr + P_PQ), (int*)(pr + P_IDX), (float*)(pr + P_PG), task >> 3, task & 7, lane);
        SEAM();
    }
    if (RUN(PH_EXPERTS)) {
        int tid = threadIdx.x; asm volatile("" : "+v"(tid)); asm volatile("" : "+s"(ws)); int bid = blockIdx.x; asm volatile("" : "+s"(bid));
        char* pr = (char*)ws + O_PASS;
        const int wid = __builtin_amdgcn_readfirstlane(tid >> 6), lane = tid & 63;
        if (tid == 0) {
            unsigned base = 0; const unsigned myx = ALL ? bar.x : 0u;
            if (ALL) { for (unsigned jx = 0; jx < 16; ++jx) { const unsigned c = xb_ld(&bar.bar[XB_XCNT(jx)]); if (jx < myx) base += c; } MISC[12] = base + MISC[10]; }
            else MISC[12] = (unsigned)bid;
        }
        __syncthreads();
        const int vwg = (int)MISC[12];
        const int nper = G >> 3, x = vwg / nper, r = vwg % nper;
        const int tpw = M / (nper * NWAVES);
        const size_t tokw0 = (size_t)(r * NWAVES + wid) * tpw;
        {
            const unsigned char* U8x = (const unsigned char*)(ws + O_UB) + (size_t)x * ((size_t)NEXP * 128);
            experts_u_slice<2>((const unsigned char*)(ws + O_H1Q), U8x, (const int*)(pr + P_IDX), (bf16_t*)(pr + P_PD), tokw0, tpw, x, lane);
        }
        SEAM();
        experts_combine((const bf16_t*)(pr + P_PD), (const int*)(pr + P_IDX), (const float*)(pr + P_PG), (const float*)(ws + O_USC), (const float*)(ws + O_VSC), (const float*)(ws + O_HSC), (unsigned char*)(pr + P_C), (float*)(pr + P_C + (size_t)M * 128), bid * NWAVES + wid, G * NWAVES, lane);
        SEAM();
        {
            const unsigned char* V8x = (const unsigned char*)(ws + O_VB) + (size_t)x * ((size_t)NEXP * 128);
            experts_v_slice<2>(V8x, (const int*)(pr + P_IDX), (const unsigned char*)(pr + P_C), (const float*)(pr + P_C + (size_t)M * 128), (bf16_t*)(pr + P_FFN), tokw0, tpw, x, lane);
        }
        SEAM();
        for (int tok = (bid * NWAVES + wid) * 4; tok < M; tok += G * NWAVES * 4) ln2_tokens<4>((const bf16_t*)(pr + P_FFN), (const bf16_t*)(ws + O_H1B), karg_in(16), karg_in(17), karg_out(), (size_t)tok, lane);
    }
#undef RUN
#undef SEAM
}

extern "C" void kernel_launch(void* const* d_in, const int* in_sizes, int n_in, void* d_out, int out_size, void* d_ws, size_t ws_size, hipStream_t stream) {
    if (ws_size < WS_NEED || n_in != 18) return;
    static bool attr_set = false;
    if (!attr_set) { (void)hipFuncSetAttribute((const void*)mega, hipFuncAttributeMaxDynamicSharedMemorySize, LDS_BYTES); attr_set = true; }
    (void)hipMemsetAsync((char*)d_ws + O_MISC + 16384, 0, 16384, stream);
    Args a{}; for (int i = 0; i < 18; ++i) a.in[i] = (const float*)d_in[i]; a.out = (float*)d_out; a.ws = (unsigned char*)d_ws; a.ph = PH_ALL; a.pass = 0;
    mega<<<256, NTHR, LDS_BYTES, stream>>>(a);
}
```

```cpp
#include <hip/hip_runtime.h>
#include <stdint.h>
#include <math.h>

typedef unsigned short bf16_t;
typedef short bf16x8 __attribute__((ext_vector_type(8)));
typedef float f32x4 __attribute__((ext_vector_type(4)));
#define DI __device__ __forceinline__
#define ST_G(val, ptr) __builtin_nontemporal_store((val), (__attribute__((address_space(1))) decltype(val)*)(ptr))

DI const float* karg_in(int i) { const float* const* kp = (const float* const*)__builtin_amdgcn_kernarg_segment_ptr(); asm volatile("" : "+s"(kp)); return kp[i]; }
DI float* karg_out() { float* const* kp = (float* const*)__builtin_amdgcn_kernarg_segment_ptr(); asm volatile("" : "+s"(kp)); return kp[18]; }
DI float bf2f(bf16_t v) { return __uint_as_float(((unsigned)v) << 16); }
DI bf16_t f2bf(float f) { unsigned u = __float_as_uint(f); u += 0x7fffu + ((u >> 16) & 1u); return (bf16_t)(u >> 16); }

constexpr int NB = 8, S = 8192, D = 1024, M = NB * S;
constexpr int NPASS = 4, BPP = NB / NPASS, MP = BPP * S;
constexpr int INC = 10240;
constexpr int NEXP = 16384;
constexpr float ALPHA = 1.189207115002721f;
constexpr float LN_EPS = 1e-5f;
constexpr float QSCALE = 0.08838834764831845f;

constexpr size_t al(size_t x) { return (x + 255) & ~(size_t)255; }
constexpr size_t O_WIN = 0;
constexpr size_t O_WMKV = O_WIN + al((size_t)INC * D * 2);
constexpr size_t O_WBR = O_WMKV + al((size_t)1024 * 1024 * 2);
constexpr size_t O_WOUT = O_WBR + al((size_t)1024 * 1536 * 2);
constexpr size_t O_WPQ = O_WOUT + al((size_t)1024 * 1024 * 2);
constexpr size_t O_SUBK = O_WPQ + al((size_t)2048 * 1024 * 2);
constexpr size_t O_UB = O_SUBK + al((size_t)16 * 128 * 128 * 2);
constexpr size_t O_VB = O_UB + al((size_t)NEXP * D);
constexpr size_t O_USC = O_VB + al((size_t)NEXP * D);
constexpr size_t O_VSC = O_USC + al((size_t)NEXP * 4);
constexpr size_t O_XB = O_VSC + al((size_t)NEXP * 4);
constexpr size_t O_MEMB = O_XB + al((size_t)M * D * 2);
constexpr size_t O_MK = O_MEMB + al((size_t)2048 * 1024 * 2);
constexpr size_t O_MVT = O_MK + al((size_t)2048 * 512 * 2);
constexpr size_t O_H1B = O_MVT + al((size_t)8 * 512 * 256 * 2);
constexpr size_t O_H1Q = O_H1B + al((size_t)M * D * 2);
constexpr size_t O_HSC = O_H1Q + al((size_t)M * D);
constexpr size_t O_X8 = O_HSC + al((size_t)M * 4);
constexpr size_t O_XSC = O_X8 + al((size_t)M * D);
constexpr size_t O_W8 = O_XSC + al((size_t)3 * M * 4);
constexpr size_t O_WSC = O_W8 + al((size_t)INC * D);
constexpr size_t O_CMAX = O_WSC + al((size_t)INC * 4);
constexpr size_t O_WPQ8 = O_CMAX + al((size_t)INC * 4);
constexpr size_t O_MISC = O_WPQ8 + al((size_t)2048 * D);
constexpr size_t O_BGATE = O_MISC + 32768;
constexpr size_t O_PASS = O_MISC + al(65536);
constexpr size_t P_QK = 0;
constexpr size_t P_VT = P_QK + al((size_t)MP * 3072 * 2);
constexpr size_t P_IT = P_VT + (size_t)1536 * MP * 2;
constexpr size_t P_HFQG = P_IT + al((size_t)512 * MP * 2);
constexpr size_t P_MQ = P_HFQG + al((size_t)MP * 1536 * 2);
constexpr size_t P_GATE = P_MQ + al((size_t)MP * 512 * 2);
constexpr size_t P_OG = P_GATE + al((size_t)MP * 3072 * 2);
constexpr size_t P_LSE = P_OG + al((size_t)MP * 1536 * 2);
constexpr size_t P_BR = P_LSE + al((size_t)MP * 12 * 4);
constexpr size_t P_MERGED = P_BR + al((size_t)MP * 1536 * 2);
constexpr size_t P_MIX = P_MERGED + al((size_t)MP * 1024 * 2);
constexpr size_t P_HSTL = P_MIX + al((size_t)MP * 1024 * 4);
constexpr size_t P_HSTD = P_HSTL + al((size_t)256 * 16384 * 4);
constexpr size_t P_SIN = P_HSTD + al((size_t)256 * 128 * 4);
constexpr size_t P_END = P_SIN + al((size_t)256 * 16384 * 4);
constexpr size_t P_PQ = 0;
constexpr size_t P_IDX = P_PQ + al((size_t)M * 2048 * 2);
constexpr size_t P_PG = P_IDX + al((size_t)M * 128 * 4);
constexpr size_t P_C = P_PG + al((size_t)M * 128 * 4);
constexpr size_t P_END2 = P_C + al((size_t)M * 128 * 4);
constexpr size_t P_PD = 0;
constexpr size_t P_FFN = P_PD + al((size_t)M * 1024 * 2);
static_assert(P_FFN + (size_t)M * 1024 * 2 <= P_IDX, "PEER overlay");
constexpr size_t WS_NEED = O_PASS + (P_END > P_END2 ? P_END : P_END2);
static_assert(WS_NEED <= (size_t)1073741824, "workspace budget");

DI int dil_of(int g) { return g == 0 ? 1 : (g == 1 ? 4 : 16); }
DI float dpp_x(float v, const int which) {
    const int s = __float_as_int(v);
    const int r = which == 0 ? __builtin_amdgcn_update_dpp(0, s, 0xB1, 0xF, 0xF, true) : which == 1 ? __builtin_amdgcn_update_dpp(0, s, 0x4E, 0xF, 0xF, true)
                : which == 2 ? __builtin_amdgcn_update_dpp(0, s, 0x141, 0xF, 0xF, true) : __builtin_amdgcn_update_dpp(0, s, 0x128, 0xF, 0xF, true);
    return __int_as_float(r);
}
DI float pair_sum(float v) { const auto rr = __builtin_amdgcn_permlane32_swap(__float_as_uint(v), __float_as_uint(v), false, false); return __uint_as_float(rr[0]) + __uint_as_float(rr[1]); }
DI float pair_max(float v) { const auto rr = __builtin_amdgcn_permlane32_swap(__float_as_uint(v), __float_as_uint(v), false, false); return fmaxf(__uint_as_float(rr[0]), __uint_as_float(rr[1])); }
DI float wave_max(float v) {
    v = fmaxf(v, dpp_x(v, 0)); v = fmaxf(v, dpp_x(v, 1)); v = fmaxf(v, dpp_x(v, 2)); v = fmaxf(v, dpp_x(v, 3));
    { const auto rr = __builtin_amdgcn_permlane16_swap(__float_as_uint(v), __float_as_uint(v), false, false); v = fmaxf(__uint_as_float(rr[0]), __uint_as_float(rr[1])); }
    return pair_max(v);
}
DI float wave_sum(float v) {
    v += dpp_x(v, 0); v += dpp_x(v, 1); v += dpp_x(v, 2); v += dpp_x(v, 3);
    { const auto rr = __builtin_amdgcn_permlane16_swap(__float_as_uint(v), __float_as_uint(v), false, false); v = __uint_as_float(rr[0]) + __uint_as_float(rr[1]); }
    return pair_sum(v);
}

#define LAS __attribute__((address_space(3)))
#define GAS __attribute__((address_space(1)))
typedef unsigned u32x4 __attribute__((ext_vector_type(4)));
typedef unsigned u32x2 __attribute__((ext_vector_type(2)));
typedef float f32x2 __attribute__((ext_vector_type(2)));
typedef __bf16 bf16x2_t __attribute__((ext_vector_type(2)));
DI unsigned cvtpk(float lo, float hi) { f32x2 v = {lo, hi}; bf16x2_t b = __builtin_convertvector(v, bf16x2_t); return __builtin_bit_cast(unsigned, b); }
constexpr float LOG2E = 1.4426950408889634f;
constexpr int NTHR_C = 512;
DI float fast_sigmoid(float z) { return __builtin_amdgcn_rcpf(1.f + __builtin_amdgcn_exp2f(-z * LOG2E)); }

namespace g8 {
constexpr int BM = 256, BK = 64, HALF = 128, HTB = HALF * BK * 2, STAGE_BYTES = 8 * HTB;
DI int lds_byte(int r, int c) { const int st = (r >> 4) * 2 + (c >> 5), rr = r & 15, cc = c & 31, ob = rr * 64 + cc * 2; return st * 1024 + (ob ^ (((ob >> 9) & 1) << 5)); }
DI void stage_rc(int b, int& R, int& C) { const int st = b / 1024, sb = b % 1024, swz = sb ^ (((sb >> 9) & 1) << 5); R = (st >> 1) * 16 + swz / 64; C = (st & 1) * 32 + (swz % 64) / 2; }
DI int perm32(int rho) { const int n = rho >> 4, i = rho & 15; return 8 * (i >> 2) + 4 * n + (i & 3); }

struct Unit { unsigned a, b; int dla, dlb; int pm, pn, kind; };

typedef int i32x8 __attribute__((ext_vector_type(8)));
typedef int i32x4v __attribute__((ext_vector_type(4)));
template <class Epi, class Sched, int OPK = 0>
DI void gemm_phase(LAS unsigned char* lds, const char* const wsb, const int K, const Sched& S, const Epi& E, const int tid) {
    const int wid = __builtin_amdgcn_readfirstlane(tid >> 6), lane = tid & 63, wr = wid >> 2, wc = wid & 3, fr = lane & 15, fq = lane >> 4;
    constexpr bool F8 = OPK == 1;
    const int nt = K / BK;
#define G8_STAGE_OFFS(tidv) unsigned rak[2], rbk[2], ccb[2]; \
    _Pragma("unroll") for (int i_ = 0; i_ < 2; ++i_) { int R_, C_; stage_rc((tidv) * 16 + i_ * 8192, R_, C_); const int Rb_ = Epi::PERM ? ((R_ & ~31) + perm32(R_ & 31)) : R_; \
        rak[i_] = (unsigned)(R_ * K) * 2u; rbk[i_] = (unsigned)(Rb_ * K) * 2u; ccb[i_] = (unsigned)C_ * 2u; }
    const unsigned kstep = (unsigned)(BK * 2);
    const unsigned hstepA = (unsigned)(HALF * K * 2);
    const unsigned ldsw = (unsigned)wid * 1024u;
    const int aoff = lds_byte(wr * 64 + fr, fq * 8), boff = lds_byte(wc * 32 + fr, fq * 8);
#define G8_SA(b, h) (((b) * 2 + (h)) * HTB)
#define G8_SB(b, h) ((4 + (b) * 2 + (h)) * HTB)
#define G8_STAGE(bufoff, gbase, v0, v1) do { \
        __builtin_amdgcn_global_load_lds((const unsigned*)(wsb + (unsigned)((gbase) + (v0))), (LAS unsigned*)(lds + (bufoff) + ldsw), 16, 0, 0); \
        __builtin_amdgcn_global_load_lds((const unsigned*)(wsb + (unsigned)((gbase) + (v1))), (LAS unsigned*)(lds + (bufoff) + ldsw + 8192), 16, 0, 0); } while (0)
#define G8_LDA(dst, b, h) do { _Pragma("unroll") for (int m = 0; m < 4; ++m) _Pragma("unroll") for (int k = 0; k < 2; ++k) dst[m][k] = *(const LAS bf16x8*)(lds + G8_SA(b, h) + aoff + m * 2048 + k * 1024); } while (0)
#define G8_LDB(dst, b, h) do { _Pragma("unroll") for (int n = 0; n < 2; ++n) _Pragma("unroll") for (int k = 0; k < 2; ++k) dst[n][k] = *(const LAS bf16x8*)(lds + G8_SB(b, h) + boff + n * 2048 + k * 1024); } while (0)
#define G8_CAT(x) __builtin_shufflevector(__builtin_bit_cast(i32x4v, (x)[0]), __builtin_bit_cast(i32x4v, (x)[1]), 0, 1, 2, 3, 4, 5, 6, 7)
#define G8_MMA(ai, bj, At, Bt) do { __builtin_amdgcn_s_setprio(1); \
        if constexpr (F8) { _Pragma("unroll") for (int m = 0; m < 4; ++m) _Pragma("unroll") for (int n = 0; n < 2; ++n) \
            asm volatile("v_mfma_scale_f32_16x16x128_f8f6f4 %0, %1, %2, %0, %3, %3 op_sel_hi:[0,0,0]" : "+v"(acc[ai][bj][m][n]) : "v"(G8_CAT(Bt[n])), "v"(G8_CAT(At[m])), "v"(mxscale)); } \
        else if constexpr (OPK == 2) { _Pragma("unroll") for (int m = 0; m < 4; ++m) _Pragma("unroll") for (int n = 0; n < 2; ++n) _Pragma("unroll") for (int k = 0; k < 2; ++k) \
            acc[ai][bj][m][n] = __builtin_bit_cast(f32x4, __builtin_amdgcn_mfma_i32_16x16x64_i8(__builtin_bit_cast(i32x4v, Bt[n][k]), __builtin_bit_cast(i32x4v, At[m][k]), __builtin_bit_cast(i32x4v, acc[ai][bj][m][n]), 0, 0, 0)); } \
        else { _Pragma("unroll") for (int m = 0; m < 4; ++m) _Pragma("unroll") for (int n = 0; n < 2; ++n) _Pragma("unroll") for (int k = 0; k < 2; ++k) \
            acc[ai][bj][m][n] = __builtin_amdgcn_mfma_f32_16x16x32_bf16(Bt[n][k], At[m][k], acc[ai][bj][m][n], 0, 0, 0); } \
        __builtin_amdgcn_s_setprio(0); } while (0)
#define G8_WAIT_V(n) asm volatile("s_waitcnt vmcnt(" #n ")" ::: "memory")
#define G8_WAIT_L(n) asm volatile("s_waitcnt lgkmcnt(" #n ")" ::: "memory")
#define G8_BAR __builtin_amdgcn_s_barrier()
#define G8_SCHED __builtin_amdgcn_sched_barrier(0)
    Unit cur, nxt; int ui = 0;
    if (!S.next(0, cur)) return;
    f32x4 acc[2][2][4][2];
#pragma unroll
    for (int a = 0; a < 2; ++a)
#pragma unroll
        for (int b = 0; b < 2; ++b)
#pragma unroll
            for (int m = 0; m < 4; ++m)
#pragma unroll
                for (int n = 0; n < 2; ++n) acc[a][b][m][n] = (f32x4){0.f, 0.f, 0.f, 0.f};
    const int mxscale = 0x7f7f7f7f;
    bf16x8 At[4][2], B0[2][2], B1[2][2];
    unsigned cA = cur.a, cB = cur.b;
    unsigned hBc = hstepA * (unsigned)cur.dlb, hAc = hstepA * (unsigned)cur.dla;
    G8_STAGE_OFFS(tid)
    {
    const unsigned vBc0 = rbk[0] * (unsigned)cur.dlb + ccb[0], vBc1 = rbk[1] * (unsigned)cur.dlb + ccb[1];
    const unsigned vAc0 = rak[0] * (unsigned)cur.dla + ccb[0], vAc1 = rak[1] * (unsigned)cur.dla + ccb[1];
    G8_STAGE(G8_SB(0, 0), cB, vBc0, vBc1); G8_STAGE(G8_SB(0, 1), cB + hBc, vBc0, vBc1); G8_STAGE(G8_SA(0, 0), cA, vAc0, vAc1); G8_STAGE(G8_SA(0, 1), cA + hAc, vAc0, vAc1);
    if (wr == 1) G8_BAR;
    G8_WAIT_V(2); G8_BAR;
    G8_STAGE(G8_SB(1, 0), cB + kstep, vBc0, vBc1); G8_STAGE(G8_SA(1, 0), cA + kstep, vAc0, vAc1); G8_STAGE(G8_SB(1, 1), cB + hBc + kstep, vBc0, vBc1);
    G8_WAIT_V(6); G8_BAR;
    }
    for (;;) {
        const bool has_next = S.next(ui + 1, nxt);
        const unsigned nA = has_next ? nxt.a : cA, nB = has_next ? nxt.b : cB; const int dln = has_next ? nxt.dlb : cur.dlb;
        const unsigned hBn = hstepA * (unsigned)dln;
        const int dlan = has_next ? nxt.dla : cur.dla;
        const unsigned hAn = hstepA * (unsigned)dlan;
#pragma unroll 1
        for (int t = 0; t < nt; t += 2) {
            if constexpr (Epi::HOOK) E.hook(acc, cur, t, wr, wc, fr, fq);
            const bool last = (t == nt - 2);
            const bool relax = (t == 0) && (ui > 0);
            const unsigned a1 = cA + (unsigned)(t + 1) * kstep;
            const unsigned a2 = last ? nA : cA + (unsigned)(t + 2) * kstep, b2 = last ? nB : cB + (unsigned)(t + 2) * kstep;
            const unsigned a3 = a2 + kstep, b3 = b2 + kstep;
            const unsigned dBs = (unsigned)(last ? dln : cur.dlb), dAs = (unsigned)(last ? dlan : cur.dla);
            const unsigned vB0 = rbk[0] * dBs + ccb[0], vB1 = rbk[1] * dBs + ccb[1]; const unsigned hB = last ? hBn : hBc;
            const unsigned vA0 = rak[0] * dAs + ccb[0], vA1 = rak[1] * dAs + ccb[1]; const unsigned hA = last ? hAn : hAc;
            const unsigned vAc0 = rak[0] * (unsigned)cur.dla + ccb[0], vAc1 = rak[1] * (unsigned)cur.dla + ccb[1];
            G8_LDB(B0, 0, 0); G8_LDB(B1, 0, 1); G8_SCHED; G8_LDA(At, 0, 0); G8_STAGE(G8_SA(1, 1), a1 + hAc, vAc0, vAc1);
            if (relax) G8_WAIT_V(24); else G8_WAIT_V(8);
            G8_WAIT_L(0); G8_BAR; G8_MMA(0, 0, At, B0); G8_MMA(0, 1, At, B1); G8_BAR; G8_SCHED;
            G8_LDA(At, 0, 1); G8_STAGE(G8_SB(0, 0), b2, vB0, vB1); G8_STAGE(G8_SB(0, 1), b2 + hB, vB0, vB1); G8_STAGE(G8_SA(0, 0), a2, vA0, vA1);
            if (relax) G8_WAIT_V(24); else G8_WAIT_V(8);
            G8_WAIT_L(0); G8_BAR; G8_MMA(1, 0, At, B0); G8_MMA(1, 1, At, B1); G8_BAR; G8_SCHED;
            G8_LDB(B0, 1, 0); G8_LDB(B1, 1, 1); G8_SCHED; G8_LDA(At, 1, 0); G8_STAGE(G8_SA(0, 1), a2 + hA, vA0, vA1);
            G8_WAIT_V(8); G8_WAIT_L(0); G8_BAR; G8_MMA(0, 0, At, B0); G8_MMA(0, 1, At, B1); G8_BAR; G8_SCHED;
            G8_LDA(At, 1, 1); G8_STAGE(G8_SB(1, 0), b3, vB0, vB1); G8_STAGE(G8_SB(1, 1), b3 + hB, vB0, vB1); G8_STAGE(G8_SA(1, 0), a3, vA0, vA1);
            G8_WAIT_V(8); G8_WAIT_L(0); G8_BAR; G8_MMA(1, 0, At, B0); G8_MMA(1, 1, At, B1); G8_BAR; G8_SCHED;
        }
        if constexpr (F8) asm volatile("s_nop 15\n\ts_nop 7" ::: "memory");
        if (wr == 0) G8_BAR;
        E(acc, cur, wr, wc, fr, fq);
        if (!has_next) break;
#pragma unroll
        for (int a = 0; a < 2; ++a)
#pragma unroll
            for (int b = 0; b < 2; ++b)
#pragma unroll
                for (int m = 0; m < 4; ++m)
#pragma unroll
                    for (int n = 0; n < 2; ++n) acc[a][b][m][n] = (f32x4){0.f, 0.f, 0.f, 0.f};
        cur = nxt; cA = nA; cB = nB; hBc = hBn; hAc = hAn; ++ui;
        if (wr == 1) G8_BAR;
    }
    G8_WAIT_V(0);
    G8_BAR;
#undef G8_SA
#undef G8_SB
#undef G8_STAGE
#undef G8_LDA
#undef G8_LDB
#undef G8_MMA
#undef G8_STAGE_OFFS
#undef G8_CAT
#undef G8_WAIT_V
#undef G8_WAIT_L
#undef G8_BAR
#undef G8_SCHED
}
}

typedef GAS unsigned gu32;
#define XB_TMO      128
#define XB_XCNT(j)  (256  + 64 * (j))
#define XB_XSUB(j)  (1280 + 64 * (j))
#define XB_XGEN(j)  (2304 + 64 * (j))
#define XB_TOP      3328
#define XB_TOPGEN   3392
#define XCD_BAR_WORDS 3456
#define XB_SPIN_CAP (1u << 22)
DI unsigned xb_ld(unsigned* p)              { return __hip_atomic_load(p, __ATOMIC_RELAXED, __HIP_MEMORY_SCOPE_AGENT); }
DI unsigned xb_add(unsigned* p, unsigned v) { return __hip_atomic_fetch_add(p, v, __ATOMIC_RELAXED, __HIP_MEMORY_SCOPE_AGENT); }
DI unsigned xb_xcc_id() { return (unsigned)__builtin_amdgcn_s_getreg((3 << 11) | 20) & 0xFu; }
#define XB_SPIN(cond, bar) do { unsigned _sp = 0; while (cond) { __builtin_amdgcn_s_sleep(1); \
    if ((++_sp & 255u) == 0u) { if (xb_ld(&(bar)[XB_TMO])) break; if (_sp > XB_SPIN_CAP) { atomicAdd(&(bar)[XB_TMO], 1u); break; } } } } while (0)
struct XcdBarrier { unsigned* bar; unsigned x; volatile LAS unsigned* st; };
DI XcdBarrier xcd_barrier_post(unsigned* bar, volatile LAS unsigned* st) {
    XcdBarrier b; b.bar = bar; b.x = xb_xcc_id(); b.st = st;
    if (threadIdx.x == 0) st[2] = xb_add(&bar[XB_XCNT(b.x)], 1u);
    return b;
}
DI void xcd_barrier_complete(unsigned* bar, unsigned x, unsigned& nloc, unsigned& nx) {
    const unsigned G = gridDim.x * gridDim.y * gridDim.z;
    unsigned sum, cnt, mine, sp = 0u;
    for (;;) {
        sum = 0u; cnt = 0u; mine = 0u;
#pragma unroll
        for (unsigned j = 0; j < 16; ++j) { const unsigned c = xb_ld(&bar[XB_XCNT(j)]); sum += c; cnt += (c > 0u) ? 1u : 0u; mine = (j == x) ? c : mine; }
        if (sum == G) break;
        __builtin_amdgcn_s_sleep(1);
        if ((++sp & 255u) == 0u) { if (xb_ld(&bar[XB_TMO])) break; if (sp > XB_SPIN_CAP) { atomicAdd(&bar[XB_TMO], 1u); break; } }
    }
    nloc = mine > 0u ? mine : 1u; nx = cnt > 0u ? cnt : 1u;
}
DI void xcd_barrier(const XcdBarrier& b) {
    asm volatile("s_waitcnt vmcnt(0)" ::: "memory");
    __syncthreads();
    if (threadIdx.x == 0) {
        unsigned* bar = b.bar;
        __builtin_amdgcn_s_waitcnt(0);
        unsigned nloc = b.st[0], nx = b.st[1];
        if (nloc == 0u) { xcd_barrier_complete(bar, b.x, nloc, nx); b.st[0] = nloc; b.st[1] = nx; }
        const unsigned old = xb_add(&bar[XB_XSUB(b.x)], 1u);
        const unsigned gen = old / nloc;
        if (old + 1u == (gen + 1u) * nloc) {
            __builtin_amdgcn_fence(__ATOMIC_RELEASE, "agent");
            asm volatile("s_waitcnt vmcnt(0)" ::: "memory");
            const unsigned og = xb_add(&bar[XB_TOP], 1u);
            const unsigned tg = og / nx;
            if (og + 1u == (tg + 1u) * nx) xb_add(&bar[XB_TOPGEN], 1u);
            else XB_SPIN(xb_ld(&bar[XB_TOPGEN]) == tg, bar);
            __builtin_amdgcn_fence(__ATOMIC_ACQUIRE, "agent");
            xb_add(&bar[XB_XGEN(b.x)], 1u);
            asm volatile("s_waitcnt vmcnt(0)" ::: "memory");
        } else {
            XB_SPIN(xb_ld(&bar[XB_XGEN(b.x)]) == gen, bar);
            __builtin_amdgcn_fence(__ATOMIC_ACQUIRE, "agent");
            asm volatile("s_waitcnt vmcnt(0)" ::: "memory");
        }
    }
    __syncthreads();
}

constexpr int NWAVES = 8, NTHR = NWAVES * 64;
constexpr int RING_BYTES = 131072, LDS_BYTES = 147456, LDSCTL_OFF = LDS_BYTES - 1024, MISC_OFF = LDSCTL_OFF + 320;
enum { PH_ALL = 0, PH_PRO = 11, PH_PROJ = 1, PH_ATTN = 2, PH_HGPRE = 3, PH_HGMAIN = 4, PH_WIDEN = 5, PH_WOUT = 6, PH_LN1 = 7, PH_PQ = 8, PH_ROUTE = 9, PH_EXPERTS = 10, PH_HGSCAN = 12 };
struct Args { const float* in[18]; float* out; unsigned char* ws; int ph, pass; };

struct Bufs {
    const bf16_t *WIN, *XBp; bf16_t *QK, *VIT, *HFQG, *MQ, *GATE;
};

template <int KIND>
struct SchedP1 {
    static constexpr unsigned RB = 1024u;
    unsigned XBp, W; int G, c;
    DI bool next(int i, g8::Unit& u) const {
        const int L = i * G + c + (KIND ? 2048 : 0); if (L >= (KIND ? 2560 : 2048)) return false;
        if (L < 2048) { const int x = L & 7, off = L >> 3; u.pm = 8 * x + (off & 7); u.pn = off >> 3; u.kind = 0; u.dlb = 1;
            const int hp = u.pn < 12 ? (u.pn < 6 ? u.pn : u.pn - 6) : 0, lg = hp < 2 ? 0 : (hp < 4 ? 2 : 4), dl = 1 << lg;
            const int v0 = u.pm * 256, lb = v0 >> 13, vv = v0 & (S - 1), r = vv >> (13 - lg), m0 = vv & ((1 << (13 - lg)) - 1);
            u.dla = dl; u.a = XBp + (unsigned)(lb * S + m0 * dl + r) * RB; u.b = W + (unsigned)u.pn * 256u * RB; }
        else { const int idx = L - 2048; u.pm = idx & 7; u.pn = idx >> 3; u.kind = 1;
            const int lg = u.pm < 2 ? 0 : (u.pm < 4 ? 2 : (u.pm < 6 ? 4 : 0)), dl = 1 << lg;
            const int v0 = u.pn * 256, lb = v0 >> 13, vv = v0 & (S - 1), r = vv >> (13 - lg), m0 = vv & ((1 << (13 - lg)) - 1);
            u.dla = 1; u.dlb = dl; u.a = W + (unsigned)(8192 + u.pm * 256) * RB; u.b = XBp + (unsigned)(lb * S + m0 * dl + r) * RB; }
        return true;
    }
};
DI int opq(int x) { asm volatile("" : "+v"(x)); return x; }
DI f32x4 acc_i2f(const f32x4& a) { const g8::i32x4v t = __builtin_bit_cast(g8::i32x4v, a); return (f32x4){(float)t[0], (float)t[1], (float)t[2], (float)t[3]}; }
DI int frag_row_off(int d0, int r32) { return (((d0 >> 4) * 64 + ((d0 >> 3) & 1) * 32 + r32) * 8); }
DI int pos2tok(int v, int lg) { const int lb = v >> 13, pos = v & (S - 1), per_lg = 13 - lg; return (lb << 13) + ((pos & ((1 << per_lg) - 1)) << lg) + (pos >> per_lg); }
template <int KIND>
struct EpiP1 {
    static constexpr bool PERM = true, HOOK = false;
    char* ws; int t0, pad;
    DI void hook(f32x4 (&)[2][2][4][2], const g8::Unit&, int, int, int, int, int) const {}
    DI void operator()(const f32x4 (&acc)[2][2][4][2], const g8::Unit& u, int wr, int wc, int fr_in, int fq_in) const {
        char* pr = ws + O_PASS; const float* xsc = (const float*)(ws + O_XSC) + t0; const float wsg = *(const float*)(ws + O_WSC);
        const int fr = opq(fr_in), fq = opq(fq_in);
        const int rowl = wr * 64 + fr, d0 = wc * 32 + 8 * fq;
        if constexpr (KIND == 1) {
            f32x4 xq[2][2];
            { const float* xg = xsc + (u.pm < 6 ? (u.pm >> 1) : 0) * M + u.pn * 256 + d0;
#pragma unroll
              for (int bj = 0; bj < 2; ++bj) { xq[bj][0] = *(const f32x4*)(xg + bj * 128) * wsg; xq[bj][1] = *(const f32x4*)(xg + bj * 128 + 4) * wsg; } }
#pragma unroll
            for (int ai = 0; ai < 2; ++ai)
#pragma unroll
                for (int m = 0; m < 4; ++m) { const int R = u.pm * 256 + rowl + ai * 128 + m * 16;
#pragma unroll
                    for (int bj = 0; bj < 2; ++bj) { f32x4 v0 = acc_i2f(acc[ai][bj][m][0]), v1 = acc_i2f(acc[ai][bj][m][1]);
                        const int c = u.pn * 256 + bj * 128 + d0;
                        v0 = v0 * xq[bj][0]; v1 = v1 * xq[bj][1];
                        if (R < 1536) {
                            const int gh = R >> 7, d = R & 127, lb = c >> 13, pos = c & (S - 1), kk = pos & 31;
                            bf16_t* blk = (bf16_t*)(pr + P_VT) + ((size_t)((lb * 12 + gh) * 256 + (pos >> 5))) * 4096 + (((d >> 5) * 2 + (kk >> 4)) * 64 + (d & 31)) * 8 + 4 * ((kk >> 3) & 1);
                            u32x2 wa, wb; wa.x = cvtpk(v0[0], v0[1]); wa.y = cvtpk(v0[2], v0[3]); wb.x = cvtpk(v1[0], v1[1]); wb.y = cvtpk(v1[2], v1[3]);
                            ST_G(wa, (u32x2*)blk); ST_G(wb, (u32x2*)(blk + 32 * 8));
                        } else {
                            u32x4 w; w.x = cvtpk(v0[0], v0[1]); w.y = cvtpk(v0[2], v0[3]); w.z = cvtpk(v1[0], v1[1]); w.w = cvtpk(v1[2], v1[3]);
                            ST_G(w, (u32x4*)((bf16_t*)(pr + P_IT) + (size_t)(R - 1536) * MP + c));
                        } }
                    asm volatile("" ::: "memory"); }
            return;
        } else {
        float xs8[2][4];
        { const int hp_ = u.pn < 12 ? (u.pn < 6 ? u.pn : u.pn - 6) : 0; const float* xr = xsc + (hp_ < 2 ? 0 : (hp_ < 4 ? 1 : 2)) * M + u.pm * 256 + rowl;
#pragma unroll
          for (int ai = 0; ai < 2; ++ai)
#pragma unroll
              for (int m = 0; m < 4; ++m) xs8[ai][m] = xr[ai * 128 + m * 16];
#pragma unroll
          for (int ai = 0; ai < 2; ++ai)
#pragma unroll
              for (int m = 0; m < 4; ++m) xs8[ai][m] *= wsg; }
        if (u.pn < 12 || u.pn == 18 || u.pn == 19) {
#pragma unroll
            for (int ai = 0; ai < 2; ++ai)
#pragma unroll
                for (int m = 0; m < 4; ++m) { const int row = u.pm * 256 + rowl + ai * 128 + m * 16;
                    const float xs = xs8[ai][m];
#pragma unroll
                    for (int bj = 0; bj < 2; ++bj) { f32x4 v0 = acc_i2f(acc[ai][bj][m][0]), v1 = acc_i2f(acc[ai][bj][m][1]);
                        v0 = v0 * xs; v1 = v1 * xs;
                        u32x4 w; w.x = cvtpk(v0[0], v0[1]); w.y = cvtpk(v0[2], v0[3]); w.z = cvtpk(v1[0], v1[1]); w.w = cvtpk(v1[2], v1[3]);
                        bf16_t* dst;
                        if (u.pn < 12) { const int hh = u.pn * 2 + bj, qk = hh >= 12 ? 1 : 0, gh = hh - 12 * qk;
                            const int lb = row >> 13, pos = row & (S - 1);
                            dst = (bf16_t*)(pr + P_QK) + ((size_t)(((qk * BPP + lb) * 12 + gh) * 256 + (pos >> 5))) * 4096 + frag_row_off(d0, pos & 31); }
                        else { const int h = (u.pn - 18) * 2 + bj; dst = (bf16_t*)(pr + P_MQ) + ((size_t)((row >> 5) * 4 + h)) * 4096 + frag_row_off(d0, row & 31); }
                        ST_G(w, (u32x4*)dst); }
                    asm volatile("" ::: "memory"); }
            return;
        }
        bf16_t* base; int ldc, colt; bool gate = false;
        if (u.pn < 18) { base = (bf16_t*)(pr + P_HFQG); ldc = 1536; colt = (u.pn - 12) * 256; }
        else { base = (bf16_t*)(pr + P_GATE); ldc = 3072; colt = (u.pn - 20) * 256; gate = true; }
        const int row0 = u.pm * 256 + rowl, col0 = colt + d0;
        f32x4 bv[2][2];
#pragma unroll
        for (int bj = 0; bj < 2; ++bj)
#pragma unroll
            for (int n = 0; n < 2; ++n) bv[bj][n] = gate ? *(const f32x4*)((const float*)(ws + O_BGATE) + col0 + bj * 128 + 4 * n) : (f32x4){0.f, 0.f, 0.f, 0.f};
#pragma unroll
        for (int ai = 0; ai < 2; ++ai)
#pragma unroll
            for (int m = 0; m < 4; ++m) { bf16_t* rowp = base + (size_t)(row0 + ai * 128 + m * 16) * ldc + col0;
                const float xs = xs8[ai][m];
#pragma unroll
                for (int bj = 0; bj < 2; ++bj) { f32x4 v0 = acc_i2f(acc[ai][bj][m][0]), v1 = acc_i2f(acc[ai][bj][m][1]);
                    v0 = v0 * xs; v1 = v1 * xs;
                    if (gate) { v0 = v0 + bv[bj][0]; v1 = v1 + bv[bj][1];
#pragma unroll
                        for (int e = 0; e < 4; ++e) { v0[e] = fast_sigmoid(v0[e]); v1[e] = fast_sigmoid(v1[e]); } }
                    u32x4 w; w.x = cvtpk(v0[0], v0[1]); w.y = cvtpk(v0[2], v0[3]); w.z = cvtpk(v1[0], v1[1]); w.w = cvtpk(v1[2], v1[3]);
                    ST_G(w, (u32x4*)(rowp + bj * 128)); }
                asm volatile("" ::: "memory"); }
        }
    }
};

typedef float f32x16 __attribute__((ext_vector_type(16)));
typedef short s16x4 __attribute__((ext_vector_type(4)));
DI int crow(int r, int hi) { return (r & 3) + 8 * (r >> 2) + 4 * hi; }
#define MFMA32(a, b, c) __builtin_amdgcn_mfma_f32_32x32x16_bf16((a), (b), (c), 0, 0, 0)
DI bf16x8 pack8(const f32x16& p, int s) {
    u32x4 w; w.x = cvtpk(p[8 * s + 0], p[8 * s + 1]); w.y = cvtpk(p[8 * s + 2], p[8 * s + 3]); w.z = cvtpk(p[8 * s + 4], p[8 * s + 5]); w.w = cvtpk(p[8 * s + 6], p[8 * s + 7]);
    return __builtin_bit_cast(bf16x8, w);
}
DI bf16x8 ldvt(const bf16_t* vp) {
    const s16x4 lo = *(const s16x4*)vp, hi4 = *(const s16x4*)(vp + 8);
    return __builtin_shufflevector(lo, hi4, 0, 1, 2, 3, 4, 5, 6, 7);
}
constexpr int DIL_TASKS = BPP * 12 * (S / 32);
constexpr int MEM_TASKS = (MP / 32) * 4;
DI void attn_dil_wave(const bf16_t* __restrict__ QK, const bf16_t* __restrict__ VT, const LAS float* btab, LAS unsigned char* ostg, bf16_t* __restrict__ OG, float* __restrict__ LSE, int task, int lane) {
    const int r32 = lane & 31, hi = lane >> 5;
    const int q32 = task & 255, gh = (task >> 8) % 12, lb = task / (256 * 12);
    const int g = gh >> 2, h = gh & 3, dl = dil_of(g), per = S / dl;
    const int tok0 = q32 * 32, r = tok0 / per, m0 = tok0 % per;
    const size_t rowq = (size_t)lb * S + (size_t)(m0 + r32) * dl + r;
    bf16x8 qf[8];
    const int tile0 = (r * per + m0) >> 5;
    { const bf16_t* qp = QK + ((size_t)((lb * 12 + gh) * 256 + tile0)) * 4096 + lane * 8;
#pragma unroll
      for (int ks = 0; ks < 8; ++ks) qf[ks] = *(const bf16x8*)(qp + ks * 512); }
    const LAS float* bt = btab + g * 129 * 4 + h;
    f32x16 o[4];
#pragma unroll
    for (int dt = 0; dt < 4; ++dt)
#pragma unroll
        for (int i = 0; i < 16; ++i) o[dt][i] = 0.f;
    float mrun = -INFINITY, sum = 0.f;
    const bf16_t* vbase = VT + ((size_t)((lb * 12 + gh) * 256 + tile0 - 4)) * 4096 + lane * 8;
    const bf16_t* kbase = QK + ((size_t)(((BPP + lb) * 12 + gh) * 256 + tile0 - 4)) * 4096 + lane * 8;
    const int kt0 = (m0 >= 128 ? 0 : (128 - m0) >> 5);
    bf16x8 kf[8], vf[8];
#pragma unroll
    for (int ks = 0; ks < 8; ++ks) kf[ks] = *(const bf16x8*)(kbase + (size_t)kt0 * 4096 + ks * 512);
#pragma unroll 1
    for (int kt = kt0; kt < 5; ++kt) {
#pragma unroll
        for (int i = 0; i < 8; ++i) vf[i] = *(const bf16x8*)(vbase + (size_t)kt * 4096 + i * 512);
        f32x16 sc;
#pragma unroll
        for (int i = 0; i < 16; ++i) sc[i] = 0.f;
#pragma unroll
        for (int ks = 0; ks < 8; ++ks) sc = MFMA32(kf[ks], qf[ks], sc);
        if (kt < 4) {
#pragma unroll
            for (int ks = 0; ks < 8; ++ks) kf[ks] = *(const bf16x8*)(kbase + (size_t)(kt + 1) * 4096 + ks * 512);
        }
        float mx = -INFINITY;
        if (kt == 0 || kt == 4) {
#pragma unroll
            for (int i = 0; i < 16; ++i) {
                const int delta = 128 - 32 * kt + r32 - crow(i, hi);
                const bool valid = (delta >= 0) && (delta <= 128);
                const int di = delta < 0 ? 0 : (delta > 128 ? 128 : delta);
                const float x = sc[i] * (QSCALE * LOG2E) + bt[di * 4];
                sc[i] = valid ? x : -INFINITY; mx = fmaxf(mx, sc[i]);
            }
        } else {
            const LAS float* btk = bt + (128 - 32 * kt + r32 - 4 * hi) * 4;
#pragma unroll
            for (int i = 0; i < 16; ++i) { sc[i] = sc[i] * (QSCALE * LOG2E) + btk[-4 * ((i & 3) + 8 * (i >> 2))]; mx = fmaxf(mx, sc[i]); }
        }
        mx = pair_max(mx);
        if (__any(mx > mrun + 8.f)) {
            const float mnew = fmaxf(mrun, mx); const float f = __builtin_amdgcn_exp2f(mrun - mnew);
            sum *= f;
#pragma unroll
            for (int dt = 0; dt < 4; ++dt)
#pragma unroll
                for (int i = 0; i < 16; ++i) o[dt][i] *= f;
            mrun = mnew;
        }
        float ps = 0.f;
#pragma unroll
        for (int i = 0; i < 16; ++i) { sc[i] = __builtin_amdgcn_exp2f(sc[i] - mrun); ps += sc[i]; }
        ps = pair_sum(ps); sum += ps;
#pragma unroll
        for (int s = 0; s < 2; ++s) {
            const bf16x8 pb = pack8(sc, s);
#pragma unroll
            for (int dt = 0; dt < 4; ++dt) o[dt] = MFMA32(vf[dt * 2 + s], pb, o[dt]);
        }
    }
    const float inv = 1.f / sum;
#pragma unroll
    for (int dt = 0; dt < 4; ++dt)
#pragma unroll
        for (int a = 0; a < 4; ++a) { u32x2 w; w.x = cvtpk(o[dt][4 * a] * inv, o[dt][4 * a + 1] * inv); w.y = cvtpk(o[dt][4 * a + 2] * inv, o[dt][4 * a + 3] * inv);
            *(LAS u32x2*)(ostg + r32 * 272 + (32 * dt + 8 * a + 4 * hi) * 2) = w; }
    asm volatile("s_waitcnt lgkmcnt(0)" ::: "memory");
#pragma unroll
    for (int it = 0; it < 8; ++it) { const int rr = 4 * it + (lane >> 4), ch = lane & 15;
        const u32x4 w = *(const LAS u32x4*)(ostg + rr * 272 + ch * 16);
        *(u32x4*)(OG + ((size_t)lb * S + (size_t)(m0 + rr) * dl + r) * 1536 + g * 512 + h * 128 + ch * 8) = w; }
    asm volatile("s_waitcnt lgkmcnt(0)" ::: "memory");
    if (hi == 0) LSE[rowq * 12 + gh] = (mrun + __builtin_amdgcn_logf(sum)) * 0.6931471805599453f;
}
DI void attn_mem_wave(const bf16_t* __restrict__ MQ, const bf16_t* __restrict__ MK, const bf16_t* __restrict__ MVT, bf16_t* __restrict__ BR, int task, int batch0, int lane) {
    const int r32 = lane & 31, hi = lane >> 5;
    const int h = task & 3, blk = task >> 2;
    const size_t rowq = (size_t)blk * 32 + r32; const int b = batch0 + blk * 32 / S;
    bf16x8 qf[8];
    { const bf16_t* qp = MQ + ((size_t)(blk * 4 + h)) * 4096 + lane * 8;
#pragma unroll
      for (int ks = 0; ks < 8; ++ks) qf[ks] = *(const bf16x8*)(qp + ks * 512); }
    f32x16 o[4];
#pragma unroll
    for (int dt = 0; dt < 4; ++dt)
#pragma unroll
        for (int i = 0; i < 16; ++i) o[dt][i] = 0.f;
    float mrun = -INFINITY, sum = 0.f;
    const bf16_t* vbase = MVT + ((size_t)((b * 4 + h) * 8)) * 4096 + lane * 8;
    const bf16_t* kbase = MK + ((size_t)((b * 4 + h) * 8)) * 4096 + lane * 8;
#pragma unroll 1
    for (int c = 0; c < 4; ++c) {
        bf16x8 vf[16];
#pragma unroll
        for (int i = 0; i < 16; ++i) vf[i] = *(const bf16x8*)(vbase + (size_t)(c * 2 + (i >> 3)) * 4096 + (i & 7) * 512);
        f32x16 sc[2]; float mx = -INFINITY;
#pragma unroll
        for (int kt = 0; kt < 2; ++kt) {
            const bf16_t* kp = kbase + (size_t)(c * 2 + kt) * 4096;
            f32x16 acc;
#pragma unroll
            for (int i = 0; i < 16; ++i) acc[i] = 0.f;
#pragma unroll
            for (int ks = 0; ks < 8; ++ks) { const bf16x8 kf = *(const bf16x8*)(kp + ks * 512); acc = MFMA32(kf, qf[ks], acc); }
#pragma unroll
            for (int i = 0; i < 16; ++i) { sc[kt][i] = acc[i] * (QSCALE * LOG2E); mx = fmaxf(mx, sc[kt][i]); }
            asm volatile("" ::: "memory");
        }
        mx = pair_max(mx);
        if (__any(mx > mrun + 8.f)) {
            const float mnew = fmaxf(mrun, mx); const float f = __builtin_amdgcn_exp2f(mrun - mnew);
            sum *= f;
#pragma unroll
            for (int dt = 0; dt < 4; ++dt)
#pragma unroll
                for (int i = 0; i < 16; ++i) o[dt][i] *= f;
            mrun = mnew;
        }
        float ps = 0.f;
#pragma unroll
        for (int kt = 0; kt < 2; ++kt)
#pragma unroll
            for (int i = 0; i < 16; ++i) { sc[kt][i] = __builtin_amdgcn_exp2f(sc[kt][i] - mrun); ps += sc[kt][i]; }
        ps = pair_sum(ps); sum += ps;
#pragma unroll
        for (int kt = 0; kt < 2; ++kt)
#pragma unroll
            for (int s = 0; s < 2; ++s) {
                const bf16x8 pb = pack8(sc[kt], s);
#pragma unroll
                for (int dt = 0; dt < 4; ++dt) o[dt] = MFMA32(vf[kt * 8 + dt * 2 + s], pb, o[dt]);
                asm volatile("" ::: "memory");
            }
    }
    const float inv = 1.f / sum;
    bf16_t* op = BR + rowq * 1536 + 1024 + h * 128 + 4 * hi;
#pragma unroll
    for (int dt = 0; dt < 4; ++dt)
#pragma unroll
        for (int a = 0; a < 4; ++a) { u32x2 w; w.x = cvtpk(o[dt][4 * a] * inv, o[dt][4 * a + 1] * inv); w.y = cvtpk(o[dt][4 * a + 2] * inv, o[dt][4 * a + 3] * inv); *(u32x2*)(op + 32 * dt + 8 * a) = w; }
}

constexpr int HG_SCH = 4, HG_UPS = S / 64 / HG_SCH  , HG_UNITS = BPP * 4 * HG_UPS  ;
constexpr int HG_ROW = 136, HG_KT_ROW = 72;
constexpr int HG_KP = 0, HG_QP = 64 * HG_ROW * 2, HG_QPP = 2 * HG_QP, HG_KPPT = 3 * HG_QP, HG_DEC = HG_KPPT + 128 * HG_KT_ROW * 2, HG_SSQ = HG_DEC + 512, HG_PSUM = HG_SSQ + 1024, HG_UNIT_BYTES = HG_PSUM + 2048;
DI bf16x8 lds_ld2x8(const LAS unsigned char* p) {
    const s16x4 lo = *(const LAS s16x4*)p, hi4 = *(const LAS s16x4*)(p + 16);
    return __builtin_shufflevector(lo, hi4, 0, 1, 2, 3, 4, 5, 6, 7);
}
DI float lds_bf(const LAS unsigned char* p) { return __uint_as_float((unsigned)(*(const LAS unsigned short*)p) << 16); }
template <bool MAIN>
DI void hgrn_unit(LAS unsigned char* ul, int unit, int u, const bf16_t* __restrict__ HFQG, const bf16_t* __restrict__ IT, const float* __restrict__ lbv, const float* __restrict__ nwv,
                  float* HSTL, float* HSTD, const float* __restrict__ SIN, bf16_t* __restrict__ BR) {
    constexpr int NX = MAIN ? 4 : 2;
    const int lane = u & 63, w = u >> 6, r32 = lane & 31, hi = lane >> 5, dvt = w & 3, wh = w >> 2;
    const int seq = unit / HG_UPS, j = unit % HG_UPS, lb = seq >> 2, h = seq & 3;
    const int dk = u & 127, qt = u >> 7, cb = 16 * qt;
    const float lbd = lbv[h * 128 + dk];
    const size_t row0 = (size_t)lb * S + (size_t)j * (64 * HG_SCH);
    LAS unsigned char* Kp = ul + HG_KP; LAS unsigned char* Qp = ul + HG_QP; LAS unsigned char* Qpp = ul + HG_QPP; LAS unsigned char* KppT = ul + HG_KPPT;
    LAS float* dec = (LAS float*)(ul + HG_DEC); LAS float* ssq = (LAS float*)(ul + HG_SSQ); LAS float* psum = (LAS float*)(ul + HG_PSUM);
    const int dk0 = MAIN ? 0 : 64 * wh;
    f32x16 X[NX];
    if (MAIN) {
        const float* Sp = SIN + (size_t)unit * 16384 + 32 * dvt + r32;
#pragma unroll
        for (int t = 0; t < NX; ++t)
#pragma unroll
            for (int i = 0; i < 16; ++i) X[t][i] = Sp[(size_t)(32 * t + crow(i, hi)) * 128];
    } else {
#pragma unroll
        for (int t = 0; t < NX; ++t)
#pragma unroll
            for (int i = 0; i < 16; ++i) X[t][i] = 0.f;
    }
    float atot = 0.f;
    u32x4 sf[2], sq[2];
    {
        const int sc0 = u >> 4, sch = (u & 15) * 8;
        const bf16_t* fp = HFQG + (row0 + sc0) * 1536 + h * 128 + sch;
#pragma unroll
        for (int i = 0; i < 2; ++i) { sf[i] = *(const u32x4*)(fp + (size_t)(32 * i) * 1536); if (MAIN) sq[i] = *(const u32x4*)(fp + (size_t)(32 * i) * 1536 + 512); }
    }
#pragma unroll 1
    for (int ch = 0; ch < HG_SCH; ++ch) {
        const size_t rc = row0 + (size_t)ch * 64;
        {
            const int sc0 = opq(u) >> 4, sch = (opq(u) & 15) * 8;
#pragma unroll
            for (int i = 0; i < 2; ++i) { *(LAS u32x4*)(Kp + ((sc0 + 32 * i) * HG_ROW + sch) * 2) = sf[i]; if (MAIN) *(LAS u32x4*)(Qp + ((sc0 + 32 * i) * HG_ROW + sch) * 2) = sq[i]; }
        }
        __syncthreads();
        const bf16_t* itrow = IT + (size_t)(h * 128 + 32 * dvt + opq(r32)) * MP;
        bf16x8 ib[4], it0[2], it1[2]; u32x2 gwv[4];
#pragma unroll
        for (int ks = 0; ks < 4; ++ks) ib[ks] = *(const bf16x8*)(itrow + rc + 16 * ks + 8 * hi);
        if (MAIN) {
#pragma unroll
            for (int step = 0; step < 2; ++step) { it0[step] = ldvt(itrow + rc + 16 * step + 4 * hi); it1[step] = ldvt(itrow + rc + 32 + 16 * step + 4 * hi); }
            const size_t grow = rc + 32 * wh + opq(r32);
#pragma unroll
            for (int a4 = 0; a4 < 4; ++a4) gwv[a4] = *(const u32x2*)(HFQG + grow * 1536 + 1024 + h * 128 + 32 * dvt + 4 * opq(hi) + 8 * a4);
        }
        float fv[16], lf[16];
        {
            float s = 0.f;
#pragma unroll
            for (int i = 0; i < 16; ++i) { fv[i] = lbd + (1.f - lbd) * fast_sigmoid(lds_bf(Kp + ((cb + i) * HG_ROW + dk) * 2)); lf[i] = __builtin_amdgcn_logf(fv[i]); s += lf[i]; }
            psum[qt * 128 + dk] = s;
        }
        __syncthreads();
        {
            const float p0 = psum[dk], p1 = psum[128 + dk], p2 = psum[256 + dk], p3 = psum[384 + dk];
            const float amid = p0 + p1, alast = (p0 + p1) + (p2 + p3);
            float run = qt == 0 ? 0.f : (qt == 1 ? p0 : (qt == 2 ? amid : amid + p2));
            atot += alast;
            const float Ela = __builtin_amdgcn_exp2f(alast - amid), Ea = __builtin_amdgcn_exp2f(amid);
#pragma unroll
            for (int c8 = 0; c8 < 2; ++c8) {
                float kt[8];
#pragma unroll
                for (int e = 0; e < 8; ++e) { const int i = 8 * c8 + e, c = cb + i; run += lf[i]; const float key = 1.f - fv[i];
                    const float e1 = __builtin_amdgcn_exp2f(amid - run);
                    const float kp = key * e1;
                    kt[e] = kp * Ela;
                    if (MAIN) { *(LAS bf16_t*)(Kp + (c * HG_ROW + dk) * 2) = (bf16_t)cvtpk(kp, kp);
                        const float qp = lds_bf(Qp + (c * HG_ROW + dk) * 2) * __builtin_amdgcn_rcpf(e1);
                        *(LAS bf16_t*)(Qp + (c * HG_ROW + dk) * 2) = (bf16_t)cvtpk(qp, qp);
                        *(LAS bf16_t*)(Qpp + (c * HG_ROW + dk) * 2) = (bf16_t)cvtpk(qp * Ea, qp * Ea); } }
                u32x4 wv; wv.x = cvtpk(kt[0], kt[1]); wv.y = cvtpk(kt[2], kt[3]); wv.z = cvtpk(kt[4], kt[5]); wv.w = cvtpk(kt[6], kt[7]);
                *(LAS u32x4*)(KppT + (dk * HG_KT_ROW + cb + 8 * c8) * 2) = wv;
            }
            if (qt == 0) dec[dk] = __builtin_amdgcn_exp2f(alast);
        }
        if (ch + 1 < HG_SCH) {
            const int sc0 = opq(u) >> 4, sch = (opq(u) & 15) * 8;
            const bf16_t* fp = HFQG + (rc + 64 + sc0) * 1536 + h * 128 + sch;
#pragma unroll
            for (int i = 0; i < 2; ++i) { sf[i] = *(const u32x4*)(fp + (size_t)(32 * i) * 1536); if (MAIN) sq[i] = *(const u32x4*)(fp + (size_t)(32 * i) * 1536 + 512); }
        }
        __syncthreads();
        f32x16 o;
        if (MAIN) {
#pragma unroll
            for (int i = 0; i < 16; ++i) o[i] = 0.f;
            const LAS unsigned char* qrow = Qpp + ((32 * wh + r32) * HG_ROW) * 2;
#pragma unroll
            for (int t = 0; t < 4; ++t)
#pragma unroll
                for (int step = 0; step < 2; ++step) { o = MFMA32(pack8(X[t], step), lds_ld2x8(qrow + (32 * t + 16 * step + 4 * hi) * 2), o); }
            __builtin_amdgcn_sched_barrier(0);
            const int r32m = opq(r32);
            const LAS unsigned char* qprow = Qp + ((32 * wh + r32) * HG_ROW) * 2;
            {
                f32x16 sc;
#pragma unroll
                for (int i = 0; i < 16; ++i) sc[i] = 0.f;
#pragma unroll
                for (int ks = 0; ks < 8; ++ks) { const int cof = (16 * ks + 8 * hi) * 2; sc = MFMA32(*(const LAS bf16x8*)(Kp + (r32 * HG_ROW) * 2 + cof), *(const LAS bf16x8*)(qprow + cof), sc); }
                if (wh == 0) {
#pragma unroll
                    for (int i = 0; i < 16; ++i) sc[i] = (crow(i, hi) <= r32m) ? sc[i] : 0.f;
                }
#pragma unroll
                for (int step = 0; step < 2; ++step) o = MFMA32(it0[step], pack8(sc, step), o);
                __builtin_amdgcn_sched_barrier(0);
            }
            if (wh == 1) {
                f32x16 sc;
#pragma unroll
                for (int i = 0; i < 16; ++i) sc[i] = 0.f;
#pragma unroll
                for (int ks = 0; ks < 8; ++ks) { const int cof = (16 * ks + 8 * hi) * 2; sc = MFMA32(*(const LAS bf16x8*)(Kp + ((32 + r32) * HG_ROW) * 2 + cof), *(const LAS bf16x8*)(qprow + cof), sc); }
#pragma unroll
                for (int i = 0; i < 16; ++i) sc[i] = (crow(i, hi) <= r32m) ? sc[i] : 0.f;
#pragma unroll
                for (int step = 0; step < 2; ++step) o = MFMA32(it1[step], pack8(sc, step), o);
                __builtin_amdgcn_sched_barrier(0);
            }
        }
        {
#pragma unroll
            for (int t = 0; t < NX; ++t) {
#pragma unroll
                for (int i = 0; i < 16; ++i) X[t][i] *= dec[dk0 + 32 * t + crow(i, hi)];
#pragma unroll
                for (int ks = 0; ks < 4; ++ks) { const bf16x8 ka = *(const LAS bf16x8*)(KppT + ((dk0 + 32 * t + r32) * HG_KT_ROW + 16 * ks + 8 * hi) * 2); X[t] = MFMA32(ka, ib[ks], X[t]); }
                __builtin_amdgcn_sched_barrier(0);
            }
        }
        if (MAIN) {
            float q2 = 0.f;
#pragma unroll
            for (int i = 0; i < 16; ++i) q2 += o[i] * o[i];
            q2 = pair_sum(q2); if (hi == 0) ssq[dvt * 64 + 32 * wh + r32] = q2;
        }
        __syncthreads();
        if (MAIN) {
            const int r32o = opq(r32), hio = opq(hi);
            const int c = 32 * wh + r32o; const float tot = ssq[c] + ssq[64 + c] + ssq[128 + c] + ssq[192 + c];
            const float rs = rsqrtf(tot * (1.f / 128.f) + LN_EPS);
            const size_t row = rc + c; const int col = h * 128 + 32 * dvt + 4 * hio;
#pragma unroll
            for (int a4 = 0; a4 < 4; ++a4) {
                const u32x2 gw = gwv[a4]; const f32x4 nw4 = *(const f32x4*)(nwv + col + 8 * a4);
                const float g0 = __uint_as_float(gw.x << 16), g1 = __uint_as_float(gw.x & 0xffff0000u), g2 = __uint_as_float(gw.y << 16), g3 = __uint_as_float(gw.y & 0xffff0000u);
                const float v0 = o[4 * a4] * rs * nw4[0] * g0 * fast_sigmoid(g0), v1 = o[4 * a4 + 1] * rs * nw4[1] * g1 * fast_sigmoid(g1);
                const float v2 = o[4 * a4 + 2] * rs * nw4[2] * g2 * fast_sigmoid(g2), v3 = o[4 * a4 + 3] * rs * nw4[3] * g3 * fast_sigmoid(g3);
                u32x2 wv; wv.x = cvtpk(v0, v1); wv.y = cvtpk(v2, v3);
                *(u32x2*)(BR + row * 1536 + 512 + col + 8 * a4) = wv;
            }
        }
    }
    if (!MAIN) {
        float* L = HSTL + (size_t)unit * 16384 + 32 * dvt + r32;
#pragma unroll
        for (int t = 0; t < NX; ++t)
#pragma unroll
            for (int i = 0; i < 16; ++i) L[(size_t)(dk0 + 32 * t + crow(i, hi)) * 128] = X[t][i];
        if (qt == 0) HSTD[(size_t)unit * 128 + dk] = __builtin_amdgcn_exp2f(atot);
    }
}
DI void hgrn_scan(const float* __restrict__ HSTL, const float* __restrict__ HSTD, float* __restrict__ SIN, int gt) {
    if (gt >= BPP * 4 * 16384) return;
    const int seq = gt >> 14, el = gt & 16383, dkk = el >> 7;
    float st = 0.f;
    for (int j = 0; j < HG_UPS; ++j) { const size_t uo = (size_t)(seq * HG_UPS + j); SIN[uo * 16384 + el] = st; st = HSTD[uo * 128 + dkk] * st + HSTL[uo * 16384 + el]; }
}

struct SchedRows {
    unsigned A, B; int K, nN, nU, G, c;
    DI bool next(int i, g8::Unit& u) const {
        const int L = i * G + c; if (L >= nU) return false;
        const int x = L & 7, off = L >> 3, grp = off / (8 * nN), o2 = off % (8 * nN);
        const int ppx = nU / nN / 8;
        u.pm = x * ppx + 8 * grp + (o2 & 7); u.pn = o2 >> 3; u.kind = 0; u.dla = 1; u.dlb = 1;
        u.a = A + (unsigned)u.pm * 256u * K * 2u; u.b = B + (unsigned)u.pn * 256u * K * 2u; return true;
    }
};
DI void unpack8(const u32x4 w, float (&f)[8]) {
    f[0] = __uint_as_float(w.x << 16); f[1] = __uint_as_float(w.x & 0xffff0000u); f[2] = __uint_as_float(w.y << 16); f[3] = __uint_as_float(w.y & 0xffff0000u);
    f[4] = __uint_as_float(w.z << 16); f[5] = __uint_as_float(w.z & 0xffff0000u); f[6] = __uint_as_float(w.w << 16); f[7] = __uint_as_float(w.w & 0xffff0000u);
}
struct EpiWidenF {
    static constexpr bool PERM = true, HOOK = true;
    const bf16_t* GATE; bf16_t* MERGED;
    DI void hook(f32x4 (&acc)[2][2][4][2], const g8::Unit& u, int t, int wr, int wc, int fr, int fq) const {
        if (t != 8 && t != 16) return;
        const int g = (t >> 3) - 1;
        const int row0 = u.pm * 256 + wr * 64 + fr, col0 = u.pn * 256 + wc * 32 + 8 * fq;
#pragma unroll
        for (int ai = 0; ai < 2; ++ai)
#pragma unroll
            for (int m = 0; m < 4; ++m) { const bf16_t* gp = GATE + (size_t)(row0 + ai * 128 + m * 16) * 3072 + g * 1024 + col0;
#pragma unroll
                for (int bj = 0; bj < 2; ++bj) { float ga[8], gb[8]; unpack8(*(const u32x4*)(gp + bj * 128), ga); unpack8(*(const u32x4*)(gp + 1024 + bj * 128), gb);
#pragma unroll
                    for (int e = 0; e < 4; ++e) { acc[ai][bj][m][0][e] *= ga[e] * __builtin_amdgcn_rcpf(gb[e]); acc[ai][bj][m][1][e] *= ga[4 + e] * __builtin_amdgcn_rcpf(gb[4 + e]); } } }
    }
    DI void operator()(const f32x4 (&acc)[2][2][4][2], const g8::Unit& u, int wr, int wc, int fr, int fq) const {
        const int row0 = u.pm * 256 + wr * 64 + fr, col0 = u.pn * 256 + wc * 32 + 8 * fq;
#pragma unroll
        for (int ai = 0; ai < 2; ++ai)
#pragma unroll
            for (int m = 0; m < 4; ++m) { const size_t row = (size_t)(row0 + ai * 128 + m * 16);
#pragma unroll
                for (int bj = 0; bj < 2; ++bj) { float gc[8]; unpack8(*(const u32x4*)(GATE + row * 3072 + 2048 + col0 + bj * 128), gc);
                    const f32x4 v0 = acc[ai][bj][m][0], v1 = acc[ai][bj][m][1];
                    u32x4 w; w.x = cvtpk(v0[0] * gc[0], v0[1] * gc[1]); w.y = cvtpk(v0[2] * gc[2], v0[3] * gc[3]); w.z = cvtpk(v1[0] * gc[4], v1[1] * gc[5]); w.w = cvtpk(v1[2] * gc[6], v1[3] * gc[7]);
                    *(u32x4*)(MERGED + row * 1024 + col0 + bj * 128) = w; } }
    }
};
struct EpiScores {
    static constexpr bool PERM = true, HOOK = false;
    bf16_t* SC; const float* hsc; const float* wsc;
    DI void hook(f32x4 (&)[2][2][4][2], const g8::Unit&, int, int, int, int, int) const {}
    DI void operator()(const f32x4 (&acc)[2][2][4][2], const g8::Unit& u, int wr, int wc, int fr, int fq) const {
        const int rowl = wr * 64 + fr, d0 = wc * 32 + 8 * fq;
        float xs8[2][4];
        { const float* xr = hsc + u.pm * 256 + rowl; const float wsg = wsc[0];
#pragma unroll
          for (int ai = 0; ai < 2; ++ai)
#pragma unroll
              for (int m = 0; m < 4; ++m) xs8[ai][m] = xr[ai * 128 + m * 16];
#pragma unroll
          for (int ai = 0; ai < 2; ++ai)
#pragma unroll
              for (int m = 0; m < 4; ++m) xs8[ai][m] *= wsg; }
#pragma unroll
        for (int ai = 0; ai < 2; ++ai)
#pragma unroll
            for (int m = 0; m < 4; ++m) { const int row = u.pm * 256 + rowl + ai * 128 + m * 16;
#pragma unroll
                for (int bj = 0; bj < 2; ++bj) { const f32x4 v0 = acc_i2f(acc[ai][bj][m][0]) * xs8[ai][m], v1 = acc_i2f(acc[ai][bj][m][1]) * xs8[ai][m];
                    u32x4 w; w.x = cvtpk(v0[0], v0[1]); w.y = cvtpk(v0[2], v0[3]); w.z = cvtpk(v1[0], v1[1]); w.w = cvtpk(v1[2], v1[3]);
                    *(u32x4*)(SC + ((size_t)((row >> 5) * 16 + u.pn * 2 + bj)) * 4096 + frag_row_off(d0, row & 31)) = w; } }
    }
};
struct EpiPlainB16 {
    static constexpr bool PERM = true, HOOK = false;
    bf16_t* C; int ldc, pad;
    DI void hook(f32x4 (&)[2][2][4][2], const g8::Unit&, int, int, int, int, int) const {}
    DI void operator()(const f32x4 (&acc)[2][2][4][2], const g8::Unit& u, int wr, int wc, int fr, int fq) const {
        const int row0 = u.pm * 256 + wr * 64 + fr, col0 = u.pn * 256 + wc * 32 + 8 * fq;
#pragma unroll
        for (int ai = 0; ai < 2; ++ai)
#pragma unroll
            for (int m = 0; m < 4; ++m) { bf16_t* rowp = C + (size_t)(row0 + ai * 128 + m * 16) * ldc + col0;
#pragma unroll
                for (int bj = 0; bj < 2; ++bj) { const f32x4 v0 = acc[ai][bj][m][0], v1 = acc[ai][bj][m][1];
                    u32x4 w; w.x = cvtpk(v0[0], v0[1]); w.y = cvtpk(v0[2], v0[3]); w.z = cvtpk(v1[0], v1[1]); w.w = cvtpk(v1[2], v1[3]);
                    *(u32x4*)(rowp + bj * 128) = w; } }
    }
};
DI void lse_merge_items(const bf16_t* __restrict__ OG, const float* __restrict__ LSE, bf16_t* __restrict__ BR, int first, int stride) {
    for (int it0 = first; it0 < MP * 64; it0 += 4 * stride) {
        u32x4 va[4], vb[4], vc[4]; float l0[4], l1[4], l2[4];
#pragma unroll
        for (int u = 0; u < 4; ++u) { const int it = it0 + u * stride; const int row = it >> 6, c8 = it & 63, h = c8 >> 4;
            const bf16_t* og = OG + (size_t)row * 1536 + c8 * 8;
            va[u] = *(const u32x4*)og; vb[u] = *(const u32x4*)(og + 512); vc[u] = *(const u32x4*)(og + 1024);
            l0[u] = LSE[(size_t)row * 12 + h]; l1[u] = LSE[(size_t)row * 12 + 4 + h]; l2[u] = LSE[(size_t)row * 12 + 8 + h]; }
#pragma unroll
        for (int u = 0; u < 4; ++u) { const int it = it0 + u * stride; const int row = it >> 6, c8 = it & 63;
            const float mx = fmaxf(l0[u], fmaxf(l1[u], l2[u])); const float e0 = __expf(l0[u] - mx), e1 = __expf(l1[u] - mx), e2 = __expf(l2[u] - mx); const float inv = 1.f / (e0 + e1 + e2);
            float a[8], b[8], c[8]; unpack8(va[u], a); unpack8(vb[u], b); unpack8(vc[u], c);
            float r[8];
#pragma unroll
            for (int e = 0; e < 8; ++e) r[e] = (e0 * a[e] + e1 * b[e] + e2 * c[e]) * inv;
            u32x4 w; w.x = cvtpk(r[0], r[1]); w.y = cvtpk(r[2], r[3]); w.z = cvtpk(r[4], r[5]); w.w = cvtpk(r[6], r[7]);
            *(u32x4*)(BR + (size_t)row * 1536 + c8 * 8) = w; }
    }
}
template <int NR>
DI void ln1_rows(const bf16_t* __restrict__ x, const bf16_t* __restrict__ mix, const float* __restrict__ g, const float* __restrict__ b, bf16_t* __restrict__ h1b, unsigned char* __restrict__ h1q, float* __restrict__ hsc, int wave0, int nwaves, int lane) {
    for (int row0 = wave0 * NR; row0 < MP; row0 += nwaves * NR) {
        u32x4 xa[NR], xb[NR], ma[NR], mb[NR];
#pragma unroll
        for (int r = 0; r < NR; ++r) { const size_t o = (size_t)(row0 + r) * D + 16 * lane;
            xa[r] = *(const u32x4*)(x + o); xb[r] = *(const u32x4*)(x + o + 8); ma[r] = *(const u32x4*)(mix + o); mb[r] = *(const u32x4*)(mix + o + 8); }
#pragma unroll
        for (int r = 0; r < NR; ++r) {
            const int row = row0 + r;
            float xf[16], mf[16]; unpack8(xa[r], *(float(*)[8])&xf[0]); unpack8(xb[r], *(float(*)[8])&xf[8]); unpack8(ma[r], *(float(*)[8])&mf[0]); unpack8(mb[r], *(float(*)[8])&mf[8]);
            f32x4 v[4]; float s = 0.f;
#pragma unroll
            for (int j = 0; j < 4; ++j) {
#pragma unroll
                for (int e = 0; e < 4; ++e) { v[j][e] = xf[4 * j + e] * ALPHA + mf[4 * j + e]; s += v[j][e]; } }
            const float mean = wave_sum(s) * (1.f / D); float q = 0.f;
#pragma unroll
            for (int j = 0; j < 4; ++j) { v[j] = v[j] - mean; q += (v[j][0] * v[j][0] + v[j][1] * v[j][1]) + (v[j][2] * v[j][2] + v[j][3] * v[j][3]); }
            const float rstd = rsqrtf(wave_sum(q) * (1.f / D) + LN_EPS);
            u32x4 o0, o1; float amax = 0.f;
#pragma unroll
            for (int j = 0; j < 4; ++j) { const f32x4 gg = *(const f32x4*)(g + 16 * lane + 4 * j), bb = *(const f32x4*)(b + 16 * lane + 4 * j); const f32x4 o = v[j] * rstd * gg + bb; v[j] = o;
                amax = fmaxf(amax, fmaxf(fmaxf(fabsf(o[0]), fabsf(o[1])), fmaxf(fabsf(o[2]), fabsf(o[3]))));
                if (j < 2) { o0[2 * j] = cvtpk(o[0], o[1]); o0[2 * j + 1] = cvtpk(o[2], o[3]); } else { o1[2 * (j - 2)] = cvtpk(o[0], o[1]); o1[2 * (j - 2) + 1] = cvtpk(o[2], o[3]); } }
            *(u32x4*)(h1b + (size_t)row * D + 16 * lane) = o0; *(u32x4*)(h1b + (size_t)row * D + 16 * lane + 8) = o1;
            amax = wave_max(amax); const float qs = amax > 0.f ? 127.f / amax : 1.f;
            u32x4 qv;
#pragma unroll
            for (int j = 0; j < 4; ++j) qv[j] = ((unsigned)__float2int_rn(v[j][0] * qs) & 0xffu) | (((unsigned)__float2int_rn(v[j][1] * qs) & 0xffu) << 8) | (((unsigned)__float2int_rn(v[j][2] * qs) & 0xffu) << 16) | (((unsigned)__float2int_rn(v[j][3] * qs) & 0xffu) << 24);
            *(u32x4*)(h1q + (size_t)row * D + 16 * lane) = qv;
            if (lane == 0) hsc[row] = amax > 0.f ? amax * (1.f / 127.f) : 1.f;
        }
    }
}

DI unsigned mono(float f) { const unsigned u = __float_as_uint(f); return (u & 0x80000000u) ? ~u : (u | 0x80000000u); }
DI float demono(unsigned m) { return __uint_as_float((m & 0x80000000u) ? (m & 0x7fffffffu) : ~m); }
#define CE_DESC(a, b) do { const unsigned _hi = (a) > (b) ? (a) : (b), _lo = (a) > (b) ? (b) : (a); (a) = _hi; (b) = _lo; } while (0)
DI void sort16_desc(unsigned (&k)[16]) {
#pragma unroll
    for (int size = 2; size <= 16; size <<= 1)
#pragma unroll
        for (int stride = size >> 1; stride > 0; stride >>= 1)
#pragma unroll
            for (int i = 0; i < 16; ++i) { const int j = i ^ stride;
                if (j > i) { if ((i & size) == 0 || size == 16) CE_DESC(k[i], k[j]); else CE_DESC(k[j], k[i]); } }
}
DI void merge_top16(unsigned (&t)[16], const unsigned (&l)[16]) {
#pragma unroll
    for (int i = 0; i < 16; ++i) t[i] = t[i] > l[15 - i] ? t[i] : l[15 - i];
#pragma unroll
    for (int stride = 8; stride > 0; stride >>= 1)
#pragma unroll
        for (int i = 0; i < 16; ++i) { const int j = i ^ stride; if (j > i) CE_DESC(t[i], t[j]); }
}
DI void route_wave(const bf16_t* __restrict__ SC, int* __restrict__ IDX, float* __restrict__ PG, int tb, int h, int lane) {
    const int r32 = lane & 31, hi = lane >> 5;
    const size_t tok = (size_t)tb * 32 + r32;
    unsigned Tp[2][16];
#pragma unroll
    for (int p = 0; p < 2; ++p) {
        const bf16_t* sp = SC + ((size_t)(tb * 16 + h * 2 + p)) * 4096 + lane * 8;
        u32x4 sv[8];
#pragma unroll
        for (int ks = 0; ks < 8; ++ks) sv[ks] = *(const u32x4*)(sp + ks * 512);
#pragma unroll
        for (int nt = 0; nt < 4; ++nt) {
            unsigned L[16];
#pragma unroll
            for (int e = 0; e < 16; ++e) { const int ks = 2 * nt + (e >> 3), j = e & 7; const unsigned w = sv[ks][j >> 1];
                const float sc = __uint_as_float((j & 1) ? (w & 0xffff0000u) : (w << 16));
                L[e] = (mono(sc) & ~0x7fu) | (unsigned)(127 - (16 * ks + 8 * hi + j)); }
            sort16_desc(L);
            if (nt == 0) {
#pragma unroll
                for (int i = 0; i < 16; ++i) Tp[p][i] = L[i];
            } else merge_top16(Tp[p], L);
            __builtin_amdgcn_sched_barrier(0);
        }
    }
    unsigned T[16];
    { unsigned O[16];
#pragma unroll
      for (int i = 0; i < 16; ++i) { const auto rr = __builtin_amdgcn_permlane32_swap(Tp[0][i], Tp[1][i], false, false); T[i] = rr[0]; O[i] = rr[1]; }
      merge_top16(T, O); }
    __builtin_amdgcn_sched_barrier(0);
    float s1[16], s2[16]; unsigned i1[16], i2[16];
#pragma unroll
    for (int i = 0; i < 16; ++i) { const auto rr = __builtin_amdgcn_permlane32_swap(T[i], T[i], false, false);
        s1[i] = demono(rr[0] & ~0x7fu); i1[i] = 127u - (rr[0] & 0x7fu); s2[i] = demono(rr[1] & ~0x7fu); i2[i] = 127u - (rr[1] & 0x7fu); }
    unsigned C[64];
    { int n = 0;
#pragma unroll
      for (int a = 0; a < 16; ++a)
#pragma unroll
          for (int b = 0; b < 16; ++b) if ((a + 1) * (b + 1) <= 16) { C[n] = (mono(s1[a] + s2[b]) & ~0x3fffu) | (i1[a] << 7) | i2[b]; ++n; }
#pragma unroll
      for (int i = 50; i < 64; ++i) C[i] = 0u; }
    unsigned F[16];
#pragma unroll
    for (int i = 0; i < 16; ++i) F[i] = C[i];
    sort16_desc(F);
#pragma unroll
    for (int g = 1; g < 4; ++g) { unsigned L[16];
#pragma unroll
        for (int i = 0; i < 16; ++i) L[i] = C[16 * g + i];
        sort16_desc(L); merge_top16(F, L); __builtin_amdgcn_sched_barrier(0); }
    if (hi == 0) {
        float e[16]; float sum = 0.f; const float v0 = demono(F[0] & ~0x3fffu);
#pragma unroll
        for (int i = 0; i < 16; ++i) { e[i] = __expf(demono(F[i] & ~0x3fffu) - v0); sum += e[i]; }
        const float inv = 1.f / sum;
        int* ip = IDX + tok * 128 + h * 16; float* gp = PG + tok * 128 + h * 16;
#pragma unroll
        for (int q = 0; q < 4; ++q) { u32x4 iv; iv.x = F[4 * q] & 0x3fffu; iv.y = F[4 * q + 1] & 0x3fffu; iv.z = F[4 * q + 2] & 0x3fffu; iv.w = F[4 * q + 3] & 0x3fffu; *(u32x4*)(ip + 4 * q) = iv;
            f32x4 gv; gv[0] = e[4 * q] * inv; gv[1] = e[4 * q + 1] * inv; gv[2] = e[4 * q + 2] * inv; gv[3] = e[4 * q + 3] * inv; *(f32x4*)(gp + 4 * q) = gv; }
    }
}
typedef __bf16 bf16x2v __attribute__((ext_vector_type(2)));
DI float dot2bf(unsigned w, unsigned x, float acc) { return __builtin_amdgcn_fdot2_f32_bf16(__builtin_bit_cast(bf16x2v, w), __builtin_bit_cast(bf16x2v, x), acc, false); }
DI float gelu_erf(float v) {
    const float av = fabsf(v), t = __builtin_amdgcn_rcpf(av * 0.2316418882f + 1.0f);
    float q = t * 0.5307027145f + (-0.7265760135f); q = q * t + 0.7107068705f; q = q * t + (-0.142248368f); q = q * t + 0.127414796f; q = q * t;
    const float e = __builtin_amdgcn_exp2f((v * v) * (-0.72134752044f)); const float m = v * (q * e);
    return v < 0.f ? m : v - m;
}
DI float dppf(float v, const int ctrl_sel) {
    const int s = __float_as_int(v);
    int r;
    if (ctrl_sel == 0) r = __builtin_amdgcn_update_dpp(0, s, 0xB1, 0xF, 0xF, true);
    else if (ctrl_sel == 1) r = __builtin_amdgcn_update_dpp(0, s, 0x4E, 0xF, 0xF, true);
    else if (ctrl_sel == 2) r = __builtin_amdgcn_update_dpp(0, s, 0x141, 0xF, 0xF, true);
    else r = __builtin_amdgcn_update_dpp(0, s, 0x128, 0xF, 0xF, true);
    return __int_as_float(r);
}
DI int dppi(int s, const int ctrl_sel) {
    if (ctrl_sel == 0) return __builtin_amdgcn_update_dpp(0, s, 0xB1, 0xF, 0xF, true);
    if (ctrl_sel == 1) return __builtin_amdgcn_update_dpp(0, s, 0x4E, 0xF, 0xF, true);
    return __builtin_amdgcn_update_dpp(0, s, 0x141, 0xF, 0xF, true);
}
template <int NT>
DI void experts_u_slice(const unsigned char* __restrict__ H1Q, const unsigned char* __restrict__ U8x, const int* __restrict__ IDX, bf16_t* __restrict__ PD, size_t tok0, int ntok, int x, int lane) {
    const int g = lane >> 3, l8 = lane & 7;
    u32x4 hq[NT], iv[NT][4];
#pragma unroll
    for (int t = 0; t < NT; ++t) { hq[t] = *(const u32x4*)(H1Q + (tok0 + t) * D + 128 * x + 16 * l8);
#pragma unroll
        for (int q = 0; q < 4; ++q) iv[t][q] = *(const u32x4*)(IDX + (tok0 + t) * 128 + 16 * g + 4 * q); }
#pragma unroll 1
    for (int i = 0; i < ntok; i += NT) {
        const size_t tok = tok0 + i;
        u32x4 w[NT][16], hc[NT];
#pragma unroll
        for (int t = 0; t < NT; ++t) { hc[t] = hq[t];
#pragma unroll
            for (int j = 0; j < 16; ++j) w[t][j] = *(const u32x4*)(U8x + (size_t)(iv[t][j >> 2][j & 3] * 128u + 16u * l8)); }
        if (i + NT < ntok) {
#pragma unroll
            for (int t = 0; t < NT; ++t) { hq[t] = *(const u32x4*)(H1Q + (tok + NT + t) * D + 128 * x + 16 * l8);
#pragma unroll
                for (int q = 0; q < 4; ++q) iv[t][q] = *(const u32x4*)(IDX + (tok + NT + t) * 128 + 16 * g + 4 * q); }
        }
#pragma unroll
        for (int t = 0; t < NT; ++t) {
            float p[16];
#pragma unroll
            for (int j = 0; j < 16; ++j) { int d = 0;
#pragma unroll
                for (int q = 0; q < 4; ++q) d = __builtin_amdgcn_sdot4((int)w[t][j][q], (int)hc[t][q], d, false);
                d += dppi(d, 0); d += dppi(d, 1); d += dppi(d, 2); p[j] = (float)d; }
            if (l8 == 0) {
                u32x4 o0, o1;
                o0.x = cvtpk(p[0], p[1]); o0.y = cvtpk(p[2], p[3]); o0.z = cvtpk(p[4], p[5]); o0.w = cvtpk(p[6], p[7]);
                o1.x = cvtpk(p[8], p[9]); o1.y = cvtpk(p[10], p[11]); o1.z = cvtpk(p[12], p[13]); o1.w = cvtpk(p[14], p[15]);
                bf16_t* dp = PD + ((tok + t) * 8 + x) * 128 + 16 * g; *(u32x4*)dp = o0; *(u32x4*)(dp + 8) = o1;
            }
        }
    }
}
DI void experts_combine(const bf16_t* __restrict__ PD, const int* __restrict__ IDX, const float* __restrict__ PG, const float* __restrict__ USC, const float* __restrict__ VSC, const float* __restrict__ HSC,
                        unsigned char* __restrict__ C8, float* __restrict__ CSC, int wave0, int nwaves, int lane) {
    for (int tokb = wave0 * 2; tokb < M; tokb += nwaves * 2) {
        unsigned pw[2][8]; u32x2 rows[2]; f32x2 gt[2]; float hs[2];
#pragma unroll
        for (int r = 0; r < 2; ++r) { const size_t tok = (size_t)tokb + r;
#pragma unroll
            for (int x = 0; x < 8; ++x) pw[r][x] = *(const unsigned*)(PD + (tok * 8 + x) * 128 + 2 * lane);
            rows[r] = *(const u32x2*)(IDX + tok * 128 + 2 * lane); gt[r] = *(const f32x2*)(PG + tok * 128 + 2 * lane); hs[r] = HSC[tok]; }
#pragma unroll
        for (int r = 0; r < 2; ++r) { const size_t tok = (size_t)tokb + r;
            float s0 = 0.f, s1 = 0.f;
#pragma unroll
            for (int x = 0; x < 8; ++x) { s0 += __uint_as_float(pw[r][x] << 16); s1 += __uint_as_float(pw[r][x] & 0xffff0000u); }
            const float c0 = gt[r][0] * gelu_erf(s0 * USC[rows[r].x] * hs[r]) * VSC[rows[r].x], c1 = gt[r][1] * gelu_erf(s1 * USC[rows[r].y] * hs[r]) * VSC[rows[r].y];
            const float amax = wave_max(fmaxf(fabsf(c0), fabsf(c1)));
            const float qs = amax > 0.f ? 127.f / amax : 1.f;
            const unsigned short q2 = (unsigned short)(((unsigned)__float2int_rn(c0 * qs) & 0xffu) | (((unsigned)__float2int_rn(c1 * qs) & 0xffu) << 8));
            *(unsigned short*)(C8 + tok * 128 + 2 * lane) = q2;
            if (lane == 0) CSC[tok] = amax > 0.f ? amax * (1.f / 127.f) : 1.f;
        }
    }
}
template <int NT>
DI void experts_v_slice(const unsigned char* __restrict__ V8x, const int* __restrict__ IDX, const unsigned char* __restrict__ C8, const float* __restrict__ CSC, bf16_t* __restrict__ FFN, size_t tok0, int ntok, int x, int lane) {
    const int g = lane >> 3, l8 = lane & 7;
    u32x4 iv[NT][4], cqn[NT]; float csn[NT];
#pragma unroll
    for (int t = 0; t < NT; ++t) { cqn[t] = *(const u32x4*)(C8 + (tok0 + t) * 128 + 16 * g); csn[t] = CSC[tok0 + t];
#pragma unroll
        for (int q = 0; q < 4; ++q) iv[t][q] = *(const u32x4*)(IDX + (tok0 + t) * 128 + 16 * g + 4 * q); }
#pragma unroll 1
    for (int i = 0; i < ntok; i += NT) {
        const size_t tok = tok0 + i;
        u32x4 w[NT][16], cq[NT]; float csc[NT];
#pragma unroll
        for (int t = 0; t < NT; ++t) { cq[t] = cqn[t]; csc[t] = csn[t];
#pragma unroll
            for (int j = 0; j < 16; ++j) w[t][j] = *(const u32x4*)(V8x + (size_t)(iv[t][j >> 2][j & 3] * 128u + 16u * l8)); }
        if (i + NT < ntok) {
#pragma unroll
            for (int t = 0; t < NT; ++t) { cqn[t] = *(const u32x4*)(C8 + (tok + NT + t) * 128 + 16 * g); csn[t] = CSC[tok + NT + t];
#pragma unroll
                for (int q = 0; q < 4; ++q) iv[t][q] = *(const u32x4*)(IDX + (tok + NT + t) * 128 + 16 * g + 4 * q); }
        }
#pragma unroll
        for (int t = 0; t < NT; ++t) {
            int acc[16];
#pragma unroll
            for (int k = 0; k < 16; ++k) acc[k] = 0;
#pragma unroll
            for (int jj = 0; jj < 4; ++jj) {
                const int cdw = (int)cq[t][jj];
#pragma unroll
                for (int q = 0; q < 4; ++q) {
                    const unsigned r0 = w[t][4 * jj][q], r1 = w[t][4 * jj + 1][q], r2 = w[t][4 * jj + 2][q], r3 = w[t][4 * jj + 3][q];
                    const unsigned lo01 = __builtin_amdgcn_perm(r1, r0, 0x05010400u), hi01 = __builtin_amdgcn_perm(r1, r0, 0x07030602u);
                    const unsigned lo23 = __builtin_amdgcn_perm(r3, r2, 0x05010400u), hi23 = __builtin_amdgcn_perm(r3, r2, 0x07030602u);
                    acc[4 * q + 0] = __builtin_amdgcn_sdot4((int)__builtin_amdgcn_perm(lo23, lo01, 0x05040100u), cdw, acc[4 * q + 0], false);
                    acc[4 * q + 1] = __builtin_amdgcn_sdot4((int)__builtin_amdgcn_perm(lo23, lo01, 0x07060302u), cdw, acc[4 * q + 1], false);
                    acc[4 * q + 2] = __builtin_amdgcn_sdot4((int)__builtin_amdgcn_perm(hi23, hi01, 0x05040100u), cdw, acc[4 * q + 2], false);
                    acc[4 * q + 3] = __builtin_amdgcn_sdot4((int)__builtin_amdgcn_perm(hi23, hi01, 0x07060302u), cdw, acc[4 * q + 3], false);
                }
            }
            const float cs = csc[t];
#pragma unroll
            for (int k = 0; k < 8; ++k) { const auto rr = __builtin_amdgcn_permlane32_swap((unsigned)acc[k], (unsigned)acc[k + 8], false, false); acc[k] = (int)rr[0] + (int)rr[1]; }
#pragma unroll
            for (int k = 0; k < 4; ++k) { const auto rr = __builtin_amdgcn_permlane16_swap((unsigned)acc[k], (unsigned)acc[k + 4], false, false); acc[k] = (int)rr[0] + (int)rr[1]; }
            { const bool up = (lane & 8) != 0;
#pragma unroll
              for (int k = 0; k < 2; ++k) { const int send = up ? acc[k] : acc[k + 2], keep = up ? acc[k + 2] : acc[k]; acc[k] = keep + __builtin_amdgcn_update_dpp(0, send, 0x128, 0xF, 0xF, true); } }
            *(unsigned*)(FFN + (tok + t) * D + 128 * x + 16 * l8 + 2 * g) = cvtpk((float)acc[0] * cs, (float)acc[1] * cs);
        }
    }
}
template <int NR>
DI void ln2_tokens(const bf16_t* __restrict__ FFN, const bf16_t* __restrict__ H1B, const float* __restrict__ g2, const float* __restrict__ b2, float* __restrict__ outp, size_t tok0, int lane) {
    u32x4 fa[NR], fb[NR], ha[NR], hb[NR];
#pragma unroll
    for (int r = 0; r < NR; ++r) { const size_t o = (tok0 + r) * D + 16 * lane;
        fa[r] = *(const u32x4*)(FFN + o); fb[r] = *(const u32x4*)(FFN + o + 8); ha[r] = *(const u32x4*)(H1B + o); hb[r] = *(const u32x4*)(H1B + o + 8); }
#pragma unroll
    for (int r = 0; r < NR; ++r) {
        float* hr = outp + (tok0 + r) * D + 16 * lane;
        float ff[16], hh[16]; unpack8(fa[r], *(float(*)[8])&ff[0]); unpack8(fb[r], *(float(*)[8])&ff[8]); unpack8(ha[r], *(float(*)[8])&hh[0]); unpack8(hb[r], *(float(*)[8])&hh[8]);
        f32x4 v[4]; float s = 0.f;
#pragma unroll
        for (int j = 0; j < 4; ++j)
#pragma unroll
            for (int e = 0; e < 4; ++e) { v[j][e] = hh[4 * j + e] * ALPHA + ff[4 * j + e]; s += v[j][e]; }
        const float mean = wave_sum(s) * (1.f / D); float q2 = 0.f;
#pragma unroll
        for (int j = 0; j < 4; ++j)
#pragma unroll
            for (int e = 0; e < 4; ++e) { v[j][e] -= mean; q2 += v[j][e] * v[j][e]; }
        const float rstd = rsqrtf(wave_sum(q2) * (1.f / D) + LN_EPS);
#pragma unroll
        for (int j = 0; j < 4; ++j) { const f32x4 gg = *(const f32x4*)(g2 + 16 * lane + 4 * j), bb = *(const f32x4*)(b2 + 16 * lane + 4 * j); *(f32x4*)(hr + 4 * j) = v[j] * rstd * gg + bb; }
    }
}

DI void p0_convert(const float* __restrict__ in, bf16_t* __restrict__ out, size_t n8, size_t first, size_t stride) {
    for (size_t i = first; i < n8; i += stride) { const f32x4 a = ((const f32x4*)in)[2 * i], b = ((const f32x4*)in)[2 * i + 1];
        u32x4 w; w.x = cvtpk(a[0], a[1]); w.y = cvtpk(a[2], a[3]); w.z = cvtpk(b[0], b[1]); w.w = cvtpk(b[2], b[3]); ((u32x4*)out)[i] = w; }
}
DI void p0_transpose_item(const float* __restrict__ W, int ldw, int ncols, bf16_t* __restrict__ out, int ldo, int koff, LAS float* scr, int item, int lane) {
    const int nblk = ncols / 32, kb = item / nblk, nb = item % nblk, k0 = 64 * kb, n0 = 32 * nb;
#pragma unroll 8
    for (int i = 0; i < 32; ++i) { const int kk = 2 * i + (lane >> 5); scr[kk * 33 + (lane & 31)] = W[(size_t)(k0 + kk) * ldw + n0 + (lane & 31)]; }
    asm volatile("s_waitcnt lgkmcnt(0)" ::: "memory");
    const int c = lane & 7;
#pragma unroll
    for (int j = 0; j < 4; ++j) { const int n = (lane >> 3) + 8 * j; const LAS float* s = scr + (8 * c) * 33 + n;
        u32x4 o; o.x = cvtpk(s[0 * 33], s[1 * 33]); o.y = cvtpk(s[2 * 33], s[3 * 33]); o.z = cvtpk(s[4 * 33], s[5 * 33]); o.w = cvtpk(s[6 * 33], s[7 * 33]);
        *(u32x4*)(out + (size_t)(n0 + n) * ldo + koff + k0 + 8 * c) = o; }
    asm volatile("s_waitcnt lgkmcnt(0)" ::: "memory");
}
template <int NR>
DI void p0_q8_rows(const float* __restrict__ src, unsigned char* __restrict__ dst, float* __restrict__ scale, int row0, int lane) {
    f32x4 v[NR][4];
#pragma unroll
    for (int r = 0; r < NR; ++r) { const f32x4* sp = (const f32x4*)(src + (size_t)(row0 + r) * D) + 4 * lane;
#pragma unroll
        for (int j = 0; j < 4; ++j) v[r][j] = sp[j]; }
#pragma unroll
    for (int r = 0; r < NR; ++r) {
        float mx = 0.f;
#pragma unroll
        for (int j = 0; j < 4; ++j) mx = fmaxf(mx, fmaxf(fmaxf(fabsf(v[r][j][0]), fabsf(v[r][j][1])), fmaxf(fabsf(v[r][j][2]), fabsf(v[r][j][3]))));
        mx = wave_max(mx);
        const float sc = mx > 0.f ? 127.f / mx : 1.f;
        u32x4 w;
#pragma unroll
        for (int j = 0; j < 4; ++j) w[j] = ((unsigned)__float2int_rn(v[r][j][0] * sc) & 0xffu) | (((unsigned)__float2int_rn(v[r][j][1] * sc) & 0xffu) << 8) | (((unsigned)__float2int_rn(v[r][j][2] * sc) & 0xffu) << 16) | (((unsigned)__float2int_rn(v[r][j][3] * sc) & 0xffu) << 24);
        *(u32x4*)(dst + (size_t)(lane >> 3) * ((size_t)NEXP * 128) + (size_t)(row0 + r) * 128 + 16 * (lane & 7)) = w;
        if (lane == 0) scale[row0 + r] = mx > 0.f ? mx * (1.f / 127.f) : 1.f;
    }
}
DI void p0_fold_tile(const float* __restrict__ wq, const float* __restrict__ keys, bf16_t* __restrict__ out, int* __restrict__ gmax, LAS float* sm, int tile, int tid) {
    const int hp = tile >> 4, d0 = (tile & 15) * 64;
    LAS float* skT = sm; LAS float* swT = sm + 128 * 132;
    { const int r = tid & 127;
      for (int c4 = (tid >> 7) * 4; c4 < 128; c4 += 16) { const f32x4 v = *(const f32x4*)(keys + (size_t)(hp * 128 + r) * 128 + c4);
          skT[(c4 + 0) * 132 + r] = v[0]; skT[(c4 + 1) * 132 + r] = v[1]; skT[(c4 + 2) * 132 + r] = v[2]; skT[(c4 + 3) * 132 + r] = v[3]; } }
    { const int r = tid & 63;
      for (int c4 = (tid >> 6) * 4; c4 < 128; c4 += 32) { const f32x4 v = *(const f32x4*)(wq + (size_t)(d0 + r) * 2048 + hp * 128 + c4);
          swT[(c4 + 0) * 68 + r] = v[0]; swT[(c4 + 1) * 68 + r] = v[1]; swT[(c4 + 2) * 68 + r] = v[2]; swT[(c4 + 3) * 68 + r] = v[3]; } }
    __syncthreads();
    const int nb = tid & 31, db = tid >> 5;
    f32x4 acc[4];
#pragma unroll
    for (int i = 0; i < 4; ++i) acc[i] = (f32x4){0.f, 0.f, 0.f, 0.f};
#pragma unroll 4
    for (int k = 0; k < 128; ++k) { const f32x4 a = *(const LAS f32x4*)(skT + k * 132 + 4 * nb), b = *(const LAS f32x4*)(swT + k * 68 + 4 * db);
#pragma unroll
        for (int i = 0; i < 4; ++i) acc[i] += b * a[i]; }
#pragma unroll
    for (int i = 0; i < 4; ++i) { u32x2 o; o.x = cvtpk(acc[i][0], acc[i][1]); o.y = cvtpk(acc[i][2], acc[i][3]); *(u32x2*)(out + (size_t)(hp * 128 + 4 * nb + i) * D + d0 + 4 * db) = o; }
    { float mx = 0.f;
#pragma unroll
      for (int i = 0; i < 4; ++i) mx = fmaxf(mx, fmaxf(fmaxf(fabsf(acc[i][0]), fabsf(acc[i][1])), fmaxf(fabsf(acc[i][2]), fabsf(acc[i][3]))));
      mx = wave_max(mx);
      if ((tid & 63) == 0) __hip_atomic_fetch_max(gmax, __float_as_int(mx), __ATOMIC_RELAXED, __HIP_MEMORY_SCOPE_AGENT); }
    __syncthreads();
}
DI unsigned q8pack(float a, float b, float c, float d) {
    const unsigned ia = __float_as_uint(a + 12582912.f), ib = __float_as_uint(b + 12582912.f), ic = __float_as_uint(c + 12582912.f), id = __float_as_uint(d + 12582912.f);
    return (ia & 0xffu) | ((ib & 0xffu) << 8) | ((ic & 0xffu) << 16) | (id << 24);
}
template <int NR>
DI void p0_x_rows(const float* __restrict__ x, bf16_t* __restrict__ xb, unsigned char* __restrict__ x8, float* __restrict__ xsc, int row0, int lane) {
    f32x4 v[NR][4];
#pragma unroll
    for (int r = 0; r < NR; ++r) { const f32x4* sp = (const f32x4*)(x + (size_t)(row0 + r) * D) + 4 * lane;
#pragma unroll
        for (int j = 0; j < 4; ++j) v[r][j] = sp[j]; }
#pragma unroll
    for (int r = 0; r < NR; ++r) {
        float mx = 0.f; u32x4 o0, o1;
#pragma unroll
        for (int j = 0; j < 4; ++j) { mx = fmaxf(mx, fmaxf(fmaxf(fabsf(v[r][j][0]), fabsf(v[r][j][1])), fmaxf(fabsf(v[r][j][2]), fabsf(v[r][j][3]))));
            if (j < 2) { o0[2 * j] = cvtpk(v[r][j][0], v[r][j][1]); o0[2 * j + 1] = cvtpk(v[r][j][2], v[r][j][3]); } else { o1[2 * (j - 2)] = cvtpk(v[r][j][0], v[r][j][1]); o1[2 * (j - 2) + 1] = cvtpk(v[r][j][2], v[r][j][3]); } }
        *(u32x4*)(xb + (size_t)(row0 + r) * D + 16 * lane) = o0; *(u32x4*)(xb + (size_t)(row0 + r) * D + 16 * lane + 8) = o1;
        mx = wave_max(mx);
        const float sc = mx > 0.f ? 127.f / mx : 1.f;
        u32x4 w;
#pragma unroll
        for (int j = 0; j < 4; ++j) w[j] = q8pack(v[r][j][0] * sc, v[r][j][1] * sc, v[r][j][2] * sc, v[r][j][3] * sc);
        *(u32x4*)(x8 + (size_t)(row0 + r) * D + 16 * lane) = w;
        if (lane == 0) { const float v = mx > 0.f ? mx * (1.f / 127.f) : 1.f; const int row = row0 + r, hi = row & ~(S - 1), s = row & (S - 1);
            xsc[row] = v; xsc[M + hi + ((s & 3) << 11) + (s >> 2)] = v; xsc[2 * M + hi + ((s & 15) << 9) + (s >> 4)] = v; }
    }
}
DI void p0_transpose_item_f8(const float* __restrict__ W, int ncols, const float* __restrict__ cmax, unsigned char* __restrict__ out8, float* __restrict__ wsc, LAS float* scr, int item, int lane) {
    const int nblk = ncols / 32, kb = item / nblk, nb = item % nblk, k0 = 64 * kb, n0 = 32 * nb;
    const float cm = cmax[0]; const float sc = cm > 0.f ? 127.f / cm : 1.f;
#pragma unroll 8
    for (int i = 0; i < 32; ++i) { const int kk = 2 * i + (lane >> 5); scr[kk * 33 + (lane & 31)] = W[(size_t)(k0 + kk) * INC + n0 + (lane & 31)] * sc; }
    asm volatile("s_waitcnt lgkmcnt(0)" ::: "memory");
    const int c = lane & 7;
#pragma unroll
    for (int j = 0; j < 4; ++j) { const int n = (lane >> 3) + 8 * j; const LAS float* s = scr + (8 * c) * 33 + n;
        u32x2 o; o.x = q8pack(s[0 * 33], s[1 * 33], s[2 * 33], s[3 * 33]); o.y = q8pack(s[4 * 33], s[5 * 33], s[6 * 33], s[7 * 33]);
        *(u32x2*)(out8 + (size_t)(n0 + n) * D + k0 + 8 * c) = o; }
    if (item == 0 && lane == 0) wsc[0] = cm > 0.f ? cm * (1.f / 127.f) : 1.f;
    asm volatile("s_waitcnt lgkmcnt(0)" ::: "memory");
}
DI void p0_misc(const float* __restrict__ hgrn_lb, const float* __restrict__ rel_bias, float* __restrict__ misc, int i) {
    if (i < 512) { const float a = hgrn_lb[i], b = hgrn_lb[512 + i]; const float mx = fmaxf(a, b); const float ea = expf(a - mx), eb = expf(b - mx); misc[i] = ea / (ea + eb); }
    if (i < 3 * 129) {
        const int g = i / 129, j = i % 129; const int dl = g == 0 ? 1 : (g == 1 ? 4 : 16); const int n = j * dl;
        int bucket;
        if (n < 16) bucket = n;
        else { const double v = log((double)n / 16.0) / log(128.0) * 16.0; int l = 16 + (int)v; bucket = l < 31 ? l : 31; }
        for (int h = 0; h < 4; ++h) misc[512 + i * 4 + h] = rel_bias[bucket * 12 + g * 4 + h];
    }
}
struct SchedMemKV {
    unsigned MEMB, W; int G, c;
    DI bool next(int i, g8::Unit& u) const {
        const int L = i * G + c; if (L >= 32) return false;
        u.dla = 1; u.dlb = 1;
        if (L < 16) { u.kind = 0; u.pm = L >> 1; u.pn = L & 1; u.a = MEMB + (unsigned)u.pm * 256u * D * 2u; u.b = W + (unsigned)u.pn * 256u * D * 2u; }
        else { const int q = L - 16; u.kind = 1; u.pm = q >> 3; u.pn = q & 7; u.a = W + (unsigned)(512 + u.pm * 256) * D * 2u; u.b = MEMB + (unsigned)u.pn * 256u * D * 2u; }
        return true;
    }
};
struct EpiMemKVF {
    static constexpr bool PERM = true, HOOK = false;
    bf16_t *MK, *MVT;
    DI void hook(f32x4 (&)[2][2][4][2], const g8::Unit&, int, int, int, int, int) const {}
    DI void operator()(const f32x4 (&acc)[2][2][4][2], const g8::Unit& u, int wr, int wc, int fr, int fq) const {
        const int rowl = wr * 64 + fr, d0 = wc * 32 + 8 * fq;
#pragma unroll
        for (int ai = 0; ai < 2; ++ai)
#pragma unroll
            for (int m = 0; m < 4; ++m) { const int R = u.pm * 256 + rowl + ai * 128 + m * 16;
#pragma unroll
                for (int bj = 0; bj < 2; ++bj) { const f32x4 v0 = acc[ai][bj][m][0], v1 = acc[ai][bj][m][1];
                    if (u.kind == 0) { const int b = R >> 8, mm = R & 255, h = u.pn * 2 + bj;
                        u32x4 w; w.x = cvtpk(v0[0], v0[1]); w.y = cvtpk(v0[2], v0[3]); w.z = cvtpk(v1[0], v1[1]); w.w = cvtpk(v1[2], v1[3]);
                        *(u32x4*)(MK + ((size_t)((b * 4 + h) * 8 + (mm >> 5))) * 4096 + frag_row_off(d0, mm & 31)) = w; }
                    else { const int h = R >> 7, d = R & 127, c = u.pn * 256 + bj * 128 + d0, b = c >> 8, mm = c & 255, kk = mm & 31;
                        bf16_t* blk = MVT + ((size_t)((b * 4 + h) * 8 + (mm >> 5))) * 4096 + (((d >> 5) * 2 + (kk >> 4)) * 64 + (d & 31)) * 8 + 4 * ((kk >> 3) & 1);
                        u32x2 wa, wb; wa.x = cvtpk(v0[0], v0[1]); wa.y = cvtpk(v0[2], v0[3]); wb.x = cvtpk(v1[0], v1[1]); wb.y = cvtpk(v1[2], v1[3]);
                        *(u32x2*)blk = wa; *(u32x2*)(blk + 32 * 8) = wb; } } }
    }
};

static_assert(HG_UNIT_BYTES <= LDSCTL_OFF, "hgrn LDS");
static_assert(HG_UNIT_BYTES <= LDSCTL_OFF, "hgrn LDS");
__global__ void __launch_bounds__(NTHR, 2) mega(Args args) {
    extern __shared__ __attribute__((aligned(16))) unsigned char lds_raw[];
    LAS unsigned char* lds = (LAS unsigned char*)lds_raw;
    volatile LAS unsigned* MISC = (volatile LAS unsigned*)(lds + MISC_OFF);
    for (int u = threadIdx.x; u < (LDS_BYTES - LDSCTL_OFF) / 4; u += NTHR) ((LAS unsigned*)(lds + LDSCTL_OFF))[u] = 0u;
    __syncthreads();
    unsigned char* ws = args.ws;
    constexpr int G = 256;
    constexpr bool ALL = true;
    XcdBarrier bar; bar.bar = (unsigned*)(ws + O_MISC + 16384); bar.x = 0; bar.st = nullptr;
    if (ALL) bar = xcd_barrier_post((unsigned*)(ws + O_MISC + 16384), MISC + 8);
#ifndef REP_MASK
#define REP_MASK 0
#endif
#define RUN(k) (true)
#define NREP(k) (((REP_MASK >> (k)) & 1) ? 2 : 1)
#define SEAM() do { if (ALL) xcd_barrier(bar); } while (0)
    for (int rep_ = 0; rep_ < NREP(PH_PRO); ++rep_) if (RUN(PH_PRO)) {
        int tid = threadIdx.x; asm volatile("" : "+v"(tid)); asm volatile("" : "+s"(ws)); int bid = blockIdx.x; asm volatile("" : "+s"(bid));
        const size_t gt = (size_t)bid * NTHR + tid, nth = (size_t)G * NTHR;
        p0_convert(karg_in(1), (bf16_t*)(ws + O_MEMB), (size_t)2048 * 1024 / 8, gt, nth);
        if (bid == 0) p0_misc(karg_in(6), karg_in(5), (float*)(ws + O_MISC), tid);
        if (bid == 1) { const float* bg = karg_in(3); for (int i = tid; i < 3072; i += NTHR) ((float*)(ws + O_BGATE))[i] = bg[i]; }
        const int wid = __builtin_amdgcn_readfirstlane(tid >> 6), lane = tid & 63;
        LAS float* scr = (LAS float*)(lds + wid * 16384);
        const int gw = bid * NWAVES + wid, ngw = G * NWAVES;
        for (int r = gw * 4; r < M; r += ngw * 4) p0_x_rows<4>(karg_in(0), (bf16_t*)(ws + O_XB), (unsigned char*)(ws + O_X8), (float*)(ws + O_XSC), r, lane);
        {
            const float* wi = karg_in(2); float mx = 0.f;
            for (int k = bid; k < D; k += G) for (int n = tid; n < INC; n += NTHR) mx = fmaxf(mx, fabsf(wi[(size_t)k * INC + n]));
            mx = wave_max(mx);
            if (lane == 0) __hip_atomic_fetch_max((int*)(ws + O_CMAX), __float_as_int(mx), __ATOMIC_RELAXED, __HIP_MEMORY_SCOPE_AGENT);
        }
        for (int r = gw * 4; r < 2 * NEXP; r += ngw * 4) {
            if (r < NEXP) p0_q8_rows<4>(karg_in(14), (unsigned char*)(ws + O_UB), (float*)(ws + O_USC), r, lane);
            else p0_q8_rows<4>(karg_in(15), (unsigned char*)(ws + O_VB), (float*)(ws + O_VSC), r - NEXP, lane);
        }
        constexpr int NJ = 12;
        for (int it = gw; ; it += ngw) {
            int r = it; bool done = true;
#pragma unroll
            for (int j = 0; j < NJ; ++j) {
                const int srcc[NJ] = {0, 4608, 5632, 6656, 7168, 3072, 5120, 0, 0, 0, 0, 0};
                const int cnt[NJ] = {3072, 512, 1024, 512, 3072, 1536, 512, 1024, 1024, 1024, 1024, 1024};
                const int drow[NJ] = {0, 3072, 3584, 4608, 5120, 8192, 9728, 0, 0, 0, 0, 0};
                const int Kj = (j >= 8 && j <= 10) ? 512 : 1024;
                const int items = (Kj / 64) * (cnt[j] / 32);
                if (done && r < items) {
                    const float* W; int ldw; bf16_t* o; int ldo, koff = 0;
                    if (j < 7) { done = false; }
                    else if (j == 7) { W = karg_in(4); ldw = 1024; o = (bf16_t*)(ws + O_WMKV); ldo = 1024; }
                    else if (j <= 10) { W = karg_in(8) + (size_t)(j - 8) * 512 * 1024; ldw = 1024; o = (bf16_t*)(ws + O_WBR); ldo = 1536; koff = (j - 8) * 512; }
                    else { W = karg_in(9); ldw = 1024; o = (bf16_t*)(ws + O_WOUT); ldo = 1024; }
                    if (j >= 7) { p0_transpose_item(W, ldw, cnt[j], o, ldo, koff, scr, r, lane); done = false; }
                }
                r -= items;
            }
            if (done) break;
        }
        __syncthreads();
        for (int tile = bid; tile < 256; tile += G) p0_fold_tile(karg_in(12), karg_in(13), (bf16_t*)(ws + O_WPQ), (int*)(ws + O_CMAX) + 1, (LAS float*)lds, tile, tid);
        SEAM();
        for (int it = gw; ; it += ngw) {
            int r = it; bool done = true;
#pragma unroll
            for (int j = 0; j < 7; ++j) {
                const int srcc[7] = {0, 4608, 5632, 6656, 7168, 3072, 5120};
                const int cnt[7] = {3072, 512, 1024, 512, 3072, 1536, 512};
                const int drow[7] = {0, 3072, 3584, 4608, 5120, 8192, 9728};
                const int items = 16 * (cnt[j] / 32);
                if (done && r < items) { p0_transpose_item_f8(karg_in(2) + srcc[j], cnt[j], (const float*)(ws + O_CMAX), (unsigned char*)(ws + O_W8) + (size_t)drow[j] * 1024, (float*)(ws + O_WSC), scr, r, lane); done = false; }
                r -= items;
            }
            if (done) break;
        }
        {
            const float cm = ((const float*)(ws + O_CMAX))[1]; const float sc = cm > 0.f ? 127.f / cm : 1.f;
            for (size_t i = gt; i < (size_t)2048 * D / 16; i += nth) { const u32x4 a = *(const u32x4*)(ws + O_WPQ + i * 32), b = *(const u32x4*)(ws + O_WPQ + i * 32 + 16);
                float f[8], g[8]; unpack8(a, f); unpack8(b, g);
                u32x4 o; o.x = q8pack(f[0] * sc, f[1] * sc, f[2] * sc, f[3] * sc); o.y = q8pack(f[4] * sc, f[5] * sc, f[6] * sc, f[7] * sc); o.z = q8pack(g[0] * sc, g[1] * sc, g[2] * sc, g[3] * sc); o.w = q8pack(g[4] * sc, g[5] * sc, g[6] * sc, g[7] * sc);
                *(u32x4*)(ws + O_WPQ8 + i * 16) = o; }
            if (gt == 0) ((float*)(ws + O_WSC))[1] = cm > 0.f ? cm * (1.f / 127.f) : 1.f;
        }
        SEAM();
    }
#pragma unroll 1
    for (int p = 0; p < NPASS; ++p) {
        int bid = blockIdx.x; asm volatile("" : "+s"(bid));
        int tid = threadIdx.x; asm volatile("" : "+v"(tid));
        asm volatile("" : "+s"(ws));
        char* pr = (char*)ws + O_PASS;
        const size_t t0 = (size_t)p * MP;
        for (int rep_ = 0; rep_ < NREP(PH_PROJ); ++rep_) if (RUN(PH_PROJ)) {
            asm volatile("" : "+s"(bid)); asm volatile("" : "+v"(tid)); asm volatile("" : "+s"(ws)); pr = (char*)ws + O_PASS;
            { SchedP1<0> Sc{(unsigned)(O_X8 + t0 * D), (unsigned)O_W8, G, bid};
              EpiP1<0> E{(char*)ws, (int)t0, 0};
              g8::gemm_phase<EpiP1<0>, SchedP1<0>, 2>(lds, (const char*)ws, D / 2, Sc, E, tid); }
            asm volatile("" : "+v"(tid)); asm volatile("" : "+s"(bid)); asm volatile("" : "+s"(ws));
            { SchedP1<1> Sc{(unsigned)(O_X8 + t0 * D), (unsigned)O_W8, G, bid};
              EpiP1<1> E{(char*)ws, (int)t0, 0};
              g8::gemm_phase<EpiP1<1>, SchedP1<1>, 2>(lds, (const char*)ws, D / 2, Sc, E, tid); }
            if (p == 0) {
                asm volatile("" : "+v"(tid)); asm volatile("" : "+s"(bid));
                SchedMemKV S2{(unsigned)O_MEMB, (unsigned)O_WMKV, G, bid};
                EpiMemKVF E2{(bf16_t*)(ws + O_MK), (bf16_t*)(ws + O_MVT)};
                g8::gemm_phase<EpiMemKVF, SchedMemKV>(lds, (const char*)ws, D, S2, E2, tid);
            }
            SEAM();
        }
        for (int rep_ = 0; rep_ < NREP(PH_ATTN); ++rep_) if (RUN(PH_ATTN)) {
            asm volatile("" : "+s"(bid)); asm volatile("" : "+v"(tid)); asm volatile("" : "+s"(ws)); pr = (char*)ws + O_PASS;
            const float* bsrc = (const float*)(ws + O_MISC) + 512; LAS float* btab = (LAS float*)lds;
            for (int i = tid; i < 3 * 129 * 4; i += NTHR) btab[i] = bsrc[i] * LOG2E;
            __syncthreads();
            const int wid = __builtin_amdgcn_readfirstlane(tid >> 6), lane = tid & 63;
            for (int task = bid * NWAVES + wid; task < DIL_TASKS; task += G * NWAVES)
                attn_dil_wave((const bf16_t*)(pr + P_QK), (const bf16_t*)(pr + P_VT), btab, lds + 8192 + wid * 8704, (bf16_t*)(pr + P_OG), (float*)(pr + P_LSE), task, lane);
            for (int task = bid * NWAVES + wid; task < MEM_TASKS; task += G * NWAVES)
                attn_mem_wave((const bf16_t*)(pr + P_MQ), (const bf16_t*)(ws + O_MK), (const bf16_t*)(ws + O_MVT), (bf16_t*)(pr + P_BR), task, p * BPP, lane);
            __syncthreads();
        }
        for (int rep_ = 0; rep_ < NREP(PH_HGPRE); ++rep_) if (RUN(PH_HGPRE)) {
            asm volatile("" : "+s"(bid)); asm volatile("" : "+v"(tid)); asm volatile("" : "+s"(ws)); pr = (char*)ws + O_PASS;
            { const int unit = bid; static_assert(HG_UNITS == 256, "one HGRN unit per workgroup"); if (unit < HG_UNITS) {
                hgrn_unit<false>(lds, unit, tid, (const bf16_t*)(pr + P_HFQG), (const bf16_t*)(pr + P_IT), (const float*)(ws + O_MISC), karg_in(7),
                                 (float*)(pr + P_HSTL), (float*)(pr + P_HSTD), (const float*)(pr + P_SIN), (bf16_t*)(pr + P_BR));
            } }
            SEAM();
        }
        for (int rep_ = 0; rep_ < NREP(PH_HGSCAN); ++rep_) if (RUN(PH_HGSCAN)) {
            asm volatile("" : "+s"(bid)); asm volatile("" : "+v"(tid)); asm volatile("" : "+s"(ws)); pr = (char*)ws + O_PASS;
            hgrn_scan((const float*)(pr + P_HSTL), (const float*)(pr + P_HSTD), (float*)(pr + P_SIN), bid * NTHR + tid);
            lse_merge_items((const bf16_t*)(pr + P_OG), (const float*)(pr + P_LSE), (bf16_t*)(pr + P_BR), bid * NTHR + tid, G * NTHR);
            SEAM();
        }
        for (int rep_ = 0; rep_ < NREP(PH_HGMAIN); ++rep_) if (RUN(PH_HGMAIN)) {
            asm volatile("" : "+s"(bid)); asm volatile("" : "+v"(tid)); asm volatile("" : "+s"(ws)); pr = (char*)ws + O_PASS;
            { const int unit = bid; static_assert(HG_UNITS == 256, "one HGRN unit per workgroup"); if (unit < HG_UNITS) {
                hgrn_unit<true>(lds, unit, tid, (const bf16_t*)(pr + P_HFQG), (const bf16_t*)(pr + P_IT), (const float*)(ws + O_MISC), karg_in(7),
                                (float*)(pr + P_HSTL), (float*)(pr + P_HSTD), (const float*)(pr + P_SIN), (bf16_t*)(pr + P_BR));
            } }
            SEAM();
        }
        for (int rep_ = 0; rep_ < NREP(PH_WIDEN); ++rep_) if (RUN(PH_WIDEN)) {
            asm volatile("" : "+s"(bid)); asm volatile("" : "+v"(tid)); asm volatile("" : "+s"(ws)); pr = (char*)ws + O_PASS;
            SchedRows Sc{(unsigned)(O_PASS + P_BR), (unsigned)O_WBR, 1536, 4, 256, G, bid};
            EpiWidenF E{(const bf16_t*)(pr + P_GATE), (bf16_t*)(pr + P_MERGED)};
            g8::gemm_phase<EpiWidenF, SchedRows>(lds, (const char*)ws, 1536, Sc, E, tid);
            SEAM();
        }
        for (int rep_ = 0; rep_ < NREP(PH_WOUT); ++rep_) if (RUN(PH_WOUT)) {
            asm volatile("" : "+s"(bid)); asm volatile("" : "+v"(tid)); asm volatile("" : "+s"(ws)); pr = (char*)ws + O_PASS;
            SchedRows Sc{(unsigned)(O_PASS + P_MERGED), (unsigned)O_WOUT, 1024, 4, 256, G, bid};
            EpiPlainB16 E{(bf16_t*)(pr + P_MIX), 1024, 0};
            g8::gemm_phase<EpiPlainB16, SchedRows>(lds, (const char*)ws, 1024, Sc, E, tid);
            SEAM();
        }
        for (int rep_ = 0; rep_ < NREP(PH_LN1); ++rep_) if (RUN(PH_LN1)) {
            asm volatile("" : "+s"(bid)); asm volatile("" : "+v"(tid)); asm volatile("" : "+s"(ws)); pr = (char*)ws + O_PASS;
            ln1_rows<4>((const bf16_t*)(ws + O_XB) + t0 * D, (const bf16_t*)(pr + P_MIX), karg_in(10), karg_in(11), (bf16_t*)(ws + O_H1B) + t0 * D, (unsigned char*)(ws + O_H1Q) + t0 * D, (float*)(ws + O_HSC) + t0, bid * NWAVES + (tid >> 6), G * NWAVES, tid & 63);
        }
    }
    for (int rep_ = 0; rep_ < NREP(PH_PQ); ++rep_) if (RUN(PH_PQ)) {
        SEAM();
        int tid = threadIdx.x; asm volatile("" : "+v"(tid)); asm volatile("" : "+s"(ws)); int bid = blockIdx.x; asm volatile("" : "+s"(bid));
        char* pr = (char*)ws + O_PASS;
        SchedRows Sc{(unsigned)O_H1Q, (unsigned)O_WPQ8, 512, 8, 2048, G, bid};
        EpiScores E{(bf16_t*)(pr + P_PQ), (const float*)(ws + O_HSC), (const float*)(ws + O_WSC) + 1};
        g8::gemm_phase<EpiScores, SchedRows, 2>(lds, (const char*)ws, 512, Sc, E, tid);
        SEAM();
    }
    for (int rep_ = 0; rep_ < NREP(PH_ROUTE); ++rep_) if (RUN(PH_ROUTE)) {
        int tid = threadIdx.x; asm volatile("" : "+v"(tid)); asm volatile("" : "+s"(ws)); int bid = blockIdx.x; asm volatile("" : "+s"(bid));
        char* pr = (char*)ws + O_PASS;
        const int wid = __builtin_amdgcn_readfirstlane(tid >> 6), lane = tid & 63;
        for (int task = bid * NWAVES + wid; task < (M / 32) * 8; task += G * NWAVES)
            route_wave((const bf16_t*)(pr + P_PQ), (int*)(pr + P_IDX), (float*)(pr + P_PG), task >> 3, task & 7, lane);
        SEAM();
    }
    if (RUN(PH_EXPERTS)) {
        int tid = threadIdx.x; asm volatile("" : "+v"(tid)); asm volatile("" : "+s"(ws)); int bid = blockIdx.x; asm volatile("" : "+s"(bid));
        char* pr = (char*)ws + O_PASS;
        const int wid = __builtin_amdgcn_readfirstlane(tid >> 6), lane = tid & 63;
        if (tid == 0) {
            unsigned base = 0; const unsigned myx = ALL ? bar.x : 0u;
            if (ALL) { for (unsigned jx = 0; jx < 16; ++jx) { const unsigned c = xb_ld(&bar.bar[XB_XCNT(jx)]); if (jx < myx) base += c; } MISC[12] = base + MISC[10]; }
            else MISC[12] = (unsigned)bid;
        }
        __syncthreads();
        const int vwg = (int)MISC[12];
        const int nper = G >> 3, x = vwg / nper, r = vwg % nper;
        const int tpw = M / (nper * NWAVES);
        const size_t tokw0 = (size_t)(r * NWAVES + wid) * tpw;
        {
            const unsigned char* U8x = (const unsigned char*)(ws + O_UB) + (size_t)x * ((size_t)NEXP * 128);
            experts_u_slice<2>((const unsigned char*)(ws + O_H1Q), U8x, (const int*)(pr + P_IDX), (bf16_t*)(pr + P_PD), tokw0, tpw, x, lane);
        }
        SEAM();
        experts_combine((const bf16_t*)(pr + P_PD), (const int*)(pr + P_IDX), (const float*)(pr + P_PG), (const float*)(ws + O_USC), (const float*)(ws + O_VSC), (const float*)(ws + O_HSC), (unsigned char*)(pr + P_C), (float*)(pr + P_C + (size_t)M * 128), bid * NWAVES + wid, G * NWAVES, lane);
        SEAM();
        {
            const unsigned char* V8x = (const unsigned char*)(ws + O_VB) + (size_t)x * ((size_t)NEXP * 128);
            experts_v_slice<2>(V8x, (const int*)(pr + P_IDX), (const unsigned char*)(pr + P_C), (const float*)(pr + P_C + (size_t)M * 128), (bf16_t*)(pr + P_FFN), tokw0, tpw, x, lane);
        }
        SEAM();
        for (int tok = (bid * NWAVES + wid) * 4; tok < M; tok += G * NWAVES * 4) ln2_tokens<4>((const bf16_t*)(pr + P_FFN), (const bf16_t*)(ws + O_H1B), karg_in(16), karg_in(17), karg_out(), (size_t)tok, lane);
    }
#undef RUN
#undef SEAM
}

extern "C" void kernel_launch(void* const* d_in, const int* in_sizes, int n_in, void* d_out, int out_size, void* d_ws, size_t ws_size, hipStream_t stream) {
    if (ws_size < WS_NEED || n_in != 18) return;
    static bool attr_set = false;
    if (!attr_set) { (void)hipFuncSetAttribute((const void*)mega, hipFuncAttributeMaxDynamicSharedMemorySize, LDS_BYTES); attr_set = true; }
    (void)hipMemsetAsync((char*)d_ws + O_MISC + 16384, 0, 16384, stream);
    (void)hipMemsetAsync((char*)d_ws + O_CMAX, 0, (size_t)INC * 4, stream);
    Args a{}; for (int i = 0; i < 18; ++i) a.in[i] = (const float*)d_in[i]; a.out = (float*)d_out; a.ws = (unsigned char*)d_ws; a.ph = PH_ALL; a.pass = 0;
    mega<<<256, NTHR, LDS_BYTES, stream>>>(a);
}
```

```cpp
#include <hip/hip_runtime.h>
#include <stdint.h>
#include <math.h>

typedef unsigned short bf16_t;
typedef short bf16x8 __attribute__((ext_vector_type(8)));
typedef float f32x4 __attribute__((ext_vector_type(4)));
#define DI __device__ __forceinline__
#define ST_G(val, ptr) __builtin_nontemporal_store((val), (__attribute__((address_space(1))) decltype(val)*)(ptr))

DI const float* karg_in(int i) { const float* const* kp = (const float* const*)__builtin_amdgcn_kernarg_segment_ptr(); asm volatile("" : "+s"(kp)); return kp[i]; }
DI float* karg_out() { float* const* kp = (float* const*)__builtin_amdgcn_kernarg_segment_ptr(); asm volatile("" : "+s"(kp)); return kp[18]; }
DI float bf2f(bf16_t v) { return __uint_as_float(((unsigned)v) << 16); }
DI bf16_t f2bf(float f) { unsigned u = __float_as_uint(f); u += 0x7fffu + ((u >> 16) & 1u); return (bf16_t)(u >> 16); }

constexpr int NB = 8, S = 8192, D = 1024, M = NB * S;
constexpr int NPASS = 4, BPP = NB / NPASS, MP = BPP * S;
constexpr int INC = 10240;
constexpr int NEXP = 16384;
constexpr float ALPHA = 1.189207115002721f;
constexpr float LN_EPS = 1e-5f;
constexpr float QSCALE = 0.08838834764831845f;

constexpr size_t al(size_t x) { return (x + 255) & ~(size_t)255; }
constexpr size_t O_WIN = 0;
constexpr size_t O_WMKV = O_WIN + al((size_t)INC * D * 2);
constexpr size_t O_WBR = O_WMKV + al((size_t)1024 * 1024 * 2);
constexpr size_t O_WOUT = O_WBR + al((size_t)1024 * 1536 * 2);
constexpr size_t O_WPQ = O_WOUT + al((size_t)1024 * 1024 * 2);
constexpr size_t O_SUBK = O_WPQ + al((size_t)2048 * 1024 * 2);
constexpr size_t O_UB = O_SUBK + al((size_t)16 * 128 * 128 * 2);
constexpr size_t O_VB = O_UB + al((size_t)NEXP * D);
constexpr size_t O_USC = O_VB + al((size_t)NEXP * D);
constexpr size_t O_VSC = O_USC + al((size_t)NEXP * 4);
constexpr size_t O_XB = O_VSC + al((size_t)NEXP * 4);
constexpr size_t O_MEMB = O_XB + al((size_t)M * D * 2);
constexpr size_t O_MK = O_MEMB + al((size_t)2048 * 1024 * 2);
constexpr size_t O_MVT = O_MK + al((size_t)2048 * 512 * 2);
constexpr size_t O_H1B = O_MVT + al((size_t)8 * 512 * 256 * 2);
constexpr size_t O_H1Q = O_H1B + al((size_t)M * D * 2);
constexpr size_t O_HSC = O_H1Q + al((size_t)M * D);
constexpr size_t O_X8 = O_HSC + al((size_t)M * 4);
constexpr size_t O_XSC = O_X8 + al((size_t)M * D);
constexpr size_t O_W8 = O_XSC + al((size_t)3 * M * 4);
constexpr size_t O_WSC = O_W8 + al((size_t)INC * D);
constexpr size_t O_CMAX = O_WSC + al((size_t)INC * 4);
constexpr size_t O_WPQ8 = O_CMAX + al((size_t)INC * 4);
constexpr size_t O_MISC = O_WPQ8 + al((size_t)2048 * D);
constexpr size_t O_BGATE = O_MISC + 32768;
constexpr size_t O_PASS = O_MISC + al(65536);
constexpr size_t P_QK = 0;
constexpr size_t P_VT = P_QK + al((size_t)MP * 3072 * 2);
constexpr size_t P_IT = P_VT + (size_t)1536 * MP * 2;
constexpr size_t P_HFQG = P_IT + al((size_t)512 * MP * 2);
constexpr size_t P_MQ = P_HFQG + al((size_t)MP * 1536 * 2);
constexpr size_t P_GATE = P_MQ + al((size_t)MP * 512 * 2);
constexpr size_t P_OG = P_GATE + al((size_t)MP * 3072 * 2);
constexpr size_t P_LSE = P_OG + al((size_t)MP * 1536 * 2);
constexpr size_t P_BR = P_LSE + al((size_t)MP * 12 * 4);
constexpr size_t P_MERGED = P_BR + al((size_t)MP * 1536 * 2);
constexpr size_t P_MIX = P_MERGED + al((size_t)MP * 1024 * 2);
constexpr size_t P_HSTL = P_MIX + al((size_t)MP * 1024 * 4);
constexpr size_t P_HSTD = P_HSTL + al((size_t)256 * 16384 * 4);
constexpr size_t P_SIN = P_HSTD + al((size_t)256 * 128 * 4);
constexpr size_t P_END = P_SIN + al((size_t)256 * 16384 * 4);
constexpr size_t P_PQ = 0;
constexpr size_t P_IDX = P_PQ + al((size_t)M * 2048 * 2);
constexpr size_t P_PG = P_IDX + al((size_t)M * 128 * 4);
constexpr size_t P_C = P_PG + al((size_t)M * 128 * 4);
constexpr size_t P_END2 = P_C + al((size_t)M * 128 * 4);
constexpr size_t P_PD = 0;
constexpr size_t P_FFN = P_PD + al((size_t)M * 1024 * 2);
static_assert(P_FFN + (size_t)M * 1024 * 2 <= P_IDX, "PEER overlay");
constexpr size_t WS_NEED = O_PASS + (P_END > P_END2 ? P_END : P_END2);
static_assert(WS_NEED <= (size_t)1073741824, "workspace budget");

DI int dil_of(int g) { return g == 0 ? 1 : (g == 1 ? 4 : 16); }
DI float dpp_x(float v, const int which) {
    const int s = __float_as_int(v);
    const int r = which == 0 ? __builtin_amdgcn_update_dpp(0, s, 0xB1, 0xF, 0xF, true) : which == 1 ? __builtin_amdgcn_update_dpp(0, s, 0x4E, 0xF, 0xF, true)
                : which == 2 ? __builtin_amdgcn_update_dpp(0, s, 0x141, 0xF, 0xF, true) : __builtin_amdgcn_update_dpp(0, s, 0x128, 0xF, 0xF, true);
    return __int_as_float(r);
}
DI float pair_sum(float v) { const auto rr = __builtin_amdgcn_permlane32_swap(__float_as_uint(v), __float_as_uint(v), false, false); return __uint_as_float(rr[0]) + __uint_as_float(rr[1]); }
DI float pair_max(float v) { const auto rr = __builtin_amdgcn_permlane32_swap(__float_as_uint(v), __float_as_uint(v), false, false); return fmaxf(__uint_as_float(rr[0]), __uint_as_float(rr[1])); }
DI float wave_max(float v) {
    v = fmaxf(v, dpp_x(v, 0)); v = fmaxf(v, dpp_x(v, 1)); v = fmaxf(v, dpp_x(v, 2)); v = fmaxf(v, dpp_x(v, 3));
    { const auto rr = __builtin_amdgcn_permlane16_swap(__float_as_uint(v), __float_as_uint(v), false, false); v = fmaxf(__uint_as_float(rr[0]), __uint_as_float(rr[1])); }
    return pair_max(v);
}
DI float wave_sum(float v) {
    v += dpp_x(v, 0); v += dpp_x(v, 1); v += dpp_x(v, 2); v += dpp_x(v, 3);
    { const auto rr = __builtin_amdgcn_permlane16_swap(__float_as_uint(v), __float_as_uint(v), false, false); v = __uint_as_float(rr[0]) + __uint_as_float(rr[1]); }
    return pair_sum(v);
}

#define LAS __attribute__((address_space(3)))
#define GAS __attribute__((address_space(1)))
typedef unsigned u32x4 __attribute__((ext_vector_type(4)));
typedef unsigned u32x2 __attribute__((ext_vector_type(2)));
typedef float f32x2 __attribute__((ext_vector_type(2)));
typedef __bf16 bf16x2_t __attribute__((ext_vector_type(2)));
DI unsigned cvtpk(float lo, float hi) { f32x2 v = {lo, hi}; bf16x2_t b = __builtin_convertvector(v, bf16x2_t); return __builtin_bit_cast(unsigned, b); }
constexpr float LOG2E = 1.4426950408889634f;
constexpr int NTHR_C = 512;
DI float fast_sigmoid(float z) { return __builtin_amdgcn_rcpf(1.f + __builtin_amdgcn_exp2f(-z * LOG2E)); }

namespace g8 {
constexpr int BM = 256, BK = 64, HALF = 128, HTB = HALF * BK * 2, STAGE_BYTES = 8 * HTB;
DI int lds_byte(int r, int c) { const int st = (r >> 4) * 2 + (c >> 5), rr = r & 15, cc = c & 31, ob = rr * 64 + cc * 2; return st * 1024 + (ob ^ (((ob >> 9) & 1) << 5)); }
DI void stage_rc(int b, int& R, int& C) { const int st = b / 1024, sb = b % 1024, swz = sb ^ (((sb >> 9) & 1) << 5); R = (st >> 1) * 16 + swz / 64; C = (st & 1) * 32 + (swz % 64) / 2; }
DI int perm32(int rho) { const int n = rho >> 4, i = rho & 15; return 8 * (i >> 2) + 4 * n + (i & 3); }

struct Unit { unsigned a, b; int dla, dlb; int pm, pn, kind; };

typedef int i32x8 __attribute__((ext_vector_type(8)));
typedef int i32x4v __attribute__((ext_vector_type(4)));
template <class Epi, class Sched, int OPK = 0>
DI void gemm_phase(LAS unsigned char* lds, const char* const wsb, const int K, const Sched& S, const Epi& E, const int tid) {
    const int wid = __builtin_amdgcn_readfirstlane(tid >> 6), lane = tid & 63, wr = wid >> 2, wc = wid & 3, fr = lane & 15, fq = lane >> 4;
    constexpr bool F8 = OPK == 1;
    const int nt = K / BK;
#define G8_STAGE_OFFS(tidv) unsigned rak[2], rbk[2], ccb[2]; \
    _Pragma("unroll") for (int i_ = 0; i_ < 2; ++i_) { int R_, C_; stage_rc((tidv) * 16 + i_ * 8192, R_, C_); const int Rb_ = Epi::PERM ? ((R_ & ~31) + perm32(R_ & 31)) : R_; \
        rak[i_] = (unsigned)(R_ * K) * 2u; rbk[i_] = (unsigned)(Rb_ * K) * 2u; ccb[i_] = (unsigned)C_ * 2u; }
    const unsigned kstep = (unsigned)(BK * 2);
    const unsigned hstepA = (unsigned)(HALF * K * 2);
    const unsigned ldsw = (unsigned)wid * 1024u;
    const int aoff = lds_byte(wr * 64 + fr, fq * 8), boff = lds_byte(wc * 32 + fr, fq * 8);
#define G8_SA(b, h) (((b) * 2 + (h)) * HTB)
#define G8_SB(b, h) ((4 + (b) * 2 + (h)) * HTB)
#define G8_STAGE(bufoff, gbase, v0, v1) do { \
        __builtin_amdgcn_global_load_lds((const unsigned*)(wsb + (unsigned)((gbase) + (v0))), (LAS unsigned*)(lds + (bufoff) + ldsw), 16, 0, 0); \
        __builtin_amdgcn_global_load_lds((const unsigned*)(wsb + (unsigned)((gbase) + (v1))), (LAS unsigned*)(lds + (bufoff) + ldsw + 8192), 16, 0, 0); } while (0)
#define G8_LDA(dst, b, h) do { _Pragma("unroll") for (int m = 0; m < 4; ++m) _Pragma("unroll") for (int k = 0; k < 2; ++k) dst[m][k] = *(const LAS bf16x8*)(lds + G8_SA(b, h) + aoff + m * 2048 + k * 1024); } while (0)
#define G8_LDB(dst, b, h) do { _Pragma("unroll") for (int n = 0; n < 2; ++n) _Pragma("unroll") for (int k = 0; k < 2; ++k) dst[n][k] = *(const LAS bf16x8*)(lds + G8_SB(b, h) + boff + n * 2048 + k * 1024); } while (0)
#define G8_CAT(x) __builtin_shufflevector(__builtin_bit_cast(i32x4v, (x)[0]), __builtin_bit_cast(i32x4v, (x)[1]), 0, 1, 2, 3, 4, 5, 6, 7)
#define G8_MMA(ai, bj, At, Bt) do { __builtin_amdgcn_s_setprio(1); \
        if constexpr (F8) { _Pragma("unroll") for (int m = 0; m < 4; ++m) _Pragma("unroll") for (int n = 0; n < 2; ++n) \
            asm volatile("v_mfma_scale_f32_16x16x128_f8f6f4 %0, %1, %2, %0, %3, %3 op_sel_hi:[0,0,0]" : "+v"(acc[ai][bj][m][n]) : "v"(G8_CAT(Bt[n])), "v"(G8_CAT(At[m])), "v"(mxscale)); } \
        else if constexpr (OPK == 2) { _Pragma("unroll") for (int m = 0; m < 4; ++m) _Pragma("unroll") for (int n = 0; n < 2; ++n) _Pragma("unroll") for (int k = 0; k < 2; ++k) \
            acc[ai][bj][m][n] = __builtin_bit_cast(f32x4, __builtin_amdgcn_mfma_i32_16x16x64_i8(__builtin_bit_cast(i32x4v, Bt[n][k]), __builtin_bit_cast(i32x4v, At[m][k]), __builtin_bit_cast(i32x4v, acc[ai][bj][m][n]), 0, 0, 0)); } \
        else { _Pragma("unroll") for (int m = 0; m < 4; ++m) _Pragma("unroll") for (int n = 0; n < 2; ++n) _Pragma("unroll") for (int k = 0; k < 2; ++k) \
            acc[ai][bj][m][n] = __builtin_amdgcn_mfma_f32_16x16x32_bf16(Bt[n][k], At[m][k], acc[ai][bj][m][n], 0, 0, 0); } \
        __builtin_amdgcn_s_setprio(0); } while (0)
#define G8_WAIT_V(n) asm volatile("s_waitcnt vmcnt(" #n ")" ::: "memory")
#define G8_WAIT_L(n) asm volatile("s_waitcnt lgkmcnt(" #n ")" ::: "memory")
#define G8_BAR __builtin_amdgcn_s_barrier()
#define G8_SCHED __builtin_amdgcn_sched_barrier(0)
    Unit cur, nxt; int ui = 0;
    if (!S.next(0, cur)) return;
    f32x4 acc[2][2][4][2];
#pragma unroll
    for (int a = 0; a < 2; ++a)
#pragma unroll
        for (int b = 0; b < 2; ++b)
#pragma unroll
            for (int m = 0; m < 4; ++m)
#pragma unroll
                for (int n = 0; n < 2; ++n) acc[a][b][m][n] = (f32x4){0.f, 0.f, 0.f, 0.f};
    const int mxscale = 0x7f7f7f7f;
    bf16x8 At[4][2], B0[2][2], B1[2][2];
    unsigned cA = cur.a, cB = cur.b;
    unsigned hBc = hstepA * (unsigned)cur.dlb, hAc = hstepA * (unsigned)cur.dla;
    G8_STAGE_OFFS(tid)
    {
    const unsigned vBc0 = rbk[0] * (unsigned)cur.dlb + ccb[0], vBc1 = rbk[1] * (unsigned)cur.dlb + ccb[1];
    const unsigned vAc0 = rak[0] * (unsigned)cur.dla + ccb[0], vAc1 = rak[1] * (unsigned)cur.dla + ccb[1];
    G8_STAGE(G8_SB(0, 0), cB, vBc0, vBc1); G8_STAGE(G8_SB(0, 1), cB + hBc, vBc0, vBc1); G8_STAGE(G8_SA(0, 0), cA, vAc0, vAc1); G8_STAGE(G8_SA(0, 1), cA + hAc, vAc0, vAc1);
    if (wr == 1) G8_BAR;
    G8_WAIT_V(2); G8_BAR;
    G8_STAGE(G8_SB(1, 0), cB + kstep, vBc0, vBc1); G8_STAGE(G8_SA(1, 0), cA + kstep, vAc0, vAc1); G8_STAGE(G8_SB(1, 1), cB + hBc + kstep, vBc0, vBc1);
    G8_WAIT_V(6); G8_BAR;
    }
    for (;;) {
        const bool has_next = S.next(ui + 1, nxt);
        const unsigned nA = has_next ? nxt.a : cA, nB = has_next ? nxt.b : cB; const int dln = has_next ? nxt.dlb : cur.dlb;
        const unsigned hBn = hstepA * (unsigned)dln;
        const int dlan = has_next ? nxt.dla : cur.dla;
        const unsigned hAn = hstepA * (unsigned)dlan;
#pragma unroll 1
        for (int t = 0; t < nt; t += 2) {
            if constexpr (Epi::HOOK) E.hook(acc, cur, t, wr, wc, fr, fq);
            const bool last = (t == nt - 2);
            const bool relax = (t == 0) && (ui > 0);
            const unsigned a1 = cA + (unsigned)(t + 1) * kstep;
            const unsigned a2 = last ? nA : cA + (unsigned)(t + 2) * kstep, b2 = last ? nB : cB + (unsigned)(t + 2) * kstep;
            const unsigned a3 = a2 + kstep, b3 = b2 + kstep;
            const unsigned dBs = (unsigned)(last ? dln : cur.dlb), dAs = (unsigned)(last ? dlan : cur.dla);
            const unsigned vB0 = rbk[0] * dBs + ccb[0], vB1 = rbk[1] * dBs + ccb[1]; const unsigned hB = last ? hBn : hBc;
            const unsigned vA0 = rak[0] * dAs + ccb[0], vA1 = rak[1] * dAs + ccb[1]; const unsigned hA = last ? hAn : hAc;
            const unsigned vAc0 = rak[0] * (unsigned)cur.dla + ccb[0], vAc1 = rak[1] * (unsigned)cur.dla + ccb[1];
            G8_LDB(B0, 0, 0); G8_LDB(B1, 0, 1); G8_SCHED; G8_LDA(At, 0, 0); G8_STAGE(G8_SA(1, 1), a1 + hAc, vAc0, vAc1);
            if (relax) G8_WAIT_V(24); else G8_WAIT_V(8);
            G8_WAIT_L(0); G8_BAR; G8_MMA(0, 0, At, B0); G8_MMA(0, 1, At, B1); G8_BAR; G8_SCHED;
            G8_LDA(At, 0, 1); G8_STAGE(G8_SB(0, 0), b2, vB0, vB1); G8_STAGE(G8_SB(0, 1), b2 + hB, vB0, vB1); G8_STAGE(G8_SA(0, 0), a2, vA0, vA1);
            if (relax) G8_WAIT_V(24); else G8_WAIT_V(8);
            G8_WAIT_L(0); G8_BAR; G8_MMA(1, 0, At, B0); G8_MMA(1, 1, At, B1); G8_BAR; G8_SCHED;
            G8_LDB(B0, 1, 0); G8_LDB(B1, 1, 1); G8_SCHED; G8_LDA(At, 1, 0); G8_STAGE(G8_SA(0, 1), a2 + hA, vA0, vA1);
            G8_WAIT_V(8); G8_WAIT_L(0); G8_BAR; G8_MMA(0, 0, At, B0); G8_MMA(0, 1, At, B1); G8_BAR; G8_SCHED;
            G8_LDA(At, 1, 1); G8_STAGE(G8_SB(1, 0), b3, vB0, vB1); G8_STAGE(G8_SB(1, 1), b3 + hB, vB0, vB1); G8_STAGE(G8_SA(1, 0), a3, vA0, vA1);
            G8_WAIT_V(8); G8_WAIT_L(0); G8_BAR; G8_MMA(1, 0, At, B0); G8_MMA(1, 1, At, B1); G8_BAR; G8_SCHED;
        }
        if constexpr (F8) asm volatile("s_nop 15\n\ts_nop 7" ::: "memory");
        if (wr == 0) G8_BAR;
        E(acc, cur, wr, wc, fr, fq);
        if (!has_next) break;
#pragma unroll
        for (int a = 0; a < 2; ++a)
#pragma unroll
            for (int b = 0; b < 2; ++b)
#pragma unroll
                for (int m = 0; m < 4; ++m)
#pragma unroll
                    for (int n = 0; n < 2; ++n) acc[a][b][m][n] = (f32x4){0.f, 0.f, 0.f, 0.f};
        cur = nxt; cA = nA; cB = nB; hBc = hBn; hAc = hAn; ++ui;
        if (wr == 1) G8_BAR;
    }
    G8_WAIT_V(0);
    G8_BAR;
#undef G8_SA
#undef G8_SB
#undef G8_STAGE
#undef G8_LDA
#undef G8_LDB
#undef G8_MMA
#undef G8_STAGE_OFFS
#undef G8_CAT
#undef G8_WAIT_V
#undef G8_WAIT_L
#undef G8_BAR
#undef G8_SCHED
}
}

typedef GAS unsigned gu32;
#define XB_TMO      128
#define XB_XCNT(j)  (256  + 64 * (j))
#define XB_XSUB(j)  (1280 + 64 * (j))
#define XB_XGEN(j)  (2304 + 64 * (j))
#define XB_TOP      3328
#define XB_TOPGEN   3392
#define XCD_BAR_WORDS 3456
#define XB_SPIN_CAP (1u << 22)
DI unsigned xb_ld(unsigned* p)              { return __hip_atomic_load(p, __ATOMIC_RELAXED, __HIP_MEMORY_SCOPE_AGENT); }
DI unsigned xb_add(unsigned* p, unsigned v) { return __hip_atomic_fetch_add(p, v, __ATOMIC_RELAXED, __HIP_MEMORY_SCOPE_AGENT); }
DI unsigned xb_xcc_id() { return (unsigned)__builtin_amdgcn_s_getreg((3 << 11) | 20) & 0xFu; }
#define XB_SPIN(cond, bar) do { unsigned _sp = 0; while (cond) { __builtin_amdgcn_s_sleep(1); \
    if ((++_sp & 255u) == 0u) { if (xb_ld(&(bar)[XB_TMO])) break; if (_sp > XB_SPIN_CAP) { atomicAdd(&(bar)[XB_TMO], 1u); break; } } } } while (0)
struct XcdBarrier { unsigned* bar; unsigned x; volatile LAS unsigned* st; };
DI XcdBarrier xcd_barrier_post(unsigned* bar, volatile LAS unsigned* st) {
    XcdBarrier b; b.bar = bar; b.x = xb_xcc_id(); b.st = st;
    if (threadIdx.x == 0) st[2] = xb_add(&bar[XB_XCNT(b.x)], 1u);
    return b;
}
DI void xcd_barrier_complete(unsigned* bar, unsigned x, unsigned& nloc, unsigned& nx) {
    const unsigned G = gridDim.x * gridDim.y * gridDim.z;
    unsigned sum, cnt, mine, sp = 0u;
    for (;;) {
        sum = 0u; cnt = 0u; mine = 0u;
#pragma unroll
        for (unsigned j = 0; j < 16; ++j) { const unsigned c = xb_ld(&bar[XB_XCNT(j)]); sum += c; cnt += (c > 0u) ? 1u : 0u; mine = (j == x) ? c : mine; }
        if (sum == G) break;
        __builtin_amdgcn_s_sleep(1);
        if ((++sp & 255u) == 0u) { if (xb_ld(&bar[XB_TMO])) break; if (sp > XB_SPIN_CAP) { atomicAdd(&bar[XB_TMO], 1u); break; } }
    }
    nloc = mine > 0u ? mine : 1u; nx = cnt > 0u ? cnt : 1u;
}
DI void xcd_barrier(const XcdBarrier& b) {
    asm volatile("s_waitcnt vmcnt(0)" ::: "memory");
    __syncthreads();
    if (threadIdx.x == 0) {
        unsigned* bar = b.bar;
        __builtin_amdgcn_s_waitcnt(0);
        unsigned nloc = b.st[0], nx = b.st[1];
        if (nloc == 0u) { xcd_barrier_complete(bar, b.x, nloc, nx); b.st[0] = nloc; b.st[1] = nx; }
        const unsigned old = xb_add(&bar[XB_XSUB(b.x)], 1u);
        const unsigned gen = old / nloc;
        if (old + 1u == (gen + 1u) * nloc) {
            __builtin_amdgcn_fence(__ATOMIC_RELEASE, "agent");
            asm volatile("s_waitcnt vmcnt(0)" ::: "memory");
            const unsigned og = xb_add(&bar[XB_TOP], 1u);
            const unsigned tg = og / nx;
            if (og + 1u == (tg + 1u) * nx) xb_add(&bar[XB_TOPGEN], 1u);
            else XB_SPIN(xb_ld(&bar[XB_TOPGEN]) == tg, bar);
            __builtin_amdgcn_fence(__ATOMIC_ACQUIRE, "agent");
            xb_add(&bar[XB_XGEN(b.x)], 1u);
            asm volatile("s_waitcnt vmcnt(0)" ::: "memory");
        } else {
            XB_SPIN(xb_ld(&bar[XB_XGEN(b.x)]) == gen, bar);
            __builtin_amdgcn_fence(__ATOMIC_ACQUIRE, "agent");
            asm volatile("s_waitcnt vmcnt(0)" ::: "memory");
        }
    }
    __syncthreads();
}

constexpr int NWAVES = 8, NTHR = NWAVES * 64;
constexpr int RING_BYTES = 131072, LDS_BYTES = 147456, LDSCTL_OFF = LDS_BYTES - 1024, MISC_OFF = LDSCTL_OFF + 320;
enum { PH_ALL = 0, PH_PRO = 11, PH_PROJ = 1, PH_ATTN = 2, PH_HGPRE = 3, PH_HGMAIN = 4, PH_WIDEN = 5, PH_WOUT = 6, PH_LN1 = 7, PH_PQ = 8, PH_ROUTE = 9, PH_EXPERTS = 10, PH_HGSCAN = 12 };
struct Args { const float* in[18]; float* out; unsigned char* ws; int ph, pass; };

struct Bufs {
    const bf16_t *WIN, *XBp; bf16_t *QK, *VIT, *HFQG, *MQ, *GATE;
};

template <int KIND>
struct SchedP1 {
    static constexpr unsigned RB = 1024u;
    unsigned XBp, W; int G, c;
    DI bool next(int i, g8::Unit& u) const {
        const int L = i * G + c + (KIND ? 2048 : 0); if (L >= (KIND ? 2560 : 2048)) return false;
        if (L < 2048) { const int x = L & 7, off = L >> 3; u.pm = 8 * x + (off & 7); u.pn = off >> 3; u.kind = 0; u.dlb = 1;
            const int hp = u.pn < 12 ? (u.pn < 6 ? u.pn : u.pn - 6) : 0, lg = hp < 2 ? 0 : (hp < 4 ? 2 : 4), dl = 1 << lg;
            const int v0 = u.pm * 256, lb = v0 >> 13, vv = v0 & (S - 1), r = vv >> (13 - lg), m0 = vv & ((1 << (13 - lg)) - 1);
            u.dla = dl; u.a = XBp + (unsigned)(lb * S + m0 * dl + r) * RB; u.b = W + (unsigned)u.pn * 256u * RB; }
        else { const int idx = L - 2048; u.pm = idx & 7; u.pn = idx >> 3; u.kind = 1;
            const int lg = u.pm < 2 ? 0 : (u.pm < 4 ? 2 : (u.pm < 6 ? 4 : 0)), dl = 1 << lg;
            const int v0 = u.pn * 256, lb = v0 >> 13, vv = v0 & (S - 1), r = vv >> (13 - lg), m0 = vv & ((1 << (13 - lg)) - 1);
            u.dla = 1; u.dlb = dl; u.a = W + (unsigned)(8192 + u.pm * 256) * RB; u.b = XBp + (unsigned)(lb * S + m0 * dl + r) * RB; }
        return true;
    }
};
DI int opq(int x) { asm volatile("" : "+v"(x)); return x; }
DI f32x4 acc_i2f(const f32x4& a) { const g8::i32x4v t = __builtin_bit_cast(g8::i32x4v, a); return (f32x4){(float)t[0], (float)t[1], (float)t[2], (float)t[3]}; }
DI int frag_row_off(int d0, int r32) { return (((d0 >> 4) * 64 + ((d0 >> 3) & 1) * 32 + r32) * 8); }
DI int pos2tok(int v, int lg) { const int lb = v >> 13, pos = v & (S - 1), per_lg = 13 - lg; return (lb << 13) + ((pos & ((1 << per_lg) - 1)) << lg) + (pos >> per_lg); }
template <int KIND>
struct EpiP1 {
    static constexpr bool PERM = true, HOOK = false;
    char* ws; int t0, pad;
    DI void hook(f32x4 (&)[2][2][4][2], const g8::Unit&, int, int, int, int, int) const {}
    DI void operator()(const f32x4 (&acc)[2][2][4][2], const g8::Unit& u, int wr, int wc, int fr_in, int fq_in) const {
        char* pr = ws + O_PASS; const float* xsc = (const float*)(ws + O_XSC) + t0; const float wsg = *(const float*)(ws + O_WSC);
        const int fr = opq(fr_in), fq = opq(fq_in);
        const int rowl = wr * 64 + fr, d0 = wc * 32 + 8 * fq;
        if constexpr (KIND == 1) {
            f32x4 xq[2][2];
            { const float* xg = xsc + (u.pm < 6 ? (u.pm >> 1) : 0) * M + u.pn * 256 + d0;
#pragma unroll
              for (int bj = 0; bj < 2; ++bj) { xq[bj][0] = *(const f32x4*)(xg + bj * 128) * wsg; xq[bj][1] = *(const f32x4*)(xg + bj * 128 + 4) * wsg; } }
#pragma unroll
            for (int ai = 0; ai < 2; ++ai)
#pragma unroll
                for (int m = 0; m < 4; ++m) { const int R = u.pm * 256 + rowl + ai * 128 + m * 16;
#pragma unroll
                    for (int bj = 0; bj < 2; ++bj) { f32x4 v0 = acc_i2f(acc[ai][bj][m][0]), v1 = acc_i2f(acc[ai][bj][m][1]);
                        const int c = u.pn * 256 + bj * 128 + d0;
                        v0 = v0 * xq[bj][0]; v1 = v1 * xq[bj][1];
                        if (R < 1536) {
                            const int gh = R >> 7, d = R & 127, lb = c >> 13, pos = c & (S - 1), kk = pos & 31;
                            bf16_t* blk = (bf16_t*)(pr + P_VT) + ((size_t)((lb * 12 + gh) * 256 + (pos >> 5))) * 4096 + (((d >> 5) * 2 + (kk >> 4)) * 64 + (d & 31)) * 8 + 4 * ((kk >> 3) & 1);
                            u32x2 wa, wb; wa.x = cvtpk(v0[0], v0[1]); wa.y = cvtpk(v0[2], v0[3]); wb.x = cvtpk(v1[0], v1[1]); wb.y = cvtpk(v1[2], v1[3]);
                            ST_G(wa, (u32x2*)blk); ST_G(wb, (u32x2*)(blk + 32 * 8));
                        } else {
                            u32x4 w; w.x = cvtpk(v0[0], v0[1]); w.y = cvtpk(v0[2], v0[3]); w.z = cvtpk(v1[0], v1[1]); w.w = cvtpk(v1[2], v1[3]);
                            ST_G(w, (u32x4*)((bf16_t*)(pr + P_IT) + (size_t)(R - 1536) * MP + c));
                        } }
                    asm volatile("" ::: "memory"); }
            return;
        } else {
        float xs8[2][4];
        { const int hp_ = u.pn < 12 ? (u.pn < 6 ? u.pn : u.pn - 6) : 0; const float* xr = xsc + (hp_ < 2 ? 0 : (hp_ < 4 ? 1 : 2)) * M + u.pm * 256 + rowl;
#pragma unroll
          for (int ai = 0; ai < 2; ++ai)
#pragma unroll
              for (int m = 0; m < 4; ++m) xs8[ai][m] = xr[ai * 128 + m * 16];
#pragma unroll
          for (int ai = 0; ai < 2; ++ai)
#pragma unroll
              for (int m = 0; m < 4; ++m) xs8[ai][m] *= wsg; }
        if (u.pn < 12 || u.pn == 18 || u.pn == 19) {
#pragma unroll
            for (int ai = 0; ai < 2; ++ai)
#pragma unroll
                for (int m = 0; m < 4; ++m) { const int row = u.pm * 256 + rowl + ai * 128 + m * 16;
                    const float xs = xs8[ai][m];
#pragma unroll
                    for (int bj = 0; bj < 2; ++bj) { f32x4 v0 = acc_i2f(acc[ai][bj][m][0]), v1 = acc_i2f(acc[ai][bj][m][1]);
                        v0 = v0 * xs; v1 = v1 * xs;
                        u32x4 w; w.x = cvtpk(v0[0], v0[1]); w.y = cvtpk(v0[2], v0[3]); w.z = cvtpk(v1[0], v1[1]); w.w = cvtpk(v1[2], v1[3]);
                        bf16_t* dst;
                        if (u.pn < 12) { const int hh = u.pn * 2 + bj, qk = hh >= 12 ? 1 : 0, gh = hh - 12 * qk;
                            const int lb = row >> 13, pos = row & (S - 1);
                            dst = (bf16_t*)(pr + P_QK) + ((size_t)(((qk * BPP + lb) * 12 + gh) * 256 + (pos >> 5))) * 4096 + frag_row_off(d0, pos & 31); }
                        else { const int h = (u.pn - 18) * 2 + bj; dst = (bf16_t*)(pr + P_MQ) + ((size_t)((row >> 5) * 4 + h)) * 4096 + frag_row_off(d0, row & 31); }
                        ST_G(w, (u32x4*)dst); }
                    asm volatile("" ::: "memory"); }
            return;
        }
        bf16_t* base; int ldc, colt; bool gate = false;
        if (u.pn < 18) { base = (bf16_t*)(pr + P_HFQG); ldc = 1536; colt = (u.pn - 12) * 256; }
        else { base = (bf16_t*)(pr + P_GATE); ldc = 3072; colt = (u.pn - 20) * 256; gate = true; }
        const int row0 = u.pm * 256 + rowl, col0 = colt + d0;
        f32x4 bv[2][2];
#pragma unroll
        for (int bj = 0; bj < 2; ++bj)
#pragma unroll
            for (int n = 0; n < 2; ++n) bv[bj][n] = gate ? *(const f32x4*)((const float*)(ws + O_BGATE) + col0 + bj * 128 + 4 * n) : (f32x4){0.f, 0.f, 0.f, 0.f};
#pragma unroll
        for (int ai = 0; ai < 2; ++ai)
#pragma unroll
            for (int m = 0; m < 4; ++m) { bf16_t* rowp = base + (size_t)(row0 + ai * 128 + m * 16) * ldc + col0;
                const float xs = xs8[ai][m];
#pragma unroll
                for (int bj = 0; bj < 2; ++bj) { f32x4 v0 = acc_i2f(acc[ai][bj][m][0]), v1 = acc_i2f(acc[ai][bj][m][1]);
                    v0 = v0 * xs; v1 = v1 * xs;
                    if (gate) { v0 = v0 + bv[bj][0]; v1 = v1 + bv[bj][1];
#pragma unroll
                        for (int e = 0; e < 4; ++e) { v0[e] = fast_sigmoid(v0[e]); v1[e] = fast_sigmoid(v1[e]); } }
                    u32x4 w; w.x = cvtpk(v0[0], v0[1]); w.y = cvtpk(v0[2], v0[3]); w.z = cvtpk(v1[0], v1[1]); w.w = cvtpk(v1[2], v1[3]);
                    ST_G(w, (u32x4*)(rowp + bj * 128)); }
                asm volatile("" ::: "memory"); }
        }
    }
};

typedef float f32x16 __attribute__((ext_vector_type(16)));
typedef short s16x4 __attribute__((ext_vector_type(4)));
DI int crow(int r, int hi) { return (r & 3) + 8 * (r >> 2) + 4 * hi; }
#define MFMA32(a, b, c) __builtin_amdgcn_mfma_f32_32x32x16_bf16((a), (b), (c), 0, 0, 0)
DI bf16x8 pack8(const f32x16& p, int s) {
    u32x4 w; w.x = cvtpk(p[8 * s + 0], p[8 * s + 1]); w.y = cvtpk(p[8 * s + 2], p[8 * s + 3]); w.z = cvtpk(p[8 * s + 4], p[8 * s + 5]); w.w = cvtpk(p[8 * s + 6], p[8 * s + 7]);
    return __builtin_bit_cast(bf16x8, w);
}
DI bf16x8 ldvt(const bf16_t* vp) {
    const s16x4 lo = *(const s16x4*)vp, hi4 = *(const s16x4*)(vp + 8);
    return __builtin_shufflevector(lo, hi4, 0, 1, 2, 3, 4, 5, 6, 7);
}
constexpr int DIL_TASKS = BPP * 12 * (S / 32);
constexpr int MEM_TASKS = (MP / 32) * 4;
DI void attn_dil_wave(const bf16_t* __restrict__ QK, const bf16_t* __restrict__ VT, const LAS float* btab, LAS unsigned char* ostg, bf16_t* __restrict__ OG, float* __restrict__ LSE, int task, int lane) {
    const int r32 = lane & 31, hi = lane >> 5;
    const int q32 = task & 255, gh = (task >> 8) % 12, lb = task / (256 * 12);
    const int g = gh >> 2, h = gh & 3, dl = dil_of(g), per = S / dl;
    const int tok0 = q32 * 32, r = tok0 / per, m0 = tok0 % per;
    const size_t rowq = (size_t)lb * S + (size_t)(m0 + r32) * dl + r;
    bf16x8 qf[8];
    const int tile0 = (r * per + m0) >> 5;
    { const bf16_t* qp = QK + ((size_t)((lb * 12 + gh) * 256 + tile0)) * 4096 + lane * 8;
#pragma unroll
      for (int ks = 0; ks < 8; ++ks) qf[ks] = *(const bf16x8*)(qp + ks * 512); }
    const LAS float* bt = btab + g * 129 * 4 + h;
    f32x16 o[4];
#pragma unroll
    for (int dt = 0; dt < 4; ++dt)
#pragma unroll
        for (int i = 0; i < 16; ++i) o[dt][i] = 0.f;
    float mrun = -INFINITY, sum = 0.f;
    const bf16_t* vbase = VT + ((size_t)((lb * 12 + gh) * 256 + tile0 - 4)) * 4096 + lane * 8;
    const bf16_t* kbase = QK + ((size_t)(((BPP + lb) * 12 + gh) * 256 + tile0 - 4)) * 4096 + lane * 8;
    const int kt0 = (m0 >= 128 ? 0 : (128 - m0) >> 5);
    bf16x8 kf[8], vf[8];
#pragma unroll
    for (int ks = 0; ks < 8; ++ks) kf[ks] = *(const bf16x8*)(kbase + (size_t)kt0 * 4096 + ks * 512);
#pragma unroll 1
    for (int kt = kt0; kt < 5; ++kt) {
#pragma unroll
        for (int i = 0; i < 8; ++i) vf[i] = *(const bf16x8*)(vbase + (size_t)kt * 4096 + i * 512);
        f32x16 sc;
#pragma unroll
        for (int i = 0; i < 16; ++i) sc[i] = 0.f;
#pragma unroll
        for (int ks = 0; ks < 8; ++ks) sc = MFMA32(kf[ks], qf[ks], sc);
        if (kt < 4) {
#pragma unroll
            for (int ks = 0; ks < 8; ++ks) kf[ks] = *(const bf16x8*)(kbase + (size_t)(kt + 1) * 4096 + ks * 512);
        }
        float mx = -INFINITY;
        if (kt == 0 || kt == 4) {
#pragma unroll
            for (int i = 0; i < 16; ++i) {
                const int delta = 128 - 32 * kt + r32 - crow(i, hi);
                const bool valid = (delta >= 0) && (delta <= 128);
                const int di = delta < 0 ? 0 : (delta > 128 ? 128 : delta);
                const float x = sc[i] * (QSCALE * LOG2E) + bt[di * 4];
                sc[i] = valid ? x : -INFINITY; mx = fmaxf(mx, sc[i]);
            }
        } else {
            const LAS float* btk = bt + (128 - 32 * kt + r32 - 4 * hi) * 4;
#pragma unroll
            for (int i = 0; i < 16; ++i) { sc[i] = sc[i] * (QSCALE * LOG2E) + btk[-4 * ((i & 3) + 8 * (i >> 2))]; mx = fmaxf(mx, sc[i]); }
        }
        mx = pair_max(mx);
        if (__any(mx > mrun + 8.f)) {
            const float mnew = fmaxf(mrun, mx); const float f = __builtin_amdgcn_exp2f(mrun - mnew);
            sum *= f;
#pragma unroll
            for (int dt = 0; dt < 4; ++dt)
#pragma unroll
                for (int i = 0; i < 16; ++i) o[dt][i] *= f;
            mrun = mnew;
        }
        float ps = 0.f;
#pragma unroll
        for (int i = 0; i < 16; ++i) { sc[i] = __builtin_amdgcn_exp2f(sc[i] - mrun); ps += sc[i]; }
        ps = pair_sum(ps); sum += ps;
#pragma unroll
        for (int s = 0; s < 2; ++s) {
            const bf16x8 pb = pack8(sc, s);
#pragma unroll
            for (int dt = 0; dt < 4; ++dt) o[dt] = MFMA32(vf[dt * 2 + s], pb, o[dt]);
        }
    }
    const float inv = 1.f / sum;
#pragma unroll
    for (int dt = 0; dt < 4; ++dt)
#pragma unroll
        for (int a = 0; a < 4; ++a) { u32x2 w; w.x = cvtpk(o[dt][4 * a] * inv, o[dt][4 * a + 1] * inv); w.y = cvtpk(o[dt][4 * a + 2] * inv, o[dt][4 * a + 3] * inv);
            *(LAS u32x2*)(ostg + r32 * 272 + (32 * dt + 8 * a + 4 * hi) * 2) = w; }
    asm volatile("s_waitcnt lgkmcnt(0)" ::: "memory");
#pragma unroll
    for (int it = 0; it < 8; ++it) { const int rr = 4 * it + (lane >> 4), ch = lane & 15;
        const u32x4 w = *(const LAS u32x4*)(ostg + rr * 272 + ch * 16);
        *(u32x4*)(OG + ((size_t)lb * S + (size_t)(m0 + rr) * dl + r) * 1536 + g * 512 + h * 128 + ch * 8) = w; }
    asm volatile("s_waitcnt lgkmcnt(0)" ::: "memory");
    if (hi == 0) LSE[rowq * 12 + gh] = (mrun + __builtin_amdgcn_logf(sum)) * 0.6931471805599453f;
}
DI void attn_mem_wave(const bf16_t* __restrict__ MQ, const bf16_t* __restrict__ MK, const bf16_t* __restrict__ MVT, bf16_t* __restrict__ BR, int task, int batch0, int lane) {
    const int r32 = lane & 31, hi = lane >> 5;
    const int h = task & 3, blk = task >> 2;
    const size_t rowq = (size_t)blk * 32 + r32; const int b = batch0 + blk * 32 / S;
    bf16x8 qf[8];
    { const bf16_t* qp = MQ + ((size_t)(blk * 4 + h)) * 4096 + lane * 8;
#pragma unroll
      for (int ks = 0; ks < 8; ++ks) qf[ks] = *(const bf16x8*)(qp + ks * 512); }
    f32x16 o[4];
#pragma unroll
    for (int dt = 0; dt < 4; ++dt)
#pragma unroll
        for (int i = 0; i < 16; ++i) o[dt][i] = 0.f;
    float mrun = -INFINITY, sum = 0.f;
    const bf16_t* vbase = MVT + ((size_t)((b * 4 + h) * 8)) * 4096 + lane * 8;
    const bf16_t* kbase = MK + ((size_t)((b * 4 + h) * 8)) * 4096 + lane * 8;
#pragma unroll 1
    for (int c = 0; c < 4; ++c) {
        bf16x8 vf[16];
#pragma unroll
        for (int i = 0; i < 16; ++i) vf[i] = *(const bf16x8*)(vbase + (size_t)(c * 2 + (i >> 3)) * 4096 + (i & 7) * 512);
        f32x16 sc[2]; float mx = -INFINITY;
#pragma unroll
        for (int kt = 0; kt < 2; ++kt) {
            const bf16_t* kp = kbase + (size_t)(c * 2 + kt) * 4096;
            f32x16 acc;
#pragma unroll
            for (int i = 0; i < 16; ++i) acc[i] = 0.f;
#pragma unroll
            for (int ks = 0; ks < 8; ++ks) { const bf16x8 kf = *(const bf16x8*)(kp + ks * 512); acc = MFMA32(kf, qf[ks], acc); }
#pragma unroll
            for (int i = 0; i < 16; ++i) { sc[kt][i] = acc[i] * (QSCALE * LOG2E); mx = fmaxf(mx, sc[kt][i]); }
            asm volatile("" ::: "memory");
        }
        mx = pair_max(mx);
        if (__any(mx > mrun + 8.f)) {
            const float mnew = fmaxf(mrun, mx); const float f = __builtin_amdgcn_exp2f(mrun - mnew);
            sum *= f;
#pragma unroll
            for (int dt = 0; dt < 4; ++dt)
#pragma unroll
                for (int i = 0; i < 16; ++i) o[dt][i] *= f;
            mrun = mnew;
        }
        float ps = 0.f;
#pragma unroll
        for (int kt = 0; kt < 2; ++kt)
#pragma unroll
            for (int i = 0; i < 16; ++i) { sc[kt][i] = __builtin_amdgcn_exp2f(sc[kt][i] - mrun); ps += sc[kt][i]; }
        ps = pair_sum(ps); sum += ps;
#pragma unroll
        for (int kt = 0; kt < 2; ++kt)
#pragma unroll
            for (int s = 0; s < 2; ++s) {
                const bf16x8 pb = pack8(sc[kt], s);
#pragma unroll
                for (int dt = 0; dt < 4; ++dt) o[dt] = MFMA32(vf[kt * 8 + dt * 2 + s], pb, o[dt]);
                asm volatile("" ::: "memory");
            }
    }
    const float inv = 1.f / sum;
    bf16_t* op = BR + rowq * 1536 + 1024 + h * 128 + 4 * hi;
#pragma unroll
    for (int dt = 0; dt < 4; ++dt)
#pragma unroll
        for (int a = 0; a < 4; ++a) { u32x2 w; w.x = cvtpk(o[dt][4 * a] * inv, o[dt][4 * a + 1] * inv); w.y = cvtpk(o[dt][4 * a + 2] * inv, o[dt][4 * a + 3] * inv); *(u32x2*)(op + 32 * dt + 8 * a) = w; }
}

constexpr int HG_SCH = 4, HG_UPS = S / 64 / HG_SCH  , HG_UNITS = BPP * 4 * HG_UPS  ;
constexpr int HG_ROW = 136, HG_KT_ROW = 72;
constexpr int HG_KP = 0, HG_QP = 64 * HG_ROW * 2, HG_QPP = 2 * HG_QP, HG_KPPT = 3 * HG_QP, HG_DEC = HG_KPPT + 128 * HG_KT_ROW * 2, HG_SSQ = HG_DEC + 512, HG_PSUM = HG_SSQ + 1024, HG_UNIT_BYTES = HG_PSUM + 2048;
DI bf16x8 lds_ld2x8(const LAS unsigned char* p) {
    const s16x4 lo = *(const LAS s16x4*)p, hi4 = *(const LAS s16x4*)(p + 16);
    return __builtin_shufflevector(lo, hi4, 0, 1, 2, 3, 4, 5, 6, 7);
}
DI float lds_bf(const LAS unsigned char* p) { return __uint_as_float((unsigned)(*(const LAS unsigned short*)p) << 16); }
template <bool MAIN>
DI void hgrn_unit(LAS unsigned char* ul, int unit, int u, const bf16_t* __restrict__ HFQG, const bf16_t* __restrict__ IT, const float* __restrict__ lbv, const float* __restrict__ nwv,
                  float* HSTL, float* HSTD, const float* __restrict__ SIN, bf16_t* __restrict__ BR) {
    constexpr int NX = MAIN ? 4 : 2;
    const int lane = u & 63, w = u >> 6, r32 = lane & 31, hi = lane >> 5, dvt = w & 3, wh = w >> 2;
    const int seq = unit / HG_UPS, j = unit % HG_UPS, lb = seq >> 2, h = seq & 3;
    const int dk = u & 127, qt = u >> 7, cb = 16 * qt;
    const float lbd = lbv[h * 128 + dk];
    const size_t row0 = (size_t)lb * S + (size_t)j * (64 * HG_SCH);
    LAS unsigned char* Kp = ul + HG_KP; LAS unsigned char* Qp = ul + HG_QP; LAS unsigned char* Qpp = ul + HG_QPP; LAS unsigned char* KppT = ul + HG_KPPT;
    LAS float* dec = (LAS float*)(ul + HG_DEC); LAS float* ssq = (LAS float*)(ul + HG_SSQ); LAS float* psum = (LAS float*)(ul + HG_PSUM);
    const int dk0 = MAIN ? 0 : 64 * wh;
    f32x16 X[NX];
    if (MAIN) {
        const float* Sp = SIN + (size_t)unit * 16384 + 32 * dvt + r32;
#pragma unroll
        for (int t = 0; t < NX; ++t)
#pragma unroll
            for (int i = 0; i < 16; ++i) X[t][i] = Sp[(size_t)(32 * t + crow(i, hi)) * 128];
    } else {
#pragma unroll
        for (int t = 0; t < NX; ++t)
#pragma unroll
            for (int i = 0; i < 16; ++i) X[t][i] = 0.f;
    }
    float atot = 0.f;
    u32x4 sf[2], sq[2];
    {
        const int sc0 = u >> 4, sch = (u & 15) * 8;
        const bf16_t* fp = HFQG + (row0 + sc0) * 1536 + h * 128 + sch;
#pragma unroll
        for (int i = 0; i < 2; ++i) { sf[i] = *(const u32x4*)(fp + (size_t)(32 * i) * 1536); if (MAIN) sq[i] = *(const u32x4*)(fp + (size_t)(32 * i) * 1536 + 512); }
    }
#pragma unroll 1
    for (int ch = 0; ch < HG_SCH; ++ch) {
        const size_t rc = row0 + (size_t)ch * 64;
        {
            const int sc0 = opq(u) >> 4, sch = (opq(u) & 15) * 8;
#pragma unroll
            for (int i = 0; i < 2; ++i) { *(LAS u32x4*)(Kp + ((sc0 + 32 * i) * HG_ROW + sch) * 2) = sf[i]; if (MAIN) *(LAS u32x4*)(Qp + ((sc0 + 32 * i) * HG_ROW + sch) * 2) = sq[i]; }
        }
        __syncthreads();
        const bf16_t* itrow = IT + (size_t)(h * 128 + 32 * dvt + opq(r32)) * MP;
        bf16x8 ib[4], it0[2], it1[2]; u32x2 gwv[4];
#pragma unroll
        for (int ks = 0; ks < 4; ++ks) ib[ks] = *(const bf16x8*)(itrow + rc + 16 * ks + 8 * hi);
        if (MAIN) {
#pragma unroll
            for (int step = 0; step < 2; ++step) { it0[step] = ldvt(itrow + rc + 16 * step + 4 * hi); it1[step] = ldvt(itrow + rc + 32 + 16 * step + 4 * hi); }
            const size_t grow = rc + 32 * wh + opq(r32);
#pragma unroll
            for (int a4 = 0; a4 < 4; ++a4) gwv[a4] = *(const u32x2*)(HFQG + grow * 1536 + 1024 + h * 128 + 32 * dvt + 4 * opq(hi) + 8 * a4);
        }
        float fv[16], lf[16];
        {
            float s = 0.f;
#pragma unroll
            for (int i = 0; i < 16; ++i) { fv[i] = lbd + (1.f - lbd) * fast_sigmoid(lds_bf(Kp + ((cb + i) * HG_ROW + dk) * 2)); lf[i] = __builtin_amdgcn_logf(fv[i]); s += lf[i]; }
            psum[qt * 128 + dk] = s;
        }
        __syncthreads();
        {
            const float p0 = psum[dk], p1 = psum[128 + dk], p2 = psum[256 + dk], p3 = psum[384 + dk];
            const float amid = p0 + p1, alast = (p0 + p1) + (p2 + p3);
            float run = qt == 0 ? 0.f : (qt == 1 ? p0 : (qt == 2 ? amid : amid + p2));
            atot += alast;
            const float Ela = __builtin_amdgcn_exp2f(alast - amid), Ea = __builtin_amdgcn_exp2f(amid);
#pragma unroll
            for (int c8 = 0; c8 < 2; ++c8) {
                float kt[8];
#pragma unroll
                for (int e = 0; e < 8; ++e) { const int i = 8 * c8 + e, c = cb + i; run += lf[i]; const float key = 1.f - fv[i];
                    const float e1 = __builtin_amdgcn_exp2f(amid - run);
                    const float kp = key * e1;
                    kt[e] = kp * Ela;
                    if (MAIN) { *(LAS bf16_t*)(Kp + (c * HG_ROW + dk) * 2) = (bf16_t)cvtpk(kp, kp);
                        const float qp = lds_bf(Qp + (c * HG_ROW + dk) * 2) * __builtin_amdgcn_rcpf(e1);
                        *(LAS bf16_t*)(Qp + (c * HG_ROW + dk) * 2) = (bf16_t)cvtpk(qp, qp);
                        *(LAS bf16_t*)(Qpp + (c * HG_ROW + dk) * 2) = (bf16_t)cvtpk(qp * Ea, qp * Ea); } }
                u32x4 wv; wv.x = cvtpk(kt[0], kt[1]); wv.y = cvtpk(kt[2], kt[3]); wv.z = cvtpk(kt[4], kt[5]); wv.w = cvtpk(kt[6], kt[7]);
                *(LAS u32x4*)(KppT + (dk * HG_KT_ROW + cb + 8 * c8) * 2) = wv;
            }
            if (qt == 0) dec[dk] = __builtin_amdgcn_exp2f(alast);
        }
        if (ch + 1 < HG_SCH) {
            const int sc0 = opq(u) >> 4, sch = (opq(u) & 15) * 8;
            const bf16_t* fp = HFQG + (rc + 64 + sc0) * 1536 + h * 128 + sch;
#pragma unroll
            for (int i = 0; i < 2; ++i) { sf[i] = *(const u32x4*)(fp + (size_t)(32 * i) * 1536); if (MAIN) sq[i] = *(const u32x4*)(fp + (size_t)(32 * i) * 1536 + 512); }
        }
        __syncthreads();
        f32x16 o;
        if (MAIN) {
#pragma unroll
            for (int i = 0; i < 16; ++i) o[i] = 0.f;
            const LAS unsigned char* qrow = Qpp + ((32 * wh + r32) * HG_ROW) * 2;
#pragma unroll
            for (int t = 0; t < 4; ++t)
#pragma unroll
                for (int step = 0; step < 2; ++step) { o = MFMA32(pack8(X[t], step), lds_ld2x8(qrow + (32 * t + 16 * step + 4 * hi) * 2), o); }
            __builtin_amdgcn_sched_barrier(0);
            const int r32m = opq(r32);
            const LAS unsigned char* qprow = Qp + ((32 * wh + r32) * HG_ROW) * 2;
            {
                f32x16 sc;
#pragma unroll
                for (int i = 0; i < 16; ++i) sc[i] = 0.f;
#pragma unroll
                for (int ks = 0; ks < 8; ++ks) { const int cof = (16 * ks + 8 * hi) * 2; sc = MFMA32(*(const LAS bf16x8*)(Kp + (r32 * HG_ROW) * 2 + cof), *(const LAS bf16x8*)(qprow + cof), sc); }
                if (wh == 0) {
#pragma unroll
                    for (int i = 0; i < 16; ++i) sc[i] = (crow(i, hi) <= r32m) ? sc[i] : 0.f;
                }
#pragma unroll
                for (int step = 0; step < 2; ++step) o = MFMA32(it0[step], pack8(sc, step), o);
                __builtin_amdgcn_sched_barrier(0);
            }
            if (wh == 1) {
                f32x16 sc;
#pragma unroll
                for (int i = 0; i < 16; ++i) sc[i] = 0.f;
#pragma unroll
                for (int ks = 0; ks < 8; ++ks) { const int cof = (16 * ks + 8 * hi) * 2; sc = MFMA32(*(const LAS bf16x8*)(Kp + ((32 + r32) * HG_ROW) * 2 + cof), *(const LAS bf16x8*)(qprow + cof), sc); }
#pragma unroll
                for (int i = 0; i < 16; ++i) sc[i] = (crow(i, hi) <= r32m) ? sc[i] : 0.f;
#pragma unroll
                for (int step = 0; step < 2; ++step) o = MFMA32(it1[step], pack8(sc, step), o);
                __builtin_amdgcn_sched_barrier(0);
            }
        }
        {
#pragma unroll
            for (int t = 0; t < NX; ++t) {
#pragma unroll
                for (int i = 0; i < 16; ++i) X[t][i] *= dec[dk0 + 32 * t + crow(i, hi)];
#pragma unroll
                for (int ks = 0; ks < 4; ++ks) { const bf16x8 ka = *(const LAS bf16x8*)(KppT + ((dk0 + 32 * t + r32) * HG_KT_ROW + 16 * ks + 8 * hi) * 2); X[t] = MFMA32(ka, ib[ks], X[t]); }
                __builtin_amdgcn_sched_barrier(0);
            }
        }
        if (MAIN) {
            float q2 = 0.f;
#pragma unroll
            for (int i = 0; i < 16; ++i) q2 += o[i] * o[i];
            q2 = pair_sum(q2); if (hi == 0) ssq[dvt * 64 + 32 * wh + r32] = q2;
        }
        __syncthreads();
        if (MAIN) {
            const int r32o = opq(r32), hio = opq(hi);
            const int c = 32 * wh + r32o; const float tot = ssq[c] + ssq[64 + c] + ssq[128 + c] + ssq[192 + c];
            const float rs = rsqrtf(tot * (1.f / 128.f) + LN_EPS);
            const size_t row = rc + c; const int col = h * 128 + 32 * dvt + 4 * hio;
#pragma unroll
            for (int a4 = 0; a4 < 4; ++a4) {
                const u32x2 gw = gwv[a4]; const f32x4 nw4 = *(const f32x4*)(nwv + col + 8 * a4);
                const float g0 = __uint_as_float(gw.x << 16), g1 = __uint_as_float(gw.x & 0xffff0000u), g2 = __uint_as_float(gw.y << 16), g3 = __uint_as_float(gw.y & 0xffff0000u);
                const float v0 = o[4 * a4] * rs * nw4[0] * g0 * fast_sigmoid(g0), v1 = o[4 * a4 + 1] * rs * nw4[1] * g1 * fast_sigmoid(g1);
                const float v2 = o[4 * a4 + 2] * rs * nw4[2] * g2 * fast_sigmoid(g2), v3 = o[4 * a4 + 3] * rs * nw4[3] * g3 * fast_sigmoid(g3);
                u32x2 wv; wv.x = cvtpk(v0, v1); wv.y = cvtpk(v2, v3);
                *(u32x2*)(BR + row * 1536 + 512 + col + 8 * a4) = wv;
            }
        }
    }
    if (!MAIN) {
        float* L = HSTL + (size_t)unit * 16384 + 32 * dvt + r32;
#pragma unroll
        for (int t = 0; t < NX; ++t)
#pragma unroll
            for (int i = 0; i < 16; ++i) L[(size_t)(dk0 + 32 * t + crow(i, hi)) * 128] = X[t][i];
        if (qt == 0) HSTD[(size_t)unit * 128 + dk] = __builtin_amdgcn_exp2f(atot);
    }
}
DI void hgrn_scan(const float* __restrict__ HSTL, const float* __restrict__ HSTD, float* __restrict__ SIN, int gt) {
    if (gt >= BPP * 4 * 16384) return;
    const int seq = gt >> 14, el = gt & 16383, dkk = el >> 7;
    float st = 0.f;
    for (int j = 0; j < HG_UPS; ++j) { const size_t uo = (size_t)(seq * HG_UPS + j); SIN[uo * 16384 + el] = st; st = HSTD[uo * 128 + dkk] * st + HSTL[uo * 16384 + el]; }
}

struct SchedRows {
    unsigned A, B; int K, nN, nU, G, c;
    DI bool next(int i, g8::Unit& u) const {
        const int L = i * G + c; if (L >= nU) return false;
        const int x = L & 7, off = L >> 3, grp = off / (8 * nN), o2 = off % (8 * nN);
        const int ppx = nU / nN / 8;
        u.pm = x * ppx + 8 * grp + (o2 & 7); u.pn = o2 >> 3; u.kind = 0; u.dla = 1; u.dlb = 1;
        u.a = A + (unsigned)u.pm * 256u * K * 2u; u.b = B + (unsigned)u.pn * 256u * K * 2u; return true;
    }
};
DI void unpack8(const u32x4 w, float (&f)[8]) {
    f[0] = __uint_as_float(w.x << 16); f[1] = __uint_as_float(w.x & 0xffff0000u); f[2] = __uint_as_float(w.y << 16); f[3] = __uint_as_float(w.y & 0xffff0000u);
    f[4] = __uint_as_float(w.z << 16); f[5] = __uint_as_float(w.z & 0xffff0000u); f[6] = __uint_as_float(w.w << 16); f[7] = __uint_as_float(w.w & 0xffff0000u);
}
struct EpiWidenF {
    static constexpr bool PERM = true, HOOK = true;
    const bf16_t* GATE; bf16_t* MERGED;
    DI void hook(f32x4 (&acc)[2][2][4][2], const g8::Unit& u, int t, int wr, int wc, int fr, int fq) const {
        if (t != 8 && t != 16) return;
        const int g = (t >> 3) - 1;
        const int row0 = u.pm * 256 + wr * 64 + fr, col0 = u.pn * 256 + wc * 32 + 8 * fq;
#pragma unroll
        for (int ai = 0; ai < 2; ++ai)
#pragma unroll
            for (int m = 0; m < 4; ++m) { const bf16_t* gp = GATE + (size_t)(row0 + ai * 128 + m * 16) * 3072 + g * 1024 + col0;
#pragma unroll
                for (int bj = 0; bj < 2; ++bj) { float ga[8], gb[8]; unpack8(*(const u32x4*)(gp + bj * 128), ga); unpack8(*(const u32x4*)(gp + 1024 + bj * 128), gb);
#pragma unroll
                    for (int e = 0; e < 4; ++e) { acc[ai][bj][m][0][e] *= ga[e] * __builtin_amdgcn_rcpf(gb[e]); acc[ai][bj][m][1][e] *= ga[4 + e] * __builtin_amdgcn_rcpf(gb[4 + e]); } } }
    }
    DI void operator()(const f32x4 (&acc)[2][2][4][2], const g8::Unit& u, int wr, int wc, int fr, int fq) const {
        const int row0 = u.pm * 256 + wr * 64 + fr, col0 = u.pn * 256 + wc * 32 + 8 * fq;
#pragma unroll
        for (int ai = 0; ai < 2; ++ai)
#pragma unroll
            for (int m = 0; m < 4; ++m) { const size_t row = (size_t)(row0 + ai * 128 + m * 16);
#pragma unroll
                for (int bj = 0; bj < 2; ++bj) { float gc[8]; unpack8(*(const u32x4*)(GATE + row * 3072 + 2048 + col0 + bj * 128), gc);
                    const f32x4 v0 = acc[ai][bj][m][0], v1 = acc[ai][bj][m][1];
                    u32x4 w; w.x = cvtpk(v0[0] * gc[0], v0[1] * gc[1]); w.y = cvtpk(v0[2] * gc[2], v0[3] * gc[3]); w.z = cvtpk(v1[0] * gc[4], v1[1] * gc[5]); w.w = cvtpk(v1[2] * gc[6], v1[3] * gc[7]);
                    *(u32x4*)(MERGED + row * 1024 + col0 + bj * 128) = w; } }
    }
};
struct EpiScores {
    static constexpr bool PERM = true, HOOK = false;
    bf16_t* SC; const float* hsc; const float* wsc;
    DI void hook(f32x4 (&)[2][2][4][2], const g8::Unit&, int, int, int, int, int) const {}
    DI void operator()(const f32x4 (&acc)[2][2][4][2], const g8::Unit& u, int wr, int wc, int fr, int fq) const {
        const int rowl = wr * 64 + fr, d0 = wc * 32 + 8 * fq;
        float xs8[2][4];
        { const float* xr = hsc + u.pm * 256 + rowl; const float wsg = wsc[0];
#pragma unroll
          for (int ai = 0; ai < 2; ++ai)
#pragma unroll
              for (int m = 0; m < 4; ++m) xs8[ai][m] = xr[ai * 128 + m * 16];
#pragma unroll
          for (int ai = 0; ai < 2; ++ai)
#pragma unroll
              for (int m = 0; m < 4; ++m) xs8[ai][m] *= wsg; }
#pragma unroll
        for (int ai = 0; ai < 2; ++ai)
#pragma unroll
            for (int m = 0; m < 4; ++m) { const int row = u.pm * 256 + rowl + ai * 128 + m * 16;
#pragma unroll
                for (int bj = 0; bj < 2; ++bj) { const f32x4 v0 = acc_i2f(acc[ai][bj][m][0]) * xs8[ai][m], v1 = acc_i2f(acc[ai][bj][m][1]) * xs8[ai][m];
                    u32x4 w; w.x = cvtpk(v0[0], v0[1]); w.y = cvtpk(v0[2], v0[3]); w.z = cvtpk(v1[0], v1[1]); w.w = cvtpk(v1[2], v1[3]);
                    *(u32x4*)(SC + ((size_t)((row >> 5) * 16 + u.pn * 2 + bj)) * 4096 + frag_row_off(d0, row & 31)) = w; } }
    }
};
struct EpiPlainB16 {
    static constexpr bool PERM = true, HOOK = false;
    bf16_t* C; int ldc, pad;
    DI void hook(f32x4 (&)[2][2][4][2], const g8::Unit&, int, int, int, int, int) const {}
    DI void operator()(const f32x4 (&acc)[2][2][4][2], const g8::Unit& u, int wr, int wc, int fr, int fq) const {
        const int row0 = u.pm * 256 + wr * 64 + fr, col0 = u.pn * 256 + wc * 32 + 8 * fq;
#pragma unroll
        for (int ai = 0; ai < 2; ++ai)
#pragma unroll
            for (int m = 0; m < 4; ++m) { bf16_t* rowp = C + (size_t)(row0 + ai * 128 + m * 16) * ldc + col0;
#pragma unroll
                for (int bj = 0; bj < 2; ++bj) { const f32x4 v0 = acc[ai][bj][m][0], v1 = acc[ai][bj][m][1];
                    u32x4 w; w.x = cvtpk(v0[0], v0[1]); w.y = cvtpk(v0[2], v0[3]); w.z = cvtpk(v1[0], v1[1]); w.w = cvtpk(v1[2], v1[3]);
                    *(u32x4*)(rowp + bj * 128) = w; } }
    }
};
DI void lse_merge_items(const bf16_t* __restrict__ OG, const float* __restrict__ LSE, bf16_t* __restrict__ BR, int first, int stride) {
    for (int it0 = first; it0 < MP * 64; it0 += 4 * stride) {
        u32x4 va[4], vb[4], vc[4]; float l0[4], l1[4], l2[4];
#pragma unroll
        for (int u = 0; u < 4; ++u) { const int it = it0 + u * stride; const int row = it >> 6, c8 = it & 63, h = c8 >> 4;
            const bf16_t* og = OG + (size_t)row * 1536 + c8 * 8;
            va[u] = *(const u32x4*)og; vb[u] = *(const u32x4*)(og + 512); vc[u] = *(const u32x4*)(og + 1024);
            l0[u] = LSE[(size_t)row * 12 + h]; l1[u] = LSE[(size_t)row * 12 + 4 + h]; l2[u] = LSE[(size_t)row * 12 + 8 + h]; }
#pragma unroll
        for (int u = 0; u < 4; ++u) { const int it = it0 + u * stride; const int row = it >> 6, c8 = it & 63;
            const float mx = fmaxf(l0[u], fmaxf(l1[u], l2[u])); const float e0 = __expf(l0[u] - mx), e1 = __expf(l1[u] - mx), e2 = __expf(l2[u] - mx); const float inv = 1.f / (e0 + e1 + e2);
            float a[8], b[8], c[8]; unpack8(va[u], a); unpack8(vb[u], b); unpack8(vc[u], c);
            float r[8];
#pragma unroll
            for (int e = 0; e < 8; ++e) r[e] = (e0 * a[e] + e1 * b[e] + e2 * c[e]) * inv;
            u32x4 w; w.x = cvtpk(r[0], r[1]); w.y = cvtpk(r[2], r[3]); w.z = cvtpk(r[4], r[5]); w.w = cvtpk(r[6], r[7]);
            *(u32x4*)(BR + (size_t)row * 1536 + c8 * 8) = w; }
    }
}
template <int NR>
DI void ln1_rows(const bf16_t* __restrict__ x, const bf16_t* __restrict__ mix, const float* __restrict__ g, const float* __restrict__ b, bf16_t* __restrict__ h1b, unsigned char* __restrict__ h1q, float* __restrict__ hsc, int wave0, int nwaves, int lane) {
    for (int row0 = wave0 * NR; row0 < MP; row0 += nwaves * NR) {
        u32x4 xa[NR], xb[NR], ma[NR], mb[NR];
#pragma unroll
        for (int r = 0; r < NR; ++r) { const size_t o = (size_t)(row0 + r) * D + 16 * lane;
            xa[r] = *(const u32x4*)(x + o); xb[r] = *(const u32x4*)(x + o + 8); ma[r] = *(const u32x4*)(mix + o); mb[r] = *(const u32x4*)(mix + o + 8); }
#pragma unroll
        for (int r = 0; r < NR; ++r) {
            const int row = row0 + r;
            float xf[16], mf[16]; unpack8(xa[r], *(float(*)[8])&xf[0]); unpack8(xb[r], *(float(*)[8])&xf[8]); unpack8(ma[r], *(float(*)[8])&mf[0]); unpack8(mb[r], *(float(*)[8])&mf[8]);
            f32x4 v[4]; float s = 0.f;
#pragma unroll
            for (int j = 0; j < 4; ++j) {
#pragma unroll
                for (int e = 0; e < 4; ++e) { v[j][e] = xf[4 * j + e] * ALPHA + mf[4 * j + e]; s += v[j][e]; } }
            const float mean = wave_sum(s) * (1.f / D); float q = 0.f;
#pragma unroll
            for (int j = 0; j < 4; ++j) { v[j] = v[j] - mean; q += (v[j][0] * v[j][0] + v[j][1] * v[j][1]) + (v[j][2] * v[j][2] + v[j][3] * v[j][3]); }
            const float rstd = rsqrtf(wave_sum(q) * (1.f / D) + LN_EPS);
            u32x4 o0, o1; float amax = 0.f;
#pragma unroll
            for (int j = 0; j < 4; ++j) { const f32x4 gg = *(const f32x4*)(g + 16 * lane + 4 * j), bb = *(const f32x4*)(b + 16 * lane + 4 * j); const f32x4 o = v[j] * rstd * gg + bb; v[j] = o;
                amax = fmaxf(amax, fmaxf(fmaxf(fabsf(o[0]), fabsf(o[1])), fmaxf(fabsf(o[2]), fabsf(o[3]))));
                if (j < 2) { o0[2 * j] = cvtpk(o[0], o[1]); o0[2 * j + 1] = cvtpk(o[2], o[3]); } else { o1[2 * (j - 2)] = cvtpk(o[0], o[1]); o1[2 * (j - 2) + 1] = cvtpk(o[2], o[3]); } }
            amax = wave_max(amax); const float qs = amax > 0.f ? 127.f / amax : 1.f;
            u32x4 qv;
#pragma unroll
            for (int j = 0; j < 4; ++j) qv[j] = ((unsigned)__float2int_rn(v[j][0] * qs) & 0xffu) | (((unsigned)__float2int_rn(v[j][1] * qs) & 0xffu) << 8) | (((unsigned)__float2int_rn(v[j][2] * qs) & 0xffu) << 16) | (((unsigned)__float2int_rn(v[j][3] * qs) & 0xffu) << 24);
            *(u32x4*)(h1q + (size_t)row * D + 16 * lane) = qv;
            if (lane == 0) hsc[row] = amax > 0.f ? amax * (1.f / 127.f) : 1.f;
        }
    }
}

DI unsigned mono(float f) { const unsigned u = __float_as_uint(f); return (u & 0x80000000u) ? ~u : (u | 0x80000000u); }
DI float demono(unsigned m) { return __uint_as_float((m & 0x80000000u) ? (m & 0x7fffffffu) : ~m); }
#define CE_DESC(a, b) do { const unsigned _hi = (a) > (b) ? (a) : (b), _lo = (a) > (b) ? (b) : (a); (a) = _hi; (b) = _lo; } while (0)
DI void sort16_desc(unsigned (&k)[16]) {
#pragma unroll
    for (int size = 2; size <= 16; size <<= 1)
#pragma unroll
        for (int stride = size >> 1; stride > 0; stride >>= 1)
#pragma unroll
            for (int i = 0; i < 16; ++i) { const int j = i ^ stride;
                if (j > i) { if ((i & size) == 0 || size == 16) CE_DESC(k[i], k[j]); else CE_DESC(k[j], k[i]); } }
}
DI void merge_top16(unsigned (&t)[16], const unsigned (&l)[16]) {
#pragma unroll
    for (int i = 0; i < 16; ++i) t[i] = t[i] > l[15 - i] ? t[i] : l[15 - i];
#pragma unroll
    for (int stride = 8; stride > 0; stride >>= 1)
#pragma unroll
        for (int i = 0; i < 16; ++i) { const int j = i ^ stride; if (j > i) CE_DESC(t[i], t[j]); }
}
DI void route_wave(const bf16_t* __restrict__ SC, int* __restrict__ IDX, float* __restrict__ PG, int tb, int h, int lane) {
    const int r32 = lane & 31, hi = lane >> 5;
    const size_t tok = (size_t)tb * 32 + r32;
    unsigned Tp[2][16];
#pragma unroll
    for (int p = 0; p < 2; ++p) {
        const bf16_t* sp = SC + ((size_t)(tb * 16 + h * 2 + p)) * 4096 + lane * 8;
        u32x4 sv[8];
#pragma unroll
        for (int ks = 0; ks < 8; ++ks) sv[ks] = *(const u32x4*)(sp + ks * 512);
#pragma unroll
        for (int nt = 0; nt < 4; ++nt) {
            unsigned L[16];
#pragma unroll
            for (int e = 0; e < 16; ++e) { const int ks = 2 * nt + (e >> 3), j = e & 7; const unsigned w = sv[ks][j >> 1];
                const float sc = __uint_as_float((j & 1) ? (w & 0xffff0000u) : (w << 16));
                L[e] = (mono(sc) & ~0x7fu) | (unsigned)(127 - (16 * ks + 8 * hi + j)); }
            sort16_desc(L);
            if (nt == 0) {
#pragma unroll
                for (int i = 0; i < 16; ++i) Tp[p][i] = L[i];
            } else merge_top16(Tp[p], L);
            __builtin_amdgcn_sched_barrier(0);
        }
    }
    unsigned T[16];
    { unsigned O[16];
#pragma unroll
      for (int i = 0; i < 16; ++i) { const auto rr = __builtin_amdgcn_permlane32_swap(Tp[0][i], Tp[1][i], false, false); T[i] = rr[0]; O[i] = rr[1]; }
      merge_top16(T, O); }
    __builtin_amdgcn_sched_barrier(0);
    float s1[16], s2[16]; unsigned i1[16], i2[16];
#pragma unroll
    for (int i = 0; i < 16; ++i) { const auto rr = __builtin_amdgcn_permlane32_swap(T[i], T[i], false, false);
        s1[i] = demono(rr[0] & ~0x7fu); i1[i] = 127u - (rr[0] & 0x7fu); s2[i] = demono(rr[1] & ~0x7fu); i2[i] = 127u - (rr[1] & 0x7fu); }
    unsigned C[64];
    { int n = 0;
#pragma unroll
      for (int a = 0; a < 16; ++a)
#pragma unroll
          for (int b = 0; b < 16; ++b) if ((a + 1) * (b + 1) <= 16) { C[n] = (mono(s1[a] + s2[b]) & ~0x3fffu) | (i1[a] << 7) | i2[b]; ++n; }
#pragma unroll
      for (int i = 50; i < 64; ++i) C[i] = 0u; }
    unsigned F[16];
#pragma unroll
    for (int i = 0; i < 16; ++i) F[i] = C[i];
    sort16_desc(F);
#pragma unroll
    for (int g = 1; g < 4; ++g) { unsigned L[16];
#pragma unroll
        for (int i = 0; i < 16; ++i) L[i] = C[16 * g + i];
        sort16_desc(L); merge_top16(F, L); __builtin_amdgcn_sched_barrier(0); }
    if (hi == 0) {
        float e[16]; float sum = 0.f; const float v0 = demono(F[0] & ~0x3fffu);
#pragma unroll
        for (int i = 0; i < 16; ++i) { e[i] = __expf(demono(F[i] & ~0x3fffu) - v0); sum += e[i]; }
        const float inv = 1.f / sum;
        int* ip = IDX + tok * 128 + h * 16; float* gp = PG + tok * 128 + h * 16;
#pragma unroll
        for (int q = 0; q < 4; ++q) { u32x4 iv; iv.x = F[4 * q] & 0x3fffu; iv.y = F[4 * q + 1] & 0x3fffu; iv.z = F[4 * q + 2] & 0x3fffu; iv.w = F[4 * q + 3] & 0x3fffu; *(u32x4*)(ip + 4 * q) = iv;
            f32x4 gv; gv[0] = e[4 * q] * inv; gv[1] = e[4 * q + 1] * inv; gv[2] = e[4 * q + 2] * inv; gv[3] = e[4 * q + 3] * inv; *(f32x4*)(gp + 4 * q) = gv; }
    }
}
typedef __bf16 bf16x2v __attribute__((ext_vector_type(2)));
DI float dot2bf(unsigned w, unsigned x, float acc) { return __builtin_amdgcn_fdot2_f32_bf16(__builtin_bit_cast(bf16x2v, w), __builtin_bit_cast(bf16x2v, x), acc, false); }
DI float gelu_erf(float v) {
    const float av = fabsf(v), t = __builtin_amdgcn_rcpf(av * 0.2316418882f + 1.0f);
    float q = t * 0.5307027145f + (-0.7265760135f); q = q * t + 0.7107068705f; q = q * t + (-0.142248368f); q = q * t + 0.127414796f; q = q * t;
    const float e = __builtin_amdgcn_exp2f((v * v) * (-0.72134752044f)); const float m = v * (q * e);
    return v < 0.f ? m : v - m;
}
DI float dppf(float v, const int ctrl_sel) {
    const int s = __float_as_int(v);
    int r;
    if (ctrl_sel == 0) r = __builtin_amdgcn_update_dpp(0, s, 0xB1, 0xF, 0xF, true);
    else if (ctrl_sel == 1) r = __builtin_amdgcn_update_dpp(0, s, 0x4E, 0xF, 0xF, true);
    else if (ctrl_sel == 2) r = __builtin_amdgcn_update_dpp(0, s, 0x141, 0xF, 0xF, true);
    else r = __builtin_amdgcn_update_dpp(0, s, 0x128, 0xF, 0xF, true);
    return __int_as_float(r);
}
DI int dppi(int s, const int ctrl_sel) {
    if (ctrl_sel == 0) return __builtin_amdgcn_update_dpp(0, s, 0xB1, 0xF, 0xF, true);
    if (ctrl_sel == 1) return __builtin_amdgcn_update_dpp(0, s, 0x4E, 0xF, 0xF, true);
    return __builtin_amdgcn_update_dpp(0, s, 0x141, 0xF, 0xF, true);
}
template <int NT>
DI void experts_u_slice(const unsigned char* __restrict__ H1Q, const unsigned char* __restrict__ U8x, const int* __restrict__ IDX, bf16_t* __restrict__ PD, size_t tok0, int ntok, int x, int lane) {
    const int g = lane >> 3, l8 = lane & 7;
    u32x4 hq[NT], iv[NT][4];
#pragma unroll
    for (int t = 0; t < NT; ++t) { hq[t] = *(const u32x4*)(H1Q + (tok0 + t) * D + 128 * x + 16 * l8);
#pragma unroll
        for (int q = 0; q < 4; ++q) iv[t][q] = *(const u32x4*)(IDX + (tok0 + t) * 128 + 16 * g + 4 * q); }
#pragma unroll 1
    for (int i = 0; i < ntok; i += NT) {
        const size_t tok = tok0 + i;
        u32x4 w[NT][16], hc[NT];
#pragma unroll
        for (int t = 0; t < NT; ++t) { hc[t] = hq[t];
#pragma unroll
            for (int j = 0; j < 16; ++j) w[t][j] = *(const u32x4*)(U8x + (size_t)(iv[t][j >> 2][j & 3] * 128u + 16u * l8)); }
        if (i + NT < ntok) {
#pragma unroll
            for (int t = 0; t < NT; ++t) { hq[t] = *(const u32x4*)(H1Q + (tok + NT + t) * D + 128 * x + 16 * l8);
#pragma unroll
                for (int q = 0; q < 4; ++q) iv[t][q] = *(const u32x4*)(IDX + (tok + NT + t) * 128 + 16 * g + 4 * q); }
        }
#pragma unroll
        for (int t = 0; t < NT; ++t) {
            float p[16];
#pragma unroll
            for (int j = 0; j < 16; ++j) { int d = 0;
#pragma unroll
                for (int q = 0; q < 4; ++q) d = __builtin_amdgcn_sdot4((int)w[t][j][q], (int)hc[t][q], d, false);
                d += dppi(d, 0); d += dppi(d, 1); d += dppi(d, 2); p[j] = (float)d; }
            if (l8 == 0) {
                u32x4 o0, o1;
                o0.x = cvtpk(p[0], p[1]); o0.y = cvtpk(p[2], p[3]); o0.z = cvtpk(p[4], p[5]); o0.w = cvtpk(p[6], p[7]);
                o1.x = cvtpk(p[8], p[9]); o1.y = cvtpk(p[10], p[11]); o1.z = cvtpk(p[12], p[13]); o1.w = cvtpk(p[14], p[15]);
                bf16_t* dp = PD + ((tok + t) * 8 + x) * 128 + 16 * g; *(u32x4*)dp = o0; *(u32x4*)(dp + 8) = o1;
            }
        }
    }
}
DI void experts_combine(const bf16_t* __restrict__ PD, const int* __restrict__ IDX, const float* __restrict__ PG, const float* __restrict__ USC, const float* __restrict__ VSC, const float* __restrict__ HSC,
                        unsigned char* __restrict__ C8, float* __restrict__ CSC, int wave0, int nwaves, int lane) {
    for (int tokb = wave0 * 2; tokb < M; tokb += nwaves * 2) {
        unsigned pw[2][8]; u32x2 rows[2]; f32x2 gt[2]; float hs[2];
#pragma unroll
        for (int r = 0; r < 2; ++r) { const size_t tok = (size_t)tokb + r;
#pragma unroll
            for (int x = 0; x < 8; ++x) pw[r][x] = *(const unsigned*)(PD + (tok * 8 + x) * 128 + 2 * lane);
            rows[r] = *(const u32x2*)(IDX + tok * 128 + 2 * lane); gt[r] = *(const f32x2*)(PG + tok * 128 + 2 * lane); hs[r] = HSC[tok]; }
#pragma unroll
        for (int r = 0; r < 2; ++r) { const size_t tok = (size_t)tokb + r;
            float s0 = 0.f, s1 = 0.f;
#pragma unroll
            for (int x = 0; x < 8; ++x) { s0 += __uint_as_float(pw[r][x] << 16); s1 += __uint_as_float(pw[r][x] & 0xffff0000u); }
            const float c0 = gt[r][0] * gelu_erf(s0 * USC[rows[r].x] * hs[r]) * VSC[rows[r].x], c1 = gt[r][1] * gelu_erf(s1 * USC[rows[r].y] * hs[r]) * VSC[rows[r].y];
            const float amax = wave_max(fmaxf(fabsf(c0), fabsf(c1)));
            const float qs = amax > 0.f ? 127.f / amax : 1.f;
            const unsigned short q2 = (unsigned short)(((unsigned)__float2int_rn(c0 * qs) & 0xffu) | (((unsigned)__float2int_rn(c1 * qs) & 0xffu) << 8));
            *(unsigned short*)(C8 + tok * 128 + 2 * lane) = q2;
            if (lane == 0) CSC[tok] = amax > 0.f ? amax * (1.f / 127.f) : 1.f;
        }
    }
}
template <int NT>
DI void experts_v_slice(const unsigned char* __restrict__ V8x, const int* __restrict__ IDX, const unsigned char* __restrict__ C8, const float* __restrict__ CSC, bf16_t* __restrict__ FFN, size_t tok0, int ntok, int x, int lane) {
    const int g = lane >> 3, l8 = lane & 7;
    u32x4 iv[NT][4], cqn[NT]; float csn[NT];
#pragma unroll
    for (int t = 0; t < NT; ++t) { cqn[t] = *(const u32x4*)(C8 + (tok0 + t) * 128 + 16 * g); csn[t] = CSC[tok0 + t];
#pragma unroll
        for (int q = 0; q < 4; ++q) iv[t][q] = *(const u32x4*)(IDX + (tok0 + t) * 128 + 16 * g + 4 * q); }
#pragma unroll 1
    for (int i = 0; i < ntok; i += NT) {
        const size_t tok = tok0 + i;
        u32x4 w[NT][16], cq[NT]; float csc[NT];
#pragma unroll
        for (int t = 0; t < NT; ++t) { cq[t] = cqn[t]; csc[t] = csn[t];
#pragma unroll
            for (int j = 0; j < 16; ++j) w[t][j] = *(const u32x4*)(V8x + (size_t)(iv[t][j >> 2][j & 3] * 128u + 16u * l8)); }
        if (i + NT < ntok) {
#pragma unroll
            for (int t = 0; t < NT; ++t) { cqn[t] = *(const u32x4*)(C8 + (tok + NT + t) * 128 + 16 * g); csn[t] = CSC[tok + NT + t];
#pragma unroll
                for (int q = 0; q < 4; ++q) iv[t][q] = *(const u32x4*)(IDX + (tok + NT + t) * 128 + 16 * g + 4 * q); }
        }
#pragma unroll
        for (int t = 0; t < NT; ++t) {
            int acc[16];
#pragma unroll
            for (int k = 0; k < 16; ++k) acc[k] = 0;
#pragma unroll
            for (int jj = 0; jj < 4; ++jj) {
                const int cdw = (int)cq[t][jj];
#pragma unroll
                for (int q = 0; q < 4; ++q) {
                    const unsigned r0 = w[t][4 * jj][q], r1 = w[t][4 * jj + 1][q], r2 = w[t][4 * jj + 2][q], r3 = w[t][4 * jj + 3][q];
                    const unsigned lo01 = __builtin_amdgcn_perm(r1, r0, 0x05010400u), hi01 = __builtin_amdgcn_perm(r1, r0, 0x07030602u);
                    const unsigned lo23 = __builtin_amdgcn_perm(r3, r2, 0x05010400u), hi23 = __builtin_amdgcn_perm(r3, r2, 0x07030602u);
                    acc[4 * q + 0] = __builtin_amdgcn_sdot4((int)__builtin_amdgcn_perm(lo23, lo01, 0x05040100u), cdw, acc[4 * q + 0], false);
                    acc[4 * q + 1] = __builtin_amdgcn_sdot4((int)__builtin_amdgcn_perm(lo23, lo01, 0x07060302u), cdw, acc[4 * q + 1], false);
                    acc[4 * q + 2] = __builtin_amdgcn_sdot4((int)__builtin_amdgcn_perm(hi23, hi01, 0x05040100u), cdw, acc[4 * q + 2], false);
                    acc[4 * q + 3] = __builtin_amdgcn_sdot4((int)__builtin_amdgcn_perm(hi23, hi01, 0x07060302u), cdw, acc[4 * q + 3], false);
                }
            }
            const float cs = csc[t];
#pragma unroll
            for (int k = 0; k < 8; ++k) { const auto rr = __builtin_amdgcn_permlane32_swap((unsigned)acc[k], (unsigned)acc[k + 8], false, false); acc[k] = (int)rr[0] + (int)rr[1]; }
#pragma unroll
            for (int k = 0; k < 4; ++k) { const auto rr = __builtin_amdgcn_permlane16_swap((unsigned)acc[k], (unsigned)acc[k + 4], false, false); acc[k] = (int)rr[0] + (int)rr[1]; }
            { const bool up = (lane & 8) != 0;
#pragma unroll
              for (int k = 0; k < 2; ++k) { const int send = up ? acc[k] : acc[k + 2], keep = up ? acc[k + 2] : acc[k]; acc[k] = keep + __builtin_amdgcn_update_dpp(0, send, 0x128, 0xF, 0xF, true); } }
            *(unsigned*)(FFN + (tok + t) * D + 128 * x + 16 * l8 + 2 * g) = cvtpk((float)acc[0] * cs, (float)acc[1] * cs);
        }
    }
}
template <int NR>
DI void ln2_tokens(const bf16_t* __restrict__ FFN, const unsigned char* __restrict__ H1Q, const float* __restrict__ HSC, const float* __restrict__ g2, const float* __restrict__ b2, float* __restrict__ outp, size_t tok0, int lane) {
    u32x4 fa[NR], fb[NR], hq[NR]; float hs[NR];
#pragma unroll
    for (int r = 0; r < NR; ++r) { const size_t o = (tok0 + r) * D + 16 * lane;
        fa[r] = *(const u32x4*)(FFN + o); fb[r] = *(const u32x4*)(FFN + o + 8); hq[r] = *(const u32x4*)(H1Q + o); hs[r] = HSC[tok0 + r] * ALPHA; }
#pragma unroll
    for (int r = 0; r < NR; ++r) {
        float* hr = outp + (tok0 + r) * D + 16 * lane;
        float ff[16], hh[16]; unpack8(fa[r], *(float(*)[8])&ff[0]); unpack8(fb[r], *(float(*)[8])&ff[8]);
#pragma unroll
        for (int j = 0; j < 4; ++j) { const unsigned w = hq[r][j] ^ 0x80808080u;
            hh[4 * j] = (float)(w & 0xffu) - 128.f; hh[4 * j + 1] = (float)((w >> 8) & 0xffu) - 128.f; hh[4 * j + 2] = (float)((w >> 16) & 0xffu) - 128.f; hh[4 * j + 3] = (float)(w >> 24) - 128.f; }
        f32x4 v[4]; float s = 0.f;
#pragma unroll
        for (int j = 0; j < 4; ++j)
#pragma unroll
            for (int e = 0; e < 4; ++e) { v[j][e] = hh[4 * j + e] * hs[r] + ff[4 * j + e]; s += v[j][e]; }
        const float mean = wave_sum(s) * (1.f / D); float q2 = 0.f;
#pragma unroll
        for (int j = 0; j < 4; ++j)
#pragma unroll
            for (int e = 0; e < 4; ++e) { v[j][e] -= mean; q2 += v[j][e] * v[j][e]; }
        const float rstd = rsqrtf(wave_sum(q2) * (1.f / D) + LN_EPS);
#pragma unroll
        for (int j = 0; j < 4; ++j) { const f32x4 gg = *(const f32x4*)(g2 + 16 * lane + 4 * j), bb = *(const f32x4*)(b2 + 16 * lane + 4 * j); *(f32x4*)(hr + 4 * j) = v[j] * rstd * gg + bb; }
    }
}

DI void p0_convert(const float* __restrict__ in, bf16_t* __restrict__ out, size_t n8, size_t first, size_t stride) {
    for (size_t i = first; i < n8; i += stride) { const f32x4 a = ((const f32x4*)in)[2 * i], b = ((const f32x4*)in)[2 * i + 1];
        u32x4 w; w.x = cvtpk(a[0], a[1]); w.y = cvtpk(a[2], a[3]); w.z = cvtpk(b[0], b[1]); w.w = cvtpk(b[2], b[3]); ((u32x4*)out)[i] = w; }
}
DI void p0_transpose_item(const float* __restrict__ W, int ldw, int ncols, bf16_t* __restrict__ out, int ldo, int koff, LAS float* scr, int item, int lane) {
    const int nblk = ncols / 32, kb = item / nblk, nb = item % nblk, k0 = 64 * kb, n0 = 32 * nb;
#pragma unroll 8
    for (int i = 0; i < 32; ++i) { const int kk = 2 * i + (lane >> 5); scr[kk * 33 + (lane & 31)] = W[(size_t)(k0 + kk) * ldw + n0 + (lane & 31)]; }
    asm volatile("s_waitcnt lgkmcnt(0)" ::: "memory");
    const int c = lane & 7;
#pragma unroll
    for (int j = 0; j < 4; ++j) { const int n = (lane >> 3) + 8 * j; const LAS float* s = scr + (8 * c) * 33 + n;
        u32x4 o; o.x = cvtpk(s[0 * 33], s[1 * 33]); o.y = cvtpk(s[2 * 33], s[3 * 33]); o.z = cvtpk(s[4 * 33], s[5 * 33]); o.w = cvtpk(s[6 * 33], s[7 * 33]);
        *(u32x4*)(out + (size_t)(n0 + n) * ldo + koff + k0 + 8 * c) = o; }
    asm volatile("s_waitcnt lgkmcnt(0)" ::: "memory");
}
template <int NR>
DI void p0_q8_rows(const float* __restrict__ src, unsigned char* __restrict__ dst, float* __restrict__ scale, int row0, int lane) {
    f32x4 v[NR][4];
#pragma unroll
    for (int r = 0; r < NR; ++r) { const f32x4* sp = (const f32x4*)(src + (size_t)(row0 + r) * D) + 4 * lane;
#pragma unroll
        for (int j = 0; j < 4; ++j) v[r][j] = sp[j]; }
#pragma unroll
    for (int r = 0; r < NR; ++r) {
        float mx = 0.f;
#pragma unroll
        for (int j = 0; j < 4; ++j) mx = fmaxf(mx, fmaxf(fmaxf(fabsf(v[r][j][0]), fabsf(v[r][j][1])), fmaxf(fabsf(v[r][j][2]), fabsf(v[r][j][3]))));
        mx = wave_max(mx);
        const float sc = mx > 0.f ? 127.f / mx : 1.f;
        u32x4 w;
#pragma unroll
        for (int j = 0; j < 4; ++j) w[j] = ((unsigned)__float2int_rn(v[r][j][0] * sc) & 0xffu) | (((unsigned)__float2int_rn(v[r][j][1] * sc) & 0xffu) << 8) | (((unsigned)__float2int_rn(v[r][j][2] * sc) & 0xffu) << 16) | (((unsigned)__float2int_rn(v[r][j][3] * sc) & 0xffu) << 24);
        *(u32x4*)(dst + (size_t)(lane >> 3) * ((size_t)NEXP * 128) + (size_t)(row0 + r) * 128 + 16 * (lane & 7)) = w;
        if (lane == 0) scale[row0 + r] = mx > 0.f ? mx * (1.f / 127.f) : 1.f;
    }
}
DI void p0_fold_tile(const float* __restrict__ wq, const float* __restrict__ keys, bf16_t* __restrict__ out, int* __restrict__ gmax, LAS float* sm, int tile, int tid) {
    const int hp = tile >> 4, d0 = (tile & 15) * 64;
    LAS float* skT = sm; LAS float* swT = sm + 128 * 132;
    { const int r = tid & 127;
      for (int c4 = (tid >> 7) * 4; c4 < 128; c4 += 16) { const f32x4 v = *(const f32x4*)(keys + (size_t)(hp * 128 + r) * 128 + c4);
          skT[(c4 + 0) * 132 + r] = v[0]; skT[(c4 + 1) * 132 + r] = v[1]; skT[(c4 + 2) * 132 + r] = v[2]; skT[(c4 + 3) * 132 + r] = v[3]; } }
    { const int r = tid & 63;
      for (int c4 = (tid >> 6) * 4; c4 < 128; c4 += 32) { const f32x4 v = *(const f32x4*)(wq + (size_t)(d0 + r) * 2048 + hp * 128 + c4);
          swT[(c4 + 0) * 68 + r] = v[0]; swT[(c4 + 1) * 68 + r] = v[1]; swT[(c4 + 2) * 68 + r] = v[2]; swT[(c4 + 3) * 68 + r] = v[3]; } }
    __syncthreads();
    const int nb = tid & 31, db = tid >> 5;
    f32x4 acc[4];
#pragma unroll
    for (int i = 0; i < 4; ++i) acc[i] = (f32x4){0.f, 0.f, 0.f, 0.f};
#pragma unroll 4
    for (int k = 0; k < 128; ++k) { const f32x4 a = *(const LAS f32x4*)(skT + k * 132 + 4 * nb), b = *(const LAS f32x4*)(swT + k * 68 + 4 * db);
#pragma unroll
        for (int i = 0; i < 4; ++i) acc[i] += b * a[i]; }
#pragma unroll
    for (int i = 0; i < 4; ++i) { u32x2 o; o.x = cvtpk(acc[i][0], acc[i][1]); o.y = cvtpk(acc[i][2], acc[i][3]); *(u32x2*)(out + (size_t)(hp * 128 + 4 * nb + i) * D + d0 + 4 * db) = o; }
    { float mx = 0.f;
#pragma unroll
      for (int i = 0; i < 4; ++i) mx = fmaxf(mx, fmaxf(fmaxf(fabsf(acc[i][0]), fabsf(acc[i][1])), fmaxf(fabsf(acc[i][2]), fabsf(acc[i][3]))));
      mx = wave_max(mx);
      if ((tid & 63) == 0) __hip_atomic_fetch_max(gmax, __float_as_int(mx), __ATOMIC_RELAXED, __HIP_MEMORY_SCOPE_AGENT); }
    __syncthreads();
}
DI unsigned q8pack(float a, float b, float c, float d) {
    const unsigned ia = __float_as_uint(a + 12582912.f), ib = __float_as_uint(b + 12582912.f), ic = __float_as_uint(c + 12582912.f), id = __float_as_uint(d + 12582912.f);
    return (ia & 0xffu) | ((ib & 0xffu) << 8) | ((ic & 0xffu) << 16) | (id << 24);
}
template <int NR>
DI void p0_x_rows(const float* __restrict__ x, bf16_t* __restrict__ xb, unsigned char* __restrict__ x8, float* __restrict__ xsc, int row0, int lane) {
    f32x4 v[NR][4];
#pragma unroll
    for (int r = 0; r < NR; ++r) { const f32x4* sp = (const f32x4*)(x + (size_t)(row0 + r) * D) + 4 * lane;
#pragma unroll
        for (int j = 0; j < 4; ++j) v[r][j] = sp[j]; }
#pragma unroll
    for (int r = 0; r < NR; ++r) {
        float mx = 0.f; u32x4 o0, o1;
#pragma unroll
        for (int j = 0; j < 4; ++j) { mx = fmaxf(mx, fmaxf(fmaxf(fabsf(v[r][j][0]), fabsf(v[r][j][1])), fmaxf(fabsf(v[r][j][2]), fabsf(v[r][j][3]))));
            if (j < 2) { o0[2 * j] = cvtpk(v[r][j][0], v[r][j][1]); o0[2 * j + 1] = cvtpk(v[r][j][2], v[r][j][3]); } else { o1[2 * (j - 2)] = cvtpk(v[r][j][0], v[r][j][1]); o1[2 * (j - 2) + 1] = cvtpk(v[r][j][2], v[r][j][3]); } }
        *(u32x4*)(xb + (size_t)(row0 + r) * D + 16 * lane) = o0; *(u32x4*)(xb + (size_t)(row0 + r) * D + 16 * lane + 8) = o1;
        mx = wave_max(mx);
        const float sc = mx > 0.f ? 127.f / mx : 1.f;
        u32x4 w;
#pragma unroll
        for (int j = 0; j < 4; ++j) w[j] = q8pack(v[r][j][0] * sc, v[r][j][1] * sc, v[r][j][2] * sc, v[r][j][3] * sc);
        *(u32x4*)(x8 + (size_t)(row0 + r) * D + 16 * lane) = w;
        if (lane == 0) { const float v = mx > 0.f ? mx * (1.f / 127.f) : 1.f; const int row = row0 + r, hi = row & ~(S - 1), s = row & (S - 1);
            xsc[row] = v; xsc[M + hi + ((s & 3) << 11) + (s >> 2)] = v; xsc[2 * M + hi + ((s & 15) << 9) + (s >> 4)] = v; }
    }
}
DI void p0_transpose_item_f8(const float* __restrict__ W, int ncols, const float* __restrict__ cmax, unsigned char* __restrict__ out8, float* __restrict__ wsc, LAS float* scr, int item, int lane) {
    const int nblk = ncols / 32, kb = item / nblk, nb = item % nblk, k0 = 64 * kb, n0 = 32 * nb;
    const float cm = cmax[0]; const float sc = cm > 0.f ? 127.f / cm : 1.f;
#pragma unroll 8
    for (int i = 0; i < 32; ++i) { const int kk = 2 * i + (lane >> 5); scr[kk * 33 + (lane & 31)] = W[(size_t)(k0 + kk) * INC + n0 + (lane & 31)] * sc; }
    asm volatile("s_waitcnt lgkmcnt(0)" ::: "memory");
    const int c = lane & 7;
#pragma unroll
    for (int j = 0; j < 4; ++j) { const int n = (lane >> 3) + 8 * j; const LAS float* s = scr + (8 * c) * 33 + n;
        u32x2 o; o.x = q8pack(s[0 * 33], s[1 * 33], s[2 * 33], s[3 * 33]); o.y = q8pack(s[4 * 33], s[5 * 33], s[6 * 33], s[7 * 33]);
        *(u32x2*)(out8 + (size_t)(n0 + n) * D + k0 + 8 * c) = o; }
    if (item == 0 && lane == 0) wsc[0] = cm > 0.f ? cm * (1.f / 127.f) : 1.f;
    asm volatile("s_waitcnt lgkmcnt(0)" ::: "memory");
}
DI void p0_misc(const float* __restrict__ hgrn_lb, const float* __restrict__ rel_bias, float* __restrict__ misc, int i) {
    if (i < 512) { const float a = hgrn_lb[i], b = hgrn_lb[512 + i]; const float mx = fmaxf(a, b); const float ea = expf(a - mx), eb = expf(b - mx); misc[i] = ea / (ea + eb); }
    if (i < 3 * 129) {
        const int g = i / 129, j = i % 129; const int dl = g == 0 ? 1 : (g == 1 ? 4 : 16); const int n = j * dl;
        int bucket;
        if (n < 16) bucket = n;
        else { const double v = log((double)n / 16.0) / log(128.0) * 16.0; int l = 16 + (int)v; bucket = l < 31 ? l : 31; }
        for (int h = 0; h < 4; ++h) misc[512 + i * 4 + h] = rel_bias[bucket * 12 + g * 4 + h];
    }
}
struct SchedMemKV {
    unsigned MEMB, W; int G, c;
    DI bool next(int i, g8::Unit& u) const {
        const int L = i * G + c; if (L >= 32) return false;
        u.dla = 1; u.dlb = 1;
        if (L < 16) { u.kind = 0; u.pm = L >> 1; u.pn = L & 1; u.a = MEMB + (unsigned)u.pm * 256u * D * 2u; u.b = W + (unsigned)u.pn * 256u * D * 2u; }
        else { const int q = L - 16; u.kind = 1; u.pm = q >> 3; u.pn = q & 7; u.a = W + (unsigned)(512 + u.pm * 256) * D * 2u; u.b = MEMB + (unsigned)u.pn * 256u * D * 2u; }
        return true;
    }
};
struct EpiMemKVF {
    static constexpr bool PERM = true, HOOK = false;
    bf16_t *MK, *MVT;
    DI void hook(f32x4 (&)[2][2][4][2], const g8::Unit&, int, int, int, int, int) const {}
    DI void operator()(const f32x4 (&acc)[2][2][4][2], const g8::Unit& u, int wr, int wc, int fr, int fq) const {
        const int rowl = wr * 64 + fr, d0 = wc * 32 + 8 * fq;
#pragma unroll
        for (int ai = 0; ai < 2; ++ai)
#pragma unroll
            for (int m = 0; m < 4; ++m) { const int R = u.pm * 256 + rowl + ai * 128 + m * 16;
#pragma unroll
                for (int bj = 0; bj < 2; ++bj) { const f32x4 v0 = acc[ai][bj][m][0], v1 = acc[ai][bj][m][1];
                    if (u.kind == 0) { const int b = R >> 8, mm = R & 255, h = u.pn * 2 + bj;
                        u32x4 w; w.x = cvtpk(v0[0], v0[1]); w.y = cvtpk(v0[2], v0[3]); w.z = cvtpk(v1[0], v1[1]); w.w = cvtpk(v1[2], v1[3]);
                        *(u32x4*)(MK + ((size_t)((b * 4 + h) * 8 + (mm >> 5))) * 4096 + frag_row_off(d0, mm & 31)) = w; }
                    else { const int h = R >> 7, d = R & 127, c = u.pn * 256 + bj * 128 + d0, b = c >> 8, mm = c & 255, kk = mm & 31;
                        bf16_t* blk = MVT + ((size_t)((b * 4 + h) * 8 + (mm >> 5))) * 4096 + (((d >> 5) * 2 + (kk >> 4)) * 64 + (d & 31)) * 8 + 4 * ((kk >> 3) & 1);
                        u32x2 wa, wb; wa.x = cvtpk(v0[0], v0[1]); wa.y = cvtpk(v0[2], v0[3]); wb.x = cvtpk(v1[0], v1[1]); wb.y = cvtpk(v1[2], v1[3]);
                        *(u32x2*)blk = wa; *(u32x2*)(blk + 32 * 8) = wb; } } }
    }
};

static_assert(HG_UNIT_BYTES <= LDSCTL_OFF, "hgrn LDS");
static_assert(HG_UNIT_BYTES <= LDSCTL_OFF, "hgrn LDS");
__global__ void __launch_bounds__(NTHR, 2) mega(Args args) {
    extern __shared__ __attribute__((aligned(16))) unsigned char lds_raw[];
    LAS unsigned char* lds = (LAS unsigned char*)lds_raw;
    volatile LAS unsigned* MISC = (volatile LAS unsigned*)(lds + MISC_OFF);
    for (int u = threadIdx.x; u < (LDS_BYTES - LDSCTL_OFF) / 4; u += NTHR) ((LAS unsigned*)(lds + LDSCTL_OFF))[u] = 0u;
    __syncthreads();
    unsigned char* ws = args.ws;
    constexpr int G = 256;
    constexpr bool ALL = true;
    XcdBarrier bar; bar.bar = (unsigned*)(ws + O_MISC + 16384); bar.x = 0; bar.st = nullptr;
    if (ALL) bar = xcd_barrier_post((unsigned*)(ws + O_MISC + 16384), MISC + 8);
#ifndef REP_MASK
#define REP_MASK 0
#endif
#define RUN(k) (true)
#define NREP(k) (((REP_MASK >> (k)) & 1) ? 2 : 1)
#define SEAM() do { if (ALL) xcd_barrier(bar); } while (0)
    for (int rep_ = 0; rep_ < NREP(PH_PRO); ++rep_) if (RUN(PH_PRO)) {
        int tid = threadIdx.x; asm volatile("" : "+v"(tid)); asm volatile("" : "+s"(ws)); int bid = blockIdx.x; asm volatile("" : "+s"(bid));
        const size_t gt = (size_t)bid * NTHR + tid, nth = (size_t)G * NTHR;
        p0_convert(karg_in(1), (bf16_t*)(ws + O_MEMB), (size_t)2048 * 1024 / 8, gt, nth);
        if (bid == 0) p0_misc(karg_in(6), karg_in(5), (float*)(ws + O_MISC), tid);
        if (bid == 1) { const float* bg = karg_in(3); for (int i = tid; i < 3072; i += NTHR) ((float*)(ws + O_BGATE))[i] = bg[i]; }
        const int wid = __builtin_amdgcn_readfirstlane(tid >> 6), lane = tid & 63;
        LAS float* scr = (LAS float*)(lds + wid * 16384);
        const int gw = bid * NWAVES + wid, ngw = G * NWAVES;
        for (int r = gw * 4; r < M; r += ngw * 4) p0_x_rows<4>(karg_in(0), (bf16_t*)(ws + O_XB), (unsigned char*)(ws + O_X8), (float*)(ws + O_XSC), r, lane);
        {
            const float* wi = karg_in(2); float mx = 0.f;
            for (int k = bid; k < D; k += G) for (int n = tid; n < INC; n += NTHR) mx = fmaxf(mx, fabsf(wi[(size_t)k * INC + n]));
            mx = wave_max(mx);
            if (lane == 0) __hip_atomic_fetch_max((int*)(ws + O_CMAX), __float_as_int(mx), __ATOMIC_RELAXED, __HIP_MEMORY_SCOPE_AGENT);
        }
        for (int r = gw * 4; r < 2 * NEXP; r += ngw * 4) {
            if (r < NEXP) p0_q8_rows<4>(karg_in(14), (unsigned char*)(ws + O_UB), (float*)(ws + O_USC), r, lane);
            else p0_q8_rows<4>(karg_in(15), (unsigned char*)(ws + O_VB), (float*)(ws + O_VSC), r - NEXP, lane);
        }
        constexpr int NJ = 12;
        for (int it = gw; ; it += ngw) {
            int r = it; bool done = true;
#pragma unroll
            for (int j = 0; j < NJ; ++j) {
                const int srcc[NJ] = {0, 4608, 5632, 6656, 7168, 3072, 5120, 0, 0, 0, 0, 0};
                const int cnt[NJ] = {3072, 512, 1024, 512, 3072, 1536, 512, 1024, 1024, 1024, 1024, 1024};
                const int drow[NJ] = {0, 3072, 3584, 4608, 5120, 8192, 9728, 0, 0, 0, 0, 0};
                const int Kj = (j >= 8 && j <= 10) ? 512 : 1024;
                const int items = (Kj / 64) * (cnt[j] / 32);
                if (done && r < items) {
                    const float* W; int ldw; bf16_t* o; int ldo, koff = 0;
                    if (j < 7) { done = false; }
                    else if (j == 7) { W = karg_in(4); ldw = 1024; o = (bf16_t*)(ws + O_WMKV); ldo = 1024; }
                    else if (j <= 10) { W = karg_in(8) + (size_t)(j - 8) * 512 * 1024; ldw = 1024; o = (bf16_t*)(ws + O_WBR); ldo = 1536; koff = (j - 8) * 512; }
                    else { W = karg_in(9); ldw = 1024; o = (bf16_t*)(ws + O_WOUT); ldo = 1024; }
                    if (j >= 7) { p0_transpose_item(W, ldw, cnt[j], o, ldo, koff, scr, r, lane); done = false; }
                }
                r -= items;
            }
            if (done) break;
        }
        __syncthreads();
        for (int tile = bid; tile < 256; tile += G) p0_fold_tile(karg_in(12), karg_in(13), (bf16_t*)(ws + O_WPQ), (int*)(ws + O_CMAX) + 1, (LAS float*)lds, tile, tid);
        SEAM();
        for (int it = gw; ; it += ngw) {
            int r = it; bool done = true;
#pragma unroll
            for (int j = 0; j < 7; ++j) {
                const int srcc[7] = {0, 4608, 5632, 6656, 7168, 3072, 5120};
                const int cnt[7] = {3072, 512, 1024, 512, 3072, 1536, 512};
                const int drow[7] = {0, 3072, 3584, 4608, 5120, 8192, 9728};
                const int items = 16 * (cnt[j] / 32);
                if (done && r < items) { p0_transpose_item_f8(karg_in(2) + srcc[j], cnt[j], (const float*)(ws + O_CMAX), (unsigned char*)(ws + O_W8) + (size_t)drow[j] * 1024, (float*)(ws + O_WSC), scr, r, lane); done = false; }
                r -= items;
            }
            if (done) break;
        }
        {
            const float cm = ((const float*)(ws + O_CMAX))[1]; const float sc = cm > 0.f ? 127.f / cm : 1.f;
            for (size_t i = gt; i < (size_t)2048 * D / 16; i += nth) { const u32x4 a = *(const u32x4*)(ws + O_WPQ + i * 32), b = *(const u32x4*)(ws + O_WPQ + i * 32 + 16);
                float f[8], g[8]; unpack8(a, f); unpack8(b, g);
                u32x4 o; o.x = q8pack(f[0] * sc, f[1] * sc, f[2] * sc, f[3] * sc); o.y = q8pack(f[4] * sc, f[5] * sc, f[6] * sc, f[7] * sc); o.z = q8pack(g[0] * sc, g[1] * sc, g[2] * sc, g[3] * sc); o.w = q8pack(g[4] * sc, g[5] * sc, g[6] * sc, g[7] * sc);
                *(u32x4*)(ws + O_WPQ8 + i * 16) = o; }
            if (gt == 0) ((float*)(ws + O_WSC))[1] = cm > 0.f ? cm * (1.f / 127.f) : 1.f;
        }
        SEAM();
    }
#pragma unroll 1
    for (int p = 0; p < NPASS; ++p) {
        int bid = blockIdx.x; asm volatile("" : "+s"(bid));
        int tid = threadIdx.x; asm volatile("" : "+v"(tid));
        asm volatile("" : "+s"(ws));
        char* pr = (char*)ws + O_PASS;
        const size_t t0 = (size_t)p * MP;
        for (int rep_ = 0; rep_ < NREP(PH_PROJ); ++rep_) if (RUN(PH_PROJ)) {
            asm volatile("" : "+s"(bid)); asm volatile("" : "+v"(tid)); asm volatile("" : "+s"(ws)); pr = (char*)ws + O_PASS;
            { SchedP1<0> Sc{(unsigned)(O_X8 + t0 * D), (unsigned)O_W8, G, bid};
              EpiP1<0> E{(char*)ws, (int)t0, 0};
              g8::gemm_phase<EpiP1<0>, SchedP1<0>, 2>(lds, (const char*)ws, D / 2, Sc, E, tid); }
            asm volatile("" : "+v"(tid)); asm volatile("" : "+s"(bid)); asm volatile("" : "+s"(ws));
            { SchedP1<1> Sc{(unsigned)(O_X8 + t0 * D), (unsigned)O_W8, G, bid};
              EpiP1<1> E{(char*)ws, (int)t0, 0};
              g8::gemm_phase<EpiP1<1>, SchedP1<1>, 2>(lds, (const char*)ws, D / 2, Sc, E, tid); }
            if (p == 0) {
                asm volatile("" : "+v"(tid)); asm volatile("" : "+s"(bid));
                SchedMemKV S2{(unsigned)O_MEMB, (unsigned)O_WMKV, G, bid};
                EpiMemKVF E2{(bf16_t*)(ws + O_MK), (bf16_t*)(ws + O_MVT)};
                g8::gemm_phase<EpiMemKVF, SchedMemKV>(lds, (const char*)ws, D, S2, E2, tid);
            }
            SEAM();
        }
        for (int rep_ = 0; rep_ < NREP(PH_ATTN); ++rep_) if (RUN(PH_ATTN)) {
            asm volatile("" : "+s"(bid)); asm volatile("" : "+v"(tid)); asm volatile("" : "+s"(ws)); pr = (char*)ws + O_PASS;
            const float* bsrc = (const float*)(ws + O_MISC) + 512; LAS float* btab = (LAS float*)lds;
            for (int i = tid; i < 3 * 129 * 4; i += NTHR) btab[i] = bsrc[i] * LOG2E;
            __syncthreads();
            const int wid = __builtin_amdgcn_readfirstlane(tid >> 6), lane = tid & 63;
            for (int task = bid * NWAVES + wid; task < DIL_TASKS; task += G * NWAVES)
                attn_dil_wave((const bf16_t*)(pr + P_QK), (const bf16_t*)(pr + P_VT), btab, lds + 8192 + wid * 8704, (bf16_t*)(pr + P_OG), (float*)(pr + P_LSE), task, lane);
            for (int task = bid * NWAVES + wid; task < MEM_TASKS; task += G * NWAVES)
                attn_mem_wave((const bf16_t*)(pr + P_MQ), (const bf16_t*)(ws + O_MK), (const bf16_t*)(ws + O_MVT), (bf16_t*)(pr + P_BR), task, p * BPP, lane);
            __syncthreads();
        }
        for (int rep_ = 0; rep_ < NREP(PH_HGPRE); ++rep_) if (RUN(PH_HGPRE)) {
            asm volatile("" : "+s"(bid)); asm volatile("" : "+v"(tid)); asm volatile("" : "+s"(ws)); pr = (char*)ws + O_PASS;
            { const int unit = bid; static_assert(HG_UNITS == 256, "one HGRN unit per workgroup"); if (unit < HG_UNITS) {
                hgrn_unit<false>(lds, unit, tid, (const bf16_t*)(pr + P_HFQG), (const bf16_t*)(pr + P_IT), (const float*)(ws + O_MISC), karg_in(7),
                                 (float*)(pr + P_HSTL), (float*)(pr + P_HSTD), (const float*)(pr + P_SIN), (bf16_t*)(pr + P_BR));
            } }
            SEAM();
        }
        for (int rep_ = 0; rep_ < NREP(PH_HGSCAN); ++rep_) if (RUN(PH_HGSCAN)) {
            asm volatile("" : "+s"(bid)); asm volatile("" : "+v"(tid)); asm volatile("" : "+s"(ws)); pr = (char*)ws + O_PASS;
            hgrn_scan((const float*)(pr + P_HSTL), (const float*)(pr + P_HSTD), (float*)(pr + P_SIN), bid * NTHR + tid);
            lse_merge_items((const bf16_t*)(pr + P_OG), (const float*)(pr + P_LSE), (bf16_t*)(pr + P_BR), bid * NTHR + tid, G * NTHR);
            SEAM();
        }
        for (int rep_ = 0; rep_ < NREP(PH_HGMAIN); ++rep_) if (RUN(PH_HGMAIN)) {
            asm volatile("" : "+s"(bid)); asm volatile("" : "+v"(tid)); asm volatile("" : "+s"(ws)); pr = (char*)ws + O_PASS;
            { const int unit = bid; static_assert(HG_UNITS == 256, "one HGRN unit per workgroup"); if (unit < HG_UNITS) {
                hgrn_unit<true>(lds, unit, tid, (const bf16_t*)(pr + P_HFQG), (const bf16_t*)(pr + P_IT), (const float*)(ws + O_MISC), karg_in(7),
                                (float*)(pr + P_HSTL), (float*)(pr + P_HSTD), (const float*)(pr + P_SIN), (bf16_t*)(pr + P_BR));
            } }
            SEAM();
        }
        for (int rep_ = 0; rep_ < NREP(PH_WIDEN); ++rep_) if (RUN(PH_WIDEN)) {
            asm volatile("" : "+s"(bid)); asm volatile("" : "+v"(tid)); asm volatile("" : "+s"(ws)); pr = (char*)ws + O_PASS;
            SchedRows Sc{(unsigned)(O_PASS + P_BR), (unsigned)O_WBR, 1536, 4, 256, G, bid};
            EpiWidenF E{(const bf16_t*)(pr + P_GATE), (bf16_t*)(pr + P_MERGED)};
            g8::gemm_phase<EpiWidenF, SchedRows>(lds, (const char*)ws, 1536, Sc, E, tid);
            SEAM();
        }
        for (int rep_ = 0; rep_ < NREP(PH_WOUT); ++rep_) if (RUN(PH_WOUT)) {
            asm volatile("" : "+s"(bid)); asm volatile("" : "+v"(tid)); asm volatile("" : "+s"(ws)); pr = (char*)ws + O_PASS;
            SchedRows Sc{(unsigned)(O_PASS + P_MERGED), (unsigned)O_WOUT, 1024, 4, 256, G, bid};
            EpiPlainB16 E{(bf16_t*)(pr + P_MIX), 1024, 0};
            g8::gemm_phase<EpiPlainB16, SchedRows>(lds, (const char*)ws, 1024, Sc, E, tid);
            SEAM();
        }
        for (int rep_ = 0; rep_ < NREP(PH_LN1); ++rep_) if (RUN(PH_LN1)) {
            asm volatile("" : "+s"(bid)); asm volatile("" : "+v"(tid)); asm volatile("" : "+s"(ws)); pr = (char*)ws + O_PASS;
            ln1_rows<4>((const bf16_t*)(ws + O_XB) + t0 * D, (const bf16_t*)(pr + P_MIX), karg_in(10), karg_in(11), (bf16_t*)(ws + O_H1B) + t0 * D, (unsigned char*)(ws + O_H1Q) + t0 * D, (float*)(ws + O_HSC) + t0, bid * NWAVES + (tid >> 6), G * NWAVES, tid & 63);
        }
    }
    for (int rep_ = 0; rep_ < NREP(PH_PQ); ++rep_) if (RUN(PH_PQ)) {
        SEAM();
        int tid = threadIdx.x; asm volatile("" : "+v"(tid)); asm volatile("" : "+s"(ws)); int bid = blockIdx.x; asm volatile("" : "+s"(bid));
        char* pr = (char*)ws + O_PASS;
        SchedRows Sc{(unsigned)O_H1Q, (unsigned)O_WPQ8, 512, 8, 2048, G, bid};
        EpiScores E{(bf16_t*)(pr + P_PQ), (const float*)(ws + O_HSC), (const float*)(ws + O_WSC) + 1};
        g8::gemm_phase<EpiScores, SchedRows, 2>(lds, (const char*)ws, 512, Sc, E, tid);
        SEAM();
    }
    for (int rep_ = 0; rep_ < NREP(PH_ROUTE); ++rep_) if (RUN(PH_ROUTE)) {
        int tid = threadIdx.x; asm volatile("" : "+v"(tid)); asm volatile("" : "+s"(ws)); int bid = blockIdx.x; asm volatile("" : "+s"(bid));
        char* pr = (char*)ws + O_PASS;
        const int wid = __builtin_amdgcn_readfirstlane(tid >> 6), lane = tid & 63;
        for (int task = bid * NWAVES + wid; task < (M / 32) * 8; task += G * NWAVES)
            route_wave((const bf16_t*)(pr + P_PQ), (int*)(pr + P_IDX), (float*)(pr + P_PG), task >> 3, task & 7, lane);
        SEAM();
    }
    if (RUN(PH_EXPERTS)) {
        int tid = threadIdx.x; asm volatile("" : "+v"(tid)); asm volatile("" : "+s"(ws)); int bid = blockIdx.x; asm volatile("" : "+s"(bid));
        char* pr = (char*)ws + O_PASS;
        const int wid = __builtin_amdgcn_readfirstlane(tid >> 6), lane = tid & 63;
        if (tid == 0) {
            unsigned base = 0; const unsigned myx = ALL ? bar.x : 0u;
            if (ALL) { for (unsigned jx = 0; jx < 16; ++jx) { const unsigned c = xb_ld(&bar.bar[XB_XCNT(jx)]); if (jx < myx) base += c; } MISC[12] = base + MISC[10]; }
            else MISC[12] = (unsigned)bid;
        }
        __syncthreads();
        const int vwg = (int)MISC[12];
        const int nper = G >> 3, x = vwg / nper, r = vwg % nper;
        const int tpw = M / (nper * NWAVES);
        const size_t tokw0 = (size_t)(r * NWAVES + wid) * tpw;
        {
            const unsigned char* U8x = (const unsigned char*)(ws + O_UB) + (size_t)x * ((size_t)NEXP * 128);
            experts_u_slice<2>((const unsigned char*)(ws + O_H1Q), U8x, (const int*)(pr + P_IDX), (bf16_t*)(pr + P_PD), tokw0, tpw, x, lane);
        }
        SEAM();
        experts_combine((const bf16_t*)(pr + P_PD), (const int*)(pr + P_IDX), (const float*)(pr + P_PG), (const float*)(ws + O_USC), (const float*)(ws + O_VSC), (const float*)(ws + O_HSC), (unsigned char*)(pr + P_C), (float*)(pr + P_C + (size_t)M * 128), bid * NWAVES + wid, G * NWAVES, lane);
        SEAM();
        {
            const unsigned char* V8x = (const unsigned char*)(ws + O_VB) + (size_t)x * ((size_t)NEXP * 128);
            experts_v_slice<2>(V8x, (const int*)(pr + P_IDX), (const unsigned char*)(pr + P_C), (const float*)(pr + P_C + (size_t)M * 128), (bf16_t*)(pr + P_FFN), tokw0, tpw, x, lane);
        }
        SEAM();
        for (int tok = (bid * NWAVES + wid) * 4; tok < M; tok += G * NWAVES * 4) ln2_tokens<4>((const bf16_t*)(pr + P_FFN), (const unsigned char*)(ws + O_H1Q), (const float*)(ws + O_HSC), karg_in(16), karg_in(17), karg_out(), (size_t)tok, lane);
    }
#undef RUN
#undef SEAM
}

extern "C" void kernel_launch(void* const* d_in, const int* in_sizes, int n_in, void* d_out, int out_size, void* d_ws, size_t ws_size, hipStream_t stream) {
    if (ws_size < WS_NEED || n_in != 18) return;
    static bool attr_set = false;
    if (!attr_set) { (void)hipFuncSetAttribute((const void*)mega, hipFuncAttributeMaxDynamicSharedMemorySize, LDS_BYTES); attr_set = true; }
    (void)hipMemsetAsync((char*)d_ws + O_MISC + 16384, 0, 16384, stream);
    (void)hipMemsetAsync((char*)d_ws + O_CMAX, 0, (size_t)INC * 4, stream);
    Args a{}; for (int i = 0; i < 18; ++i) a.in[i] = (const float*)d_in[i]; a.out = (float*)d_out; a.ws = (unsigned char*)d_ws; a.ph = PH_ALL; a.pass = 0;
    mega<<<256, NTHR, LDS_BYTES, stream>>>(a);
}
```

```cpp
#include <hip/hip_runtime.h>
#include <stdint.h>
#include <math.h>

typedef unsigned short bf16_t;
typedef short bf16x8 __attribute__((ext_vector_type(8)));
typedef float f32x4 __attribute__((ext_vector_type(4)));
#define DI __device__ __forceinline__
#define ST_G(val, ptr) __builtin_nontemporal_store((val), (__attribute__((address_space(1))) decltype(val)*)(ptr))

DI const float* karg_in(int i) { const float* const* kp = (const float* const*)__builtin_amdgcn_kernarg_segment_ptr(); asm volatile("" : "+s"(kp)); return kp[i]; }
DI float* karg_out() { float* const* kp = (float* const*)__builtin_amdgcn_kernarg_segment_ptr(); asm volatile("" : "+s"(kp)); return kp[18]; }
DI float bf2f(bf16_t v) { return __uint_as_float(((unsigned)v) << 16); }
DI bf16_t f2bf(float f) { unsigned u = __float_as_uint(f); u += 0x7fffu + ((u >> 16) & 1u); return (bf16_t)(u >> 16); }

constexpr int NB = 8, S = 8192, D = 1024, M = NB * S;
constexpr int NPASS = 4, BPP = NB / NPASS, MP = BPP * S;
constexpr int INC = 10240;
constexpr int NEXP = 16384;
constexpr float ALPHA = 1.189207115002721f;
constexpr float LN_EPS = 1e-5f;
constexpr float QSCALE = 0.08838834764831845f;

constexpr size_t al(size_t x) { return (x + 255) & ~(size_t)255; }
constexpr size_t O_WIN = 0;
constexpr size_t O_WMKV = O_WIN + al((size_t)INC * D * 2);
constexpr size_t O_WBR = O_WMKV + al((size_t)1024 * 1024 * 2);
constexpr size_t O_WOUT = O_WBR + al((size_t)1024 * 1536 * 2);
constexpr size_t O_WPQ = O_WOUT + al((size_t)1024 * 1024 * 2);
constexpr size_t O_SUBK = O_WPQ + al((size_t)2048 * 1024 * 2);
constexpr size_t O_UB = O_SUBK + al((size_t)16 * 128 * 128 * 2);
constexpr size_t O_VB = O_UB + al((size_t)NEXP * D);
constexpr size_t O_USC = O_VB + al((size_t)NEXP * D);
constexpr size_t O_VSC = O_USC + al((size_t)NEXP * 4);
constexpr size_t O_XB = O_VSC + al((size_t)NEXP * 4);
constexpr size_t O_MEMB = O_XB + al((size_t)M * D * 2);
constexpr size_t O_MK = O_MEMB + al((size_t)2048 * 1024 * 2);
constexpr size_t O_MVT = O_MK + al((size_t)2048 * 512 * 2);
constexpr size_t O_H1B = O_MVT + al((size_t)8 * 512 * 256 * 2);
constexpr size_t O_H1Q = O_H1B + al((size_t)M * D * 2);
constexpr size_t O_HSC = O_H1Q + al((size_t)M * D);
constexpr size_t O_X8 = O_HSC + al((size_t)M * 4);
constexpr size_t O_XSC = O_X8 + al((size_t)M * D);
constexpr size_t O_W8 = O_XSC + al((size_t)3 * M * 4);
constexpr size_t O_WSC = O_W8 + al((size_t)INC * D);
constexpr size_t O_CMAX = O_WSC + al((size_t)INC * 4);
constexpr size_t O_WPQ8 = O_CMAX + al((size_t)INC * 4);
constexpr size_t O_MISC = O_WPQ8 + al((size_t)2048 * D);
constexpr size_t O_BGATE = O_MISC + 32768;
constexpr size_t O_PASS = O_MISC + al(65536);
constexpr size_t P_QK = 0;
constexpr size_t P_VT = P_QK + al((size_t)MP * 3072 * 2);
constexpr size_t P_IT = P_VT + (size_t)1536 * MP * 2;
constexpr size_t P_HFQG = P_IT + al((size_t)512 * MP * 2);
constexpr size_t P_MQ = P_HFQG + al((size_t)MP * 1536 * 2);
constexpr size_t P_GATE = P_MQ + al((size_t)MP * 512 * 2);
constexpr size_t P_OG = P_GATE + al((size_t)MP * 3072 * 2);
constexpr size_t P_LSE = P_OG + al((size_t)MP * 1536 * 2);
constexpr size_t P_BR = P_LSE + al((size_t)MP * 12 * 4);
constexpr size_t P_MERGED = P_BR + al((size_t)MP * 1536 * 2);
constexpr size_t P_MIX = P_MERGED + al((size_t)MP * 1024 * 2);
constexpr size_t P_HSTL = P_MIX + al((size_t)MP * 1024 * 4);
constexpr size_t P_HSTD = P_HSTL + al((size_t)256 * 16384 * 4);
constexpr size_t P_SIN = P_HSTD + al((size_t)256 * 128 * 4);
constexpr size_t P_END = P_SIN + al((size_t)256 * 16384 * 4);
constexpr size_t P_PQ = 0;
constexpr size_t P_IDX = P_PQ + al((size_t)M * 2048 * 2);
constexpr size_t P_PG = P_IDX + al((size_t)M * 128 * 4);
constexpr size_t P_C = P_PG + al((size_t)M * 128 * 4);
constexpr size_t P_END2 = P_C + al((size_t)M * 128 * 4);
constexpr size_t P_PD = 0;
constexpr size_t P_FFN = P_PD + al((size_t)M * 1024 * 2);
static_assert(P_FFN + (size_t)M * 1024 * 2 <= P_IDX, "PEER overlay");
constexpr size_t WS_NEED = O_PASS + (P_END > P_END2 ? P_END : P_END2);
static_assert(WS_NEED <= (size_t)1073741824, "workspace budget");

DI int dil_of(int g) { return g == 0 ? 1 : (g == 1 ? 4 : 16); }
DI float dpp_x(float v, const int which) {
    const int s = __float_as_int(v);
    const int r = which == 0 ? __builtin_amdgcn_update_dpp(0, s, 0xB1, 0xF, 0xF, true) : which == 1 ? __builtin_amdgcn_update_dpp(0, s, 0x4E, 0xF, 0xF, true)
                : which == 2 ? __builtin_amdgcn_update_dpp(0, s, 0x141, 0xF, 0xF, true) : __builtin_amdgcn_update_dpp(0, s, 0x128, 0xF, 0xF, true);
    return __int_as_float(r);
}
DI float pair_sum(float v) { const auto rr = __builtin_amdgcn_permlane32_swap(__float_as_uint(v), __float_as_uint(v), false, false); return __uint_as_float(rr[0]) + __uint_as_float(rr[1]); }
DI float pair_max(float v) { const auto rr = __builtin_amdgcn_permlane32_swap(__float_as_uint(v), __float_as_uint(v), false, false); return fmaxf(__uint_as_float(rr[0]), __uint_as_float(rr[1])); }
DI float wave_max(float v) {
    v = fmaxf(v, dpp_x(v, 0)); v = fmaxf(v, dpp_x(v, 1)); v = fmaxf(v, dpp_x(v, 2)); v = fmaxf(v, dpp_x(v, 3));
    { const auto rr = __builtin_amdgcn_permlane16_swap(__float_as_uint(v), __float_as_uint(v), false, false); v = fmaxf(__uint_as_float(rr[0]), __uint_as_float(rr[1])); }
    return pair_max(v);
}
DI float wave_sum(float v) {
    v += dpp_x(v, 0); v += dpp_x(v, 1); v += dpp_x(v, 2); v += dpp_x(v, 3);
    { const auto rr = __builtin_amdgcn_permlane16_swap(__float_as_uint(v), __float_as_uint(v), false, false); v = __uint_as_float(rr[0]) + __uint_as_float(rr[1]); }
    return pair_sum(v);
}

#define LAS __attribute__((address_space(3)))
#define GAS __attribute__((address_space(1)))
typedef unsigned u32x4 __attribute__((ext_vector_type(4)));
typedef unsigned u32x2 __attribute__((ext_vector_type(2)));
typedef float f32x2 __attribute__((ext_vector_type(2)));
typedef __bf16 bf16x2_t __attribute__((ext_vector_type(2)));
DI unsigned cvtpk(float lo, float hi) { f32x2 v = {lo, hi}; bf16x2_t b = __builtin_convertvector(v, bf16x2_t); return __builtin_bit_cast(unsigned, b); }
constexpr float LOG2E = 1.4426950408889634f;
constexpr int NTHR_C = 512;
DI float fast_sigmoid(float z) { return __builtin_amdgcn_rcpf(1.f + __builtin_amdgcn_exp2f(-z * LOG2E)); }

namespace g8 {
constexpr int BM = 256, BK = 64, HALF = 128, HTB = HALF * BK * 2, STAGE_BYTES = 8 * HTB;
DI int lds_byte(int r, int c) { const int st = (r >> 4) * 2 + (c >> 5), rr = r & 15, cc = c & 31, ob = rr * 64 + cc * 2; return st * 1024 + (ob ^ (((ob >> 9) & 1) << 5)); }
DI void stage_rc(int b, int& R, int& C) { const int st = b / 1024, sb = b % 1024, swz = sb ^ (((sb >> 9) & 1) << 5); R = (st >> 1) * 16 + swz / 64; C = (st & 1) * 32 + (swz % 64) / 2; }
DI int perm32(int rho) { const int n = rho >> 4, i = rho & 15; return 8 * (i >> 2) + 4 * n + (i & 3); }

struct Unit { unsigned a, b; int dla, dlb; int pm, pn, kind; };

typedef int i32x8 __attribute__((ext_vector_type(8)));
typedef int i32x4v __attribute__((ext_vector_type(4)));
template <class Epi, class Sched, int OPK = 0>
DI void gemm_phase(LAS unsigned char* lds, const char* const wsb, const int K, const Sched& S, const Epi& E, const int tid) {
    const int wid = __builtin_amdgcn_readfirstlane(tid >> 6), lane = tid & 63, wr = wid >> 2, wc = wid & 3, fr = lane & 15, fq = lane >> 4;
    constexpr bool F8 = OPK == 1;
    const int nt = K / BK;
#define G8_STAGE_OFFS(tidv) unsigned rak[2], rbk[2], ccb[2]; \
    _Pragma("unroll") for (int i_ = 0; i_ < 2; ++i_) { int R_, C_; stage_rc((tidv) * 16 + i_ * 8192, R_, C_); const int Rb_ = Epi::PERM ? ((R_ & ~31) + perm32(R_ & 31)) : R_; \
        rak[i_] = (unsigned)(R_ * K) * 2u; rbk[i_] = (unsigned)(Rb_ * K) * 2u; ccb[i_] = (unsigned)C_ * 2u; }
    const unsigned kstep = (unsigned)(BK * 2);
    const unsigned hstepA = (unsigned)(HALF * K * 2);
    const unsigned ldsw = (unsigned)wid * 1024u;
    const int aoff = lds_byte(wr * 64 + fr, fq * 8), boff = lds_byte(wc * 32 + fr, fq * 8);
#define G8_SA(b, h) (((b) * 2 + (h)) * HTB)
#define G8_SB(b, h) ((4 + (b) * 2 + (h)) * HTB)
#define G8_STAGE(bufoff, gbase, v0, v1) do { \
        __builtin_amdgcn_global_load_lds((const unsigned*)(wsb + (unsigned)((gbase) + (v0))), (LAS unsigned*)(lds + (bufoff) + ldsw), 16, 0, 0); \
        __builtin_amdgcn_global_load_lds((const unsigned*)(wsb + (unsigned)((gbase) + (v1))), (LAS unsigned*)(lds + (bufoff) + ldsw + 8192), 16, 0, 0); } while (0)
#define G8_LDA(dst, b, h) do { _Pragma("unroll") for (int m = 0; m < 4; ++m) _Pragma("unroll") for (int k = 0; k < 2; ++k) dst[m][k] = *(const LAS bf16x8*)(lds + G8_SA(b, h) + aoff + m * 2048 + k * 1024); } while (0)
#define G8_LDB(dst, b, h) do { _Pragma("unroll") for (int n = 0; n < 2; ++n) _Pragma("unroll") for (int k = 0; k < 2; ++k) dst[n][k] = *(const LAS bf16x8*)(lds + G8_SB(b, h) + boff + n * 2048 + k * 1024); } while (0)
#define G8_CAT(x) __builtin_shufflevector(__builtin_bit_cast(i32x4v, (x)[0]), __builtin_bit_cast(i32x4v, (x)[1]), 0, 1, 2, 3, 4, 5, 6, 7)
#define G8_MMA(ai, bj, At, Bt) do { __builtin_amdgcn_s_setprio(1); \
        if constexpr (F8) { _Pragma("unroll") for (int m = 0; m < 4; ++m) _Pragma("unroll") for (int n = 0; n < 2; ++n) \
            asm volatile("v_mfma_scale_f32_16x16x128_f8f6f4 %0, %1, %2, %0, %3, %3 op_sel_hi:[0,0,0]" : "+v"(acc[ai][bj][m][n]) : "v"(G8_CAT(Bt[n])), "v"(G8_CAT(At[m])), "v"(mxscale)); } \
        else if constexpr (OPK == 2) { _Pragma("unroll") for (int m = 0; m < 4; ++m) _Pragma("unroll") for (int n = 0; n < 2; ++n) _Pragma("unroll") for (int k = 0; k < 2; ++k) \
            acc[ai][bj][m][n] = __builtin_bit_cast(f32x4, __builtin_amdgcn_mfma_i32_16x16x64_i8(__builtin_bit_cast(i32x4v, Bt[n][k]), __builtin_bit_cast(i32x4v, At[m][k]), __builtin_bit_cast(i32x4v, acc[ai][bj][m][n]), 0, 0, 0)); } \
        else { _Pragma("unroll") for (int m = 0; m < 4; ++m) _Pragma("unroll") for (int n = 0; n < 2; ++n) _Pragma("unroll") for (int k = 0; k < 2; ++k) \
            acc[ai][bj][m][n] = __builtin_amdgcn_mfma_f32_16x16x32_bf16(Bt[n][k], At[m][k], acc[ai][bj][m][n], 0, 0, 0); } \
        __builtin_amdgcn_s_setprio(0); } while (0)
#define G8_WAIT_V(n) asm volatile("s_waitcnt vmcnt(" #n ")" ::: "memory")
#define G8_WAIT_L(n) asm volatile("s_waitcnt lgkmcnt(" #n ")" ::: "memory")
#define G8_BAR __builtin_amdgcn_s_barrier()
#define G8_SCHED __builtin_amdgcn_sched_barrier(0)
    Unit cur, nxt; int ui = 0;
    if (!S.next(0, cur)) return;
    f32x4 acc[2][2][4][2];
#pragma unroll
    for (int a = 0; a < 2; ++a)
#pragma unroll
        for (int b = 0; b < 2; ++b)
#pragma unroll
            for (int m = 0; m < 4; ++m)
#pragma unroll
                for (int n = 0; n < 2; ++n) acc[a][b][m][n] = (f32x4){0.f, 0.f, 0.f, 0.f};
    const int mxscale = 0x7f7f7f7f;
    bf16x8 At[4][2], B0[2][2], B1[2][2];
    unsigned cA = cur.a, cB = cur.b;
    unsigned hBc = hstepA * (unsigned)cur.dlb, hAc = hstepA * (unsigned)cur.dla;
    G8_STAGE_OFFS(tid)
    {
    const unsigned vBc0 = rbk[0] * (unsigned)cur.dlb + ccb[0], vBc1 = rbk[1] * (unsigned)cur.dlb + ccb[1];
    const unsigned vAc0 = rak[0] * (unsigned)cur.dla + ccb[0], vAc1 = rak[1] * (unsigned)cur.dla + ccb[1];
    G8_STAGE(G8_SB(0, 0), cB, vBc0, vBc1); G8_STAGE(G8_SB(0, 1), cB + hBc, vBc0, vBc1); G8_STAGE(G8_SA(0, 0), cA, vAc0, vAc1); G8_STAGE(G8_SA(0, 1), cA + hAc, vAc0, vAc1);
    if (wr == 1) G8_BAR;
    G8_WAIT_V(2); G8_BAR;
    G8_STAGE(G8_SB(1, 0), cB + kstep, vBc0, vBc1); G8_STAGE(G8_SA(1, 0), cA + kstep, vAc0, vAc1); G8_STAGE(G8_SB(1, 1), cB + hBc + kstep, vBc0, vBc1);
    G8_WAIT_V(6); G8_BAR;
    }
    for (;;) {
        const bool has_next = S.next(ui + 1, nxt);
        const unsigned nA = has_next ? nxt.a : cA, nB = has_next ? nxt.b : cB; const int dln = has_next ? nxt.dlb : cur.dlb;
        const unsigned hBn = hstepA * (unsigned)dln;
        const int dlan = has_next ? nxt.dla : cur.dla;
        const unsigned hAn = hstepA * (unsigned)dlan;
#pragma unroll 1
        for (int t = 0; t < nt; t += 2) {
            if constexpr (Epi::HOOK) E.hook(acc, cur, t, wr, wc, fr, fq);
            const bool last = (t == nt - 2);
            const bool relax = (t == 0) && (ui > 0);
            const unsigned a1 = cA + (unsigned)(t + 1) * kstep;
            const unsigned a2 = last ? nA : cA + (unsigned)(t + 2) * kstep, b2 = last ? nB : cB + (unsigned)(t + 2) * kstep;
            const unsigned a3 = a2 + kstep, b3 = b2 + kstep;
            const unsigned dBs = (unsigned)(last ? dln : cur.dlb), dAs = (unsigned)(last ? dlan : cur.dla);
            const unsigned vB0 = rbk[0] * dBs + ccb[0], vB1 = rbk[1] * dBs + ccb[1]; const unsigned hB = last ? hBn : hBc;
            const unsigned vA0 = rak[0] * dAs + ccb[0], vA1 = rak[1] * dAs + ccb[1]; const unsigned hA = last ? hAn : hAc;
            const unsigned vAc0 = rak[0] * (unsigned)cur.dla + ccb[0], vAc1 = rak[1] * (unsigned)cur.dla + ccb[1];
            G8_LDB(B0, 0, 0); G8_LDB(B1, 0, 1); G8_SCHED; G8_LDA(At, 0, 0); G8_STAGE(G8_SA(1, 1), a1 + hAc, vAc0, vAc1);
            if (relax) G8_WAIT_V(24); else G8_WAIT_V(8);
            G8_WAIT_L(0); G8_BAR; G8_MMA(0, 0, At, B0); G8_MMA(0, 1, At, B1); G8_BAR; G8_SCHED;
            G8_LDA(At, 0, 1); G8_STAGE(G8_SB(0, 0), b2, vB0, vB1); G8_STAGE(G8_SB(0, 1), b2 + hB, vB0, vB1); G8_STAGE(G8_SA(0, 0), a2, vA0, vA1);
            if (relax) G8_WAIT_V(24); else G8_WAIT_V(8);
            G8_WAIT_L(0); G8_BAR; G8_MMA(1, 0, At, B0); G8_MMA(1, 1, At, B1); G8_BAR; G8_SCHED;
            G8_LDB(B0, 1, 0); G8_LDB(B1, 1, 1); G8_SCHED; G8_LDA(At, 1, 0); G8_STAGE(G8_SA(0, 1), a2 + hA, vA0, vA1);
            G8_WAIT_V(8); G8_WAIT_L(0); G8_BAR; G8_MMA(0, 0, At, B0); G8_MMA(0, 1, At, B1); G8_BAR; G8_SCHED;
            G8_LDA(At, 1, 1); G8_STAGE(G8_SB(1, 0), b3, vB0, vB1); G8_STAGE(G8_SB(1, 1), b3 + hB, vB0, vB1); G8_STAGE(G8_SA(1, 0), a3, vA0, vA1);
            G8_WAIT_V(8); G8_WAIT_L(0); G8_BAR; G8_MMA(1, 0, At, B0); G8_MMA(1, 1, At, B1); G8_BAR; G8_SCHED;
        }
        if constexpr (F8) asm volatile("s_nop 15\n\ts_nop 7" ::: "memory");
        if (wr == 0) G8_BAR;
        E(acc, cur, wr, wc, fr, fq);
        if (!has_next) break;
#pragma unroll
        for (int a = 0; a < 2; ++a)
#pragma unroll
            for (int b = 0; b < 2; ++b)
#pragma unroll
                for (int m = 0; m < 4; ++m)
#pragma unroll
                    for (int n = 0; n < 2; ++n) acc[a][b][m][n] = (f32x4){0.f, 0.f, 0.f, 0.f};
        cur = nxt; cA = nA; cB = nB; hBc = hBn; hAc = hAn; ++ui;
        if (wr == 1) G8_BAR;
    }
    G8_WAIT_V(0);
    G8_BAR;
#undef G8_SA
#undef G8_SB
#undef G8_STAGE
#undef G8_LDA
#undef G8_LDB
#undef G8_MMA
#undef G8_STAGE_OFFS
#undef G8_CAT
#undef G8_WAIT_V
#undef G8_WAIT_L
#undef G8_BAR
#undef G8_SCHED
}
}

typedef GAS unsigned gu32;
#define XB_TMO      128
#define XB_XCNT(j)  (256  + 64 * (j))
#define XB_XSUB(j)  (1280 + 64 * (j))
#define XB_XGEN(j)  (2304 + 64 * (j))
#define XB_TOP      3328
#define XB_TOPGEN   3392
#define XCD_BAR_WORDS 3456
#define XB_SPIN_CAP (1u << 22)
DI unsigned xb_ld(unsigned* p)              { return __hip_atomic_load(p, __ATOMIC_RELAXED, __HIP_MEMORY_SCOPE_AGENT); }
DI unsigned xb_add(unsigned* p, unsigned v) { return __hip_atomic_fetch_add(p, v, __ATOMIC_RELAXED, __HIP_MEMORY_SCOPE_AGENT); }
DI unsigned xb_xcc_id() { return (unsigned)__builtin_amdgcn_s_getreg((3 << 11) | 20) & 0xFu; }
#define XB_SPIN(cond, bar) do { unsigned _sp = 0; while (cond) { __builtin_amdgcn_s_sleep(1); \
    if ((++_sp & 255u) == 0u) { if (xb_ld(&(bar)[XB_TMO])) break; if (_sp > XB_SPIN_CAP) { atomicAdd(&(bar)[XB_TMO], 1u); break; } } } } while (0)
struct XcdBarrier { unsigned* bar; unsigned x; volatile LAS unsigned* st; };
DI XcdBarrier xcd_barrier_post(unsigned* bar, volatile LAS unsigned* st) {
    XcdBarrier b; b.bar = bar; b.x = xb_xcc_id(); b.st = st;
    if (threadIdx.x == 0) st[2] = xb_add(&bar[XB_XCNT(b.x)], 1u);
    return b;
}
DI void xcd_barrier_complete(unsigned* bar, unsigned x, unsigned& nloc, unsigned& nx) {
    const unsigned G = gridDim.x * gridDim.y * gridDim.z;
    unsigned sum, cnt, mine, sp = 0u;
    for (;;) {
        sum = 0u; cnt = 0u; mine = 0u;
#pragma unroll
        for (unsigned j = 0; j < 16; ++j) { const unsigned c = xb_ld(&bar[XB_XCNT(j)]); sum += c; cnt += (c > 0u) ? 1u : 0u; mine = (j == x) ? c : mine; }
        if (sum == G) break;
        __builtin_amdgcn_s_sleep(1);
        if ((++sp & 255u) == 0u) { if (xb_ld(&bar[XB_TMO])) break; if (sp > XB_SPIN_CAP) { atomicAdd(&bar[XB_TMO], 1u); break; } }
    }
    nloc = mine > 0u ? mine : 1u; nx = cnt > 0u ? cnt : 1u;
}
DI void xcd_barrier(const XcdBarrier& b) {
    asm volatile("s_waitcnt vmcnt(0)" ::: "memory");
    __syncthreads();
    if (threadIdx.x == 0) {
        unsigned* bar = b.bar;
        __builtin_amdgcn_s_waitcnt(0);
        unsigned nloc = b.st[0], nx = b.st[1];
        if (nloc == 0u) { xcd_barrier_complete(bar, b.x, nloc, nx); b.st[0] = nloc; b.st[1] = nx; }
        const unsigned old = xb_add(&bar[XB_XSUB(b.x)], 1u);
        const unsigned gen = old / nloc;
        if (old + 1u == (gen + 1u) * nloc) {
            __builtin_amdgcn_fence(__ATOMIC_RELEASE, "agent");
            asm volatile("s_waitcnt vmcnt(0)" ::: "memory");
            const unsigned og = xb_add(&bar[XB_TOP], 1u);
            const unsigned tg = og / nx;
            if (og + 1u == (tg + 1u) * nx) xb_add(&bar[XB_TOPGEN], 1u);
            else XB_SPIN(xb_ld(&bar[XB_TOPGEN]) == tg, bar);
            __builtin_amdgcn_fence(__ATOMIC_ACQUIRE, "agent");
            xb_add(&bar[XB_XGEN(b.x)], 1u);
            asm volatile("s_waitcnt vmcnt(0)" ::: "memory");
        } else {
            XB_SPIN(xb_ld(&bar[XB_XGEN(b.x)]) == gen, bar);
            __builtin_amdgcn_fence(__ATOMIC_ACQUIRE, "agent");
            asm volatile("s_waitcnt vmcnt(0)" ::: "memory");
        }
    }
    __syncthreads();
}

constexpr int NWAVES = 8, NTHR = NWAVES * 64;
constexpr int RING_BYTES = 131072, LDS_BYTES = 147456, LDSCTL_OFF = LDS_BYTES - 1024, MISC_OFF = LDSCTL_OFF + 320;
enum { PH_ALL = 0, PH_PRO = 11, PH_PROJ = 1, PH_ATTN = 2, PH_HGPRE = 3, PH_HGMAIN = 4, PH_WIDEN = 5, PH_WOUT = 6, PH_LN1 = 7, PH_PQ = 8, PH_ROUTE = 9, PH_EXPERTS = 10, PH_HGSCAN = 12 };
struct Args { const float* in[18]; float* out; unsigned char* ws; int ph, pass; };

struct Bufs {
    const bf16_t *WIN, *XBp; bf16_t *QK, *VIT, *HFQG, *MQ, *GATE;
};

template <int KIND>
struct SchedP1 {
    static constexpr unsigned RB = 1024u;
    unsigned XBp, W; int G, c;
    DI bool next(int i, g8::Unit& u) const {
        const int L = i * G + c + (KIND ? 2048 : 0); if (L >= (KIND ? 2560 : 2048)) return false;
        if (L < 2048) { const int x = L & 7, off = L >> 3; u.pm = 8 * x + (off & 7); u.pn = off >> 3; u.kind = 0; u.dlb = 1;
            const int hp = u.pn < 12 ? (u.pn < 6 ? u.pn : u.pn - 6) : 0, lg = hp < 2 ? 0 : (hp < 4 ? 2 : 4), dl = 1 << lg;
            const int v0 = u.pm * 256, lb = v0 >> 13, vv = v0 & (S - 1), r = vv >> (13 - lg), m0 = vv & ((1 << (13 - lg)) - 1);
            u.dla = dl; u.a = XBp + (unsigned)(lb * S + m0 * dl + r) * RB; u.b = W + (unsigned)u.pn * 256u * RB; }
        else { const int idx = L - 2048; u.pm = idx & 7; u.pn = idx >> 3; u.kind = 1;
            const int lg = u.pm < 2 ? 0 : (u.pm < 4 ? 2 : (u.pm < 6 ? 4 : 0)), dl = 1 << lg;
            const int v0 = u.pn * 256, lb = v0 >> 13, vv = v0 & (S - 1), r = vv >> (13 - lg), m0 = vv & ((1 << (13 - lg)) - 1);
            u.dla = 1; u.dlb = dl; u.a = W + (unsigned)(8192 + u.pm * 256) * RB; u.b = XBp + (unsigned)(lb * S + m0 * dl + r) * RB; }
        return true;
    }
};
DI int opq(int x) { asm volatile("" : "+v"(x)); return x; }
DI f32x4 acc_i2f(const f32x4& a) { const g8::i32x4v t = __builtin_bit_cast(g8::i32x4v, a); return (f32x4){(float)t[0], (float)t[1], (float)t[2], (float)t[3]}; }
DI int frag_row_off(int d0, int r32) { return (((d0 >> 4) * 64 + ((d0 >> 3) & 1) * 32 + r32) * 8); }
DI int pos2tok(int v, int lg) { const int lb = v >> 13, pos = v & (S - 1), per_lg = 13 - lg; return (lb << 13) + ((pos & ((1 << per_lg) - 1)) << lg) + (pos >> per_lg); }
template <int KIND>
struct EpiP1 {
    static constexpr bool PERM = true, HOOK = false;
    char* ws; int t0, pad;
    DI void hook(f32x4 (&)[2][2][4][2], const g8::Unit&, int, int, int, int, int) const {}
    DI void operator()(const f32x4 (&acc)[2][2][4][2], const g8::Unit& u, int wr, int wc, int fr_in, int fq_in) const {
        char* pr = ws + O_PASS; const float* xsc = (const float*)(ws + O_XSC) + t0; const float wsg = *(const float*)(ws + O_WSC);
        const int fr = opq(fr_in), fq = opq(fq_in);
        const int rowl = wr * 64 + fr, d0 = wc * 32 + 8 * fq;
        if constexpr (KIND == 1) {
            f32x4 xq[2][2];
            { const float* xg = xsc + (u.pm < 6 ? (u.pm >> 1) : 0) * M + u.pn * 256 + d0;
#pragma unroll
              for (int bj = 0; bj < 2; ++bj) { xq[bj][0] = *(const f32x4*)(xg + bj * 128) * wsg; xq[bj][1] = *(const f32x4*)(xg + bj * 128 + 4) * wsg; } }
#pragma unroll
            for (int ai = 0; ai < 2; ++ai)
#pragma unroll
                for (int m = 0; m < 4; ++m) { const int R = u.pm * 256 + rowl + ai * 128 + m * 16;
#pragma unroll
                    for (int bj = 0; bj < 2; ++bj) { f32x4 v0 = acc_i2f(acc[ai][bj][m][0]), v1 = acc_i2f(acc[ai][bj][m][1]);
                        const int c = u.pn * 256 + bj * 128 + d0;
                        v0 = v0 * xq[bj][0]; v1 = v1 * xq[bj][1];
                        if (R < 1536) {
                            const int gh = R >> 7, d = R & 127, lb = c >> 13, pos = c & (S - 1), kk = pos & 31;
                            bf16_t* blk = (bf16_t*)(pr + P_VT) + ((size_t)((lb * 12 + gh) * 256 + (pos >> 5))) * 4096 + (((d >> 5) * 2 + (kk >> 4)) * 64 + (d & 31)) * 8 + 4 * ((kk >> 3) & 1);
                            u32x2 wa, wb; wa.x = cvtpk(v0[0], v0[1]); wa.y = cvtpk(v0[2], v0[3]); wb.x = cvtpk(v1[0], v1[1]); wb.y = cvtpk(v1[2], v1[3]);
                            ST_G(wa, (u32x2*)blk); ST_G(wb, (u32x2*)(blk + 32 * 8));
                        } else {
                            u32x4 w; w.x = cvtpk(v0[0], v0[1]); w.y = cvtpk(v0[2], v0[3]); w.z = cvtpk(v1[0], v1[1]); w.w = cvtpk(v1[2], v1[3]);
                            ST_G(w, (u32x4*)((bf16_t*)(pr + P_IT) + (size_t)(R - 1536) * MP + c));
                        } }
                    asm volatile("" ::: "memory"); }
            return;
        } else {
        float xs8[2][4];
        { const int hp_ = u.pn < 12 ? (u.pn < 6 ? u.pn : u.pn - 6) : 0; const float* xr = xsc + (hp_ < 2 ? 0 : (hp_ < 4 ? 1 : 2)) * M + u.pm * 256 + rowl;
#pragma unroll
          for (int ai = 0; ai < 2; ++ai)
#pragma unroll
              for (int m = 0; m < 4; ++m) xs8[ai][m] = xr[ai * 128 + m * 16];
#pragma unroll
          for (int ai = 0; ai < 2; ++ai)
#pragma unroll
              for (int m = 0; m < 4; ++m) xs8[ai][m] *= wsg; }
        if (u.pn < 12 || u.pn == 18 || u.pn == 19) {
#pragma unroll
            for (int ai = 0; ai < 2; ++ai)
#pragma unroll
                for (int m = 0; m < 4; ++m) { const int row = u.pm * 256 + rowl + ai * 128 + m * 16;
                    const float xs = xs8[ai][m];
#pragma unroll
                    for (int bj = 0; bj < 2; ++bj) { f32x4 v0 = acc_i2f(acc[ai][bj][m][0]), v1 = acc_i2f(acc[ai][bj][m][1]);
                        v0 = v0 * xs; v1 = v1 * xs;
                        u32x4 w; w.x = cvtpk(v0[0], v0[1]); w.y = cvtpk(v0[2], v0[3]); w.z = cvtpk(v1[0], v1[1]); w.w = cvtpk(v1[2], v1[3]);
                        bf16_t* dst;
                        if (u.pn < 12) { const int hh = u.pn * 2 + bj, qk = hh >= 12 ? 1 : 0, gh = hh - 12 * qk;
                            const int lb = row >> 13, pos = row & (S - 1);
                            dst = (bf16_t*)(pr + P_QK) + ((size_t)(((qk * BPP + lb) * 12 + gh) * 256 + (pos >> 5))) * 4096 + frag_row_off(d0, pos & 31); }
                        else { const int h = (u.pn - 18) * 2 + bj; dst = (bf16_t*)(pr + P_MQ) + ((size_t)((row >> 5) * 4 + h)) * 4096 + frag_row_off(d0, row & 31); }
                        ST_G(w, (u32x4*)dst); }
                    asm volatile("" ::: "memory"); }
            return;
        }
        bf16_t* base; int ldc, colt; bool gate = false;
        if (u.pn < 18) { base = (bf16_t*)(pr + P_HFQG); ldc = 1536; colt = (u.pn - 12) * 256; }
        else { base = (bf16_t*)(pr + P_GATE); ldc = 3072; colt = (u.pn - 20) * 256; gate = true; }
        const int row0 = u.pm * 256 + rowl, col0 = colt + d0;
        f32x4 bv[2][2];
#pragma unroll
        for (int bj = 0; bj < 2; ++bj)
#pragma unroll
            for (int n = 0; n < 2; ++n) bv[bj][n] = gate ? *(const f32x4*)((const float*)(ws + O_BGATE) + col0 + bj * 128 + 4 * n) : (f32x4){0.f, 0.f, 0.f, 0.f};
#pragma unroll
        for (int ai = 0; ai < 2; ++ai)
#pragma unroll
            for (int m = 0; m < 4; ++m) { bf16_t* rowp = base + (size_t)(row0 + ai * 128 + m * 16) * ldc + col0;
                const float xs = xs8[ai][m];
#pragma unroll
                for (int bj = 0; bj < 2; ++bj) { f32x4 v0 = acc_i2f(acc[ai][bj][m][0]), v1 = acc_i2f(acc[ai][bj][m][1]);
                    v0 = v0 * xs; v1 = v1 * xs;
                    if (gate) { v0 = v0 + bv[bj][0]; v1 = v1 + bv[bj][1];
#pragma unroll
                        for (int e = 0; e < 4; ++e) { v0[e] = fast_sigmoid(v0[e]); v1[e] = fast_sigmoid(v1[e]); } }
                    u32x4 w; w.x = cvtpk(v0[0], v0[1]); w.y = cvtpk(v0[2], v0[3]); w.z = cvtpk(v1[0], v1[1]); w.w = cvtpk(v1[2], v1[3]);
                    ST_G(w, (u32x4*)(rowp + bj * 128)); }
                asm volatile("" ::: "memory"); }
        }
    }
};

typedef float f32x16 __attribute__((ext_vector_type(16)));
typedef short s16x4 __attribute__((ext_vector_type(4)));
DI int crow(int r, int hi) { return (r & 3) + 8 * (r >> 2) + 4 * hi; }
#define MFMA32(a, b, c) __builtin_amdgcn_mfma_f32_32x32x16_bf16((a), (b), (c), 0, 0, 0)
DI bf16x8 pack8(const f32x16& p, int s) {
    u32x4 w; w.x = cvtpk(p[8 * s + 0], p[8 * s + 1]); w.y = cvtpk(p[8 * s + 2], p[8 * s + 3]); w.z = cvtpk(p[8 * s + 4], p[8 * s + 5]); w.w = cvtpk(p[8 * s + 6], p[8 * s + 7]);
    return __builtin_bit_cast(bf16x8, w);
}
DI bf16x8 ldvt(const bf16_t* vp) {
    const s16x4 lo = *(const s16x4*)vp, hi4 = *(const s16x4*)(vp + 8);
    return __builtin_shufflevector(lo, hi4, 0, 1, 2, 3, 4, 5, 6, 7);
}
constexpr int DIL_TASKS = BPP * 12 * (S / 32);
constexpr int MEM_TASKS = (MP / 32) * 4;
DI void attn_dil_wave(const bf16_t* __restrict__ QK, const bf16_t* __restrict__ VT, const LAS float* btab, LAS unsigned char* ostg, bf16_t* __restrict__ OG, float* __restrict__ LSE, int task, int lane) {
    const int r32 = lane & 31, hi = lane >> 5;
    const int q32 = task & 255, gh = (task >> 8) % 12, lb = task / (256 * 12);
    const int g = gh >> 2, h = gh & 3, dl = dil_of(g), per = S / dl;
    const int tok0 = q32 * 32, r = tok0 / per, m0 = tok0 % per;
    const size_t rowq = (size_t)lb * S + (size_t)(m0 + r32) * dl + r;
    bf16x8 qf[8];
    const int tile0 = (r * per + m0) >> 5;
    { const bf16_t* qp = QK + ((size_t)((lb * 12 + gh) * 256 + tile0)) * 4096 + lane * 8;
#pragma unroll
      for (int ks = 0; ks < 8; ++ks) qf[ks] = *(const bf16x8*)(qp + ks * 512); }
    const LAS float* bt = btab + g * 129 * 4 + h;
    f32x16 o[4];
#pragma unroll
    for (int dt = 0; dt < 4; ++dt)
#pragma unroll
        for (int i = 0; i < 16; ++i) o[dt][i] = 0.f;
    float mrun = -INFINITY, sum = 0.f;
    const bf16_t* vbase = VT + ((size_t)((lb * 12 + gh) * 256 + tile0 - 4)) * 4096 + lane * 8;
    const bf16_t* kbase = QK + ((size_t)(((BPP + lb) * 12 + gh) * 256 + tile0 - 4)) * 4096 + lane * 8;
    const int kt0 = (m0 >= 128 ? 0 : (128 - m0) >> 5);
    bf16x8 kf[8], vf[8];
#pragma unroll
    for (int ks = 0; ks < 8; ++ks) kf[ks] = *(const bf16x8*)(kbase + (size_t)kt0 * 4096 + ks * 512);
#pragma unroll 1
    for (int kt = kt0; kt < 5; ++kt) {
#pragma unroll
        for (int i = 0; i < 8; ++i) vf[i] = *(const bf16x8*)(vbase + (size_t)kt * 4096 + i * 512);
        f32x16 sc;
#pragma unroll
        for (int i = 0; i < 16; ++i) sc[i] = 0.f;
#pragma unroll
        for (int ks = 0; ks < 8; ++ks) sc = MFMA32(kf[ks], qf[ks], sc);
        if (kt < 4) {
#pragma unroll
            for (int ks = 0; ks < 8; ++ks) kf[ks] = *(const bf16x8*)(kbase + (size_t)(kt + 1) * 4096 + ks * 512);
        }
        float mx = -INFINITY;
        if (kt == 0 || kt == 4) {
#pragma unroll
            for (int i = 0; i < 16; ++i) {
                const int delta = 128 - 32 * kt + r32 - crow(i, hi);
                const bool valid = (delta >= 0) && (delta <= 128);
                const int di = delta < 0 ? 0 : (delta > 128 ? 128 : delta);
                const float x = sc[i] * (QSCALE * LOG2E) + bt[di * 4];
                sc[i] = valid ? x : -INFINITY; mx = fmaxf(mx, sc[i]);
            }
        } else {
            const LAS float* btk = bt + (128 - 32 * kt + r32 - 4 * hi) * 4;
#pragma unroll
            for (int i = 0; i < 16; ++i) { sc[i] = sc[i] * (QSCALE * LOG2E) + btk[-4 * ((i & 3) + 8 * (i >> 2))]; mx = fmaxf(mx, sc[i]); }
        }
        mx = pair_max(mx);
        if (__any(mx > mrun + 8.f)) {
            const float mnew = fmaxf(mrun, mx); const float f = __builtin_amdgcn_exp2f(mrun - mnew);
            sum *= f;
#pragma unroll
            for (int dt = 0; dt < 4; ++dt)
#pragma unroll
                for (int i = 0; i < 16; ++i) o[dt][i] *= f;
            mrun = mnew;
        }
        float ps = 0.f;
#pragma unroll
        for (int i = 0; i < 16; ++i) { sc[i] = __builtin_amdgcn_exp2f(sc[i] - mrun); ps += sc[i]; }
        ps = pair_sum(ps); sum += ps;
#pragma unroll
        for (int s = 0; s < 2; ++s) {
            const bf16x8 pb = pack8(sc, s);
#pragma unroll
            for (int dt = 0; dt < 4; ++dt) o[dt] = MFMA32(vf[dt * 2 + s], pb, o[dt]);
        }
    }
    const float inv = 1.f / sum;
#pragma unroll
    for (int dt = 0; dt < 4; ++dt)
#pragma unroll
        for (int a = 0; a < 4; ++a) { u32x2 w; w.x = cvtpk(o[dt][4 * a] * inv, o[dt][4 * a + 1] * inv); w.y = cvtpk(o[dt][4 * a + 2] * inv, o[dt][4 * a + 3] * inv);
            *(LAS u32x2*)(ostg + r32 * 272 + (32 * dt + 8 * a + 4 * hi) * 2) = w; }
    asm volatile("s_waitcnt lgkmcnt(0)" ::: "memory");
#pragma unroll
    for (int it = 0; it < 8; ++it) { const int rr = 4 * it + (lane >> 4), ch = lane & 15;
        const u32x4 w = *(const LAS u32x4*)(ostg + rr * 272 + ch * 16);
        *(u32x4*)(OG + ((size_t)lb * S + (size_t)(m0 + rr) * dl + r) * 1536 + g * 512 + h * 128 + ch * 8) = w; }
    asm volatile("s_waitcnt lgkmcnt(0)" ::: "memory");
    if (hi == 0) LSE[rowq * 12 + gh] = (mrun + __builtin_amdgcn_logf(sum)) * 0.6931471805599453f;
}
DI void attn_mem_wave(const bf16_t* __restrict__ MQ, const bf16_t* __restrict__ MK, const bf16_t* __restrict__ MVT, bf16_t* __restrict__ BR, int task, int batch0, int lane) {
    const int r32 = lane & 31, hi = lane >> 5;
    const int h = task & 3, blk = task >> 2;
    const size_t rowq = (size_t)blk * 32 + r32; const int b = batch0 + blk * 32 / S;
    bf16x8 qf[8];
    { const bf16_t* qp = MQ + ((size_t)(blk * 4 + h)) * 4096 + lane * 8;
#pragma unroll
      for (int ks = 0; ks < 8; ++ks) qf[ks] = *(const bf16x8*)(qp + ks * 512); }
    f32x16 o[4];
#pragma unroll
    for (int dt = 0; dt < 4; ++dt)
#pragma unroll
        for (int i = 0; i < 16; ++i) o[dt][i] = 0.f;
    float mrun = -INFINITY, sum = 0.f;
    const bf16_t* vbase = MVT + ((size_t)((b * 4 + h) * 8)) * 4096 + lane * 8;
    const bf16_t* kbase = MK + ((size_t)((b * 4 + h) * 8)) * 4096 + lane * 8;
#pragma unroll 1
    for (int c = 0; c < 4; ++c) {
        bf16x8 vf[16];
#pragma unroll
        for (int i = 0; i < 16; ++i) vf[i] = *(const bf16x8*)(vbase + (size_t)(c * 2 + (i >> 3)) * 4096 + (i & 7) * 512);
        f32x16 sc[2]; float mx = -INFINITY;
#pragma unroll
        for (int kt = 0; kt < 2; ++kt) {
            const bf16_t* kp = kbase + (size_t)(c * 2 + kt) * 4096;
            f32x16 acc;
#pragma unroll
            for (int i = 0; i < 16; ++i) acc[i] = 0.f;
#pragma unroll
            for (int ks = 0; ks < 8; ++ks) { const bf16x8 kf = *(const bf16x8*)(kp + ks * 512); acc = MFMA32(kf, qf[ks], acc); }
#pragma unroll
            for (int i = 0; i < 16; ++i) { sc[kt][i] = acc[i] * (QSCALE * LOG2E); mx = fmaxf(mx, sc[kt][i]); }
            asm volatile("" ::: "memory");
        }
        mx = pair_max(mx);
        if (__any(mx > mrun + 8.f)) {
            const float mnew = fmaxf(mrun, mx); const float f = __builtin_amdgcn_exp2f(mrun - mnew);
            sum *= f;
#pragma unroll
            for (int dt = 0; dt < 4; ++dt)
#pragma unroll
                for (int i = 0; i < 16; ++i) o[dt][i] *= f;
            mrun = mnew;
        }
        float ps = 0.f;
#pragma unroll
        for (int kt = 0; kt < 2; ++kt)
#pragma unroll
            for (int i = 0; i < 16; ++i) { sc[kt][i] = __builtin_amdgcn_exp2f(sc[kt][i] - mrun); ps += sc[kt][i]; }
        ps = pair_sum(ps); sum += ps;
#pragma unroll
        for (int kt = 0; kt < 2; ++kt)
#pragma unroll
            for (int s = 0; s < 2; ++s) {
                const bf16x8 pb = pack8(sc[kt], s);
#pragma unroll
                for (int dt = 0; dt < 4; ++dt) o[dt] = MFMA32(vf[kt * 8 + dt * 2 + s], pb, o[dt]);
                asm volatile("" ::: "memory");
            }
    }
    const float inv = 1.f / sum;
    bf16_t* op = BR + rowq * 1536 + 1024 + h * 128 + 4 * hi;
#pragma unroll
    for (int dt = 0; dt < 4; ++dt)
#pragma unroll
        for (int a = 0; a < 4; ++a) { u32x2 w; w.x = cvtpk(o[dt][4 * a] * inv, o[dt][4 * a + 1] * inv); w.y = cvtpk(o[dt][4 * a + 2] * inv, o[dt][4 * a + 3] * inv); *(u32x2*)(op + 32 * dt + 8 * a) = w; }
}

constexpr int HG_SCH = 4, HG_UPS = S / 64 / HG_SCH  , HG_UNITS = BPP * 4 * HG_UPS  ;
constexpr int HG_ROW = 136, HG_KT_ROW = 72;
constexpr int HG_KP = 0, HG_QP = 64 * HG_ROW * 2, HG_QPP = 2 * HG_QP, HG_KPPT = 3 * HG_QP, HG_DEC = HG_KPPT + 128 * HG_KT_ROW * 2, HG_SSQ = HG_DEC + 512, HG_PSUM = HG_SSQ + 1024, HG_UNIT_BYTES = HG_PSUM + 2048;
DI bf16x8 lds_ld2x8(const LAS unsigned char* p) {
    const s16x4 lo = *(const LAS s16x4*)p, hi4 = *(const LAS s16x4*)(p + 16);
    return __builtin_shufflevector(lo, hi4, 0, 1, 2, 3, 4, 5, 6, 7);
}
DI float lds_bf(const LAS unsigned char* p) { return __uint_as_float((unsigned)(*(const LAS unsigned short*)p) << 16); }
template <bool MAIN>
DI void hgrn_unit(LAS unsigned char* ul, int unit, int u, const bf16_t* __restrict__ HFQG, const bf16_t* __restrict__ IT, const float* __restrict__ lbv, const float* __restrict__ nwv,
                  float* HSTL, float* HSTD, const float* __restrict__ SIN, bf16_t* __restrict__ BR) {
    constexpr int NX = MAIN ? 4 : 2;
    const int lane = u & 63, w = u >> 6, r32 = lane & 31, hi = lane >> 5, dvt = w & 3, wh = w >> 2;
    const int seq = unit / HG_UPS, j = unit % HG_UPS, lb = seq >> 2, h = seq & 3;
    const int dk = u & 127, qt = u >> 7, cb = 16 * qt;
    const float lbd = lbv[h * 128 + dk];
    const size_t row0 = (size_t)lb * S + (size_t)j * (64 * HG_SCH);
    LAS unsigned char* Kp = ul + HG_KP; LAS unsigned char* Qp = ul + HG_QP; LAS unsigned char* Qpp = ul + HG_QPP; LAS unsigned char* KppT = ul + HG_KPPT;
    LAS float* dec = (LAS float*)(ul + HG_DEC); LAS float* ssq = (LAS float*)(ul + HG_SSQ); LAS float* psum = (LAS float*)(ul + HG_PSUM);
    const int dk0 = MAIN ? 0 : 64 * wh;
    f32x16 X[NX];
    if (MAIN) {
        const float* Sp = SIN + (size_t)unit * 16384 + 32 * dvt + r32;
#pragma unroll
        for (int t = 0; t < NX; ++t)
#pragma unroll
            for (int i = 0; i < 16; ++i) X[t][i] = Sp[(size_t)(32 * t + crow(i, hi)) * 128];
    } else {
#pragma unroll
        for (int t = 0; t < NX; ++t)
#pragma unroll
            for (int i = 0; i < 16; ++i) X[t][i] = 0.f;
    }
    float atot = 0.f;
    u32x4 sf[2], sq[2];
    {
        const int sc0 = u >> 4, sch = (u & 15) * 8;
        const bf16_t* fp = HFQG + (row0 + sc0) * 1536 + h * 128 + sch;
#pragma unroll
        for (int i = 0; i < 2; ++i) { sf[i] = *(const u32x4*)(fp + (size_t)(32 * i) * 1536); if (MAIN) sq[i] = *(const u32x4*)(fp + (size_t)(32 * i) * 1536 + 512); }
    }
#pragma unroll 1
    for (int ch = 0; ch < HG_SCH; ++ch) {
        const size_t rc = row0 + (size_t)ch * 64;
        {
            const int sc0 = opq(u) >> 4, sch = (opq(u) & 15) * 8;
#pragma unroll
            for (int i = 0; i < 2; ++i) { *(LAS u32x4*)(Kp + ((sc0 + 32 * i) * HG_ROW + sch) * 2) = sf[i]; if (MAIN) *(LAS u32x4*)(Qp + ((sc0 + 32 * i) * HG_ROW + sch) * 2) = sq[i]; }
        }
        __syncthreads();
        const bf16_t* itrow = IT + (size_t)(h * 128 + 32 * dvt + opq(r32)) * MP;
        bf16x8 ib[4], it0[2], it1[2]; u32x2 gwv[4];
#pragma unroll
        for (int ks = 0; ks < 4; ++ks) ib[ks] = *(const bf16x8*)(itrow + rc + 16 * ks + 8 * hi);
        if (MAIN) {
#pragma unroll
            for (int step = 0; step < 2; ++step) { it0[step] = ldvt(itrow + rc + 16 * step + 4 * hi); it1[step] = ldvt(itrow + rc + 32 + 16 * step + 4 * hi); }
            const size_t grow = rc + 32 * wh + opq(r32);
#pragma unroll
            for (int a4 = 0; a4 < 4; ++a4) gwv[a4] = *(const u32x2*)(HFQG + grow * 1536 + 1024 + h * 128 + 32 * dvt + 4 * opq(hi) + 8 * a4);
        }
        float fv[16], lf[16];
        {
            float s = 0.f;
#pragma unroll
            for (int i = 0; i < 16; ++i) { fv[i] = lbd + (1.f - lbd) * fast_sigmoid(lds_bf(Kp + ((cb + i) * HG_ROW + dk) * 2)); lf[i] = __builtin_amdgcn_logf(fv[i]); s += lf[i]; }
            psum[qt * 128 + dk] = s;
        }
        __syncthreads();
        {
            const float p0 = psum[dk], p1 = psum[128 + dk], p2 = psum[256 + dk], p3 = psum[384 + dk];
            const float amid = p0 + p1, alast = (p0 + p1) + (p2 + p3);
            float run = qt == 0 ? 0.f : (qt == 1 ? p0 : (qt == 2 ? amid : amid + p2));
            atot += alast;
            const float Ela = __builtin_amdgcn_exp2f(alast - amid), Ea = __builtin_amdgcn_exp2f(amid);
#pragma unroll
            for (int c8 = 0; c8 < 2; ++c8) {
                float kt[8];
#pragma unroll
                for (int e = 0; e < 8; ++e) { const int i = 8 * c8 + e, c = cb + i; run += lf[i]; const float key = 1.f - fv[i];
                    const float e1 = __builtin_amdgcn_exp2f(amid - run);
                    const float kp = key * e1;
                    kt[e] = kp * Ela;
                    if (MAIN) { *(LAS bf16_t*)(Kp + (c * HG_ROW + dk) * 2) = (bf16_t)cvtpk(kp, kp);
                        const float qp = lds_bf(Qp + (c * HG_ROW + dk) * 2) * __builtin_amdgcn_rcpf(e1);
                        *(LAS bf16_t*)(Qp + (c * HG_ROW + dk) * 2) = (bf16_t)cvtpk(qp, qp);
                        *(LAS bf16_t*)(Qpp + (c * HG_ROW + dk) * 2) = (bf16_t)cvtpk(qp * Ea, qp * Ea); } }
                u32x4 wv; wv.x = cvtpk(kt[0], kt[1]); wv.y = cvtpk(kt[2], kt[3]); wv.z = cvtpk(kt[4], kt[5]); wv.w = cvtpk(kt[6], kt[7]);
                *(LAS u32x4*)(KppT + (dk * HG_KT_ROW + cb + 8 * c8) * 2) = wv;
            }
            if (qt == 0) dec[dk] = __builtin_amdgcn_exp2f(alast);
        }
        if (ch + 1 < HG_SCH) {
            const int sc0 = opq(u) >> 4, sch = (opq(u) & 15) * 8;
            const bf16_t* fp = HFQG + (rc + 64 + sc0) * 1536 + h * 128 + sch;
#pragma unroll
            for (int i = 0; i < 2; ++i) { sf[i] = *(const u32x4*)(fp + (size_t)(32 * i) * 1536); if (MAIN) sq[i] = *(const u32x4*)(fp + (size_t)(32 * i) * 1536 + 512); }
        }
        __syncthreads();
        f32x16 o;
        if (MAIN) {
#pragma unroll
            for (int i = 0; i < 16; ++i) o[i] = 0.f;
            const LAS unsigned char* qrow = Qpp + ((32 * wh + r32) * HG_ROW) * 2;
#pragma unroll
            for (int t = 0; t < 4; ++t)
#pragma unroll
                for (int step = 0; step < 2; ++step) { o = MFMA32(pack8(X[t], step), lds_ld2x8(qrow + (32 * t + 16 * step + 4 * hi) * 2), o); }
            __builtin_amdgcn_sched_barrier(0);
            const int r32m = opq(r32);
            const LAS unsigned char* qprow = Qp + ((32 * wh + r32) * HG_ROW) * 2;
            {
                f32x16 sc;
#pragma unroll
                for (int i = 0; i < 16; ++i) sc[i] = 0.f;
#pragma unroll
                for (int ks = 0; ks < 8; ++ks) { const int cof = (16 * ks + 8 * hi) * 2; sc = MFMA32(*(const LAS bf16x8*)(Kp + (r32 * HG_ROW) * 2 + cof), *(const LAS bf16x8*)(qprow + cof), sc); }
                if (wh == 0) {
#pragma unroll
                    for (int i = 0; i < 16; ++i) sc[i] = (crow(i, hi) <= r32m) ? sc[i] : 0.f;
                }
#pragma unroll
                for (int step = 0; step < 2; ++step) o = MFMA32(it0[step], pack8(sc, step), o);
                __builtin_amdgcn_sched_barrier(0);
            }
            if (wh == 1) {
                f32x16 sc;
#pragma unroll
                for (int i = 0; i < 16; ++i) sc[i] = 0.f;
#pragma unroll
                for (int ks = 0; ks < 8; ++ks) { const int cof = (16 * ks + 8 * hi) * 2; sc = MFMA32(*(const LAS bf16x8*)(Kp + ((32 + r32) * HG_ROW) * 2 + cof), *(const LAS bf16x8*)(qprow + cof), sc); }
#pragma unroll
                for (int i = 0; i < 16; ++i) sc[i] = (crow(i, hi) <= r32m) ? sc[i] : 0.f;
#pragma unroll
                for (int step = 0; step < 2; ++step) o = MFMA32(it1[step], pack8(sc, step), o);
                __builtin_amdgcn_sched_barrier(0);
            }
        }
        {
#pragma unroll
            for (int t = 0; t < NX; ++t) {
#pragma unroll
                for (int i = 0; i < 16; ++i) X[t][i] *= dec[dk0 + 32 * t + crow(i, hi)];
#pragma unroll
                for (int ks = 0; ks < 4; ++ks) { const bf16x8 ka = *(const LAS bf16x8*)(KppT + ((dk0 + 32 * t + r32) * HG_KT_ROW + 16 * ks + 8 * hi) * 2); X[t] = MFMA32(ka, ib[ks], X[t]); }
                __builtin_amdgcn_sched_barrier(0);
            }
        }
        if (MAIN) {
            float q2 = 0.f;
#pragma unroll
            for (int i = 0; i < 16; ++i) q2 += o[i] * o[i];
            q2 = pair_sum(q2); if (hi == 0) ssq[dvt * 64 + 32 * wh + r32] = q2;
        }
        __syncthreads();
        if (MAIN) {
            const int r32o = opq(r32), hio = opq(hi);
            const int c = 32 * wh + r32o; const float tot = ssq[c] + ssq[64 + c] + ssq[128 + c] + ssq[192 + c];
            const float rs = rsqrtf(tot * (1.f / 128.f) + LN_EPS);
            const size_t row = rc + c; const int col = h * 128 + 32 * dvt + 4 * hio;
#pragma unroll
            for (int a4 = 0; a4 < 4; ++a4) {
                const u32x2 gw = gwv[a4]; const f32x4 nw4 = *(const f32x4*)(nwv + col + 8 * a4);
                const float g0 = __uint_as_float(gw.x << 16), g1 = __uint_as_float(gw.x & 0xffff0000u), g2 = __uint_as_float(gw.y << 16), g3 = __uint_as_float(gw.y & 0xffff0000u);
                const float v0 = o[4 * a4] * rs * nw4[0] * g0 * fast_sigmoid(g0), v1 = o[4 * a4 + 1] * rs * nw4[1] * g1 * fast_sigmoid(g1);
                const float v2 = o[4 * a4 + 2] * rs * nw4[2] * g2 * fast_sigmoid(g2), v3 = o[4 * a4 + 3] * rs * nw4[3] * g3 * fast_sigmoid(g3);
                u32x2 wv; wv.x = cvtpk(v0, v1); wv.y = cvtpk(v2, v3);
                *(u32x2*)(BR + row * 1536 + 512 + col + 8 * a4) = wv;
            }
        }
    }
    if (!MAIN) {
        float* L = HSTL + (size_t)unit * 16384 + 32 * dvt + r32;
#pragma unroll
        for (int t = 0; t < NX; ++t)
#pragma unroll
            for (int i = 0; i < 16; ++i) L[(size_t)(dk0 + 32 * t + crow(i, hi)) * 128] = X[t][i];
        if (qt == 0) HSTD[(size_t)unit * 128 + dk] = __builtin_amdgcn_exp2f(atot);
    }
}
DI void hgrn_scan(const float* __restrict__ HSTL, const float* __restrict__ HSTD, float* __restrict__ SIN, int gt) {
    if (gt >= BPP * 4 * 16384) return;
    const int seq = gt >> 14, el = gt & 16383, dkk = el >> 7;
    float st = 0.f;
    for (int j = 0; j < HG_UPS; ++j) { const size_t uo = (size_t)(seq * HG_UPS + j); SIN[uo * 16384 + el] = st; st = HSTD[uo * 128 + dkk] * st + HSTL[uo * 16384 + el]; }
}

struct SchedRows {
    unsigned A, B; int K, nN, nU, G, c;
    DI bool next(int i, g8::Unit& u) const {
        const int L = i * G + c; if (L >= nU) return false;
        const int x = L & 7, off = L >> 3, grp = off / (8 * nN), o2 = off % (8 * nN);
        const int ppx = nU / nN / 8;
        u.pm = x * ppx + 8 * grp + (o2 & 7); u.pn = o2 >> 3; u.kind = 0; u.dla = 1; u.dlb = 1;
        u.a = A + (unsigned)u.pm * 256u * K * 2u; u.b = B + (unsigned)u.pn * 256u * K * 2u; return true;
    }
};
DI void unpack8(const u32x4 w, float (&f)[8]) {
    f[0] = __uint_as_float(w.x << 16); f[1] = __uint_as_float(w.x & 0xffff0000u); f[2] = __uint_as_float(w.y << 16); f[3] = __uint_as_float(w.y & 0xffff0000u);
    f[4] = __uint_as_float(w.z << 16); f[5] = __uint_as_float(w.z & 0xffff0000u); f[6] = __uint_as_float(w.w << 16); f[7] = __uint_as_float(w.w & 0xffff0000u);
}
struct EpiWidenF {
    static constexpr bool PERM = true, HOOK = true;
    const bf16_t* GATE; bf16_t* MERGED;
    DI void hook(f32x4 (&acc)[2][2][4][2], const g8::Unit& u, int t, int wr, int wc, int fr, int fq) const {
        if (t != 8 && t != 16) return;
        const int g = (t >> 3) - 1;
        const int row0 = u.pm * 256 + wr * 64 + fr, col0 = u.pn * 256 + wc * 32 + 8 * fq;
#pragma unroll
        for (int ai = 0; ai < 2; ++ai)
#pragma unroll
            for (int m = 0; m < 4; ++m) { const bf16_t* gp = GATE + (size_t)(row0 + ai * 128 + m * 16) * 3072 + g * 1024 + col0;
#pragma unroll
                for (int bj = 0; bj < 2; ++bj) { float ga[8], gb[8]; unpack8(*(const u32x4*)(gp + bj * 128), ga); unpack8(*(const u32x4*)(gp + 1024 + bj * 128), gb);
#pragma unroll
                    for (int e = 0; e < 4; ++e) { acc[ai][bj][m][0][e] *= ga[e] * __builtin_amdgcn_rcpf(gb[e]); acc[ai][bj][m][1][e] *= ga[4 + e] * __builtin_amdgcn_rcpf(gb[4 + e]); } } }
    }
    DI void operator()(const f32x4 (&acc)[2][2][4][2], const g8::Unit& u, int wr, int wc, int fr, int fq) const {
        const int row0 = u.pm * 256 + wr * 64 + fr, col0 = u.pn * 256 + wc * 32 + 8 * fq;
#pragma unroll
        for (int ai = 0; ai < 2; ++ai)
#pragma unroll
            for (int m = 0; m < 4; ++m) { const size_t row = (size_t)(row0 + ai * 128 + m * 16);
#pragma unroll
                for (int bj = 0; bj < 2; ++bj) { float gc[8]; unpack8(*(const u32x4*)(GATE + row * 3072 + 2048 + col0 + bj * 128), gc);
                    const f32x4 v0 = acc[ai][bj][m][0], v1 = acc[ai][bj][m][1];
                    u32x4 w; w.x = cvtpk(v0[0] * gc[0], v0[1] * gc[1]); w.y = cvtpk(v0[2] * gc[2], v0[3] * gc[3]); w.z = cvtpk(v1[0] * gc[4], v1[1] * gc[5]); w.w = cvtpk(v1[2] * gc[6], v1[3] * gc[7]);
                    *(u32x4*)(MERGED + row * 1024 + col0 + bj * 128) = w; } }
    }
};
struct EpiScores {
    static constexpr bool PERM = true, HOOK = false;
    bf16_t* SC; const float* hsc; const float* wsc;
    DI void hook(f32x4 (&)[2][2][4][2], const g8::Unit&, int, int, int, int, int) const {}
    DI void operator()(const f32x4 (&acc)[2][2][4][2], const g8::Unit& u, int wr, int wc, int fr, int fq) const {
        const int rowl = wr * 64 + fr, d0 = wc * 32 + 8 * fq;
        float xs8[2][4];
        { const float* xr = hsc + u.pm * 256 + rowl; const float wsg = wsc[0];
#pragma unroll
          for (int ai = 0; ai < 2; ++ai)
#pragma unroll
              for (int m = 0; m < 4; ++m) xs8[ai][m] = xr[ai * 128 + m * 16];
#pragma unroll
          for (int ai = 0; ai < 2; ++ai)
#pragma unroll
              for (int m = 0; m < 4; ++m) xs8[ai][m] *= wsg; }
#pragma unroll
        for (int ai = 0; ai < 2; ++ai)
#pragma unroll
            for (int m = 0; m < 4; ++m) { const int row = u.pm * 256 + rowl + ai * 128 + m * 16;
#pragma unroll
                for (int bj = 0; bj < 2; ++bj) { const f32x4 v0 = acc_i2f(acc[ai][bj][m][0]) * xs8[ai][m], v1 = acc_i2f(acc[ai][bj][m][1]) * xs8[ai][m];
                    u32x4 w; w.x = cvtpk(v0[0], v0[1]); w.y = cvtpk(v0[2], v0[3]); w.z = cvtpk(v1[0], v1[1]); w.w = cvtpk(v1[2], v1[3]);
                    *(u32x4*)(SC + ((size_t)((row >> 5) * 16 + u.pn * 2 + bj)) * 4096 + frag_row_off(d0, row & 31)) = w; } }
    }
};
struct EpiPlainB16 {
    static constexpr bool PERM = true, HOOK = false;
    bf16_t* C; int ldc, pad;
    DI void hook(f32x4 (&)[2][2][4][2], const g8::Unit&, int, int, int, int, int) const {}
    DI void operator()(const f32x4 (&acc)[2][2][4][2], const g8::Unit& u, int wr, int wc, int fr, int fq) const {
        const int row0 = u.pm * 256 + wr * 64 + fr, col0 = u.pn * 256 + wc * 32 + 8 * fq;
#pragma unroll
        for (int ai = 0; ai < 2; ++ai)
#pragma unroll
            for (int m = 0; m < 4; ++m) { bf16_t* rowp = C + (size_t)(row0 + ai * 128 + m * 16) * ldc + col0;
#pragma unroll
                for (int bj = 0; bj < 2; ++bj) { const f32x4 v0 = acc[ai][bj][m][0], v1 = acc[ai][bj][m][1];
                    u32x4 w; w.x = cvtpk(v0[0], v0[1]); w.y = cvtpk(v0[2], v0[3]); w.z = cvtpk(v1[0], v1[1]); w.w = cvtpk(v1[2], v1[3]);
                    *(u32x4*)(rowp + bj * 128) = w; } }
    }
};
DI void lse_merge_items(const bf16_t* __restrict__ OG, const float* __restrict__ LSE, bf16_t* __restrict__ BR, int first, int stride) {
    for (int it0 = first; it0 < MP * 64; it0 += 4 * stride) {
        u32x4 va[4], vb[4], vc[4]; float l0[4], l1[4], l2[4];
#pragma unroll
        for (int u = 0; u < 4; ++u) { const int it = it0 + u * stride; const int row = it >> 6, c8 = it & 63, h = c8 >> 4;
            const bf16_t* og = OG + (size_t)row * 1536 + c8 * 8;
            va[u] = *(const u32x4*)og; vb[u] = *(const u32x4*)(og + 512); vc[u] = *(const u32x4*)(og + 1024);
            l0[u] = LSE[(size_t)row * 12 + h]; l1[u] = LSE[(size_t)row * 12 + 4 + h]; l2[u] = LSE[(size_t)row * 12 + 8 + h]; }
#pragma unroll
        for (int u = 0; u < 4; ++u) { const int it = it0 + u * stride; const int row = it >> 6, c8 = it & 63;
            const float mx = fmaxf(l0[u], fmaxf(l1[u], l2[u])); const float e0 = __expf(l0[u] - mx), e1 = __expf(l1[u] - mx), e2 = __expf(l2[u] - mx); const float inv = 1.f / (e0 + e1 + e2);
            float a[8], b[8], c[8]; unpack8(va[u], a); unpack8(vb[u], b); unpack8(vc[u], c);
            float r[8];
#pragma unroll
            for (int e = 0; e < 8; ++e) r[e] = (e0 * a[e] + e1 * b[e] + e2 * c[e]) * inv;
            u32x4 w; w.x = cvtpk(r[0], r[1]); w.y = cvtpk(r[2], r[3]); w.z = cvtpk(r[4], r[5]); w.w = cvtpk(r[6], r[7]);
            *(u32x4*)(BR + (size_t)row * 1536 + c8 * 8) = w; }
    }
}
template <int NR>
DI void ln1_rows(const bf16_t* __restrict__ x, const bf16_t* __restrict__ mix, const float* __restrict__ g, const float* __restrict__ b, bf16_t* __restrict__ h1b, unsigned char* __restrict__ h1q, float* __restrict__ hsc, int wave0, int nwaves, int lane) {
    for (int row0 = wave0 * NR; row0 < MP; row0 += nwaves * NR) {
        u32x4 xa[NR], xb[NR], ma[NR], mb[NR];
#pragma unroll
        for (int r = 0; r < NR; ++r) { const size_t o = (size_t)(row0 + r) * D + 16 * lane;
            xa[r] = *(const u32x4*)(x + o); xb[r] = *(const u32x4*)(x + o + 8); ma[r] = *(const u32x4*)(mix + o); mb[r] = *(const u32x4*)(mix + o + 8); }
#pragma unroll
        for (int r = 0; r < NR; ++r) {
            const int row = row0 + r;
            float xf[16], mf[16]; unpack8(xa[r], *(float(*)[8])&xf[0]); unpack8(xb[r], *(float(*)[8])&xf[8]); unpack8(ma[r], *(float(*)[8])&mf[0]); unpack8(mb[r], *(float(*)[8])&mf[8]);
            f32x4 v[4]; float s = 0.f;
#pragma unroll
            for (int j = 0; j < 4; ++j) {
#pragma unroll
                for (int e = 0; e < 4; ++e) { v[j][e] = xf[4 * j + e] * ALPHA + mf[4 * j + e]; s += v[j][e]; } }
            const float mean = wave_sum(s) * (1.f / D); float q = 0.f;
#pragma unroll
            for (int j = 0; j < 4; ++j) { v[j] = v[j] - mean; q += (v[j][0] * v[j][0] + v[j][1] * v[j][1]) + (v[j][2] * v[j][2] + v[j][3] * v[j][3]); }
            const float rstd = rsqrtf(wave_sum(q) * (1.f / D) + LN_EPS);
            u32x4 o0, o1; float amax = 0.f;
#pragma unroll
            for (int j = 0; j < 4; ++j) { const f32x4 gg = *(const f32x4*)(g + 16 * lane + 4 * j), bb = *(const f32x4*)(b + 16 * lane + 4 * j); const f32x4 o = v[j] * rstd * gg + bb; v[j] = o;
                amax = fmaxf(amax, fmaxf(fmaxf(fabsf(o[0]), fabsf(o[1])), fmaxf(fabsf(o[2]), fabsf(o[3]))));
                if (j < 2) { o0[2 * j] = cvtpk(o[0], o[1]); o0[2 * j + 1] = cvtpk(o[2], o[3]); } else { o1[2 * (j - 2)] = cvtpk(o[0], o[1]); o1[2 * (j - 2) + 1] = cvtpk(o[2], o[3]); } }
            amax = wave_max(amax); const float qs = amax > 0.f ? 127.f / amax : 1.f;
            u32x4 qv;
#pragma unroll
            for (int j = 0; j < 4; ++j) qv[j] = ((unsigned)__float2int_rn(v[j][0] * qs) & 0xffu) | (((unsigned)__float2int_rn(v[j][1] * qs) & 0xffu) << 8) | (((unsigned)__float2int_rn(v[j][2] * qs) & 0xffu) << 16) | (((unsigned)__float2int_rn(v[j][3] * qs) & 0xffu) << 24);
            *(u32x4*)(h1q + (size_t)row * D + 16 * lane) = qv;
            if (lane == 0) hsc[row] = amax > 0.f ? amax * (1.f / 127.f) : 1.f;
        }
    }
}

DI unsigned mono(float f) { const unsigned u = __float_as_uint(f); return (u & 0x80000000u) ? ~u : (u | 0x80000000u); }
DI float demono(unsigned m) { return __uint_as_float((m & 0x80000000u) ? (m & 0x7fffffffu) : ~m); }
#define CE_DESC(a, b) do { const unsigned _hi = (a) > (b) ? (a) : (b), _lo = (a) > (b) ? (b) : (a); (a) = _hi; (b) = _lo; } while (0)
DI void sort16_desc(unsigned (&k)[16]) {
    constexpr unsigned char NA[63] = {0, 2, 0, 1, 1, 4, 6, 4, 5, 5, 0, 2, 2, 1, 3, 3, 1, 3, 5, 8, 10, 8, 9, 9, 12, 14, 12, 13, 13, 8, 10, 10, 9, 11, 11, 9, 11, 13, 0, 4, 4, 2, 6, 6, 2, 6, 10, 1, 5, 5, 3, 7, 7, 3, 7, 11, 1, 3, 5, 7, 9, 11, 13};
    constexpr unsigned char NB[63] = {1, 3, 2, 3, 2, 5, 7, 6, 7, 6, 4, 6, 4, 5, 7, 5, 2, 4, 6, 9, 11, 10, 11, 10, 13, 15, 14, 15, 14, 12, 14, 12, 13, 15, 13, 10, 12, 14, 8, 12, 8, 10, 14, 10, 4, 8, 12, 9, 13, 9, 11, 15, 11, 5, 9, 13, 2, 4, 6, 8, 10, 12, 14};
#pragma unroll
    for (int c = 0; c < 63; ++c) CE_DESC(k[NA[c]], k[NB[c]]);
}
DI void merge_top16(unsigned (&t)[16], const unsigned (&l)[16]) {
#pragma unroll
    for (int i = 0; i < 16; ++i) t[i] = t[i] > l[15 - i] ? t[i] : l[15 - i];
#pragma unroll
    for (int stride = 8; stride > 0; stride >>= 1)
#pragma unroll
        for (int i = 0; i < 16; ++i) { const int j = i ^ stride; if (j > i) CE_DESC(t[i], t[j]); }
}
DI void route_wave(const bf16_t* __restrict__ SC, int* __restrict__ IDX, float* __restrict__ PG, int tb, int h, int lane) {
    const int r32 = lane & 31, hi = lane >> 5;
    const size_t tok = (size_t)tb * 32 + r32;
    unsigned Tp[2][16];
#pragma unroll
    for (int p = 0; p < 2; ++p) {
        const bf16_t* sp = SC + ((size_t)(tb * 16 + h * 2 + p)) * 4096 + lane * 8;
        u32x4 sv[8];
#pragma unroll
        for (int ks = 0; ks < 8; ++ks) sv[ks] = *(const u32x4*)(sp + ks * 512);
#pragma unroll
        for (int nt = 0; nt < 4; ++nt) {
            unsigned L[16];
#pragma unroll
            for (int e = 0; e < 16; ++e) { const int ks = 2 * nt + (e >> 3), j = e & 7; const unsigned w = sv[ks][j >> 1];
                const float sc = __uint_as_float((j & 1) ? (w & 0xffff0000u) : (w << 16));
                L[e] = (mono(sc) & ~0x7fu) | (unsigned)(127 - (16 * ks + 8 * hi + j)); }
            sort16_desc(L);
            if (nt == 0) {
#pragma unroll
                for (int i = 0; i < 16; ++i) Tp[p][i] = L[i];
            } else merge_top16(Tp[p], L);
            __builtin_amdgcn_sched_barrier(0);
        }
    }
    unsigned T[16];
    { unsigned O[16];
#pragma unroll
      for (int i = 0; i < 16; ++i) { const auto rr = __builtin_amdgcn_permlane32_swap(Tp[0][i], Tp[1][i], false, false); T[i] = rr[0]; O[i] = rr[1]; }
      merge_top16(T, O); }
    __builtin_amdgcn_sched_barrier(0);
    float s1[16], s2[16]; unsigned i1[16], i2[16];
#pragma unroll
    for (int i = 0; i < 16; ++i) { const auto rr = __builtin_amdgcn_permlane32_swap(T[i], T[i], false, false);
        s1[i] = demono(rr[0] & ~0x7fu); i1[i] = 127u - (rr[0] & 0x7fu); s2[i] = demono(rr[1] & ~0x7fu); i2[i] = 127u - (rr[1] & 0x7fu); }
    unsigned C[64];
    { int n = 0;
#pragma unroll
      for (int a = 0; a < 16; ++a)
#pragma unroll
          for (int b = 0; b < 16; ++b) if ((a + 1) * (b + 1) <= 16) { C[n] = (mono(s1[a] + s2[b]) & ~0x3fffu) | (i1[a] << 7) | i2[b]; ++n; }
#pragma unroll
      for (int i = 50; i < 64; ++i) C[i] = 0u; }
    unsigned F[16];
#pragma unroll
    for (int i = 0; i < 16; ++i) F[i] = C[i];
    sort16_desc(F);
#pragma unroll
    for (int g = 1; g < 4; ++g) { unsigned L[16];
#pragma unroll
        for (int i = 0; i < 16; ++i) L[i] = C[16 * g + i];
        sort16_desc(L); merge_top16(F, L); __builtin_amdgcn_sched_barrier(0); }
    if (hi == 0) {
        float e[16]; float sum = 0.f; const float v0 = demono(F[0] & ~0x3fffu);
#pragma unroll
        for (int i = 0; i < 16; ++i) { e[i] = __expf(demono(F[i] & ~0x3fffu) - v0); sum += e[i]; }
        const float inv = 1.f / sum;
        int* ip = IDX + tok * 128 + h * 16; float* gp = PG + tok * 128 + h * 16;
#pragma unroll
        for (int q = 0; q < 4; ++q) { u32x4 iv; iv.x = F[4 * q] & 0x3fffu; iv.y = F[4 * q + 1] & 0x3fffu; iv.z = F[4 * q + 2] & 0x3fffu; iv.w = F[4 * q + 3] & 0x3fffu; *(u32x4*)(ip + 4 * q) = iv;
            f32x4 gv; gv[0] = e[4 * q] * inv; gv[1] = e[4 * q + 1] * inv; gv[2] = e[4 * q + 2] * inv; gv[3] = e[4 * q + 3] * inv; *(f32x4*)(gp + 4 * q) = gv; }
    }
}
typedef __bf16 bf16x2v __attribute__((ext_vector_type(2)));
DI float dot2bf(unsigned w, unsigned x, float acc) { return __builtin_amdgcn_fdot2_f32_bf16(__builtin_bit_cast(bf16x2v, w), __builtin_bit_cast(bf16x2v, x), acc, false); }
DI float gelu_erf(float v) {
    const float av = fabsf(v), t = __builtin_amdgcn_rcpf(av * 0.2316418882f + 1.0f);
    float q = t * 0.5307027145f + (-0.7265760135f); q = q * t + 0.7107068705f; q = q * t + (-0.142248368f); q = q * t + 0.127414796f; q = q * t;
    const float e = __builtin_amdgcn_exp2f((v * v) * (-0.72134752044f)); const float m = v * (q * e);
    return v < 0.f ? m : v - m;
}
DI float dppf(float v, const int ctrl_sel) {
    const int s = __float_as_int(v);
    int r;
    if (ctrl_sel == 0) r = __builtin_amdgcn_update_dpp(0, s, 0xB1, 0xF, 0xF, true);
    else if (ctrl_sel == 1) r = __builtin_amdgcn_update_dpp(0, s, 0x4E, 0xF, 0xF, true);
    else if (ctrl_sel == 2) r = __builtin_amdgcn_update_dpp(0, s, 0x141, 0xF, 0xF, true);
    else r = __builtin_amdgcn_update_dpp(0, s, 0x128, 0xF, 0xF, true);
    return __int_as_float(r);
}
DI int dppi(int s, const int ctrl_sel) {
    if (ctrl_sel == 0) return __builtin_amdgcn_update_dpp(0, s, 0xB1, 0xF, 0xF, true);
    if (ctrl_sel == 1) return __builtin_amdgcn_update_dpp(0, s, 0x4E, 0xF, 0xF, true);
    return __builtin_amdgcn_update_dpp(0, s, 0x141, 0xF, 0xF, true);
}
template <int NT>
DI void experts_u_slice(const unsigned char* __restrict__ H1Q, const unsigned char* __restrict__ U8x, const int* __restrict__ IDX, bf16_t* __restrict__ PD, size_t tok0, int ntok, int x, int lane) {
    const int g = lane >> 3, l8 = lane & 7;
    u32x4 hq[NT], iv[NT][4];
#pragma unroll
    for (int t = 0; t < NT; ++t) { hq[t] = *(const u32x4*)(H1Q + (tok0 + t) * D + 128 * x + 16 * l8);
#pragma unroll
        for (int q = 0; q < 4; ++q) iv[t][q] = *(const u32x4*)(IDX + (tok0 + t) * 128 + 16 * g + 4 * q); }
#pragma unroll 1
    for (int i = 0; i < ntok; i += NT) {
        const size_t tok = tok0 + i;
        u32x4 w[NT][16], hc[NT];
#pragma unroll
        for (int t = 0; t < NT; ++t) { hc[t] = hq[t];
#pragma unroll
            for (int j = 0; j < 16; ++j) w[t][j] = *(const u32x4*)(U8x + (size_t)(iv[t][j >> 2][j & 3] * 128u + 16u * l8)); }
        if (i + NT < ntok) {
#pragma unroll
            for (int t = 0; t < NT; ++t) { hq[t] = *(const u32x4*)(H1Q + (tok + NT + t) * D + 128 * x + 16 * l8);
#pragma unroll
                for (int q = 0; q < 4; ++q) iv[t][q] = *(const u32x4*)(IDX + (tok + NT + t) * 128 + 16 * g + 4 * q); }
        }
#pragma unroll
        for (int t = 0; t < NT; ++t) {
            float p[16];
#pragma unroll
            for (int j = 0; j < 16; ++j) { int d = 0;
#pragma unroll
                for (int q = 0; q < 4; ++q) d = __builtin_amdgcn_sdot4((int)w[t][j][q], (int)hc[t][q], d, false);
                d += dppi(d, 0); d += dppi(d, 1); d += dppi(d, 2); p[j] = (float)d; }
            if (l8 == 0) {
                u32x4 o0, o1;
                o0.x = cvtpk(p[0], p[1]); o0.y = cvtpk(p[2], p[3]); o0.z = cvtpk(p[4], p[5]); o0.w = cvtpk(p[6], p[7]);
                o1.x = cvtpk(p[8], p[9]); o1.y = cvtpk(p[10], p[11]); o1.z = cvtpk(p[12], p[13]); o1.w = cvtpk(p[14], p[15]);
                bf16_t* dp = PD + ((tok + t) * 8 + x) * 128 + 16 * g; *(u32x4*)dp = o0; *(u32x4*)(dp + 8) = o1;
            }
        }
    }
}
DI void experts_combine(const bf16_t* __restrict__ PD, const int* __restrict__ IDX, const float* __restrict__ PG, const float* __restrict__ USC, const float* __restrict__ VSC, const float* __restrict__ HSC,
                        unsigned char* __restrict__ C8, float* __restrict__ CSC, int wave0, int nwaves, int lane) {
    for (int tokb = wave0 * 2; tokb < M; tokb += nwaves * 2) {
        unsigned pw[2][8]; u32x2 rows[2]; f32x2 gt[2]; float hs[2];
#pragma unroll
        for (int r = 0; r < 2; ++r) { const size_t tok = (size_t)tokb + r;
#pragma unroll
            for (int x = 0; x < 8; ++x) pw[r][x] = *(const unsigned*)(PD + (tok * 8 + x) * 128 + 2 * lane);
            rows[r] = *(const u32x2*)(IDX + tok * 128 + 2 * lane); gt[r] = *(const f32x2*)(PG + tok * 128 + 2 * lane); hs[r] = HSC[tok]; }
#pragma unroll
        for (int r = 0; r < 2; ++r) { const size_t tok = (size_t)tokb + r;
            float s0 = 0.f, s1 = 0.f;
#pragma unroll
            for (int x = 0; x < 8; ++x) { s0 += __uint_as_float(pw[r][x] << 16); s1 += __uint_as_float(pw[r][x] & 0xffff0000u); }
            const float c0 = gt[r][0] * gelu_erf(s0 * USC[rows[r].x] * hs[r]) * VSC[rows[r].x], c1 = gt[r][1] * gelu_erf(s1 * USC[rows[r].y] * hs[r]) * VSC[rows[r].y];
            const float amax = wave_max(fmaxf(fabsf(c0), fabsf(c1)));
            const float qs = amax > 0.f ? 127.f / amax : 1.f;
            const unsigned short q2 = (unsigned short)(((unsigned)__float2int_rn(c0 * qs) & 0xffu) | (((unsigned)__float2int_rn(c1 * qs) & 0xffu) << 8));
            *(unsigned short*)(C8 + tok * 128 + 2 * lane) = q2;
            if (lane == 0) CSC[tok] = amax > 0.f ? amax * (1.f / 127.f) : 1.f;
        }
    }
}
template <int NT>
DI void experts_v_slice(const unsigned char* __restrict__ V8x, const int* __restrict__ IDX, const unsigned char* __restrict__ C8, const float* __restrict__ CSC, bf16_t* __restrict__ FFN, size_t tok0, int ntok, int x, int lane) {
    const int g = lane >> 3, l8 = lane & 7;
    u32x4 iv[NT][4], cqn[NT]; float csn[NT];
#pragma unroll
    for (int t = 0; t < NT; ++t) { cqn[t] = *(const u32x4*)(C8 + (tok0 + t) * 128 + 16 * g); csn[t] = CSC[tok0 + t];
#pragma unroll
        for (int q = 0; q < 4; ++q) iv[t][q] = *(const u32x4*)(IDX + (tok0 + t) * 128 + 16 * g + 4 * q); }
#pragma unroll 1
    for (int i = 0; i < ntok; i += NT) {
        const size_t tok = tok0 + i;
        u32x4 w[NT][16], cq[NT]; float csc[NT];
#pragma unroll
        for (int t = 0; t < NT; ++t) { cq[t] = cqn[t]; csc[t] = csn[t];
#pragma unroll
            for (int j = 0; j < 16; ++j) w[t][j] = *(const u32x4*)(V8x + (size_t)(iv[t][j >> 2][j & 3] * 128u + 16u * l8)); }
        if (i + NT < ntok) {
#pragma unroll
            for (int t = 0; t < NT; ++t) { cqn[t] = *(const u32x4*)(C8 + (tok + NT + t) * 128 + 16 * g); csn[t] = CSC[tok + NT + t];
#pragma unroll
                for (int q = 0; q < 4; ++q) iv[t][q] = *(const u32x4*)(IDX + (tok + NT + t) * 128 + 16 * g + 4 * q); }
        }
#pragma unroll
        for (int t = 0; t < NT; ++t) {
            int acc[16];
#pragma unroll
            for (int k = 0; k < 16; ++k) acc[k] = 0;
#pragma unroll
            for (int jj = 0; jj < 4; ++jj) {
                const int cdw = (int)cq[t][jj];
#pragma unroll
                for (int q = 0; q < 4; ++q) {
                    const unsigned r0 = w[t][4 * jj][q], r1 = w[t][4 * jj + 1][q], r2 = w[t][4 * jj + 2][q], r3 = w[t][4 * jj + 3][q];
                    const unsigned lo01 = __builtin_amdgcn_perm(r1, r0, 0x05010400u), hi01 = __builtin_amdgcn_perm(r1, r0, 0x07030602u);
                    const unsigned lo23 = __builtin_amdgcn_perm(r3, r2, 0x05010400u), hi23 = __builtin_amdgcn_perm(r3, r2, 0x07030602u);
                    acc[4 * q + 0] = __builtin_amdgcn_sdot4((int)__builtin_amdgcn_perm(lo23, lo01, 0x05040100u), cdw, acc[4 * q + 0], false);
                    acc[4 * q + 1] = __builtin_amdgcn_sdot4((int)__builtin_amdgcn_perm(lo23, lo01, 0x07060302u), cdw, acc[4 * q + 1], false);
                    acc[4 * q + 2] = __builtin_amdgcn_sdot4((int)__builtin_amdgcn_perm(hi23, hi01, 0x05040100u), cdw, acc[4 * q + 2], false);
                    acc[4 * q + 3] = __builtin_amdgcn_sdot4((int)__builtin_amdgcn_perm(hi23, hi01, 0x07060302u), cdw, acc[4 * q + 3], false);
                }
            }
            const float cs = csc[t];
#pragma unroll
            for (int k = 0; k < 8; ++k) { const auto rr = __builtin_amdgcn_permlane32_swap((unsigned)acc[k], (unsigned)acc[k + 8], false, false); acc[k] = (int)rr[0] + (int)rr[1]; }
#pragma unroll
            for (int k = 0; k < 4; ++k) { const auto rr = __builtin_amdgcn_permlane16_swap((unsigned)acc[k], (unsigned)acc[k + 4], false, false); acc[k] = (int)rr[0] + (int)rr[1]; }
            { const bool up = (lane & 8) != 0;
#pragma unroll
              for (int k = 0; k < 2; ++k) { const int send = up ? acc[k] : acc[k + 2], keep = up ? acc[k + 2] : acc[k]; acc[k] = keep + __builtin_amdgcn_update_dpp(0, send, 0x128, 0xF, 0xF, true); } }
            *(unsigned*)(FFN + (tok + t) * D + 128 * x + 16 * l8 + 2 * g) = cvtpk((float)acc[0] * cs, (float)acc[1] * cs);
        }
    }
}
template <int NR>
DI void ln2_tokens(const bf16_t* __restrict__ FFN, const unsigned char* __restrict__ H1Q, const float* __restrict__ HSC, const float* __restrict__ g2, const float* __restrict__ b2, float* __restrict__ outp, size_t tok0, int lane) {
    u32x4 fa[NR], fb[NR], hq[NR]; float hs[NR];
#pragma unroll
    for (int r = 0; r < NR; ++r) { const size_t o = (tok0 + r) * D + 16 * lane;
        fa[r] = *(const u32x4*)(FFN + o); fb[r] = *(const u32x4*)(FFN + o + 8); hq[r] = *(const u32x4*)(H1Q + o); hs[r] = HSC[tok0 + r] * ALPHA; }
#pragma unroll
    for (int r = 0; r < NR; ++r) {
        float* hr = outp + (tok0 + r) * D + 16 * lane;
        float ff[16], hh[16]; unpack8(fa[r], *(float(*)[8])&ff[0]); unpack8(fb[r], *(float(*)[8])&ff[8]);
#pragma unroll
        for (int j = 0; j < 4; ++j) { const unsigned w = hq[r][j] ^ 0x80808080u;
            hh[4 * j] = (float)(w & 0xffu) - 128.f; hh[4 * j + 1] = (float)((w >> 8) & 0xffu) - 128.f; hh[4 * j + 2] = (float)((w >> 16) & 0xffu) - 128.f; hh[4 * j + 3] = (float)(w >> 24) - 128.f; }
        f32x4 v[4]; float s = 0.f;
#pragma unroll
        for (int j = 0; j < 4; ++j)
#pragma unroll
            for (int e = 0; e < 4; ++e) { v[j][e] = hh[4 * j + e] * hs[r] + ff[4 * j + e]; s += v[j][e]; }
        const float mean = wave_sum(s) * (1.f / D); float q2 = 0.f;
#pragma unroll
        for (int j = 0; j < 4; ++j)
#pragma unroll
            for (int e = 0; e < 4; ++e) { v[j][e] -= mean; q2 += v[j][e] * v[j][e]; }
        const float rstd = rsqrtf(wave_sum(q2) * (1.f / D) + LN_EPS);
#pragma unroll
        for (int j = 0; j < 4; ++j) { const f32x4 gg = *(const f32x4*)(g2 + 16 * lane + 4 * j), bb = *(const f32x4*)(b2 + 16 * lane + 4 * j); *(f32x4*)(hr + 4 * j) = v[j] * rstd * gg + bb; }
    }
}

DI void p0_convert(const float* __restrict__ in, bf16_t* __restrict__ out, size_t n8, size_t first, size_t stride) {
    for (size_t i = first; i < n8; i += stride) { const f32x4 a = ((const f32x4*)in)[2 * i], b = ((const f32x4*)in)[2 * i + 1];
        u32x4 w; w.x = cvtpk(a[0], a[1]); w.y = cvtpk(a[2], a[3]); w.z = cvtpk(b[0], b[1]); w.w = cvtpk(b[2], b[3]); ((u32x4*)out)[i] = w; }
}
DI void p0_transpose_item(const float* __restrict__ W, int ldw, int ncols, bf16_t* __restrict__ out, int ldo, int koff, LAS float* scr, int item, int lane) {
    const int nblk = ncols / 32, kb = item / nblk, nb = item % nblk, k0 = 64 * kb, n0 = 32 * nb;
#pragma unroll 8
    for (int i = 0; i < 32; ++i) { const int kk = 2 * i + (lane >> 5); scr[kk * 33 + (lane & 31)] = W[(size_t)(k0 + kk) * ldw + n0 + (lane & 31)]; }
    asm volatile("s_waitcnt lgkmcnt(0)" ::: "memory");
    const int c = lane & 7;
#pragma unroll
    for (int j = 0; j < 4; ++j) { const int n = (lane >> 3) + 8 * j; const LAS float* s = scr + (8 * c) * 33 + n;
        u32x4 o; o.x = cvtpk(s[0 * 33], s[1 * 33]); o.y = cvtpk(s[2 * 33], s[3 * 33]); o.z = cvtpk(s[4 * 33], s[5 * 33]); o.w = cvtpk(s[6 * 33], s[7 * 33]);
        *(u32x4*)(out + (size_t)(n0 + n) * ldo + koff + k0 + 8 * c) = o; }
    asm volatile("s_waitcnt lgkmcnt(0)" ::: "memory");
}
template <int NR>
DI void p0_q8_rows(const float* __restrict__ src, unsigned char* __restrict__ dst, float* __restrict__ scale, int row0, int lane) {
    f32x4 v[NR][4];
#pragma unroll
    for (int r = 0; r < NR; ++r) { const f32x4* sp = (const f32x4*)(src + (size_t)(row0 + r) * D) + 4 * lane;
#pragma unroll
        for (int j = 0; j < 4; ++j) v[r][j] = sp[j]; }
#pragma unroll
    for (int r = 0; r < NR; ++r) {
        float mx = 0.f;
#pragma unroll
        for (int j = 0; j < 4; ++j) mx = fmaxf(mx, fmaxf(fmaxf(fabsf(v[r][j][0]), fabsf(v[r][j][1])), fmaxf(fabsf(v[r][j][2]), fabsf(v[r][j][3]))));
        mx = wave_max(mx);
        const float sc = mx > 0.f ? 127.f / mx : 1.f;
        u32x4 w;
#pragma unroll
        for (int j = 0; j < 4; ++j) w[j] = ((unsigned)__float2int_rn(v[r][j][0] * sc) & 0xffu) | (((unsigned)__float2int_rn(v[r][j][1] * sc) & 0xffu) << 8) | (((unsigned)__float2int_rn(v[r][j][2] * sc) & 0xffu) << 16) | (((unsigned)__float2int_rn(v[r][j][3] * sc) & 0xffu) << 24);
        *(u32x4*)(dst + (size_t)(lane >> 3) * ((size_t)NEXP * 128) + (size_t)(row0 + r) * 128 + 16 * (lane & 7)) = w;
        if (lane == 0) scale[row0 + r] = mx > 0.f ? mx * (1.f / 127.f) : 1.f;
    }
}
DI void p0_fold_tile(const float* __restrict__ wq, const float* __restrict__ keys, bf16_t* __restrict__ out, int* __restrict__ gmax, LAS float* sm, int tile, int tid) {
    const int hp = tile >> 4, d0 = (tile & 15) * 64;
    LAS float* skT = sm; LAS float* swT = sm + 128 * 132;
    { const int r = tid & 127;
      for (int c4 = (tid >> 7) * 4; c4 < 128; c4 += 16) { const f32x4 v = *(const f32x4*)(keys + (size_t)(hp * 128 + r) * 128 + c4);
          skT[(c4 + 0) * 132 + r] = v[0]; skT[(c4 + 1) * 132 + r] = v[1]; skT[(c4 + 2) * 132 + r] = v[2]; skT[(c4 + 3) * 132 + r] = v[3]; } }
    { const int r = tid & 63;
      for (int c4 = (tid >> 6) * 4; c4 < 128; c4 += 32) { const f32x4 v = *(const f32x4*)(wq + (size_t)(d0 + r) * 2048 + hp * 128 + c4);
          swT[(c4 + 0) * 68 + r] = v[0]; swT[(c4 + 1) * 68 + r] = v[1]; swT[(c4 + 2) * 68 + r] = v[2]; swT[(c4 + 3) * 68 + r] = v[3]; } }
    __syncthreads();
    const int nb = tid & 31, db = tid >> 5;
    f32x4 acc[4];
#pragma unroll
    for (int i = 0; i < 4; ++i) acc[i] = (f32x4){0.f, 0.f, 0.f, 0.f};
#pragma unroll 4
    for (int k = 0; k < 128; ++k) { const f32x4 a = *(const LAS f32x4*)(skT + k * 132 + 4 * nb), b = *(const LAS f32x4*)(swT + k * 68 + 4 * db);
#pragma unroll
        for (int i = 0; i < 4; ++i) acc[i] += b * a[i]; }
#pragma unroll
    for (int i = 0; i < 4; ++i) { u32x2 o; o.x = cvtpk(acc[i][0], acc[i][1]); o.y = cvtpk(acc[i][2], acc[i][3]); *(u32x2*)(out + (size_t)(hp * 128 + 4 * nb + i) * D + d0 + 4 * db) = o; }
    { float mx = 0.f;
#pragma unroll
      for (int i = 0; i < 4; ++i) mx = fmaxf(mx, fmaxf(fmaxf(fabsf(acc[i][0]), fabsf(acc[i][1])), fmaxf(fabsf(acc[i][2]), fabsf(acc[i][3]))));
      mx = wave_max(mx);
      if ((tid & 63) == 0) __hip_atomic_fetch_max(gmax, __float_as_int(mx), __ATOMIC_RELAXED, __HIP_MEMORY_SCOPE_AGENT); }
    __syncthreads();
}
DI unsigned q8pack(float a, float b, float c, float d) {
    const unsigned ia = __float_as_uint(a + 12582912.f), ib = __float_as_uint(b + 12582912.f), ic = __float_as_uint(c + 12582912.f), id = __float_as_uint(d + 12582912.f);
    return (ia & 0xffu) | ((ib & 0xffu) << 8) | ((ic & 0xffu) << 16) | (id << 24);
}
template <int NR>
DI void p0_x_rows(const float* __restrict__ x, bf16_t* __restrict__ xb, unsigned char* __restrict__ x8, float* __restrict__ xsc, int row0, int lane) {
    f32x4 v[NR][4];
#pragma unroll
    for (int r = 0; r < NR; ++r) { const f32x4* sp = (const f32x4*)(x + (size_t)(row0 + r) * D) + 4 * lane;
#pragma unroll
        for (int j = 0; j < 4; ++j) v[r][j] = sp[j]; }
#pragma unroll
    for (int r = 0; r < NR; ++r) {
        float mx = 0.f; u32x4 o0, o1;
#pragma unroll
        for (int j = 0; j < 4; ++j) { mx = fmaxf(mx, fmaxf(fmaxf(fabsf(v[r][j][0]), fabsf(v[r][j][1])), fmaxf(fabsf(v[r][j][2]), fabsf(v[r][j][3]))));
            if (j < 2) { o0[2 * j] = cvtpk(v[r][j][0], v[r][j][1]); o0[2 * j + 1] = cvtpk(v[r][j][2], v[r][j][3]); } else { o1[2 * (j - 2)] = cvtpk(v[r][j][0], v[r][j][1]); o1[2 * (j - 2) + 1] = cvtpk(v[r][j][2], v[r][j][3]); } }
        *(u32x4*)(xb + (size_t)(row0 + r) * D + 16 * lane) = o0; *(u32x4*)(xb + (size_t)(row0 + r) * D + 16 * lane + 8) = o1;
        mx = wave_max(mx);
        const float sc = mx > 0.f ? 127.f / mx : 1.f;
        u32x4 w;
#pragma unroll
        for (int j = 0; j < 4; ++j) w[j] = q8pack(v[r][j][0] * sc, v[r][j][1] * sc, v[r][j][2] * sc, v[r][j][3] * sc);
        *(u32x4*)(x8 + (size_t)(row0 + r) * D + 16 * lane) = w;
        if (lane == 0) { const float v = mx > 0.f ? mx * (1.f / 127.f) : 1.f; const int row = row0 + r, hi = row & ~(S - 1), s = row & (S - 1);
            xsc[row] = v; xsc[M + hi + ((s & 3) << 11) + (s >> 2)] = v; xsc[2 * M + hi + ((s & 15) << 9) + (s >> 4)] = v; }
    }
}
DI void p0_transpose_item_f8(const float* __restrict__ W, int ncols, const float* __restrict__ cmax, unsigned char* __restrict__ out8, float* __restrict__ wsc, LAS float* scr, int item, int lane) {
    const int nblk = ncols / 32, kb = item / nblk, nb = item % nblk, k0 = 64 * kb, n0 = 32 * nb;
    const float cm = cmax[0]; const float sc = cm > 0.f ? 127.f / cm : 1.f;
#pragma unroll 8
    for (int i = 0; i < 32; ++i) { const int kk = 2 * i + (lane >> 5); scr[kk * 33 + (lane & 31)] = W[(size_t)(k0 + kk) * INC + n0 + (lane & 31)] * sc; }
    asm volatile("s_waitcnt lgkmcnt(0)" ::: "memory");
    const int c = lane & 7;
#pragma unroll
    for (int j = 0; j < 4; ++j) { const int n = (lane >> 3) + 8 * j; const LAS float* s = scr + (8 * c) * 33 + n;
        u32x2 o; o.x = q8pack(s[0 * 33], s[1 * 33], s[2 * 33], s[3 * 33]); o.y = q8pack(s[4 * 33], s[5 * 33], s[6 * 33], s[7 * 33]);
        *(u32x2*)(out8 + (size_t)(n0 + n) * D + k0 + 8 * c) = o; }
    if (item == 0 && lane == 0) wsc[0] = cm > 0.f ? cm * (1.f / 127.f) : 1.f;
    asm volatile("s_waitcnt lgkmcnt(0)" ::: "memory");
}
DI void p0_misc(const float* __restrict__ hgrn_lb, const float* __restrict__ rel_bias, float* __restrict__ misc, int i) {
    if (i < 512) { const float a = hgrn_lb[i], b = hgrn_lb[512 + i]; const float mx = fmaxf(a, b); const float ea = expf(a - mx), eb = expf(b - mx); misc[i] = ea / (ea + eb); }
    if (i < 3 * 129) {
        const int g = i / 129, j = i % 129; const int dl = g == 0 ? 1 : (g == 1 ? 4 : 16); const int n = j * dl;
        int bucket;
        if (n < 16) bucket = n;
        else { const double v = log((double)n / 16.0) / log(128.0) * 16.0; int l = 16 + (int)v; bucket = l < 31 ? l : 31; }
        for (int h = 0; h < 4; ++h) misc[512 + i * 4 + h] = rel_bias[bucket * 12 + g * 4 + h];
    }
}
struct SchedMemKV {
    unsigned MEMB, W; int G, c;
    DI bool next(int i, g8::Unit& u) const {
        const int L = i * G + c; if (L >= 32) return false;
        u.dla = 1; u.dlb = 1;
        if (L < 16) { u.kind = 0; u.pm = L >> 1; u.pn = L & 1; u.a = MEMB + (unsigned)u.pm * 256u * D * 2u; u.b = W + (unsigned)u.pn * 256u * D * 2u; }
        else { const int q = L - 16; u.kind = 1; u.pm = q >> 3; u.pn = q & 7; u.a = W + (unsigned)(512 + u.pm * 256) * D * 2u; u.b = MEMB + (unsigned)u.pn * 256u * D * 2u; }
        return true;
    }
};
struct EpiMemKVF {
    static constexpr bool PERM = true, HOOK = false;
    bf16_t *MK, *MVT;
    DI void hook(f32x4 (&)[2][2][4][2], const g8::Unit&, int, int, int, int, int) const {}
    DI void operator()(const f32x4 (&acc)[2][2][4][2], const g8::Unit& u, int wr, int wc, int fr, int fq) const {
        const int rowl = wr * 64 + fr, d0 = wc * 32 + 8 * fq;
#pragma unroll
        for (int ai = 0; ai < 2; ++ai)
#pragma unroll
            for (int m = 0; m < 4; ++m) { const int R = u.pm * 256 + rowl + ai * 128 + m * 16;
#pragma unroll
                for (int bj = 0; bj < 2; ++bj) { const f32x4 v0 = acc[ai][bj][m][0], v1 = acc[ai][bj][m][1];
                    if (u.kind == 0) { const int b = R >> 8, mm = R & 255, h = u.pn * 2 + bj;
                        u32x4 w; w.x = cvtpk(v0[0], v0[1]); w.y = cvtpk(v0[2], v0[3]); w.z = cvtpk(v1[0], v1[1]); w.w = cvtpk(v1[2], v1[3]);
                        *(u32x4*)(MK + ((size_t)((b * 4 + h) * 8 + (mm >> 5))) * 4096 + frag_row_off(d0, mm & 31)) = w; }
                    else { const int h = R >> 7, d = R & 127, c = u.pn * 256 + bj * 128 + d0, b = c >> 8, mm = c & 255, kk = mm & 31;
                        bf16_t* blk = MVT + ((size_t)((b * 4 + h) * 8 + (mm >> 5))) * 4096 + (((d >> 5) * 2 + (kk >> 4)) * 64 + (d & 31)) * 8 + 4 * ((kk >> 3) & 1);
                        u32x2 wa, wb; wa.x = cvtpk(v0[0], v0[1]); wa.y = cvtpk(v0[2], v0[3]); wb.x = cvtpk(v1[0], v1[1]); wb.y = cvtpk(v1[2], v1[3]);
                        *(u32x2*)blk = wa; *(u32x2*)(blk + 32 * 8) = wb; } } }
    }
};

static_assert(HG_UNIT_BYTES <= LDSCTL_OFF, "hgrn LDS");
static_assert(HG_UNIT_BYTES <= LDSCTL_OFF, "hgrn LDS");
__global__ void __launch_bounds__(NTHR, 2) mega(Args args) {
    extern __shared__ __attribute__((aligned(16))) unsigned char lds_raw[];
    LAS unsigned char* lds = (LAS unsigned char*)lds_raw;
    volatile LAS unsigned* MISC = (volatile LAS unsigned*)(lds + MISC_OFF);
    for (int u = threadIdx.x; u < (LDS_BYTES - LDSCTL_OFF) / 4; u += NTHR) ((LAS unsigned*)(lds + LDSCTL_OFF))[u] = 0u;
    __syncthreads();
    unsigned char* ws = args.ws;
    constexpr int G = 256;
    constexpr bool ALL = true;
    XcdBarrier bar; bar.bar = (unsigned*)(ws + O_MISC + 16384); bar.x = 0; bar.st = nullptr;
    if (ALL) bar = xcd_barrier_post((unsigned*)(ws + O_MISC + 16384), MISC + 8);
#ifndef REP_MASK
#define REP_MASK 0
#endif
#define RUN(k) (true)
#define NREP(k) (((REP_MASK >> (k)) & 1) ? 2 : 1)
#define SEAM() do { if (ALL) xcd_barrier(bar); } while (0)
    for (int rep_ = 0; rep_ < NREP(PH_PRO); ++rep_) if (RUN(PH_PRO)) {
        int tid = threadIdx.x; asm volatile("" : "+v"(tid)); asm volatile("" : "+s"(ws)); int bid = blockIdx.x; asm volatile("" : "+s"(bid));
        const size_t gt = (size_t)bid * NTHR + tid, nth = (size_t)G * NTHR;
        p0_convert(karg_in(1), (bf16_t*)(ws + O_MEMB), (size_t)2048 * 1024 / 8, gt, nth);
        if (bid == 0) p0_misc(karg_in(6), karg_in(5), (float*)(ws + O_MISC), tid);
        if (bid == 1) { const float* bg = karg_in(3); for (int i = tid; i < 3072; i += NTHR) ((float*)(ws + O_BGATE))[i] = bg[i]; }
        const int wid = __builtin_amdgcn_readfirstlane(tid >> 6), lane = tid & 63;
        LAS float* scr = (LAS float*)(lds + wid * 16384);
        const int gw = bid * NWAVES + wid, ngw = G * NWAVES;
        for (int r = gw * 4; r < M; r += ngw * 4) p0_x_rows<4>(karg_in(0), (bf16_t*)(ws + O_XB), (unsigned char*)(ws + O_X8), (float*)(ws + O_XSC), r, lane);
        {
            const float* wi = karg_in(2); float mx = 0.f;
            for (int k = bid; k < D; k += G) for (int n = tid; n < INC; n += NTHR) mx = fmaxf(mx, fabsf(wi[(size_t)k * INC + n]));
            mx = wave_max(mx);
            if (lane == 0) __hip_atomic_fetch_max((int*)(ws + O_CMAX), __float_as_int(mx), __ATOMIC_RELAXED, __HIP_MEMORY_SCOPE_AGENT);
        }
        for (int r = gw * 4; r < 2 * NEXP; r += ngw * 4) {
            if (r < NEXP) p0_q8_rows<4>(karg_in(14), (unsigned char*)(ws + O_UB), (float*)(ws + O_USC), r, lane);
            else p0_q8_rows<4>(karg_in(15), (unsigned char*)(ws + O_VB), (float*)(ws + O_VSC), r - NEXP, lane);
        }
        constexpr int NJ = 12;
        for (int it = gw; ; it += ngw) {
            int r = it; bool done = true;
#pragma unroll
            for (int j = 0; j < NJ; ++j) {
                const int srcc[NJ] = {0, 4608, 5632, 6656, 7168, 3072, 5120, 0, 0, 0, 0, 0};
                const int cnt[NJ] = {3072, 512, 1024, 512, 3072, 1536, 512, 1024, 1024, 1024, 1024, 1024};
                const int drow[NJ] = {0, 3072, 3584, 4608, 5120, 8192, 9728, 0, 0, 0, 0, 0};
                const int Kj = (j >= 8 && j <= 10) ? 512 : 1024;
                const int items = (Kj / 64) * (cnt[j] / 32);
                if (done && r < items) {
                    const float* W; int ldw; bf16_t* o; int ldo, koff = 0;
                    if (j < 7) { done = false; }
                    else if (j == 7) { W = karg_in(4); ldw = 1024; o = (bf16_t*)(ws + O_WMKV); ldo = 1024; }
                    else if (j <= 10) { W = karg_in(8) + (size_t)(j - 8) * 512 * 1024; ldw = 1024; o = (bf16_t*)(ws + O_WBR); ldo = 1536; koff = (j - 8) * 512; }
                    else { W = karg_in(9); ldw = 1024; o = (bf16_t*)(ws + O_WOUT); ldo = 1024; }
                    if (j >= 7) { p0_transpose_item(W, ldw, cnt[j], o, ldo, koff, scr, r, lane); done = false; }
                }
                r -= items;
            }
            if (done) break;
        }
        __syncthreads();
        for (int tile = bid; tile < 256; tile += G) p0_fold_tile(karg_in(12), karg_in(13), (bf16_t*)(ws + O_WPQ), (int*)(ws + O_CMAX) + 1, (LAS float*)lds, tile, tid);
        SEAM();
        for (int it = gw; ; it += ngw) {
            int r = it; bool done = true;
#pragma unroll
            for (int j = 0; j < 7; ++j) {
                const int srcc[7] = {0, 4608, 5632, 6656, 7168, 3072, 5120};
                const int cnt[7] = {3072, 512, 1024, 512, 3072, 1536, 512};
                const int drow[7] = {0, 3072, 3584, 4608, 5120, 8192, 9728};
                const int items = 16 * (cnt[j] / 32);
                if (done && r < items) { p0_transpose_item_f8(karg_in(2) + srcc[j], cnt[j], (const float*)(ws + O_CMAX), (unsigned char*)(ws + O_W8) + (size_t)drow[j] * 1024, (float*)(ws + O_WSC), scr, r, lane); done = false; }
                r -= items;
            }
            if (done) break;
        }
        {
            const float cm = ((const float*)(ws + O_CMAX))[1]; const float sc = cm > 0.f ? 127.f / cm : 1.f;
            for (size_t i = gt; i < (size_t)2048 * D / 16; i += nth) { const u32x4 a = *(const u32x4*)(ws + O_WPQ + i * 32), b = *(const u32x4*)(ws + O_WPQ + i * 32 + 16);
                float f[8], g[8]; unpack8(a, f); unpack8(b, g);
                u32x4 o; o.x = q8pack(f[0] * sc, f[1] * sc, f[2] * sc, f[3] * sc); o.y = q8pack(f[4] * sc, f[5] * sc, f[6] * sc, f[7] * sc); o.z = q8pack(g[0] * sc, g[1] * sc, g[2] * sc, g[3] * sc); o.w = q8pack(g[4] * sc, g[5] * sc, g[6] * sc, g[7] * sc);
                *(u32x4*)(ws + O_WPQ8 + i * 16) = o; }
            if (gt == 0) ((float*)(ws + O_WSC))[1] = cm > 0.f ? cm * (1.f / 127.f) : 1.f;
        }
        SEAM();
    }
#pragma unroll 1
    for (int p = 0; p < NPASS; ++p) {
        int bid = blockIdx.x; asm volatile("" : "+s"(bid));
        int tid = threadIdx.x; asm volatile("" : "+v"(tid));
        asm volatile("" : "+s"(ws));
        char* pr = (char*)ws + O_PASS;
        const size_t t0 = (size_t)p * MP;
        for (int rep_ = 0; rep_ < NREP(PH_PROJ); ++rep_) if (RUN(PH_PROJ)) {
            asm volatile("" : "+s"(bid)); asm volatile("" : "+v"(tid)); asm volatile("" : "+s"(ws)); pr = (char*)ws + O_PASS;
            { SchedP1<0> Sc{(unsigned)(O_X8 + t0 * D), (unsigned)O_W8, G, bid};
              EpiP1<0> E{(char*)ws, (int)t0, 0};
              g8::gemm_phase<EpiP1<0>, SchedP1<0>, 2>(lds, (const char*)ws, D / 2, Sc, E, tid); }
            asm volatile("" : "+v"(tid)); asm volatile("" : "+s"(bid)); asm volatile("" : "+s"(ws));
            { SchedP1<1> Sc{(unsigned)(O_X8 + t0 * D), (unsigned)O_W8, G, bid};
              EpiP1<1> E{(char*)ws, (int)t0, 0};
              g8::gemm_phase<EpiP1<1>, SchedP1<1>, 2>(lds, (const char*)ws, D / 2, Sc, E, tid); }
            if (p == 0) {
                asm volatile("" : "+v"(tid)); asm volatile("" : "+s"(bid));
                SchedMemKV S2{(unsigned)O_MEMB, (unsigned)O_WMKV, G, bid};
                EpiMemKVF E2{(bf16_t*)(ws + O_MK), (bf16_t*)(ws + O_MVT)};
                g8::gemm_phase<EpiMemKVF, SchedMemKV>(lds, (const char*)ws, D, S2, E2, tid);
            }
            SEAM();
        }
        for (int rep_ = 0; rep_ < NREP(PH_ATTN); ++rep_) if (RUN(PH_ATTN)) {
            asm volatile("" : "+s"(bid)); asm volatile("" : "+v"(tid)); asm volatile("" : "+s"(ws)); pr = (char*)ws + O_PASS;
            const float* bsrc = (const float*)(ws + O_MISC) + 512; LAS float* btab = (LAS float*)lds;
            for (int i = tid; i < 3 * 129 * 4; i += NTHR) btab[i] = bsrc[i] * LOG2E;
            __syncthreads();
            const int wid = __builtin_amdgcn_readfirstlane(tid >> 6), lane = tid & 63;
            for (int task = bid * NWAVES + wid; task < DIL_TASKS; task += G * NWAVES)
                attn_dil_wave((const bf16_t*)(pr + P_QK), (const bf16_t*)(pr + P_VT), btab, lds + 8192 + wid * 8704, (bf16_t*)(pr + P_OG), (float*)(pr + P_LSE), task, lane);
            for (int task = bid * NWAVES + wid; task < MEM_TASKS; task += G * NWAVES)
                attn_mem_wave((const bf16_t*)(pr + P_MQ), (const bf16_t*)(ws + O_MK), (const bf16_t*)(ws + O_MVT), (bf16_t*)(pr + P_BR), task, p * BPP, lane);
            __syncthreads();
        }
        for (int rep_ = 0; rep_ < NREP(PH_HGPRE); ++rep_) if (RUN(PH_HGPRE)) {
            asm volatile("" : "+s"(bid)); asm volatile("" : "+v"(tid)); asm volatile("" : "+s"(ws)); pr = (char*)ws + O_PASS;
            { const int unit = bid; static_assert(HG_UNITS == 256, "one HGRN unit per workgroup"); if (unit < HG_UNITS) {
                hgrn_unit<false>(lds, unit, tid, (const bf16_t*)(pr + P_HFQG), (const bf16_t*)(pr + P_IT), (const float*)(ws + O_MISC), karg_in(7),
                                 (float*)(pr + P_HSTL), (float*)(pr + P_HSTD), (const float*)(pr + P_SIN), (bf16_t*)(pr + P_BR));
            } }
            SEAM();
        }
        for (int rep_ = 0; rep_ < NREP(PH_HGSCAN); ++rep_) if (RUN(PH_HGSCAN)) {
            asm volatile("" : "+s"(bid)); asm volatile("" : "+v"(tid)); asm volatile("" : "+s"(ws)); pr = (char*)ws + O_PASS;
            hgrn_scan((const float*)(pr + P_HSTL), (const float*)(pr + P_HSTD), (float*)(pr + P_SIN), bid * NTHR + tid);
            lse_merge_items((const bf16_t*)(pr + P_OG), (const float*)(pr + P_LSE), (bf16_t*)(pr + P_BR), bid * NTHR + tid, G * NTHR);
            SEAM();
        }
        for (int rep_ = 0; rep_ < NREP(PH_HGMAIN); ++rep_) if (RUN(PH_HGMAIN)) {
            asm volatile("" : "+s"(bid)); asm volatile("" : "+v"(tid)); asm volatile("" : "+s"(ws)); pr = (char*)ws + O_PASS;
            { const int unit = bid; static_assert(HG_UNITS == 256, "one HGRN unit per workgroup"); if (unit < HG_UNITS) {
                hgrn_unit<true>(lds, unit, tid, (const bf16_t*)(pr + P_HFQG), (const bf16_t*)(pr + P_IT), (const float*)(ws + O_MISC), karg_in(7),
                                (float*)(pr + P_HSTL), (float*)(pr + P_HSTD), (const float*)(pr + P_SIN), (bf16_t*)(pr + P_BR));
            } }
            SEAM();
        }
        for (int rep_ = 0; rep_ < NREP(PH_WIDEN); ++rep_) if (RUN(PH_WIDEN)) {
            asm volatile("" : "+s"(bid)); asm volatile("" : "+v"(tid)); asm volatile("" : "+s"(ws)); pr = (char*)ws + O_PASS;
            SchedRows Sc{(unsigned)(O_PASS + P_BR), (unsigned)O_WBR, 1536, 4, 256, G, bid};
            EpiWidenF E{(const bf16_t*)(pr + P_GATE), (bf16_t*)(pr + P_MERGED)};
            g8::gemm_phase<EpiWidenF, SchedRows>(lds, (const char*)ws, 1536, Sc, E, tid);
            SEAM();
        }
        for (int rep_ = 0; rep_ < NREP(PH_WOUT); ++rep_) if (RUN(PH_WOUT)) {
            asm volatile("" : "+s"(bid)); asm volatile("" : "+v"(tid)); asm volatile("" : "+s"(ws)); pr = (char*)ws + O_PASS;
            SchedRows Sc{(unsigned)(O_PASS + P_MERGED), (unsigned)O_WOUT, 1024, 4, 256, G, bid};
            EpiPlainB16 E{(bf16_t*)(pr + P_MIX), 1024, 0};
            g8::gemm_phase<EpiPlainB16, SchedRows>(lds, (const char*)ws, 1024, Sc, E, tid);
            SEAM();
        }
        for (int rep_ = 0; rep_ < NREP(PH_LN1); ++rep_) if (RUN(PH_LN1)) {
            asm volatile("" : "+s"(bid)); asm volatile("" : "+v"(tid)); asm volatile("" : "+s"(ws)); pr = (char*)ws + O_PASS;
            ln1_rows<4>((const bf16_t*)(ws + O_XB) + t0 * D, (const bf16_t*)(pr + P_MIX), karg_in(10), karg_in(11), (bf16_t*)(ws + O_H1B) + t0 * D, (unsigned char*)(ws + O_H1Q) + t0 * D, (float*)(ws + O_HSC) + t0, bid * NWAVES + (tid >> 6), G * NWAVES, tid & 63);
        }
    }
    for (int rep_ = 0; rep_ < NREP(PH_PQ); ++rep_) if (RUN(PH_PQ)) {
        SEAM();
        int tid = threadIdx.x; asm volatile("" : "+v"(tid)); asm volatile("" : "+s"(ws)); int bid = blockIdx.x; asm volatile("" : "+s"(bid));
        char* pr = (char*)ws + O_PASS;
        SchedRows Sc{(unsigned)O_H1Q, (unsigned)O_WPQ8, 512, 8, 2048, G, bid};
        EpiScores E{(bf16_t*)(pr + P_PQ), (const float*)(ws + O_HSC), (const float*)(ws + O_WSC) + 1};
        g8::gemm_phase<EpiScores, SchedRows, 2>(lds, (const char*)ws, 512, Sc, E, tid);
        SEAM();
    }
    for (int rep_ = 0; rep_ < NREP(PH_ROUTE); ++rep_) if (RUN(PH_ROUTE)) {
        int tid = threadIdx.x; asm volatile("" : "+v"(tid)); asm volatile("" : "+s"(ws)); int bid = blockIdx.x; asm volatile("" : "+s"(bid));
        char* pr = (char*)ws + O_PASS;
        const int wid = __builtin_amdgcn_readfirstlane(tid >> 6), lane = tid & 63;
        for (int task = bid * NWAVES + wid; task < (M / 32) * 8; task += G * NWAVES)
            route_wave((const bf16_t*)(pr + P_PQ), (int*)(pr + P_IDX), (float*)(pr + P_PG), task >> 3, task & 7, lane);
        SEAM();
    }
    if (RUN(PH_EXPERTS)) {
        int tid = threadIdx.x; asm volatile("" : "+v"(tid)); asm volatile("" : "+s"(ws)); int bid = blockIdx.x; asm volatile("" : "+s"(bid));
        char* pr = (char*)ws + O_PASS;
        const int wid = __builtin_amdgcn_readfirstlane(tid >> 6), lane = tid & 63;
        if (tid == 0) {
            unsigned base = 0; const unsigned myx = ALL ? bar.x : 0u;
            if (ALL) { for (unsigned jx = 0; jx < 16; ++jx) { const unsigned c = xb_ld(&bar.bar[XB_XCNT(jx)]); if (jx < myx) base += c; } MISC[12] = base + MISC[10]; }
            else MISC[12] = (unsigned)bid;
        }
        __syncthreads();
        const int vwg = (int)MISC[12];
        const int nper = G >> 3, x = vwg / nper, r = vwg % nper;
        const int tpw = M / (nper * NWAVES);
        const size_t tokw0 = (size_t)(r * NWAVES + wid) * tpw;
        {
            const unsigned char* U8x = (const unsigned char*)(ws + O_UB) + (size_t)x * ((size_t)NEXP * 128);
            experts_u_slice<2>((const unsigned char*)(ws + O_H1Q), U8x, (const int*)(pr + P_IDX), (bf16_t*)(pr + P_PD), tokw0, tpw, x, lane);
        }
        SEAM();
        experts_combine((const bf16_t*)(pr + P_PD), (const int*)(pr + P_IDX), (const float*)(pr + P_PG), (const float*)(ws + O_USC), (const float*)(ws + O_VSC), (const float*)(ws + O_HSC), (unsigned char*)(pr + P_C), (float*)(pr + P_C + (size_t)M * 128), bid * NWAVES + wid, G * NWAVES, lane);
        SEAM();
        {
            const unsigned char* V8x = (const unsigned char*)(ws + O_VB) + (size_t)x * ((size_t)NEXP * 128);
            experts_v_slice<2>(V8x, (const int*)(pr + P_IDX), (const unsigned char*)(pr + P_C), (const float*)(pr + P_C + (size_t)M * 128), (bf16_t*)(pr + P_FFN), tokw0, tpw, x, lane);
        }
        SEAM();
        for (int tok = (bid * NWAVES + wid) * 4; tok < M; tok += G * NWAVES * 4) ln2_tokens<4>((const bf16_t*)(pr + P_FFN), (const unsigned char*)(ws + O_H1Q), (const float*)(ws + O_HSC), karg_in(16), karg_in(17), karg_out(), (size_t)tok, lane);
    }
#undef RUN
#undef SEAM
}

extern "C" void kernel_launch(void* const* d_in, const int* in_sizes, int n_in, void* d_out, int out_size, void* d_ws, size_t ws_size, hipStream_t stream) {
    if (ws_size < WS_NEED || n_in != 18) return;
    static bool attr_set = false;
    if (!attr_set) { (void)hipFuncSetAttribute((const void*)mega, hipFuncAttributeMaxDynamicSharedMemorySize, LDS_BYTES); attr_set = true; }
    (void)hipMemsetAsync((char*)d_ws + O_MISC + 16384, 0, 16384, stream);
    (void)hipMemsetAsync((char*)d_ws + O_CMAX, 0, (size_t)INC * 4, stream);
    Args a{}; for (int i = 0; i < 18; ++i) a.in[i] = (const float*)d_in[i]; a.out = (float*)d_out; a.ws = (unsigned char*)d_ws; a.ph = PH_ALL; a.pass = 0;
    mega<<<256, NTHR, LDS_BYTES, stream>>>(a);
}
```
